# Optimizing an MI355X kernel written in HIP

```python
import math
import jax, jax.numpy as jnp
from jax import lax
import numpy as np

D_MODEL = 2048
BATCH = 1
SEQ = 8192
DEPTH = 2

N_MEM = 256
MLA_HEADS = 6
MLA_Q_RANK = 384
MLA_KV_RANK = 128
MLA_NOPE = 128
MLA_ROPE = 64
MLA_V = 128
ROPE_THETA = 10000.0
DIL_HEADS = 6
DIL_HEAD_DIM = 128
DIL_BRANCHES = ((128, 1), (512, 4), (2048, 16))
MEM_HEADS = 4
MEM_HEAD_DIM = 128
W_MLA = MLA_HEADS * MLA_V
W_DIL = DIL_HEADS * DIL_HEAD_DIM
W_MEM = MEM_HEADS * MEM_HEAD_DIM
D_MIX = W_MLA + W_DIL + W_MEM
IN_MLA = MLA_Q_RANK + MLA_KV_RANK + MLA_ROPE
IN_DIL = 3 * W_DIL
IN_MEM = W_MEM
D_IN = IN_MLA + IN_DIL + IN_MEM
REL_BUCKETS = 32
REL_MAX_DIST = 1024
D_FF = 5632
N_EXPERTS = 8
TOP_K = 2
D_FF_EXPERT = 7168
N_DENSE = (DEPTH + 1) // 2
N_MOE = DEPTH // 2

Q_BLOCK = 128
EPS = 1e-6
NEG_INF = -1e30

kernel_name = "hybrid_mla_dilated_memory_moe_encoder"


def rmsnorm(x, g):
    xf = x.astype(jnp.float32)
    y = xf * lax.rsqrt(jnp.mean(xf * xf, axis=-1, keepdims=True) + EPS)
    return (y * g.astype(jnp.float32)).astype(x.dtype)


def t5_bucket(rel):
    nb = REL_BUCKETS // 2
    ret = (rel > 0).astype(np.int32) * nb
    n = np.abs(rel)
    max_exact = nb // 2
    large = max_exact + (np.log(np.maximum(n, 1) / max_exact)
                         / np.log(REL_MAX_DIST / max_exact) * (nb - max_exact)).astype(np.int32)
    large = np.minimum(large, nb - 1)
    return (ret + np.where(n < max_exact, n, large)).astype(np.int32)


def rope_tables(pos):
    half = MLA_ROPE // 2
    inv = 1.0 / (ROPE_THETA ** (jnp.arange(half, dtype=jnp.float32) / half))
    ang = pos.astype(jnp.float32)[..., None] * inv
    return jnp.cos(ang), jnp.sin(ang)


def apply_rope(x, cos, sin):
    half = MLA_ROPE // 2
    xf = x.astype(jnp.float32)
    x1, x2 = xf[..., :half], xf[..., half:]
    return jnp.concatenate([x1 * cos - x2 * sin, x1 * sin + x2 * cos], axis=-1).astype(x.dtype)


def mla_attention(h, pos, g_q, w_uq, g_kv, w_ukv):
    B, S, _ = h.shape
    c_q = h[..., :MLA_Q_RANK]
    c_kv = h[..., MLA_Q_RANK:MLA_Q_RANK + MLA_KV_RANK]
    k_rope = h[..., MLA_Q_RANK + MLA_KV_RANK:]
    q = (rmsnorm(c_q, g_q) @ w_uq).reshape(B, S, MLA_HEADS, MLA_NOPE + MLA_ROPE)
    kv = (rmsnorm(c_kv, g_kv) @ w_ukv).reshape(B, S, MLA_HEADS, MLA_NOPE + MLA_V)
    cos, sin = rope_tables(pos)
    q_nope = q[..., :MLA_NOPE].transpose(0, 2, 1, 3)
    q_rope = apply_rope(q[..., MLA_NOPE:], cos[:, :, None], sin[:, :, None]).transpose(0, 2, 1, 3)
    k_rope = apply_rope(k_rope, cos, sin)
    k_nope = kv[..., :MLA_NOPE].transpose(0, 2, 1, 3)
    v = kv[..., MLA_NOPE:].transpose(0, 2, 1, 3)
    scale = (MLA_NOPE + MLA_ROPE) ** -0.5

    def block(i):
        s0 = i * Q_BLOCK
        qn = lax.dynamic_slice_in_dim(q_nope, s0, Q_BLOCK, axis=2)
        qr = lax.dynamic_slice_in_dim(q_rope, s0, Q_BLOCK, axis=2)
        s = (jnp.einsum('bhqd,bhkd->bhqk', qn, k_nope)
             + jnp.einsum('bhqr,bkr->bhqk', qr, k_rope)).astype(jnp.float32) * scale
        p = jax.nn.softmax(s, axis=-1).astype(v.dtype)
        return jnp.einsum('bhqk,bhkd->bhqd', p, v)

    out = lax.map(block, jnp.arange(S // Q_BLOCK))
    return out.transpose(1, 0, 3, 2, 4).reshape(B, S, W_MLA)


def dilated_attention(h, rel_bias):
    B, S, _ = h.shape
    qkv = h.reshape(B, S, 3, DIL_HEADS, DIL_HEAD_DIM)
    q = qkv[:, :, 0].transpose(0, 2, 1, 3)
    k = qkv[:, :, 1].transpose(0, 2, 1, 3)
    v = qkv[:, :, 2].transpose(0, 2, 1, 3)
    scale = DIL_HEAD_DIM ** -0.5
    branches = []
    for (w, d) in DIL_BRANCHES:
        n_side = w // (2 * d)
        offs = np.arange(-n_side, n_side + 1, dtype=np.int32) * d
        bias = jnp.take(rel_bias, jnp.asarray(t5_bucket(offs)), axis=0).T.astype(jnp.float32)
        branches.append((jnp.asarray(offs), bias))

    def block(i):
        s0 = i * Q_BLOCK
        qb = lax.dynamic_slice_in_dim(q, s0, Q_BLOCK, axis=2)
        qpos = s0 + jnp.arange(Q_BLOCK, dtype=jnp.int32)
        outs, lses = [], []
        for offs, bias in branches:
            idx = qpos[:, None] + offs[None, :]
            valid = (idx >= 0) & (idx < S)
            idx_c = jnp.clip(idx, 0, S - 1)
            kg = jnp.take(k, idx_c, axis=2)
            vg = jnp.take(v, idx_c, axis=2)
            s = jnp.einsum('bhqd,bhqnd->bhqn', qb, kg).astype(jnp.float32) * scale + bias[:, None, :]
            s = jnp.where(valid, s, NEG_INF)
            lse = jax.nn.logsumexp(s, axis=-1, keepdims=True)
            p = jnp.exp(s - lse).astype(vg.dtype)
            outs.append(jnp.einsum('bhqn,bhqnd->bhqd', p, vg).astype(jnp.float32))
            lses.append(lse)
        wgt = jax.nn.softmax(jnp.concatenate(lses, axis=-1), axis=-1)
        o = jnp.einsum('bhqj,jbhqd->bhqd', wgt, jnp.stack(outs, axis=0))
        return o.astype(h.dtype)

    out = lax.map(block, jnp.arange(S // Q_BLOCK))
    return out.transpose(1, 0, 3, 2, 4).reshape(B, S, W_DIL)


def memory_attention(h, mem_n, w_mem_kv):
    B, S, _ = h.shape
    q = h.reshape(B, S, MEM_HEADS, MEM_HEAD_DIM)
    kv = (mem_n @ w_mem_kv).reshape(B, mem_n.shape[1], 2, MEM_HEADS, MEM_HEAD_DIM)
    k, v = kv[:, :, 0], kv[:, :, 1]
    s = jnp.einsum('bshd,bmhd->bhsm', q, k).astype(jnp.float32) * (MEM_HEAD_DIM ** -0.5)
    p = jax.nn.softmax(s, axis=-1).astype(v.dtype)
    return jnp.einsum('bhsm,bmhd->bshd', p, v).reshape(B, S, W_MEM)


def swiglu(h, w_gate, w_up, w_down):
    return (jax.nn.silu(h @ w_gate) * (h @ w_up)) @ w_down


def moe_swiglu(h, w_router, w_gate, w_up, w_down):
    logits = (h @ w_router).astype(jnp.float32)
    top_v, top_i = lax.top_k(logits, TOP_K)
    gates = jax.nn.softmax(top_v, axis=-1)
    combine = jnp.sum(jax.nn.one_hot(top_i, N_EXPERTS, dtype=jnp.float32) * gates[..., None], axis=-2)
    out = jnp.zeros(h.shape[:-1] + (w_down.shape[-1],), jnp.float32)
    for e in range(N_EXPERTS):
        out = out + combine[..., e:e + 1] * swiglu(h, w_gate[e], w_up[e], w_down[e]).astype(jnp.float32)
    return out.astype(h.dtype)


def setup_inputs(seed: int = 0) -> dict:
    key = jax.random.key(seed)
    ks = jax.random.split(key, 24)
    f32 = jnp.float32

    def w(k, shape, fan_in):
        return jax.random.normal(k, shape, f32) * (fan_in ** -0.5)

    def gain(k, shape):
        return 1.0 + 0.05 * jax.random.normal(k, shape, f32)

    x = jax.random.normal(ks[0], (BATCH, SEQ, D_MODEL), f32)
    mem = jax.random.normal(ks[1], (BATCH, N_MEM, D_MODEL), f32)
    positions = (jnp.arange(SEQ, dtype=jnp.int32)[None, :]
                 + jax.random.randint(ks[2], (BATCH, 1), 0, 4096, dtype=jnp.int32))
    return {
        "x": x,
        "mem": mem,
        "positions": positions,
        "rel_bias": 0.5 * jax.random.normal(ks[3], (REL_BUCKETS, DIL_HEADS), f32),
        "norm_mix": gain(ks[4], (DEPTH, D_MODEL)),
        "w_in": w(ks[5], (DEPTH, D_MODEL, D_IN), D_MODEL),
        "mla_q_norm": gain(ks[6], (DEPTH, MLA_Q_RANK)),
        "mla_w_uq": w(ks[7], (DEPTH, MLA_Q_RANK, MLA_HEADS * (MLA_NOPE + MLA_ROPE)), MLA_Q_RANK),
        "mla_kv_norm": gain(ks[8], (DEPTH, MLA_KV_RANK)),
        "mla_w_ukv": w(ks[9], (DEPTH, MLA_KV_RANK, MLA_HEADS * (MLA_NOPE + MLA_V)), MLA_KV_RANK),
        "norm_mem": gain(ks[10], (DEPTH, D_MODEL)),
        "w_mem_kv": w(ks[11], (DEPTH, D_MODEL, 2 * W_MEM), D_MODEL),
        "out_norm": gain(ks[12], (DEPTH, D_MIX)),
        "w_out": w(ks[13], (DEPTH, D_MIX, D_MODEL), D_MIX),
        "norm_ffn": gain(ks[14], (DEPTH, D_MODEL)),
        "ffn_w_gate": w(ks[15], (N_DENSE, D_MODEL, D_FF), D_MODEL),
        "ffn_w_up": w(ks[16], (N_DENSE, D_MODEL, D_FF), D_MODEL),
        "ffn_w_down": w(ks[17], (N_DENSE, D_FF, D_MODEL), D_FF),
        "moe_w_router": w(ks[18], (N_MOE, D_MODEL, N_EXPERTS), D_MODEL),
        "moe_w_gate": w(ks[19], (N_MOE, N_EXPERTS, D_MODEL, D_FF_EXPERT), D_MODEL),
        "moe_w_up": w(ks[20], (N_MOE, N_EXPERTS, D_MODEL, D_FF_EXPERT), D_MODEL),
        "moe_w_down": w(ks[21], (N_MOE, N_EXPERTS, D_FF_EXPERT, D_MODEL), D_FF_EXPERT),
        "norm_final": gain(ks[22], (D_MODEL,)),
    }


def reference(x, mem, positions, rel_bias, norm_mix, w_in, mla_q_norm, mla_w_uq, mla_kv_norm,
              mla_w_ukv, norm_mem, w_mem_kv, out_norm, w_out, norm_ffn, ffn_w_gate, ffn_w_up,
              ffn_w_down, moe_w_router, moe_w_gate, moe_w_up, moe_w_down, norm_final):
    for l in range(DEPTH):
        h = rmsnorm(x, norm_mix[l])
        proj = h @ w_in[l]
        a_in = proj[..., :IN_MLA]
        b_in = proj[..., IN_MLA:IN_MLA + IN_DIL]
        c_in = proj[..., IN_MLA + IN_DIL:]
        y_a = mla_attention(a_in, positions, mla_q_norm[l], mla_w_uq[l], mla_kv_norm[l], mla_w_ukv[l])
        y_b = dilated_attention(b_in, rel_bias)
        y_c = memory_attention(c_in, rmsnorm(mem, norm_mem[l]), w_mem_kv[l])
        g = out_norm[l]
        y = jnp.concatenate([rmsnorm(y_a, g[:W_MLA]),
                             rmsnorm(y_b, g[W_MLA:W_MLA + W_DIL]),
                             rmsnorm(y_c, g[W_MLA + W_DIL:])], axis=-1)
        x = x + y @ w_out[l]
        h = rmsnorm(x, norm_ffn[l])
        if l % 2 == 0:
            j = l // 2
            f = swiglu(h, ffn_w_gate[j], ffn_w_up[j], ffn_w_down[j])
        else:
            j = l // 2
            f = moe_swiglu(h, moe_w_router[j], moe_w_gate[j], moe_w_up[j], moe_w_down[j])
        x = x + f
    return rmsnorm(x, norm_final)
```

```cpp
#include <hip/hip_runtime.h>
#include <cstdio>
#include <cstdint>
#include <cmath>
#ifndef MK_N_LAUNCHES
#define MK_N_LAUNCHES 23
#endif
namespace pg8 {
#define PG8_LAS __attribute__((address_space(3)))
typedef unsigned short bf16_t;
typedef short bf16x8 __attribute__((ext_vector_type(8)));
typedef float f32x4 __attribute__((ext_vector_type(4)));
typedef unsigned u32x4 __attribute__((ext_vector_type(4)));
constexpr int BM = 256, BK = 64, HALF = 128, HTB = HALF * BK * 2  , STAGE_BYTES = 8 * HTB, NXCD = 8, WGM = 8;

__host__ __device__ __forceinline__ int lds_byte(int r, int c) { const int st = (r >> 4) * 2 + (c >> 5), rr = r & 15, cc = c & 31, ob = rr * 64 + cc * 2; return st * 1024 + (ob ^ (((ob >> 9) & 1) << 5)); }
__host__ __device__ __forceinline__ void stage_rc(int b, int& R, int& C) { const int st = b / 1024, sb = b % 1024, swz = sb ^ (((sb >> 9) & 1) << 5); R = (st >> 1) * 16 + swz / 64; C = (st & 1) * 32 + (swz % 64) / 2; }
__host__ __device__ __forceinline__ int perm32(int rho) { const int n = rho >> 4, i = rho & 15; return 8 * (i >> 2) + 4 * n + (i & 3); }

struct Unit { int pm, pn; };
struct Gemm { const bf16_t* A; const bf16_t* Bt; int lda, ldb, K; };

struct StaticOrder {
    int nM, nN, nwg, G, c;
    __device__ void init(int M, int N, int G_, int c_) { nM = M / BM; nN = N / BM; nwg = nM * nN; G = G_; c = c_; }
    __device__ bool next(int i, Unit& u) const {
        const long L = (long)i * G + c; if (L >= nwg) return false;
        int wgid = (int)L; { const int q = nwg / NXCD, r = nwg % NXCD, xcd = wgid % NXCD, off = wgid / NXCD; wgid = (xcd < r ? xcd * (q + 1) : r * (q + 1) + (xcd - r) * q) + off; }
        const int nig = WGM * nN, gid = wgid / nig, fm = gid * WGM, gsz = (nM - fm) < WGM ? (nM - fm) : WGM;
        u.pm = fm + ((wgid % nig) % gsz); u.pn = (wgid % nig) / gsz; return true;
    }
    __device__ __forceinline__ const char* abase(const Gemm& g, const Unit& u) const { return (const char*)g.A + (size_t)u.pm * BM * g.lda * 2; }
    __device__ __forceinline__ const char* bbase(const Gemm& g, const Unit& u) const { return (const char*)g.Bt + (size_t)u.pn * BM * g.ldb * 2; }
};
struct InProjOrder {
    StaticOrder so; int nextra; const bf16_t* A2; const bf16_t* B2;
    __device__ bool next(int i, Unit& u) const { if (so.next(i, u)) return true; const long L = (long)i * so.G + so.c - so.nwg; if (L < 0 || L >= nextra) return false; u.pm = 32 + (int)(L >> 2); u.pn = (int)(L & 3); return true; }
    __device__ __forceinline__ const char* abase(const Gemm& g, const Unit& u) const { return u.pm < 32 ? (const char*)g.A + (size_t)u.pm * BM * g.lda * 2 : (const char*)A2 + (size_t)(u.pm - 32) * BM * g.lda * 2; }
    __device__ __forceinline__ const char* bbase(const Gemm& g, const Unit& u) const { return u.pm < 32 ? (const char*)g.Bt + (size_t)u.pn * BM * g.ldb * 2 : (const char*)B2 + (size_t)((u.pm - 32) * 1024 + u.pn * BM) * g.ldb * 2; }
};
struct MemOrder {
    int G, c;
    __device__ bool next(int i, Unit& u) const { const int L = c - (G - 8); if (i != 0 || L < 0 || L >= 8) return false; u.pm = L >> 2; u.pn = L & 3; return true; }
    __device__ __forceinline__ const char* abase(const Gemm& g, const Unit& u) const { return (const char*)g.A + (size_t)u.pm * BM * g.lda * 2; }
    __device__ __forceinline__ const char* bbase(const Gemm& g, const Unit& u) const { return (const char*)g.Bt + (size_t)(u.pm * 1024 + u.pn * BM) * g.ldb * 2; }
};
struct MoeOrder {
    int G, c, nN, ntile, nexp_rows; const int* tile_e;
    __device__ bool next(int i, Unit& u) const { const long L = (long)i * G + c; if (L >= (long)ntile * nN) return false; u.pm = (int)(L / nN); u.pn = (int)(L % nN); return true; }
    __device__ __forceinline__ const char* abase(const Gemm& g, const Unit& u) const { return (const char*)g.A + (size_t)u.pm * BM * g.lda * 2; }
    __device__ __forceinline__ const char* bbase(const Gemm& g, const Unit& u) const { const int e = __builtin_amdgcn_readfirstlane(tile_e[u.pm]); return (const char*)g.Bt + ((size_t)e * nexp_rows + (size_t)u.pn * BM) * g.ldb * 2; }
};

__device__ __forceinline__ unsigned cvt_pk_bf16(float lo, float hi) { unsigned r; asm volatile("v_cvt_pk_bf16_f32 %0, %1, %2" : "=v"(r) : "v"(lo), "v"(hi)); return r; }

struct EpiBf16 {
    static constexpr bool PERM = true;
    bf16_t* O; int ldc;
    __device__ __forceinline__ void operator()(const f32x4 (&acc)[2][2][4][2], const Unit& u, int wr, int wc, int fr, int fq) const {
        const int row0 = u.pm * BM + wr * 64 + fr, col0 = u.pn * BM + wc * 32 + 8 * fq;
#pragma unroll
        for (int ai = 0; ai < 2; ++ai)
#pragma unroll
            for (int m = 0; m < 4; ++m) { bf16_t* rowp = O + (size_t)(row0 + ai * HALF + m * 16) * ldc + col0;
#pragma unroll
                for (int bj = 0; bj < 2; ++bj) { const f32x4 v0 = acc[ai][bj][m][0], v1 = acc[ai][bj][m][1];
                    u32x4 w; w.x = cvt_pk_bf16(v0[0], v0[1]); w.y = cvt_pk_bf16(v0[2], v0[3]); w.z = cvt_pk_bf16(v1[0], v1[1]); w.w = cvt_pk_bf16(v1[2], v1[3]);
                    *(u32x4*)(rowp + bj * HALF) = w; } }
    }
};
struct EpiBf16Sel {
    static constexpr bool PERM = true;
    bf16_t* O; int ldc; bf16_t* O2; int ldc2;
    __device__ __forceinline__ void operator()(const f32x4 (&acc)[2][2][4][2], const Unit& u, int wr, int wc, int fr, int fq) const {
        const bool ex = u.pm >= 32; bf16_t* base = ex ? O2 : O; const int ld = ex ? ldc2 : ldc;
        const int row0 = (ex ? u.pm - 32 : u.pm) * BM + wr * 64 + fr, col0 = u.pn * BM + wc * 32 + 8 * fq;
#pragma unroll
        for (int ai = 0; ai < 2; ++ai)
#pragma unroll
            for (int m = 0; m < 4; ++m) { bf16_t* rowp = base + (size_t)(row0 + ai * HALF + m * 16) * ld + col0;
#pragma unroll
                for (int bj = 0; bj < 2; ++bj) { const f32x4 v0 = acc[ai][bj][m][0], v1 = acc[ai][bj][m][1];
                    u32x4 w; w.x = cvt_pk_bf16(v0[0], v0[1]); w.y = cvt_pk_bf16(v0[2], v0[3]); w.z = cvt_pk_bf16(v1[0], v1[1]); w.w = cvt_pk_bf16(v1[2], v1[3]);
                    *(u32x4*)(rowp + bj * HALF) = w; } }
    }
};
struct EpiResF32 {
    static constexpr bool PERM = false;
    const float* R; float* C; int ldc;
    __device__ __forceinline__ void operator()(const f32x4 (&acc)[2][2][4][2], const Unit& u, int wr, int wc, int fr, int fq) const {
        const int row0 = u.pm * BM + wr * 64 + fr, col0 = u.pn * BM + wc * 32 + 4 * fq;
#pragma unroll
        for (int ai = 0; ai < 2; ++ai)
#pragma unroll
            for (int m = 0; m < 4; ++m) { const size_t off = (size_t)(row0 + ai * HALF + m * 16) * ldc + col0;
#pragma unroll
                for (int bj = 0; bj < 2; ++bj)
#pragma unroll
                    for (int n = 0; n < 2; ++n) { const f32x4 r = *(const f32x4*)(R + off + bj * HALF + n * 16); *(f32x4*)(C + off + bj * HALF + n * 16) = r + acc[ai][bj][m][n]; } }
    }
};
__device__ __forceinline__ float silu_mul(float g, float u) { return g * u * __builtin_amdgcn_rcpf(1.0f + __builtin_amdgcn_exp2f(-1.4426950408889634f * g)); }
struct EpiSwiGLU {
    static constexpr bool PERM = true;
    bf16_t* O; int ldc;
    __device__ __forceinline__ void operator()(const f32x4 (&acc)[2][2][4][2], const Unit& u, int wr, int wc, int fr, int fq) const {
        const int row0 = u.pm * BM + wr * 64 + fr, col0 = u.pn * HALF + wc * 32 + 8 * fq;
#pragma unroll
        for (int ai = 0; ai < 2; ++ai)
#pragma unroll
            for (int m = 0; m < 4; ++m) { bf16_t* rowp = O + (size_t)(row0 + ai * HALF + m * 16) * ldc + col0;
                const f32x4 g0 = acc[ai][0][m][0], g1 = acc[ai][0][m][1], u0 = acc[ai][1][m][0], u1 = acc[ai][1][m][1];
                u32x4 w; w.x = cvt_pk_bf16(silu_mul(g0[0], u0[0]), silu_mul(g0[1], u0[1])); w.y = cvt_pk_bf16(silu_mul(g0[2], u0[2]), silu_mul(g0[3], u0[3]));
                w.z = cvt_pk_bf16(silu_mul(g1[0], u1[0]), silu_mul(g1[1], u1[1])); w.w = cvt_pk_bf16(silu_mul(g1[2], u1[2]), silu_mul(g1[3], u1[3]));
                *(u32x4*)rowp = w; }
    }
};

template <class Epi, class Sched, bool ALIGN_EPI = false, bool SP2 = false>
__device__ __forceinline__ void gemm_phase(PG8_LAS unsigned char* lds, const Gemm g, const Sched& S, const Epi& E) {
    int tid_ = threadIdx.x; asm volatile("" : "+v"(tid_));
    const int tid = tid_, wid = __builtin_amdgcn_readfirstlane(tid >> 6), lane = tid & 63, wr = wid >> 2, wc = wid & 3, fr = lane & 15, fq = lane >> 4;
    const int K = g.K, nt = K / BK;
    unsigned voffA[2], voffB[2];
#pragma unroll
    for (int i = 0; i < 2; ++i) { int R, C; stage_rc(tid * 16 + i * 8192, R, C); const int Rb = Epi::PERM ? ((R & ~31) + perm32(R & 31)) : R;
        voffA[i] = (unsigned)(R * g.lda + C) * 2u; voffB[i] = (unsigned)(Rb * g.ldb + C) * 2u; }
    const size_t kstep = (size_t)(BK * 2);
    const size_t hstepA = (size_t)HALF * g.lda * 2, hstepB = (size_t)HALF * g.ldb * 2;
    const unsigned ldsw = (unsigned)wid * 1024u;
    const int aoff = lds_byte(wr * 64 + fr, fq * 8), boff = lds_byte(wc * 32 + fr, fq * 8);
#define PG8_SA(b, h) (((b) * 2 + (h)) * HTB)
#define PG8_SB(b, h) ((4 + (b) * 2 + (h)) * HTB)
#define PG8_STAGE(bufoff, gbase, voff) do { _Pragma("unroll") for (int _i = 0; _i < 2; ++_i) \
        __builtin_amdgcn_global_load_lds((const unsigned*)((const char*)(gbase) + (voff)[_i]), (PG8_LAS unsigned*)(lds + (bufoff) + ldsw + _i * 8192), 16, 0, 0); } while (0)
#define PG8_LDA(dst, b, h) do { _Pragma("unroll") for (int m = 0; m < 4; ++m) _Pragma("unroll") for (int k = 0; k < 2; ++k) dst[m][k] = *(const PG8_LAS bf16x8*)(lds + PG8_SA(b, h) + aoff + m * 2048 + k * 1024); } while (0)
#define PG8_LDB(dst, b, h) do { _Pragma("unroll") for (int n = 0; n < 2; ++n) _Pragma("unroll") for (int k = 0; k < 2; ++k) dst[n][k] = *(const PG8_LAS bf16x8*)(lds + PG8_SB(b, h) + boff + n * 2048 + k * 1024); } while (0)
#define PG8_MMA(ai, bj, At, Bt) do { __builtin_amdgcn_s_setprio(1); _Pragma("unroll") for (int m = 0; m < 4; ++m) _Pragma("unroll") for (int n = 0; n < 2; ++n) _Pragma("unroll") for (int k = 0; k < 2; ++k) \
        acc[ai][bj][m][n] = __builtin_amdgcn_mfma_f32_16x16x32_bf16(Bt[n][k], At[m][k], acc[ai][bj][m][n], 0, 0, 0); __builtin_amdgcn_s_setprio(0); } while (0)
#define PG8_WAIT_V(n) asm volatile("s_waitcnt vmcnt(" #n ")" ::: "memory")
#define PG8_WAIT_L(n) asm volatile("s_waitcnt lgkmcnt(" #n ")" ::: "memory")
#define PG8_BAR __builtin_amdgcn_s_barrier()
#define PG8_SCHED __builtin_amdgcn_sched_barrier(0)
    Unit cur, nxt; int ui = 0;
    if (!S.next(0, cur)) return;
    f32x4 acc[2][2][4][2];
#pragma unroll
    for (int a = 0; a < 2; ++a)
#pragma unroll
        for (int b = 0; b < 2; ++b)
#pragma unroll
            for (int m = 0; m < 4; ++m)
#pragma unroll
                for (int n = 0; n < 2; ++n) acc[a][b][m][n] = (f32x4){0.f, 0.f, 0.f, 0.f};
    bf16x8 At[4][2], B0[2][2], B1[2][2];
    const char* cA = S.abase(g, cur); const char* cB = S.bbase(g, cur);
    if constexpr (SP2) {
        PG8_STAGE(PG8_SB(0, 0), cB, voffB); PG8_STAGE(PG8_SB(0, 1), cB + hstepB, voffB); PG8_STAGE(PG8_SA(0, 0), cA, voffA); PG8_STAGE(PG8_SA(0, 1), cA + hstepA, voffA);
        if (wr == 1) PG8_BAR;
        PG8_WAIT_V(2); PG8_BAR;
        PG8_STAGE(PG8_SB(1, 0), cB + kstep, voffB); PG8_STAGE(PG8_SA(1, 0), cA + kstep, voffA); PG8_STAGE(PG8_SB(1, 1), cB + hstepB + kstep, voffB);
        PG8_WAIT_V(6); PG8_BAR;
    } else {
        PG8_STAGE(PG8_SB(0, 0), cB, voffB); PG8_STAGE(PG8_SA(0, 0), cA, voffA); PG8_STAGE(PG8_SB(0, 1), cB + hstepB, voffB); PG8_STAGE(PG8_SA(0, 1), cA + hstepA, voffA);
        if (wr == 1) PG8_BAR;
        PG8_WAIT_V(4); PG8_BAR;
        PG8_STAGE(PG8_SB(1, 0), cB + kstep, voffB); PG8_STAGE(PG8_SA(1, 0), cA + kstep, voffA); PG8_STAGE(PG8_SB(1, 1), cB + hstepB + kstep, voffB);
        PG8_WAIT_V(6); PG8_BAR;
    }
    for (;;) {
        const bool has_next = S.next(ui + 1, nxt);
        const char* nA = has_next ? S.abase(g, nxt) : cA; const char* nB = has_next ? S.bbase(g, nxt) : cB;
        for (int t = 0; t < nt; t += 2) {
            const bool last = (t == nt - 2);
            const char* a1 = cA + (size_t)(t + 1) * kstep;
            const char* a2 = last ? nA : cA + (size_t)(t + 2) * kstep; const char* b2 = last ? nB : cB + (size_t)(t + 2) * kstep;
            const char* a3 = a2 + kstep; const char* b3 = b2 + kstep;
            if constexpr (SP2) {
            PG8_LDB(B0, 0, 0); PG8_LDB(B1, 0, 1); PG8_SCHED; PG8_LDA(At, 0, 0); PG8_STAGE(PG8_SA(1, 1), a1 + hstepA, voffA);
            PG8_WAIT_V(8); PG8_WAIT_L(0); PG8_BAR; PG8_MMA(0, 0, At, B0); PG8_MMA(0, 1, At, B1); PG8_BAR; PG8_SCHED;
            PG8_LDA(At, 0, 1); PG8_STAGE(PG8_SB(0, 0), b2, voffB); PG8_STAGE(PG8_SB(0, 1), b2 + hstepB, voffB); PG8_STAGE(PG8_SA(0, 0), a2, voffA);
            PG8_WAIT_V(8); PG8_WAIT_L(0); PG8_BAR; PG8_MMA(1, 0, At, B0); PG8_MMA(1, 1, At, B1); PG8_BAR; PG8_SCHED;
            PG8_LDB(B0, 1, 0); PG8_LDB(B1, 1, 1); PG8_SCHED; PG8_LDA(At, 1, 0); PG8_STAGE(PG8_SA(0, 1), a2 + hstepA, voffA);
            PG8_WAIT_V(8); PG8_WAIT_L(0); PG8_BAR; PG8_MMA(0, 0, At, B0); PG8_MMA(0, 1, At, B1); PG8_BAR; PG8_SCHED;
            PG8_LDA(At, 1, 1); PG8_STAGE(PG8_SB(1, 0), b3, voffB); PG8_STAGE(PG8_SB(1, 1), b3 + hstepB, voffB); PG8_STAGE(PG8_SA(1, 0), a3, voffA);
            PG8_WAIT_V(8); PG8_WAIT_L(0); PG8_BAR; PG8_MMA(1, 0, At, B0); PG8_MMA(1, 1, At, B1); PG8_BAR; PG8_SCHED;
            } else {
            PG8_LDB(B0, 0, 0); PG8_SCHED; PG8_LDA(At, 0, 0); PG8_STAGE(PG8_SA(1, 1), a1 + hstepA, voffA);
            PG8_WAIT_L(8); PG8_BAR; PG8_WAIT_L(0); PG8_MMA(0, 0, At, B0); PG8_BAR; PG8_SCHED;
            PG8_LDB(B1, 0, 1); PG8_STAGE(PG8_SB(0, 0), b2, voffB);
            PG8_BAR; PG8_WAIT_L(0); PG8_MMA(0, 1, At, B1); PG8_BAR;
            PG8_LDA(At, 0, 1); PG8_STAGE(PG8_SA(0, 0), a2, voffA);
            PG8_BAR; PG8_WAIT_L(0); PG8_MMA(1, 0, At, B0); PG8_BAR; PG8_SCHED;
            PG8_STAGE(PG8_SB(0, 1), b2 + hstepB, voffB);
            PG8_WAIT_V(6); PG8_BAR; PG8_MMA(1, 1, At, B1); PG8_BAR;
            PG8_LDB(B0, 1, 0); PG8_SCHED; PG8_LDA(At, 1, 0); PG8_STAGE(PG8_SA(0, 1), a2 + hstepA, voffA);
            PG8_WAIT_L(8); PG8_BAR; PG8_WAIT_L(0); PG8_MMA(0, 0, At, B0); PG8_BAR; PG8_SCHED;
            PG8_LDB(B1, 1, 1); PG8_STAGE(PG8_SB(1, 0), b3, voffB);
            PG8_BAR; PG8_WAIT_L(0); PG8_MMA(0, 1, At, B1); PG8_BAR;
            PG8_LDA(At, 1, 1); PG8_STAGE(PG8_SA(1, 0), a3, voffA);
            PG8_BAR; PG8_WAIT_L(0); PG8_MMA(1, 0, At, B0); PG8_BAR; PG8_SCHED;
            PG8_STAGE(PG8_SB(1, 1), b3 + hstepB, voffB);
            PG8_WAIT_V(6); PG8_BAR; PG8_MMA(1, 1, At, B1); PG8_BAR;
            }
        }
        if constexpr (ALIGN_EPI) { if (wr == 0) PG8_BAR; }
        E(acc, cur, wr, wc, fr, fq);
        if (!has_next) break;
#pragma unroll
        for (int a = 0; a < 2; ++a)
#pragma unroll
            for (int b = 0; b < 2; ++b)
#pragma unroll
                for (int m = 0; m < 4; ++m)
#pragma unroll
                    for (int n = 0; n < 2; ++n) acc[a][b][m][n] = (f32x4){0.f, 0.f, 0.f, 0.f};
        cur = nxt; cA = nA; cB = nB; ++ui;
        if constexpr (ALIGN_EPI) { if (wr == 1) PG8_BAR; }
    }
    PG8_WAIT_V(0);
    if constexpr (!ALIGN_EPI) { if (wr == 0) PG8_BAR; }
    PG8_BAR;
#undef PG8_SA
#undef PG8_SB
#undef PG8_STAGE
#undef PG8_LDA
#undef PG8_LDB
#undef PG8_MMA
#undef PG8_WAIT_V
#undef PG8_WAIT_L
#undef PG8_BAR
#undef PG8_SCHED
}
}
namespace att {
#define ATT_LAS __attribute__((address_space(3)))
#define ATT_GAS __attribute__((address_space(1)))
typedef unsigned short bf16;
using bf16x8 = __attribute__((ext_vector_type(8))) short;
using s16x4  = __attribute__((ext_vector_type(4))) short;
using f32x16 = __attribute__((ext_vector_type(16))) float;
using f32x4  = __attribute__((ext_vector_type(4))) float;
using u32x4  = __attribute__((ext_vector_type(4))) unsigned;
constexpr int NW = 8, QBLK = 32, KVBLK = 64, DV = 128;
constexpr float LOG2E = 1.4426950408889634f;
#define SBAR() __builtin_amdgcn_sched_barrier(0)
__device__ __forceinline__ int crow(int r, int hi) { return (r & 3) + 8 * (r >> 2) + 4 * hi; }
__device__ __forceinline__ unsigned cvtpk(float lo, float hi) { unsigned r; asm volatile("v_cvt_pk_bf16_f32 %0, %1, %2" : "=v"(r) : "v"(lo), "v"(hi)); return r; }
__device__ __forceinline__ float bf2f(short s) { return __uint_as_float(((unsigned)(unsigned short)s) << 16); }

__device__ __forceinline__ void partialSM(f32x16& p0, f32x16& p1, float& m_reg, float& mn, float& alpha, const float C, const float THRS) {
  float pmax = p0[0];
#pragma unroll
  for (int r = 1; r < 16; ++r) pmax = fmaxf(pmax, p0[r]);
#pragma unroll
  for (int r = 0; r < 16; ++r) pmax = fmaxf(pmax, p1[r]);
  { auto rr = __builtin_amdgcn_permlane32_swap(__float_as_uint(pmax), __float_as_uint(pmax), false, false);
    pmax = fmaxf(__uint_as_float(rr[0]), __uint_as_float(rr[1])); }
  if (__builtin_expect(__all(pmax - m_reg <= THRS), 1)) { mn = m_reg; alpha = 1.f; }
  else { mn = fmaxf(m_reg, pmax); alpha = __builtin_amdgcn_exp2f((m_reg - mn) * C); m_reg = mn; }
  float mnC = -mn * C;
#pragma unroll
  for (int r = 0; r < 16; ++r) p0[r] = fmaf(p0[r], C, mnC);
#pragma unroll
  for (int r = 0; r < 16; ++r) p1[r] = fmaf(p1[r], C, mnC);
#pragma unroll
  for (int r = 0; r < 16; ++r) p0[r] = __builtin_amdgcn_exp2f(p0[r]);
}
#define ATT_PK4(P, BASE, OUT) do { unsigned a0 = cvtpk(P[BASE + 0], P[BASE + 1]), a1 = cvtpk(P[BASE + 2], P[BASE + 3]);   \
    unsigned b0 = cvtpk(P[BASE + 4], P[BASE + 5]), b1 = cvtpk(P[BASE + 6], P[BASE + 7]);                              \
    auto r0 = __builtin_amdgcn_permlane32_swap(a0, b0, false, false); auto r1 = __builtin_amdgcn_permlane32_swap(a1, b1, false, false); \
    u32x4 w = {r0[0], r1[0], r0[1], r1[1]}; OUT = *reinterpret_cast<bf16x8*>(&w); } while (0)
__device__ __forceinline__ void finishSM(f32x16& p0, f32x16& p1, float alpha, float& l_reg, bf16x8& pa0, bf16x8& pa1, bf16x8& pa2, bf16x8& pa3) {
#pragma unroll
  for (int r = 0; r < 16; ++r) p1[r] = __builtin_amdgcn_exp2f(p1[r]);
  float ps = 0;
#pragma unroll
  for (int r = 0; r < 16; ++r) ps += p0[r];
#pragma unroll
  for (int r = 0; r < 16; ++r) ps += p1[r];
  { auto rr = __builtin_amdgcn_permlane32_swap(__float_as_uint(ps), __float_as_uint(ps), false, false);
    ps = __uint_as_float(rr[0]) + __uint_as_float(rr[1]); }
  l_reg = l_reg * alpha + ps;
  ATT_PK4(p0, 0, pa0); ATT_PK4(p0, 8, pa1); ATT_PK4(p1, 0, pa2); ATT_PK4(p1, 8, pa3);
}
template <int RB> __device__ __forceinline__ int kswz(int row, int colB) { return row * RB + (colB ^ ((row & 7) << 4)); }
template <int DQK> __device__ __forceinline__ void qkt(f32x16& p0, f32x16& p1, const ATT_LAS char* Ks, const bf16x8 (&qr)[DQK / 16], int r32, int hi) {
  p0 = f32x16{}; p1 = f32x16{};
#pragma unroll
  for (int d0 = 0; d0 < DQK / 16; ++d0) { const int cb = (d0 * 16 + hi * 8) * 2;
    bf16x8 b0 = *reinterpret_cast<const ATT_LAS bf16x8*>(Ks + kswz<DQK * 2>(r32, cb));
    bf16x8 b1 = *reinterpret_cast<const ATT_LAS bf16x8*>(Ks + kswz<DQK * 2>(32 + r32, cb));
    p0 = __builtin_amdgcn_mfma_f32_32x32x16_bf16(b0, qr[d0], p0, 0, 0, 0);
    p1 = __builtin_amdgcn_mfma_f32_32x32x16_bf16(b1, qr[d0], p1, 0, 0, 0); }
}
__device__ __forceinline__ int v_st(int k, int c) { const int kk = (k & ~0xC) | ((k & 4) << 1) | ((k & 8) >> 1); return ((kk >> 3) * 4 + (c >> 5)) * 512 + ((kk & 7) * 32 + (c & 31)) * 2; }
__device__ __forceinline__ int v_rd_base(int lane) { return ((lane & 3) << 3) | (((lane >> 2) & 3) << 6) | (((lane >> 4) & 1) << 5) | (((lane >> 5) & 1) << 8); }
constexpr int v_rd_off(int d0, int ks, int half) { return d0 * 512 + ks * 4096 + half * 2048; }
template <int OFF> __device__ __forceinline__ s16x4 tr_read(int vb) {
  s16x4 r; asm volatile("ds_read_b64_tr_b16 %0, %1 offset:%2" : "=&v"(r) : "v"(vb), "i"(OFF) : "memory"); return r;
}
#define ATT_PK(L, H) (bf16x8){L[0], L[1], L[2], L[3], H[0], H[1], H[2], H[3]}
template <int D0> __device__ __forceinline__ void pv_one(f32x16& od, int vb, bf16x8 pa0, bf16x8 pa1, bf16x8 pa2, bf16x8 pa3) {
  const s16x4 l0 = tr_read<v_rd_off(D0, 0, 0)>(vb), h0 = tr_read<v_rd_off(D0, 0, 1)>(vb), l1 = tr_read<v_rd_off(D0, 1, 0)>(vb), h1 = tr_read<v_rd_off(D0, 1, 1)>(vb);
  const s16x4 l2 = tr_read<v_rd_off(D0, 2, 0)>(vb), h2 = tr_read<v_rd_off(D0, 2, 1)>(vb), l3 = tr_read<v_rd_off(D0, 3, 0)>(vb), h3 = tr_read<v_rd_off(D0, 3, 1)>(vb);
  asm volatile("s_waitcnt lgkmcnt(0)" ::: "memory"); SBAR();
  od = __builtin_amdgcn_mfma_f32_32x32x16_bf16(pa0, ATT_PK(l0, h0), od, 0, 0, 0);
  od = __builtin_amdgcn_mfma_f32_32x32x16_bf16(pa1, ATT_PK(l1, h1), od, 0, 0, 0);
  od = __builtin_amdgcn_mfma_f32_32x32x16_bf16(pa2, ATT_PK(l2, h2), od, 0, 0, 0);
  od = __builtin_amdgcn_mfma_f32_32x32x16_bf16(pa3, ATT_PK(l3, h3), od, 0, 0, 0);
}
__device__ __forceinline__ void pv_d0(f32x16 (&o)[4], int vb, bf16x8 pa0, bf16x8 pa1, bf16x8 pa2, bf16x8 pa3) {
  pv_one<0>(o[0], vb, pa0, pa1, pa2, pa3); pv_one<1>(o[1], vb, pa0, pa1, pa2, pa3); pv_one<2>(o[2], vb, pa0, pa1, pa2, pa3); pv_one<3>(o[3], vb, pa0, pa1, pa2, pa3);
}
template <int D0> __device__ __forceinline__ void pv32_one(f32x16& od, int vb, bf16x8 pa0, bf16x8 pa1) {
  const s16x4 l0 = tr_read<v_rd_off(D0, 0, 0)>(vb), h0 = tr_read<v_rd_off(D0, 0, 1)>(vb), l1 = tr_read<v_rd_off(D0, 1, 0)>(vb), h1 = tr_read<v_rd_off(D0, 1, 1)>(vb);
  asm volatile("s_waitcnt lgkmcnt(0)" ::: "memory"); SBAR();
  od = __builtin_amdgcn_mfma_f32_32x32x16_bf16(pa0, ATT_PK(l0, h0), od, 0, 0, 0);
  od = __builtin_amdgcn_mfma_f32_32x32x16_bf16(pa1, ATT_PK(l1, h1), od, 0, 0, 0);
}

template <int DQK, int LDQ, int LDK, int LDO, int SDEPTH>
__device__ __forceinline__ void attn_dense_body(const bf16* __restrict__ Qb, const bf16* __restrict__ Kh, const bf16* __restrict__ Kr, const bf16* __restrict__ Vh,
                                                const float* __restrict__ cs_rows, float* __restrict__ Ob, int seq, const float scale, ATT_LAS char* lds) {
  constexpr int SHM_V = KVBLK * DV * 2, SHM_K = KVBLK * DQK * 2, RB = DQK * 2, NQ = DQK / 16;
  constexpr bool ROPE = (DQK == 192);
  const float C = scale * LOG2E, THRS = 8.f / scale;
  int tid_ = threadIdx.x; asm volatile("" : "+v"(tid_));
  const int tid = tid_, wid = tid >> 6, lane = tid & 63, r32 = lane & 31, hi = lane >> 5;
  ATT_LAS char* V_lds = lds; ATT_LAS char* K_lds = lds + 2 * SHM_V;
  ATT_LAS float* ws = (ATT_LAS float*)(lds + 2 * SHM_V + 2 * SHM_K) + wid * 64; ATT_LAS float* li_l = ws; ATT_LAS float* al_l = ws + 32;
  float m_reg = -1e30f, l_reg = 0; f32x16 o[4] = {}; bf16x8 qr[NQ];
  const bf16* Qw = Qb + (long)(wid * QBLK + r32) * LDQ + hi * 8;
#pragma unroll
  for (int d0 = 0; d0 < NQ; ++d0) qr[d0] = *(const ATT_GAS bf16x8*)(Qw + d0 * 16);
  if constexpr (ROPE) {
    const float* cs = cs_rows + (long)(wid * QBLK + r32) * 64 + hi * 8;
#pragma unroll
    for (int g = 0; g < 2; ++g) {
      const f32x4 c0 = *(const ATT_GAS f32x4*)(cs + g * 16), c1 = *(const ATT_GAS f32x4*)(cs + g * 16 + 4);
      const f32x4 s0 = *(const ATT_GAS f32x4*)(cs + 32 + g * 16), s1 = *(const ATT_GAS f32x4*)(cs + 32 + g * 16 + 4);
      float y1[8], y2[8];
#pragma unroll
      for (int j = 0; j < 8; ++j) { const float co = j < 4 ? c0[j & 3] : c1[j & 3], si = j < 4 ? s0[j & 3] : s1[j & 3];
        const float x1 = bf2f(qr[8 + g][j]), x2 = bf2f(qr[10 + g][j]); y1[j] = x1 * co - x2 * si; y2[j] = x1 * si + x2 * co; }
      u32x4 w1 = {cvtpk(y1[0], y1[1]), cvtpk(y1[2], y1[3]), cvtpk(y1[4], y1[5]), cvtpk(y1[6], y1[7])};
      u32x4 w2 = {cvtpk(y2[0], y2[1]), cvtpk(y2[2], y2[3]), cvtpk(y2[4], y2[5]), cvtpk(y2[6], y2[7])};
      qr[8 + g] = *reinterpret_cast<bf16x8*>(&w1); qr[10 + g] = *reinterpret_cast<bf16x8*>(&w2);
    }
  }
  const int sr = tid >> 4, sc = (tid & 15) * 8, vst0 = v_st(sr, sc), vst1 = v_st(32 + sr, sc);
  const int rr = tid >> 3, rc = (tid & 7) * 8;
  const int vb0 = (int)(unsigned)(uintptr_t)V_lds + v_rd_base(lane);
  struct Slot { bf16x8 vs0, vs1, ks0, ks1, kr; } sr_[SDEPTH];
#define SLOAD(i, k0) do { sr_[i].vs0 = *(const ATT_GAS bf16x8*)(&Vh[(long)((k0) + sr) * LDK + sc]); sr_[i].vs1 = *(const ATT_GAS bf16x8*)(&Vh[(long)((k0) + 32 + sr) * LDK + sc]); \
    sr_[i].ks0 = *(const ATT_GAS bf16x8*)(&Kh[(long)((k0) + sr) * LDK + sc]); sr_[i].ks1 = *(const ATT_GAS bf16x8*)(&Kh[(long)((k0) + 32 + sr) * LDK + sc]); \
    if constexpr (ROPE) sr_[i].kr = *(const ATT_GAS bf16x8*)(&Kr[(long)((k0) + rr) * 64 + rc]); } while (0)
#define SWRITE(b, i) do { *reinterpret_cast<ATT_LAS bf16x8*>(V_lds + (b) * SHM_V + vst0) = sr_[i].vs0;          \
    *reinterpret_cast<ATT_LAS bf16x8*>(V_lds + (b) * SHM_V + vst1) = sr_[i].vs1; const int kc = sc * 2;               \
    *reinterpret_cast<ATT_LAS bf16x8*>(K_lds + (b) * SHM_K + kswz<RB>(sr, kc)) = sr_[i].ks0;                       \
    *reinterpret_cast<ATT_LAS bf16x8*>(K_lds + (b) * SHM_K + kswz<RB>(32 + sr, kc)) = sr_[i].ks1;                  \
    if constexpr (ROPE) *reinterpret_cast<ATT_LAS bf16x8*>(K_lds + (b) * SHM_K + kswz<RB>(rr, 256 + rc * 2)) = sr_[i].kr; } while (0)
#define SWAIT() do { if constexpr (SDEPTH == 2) { if constexpr (ROPE) asm volatile("s_waitcnt vmcnt(5)" ::: "memory"); else asm volatile("s_waitcnt vmcnt(4)" ::: "memory"); } else asm volatile("s_waitcnt vmcnt(0)" ::: "memory"); } while (0)
#define RESC(a) do { if (__any((a) < 1.f)) { if (hi == 0) al_l[r32] = (a); asm volatile("s_waitcnt lgkmcnt(0)" ::: "memory"); \
    _Pragma("unroll") for (int d = 0; d < 4; ++d) _Pragma("unroll") for (int r = 0; r < 16; ++r) o[d][r] *= al_l[crow(r, hi)]; } } while (0)
  f32x16 pA0, pA1, pB0, pB1; float mnA, mnB, alA, alB; bf16x8 pa0, pa1, pa2, pa3; const int NT = seq / KVBLK;
  constexpr int SE = 0, SO = SDEPTH - 1;
  SLOAD(SE, 0); asm volatile("s_waitcnt vmcnt(0)" ::: "memory"); SWRITE(0, SE); __syncthreads();
  qkt<DQK>(pA0, pA1, K_lds, qr, r32, hi); partialSM(pA0, pA1, m_reg, mnA, alA, C, THRS);
  SLOAD(SO, KVBLK); if constexpr (SDEPTH == 2) { if (2 < NT) SLOAD(SE, 2 * KVBLK); }
  SWAIT(); SWRITE(1, SO); __syncthreads();
  for (int j = 1; j + 1 < NT; j += 2) {
    SBAR(); qkt<DQK>(pB0, pB1, K_lds + SHM_K, qr, r32, hi);
    finishSM(pA0, pA1, alA, l_reg, pa0, pa1, pa2, pa3); SBAR();
    SLOAD(SO, (j + SDEPTH) * KVBLK); SBAR();
    pv_d0(o, vb0, pa0, pa1, pa2, pa3); partialSM(pB0, pB1, m_reg, mnB, alB, C, THRS);
    __syncthreads(); SWAIT(); SWRITE(0, SE);
    RESC(alB); __syncthreads();
    SBAR(); qkt<DQK>(pA0, pA1, K_lds, qr, r32, hi);
    finishSM(pB0, pB1, alB, l_reg, pa0, pa1, pa2, pa3); SBAR();
    if (SDEPTH == 1 || j + 3 < NT) SLOAD(SE, (j + 1 + SDEPTH) * KVBLK); SBAR();
    pv_d0(o, vb0 + SHM_V, pa0, pa1, pa2, pa3); partialSM(pA0, pA1, m_reg, mnA, alA, C, THRS);
    __syncthreads(); SWAIT(); SWRITE(1, SO);
    RESC(alA); __syncthreads();
  }
  SBAR(); qkt<DQK>(pB0, pB1, K_lds + SHM_K, qr, r32, hi);
  finishSM(pA0, pA1, alA, l_reg, pa0, pa1, pa2, pa3); SBAR();
  pv_d0(o, vb0, pa0, pa1, pa2, pa3); partialSM(pB0, pB1, m_reg, mnB, alB, C, THRS);
  __syncthreads(); RESC(alB);
  finishSM(pB0, pB1, alB, l_reg, pa0, pa1, pa2, pa3); SBAR();
  pv_d0(o, vb0 + SHM_V, pa0, pa1, pa2, pa3);
  if (hi == 0) li_l[r32] = l_reg; asm volatile("s_waitcnt lgkmcnt(0)" ::: "memory");
  float rli[16];
#pragma unroll
  for (int r = 0; r < 16; ++r) rli[r] = __builtin_amdgcn_rcpf(li_l[crow(r, hi)]);
  float* Ow = Ob + (long)(wid * QBLK) * LDO;
#pragma unroll
  for (int r = 0; r < 16; ++r) { const int orow = crow(r, hi);
#pragma unroll
    for (int d0 = 0; d0 < 4; ++d0) Ow[(long)orow * LDO + d0 * 32 + r32] = o[d0][r] * rli[r]; }
  __syncthreads();
#undef SLOAD
#undef SWRITE
#undef SWAIT
#undef RESC
}

template <int DQK, int LDQ, int LDK, int LDO>
__device__ __forceinline__ void attn_simple_body(const bf16* __restrict__ Qb, const bf16* __restrict__ Kh, const bf16* __restrict__ Kr, const bf16* __restrict__ Vh,
                                                 const float* __restrict__ cs_rows, float* __restrict__ Ob, int seq, const float scale, ATT_LAS char* lds) {
  constexpr int SHM_V = KVBLK * DV * 2, SHM_K = KVBLK * DQK * 2, RB = DQK * 2, NQ = DQK / 16;
  constexpr bool ROPE = (DQK == 192);
  const float C = scale * LOG2E, THRS = 8.f / scale;
  int tid_ = threadIdx.x; asm volatile("" : "+v"(tid_));
  const int tid = tid_, wid = tid >> 6, lane = tid & 63, r32 = lane & 31, hi = lane >> 5;
  ATT_LAS char* V_lds = lds; ATT_LAS char* K_lds = lds + 2 * SHM_V;
  ATT_LAS float* ws = (ATT_LAS float*)(lds + 2 * SHM_V + 2 * SHM_K) + wid * 64; ATT_LAS float* li_l = ws; ATT_LAS float* al_l = ws + 32;
  float m_reg = -1e30f, l_reg = 0; f32x16 o[4] = {}; bf16x8 qr[NQ];
  const bf16* Qw = Qb + (long)(wid * QBLK + r32) * LDQ + hi * 8;
#pragma unroll
  for (int d0 = 0; d0 < NQ; ++d0) qr[d0] = *(const ATT_GAS bf16x8*)(Qw + d0 * 16);
  if constexpr (ROPE) {
    const float* cs = cs_rows + (long)(wid * QBLK + r32) * 64 + hi * 8;
#pragma unroll
    for (int g = 0; g < 2; ++g) {
      const f32x4 c0 = *(const ATT_GAS f32x4*)(cs + g * 16), c1 = *(const ATT_GAS f32x4*)(cs + g * 16 + 4);
      const f32x4 s0 = *(const ATT_GAS f32x4*)(cs + 32 + g * 16), s1 = *(const ATT_GAS f32x4*)(cs + 32 + g * 16 + 4);
      float y1[8], y2[8];
#pragma unroll
      for (int j = 0; j < 8; ++j) { const float co = j < 4 ? c0[j & 3] : c1[j & 3], si = j < 4 ? s0[j & 3] : s1[j & 3];
        const float x1 = bf2f(qr[8 + g][j]), x2 = bf2f(qr[10 + g][j]); y1[j] = x1 * co - x2 * si; y2[j] = x1 * si + x2 * co; }
      u32x4 w1 = {cvtpk(y1[0], y1[1]), cvtpk(y1[2], y1[3]), cvtpk(y1[4], y1[5]), cvtpk(y1[6], y1[7])};
      u32x4 w2 = {cvtpk(y2[0], y2[1]), cvtpk(y2[2], y2[3]), cvtpk(y2[4], y2[5]), cvtpk(y2[6], y2[7])};
      qr[8 + g] = *reinterpret_cast<bf16x8*>(&w1); qr[10 + g] = *reinterpret_cast<bf16x8*>(&w2);
    }
  }
  const int sr = tid >> 4, sc = (tid & 15) * 8, vst0 = v_st(sr, sc), vst1 = v_st(32 + sr, sc);
  const int rr = tid >> 3, rc = (tid & 7) * 8;
  const int vb0 = (int)(unsigned)(uintptr_t)V_lds + v_rd_base(lane);
  bf16x8 vs0, vs1, ks0, ks1, kr;
#define SLOAD(k0) do { vs0 = *(const ATT_GAS bf16x8*)(&Vh[(long)((k0) + sr) * LDK + sc]); vs1 = *(const ATT_GAS bf16x8*)(&Vh[(long)((k0) + 32 + sr) * LDK + sc]); \
    ks0 = *(const ATT_GAS bf16x8*)(&Kh[(long)((k0) + sr) * LDK + sc]); ks1 = *(const ATT_GAS bf16x8*)(&Kh[(long)((k0) + 32 + sr) * LDK + sc]); \
    if constexpr (ROPE) kr = *(const ATT_GAS bf16x8*)(&Kr[(long)((k0) + rr) * 64 + rc]); } while (0)
#define SWRITE(b) do { *reinterpret_cast<ATT_LAS bf16x8*>(V_lds + (b) * SHM_V + vst0) = vs0;          \
    *reinterpret_cast<ATT_LAS bf16x8*>(V_lds + (b) * SHM_V + vst1) = vs1; const int kc = sc * 2;               \
    *reinterpret_cast<ATT_LAS bf16x8*>(K_lds + (b) * SHM_K + kswz<RB>(sr, kc)) = ks0;                       \
    *reinterpret_cast<ATT_LAS bf16x8*>(K_lds + (b) * SHM_K + kswz<RB>(32 + sr, kc)) = ks1;                  \
    if constexpr (ROPE) *reinterpret_cast<ATT_LAS bf16x8*>(K_lds + (b) * SHM_K + kswz<RB>(rr, 256 + rc * 2)) = kr; } while (0)
#define RESC(a) do { if (__any((a) < 1.f)) { if (hi == 0) al_l[r32] = (a); asm volatile("s_waitcnt lgkmcnt(0)" ::: "memory"); \
    _Pragma("unroll") for (int d = 0; d < 4; ++d) _Pragma("unroll") for (int r = 0; r < 16; ++r) o[d][r] *= al_l[crow(r, hi)]; } } while (0)
  const int NT = seq / KVBLK;
  SLOAD(0); SWRITE(0); __syncthreads();
  for (int j = 0; j < NT; ++j) {
    const int b = j & 1;
    if (j + 1 < NT) SLOAD((j + 1) * KVBLK);
    f32x16 p0, p1; float mn, al; bf16x8 pa0, pa1, pa2, pa3;
    SBAR(); qkt<DQK>(p0, p1, K_lds + b * SHM_K, qr, r32, hi);
    partialSM(p0, p1, m_reg, mn, al, C, THRS); RESC(al);
    finishSM(p0, p1, al, l_reg, pa0, pa1, pa2, pa3); SBAR();
    pv_d0(o, vb0 + b * SHM_V, pa0, pa1, pa2, pa3);
    if (j + 1 < NT) SWRITE(b ^ 1);
    __syncthreads();
  }
  if (hi == 0) li_l[r32] = l_reg; asm volatile("s_waitcnt lgkmcnt(0)" ::: "memory");
  float rli[16];
#pragma unroll
  for (int r = 0; r < 16; ++r) rli[r] = __builtin_amdgcn_rcpf(li_l[crow(r, hi)]);
  float* Ow = Ob + (long)(wid * QBLK) * LDO;
#pragma unroll
  for (int r = 0; r < 16; ++r) { const int orow = crow(r, hi);
#pragma unroll
    for (int d0 = 0; d0 < 4; ++d0) Ow[(long)orow * LDO + d0 * 32 + r32] = o[d0][r] * rli[r]; }
  __syncthreads();
#undef SLOAD
#undef SWRITE
#undef RESC
}

template <int LDP>
__device__ __forceinline__ void dil_wave_unit(const bf16* __restrict__ P, int qc, int kc, int vc, int d, int r, int t0, int nT,
                                              float* __restrict__ O, int oc, float* __restrict__ ST  ,
                                              ATT_LAS char* vlds  , const ATT_LAS float* bias2, const float C, int lane_) {
  int lane = lane_; asm volatile("" : "+v"(lane));
  const int r32 = lane & 31, hi = lane >> 5;
  bf16x8 qr[8];
  { const bf16* qp = P + (long)(r + d * (t0 + r32)) * LDP + qc + hi * 8;
#pragma unroll
    for (int d0 = 0; d0 < 8; ++d0) qr[d0] = *(const ATT_GAS bf16x8*)(qp + d0 * 16); }
  f32x16 p[5];
#pragma unroll
  for (int kb = 0; kb < 5; ++kb) {
    int kt = t0 - 64 + kb * 32 + r32; kt = kt < 0 ? 0 : (kt > nT - 1 ? nT - 1 : kt);
    const bf16* kp = P + (long)(r + d * kt) * LDP + kc + hi * 8;
    bf16x8 kf[8];
#pragma unroll
    for (int d0 = 0; d0 < 8; ++d0) kf[d0] = *(const ATT_GAS bf16x8*)(kp + d0 * 16);
    p[kb] = f32x16{};
#pragma unroll
    for (int d0 = 0; d0 < 8; ++d0) p[kb] = __builtin_amdgcn_mfma_f32_32x32x16_bf16(kf[d0], qr[d0], p[kb], 0, 0, 0);
  }
  float m = -1e30f;
#pragma unroll
  for (int kb = 0; kb < 5; ++kb)
#pragma unroll
    for (int rg = 0; rg < 16; ++rg) {
      const int jj = kb * 32 + crow(rg, hi) - r32;
      const int kt = t0 - 64 + kb * 32 + crow(rg, hi);
      const bool valid = (jj >= 0) && (jj <= 128) && (kt >= 0) && (kt < nT);
      const int bi = jj < 0 ? 0 : (jj > 128 ? 128 : jj);
      const float s = fmaf(p[kb][rg], C, bias2[bi]);
      p[kb][rg] = valid ? s : -1e30f; m = fmaxf(m, p[kb][rg]);
    }
  { auto rr = __builtin_amdgcn_permlane32_swap(__float_as_uint(m), __float_as_uint(m), false, false); m = fmaxf(__uint_as_float(rr[0]), __uint_as_float(rr[1])); }
  float Z = 0.f;
#pragma unroll
  for (int kb = 0; kb < 5; ++kb)
#pragma unroll
    for (int rg = 0; rg < 16; ++rg) { p[kb][rg] = __builtin_amdgcn_exp2f(p[kb][rg] - m); Z += p[kb][rg]; }
  { auto rr = __builtin_amdgcn_permlane32_swap(__float_as_uint(Z), __float_as_uint(Z), false, false); Z = __uint_as_float(rr[0]) + __uint_as_float(rr[1]); }
  f32x16 o[4] = {};
  const int vb = (int)(unsigned)(uintptr_t)vlds + v_rd_base(lane);
#pragma unroll
  for (int kb = 0; kb < 5; ++kb) {
    bf16x8 vv[8];
#pragma unroll
    for (int i = 0; i < 8; ++i) { const int id = lane + 64 * i, row = id >> 4, c = (id & 15) * 8;
      int kt = t0 - 64 + kb * 32 + row; kt = kt < 0 ? 0 : (kt > nT - 1 ? nT - 1 : kt);
      vv[i] = *(const ATT_GAS bf16x8*)(P + (long)(r + d * kt) * LDP + vc + c); }
#pragma unroll
    for (int i = 0; i < 8; ++i) { const int id = lane + 64 * i, row = id >> 4, c = (id & 15) * 8;
      *reinterpret_cast<ATT_LAS bf16x8*>(vlds + v_st(row, c)) = vv[i]; }
    bf16x8 pa0, pa1; ATT_PK4(p[kb], 0, pa0); ATT_PK4(p[kb], 8, pa1);
    asm volatile("s_waitcnt lgkmcnt(0)" ::: "memory"); SBAR();
    pv32_one<0>(o[0], vb, pa0, pa1); pv32_one<1>(o[1], vb, pa0, pa1); pv32_one<2>(o[2], vb, pa0, pa1); pv32_one<3>(o[3], vb, pa0, pa1);
    SBAR();
  }
#pragma unroll
  for (int rg = 0; rg < 16; ++rg) { const long row = r + d * (t0 + crow(rg, hi));
#pragma unroll
    for (int d0 = 0; d0 < 4; ++d0) O[row * 768 + oc + d0 * 32 + r32] = o[d0][rg]; }
  if (hi == 0) { const long row = r + d * (t0 + r32); typedef float f32x2_ __attribute__((ext_vector_type(2))); *(ATT_GAS f32x2_*)(ST + row * 12) = (f32x2_){m, Z}; }
}
}
constexpr int S = 8192, D = 2048, NMEM = 256;
constexpr int DIN = 3392, DINP = 3584;
constexpr int PC_DIL = 768, PC_MEM = 3072;
constexpr int QR = 384, KVR = 128, AQ = 512;
constexpr int NUP = 2816;
constexpr int UC_KV = 1280;
constexpr int DFF = 5632, DFE = 7168, NE = 8;
constexpr int MP = 18432;
constexpr float EPS = 1e-6f;
constexpr int NWAVES = 8;

constexpr size_t al256(size_t x) { return (x + 255) / 256 * 256; }
constexpr size_t WS_CTL = 0, CTL_ZERO_BYTES = 1u << 20;
constexpr size_t WS_WIN = WS_CTL + CTL_ZERO_BYTES;
constexpr size_t WS_WUP = WS_WIN + al256((size_t)2 * DINP * D * 2);
constexpr size_t WS_WMEM = WS_WUP + al256((size_t)2 * NUP * AQ * 2);
constexpr size_t WS_WOUT = WS_WMEM + al256((size_t)2 * 1024 * D * 2);
constexpr size_t WS_WGU = WS_WOUT + al256((size_t)2 * D * D * 2);
constexpr size_t WS_WDN = WS_WGU + al256((size_t)2 * DFF * D * 2);
constexpr size_t WS_MGU = WS_WDN + al256((size_t)D * DFF * 2);
constexpr size_t WS_MDN = WS_MGU + al256((size_t)NE * 2 * DFE * D * 2);
constexpr size_t WS_XN = WS_MDN + al256((size_t)NE * D * DFE * 2);
constexpr size_t WS_MEMN = WS_XN + al256((size_t)S * D * 2);
constexpr size_t WS_MEMKV = WS_MEMN + al256((size_t)2 * NMEM * D * 2);
constexpr size_t WS_PROJ = WS_MEMKV + al256((size_t)2 * NMEM * 1024 * 2);
constexpr size_t WS_AQKV = WS_PROJ + al256((size_t)S * DINP * 2);
constexpr size_t WS_KROPE = WS_AQKV + al256((size_t)S * AQ * 2);
constexpr size_t WS_ROPECS = WS_KROPE + al256((size_t)S * 64 * 2);
constexpr size_t WS_QKVM = WS_ROPECS + al256((size_t)S * 64 * 4);
constexpr size_t WS_YPRE = WS_QKVM + al256((size_t)S * NUP * 2);
constexpr size_t WS_DILO = WS_YPRE + al256((size_t)S * D * 4);
constexpr size_t WS_DILS = WS_DILO + al256((size_t)3 * S * 768 * 4);
constexpr size_t WS_Y = WS_DILS + al256((size_t)3 * S * 12 * 4);
constexpr size_t WS_XA = WS_Y + al256((size_t)S * D * 2);
constexpr size_t WS_ROUTE = WS_XA + al256((size_t)S * D * 4);
constexpr size_t WS_XP = WS_ROUTE + al256((size_t)S * 32);
constexpr size_t WS_OUTP = WS_XP + al256((size_t)MP * D * 2);
constexpr size_t WS_ACTP = WS_OUTP + al256((size_t)MP * D * 2);
constexpr size_t WS_END = WS_ACTP + al256((size_t)MP * DFE * 2);
static_assert(WS_END <= 1879048192ull, "workspace map exceeds 4 x the largest input");
constexpr int CW_BAR = 4096;
constexpr int CW_QUEUE = 8192;
constexpr int CW_CNT = 8192 + 256;
constexpr int CW_TILEE = 8192 + 512;
constexpr int RING_BYTES = 131072;
constexpr int LDSCTL_OFF = RING_BYTES, MISC_OFF = LDSCTL_OFF + 320;
constexpr int BIAS_OFF = 114688;
constexpr int LDS_BYTES = 147456;

#define GAS __attribute__((address_space(1)))
#define LAS __attribute__((address_space(3)))
typedef unsigned short bf16;
typedef unsigned v4u __attribute__((ext_vector_type(4)));
typedef unsigned v2u __attribute__((ext_vector_type(2)));
typedef float f32x4 __attribute__((ext_vector_type(4)));
typedef short bf16x8 __attribute__((ext_vector_type(8)));
typedef GAS unsigned gu32;
#define RLX_AGENT __ATOMIC_RELAXED, __HIP_MEMORY_SCOPE_AGENT
#define LDS_WAIT() asm volatile("s_waitcnt lgkmcnt(0)" ::: "memory")
#define VM_WAIT() asm volatile("s_waitcnt vmcnt(0)" ::: "memory")
__device__ __forceinline__ unsigned f2bf(float f) { unsigned u = __builtin_bit_cast(unsigned, f); return (u + 0x7fffu + ((u >> 16) & 1u)) >> 16; }
__device__ __forceinline__ unsigned pk2(float lo, float hi) { return f2bf(lo) | (f2bf(hi) << 16); }
__device__ __forceinline__ float bflo(unsigned w) { return __uint_as_float(w << 16); }
__device__ __forceinline__ float bfhi(unsigned w) { return __uint_as_float(w & 0xffff0000u); }

#define XB_TMO      128
#define XB_XCNT(j)  (256  + 64 * (j))
#define XB_XSUB(j)  (1280 + 64 * (j))
#define XB_XGEN(j)  (2304 + 64 * (j))
#define XB_TOP      3328
#define XB_TOPGEN   3392
#define XCD_BAR_WORDS 3456
#define XB_SPIN_CAP (1u << 18)
__device__ __forceinline__ unsigned xb_ld(unsigned* p)              { return __hip_atomic_load(p, __ATOMIC_RELAXED, __HIP_MEMORY_SCOPE_AGENT); }
__device__ __forceinline__ unsigned xb_add(unsigned* p, unsigned v) { return __hip_atomic_fetch_add(p, v, __ATOMIC_RELAXED, __HIP_MEMORY_SCOPE_AGENT); }
__device__ __forceinline__ unsigned xb_xcc_id() { return (unsigned)__builtin_amdgcn_s_getreg((3 << 11) | 20) & 0xFu; }
#define XB_SPIN(cond, bar) do { unsigned _sp = 0; while (cond) { __builtin_amdgcn_s_sleep(1); \
    if ((++_sp & 255u) == 0u) { if (xb_ld(&(bar)[XB_TMO])) break; if (_sp > XB_SPIN_CAP) { atomicAdd(&(bar)[XB_TMO], 1u); break; } } } } while (0)
struct XcdBarrier { unsigned* bar; unsigned x; volatile LAS unsigned* st; };
__device__ __forceinline__ XcdBarrier xcd_barrier_post(unsigned* bar, volatile LAS unsigned* st) {
    XcdBarrier b; b.bar = bar; b.x = xb_xcc_id(); b.st = st;
    if (threadIdx.x == 0) (void)xb_add(&bar[XB_XCNT(b.x)], 1u);
    return b;
}
__device__ __forceinline__ void xcd_barrier_complete(unsigned* bar, unsigned x, unsigned& nloc, unsigned& nx) {
    const unsigned G = gridDim.x * gridDim.y * gridDim.z;
    unsigned sum, cnt, mine, sp = 0u;
    for (;;) {
        sum = 0u; cnt = 0u; mine = 0u;
#pragma unroll
        for (unsigned j = 0; j < 16; ++j) { const unsigned c = xb_ld(&bar[XB_XCNT(j)]); sum += c; cnt += (c > 0u) ? 1u : 0u; mine = (j == x) ? c : mine; }
        if (sum == G) break;
        __builtin_amdgcn_s_sleep(1);
        if ((++sp & 255u) == 0u) { if (xb_ld(&bar[XB_TMO])) break; if (sp > XB_SPIN_CAP) { atomicAdd(&bar[XB_TMO], 1u); break; } }
    }
    nloc = mine > 0u ? mine : 1u; nx = cnt > 0u ? cnt : 1u;
}
__device__ __forceinline__ void xcd_barrier(const XcdBarrier& b) {
    asm volatile("s_waitcnt vmcnt(0)" ::: "memory");
    __syncthreads();
    if (threadIdx.x == 0) {
        unsigned* bar = b.bar;
        __builtin_amdgcn_s_waitcnt(0);
        unsigned nloc = b.st[0], nx = b.st[1];
        if (nloc == 0u) { xcd_barrier_complete(bar, b.x, nloc, nx); b.st[0] = nloc; b.st[1] = nx; }
        const unsigned old = xb_add(&bar[XB_XSUB(b.x)], 1u);
        const unsigned gen = old / nloc;
        if (old + 1u == (gen + 1u) * nloc) {
            __builtin_amdgcn_fence(__ATOMIC_RELEASE, "agent");
            asm volatile("s_waitcnt vmcnt(0)" ::: "memory");
            const unsigned og = xb_add(&bar[XB_TOP], 1u);
            const unsigned tg = og / nx;
            if (og + 1u == (tg + 1u) * nx) xb_add(&bar[XB_TOPGEN], 1u);
            else XB_SPIN(xb_ld(&bar[XB_TOPGEN]) == tg, bar);
            __builtin_amdgcn_fence(__ATOMIC_ACQUIRE, "agent");
            xb_add(&bar[XB_XGEN(b.x)], 1u);
            asm volatile("s_waitcnt vmcnt(0)" ::: "memory");
        } else {
            XB_SPIN(xb_ld(&bar[XB_XGEN(b.x)]) == gen, bar);
            __builtin_amdgcn_fence(__ATOMIC_ACQUIRE, "agent");
            asm volatile("s_waitcnt vmcnt(0)" ::: "memory");
        }
    }
    __syncthreads();
}

struct Args {
    const float* in[23]; float* out; unsigned char* ws;
    float invf[32];
    int ph_lo, ph_hi, li, pad;
};
struct Frame {
    LAS unsigned char* lds;
    volatile LAS unsigned* MISC;
    gu32* ctl;
    int tid, lane, wave, G, gw, NGW;
    unsigned char* ws;
};
__device__ __forceinline__ float wave_sum(float v) {
#pragma unroll
    for (int o = 1; o < 64; o <<= 1) v += __shfl_xor(v, o);
    return v;
}
__device__ __forceinline__ float wave_max(float v) {
#pragma unroll
    for (int o = 1; o < 64; o <<= 1) v = fmaxf(v, __shfl_xor(v, o));
    return v;
}

__device__ __forceinline__ void cvt_item(const float* __restrict__ W, int N, int k0, int n0, bf16* __restrict__ dst, int ldd, int drow0, int kdst0, LAS float* scr, int lane) {
    f32x4 v[8];
    const int lr = lane >> 3, lc = (lane & 7) * 4;
#pragma unroll
    for (int i = 0; i < 8; ++i) v[i] = *(const GAS f32x4*)(W + (size_t)(k0 + i * 8 + lr) * N + n0 + lc);
#pragma unroll
    for (int i = 0; i < 8; ++i) { LAS float* s = scr + (i * 8 + lr) * 33 + lc; s[0] = v[i][0]; s[1] = v[i][1]; s[2] = v[i][2]; s[3] = v[i][3]; }
    LDS_WAIT(); asm volatile("" ::: "memory");
    const int c = lane & 7;
#pragma unroll
    for (int j = 0; j < 4; ++j) { const int n = (lane >> 3) + 8 * j; const LAS float* s = scr + (8 * c) * 33 + n;
        v4u o; o.x = pk2(s[0 * 33], s[1 * 33]); o.y = pk2(s[2 * 33], s[3 * 33]); o.z = pk2(s[4 * 33], s[5 * 33]); o.w = pk2(s[6 * 33], s[7 * 33]);
        *(GAS v4u*)(dst + (size_t)(drow0 + n) * ldd + kdst0 + k0 + 8 * c) = o; }
    LDS_WAIT(); asm volatile("" ::: "memory");
}
__device__ __forceinline__ void cvt_job(Frame& F, const float* W, int K, int N, bf16* dst, int ldd, int kdst0, int mode, int roff, LAS float* scr) {
    const int nnb = N / 32, nitems = (K / 64) * nnb;
    for (int it = F.gw; it < nitems; it += F.NGW) {
        const int kb = it / nnb, nb = it % nnb, n0 = nb * 32;
        int drow0;
        if (mode == 0) drow0 = n0 + roff; else if (mode == 1) drow0 = (n0 >> 7) * 256 + (n0 & 127); else if (mode == 2) drow0 = (n0 >> 7) * 256 + 128 + (n0 & 127); else drow0 = n0 < 576 ? n0 : n0 + 192;
        cvt_item(W, N, kb * 64, n0, dst, ldd, drow0, kdst0, scr, F.lane);
    }
}
__device__ __forceinline__ void rms_row_to_bf16(const float* xrow, const float* g, bf16* orow, int lane) {
    const GAS f32x4* xr = (const GAS f32x4*)xrow + lane; const GAS f32x4* gr = (const GAS f32x4*)g + lane;
    f32x4 v[8]; float s = 0.f;
#pragma unroll
    for (int j = 0; j < 8; ++j) { v[j] = xr[64 * j]; s += (v[j].x * v[j].x + v[j].y * v[j].y) + (v[j].z * v[j].z + v[j].w * v[j].w); }
    const float rstd = 1.f / sqrtf(wave_sum(s) * (1.f / D) + EPS);
    GAS v2u* o8 = (GAS v2u*)orow + lane;
#pragma unroll
    for (int j = 0; j < 8; ++j) { const f32x4 gg = gr[64 * j]; v2u w; w.x = pk2(v[j].x * rstd * gg.x, v[j].y * rstd * gg.y); w.y = pk2(v[j].z * rstd * gg.z, v[j].w * rstd * gg.w); o8[64 * j] = w; }
}
__device__ __forceinline__ void sincos_f64(float ang, float& c, float& s) {
    const double a = (double)ang, twopi = 6.283185307179586476925286766559, inv2pi = 0.15915494309189533576888376337251;
    const double q = __builtin_rint(a * inv2pi); const double r = a - q * twopi;
    const double r2 = r * r; double ss = 1.0, cc = 1.0;
#pragma unroll
    for (int k = 14; k >= 1; --k) { ss = 1.0 - r2 * (1.0 / (double)((2 * k) * (2 * k + 1))) * ss; cc = 1.0 - r2 * (1.0 / (double)((2 * k - 1) * (2 * k))) * cc; }
    s = (float)(r * ss); c = (float)cc;
}
__device__ const unsigned char DIL_BUCKET[3][129] = {
 {11,11,11,11,11,11,11,11,11,11,11,11,11,11,11,10,10,10,10,10,10,10,10,10,10,10,10,10,10,10,10,10,10,10,10,10,10,10,9,9,9,9,9,9,9,9,9,9,9,9,8,8,8,8,8,8,8,7,6,5,4,3,2,1,0,17,18,19,20,21,22,23,24,24,24,24,24,24,24,25,25,25,25,25,25,25,25,25,25,25,25,26,26,26,26,26,26,26,26,26,26,26,26,26,26,26,26,26,26,26,26,26,26,26,27,27,27,27,27,27,27,27,27,27,27,27,27,27,27},
 {13,13,13,13,13,13,13,13,13,13,13,13,13,13,13,13,13,13,13,13,13,13,13,12,12,12,12,12,12,12,12,12,12,12,12,12,12,12,12,12,12,12,11,11,11,11,11,11,11,11,11,11,10,10,10,10,10,10,9,9,9,8,8,4,0,20,24,24,25,25,25,26,26,26,26,26,26,27,27,27,27,27,27,27,27,27,27,28,28,28,28,28,28,28,28,28,28,28,28,28,28,28,28,28,28,28,29,29,29,29,29,29,29,29,29,29,29,29,29,29,29,29,29,29,29,29,29,29,29},
 {15,15,15,15,15,15,15,15,15,15,15,15,15,15,15,15,15,15,15,15,15,15,15,15,15,15,15,15,15,15,14,14,14,14,14,14,14,14,14,14,14,14,14,14,14,13,13,13,13,13,13,13,13,13,12,12,12,12,12,11,11,10,10,9,0,25,26,26,27,27,28,28,28,28,28,29,29,29,29,29,29,29,29,29,30,30,30,30,30,30,30,30,30,30,30,30,30,30,30,31,31,31,31,31,31,31,31,31,31,31,31,31,31,31,31,31,31,31,31,31,31,31,31,31,31,31,31,31,31}};

typedef float f32x2 __attribute__((ext_vector_type(2)));
#ifndef PH_MASK
#define PH_MASK 0xFFFFu
#endif
#ifndef ATT_EN
#define ATT_EN 7
#endif
#define PEN(k) ((PH_MASK >> (k)) & 1u)
constexpr int PH_PER_LAYER = 11, N_PHASES = 1 + 2 * PH_PER_LAYER;
#ifndef MK_N_LAUNCHES
#define MK_N_LAUNCHES 1
#endif
constexpr int N_LAUNCHES = MK_N_LAUNCHES;

__global__ void __launch_bounds__(NWAVES * 64, 2) mk_fwd(Args args) {
    extern __shared__ __attribute__((aligned(16))) unsigned char lds[];
    Frame F;
    F.lds = (LAS unsigned char*)lds;
    F.MISC = (volatile LAS unsigned*)(F.lds + MISC_OFF);
    F.tid = threadIdx.x; F.lane = F.tid & 63; F.wave = __builtin_amdgcn_readfirstlane(F.tid >> 6);
    F.G = gridDim.x; F.gw = blockIdx.x * NWAVES + F.wave; F.NGW = F.G * NWAVES;
    F.ws = args.ws; F.ctl = (gu32*)(args.ws + WS_CTL);
    unsigned char* ws = args.ws;
    for (int u = F.tid; u < (LDS_BYTES - LDSCTL_OFF) / 4; u += NWAVES * 64) ((LAS unsigned*)(F.lds + LDSCTL_OFF))[u] = 0u;
    __syncthreads();
    XcdBarrier bar; bar.bar = (unsigned*)(F.ctl + CW_BAR); bar.x = 0; bar.st = nullptr;
    if (N_LAUNCHES == 1) bar = xcd_barrier_post((unsigned*)(F.ctl + CW_BAR), F.MISC + 8);
#define GRID_BAR() do { if (N_LAUNCHES == 1) xcd_barrier(bar); } while (0)
    const int lo = args.ph_lo, hi = args.ph_hi;
#define IN(k) (lo <= (k) && (k) < hi)
#define BOTH(k) (IN(k) && IN((k) + 1))

#define x_in (args.in[0])
#define WIN ((bf16*)(ws + WS_WIN))
#define WUP ((bf16*)(ws + WS_WUP))
#define WMEM ((bf16*)(ws + WS_WMEM))
#define WOUT ((bf16*)(ws + WS_WOUT))
#define WGU ((bf16*)(ws + WS_WGU))
#define WDN ((bf16*)(ws + WS_WDN))
#define MGU ((bf16*)(ws + WS_MGU))
#define MDN ((bf16*)(ws + WS_MDN))
#define XN ((bf16*)(ws + WS_XN))
#define MEMN ((bf16*)(ws + WS_MEMN))
#define MEMKV ((bf16*)(ws + WS_MEMKV))
#define PROJ ((bf16*)(ws + WS_PROJ))
#define AQKV ((bf16*)(ws + WS_AQKV))
#define KROPE ((bf16*)(ws + WS_KROPE))
#define ROPECS ((float*)(ws + WS_ROPECS))
#define QKVM ((bf16*)(ws + WS_QKVM))
#define YPRE ((float*)(ws + WS_YPRE))
#define DILO ((float*)(ws + WS_DILO))
#define DILS ((float*)(ws + WS_DILS))
#define Y ((bf16*)(ws + WS_Y))
#define XA ((float*)(ws + WS_XA))
#define ROUTE ((unsigned*)(ws + WS_ROUTE))
#define XP ((bf16*)(ws + WS_XP))
#define OUTP ((bf16*)(ws + WS_OUTP))
#define ACTP ((bf16*)(ws + WS_ACTP))
#define ACT ((bf16*)(ws + WS_ACTP))
#define PHASE_BEGIN() do { int t_ = threadIdx.x; asm volatile("" : "+v"(t_)); F.tid = t_; F.lane = t_ & 63; } while (0)

    if (PEN(0) && IN(0)) { PHASE_BEGIN();
        LAS float* scr = (LAS float*)(F.lds + F.wave * 16384);
        for (int l = 0; l < 2; ++l) {
            cvt_job(F, args.in[5] + (size_t)l * D * DIN, D, DIN, WIN + (size_t)l * DINP * D, D, 0, 3, 0, scr);
            cvt_job(F, args.in[7] + (size_t)l * QR * 1152, QR, 1152, WUP + (size_t)l * NUP * AQ, AQ, 0, 0, 0, scr);
            cvt_job(F, args.in[9] + (size_t)l * KVR * 1536, KVR, 1536, WUP + (size_t)l * NUP * AQ, AQ, QR, 0, UC_KV, scr);
            cvt_job(F, args.in[11] + (size_t)l * D * 1024, D, 1024, WMEM + (size_t)l * 1024 * D, D, 0, 0, 0, scr);
            cvt_job(F, args.in[13] + (size_t)l * D * D, D, D, WOUT + (size_t)l * D * D, D, 0, 0, 0, scr);
        }
        cvt_job(F, args.in[15], D, DFF, WGU, D, 0, 1, 0, scr);
        cvt_job(F, args.in[16], D, DFF, WGU, D, 0, 2, 0, scr);
        cvt_job(F, args.in[17], DFF, D, WDN, DFF, 0, 0, 0, scr);
        for (int e = 0; e < NE; ++e) {
            cvt_job(F, args.in[19] + (size_t)e * D * DFE, D, DFE, MGU + (size_t)e * 2 * DFE * D, D, 0, 1, 0, scr);
            cvt_job(F, args.in[20] + (size_t)e * D * DFE, D, DFE, MGU + (size_t)e * 2 * DFE * D, D, 0, 2, 0, scr);
            cvt_job(F, args.in[21] + (size_t)e * DFE * D, DFE, D, MDN + (size_t)e * D * DFE, DFE, 0, 0, 0, scr);
        }
        { const int* pos = (const int*)args.in[2];
          for (int idx = blockIdx.x * (NWAVES * 64) + F.tid; idx < S * 32; idx += F.G * NWAVES * 64) { const int row = idx >> 5, i = idx & 31;
              const float ang = (float)pos[row] * args.invf[i]; float c, s; sincos_f64(ang, c, s); ROPECS[row * 64 + i] = c; ROPECS[row * 64 + 32 + i] = s; } }
        for (int m = F.gw; m < 2 * NMEM; m += F.NGW) { const int l = m >> 8, r = m & 255; rms_row_to_bf16(args.in[1] + (size_t)r * D, args.in[10] + (size_t)l * D, MEMN + (size_t)m * D, F.lane); }
        for (int m = F.gw; m < S; m += F.NGW) rms_row_to_bf16(x_in + (size_t)m * D, args.in[4], XN + (size_t)m * D, F.lane);
        if (BOTH(0)) GRID_BAR();
    }

    for (int l = 0; l < 2; ++l) {
        const int pb = 1 + l * PH_PER_LAYER;
        if (PEN(1) && IN(pb + 0)) { PHASE_BEGIN();
            { pg8::Gemm g{XN, WIN + (size_t)l * DINP * D, D, D, D}; pg8::InProjOrder So; So.so.init(S, DINP, F.G, (int)blockIdx.x); So.nextra = (l == 0) ? 8 : 0; So.A2 = MEMN; So.B2 = WMEM;
              pg8::EpiBf16Sel E{PROJ, DINP, MEMKV, 1024};
              pg8::gemm_phase<pg8::EpiBf16Sel, pg8::InProjOrder, true, true>(F.lds, g, So, E); }
            if (BOTH(pb + 0)) GRID_BAR();
        }
        if (PEN(2) && IN(pb + 1)) { PHASE_BEGIN();
            const float* gq = args.in[6] + l * QR; const float* gkv = args.in[8] + l * KVR;
            for (int m = F.gw; m < S; m += F.NGW) {
                const v4u w = *(const GAS v4u*)(PROJ + (size_t)m * DINP + F.lane * 8);
                float v[8] = {bflo(w.x), bfhi(w.x), bflo(w.y), bfhi(w.y), bflo(w.z), bfhi(w.z), bflo(w.w), bfhi(w.w)};
                float sq = 0.f;
#pragma unroll
                for (int j = 0; j < 8; ++j) sq += v[j] * v[j];
                const float sq_q = wave_sum(F.lane < 48 ? sq : 0.f), sq_kv = wave_sum(F.lane >= 48 ? sq : 0.f);
                const float rstd = F.lane < 48 ? 1.f / sqrtf(sq_q * (1.f / QR) + EPS) : 1.f / sqrtf(sq_kv * (1.f / KVR) + EPS);
                const float* gp = F.lane < 48 ? gq + F.lane * 8 : gkv + (F.lane - 48) * 8;
                const f32x4 g0 = *(const GAS f32x4*)gp, g1 = *(const GAS f32x4*)(gp + 4);
                v4u o; o.x = pk2(v[0] * rstd * g0.x, v[1] * rstd * g0.y); o.y = pk2(v[2] * rstd * g0.z, v[3] * rstd * g0.w);
                o.z = pk2(v[4] * rstd * g1.x, v[5] * rstd * g1.y); o.w = pk2(v[6] * rstd * g1.z, v[7] * rstd * g1.w);
                *(GAS v4u*)(AQKV + (size_t)m * AQ + F.lane * 8) = o;
                const int c = F.lane & 7;
                const v4u kw = *(const GAS v4u*)(PROJ + (size_t)m * DINP + 512 + c * 8);
                float kv[8] = {bflo(kw.x), bfhi(kw.x), bflo(kw.y), bfhi(kw.y), bflo(kw.z), bfhi(kw.z), bflo(kw.w), bfhi(kw.w)};
                float ko[8];
                const float* cs = ROPECS + (size_t)m * 64 + (c & 3) * 8;
#pragma unroll
                for (int j = 0; j < 8; ++j) { const float other = __shfl_xor(kv[j], 4); const float co = cs[j], si = cs[32 + j];
                    ko[j] = (c < 4) ? (kv[j] * co - other * si) : (other * si + kv[j] * co); }
                if (F.lane < 8) { v4u ow; ow.x = pk2(ko[0], ko[1]); ow.y = pk2(ko[2], ko[3]); ow.z = pk2(ko[4], ko[5]); ow.w = pk2(ko[6], ko[7]); *(GAS v4u*)(KROPE + (size_t)m * 64 + c * 8) = ow; }
            }
            if (BOTH(pb + 1)) GRID_BAR();
        }
        if (PEN(3) && IN(pb + 2)) { PHASE_BEGIN();
            pg8::Gemm g{AQKV, WUP + (size_t)l * NUP * AQ, AQ, AQ, AQ}; pg8::StaticOrder So; So.init(S, NUP, F.G, (int)blockIdx.x);
            pg8::EpiBf16 E{QKVM, NUP};
            pg8::gemm_phase<pg8::EpiBf16, pg8::StaticOrder, true, true>(F.lds, g, So, E);
            if (BOTH(pb + 2)) GRID_BAR();
        }
        if (PEN(4) && IN(pb + 3)) { PHASE_BEGIN();
            LAS float* BIAS = (LAS float*)(F.lds + BIAS_OFF);
            for (int i = F.tid; i < 3 * 6 * 129; i += NWAVES * 64) { const int b = i / (6 * 129), rem = i % (6 * 129), h = rem / 129, j = rem % 129;
                BIAS[(b * 6 + h) * 132 + j] = args.in[3][DIL_BUCKET[b][j] * 6 + h] * att::LOG2E; }
            __syncthreads();
            gu32* qhead = F.ctl + CW_QUEUE + 64 * l;
            constexpr int NU_MLA = 6 * 32, NU_MEM = 4 * 32, NU_DIL = 3 * 6 * 32, NU = NU_MLA + NU_MEM + NU_DIL;
#define QPULL(u) do { if (F.tid == 0) F.MISC[16] = __hip_atomic_fetch_add(qhead, 1u, RLX_AGENT); __syncthreads(); u = (int)F.MISC[16]; __syncthreads(); } while (0)
            int u; QPULL(u);
            if (ATT_EN & 1) while (u < NU_MLA) {
                const int h = u >> 5, qb = u & 31;
                att::attn_simple_body<192, NUP, NUP, D>(QKVM + (size_t)qb * 256 * NUP + h * 192, QKVM + UC_KV + h * 256, KROPE, QKVM + UC_KV + h * 256 + 128,
                                                        ROPECS + (size_t)qb * 256 * 64, YPRE + (size_t)qb * 256 * D + h * 128, S, 0.07216878364870322f, (LAS char*)F.lds);
                QPULL(u);
            }
            if (ATT_EN & 2) while (u < NU_MLA + NU_MEM) {
                const int v = u - NU_MLA, h = v >> 5, qb = v & 31;
                const bf16* kv = MEMKV + (size_t)l * NMEM * 1024;
                att::attn_dense_body<128, DINP, 1024, D, 1>(PROJ + (size_t)qb * 256 * DINP + PC_MEM + h * 128, kv + h * 128, nullptr, kv + 512 + h * 128,
                                                            nullptr, YPRE + (size_t)qb * 256 * D + 1536 + h * 128, NMEM, 0.08838834764831845f, (LAS char*)F.lds);
                QPULL(u);
            }
            if (ATT_EN & 4) while (u < NU) {
                const int w = (u - NU_MLA - NU_MEM) * 8 + F.wave;
                const int b = w / 1536, h = (w % 1536) >> 8, tile = w & 255;
                const int d = b == 0 ? 1 : (b == 1 ? 4 : 16), nT = S / d, tpr = nT / 32;
                const int r = tile / tpr, t0 = (tile % tpr) * 32;
                att::dil_wave_unit<DINP>(PROJ, PC_DIL + h * 128, PC_DIL + 768 + h * 128, PC_DIL + 1536 + h * 128, d, r, t0, nT,
                                         DILO + (size_t)b * S * 768, h * 128, DILS + (size_t)b * S * 12 + h * 2,
                                         (LAS char*)F.lds + F.wave * 8192, BIAS + (b * 6 + h) * 132, 0.08838834764831845f * att::LOG2E, F.lane);
                QPULL(u);
            }
#undef QPULL
            if (BOTH(pb + 3)) GRID_BAR();
        }
        if (PEN(5) && IN(pb + 4)) { PHASE_BEGIN();
            const float* gn = args.in[12] + (size_t)l * D;
            for (int m = F.gw; m < S; m += F.NGW) {
                const float* yr = YPRE + (size_t)m * D;
                f32x4 a[3]; float sa = 0.f;
#pragma unroll
                for (int j = 0; j < 3; ++j) { a[j] = *(const GAS f32x4*)(yr + (F.lane + 64 * j) * 4); sa += (a[j].x * a[j].x + a[j].y * a[j].y) + (a[j].z * a[j].z + a[j].w * a[j].w); }
                f32x4 c[2]; float sc = 0.f;
#pragma unroll
                for (int j = 0; j < 2; ++j) { c[j] = *(const GAS f32x4*)(yr + 1536 + (F.lane + 64 * j) * 4); sc += (c[j].x * c[j].x + c[j].y * c[j].y) + (c[j].z * c[j].z + c[j].w * c[j].w); }
                f32x4 bq[3]; float sb = 0.f;
#pragma unroll
                for (int j = 0; j < 3; ++j) { const int col = (F.lane + 64 * j) * 4, h = col >> 7;
                    float mm[3], zz[3];
#pragma unroll
                    for (int b = 0; b < 3; ++b) { const f32x2 st = *(const GAS f32x2*)(DILS + ((size_t)b * S + m) * 12 + h * 2); mm[b] = st.x; zz[b] = st.y; }
                    const float M = fmaxf(mm[0], fmaxf(mm[1], mm[2]));
                    float wgt[3], den = 0.f;
#pragma unroll
                    for (int b = 0; b < 3; ++b) { wgt[b] = __builtin_amdgcn_exp2f(mm[b] - M); den += wgt[b] * zz[b]; }
                    const float inv = 1.f / den; f32x4 acc = {0.f, 0.f, 0.f, 0.f};
#pragma unroll
                    for (int b = 0; b < 3; ++b) { const f32x4 ob = *(const GAS f32x4*)(DILO + ((size_t)b * S + m) * 768 + col); acc += ob * (wgt[b] * inv); }
                    bq[j] = acc; sb += (acc.x * acc.x + acc.y * acc.y) + (acc.z * acc.z + acc.w * acc.w); }
                const float ra = 1.f / sqrtf(wave_sum(sa) * (1.f / 768.f) + EPS), rb = 1.f / sqrtf(wave_sum(sb) * (1.f / 768.f) + EPS), rc = 1.f / sqrtf(wave_sum(sc) * (1.f / 512.f) + EPS);
                bf16* yo = Y + (size_t)m * D;
#pragma unroll
                for (int j = 0; j < 3; ++j) { const int col = (F.lane + 64 * j) * 4; const f32x4 g = *(const GAS f32x4*)(gn + col);
                    v2u w; w.x = pk2(a[j].x * ra * g.x, a[j].y * ra * g.y); w.y = pk2(a[j].z * ra * g.z, a[j].w * ra * g.w); *(GAS v2u*)(yo + col) = w; }
#pragma unroll
                for (int j = 0; j < 3; ++j) { const int col = (F.lane + 64 * j) * 4; const f32x4 g = *(const GAS f32x4*)(gn + 768 + col);
                    v2u w; w.x = pk2(bq[j].x * rb * g.x, bq[j].y * rb * g.y); w.y = pk2(bq[j].z * rb * g.z, bq[j].w * rb * g.w); *(GAS v2u*)(yo + 768 + col) = w; }
#pragma unroll
                for (int j = 0; j < 2; ++j) { const int col = (F.lane + 64 * j) * 4; const f32x4 g = *(const GAS f32x4*)(gn + 1536 + col);
                    v2u w; w.x = pk2(c[j].x * rc * g.x, c[j].y * rc * g.y); w.y = pk2(c[j].z * rc * g.z, c[j].w * rc * g.w); *(GAS v2u*)(yo + 1536 + col) = w; }
            }
            if (BOTH(pb + 4)) GRID_BAR();
        }
        if (PEN(6) && IN(pb + 5)) { PHASE_BEGIN();
            pg8::Gemm g{Y, WOUT + (size_t)l * D * D, D, D, D}; pg8::StaticOrder So; So.init(S, D, F.G, (int)blockIdx.x);
            pg8::EpiResF32 E{l == 0 ? x_in : XA, XA, D};
            pg8::gemm_phase<pg8::EpiResF32, pg8::StaticOrder, true, true>(F.lds, g, So, E);
            if (BOTH(pb + 5)) GRID_BAR();
        }
        if (PEN(7) && IN(pb + 6)) { PHASE_BEGIN();
            const float* gf = args.in[14] + (size_t)l * D;
            if (l == 0) { for (int m = F.gw; m < S; m += F.NGW) rms_row_to_bf16(XA + (size_t)m * D, gf, XN + (size_t)m * D, F.lane); }
            else {
                const float* Wr = args.in[18];
                for (int m = F.gw; m < S; m += F.NGW) {
                    const GAS f32x4* xr = (const GAS f32x4*)(XA + (size_t)m * D) + F.lane; const GAS f32x4* gr = (const GAS f32x4*)gf + F.lane;
                    f32x4 v[8]; float s = 0.f;
#pragma unroll
                    for (int j = 0; j < 8; ++j) { v[j] = xr[64 * j]; s += (v[j].x * v[j].x + v[j].y * v[j].y) + (v[j].z * v[j].z + v[j].w * v[j].w); }
                    const float rstd = 1.f / sqrtf(wave_sum(s) * (1.f / D) + EPS);
                    float lg[8] = {0.f, 0.f, 0.f, 0.f, 0.f, 0.f, 0.f, 0.f};
                    GAS v2u* o8 = (GAS v2u*)(XN + (size_t)m * D) + F.lane;
#pragma unroll
                    for (int j = 0; j < 8; ++j) { const f32x4 gg = gr[64 * j]; const f32x4 hh = {v[j].x * rstd * gg.x, v[j].y * rstd * gg.y, v[j].z * rstd * gg.z, v[j].w * rstd * gg.w};
                        v2u w; w.x = pk2(hh.x, hh.y); w.y = pk2(hh.z, hh.w); o8[64 * j] = w;
                        const float* wr = Wr + (size_t)((F.lane + 64 * j) * 4) * NE;
#pragma unroll
                        for (int q = 0; q < 4; ++q) { const f32x4 w0 = *(const GAS f32x4*)(wr + q * NE), w1 = *(const GAS f32x4*)(wr + q * NE + 4); const float hv = hh[q];
                            lg[0] += hv * w0.x; lg[1] += hv * w0.y; lg[2] += hv * w0.z; lg[3] += hv * w0.w; lg[4] += hv * w1.x; lg[5] += hv * w1.y; lg[6] += hv * w1.z; lg[7] += hv * w1.w; } }
#pragma unroll
                    for (int e = 0; e < NE; ++e) lg[e] = wave_sum(lg[e]);
                    int e1 = 0; float v1 = lg[0];
#pragma unroll
                    for (int e = 1; e < NE; ++e) if (lg[e] > v1) { v1 = lg[e]; e1 = e; }
                    int e2 = -1; float v2 = -3.0e38f;
#pragma unroll
                    for (int e = 0; e < NE; ++e) if (e != e1 && lg[e] > v2) { v2 = lg[e]; e2 = e; }
                    const float g1 = 1.f / (1.f + __expf(v2 - v1)), g2 = 1.f - g1;
                    if (F.lane == 0) { const unsigned s1 = __hip_atomic_fetch_add(F.ctl + CW_CNT + e1, 1u, RLX_AGENT), s2 = __hip_atomic_fetch_add(F.ctl + CW_CNT + e2, 1u, RLX_AGENT);
                        v4u r0 = {(unsigned)e1, (unsigned)e2, s1, s2}; v4u r1 = {__float_as_uint(g1), __float_as_uint(g2), 0u, 0u};
                        *(GAS v4u*)(ROUTE + (size_t)m * 8) = r0; *(GAS v4u*)(ROUTE + (size_t)m * 8 + 4) = r1; }
                }
            }
            if (BOTH(pb + 6)) GRID_BAR();
        }
        if (PEN(8) && IN(pb + 7)) { PHASE_BEGIN();
            if (l == 1) {
                int base[NE]; int tstart = 0;
#pragma unroll
                for (int e = 0; e < NE; ++e) { const int c = (int)__hip_atomic_load(F.ctl + CW_CNT + e, RLX_AGENT); base[e] = tstart * 256; const int nt = (c + 255) >> 8;
                    if (blockIdx.x == 0 && F.tid == 0) { for (int t = 0; t < nt; ++t) F.ctl[CW_TILEE + 1 + tstart + t] = (unsigned)e; }
                    tstart += nt; }
                if (blockIdx.x == 0 && F.tid == 0) F.ctl[CW_TILEE] = (unsigned)tstart;
                for (int m = F.gw; m < S; m += F.NGW) {
                    const v4u r0 = *(const GAS v4u*)(ROUTE + (size_t)m * 8);
                    int p1 = (int)r0.z, p2 = (int)r0.w;
#pragma unroll
                    for (int e = 0; e < NE; ++e) { if ((int)r0.x == e) p1 += base[e]; if ((int)r0.y == e) p2 += base[e]; }
                    if (F.lane == 0) { ROUTE[(size_t)m * 8 + 6] = (unsigned)p1; ROUTE[(size_t)m * 8 + 7] = (unsigned)p2; }
                    const GAS v4u* src = (const GAS v4u*)(XN + (size_t)m * D) + F.lane; GAS v4u* d1 = (GAS v4u*)(XP + (size_t)p1 * D) + F.lane; GAS v4u* d2 = (GAS v4u*)(XP + (size_t)p2 * D) + F.lane;
#pragma unroll
                    for (int j = 0; j < 4; ++j) { const v4u t = src[64 * j]; d1[64 * j] = t; d2[64 * j] = t; }
                }
            }
            if (BOTH(pb + 7) && l == 1) GRID_BAR();
        }
        if (PEN(9) && IN(pb + 8)) { PHASE_BEGIN();
            if (l == 0) { pg8::Gemm g{XN, WGU, D, D, D}; pg8::StaticOrder So; So.init(S, 2 * DFF, F.G, (int)blockIdx.x);
                pg8::EpiSwiGLU E{ACT, DFF};
                pg8::gemm_phase<pg8::EpiSwiGLU, pg8::StaticOrder, true, true>(F.lds, g, So, E); }
            else { const int ntile = (int)__hip_atomic_load(F.ctl + CW_TILEE, RLX_AGENT);
                pg8::Gemm g{XP, MGU, D, D, D}; pg8::MoeOrder So{F.G, (int)blockIdx.x, 2 * DFE / 256, ntile, 2 * DFE, (const int*)(F.ctl + CW_TILEE + 1)};
                pg8::EpiSwiGLU E{ACTP, DFE};
                pg8::gemm_phase<pg8::EpiSwiGLU, pg8::MoeOrder, true, true>(F.lds, g, So, E); }
            if (BOTH(pb + 8)) GRID_BAR();
        }
        if (PEN(10) && IN(pb + 9)) { PHASE_BEGIN();
            if (l == 0) { pg8::Gemm g{ACT, WDN, DFF, DFF, DFF}; pg8::StaticOrder So; So.init(S, D, F.G, (int)blockIdx.x);
                pg8::EpiResF32 E{XA, XA, D};
                pg8::gemm_phase<pg8::EpiResF32, pg8::StaticOrder, true, true>(F.lds, g, So, E); }
            else { const int ntile = (int)__hip_atomic_load(F.ctl + CW_TILEE, RLX_AGENT);
                pg8::Gemm g{ACTP, MDN, DFE, DFE, DFE}; pg8::MoeOrder So{F.G, (int)blockIdx.x, D / 256, ntile, D, (const int*)(F.ctl + CW_TILEE + 1)};
                pg8::EpiBf16 E{OUTP, D};
                pg8::gemm_phase<pg8::EpiBf16, pg8::MoeOrder, true, true>(F.lds, g, So, E); }
            if (BOTH(pb + 9)) GRID_BAR();
        }
        if (PEN(11) && IN(pb + 10)) { PHASE_BEGIN();
            if (l == 0) { for (int m = F.gw; m < S; m += F.NGW) rms_row_to_bf16(XA + (size_t)m * D, args.in[4] + D, XN + (size_t)m * D, F.lane); }
            else {
                const float* gfin = args.in[22];
                for (int m = F.gw; m < S; m += F.NGW) {
                    const v4u r1 = *(const GAS v4u*)(ROUTE + (size_t)m * 8 + 4);
                    const float g1 = __uint_as_float(r1.x), g2 = __uint_as_float(r1.y); const int p1 = (int)r1.z, p2 = (int)r1.w;
                    const GAS f32x4* xr = (const GAS f32x4*)(XA + (size_t)m * D) + F.lane;
                    const GAS v2u* o1 = (const GAS v2u*)(OUTP + (size_t)p1 * D) + F.lane; const GAS v2u* o2 = (const GAS v2u*)(OUTP + (size_t)p2 * D) + F.lane;
                    f32x4 v[8]; float s = 0.f;
#pragma unroll
                    for (int j = 0; j < 8; ++j) { const f32x4 xv = xr[64 * j]; const v2u a = o1[64 * j], b = o2[64 * j];
                        v[j].x = xv.x + g1 * bflo(a.x) + g2 * bflo(b.x); v[j].y = xv.y + g1 * bfhi(a.x) + g2 * bfhi(b.x);
                        v[j].z = xv.z + g1 * bflo(a.y) + g2 * bflo(b.y); v[j].w = xv.w + g1 * bfhi(a.y) + g2 * bfhi(b.y);
                        s += (v[j].x * v[j].x + v[j].y * v[j].y) + (v[j].z * v[j].z + v[j].w * v[j].w); }
                    const float rstd = 1.f / sqrtf(wave_sum(s) * (1.f / D) + EPS);
                    GAS f32x4* orow = (GAS f32x4*)(args.out + (size_t)m * D) + F.lane; const GAS f32x4* gr = (const GAS f32x4*)gfin + F.lane;
#pragma unroll
                    for (int j = 0; j < 8; ++j) { const f32x4 gg = gr[64 * j]; orow[64 * j] = (f32x4){v[j].x * rstd * gg.x, v[j].y * rstd * gg.y, v[j].z * rstd * gg.z, v[j].w * rstd * gg.w}; }
                }
            }
            if (BOTH(pb + 10) && l == 0) GRID_BAR();
        }
    }
#undef IN
#undef BOTH
#undef GRID_BAR
#undef WIN
#undef WUP
#undef WMEM
#undef WOUT
#undef WGU
#undef WDN
#undef MGU
#undef MDN
#undef XN
#undef MEMN
#undef MEMKV
#undef PROJ
#undef AQKV
#undef KROPE
#undef ROPECS
#undef QKVM
#undef YPRE
#undef DILO
#undef DILS
#undef Y
#undef XA
#undef ROUTE
#undef XP
#undef OUTP
#undef ACTP
#undef ACT
#undef x_in
#undef PHASE_BEGIN
}

extern "C" void kernel_launch(void* const* d_in, const int* in_sizes, int n_in, void* d_out, int out_size, void* d_ws, size_t ws_size, hipStream_t stream) {
    static int grid = 0;
    if (grid == 0) {
        if (n_in != 23 || in_sizes[0] != S * D || out_size != S * D || ws_size < WS_END) { fprintf(stderr, "kernel_launch: shape/workspace mismatch: n_in %d in0 %d out %d ws %zu (need %zu)\n", n_in, n_in > 0 ? in_sizes[0] : -1, out_size, ws_size, (size_t)WS_END); grid = -1; return; }
        int dev = 0, cus = 0, per_cu = 0;
        if (hipGetDevice(&dev) != hipSuccess || hipDeviceGetAttribute(&cus, hipDeviceAttributeMultiprocessorCount, dev) != hipSuccess) { fprintf(stderr, "kernel_launch: device query failed\n"); grid = -1; return; }
        if (hipFuncSetAttribute((const void*)mk_fwd, hipFuncAttributeMaxDynamicSharedMemorySize, LDS_BYTES) != hipSuccess) { fprintf(stderr, "kernel_launch: hipFuncSetAttribute failed\n"); grid = -1; return; }
        if (hipOccupancyMaxActiveBlocksPerMultiprocessor(&per_cu, (const void*)mk_fwd, NWAVES * 64, LDS_BYTES) != hipSuccess || per_cu < 1) { fprintf(stderr, "kernel_launch: occupancy query reports %d workgroups per CU\n", per_cu); }
        (void)hipGetLastError();
        grid = cus;
    }
    if (grid < 0) return;
    (void)hipMemsetAsync((char*)d_ws + WS_CTL, 0, CTL_ZERO_BYTES, stream);
    (void)hipMemsetAsync((char*)d_ws + WS_WIN, 0, (size_t)2 * DINP * D * 2, stream);
    (void)hipMemsetAsync((char*)d_ws + WS_WUP, 0, (size_t)2 * NUP * AQ * 2, stream);
    Args a{};
    for (int i = 0; i < 23; ++i) a.in[i] = (const float*)d_in[i];
    a.out = (float*)d_out; a.ws = (unsigned char*)d_ws;
    for (int i = 0; i < 32; ++i) a.invf[i] = 1.0f / powf(10000.0f, (float)i / 32.0f);
    for (int li = 0; li < N_LAUNCHES; ++li) {
        a.ph_lo = (N_LAUNCHES == 1) ? 0 : li; a.ph_hi = (N_LAUNCHES == 1) ? N_PHASES : li + 1; a.li = li; a.pad = 0;
        hipLaunchKernelGGL(mk_fwd, dim3(grid), dim3(NWAVES * 64), LDS_BYTES, stream, a);
        const hipError_t le = hipPeekAtLastError();
        if (le != hipSuccess) { fprintf(stderr, "kernel_launch: launch %d failed: %s\n", li, hipGetErrorName(le)); break; }
    }
}
```

```cpp
#include <hip/hip_runtime.h>
#include <cstdio>
#include <cstdint>
#include <cmath>
#ifndef MK_N_LAUNCHES
#define MK_N_LAUNCHES 1
#endif
namespace pg8 {
#define PG8_LAS __attribute__((address_space(3)))
typedef unsigned short bf16_t;
typedef short bf16x8 __attribute__((ext_vector_type(8)));
typedef float f32x4 __attribute__((ext_vector_type(4)));
typedef unsigned u32x4 __attribute__((ext_vector_type(4)));
constexpr int BM = 256, BK = 64, HALF = 128, HTB = HALF * BK * 2  , STAGE_BYTES = 8 * HTB, NXCD = 8, WGM = 8;

__host__ __device__ __forceinline__ int lds_byte(int r, int c) { const int st = (r >> 4) * 2 + (c >> 5), rr = r & 15, cc = c & 31, ob = rr * 64 + cc * 2; return st * 1024 + (ob ^ (((ob >> 9) & 1) << 5)); }
__host__ __device__ __forceinline__ void stage_rc(int b, int& R, int& C) { const int st = b / 1024, sb = b % 1024, swz = sb ^ (((sb >> 9) & 1) << 5); R = (st >> 1) * 16 + swz / 64; C = (st & 1) * 32 + (swz % 64) / 2; }
__host__ __device__ __forceinline__ int perm32(int rho) { const int n = rho >> 4, i = rho & 15; return 8 * (i >> 2) + 4 * n + (i & 3); }

struct Unit { int pm, pn; };
struct Gemm { const bf16_t* A; const bf16_t* Bt; int lda, ldb, K; };

struct StaticOrder {
    int nM, nN, nwg, G, c;
    __device__ void init(int M, int N, int G_, int c_) { nM = M / BM; nN = N / BM; nwg = nM * nN; G = G_; c = c_; }
    __device__ bool next(int i, Unit& u) const {
        const long L = (long)i * G + c; if (L >= nwg) return false;
        int wgid = (int)L; { const int q = nwg / NXCD, r = nwg % NXCD, xcd = wgid % NXCD, off = wgid / NXCD; wgid = (xcd < r ? xcd * (q + 1) : r * (q + 1) + (xcd - r) * q) + off; }
        const int nig = WGM * nN, gid = wgid / nig, fm = gid * WGM, gsz = (nM - fm) < WGM ? (nM - fm) : WGM;
        u.pm = fm + ((wgid % nig) % gsz); u.pn = (wgid % nig) / gsz; return true;
    }
    __device__ __forceinline__ const char* abase(const Gemm& g, const Unit& u) const { return (const char*)g.A + (size_t)u.pm * BM * g.lda * 2; }
    __device__ __forceinline__ const char* bbase(const Gemm& g, const Unit& u) const { return (const char*)g.Bt + (size_t)u.pn * BM * g.ldb * 2; }
};
struct InProjOrder {
    StaticOrder so; int nextra; const bf16_t* A2; const bf16_t* B2;
    __device__ bool next(int i, Unit& u) const { if (so.next(i, u)) return true; const long L = (long)i * so.G + so.c - so.nwg; if (L < 0 || L >= nextra) return false; u.pm = 32 + (int)(L >> 2); u.pn = (int)(L & 3); return true; }
    __device__ __forceinline__ const char* abase(const Gemm& g, const Unit& u) const { return u.pm < 32 ? (const char*)g.A + (size_t)u.pm * BM * g.lda * 2 : (const char*)A2 + (size_t)(u.pm - 32) * BM * g.lda * 2; }
    __device__ __forceinline__ const char* bbase(const Gemm& g, const Unit& u) const { return u.pm < 32 ? (const char*)g.Bt + (size_t)u.pn * BM * g.ldb * 2 : (const char*)B2 + (size_t)((u.pm - 32) * 1024 + u.pn * BM) * g.ldb * 2; }
};
struct MemOrder {
    int G, c;
    __device__ bool next(int i, Unit& u) const { const int L = c - (G - 8); if (i != 0 || L < 0 || L >= 8) return false; u.pm = L >> 2; u.pn = L & 3; return true; }
    __device__ __forceinline__ const char* abase(const Gemm& g, const Unit& u) const { return (const char*)g.A + (size_t)u.pm * BM * g.lda * 2; }
    __device__ __forceinline__ const char* bbase(const Gemm& g, const Unit& u) const { return (const char*)g.Bt + (size_t)(u.pm * 1024 + u.pn * BM) * g.ldb * 2; }
};
struct MoeOrder {
    int G, c, nN, ntile, nexp_rows; const int* tile_e;
    __device__ bool next(int i, Unit& u) const { const long L = (long)i * G + c; if (L >= (long)ntile * nN) return false; u.pm = (int)(L / nN); u.pn = (int)(L % nN); return true; }
    __device__ __forceinline__ const char* abase(const Gemm& g, const Unit& u) const { return (const char*)g.A + (size_t)u.pm * BM * g.lda * 2; }
    __device__ __forceinline__ const char* bbase(const Gemm& g, const Unit& u) const { const int e = __builtin_amdgcn_readfirstlane(tile_e[u.pm]); return (const char*)g.Bt + ((size_t)e * nexp_rows + (size_t)u.pn * BM) * g.ldb * 2; }
};

__device__ __forceinline__ unsigned cvt_pk_bf16(float lo, float hi) { unsigned r; asm volatile("v_cvt_pk_bf16_f32 %0, %1, %2" : "=v"(r) : "v"(lo), "v"(hi)); return r; }

struct EpiBf16 {
    static constexpr bool PERM = true;
    bf16_t* O; int ldc;
    __device__ __forceinline__ void operator()(const f32x4 (&acc)[2][2][4][2], const Unit& u, int wr, int wc, int fr, int fq) const {
        const int row0 = u.pm * BM + wr * 64 + fr, col0 = u.pn * BM + wc * 32 + 8 * fq;
#pragma unroll
        for (int ai = 0; ai < 2; ++ai)
#pragma unroll
            for (int m = 0; m < 4; ++m) { bf16_t* rowp = O + (size_t)(row0 + ai * HALF + m * 16) * ldc + col0;
#pragma unroll
                for (int bj = 0; bj < 2; ++bj) { const f32x4 v0 = acc[ai][bj][m][0], v1 = acc[ai][bj][m][1];
                    u32x4 w; w.x = cvt_pk_bf16(v0[0], v0[1]); w.y = cvt_pk_bf16(v0[2], v0[3]); w.z = cvt_pk_bf16(v1[0], v1[1]); w.w = cvt_pk_bf16(v1[2], v1[3]);
                    *(u32x4*)(rowp + bj * HALF) = w; } }
    }
};
struct EpiBf16Sel {
    static constexpr bool PERM = true;
    bf16_t* O; int ldc; bf16_t* O2; int ldc2;
    __device__ __forceinline__ void operator()(const f32x4 (&acc)[2][2][4][2], const Unit& u, int wr, int wc, int fr, int fq) const {
        const bool ex = u.pm >= 32; bf16_t* base = ex ? O2 : O; const int ld = ex ? ldc2 : ldc;
        const int row0 = (ex ? u.pm - 32 : u.pm) * BM + wr * 64 + fr, col0 = u.pn * BM + wc * 32 + 8 * fq;
#pragma unroll
        for (int ai = 0; ai < 2; ++ai)
#pragma unroll
            for (int m = 0; m < 4; ++m) { bf16_t* rowp = base + (size_t)(row0 + ai * HALF + m * 16) * ld + col0;
#pragma unroll
                for (int bj = 0; bj < 2; ++bj) { const f32x4 v0 = acc[ai][bj][m][0], v1 = acc[ai][bj][m][1];
                    u32x4 w; w.x = cvt_pk_bf16(v0[0], v0[1]); w.y = cvt_pk_bf16(v0[2], v0[3]); w.z = cvt_pk_bf16(v1[0], v1[1]); w.w = cvt_pk_bf16(v1[2], v1[3]);
                    *(u32x4*)(rowp + bj * HALF) = w; } }
    }
};
struct EpiResF32 {
    static constexpr bool PERM = false;
    const float* R; float* C; int ldc;
    __device__ __forceinline__ void operator()(const f32x4 (&acc)[2][2][4][2], const Unit& u, int wr, int wc, int fr, int fq) const {
        const int row0 = u.pm * BM + wr * 64 + fr, col0 = u.pn * BM + wc * 32 + 4 * fq;
#pragma unroll
        for (int ai = 0; ai < 2; ++ai)
#pragma unroll
            for (int m = 0; m < 4; ++m) { const size_t off = (size_t)(row0 + ai * HALF + m * 16) * ldc + col0;
#pragma unroll
                for (int bj = 0; bj < 2; ++bj)
#pragma unroll
                    for (int n = 0; n < 2; ++n) { const f32x4 r = *(const f32x4*)(R + off + bj * HALF + n * 16); *(f32x4*)(C + off + bj * HALF + n * 16) = r + acc[ai][bj][m][n]; } }
    }
};
__device__ __forceinline__ float silu_mul(float g, float u) { return g * u * __builtin_amdgcn_rcpf(1.0f + __builtin_amdgcn_exp2f(-1.4426950408889634f * g)); }
struct EpiSwiGLU {
    static constexpr bool PERM = true;
    bf16_t* O; int ldc;
    __device__ __forceinline__ void operator()(const f32x4 (&acc)[2][2][4][2], const Unit& u, int wr, int wc, int fr, int fq) const {
        const int row0 = u.pm * BM + wr * 64 + fr, col0 = u.pn * HALF + wc * 32 + 8 * fq;
#pragma unroll
        for (int ai = 0; ai < 2; ++ai)
#pragma unroll
            for (int m = 0; m < 4; ++m) { bf16_t* rowp = O + (size_t)(row0 + ai * HALF + m * 16) * ldc + col0;
                const f32x4 g0 = acc[ai][0][m][0], g1 = acc[ai][0][m][1], u0 = acc[ai][1][m][0], u1 = acc[ai][1][m][1];
                u32x4 w; w.x = cvt_pk_bf16(silu_mul(g0[0], u0[0]), silu_mul(g0[1], u0[1])); w.y = cvt_pk_bf16(silu_mul(g0[2], u0[2]), silu_mul(g0[3], u0[3]));
                w.z = cvt_pk_bf16(silu_mul(g1[0], u1[0]), silu_mul(g1[1], u1[1])); w.w = cvt_pk_bf16(silu_mul(g1[2], u1[2]), silu_mul(g1[3], u1[3]));
                *(u32x4*)rowp = w; }
    }
};

template <class Epi, class Sched, bool ALIGN_EPI = false, bool SP2 = false>
__device__ __forceinline__ void gemm_phase(PG8_LAS unsigned char* lds, const Gemm g, const Sched& S, const Epi& E) {
    int tid_ = threadIdx.x; asm volatile("" : "+v"(tid_));
    const int tid = tid_, wid = __builtin_amdgcn_readfirstlane(tid >> 6), lane = tid & 63, wr = wid >> 2, wc = wid & 3, fr = lane & 15, fq = lane >> 4;
    const int K = g.K, nt = K / BK;
    unsigned voffA[2], voffB[2];
#pragma unroll
    for (int i = 0; i < 2; ++i) { int R, C; stage_rc(tid * 16 + i * 8192, R, C); const int Rb = Epi::PERM ? ((R & ~31) + perm32(R & 31)) : R;
        voffA[i] = (unsigned)(R * g.lda + C) * 2u; voffB[i] = (unsigned)(Rb * g.ldb + C) * 2u; }
    const size_t kstep = (size_t)(BK * 2);
    const size_t hstepA = (size_t)HALF * g.lda * 2, hstepB = (size_t)HALF * g.ldb * 2;
    const unsigned ldsw = (unsigned)wid * 1024u;
    const int aoff = lds_byte(wr * 64 + fr, fq * 8), boff = lds_byte(wc * 32 + fr, fq * 8);
#define PG8_SA(b, h) (((b) * 2 + (h)) * HTB)
#define PG8_SB(b, h) ((4 + (b) * 2 + (h)) * HTB)
#define PG8_STAGE(bufoff, gbase, voff) do { _Pragma("unroll") for (int _i = 0; _i < 2; ++_i) \
        __builtin_amdgcn_global_load_lds((const unsigned*)((const char*)(gbase) + (voff)[_i]), (PG8_LAS unsigned*)(lds + (bufoff) + ldsw + _i * 8192), 16, 0, 0); } while (0)
#define PG8_LDA(dst, b, h) do { _Pragma("unroll") for (int m = 0; m < 4; ++m) _Pragma("unroll") for (int k = 0; k < 2; ++k) dst[m][k] = *(const PG8_LAS bf16x8*)(lds + PG8_SA(b, h) + aoff + m * 2048 + k * 1024); } while (0)
#define PG8_LDB(dst, b, h) do { _Pragma("unroll") for (int n = 0; n < 2; ++n) _Pragma("unroll") for (int k = 0; k < 2; ++k) dst[n][k] = *(const PG8_LAS bf16x8*)(lds + PG8_SB(b, h) + boff + n * 2048 + k * 1024); } while (0)
#define PG8_MMA(ai, bj, At, Bt) do { __builtin_amdgcn_s_setprio(1); _Pragma("unroll") for (int m = 0; m < 4; ++m) _Pragma("unroll") for (int n = 0; n < 2; ++n) _Pragma("unroll") for (int k = 0; k < 2; ++k) \
        acc[ai][bj][m][n] = __builtin_amdgcn_mfma_f32_16x16x32_bf16(Bt[n][k], At[m][k], acc[ai][bj][m][n], 0, 0, 0); __builtin_amdgcn_s_setprio(0); } while (0)
#define PG8_WAIT_V(n) asm volatile("s_waitcnt vmcnt(" #n ")" ::: "memory")
#define PG8_WAIT_L(n) asm volatile("s_waitcnt lgkmcnt(" #n ")" ::: "memory")
#define PG8_BAR __builtin_amdgcn_s_barrier()
#define PG8_SCHED __builtin_amdgcn_sched_barrier(0)
    Unit cur, nxt; int ui = 0;
    if (!S.next(0, cur)) return;
    f32x4 acc[2][2][4][2];
#pragma unroll
    for (int a = 0; a < 2; ++a)
#pragma unroll
        for (int b = 0; b < 2; ++b)
#pragma unroll
            for (int m = 0; m < 4; ++m)
#pragma unroll
                for (int n = 0; n < 2; ++n) acc[a][b][m][n] = (f32x4){0.f, 0.f, 0.f, 0.f};
    bf16x8 At[4][2], B0[2][2], B1[2][2];
    const char* cA = S.abase(g, cur); const char* cB = S.bbase(g, cur);
    if constexpr (SP2) {
        PG8_STAGE(PG8_SB(0, 0), cB, voffB); PG8_STAGE(PG8_SB(0, 1), cB + hstepB, voffB); PG8_STAGE(PG8_SA(0, 0), cA, voffA); PG8_STAGE(PG8_SA(0, 1), cA + hstepA, voffA);
        if (wr == 1) PG8_BAR;
        PG8_WAIT_V(2); PG8_BAR;
        PG8_STAGE(PG8_SB(1, 0), cB + kstep, voffB); PG8_STAGE(PG8_SA(1, 0), cA + kstep, voffA); PG8_STAGE(PG8_SB(1, 1), cB + hstepB + kstep, voffB);
        PG8_WAIT_V(6); PG8_BAR;
    } else {
        PG8_STAGE(PG8_SB(0, 0), cB, voffB); PG8_STAGE(PG8_SA(0, 0), cA, voffA); PG8_STAGE(PG8_SB(0, 1), cB + hstepB, voffB); PG8_STAGE(PG8_SA(0, 1), cA + hstepA, voffA);
        if (wr == 1) PG8_BAR;
        PG8_WAIT_V(4); PG8_BAR;
        PG8_STAGE(PG8_SB(1, 0), cB + kstep, voffB); PG8_STAGE(PG8_SA(1, 0), cA + kstep, voffA); PG8_STAGE(PG8_SB(1, 1), cB + hstepB + kstep, voffB);
        PG8_WAIT_V(6); PG8_BAR;
    }
    for (;;) {
        const bool has_next = S.next(ui + 1, nxt);
        const char* nA = has_next ? S.abase(g, nxt) : cA; const char* nB = has_next ? S.bbase(g, nxt) : cB;
        for (int t = 0; t < nt; t += 2) {
            const bool last = (t == nt - 2);
            const char* a1 = cA + (size_t)(t + 1) * kstep;
            const char* a2 = last ? nA : cA + (size_t)(t + 2) * kstep; const char* b2 = last ? nB : cB + (size_t)(t + 2) * kstep;
            const char* a3 = a2 + kstep; const char* b3 = b2 + kstep;
            if constexpr (SP2) {
            PG8_LDB(B0, 0, 0); PG8_LDB(B1, 0, 1); PG8_SCHED; PG8_LDA(At, 0, 0); PG8_STAGE(PG8_SA(1, 1), a1 + hstepA, voffA);
            PG8_WAIT_V(8); PG8_WAIT_L(0); PG8_BAR; PG8_MMA(0, 0, At, B0); PG8_MMA(0, 1, At, B1); PG8_BAR; PG8_SCHED;
            PG8_LDA(At, 0, 1); PG8_STAGE(PG8_SB(0, 0), b2, voffB); PG8_STAGE(PG8_SB(0, 1), b2 + hstepB, voffB); PG8_STAGE(PG8_SA(0, 0), a2, voffA);
            PG8_WAIT_V(8); PG8_WAIT_L(0); PG8_BAR; PG8_MMA(1, 0, At, B0); PG8_MMA(1, 1, At, B1); PG8_BAR; PG8_SCHED;
            PG8_LDB(B0, 1, 0); PG8_LDB(B1, 1, 1); PG8_SCHED; PG8_LDA(At, 1, 0); PG8_STAGE(PG8_SA(0, 1), a2 + hstepA, voffA);
            PG8_WAIT_V(8); PG8_WAIT_L(0); PG8_BAR; PG8_MMA(0, 0, At, B0); PG8_MMA(0, 1, At, B1); PG8_BAR; PG8_SCHED;
            PG8_LDA(At, 1, 1); PG8_STAGE(PG8_SB(1, 0), b3, voffB); PG8_STAGE(PG8_SB(1, 1), b3 + hstepB, voffB); PG8_STAGE(PG8_SA(1, 0), a3, voffA);
            PG8_WAIT_V(8); PG8_WAIT_L(0); PG8_BAR; PG8_MMA(1, 0, At, B0); PG8_MMA(1, 1, At, B1); PG8_BAR; PG8_SCHED;
            } else {
            PG8_LDB(B0, 0, 0); PG8_SCHED; PG8_LDA(At, 0, 0); PG8_STAGE(PG8_SA(1, 1), a1 + hstepA, voffA);
            PG8_WAIT_L(8); PG8_BAR; PG8_WAIT_L(0); PG8_MMA(0, 0, At, B0); PG8_BAR; PG8_SCHED;
            PG8_LDB(B1, 0, 1); PG8_STAGE(PG8_SB(0, 0), b2, voffB);
            PG8_BAR; PG8_WAIT_L(0); PG8_MMA(0, 1, At, B1); PG8_BAR;
            PG8_LDA(At, 0, 1); PG8_STAGE(PG8_SA(0, 0), a2, voffA);
            PG8_BAR; PG8_WAIT_L(0); PG8_MMA(1, 0, At, B0); PG8_BAR; PG8_SCHED;
            PG8_STAGE(PG8_SB(0, 1), b2 + hstepB, voffB);
            PG8_WAIT_V(6); PG8_BAR; PG8_MMA(1, 1, At, B1); PG8_BAR;
            PG8_LDB(B0, 1, 0); PG8_SCHED; PG8_LDA(At, 1, 0); PG8_STAGE(PG8_SA(0, 1), a2 + hstepA, voffA);
            PG8_WAIT_L(8); PG8_BAR; PG8_WAIT_L(0); PG8_MMA(0, 0, At, B0); PG8_BAR; PG8_SCHED;
            PG8_LDB(B1, 1, 1); PG8_STAGE(PG8_SB(1, 0), b3, voffB);
            PG8_BAR; PG8_WAIT_L(0); PG8_MMA(0, 1, At, B1); PG8_BAR;
            PG8_LDA(At, 1, 1); PG8_STAGE(PG8_SA(1, 0), a3, voffA);
            PG8_BAR; PG8_WAIT_L(0); PG8_MMA(1, 0, At, B0); PG8_BAR; PG8_SCHED;
            PG8_STAGE(PG8_SB(1, 1), b3 + hstepB, voffB);
            PG8_WAIT_V(6); PG8_BAR; PG8_MMA(1, 1, At, B1); PG8_BAR;
            }
        }
        if constexpr (ALIGN_EPI) { if (wr == 0) PG8_BAR; }
        E(acc, cur, wr, wc, fr, fq);
        if (!has_next) break;
#pragma unroll
        for (int a = 0; a < 2; ++a)
#pragma unroll
            for (int b = 0; b < 2; ++b)
#pragma unroll
                for (int m = 0; m < 4; ++m)
#pragma unroll
                    for (int n = 0; n < 2; ++n) acc[a][b][m][n] = (f32x4){0.f, 0.f, 0.f, 0.f};
        cur = nxt; cA = nA; cB = nB; ++ui;
        if constexpr (ALIGN_EPI) { if (wr == 1) PG8_BAR; }
    }
    PG8_WAIT_V(0);
    if constexpr (!ALIGN_EPI) { if (wr == 0) PG8_BAR; }
    PG8_BAR;
#undef PG8_SA
#undef PG8_SB
#undef PG8_STAGE
#undef PG8_LDA
#undef PG8_LDB
#undef PG8_MMA
#undef PG8_WAIT_V
#undef PG8_WAIT_L
#undef PG8_BAR
#undef PG8_SCHED
}
}
namespace att {
#define ATT_LAS __attribute__((address_space(3)))
#define ATT_GAS __attribute__((address_space(1)))
typedef unsigned short bf16;
using bf16x8 = __attribute__((ext_vector_type(8))) short;
using s16x4  = __attribute__((ext_vector_type(4))) short;
using f32x16 = __attribute__((ext_vector_type(16))) float;
using f32x4  = __attribute__((ext_vector_type(4))) float;
using u32x4  = __attribute__((ext_vector_type(4))) unsigned;
constexpr int NW = 8, QBLK = 32, KVBLK = 64, DV = 128;
constexpr float LOG2E = 1.4426950408889634f;
#define SBAR() __builtin_amdgcn_sched_barrier(0)
__device__ __forceinline__ int crow(int r, int hi) { return (r & 3) + 8 * (r >> 2) + 4 * hi; }
__device__ __forceinline__ unsigned cvtpk(float lo, float hi) { unsigned r; asm volatile("v_cvt_pk_bf16_f32 %0, %1, %2" : "=v"(r) : "v"(lo), "v"(hi)); return r; }
__device__ __forceinline__ float bf2f(short s) { return __uint_as_float(((unsigned)(unsigned short)s) << 16); }

__device__ __forceinline__ void partialSM(f32x16& p0, f32x16& p1, float& m_reg, float& mn, float& alpha, const float C, const float THRS) {
  float pmax = p0[0];
#pragma unroll
  for (int r = 1; r < 16; ++r) pmax = fmaxf(pmax, p0[r]);
#pragma unroll
  for (int r = 0; r < 16; ++r) pmax = fmaxf(pmax, p1[r]);
  { auto rr = __builtin_amdgcn_permlane32_swap(__float_as_uint(pmax), __float_as_uint(pmax), false, false);
    pmax = fmaxf(__uint_as_float(rr[0]), __uint_as_float(rr[1])); }
  if (__builtin_expect(__all(pmax - m_reg <= THRS), 1)) { mn = m_reg; alpha = 1.f; }
  else { mn = fmaxf(m_reg, pmax); alpha = __builtin_amdgcn_exp2f((m_reg - mn) * C); m_reg = mn; }
  float mnC = -mn * C;
#pragma unroll
  for (int r = 0; r < 16; ++r) p0[r] = fmaf(p0[r], C, mnC);
#pragma unroll
  for (int r = 0; r < 16; ++r) p1[r] = fmaf(p1[r], C, mnC);
#pragma unroll
  for (int r = 0; r < 16; ++r) p0[r] = __builtin_amdgcn_exp2f(p0[r]);
}
#define ATT_PK4(P, BASE, OUT) do { unsigned a0 = cvtpk(P[BASE + 0], P[BASE + 1]), a1 = cvtpk(P[BASE + 2], P[BASE + 3]);   \
    unsigned b0 = cvtpk(P[BASE + 4], P[BASE + 5]), b1 = cvtpk(P[BASE + 6], P[BASE + 7]);                              \
    auto r0 = __builtin_amdgcn_permlane32_swap(a0, b0, false, false); auto r1 = __builtin_amdgcn_permlane32_swap(a1, b1, false, false); \
    u32x4 w = {r0[0], r1[0], r0[1], r1[1]}; OUT = *reinterpret_cast<bf16x8*>(&w); } while (0)
__device__ __forceinline__ void finishSM(f32x16& p0, f32x16& p1, float alpha, float& l_reg, bf16x8& pa0, bf16x8& pa1, bf16x8& pa2, bf16x8& pa3) {
#pragma unroll
  for (int r = 0; r < 16; ++r) p1[r] = __builtin_amdgcn_exp2f(p1[r]);
  float ps = 0;
#pragma unroll
  for (int r = 0; r < 16; ++r) ps += p0[r];
#pragma unroll
  for (int r = 0; r < 16; ++r) ps += p1[r];
  { auto rr = __builtin_amdgcn_permlane32_swap(__float_as_uint(ps), __float_as_uint(ps), false, false);
    ps = __uint_as_float(rr[0]) + __uint_as_float(rr[1]); }
  l_reg = l_reg * alpha + ps;
  ATT_PK4(p0, 0, pa0); ATT_PK4(p0, 8, pa1); ATT_PK4(p1, 0, pa2); ATT_PK4(p1, 8, pa3);
}
template <int RB> __device__ __forceinline__ int kswz(int row, int colB) { return row * RB + (colB ^ ((row & 7) << 4)); }
template <int DQK> __device__ __forceinline__ void qkt(f32x16& p0, f32x16& p1, const ATT_LAS char* Ks, const bf16x8 (&qr)[DQK / 16], int r32, int hi) {
  p0 = f32x16{}; p1 = f32x16{};
#pragma unroll
  for (int d0 = 0; d0 < DQK / 16; ++d0) { const int cb = (d0 * 16 + hi * 8) * 2;
    bf16x8 b0 = *reinterpret_cast<const ATT_LAS bf16x8*>(Ks + kswz<DQK * 2>(r32, cb));
    bf16x8 b1 = *reinterpret_cast<const ATT_LAS bf16x8*>(Ks + kswz<DQK * 2>(32 + r32, cb));
    p0 = __builtin_amdgcn_mfma_f32_32x32x16_bf16(b0, qr[d0], p0, 0, 0, 0);
    p1 = __builtin_amdgcn_mfma_f32_32x32x16_bf16(b1, qr[d0], p1, 0, 0, 0); }
}
__device__ __forceinline__ int v_st(int k, int c) { const int kk = (k & ~0xC) | ((k & 4) << 1) | ((k & 8) >> 1); return ((kk >> 3) * 4 + (c >> 5)) * 512 + ((kk & 7) * 32 + (c & 31)) * 2; }
__device__ __forceinline__ int v_rd_base(int lane) { return ((lane & 3) << 3) | (((lane >> 2) & 3) << 6) | (((lane >> 4) & 1) << 5) | (((lane >> 5) & 1) << 8); }
constexpr int v_rd_off(int d0, int ks, int half) { return d0 * 512 + ks * 4096 + half * 2048; }
template <int OFF> __device__ __forceinline__ s16x4 tr_read(int vb) {
  s16x4 r; asm volatile("ds_read_b64_tr_b16 %0, %1 offset:%2" : "=&v"(r) : "v"(vb), "i"(OFF) : "memory"); return r;
}
#define ATT_PK(L, H) (bf16x8){L[0], L[1], L[2], L[3], H[0], H[1], H[2], H[3]}
template <int D0> __device__ __forceinline__ void pv_one(f32x16& od, int vb, bf16x8 pa0, bf16x8 pa1, bf16x8 pa2, bf16x8 pa3) {
  const s16x4 l0 = tr_read<v_rd_off(D0, 0, 0)>(vb), h0 = tr_read<v_rd_off(D0, 0, 1)>(vb), l1 = tr_read<v_rd_off(D0, 1, 0)>(vb), h1 = tr_read<v_rd_off(D0, 1, 1)>(vb);
  const s16x4 l2 = tr_read<v_rd_off(D0, 2, 0)>(vb), h2 = tr_read<v_rd_off(D0, 2, 1)>(vb), l3 = tr_read<v_rd_off(D0, 3, 0)>(vb), h3 = tr_read<v_rd_off(D0, 3, 1)>(vb);
  asm volatile("s_waitcnt lgkmcnt(0)" ::: "memory"); SBAR();
  od = __builtin_amdgcn_mfma_f32_32x32x16_bf16(pa0, ATT_PK(l0, h0), od, 0, 0, 0);
  od = __builtin_amdgcn_mfma_f32_32x32x16_bf16(pa1, ATT_PK(l1, h1), od, 0, 0, 0);
  od = __builtin_amdgcn_mfma_f32_32x32x16_bf16(pa2, ATT_PK(l2, h2), od, 0, 0, 0);
  od = __builtin_amdgcn_mfma_f32_32x32x16_bf16(pa3, ATT_PK(l3, h3), od, 0, 0, 0);
}
__device__ __forceinline__ void pv_d0(f32x16 (&o)[4], int vb, bf16x8 pa0, bf16x8 pa1, bf16x8 pa2, bf16x8 pa3) {
  pv_one<0>(o[0], vb, pa0, pa1, pa2, pa3); pv_one<1>(o[1], vb, pa0, pa1, pa2, pa3); pv_one<2>(o[2], vb, pa0, pa1, pa2, pa3); pv_one<3>(o[3], vb, pa0, pa1, pa2, pa3);
}
template <int D0> __device__ __forceinline__ void pv32_one(f32x16& od, int vb, bf16x8 pa0, bf16x8 pa1) {
  const s16x4 l0 = tr_read<v_rd_off(D0, 0, 0)>(vb), h0 = tr_read<v_rd_off(D0, 0, 1)>(vb), l1 = tr_read<v_rd_off(D0, 1, 0)>(vb), h1 = tr_read<v_rd_off(D0, 1, 1)>(vb);
  asm volatile("s_waitcnt lgkmcnt(0)" ::: "memory"); SBAR();
  od = __builtin_amdgcn_mfma_f32_32x32x16_bf16(pa0, ATT_PK(l0, h0), od, 0, 0, 0);
  od = __builtin_amdgcn_mfma_f32_32x32x16_bf16(pa1, ATT_PK(l1, h1), od, 0, 0, 0);
}

template <int DQK, int LDQ, int LDK, int LDO, int SDEPTH>
__device__ __forceinline__ void attn_dense_body(const bf16* __restrict__ Qb, const bf16* __restrict__ Kh, const bf16* __restrict__ Kr, const bf16* __restrict__ Vh,
                                                const float* __restrict__ cs_rows, float* __restrict__ Ob, int seq, const float scale, ATT_LAS char* lds) {
  constexpr int SHM_V = KVBLK * DV * 2, SHM_K = KVBLK * DQK * 2, RB = DQK * 2, NQ = DQK / 16;
  constexpr bool ROPE = (DQK == 192);
  const float C = scale * LOG2E, THRS = 8.f / scale;
  int tid_ = threadIdx.x; asm volatile("" : "+v"(tid_));
  const int tid = tid_, wid = tid >> 6, lane = tid & 63, r32 = lane & 31, hi = lane >> 5;
  ATT_LAS char* V_lds = lds; ATT_LAS char* K_lds = lds + 2 * SHM_V;
  ATT_LAS float* ws = (ATT_LAS float*)(lds + 2 * SHM_V + 2 * SHM_K) + wid * 64; ATT_LAS float* li_l = ws; ATT_LAS float* al_l = ws + 32;
  float m_reg = -1e30f, l_reg = 0; f32x16 o[4] = {}; bf16x8 qr[NQ];
  const bf16* Qw = Qb + (long)(wid * QBLK + r32) * LDQ + hi * 8;
#pragma unroll
  for (int d0 = 0; d0 < NQ; ++d0) qr[d0] = *(const ATT_GAS bf16x8*)(Qw + d0 * 16);
  if constexpr (ROPE) {
    const float* cs = cs_rows + (long)(wid * QBLK + r32) * 64 + hi * 8;
#pragma unroll
    for (int g = 0; g < 2; ++g) {
      const f32x4 c0 = *(const ATT_GAS f32x4*)(cs + g * 16), c1 = *(const ATT_GAS f32x4*)(cs + g * 16 + 4);
      const f32x4 s0 = *(const ATT_GAS f32x4*)(cs + 32 + g * 16), s1 = *(const ATT_GAS f32x4*)(cs + 32 + g * 16 + 4);
      float y1[8], y2[8];
#pragma unroll
      for (int j = 0; j < 8; ++j) { const float co = j < 4 ? c0[j & 3] : c1[j & 3], si = j < 4 ? s0[j & 3] : s1[j & 3];
        const float x1 = bf2f(qr[8 + g][j]), x2 = bf2f(qr[10 + g][j]); y1[j] = x1 * co - x2 * si; y2[j] = x1 * si + x2 * co; }
      u32x4 w1 = {cvtpk(y1[0], y1[1]), cvtpk(y1[2], y1[3]), cvtpk(y1[4], y1[5]), cvtpk(y1[6], y1[7])};
      u32x4 w2 = {cvtpk(y2[0], y2[1]), cvtpk(y2[2], y2[3]), cvtpk(y2[4], y2[5]), cvtpk(y2[6], y2[7])};
      qr[8 + g] = *reinterpret_cast<bf16x8*>(&w1); qr[10 + g] = *reinterpret_cast<bf16x8*>(&w2);
    }
  }
  const int sr = tid >> 4, sc = (tid & 15) * 8, vst0 = v_st(sr, sc), vst1 = v_st(32 + sr, sc);
  const int rr = tid >> 3, rc = (tid & 7) * 8;
  const int vb0 = (int)(unsigned)(uintptr_t)V_lds + v_rd_base(lane);
  struct Slot { bf16x8 vs0, vs1, ks0, ks1, kr; } sr_[SDEPTH];
#define SLOAD(i, k0) do { sr_[i].vs0 = *(const ATT_GAS bf16x8*)(&Vh[(long)((k0) + sr) * LDK + sc]); sr_[i].vs1 = *(const ATT_GAS bf16x8*)(&Vh[(long)((k0) + 32 + sr) * LDK + sc]); \
    sr_[i].ks0 = *(const ATT_GAS bf16x8*)(&Kh[(long)((k0) + sr) * LDK + sc]); sr_[i].ks1 = *(const ATT_GAS bf16x8*)(&Kh[(long)((k0) + 32 + sr) * LDK + sc]); \
    if constexpr (ROPE) sr_[i].kr = *(const ATT_GAS bf16x8*)(&Kr[(long)((k0) + rr) * 64 + rc]); } while (0)
#define SWRITE(b, i) do { *reinterpret_cast<ATT_LAS bf16x8*>(V_lds + (b) * SHM_V + vst0) = sr_[i].vs0;          \
    *reinterpret_cast<ATT_LAS bf16x8*>(V_lds + (b) * SHM_V + vst1) = sr_[i].vs1; const int kc = sc * 2;               \
    *reinterpret_cast<ATT_LAS bf16x8*>(K_lds + (b) * SHM_K + kswz<RB>(sr, kc)) = sr_[i].ks0;                       \
    *reinterpret_cast<ATT_LAS bf16x8*>(K_lds + (b) * SHM_K + kswz<RB>(32 + sr, kc)) = sr_[i].ks1;                  \
    if constexpr (ROPE) *reinterpret_cast<ATT_LAS bf16x8*>(K_lds + (b) * SHM_K + kswz<RB>(rr, 256 + rc * 2)) = sr_[i].kr; } while (0)
#define SWAIT() do { if constexpr (SDEPTH == 2) { if constexpr (ROPE) asm volatile("s_waitcnt vmcnt(5)" ::: "memory"); else asm volatile("s_waitcnt vmcnt(4)" ::: "memory"); } else asm volatile("s_waitcnt vmcnt(0)" ::: "memory"); } while (0)
#define RESC(a) do { if (__any((a) < 1.f)) { if (hi == 0) al_l[r32] = (a); asm volatile("s_waitcnt lgkmcnt(0)" ::: "memory"); \
    _Pragma("unroll") for (int d = 0; d < 4; ++d) _Pragma("unroll") for (int r = 0; r < 16; ++r) o[d][r] *= al_l[crow(r, hi)]; } } while (0)
  f32x16 pA0, pA1, pB0, pB1; float mnA, mnB, alA, alB; bf16x8 pa0, pa1, pa2, pa3; const int NT = seq / KVBLK;
  constexpr int SE = 0, SO = SDEPTH - 1;
  SLOAD(SE, 0); asm volatile("s_waitcnt vmcnt(0)" ::: "memory"); SWRITE(0, SE); __syncthreads();
  qkt<DQK>(pA0, pA1, K_lds, qr, r32, hi); partialSM(pA0, pA1, m_reg, mnA, alA, C, THRS);
  SLOAD(SO, KVBLK); if constexpr (SDEPTH == 2) { if (2 < NT) SLOAD(SE, 2 * KVBLK); }
  SWAIT(); SWRITE(1, SO); __syncthreads();
  for (int j = 1; j + 1 < NT; j += 2) {
    SBAR(); qkt<DQK>(pB0, pB1, K_lds + SHM_K, qr, r32, hi);
    finishSM(pA0, pA1, alA, l_reg, pa0, pa1, pa2, pa3); SBAR();
    SLOAD(SO, (j + SDEPTH) * KVBLK); SBAR();
    pv_d0(o, vb0, pa0, pa1, pa2, pa3); partialSM(pB0, pB1, m_reg, mnB, alB, C, THRS);
    __syncthreads(); SWAIT(); SWRITE(0, SE);
    RESC(alB); __syncthreads();
    SBAR(); qkt<DQK>(pA0, pA1, K_lds, qr, r32, hi);
    finishSM(pB0, pB1, alB, l_reg, pa0, pa1, pa2, pa3); SBAR();
    if (SDEPTH == 1 || j + 3 < NT) SLOAD(SE, (j + 1 + SDEPTH) * KVBLK); SBAR();
    pv_d0(o, vb0 + SHM_V, pa0, pa1, pa2, pa3); partialSM(pA0, pA1, m_reg, mnA, alA, C, THRS);
    __syncthreads(); SWAIT(); SWRITE(1, SO);
    RESC(alA); __syncthreads();
  }
  SBAR(); qkt<DQK>(pB0, pB1, K_lds + SHM_K, qr, r32, hi);
  finishSM(pA0, pA1, alA, l_reg, pa0, pa1, pa2, pa3); SBAR();
  pv_d0(o, vb0, pa0, pa1, pa2, pa3); partialSM(pB0, pB1, m_reg, mnB, alB, C, THRS);
  __syncthreads(); RESC(alB);
  finishSM(pB0, pB1, alB, l_reg, pa0, pa1, pa2, pa3); SBAR();
  pv_d0(o, vb0 + SHM_V, pa0, pa1, pa2, pa3);
  if (hi == 0) li_l[r32] = l_reg; asm volatile("s_waitcnt lgkmcnt(0)" ::: "memory");
  float rli[16];
#pragma unroll
  for (int r = 0; r < 16; ++r) rli[r] = __builtin_amdgcn_rcpf(li_l[crow(r, hi)]);
  float* Ow = Ob + (long)(wid * QBLK) * LDO;
#pragma unroll
  for (int r = 0; r < 16; ++r) { const int orow = crow(r, hi);
#pragma unroll
    for (int d0 = 0; d0 < 4; ++d0) Ow[(long)orow * LDO + d0 * 32 + r32] = o[d0][r] * rli[r]; }
  __syncthreads();
#undef SLOAD
#undef SWRITE
#undef SWAIT
#undef RESC
}

template <int DQK, int LDQ, int LDK, int LDO>
__device__ __forceinline__ void attn_simple_body(const bf16* __restrict__ Qb, const bf16* __restrict__ Kh, const bf16* __restrict__ Kr, const bf16* __restrict__ Vh,
                                                 const float* __restrict__ cs_rows, float* __restrict__ Ob, int seq, const float scale, ATT_LAS char* lds) {
  constexpr int SHM_V = KVBLK * DV * 2, SHM_K = KVBLK * DQK * 2, RB = DQK * 2, NQ = DQK / 16;
  constexpr bool ROPE = (DQK == 192);
  const float C = scale * LOG2E, THRS = 8.f / scale;
  int tid_ = threadIdx.x; asm volatile("" : "+v"(tid_));
  const int tid = tid_, wid = tid >> 6, lane = tid & 63, r32 = lane & 31, hi = lane >> 5;
  ATT_LAS char* V_lds = lds; ATT_LAS char* K_lds = lds + 2 * SHM_V;
  ATT_LAS float* ws = (ATT_LAS float*)(lds + 2 * SHM_V + 2 * SHM_K) + wid * 64; ATT_LAS float* li_l = ws; ATT_LAS float* al_l = ws + 32;
  float m_reg = -1e30f, l_reg = 0; f32x16 o[4] = {}; bf16x8 qr[NQ];
  const bf16* Qw = Qb + (long)(wid * QBLK + r32) * LDQ + hi * 8;
#pragma unroll
  for (int d0 = 0; d0 < NQ; ++d0) qr[d0] = *(const ATT_GAS bf16x8*)(Qw + d0 * 16);
  if constexpr (ROPE) {
    const float* cs = cs_rows + (long)(wid * QBLK + r32) * 64 + hi * 8;
#pragma unroll
    for (int g = 0; g < 2; ++g) {
      const f32x4 c0 = *(const ATT_GAS f32x4*)(cs + g * 16), c1 = *(const ATT_GAS f32x4*)(cs + g * 16 + 4);
      const f32x4 s0 = *(const ATT_GAS f32x4*)(cs + 32 + g * 16), s1 = *(const ATT_GAS f32x4*)(cs + 32 + g * 16 + 4);
      float y1[8], y2[8];
#pragma unroll
      for (int j = 0; j < 8; ++j) { const float co = j < 4 ? c0[j & 3] : c1[j & 3], si = j < 4 ? s0[j & 3] : s1[j & 3];
        const float x1 = bf2f(qr[8 + g][j]), x2 = bf2f(qr[10 + g][j]); y1[j] = x1 * co - x2 * si; y2[j] = x1 * si + x2 * co; }
      u32x4 w1 = {cvtpk(y1[0], y1[1]), cvtpk(y1[2], y1[3]), cvtpk(y1[4], y1[5]), cvtpk(y1[6], y1[7])};
      u32x4 w2 = {cvtpk(y2[0], y2[1]), cvtpk(y2[2], y2[3]), cvtpk(y2[4], y2[5]), cvtpk(y2[6], y2[7])};
      qr[8 + g] = *reinterpret_cast<bf16x8*>(&w1); qr[10 + g] = *reinterpret_cast<bf16x8*>(&w2);
    }
  }
  const int sr = tid >> 4, sc = (tid & 15) * 8, vst0 = v_st(sr, sc), vst1 = v_st(32 + sr, sc);
  const int rr = tid >> 3, rc = (tid & 7) * 8;
  const int vb0 = (int)(unsigned)(uintptr_t)V_lds + v_rd_base(lane);
  bf16x8 vs0, vs1, ks0, ks1, kr;
#define SLOAD(k0) do { vs0 = *(const ATT_GAS bf16x8*)(&Vh[(long)((k0) + sr) * LDK + sc]); vs1 = *(const ATT_GAS bf16x8*)(&Vh[(long)((k0) + 32 + sr) * LDK + sc]); \
    ks0 = *(const ATT_GAS bf16x8*)(&Kh[(long)((k0) + sr) * LDK + sc]); ks1 = *(const ATT_GAS bf16x8*)(&Kh[(long)((k0) + 32 + sr) * LDK + sc]); \
    if constexpr (ROPE) kr = *(const ATT_GAS bf16x8*)(&Kr[(long)((k0) + rr) * 64 + rc]); } while (0)
#define SWRITE(b) do { *reinterpret_cast<ATT_LAS bf16x8*>(V_lds + (b) * SHM_V + vst0) = vs0;          \
    *reinterpret_cast<ATT_LAS bf16x8*>(V_lds + (b) * SHM_V + vst1) = vs1; const int kc = sc * 2;               \
    *reinterpret_cast<ATT_LAS bf16x8*>(K_lds + (b) * SHM_K + kswz<RB>(sr, kc)) = ks0;                       \
    *reinterpret_cast<ATT_LAS bf16x8*>(K_lds + (b) * SHM_K + kswz<RB>(32 + sr, kc)) = ks1;                  \
    if constexpr (ROPE) *reinterpret_cast<ATT_LAS bf16x8*>(K_lds + (b) * SHM_K + kswz<RB>(rr, 256 + rc * 2)) = kr; } while (0)
#define RESC(a) do { if (__any((a) < 1.f)) { if (hi == 0) al_l[r32] = (a); asm volatile("s_waitcnt lgkmcnt(0)" ::: "memory"); \
    _Pragma("unroll") for (int d = 0; d < 4; ++d) _Pragma("unroll") for (int r = 0; r < 16; ++r) o[d][r] *= al_l[crow(r, hi)]; } } while (0)
  const int NT = seq / KVBLK;
  SLOAD(0); SWRITE(0); __syncthreads();
  for (int j = 0; j < NT; ++j) {
    const int b = j & 1;
    if (j + 1 < NT) SLOAD((j + 1) * KVBLK);
    f32x16 p0, p1; float mn, al; bf16x8 pa0, pa1, pa2, pa3;
    SBAR(); qkt<DQK>(p0, p1, K_lds + b * SHM_K, qr, r32, hi);
    partialSM(p0, p1, m_reg, mn, al, C, THRS); RESC(al);
    finishSM(p0, p1, al, l_reg, pa0, pa1, pa2, pa3); SBAR();
    pv_d0(o, vb0 + b * SHM_V, pa0, pa1, pa2, pa3);
    if (j + 1 < NT) SWRITE(b ^ 1);
    __syncthreads();
  }
  if (hi == 0) li_l[r32] = l_reg; asm volatile("s_waitcnt lgkmcnt(0)" ::: "memory");
  float rli[16];
#pragma unroll
  for (int r = 0; r < 16; ++r) rli[r] = __builtin_amdgcn_rcpf(li_l[crow(r, hi)]);
  float* Ow = Ob + (long)(wid * QBLK) * LDO;
#pragma unroll
  for (int r = 0; r < 16; ++r) { const int orow = crow(r, hi);
#pragma unroll
    for (int d0 = 0; d0 < 4; ++d0) Ow[(long)orow * LDO + d0 * 32 + r32] = o[d0][r] * rli[r]; }
  __syncthreads();
#undef SLOAD
#undef SWRITE
#undef RESC
}

template <int LDP>
__device__ __forceinline__ void dil_wave_unit(const bf16* __restrict__ P, int qc, int kc, int vc, int d, int r, int t0, int nT,
                                              float* __restrict__ O, int oc, float* __restrict__ ST  ,
                                              ATT_LAS char* vlds  , const ATT_LAS float* bias2, const float C, int lane_) {
  int lane = lane_; asm volatile("" : "+v"(lane));
  const int r32 = lane & 31, hi = lane >> 5;
  bf16x8 qr[8];
  { const bf16* qp = P + (long)(r + d * (t0 + r32)) * LDP + qc + hi * 8;
#pragma unroll
    for (int d0 = 0; d0 < 8; ++d0) qr[d0] = *(const ATT_GAS bf16x8*)(qp + d0 * 16); }
  f32x16 p[5];
#pragma unroll
  for (int kb = 0; kb < 5; ++kb) {
    int kt = t0 - 64 + kb * 32 + r32; kt = kt < 0 ? 0 : (kt > nT - 1 ? nT - 1 : kt);
    const bf16* kp = P + (long)(r + d * kt) * LDP + kc + hi * 8;
    bf16x8 kf[8];
#pragma unroll
    for (int d0 = 0; d0 < 8; ++d0) kf[d0] = *(const ATT_GAS bf16x8*)(kp + d0 * 16);
    p[kb] = f32x16{};
#pragma unroll
    for (int d0 = 0; d0 < 8; ++d0) p[kb] = __builtin_amdgcn_mfma_f32_32x32x16_bf16(kf[d0], qr[d0], p[kb], 0, 0, 0);
  }
  float m = -1e30f;
#pragma unroll
  for (int kb = 0; kb < 5; ++kb)
#pragma unroll
    for (int rg = 0; rg < 16; ++rg) {
      const int jj = kb * 32 + crow(rg, hi) - r32;
      const int kt = t0 - 64 + kb * 32 + crow(rg, hi);
      const bool valid = (jj >= 0) && (jj <= 128) && (kt >= 0) && (kt < nT);
      const int bi = jj < 0 ? 0 : (jj > 128 ? 128 : jj);
      const float s = fmaf(p[kb][rg], C, bias2[bi]);
      p[kb][rg] = valid ? s : -1e30f; m = fmaxf(m, p[kb][rg]);
    }
  { auto rr = __builtin_amdgcn_permlane32_swap(__float_as_uint(m), __float_as_uint(m), false, false); m = fmaxf(__uint_as_float(rr[0]), __uint_as_float(rr[1])); }
  float Z = 0.f;
#pragma unroll
  for (int kb = 0; kb < 5; ++kb)
#pragma unroll
    for (int rg = 0; rg < 16; ++rg) { p[kb][rg] = __builtin_amdgcn_exp2f(p[kb][rg] - m); Z += p[kb][rg]; }
  { auto rr = __builtin_amdgcn_permlane32_swap(__float_as_uint(Z), __float_as_uint(Z), false, false); Z = __uint_as_float(rr[0]) + __uint_as_float(rr[1]); }
  f32x16 o[4] = {};
  const int vb = (int)(unsigned)(uintptr_t)vlds + v_rd_base(lane);
#pragma unroll
  for (int kb = 0; kb < 5; ++kb) {
    bf16x8 vv[8];
#pragma unroll
    for (int i = 0; i < 8; ++i) { const int id = lane + 64 * i, row = id >> 4, c = (id & 15) * 8;
      int kt = t0 - 64 + kb * 32 + row; kt = kt < 0 ? 0 : (kt > nT - 1 ? nT - 1 : kt);
      vv[i] = *(const ATT_GAS bf16x8*)(P + (long)(r + d * kt) * LDP + vc + c); }
#pragma unroll
    for (int i = 0; i < 8; ++i) { const int id = lane + 64 * i, row = id >> 4, c = (id & 15) * 8;
      *reinterpret_cast<ATT_LAS bf16x8*>(vlds + v_st(row, c)) = vv[i]; }
    bf16x8 pa0, pa1; ATT_PK4(p[kb], 0, pa0); ATT_PK4(p[kb], 8, pa1);
    asm volatile("s_waitcnt lgkmcnt(0)" ::: "memory"); SBAR();
    pv32_one<0>(o[0], vb, pa0, pa1); pv32_one<1>(o[1], vb, pa0, pa1); pv32_one<2>(o[2], vb, pa0, pa1); pv32_one<3>(o[3], vb, pa0, pa1);
    SBAR();
  }
#pragma unroll
  for (int rg = 0; rg < 16; ++rg) { const long row = r + d * (t0 + crow(rg, hi));
#pragma unroll
    for (int d0 = 0; d0 < 4; ++d0) O[row * 768 + oc + d0 * 32 + r32] = o[d0][rg]; }
  if (hi == 0) { const long row = r + d * (t0 + r32); typedef float f32x2_ __attribute__((ext_vector_type(2))); *(ATT_GAS f32x2_*)(ST + row * 12) = (f32x2_){m, Z}; }
}
}
constexpr int S = 8192, D = 2048, NMEM = 256;
constexpr int DIN = 3392, DINP = 3584;
constexpr int PC_DIL = 768, PC_MEM = 3072;
constexpr int QR = 384, KVR = 128, AQ = 512;
constexpr int NUP = 2816;
constexpr int UC_KV = 1280;
constexpr int DFF = 5632, DFE = 7168, NE = 8;
constexpr int MP = 18432;
constexpr float EPS = 1e-6f;
constexpr int NWAVES = 8;

constexpr size_t al256(size_t x) { return (x + 255) / 256 * 256; }
constexpr size_t WS_CTL = 0, CTL_ZERO_BYTES = 1u << 20;
constexpr size_t WS_WIN = WS_CTL + CTL_ZERO_BYTES;
constexpr size_t WS_WUP = WS_WIN + al256((size_t)2 * DINP * D * 2);
constexpr size_t WS_WMEM = WS_WUP + al256((size_t)2 * NUP * AQ * 2);
constexpr size_t WS_WOUT = WS_WMEM + al256((size_t)2 * 1024 * D * 2);
constexpr size_t WS_WGU = WS_WOUT + al256((size_t)2 * D * D * 2);
constexpr size_t WS_WDN = WS_WGU + al256((size_t)2 * DFF * D * 2);
constexpr size_t WS_MGU = WS_WDN + al256((size_t)D * DFF * 2);
constexpr size_t WS_MDN = WS_MGU + al256((size_t)NE * 2 * DFE * D * 2);
constexpr size_t WS_XN = WS_MDN + al256((size_t)NE * D * DFE * 2);
constexpr size_t WS_MEMN = WS_XN + al256((size_t)S * D * 2);
constexpr size_t WS_MEMKV = WS_MEMN + al256((size_t)2 * NMEM * D * 2);
constexpr size_t WS_PROJ = WS_MEMKV + al256((size_t)2 * NMEM * 1024 * 2);
constexpr size_t WS_AQKV = WS_PROJ + al256((size_t)S * DINP * 2);
constexpr size_t WS_KROPE = WS_AQKV + al256((size_t)S * AQ * 2);
constexpr size_t WS_ROPECS = WS_KROPE + al256((size_t)S * 64 * 2);
constexpr size_t WS_QKVM = WS_ROPECS + al256((size_t)S * 64 * 4);
constexpr size_t WS_YPRE = WS_QKVM + al256((size_t)S * NUP * 2);
constexpr size_t WS_DILO = WS_YPRE + al256((size_t)S * D * 4);
constexpr size_t WS_DILS = WS_DILO + al256((size_t)3 * S * 768 * 4);
constexpr size_t WS_Y = WS_DILS + al256((size_t)3 * S * 12 * 4);
constexpr size_t WS_XA = WS_Y + al256((size_t)S * D * 2);
constexpr size_t WS_ROUTE = WS_XA + al256((size_t)S * D * 4);
constexpr size_t WS_XP = WS_ROUTE + al256((size_t)S * 32);
constexpr size_t WS_OUTP = WS_XP + al256((size_t)MP * D * 2);
constexpr size_t WS_ACTP = WS_OUTP + al256((size_t)MP * D * 2);
constexpr size_t WS_END = WS_ACTP + al256((size_t)MP * DFE * 2);
static_assert(WS_END <= 1879048192ull, "workspace map exceeds 4 x the largest input");
constexpr int CW_BAR = 4096;
constexpr int CW_QUEUE = 8192;
constexpr int CW_CNT = 8192 + 256;
constexpr int CW_TILEE = 8192 + 512;
constexpr int RING_BYTES = 131072;
constexpr int LDSCTL_OFF = RING_BYTES, MISC_OFF = LDSCTL_OFF + 320;
constexpr int BIAS_OFF = 114688;
constexpr int LDS_BYTES = 147456;

#define GAS __attribute__((address_space(1)))
#define LAS __attribute__((address_space(3)))
typedef unsigned short bf16;
typedef unsigned v4u __attribute__((ext_vector_type(4)));
typedef unsigned v2u __attribute__((ext_vector_type(2)));
typedef float f32x4 __attribute__((ext_vector_type(4)));
typedef short bf16x8 __attribute__((ext_vector_type(8)));
typedef GAS unsigned gu32;
#define RLX_AGENT __ATOMIC_RELAXED, __HIP_MEMORY_SCOPE_AGENT
#define LDS_WAIT() asm volatile("s_waitcnt lgkmcnt(0)" ::: "memory")
#define VM_WAIT() asm volatile("s_waitcnt vmcnt(0)" ::: "memory")
__device__ __forceinline__ unsigned f2bf(float f) { unsigned u = __builtin_bit_cast(unsigned, f); return (u + 0x7fffu + ((u >> 16) & 1u)) >> 16; }
__device__ __forceinline__ unsigned pk2(float lo, float hi) { return f2bf(lo) | (f2bf(hi) << 16); }
__device__ __forceinline__ float bflo(unsigned w) { return __uint_as_float(w << 16); }
__device__ __forceinline__ float bfhi(unsigned w) { return __uint_as_float(w & 0xffff0000u); }

#define XB_TMO      128
#define XB_XCNT(j)  (256  + 64 * (j))
#define XB_XSUB(j)  (1280 + 64 * (j))
#define XB_XGEN(j)  (2304 + 64 * (j))
#define XB_TOP      3328
#define XB_TOPGEN   3392
#define XCD_BAR_WORDS 3456
#define XB_SPIN_CAP (1u << 18)
__device__ __forceinline__ unsigned xb_ld(unsigned* p)              { return __hip_atomic_load(p, __ATOMIC_RELAXED, __HIP_MEMORY_SCOPE_AGENT); }
__device__ __forceinline__ unsigned xb_add(unsigned* p, unsigned v) { return __hip_atomic_fetch_add(p, v, __ATOMIC_RELAXED, __HIP_MEMORY_SCOPE_AGENT); }
__device__ __forceinline__ unsigned xb_xcc_id() { return (unsigned)__builtin_amdgcn_s_getreg((3 << 11) | 20) & 0xFu; }
#define XB_SPIN(cond, bar) do { unsigned _sp = 0; while (cond) { __builtin_amdgcn_s_sleep(1); \
    if ((++_sp & 255u) == 0u) { if (xb_ld(&(bar)[XB_TMO])) break; if (_sp > XB_SPIN_CAP) { atomicAdd(&(bar)[XB_TMO], 1u); break; } } } } while (0)
struct XcdBarrier { unsigned* bar; unsigned x; volatile LAS unsigned* st; };
__device__ __forceinline__ XcdBarrier xcd_barrier_post(unsigned* bar, volatile LAS unsigned* st) {
    XcdBarrier b; b.bar = bar; b.x = xb_xcc_id(); b.st = st;
    if (threadIdx.x == 0) (void)xb_add(&bar[XB_XCNT(b.x)], 1u);
    return b;
}
__device__ __forceinline__ void xcd_barrier_complete(unsigned* bar, unsigned x, unsigned& nloc, unsigned& nx) {
    const unsigned G = gridDim.x * gridDim.y * gridDim.z;
    unsigned sum, cnt, mine, sp = 0u;
    for (;;) {
        sum = 0u; cnt = 0u; mine = 0u;
#pragma unroll
        for (unsigned j = 0; j < 16; ++j) { const unsigned c = xb_ld(&bar[XB_XCNT(j)]); sum += c; cnt += (c > 0u) ? 1u : 0u; mine = (j == x) ? c : mine; }
        if (sum == G) break;
        __builtin_amdgcn_s_sleep(1);
        if ((++sp & 255u) == 0u) { if (xb_ld(&bar[XB_TMO])) break; if (sp > XB_SPIN_CAP) { atomicAdd(&bar[XB_TMO], 1u); break; } }
    }
    nloc = mine > 0u ? mine : 1u; nx = cnt > 0u ? cnt : 1u;
}
__device__ __forceinline__ void xcd_barrier(const XcdBarrier& b) {
    asm volatile("s_waitcnt vmcnt(0)" ::: "memory");
    __syncthreads();
    if (threadIdx.x == 0) {
        unsigned* bar = b.bar;
        __builtin_amdgcn_s_waitcnt(0);
        unsigned nloc = b.st[0], nx = b.st[1];
        if (nloc == 0u) { xcd_barrier_complete(bar, b.x, nloc, nx); b.st[0] = nloc; b.st[1] = nx; }
        const unsigned old = xb_add(&bar[XB_XSUB(b.x)], 1u);
        const unsigned gen = old / nloc;
        if (old + 1u == (gen + 1u) * nloc) {
            __builtin_amdgcn_fence(__ATOMIC_RELEASE, "agent");
            asm volatile("s_waitcnt vmcnt(0)" ::: "memory");
            const unsigned og = xb_add(&bar[XB_TOP], 1u);
            const unsigned tg = og / nx;
            if (og + 1u == (tg + 1u) * nx) xb_add(&bar[XB_TOPGEN], 1u);
            else XB_SPIN(xb_ld(&bar[XB_TOPGEN]) == tg, bar);
            __builtin_amdgcn_fence(__ATOMIC_ACQUIRE, "agent");
            xb_add(&bar[XB_XGEN(b.x)], 1u);
            asm volatile("s_waitcnt vmcnt(0)" ::: "memory");
        } else {
            XB_SPIN(xb_ld(&bar[XB_XGEN(b.x)]) == gen, bar);
            __builtin_amdgcn_fence(__ATOMIC_ACQUIRE, "agent");
            asm volatile("s_waitcnt vmcnt(0)" ::: "memory");
        }
    }
    __syncthreads();
}

struct Args {
    const float* in[23]; float* out; unsigned char* ws;
    float invf[32];
    int ph_lo, ph_hi, li, pad;
};
struct Frame {
    LAS unsigned char* lds;
    volatile LAS unsigned* MISC;
    gu32* ctl;
    int tid, lane, wave, G, gw, NGW;
    unsigned char* ws;
};
__device__ __forceinline__ float wave_sum(float v) {
#pragma unroll
    for (int o = 1; o < 64; o <<= 1) v += __shfl_xor(v, o);
    return v;
}
__device__ __forceinline__ float wave_max(float v) {
#pragma unroll
    for (int o = 1; o < 64; o <<= 1) v = fmaxf(v, __shfl_xor(v, o));
    return v;
}

__device__ __forceinline__ void cvt_item(const float* __restrict__ W, int N, int k0, int n0, bf16* __restrict__ dst, int ldd, int drow0, int kdst0, LAS float* scr, int lane) {
    f32x4 v[8];
    const int lr = lane >> 3, lc = (lane & 7) * 4;
#pragma unroll
    for (int i = 0; i < 8; ++i) v[i] = *(const GAS f32x4*)(W + (size_t)(k0 + i * 8 + lr) * N + n0 + lc);
#pragma unroll
    for (int i = 0; i < 8; ++i) { LAS float* s = scr + (i * 8 + lr) * 33 + lc; s[0] = v[i][0]; s[1] = v[i][1]; s[2] = v[i][2]; s[3] = v[i][3]; }
    LDS_WAIT(); asm volatile("" ::: "memory");
    const int c = lane & 7;
#pragma unroll
    for (int j = 0; j < 4; ++j) { const int n = (lane >> 3) + 8 * j; const LAS float* s = scr + (8 * c) * 33 + n;
        v4u o; o.x = pk2(s[0 * 33], s[1 * 33]); o.y = pk2(s[2 * 33], s[3 * 33]); o.z = pk2(s[4 * 33], s[5 * 33]); o.w = pk2(s[6 * 33], s[7 * 33]);
        *(GAS v4u*)(dst + (size_t)(drow0 + n) * ldd + kdst0 + k0 + 8 * c) = o; }
    LDS_WAIT(); asm volatile("" ::: "memory");
}
__device__ __forceinline__ void cvt_job(Frame& F, const float* W, int K, int N, bf16* dst, int ldd, int kdst0, int mode, int roff, LAS float* scr) {
    const int nnb = N / 32, nitems = (K / 64) * nnb;
    for (int it = F.gw; it < nitems; it += F.NGW) {
        const int kb = it / nnb, nb = it % nnb, n0 = nb * 32;
        int drow0;
        if (mode == 0) drow0 = n0 + roff; else if (mode == 1) drow0 = (n0 >> 7) * 256 + (n0 & 127); else if (mode == 2) drow0 = (n0 >> 7) * 256 + 128 + (n0 & 127); else drow0 = n0 < 576 ? n0 : n0 + 192;
        cvt_item(W, N, kb * 64, n0, dst, ldd, drow0, kdst0, scr, F.lane);
    }
}
__device__ __forceinline__ void rms_row_to_bf16(const float* xrow, const float* g, bf16* orow, int lane) {
    const GAS f32x4* xr = (const GAS f32x4*)xrow + lane; const GAS f32x4* gr = (const GAS f32x4*)g + lane;
    f32x4 v[8]; float s = 0.f;
#pragma unroll
    for (int j = 0; j < 8; ++j) { v[j] = xr[64 * j]; s += (v[j].x * v[j].x + v[j].y * v[j].y) + (v[j].z * v[j].z + v[j].w * v[j].w); }
    const float rstd = 1.f / sqrtf(wave_sum(s) * (1.f / D) + EPS);
    GAS v2u* o8 = (GAS v2u*)orow + lane;
#pragma unroll
    for (int j = 0; j < 8; ++j) { const f32x4 gg = gr[64 * j]; v2u w; w.x = pk2(v[j].x * rstd * gg.x, v[j].y * rstd * gg.y); w.y = pk2(v[j].z * rstd * gg.z, v[j].w * rstd * gg.w); o8[64 * j] = w; }
}
__device__ __forceinline__ void sincos_f64(float ang, float& c, float& s) {
    const double a = (double)ang, twopi = 6.283185307179586476925286766559, inv2pi = 0.15915494309189533576888376337251;
    const double q = __builtin_rint(a * inv2pi); const double r = a - q * twopi;
    const double r2 = r * r; double ss = 1.0, cc = 1.0;
#pragma unroll
    for (int k = 14; k >= 1; --k) { ss = 1.0 - r2 * (1.0 / (double)((2 * k) * (2 * k + 1))) * ss; cc = 1.0 - r2 * (1.0 / (double)((2 * k - 1) * (2 * k))) * cc; }
    s = (float)(r * ss); c = (float)cc;
}
__device__ const unsigned char DIL_BUCKET[3][129] = {
 {11,11,11,11,11,11,11,11,11,11,11,11,11,11,11,10,10,10,10,10,10,10,10,10,10,10,10,10,10,10,10,10,10,10,10,10,10,10,9,9,9,9,9,9,9,9,9,9,9,9,8,8,8,8,8,8,8,7,6,5,4,3,2,1,0,17,18,19,20,21,22,23,24,24,24,24,24,24,24,25,25,25,25,25,25,25,25,25,25,25,25,26,26,26,26,26,26,26,26,26,26,26,26,26,26,26,26,26,26,26,26,26,26,26,27,27,27,27,27,27,27,27,27,27,27,27,27,27,27},
 {13,13,13,13,13,13,13,13,13,13,13,13,13,13,13,13,13,13,13,13,13,13,13,12,12,12,12,12,12,12,12,12,12,12,12,12,12,12,12,12,12,12,11,11,11,11,11,11,11,11,11,11,10,10,10,10,10,10,9,9,9,8,8,4,0,20,24,24,25,25,25,26,26,26,26,26,26,27,27,27,27,27,27,27,27,27,27,28,28,28,28,28,28,28,28,28,28,28,28,28,28,28,28,28,28,28,29,29,29,29,29,29,29,29,29,29,29,29,29,29,29,29,29,29,29,29,29,29,29},
 {15,15,15,15,15,15,15,15,15,15,15,15,15,15,15,15,15,15,15,15,15,15,15,15,15,15,15,15,15,15,14,14,14,14,14,14,14,14,14,14,14,14,14,14,14,13,13,13,13,13,13,13,13,13,12,12,12,12,12,11,11,10,10,9,0,25,26,26,27,27,28,28,28,28,28,29,29,29,29,29,29,29,29,29,30,30,30,30,30,30,30,30,30,30,30,30,30,30,30,31,31,31,31,31,31,31,31,31,31,31,31,31,31,31,31,31,31,31,31,31,31,31,31,31,31,31,31,31,31}};

typedef float f32x2 __attribute__((ext_vector_type(2)));
#ifndef PH_MASK
#define PH_MASK 0xFFFFu
#endif
#ifndef ATT_EN
#define ATT_EN 7
#endif
#define PEN(k) ((PH_MASK >> (k)) & 1u)
constexpr int PH_PER_LAYER = 11, N_PHASES = 1 + 2 * PH_PER_LAYER;
#ifndef MK_N_LAUNCHES
#define MK_N_LAUNCHES 1
#endif
constexpr int N_LAUNCHES = MK_N_LAUNCHES;

__global__ void __launch_bounds__(NWAVES * 64, 2) mk_fwd(Args args) {
    extern __shared__ __attribute__((aligned(16))) unsigned char lds[];
    Frame F;
    F.lds = (LAS unsigned char*)lds;
    F.MISC = (volatile LAS unsigned*)(F.lds + MISC_OFF);
    F.tid = threadIdx.x; F.lane = F.tid & 63; F.wave = __builtin_amdgcn_readfirstlane(F.tid >> 6);
    F.G = gridDim.x; F.gw = blockIdx.x * NWAVES + F.wave; F.NGW = F.G * NWAVES;
    F.ws = args.ws; F.ctl = (gu32*)(args.ws + WS_CTL);
    unsigned char* ws = args.ws;
    for (int u = F.tid; u < (LDS_BYTES - LDSCTL_OFF) / 4; u += NWAVES * 64) ((LAS unsigned*)(F.lds + LDSCTL_OFF))[u] = 0u;
    __syncthreads();
    XcdBarrier bar; bar.bar = (unsigned*)(F.ctl + CW_BAR); bar.x = 0; bar.st = nullptr;
    if (N_LAUNCHES == 1) bar = xcd_barrier_post((unsigned*)(F.ctl + CW_BAR), F.MISC + 8);
#define GRID_BAR() do { if (N_LAUNCHES == 1) xcd_barrier(bar); } while (0)
    const int lo = args.ph_lo, hi = args.ph_hi;
#define IN(k) (lo <= (k) && (k) < hi)
#define BOTH(k) (IN(k) && IN((k) + 1))

#define x_in (args.in[0])
#define WIN ((bf16*)(ws + WS_WIN))
#define WUP ((bf16*)(ws + WS_WUP))
#define WMEM ((bf16*)(ws + WS_WMEM))
#define WOUT ((bf16*)(ws + WS_WOUT))
#define WGU ((bf16*)(ws + WS_WGU))
#define WDN ((bf16*)(ws + WS_WDN))
#define MGU ((bf16*)(ws + WS_MGU))
#define MDN ((bf16*)(ws + WS_MDN))
#define XN ((bf16*)(ws + WS_XN))
#define MEMN ((bf16*)(ws + WS_MEMN))
#define MEMKV ((bf16*)(ws + WS_MEMKV))
#define PROJ ((bf16*)(ws + WS_PROJ))
#define AQKV ((bf16*)(ws + WS_AQKV))
#define KROPE ((bf16*)(ws + WS_KROPE))
#define ROPECS ((float*)(ws + WS_ROPECS))
#define QKVM ((bf16*)(ws + WS_QKVM))
#define YPRE ((float*)(ws + WS_YPRE))
#define DILO ((float*)(ws + WS_DILO))
#define DILS ((float*)(ws + WS_DILS))
#define Y ((bf16*)(ws + WS_Y))
#define XA ((float*)(ws + WS_XA))
#define ROUTE ((unsigned*)(ws + WS_ROUTE))
#define XP ((bf16*)(ws + WS_XP))
#define OUTP ((bf16*)(ws + WS_OUTP))
#define ACTP ((bf16*)(ws + WS_ACTP))
#define ACT ((bf16*)(ws + WS_ACTP))
#define PHASE_BEGIN() do { int t_ = threadIdx.x; asm volatile("" : "+v"(t_)); F.tid = t_; F.lane = t_ & 63; } while (0)

    if (PEN(0) && IN(0)) { PHASE_BEGIN();
        LAS float* scr = (LAS float*)(F.lds + F.wave * 16384);
        for (int l = 0; l < 2; ++l) {
            cvt_job(F, args.in[5] + (size_t)l * D * DIN, D, DIN, WIN + (size_t)l * DINP * D, D, 0, 3, 0, scr);
            cvt_job(F, args.in[7] + (size_t)l * QR * 1152, QR, 1152, WUP + (size_t)l * NUP * AQ, AQ, 0, 0, 0, scr);
            cvt_job(F, args.in[9] + (size_t)l * KVR * 1536, KVR, 1536, WUP + (size_t)l * NUP * AQ, AQ, QR, 0, UC_KV, scr);
            cvt_job(F, args.in[11] + (size_t)l * D * 1024, D, 1024, WMEM + (size_t)l * 1024 * D, D, 0, 0, 0, scr);
            cvt_job(F, args.in[13] + (size_t)l * D * D, D, D, WOUT + (size_t)l * D * D, D, 0, 0, 0, scr);
        }
        cvt_job(F, args.in[15], D, DFF, WGU, D, 0, 1, 0, scr);
        cvt_job(F, args.in[16], D, DFF, WGU, D, 0, 2, 0, scr);
        cvt_job(F, args.in[17], DFF, D, WDN, DFF, 0, 0, 0, scr);
        for (int e = 0; e < NE; ++e) {
            cvt_job(F, args.in[19] + (size_t)e * D * DFE, D, DFE, MGU + (size_t)e * 2 * DFE * D, D, 0, 1, 0, scr);
            cvt_job(F, args.in[20] + (size_t)e * D * DFE, D, DFE, MGU + (size_t)e * 2 * DFE * D, D, 0, 2, 0, scr);
            cvt_job(F, args.in[21] + (size_t)e * DFE * D, DFE, D, MDN + (size_t)e * D * DFE, DFE, 0, 0, 0, scr);
        }
        { const int* pos = (const int*)args.in[2];
          for (int idx = blockIdx.x * (NWAVES * 64) + F.tid; idx < S * 32; idx += F.G * NWAVES * 64) { const int row = idx >> 5, i = idx & 31;
              const float ang = (float)pos[row] * args.invf[i]; float c, s; sincos_f64(ang, c, s); ROPECS[row * 64 + i] = c; ROPECS[row * 64 + 32 + i] = s; } }
        for (int m = F.gw; m < 2 * NMEM; m += F.NGW) { const int l = m >> 8, r = m & 255; rms_row_to_bf16(args.in[1] + (size_t)r * D, args.in[10] + (size_t)l * D, MEMN + (size_t)m * D, F.lane); }
        for (int m = F.gw; m < S; m += F.NGW) rms_row_to_bf16(x_in + (size_t)m * D, args.in[4], XN + (size_t)m * D, F.lane);
        if (BOTH(0)) GRID_BAR();
    }

    for (int l = 0; l < 2; ++l) {
        const int pb = 1 + l * PH_PER_LAYER;
        if (PEN(1) && IN(pb + 0)) { PHASE_BEGIN();
            { pg8::Gemm g{XN, WIN + (size_t)l * DINP * D, D, D, D}; pg8::InProjOrder So; So.so.init(S, DINP, F.G, (int)blockIdx.x); So.nextra = (l == 0) ? 8 : 0; So.A2 = MEMN; So.B2 = WMEM;
              pg8::EpiBf16Sel E{PROJ, DINP, MEMKV, 1024};
              pg8::gemm_phase<pg8::EpiBf16Sel, pg8::InProjOrder, true, true>(F.lds, g, So, E); }
            if (BOTH(pb + 0)) GRID_BAR();
        }
        if (PEN(2) && IN(pb + 1)) { PHASE_BEGIN();
            const float* gq = args.in[6] + l * QR; const float* gkv = args.in[8] + l * KVR;
            for (int m = F.gw; m < S; m += F.NGW) {
                const v4u w = *(const GAS v4u*)(PROJ + (size_t)m * DINP + F.lane * 8);
                float v[8] = {bflo(w.x), bfhi(w.x), bflo(w.y), bfhi(w.y), bflo(w.z), bfhi(w.z), bflo(w.w), bfhi(w.w)};
                float sq = 0.f;
#pragma unroll
                for (int j = 0; j < 8; ++j) sq += v[j] * v[j];
                const float sq_q = wave_sum(F.lane < 48 ? sq : 0.f), sq_kv = wave_sum(F.lane >= 48 ? sq : 0.f);
                const float rstd = F.lane < 48 ? 1.f / sqrtf(sq_q * (1.f / QR) + EPS) : 1.f / sqrtf(sq_kv * (1.f / KVR) + EPS);
                const float* gp = F.lane < 48 ? gq + F.lane * 8 : gkv + (F.lane - 48) * 8;
                const f32x4 g0 = *(const GAS f32x4*)gp, g1 = *(const GAS f32x4*)(gp + 4);
                v4u o; o.x = pk2(v[0] * rstd * g0.x, v[1] * rstd * g0.y); o.y = pk2(v[2] * rstd * g0.z, v[3] * rstd * g0.w);
                o.z = pk2(v[4] * rstd * g1.x, v[5] * rstd * g1.y); o.w = pk2(v[6] * rstd * g1.z, v[7] * rstd * g1.w);
                *(GAS v4u*)(AQKV + (size_t)m * AQ + F.lane * 8) = o;
                const int c = F.lane & 7;
                const v4u kw = *(const GAS v4u*)(PROJ + (size_t)m * DINP + 512 + c * 8);
                float kv[8] = {bflo(kw.x), bfhi(kw.x), bflo(kw.y), bfhi(kw.y), bflo(kw.z), bfhi(kw.z), bflo(kw.w), bfhi(kw.w)};
                float ko[8];
                const float* cs = ROPECS + (size_t)m * 64 + (c & 3) * 8;
#pragma unroll
                for (int j = 0; j < 8; ++j) { const float other = __shfl_xor(kv[j], 4); const float co = cs[j], si = cs[32 + j];
                    ko[j] = (c < 4) ? (kv[j] * co - other * si) : (other * si + kv[j] * co); }
                if (F.lane < 8) { v4u ow; ow.x = pk2(ko[0], ko[1]); ow.y = pk2(ko[2], ko[3]); ow.z = pk2(ko[4], ko[5]); ow.w = pk2(ko[6], ko[7]); *(GAS v4u*)(KROPE + (size_t)m * 64 + c * 8) = ow; }
            }
            if (BOTH(pb + 1)) GRID_BAR();
        }
        if (PEN(3) && IN(pb + 2)) { PHASE_BEGIN();
            pg8::Gemm g{AQKV, WUP + (size_t)l * NUP * AQ, AQ, AQ, AQ}; pg8::StaticOrder So; So.init(S, NUP, F.G, (int)blockIdx.x);
            pg8::EpiBf16 E{QKVM, NUP};
            pg8::gemm_phase<pg8::EpiBf16, pg8::StaticOrder, true, true>(F.lds, g, So, E);
            if (BOTH(pb + 2)) GRID_BAR();
        }
        if (PEN(4) && IN(pb + 3)) { PHASE_BEGIN();
            LAS float* BIAS = (LAS float*)(F.lds + BIAS_OFF);
            for (int i = F.tid; i < 3 * 6 * 129; i += NWAVES * 64) { const int b = i / (6 * 129), rem = i % (6 * 129), h = rem / 129, j = rem % 129;
                BIAS[(b * 6 + h) * 132 + j] = args.in[3][DIL_BUCKET[b][j] * 6 + h] * att::LOG2E; }
            __syncthreads();
            gu32* qhead = F.ctl + CW_QUEUE + 64 * l;
            constexpr int NU_MLA = 6 * 32, NU_MEM = 4 * 32, NU_DIL = 3 * 6 * 32, NU = NU_MLA + NU_MEM + NU_DIL;
#define QPULL(u) do { if (F.tid == 0) F.MISC[16] = __hip_atomic_fetch_add(qhead, 1u, RLX_AGENT); __syncthreads(); u = (int)F.MISC[16]; __syncthreads(); } while (0)
            int u; QPULL(u);
            if (ATT_EN & 1) while (u < NU_MLA) {
                const int h = u >> 5, qb = u & 31;
                att::attn_simple_body<192, NUP, NUP, D>(QKVM + (size_t)qb * 256 * NUP + h * 192, QKVM + UC_KV + h * 256, KROPE, QKVM + UC_KV + h * 256 + 128,
                                                        ROPECS + (size_t)qb * 256 * 64, YPRE + (size_t)qb * 256 * D + h * 128, S, 0.07216878364870322f, (LAS char*)F.lds);
                QPULL(u);
            }
            if (ATT_EN & 2) while (u < NU_MLA + NU_MEM) {
                const int v = u - NU_MLA, h = v >> 5, qb = v & 31;
                const bf16* kv = MEMKV + (size_t)l * NMEM * 1024;
                att::attn_dense_body<128, DINP, 1024, D, 1>(PROJ + (size_t)qb * 256 * DINP + PC_MEM + h * 128, kv + h * 128, nullptr, kv + 512 + h * 128,
                                                            nullptr, YPRE + (size_t)qb * 256 * D + 1536 + h * 128, NMEM, 0.08838834764831845f, (LAS char*)F.lds);
                QPULL(u);
            }
            if (ATT_EN & 4) while (u < NU) {
                const int w = (u - NU_MLA - NU_MEM) * 8 + F.wave;
                const int b = w / 1536, h = (w % 1536) >> 8, tile = w & 255;
                const int d = b == 0 ? 1 : (b == 1 ? 4 : 16), nT = S / d, tpr = nT / 32;
                const int r = tile / tpr, t0 = (tile % tpr) * 32;
                att::dil_wave_unit<DINP>(PROJ, PC_DIL + h * 128, PC_DIL + 768 + h * 128, PC_DIL + 1536 + h * 128, d, r, t0, nT,
                                         DILO + (size_t)b * S * 768, h * 128, DILS + (size_t)b * S * 12 + h * 2,
                                         (LAS char*)F.lds + F.wave * 8192, BIAS + (b * 6 + h) * 132, 0.08838834764831845f * att::LOG2E, F.lane);
                QPULL(u);
            }
#undef QPULL
            if (BOTH(pb + 3)) GRID_BAR();
        }
        if (PEN(5) && IN(pb + 4)) { PHASE_BEGIN();
            const float* gn = args.in[12] + (size_t)l * D;
            for (int m = F.gw; m < S; m += F.NGW) {
                const float* yr = YPRE + (size_t)m * D;
                f32x4 a[3]; float sa = 0.f;
#pragma unroll
                for (int j = 0; j < 3; ++j) { a[j] = *(const GAS f32x4*)(yr + (F.lane + 64 * j) * 4); sa += (a[j].x * a[j].x + a[j].y * a[j].y) + (a[j].z * a[j].z + a[j].w * a[j].w); }
                f32x4 c[2]; float sc = 0.f;
#pragma unroll
                for (int j = 0; j < 2; ++j) { c[j] = *(const GAS f32x4*)(yr + 1536 + (F.lane + 64 * j) * 4); sc += (c[j].x * c[j].x + c[j].y * c[j].y) + (c[j].z * c[j].z + c[j].w * c[j].w); }
                f32x4 bq[3]; float sb = 0.f;
#pragma unroll
                for (int j = 0; j < 3; ++j) { const int col = (F.lane + 64 * j) * 4, h = col >> 7;
                    float mm[3], zz[3];
#pragma unroll
                    for (int b = 0; b < 3; ++b) { const f32x2 st = *(const GAS f32x2*)(DILS + ((size_t)b * S + m) * 12 + h * 2); mm[b] = st.x; zz[b] = st.y; }
                    const float M = fmaxf(mm[0], fmaxf(mm[1], mm[2]));
                    float wgt[3], den = 0.f;
#pragma unroll
                    for (int b = 0; b < 3; ++b) { wgt[b] = __builtin_amdgcn_exp2f(mm[b] - M); den += wgt[b] * zz[b]; }
                    const float inv = 1.f / den; f32x4 acc = {0.f, 0.f, 0.f, 0.f};
#pragma unroll
                    for (int b = 0; b < 3; ++b) { const f32x4 ob = *(const GAS f32x4*)(DILO + ((size_t)b * S + m) * 768 + col); acc += ob * (wgt[b] * inv); }
                    bq[j] = acc; sb += (acc.x * acc.x + acc.y * acc.y) + (acc.z * acc.z + acc.w * acc.w); }
                const float ra = 1.f / sqrtf(wave_sum(sa) * (1.f / 768.f) + EPS), rb = 1.f / sqrtf(wave_sum(sb) * (1.f / 768.f) + EPS), rc = 1.f / sqrtf(wave_sum(sc) * (1.f / 512.f) + EPS);
                bf16* yo = Y + (size_t)m * D;
#pragma unroll
                for (int j = 0; j < 3; ++j) { const int col = (F.lane + 64 * j) * 4; const f32x4 g = *(const GAS f32x4*)(gn + col);
                    v2u w; w.x = pk2(a[j].x * ra * g.x, a[j].y * ra * g.y); w.y = pk2(a[j].z * ra * g.z, a[j].w * ra * g.w); *(GAS v2u*)(yo + col) = w; }
#pragma unroll
                for (int j = 0; j < 3; ++j) { const int col = (F.lane + 64 * j) * 4; const f32x4 g = *(const GAS f32x4*)(gn + 768 + col);
                    v2u w; w.x = pk2(bq[j].x * rb * g.x, bq[j].y * rb * g.y); w.y = pk2(bq[j].z * rb * g.z, bq[j].w * rb * g.w); *(GAS v2u*)(yo + 768 + col) = w; }
#pragma unroll
                for (int j = 0; j < 2; ++j) { const int col = (F.lane + 64 * j) * 4; const f32x4 g = *(const GAS f32x4*)(gn + 1536 + col);
                    v2u w; w.x = pk2(c[j].x * rc * g.x, c[j].y * rc * g.y); w.y = pk2(c[j].z * rc * g.z, c[j].w * rc * g.w); *(GAS v2u*)(yo + 1536 + col) = w; }
            }
            if (BOTH(pb + 4)) GRID_BAR();
        }
        if (PEN(6) && IN(pb + 5)) { PHASE_BEGIN();
            pg8::Gemm g{Y, WOUT + (size_t)l * D * D, D, D, D}; pg8::StaticOrder So; So.init(S, D, F.G, (int)blockIdx.x);
            pg8::EpiResF32 E{l == 0 ? x_in : XA, XA, D};
            pg8::gemm_phase<pg8::EpiResF32, pg8::StaticOrder, true, true>(F.lds, g, So, E);
            if (BOTH(pb + 5)) GRID_BAR();
        }
        if (PEN(7) && IN(pb + 6)) { PHASE_BEGIN();
            const float* gf = args.in[14] + (size_t)l * D;
            if (l == 0) { for (int m = F.gw; m < S; m += F.NGW) rms_row_to_bf16(XA + (size_t)m * D, gf, XN + (size_t)m * D, F.lane); }
            else {
                const float* Wr = args.in[18];
                for (int m = F.gw; m < S; m += F.NGW) {
                    const GAS f32x4* xr = (const GAS f32x4*)(XA + (size_t)m * D) + F.lane; const GAS f32x4* gr = (const GAS f32x4*)gf + F.lane;
                    f32x4 v[8]; float s = 0.f;
#pragma unroll
                    for (int j = 0; j < 8; ++j) { v[j] = xr[64 * j]; s += (v[j].x * v[j].x + v[j].y * v[j].y) + (v[j].z * v[j].z + v[j].w * v[j].w); }
                    const float rstd = 1.f / sqrtf(wave_sum(s) * (1.f / D) + EPS);
                    float lg[8] = {0.f, 0.f, 0.f, 0.f, 0.f, 0.f, 0.f, 0.f};
                    GAS v2u* o8 = (GAS v2u*)(XN + (size_t)m * D) + F.lane;
#pragma unroll
                    for (int j = 0; j < 8; ++j) { const f32x4 gg = gr[64 * j]; const f32x4 hh = {v[j].x * rstd * gg.x, v[j].y * rstd * gg.y, v[j].z * rstd * gg.z, v[j].w * rstd * gg.w};
                        v2u w; w.x = pk2(hh.x, hh.y); w.y = pk2(hh.z, hh.w); o8[64 * j] = w;
                        const float* wr = Wr + (size_t)((F.lane + 64 * j) * 4) * NE;
#pragma unroll
                        for (int q = 0; q < 4; ++q) { const f32x4 w0 = *(const GAS f32x4*)(wr + q * NE), w1 = *(const GAS f32x4*)(wr + q * NE + 4); const float hv = hh[q];
                            lg[0] += hv * w0.x; lg[1] += hv * w0.y; lg[2] += hv * w0.z; lg[3] += hv * w0.w; lg[4] += hv * w1.x; lg[5] += hv * w1.y; lg[6] += hv * w1.z; lg[7] += hv * w1.w; } }
#pragma unroll
                    for (int e = 0; e < NE; ++e) lg[e] = wave_sum(lg[e]);
                    int e1 = 0; float v1 = lg[0];
#pragma unroll
                    for (int e = 1; e < NE; ++e) if (lg[e] > v1) { v1 = lg[e]; e1 = e; }
                    int e2 = -1; float v2 = -3.0e38f;
#pragma unroll
                    for (int e = 0; e < NE; ++e) if (e != e1 && lg[e] > v2) { v2 = lg[e]; e2 = e; }
                    const float g1 = 1.f / (1.f + __expf(v2 - v1)), g2 = 1.f - g1;
                    if (F.lane == 0) { const unsigned s1 = __hip_atomic_fetch_add(F.ctl + CW_CNT + e1, 1u, RLX_AGENT), s2 = __hip_atomic_fetch_add(F.ctl + CW_CNT + e2, 1u, RLX_AGENT);
                        v4u r0 = {(unsigned)e1, (unsigned)e2, s1, s2}; v4u r1 = {__float_as_uint(g1), __float_as_uint(g2), 0u, 0u};
                        *(GAS v4u*)(ROUTE + (size_t)m * 8) = r0; *(GAS v4u*)(ROUTE + (size_t)m * 8 + 4) = r1; }
                }
            }
            if (BOTH(pb + 6)) GRID_BAR();
        }
        if (PEN(8) && IN(pb + 7)) { PHASE_BEGIN();
            if (l == 1) {
                int base[NE]; int tstart = 0;
#pragma unroll
                for (int e = 0; e < NE; ++e) { const int c = (int)__hip_atomic_load(F.ctl + CW_CNT + e, RLX_AGENT); base[e] = tstart * 256; const int nt = (c + 255) >> 8;
                    if (blockIdx.x == 0 && F.tid == 0) { for (int t = 0; t < nt; ++t) F.ctl[CW_TILEE + 1 + tstart + t] = (unsigned)e; }
                    tstart += nt; }
                if (blockIdx.x == 0 && F.tid == 0) F.ctl[CW_TILEE] = (unsigned)tstart;
                for (int m = F.gw; m < S; m += F.NGW) {
                    const v4u r0 = *(const GAS v4u*)(ROUTE + (size_t)m * 8);
                    int p1 = (int)r0.z, p2 = (int)r0.w;
#pragma unroll
                    for (int e = 0; e < NE; ++e) { if ((int)r0.x == e) p1 += base[e]; if ((int)r0.y == e) p2 += base[e]; }
                    if (F.lane == 0) { ROUTE[(size_t)m * 8 + 6] = (unsigned)p1; ROUTE[(size_t)m * 8 + 7] = (unsigned)p2; }
                    const GAS v4u* src = (const GAS v4u*)(XN + (size_t)m * D) + F.lane; GAS v4u* d1 = (GAS v4u*)(XP + (size_t)p1 * D) + F.lane; GAS v4u* d2 = (GAS v4u*)(XP + (size_t)p2 * D) + F.lane;
#pragma unroll
                    for (int j = 0; j < 4; ++j) { const v4u t = src[64 * j]; d1[64 * j] = t; d2[64 * j] = t; }
                }
            }
            if (BOTH(pb + 7) && l == 1) GRID_BAR();
        }
        if (PEN(9) && IN(pb + 8)) { PHASE_BEGIN();
            if (l == 0) { pg8::Gemm g{XN, WGU, D, D, D}; pg8::StaticOrder So; So.init(S, 2 * DFF, F.G, (int)blockIdx.x);
                pg8::EpiSwiGLU E{ACT, DFF};
                pg8::gemm_phase<pg8::EpiSwiGLU, pg8::StaticOrder, true, true>(F.lds, g, So, E); }
            else { const int ntile = (int)__hip_atomic_load(F.ctl + CW_TILEE, RLX_AGENT);
                pg8::Gemm g{XP, MGU, D, D, D}; pg8::MoeOrder So{F.G, (int)blockIdx.x, 2 * DFE / 256, ntile, 2 * DFE, (const int*)(F.ctl + CW_TILEE + 1)};
                pg8::EpiSwiGLU E{ACTP, DFE};
                pg8::gemm_phase<pg8::EpiSwiGLU, pg8::MoeOrder, true, true>(F.lds, g, So, E); }
            if (BOTH(pb + 8)) GRID_BAR();
        }
        if (PEN(10) && IN(pb + 9)) { PHASE_BEGIN();
            if (l == 0) { pg8::Gemm g{ACT, WDN, DFF, DFF, DFF}; pg8::StaticOrder So; So.init(S, D, F.G, (int)blockIdx.x);
                pg8::EpiResF32 E{XA, XA, D};
                pg8::gemm_phase<pg8::EpiResF32, pg8::StaticOrder, true, true>(F.lds, g, So, E); }
            else { const int ntile = (int)__hip_atomic_load(F.ctl + CW_TILEE, RLX_AGENT);
                pg8::Gemm g{ACTP, MDN, DFE, DFE, DFE}; pg8::MoeOrder So{F.G, (int)blockIdx.x, D / 256, ntile, D, (const int*)(F.ctl + CW_TILEE + 1)};
                pg8::EpiBf16 E{OUTP, D};
                pg8::gemm_phase<pg8::EpiBf16, pg8::MoeOrder, true, true>(F.lds, g, So, E); }
            if (BOTH(pb + 9)) GRID_BAR();
        }
        if (PEN(11) && IN(pb + 10)) { PHASE_BEGIN();
            if (l == 0) { for (int m = F.gw; m < S; m += F.NGW) rms_row_to_bf16(XA + (size_t)m * D, args.in[4] + D, XN + (size_t)m * D, F.lane); }
            else {
                const float* gfin = args.in[22];
                for (int m = F.gw; m < S; m += F.NGW) {
                    const v4u r1 = *(const GAS v4u*)(ROUTE + (size_t)m * 8 + 4);
                    const float g1 = __uint_as_float(r1.x), g2 = __uint_as_float(r1.y); const int p1 = (int)r1.z, p2 = (int)r1.w;
                    const GAS f32x4* xr = (const GAS f32x4*)(XA + (size_t)m * D) + F.lane;
                    const GAS v2u* o1 = (const GAS v2u*)(OUTP + (size_t)p1 * D) + F.lane; const GAS v2u* o2 = (const GAS v2u*)(OUTP + (size_t)p2 * D) + F.lane;
                    f32x4 v[8]; float s = 0.f;
#pragma unroll
                    for (int j = 0; j < 8; ++j) { const f32x4 xv = xr[64 * j]; const v2u a = o1[64 * j], b = o2[64 * j];
                        v[j].x = xv.x + g1 * bflo(a.x) + g2 * bflo(b.x); v[j].y = xv.y + g1 * bfhi(a.x) + g2 * bfhi(b.x);
                        v[j].z = xv.z + g1 * bflo(a.y) + g2 * bflo(b.y); v[j].w = xv.w + g1 * bfhi(a.y) + g2 * bfhi(b.y);
                        s += (v[j].x * v[j].x + v[j].y * v[j].y) + (v[j].z * v[j].z + v[j].w * v[j].w); }
                    const float rstd = 1.f / sqrtf(wave_sum(s) * (1.f / D) + EPS);
                    GAS f32x4* orow = (GAS f32x4*)(args.out + (size_t)m * D) + F.lane; const GAS f32x4* gr = (const GAS f32x4*)gfin + F.lane;
#pragma unroll
                    for (int j = 0; j < 8; ++j) { const f32x4 gg = gr[64 * j]; orow[64 * j] = (f32x4){v[j].x * rstd * gg.x, v[j].y * rstd * gg.y, v[j].z * rstd * gg.z, v[j].w * rstd * gg.w}; }
                }
            }
            if (BOTH(pb + 10) && l == 0) GRID_BAR();
        }
    }
#undef IN
#undef BOTH
#undef GRID_BAR
#undef WIN
#undef WUP
#undef WMEM
#undef WOUT
#undef WGU
#undef WDN
#undef MGU
#undef MDN
#undef XN
#undef MEMN
#undef MEMKV
#undef PROJ
#undef AQKV
#undef KROPE
#undef ROPECS
#undef QKVM
#undef YPRE
#undef DILO
#undef DILS
#undef Y
#undef XA
#undef ROUTE
#undef XP
#undef OUTP
#undef ACTP
#undef ACT
#undef x_in
#undef PHASE_BEGIN
}

extern "C" void kernel_launch(void* const* d_in, const int* in_sizes, int n_in, void* d_out, int out_size, void* d_ws, size_t ws_size, hipStream_t stream) {
    static int grid = 0;
    if (grid == 0) {
        if (n_in != 23 || in_sizes[0] != S * D || out_size != S * D || ws_size < WS_END) { fprintf(stderr, "kernel_launch: shape/workspace mismatch: n_in %d in0 %d out %d ws %zu (need %zu)\n", n_in, n_in > 0 ? in_sizes[0] : -1, out_size, ws_size, (size_t)WS_END); grid = -1; return; }
        int dev = 0, cus = 0, per_cu = 0;
        if (hipGetDevice(&dev) != hipSuccess || hipDeviceGetAttribute(&cus, hipDeviceAttributeMultiprocessorCount, dev) != hipSuccess) { fprintf(stderr, "kernel_launch: device query failed\n"); grid = -1; return; }
        if (hipFuncSetAttribute((const void*)mk_fwd, hipFuncAttributeMaxDynamicSharedMemorySize, LDS_BYTES) != hipSuccess) { fprintf(stderr, "kernel_launch: hipFuncSetAttribute failed\n"); grid = -1; return; }
        if (hipOccupancyMaxActiveBlocksPerMultiprocessor(&per_cu, (const void*)mk_fwd, NWAVES * 64, LDS_BYTES) != hipSuccess || per_cu < 1) { fprintf(stderr, "kernel_launch: occupancy query reports %d workgroups per CU\n", per_cu); }
        (void)hipGetLastError();
        grid = cus;
    }
    if (grid < 0) return;
    (void)hipMemsetAsync((char*)d_ws + WS_CTL, 0, CTL_ZERO_BYTES, stream);
    (void)hipMemsetAsync((char*)d_ws + WS_WIN, 0, (size_t)2 * DINP * D * 2, stream);
    (void)hipMemsetAsync((char*)d_ws + WS_WUP, 0, (size_t)2 * NUP * AQ * 2, stream);
    Args a{};
    for (int i = 0; i < 23; ++i) a.in[i] = (const float*)d_in[i];
    a.out = (float*)d_out; a.ws = (unsigned char*)d_ws;
    for (int i = 0; i < 32; ++i) a.invf[i] = 1.0f / powf(10000.0f, (float)i / 32.0f);
    for (int li = 0; li < N_LAUNCHES; ++li) {
        a.ph_lo = (N_LAUNCHES == 1) ? 0 : li; a.ph_hi = (N_LAUNCHES == 1) ? N_PHASES : li + 1; a.li = li; a.pad = 0;
        hipLaunchKernelGGL(mk_fwd, dim3(grid), dim3(NWAVES * 64), LDS_BYTES, stream, a);
        const hipError_t le = hipPeekAtLastError();
        if (le != hipSuccess) { fprintf(stderr, "kernel_launch: launch %d failed: %s\n", li, hipGetErrorName(le)); break; }
    }
}
```

```cpp
#include <hip/hip_runtime.h>
#include <cstdio>
#include <cstdint>
#include <cmath>
#include <type_traits>
#ifndef MK_N_LAUNCHES
#define MK_N_LAUNCHES 1
#endif
#define REPEAT_PHASE -1
#define FFN_FP8 3
namespace pg8 {
#define PG8_LAS __attribute__((address_space(3)))
typedef unsigned short bf16_t;
typedef short bf16x8 __attribute__((ext_vector_type(8)));
typedef float f32x4 __attribute__((ext_vector_type(4)));
typedef unsigned u32x4 __attribute__((ext_vector_type(4)));
constexpr int BM = 256, BK = 64, HALF = 128, HTB = HALF * BK * 2  , STAGE_BYTES = 8 * HTB, NXCD = 8, WGM = 8;

__host__ __device__ __forceinline__ int lds_byte(int r, int c) { const int st = (r >> 4) * 2 + (c >> 5), rr = r & 15, cc = c & 31, ob = rr * 64 + cc * 2; return st * 1024 + (ob ^ (((ob >> 9) & 1) << 5)); }
__host__ __device__ __forceinline__ void stage_rc(int b, int& R, int& C) { const int st = b / 1024, sb = b % 1024, swz = sb ^ (((sb >> 9) & 1) << 5); R = (st >> 1) * 16 + swz / 64; C = (st & 1) * 32 + (swz % 64) / 2; }
__host__ __device__ __forceinline__ int perm32(int rho) { const int n = rho >> 4, i = rho & 15; return 8 * (i >> 2) + 4 * n + (i & 3); }

struct Unit { int pm, pn; };
struct Gemm { const void* A; const void* Bt; int lda, ldb, nt; };

struct StaticOrder {
    int nM, nN, nwg, G, c;
    __device__ void init(int M, int N, int G_, int c_) { nM = M / BM; nN = N / BM; nwg = nM * nN; G = G_; c = c_; }
    __device__ bool next(int i, Unit& u) const {
        const long L = (long)i * G + c; if (L >= nwg) return false;
        int wgid = (int)L; { const int q = nwg / NXCD, r = nwg % NXCD, xcd = wgid % NXCD, off = wgid / NXCD; wgid = (xcd < r ? xcd * (q + 1) : r * (q + 1) + (xcd - r) * q) + off; }
        const int nig = WGM * nN, gid = wgid / nig, fm = gid * WGM, gsz = (nM - fm) < WGM ? (nM - fm) : WGM;
        u.pm = fm + ((wgid % nig) % gsz); u.pn = (wgid % nig) / gsz; return true;
    }
    __device__ __forceinline__ const char* abase(const Gemm& g, const Unit& u) const { return (const char*)g.A + (size_t)u.pm * BM * g.lda; }
    __device__ __forceinline__ const char* bbase(const Gemm& g, const Unit& u) const { return (const char*)g.Bt + (size_t)u.pn * BM * g.ldb; }
};
struct InProjOrder {
    StaticOrder so; int nextra; const void* A2; const void* B2;
    __device__ bool next(int i, Unit& u) const { if (so.next(i, u)) return true; const long L = (long)i * so.G + so.c - so.nwg; if (L < 0 || L >= nextra) return false; u.pm = 32 + (int)(L >> 2); u.pn = (int)(L & 3); return true; }
    __device__ __forceinline__ const char* abase(const Gemm& g, const Unit& u) const { return u.pm < 32 ? (const char*)g.A + (size_t)u.pm * BM * g.lda : (const char*)A2 + (size_t)(u.pm - 32) * BM * g.lda; }
    __device__ __forceinline__ const char* bbase(const Gemm& g, const Unit& u) const { return u.pm < 32 ? (const char*)g.Bt + (size_t)u.pn * BM * g.ldb : (const char*)B2 + (size_t)((u.pm - 32) * 1024 + u.pn * BM) * g.ldb; }
};
struct MemOrder {
    int G, c;
    __device__ bool next(int i, Unit& u) const { const int L = c - (G - 8); if (i != 0 || L < 0 || L >= 8) return false; u.pm = L >> 2; u.pn = L & 3; return true; }
    __device__ __forceinline__ const char* abase(const Gemm& g, const Unit& u) const { return (const char*)g.A + (size_t)u.pm * BM * g.lda; }
    __device__ __forceinline__ const char* bbase(const Gemm& g, const Unit& u) const { return (const char*)g.Bt + (size_t)(u.pm * 1024 + u.pn * BM) * g.ldb; }
};
struct MoeOrder {
    int G, c, nN, ntile, nexp_rows; const int* tile_e;
    __device__ bool next(int i, Unit& u) const { const long L = (long)i * G + c; if (L >= (long)ntile * nN) return false; u.pm = (int)(L / nN); u.pn = (int)(L % nN); return true; }
    __device__ __forceinline__ const char* abase(const Gemm& g, const Unit& u) const { return (const char*)g.A + (size_t)u.pm * BM * g.lda; }
    __device__ __forceinline__ const char* bbase(const Gemm& g, const Unit& u) const { const int e = __builtin_amdgcn_readfirstlane(tile_e[u.pm]); return (const char*)g.Bt + ((size_t)e * nexp_rows + (size_t)u.pn * BM) * g.ldb; }
};

__device__ __forceinline__ unsigned cvt_pk_bf16(float lo, float hi) { unsigned r; asm volatile("v_cvt_pk_bf16_f32 %0, %1, %2" : "=v"(r) : "v"(lo), "v"(hi)); return r; }

struct EpiBf16 {
    static constexpr bool PERM = true;
    bf16_t* O; int ldc; float sc;
    __device__ __forceinline__ void operator()(const f32x4 (&acc)[2][2][4][2], const Unit& u, int wr, int wc, int fr, int fq) const {
        const int row0 = u.pm * BM + wr * 64 + fr, col0 = u.pn * BM + wc * 32 + 8 * fq;
#pragma unroll
        for (int ai = 0; ai < 2; ++ai)
#pragma unroll
            for (int m = 0; m < 4; ++m) { bf16_t* rowp = O + (size_t)(row0 + ai * HALF + m * 16) * ldc + col0;
#pragma unroll
                for (int bj = 0; bj < 2; ++bj) { const f32x4 v0 = acc[ai][bj][m][0] * sc, v1 = acc[ai][bj][m][1] * sc;
                    u32x4 w; w.x = cvt_pk_bf16(v0[0], v0[1]); w.y = cvt_pk_bf16(v0[2], v0[3]); w.z = cvt_pk_bf16(v1[0], v1[1]); w.w = cvt_pk_bf16(v1[2], v1[3]);
                    *(u32x4*)(rowp + bj * HALF) = w; } }
    }
};
struct EpiBf16Sel {
    static constexpr bool PERM = true;
    bf16_t* O; int ldc; bf16_t* O2; int ldc2;
    __device__ __forceinline__ void operator()(const f32x4 (&acc)[2][2][4][2], const Unit& u, int wr, int wc, int fr, int fq) const {
        const bool ex = u.pm >= 32; bf16_t* base = ex ? O2 : O; const int ld = ex ? ldc2 : ldc;
        const int row0 = (ex ? u.pm - 32 : u.pm) * BM + wr * 64 + fr, col0 = u.pn * BM + wc * 32 + 8 * fq;
#pragma unroll
        for (int ai = 0; ai < 2; ++ai)
#pragma unroll
            for (int m = 0; m < 4; ++m) { bf16_t* rowp = base + (size_t)(row0 + ai * HALF + m * 16) * ld + col0;
#pragma unroll
                for (int bj = 0; bj < 2; ++bj) { const f32x4 v0 = acc[ai][bj][m][0], v1 = acc[ai][bj][m][1];
                    u32x4 w; w.x = cvt_pk_bf16(v0[0], v0[1]); w.y = cvt_pk_bf16(v0[2], v0[3]); w.z = cvt_pk_bf16(v1[0], v1[1]); w.w = cvt_pk_bf16(v1[2], v1[3]);
                    *(u32x4*)(rowp + bj * HALF) = w; } }
    }
};
struct EpiResF32 {
    static constexpr bool PERM = false;
    const float* R; float* C; int ldc; float sc;
    __device__ __forceinline__ void operator()(const f32x4 (&acc)[2][2][4][2], const Unit& u, int wr, int wc, int fr, int fq) const {
        const int row0 = u.pm * BM + wr * 64 + fr, col0 = u.pn * BM + wc * 32 + 4 * fq;
#pragma unroll
        for (int ai = 0; ai < 2; ++ai)
#pragma unroll
            for (int m = 0; m < 4; ++m) { const size_t off = (size_t)(row0 + ai * HALF + m * 16) * ldc + col0;
#pragma unroll
                for (int bj = 0; bj < 2; ++bj)
#pragma unroll
                    for (int n = 0; n < 2; ++n) { const f32x4 r = *(const f32x4*)(R + off + bj * HALF + n * 16); *(f32x4*)(C + off + bj * HALF + n * 16) = r + acc[ai][bj][m][n] * sc; } }
    }
};
__device__ __forceinline__ float silu_mul(float g, float u) { return g * u * __builtin_amdgcn_rcpf(1.0f + __builtin_amdgcn_exp2f(-1.4426950408889634f * g)); }
struct EpiSwiGLU {
    static constexpr bool PERM = true;
    bf16_t* O; int ldc;
    __device__ __forceinline__ void operator()(const f32x4 (&acc)[2][2][4][2], const Unit& u, int wr, int wc, int fr, int fq) const {
        const int row0 = u.pm * BM + wr * 64 + fr, col0 = u.pn * HALF + wc * 32 + 8 * fq;
#pragma unroll
        for (int ai = 0; ai < 2; ++ai)
#pragma unroll
            for (int m = 0; m < 4; ++m) { bf16_t* rowp = O + (size_t)(row0 + ai * HALF + m * 16) * ldc + col0;
                const f32x4 g0 = acc[ai][0][m][0], g1 = acc[ai][0][m][1], u0 = acc[ai][1][m][0], u1 = acc[ai][1][m][1];
                u32x4 w; w.x = cvt_pk_bf16(silu_mul(g0[0], u0[0]), silu_mul(g0[1], u0[1])); w.y = cvt_pk_bf16(silu_mul(g0[2], u0[2]), silu_mul(g0[3], u0[3]));
                w.z = cvt_pk_bf16(silu_mul(g1[0], u1[0]), silu_mul(g1[1], u1[1])); w.w = cvt_pk_bf16(silu_mul(g1[2], u1[2]), silu_mul(g1[3], u1[3]));
                *(u32x4*)rowp = w; }
    }
};

typedef int v8i_t __attribute__((ext_vector_type(8)));
__device__ __forceinline__ v8i_t pg8_cat(bf16x8 lo, bf16x8 hi) { typedef int v4i_t __attribute__((ext_vector_type(4))); const v4i_t a = __builtin_bit_cast(v4i_t, lo), b = __builtin_bit_cast(v4i_t, hi); return (v8i_t){a.x, a.y, a.z, a.w, b.x, b.y, b.z, b.w}; }
struct EpiSwiGLU8 {
    static constexpr bool PERM = true;
    unsigned char* O; int ldc; float sc_in, sc_out;
    __device__ __forceinline__ void operator()(const f32x4 (&acc)[2][2][4][2], const Unit& u, int wr, int wc, int fr, int fq) const {
        const int row0 = u.pm * BM + wr * 64 + fr, col0 = u.pn * HALF + wc * 32 + 8 * fq;
#pragma unroll
        for (int ai = 0; ai < 2; ++ai)
#pragma unroll
            for (int m = 0; m < 4; ++m) { unsigned char* rowp = O + (size_t)(row0 + ai * HALF + m * 16) * ldc + col0;
                const f32x4 g0 = acc[ai][0][m][0] * sc_in, g1 = acc[ai][0][m][1] * sc_in, u0 = acc[ai][1][m][0] * (sc_in * sc_out), u1 = acc[ai][1][m][1] * (sc_in * sc_out);
                int w0 = 0, w1 = 0;
                w0 = __builtin_amdgcn_cvt_pk_fp8_f32(silu_mul(g0[0], u0[0]), silu_mul(g0[1], u0[1]), w0, false); w0 = __builtin_amdgcn_cvt_pk_fp8_f32(silu_mul(g0[2], u0[2]), silu_mul(g0[3], u0[3]), w0, true);
                w1 = __builtin_amdgcn_cvt_pk_fp8_f32(silu_mul(g1[0], u1[0]), silu_mul(g1[1], u1[1]), w1, false); w1 = __builtin_amdgcn_cvt_pk_fp8_f32(silu_mul(g1[2], u1[2]), silu_mul(g1[3], u1[3]), w1, true);
                typedef int v2i_t __attribute__((ext_vector_type(2))); *(v2i_t*)rowp = (v2i_t){w0, w1}; }
    }
};
__device__ __forceinline__ void pg8_mfma8(f32x4& c, v8i_t a, v8i_t b, int sc) { asm volatile("v_mfma_scale_f32_16x16x128_f8f6f4 %0, %1, %2, %0, %3, %3 op_sel_hi:[0,0,0]" : "+v"(c) : "v"(a), "v"(b), "v"(sc)); }
template <class Epi, class Sched, bool ALIGN_EPI = false, bool SP2 = false, bool FP8 = false>
__device__ __forceinline__ void gemm_phase(PG8_LAS unsigned char* lds, const Gemm g, const Sched& S, const Epi& E) {
    int tid_ = threadIdx.x; asm volatile("" : "+v"(tid_));
    const int tid = tid_, wid = __builtin_amdgcn_readfirstlane(tid >> 6), lane = tid & 63, wr = wid >> 2, wc = wid & 3, fr = lane & 15, fq = lane >> 4;
    const int nt = g.nt;
    unsigned voffA[2], voffB[2];
#pragma unroll
    for (int i = 0; i < 2; ++i) { int R, C; stage_rc(tid * 16 + i * 8192, R, C); const int Rb = Epi::PERM ? ((R & ~31) + perm32(R & 31)) : R;
        voffA[i] = (unsigned)(R * g.lda + C * 2); voffB[i] = (unsigned)(Rb * g.ldb + C * 2); }
    const size_t kstep = (size_t)(BK * 2);
    const size_t hstepA = (size_t)HALF * g.lda, hstepB = (size_t)HALF * g.ldb;
    const unsigned ldsw = (unsigned)wid * 1024u;
    const int aoff = lds_byte(wr * 64 + fr, fq * 8), boff = lds_byte(wc * 32 + fr, fq * 8);
#define PG8_SA(b, h) (((b) * 2 + (h)) * HTB)
#define PG8_SB(b, h) ((4 + (b) * 2 + (h)) * HTB)
#define PG8_STAGE(bufoff, gbase, voff) do { _Pragma("unroll") for (int _i = 0; _i < 2; ++_i) \
        __builtin_amdgcn_global_load_lds((const unsigned*)((const char*)(gbase) + (voff)[_i]), (PG8_LAS unsigned*)(lds + (bufoff) + ldsw + _i * 8192), 16, 0, 0); } while (0)
#define PG8_LDA(dst, b, h) do { _Pragma("unroll") for (int m = 0; m < 4; ++m) _Pragma("unroll") for (int k = 0; k < 2; ++k) dst[m][k] = *(const PG8_LAS bf16x8*)(lds + PG8_SA(b, h) + aoff + m * 2048 + k * 1024); } while (0)
#define PG8_LDB(dst, b, h) do { _Pragma("unroll") for (int n = 0; n < 2; ++n) _Pragma("unroll") for (int k = 0; k < 2; ++k) dst[n][k] = *(const PG8_LAS bf16x8*)(lds + PG8_SB(b, h) + boff + n * 2048 + k * 1024); } while (0)
#define PG8_MMA(ai, bj, At, Bt) do { __builtin_amdgcn_s_setprio(1); if constexpr (FP8) { _Pragma("unroll") for (int m = 0; m < 4; ++m) _Pragma("unroll") for (int n = 0; n < 2; ++n) \
        pg8_mfma8(acc[ai][bj][m][n], pg8_cat(Bt[n][0], Bt[n][1]), pg8_cat(At[m][0], At[m][1]), sc8); } else { \
        _Pragma("unroll") for (int m = 0; m < 4; ++m) _Pragma("unroll") for (int n = 0; n < 2; ++n) _Pragma("unroll") for (int k = 0; k < 2; ++k) \
        acc[ai][bj][m][n] = __builtin_amdgcn_mfma_f32_16x16x32_bf16(Bt[n][k], At[m][k], acc[ai][bj][m][n], 0, 0, 0); } __builtin_amdgcn_s_setprio(0); } while (0)
#define PG8_WAIT_V(n) asm volatile("s_waitcnt vmcnt(" #n ")" ::: "memory")
#define PG8_WAIT_L(n) asm volatile("s_waitcnt lgkmcnt(" #n ")" ::: "memory")
#define PG8_BAR __builtin_amdgcn_s_barrier()
#define PG8_SCHED __builtin_amdgcn_sched_barrier(0)
    Unit cur, nxt; int ui = 0;
    if (!S.next(0, cur)) return;
    int sc8 = 0x7F7F7F7F; asm volatile("" : "+v"(sc8));
    f32x4 acc[2][2][4][2];
#pragma unroll
    for (int a = 0; a < 2; ++a)
#pragma unroll
        for (int b = 0; b < 2; ++b)
#pragma unroll
            for (int m = 0; m < 4; ++m)
#pragma unroll
                for (int n = 0; n < 2; ++n) acc[a][b][m][n] = (f32x4){0.f, 0.f, 0.f, 0.f};
    bf16x8 At[4][2], B0[2][2], B1[2][2];
    const char* cA = S.abase(g, cur); const char* cB = S.bbase(g, cur);
    if constexpr (SP2) {
        PG8_STAGE(PG8_SB(0, 0), cB, voffB); PG8_STAGE(PG8_SB(0, 1), cB + hstepB, voffB); PG8_STAGE(PG8_SA(0, 0), cA, voffA); PG8_STAGE(PG8_SA(0, 1), cA + hstepA, voffA);
        if (wr == 1) PG8_BAR;
        PG8_WAIT_V(2); PG8_BAR;
        PG8_STAGE(PG8_SB(1, 0), cB + kstep, voffB); PG8_STAGE(PG8_SA(1, 0), cA + kstep, voffA); PG8_STAGE(PG8_SB(1, 1), cB + hstepB + kstep, voffB);
        PG8_WAIT_V(6); PG8_BAR;
    } else {
        PG8_STAGE(PG8_SB(0, 0), cB, voffB); PG8_STAGE(PG8_SA(0, 0), cA, voffA); PG8_STAGE(PG8_SB(0, 1), cB + hstepB, voffB); PG8_STAGE(PG8_SA(0, 1), cA + hstepA, voffA);
        if (wr == 1) PG8_BAR;
        PG8_WAIT_V(4); PG8_BAR;
        PG8_STAGE(PG8_SB(1, 0), cB + kstep, voffB); PG8_STAGE(PG8_SA(1, 0), cA + kstep, voffA); PG8_STAGE(PG8_SB(1, 1), cB + hstepB + kstep, voffB);
        PG8_WAIT_V(6); PG8_BAR;
    }
    for (;;) {
        const bool has_next = S.next(ui + 1, nxt);
        const char* nA = has_next ? S.abase(g, nxt) : cA; const char* nB = has_next ? S.bbase(g, nxt) : cB;
        for (int t = 0; t < nt; t += 2) {
            const bool last = (t == nt - 2);
            const char* a1 = cA + (size_t)(t + 1) * kstep;
            const char* a2 = last ? nA : cA + (size_t)(t + 2) * kstep; const char* b2 = last ? nB : cB + (size_t)(t + 2) * kstep;
            const char* a3 = a2 + kstep; const char* b3 = b2 + kstep;
            if constexpr (SP2) {
            PG8_LDB(B0, 0, 0); PG8_LDB(B1, 0, 1); PG8_SCHED; PG8_LDA(At, 0, 0); PG8_STAGE(PG8_SA(1, 1), a1 + hstepA, voffA);
            PG8_WAIT_V(8); PG8_WAIT_L(0); PG8_BAR; PG8_MMA(0, 0, At, B0); PG8_MMA(0, 1, At, B1); PG8_BAR; PG8_SCHED;
            PG8_LDA(At, 0, 1); PG8_STAGE(PG8_SB(0, 0), b2, voffB); PG8_STAGE(PG8_SB(0, 1), b2 + hstepB, voffB); PG8_STAGE(PG8_SA(0, 0), a2, voffA);
            PG8_WAIT_V(8); PG8_WAIT_L(0); PG8_BAR; PG8_MMA(1, 0, At, B0); PG8_MMA(1, 1, At, B1); PG8_BAR; PG8_SCHED;
            PG8_LDB(B0, 1, 0); PG8_LDB(B1, 1, 1); PG8_SCHED; PG8_LDA(At, 1, 0); PG8_STAGE(PG8_SA(0, 1), a2 + hstepA, voffA);
            PG8_WAIT_V(8); PG8_WAIT_L(0); PG8_BAR; PG8_MMA(0, 0, At, B0); PG8_MMA(0, 1, At, B1); PG8_BAR; PG8_SCHED;
            PG8_LDA(At, 1, 1); PG8_STAGE(PG8_SB(1, 0), b3, voffB); PG8_STAGE(PG8_SB(1, 1), b3 + hstepB, voffB); PG8_STAGE(PG8_SA(1, 0), a3, voffA);
            PG8_WAIT_V(8); PG8_WAIT_L(0); PG8_BAR; PG8_MMA(1, 0, At, B0); PG8_MMA(1, 1, At, B1); PG8_BAR; PG8_SCHED;
            } else {
            PG8_LDB(B0, 0, 0); PG8_SCHED; PG8_LDA(At, 0, 0); PG8_STAGE(PG8_SA(1, 1), a1 + hstepA, voffA);
            PG8_WAIT_L(8); PG8_BAR; PG8_WAIT_L(0); PG8_MMA(0, 0, At, B0); PG8_BAR; PG8_SCHED;
            PG8_LDB(B1, 0, 1); PG8_STAGE(PG8_SB(0, 0), b2, voffB);
            PG8_BAR; PG8_WAIT_L(0); PG8_MMA(0, 1, At, B1); PG8_BAR;
            PG8_LDA(At, 0, 1); PG8_STAGE(PG8_SA(0, 0), a2, voffA);
            PG8_BAR; PG8_WAIT_L(0); PG8_MMA(1, 0, At, B0); PG8_BAR; PG8_SCHED;
            PG8_STAGE(PG8_SB(0, 1), b2 + hstepB, voffB);
            PG8_WAIT_V(6); PG8_BAR; PG8_MMA(1, 1, At, B1); PG8_BAR;
            PG8_LDB(B0, 1, 0); PG8_SCHED; PG8_LDA(At, 1, 0); PG8_STAGE(PG8_SA(0, 1), a2 + hstepA, voffA);
            PG8_WAIT_L(8); PG8_BAR; PG8_WAIT_L(0); PG8_MMA(0, 0, At, B0); PG8_BAR; PG8_SCHED;
            PG8_LDB(B1, 1, 1); PG8_STAGE(PG8_SB(1, 0), b3, voffB);
            PG8_BAR; PG8_WAIT_L(0); PG8_MMA(0, 1, At, B1); PG8_BAR;
            PG8_LDA(At, 1, 1); PG8_STAGE(PG8_SA(1, 0), a3, voffA);
            PG8_BAR; PG8_WAIT_L(0); PG8_MMA(1, 0, At, B0); PG8_BAR; PG8_SCHED;
            PG8_STAGE(PG8_SB(1, 1), b3 + hstepB, voffB);
            PG8_WAIT_V(6); PG8_BAR; PG8_MMA(1, 1, At, B1); PG8_BAR;
            }
        }
        if constexpr (ALIGN_EPI) { if (wr == 0) PG8_BAR; }
        if constexpr (FP8) { PG8_SCHED; asm volatile("s_nop 15\n\ts_nop 7" ::: "memory"); PG8_SCHED; }
        E(acc, cur, wr, wc, fr, fq);
        if (!has_next) break;
#pragma unroll
        for (int a = 0; a < 2; ++a)
#pragma unroll
            for (int b = 0; b < 2; ++b)
#pragma unroll
                for (int m = 0; m < 4; ++m)
#pragma unroll
                    for (int n = 0; n < 2; ++n) acc[a][b][m][n] = (f32x4){0.f, 0.f, 0.f, 0.f};
        cur = nxt; cA = nA; cB = nB; ++ui;
        if constexpr (ALIGN_EPI) { if (wr == 1) PG8_BAR; }
    }
    PG8_WAIT_V(0);
    if constexpr (!ALIGN_EPI) { if (wr == 0) PG8_BAR; }
    PG8_BAR;
#undef PG8_SA
#undef PG8_SB
#undef PG8_STAGE
#undef PG8_LDA
#undef PG8_LDB
#undef PG8_MMA
#undef PG8_WAIT_V
#undef PG8_WAIT_L
#undef PG8_BAR
#undef PG8_SCHED
}
}
namespace att {
#define ATT_LAS __attribute__((address_space(3)))
#define ATT_GAS __attribute__((address_space(1)))
typedef unsigned short bf16;
using bf16x8 = __attribute__((ext_vector_type(8))) short;
using s16x4  = __attribute__((ext_vector_type(4))) short;
using f32x16 = __attribute__((ext_vector_type(16))) float;
using f32x4  = __attribute__((ext_vector_type(4))) float;
using u32x4  = __attribute__((ext_vector_type(4))) unsigned;
constexpr int NW = 8, QBLK = 32, KVBLK = 64, DV = 128;
constexpr float LOG2E = 1.4426950408889634f;
#define SBAR() __builtin_amdgcn_sched_barrier(0)
__device__ __forceinline__ int crow(int r, int hi) { return (r & 3) + 8 * (r >> 2) + 4 * hi; }
__device__ __forceinline__ unsigned cvtpk(float lo, float hi) { unsigned r; asm volatile("v_cvt_pk_bf16_f32 %0, %1, %2" : "=v"(r) : "v"(lo), "v"(hi)); return r; }
__device__ __forceinline__ float bf2f(short s) { return __uint_as_float(((unsigned)(unsigned short)s) << 16); }

__device__ __forceinline__ void partialSM(f32x16& p0, f32x16& p1, float& m_reg, float& mn, float& alpha, const float C, const float THRS) {
  float pmax = p0[0];
#pragma unroll
  for (int r = 1; r < 16; ++r) pmax = fmaxf(pmax, p0[r]);
#pragma unroll
  for (int r = 0; r < 16; ++r) pmax = fmaxf(pmax, p1[r]);
  { auto rr = __builtin_amdgcn_permlane32_swap(__float_as_uint(pmax), __float_as_uint(pmax), false, false);
    pmax = fmaxf(__uint_as_float(rr[0]), __uint_as_float(rr[1])); }
  if (__builtin_expect(__all(pmax - m_reg <= THRS), 1)) { mn = m_reg; alpha = 1.f; }
  else { mn = fmaxf(m_reg, pmax); alpha = __builtin_amdgcn_exp2f((m_reg - mn) * C); m_reg = mn; }
  float mnC = -mn * C;
#pragma unroll
  for (int r = 0; r < 16; ++r) p0[r] = fmaf(p0[r], C, mnC);
#pragma unroll
  for (int r = 0; r < 16; ++r) p1[r] = fmaf(p1[r], C, mnC);
#pragma unroll
  for (int r = 0; r < 16; ++r) p0[r] = __builtin_amdgcn_exp2f(p0[r]);
}
#define ATT_PK4(P, BASE, OUT) do { unsigned a0 = cvtpk(P[BASE + 0], P[BASE + 1]), a1 = cvtpk(P[BASE + 2], P[BASE + 3]);   \
    unsigned b0 = cvtpk(P[BASE + 4], P[BASE + 5]), b1 = cvtpk(P[BASE + 6], P[BASE + 7]);                              \
    auto r0 = __builtin_amdgcn_permlane32_swap(a0, b0, false, false); auto r1 = __builtin_amdgcn_permlane32_swap(a1, b1, false, false); \
    u32x4 w = {r0[0], r1[0], r0[1], r1[1]}; OUT = *reinterpret_cast<bf16x8*>(&w); } while (0)
__device__ __forceinline__ void finishSM(f32x16& p0, f32x16& p1, float alpha, float& l_reg, bf16x8& pa0, bf16x8& pa1, bf16x8& pa2, bf16x8& pa3) {
#pragma unroll
  for (int r = 0; r < 16; ++r) p1[r] = __builtin_amdgcn_exp2f(p1[r]);
  float ps = 0;
#pragma unroll
  for (int r = 0; r < 16; ++r) ps += p0[r];
#pragma unroll
  for (int r = 0; r < 16; ++r) ps += p1[r];
  { auto rr = __builtin_amdgcn_permlane32_swap(__float_as_uint(ps), __float_as_uint(ps), false, false);
    ps = __uint_as_float(rr[0]) + __uint_as_float(rr[1]); }
  l_reg = l_reg * alpha + ps;
  ATT_PK4(p0, 0, pa0); ATT_PK4(p0, 8, pa1); ATT_PK4(p1, 0, pa2); ATT_PK4(p1, 8, pa3);
}
template <int RB> __device__ __forceinline__ int kswz(int row, int colB) { return row * RB + (colB ^ ((row & 7) << 4)); }
template <int DQK> __device__ __forceinline__ void qkt(f32x16& p0, f32x16& p1, const ATT_LAS char* Ks, const bf16x8 (&qr)[DQK / 16], int r32, int hi) {
  p0 = f32x16{}; p1 = f32x16{};
#pragma unroll
  for (int d0 = 0; d0 < DQK / 16; ++d0) { const int cb = (d0 * 16 + hi * 8) * 2;
    bf16x8 b0 = *reinterpret_cast<const ATT_LAS bf16x8*>(Ks + kswz<DQK * 2>(r32, cb));
    bf16x8 b1 = *reinterpret_cast<const ATT_LAS bf16x8*>(Ks + kswz<DQK * 2>(32 + r32, cb));
    p0 = __builtin_amdgcn_mfma_f32_32x32x16_bf16(b0, qr[d0], p0, 0, 0, 0);
    p1 = __builtin_amdgcn_mfma_f32_32x32x16_bf16(b1, qr[d0], p1, 0, 0, 0); }
}
__device__ __forceinline__ int v_st(int k, int c) { const int kk = (k & ~0xC) | ((k & 4) << 1) | ((k & 8) >> 1); return ((kk >> 3) * 4 + (c >> 5)) * 512 + ((kk & 7) * 32 + (c & 31)) * 2; }
__device__ __forceinline__ int v_rd_base(int lane) { return ((lane & 3) << 3) | (((lane >> 2) & 3) << 6) | (((lane >> 4) & 1) << 5) | (((lane >> 5) & 1) << 8); }
constexpr int v_rd_off(int d0, int ks, int half) { return d0 * 512 + ks * 4096 + half * 2048; }
template <int OFF> __device__ __forceinline__ s16x4 tr_read(int vb) {
  s16x4 r; asm volatile("ds_read_b64_tr_b16 %0, %1 offset:%2" : "=&v"(r) : "v"(vb), "i"(OFF) : "memory"); return r;
}
#define ATT_PK(L, H) (bf16x8){L[0], L[1], L[2], L[3], H[0], H[1], H[2], H[3]}
template <int D0> __device__ __forceinline__ void pv_one(f32x16& od, int vb, bf16x8 pa0, bf16x8 pa1, bf16x8 pa2, bf16x8 pa3) {
  const s16x4 l0 = tr_read<v_rd_off(D0, 0, 0)>(vb), h0 = tr_read<v_rd_off(D0, 0, 1)>(vb), l1 = tr_read<v_rd_off(D0, 1, 0)>(vb), h1 = tr_read<v_rd_off(D0, 1, 1)>(vb);
  const s16x4 l2 = tr_read<v_rd_off(D0, 2, 0)>(vb), h2 = tr_read<v_rd_off(D0, 2, 1)>(vb), l3 = tr_read<v_rd_off(D0, 3, 0)>(vb), h3 = tr_read<v_rd_off(D0, 3, 1)>(vb);
  asm volatile("s_waitcnt lgkmcnt(0)" ::: "memory"); SBAR();
  od = __builtin_amdgcn_mfma_f32_32x32x16_bf16(pa0, ATT_PK(l0, h0), od, 0, 0, 0);
  od = __builtin_amdgcn_mfma_f32_32x32x16_bf16(pa1, ATT_PK(l1, h1), od, 0, 0, 0);
  od = __builtin_amdgcn_mfma_f32_32x32x16_bf16(pa2, ATT_PK(l2, h2), od, 0, 0, 0);
  od = __builtin_amdgcn_mfma_f32_32x32x16_bf16(pa3, ATT_PK(l3, h3), od, 0, 0, 0);
}
__device__ __forceinline__ void pv_d0(f32x16 (&o)[4], int vb, bf16x8 pa0, bf16x8 pa1, bf16x8 pa2, bf16x8 pa3) {
  pv_one<0>(o[0], vb, pa0, pa1, pa2, pa3); pv_one<1>(o[1], vb, pa0, pa1, pa2, pa3); pv_one<2>(o[2], vb, pa0, pa1, pa2, pa3); pv_one<3>(o[3], vb, pa0, pa1, pa2, pa3);
}
template <int D0> __device__ __forceinline__ void pv32_one(f32x16& od, int vb, bf16x8 pa0, bf16x8 pa1) {
  const s16x4 l0 = tr_read<v_rd_off(D0, 0, 0)>(vb), h0 = tr_read<v_rd_off(D0, 0, 1)>(vb), l1 = tr_read<v_rd_off(D0, 1, 0)>(vb), h1 = tr_read<v_rd_off(D0, 1, 1)>(vb);
  asm volatile("s_waitcnt lgkmcnt(0)" ::: "memory"); SBAR();
  od = __builtin_amdgcn_mfma_f32_32x32x16_bf16(pa0, ATT_PK(l0, h0), od, 0, 0, 0);
  od = __builtin_amdgcn_mfma_f32_32x32x16_bf16(pa1, ATT_PK(l1, h1), od, 0, 0, 0);
}

template <int DQK, int LDQ, int LDK, int LDO, int SDEPTH>
__device__ __forceinline__ void attn_dense_body(const bf16* __restrict__ Qb, const bf16* __restrict__ Kh, const bf16* __restrict__ Kr, const bf16* __restrict__ Vh,
                                                const float* __restrict__ cs_rows, float* __restrict__ Ob, int seq, const float scale, ATT_LAS char* lds) {
  constexpr int SHM_V = KVBLK * DV * 2, SHM_K = KVBLK * DQK * 2, RB = DQK * 2, NQ = DQK / 16;
  constexpr bool ROPE = (DQK == 192);
  const float C = scale * LOG2E, THRS = 8.f / scale;
  int tid_ = threadIdx.x; asm volatile("" : "+v"(tid_));
  const int tid = tid_, wid = tid >> 6, lane = tid & 63, r32 = lane & 31, hi = lane >> 5;
  ATT_LAS char* V_lds = lds; ATT_LAS char* K_lds = lds + 2 * SHM_V;
  ATT_LAS float* ws = (ATT_LAS float*)(lds + 2 * SHM_V + 2 * SHM_K) + wid * 64; ATT_LAS float* li_l = ws; ATT_LAS float* al_l = ws + 32;
  float m_reg = -1e30f, l_reg = 0; f32x16 o[4] = {}; bf16x8 qr[NQ];
  const bf16* Qw = Qb + (long)(wid * QBLK + r32) * LDQ + hi * 8;
#pragma unroll
  for (int d0 = 0; d0 < NQ; ++d0) qr[d0] = *(const ATT_GAS bf16x8*)(Qw + d0 * 16);
  if constexpr (ROPE) {
    const float* cs = cs_rows + (long)(wid * QBLK + r32) * 64 + hi * 8;
#pragma unroll
    for (int g = 0; g < 2; ++g) {
      const f32x4 c0 = *(const ATT_GAS f32x4*)(cs + g * 16), c1 = *(const ATT_GAS f32x4*)(cs + g * 16 + 4);
      const f32x4 s0 = *(const ATT_GAS f32x4*)(cs + 32 + g * 16), s1 = *(const ATT_GAS f32x4*)(cs + 32 + g * 16 + 4);
      float y1[8], y2[8];
#pragma unroll
      for (int j = 0; j < 8; ++j) { const float co = j < 4 ? c0[j & 3] : c1[j & 3], si = j < 4 ? s0[j & 3] : s1[j & 3];
        const float x1 = bf2f(qr[8 + g][j]), x2 = bf2f(qr[10 + g][j]); y1[j] = x1 * co - x2 * si; y2[j] = x1 * si + x2 * co; }
      u32x4 w1 = {cvtpk(y1[0], y1[1]), cvtpk(y1[2], y1[3]), cvtpk(y1[4], y1[5]), cvtpk(y1[6], y1[7])};
      u32x4 w2 = {cvtpk(y2[0], y2[1]), cvtpk(y2[2], y2[3]), cvtpk(y2[4], y2[5]), cvtpk(y2[6], y2[7])};
      qr[8 + g] = *reinterpret_cast<bf16x8*>(&w1); qr[10 + g] = *reinterpret_cast<bf16x8*>(&w2);
    }
  }
  const int sr = tid >> 4, sc = (tid & 15) * 8, vst0 = v_st(sr, sc), vst1 = v_st(32 + sr, sc);
  const int rr = tid >> 3, rc = (tid & 7) * 8;
  const int vb0 = (int)(unsigned)(uintptr_t)V_lds + v_rd_base(lane);
  struct Slot { bf16x8 vs0, vs1, ks0, ks1, kr; } sr_[SDEPTH];
#define SLOAD(i, k0) do { sr_[i].vs0 = *(const ATT_GAS bf16x8*)(&Vh[(long)((k0) + sr) * LDK + sc]); sr_[i].vs1 = *(const ATT_GAS bf16x8*)(&Vh[(long)((k0) + 32 + sr) * LDK + sc]); \
    sr_[i].ks0 = *(const ATT_GAS bf16x8*)(&Kh[(long)((k0) + sr) * LDK + sc]); sr_[i].ks1 = *(const ATT_GAS bf16x8*)(&Kh[(long)((k0) + 32 + sr) * LDK + sc]); \
    if constexpr (ROPE) sr_[i].kr = *(const ATT_GAS bf16x8*)(&Kr[(long)((k0) + rr) * 64 + rc]); } while (0)
#define SWRITE(b, i) do { *reinterpret_cast<ATT_LAS bf16x8*>(V_lds + (b) * SHM_V + vst0) = sr_[i].vs0;          \
    *reinterpret_cast<ATT_LAS bf16x8*>(V_lds + (b) * SHM_V + vst1) = sr_[i].vs1; const int kc = sc * 2;               \
    *reinterpret_cast<ATT_LAS bf16x8*>(K_lds + (b) * SHM_K + kswz<RB>(sr, kc)) = sr_[i].ks0;                       \
    *reinterpret_cast<ATT_LAS bf16x8*>(K_lds + (b) * SHM_K + kswz<RB>(32 + sr, kc)) = sr_[i].ks1;                  \
    if constexpr (ROPE) *reinterpret_cast<ATT_LAS bf16x8*>(K_lds + (b) * SHM_K + kswz<RB>(rr, 256 + rc * 2)) = sr_[i].kr; } while (0)
#define SWAIT() do { if constexpr (SDEPTH == 2) { if constexpr (ROPE) asm volatile("s_waitcnt vmcnt(5)" ::: "memory"); else asm volatile("s_waitcnt vmcnt(4)" ::: "memory"); } else asm volatile("s_waitcnt vmcnt(0)" ::: "memory"); } while (0)
#define RESC(a) do { if (__any((a) < 1.f)) { if (hi == 0) al_l[r32] = (a); asm volatile("s_waitcnt lgkmcnt(0)" ::: "memory"); \
    _Pragma("unroll") for (int d = 0; d < 4; ++d) _Pragma("unroll") for (int r = 0; r < 16; ++r) o[d][r] *= al_l[crow(r, hi)]; } } while (0)
  f32x16 pA0, pA1, pB0, pB1; float mnA, mnB, alA, alB; bf16x8 pa0, pa1, pa2, pa3; const int NT = seq / KVBLK;
  constexpr int SE = 0, SO = SDEPTH - 1;
  SLOAD(SE, 0); asm volatile("s_waitcnt vmcnt(0)" ::: "memory"); SWRITE(0, SE); __syncthreads();
  qkt<DQK>(pA0, pA1, K_lds, qr, r32, hi); partialSM(pA0, pA1, m_reg, mnA, alA, C, THRS);
  SLOAD(SO, KVBLK); if constexpr (SDEPTH == 2) { if (2 < NT) SLOAD(SE, 2 * KVBLK); }
  SWAIT(); SWRITE(1, SO); __syncthreads();
  for (int j = 1; j + 1 < NT; j += 2) {
    SBAR(); qkt<DQK>(pB0, pB1, K_lds + SHM_K, qr, r32, hi);
    finishSM(pA0, pA1, alA, l_reg, pa0, pa1, pa2, pa3); SBAR();
    SLOAD(SO, (j + SDEPTH) * KVBLK); SBAR();
    pv_d0(o, vb0, pa0, pa1, pa2, pa3); partialSM(pB0, pB1, m_reg, mnB, alB, C, THRS);
    __syncthreads(); SWAIT(); SWRITE(0, SE);
    RESC(alB); __syncthreads();
    SBAR(); qkt<DQK>(pA0, pA1, K_lds, qr, r32, hi);
    finishSM(pB0, pB1, alB, l_reg, pa0, pa1, pa2, pa3); SBAR();
    if (SDEPTH == 1 || j + 3 < NT) SLOAD(SE, (j + 1 + SDEPTH) * KVBLK); SBAR();
    pv_d0(o, vb0 + SHM_V, pa0, pa1, pa2, pa3); partialSM(pA0, pA1, m_reg, mnA, alA, C, THRS);
    __syncthreads(); SWAIT(); SWRITE(1, SO);
    RESC(alA); __syncthreads();
  }
  SBAR(); qkt<DQK>(pB0, pB1, K_lds + SHM_K, qr, r32, hi);
  finishSM(pA0, pA1, alA, l_reg, pa0, pa1, pa2, pa3); SBAR();
  pv_d0(o, vb0, pa0, pa1, pa2, pa3); partialSM(pB0, pB1, m_reg, mnB, alB, C, THRS);
  __syncthreads(); RESC(alB);
  finishSM(pB0, pB1, alB, l_reg, pa0, pa1, pa2, pa3); SBAR();
  pv_d0(o, vb0 + SHM_V, pa0, pa1, pa2, pa3);
  if (hi == 0) li_l[r32] = l_reg; asm volatile("s_waitcnt lgkmcnt(0)" ::: "memory");
  float rli[16];
#pragma unroll
  for (int r = 0; r < 16; ++r) rli[r] = __builtin_amdgcn_rcpf(li_l[crow(r, hi)]);
  float* Ow = Ob + (long)(wid * QBLK) * LDO;
#pragma unroll
  for (int r = 0; r < 16; ++r) { const int orow = crow(r, hi);
#pragma unroll
    for (int d0 = 0; d0 < 4; ++d0) Ow[(long)orow * LDO + d0 * 32 + r32] = o[d0][r] * rli[r]; }
  __syncthreads();
#undef SLOAD
#undef SWRITE
#undef SWAIT
#undef RESC
}

template <int DQK, int LDQ, int LDK, int LDO>
__device__ __forceinline__ void attn_simple_body(const bf16* __restrict__ Qb, const bf16* __restrict__ Kh, const bf16* __restrict__ Kr, const bf16* __restrict__ Vh,
                                                 const float* __restrict__ cs_rows, float* __restrict__ Ob, int seq, const float scale, ATT_LAS char* lds) {
  constexpr int SHM_V = KVBLK * DV * 2, SHM_K = KVBLK * DQK * 2, RB = DQK * 2, NQ = DQK / 16;
  constexpr bool ROPE = (DQK == 192);
  const float C = scale * LOG2E, THRS = 8.f / scale;
  int tid_ = threadIdx.x; asm volatile("" : "+v"(tid_));
  const int tid = tid_, wid = tid >> 6, lane = tid & 63, r32 = lane & 31, hi = lane >> 5;
  ATT_LAS char* V_lds = lds; ATT_LAS char* K_lds = lds + 2 * SHM_V;
  ATT_LAS float* ws = (ATT_LAS float*)(lds + 2 * SHM_V + 2 * SHM_K) + wid * 64; ATT_LAS float* li_l = ws; ATT_LAS float* al_l = ws + 32;
  float m_reg = -1e30f, l_reg = 0; f32x16 o[4] = {}; bf16x8 qr[NQ];
  const bf16* Qw = Qb + (long)(wid * QBLK + r32) * LDQ + hi * 8;
#pragma unroll
  for (int d0 = 0; d0 < NQ; ++d0) qr[d0] = *(const ATT_GAS bf16x8*)(Qw + d0 * 16);
  if constexpr (ROPE) {
    const float* cs = cs_rows + (long)(wid * QBLK + r32) * 64 + hi * 8;
#pragma unroll
    for (int g = 0; g < 2; ++g) {
      const f32x4 c0 = *(const ATT_GAS f32x4*)(cs + g * 16), c1 = *(const ATT_GAS f32x4*)(cs + g * 16 + 4);
      const f32x4 s0 = *(const ATT_GAS f32x4*)(cs + 32 + g * 16), s1 = *(const ATT_GAS f32x4*)(cs + 32 + g * 16 + 4);
      float y1[8], y2[8];
#pragma unroll
      for (int j = 0; j < 8; ++j) { const float co = j < 4 ? c0[j & 3] : c1[j & 3], si = j < 4 ? s0[j & 3] : s1[j & 3];
        const float x1 = bf2f(qr[8 + g][j]), x2 = bf2f(qr[10 + g][j]); y1[j] = x1 * co - x2 * si; y2[j] = x1 * si + x2 * co; }
      u32x4 w1 = {cvtpk(y1[0], y1[1]), cvtpk(y1[2], y1[3]), cvtpk(y1[4], y1[5]), cvtpk(y1[6], y1[7])};
      u32x4 w2 = {cvtpk(y2[0], y2[1]), cvtpk(y2[2], y2[3]), cvtpk(y2[4], y2[5]), cvtpk(y2[6], y2[7])};
      qr[8 + g] = *reinterpret_cast<bf16x8*>(&w1); qr[10 + g] = *reinterpret_cast<bf16x8*>(&w2);
    }
  }
  const int sr = tid >> 4, sc = (tid & 15) * 8, vst0 = v_st(sr, sc), vst1 = v_st(32 + sr, sc);
  const int rr = tid >> 3, rc = (tid & 7) * 8;
  const int vb0 = (int)(unsigned)(uintptr_t)V_lds + v_rd_base(lane);
  bf16x8 vs0, vs1, ks0, ks1, kr;
#define SLOAD(k0) do { vs0 = *(const ATT_GAS bf16x8*)(&Vh[(long)((k0) + sr) * LDK + sc]); vs1 = *(const ATT_GAS bf16x8*)(&Vh[(long)((k0) + 32 + sr) * LDK + sc]); \
    ks0 = *(const ATT_GAS bf16x8*)(&Kh[(long)((k0) + sr) * LDK + sc]); ks1 = *(const ATT_GAS bf16x8*)(&Kh[(long)((k0) + 32 + sr) * LDK + sc]); \
    if constexpr (ROPE) kr = *(const ATT_GAS bf16x8*)(&Kr[(long)((k0) + rr) * 64 + rc]); } while (0)
#define SWRITE(b) do { *reinterpret_cast<ATT_LAS bf16x8*>(V_lds + (b) * SHM_V + vst0) = vs0;          \
    *reinterpret_cast<ATT_LAS bf16x8*>(V_lds + (b) * SHM_V + vst1) = vs1; const int kc = sc * 2;               \
    *reinterpret_cast<ATT_LAS bf16x8*>(K_lds + (b) * SHM_K + kswz<RB>(sr, kc)) = ks0;                       \
    *reinterpret_cast<ATT_LAS bf16x8*>(K_lds + (b) * SHM_K + kswz<RB>(32 + sr, kc)) = ks1;                  \
    if constexpr (ROPE) *reinterpret_cast<ATT_LAS bf16x8*>(K_lds + (b) * SHM_K + kswz<RB>(rr, 256 + rc * 2)) = kr; } while (0)
#define RESC(a) do { if (__any((a) < 1.f)) { if (hi == 0) al_l[r32] = (a); asm volatile("s_waitcnt lgkmcnt(0)" ::: "memory"); \
    _Pragma("unroll") for (int d = 0; d < 4; ++d) _Pragma("unroll") for (int r = 0; r < 16; ++r) o[d][r] *= al_l[crow(r, hi)]; } } while (0)
  const int NT = seq / KVBLK;
  SLOAD(0); SWRITE(0); __syncthreads();
  for (int j = 0; j < NT; ++j) {
    const int b = j & 1;
    if (j + 1 < NT) SLOAD((j + 1) * KVBLK);
    f32x16 p0, p1; float mn, al; bf16x8 pa0, pa1, pa2, pa3;
    SBAR(); qkt<DQK>(p0, p1, K_lds + b * SHM_K, qr, r32, hi);
    partialSM(p0, p1, m_reg, mn, al, C, THRS); RESC(al);
    finishSM(p0, p1, al, l_reg, pa0, pa1, pa2, pa3); SBAR();
    pv_d0(o, vb0 + b * SHM_V, pa0, pa1, pa2, pa3);
    if (j + 1 < NT) SWRITE(b ^ 1);
    __syncthreads();
  }
  if (hi == 0) li_l[r32] = l_reg; asm volatile("s_waitcnt lgkmcnt(0)" ::: "memory");
  float rli[16];
#pragma unroll
  for (int r = 0; r < 16; ++r) rli[r] = __builtin_amdgcn_rcpf(li_l[crow(r, hi)]);
  float* Ow = Ob + (long)(wid * QBLK) * LDO;
#pragma unroll
  for (int r = 0; r < 16; ++r) { const int orow = crow(r, hi);
#pragma unroll
    for (int d0 = 0; d0 < 4; ++d0) Ow[(long)orow * LDO + d0 * 32 + r32] = o[d0][r] * rli[r]; }
  __syncthreads();
#undef SLOAD
#undef SWRITE
#undef RESC
}

template <int LDP>
__device__ __forceinline__ void dil_wave_unit(const bf16* __restrict__ P, int qc, int kc, int vc, int d, int r, int t0, int nT,
                                              float* __restrict__ O, int oc, float* __restrict__ ST  ,
                                              ATT_LAS char* vlds  , const ATT_LAS float* bias2, const float C, int lane_) {
  int lane = lane_; asm volatile("" : "+v"(lane));
  const int r32 = lane & 31, hi = lane >> 5;
  bf16x8 qr[8];
  { const bf16* qp = P + (long)(r + d * (t0 + r32)) * LDP + qc + hi * 8;
#pragma unroll
    for (int d0 = 0; d0 < 8; ++d0) qr[d0] = *(const ATT_GAS bf16x8*)(qp + d0 * 16); }
  f32x16 p[5];
#pragma unroll
  for (int kb = 0; kb < 5; ++kb) {
    int kt = t0 - 64 + kb * 32 + r32; kt = kt < 0 ? 0 : (kt > nT - 1 ? nT - 1 : kt);
    const bf16* kp = P + (long)(r + d * kt) * LDP + kc + hi * 8;
    bf16x8 kf[8];
#pragma unroll
    for (int d0 = 0; d0 < 8; ++d0) kf[d0] = *(const ATT_GAS bf16x8*)(kp + d0 * 16);
    p[kb] = f32x16{};
#pragma unroll
    for (int d0 = 0; d0 < 8; ++d0) p[kb] = __builtin_amdgcn_mfma_f32_32x32x16_bf16(kf[d0], qr[d0], p[kb], 0, 0, 0);
  }
  float m = -1e30f;
#pragma unroll
  for (int kb = 0; kb < 5; ++kb)
#pragma unroll
    for (int rg = 0; rg < 16; ++rg) {
      const int jj = kb * 32 + crow(rg, hi) - r32;
      const int kt = t0 - 64 + kb * 32 + crow(rg, hi);
      const bool valid = (jj >= 0) && (jj <= 128) && (kt >= 0) && (kt < nT);
      const int bi = jj < 0 ? 0 : (jj > 128 ? 128 : jj);
      const float s = fmaf(p[kb][rg], C, bias2[bi]);
      p[kb][rg] = valid ? s : -1e30f; m = fmaxf(m, p[kb][rg]);
    }
  { auto rr = __builtin_amdgcn_permlane32_swap(__float_as_uint(m), __float_as_uint(m), false, false); m = fmaxf(__uint_as_float(rr[0]), __uint_as_float(rr[1])); }
  float Z = 0.f;
#pragma unroll
  for (int kb = 0; kb < 5; ++kb)
#pragma unroll
    for (int rg = 0; rg < 16; ++rg) { p[kb][rg] = __builtin_amdgcn_exp2f(p[kb][rg] - m); Z += p[kb][rg]; }
  { auto rr = __builtin_amdgcn_permlane32_swap(__float_as_uint(Z), __float_as_uint(Z), false, false); Z = __uint_as_float(rr[0]) + __uint_as_float(rr[1]); }
  f32x16 o[4] = {};
  const int vb = (int)(unsigned)(uintptr_t)vlds + v_rd_base(lane);
#pragma unroll
  for (int kb = 0; kb < 5; ++kb) {
    bf16x8 vv[8];
#pragma unroll
    for (int i = 0; i < 8; ++i) { const int id = lane + 64 * i, row = id >> 4, c = (id & 15) * 8;
      int kt = t0 - 64 + kb * 32 + row; kt = kt < 0 ? 0 : (kt > nT - 1 ? nT - 1 : kt);
      vv[i] = *(const ATT_GAS bf16x8*)(P + (long)(r + d * kt) * LDP + vc + c); }
#pragma unroll
    for (int i = 0; i < 8; ++i) { const int id = lane + 64 * i, row = id >> 4, c = (id & 15) * 8;
      *reinterpret_cast<ATT_LAS bf16x8*>(vlds + v_st(row, c)) = vv[i]; }
    bf16x8 pa0, pa1; ATT_PK4(p[kb], 0, pa0); ATT_PK4(p[kb], 8, pa1);
    asm volatile("s_waitcnt lgkmcnt(0)" ::: "memory"); SBAR();
    pv32_one<0>(o[0], vb, pa0, pa1); pv32_one<1>(o[1], vb, pa0, pa1); pv32_one<2>(o[2], vb, pa0, pa1); pv32_one<3>(o[3], vb, pa0, pa1);
    SBAR();
  }
#pragma unroll
  for (int rg = 0; rg < 16; ++rg) { const long row = r + d * (t0 + crow(rg, hi));
#pragma unroll
    for (int d0 = 0; d0 < 4; ++d0) O[row * 768 + oc + d0 * 32 + r32] = o[d0][rg]; }
  if (hi == 0) { const long row = r + d * (t0 + r32); typedef float f32x2_ __attribute__((ext_vector_type(2))); *(ATT_GAS f32x2_*)(ST + row * 12) = (f32x2_){m, Z}; }
}
}
constexpr int S = 8192, D = 2048, NMEM = 256;
constexpr int DIN = 3392, DINP = 3584;
constexpr int PC_DIL = 768, PC_MEM = 3072;
constexpr int QR = 384, KVR = 128, AQ = 512;
constexpr int NUP = 2816;
constexpr int UC_KV = 1280;
constexpr int DFF = 5632, DFE = 7168, NE = 8;
constexpr int MP = 18432;
constexpr float EPS = 1e-6f;
constexpr int NWAVES = 8;

constexpr size_t al256(size_t x) { return (x + 255) / 256 * 256; }
constexpr size_t WS_CTL = 0, CTL_ZERO_BYTES = 1u << 20;
constexpr size_t WS_WIN = WS_CTL + CTL_ZERO_BYTES;
constexpr size_t WS_WUP = WS_WIN + al256((size_t)2 * DINP * D * 2);
constexpr size_t WS_WMEM = WS_WUP + al256((size_t)2 * NUP * AQ * 2);
constexpr size_t WS_WOUT = WS_WMEM + al256((size_t)2 * 1024 * D * 2);
constexpr size_t WS_WGU = WS_WOUT + al256((size_t)2 * D * D * 2);
constexpr size_t WS_WDN = WS_WGU + al256((size_t)2 * DFF * D * 2);
constexpr size_t WS_MGU = WS_WDN + al256((size_t)D * DFF * 2);
constexpr size_t WS_MDN = WS_MGU + al256((size_t)NE * 2 * DFE * D * 2);
constexpr size_t WS_XN = WS_MDN + al256((size_t)NE * D * DFE * 2);
constexpr size_t WS_MEMN = WS_XN + al256((size_t)S * D * 2);
constexpr size_t WS_MEMKV = WS_MEMN + al256((size_t)2 * NMEM * D * 2);
constexpr size_t WS_PROJ = WS_MEMKV + al256((size_t)2 * NMEM * 1024 * 2);
constexpr size_t WS_AQKV = WS_PROJ + al256((size_t)S * DINP * 2);
constexpr size_t WS_KROPE = WS_AQKV + al256((size_t)S * AQ * 2);
constexpr size_t WS_ROPECS = WS_KROPE + al256((size_t)S * 64 * 2);
constexpr size_t WS_QKVM = WS_ROPECS + al256((size_t)S * 64 * 4);
constexpr size_t WS_YPRE = WS_QKVM + al256((size_t)S * NUP * 2);
constexpr size_t WS_DILO = WS_YPRE + al256((size_t)S * D * 4);
constexpr size_t WS_DILS = WS_DILO + al256((size_t)3 * S * 768 * 4);
constexpr size_t WS_Y = WS_DILS + al256((size_t)3 * S * 12 * 4);
constexpr size_t WS_XA = WS_Y + al256((size_t)S * D * 2);
constexpr size_t WS_ROUTE = WS_XA + al256((size_t)S * D * 4);
constexpr size_t WS_XP = WS_ROUTE + al256((size_t)S * 32);
constexpr size_t WS_OUTP = WS_XP + al256((size_t)MP * D * 2);
constexpr size_t WS_ACTP = WS_OUTP + al256((size_t)MP * D * 2);
constexpr size_t WS_END = WS_ACTP + al256((size_t)MP * DFE * 2);
static_assert(WS_END <= 1879048192ull, "workspace map exceeds 4 x the largest input");
constexpr int CW_BAR = 4096;
constexpr int CW_QUEUE = 8192;
constexpr int CW_CNT = 8192 + 256;
constexpr int CW_TILEE = 8192 + 512;
constexpr int RING_BYTES = 131072;
constexpr int LDSCTL_OFF = RING_BYTES, MISC_OFF = LDSCTL_OFF + 320;
constexpr int BIAS_OFF = 114688;
constexpr int LDS_BYTES = 147456;

#define GAS __attribute__((address_space(1)))
#define LAS __attribute__((address_space(3)))
typedef unsigned short bf16;
typedef unsigned v4u __attribute__((ext_vector_type(4)));
typedef unsigned v2u __attribute__((ext_vector_type(2)));
typedef float f32x4 __attribute__((ext_vector_type(4)));
typedef short bf16x8 __attribute__((ext_vector_type(8)));
typedef GAS unsigned gu32;
#define RLX_AGENT __ATOMIC_RELAXED, __HIP_MEMORY_SCOPE_AGENT
#define LDS_WAIT() asm volatile("s_waitcnt lgkmcnt(0)" ::: "memory")
#define VM_WAIT() asm volatile("s_waitcnt vmcnt(0)" ::: "memory")
__device__ __forceinline__ unsigned f2bf(float f) { unsigned u = __builtin_bit_cast(unsigned, f); return (u + 0x7fffu + ((u >> 16) & 1u)) >> 16; }
__device__ __forceinline__ unsigned pk2(float lo, float hi) { return f2bf(lo) | (f2bf(hi) << 16); }
__device__ __forceinline__ float bflo(unsigned w) { return __uint_as_float(w << 16); }
__device__ __forceinline__ float bfhi(unsigned w) { return __uint_as_float(w & 0xffff0000u); }

#define XB_TMO      128
#define XB_XCNT(j)  (256  + 64 * (j))
#define XB_XSUB(j)  (1280 + 64 * (j))
#define XB_XGEN(j)  (2304 + 64 * (j))
#define XB_TOP      3328
#define XB_TOPGEN   3392
#define XCD_BAR_WORDS 3456
#define XB_SPIN_CAP (1u << 18)
__device__ __forceinline__ unsigned xb_ld(unsigned* p)              { return __hip_atomic_load(p, __ATOMIC_RELAXED, __HIP_MEMORY_SCOPE_AGENT); }
__device__ __forceinline__ unsigned xb_add(unsigned* p, unsigned v) { return __hip_atomic_fetch_add(p, v, __ATOMIC_RELAXED, __HIP_MEMORY_SCOPE_AGENT); }
__device__ __forceinline__ unsigned xb_xcc_id() { return (unsigned)__builtin_amdgcn_s_getreg((3 << 11) | 20) & 0xFu; }
#define XB_SPIN(cond, bar) do { unsigned _sp = 0; while (cond) { __builtin_amdgcn_s_sleep(1); \
    if ((++_sp & 255u) == 0u) { if (xb_ld(&(bar)[XB_TMO])) break; if (_sp > XB_SPIN_CAP) { atomicAdd(&(bar)[XB_TMO], 1u); break; } } } } while (0)
struct XcdBarrier { unsigned* bar; unsigned x; volatile LAS unsigned* st; };
__device__ __forceinline__ XcdBarrier xcd_barrier_post(unsigned* bar, volatile LAS unsigned* st) {
    XcdBarrier b; b.bar = bar; b.x = xb_xcc_id(); b.st = st;
    if (threadIdx.x == 0) (void)xb_add(&bar[XB_XCNT(b.x)], 1u);
    return b;
}
__device__ __forceinline__ void xcd_barrier_complete(unsigned* bar, unsigned x, unsigned& nloc, unsigned& nx) {
    const unsigned G = gridDim.x * gridDim.y * gridDim.z;
    unsigned sum, cnt, mine, sp = 0u;
    for (;;) {
        sum = 0u; cnt = 0u; mine = 0u;
#pragma unroll
        for (unsigned j = 0; j < 16; ++j) { const unsigned c = xb_ld(&bar[XB_XCNT(j)]); sum += c; cnt += (c > 0u) ? 1u : 0u; mine = (j == x) ? c : mine; }
        if (sum == G) break;
        __builtin_amdgcn_s_sleep(1);
        if ((++sp & 255u) == 0u) { if (xb_ld(&bar[XB_TMO])) break; if (sp > XB_SPIN_CAP) { atomicAdd(&bar[XB_TMO], 1u); break; } }
    }
    nloc = mine > 0u ? mine : 1u; nx = cnt > 0u ? cnt : 1u;
}
__device__ __forceinline__ void xcd_barrier(const XcdBarrier& b) {
    asm volatile("s_waitcnt vmcnt(0)" ::: "memory");
    __syncthreads();
    if (threadIdx.x == 0) {
        unsigned* bar = b.bar;
        __builtin_amdgcn_s_waitcnt(0);
        unsigned nloc = b.st[0], nx = b.st[1];
        if (nloc == 0u) { xcd_barrier_complete(bar, b.x, nloc, nx); b.st[0] = nloc; b.st[1] = nx; }
        const unsigned old = xb_add(&bar[XB_XSUB(b.x)], 1u);
        const unsigned gen = old / nloc;
        if (old + 1u == (gen + 1u) * nloc) {
            __builtin_amdgcn_fence(__ATOMIC_RELEASE, "agent");
            asm volatile("s_waitcnt vmcnt(0)" ::: "memory");
            const unsigned og = xb_add(&bar[XB_TOP], 1u);
            const unsigned tg = og / nx;
            if (og + 1u == (tg + 1u) * nx) xb_add(&bar[XB_TOPGEN], 1u);
            else XB_SPIN(xb_ld(&bar[XB_TOPGEN]) == tg, bar);
            __builtin_amdgcn_fence(__ATOMIC_ACQUIRE, "agent");
            xb_add(&bar[XB_XGEN(b.x)], 1u);
            asm volatile("s_waitcnt vmcnt(0)" ::: "memory");
        } else {
            XB_SPIN(xb_ld(&bar[XB_XGEN(b.x)]) == gen, bar);
            __builtin_amdgcn_fence(__ATOMIC_ACQUIRE, "agent");
            asm volatile("s_waitcnt vmcnt(0)" ::: "memory");
        }
    }
    __syncthreads();
}

struct Args {
    const float* in[23]; float* out; unsigned char* ws;
    float invf[32];
    int ph_lo, ph_hi, li, pad;
};
struct Frame {
    LAS unsigned char* lds;
    volatile LAS unsigned* MISC;
    gu32* ctl;
    int tid, lane, wave, G, gw, NGW;
    unsigned char* ws;
};
__device__ __forceinline__ float wave_sum(float v) {
#pragma unroll
    for (int o = 1; o < 64; o <<= 1) v += __shfl_xor(v, o);
    return v;
}
__device__ __forceinline__ float wave_max(float v) {
#pragma unroll
    for (int o = 1; o < 64; o <<= 1) v = fmaxf(v, __shfl_xor(v, o));
    return v;
}

__device__ __forceinline__ unsigned pk4_fp8(float a, float b, float c, float d) { int w = 0; w = __builtin_amdgcn_cvt_pk_fp8_f32(a, b, w, false); w = __builtin_amdgcn_cvt_pk_fp8_f32(c, d, w, true); return (unsigned)w; }
template <bool FP8>
__device__ __forceinline__ void cvt_item(const float* __restrict__ W, int N, int k0, int n0, void* __restrict__ dstv, int ldd, int drow0, int kdst0, LAS float* scr, int lane, float wsc) {
    f32x4 v[8];
    const int lr = lane >> 3, lc = (lane & 7) * 4;
#pragma unroll
    for (int i = 0; i < 8; ++i) v[i] = *(const GAS f32x4*)(W + (size_t)(k0 + i * 8 + lr) * N + n0 + lc);
#pragma unroll
    for (int i = 0; i < 8; ++i) { LAS float* s = scr + (i * 8 + lr) * 33 + lc; s[0] = v[i][0]; s[1] = v[i][1]; s[2] = v[i][2]; s[3] = v[i][3]; }
    LDS_WAIT(); asm volatile("" ::: "memory");
    const int c = lane & 7;
#pragma unroll
    for (int j = 0; j < 4; ++j) { const int n = (lane >> 3) + 8 * j; const LAS float* s = scr + (8 * c) * 33 + n;
        if constexpr (FP8) { v2u o; o.x = pk4_fp8(s[0 * 33] * wsc, s[1 * 33] * wsc, s[2 * 33] * wsc, s[3 * 33] * wsc); o.y = pk4_fp8(s[4 * 33] * wsc, s[5 * 33] * wsc, s[6 * 33] * wsc, s[7 * 33] * wsc);
            *(GAS v2u*)((unsigned char*)dstv + (size_t)(drow0 + n) * ldd + kdst0 + k0 + 8 * c) = o; }
        else { v4u o; o.x = pk2(s[0 * 33], s[1 * 33]); o.y = pk2(s[2 * 33], s[3 * 33]); o.z = pk2(s[4 * 33], s[5 * 33]); o.w = pk2(s[6 * 33], s[7 * 33]);
            *(GAS v4u*)((bf16*)dstv + (size_t)(drow0 + n) * ldd + kdst0 + k0 + 8 * c) = o; } }
    LDS_WAIT(); asm volatile("" ::: "memory");
}
template <bool FP8>
__device__ __forceinline__ void cvt_job(Frame& F, const float* W, int K, int N, void* dst, int ldd, int kdst0, int mode, int roff, LAS float* scr, float wsc) {
    const int nnb = N / 32, nitems = (K / 64) * nnb;
    for (int it = F.gw; it < nitems; it += F.NGW) {
        const int kb = it / nnb, nb = it % nnb, n0 = nb * 32;
        int drow0;
        if (mode == 0) drow0 = n0 + roff; else if (mode == 1) drow0 = (n0 >> 7) * 256 + (n0 & 127); else if (mode == 2) drow0 = (n0 >> 7) * 256 + 128 + (n0 & 127); else drow0 = n0 < 576 ? n0 : n0 + 192;
        cvt_item<FP8>(W, N, kb * 64, n0, dst, ldd, drow0, kdst0, scr, F.lane, wsc);
    }
}
__device__ __forceinline__ void rms_row_to_bf16(const float* xrow, const float* g, bf16* orow, int lane) {
    const GAS f32x4* xr = (const GAS f32x4*)xrow + lane; const GAS f32x4* gr = (const GAS f32x4*)g + lane;
    f32x4 v[8]; float s = 0.f;
#pragma unroll
    for (int j = 0; j < 8; ++j) { v[j] = xr[64 * j]; s += (v[j].x * v[j].x + v[j].y * v[j].y) + (v[j].z * v[j].z + v[j].w * v[j].w); }
    const float rstd = 1.f / sqrtf(wave_sum(s) * (1.f / D) + EPS);
    GAS v2u* o8 = (GAS v2u*)orow + lane;
#pragma unroll
    for (int j = 0; j < 8; ++j) { const f32x4 gg = gr[64 * j]; v2u w; w.x = pk2(v[j].x * rstd * gg.x, v[j].y * rstd * gg.y); w.y = pk2(v[j].z * rstd * gg.z, v[j].w * rstd * gg.w); o8[64 * j] = w; }
}
__device__ __forceinline__ void rms_row_to_fp8(const float* xrow, const float* g, unsigned char* orow, int lane) {
    const GAS f32x4* xr = (const GAS f32x4*)xrow + lane; const GAS f32x4* gr = (const GAS f32x4*)g + lane;
    f32x4 v[8]; float s = 0.f;
#pragma unroll
    for (int j = 0; j < 8; ++j) { v[j] = xr[64 * j]; s += (v[j].x * v[j].x + v[j].y * v[j].y) + (v[j].z * v[j].z + v[j].w * v[j].w); }
    const float rstd = 1.f / sqrtf(wave_sum(s) * (1.f / D) + EPS);
    GAS unsigned* o4 = (GAS unsigned*)orow + lane;
#pragma unroll
    for (int j = 0; j < 8; ++j) { const f32x4 gg = gr[64 * j]; o4[64 * j] = pk4_fp8(v[j].x * rstd * gg.x, v[j].y * rstd * gg.y, v[j].z * rstd * gg.z, v[j].w * rstd * gg.w); }
}
__device__ __forceinline__ void sincos_f64(float ang, float& c, float& s) {
    const double a = (double)ang, twopi = 6.283185307179586476925286766559, inv2pi = 0.15915494309189533576888376337251;
    const double q = __builtin_rint(a * inv2pi); const double r = a - q * twopi;
    const double r2 = r * r; double ss = 1.0, cc = 1.0;
#pragma unroll
    for (int k = 14; k >= 1; --k) { ss = 1.0 - r2 * (1.0 / (double)((2 * k) * (2 * k + 1))) * ss; cc = 1.0 - r2 * (1.0 / (double)((2 * k - 1) * (2 * k))) * cc; }
    s = (float)(r * ss); c = (float)cc;
}
__device__ const unsigned char DIL_BUCKET[3][129] = {
 {11,11,11,11,11,11,11,11,11,11,11,11,11,11,11,10,10,10,10,10,10,10,10,10,10,10,10,10,10,10,10,10,10,10,10,10,10,10,9,9,9,9,9,9,9,9,9,9,9,9,8,8,8,8,8,8,8,7,6,5,4,3,2,1,0,17,18,19,20,21,22,23,24,24,24,24,24,24,24,25,25,25,25,25,25,25,25,25,25,25,25,26,26,26,26,26,26,26,26,26,26,26,26,26,26,26,26,26,26,26,26,26,26,26,27,27,27,27,27,27,27,27,27,27,27,27,27,27,27},
 {13,13,13,13,13,13,13,13,13,13,13,13,13,13,13,13,13,13,13,13,13,13,13,12,12,12,12,12,12,12,12,12,12,12,12,12,12,12,12,12,12,12,11,11,11,11,11,11,11,11,11,11,10,10,10,10,10,10,9,9,9,8,8,4,0,20,24,24,25,25,25,26,26,26,26,26,26,27,27,27,27,27,27,27,27,27,27,28,28,28,28,28,28,28,28,28,28,28,28,28,28,28,28,28,28,28,29,29,29,29,29,29,29,29,29,29,29,29,29,29,29,29,29,29,29,29,29,29,29},
 {15,15,15,15,15,15,15,15,15,15,15,15,15,15,15,15,15,15,15,15,15,15,15,15,15,15,15,15,15,15,14,14,14,14,14,14,14,14,14,14,14,14,14,14,14,13,13,13,13,13,13,13,13,13,12,12,12,12,12,11,11,10,10,9,0,25,26,26,27,27,28,28,28,28,28,29,29,29,29,29,29,29,29,29,30,30,30,30,30,30,30,30,30,30,30,30,30,30,30,31,31,31,31,31,31,31,31,31,31,31,31,31,31,31,31,31,31,31,31,31,31,31,31,31,31,31,31,31,31}};

typedef float f32x2 __attribute__((ext_vector_type(2)));
#ifndef PH_MASK
#define PH_MASK 0xFFFFu
#endif
#ifndef REPEAT_PHASE
#define REPEAT_PHASE -1
#endif
#ifndef ATT_EN
#define ATT_EN 7
#endif
#define PEN(k) ((PH_MASK >> (k)) & 1u)
#ifndef FFN_FP8
#define FFN_FP8 3
#endif
constexpr bool F8D = (FFN_FP8 & 1) != 0, F8M = (FFN_FP8 & 2) != 0;
constexpr int EBD = F8D ? 1 : 2, EBM = F8M ? 1 : 2;
template <bool B> struct Sc { static constexpr float w_gu = B ? 32.f : 1.f, w_dn = B ? 64.f : 1.f, a_sc = B ? 4.f : 1.f, dn = 1.f / (w_dn * a_sc); };
template <bool B> using FfnEpi1 = typename std::conditional<B, pg8::EpiSwiGLU8, pg8::EpiSwiGLU>::type;
template <bool B> struct Epi1Maker;
template <> struct Epi1Maker<true> { static __device__ __forceinline__ pg8::EpiSwiGLU8 make(void* O, int ldc) { return pg8::EpiSwiGLU8{(unsigned char*)O, ldc, 1.f / Sc<true>::w_gu, Sc<true>::a_sc}; } };
template <> struct Epi1Maker<false> { static __device__ __forceinline__ pg8::EpiSwiGLU make(void* O, int ldc) { return pg8::EpiSwiGLU{(unsigned short*)O, ldc}; } };

constexpr int PH_PER_LAYER = 11, N_PHASES = 1 + 2 * PH_PER_LAYER;
#ifndef MK_N_LAUNCHES
#define MK_N_LAUNCHES 1
#endif
constexpr int N_LAUNCHES = MK_N_LAUNCHES;

__global__ void __launch_bounds__(NWAVES * 64, 2) mk_fwd(Args args) {
    extern __shared__ __attribute__((aligned(16))) unsigned char lds[];
    Frame F;
    F.lds = (LAS unsigned char*)lds;
    F.MISC = (volatile LAS unsigned*)(F.lds + MISC_OFF);
    F.tid = threadIdx.x; F.lane = F.tid & 63; F.wave = __builtin_amdgcn_readfirstlane(F.tid >> 6);
    F.G = gridDim.x; F.gw = blockIdx.x * NWAVES + F.wave; F.NGW = F.G * NWAVES;
    F.ws = args.ws; F.ctl = (gu32*)(args.ws + WS_CTL);
    unsigned char* ws = args.ws;
    for (int u = F.tid; u < (LDS_BYTES - LDSCTL_OFF) / 4; u += NWAVES * 64) ((LAS unsigned*)(F.lds + LDSCTL_OFF))[u] = 0u;
    __syncthreads();
    XcdBarrier bar; bar.bar = (unsigned*)(F.ctl + CW_BAR); bar.x = 0; bar.st = nullptr;
    if (N_LAUNCHES == 1) bar = xcd_barrier_post((unsigned*)(F.ctl + CW_BAR), F.MISC + 8);
#define GRID_BAR() do { if (N_LAUNCHES == 1) xcd_barrier(bar); } while (0)
    const int lo = args.ph_lo, hi = args.ph_hi;
#define IN(k) (lo <= (k) && (k) < hi)
#define BOTH(k) (IN(k) && IN((k) + 1))

#define x_in (args.in[0])
#define XN8 ((unsigned char*)(ws + WS_XN))
#define WIN ((bf16*)(ws + WS_WIN))
#define WUP ((bf16*)(ws + WS_WUP))
#define WMEM ((bf16*)(ws + WS_WMEM))
#define WOUT ((bf16*)(ws + WS_WOUT))
#define WGU ((bf16*)(ws + WS_WGU))
#define WDN ((bf16*)(ws + WS_WDN))
#define MGU ((bf16*)(ws + WS_MGU))
#define MDN ((bf16*)(ws + WS_MDN))
#define XN ((bf16*)(ws + WS_XN))
#define MEMN ((bf16*)(ws + WS_MEMN))
#define MEMKV ((bf16*)(ws + WS_MEMKV))
#define PROJ ((bf16*)(ws + WS_PROJ))
#define AQKV ((bf16*)(ws + WS_AQKV))
#define KROPE ((bf16*)(ws + WS_KROPE))
#define ROPECS ((float*)(ws + WS_ROPECS))
#define QKVM ((bf16*)(ws + WS_QKVM))
#define YPRE ((float*)(ws + WS_YPRE))
#define DILO ((float*)(ws + WS_DILO))
#define DILS ((float*)(ws + WS_DILS))
#define Y ((bf16*)(ws + WS_Y))
#define XA ((float*)(ws + WS_XA))
#define ROUTE ((unsigned*)(ws + WS_ROUTE))
#define XP ((bf16*)(ws + WS_XP))
#define OUTP ((bf16*)(ws + WS_OUTP))
#define ACTP ((bf16*)(ws + WS_ACTP))
#define ACT ((bf16*)(ws + WS_ACTP))
#define PHASE_BEGIN() do { int t_ = threadIdx.x; asm volatile("" : "+v"(t_)); F.tid = t_; F.lane = t_ & 63; } while (0)

    if (PEN(0) && IN(0)) { PHASE_BEGIN();
        LAS float* scr = (LAS float*)(F.lds + F.wave * 16384);
        for (int rep = 0; rep < (REPEAT_PHASE == 0 ? 2 : 1); ++rep) {
        for (int l = 0; l < 2; ++l) {
            cvt_job<false>(F, args.in[5] + (size_t)l * D * DIN, D, DIN, WIN + (size_t)l * DINP * D, D, 0, 3, 0, scr, 1.f);
            cvt_job<false>(F, args.in[7] + (size_t)l * QR * 1152, QR, 1152, WUP + (size_t)l * NUP * AQ, AQ, 0, 0, 0, scr, 1.f);
            cvt_job<false>(F, args.in[9] + (size_t)l * KVR * 1536, KVR, 1536, WUP + (size_t)l * NUP * AQ, AQ, QR, 0, UC_KV, scr, 1.f);
            cvt_job<false>(F, args.in[11] + (size_t)l * D * 1024, D, 1024, WMEM + (size_t)l * 1024 * D, D, 0, 0, 0, scr, 1.f);
            cvt_job<false>(F, args.in[13] + (size_t)l * D * D, D, D, WOUT + (size_t)l * D * D, D, 0, 0, 0, scr, 1.f);
        }
        cvt_job<F8D>(F, args.in[15], D, DFF, WGU, D, 0, 1, 0, scr, Sc<F8D>::w_gu);
        cvt_job<F8D>(F, args.in[16], D, DFF, WGU, D, 0, 2, 0, scr, Sc<F8D>::w_gu);
        cvt_job<F8D>(F, args.in[17], DFF, D, WDN, DFF, 0, 0, 0, scr, Sc<F8D>::w_dn);
        for (int e = 0; e < NE; ++e) {
            cvt_job<F8M>(F, args.in[19] + (size_t)e * D * DFE, D, DFE, (unsigned char*)MGU + (size_t)e * 2 * DFE * D * EBM, D, 0, 1, 0, scr, Sc<F8M>::w_gu);
            cvt_job<F8M>(F, args.in[20] + (size_t)e * D * DFE, D, DFE, (unsigned char*)MGU + (size_t)e * 2 * DFE * D * EBM, D, 0, 2, 0, scr, Sc<F8M>::w_gu);
            cvt_job<F8M>(F, args.in[21] + (size_t)e * DFE * D, DFE, D, (unsigned char*)MDN + (size_t)e * D * DFE * EBM, DFE, 0, 0, 0, scr, Sc<F8M>::w_dn);
        }
        }
        { const int* pos = (const int*)args.in[2];
          for (int idx = blockIdx.x * (NWAVES * 64) + F.tid; idx < S * 32; idx += F.G * NWAVES * 64) { const int row = idx >> 5, i = idx & 31;
              const float ang = (float)pos[row] * args.invf[i]; float c, s; sincos_f64(ang, c, s); ROPECS[row * 64 + i] = c; ROPECS[row * 64 + 32 + i] = s; } }
        for (int m = F.gw; m < 2 * NMEM; m += F.NGW) { const int l = m >> 8, r = m & 255; rms_row_to_bf16(args.in[1] + (size_t)r * D, args.in[10] + (size_t)l * D, MEMN + (size_t)m * D, F.lane); }
        for (int m = F.gw; m < S; m += F.NGW) rms_row_to_bf16(x_in + (size_t)m * D, args.in[4], XN + (size_t)m * D, F.lane);
        if (BOTH(0)) GRID_BAR();
    }

    for (int l = 0; l < 2; ++l) {
        const int pb = 1 + l * PH_PER_LAYER;
        if (PEN(1) && IN(pb + 0)) { PHASE_BEGIN();
            { pg8::Gemm g{XN, WIN + (size_t)l * DINP * D, 2 * D, 2 * D, D / 64}; pg8::InProjOrder So; So.so.init(S, DINP, F.G, (int)blockIdx.x); So.nextra = (l == 0) ? 8 : 0; So.A2 = MEMN; So.B2 = WMEM;
              pg8::EpiBf16Sel E{PROJ, DINP, MEMKV, 1024};
              pg8::gemm_phase<pg8::EpiBf16Sel, pg8::InProjOrder, true, true>(F.lds, g, So, E); }
            if (BOTH(pb + 0)) GRID_BAR();
        }
        if (PEN(2) && IN(pb + 1)) { PHASE_BEGIN();
            const float* gq = args.in[6] + l * QR; const float* gkv = args.in[8] + l * KVR;
            for (int m = F.gw; m < S; m += F.NGW) {
                const v4u w = *(const GAS v4u*)(PROJ + (size_t)m * DINP + F.lane * 8);
                float v[8] = {bflo(w.x), bfhi(w.x), bflo(w.y), bfhi(w.y), bflo(w.z), bfhi(w.z), bflo(w.w), bfhi(w.w)};
                float sq = 0.f;
#pragma unroll
                for (int j = 0; j < 8; ++j) sq += v[j] * v[j];
                const float sq_q = wave_sum(F.lane < 48 ? sq : 0.f), sq_kv = wave_sum(F.lane >= 48 ? sq : 0.f);
                const float rstd = F.lane < 48 ? 1.f / sqrtf(sq_q * (1.f / QR) + EPS) : 1.f / sqrtf(sq_kv * (1.f / KVR) + EPS);
                const float* gp = F.lane < 48 ? gq + F.lane * 8 : gkv + (F.lane - 48) * 8;
                const f32x4 g0 = *(const GAS f32x4*)gp, g1 = *(const GAS f32x4*)(gp + 4);
                v4u o; o.x = pk2(v[0] * rstd * g0.x, v[1] * rstd * g0.y); o.y = pk2(v[2] * rstd * g0.z, v[3] * rstd * g0.w);
                o.z = pk2(v[4] * rstd * g1.x, v[5] * rstd * g1.y); o.w = pk2(v[6] * rstd * g1.z, v[7] * rstd * g1.w);
                *(GAS v4u*)(AQKV + (size_t)m * AQ + F.lane * 8) = o;
                const int c = F.lane & 7;
                const v4u kw = *(const GAS v4u*)(PROJ + (size_t)m * DINP + 512 + c * 8);
                float kv[8] = {bflo(kw.x), bfhi(kw.x), bflo(kw.y), bfhi(kw.y), bflo(kw.z), bfhi(kw.z), bflo(kw.w), bfhi(kw.w)};
                float ko[8];
                const float* cs = ROPECS + (size_t)m * 64 + (c & 3) * 8;
#pragma unroll
                for (int j = 0; j < 8; ++j) { const float other = __shfl_xor(kv[j], 4); const float co = cs[j], si = cs[32 + j];
                    ko[j] = (c < 4) ? (kv[j] * co - other * si) : (other * si + kv[j] * co); }
                if (F.lane < 8) { v4u ow; ow.x = pk2(ko[0], ko[1]); ow.y = pk2(ko[2], ko[3]); ow.z = pk2(ko[4], ko[5]); ow.w = pk2(ko[6], ko[7]); *(GAS v4u*)(KROPE + (size_t)m * 64 + c * 8) = ow; }
            }
            if (BOTH(pb + 1)) GRID_BAR();
        }
        if (PEN(3) && IN(pb + 2)) { PHASE_BEGIN();
            pg8::Gemm g{AQKV, WUP + (size_t)l * NUP * AQ, 2 * AQ, 2 * AQ, AQ / 64}; pg8::StaticOrder So; So.init(S, NUP, F.G, (int)blockIdx.x);
            pg8::EpiBf16 E{QKVM, NUP, 1.f};
            pg8::gemm_phase<pg8::EpiBf16, pg8::StaticOrder, true, true>(F.lds, g, So, E);
            if (BOTH(pb + 2)) GRID_BAR();
        }
        if (PEN(4) && IN(pb + 3)) { PHASE_BEGIN();
            LAS float* BIAS = (LAS float*)(F.lds + BIAS_OFF);
            for (int i = F.tid; i < 3 * 6 * 129; i += NWAVES * 64) { const int b = i / (6 * 129), rem = i % (6 * 129), h = rem / 129, j = rem % 129;
                BIAS[(b * 6 + h) * 132 + j] = args.in[3][DIL_BUCKET[b][j] * 6 + h] * att::LOG2E; }
            __syncthreads();
            for (int rep = 0; rep < (REPEAT_PHASE == 4 ? 2 : 1); ++rep) {
            gu32* qhead = F.ctl + CW_QUEUE + 64 * l + 32 * rep;
            constexpr int NU_MLA = 6 * 32, NU_MEM = 4 * 32, NU_DIL = 3 * 6 * 32, NU = NU_MLA + NU_MEM + NU_DIL;
#define QPULL(u) do { if (F.tid == 0) F.MISC[16] = __hip_atomic_fetch_add(qhead, 1u, RLX_AGENT); __syncthreads(); u = (int)F.MISC[16]; __syncthreads(); } while (0)
            int u; QPULL(u);
            if (ATT_EN & 1) while (u < NU_MLA) {
                const int h = u >> 5, qb = u & 31;
                att::attn_simple_body<192, NUP, NUP, D>(QKVM + (size_t)qb * 256 * NUP + h * 192, QKVM + UC_KV + h * 256, KROPE, QKVM + UC_KV + h * 256 + 128,
                                                        ROPECS + (size_t)qb * 256 * 64, YPRE + (size_t)qb * 256 * D + h * 128, S, 0.07216878364870322f, (LAS char*)F.lds);
                QPULL(u);
            }
            if (ATT_EN & 2) while (u < NU_MLA + NU_MEM) {
                const int v = u - NU_MLA, h = v >> 5, qb = v & 31;
                const bf16* kv = MEMKV + (size_t)l * NMEM * 1024;
                att::attn_dense_body<128, DINP, 1024, D, 1>(PROJ + (size_t)qb * 256 * DINP + PC_MEM + h * 128, kv + h * 128, nullptr, kv + 512 + h * 128,
                                                            nullptr, YPRE + (size_t)qb * 256 * D + 1536 + h * 128, NMEM, 0.08838834764831845f, (LAS char*)F.lds);
                QPULL(u);
            }
            if (ATT_EN & 4) while (u < NU) {
                const int w = (u - NU_MLA - NU_MEM) * 8 + F.wave;
                const int b = w / 1536, h = (w % 1536) >> 8, tile = w & 255;
                const int d = b == 0 ? 1 : (b == 1 ? 4 : 16), nT = S / d, tpr = nT / 32;
                const int r = tile / tpr, t0 = (tile % tpr) * 32;
                att::dil_wave_unit<DINP>(PROJ, PC_DIL + h * 128, PC_DIL + 768 + h * 128, PC_DIL + 1536 + h * 128, d, r, t0, nT,
                                         DILO + (size_t)b * S * 768, h * 128, DILS + (size_t)b * S * 12 + h * 2,
                                         (LAS char*)F.lds + F.wave * 8192, BIAS + (b * 6 + h) * 132, 0.08838834764831845f * att::LOG2E, F.lane);
                QPULL(u);
            }
#undef QPULL
            }
            if (BOTH(pb + 3)) GRID_BAR();
        }
        if (PEN(5) && IN(pb + 4)) { PHASE_BEGIN();
            const float* gn = args.in[12] + (size_t)l * D;
            for (int m = F.gw; m < S; m += F.NGW) {
                const float* yr = YPRE + (size_t)m * D;
                f32x4 a[3]; float sa = 0.f;
#pragma unroll
                for (int j = 0; j < 3; ++j) { a[j] = *(const GAS f32x4*)(yr + (F.lane + 64 * j) * 4); sa += (a[j].x * a[j].x + a[j].y * a[j].y) + (a[j].z * a[j].z + a[j].w * a[j].w); }
                f32x4 c[2]; float sc = 0.f;
#pragma unroll
                for (int j = 0; j < 2; ++j) { c[j] = *(const GAS f32x4*)(yr + 1536 + (F.lane + 64 * j) * 4); sc += (c[j].x * c[j].x + c[j].y * c[j].y) + (c[j].z * c[j].z + c[j].w * c[j].w); }
                f32x4 bq[3]; float sb = 0.f;
#pragma unroll
                for (int j = 0; j < 3; ++j) { const int col = (F.lane + 64 * j) * 4, h = col >> 7;
                    float mm[3], zz[3];
#pragma unroll
                    for (int b = 0; b < 3; ++b) { const f32x2 st = *(const GAS f32x2*)(DILS + ((size_t)b * S + m) * 12 + h * 2); mm[b] = st.x; zz[b] = st.y; }
                    const float M = fmaxf(mm[0], fmaxf(mm[1], mm[2]));
                    float wgt[3], den = 0.f;
#pragma unroll
                    for (int b = 0; b < 3; ++b) { wgt[b] = __builtin_amdgcn_exp2f(mm[b] - M); den += wgt[b] * zz[b]; }
                    const float inv = 1.f / den; f32x4 acc = {0.f, 0.f, 0.f, 0.f};
#pragma unroll
                    for (int b = 0; b < 3; ++b) { const f32x4 ob = *(const GAS f32x4*)(DILO + ((size_t)b * S + m) * 768 + col); acc += ob * (wgt[b] * inv); }
                    bq[j] = acc; sb += (acc.x * acc.x + acc.y * acc.y) + (acc.z * acc.z + acc.w * acc.w); }
                const float ra = 1.f / sqrtf(wave_sum(sa) * (1.f / 768.f) + EPS), rb = 1.f / sqrtf(wave_sum(sb) * (1.f / 768.f) + EPS), rc = 1.f / sqrtf(wave_sum(sc) * (1.f / 512.f) + EPS);
                bf16* yo = Y + (size_t)m * D;
#pragma unroll
                for (int j = 0; j < 3; ++j) { const int col = (F.lane + 64 * j) * 4; const f32x4 g = *(const GAS f32x4*)(gn + col);
                    v2u w; w.x = pk2(a[j].x * ra * g.x, a[j].y * ra * g.y); w.y = pk2(a[j].z * ra * g.z, a[j].w * ra * g.w); *(GAS v2u*)(yo + col) = w; }
#pragma unroll
                for (int j = 0; j < 3; ++j) { const int col = (F.lane + 64 * j) * 4; const f32x4 g = *(const GAS f32x4*)(gn + 768 + col);
                    v2u w; w.x = pk2(bq[j].x * rb * g.x, bq[j].y * rb * g.y); w.y = pk2(bq[j].z * rb * g.z, bq[j].w * rb * g.w); *(GAS v2u*)(yo + 768 + col) = w; }
#pragma unroll
                for (int j = 0; j < 2; ++j) { const int col = (F.lane + 64 * j) * 4; const f32x4 g = *(const GAS f32x4*)(gn + 1536 + col);
                    v2u w; w.x = pk2(c[j].x * rc * g.x, c[j].y * rc * g.y); w.y = pk2(c[j].z * rc * g.z, c[j].w * rc * g.w); *(GAS v2u*)(yo + 1536 + col) = w; }
            }
            if (BOTH(pb + 4)) GRID_BAR();
        }
        if (PEN(6) && IN(pb + 5)) { PHASE_BEGIN();
            pg8::Gemm g{Y, WOUT + (size_t)l * D * D, 2 * D, 2 * D, D / 64}; pg8::StaticOrder So; So.init(S, D, F.G, (int)blockIdx.x);
            pg8::EpiResF32 E{l == 0 ? x_in : XA, XA, D, 1.f};
            pg8::gemm_phase<pg8::EpiResF32, pg8::StaticOrder, true, true>(F.lds, g, So, E);
            if (BOTH(pb + 5)) GRID_BAR();
        }
        if (PEN(7) && IN(pb + 6)) { PHASE_BEGIN();
            const float* gf = args.in[14] + (size_t)l * D;
            if (l == 0) { for (int m = F.gw; m < S; m += F.NGW) { if constexpr (F8D) rms_row_to_fp8(XA + (size_t)m * D, gf, XN8 + (size_t)m * D, F.lane); else rms_row_to_bf16(XA + (size_t)m * D, gf, XN + (size_t)m * D, F.lane); } }
            else {
                const float* Wr = args.in[18];
                for (int m = F.gw; m < S; m += F.NGW) {
                    const GAS f32x4* xr = (const GAS f32x4*)(XA + (size_t)m * D) + F.lane; const GAS f32x4* gr = (const GAS f32x4*)gf + F.lane;
                    f32x4 v[8]; float s = 0.f;
#pragma unroll
                    for (int j = 0; j < 8; ++j) { v[j] = xr[64 * j]; s += (v[j].x * v[j].x + v[j].y * v[j].y) + (v[j].z * v[j].z + v[j].w * v[j].w); }
                    const float rstd = 1.f / sqrtf(wave_sum(s) * (1.f / D) + EPS);
                    float lg[8] = {0.f, 0.f, 0.f, 0.f, 0.f, 0.f, 0.f, 0.f};
                    GAS v2u* o8 = (GAS v2u*)(XN + (size_t)m * D) + F.lane; GAS unsigned* o4 = (GAS unsigned*)(XN8 + (size_t)m * D) + F.lane;
#pragma unroll
                    for (int j = 0; j < 8; ++j) { const f32x4 gg = gr[64 * j]; const f32x4 hh = {v[j].x * rstd * gg.x, v[j].y * rstd * gg.y, v[j].z * rstd * gg.z, v[j].w * rstd * gg.w};
                        if constexpr (F8M) o4[64 * j] = pk4_fp8(hh.x, hh.y, hh.z, hh.w); else { v2u w; w.x = pk2(hh.x, hh.y); w.y = pk2(hh.z, hh.w); o8[64 * j] = w; }
                        const float* wr = Wr + (size_t)((F.lane + 64 * j) * 4) * NE;
#pragma unroll
                        for (int q = 0; q < 4; ++q) { const f32x4 w0 = *(const GAS f32x4*)(wr + q * NE), w1 = *(const GAS f32x4*)(wr + q * NE + 4); const float hv = hh[q];
                            lg[0] += hv * w0.x; lg[1] += hv * w0.y; lg[2] += hv * w0.z; lg[3] += hv * w0.w; lg[4] += hv * w1.x; lg[5] += hv * w1.y; lg[6] += hv * w1.z; lg[7] += hv * w1.w; } }
#pragma unroll
                    for (int e = 0; e < NE; ++e) lg[e] = wave_sum(lg[e]);
                    int e1 = 0; float v1 = lg[0];
#pragma unroll
                    for (int e = 1; e < NE; ++e) if (lg[e] > v1) { v1 = lg[e]; e1 = e; }
                    int e2 = -1; float v2 = -3.0e38f;
#pragma unroll
                    for (int e = 0; e < NE; ++e) if (e != e1 && lg[e] > v2) { v2 = lg[e]; e2 = e; }
                    const float g1 = 1.f / (1.f + __expf(v2 - v1)), g2 = 1.f - g1;
                    if (F.lane == 0) { const unsigned s1 = __hip_atomic_fetch_add(F.ctl + CW_CNT + e1, 1u, RLX_AGENT), s2 = __hip_atomic_fetch_add(F.ctl + CW_CNT + e2, 1u, RLX_AGENT);
                        v4u r0 = {(unsigned)e1, (unsigned)e2, s1, s2}; v4u r1 = {__float_as_uint(g1), __float_as_uint(g2), 0u, 0u};
                        *(GAS v4u*)(ROUTE + (size_t)m * 8) = r0; *(GAS v4u*)(ROUTE + (size_t)m * 8 + 4) = r1; }
                }
            }
            if (BOTH(pb + 6)) GRID_BAR();
        }
        if (PEN(8) && IN(pb + 7)) { PHASE_BEGIN();
            if (l == 1) {
                int base[NE]; int tstart = 0;
#pragma unroll
                for (int e = 0; e < NE; ++e) { const int c = (int)__hip_atomic_load(F.ctl + CW_CNT + e, RLX_AGENT); base[e] = tstart * 256; const int nt = (c + 255) >> 8;
                    if (blockIdx.x == 0 && F.tid == 0) { for (int t = 0; t < nt; ++t) F.ctl[CW_TILEE + 1 + tstart + t] = (unsigned)e; }
                    tstart += nt; }
                if (blockIdx.x == 0 && F.tid == 0) F.ctl[CW_TILEE] = (unsigned)tstart;
                for (int m = F.gw; m < S; m += F.NGW) {
                    const v4u r0 = *(const GAS v4u*)(ROUTE + (size_t)m * 8);
                    int p1 = (int)r0.z, p2 = (int)r0.w;
#pragma unroll
                    for (int e = 0; e < NE; ++e) { if ((int)r0.x == e) p1 += base[e]; if ((int)r0.y == e) p2 += base[e]; }
                    if (F.lane == 0) { ROUTE[(size_t)m * 8 + 6] = (unsigned)p1; ROUTE[(size_t)m * 8 + 7] = (unsigned)p2; }
                    const unsigned char* srow = (const unsigned char*)XN8 + (size_t)m * D * EBM; unsigned char* xp = (unsigned char*)XP;
                    const GAS v4u* src = (const GAS v4u*)srow + F.lane; GAS v4u* d1 = (GAS v4u*)(xp + (size_t)p1 * D * EBM) + F.lane; GAS v4u* d2 = (GAS v4u*)(xp + (size_t)p2 * D * EBM) + F.lane;
#pragma unroll
                    for (int j = 0; j < 2 * EBM; ++j) { const v4u t = src[64 * j]; d1[64 * j] = t; d2[64 * j] = t; }
                }
            }
            if (BOTH(pb + 7) && l == 1) GRID_BAR();
        }
        if (PEN(9) && IN(pb + 8)) { PHASE_BEGIN();
            if (l == 0) { pg8::Gemm g{XN8, WGU, D * EBD, D * EBD, D * EBD / 128}; pg8::StaticOrder So; So.init(S, 2 * DFF, F.G, (int)blockIdx.x);
                FfnEpi1<F8D> E = Epi1Maker<F8D>::make(ACT, DFF);
                pg8::gemm_phase<FfnEpi1<F8D>, pg8::StaticOrder, true, true, F8D>(F.lds, g, So, E); }
            else { const int ntile = (int)__hip_atomic_load(F.ctl + CW_TILEE, RLX_AGENT);
                pg8::Gemm g{XP, MGU, D * EBM, D * EBM, D * EBM / 128}; pg8::MoeOrder So{F.G, (int)blockIdx.x, 2 * DFE / 256, ntile, 2 * DFE, (const int*)(F.ctl + CW_TILEE + 1)};
                FfnEpi1<F8M> E = Epi1Maker<F8M>::make(ACTP, DFE);
                pg8::gemm_phase<FfnEpi1<F8M>, pg8::MoeOrder, true, true, F8M>(F.lds, g, So, E); }
            if (BOTH(pb + 8)) GRID_BAR();
        }
        if (PEN(10) && IN(pb + 9)) { PHASE_BEGIN();
            if (l == 0) { pg8::Gemm g{ACT, WDN, DFF * EBD, DFF * EBD, DFF * EBD / 128}; pg8::StaticOrder So; So.init(S, D, F.G, (int)blockIdx.x);
                pg8::EpiResF32 E{XA, XA, D, Sc<F8D>::dn};
                pg8::gemm_phase<pg8::EpiResF32, pg8::StaticOrder, true, true, F8D>(F.lds, g, So, E); }
            else { const int ntile = (int)__hip_atomic_load(F.ctl + CW_TILEE, RLX_AGENT);
                pg8::Gemm g{ACTP, MDN, DFE * EBM, DFE * EBM, DFE * EBM / 128}; pg8::MoeOrder So{F.G, (int)blockIdx.x, D / 256, ntile, D, (const int*)(F.ctl + CW_TILEE + 1)};
                pg8::EpiBf16 E{OUTP, D, Sc<F8M>::dn};
                pg8::gemm_phase<pg8::EpiBf16, pg8::MoeOrder, true, true, F8M>(F.lds, g, So, E); }
            if (BOTH(pb + 9)) GRID_BAR();
        }
        if (PEN(11) && IN(pb + 10)) { PHASE_BEGIN();
            if (l == 0) { for (int m = F.gw; m < S; m += F.NGW) rms_row_to_bf16(XA + (size_t)m * D, args.in[4] + D, XN + (size_t)m * D, F.lane); }
            else {
                const float* gfin = args.in[22];
                for (int m = F.gw; m < S; m += F.NGW) {
                    const v4u r1 = *(const GAS v4u*)(ROUTE + (size_t)m * 8 + 4);
                    const float g1 = __uint_as_float(r1.x), g2 = __uint_as_float(r1.y); const int p1 = (int)r1.z, p2 = (int)r1.w;
                    const GAS f32x4* xr = (const GAS f32x4*)(XA + (size_t)m * D) + F.lane;
                    const GAS v2u* o1 = (const GAS v2u*)(OUTP + (size_t)p1 * D) + F.lane; const GAS v2u* o2 = (const GAS v2u*)(OUTP + (size_t)p2 * D) + F.lane;
                    f32x4 v[8]; float s = 0.f;
#pragma unroll
                    for (int j = 0; j < 8; ++j) { const f32x4 xv = xr[64 * j]; const v2u a = o1[64 * j], b = o2[64 * j];
                        v[j].x = xv.x + g1 * bflo(a.x) + g2 * bflo(b.x); v[j].y = xv.y + g1 * bfhi(a.x) + g2 * bfhi(b.x);
                        v[j].z = xv.z + g1 * bflo(a.y) + g2 * bflo(b.y); v[j].w = xv.w + g1 * bfhi(a.y) + g2 * bfhi(b.y);
                        s += (v[j].x * v[j].x + v[j].y * v[j].y) + (v[j].z * v[j].z + v[j].w * v[j].w); }
                    const float rstd = 1.f / sqrtf(wave_sum(s) * (1.f / D) + EPS);
                    GAS f32x4* orow = (GAS f32x4*)(args.out + (size_t)m * D) + F.lane; const GAS f32x4* gr = (const GAS f32x4*)gfin + F.lane;
#pragma unroll
                    for (int j = 0; j < 8; ++j) { const f32x4 gg = gr[64 * j]; orow[64 * j] = (f32x4){v[j].x * rstd * gg.x, v[j].y * rstd * gg.y, v[j].z * rstd * gg.z, v[j].w * rstd * gg.w}; }
                }
            }
            if (BOTH(pb + 10) && l == 0) GRID_BAR();
        }
    }
#undef IN
#undef BOTH
#undef GRID_BAR
#undef WIN
#undef WUP
#undef WMEM
#undef WOUT
#undef WGU
#undef WDN
#undef MGU
#undef MDN
#undef XN
#undef MEMN
#undef MEMKV
#undef PROJ
#undef AQKV
#undef KROPE
#undef ROPECS
#undef QKVM
#undef YPRE
#undef DILO
#undef DILS
#undef Y
#undef XA
#undef ROUTE
#undef XP
#undef OUTP
#undef ACTP
#undef ACT
#undef x_in
#undef XN8
#undef PHASE_BEGIN
}

extern "C" void kernel_launch(void* const* d_in, const int* in_sizes, int n_in, void* d_out, int out_size, void* d_ws, size_t ws_size, hipStream_t stream) {
    static int grid = 0;
    if (grid == 0) {
        if (n_in != 23 || in_sizes[0] != S * D || out_size != S * D || ws_size < WS_END) { fprintf(stderr, "kernel_launch: shape/workspace mismatch: n_in %d in0 %d out %d ws %zu (need %zu)\n", n_in, n_in > 0 ? in_sizes[0] : -1, out_size, ws_size, (size_t)WS_END); grid = -1; return; }
        int dev = 0, cus = 0, per_cu = 0;
        if (hipGetDevice(&dev) != hipSuccess || hipDeviceGetAttribute(&cus, hipDeviceAttributeMultiprocessorCount, dev) != hipSuccess) { fprintf(stderr, "kernel_launch: device query failed\n"); grid = -1; return; }
        if (hipFuncSetAttribute((const void*)mk_fwd, hipFuncAttributeMaxDynamicSharedMemorySize, LDS_BYTES) != hipSuccess) { fprintf(stderr, "kernel_launch: hipFuncSetAttribute failed\n"); grid = -1; return; }
        if (hipOccupancyMaxActiveBlocksPerMultiprocessor(&per_cu, (const void*)mk_fwd, NWAVES * 64, LDS_BYTES) != hipSuccess || per_cu < 1) { fprintf(stderr, "kernel_launch: occupancy query reports %d workgroups per CU\n", per_cu); }
        (void)hipGetLastError();
        grid = cus;
    }
    if (grid < 0) return;
    (void)hipMemsetAsync((char*)d_ws + WS_CTL, 0, CTL_ZERO_BYTES, stream);
    (void)hipMemsetAsync((char*)d_ws + WS_WIN, 0, (size_t)2 * DINP * D * 2, stream);
    (void)hipMemsetAsync((char*)d_ws + WS_WUP, 0, (size_t)2 * NUP * AQ * 2, stream);
    Args a{};
    for (int i = 0; i < 23; ++i) a.in[i] = (const float*)d_in[i];
    a.out = (float*)d_out; a.ws = (unsigned char*)d_ws;
    for (int i = 0; i < 32; ++i) a.invf[i] = 1.0f / powf(10000.0f, (float)i / 32.0f);
    for (int li = 0; li < N_LAUNCHES; ++li) {
        a.ph_lo = (N_LAUNCHES == 1) ? 0 : li; a.ph_hi = (N_LAUNCHES == 1) ? N_PHASES : li + 1; a.li = li; a.pad = 0;
        hipLaunchKernelGGL(mk_fwd, dim3(grid), dim3(NWAVES * 64), LDS_BYTES, stream, a);
        const hipError_t le = hipPeekAtLastError();
        if (le != hipSuccess) { fprintf(stderr, "kernel_launch: launch %d failed: %s\n", li, hipGetErrorName(le)); break; }
    }
}
```

```cpp
#include <hip/hip_runtime.h>
#include <cstdio>
#include <cstdint>
#include <cmath>
#include <type_traits>
#ifndef MK_N_LAUNCHES
#define MK_N_LAUNCHES 1
#endif
#define REPEAT_PHASE -1
#define FFN_FP8 3
namespace pg8 {
#define PG8_LAS __attribute__((address_space(3)))
typedef unsigned short bf16_t;
typedef short bf16x8 __attribute__((ext_vector_type(8)));
typedef float f32x4 __attribute__((ext_vector_type(4)));
typedef unsigned u32x4 __attribute__((ext_vector_type(4)));
constexpr int BM = 256, BK = 64, HALF = 128, HTB = HALF * BK * 2  , STAGE_BYTES = 8 * HTB, NXCD = 8, WGM = 8;

__host__ __device__ __forceinline__ int lds_byte(int r, int c) { const int st = (r >> 4) * 2 + (c >> 5), rr = r & 15, cc = c & 31, ob = rr * 64 + cc * 2; return st * 1024 + (ob ^ (((ob >> 9) & 1) << 5)); }
__host__ __device__ __forceinline__ void stage_rc(int b, int& R, int& C) { const int st = b / 1024, sb = b % 1024, swz = sb ^ (((sb >> 9) & 1) << 5); R = (st >> 1) * 16 + swz / 64; C = (st & 1) * 32 + (swz % 64) / 2; }
__host__ __device__ __forceinline__ int perm32(int rho) { const int n = rho >> 4, i = rho & 15; return 8 * (i >> 2) + 4 * n + (i & 3); }

struct Unit { int pm, pn; };
struct Gemm { const void* A; const void* Bt; int lda, ldb, nt; };

struct StaticOrder {
    int nM, nN, nwg, G, c;
    __device__ void init(int M, int N, int G_, int c_) { nM = M / BM; nN = N / BM; nwg = nM * nN; G = G_; c = c_; }
    __device__ bool next(int i, Unit& u) const {
        const long L = (long)i * G + c; if (L >= nwg) return false;
        int wgid = (int)L; { const int q = nwg / NXCD, r = nwg % NXCD, xcd = wgid % NXCD, off = wgid / NXCD; wgid = (xcd < r ? xcd * (q + 1) : r * (q + 1) + (xcd - r) * q) + off; }
        const int nig = WGM * nN, gid = wgid / nig, fm = gid * WGM, gsz = (nM - fm) < WGM ? (nM - fm) : WGM;
        u.pm = fm + ((wgid % nig) % gsz); u.pn = (wgid % nig) / gsz; return true;
    }
    __device__ __forceinline__ const char* abase(const Gemm& g, const Unit& u) const { return (const char*)g.A + (size_t)u.pm * BM * g.lda; }
    __device__ __forceinline__ const char* bbase(const Gemm& g, const Unit& u) const { return (const char*)g.Bt + (size_t)u.pn * BM * g.ldb; }
};
struct InProjOrder {
    StaticOrder so; int nextra; const void* A2; const void* B2;
    __device__ bool next(int i, Unit& u) const { if (so.next(i, u)) return true; const long L = (long)i * so.G + so.c - so.nwg; if (L < 0 || L >= nextra) return false; u.pm = 32 + (int)(L >> 2); u.pn = (int)(L & 3); return true; }
    __device__ __forceinline__ const char* abase(const Gemm& g, const Unit& u) const { return u.pm < 32 ? (const char*)g.A + (size_t)u.pm * BM * g.lda : (const char*)A2 + (size_t)(u.pm - 32) * BM * g.lda; }
    __device__ __forceinline__ const char* bbase(const Gemm& g, const Unit& u) const { return u.pm < 32 ? (const char*)g.Bt + (size_t)u.pn * BM * g.ldb : (const char*)B2 + (size_t)((u.pm - 32) * 1024 + u.pn * BM) * g.ldb; }
};
struct MemOrder {
    int G, c;
    __device__ bool next(int i, Unit& u) const { const int L = c - (G - 8); if (i != 0 || L < 0 || L >= 8) return false; u.pm = L >> 2; u.pn = L & 3; return true; }
    __device__ __forceinline__ const char* abase(const Gemm& g, const Unit& u) const { return (const char*)g.A + (size_t)u.pm * BM * g.lda; }
    __device__ __forceinline__ const char* bbase(const Gemm& g, const Unit& u) const { return (const char*)g.Bt + (size_t)(u.pm * 1024 + u.pn * BM) * g.ldb; }
};
struct MoeOrder {
    int G, c, nN, ntile, nexp_rows; const int* tile_e;
    __device__ bool next(int i, Unit& u) const { const long L = (long)i * G + c; if (L >= (long)ntile * nN) return false; u.pm = (int)(L / nN); u.pn = (int)(L % nN); return true; }
    __device__ __forceinline__ const char* abase(const Gemm& g, const Unit& u) const { return (const char*)g.A + (size_t)u.pm * BM * g.lda; }
    __device__ __forceinline__ const char* bbase(const Gemm& g, const Unit& u) const { const int e = __builtin_amdgcn_readfirstlane(tile_e[u.pm]); return (const char*)g.Bt + ((size_t)e * nexp_rows + (size_t)u.pn * BM) * g.ldb; }
};

__device__ __forceinline__ unsigned cvt_pk_bf16(float lo, float hi) { unsigned r; asm volatile("v_cvt_pk_bf16_f32 %0, %1, %2" : "=v"(r) : "v"(lo), "v"(hi)); return r; }

struct EpiBf16 {
    static constexpr bool PERM = true;
    bf16_t* O; int ldc; float sc;
    __device__ __forceinline__ void operator()(const f32x4 (&acc)[2][2][4][2], const Unit& u, int wr, int wc, int fr, int fq) const {
        const int row0 = u.pm * BM + wr * 64 + fr, col0 = u.pn * BM + wc * 32 + 8 * fq;
#pragma unroll
        for (int ai = 0; ai < 2; ++ai)
#pragma unroll
            for (int m = 0; m < 4; ++m) { bf16_t* rowp = O + (size_t)(row0 + ai * HALF + m * 16) * ldc + col0;
#pragma unroll
                for (int bj = 0; bj < 2; ++bj) { const f32x4 v0 = acc[ai][bj][m][0] * sc, v1 = acc[ai][bj][m][1] * sc;
                    u32x4 w; w.x = cvt_pk_bf16(v0[0], v0[1]); w.y = cvt_pk_bf16(v0[2], v0[3]); w.z = cvt_pk_bf16(v1[0], v1[1]); w.w = cvt_pk_bf16(v1[2], v1[3]);
                    *(u32x4*)(rowp + bj * HALF) = w; } }
    }
};
struct EpiBf16Sel {
    static constexpr bool PERM = true;
    bf16_t* O; int ldc; bf16_t* O2; int ldc2;
    __device__ __forceinline__ void operator()(const f32x4 (&acc)[2][2][4][2], const Unit& u, int wr, int wc, int fr, int fq) const {
        const bool ex = u.pm >= 32; bf16_t* base = ex ? O2 : O; const int ld = ex ? ldc2 : ldc;
        const int row0 = (ex ? u.pm - 32 : u.pm) * BM + wr * 64 + fr, col0 = u.pn * BM + wc * 32 + 8 * fq;
#pragma unroll
        for (int ai = 0; ai < 2; ++ai)
#pragma unroll
            for (int m = 0; m < 4; ++m) { bf16_t* rowp = base + (size_t)(row0 + ai * HALF + m * 16) * ld + col0;
#pragma unroll
                for (int bj = 0; bj < 2; ++bj) { const f32x4 v0 = acc[ai][bj][m][0], v1 = acc[ai][bj][m][1];
                    u32x4 w; w.x = cvt_pk_bf16(v0[0], v0[1]); w.y = cvt_pk_bf16(v0[2], v0[3]); w.z = cvt_pk_bf16(v1[0], v1[1]); w.w = cvt_pk_bf16(v1[2], v1[3]);
                    *(u32x4*)(rowp + bj * HALF) = w; } }
    }
};
struct EpiResF32 {
    static constexpr bool PERM = false;
    const float* R; float* C; int ldc; float sc;
    __device__ __forceinline__ void operator()(const f32x4 (&acc)[2][2][4][2], const Unit& u, int wr, int wc, int fr, int fq) const {
        const int row0 = u.pm * BM + wr * 64 + fr, col0 = u.pn * BM + wc * 32 + 4 * fq;
#pragma unroll
        for (int ai = 0; ai < 2; ++ai)
#pragma unroll
            for (int m = 0; m < 4; ++m) { const size_t off = (size_t)(row0 + ai * HALF + m * 16) * ldc + col0;
#pragma unroll
                for (int bj = 0; bj < 2; ++bj)
#pragma unroll
                    for (int n = 0; n < 2; ++n) { const f32x4 r = *(const f32x4*)(R + off + bj * HALF + n * 16); *(f32x4*)(C + off + bj * HALF + n * 16) = r + acc[ai][bj][m][n] * sc; } }
    }
};
__device__ __forceinline__ float silu_mul(float g, float u) { return g * u * __builtin_amdgcn_rcpf(1.0f + __builtin_amdgcn_exp2f(-1.4426950408889634f * g)); }
struct EpiSwiGLU {
    static constexpr bool PERM = true;
    bf16_t* O; int ldc;
    __device__ __forceinline__ void operator()(const f32x4 (&acc)[2][2][4][2], const Unit& u, int wr, int wc, int fr, int fq) const {
        const int row0 = u.pm * BM + wr * 64 + fr, col0 = u.pn * HALF + wc * 32 + 8 * fq;
#pragma unroll
        for (int ai = 0; ai < 2; ++ai)
#pragma unroll
            for (int m = 0; m < 4; ++m) { bf16_t* rowp = O + (size_t)(row0 + ai * HALF + m * 16) * ldc + col0;
                const f32x4 g0 = acc[ai][0][m][0], g1 = acc[ai][0][m][1], u0 = acc[ai][1][m][0], u1 = acc[ai][1][m][1];
                u32x4 w; w.x = cvt_pk_bf16(silu_mul(g0[0], u0[0]), silu_mul(g0[1], u0[1])); w.y = cvt_pk_bf16(silu_mul(g0[2], u0[2]), silu_mul(g0[3], u0[3]));
                w.z = cvt_pk_bf16(silu_mul(g1[0], u1[0]), silu_mul(g1[1], u1[1])); w.w = cvt_pk_bf16(silu_mul(g1[2], u1[2]), silu_mul(g1[3], u1[3]));
                *(u32x4*)rowp = w; }
    }
};

typedef int v8i_t __attribute__((ext_vector_type(8)));
__device__ __forceinline__ v8i_t pg8_cat(bf16x8 lo, bf16x8 hi) { typedef int v4i_t __attribute__((ext_vector_type(4))); const v4i_t a = __builtin_bit_cast(v4i_t, lo), b = __builtin_bit_cast(v4i_t, hi); return (v8i_t){a.x, a.y, a.z, a.w, b.x, b.y, b.z, b.w}; }
struct EpiSwiGLU8 {
    static constexpr bool PERM = true;
    unsigned char* O; int ldc; float sc_in, sc_out;
    __device__ __forceinline__ void operator()(const f32x4 (&acc)[2][2][4][2], const Unit& u, int wr, int wc, int fr, int fq) const {
        const int row0 = u.pm * BM + wr * 64 + fr, col0 = u.pn * HALF + wc * 32 + 8 * fq;
#pragma unroll
        for (int ai = 0; ai < 2; ++ai)
#pragma unroll
            for (int m = 0; m < 4; ++m) { unsigned char* rowp = O + (size_t)(row0 + ai * HALF + m * 16) * ldc + col0;
                const f32x4 g0 = acc[ai][0][m][0] * sc_in, g1 = acc[ai][0][m][1] * sc_in, u0 = acc[ai][1][m][0] * (sc_in * sc_out), u1 = acc[ai][1][m][1] * (sc_in * sc_out);
                int w0 = 0, w1 = 0;
                w0 = __builtin_amdgcn_cvt_pk_fp8_f32(silu_mul(g0[0], u0[0]), silu_mul(g0[1], u0[1]), w0, false); w0 = __builtin_amdgcn_cvt_pk_fp8_f32(silu_mul(g0[2], u0[2]), silu_mul(g0[3], u0[3]), w0, true);
                w1 = __builtin_amdgcn_cvt_pk_fp8_f32(silu_mul(g1[0], u1[0]), silu_mul(g1[1], u1[1]), w1, false); w1 = __builtin_amdgcn_cvt_pk_fp8_f32(silu_mul(g1[2], u1[2]), silu_mul(g1[3], u1[3]), w1, true);
                typedef int v2i_t __attribute__((ext_vector_type(2))); *(v2i_t*)rowp = (v2i_t){w0, w1}; }
    }
};
__device__ __forceinline__ void pg8_mfma8(f32x4& c, v8i_t a, v8i_t b, int sc) { asm volatile("v_mfma_scale_f32_16x16x128_f8f6f4 %0, %1, %2, %0, %3, %3 op_sel_hi:[0,0,0]" : "+v"(c) : "v"(a), "v"(b), "v"(sc)); }
template <class Epi, class Sched, bool ALIGN_EPI = false, bool SP2 = false, bool FP8 = false>
__device__ __forceinline__ void gemm_phase(PG8_LAS unsigned char* lds, const Gemm g, const Sched& S, const Epi& E) {
    int tid_ = threadIdx.x; asm volatile("" : "+v"(tid_));
    const int tid = tid_, wid = __builtin_amdgcn_readfirstlane(tid >> 6), lane = tid & 63, wr = wid >> 2, wc = wid & 3, fr = lane & 15, fq = lane >> 4;
    const int nt = g.nt;
    unsigned voffA[2], voffB[2];
#pragma unroll
    for (int i = 0; i < 2; ++i) { int R, C; stage_rc(tid * 16 + i * 8192, R, C); const int Rb = Epi::PERM ? ((R & ~31) + perm32(R & 31)) : R;
        voffA[i] = (unsigned)(R * g.lda + C * 2); voffB[i] = (unsigned)(Rb * g.ldb + C * 2); }
    const size_t kstep = (size_t)(BK * 2);
    const size_t hstepA = (size_t)HALF * g.lda, hstepB = (size_t)HALF * g.ldb;
    const unsigned ldsw = (unsigned)wid * 1024u;
    const int aoff = lds_byte(wr * 64 + fr, fq * 8), boff = lds_byte(wc * 32 + fr, fq * 8);
#define PG8_SA(b, h) (((b) * 2 + (h)) * HTB)
#define PG8_SB(b, h) ((4 + (b) * 2 + (h)) * HTB)
#define PG8_STAGE(bufoff, gbase, voff) do { _Pragma("unroll") for (int _i = 0; _i < 2; ++_i) \
        __builtin_amdgcn_global_load_lds((const unsigned*)((const char*)(gbase) + (voff)[_i]), (PG8_LAS unsigned*)(lds + (bufoff) + ldsw + _i * 8192), 16, 0, 0); } while (0)
#define PG8_LDA(dst, b, h) do { _Pragma("unroll") for (int m = 0; m < 4; ++m) _Pragma("unroll") for (int k = 0; k < 2; ++k) dst[m][k] = *(const PG8_LAS bf16x8*)(lds + PG8_SA(b, h) + aoff + m * 2048 + k * 1024); } while (0)
#define PG8_LDB(dst, b, h) do { _Pragma("unroll") for (int n = 0; n < 2; ++n) _Pragma("unroll") for (int k = 0; k < 2; ++k) dst[n][k] = *(const PG8_LAS bf16x8*)(lds + PG8_SB(b, h) + boff + n * 2048 + k * 1024); } while (0)
#define PG8_MMA(ai, bj, At, Bt) do { __builtin_amdgcn_s_setprio(1); if constexpr (FP8) { _Pragma("unroll") for (int m = 0; m < 4; ++m) _Pragma("unroll") for (int n = 0; n < 2; ++n) \
        pg8_mfma8(acc[ai][bj][m][n], pg8_cat(Bt[n][0], Bt[n][1]), pg8_cat(At[m][0], At[m][1]), sc8); } else { \
        _Pragma("unroll") for (int m = 0; m < 4; ++m) _Pragma("unroll") for (int n = 0; n < 2; ++n) _Pragma("unroll") for (int k = 0; k < 2; ++k) \
        acc[ai][bj][m][n] = __builtin_amdgcn_mfma_f32_16x16x32_bf16(Bt[n][k], At[m][k], acc[ai][bj][m][n], 0, 0, 0); } __builtin_amdgcn_s_setprio(0); } while (0)
#define PG8_WAIT_V(n) asm volatile("s_waitcnt vmcnt(" #n ")" ::: "memory")
#define PG8_WAIT_L(n) asm volatile("s_waitcnt lgkmcnt(" #n ")" ::: "memory")
#define PG8_BAR __builtin_amdgcn_s_barrier()
#define PG8_SCHED __builtin_amdgcn_sched_barrier(0)
    Unit cur, nxt; int ui = 0;
    if (!S.next(0, cur)) return;
    int sc8 = 0x7F7F7F7F; asm volatile("" : "+v"(sc8));
    f32x4 acc[2][2][4][2];
#pragma unroll
    for (int a = 0; a < 2; ++a)
#pragma unroll
        for (int b = 0; b < 2; ++b)
#pragma unroll
            for (int m = 0; m < 4; ++m)
#pragma unroll
                for (int n = 0; n < 2; ++n) acc[a][b][m][n] = (f32x4){0.f, 0.f, 0.f, 0.f};
    bf16x8 At[4][2], B0[2][2], B1[2][2];
    const char* cA = S.abase(g, cur); const char* cB = S.bbase(g, cur);
    if constexpr (SP2) {
        PG8_STAGE(PG8_SB(0, 0), cB, voffB); PG8_STAGE(PG8_SB(0, 1), cB + hstepB, voffB); PG8_STAGE(PG8_SA(0, 0), cA, voffA); PG8_STAGE(PG8_SA(0, 1), cA + hstepA, voffA);
        if (wr == 1) PG8_BAR;
        PG8_WAIT_V(2); PG8_BAR;
        PG8_STAGE(PG8_SB(1, 0), cB + kstep, voffB); PG8_STAGE(PG8_SA(1, 0), cA + kstep, voffA); PG8_STAGE(PG8_SB(1, 1), cB + hstepB + kstep, voffB);
        PG8_WAIT_V(6); PG8_BAR;
    } else {
        PG8_STAGE(PG8_SB(0, 0), cB, voffB); PG8_STAGE(PG8_SA(0, 0), cA, voffA); PG8_STAGE(PG8_SB(0, 1), cB + hstepB, voffB); PG8_STAGE(PG8_SA(0, 1), cA + hstepA, voffA);
        if (wr == 1) PG8_BAR;
        PG8_WAIT_V(4); PG8_BAR;
        PG8_STAGE(PG8_SB(1, 0), cB + kstep, voffB); PG8_STAGE(PG8_SA(1, 0), cA + kstep, voffA); PG8_STAGE(PG8_SB(1, 1), cB + hstepB + kstep, voffB);
        PG8_WAIT_V(6); PG8_BAR;
    }
    for (;;) {
        const bool has_next = S.next(ui + 1, nxt);
        const char* nA = has_next ? S.abase(g, nxt) : cA; const char* nB = has_next ? S.bbase(g, nxt) : cB;
        for (int t = 0; t < nt; t += 2) {
            const bool last = (t == nt - 2);
            const char* a1 = cA + (size_t)(t + 1) * kstep;
            const char* a2 = last ? nA : cA + (size_t)(t + 2) * kstep; const char* b2 = last ? nB : cB + (size_t)(t + 2) * kstep;
            const char* a3 = a2 + kstep; const char* b3 = b2 + kstep;
            if constexpr (SP2) {
            PG8_LDB(B0, 0, 0); PG8_LDB(B1, 0, 1); PG8_SCHED; PG8_LDA(At, 0, 0); PG8_STAGE(PG8_SA(1, 1), a1 + hstepA, voffA);
            PG8_WAIT_V(8); PG8_WAIT_L(0); PG8_BAR; PG8_MMA(0, 0, At, B0); PG8_MMA(0, 1, At, B1); PG8_BAR; PG8_SCHED;
            PG8_LDA(At, 0, 1); PG8_STAGE(PG8_SB(0, 0), b2, voffB); PG8_STAGE(PG8_SB(0, 1), b2 + hstepB, voffB); PG8_STAGE(PG8_SA(0, 0), a2, voffA);
            PG8_WAIT_V(8); PG8_WAIT_L(0); PG8_BAR; PG8_MMA(1, 0, At, B0); PG8_MMA(1, 1, At, B1); PG8_BAR; PG8_SCHED;
            PG8_LDB(B0, 1, 0); PG8_LDB(B1, 1, 1); PG8_SCHED; PG8_LDA(At, 1, 0); PG8_STAGE(PG8_SA(0, 1), a2 + hstepA, voffA);
            PG8_WAIT_V(8); PG8_WAIT_L(0); PG8_BAR; PG8_MMA(0, 0, At, B0); PG8_MMA(0, 1, At, B1); PG8_BAR; PG8_SCHED;
            PG8_LDA(At, 1, 1); PG8_STAGE(PG8_SB(1, 0), b3, voffB); PG8_STAGE(PG8_SB(1, 1), b3 + hstepB, voffB); PG8_STAGE(PG8_SA(1, 0), a3, voffA);
            PG8_WAIT_V(8); PG8_WAIT_L(0); PG8_BAR; PG8_MMA(1, 0, At, B0); PG8_MMA(1, 1, At, B1); PG8_BAR; PG8_SCHED;
            } else {
            PG8_LDB(B0, 0, 0); PG8_SCHED; PG8_LDA(At, 0, 0); PG8_STAGE(PG8_SA(1, 1), a1 + hstepA, voffA);
            PG8_WAIT_L(8); PG8_BAR; PG8_WAIT_L(0); PG8_MMA(0, 0, At, B0); PG8_BAR; PG8_SCHED;
            PG8_LDB(B1, 0, 1); PG8_STAGE(PG8_SB(0, 0), b2, voffB);
            PG8_BAR; PG8_WAIT_L(0); PG8_MMA(0, 1, At, B1); PG8_BAR;
            PG8_LDA(At, 0, 1); PG8_STAGE(PG8_SA(0, 0), a2, voffA);
            PG8_BAR; PG8_WAIT_L(0); PG8_MMA(1, 0, At, B0); PG8_BAR; PG8_SCHED;
            PG8_STAGE(PG8_SB(0, 1), b2 + hstepB, voffB);
            PG8_WAIT_V(6); PG8_BAR; PG8_MMA(1, 1, At, B1); PG8_BAR;
            PG8_LDB(B0, 1, 0); PG8_SCHED; PG8_LDA(At, 1, 0); PG8_STAGE(PG8_SA(0, 1), a2 + hstepA, voffA);
            PG8_WAIT_L(8); PG8_BAR; PG8_WAIT_L(0); PG8_MMA(0, 0, At, B0); PG8_BAR; PG8_SCHED;
            PG8_LDB(B1, 1, 1); PG8_STAGE(PG8_SB(1, 0), b3, voffB);
            PG8_BAR; PG8_WAIT_L(0); PG8_MMA(0, 1, At, B1); PG8_BAR;
            PG8_LDA(At, 1, 1); PG8_STAGE(PG8_SA(1, 0), a3, voffA);
            PG8_BAR; PG8_WAIT_L(0); PG8_MMA(1, 0, At, B0); PG8_BAR; PG8_SCHED;
            PG8_STAGE(PG8_SB(1, 1), b3 + hstepB, voffB);
            PG8_WAIT_V(6); PG8_BAR; PG8_MMA(1, 1, At, B1); PG8_BAR;
            }
        }
        if constexpr (ALIGN_EPI) { if (wr == 0) PG8_BAR; }
        if constexpr (FP8) { PG8_SCHED; asm volatile("s_nop 15\n\ts_nop 7" ::: "memory"); PG8_SCHED; }
        E(acc, cur, wr, wc, fr, fq);
        if (!has_next) break;
#pragma unroll
        for (int a = 0; a < 2; ++a)
#pragma unroll
            for (int b = 0; b < 2; ++b)
#pragma unroll
                for (int m = 0; m < 4; ++m)
#pragma unroll
                    for (int n = 0; n < 2; ++n) acc[a][b][m][n] = (f32x4){0.f, 0.f, 0.f, 0.f};
        cur = nxt; cA = nA; cB = nB; ++ui;
        if constexpr (ALIGN_EPI) { if (wr == 1) PG8_BAR; }
    }
    PG8_WAIT_V(0);
    if constexpr (!ALIGN_EPI) { if (wr == 0) PG8_BAR; }
    PG8_BAR;
#undef PG8_SA
#undef PG8_SB
#undef PG8_STAGE
#undef PG8_LDA
#undef PG8_LDB
#undef PG8_MMA
#undef PG8_WAIT_V
#undef PG8_WAIT_L
#undef PG8_BAR
#undef PG8_SCHED
}
}
namespace att {
#define ATT_LAS __attribute__((address_space(3)))
#define ATT_GAS __attribute__((address_space(1)))
typedef unsigned short bf16;
using bf16x8 = __attribute__((ext_vector_type(8))) short;
using s16x4  = __attribute__((ext_vector_type(4))) short;
using f32x16 = __attribute__((ext_vector_type(16))) float;
using f32x4  = __attribute__((ext_vector_type(4))) float;
using u32x4  = __attribute__((ext_vector_type(4))) unsigned;
constexpr int NW = 8, QBLK = 32, KVBLK = 64, DV = 128;
constexpr float LOG2E = 1.4426950408889634f;
#define SBAR() __builtin_amdgcn_sched_barrier(0)
__device__ __forceinline__ int crow(int r, int hi) { return (r & 3) + 8 * (r >> 2) + 4 * hi; }
__device__ __forceinline__ unsigned cvtpk(float lo, float hi) { unsigned r; asm volatile("v_cvt_pk_bf16_f32 %0, %1, %2" : "=v"(r) : "v"(lo), "v"(hi)); return r; }
__device__ __forceinline__ float bf2f(short s) { return __uint_as_float(((unsigned)(unsigned short)s) << 16); }

__device__ __forceinline__ void partialSM(f32x16& p0, f32x16& p1, float& m_reg, float& mn, float& alpha, const float C, const float THRS) {
  float pmax = p0[0];
#pragma unroll
  for (int r = 1; r < 16; ++r) pmax = fmaxf(pmax, p0[r]);
#pragma unroll
  for (int r = 0; r < 16; ++r) pmax = fmaxf(pmax, p1[r]);
  { auto rr = __builtin_amdgcn_permlane32_swap(__float_as_uint(pmax), __float_as_uint(pmax), false, false);
    pmax = fmaxf(__uint_as_float(rr[0]), __uint_as_float(rr[1])); }
  if (__builtin_expect(__all(pmax - m_reg <= THRS), 1)) { mn = m_reg; alpha = 1.f; }
  else { mn = fmaxf(m_reg, pmax); alpha = __builtin_amdgcn_exp2f((m_reg - mn) * C); m_reg = mn; }
  float mnC = -mn * C;
#pragma unroll
  for (int r = 0; r < 16; ++r) p0[r] = fmaf(p0[r], C, mnC);
#pragma unroll
  for (int r = 0; r < 16; ++r) p1[r] = fmaf(p1[r], C, mnC);
#pragma unroll
  for (int r = 0; r < 16; ++r) p0[r] = __builtin_amdgcn_exp2f(p0[r]);
}
#define ATT_PK4(P, BASE, OUT) do { unsigned a0 = cvtpk(P[BASE + 0], P[BASE + 1]), a1 = cvtpk(P[BASE + 2], P[BASE + 3]);   \
    unsigned b0 = cvtpk(P[BASE + 4], P[BASE + 5]), b1 = cvtpk(P[BASE + 6], P[BASE + 7]);                              \
    auto r0 = __builtin_amdgcn_permlane32_swap(a0, b0, false, false); auto r1 = __builtin_amdgcn_permlane32_swap(a1, b1, false, false); \
    u32x4 w = {r0[0], r1[0], r0[1], r1[1]}; OUT = *reinterpret_cast<bf16x8*>(&w); } while (0)
__device__ __forceinline__ void finishSM(f32x16& p0, f32x16& p1, float alpha, float& l_reg, bf16x8& pa0, bf16x8& pa1, bf16x8& pa2, bf16x8& pa3) {
#pragma unroll
  for (int r = 0; r < 16; ++r) p1[r] = __builtin_amdgcn_exp2f(p1[r]);
  float ps = 0;
#pragma unroll
  for (int r = 0; r < 16; ++r) ps += p0[r];
#pragma unroll
  for (int r = 0; r < 16; ++r) ps += p1[r];
  { auto rr = __builtin_amdgcn_permlane32_swap(__float_as_uint(ps), __float_as_uint(ps), false, false);
    ps = __uint_as_float(rr[0]) + __uint_as_float(rr[1]); }
  l_reg = l_reg * alpha + ps;
  ATT_PK4(p0, 0, pa0); ATT_PK4(p0, 8, pa1); ATT_PK4(p1, 0, pa2); ATT_PK4(p1, 8, pa3);
}
template <int RB> __device__ __forceinline__ int kswz(int row, int colB) { return row * RB + (colB ^ ((row & 7) << 4)); }
template <int DQK> __device__ __forceinline__ void qkt(f32x16& p0, f32x16& p1, const ATT_LAS char* Ks, const bf16x8 (&qr)[DQK / 16], int r32, int hi) {
  p0 = f32x16{}; p1 = f32x16{};
#pragma unroll
  for (int d0 = 0; d0 < DQK / 16; ++d0) { const int cb = (d0 * 16 + hi * 8) * 2;
    bf16x8 b0 = *reinterpret_cast<const ATT_LAS bf16x8*>(Ks + kswz<DQK * 2>(r32, cb));
    bf16x8 b1 = *reinterpret_cast<const ATT_LAS bf16x8*>(Ks + kswz<DQK * 2>(32 + r32, cb));
    p0 = __builtin_amdgcn_mfma_f32_32x32x16_bf16(b0, qr[d0], p0, 0, 0, 0);
    p1 = __builtin_amdgcn_mfma_f32_32x32x16_bf16(b1, qr[d0], p1, 0, 0, 0); }
}
__device__ __forceinline__ int v_st(int k, int c) { const int kk = (k & ~0xC) | ((k & 4) << 1) | ((k & 8) >> 1); return ((kk >> 3) * 4 + (c >> 5)) * 512 + ((kk & 7) * 32 + (c & 31)) * 2; }
__device__ __forceinline__ int v_rd_base(int lane) { return ((lane & 3) << 3) | (((lane >> 2) & 3) << 6) | (((lane >> 4) & 1) << 5) | (((lane >> 5) & 1) << 8); }
constexpr int v_rd_off(int d0, int ks, int half) { return d0 * 512 + ks * 4096 + half * 2048; }
template <int OFF> __device__ __forceinline__ s16x4 tr_read(int vb) {
  s16x4 r; asm volatile("ds_read_b64_tr_b16 %0, %1 offset:%2" : "=&v"(r) : "v"(vb), "i"(OFF) : "memory"); return r;
}
#define ATT_PK(L, H) (bf16x8){L[0], L[1], L[2], L[3], H[0], H[1], H[2], H[3]}
template <int D0> __device__ __forceinline__ void pv_one(f32x16& od, int vb, bf16x8 pa0, bf16x8 pa1, bf16x8 pa2, bf16x8 pa3) {
  const s16x4 l0 = tr_read<v_rd_off(D0, 0, 0)>(vb), h0 = tr_read<v_rd_off(D0, 0, 1)>(vb), l1 = tr_read<v_rd_off(D0, 1, 0)>(vb), h1 = tr_read<v_rd_off(D0, 1, 1)>(vb);
  const s16x4 l2 = tr_read<v_rd_off(D0, 2, 0)>(vb), h2 = tr_read<v_rd_off(D0, 2, 1)>(vb), l3 = tr_read<v_rd_off(D0, 3, 0)>(vb), h3 = tr_read<v_rd_off(D0, 3, 1)>(vb);
  asm volatile("s_waitcnt lgkmcnt(0)" ::: "memory"); SBAR();
  od = __builtin_amdgcn_mfma_f32_32x32x16_bf16(pa0, ATT_PK(l0, h0), od, 0, 0, 0);
  od = __builtin_amdgcn_mfma_f32_32x32x16_bf16(pa1, ATT_PK(l1, h1), od, 0, 0, 0);
  od = __builtin_amdgcn_mfma_f32_32x32x16_bf16(pa2, ATT_PK(l2, h2), od, 0, 0, 0);
  od = __builtin_amdgcn_mfma_f32_32x32x16_bf16(pa3, ATT_PK(l3, h3), od, 0, 0, 0);
}
__device__ __forceinline__ void pv_d0(f32x16 (&o)[4], int vb, bf16x8 pa0, bf16x8 pa1, bf16x8 pa2, bf16x8 pa3) {
  pv_one<0>(o[0], vb, pa0, pa1, pa2, pa3); pv_one<1>(o[1], vb, pa0, pa1, pa2, pa3); pv_one<2>(o[2], vb, pa0, pa1, pa2, pa3); pv_one<3>(o[3], vb, pa0, pa1, pa2, pa3);
}
template <int D0> __device__ __forceinline__ void pv32_one(f32x16& od, int vb, bf16x8 pa0, bf16x8 pa1) {
  const s16x4 l0 = tr_read<v_rd_off(D0, 0, 0)>(vb), h0 = tr_read<v_rd_off(D0, 0, 1)>(vb), l1 = tr_read<v_rd_off(D0, 1, 0)>(vb), h1 = tr_read<v_rd_off(D0, 1, 1)>(vb);
  asm volatile("s_waitcnt lgkmcnt(0)" ::: "memory"); SBAR();
  od = __builtin_amdgcn_mfma_f32_32x32x16_bf16(pa0, ATT_PK(l0, h0), od, 0, 0, 0);
  od = __builtin_amdgcn_mfma_f32_32x32x16_bf16(pa1, ATT_PK(l1, h1), od, 0, 0, 0);
}

template <int DQK, int LDQ, int LDK, int LDO, int SDEPTH>
__device__ __forceinline__ void attn_dense_body(const bf16* __restrict__ Qb, const bf16* __restrict__ Kh, const bf16* __restrict__ Kr, const bf16* __restrict__ Vh,
                                                const float* __restrict__ cs_rows, float* __restrict__ Ob, int seq, const float scale, ATT_LAS char* lds) {
  constexpr int SHM_V = KVBLK * DV * 2, SHM_K = KVBLK * DQK * 2, RB = DQK * 2, NQ = DQK / 16;
  constexpr bool ROPE = (DQK == 192);
  const float C = scale * LOG2E, THRS = 8.f / scale;
  int tid_ = threadIdx.x; asm volatile("" : "+v"(tid_));
  const int tid = tid_, wid = tid >> 6, lane = tid & 63, r32 = lane & 31, hi = lane >> 5;
  ATT_LAS char* V_lds = lds; ATT_LAS char* K_lds = lds + 2 * SHM_V;
  ATT_LAS float* ws = (ATT_LAS float*)(lds + 2 * SHM_V + 2 * SHM_K) + wid * 64; ATT_LAS float* li_l = ws; ATT_LAS float* al_l = ws + 32;
  float m_reg = -1e30f, l_reg = 0; f32x16 o[4] = {}; bf16x8 qr[NQ];
  const bf16* Qw = Qb + (long)(wid * QBLK + r32) * LDQ + hi * 8;
#pragma unroll
  for (int d0 = 0; d0 < NQ; ++d0) qr[d0] = *(const ATT_GAS bf16x8*)(Qw + d0 * 16);
  if constexpr (ROPE) {
    const float* cs = cs_rows + (long)(wid * QBLK + r32) * 64 + hi * 8;
#pragma unroll
    for (int g = 0; g < 2; ++g) {
      const f32x4 c0 = *(const ATT_GAS f32x4*)(cs + g * 16), c1 = *(const ATT_GAS f32x4*)(cs + g * 16 + 4);
      const f32x4 s0 = *(const ATT_GAS f32x4*)(cs + 32 + g * 16), s1 = *(const ATT_GAS f32x4*)(cs + 32 + g * 16 + 4);
      float y1[8], y2[8];
#pragma unroll
      for (int j = 0; j < 8; ++j) { const float co = j < 4 ? c0[j & 3] : c1[j & 3], si = j < 4 ? s0[j & 3] : s1[j & 3];
        const float x1 = bf2f(qr[8 + g][j]), x2 = bf2f(qr[10 + g][j]); y1[j] = x1 * co - x2 * si; y2[j] = x1 * si + x2 * co; }
      u32x4 w1 = {cvtpk(y1[0], y1[1]), cvtpk(y1[2], y1[3]), cvtpk(y1[4], y1[5]), cvtpk(y1[6], y1[7])};
      u32x4 w2 = {cvtpk(y2[0], y2[1]), cvtpk(y2[2], y2[3]), cvtpk(y2[4], y2[5]), cvtpk(y2[6], y2[7])};
      qr[8 + g] = *reinterpret_cast<bf16x8*>(&w1); qr[10 + g] = *reinterpret_cast<bf16x8*>(&w2);
    }
  }
  const int sr = tid >> 4, sc = (tid & 15) * 8, vst0 = v_st(sr, sc), vst1 = v_st(32 + sr, sc);
  const int rr = tid >> 3, rc = (tid & 7) * 8;
  const int vb0 = (int)(unsigned)(uintptr_t)V_lds + v_rd_base(lane);
  struct Slot { bf16x8 vs0, vs1, ks0, ks1, kr; } sr_[SDEPTH];
#define SLOAD(i, k0) do { sr_[i].vs0 = *(const ATT_GAS bf16x8*)(&Vh[(long)((k0) + sr) * LDK + sc]); sr_[i].vs1 = *(const ATT_GAS bf16x8*)(&Vh[(long)((k0) + 32 + sr) * LDK + sc]); \
    sr_[i].ks0 = *(const ATT_GAS bf16x8*)(&Kh[(long)((k0) + sr) * LDK + sc]); sr_[i].ks1 = *(const ATT_GAS bf16x8*)(&Kh[(long)((k0) + 32 + sr) * LDK + sc]); \
    if constexpr (ROPE) sr_[i].kr = *(const ATT_GAS bf16x8*)(&Kr[(long)((k0) + rr) * 64 + rc]); } while (0)
#define SWRITE(b, i) do { *reinterpret_cast<ATT_LAS bf16x8*>(V_lds + (b) * SHM_V + vst0) = sr_[i].vs0;          \
    *reinterpret_cast<ATT_LAS bf16x8*>(V_lds + (b) * SHM_V + vst1) = sr_[i].vs1; const int kc = sc * 2;               \
    *reinterpret_cast<ATT_LAS bf16x8*>(K_lds + (b) * SHM_K + kswz<RB>(sr, kc)) = sr_[i].ks0;                       \
    *reinterpret_cast<ATT_LAS bf16x8*>(K_lds + (b) * SHM_K + kswz<RB>(32 + sr, kc)) = sr_[i].ks1;                  \
    if constexpr (ROPE) *reinterpret_cast<ATT_LAS bf16x8*>(K_lds + (b) * SHM_K + kswz<RB>(rr, 256 + rc * 2)) = sr_[i].kr; } while (0)
#define SWAIT() do { if constexpr (SDEPTH == 2) { if constexpr (ROPE) asm volatile("s_waitcnt vmcnt(5)" ::: "memory"); else asm volatile("s_waitcnt vmcnt(4)" ::: "memory"); } else asm volatile("s_waitcnt vmcnt(0)" ::: "memory"); } while (0)
#define RESC(a) do { if (__any((a) < 1.f)) { if (hi == 0) al_l[r32] = (a); asm volatile("s_waitcnt lgkmcnt(0)" ::: "memory"); \
    _Pragma("unroll") for (int d = 0; d < 4; ++d) _Pragma("unroll") for (int r = 0; r < 16; ++r) o[d][r] *= al_l[crow(r, hi)]; } } while (0)
  f32x16 pA0, pA1, pB0, pB1; float mnA, mnB, alA, alB; bf16x8 pa0, pa1, pa2, pa3; const int NT = seq / KVBLK;
  constexpr int SE = 0, SO = SDEPTH - 1;
  SLOAD(SE, 0); asm volatile("s_waitcnt vmcnt(0)" ::: "memory"); SWRITE(0, SE); __syncthreads();
  qkt<DQK>(pA0, pA1, K_lds, qr, r32, hi); partialSM(pA0, pA1, m_reg, mnA, alA, C, THRS);
  SLOAD(SO, KVBLK); if constexpr (SDEPTH == 2) { if (2 < NT) SLOAD(SE, 2 * KVBLK); }
  SWAIT(); SWRITE(1, SO); __syncthreads();
  for (int j = 1; j + 1 < NT; j += 2) {
    SBAR(); qkt<DQK>(pB0, pB1, K_lds + SHM_K, qr, r32, hi);
    finishSM(pA0, pA1, alA, l_reg, pa0, pa1, pa2, pa3); SBAR();
    SLOAD(SO, (j + SDEPTH) * KVBLK); SBAR();
    pv_d0(o, vb0, pa0, pa1, pa2, pa3); partialSM(pB0, pB1, m_reg, mnB, alB, C, THRS);
    __syncthreads(); SWAIT(); SWRITE(0, SE);
    RESC(alB); __syncthreads();
    SBAR(); qkt<DQK>(pA0, pA1, K_lds, qr, r32, hi);
    finishSM(pB0, pB1, alB, l_reg, pa0, pa1, pa2, pa3); SBAR();
    if (SDEPTH == 1 || j + 3 < NT) SLOAD(SE, (j + 1 + SDEPTH) * KVBLK); SBAR();
    pv_d0(o, vb0 + SHM_V, pa0, pa1, pa2, pa3); partialSM(pA0, pA1, m_reg, mnA, alA, C, THRS);
    __syncthreads(); SWAIT(); SWRITE(1, SO);
    RESC(alA); __syncthreads();
  }
  SBAR(); qkt<DQK>(pB0, pB1, K_lds + SHM_K, qr, r32, hi);
  finishSM(pA0, pA1, alA, l_reg, pa0, pa1, pa2, pa3); SBAR();
  pv_d0(o, vb0, pa0, pa1, pa2, pa3); partialSM(pB0, pB1, m_reg, mnB, alB, C, THRS);
  __syncthreads(); RESC(alB);
  finishSM(pB0, pB1, alB, l_reg, pa0, pa1, pa2, pa3); SBAR();
  pv_d0(o, vb0 + SHM_V, pa0, pa1, pa2, pa3);
  if (hi == 0) li_l[r32] = l_reg; asm volatile("s_waitcnt lgkmcnt(0)" ::: "memory");
  float rli[16];
#pragma unroll
  for (int r = 0; r < 16; ++r) rli[r] = __builtin_amdgcn_rcpf(li_l[crow(r, hi)]);
  float* Ow = Ob + (long)(wid * QBLK) * LDO;
#pragma unroll
  for (int r = 0; r < 16; ++r) { const int orow = crow(r, hi);
#pragma unroll
    for (int d0 = 0; d0 < 4; ++d0) Ow[(long)orow * LDO + d0 * 32 + r32] = o[d0][r] * rli[r]; }
  __syncthreads();
#undef SLOAD
#undef SWRITE
#undef SWAIT
#undef RESC
}

template <int DQK, int LDQ, int LDK, int LDO>
__device__ __forceinline__ void attn_simple_body(const bf16* __restrict__ Qb, const bf16* __restrict__ Kh, const bf16* __restrict__ Kr, const bf16* __restrict__ Vh,
                                                 const float* __restrict__ cs_rows, float* __restrict__ Ob, int seq, const float scale, ATT_LAS char* lds) {
  constexpr int SHM_V = KVBLK * DV * 2, SHM_K = KVBLK * DQK * 2, RB = DQK * 2, NQ = DQK / 16;
  constexpr bool ROPE = (DQK == 192);
  const float C = scale * LOG2E, THRS = 8.f / scale;
  int tid_ = threadIdx.x; asm volatile("" : "+v"(tid_));
  const int tid = tid_, wid = tid >> 6, lane = tid & 63, r32 = lane & 31, hi = lane >> 5;
  ATT_LAS char* V_lds = lds; ATT_LAS char* K_lds = lds + 2 * SHM_V;
  ATT_LAS float* ws = (ATT_LAS float*)(lds + 2 * SHM_V + 2 * SHM_K) + wid * 64; ATT_LAS float* li_l = ws; ATT_LAS float* al_l = ws + 32;
  float m_reg = -1e30f, l_reg = 0; f32x16 o[4] = {}; bf16x8 qr[NQ];
  const bf16* Qw = Qb + (long)(wid * QBLK + r32) * LDQ + hi * 8;
#pragma unroll
  for (int d0 = 0; d0 < NQ; ++d0) qr[d0] = *(const ATT_GAS bf16x8*)(Qw + d0 * 16);
  if constexpr (ROPE) {
    const float* cs = cs_rows + (long)(wid * QBLK + r32) * 64 + hi * 8;
#pragma unroll
    for (int g = 0; g < 2; ++g) {
      const f32x4 c0 = *(const ATT_GAS f32x4*)(cs + g * 16), c1 = *(const ATT_GAS f32x4*)(cs + g * 16 + 4);
      const f32x4 s0 = *(const ATT_GAS f32x4*)(cs + 32 + g * 16), s1 = *(const ATT_GAS f32x4*)(cs + 32 + g * 16 + 4);
      float y1[8], y2[8];
#pragma unroll
      for (int j = 0; j < 8; ++j) { const float co = j < 4 ? c0[j & 3] : c1[j & 3], si = j < 4 ? s0[j & 3] : s1[j & 3];
        const float x1 = bf2f(qr[8 + g][j]), x2 = bf2f(qr[10 + g][j]); y1[j] = x1 * co - x2 * si; y2[j] = x1 * si + x2 * co; }
      u32x4 w1 = {cvtpk(y1[0], y1[1]), cvtpk(y1[2], y1[3]), cvtpk(y1[4], y1[5]), cvtpk(y1[6], y1[7])};
      u32x4 w2 = {cvtpk(y2[0], y2[1]), cvtpk(y2[2], y2[3]), cvtpk(y2[4], y2[5]), cvtpk(y2[6], y2[7])};
      qr[8 + g] = *reinterpret_cast<bf16x8*>(&w1); qr[10 + g] = *reinterpret_cast<bf16x8*>(&w2);
    }
  }
  const int sr = tid >> 4, sc = (tid & 15) * 8, vst0 = v_st(sr, sc), vst1 = v_st(32 + sr, sc);
  const int rr = tid >> 3, rc = (tid & 7) * 8;
  const int vb0 = (int)(unsigned)(uintptr_t)V_lds + v_rd_base(lane);
  bf16x8 vs0, vs1, ks0, ks1, kr;
#define SLOAD(k0) do { vs0 = *(const ATT_GAS bf16x8*)(&Vh[(long)((k0) + sr) * LDK + sc]); vs1 = *(const ATT_GAS bf16x8*)(&Vh[(long)((k0) + 32 + sr) * LDK + sc]); \
    ks0 = *(const ATT_GAS bf16x8*)(&Kh[(long)((k0) + sr) * LDK + sc]); ks1 = *(const ATT_GAS bf16x8*)(&Kh[(long)((k0) + 32 + sr) * LDK + sc]); \
    if constexpr (ROPE) kr = *(const ATT_GAS bf16x8*)(&Kr[(long)((k0) + rr) * 64 + rc]); } while (0)
#define SWRITE(b) do { *reinterpret_cast<ATT_LAS bf16x8*>(V_lds + (b) * SHM_V + vst0) = vs0;          \
    *reinterpret_cast<ATT_LAS bf16x8*>(V_lds + (b) * SHM_V + vst1) = vs1; const int kc = sc * 2;               \
    *reinterpret_cast<ATT_LAS bf16x8*>(K_lds + (b) * SHM_K + kswz<RB>(sr, kc)) = ks0;                       \
    *reinterpret_cast<ATT_LAS bf16x8*>(K_lds + (b) * SHM_K + kswz<RB>(32 + sr, kc)) = ks1;                  \
    if constexpr (ROPE) *reinterpret_cast<ATT_LAS bf16x8*>(K_lds + (b) * SHM_K + kswz<RB>(rr, 256 + rc * 2)) = kr; } while (0)
#define RESC(a) do { if (__any((a) < 1.f)) { if (hi == 0) al_l[r32] = (a); asm volatile("s_waitcnt lgkmcnt(0)" ::: "memory"); \
    _Pragma("unroll") for (int d = 0; d < 4; ++d) _Pragma("unroll") for (int r = 0; r < 16; ++r) o[d][r] *= al_l[crow(r, hi)]; } } while (0)
  const int NT = seq / KVBLK;
  SLOAD(0); SWRITE(0); __syncthreads();
  for (int j = 0; j < NT; ++j) {
    const int b = j & 1;
    if (j + 1 < NT) SLOAD((j + 1) * KVBLK);
    f32x16 p0, p1; float mn, al; bf16x8 pa0, pa1, pa2, pa3;
    SBAR(); qkt<DQK>(p0, p1, K_lds + b * SHM_K, qr, r32, hi);
    partialSM(p0, p1, m_reg, mn, al, C, THRS); RESC(al);
    finishSM(p0, p1, al, l_reg, pa0, pa1, pa2, pa3); SBAR();
    pv_d0(o, vb0 + b * SHM_V, pa0, pa1, pa2, pa3);
    if (j + 1 < NT) SWRITE(b ^ 1);
    __syncthreads();
  }
  if (hi == 0) li_l[r32] = l_reg; asm volatile("s_waitcnt lgkmcnt(0)" ::: "memory");
  float rli[16];
#pragma unroll
  for (int r = 0; r < 16; ++r) rli[r] = __builtin_amdgcn_rcpf(li_l[crow(r, hi)]);
  float* Ow = Ob + (long)(wid * QBLK) * LDO;
#pragma unroll
  for (int r = 0; r < 16; ++r) { const int orow = crow(r, hi);
#pragma unroll
    for (int d0 = 0; d0 < 4; ++d0) Ow[(long)orow * LDO + d0 * 32 + r32] = o[d0][r] * rli[r]; }
  __syncthreads();
#undef SLOAD
#undef SWRITE
#undef RESC
}

template <int LDP>
__device__ __forceinline__ void dil_wave_unit(const bf16* __restrict__ P, int qc, int kc, int vc, int d, int r, int t0, int nT,
                                              float* __restrict__ O, int oc, float* __restrict__ ST  ,
                                              ATT_LAS char* vlds  , const ATT_LAS float* bias2, const float C, int lane_) {
  int lane = lane_; asm volatile("" : "+v"(lane));
  const int r32 = lane & 31, hi = lane >> 5;
  bf16x8 qr[8];
  { const bf16* qp = P + (long)(r + d * (t0 + r32)) * LDP + qc + hi * 8;
#pragma unroll
    for (int d0 = 0; d0 < 8; ++d0) qr[d0] = *(const ATT_GAS bf16x8*)(qp + d0 * 16); }
  f32x16 p[5];
#pragma unroll
  for (int kb = 0; kb < 5; ++kb) {
    int kt = t0 - 64 + kb * 32 + r32; kt = kt < 0 ? 0 : (kt > nT - 1 ? nT - 1 : kt);
    const bf16* kp = P + (long)(r + d * kt) * LDP + kc + hi * 8;
    bf16x8 kf[8];
#pragma unroll
    for (int d0 = 0; d0 < 8; ++d0) kf[d0] = *(const ATT_GAS bf16x8*)(kp + d0 * 16);
    p[kb] = f32x16{};
#pragma unroll
    for (int d0 = 0; d0 < 8; ++d0) p[kb] = __builtin_amdgcn_mfma_f32_32x32x16_bf16(kf[d0], qr[d0], p[kb], 0, 0, 0);
  }
  float m = -1e30f;
#pragma unroll
  for (int kb = 0; kb < 5; ++kb)
#pragma unroll
    for (int rg = 0; rg < 16; ++rg) {
      const int jj = kb * 32 + crow(rg, hi) - r32;
      const int kt = t0 - 64 + kb * 32 + crow(rg, hi);
      const bool valid = (jj >= 0) && (jj <= 128) && (kt >= 0) && (kt < nT);
      const int bi = jj < 0 ? 0 : (jj > 128 ? 128 : jj);
      const float s = fmaf(p[kb][rg], C, bias2[bi]);
      p[kb][rg] = valid ? s : -1e30f; m = fmaxf(m, p[kb][rg]);
    }
  { auto rr = __builtin_amdgcn_permlane32_swap(__float_as_uint(m), __float_as_uint(m), false, false); m = fmaxf(__uint_as_float(rr[0]), __uint_as_float(rr[1])); }
  float Z = 0.f;
#pragma unroll
  for (int kb = 0; kb < 5; ++kb)
#pragma unroll
    for (int rg = 0; rg < 16; ++rg) { p[kb][rg] = __builtin_amdgcn_exp2f(p[kb][rg] - m); Z += p[kb][rg]; }
  { auto rr = __builtin_amdgcn_permlane32_swap(__float_as_uint(Z), __float_as_uint(Z), false, false); Z = __uint_as_float(rr[0]) + __uint_as_float(rr[1]); }
  f32x16 o[4] = {};
  const int vb = (int)(unsigned)(uintptr_t)vlds + v_rd_base(lane);
#pragma unroll
  for (int kb = 0; kb < 5; ++kb) {
    bf16x8 vv[8];
#pragma unroll
    for (int i = 0; i < 8; ++i) { const int id = lane + 64 * i, row = id >> 4, c = (id & 15) * 8;
      int kt = t0 - 64 + kb * 32 + row; kt = kt < 0 ? 0 : (kt > nT - 1 ? nT - 1 : kt);
      vv[i] = *(const ATT_GAS bf16x8*)(P + (long)(r + d * kt) * LDP + vc + c); }
#pragma unroll
    for (int i = 0; i < 8; ++i) { const int id = lane + 64 * i, row = id >> 4, c = (id & 15) * 8;
      *reinterpret_cast<ATT_LAS bf16x8*>(vlds + v_st(row, c)) = vv[i]; }
    bf16x8 pa0, pa1; ATT_PK4(p[kb], 0, pa0); ATT_PK4(p[kb], 8, pa1);
    asm volatile("s_waitcnt lgkmcnt(0)" ::: "memory"); SBAR();
    pv32_one<0>(o[0], vb, pa0, pa1); pv32_one<1>(o[1], vb, pa0, pa1); pv32_one<2>(o[2], vb, pa0, pa1); pv32_one<3>(o[3], vb, pa0, pa1);
    SBAR();
  }
#pragma unroll
  for (int rg = 0; rg < 16; ++rg) { const long row = r + d * (t0 + crow(rg, hi));
#pragma unroll
    for (int d0 = 0; d0 < 4; ++d0) O[row * 768 + oc + d0 * 32 + r32] = o[d0][rg]; }
  if (hi == 0) { const long row = r + d * (t0 + r32); typedef float f32x2_ __attribute__((ext_vector_type(2))); *(ATT_GAS f32x2_*)(ST + row * 12) = (f32x2_){m, Z}; }
}
}
constexpr int S = 8192, D = 2048, NMEM = 256;
constexpr int DIN = 3392, DINP = 3584;
constexpr int PC_DIL = 768, PC_MEM = 3072;
constexpr int QR = 384, KVR = 128, AQ = 512;
constexpr int NUP = 2816;
constexpr int UC_KV = 1280;
constexpr int DFF = 5632, DFE = 7168, NE = 8;
constexpr int MP = 18432;
constexpr float EPS = 1e-6f;
constexpr int NWAVES = 8;

constexpr size_t al256(size_t x) { return (x + 255) / 256 * 256; }
constexpr size_t WS_CTL = 0, CTL_ZERO_BYTES = 1u << 20;
constexpr size_t WS_WIN = WS_CTL + CTL_ZERO_BYTES;
constexpr size_t WS_WUP = WS_WIN + al256((size_t)2 * DINP * D * 2);
constexpr size_t WS_WMEM = WS_WUP + al256((size_t)2 * NUP * AQ * 2);
constexpr size_t WS_WOUT = WS_WMEM + al256((size_t)2 * 1024 * D * 2);
constexpr size_t WS_WGU = WS_WOUT + al256((size_t)2 * D * D * 2);
constexpr size_t WS_WDN = WS_WGU + al256((size_t)2 * DFF * D * 2);
constexpr size_t WS_MGU = WS_WDN + al256((size_t)D * DFF * 2);
constexpr size_t WS_MDN = WS_MGU + al256((size_t)NE * 2 * DFE * D * 2);
constexpr size_t WS_XN = WS_MDN + al256((size_t)NE * D * DFE * 2);
constexpr size_t WS_MEMN = WS_XN + al256((size_t)S * D * 2);
constexpr size_t WS_MEMKV = WS_MEMN + al256((size_t)2 * NMEM * D * 2);
constexpr size_t WS_PROJ = WS_MEMKV + al256((size_t)2 * NMEM * 1024 * 2);
constexpr size_t WS_AQKV = WS_PROJ + al256((size_t)S * DINP * 2);
constexpr size_t WS_KROPE = WS_AQKV + al256((size_t)S * AQ * 2);
constexpr size_t WS_ROPECS = WS_KROPE + al256((size_t)S * 64 * 2);
constexpr size_t WS_QKVM = WS_ROPECS + al256((size_t)S * 64 * 4);
constexpr size_t WS_YPRE = WS_QKVM + al256((size_t)S * NUP * 2);
constexpr size_t WS_DILO = WS_YPRE + al256((size_t)S * D * 4);
constexpr size_t WS_DILS = WS_DILO + al256((size_t)3 * S * 768 * 4);
constexpr size_t WS_Y = WS_DILS + al256((size_t)3 * S * 12 * 4);
constexpr size_t WS_XA = WS_Y + al256((size_t)S * D * 2);
constexpr size_t WS_ROUTE = WS_XA + al256((size_t)S * D * 4);
constexpr size_t WS_XP = WS_ROUTE + al256((size_t)S * 32);
constexpr size_t WS_OUTP = WS_XP + al256((size_t)MP * D * 2);
constexpr size_t WS_ACTP = WS_OUTP + al256((size_t)MP * D * 2);
constexpr size_t WS_END = WS_ACTP + al256((size_t)MP * DFE * 2);
static_assert(WS_END <= 1879048192ull, "workspace map exceeds 4 x the largest input");
constexpr int CW_BAR = 4096;
constexpr int CW_QUEUE = 8192;
constexpr int CW_CNT = 8192 + 256;
constexpr int CW_CVT = 8192 + 320;
constexpr int CW_DONE = 8192 + 384;
constexpr int CW_TILEE = 8192 + 512;
constexpr int RING_BYTES = 131072;
constexpr int LDSCTL_OFF = RING_BYTES, MISC_OFF = LDSCTL_OFF + 320;
constexpr int BIAS_OFF = 114688;
constexpr int LDS_BYTES = 147456;

#define GAS __attribute__((address_space(1)))
#define LAS __attribute__((address_space(3)))
typedef unsigned short bf16;
typedef unsigned v4u __attribute__((ext_vector_type(4)));
typedef unsigned v2u __attribute__((ext_vector_type(2)));
typedef float f32x4 __attribute__((ext_vector_type(4)));
typedef short bf16x8 __attribute__((ext_vector_type(8)));
typedef GAS unsigned gu32;
#define RLX_AGENT __ATOMIC_RELAXED, __HIP_MEMORY_SCOPE_AGENT
#define LDS_WAIT() asm volatile("s_waitcnt lgkmcnt(0)" ::: "memory")
#define VM_WAIT() asm volatile("s_waitcnt vmcnt(0)" ::: "memory")
__device__ __forceinline__ unsigned f2bf(float f) { unsigned u = __builtin_bit_cast(unsigned, f); return (u + 0x7fffu + ((u >> 16) & 1u)) >> 16; }
__device__ __forceinline__ unsigned pk2(float lo, float hi) { return f2bf(lo) | (f2bf(hi) << 16); }
__device__ __forceinline__ float bflo(unsigned w) { return __uint_as_float(w << 16); }
__device__ __forceinline__ float bfhi(unsigned w) { return __uint_as_float(w & 0xffff0000u); }

#define XB_TMO      128
#define XB_XCNT(j)  (256  + 64 * (j))
#define XB_XSUB(j)  (1280 + 64 * (j))
#define XB_XGEN(j)  (2304 + 64 * (j))
#define XB_TOP      3328
#define XB_TOPGEN   3392
#define XCD_BAR_WORDS 3456
#define XB_SPIN_CAP (1u << 18)
__device__ __forceinline__ unsigned xb_ld(unsigned* p)              { return __hip_atomic_load(p, __ATOMIC_RELAXED, __HIP_MEMORY_SCOPE_AGENT); }
__device__ __forceinline__ unsigned xb_add(unsigned* p, unsigned v) { return __hip_atomic_fetch_add(p, v, __ATOMIC_RELAXED, __HIP_MEMORY_SCOPE_AGENT); }
__device__ __forceinline__ unsigned xb_xcc_id() { return (unsigned)__builtin_amdgcn_s_getreg((3 << 11) | 20) & 0xFu; }
#define XB_SPIN(cond, bar) do { unsigned _sp = 0; while (cond) { __builtin_amdgcn_s_sleep(1); \
    if ((++_sp & 255u) == 0u) { if (xb_ld(&(bar)[XB_TMO])) break; if (_sp > XB_SPIN_CAP) { atomicAdd(&(bar)[XB_TMO], 1u); break; } } } } while (0)
struct XcdBarrier { unsigned* bar; unsigned x; volatile LAS unsigned* st; };
__device__ __forceinline__ XcdBarrier xcd_barrier_post(unsigned* bar, volatile LAS unsigned* st) {
    XcdBarrier b; b.bar = bar; b.x = xb_xcc_id(); b.st = st;
    if (threadIdx.x == 0) (void)xb_add(&bar[XB_XCNT(b.x)], 1u);
    return b;
}
__device__ __forceinline__ void xcd_barrier_complete(unsigned* bar, unsigned x, unsigned& nloc, unsigned& nx) {
    const unsigned G = gridDim.x * gridDim.y * gridDim.z;
    unsigned sum, cnt, mine, sp = 0u;
    for (;;) {
        sum = 0u; cnt = 0u; mine = 0u;
#pragma unroll
        for (unsigned j = 0; j < 16; ++j) { const unsigned c = xb_ld(&bar[XB_XCNT(j)]); sum += c; cnt += (c > 0u) ? 1u : 0u; mine = (j == x) ? c : mine; }
        if (sum == G) break;
        __builtin_amdgcn_s_sleep(1);
        if ((++sp & 255u) == 0u) { if (xb_ld(&bar[XB_TMO])) break; if (sp > XB_SPIN_CAP) { atomicAdd(&bar[XB_TMO], 1u); break; } }
    }
    nloc = mine > 0u ? mine : 1u; nx = cnt > 0u ? cnt : 1u;
}
__device__ __forceinline__ void xcd_barrier(const XcdBarrier& b) {
    asm volatile("s_waitcnt vmcnt(0)" ::: "memory");
    __syncthreads();
    if (threadIdx.x == 0) {
        unsigned* bar = b.bar;
        __builtin_amdgcn_s_waitcnt(0);
        unsigned nloc = b.st[0], nx = b.st[1];
        if (nloc == 0u) { xcd_barrier_complete(bar, b.x, nloc, nx); b.st[0] = nloc; b.st[1] = nx; }
        const unsigned old = xb_add(&bar[XB_XSUB(b.x)], 1u);
        const unsigned gen = old / nloc;
        if (old + 1u == (gen + 1u) * nloc) {
            __builtin_amdgcn_fence(__ATOMIC_RELEASE, "agent");
            asm volatile("s_waitcnt vmcnt(0)" ::: "memory");
            const unsigned og = xb_add(&bar[XB_TOP], 1u);
            const unsigned tg = og / nx;
            if (og + 1u == (tg + 1u) * nx) xb_add(&bar[XB_TOPGEN], 1u);
            else XB_SPIN(xb_ld(&bar[XB_TOPGEN]) == tg, bar);
            __builtin_amdgcn_fence(__ATOMIC_ACQUIRE, "agent");
            xb_add(&bar[XB_XGEN(b.x)], 1u);
            asm volatile("s_waitcnt vmcnt(0)" ::: "memory");
        } else {
            XB_SPIN(xb_ld(&bar[XB_XGEN(b.x)]) == gen, bar);
            __builtin_amdgcn_fence(__ATOMIC_ACQUIRE, "agent");
            asm volatile("s_waitcnt vmcnt(0)" ::: "memory");
        }
    }
    __syncthreads();
}

struct Args {
    const float* in[23]; float* out; unsigned char* ws;
    float invf[32];
    int ph_lo, ph_hi, li, pad;
};
struct Frame {
    LAS unsigned char* lds;
    volatile LAS unsigned* MISC;
    gu32* ctl;
    int tid, lane, wave, G, gw, NGW;
    unsigned char* ws;
};
__device__ __forceinline__ float wave_sum(float v) {
#pragma unroll
    for (int o = 1; o < 64; o <<= 1) v += __shfl_xor(v, o);
    return v;
}
__device__ __forceinline__ float wave_max(float v) {
#pragma unroll
    for (int o = 1; o < 64; o <<= 1) v = fmaxf(v, __shfl_xor(v, o));
    return v;
}

__device__ __forceinline__ unsigned pk4_fp8(float a, float b, float c, float d) { int w = 0; w = __builtin_amdgcn_cvt_pk_fp8_f32(a, b, w, false); w = __builtin_amdgcn_cvt_pk_fp8_f32(c, d, w, true); return (unsigned)w; }
__device__ __forceinline__ void cvt_load(const float* __restrict__ W, int N, int k0, int n0, int lane, f32x4 (&v)[8]) {
    const int lr = lane >> 3, lc = (lane & 7) * 4;
#pragma unroll
    for (int i = 0; i < 8; ++i) v[i] = *(const GAS f32x4*)(W + (size_t)(k0 + i * 8 + lr) * N + n0 + lc);
}
template <bool FP8>
__device__ __forceinline__ void cvt_finish(const f32x4 (&v)[8], int k0, void* __restrict__ dstv, int ldd, int drow0, int kdst0, LAS float* scr, int lane, float wsc) {
    const int lr = lane >> 3, lc = (lane & 7) * 4;
#pragma unroll
    for (int i = 0; i < 8; ++i) { LAS float* s = scr + (i * 8 + lr) * 33 + lc; s[0] = v[i][0]; s[1] = v[i][1]; s[2] = v[i][2]; s[3] = v[i][3]; }
    LDS_WAIT(); asm volatile("" ::: "memory");
    const int c = lane & 7;
#pragma unroll
    for (int j = 0; j < 4; ++j) { const int n = (lane >> 3) + 8 * j; const LAS float* s = scr + (8 * c) * 33 + n;
        if constexpr (FP8) { v2u o; o.x = pk4_fp8(s[0 * 33] * wsc, s[1 * 33] * wsc, s[2 * 33] * wsc, s[3 * 33] * wsc); o.y = pk4_fp8(s[4 * 33] * wsc, s[5 * 33] * wsc, s[6 * 33] * wsc, s[7 * 33] * wsc);
            *(GAS v2u*)((unsigned char*)dstv + (size_t)(drow0 + n) * ldd + kdst0 + k0 + 8 * c) = o; }
        else { v4u o; o.x = pk2(s[0 * 33], s[1 * 33]); o.y = pk2(s[2 * 33], s[3 * 33]); o.z = pk2(s[4 * 33], s[5 * 33]); o.w = pk2(s[6 * 33], s[7 * 33]);
            *(GAS v4u*)((bf16*)dstv + (size_t)(drow0 + n) * ldd + kdst0 + k0 + 8 * c) = o; } }
    LDS_WAIT(); asm volatile("" ::: "memory");
}
__device__ __forceinline__ int cvt_drow(int mode, int n0, int roff) { return mode == 0 ? n0 + roff : (mode == 1 ? (n0 >> 7) * 256 + (n0 & 127) : (mode == 2 ? (n0 >> 7) * 256 + 128 + (n0 & 127) : (n0 < 576 ? n0 : n0 + 192))); }
template <bool FP8>
__device__ __forceinline__ void cvt_job(Frame& F, const float* W, int K, int N, void* dst, int ldd, int kdst0, int mode, int roff, LAS float* scr, float wsc) {
    const int nnb = N / 32, nitems = (K / 64) * nnb;
    int it = F.gw; if (it >= nitems) return;
    f32x4 va[8], vb[8];
    cvt_load(W, N, (it / nnb) * 64, (it % nnb) * 32, F.lane, va);
    for (;;) {
        const int it1 = it + F.NGW; if (it1 < nitems) cvt_load(W, N, (it1 / nnb) * 64, (it1 % nnb) * 32, F.lane, vb);
        cvt_finish<FP8>(va, (it / nnb) * 64, dst, ldd, cvt_drow(mode, (it % nnb) * 32, roff), kdst0, scr, F.lane, wsc);
        if (it1 >= nitems) break;
        const int it2 = it1 + F.NGW; if (it2 < nitems) cvt_load(W, N, (it2 / nnb) * 64, (it2 % nnb) * 32, F.lane, va);
        cvt_finish<FP8>(vb, (it1 / nnb) * 64, dst, ldd, cvt_drow(mode, (it1 % nnb) * 32, roff), kdst0, scr, F.lane, wsc);
        if (it2 >= nitems) break;
        it = it2;
    }
}
__device__ __forceinline__ void rms_row_to_bf16(const float* xrow, const float* g, bf16* orow, int lane) {
    const GAS f32x4* xr = (const GAS f32x4*)xrow + lane; const GAS f32x4* gr = (const GAS f32x4*)g + lane;
    f32x4 v[8]; float s = 0.f;
#pragma unroll
    for (int j = 0; j < 8; ++j) { v[j] = xr[64 * j]; s += (v[j].x * v[j].x + v[j].y * v[j].y) + (v[j].z * v[j].z + v[j].w * v[j].w); }
    const float rstd = 1.f / sqrtf(wave_sum(s) * (1.f / D) + EPS);
    GAS v2u* o8 = (GAS v2u*)orow + lane;
#pragma unroll
    for (int j = 0; j < 8; ++j) { const f32x4 gg = gr[64 * j]; v2u w; w.x = pk2(v[j].x * rstd * gg.x, v[j].y * rstd * gg.y); w.y = pk2(v[j].z * rstd * gg.z, v[j].w * rstd * gg.w); o8[64 * j] = w; }
}
__device__ __forceinline__ void rms_row_to_fp8(const float* xrow, const float* g, unsigned char* orow, int lane) {
    const GAS f32x4* xr = (const GAS f32x4*)xrow + lane; const GAS f32x4* gr = (const GAS f32x4*)g + lane;
    f32x4 v[8]; float s = 0.f;
#pragma unroll
    for (int j = 0; j < 8; ++j) { v[j] = xr[64 * j]; s += (v[j].x * v[j].x + v[j].y * v[j].y) + (v[j].z * v[j].z + v[j].w * v[j].w); }
    const float rstd = 1.f / sqrtf(wave_sum(s) * (1.f / D) + EPS);
    GAS unsigned* o4 = (GAS unsigned*)orow + lane;
#pragma unroll
    for (int j = 0; j < 8; ++j) { const f32x4 gg = gr[64 * j]; o4[64 * j] = pk4_fp8(v[j].x * rstd * gg.x, v[j].y * rstd * gg.y, v[j].z * rstd * gg.z, v[j].w * rstd * gg.w); }
}
__device__ __forceinline__ void sincos_f64(float ang, float& c, float& s) {
    const double a = (double)ang, twopi = 6.283185307179586476925286766559, inv2pi = 0.15915494309189533576888376337251;
    const double q = __builtin_rint(a * inv2pi); const double r = a - q * twopi;
    const double r2 = r * r; double ss = 1.0, cc = 1.0;
#pragma unroll
    for (int k = 14; k >= 1; --k) { ss = 1.0 - r2 * (1.0 / (double)((2 * k) * (2 * k + 1))) * ss; cc = 1.0 - r2 * (1.0 / (double)((2 * k - 1) * (2 * k))) * cc; }
    s = (float)(r * ss); c = (float)cc;
}
__device__ const unsigned char DIL_BUCKET[3][129] = {
 {11,11,11,11,11,11,11,11,11,11,11,11,11,11,11,10,10,10,10,10,10,10,10,10,10,10,10,10,10,10,10,10,10,10,10,10,10,10,9,9,9,9,9,9,9,9,9,9,9,9,8,8,8,8,8,8,8,7,6,5,4,3,2,1,0,17,18,19,20,21,22,23,24,24,24,24,24,24,24,25,25,25,25,25,25,25,25,25,25,25,25,26,26,26,26,26,26,26,26,26,26,26,26,26,26,26,26,26,26,26,26,26,26,26,27,27,27,27,27,27,27,27,27,27,27,27,27,27,27},
 {13,13,13,13,13,13,13,13,13,13,13,13,13,13,13,13,13,13,13,13,13,13,13,12,12,12,12,12,12,12,12,12,12,12,12,12,12,12,12,12,12,12,11,11,11,11,11,11,11,11,11,11,10,10,10,10,10,10,9,9,9,8,8,4,0,20,24,24,25,25,25,26,26,26,26,26,26,27,27,27,27,27,27,27,27,27,27,28,28,28,28,28,28,28,28,28,28,28,28,28,28,28,28,28,28,28,29,29,29,29,29,29,29,29,29,29,29,29,29,29,29,29,29,29,29,29,29,29,29},
 {15,15,15,15,15,15,15,15,15,15,15,15,15,15,15,15,15,15,15,15,15,15,15,15,15,15,15,15,15,15,14,14,14,14,14,14,14,14,14,14,14,14,14,14,14,13,13,13,13,13,13,13,13,13,12,12,12,12,12,11,11,10,10,9,0,25,26,26,27,27,28,28,28,28,28,29,29,29,29,29,29,29,29,29,30,30,30,30,30,30,30,30,30,30,30,30,30,30,30,31,31,31,31,31,31,31,31,31,31,31,31,31,31,31,31,31,31,31,31,31,31,31,31,31,31,31,31,31,31}};

typedef float f32x2 __attribute__((ext_vector_type(2)));
#ifndef PH_MASK
#define PH_MASK 0xFFFFu
#endif
#ifndef REPEAT_PHASE
#define REPEAT_PHASE -1
#endif
#ifndef ATT_EN
#define ATT_EN 7
#endif
#define PEN(k) ((PH_MASK >> (k)) & 1u)
#ifndef FFN_FP8
#define FFN_FP8 3
#endif
constexpr bool F8D = (FFN_FP8 & 1) != 0, F8M = (FFN_FP8 & 2) != 0;
constexpr int EBD = F8D ? 1 : 2, EBM = F8M ? 1 : 2;
template <bool B> struct Sc { static constexpr float w_gu = B ? 32.f : 1.f, w_dn = B ? 64.f : 1.f, a_sc = B ? 4.f : 1.f, dn = 1.f / (w_dn * a_sc); };
template <bool B> using FfnEpi1 = typename std::conditional<B, pg8::EpiSwiGLU8, pg8::EpiSwiGLU>::type;
template <bool B> struct Epi1Maker;
template <> struct Epi1Maker<true> { static __device__ __forceinline__ pg8::EpiSwiGLU8 make(void* O, int ldc) { return pg8::EpiSwiGLU8{(unsigned char*)O, ldc, 1.f / Sc<true>::w_gu, Sc<true>::a_sc}; } };
template <> struct Epi1Maker<false> { static __device__ __forceinline__ pg8::EpiSwiGLU make(void* O, int ldc) { return pg8::EpiSwiGLU{(unsigned short*)O, ldc}; } };

constexpr int MOE_MAT_ITEMS = 7168, MOE_GU_ITEMS = 16 * MOE_MAT_ITEMS, MOE_NITEMS = 24 * MOE_MAT_ITEMS, MOE_CHUNK = 64, MOE_NCHUNK = MOE_NITEMS / MOE_CHUNK;
struct MoeItem { const float* W; void* dst; int N, k0, n0, ldd, drow0; float wsc; };
__device__ __forceinline__ MoeItem moe_item(const Args& args, unsigned char* ws, int idx) {
    MoeItem m;
    if (idx < MOE_GU_ITEMS) { const int mat = idx / MOE_MAT_ITEMS, local = idx % MOE_MAT_ITEMS, e = mat >> 1, up = mat & 1, kb = local / (DFE / 32), nb = local % (DFE / 32);
        m.W = args.in[19 + up] + (size_t)e * D * DFE; m.N = DFE; m.k0 = kb * 64; m.n0 = nb * 32; m.dst = ws + WS_MGU + (size_t)e * 2 * DFE * D * EBM; m.ldd = D;
        m.drow0 = (m.n0 >> 7) * 256 + up * 128 + (m.n0 & 127); m.wsc = Sc<F8M>::w_gu; }
    else { const int i2 = idx - MOE_GU_ITEMS, e = i2 / MOE_MAT_ITEMS, local = i2 % MOE_MAT_ITEMS, kb = local / (D / 32), nb = local % (D / 32);
        m.W = args.in[21] + (size_t)e * DFE * D; m.N = D; m.k0 = kb * 64; m.n0 = nb * 32; m.dst = ws + WS_MDN + (size_t)e * D * DFE * EBM; m.ldd = DFE; m.drow0 = m.n0; m.wsc = Sc<F8M>::w_dn; }
    return m;
}
__device__ __forceinline__ void moe_cvt_chunk(Frame& F, const Args& args, int c) {
    LAS float* scr = (LAS float*)(F.lds + F.wave * 16384);
    const int i0 = c * MOE_CHUNK + F.wave * 8;
    f32x4 va[8], vb[8];
    MoeItem ma = moe_item(args, F.ws, i0), mb;
    cvt_load(ma.W, ma.N, ma.k0, ma.n0, F.lane, va);
#pragma unroll 1
    for (int j = 0; j < 8; j += 2) {
        mb = moe_item(args, F.ws, i0 + j + 1); cvt_load(mb.W, mb.N, mb.k0, mb.n0, F.lane, vb);
        cvt_finish<F8M>(va, ma.k0, ma.dst, ma.ldd, ma.drow0, 0, scr, F.lane, ma.wsc);
        if (j + 2 < 8) { ma = moe_item(args, F.ws, i0 + j + 2); cvt_load(ma.W, ma.N, ma.k0, ma.n0, F.lane, va); }
        cvt_finish<F8M>(vb, mb.k0, mb.dst, mb.ldd, mb.drow0, 0, scr, F.lane, mb.wsc);
    }
}
__device__ __forceinline__ void moe_cvt_fill(Frame& F, const Args& args, int ph) {
    for (;;) {
        if (F.tid == 0) { unsigned c = MOE_NCHUNK;
            if (ph < 0 || __hip_atomic_load(F.ctl + CW_DONE + ph, RLX_AGENT) < (unsigned)F.G) c = __hip_atomic_fetch_add(F.ctl + CW_CVT, 1u, RLX_AGENT);
            F.MISC[17] = c; }
        __syncthreads(); const unsigned c = F.MISC[17]; __syncthreads();
        if (c >= (unsigned)MOE_NCHUNK) break;
        moe_cvt_chunk(F, args, (int)c);
    }
}
#define FILL(ph) do { __syncthreads(); if (F.tid == 0) (void)__hip_atomic_fetch_add(F.ctl + CW_DONE + (ph), 1u, RLX_AGENT); moe_cvt_fill(F, args, (ph)); } while (0)
constexpr int PH_PER_LAYER = 11, N_PHASES = 1 + 2 * PH_PER_LAYER;
#ifndef MK_N_LAUNCHES
#define MK_N_LAUNCHES 1
#endif
constexpr int N_LAUNCHES = MK_N_LAUNCHES;

__global__ void __launch_bounds__(NWAVES * 64, 2) mk_fwd(Args args) {
    extern __shared__ __attribute__((aligned(16))) unsigned char lds[];
    Frame F;
    F.lds = (LAS unsigned char*)lds;
    F.MISC = (volatile LAS unsigned*)(F.lds + MISC_OFF);
    F.tid = threadIdx.x; F.lane = F.tid & 63; F.wave = __builtin_amdgcn_readfirstlane(F.tid >> 6);
    F.G = gridDim.x; F.gw = blockIdx.x * NWAVES + F.wave; F.NGW = F.G * NWAVES;
    F.ws = args.ws; F.ctl = (gu32*)(args.ws + WS_CTL);
    unsigned char* ws = args.ws;
    for (int u = F.tid; u < (LDS_BYTES - LDSCTL_OFF) / 4; u += NWAVES * 64) ((LAS unsigned*)(F.lds + LDSCTL_OFF))[u] = 0u;
    __syncthreads();
    XcdBarrier bar; bar.bar = (unsigned*)(F.ctl + CW_BAR); bar.x = 0; bar.st = nullptr;
    if (N_LAUNCHES == 1) bar = xcd_barrier_post((unsigned*)(F.ctl + CW_BAR), F.MISC + 8);
#define GRID_BAR() do { if (N_LAUNCHES == 1) xcd_barrier(bar); } while (0)
    const int lo = args.ph_lo, hi = args.ph_hi;
#define IN(k) (lo <= (k) && (k) < hi)
#define BOTH(k) (IN(k) && IN((k) + 1))

#define x_in (args.in[0])
#define XN8 ((unsigned char*)(ws + WS_XN))
#define WIN ((bf16*)(ws + WS_WIN))
#define WUP ((bf16*)(ws + WS_WUP))
#define WMEM ((bf16*)(ws + WS_WMEM))
#define WOUT ((bf16*)(ws + WS_WOUT))
#define WGU ((bf16*)(ws + WS_WGU))
#define WDN ((bf16*)(ws + WS_WDN))
#define MGU ((bf16*)(ws + WS_MGU))
#define MDN ((bf16*)(ws + WS_MDN))
#define XN ((bf16*)(ws + WS_XN))
#define MEMN ((bf16*)(ws + WS_MEMN))
#define MEMKV ((bf16*)(ws + WS_MEMKV))
#define PROJ ((bf16*)(ws + WS_PROJ))
#define AQKV ((bf16*)(ws + WS_AQKV))
#define KROPE ((bf16*)(ws + WS_KROPE))
#define ROPECS ((float*)(ws + WS_ROPECS))
#define QKVM ((bf16*)(ws + WS_QKVM))
#define YPRE ((float*)(ws + WS_YPRE))
#define DILO ((float*)(ws + WS_DILO))
#define DILS ((float*)(ws + WS_DILS))
#define Y ((bf16*)(ws + WS_Y))
#define XA ((float*)(ws + WS_XA))
#define ROUTE ((unsigned*)(ws + WS_ROUTE))
#define XP ((bf16*)(ws + WS_XP))
#define OUTP ((bf16*)(ws + WS_OUTP))
#define ACTP ((bf16*)(ws + WS_ACTP))
#define ACT ((bf16*)(ws + WS_ACTP))
#define PHASE_BEGIN() do { int t_ = threadIdx.x; asm volatile("" : "+v"(t_)); F.tid = t_; F.lane = t_ & 63; } while (0)

    if (PEN(0) && IN(0)) { PHASE_BEGIN();
        LAS float* scr = (LAS float*)(F.lds + F.wave * 16384);
        for (int rep = 0; rep < (REPEAT_PHASE == 0 ? 2 : 1); ++rep) {
        for (int l = 0; l < 2; ++l) {
            cvt_job<false>(F, args.in[5] + (size_t)l * D * DIN, D, DIN, WIN + (size_t)l * DINP * D, D, 0, 3, 0, scr, 1.f);
            cvt_job<false>(F, args.in[7] + (size_t)l * QR * 1152, QR, 1152, WUP + (size_t)l * NUP * AQ, AQ, 0, 0, 0, scr, 1.f);
            cvt_job<false>(F, args.in[9] + (size_t)l * KVR * 1536, KVR, 1536, WUP + (size_t)l * NUP * AQ, AQ, QR, 0, UC_KV, scr, 1.f);
            cvt_job<false>(F, args.in[11] + (size_t)l * D * 1024, D, 1024, WMEM + (size_t)l * 1024 * D, D, 0, 0, 0, scr, 1.f);
            cvt_job<false>(F, args.in[13] + (size_t)l * D * D, D, D, WOUT + (size_t)l * D * D, D, 0, 0, 0, scr, 1.f);
        }
        cvt_job<F8D>(F, args.in[15], D, DFF, WGU, D, 0, 1, 0, scr, Sc<F8D>::w_gu);
        cvt_job<F8D>(F, args.in[16], D, DFF, WGU, D, 0, 2, 0, scr, Sc<F8D>::w_gu);
        cvt_job<F8D>(F, args.in[17], DFF, D, WDN, DFF, 0, 0, 0, scr, Sc<F8D>::w_dn);
        }
        { const int* pos = (const int*)args.in[2];
          for (int idx = blockIdx.x * (NWAVES * 64) + F.tid; idx < S * 32; idx += F.G * NWAVES * 64) { const int row = idx >> 5, i = idx & 31;
              const float ang = (float)pos[row] * args.invf[i]; float c, s; sincos_f64(ang, c, s); ROPECS[row * 64 + i] = c; ROPECS[row * 64 + 32 + i] = s; } }
        for (int m = F.gw; m < 2 * NMEM; m += F.NGW) { const int l = m >> 8, r = m & 255; rms_row_to_bf16(args.in[1] + (size_t)r * D, args.in[10] + (size_t)l * D, MEMN + (size_t)m * D, F.lane); }
        for (int m = F.gw; m < S; m += F.NGW) rms_row_to_bf16(x_in + (size_t)m * D, args.in[4], XN + (size_t)m * D, F.lane);
        if (BOTH(0)) GRID_BAR();
    }

    for (int l = 0; l < 2; ++l) {
        const int pb = 1 + l * PH_PER_LAYER;
        if (PEN(1) && IN(pb + 0)) { PHASE_BEGIN();
            { pg8::Gemm g{XN, WIN + (size_t)l * DINP * D, 2 * D, 2 * D, D / 64}; pg8::InProjOrder So; So.so.init(S, DINP, F.G, (int)blockIdx.x); So.nextra = (l == 0) ? 8 : 0; So.A2 = MEMN; So.B2 = WMEM;
              pg8::EpiBf16Sel E{PROJ, DINP, MEMKV, 1024};
              pg8::gemm_phase<pg8::EpiBf16Sel, pg8::InProjOrder, true, true>(F.lds, g, So, E); }
            FILL(pb + 0);
            if (BOTH(pb + 0)) GRID_BAR();
        }
        if (PEN(2) && IN(pb + 1)) { PHASE_BEGIN();
            const float* gq = args.in[6] + l * QR; const float* gkv = args.in[8] + l * KVR;
            for (int m = F.gw; m < S; m += F.NGW) {
                const v4u w = *(const GAS v4u*)(PROJ + (size_t)m * DINP + F.lane * 8);
                float v[8] = {bflo(w.x), bfhi(w.x), bflo(w.y), bfhi(w.y), bflo(w.z), bfhi(w.z), bflo(w.w), bfhi(w.w)};
                float sq = 0.f;
#pragma unroll
                for (int j = 0; j < 8; ++j) sq += v[j] * v[j];
                const float sq_q = wave_sum(F.lane < 48 ? sq : 0.f), sq_kv = wave_sum(F.lane >= 48 ? sq : 0.f);
                const float rstd = F.lane < 48 ? 1.f / sqrtf(sq_q * (1.f / QR) + EPS) : 1.f / sqrtf(sq_kv * (1.f / KVR) + EPS);
                const float* gp = F.lane < 48 ? gq + F.lane * 8 : gkv + (F.lane - 48) * 8;
                const f32x4 g0 = *(const GAS f32x4*)gp, g1 = *(const GAS f32x4*)(gp + 4);
                v4u o; o.x = pk2(v[0] * rstd * g0.x, v[1] * rstd * g0.y); o.y = pk2(v[2] * rstd * g0.z, v[3] * rstd * g0.w);
                o.z = pk2(v[4] * rstd * g1.x, v[5] * rstd * g1.y); o.w = pk2(v[6] * rstd * g1.z, v[7] * rstd * g1.w);
                *(GAS v4u*)(AQKV + (size_t)m * AQ + F.lane * 8) = o;
                const int c = F.lane & 7;
                const v4u kw = *(const GAS v4u*)(PROJ + (size_t)m * DINP + 512 + c * 8);
                float kv[8] = {bflo(kw.x), bfhi(kw.x), bflo(kw.y), bfhi(kw.y), bflo(kw.z), bfhi(kw.z), bflo(kw.w), bfhi(kw.w)};
                float ko[8];
                const float* cs = ROPECS + (size_t)m * 64 + (c & 3) * 8;
#pragma unroll
                for (int j = 0; j < 8; ++j) { const float other = __shfl_xor(kv[j], 4); const float co = cs[j], si = cs[32 + j];
                    ko[j] = (c < 4) ? (kv[j] * co - other * si) : (other * si + kv[j] * co); }
                if (F.lane < 8) { v4u ow; ow.x = pk2(ko[0], ko[1]); ow.y = pk2(ko[2], ko[3]); ow.z = pk2(ko[4], ko[5]); ow.w = pk2(ko[6], ko[7]); *(GAS v4u*)(KROPE + (size_t)m * 64 + c * 8) = ow; }
            }
            if (BOTH(pb + 1)) GRID_BAR();
        }
        if (PEN(3) && IN(pb + 2)) { PHASE_BEGIN();
            pg8::Gemm g{AQKV, WUP + (size_t)l * NUP * AQ, 2 * AQ, 2 * AQ, AQ / 64}; pg8::StaticOrder So; So.init(S, NUP, F.G, (int)blockIdx.x);
            pg8::EpiBf16 E{QKVM, NUP, 1.f};
            pg8::gemm_phase<pg8::EpiBf16, pg8::StaticOrder, true, true>(F.lds, g, So, E);
            FILL(pb + 2);
            if (BOTH(pb + 2)) GRID_BAR();
        }
        if (PEN(4) && IN(pb + 3)) { PHASE_BEGIN();
            LAS float* BIAS = (LAS float*)(F.lds + BIAS_OFF);
            for (int i = F.tid; i < 3 * 6 * 129; i += NWAVES * 64) { const int b = i / (6 * 129), rem = i % (6 * 129), h = rem / 129, j = rem % 129;
                BIAS[(b * 6 + h) * 132 + j] = args.in[3][DIL_BUCKET[b][j] * 6 + h] * att::LOG2E; }
            __syncthreads();
            for (int rep = 0; rep < (REPEAT_PHASE == 4 ? 2 : 1); ++rep) {
            gu32* qhead = F.ctl + CW_QUEUE + 64 * l + 32 * rep;
            constexpr int NU_MLA = 6 * 32, NU_MEM = 4 * 32, NU_DIL = 3 * 6 * 32, NU = NU_MLA + NU_MEM + NU_DIL;
#define QPULL(u) do { if (F.tid == 0) F.MISC[16] = __hip_atomic_fetch_add(qhead, 1u, RLX_AGENT); __syncthreads(); u = (int)F.MISC[16]; __syncthreads(); } while (0)
            int u; QPULL(u);
            if (ATT_EN & 1) while (u < NU_MLA) {
                const int h = u >> 5, qb = u & 31;
                att::attn_simple_body<192, NUP, NUP, D>(QKVM + (size_t)qb * 256 * NUP + h * 192, QKVM + UC_KV + h * 256, KROPE, QKVM + UC_KV + h * 256 + 128,
                                                        ROPECS + (size_t)qb * 256 * 64, YPRE + (size_t)qb * 256 * D + h * 128, S, 0.07216878364870322f, (LAS char*)F.lds);
                QPULL(u);
            }
            if (ATT_EN & 2) while (u < NU_MLA + NU_MEM) {
                const int v = u - NU_MLA, h = v >> 5, qb = v & 31;
                const bf16* kv = MEMKV + (size_t)l * NMEM * 1024;
                att::attn_dense_body<128, DINP, 1024, D, 1>(PROJ + (size_t)qb * 256 * DINP + PC_MEM + h * 128, kv + h * 128, nullptr, kv + 512 + h * 128,
                                                            nullptr, YPRE + (size_t)qb * 256 * D + 1536 + h * 128, NMEM, 0.08838834764831845f, (LAS char*)F.lds);
                QPULL(u);
            }
            if (ATT_EN & 4) while (u < NU) {
                const int w = (u - NU_MLA - NU_MEM) * 8 + F.wave;
                const int b = w / 1536, h = (w % 1536) >> 8, tile = w & 255;
                const int d = b == 0 ? 1 : (b == 1 ? 4 : 16), nT = S / d, tpr = nT / 32;
                const int r = tile / tpr, t0 = (tile % tpr) * 32;
                att::dil_wave_unit<DINP>(PROJ, PC_DIL + h * 128, PC_DIL + 768 + h * 128, PC_DIL + 1536 + h * 128, d, r, t0, nT,
                                         DILO + (size_t)b * S * 768, h * 128, DILS + (size_t)b * S * 12 + h * 2,
                                         (LAS char*)F.lds + F.wave * 8192, BIAS + (b * 6 + h) * 132, 0.08838834764831845f * att::LOG2E, F.lane);
                QPULL(u);
            }
#undef QPULL
            }
            FILL(pb + 3);
            if (BOTH(pb + 3)) GRID_BAR();
        }
        if (PEN(5) && IN(pb + 4)) { PHASE_BEGIN();
            const float* gn = args.in[12] + (size_t)l * D;
            for (int m = F.gw; m < S; m += F.NGW) {
                const float* yr = YPRE + (size_t)m * D;
                f32x4 a[3]; float sa = 0.f;
#pragma unroll
                for (int j = 0; j < 3; ++j) { a[j] = *(const GAS f32x4*)(yr + (F.lane + 64 * j) * 4); sa += (a[j].x * a[j].x + a[j].y * a[j].y) + (a[j].z * a[j].z + a[j].w * a[j].w); }
                f32x4 c[2]; float sc = 0.f;
#pragma unroll
                for (int j = 0; j < 2; ++j) { c[j] = *(const GAS f32x4*)(yr + 1536 + (F.lane + 64 * j) * 4); sc += (c[j].x * c[j].x + c[j].y * c[j].y) + (c[j].z * c[j].z + c[j].w * c[j].w); }
                f32x4 bq[3]; float sb = 0.f;
#pragma unroll
                for (int j = 0; j < 3; ++j) { const int col = (F.lane + 64 * j) * 4, h = col >> 7;
                    float mm[3], zz[3];
#pragma unroll
                    for (int b = 0; b < 3; ++b) { const f32x2 st = *(const GAS f32x2*)(DILS + ((size_t)b * S + m) * 12 + h * 2); mm[b] = st.x; zz[b] = st.y; }
                    const float M = fmaxf(mm[0], fmaxf(mm[1], mm[2]));
                    float wgt[3], den = 0.f;
#pragma unroll
                    for (int b = 0; b < 3; ++b) { wgt[b] = __builtin_amdgcn_exp2f(mm[b] - M); den += wgt[b] * zz[b]; }
                    const float inv = 1.f / den; f32x4 acc = {0.f, 0.f, 0.f, 0.f};
#pragma unroll
                    for (int b = 0; b < 3; ++b) { const f32x4 ob = *(const GAS f32x4*)(DILO + ((size_t)b * S + m) * 768 + col); acc += ob * (wgt[b] * inv); }
                    bq[j] = acc; sb += (acc.x * acc.x + acc.y * acc.y) + (acc.z * acc.z + acc.w * acc.w); }
                const float ra = 1.f / sqrtf(wave_sum(sa) * (1.f / 768.f) + EPS), rb = 1.f / sqrtf(wave_sum(sb) * (1.f / 768.f) + EPS), rc = 1.f / sqrtf(wave_sum(sc) * (1.f / 512.f) + EPS);
                bf16* yo = Y + (size_t)m * D;
#pragma unroll
                for (int j = 0; j < 3; ++j) { const int col = (F.lane + 64 * j) * 4; const f32x4 g = *(const GAS f32x4*)(gn + col);
                    v2u w; w.x = pk2(a[j].x * ra * g.x, a[j].y * ra * g.y); w.y = pk2(a[j].z * ra * g.z, a[j].w * ra * g.w); *(GAS v2u*)(yo + col) = w; }
#pragma unroll
                for (int j = 0; j < 3; ++j) { const int col = (F.lane + 64 * j) * 4; const f32x4 g = *(const GAS f32x4*)(gn + 768 + col);
                    v2u w; w.x = pk2(bq[j].x * rb * g.x, bq[j].y * rb * g.y); w.y = pk2(bq[j].z * rb * g.z, bq[j].w * rb * g.w); *(GAS v2u*)(yo + 768 + col) = w; }
#pragma unroll
                for (int j = 0; j < 2; ++j) { const int col = (F.lane + 64 * j) * 4; const f32x4 g = *(const GAS f32x4*)(gn + 1536 + col);
                    v2u w; w.x = pk2(c[j].x * rc * g.x, c[j].y * rc * g.y); w.y = pk2(c[j].z * rc * g.z, c[j].w * rc * g.w); *(GAS v2u*)(yo + 1536 + col) = w; }
            }
            if (BOTH(pb + 4)) GRID_BAR();
        }
        if (PEN(6) && IN(pb + 5)) { PHASE_BEGIN();
            pg8::Gemm g{Y, WOUT + (size_t)l * D * D, 2 * D, 2 * D, D / 64}; pg8::StaticOrder So; So.init(S, D, F.G, (int)blockIdx.x);
            pg8::EpiResF32 E{l == 0 ? x_in : XA, XA, D, 1.f};
            pg8::gemm_phase<pg8::EpiResF32, pg8::StaticOrder, true, true>(F.lds, g, So, E);
            if (BOTH(pb + 5)) GRID_BAR();
        }
        if (PEN(7) && IN(pb + 6)) { PHASE_BEGIN();
            const float* gf = args.in[14] + (size_t)l * D;
            if (l == 0) { for (int m = F.gw; m < S; m += F.NGW) { if constexpr (F8D) rms_row_to_fp8(XA + (size_t)m * D, gf, XN8 + (size_t)m * D, F.lane); else rms_row_to_bf16(XA + (size_t)m * D, gf, XN + (size_t)m * D, F.lane); } }
            else {
                const float* Wr = args.in[18];
                for (int m = F.gw; m < S; m += F.NGW) {
                    const GAS f32x4* xr = (const GAS f32x4*)(XA + (size_t)m * D) + F.lane; const GAS f32x4* gr = (const GAS f32x4*)gf + F.lane;
                    f32x4 v[8]; float s = 0.f;
#pragma unroll
                    for (int j = 0; j < 8; ++j) { v[j] = xr[64 * j]; s += (v[j].x * v[j].x + v[j].y * v[j].y) + (v[j].z * v[j].z + v[j].w * v[j].w); }
                    const float rstd = 1.f / sqrtf(wave_sum(s) * (1.f / D) + EPS);
                    float lg[8] = {0.f, 0.f, 0.f, 0.f, 0.f, 0.f, 0.f, 0.f};
                    GAS v2u* o8 = (GAS v2u*)(XN + (size_t)m * D) + F.lane; GAS unsigned* o4 = (GAS unsigned*)(XN8 + (size_t)m * D) + F.lane;
#pragma unroll
                    for (int j = 0; j < 8; ++j) { const f32x4 gg = gr[64 * j]; const f32x4 hh = {v[j].x * rstd * gg.x, v[j].y * rstd * gg.y, v[j].z * rstd * gg.z, v[j].w * rstd * gg.w};
                        if constexpr (F8M) o4[64 * j] = pk4_fp8(hh.x, hh.y, hh.z, hh.w); else { v2u w; w.x = pk2(hh.x, hh.y); w.y = pk2(hh.z, hh.w); o8[64 * j] = w; }
                        const float* wr = Wr + (size_t)((F.lane + 64 * j) * 4) * NE;
#pragma unroll
                        for (int q = 0; q < 4; ++q) { const f32x4 w0 = *(const GAS f32x4*)(wr + q * NE), w1 = *(const GAS f32x4*)(wr + q * NE + 4); const float hv = hh[q];
                            lg[0] += hv * w0.x; lg[1] += hv * w0.y; lg[2] += hv * w0.z; lg[3] += hv * w0.w; lg[4] += hv * w1.x; lg[5] += hv * w1.y; lg[6] += hv * w1.z; lg[7] += hv * w1.w; } }
#pragma unroll
                    for (int e = 0; e < NE; ++e) lg[e] = wave_sum(lg[e]);
                    int e1 = 0; float v1 = lg[0];
#pragma unroll
                    for (int e = 1; e < NE; ++e) if (lg[e] > v1) { v1 = lg[e]; e1 = e; }
                    int e2 = -1; float v2 = -3.0e38f;
#pragma unroll
                    for (int e = 0; e < NE; ++e) if (e != e1 && lg[e] > v2) { v2 = lg[e]; e2 = e; }
                    const float g1 = 1.f / (1.f + __expf(v2 - v1)), g2 = 1.f - g1;
                    if (F.lane == 0) { const unsigned s1 = __hip_atomic_fetch_add(F.ctl + CW_CNT + e1, 1u, RLX_AGENT), s2 = __hip_atomic_fetch_add(F.ctl + CW_CNT + e2, 1u, RLX_AGENT);
                        v4u r0 = {(unsigned)e1, (unsigned)e2, s1, s2}; v4u r1 = {__float_as_uint(g1), __float_as_uint(g2), 0u, 0u};
                        *(GAS v4u*)(ROUTE + (size_t)m * 8) = r0; *(GAS v4u*)(ROUTE + (size_t)m * 8 + 4) = r1; }
                }
            }
            if (BOTH(pb + 6)) GRID_BAR();
        }
        if (PEN(8) && IN(pb + 7)) { PHASE_BEGIN();
            if (l == 1) {
                moe_cvt_fill(F, args, -1);
                int base[NE]; int tstart = 0;
#pragma unroll
                for (int e = 0; e < NE; ++e) { const int c = (int)__hip_atomic_load(F.ctl + CW_CNT + e, RLX_AGENT); base[e] = tstart * 256; const int nt = (c + 255) >> 8;
                    if (blockIdx.x == 0 && F.tid == 0) { for (int t = 0; t < nt; ++t) F.ctl[CW_TILEE + 1 + tstart + t] = (unsigned)e; }
                    tstart += nt; }
                if (blockIdx.x == 0 && F.tid == 0) F.ctl[CW_TILEE] = (unsigned)tstart;
                for (int m = F.gw; m < S; m += F.NGW) {
                    const v4u r0 = *(const GAS v4u*)(ROUTE + (size_t)m * 8);
                    int p1 = (int)r0.z, p2 = (int)r0.w;
#pragma unroll
                    for (int e = 0; e < NE; ++e) { if ((int)r0.x == e) p1 += base[e]; if ((int)r0.y == e) p2 += base[e]; }
                    if (F.lane == 0) { ROUTE[(size_t)m * 8 + 6] = (unsigned)p1; ROUTE[(size_t)m * 8 + 7] = (unsigned)p2; }
                    const unsigned char* srow = (const unsigned char*)XN8 + (size_t)m * D * EBM; unsigned char* xp = (unsigned char*)XP;
                    const GAS v4u* src = (const GAS v4u*)srow + F.lane; GAS v4u* d1 = (GAS v4u*)(xp + (size_t)p1 * D * EBM) + F.lane; GAS v4u* d2 = (GAS v4u*)(xp + (size_t)p2 * D * EBM) + F.lane;
#pragma unroll
                    for (int j = 0; j < 2 * EBM; ++j) { const v4u t = src[64 * j]; d1[64 * j] = t; d2[64 * j] = t; }
                }
            }
            if (BOTH(pb + 7) && l == 1) GRID_BAR();
        }
        if (PEN(9) && IN(pb + 8)) { PHASE_BEGIN();
            if (l == 0) { pg8::Gemm g{XN8, WGU, D * EBD, D * EBD, D * EBD / 128}; pg8::StaticOrder So; So.init(S, 2 * DFF, F.G, (int)blockIdx.x);
                FfnEpi1<F8D> E = Epi1Maker<F8D>::make(ACT, DFF);
                pg8::gemm_phase<FfnEpi1<F8D>, pg8::StaticOrder, true, true, F8D>(F.lds, g, So, E); }
            else { const int ntile = (int)__hip_atomic_load(F.ctl + CW_TILEE, RLX_AGENT);
                pg8::Gemm g{XP, MGU, D * EBM, D * EBM, D * EBM / 128}; pg8::MoeOrder So{F.G, (int)blockIdx.x, 2 * DFE / 256, ntile, 2 * DFE, (const int*)(F.ctl + CW_TILEE + 1)};
                FfnEpi1<F8M> E = Epi1Maker<F8M>::make(ACTP, DFE);
                pg8::gemm_phase<FfnEpi1<F8M>, pg8::MoeOrder, true, true, F8M>(F.lds, g, So, E); }
            if (BOTH(pb + 8)) GRID_BAR();
        }
        if (PEN(10) && IN(pb + 9)) { PHASE_BEGIN();
            if (l == 0) { pg8::Gemm g{ACT, WDN, DFF * EBD, DFF * EBD, DFF * EBD / 128}; pg8::StaticOrder So; So.init(S, D, F.G, (int)blockIdx.x);
                pg8::EpiResF32 E{XA, XA, D, Sc<F8D>::dn};
                pg8::gemm_phase<pg8::EpiResF32, pg8::StaticOrder, true, true, F8D>(F.lds, g, So, E); }
            else { const int ntile = (int)__hip_atomic_load(F.ctl + CW_TILEE, RLX_AGENT);
                pg8::Gemm g{ACTP, MDN, DFE * EBM, DFE * EBM, DFE * EBM / 128}; pg8::MoeOrder So{F.G, (int)blockIdx.x, D / 256, ntile, D, (const int*)(F.ctl + CW_TILEE + 1)};
                pg8::EpiBf16 E{OUTP, D, Sc<F8M>::dn};
                pg8::gemm_phase<pg8::EpiBf16, pg8::MoeOrder, true, true, F8M>(F.lds, g, So, E); }
            if (BOTH(pb + 9)) GRID_BAR();
        }
        if (PEN(11) && IN(pb + 10)) { PHASE_BEGIN();
            if (l == 0) { for (int m = F.gw; m < S; m += F.NGW) rms_row_to_bf16(XA + (size_t)m * D, args.in[4] + D, XN + (size_t)m * D, F.lane); }
            else {
                const float* gfin = args.in[22];
                for (int m = F.gw; m < S; m += F.NGW) {
                    const v4u r1 = *(const GAS v4u*)(ROUTE + (size_t)m * 8 + 4);
                    const float g1 = __uint_as_float(r1.x), g2 = __uint_as_float(r1.y); const int p1 = (int)r1.z, p2 = (int)r1.w;
                    const GAS f32x4* xr = (const GAS f32x4*)(XA + (size_t)m * D) + F.lane;
                    const GAS v2u* o1 = (const GAS v2u*)(OUTP + (size_t)p1 * D) + F.lane; const GAS v2u* o2 = (const GAS v2u*)(OUTP + (size_t)p2 * D) + F.lane;
                    f32x4 v[8]; float s = 0.f;
#pragma unroll
                    for (int j = 0; j < 8; ++j) { const f32x4 xv = xr[64 * j]; const v2u a = o1[64 * j], b = o2[64 * j];
                        v[j].x = xv.x + g1 * bflo(a.x) + g2 * bflo(b.x); v[j].y = xv.y + g1 * bfhi(a.x) + g2 * bfhi(b.x);
                        v[j].z = xv.z + g1 * bflo(a.y) + g2 * bflo(b.y); v[j].w = xv.w + g1 * bfhi(a.y) + g2 * bfhi(b.y);
                        s += (v[j].x * v[j].x + v[j].y * v[j].y) + (v[j].z * v[j].z + v[j].w * v[j].w); }
                    const float rstd = 1.f / sqrtf(wave_sum(s) * (1.f / D) + EPS);
                    GAS f32x4* orow = (GAS f32x4*)(args.out + (size_t)m * D) + F.lane; const GAS f32x4* gr = (const GAS f32x4*)gfin + F.lane;
#pragma unroll
                    for (int j = 0; j < 8; ++j) { const f32x4 gg = gr[64 * j]; orow[64 * j] = (f32x4){v[j].x * rstd * gg.x, v[j].y * rstd * gg.y, v[j].z * rstd * gg.z, v[j].w * rstd * gg.w}; }
                }
            }
            if (BOTH(pb + 10) && l == 0) GRID_BAR();
        }
    }
#undef IN
#undef BOTH
#undef GRID_BAR
#undef WIN
#undef WUP
#undef WMEM
#undef WOUT
#undef WGU
#undef WDN
#undef MGU
#undef MDN
#undef XN
#undef MEMN
#undef MEMKV
#undef PROJ
#undef AQKV
#undef KROPE
#undef ROPECS
#undef QKVM
#undef YPRE
#undef DILO
#undef DILS
#undef Y
#undef XA
#undef ROUTE
#undef XP
#undef OUTP
#undef ACTP
#undef ACT
#undef x_in
#undef XN8
#undef PHASE_BEGIN
#undef FILL
}

extern "C" void kernel_launch(void* const* d_in, const int* in_sizes, int n_in, void* d_out, int out_size, void* d_ws, size_t ws_size, hipStream_t stream) {
    static int grid = 0;
    if (grid == 0) {
        if (n_in != 23 || in_sizes[0] != S * D || out_size != S * D || ws_size < WS_END) { fprintf(stderr, "kernel_launch: shape/workspace mismatch: n_in %d in0 %d out %d ws %zu (need %zu)\n", n_in, n_in > 0 ? in_sizes[0] : -1, out_size, ws_size, (size_t)WS_END); grid = -1; return; }
        int dev = 0, cus = 0, per_cu = 0;
        if (hipGetDevice(&dev) != hipSuccess || hipDeviceGetAttribute(&cus, hipDeviceAttributeMultiprocessorCount, dev) != hipSuccess) { fprintf(stderr, "kernel_launch: device query failed\n"); grid = -1; return; }
        if (hipFuncSetAttribute((const void*)mk_fwd, hipFuncAttributeMaxDynamicSharedMemorySize, LDS_BYTES) != hipSuccess) { fprintf(stderr, "kernel_launch: hipFuncSetAttribute failed\n"); grid = -1; return; }
        if (hipOccupancyMaxActiveBlocksPerMultiprocessor(&per_cu, (const void*)mk_fwd, NWAVES * 64, LDS_BYTES) != hipSuccess || per_cu < 1) { fprintf(stderr, "kernel_launch: occupancy query reports %d workgroups per CU\n", per_cu); }
        (void)hipGetLastError();
        grid = cus;
    }
    if (grid < 0) return;
    (void)hipMemsetAsync((char*)d_ws + WS_CTL, 0, CTL_ZERO_BYTES, stream);
    (void)hipMemsetAsync((char*)d_ws + WS_WIN, 0, (size_t)2 * DINP * D * 2, stream);
    (void)hipMemsetAsync((char*)d_ws + WS_WUP, 0, (size_t)2 * NUP * AQ * 2, stream);
    Args a{};
    for (int i = 0; i < 23; ++i) a.in[i] = (const float*)d_in[i];
    a.out = (float*)d_out; a.ws = (unsigned char*)d_ws;
    for (int i = 0; i < 32; ++i) a.invf[i] = 1.0f / powf(10000.0f, (float)i / 32.0f);
    for (int li = 0; li < N_LAUNCHES; ++li) {
        a.ph_lo = (N_LAUNCHES == 1) ? 0 : li; a.ph_hi = (N_LAUNCHES == 1) ? N_PHASES : li + 1; a.li = li; a.pad = 0;
        hipLaunchKernelGGL(mk_fwd, dim3(grid), dim3(NWAVES * 64), LDS_BYTES, stream, a);
        const hipError_t le = hipPeekAtLastError();
        if (le != hipSuccess) { fprintf(stderr, "kernel_launch: launch %d failed: %s\n", li, hipGetErrorName(le)); break; }
    }
}
```

```cpp
#include <hip/hip_runtime.h>
#include <cstdio>
#include <cstdint>
#include <cmath>
#include <type_traits>
#ifndef MK_N_LAUNCHES
#define MK_N_LAUNCHES 1
#endif
#define REPEAT_PHASE -1
#define FFN_FP8 3
#define PROBE_PHASE -1
#define PROBE_REPS 3
namespace pg8 {
#define PG8_LAS __attribute__((address_space(3)))
typedef unsigned short bf16_t;
typedef short bf16x8 __attribute__((ext_vector_type(8)));
typedef float f32x4 __attribute__((ext_vector_type(4)));
typedef unsigned u32x4 __attribute__((ext_vector_type(4)));
constexpr int BM = 256, BK = 64, HALF = 128, HTB = HALF * BK * 2  , STAGE_BYTES = 8 * HTB, NXCD = 8, WGM = 8;

__host__ __device__ __forceinline__ int lds_byte(int r, int c) { const int st = (r >> 4) * 2 + (c >> 5), rr = r & 15, cc = c & 31, ob = rr * 64 + cc * 2; return st * 1024 + (ob ^ (((ob >> 9) & 1) << 5)); }
__host__ __device__ __forceinline__ void stage_rc(int b, int& R, int& C) { const int st = b / 1024, sb = b % 1024, swz = sb ^ (((sb >> 9) & 1) << 5); R = (st >> 1) * 16 + swz / 64; C = (st & 1) * 32 + (swz % 64) / 2; }
__host__ __device__ __forceinline__ int perm32(int rho) { const int n = rho >> 4, i = rho & 15; return 8 * (i >> 2) + 4 * n + (i & 3); }

struct Unit { int pm, pn; };
struct Gemm { const void* A; const void* Bt; int lda, ldb, nt; };

struct StaticOrder {
    int nM, nN, nwg, G, c;
    __device__ void init(int M, int N, int G_, int c_) { nM = M / BM; nN = N / BM; nwg = nM * nN; G = G_; c = c_; }
    __device__ bool next(int i, Unit& u) const {
        const long L = (long)i * G + c; if (L >= nwg) return false;
        int wgid = (int)L; { const int q = nwg / NXCD, r = nwg % NXCD, xcd = wgid % NXCD, off = wgid / NXCD; wgid = (xcd < r ? xcd * (q + 1) : r * (q + 1) + (xcd - r) * q) + off; }
        const int nig = WGM * nN, gid = wgid / nig, fm = gid * WGM, gsz = (nM - fm) < WGM ? (nM - fm) : WGM;
        u.pm = fm + ((wgid % nig) % gsz); u.pn = (wgid % nig) / gsz; return true;
    }
    __device__ __forceinline__ const char* abase(const Gemm& g, const Unit& u) const { return (const char*)g.A + (size_t)u.pm * BM * g.lda; }
    __device__ __forceinline__ const char* bbase(const Gemm& g, const Unit& u) const { return (const char*)g.Bt + (size_t)u.pn * BM * g.ldb; }
};
struct InProjOrder {
    StaticOrder so; int nextra; const void* A2; const void* B2;
    __device__ bool next(int i, Unit& u) const { if (so.next(i, u)) return true; const long L = (long)i * so.G + so.c - so.nwg; if (L < 0 || L >= nextra) return false; u.pm = 32 + (int)(L >> 2); u.pn = (int)(L & 3); return true; }
    __device__ __forceinline__ const char* abase(const Gemm& g, const Unit& u) const { return u.pm < 32 ? (const char*)g.A + (size_t)u.pm * BM * g.lda : (const char*)A2 + (size_t)(u.pm - 32) * BM * g.lda; }
    __device__ __forceinline__ const char* bbase(const Gemm& g, const Unit& u) const { return u.pm < 32 ? (const char*)g.Bt + (size_t)u.pn * BM * g.ldb : (const char*)B2 + (size_t)((u.pm - 32) * 1024 + u.pn * BM) * g.ldb; }
};
struct MemOrder {
    int G, c;
    __device__ bool next(int i, Unit& u) const { const int L = c - (G - 8); if (i != 0 || L < 0 || L >= 8) return false; u.pm = L >> 2; u.pn = L & 3; return true; }
    __device__ __forceinline__ const char* abase(const Gemm& g, const Unit& u) const { return (const char*)g.A + (size_t)u.pm * BM * g.lda; }
    __device__ __forceinline__ const char* bbase(const Gemm& g, const Unit& u) const { return (const char*)g.Bt + (size_t)(u.pm * 1024 + u.pn * BM) * g.ldb; }
};
struct MoeOrder {
    int G, c, nN, ntile, nexp_rows; const int* tile_e;
    __device__ bool next(int i, Unit& u) const { const long L = (long)i * G + c; if (L >= (long)ntile * nN) return false; u.pm = (int)(L / nN); u.pn = (int)(L % nN); return true; }
    __device__ __forceinline__ const char* abase(const Gemm& g, const Unit& u) const { return (const char*)g.A + (size_t)u.pm * BM * g.lda; }
    __device__ __forceinline__ const char* bbase(const Gemm& g, const Unit& u) const { const int e = __builtin_amdgcn_readfirstlane(tile_e[u.pm]); return (const char*)g.Bt + ((size_t)e * nexp_rows + (size_t)u.pn * BM) * g.ldb; }
};

__device__ __forceinline__ unsigned cvt_pk_bf16(float lo, float hi) { unsigned r; asm volatile("v_cvt_pk_bf16_f32 %0, %1, %2" : "=v"(r) : "v"(lo), "v"(hi)); return r; }

struct EpiBf16 {
    static constexpr bool PERM = true;
    bf16_t* O; int ldc; float sc;
    __device__ __forceinline__ void operator()(const f32x4 (&acc)[2][2][4][2], const Unit& u, int wr, int wc, int fr, int fq) const {
        const int row0 = u.pm * BM + wr * 64 + fr, col0 = u.pn * BM + wc * 32 + 8 * fq;
#pragma unroll
        for (int ai = 0; ai < 2; ++ai)
#pragma unroll
            for (int m = 0; m < 4; ++m) { bf16_t* rowp = O + (size_t)(row0 + ai * HALF + m * 16) * ldc + col0;
#pragma unroll
                for (int bj = 0; bj < 2; ++bj) { const f32x4 v0 = acc[ai][bj][m][0] * sc, v1 = acc[ai][bj][m][1] * sc;
                    u32x4 w; w.x = cvt_pk_bf16(v0[0], v0[1]); w.y = cvt_pk_bf16(v0[2], v0[3]); w.z = cvt_pk_bf16(v1[0], v1[1]); w.w = cvt_pk_bf16(v1[2], v1[3]);
                    *(u32x4*)(rowp + bj * HALF) = w; } }
    }
};
struct EpiBf16Sel {
    static constexpr bool PERM = true;
    bf16_t* O; int ldc; bf16_t* O2; int ldc2;
    __device__ __forceinline__ void operator()(const f32x4 (&acc)[2][2][4][2], const Unit& u, int wr, int wc, int fr, int fq) const {
        const bool ex = u.pm >= 32; bf16_t* base = ex ? O2 : O; const int ld = ex ? ldc2 : ldc;
        const int row0 = (ex ? u.pm - 32 : u.pm) * BM + wr * 64 + fr, col0 = u.pn * BM + wc * 32 + 8 * fq;
#pragma unroll
        for (int ai = 0; ai < 2; ++ai)
#pragma unroll
            for (int m = 0; m < 4; ++m) { bf16_t* rowp = base + (size_t)(row0 + ai * HALF + m * 16) * ld + col0;
#pragma unroll
                for (int bj = 0; bj < 2; ++bj) { const f32x4 v0 = acc[ai][bj][m][0], v1 = acc[ai][bj][m][1];
                    u32x4 w; w.x = cvt_pk_bf16(v0[0], v0[1]); w.y = cvt_pk_bf16(v0[2], v0[3]); w.z = cvt_pk_bf16(v1[0], v1[1]); w.w = cvt_pk_bf16(v1[2], v1[3]);
                    *(u32x4*)(rowp + bj * HALF) = w; } }
    }
};
struct EpiResF32 {
    static constexpr bool PERM = false;
    const float* R; float* C; int ldc; float sc;
    __device__ __forceinline__ void operator()(const f32x4 (&acc)[2][2][4][2], const Unit& u, int wr, int wc, int fr, int fq) const {
        const int row0 = u.pm * BM + wr * 64 + fr, col0 = u.pn * BM + wc * 32 + 4 * fq;
#pragma unroll
        for (int ai = 0; ai < 2; ++ai)
#pragma unroll
            for (int m = 0; m < 4; ++m) { const size_t off = (size_t)(row0 + ai * HALF + m * 16) * ldc + col0;
#pragma unroll
                for (int bj = 0; bj < 2; ++bj)
#pragma unroll
                    for (int n = 0; n < 2; ++n) { const f32x4 r = *(const f32x4*)(R + off + bj * HALF + n * 16); *(f32x4*)(C + off + bj * HALF + n * 16) = r + acc[ai][bj][m][n] * sc; } }
    }
};
__device__ __forceinline__ float silu_mul(float g, float u) { return g * u * __builtin_amdgcn_rcpf(1.0f + __builtin_amdgcn_exp2f(-1.4426950408889634f * g)); }
struct EpiSwiGLU {
    static constexpr bool PERM = true;
    bf16_t* O; int ldc;
    __device__ __forceinline__ void operator()(const f32x4 (&acc)[2][2][4][2], const Unit& u, int wr, int wc, int fr, int fq) const {
        const int row0 = u.pm * BM + wr * 64 + fr, col0 = u.pn * HALF + wc * 32 + 8 * fq;
#pragma unroll
        for (int ai = 0; ai < 2; ++ai)
#pragma unroll
            for (int m = 0; m < 4; ++m) { bf16_t* rowp = O + (size_t)(row0 + ai * HALF + m * 16) * ldc + col0;
                const f32x4 g0 = acc[ai][0][m][0], g1 = acc[ai][0][m][1], u0 = acc[ai][1][m][0], u1 = acc[ai][1][m][1];
                u32x4 w; w.x = cvt_pk_bf16(silu_mul(g0[0], u0[0]), silu_mul(g0[1], u0[1])); w.y = cvt_pk_bf16(silu_mul(g0[2], u0[2]), silu_mul(g0[3], u0[3]));
                w.z = cvt_pk_bf16(silu_mul(g1[0], u1[0]), silu_mul(g1[1], u1[1])); w.w = cvt_pk_bf16(silu_mul(g1[2], u1[2]), silu_mul(g1[3], u1[3]));
                *(u32x4*)rowp = w; }
    }
};

typedef int v8i_t __attribute__((ext_vector_type(8)));
__device__ __forceinline__ v8i_t pg8_cat(bf16x8 lo, bf16x8 hi) { typedef int v4i_t __attribute__((ext_vector_type(4))); const v4i_t a = __builtin_bit_cast(v4i_t, lo), b = __builtin_bit_cast(v4i_t, hi); return (v8i_t){a.x, a.y, a.z, a.w, b.x, b.y, b.z, b.w}; }
struct EpiSwiGLU8 {
    static constexpr bool PERM = true;
    unsigned char* O; int ldc; float sc_in, sc_out;
    __device__ __forceinline__ void operator()(const f32x4 (&acc)[2][2][4][2], const Unit& u, int wr, int wc, int fr, int fq) const {
        const int row0 = u.pm * BM + wr * 64 + fr, col0 = u.pn * HALF + wc * 32 + 8 * fq;
#pragma unroll
        for (int ai = 0; ai < 2; ++ai)
#pragma unroll
            for (int m = 0; m < 4; ++m) { unsigned char* rowp = O + (size_t)(row0 + ai * HALF + m * 16) * ldc + col0;
                const f32x4 g0 = acc[ai][0][m][0] * sc_in, g1 = acc[ai][0][m][1] * sc_in, u0 = acc[ai][1][m][0] * (sc_in * sc_out), u1 = acc[ai][1][m][1] * (sc_in * sc_out);
                int w0 = 0, w1 = 0;
                w0 = __builtin_amdgcn_cvt_pk_fp8_f32(silu_mul(g0[0], u0[0]), silu_mul(g0[1], u0[1]), w0, false); w0 = __builtin_amdgcn_cvt_pk_fp8_f32(silu_mul(g0[2], u0[2]), silu_mul(g0[3], u0[3]), w0, true);
                w1 = __builtin_amdgcn_cvt_pk_fp8_f32(silu_mul(g1[0], u1[0]), silu_mul(g1[1], u1[1]), w1, false); w1 = __builtin_amdgcn_cvt_pk_fp8_f32(silu_mul(g1[2], u1[2]), silu_mul(g1[3], u1[3]), w1, true);
                typedef int v2i_t __attribute__((ext_vector_type(2))); *(v2i_t*)rowp = (v2i_t){w0, w1}; }
    }
};
__device__ __forceinline__ void pg8_mfma8(f32x4& c, v8i_t a, v8i_t b, int sc) { asm volatile("v_mfma_scale_f32_16x16x128_f8f6f4 %0, %1, %2, %0, %3, %3 op_sel_hi:[0,0,0]" : "+v"(c) : "v"(a), "v"(b), "v"(sc)); }
template <class Epi, class Sched, bool ALIGN_EPI = false, bool SP2 = false, bool FP8 = false>
__device__ __forceinline__ void gemm_phase(PG8_LAS unsigned char* lds, const Gemm g, const Sched& S, const Epi& E) {
    int tid_ = threadIdx.x; asm volatile("" : "+v"(tid_));
    const int tid = tid_, wid = __builtin_amdgcn_readfirstlane(tid >> 6), lane = tid & 63, wr = wid >> 2, wc = wid & 3, fr = lane & 15, fq = lane >> 4;
    const int nt = g.nt;
    unsigned voffA[2], voffB[2];
#pragma unroll
    for (int i = 0; i < 2; ++i) { int R, C; stage_rc(tid * 16 + i * 8192, R, C); const int Rb = Epi::PERM ? ((R & ~31) + perm32(R & 31)) : R;
        voffA[i] = (unsigned)(R * g.lda + C * 2); voffB[i] = (unsigned)(Rb * g.ldb + C * 2); }
    const size_t kstep = (size_t)(BK * 2);
    const size_t hstepA = (size_t)HALF * g.lda, hstepB = (size_t)HALF * g.ldb;
    const unsigned ldsw = (unsigned)wid * 1024u;
    const int aoff = lds_byte(wr * 64 + fr, fq * 8), boff = lds_byte(wc * 32 + fr, fq * 8);
#define PG8_SA(b, h) (((b) * 2 + (h)) * HTB)
#define PG8_SB(b, h) ((4 + (b) * 2 + (h)) * HTB)
#define PG8_STAGE(bufoff, gbase, voff) do { _Pragma("unroll") for (int _i = 0; _i < 2; ++_i) \
        __builtin_amdgcn_global_load_lds((const unsigned*)((const char*)(gbase) + (voff)[_i]), (PG8_LAS unsigned*)(lds + (bufoff) + ldsw + _i * 8192), 16, 0, 0); } while (0)
#define PG8_LDA(dst, b, h) do { _Pragma("unroll") for (int m = 0; m < 4; ++m) _Pragma("unroll") for (int k = 0; k < 2; ++k) dst[m][k] = *(const PG8_LAS bf16x8*)(lds + PG8_SA(b, h) + aoff + m * 2048 + k * 1024); } while (0)
#define PG8_LDB(dst, b, h) do { _Pragma("unroll") for (int n = 0; n < 2; ++n) _Pragma("unroll") for (int k = 0; k < 2; ++k) dst[n][k] = *(const PG8_LAS bf16x8*)(lds + PG8_SB(b, h) + boff + n * 2048 + k * 1024); } while (0)
#define PG8_MMA(ai, bj, At, Bt) do { __builtin_amdgcn_s_setprio(1); if constexpr (FP8) { _Pragma("unroll") for (int m = 0; m < 4; ++m) _Pragma("unroll") for (int n = 0; n < 2; ++n) \
        pg8_mfma8(acc[ai][bj][m][n], pg8_cat(Bt[n][0], Bt[n][1]), pg8_cat(At[m][0], At[m][1]), sc8); } else { \
        _Pragma("unroll") for (int m = 0; m < 4; ++m) _Pragma("unroll") for (int n = 0; n < 2; ++n) _Pragma("unroll") for (int k = 0; k < 2; ++k) \
        acc[ai][bj][m][n] = __builtin_amdgcn_mfma_f32_16x16x32_bf16(Bt[n][k], At[m][k], acc[ai][bj][m][n], 0, 0, 0); } __builtin_amdgcn_s_setprio(0); } while (0)
#define PG8_WAIT_V(n) asm volatile("s_waitcnt vmcnt(" #n ")" ::: "memory")
#define PG8_WAIT_L(n) asm volatile("s_waitcnt lgkmcnt(" #n ")" ::: "memory")
#define PG8_BAR __builtin_amdgcn_s_barrier()
#define PG8_SCHED __builtin_amdgcn_sched_barrier(0)
    Unit cur, nxt; int ui = 0;
    if (!S.next(0, cur)) return;
    int sc8 = 0x7F7F7F7F; asm volatile("" : "+v"(sc8));
    f32x4 acc[2][2][4][2];
#pragma unroll
    for (int a = 0; a < 2; ++a)
#pragma unroll
        for (int b = 0; b < 2; ++b)
#pragma unroll
            for (int m = 0; m < 4; ++m)
#pragma unroll
                for (int n = 0; n < 2; ++n) acc[a][b][m][n] = (f32x4){0.f, 0.f, 0.f, 0.f};
    bf16x8 At[4][2], B0[2][2], B1[2][2];
    const char* cA = S.abase(g, cur); const char* cB = S.bbase(g, cur);
    if constexpr (SP2) {
        PG8_STAGE(PG8_SB(0, 0), cB, voffB); PG8_STAGE(PG8_SB(0, 1), cB + hstepB, voffB); PG8_STAGE(PG8_SA(0, 0), cA, voffA); PG8_STAGE(PG8_SA(0, 1), cA + hstepA, voffA);
        if (wr == 1) PG8_BAR;
        PG8_WAIT_V(2); PG8_BAR;
        PG8_STAGE(PG8_SB(1, 0), cB + kstep, voffB); PG8_STAGE(PG8_SA(1, 0), cA + kstep, voffA); PG8_STAGE(PG8_SB(1, 1), cB + hstepB + kstep, voffB);
        PG8_WAIT_V(6); PG8_BAR;
    } else {
        PG8_STAGE(PG8_SB(0, 0), cB, voffB); PG8_STAGE(PG8_SA(0, 0), cA, voffA); PG8_STAGE(PG8_SB(0, 1), cB + hstepB, voffB); PG8_STAGE(PG8_SA(0, 1), cA + hstepA, voffA);
        if (wr == 1) PG8_BAR;
        PG8_WAIT_V(4); PG8_BAR;
        PG8_STAGE(PG8_SB(1, 0), cB + kstep, voffB); PG8_STAGE(PG8_SA(1, 0), cA + kstep, voffA); PG8_STAGE(PG8_SB(1, 1), cB + hstepB + kstep, voffB);
        PG8_WAIT_V(6); PG8_BAR;
    }
    for (;;) {
        const bool has_next = S.next(ui + 1, nxt);
        const char* nA = has_next ? S.abase(g, nxt) : cA; const char* nB = has_next ? S.bbase(g, nxt) : cB;
        for (int t = 0; t < nt; t += 2) {
            const bool last = (t == nt - 2);
            const char* a1 = cA + (size_t)(t + 1) * kstep;
            const char* a2 = last ? nA : cA + (size_t)(t + 2) * kstep; const char* b2 = last ? nB : cB + (size_t)(t + 2) * kstep;
            const char* a3 = a2 + kstep; const char* b3 = b2 + kstep;
            if constexpr (SP2) {
            PG8_LDB(B0, 0, 0); PG8_LDB(B1, 0, 1); PG8_SCHED; PG8_LDA(At, 0, 0); PG8_STAGE(PG8_SA(1, 1), a1 + hstepA, voffA);
            PG8_WAIT_V(8); PG8_WAIT_L(0); PG8_BAR; PG8_MMA(0, 0, At, B0); PG8_MMA(0, 1, At, B1); PG8_BAR; PG8_SCHED;
            PG8_LDA(At, 0, 1); PG8_STAGE(PG8_SB(0, 0), b2, voffB); PG8_STAGE(PG8_SB(0, 1), b2 + hstepB, voffB); PG8_STAGE(PG8_SA(0, 0), a2, voffA);
            PG8_WAIT_V(8); PG8_WAIT_L(0); PG8_BAR; PG8_MMA(1, 0, At, B0); PG8_MMA(1, 1, At, B1); PG8_BAR; PG8_SCHED;
            PG8_LDB(B0, 1, 0); PG8_LDB(B1, 1, 1); PG8_SCHED; PG8_LDA(At, 1, 0); PG8_STAGE(PG8_SA(0, 1), a2 + hstepA, voffA);
            PG8_WAIT_V(8); PG8_WAIT_L(0); PG8_BAR; PG8_MMA(0, 0, At, B0); PG8_MMA(0, 1, At, B1); PG8_BAR; PG8_SCHED;
            PG8_LDA(At, 1, 1); PG8_STAGE(PG8_SB(1, 0), b3, voffB); PG8_STAGE(PG8_SB(1, 1), b3 + hstepB, voffB); PG8_STAGE(PG8_SA(1, 0), a3, voffA);
            PG8_WAIT_V(8); PG8_WAIT_L(0); PG8_BAR; PG8_MMA(1, 0, At, B0); PG8_MMA(1, 1, At, B1); PG8_BAR; PG8_SCHED;
            } else {
            PG8_LDB(B0, 0, 0); PG8_SCHED; PG8_LDA(At, 0, 0); PG8_STAGE(PG8_SA(1, 1), a1 + hstepA, voffA);
            PG8_WAIT_L(8); PG8_BAR; PG8_WAIT_L(0); PG8_MMA(0, 0, At, B0); PG8_BAR; PG8_SCHED;
            PG8_LDB(B1, 0, 1); PG8_STAGE(PG8_SB(0, 0), b2, voffB);
            PG8_BAR; PG8_WAIT_L(0); PG8_MMA(0, 1, At, B1); PG8_BAR;
            PG8_LDA(At, 0, 1); PG8_STAGE(PG8_SA(0, 0), a2, voffA);
            PG8_BAR; PG8_WAIT_L(0); PG8_MMA(1, 0, At, B0); PG8_BAR; PG8_SCHED;
            PG8_STAGE(PG8_SB(0, 1), b2 + hstepB, voffB);
            PG8_WAIT_V(6); PG8_BAR; PG8_MMA(1, 1, At, B1); PG8_BAR;
            PG8_LDB(B0, 1, 0); PG8_SCHED; PG8_LDA(At, 1, 0); PG8_STAGE(PG8_SA(0, 1), a2 + hstepA, voffA);
            PG8_WAIT_L(8); PG8_BAR; PG8_WAIT_L(0); PG8_MMA(0, 0, At, B0); PG8_BAR; PG8_SCHED;
            PG8_LDB(B1, 1, 1); PG8_STAGE(PG8_SB(1, 0), b3, voffB);
            PG8_BAR; PG8_WAIT_L(0); PG8_MMA(0, 1, At, B1); PG8_BAR;
            PG8_LDA(At, 1, 1); PG8_STAGE(PG8_SA(1, 0), a3, voffA);
            PG8_BAR; PG8_WAIT_L(0); PG8_MMA(1, 0, At, B0); PG8_BAR; PG8_SCHED;
            PG8_STAGE(PG8_SB(1, 1), b3 + hstepB, voffB);
            PG8_WAIT_V(6); PG8_BAR; PG8_MMA(1, 1, At, B1); PG8_BAR;
            }
        }
        if constexpr (ALIGN_EPI) { if (wr == 0) PG8_BAR; }
        if constexpr (FP8) { PG8_SCHED; asm volatile("s_nop 15\n\ts_nop 7" ::: "memory"); PG8_SCHED; }
        E(acc, cur, wr, wc, fr, fq);
        if (!has_next) break;
#pragma unroll
        for (int a = 0; a < 2; ++a)
#pragma unroll
            for (int b = 0; b < 2; ++b)
#pragma unroll
                for (int m = 0; m < 4; ++m)
#pragma unroll
                    for (int n = 0; n < 2; ++n) acc[a][b][m][n] = (f32x4){0.f, 0.f, 0.f, 0.f};
        cur = nxt; cA = nA; cB = nB; ++ui;
        if constexpr (ALIGN_EPI) { if (wr == 1) PG8_BAR; }
    }
    PG8_WAIT_V(0);
    if constexpr (!ALIGN_EPI) { if (wr == 0) PG8_BAR; }
    PG8_BAR;
#undef PG8_SA
#undef PG8_SB
#undef PG8_STAGE
#undef PG8_LDA
#undef PG8_LDB
#undef PG8_MMA
#undef PG8_WAIT_V
#undef PG8_WAIT_L
#undef PG8_BAR
#undef PG8_SCHED
}
}
namespace att {
#define ATT_LAS __attribute__((address_space(3)))
#define ATT_GAS __attribute__((address_space(1)))
typedef unsigned short bf16;
using bf16x8 = __attribute__((ext_vector_type(8))) short;
using s16x4  = __attribute__((ext_vector_type(4))) short;
using f32x16 = __attribute__((ext_vector_type(16))) float;
using f32x4  = __attribute__((ext_vector_type(4))) float;
using u32x4  = __attribute__((ext_vector_type(4))) unsigned;
constexpr int NW = 8, QBLK = 32, KVBLK = 64, DV = 128;
constexpr float LOG2E = 1.4426950408889634f;
#define SBAR() __builtin_amdgcn_sched_barrier(0)
__device__ __forceinline__ int crow(int r, int hi) { return (r & 3) + 8 * (r >> 2) + 4 * hi; }
__device__ __forceinline__ unsigned cvtpk(float lo, float hi) { unsigned r; asm volatile("v_cvt_pk_bf16_f32 %0, %1, %2" : "=v"(r) : "v"(lo), "v"(hi)); return r; }
__device__ __forceinline__ float bf2f(short s) { return __uint_as_float(((unsigned)(unsigned short)s) << 16); }

__device__ __forceinline__ void partialSM(f32x16& p0, f32x16& p1, float& m_reg, float& mn, float& alpha, const float C, const float THRS) {
  float pmax = p0[0];
#pragma unroll
  for (int r = 1; r < 16; ++r) pmax = fmaxf(pmax, p0[r]);
#pragma unroll
  for (int r = 0; r < 16; ++r) pmax = fmaxf(pmax, p1[r]);
  { auto rr = __builtin_amdgcn_permlane32_swap(__float_as_uint(pmax), __float_as_uint(pmax), false, false);
    pmax = fmaxf(__uint_as_float(rr[0]), __uint_as_float(rr[1])); }
  if (__builtin_expect(__all(pmax - m_reg <= THRS), 1)) { mn = m_reg; alpha = 1.f; }
  else { mn = fmaxf(m_reg, pmax); alpha = __builtin_amdgcn_exp2f((m_reg - mn) * C); m_reg = mn; }
  float mnC = -mn * C;
#pragma unroll
  for (int r = 0; r < 16; ++r) p0[r] = fmaf(p0[r], C, mnC);
#pragma unroll
  for (int r = 0; r < 16; ++r) p1[r] = fmaf(p1[r], C, mnC);
#pragma unroll
  for (int r = 0; r < 16; ++r) p0[r] = __builtin_amdgcn_exp2f(p0[r]);
}
#define ATT_PK4(P, BASE, OUT) do { unsigned a0 = cvtpk(P[BASE + 0], P[BASE + 1]), a1 = cvtpk(P[BASE + 2], P[BASE + 3]);   \
    unsigned b0 = cvtpk(P[BASE + 4], P[BASE + 5]), b1 = cvtpk(P[BASE + 6], P[BASE + 7]);                              \
    auto r0 = __builtin_amdgcn_permlane32_swap(a0, b0, false, false); auto r1 = __builtin_amdgcn_permlane32_swap(a1, b1, false, false); \
    u32x4 w = {r0[0], r1[0], r0[1], r1[1]}; OUT = *reinterpret_cast<bf16x8*>(&w); } while (0)
__device__ __forceinline__ void finishSM(f32x16& p0, f32x16& p1, float alpha, float& l_reg, bf16x8& pa0, bf16x8& pa1, bf16x8& pa2, bf16x8& pa3) {
#pragma unroll
  for (int r = 0; r < 16; ++r) p1[r] = __builtin_amdgcn_exp2f(p1[r]);
  float ps = 0;
#pragma unroll
  for (int r = 0; r < 16; ++r) ps += p0[r];
#pragma unroll
  for (int r = 0; r < 16; ++r) ps += p1[r];
  { auto rr = __builtin_amdgcn_permlane32_swap(__float_as_uint(ps), __float_as_uint(ps), false, false);
    ps = __uint_as_float(rr[0]) + __uint_as_float(rr[1]); }
  l_reg = l_reg * alpha + ps;
  ATT_PK4(p0, 0, pa0); ATT_PK4(p0, 8, pa1); ATT_PK4(p1, 0, pa2); ATT_PK4(p1, 8, pa3);
}
template <int RB> __device__ __forceinline__ int kswz(int row, int colB) { return row * RB + (colB ^ ((row & 7) << 4)); }
template <int DQK> __device__ __forceinline__ void qkt(f32x16& p0, f32x16& p1, const ATT_LAS char* Ks, const bf16x8 (&qr)[DQK / 16], int r32, int hi) {
  p0 = f32x16{}; p1 = f32x16{};
#pragma unroll
  for (int d0 = 0; d0 < DQK / 16; ++d0) { const int cb = (d0 * 16 + hi * 8) * 2;
    bf16x8 b0 = *reinterpret_cast<const ATT_LAS bf16x8*>(Ks + kswz<DQK * 2>(r32, cb));
    bf16x8 b1 = *reinterpret_cast<const ATT_LAS bf16x8*>(Ks + kswz<DQK * 2>(32 + r32, cb));
    p0 = __builtin_amdgcn_mfma_f32_32x32x16_bf16(b0, qr[d0], p0, 0, 0, 0);
    p1 = __builtin_amdgcn_mfma_f32_32x32x16_bf16(b1, qr[d0], p1, 0, 0, 0); }
}
__device__ __forceinline__ int v_st(int k, int c) { const int kk = (k & ~0xC) | ((k & 4) << 1) | ((k & 8) >> 1); return ((kk >> 3) * 4 + (c >> 5)) * 512 + ((kk & 7) * 32 + (c & 31)) * 2; }
__device__ __forceinline__ int v_rd_base(int lane) { return ((lane & 3) << 3) | (((lane >> 2) & 3) << 6) | (((lane >> 4) & 1) << 5) | (((lane >> 5) & 1) << 8); }
constexpr int v_rd_off(int d0, int ks, int half) { return d0 * 512 + ks * 4096 + half * 2048; }
template <int OFF> __device__ __forceinline__ s16x4 tr_read(int vb) {
  s16x4 r; asm volatile("ds_read_b64_tr_b16 %0, %1 offset:%2" : "=&v"(r) : "v"(vb), "i"(OFF) : "memory"); return r;
}
#define ATT_PK(L, H) (bf16x8){L[0], L[1], L[2], L[3], H[0], H[1], H[2], H[3]}
template <int D0> __device__ __forceinline__ void pv_one(f32x16& od, int vb, bf16x8 pa0, bf16x8 pa1, bf16x8 pa2, bf16x8 pa3) {
  const s16x4 l0 = tr_read<v_rd_off(D0, 0, 0)>(vb), h0 = tr_read<v_rd_off(D0, 0, 1)>(vb), l1 = tr_read<v_rd_off(D0, 1, 0)>(vb), h1 = tr_read<v_rd_off(D0, 1, 1)>(vb);
  const s16x4 l2 = tr_read<v_rd_off(D0, 2, 0)>(vb), h2 = tr_read<v_rd_off(D0, 2, 1)>(vb), l3 = tr_read<v_rd_off(D0, 3, 0)>(vb), h3 = tr_read<v_rd_off(D0, 3, 1)>(vb);
  asm volatile("s_waitcnt lgkmcnt(0)" ::: "memory"); SBAR();
  od = __builtin_amdgcn_mfma_f32_32x32x16_bf16(pa0, ATT_PK(l0, h0), od, 0, 0, 0);
  od = __builtin_amdgcn_mfma_f32_32x32x16_bf16(pa1, ATT_PK(l1, h1), od, 0, 0, 0);
  od = __builtin_amdgcn_mfma_f32_32x32x16_bf16(pa2, ATT_PK(l2, h2), od, 0, 0, 0);
  od = __builtin_amdgcn_mfma_f32_32x32x16_bf16(pa3, ATT_PK(l3, h3), od, 0, 0, 0);
}
__device__ __forceinline__ void pv_d0(f32x16 (&o)[4], int vb, bf16x8 pa0, bf16x8 pa1, bf16x8 pa2, bf16x8 pa3) {
  pv_one<0>(o[0], vb, pa0, pa1, pa2, pa3); pv_one<1>(o[1], vb, pa0, pa1, pa2, pa3); pv_one<2>(o[2], vb, pa0, pa1, pa2, pa3); pv_one<3>(o[3], vb, pa0, pa1, pa2, pa3);
}
template <int D0> __device__ __forceinline__ void pv32_one(f32x16& od, int vb, bf16x8 pa0, bf16x8 pa1) {
  const s16x4 l0 = tr_read<v_rd_off(D0, 0, 0)>(vb), h0 = tr_read<v_rd_off(D0, 0, 1)>(vb), l1 = tr_read<v_rd_off(D0, 1, 0)>(vb), h1 = tr_read<v_rd_off(D0, 1, 1)>(vb);
  asm volatile("s_waitcnt lgkmcnt(0)" ::: "memory"); SBAR();
  od = __builtin_amdgcn_mfma_f32_32x32x16_bf16(pa0, ATT_PK(l0, h0), od, 0, 0, 0);
  od = __builtin_amdgcn_mfma_f32_32x32x16_bf16(pa1, ATT_PK(l1, h1), od, 0, 0, 0);
}

template <int DQK, int LDQ, int LDK, int LDO, int SDEPTH>
__device__ __forceinline__ void attn_dense_body(const bf16* __restrict__ Qb, const bf16* __restrict__ Kh, const bf16* __restrict__ Kr, const bf16* __restrict__ Vh,
                                                const float* __restrict__ cs_rows, float* __restrict__ Ob, int seq, const float scale, ATT_LAS char* lds) {
  constexpr int SHM_V = KVBLK * DV * 2, SHM_K = KVBLK * DQK * 2, RB = DQK * 2, NQ = DQK / 16;
  constexpr bool ROPE = (DQK == 192);
  const float C = scale * LOG2E, THRS = 8.f / scale;
  int tid_ = threadIdx.x; asm volatile("" : "+v"(tid_));
  const int tid = tid_, wid = tid >> 6, lane = tid & 63, r32 = lane & 31, hi = lane >> 5;
  ATT_LAS char* V_lds = lds; ATT_LAS char* K_lds = lds + 2 * SHM_V;
  ATT_LAS float* ws = (ATT_LAS float*)(lds + 2 * SHM_V + 2 * SHM_K) + wid * 64; ATT_LAS float* li_l = ws; ATT_LAS float* al_l = ws + 32;
  float m_reg = -1e30f, l_reg = 0; f32x16 o[4] = {}; bf16x8 qr[NQ];
  const bf16* Qw = Qb + (long)(wid * QBLK + r32) * LDQ + hi * 8;
#pragma unroll
  for (int d0 = 0; d0 < NQ; ++d0) qr[d0] = *(const ATT_GAS bf16x8*)(Qw + d0 * 16);
  if constexpr (ROPE) {
    const float* cs = cs_rows + (long)(wid * QBLK + r32) * 64 + hi * 8;
#pragma unroll
    for (int g = 0; g < 2; ++g) {
      const f32x4 c0 = *(const ATT_GAS f32x4*)(cs + g * 16), c1 = *(const ATT_GAS f32x4*)(cs + g * 16 + 4);
      const f32x4 s0 = *(const ATT_GAS f32x4*)(cs + 32 + g * 16), s1 = *(const ATT_GAS f32x4*)(cs + 32 + g * 16 + 4);
      float y1[8], y2[8];
#pragma unroll
      for (int j = 0; j < 8; ++j) { const float co = j < 4 ? c0[j & 3] : c1[j & 3], si = j < 4 ? s0[j & 3] : s1[j & 3];
        const float x1 = bf2f(qr[8 + g][j]), x2 = bf2f(qr[10 + g][j]); y1[j] = x1 * co - x2 * si; y2[j] = x1 * si + x2 * co; }
      u32x4 w1 = {cvtpk(y1[0], y1[1]), cvtpk(y1[2], y1[3]), cvtpk(y1[4], y1[5]), cvtpk(y1[6], y1[7])};
      u32x4 w2 = {cvtpk(y2[0], y2[1]), cvtpk(y2[2], y2[3]), cvtpk(y2[4], y2[5]), cvtpk(y2[6], y2[7])};
      qr[8 + g] = *reinterpret_cast<bf16x8*>(&w1); qr[10 + g] = *reinterpret_cast<bf16x8*>(&w2);
    }
  }
  const int sr = tid >> 4, sc = (tid & 15) * 8, vst0 = v_st(sr, sc), vst1 = v_st(32 + sr, sc);
  const int rr = tid >> 3, rc = (tid & 7) * 8;
  const int vb0 = (int)(unsigned)(uintptr_t)V_lds + v_rd_base(lane);
  struct Slot { bf16x8 vs0, vs1, ks0, ks1, kr; } sr_[SDEPTH];
#define SLOAD(i, k0) do { sr_[i].vs0 = *(const ATT_GAS bf16x8*)(&Vh[(long)((k0) + sr) * LDK + sc]); sr_[i].vs1 = *(const ATT_GAS bf16x8*)(&Vh[(long)((k0) + 32 + sr) * LDK + sc]); \
    sr_[i].ks0 = *(const ATT_GAS bf16x8*)(&Kh[(long)((k0) + sr) * LDK + sc]); sr_[i].ks1 = *(const ATT_GAS bf16x8*)(&Kh[(long)((k0) + 32 + sr) * LDK + sc]); \
    if constexpr (ROPE) sr_[i].kr = *(const ATT_GAS bf16x8*)(&Kr[(long)((k0) + rr) * 64 + rc]); } while (0)
#define SWRITE(b, i) do { *reinterpret_cast<ATT_LAS bf16x8*>(V_lds + (b) * SHM_V + vst0) = sr_[i].vs0;          \
    *reinterpret_cast<ATT_LAS bf16x8*>(V_lds + (b) * SHM_V + vst1) = sr_[i].vs1; const int kc = sc * 2;               \
    *reinterpret_cast<ATT_LAS bf16x8*>(K_lds + (b) * SHM_K + kswz<RB>(sr, kc)) = sr_[i].ks0;                       \
    *reinterpret_cast<ATT_LAS bf16x8*>(K_lds + (b) * SHM_K + kswz<RB>(32 + sr, kc)) = sr_[i].ks1;                  \
    if constexpr (ROPE) *reinterpret_cast<ATT_LAS bf16x8*>(K_lds + (b) * SHM_K + kswz<RB>(rr, 256 + rc * 2)) = sr_[i].kr; } while (0)
#define SWAIT() do { if constexpr (SDEPTH == 2) { if constexpr (ROPE) asm volatile("s_waitcnt vmcnt(5)" ::: "memory"); else asm volatile("s_waitcnt vmcnt(4)" ::: "memory"); } else asm volatile("s_waitcnt vmcnt(0)" ::: "memory"); } while (0)
#define RESC(a) do { if (__any((a) < 1.f)) { if (hi == 0) al_l[r32] = (a); asm volatile("s_waitcnt lgkmcnt(0)" ::: "memory"); \
    _Pragma("unroll") for (int d = 0; d < 4; ++d) _Pragma("unroll") for (int r = 0; r < 16; ++r) o[d][r] *= al_l[crow(r, hi)]; } } while (0)
  f32x16 pA0, pA1, pB0, pB1; float mnA, mnB, alA, alB; bf16x8 pa0, pa1, pa2, pa3; const int NT = seq / KVBLK;
  constexpr int SE = 0, SO = SDEPTH - 1;
  SLOAD(SE, 0); asm volatile("s_waitcnt vmcnt(0)" ::: "memory"); SWRITE(0, SE); __syncthreads();
  qkt<DQK>(pA0, pA1, K_lds, qr, r32, hi); partialSM(pA0, pA1, m_reg, mnA, alA, C, THRS);
  SLOAD(SO, KVBLK); if constexpr (SDEPTH == 2) { if (2 < NT) SLOAD(SE, 2 * KVBLK); }
  SWAIT(); SWRITE(1, SO); __syncthreads();
  for (int j = 1; j + 1 < NT; j += 2) {
    SBAR(); qkt<DQK>(pB0, pB1, K_lds + SHM_K, qr, r32, hi);
    finishSM(pA0, pA1, alA, l_reg, pa0, pa1, pa2, pa3); SBAR();
    SLOAD(SO, (j + SDEPTH) * KVBLK); SBAR();
    pv_d0(o, vb0, pa0, pa1, pa2, pa3); partialSM(pB0, pB1, m_reg, mnB, alB, C, THRS);
    __syncthreads(); SWAIT(); SWRITE(0, SE);
    RESC(alB); __syncthreads();
    SBAR(); qkt<DQK>(pA0, pA1, K_lds, qr, r32, hi);
    finishSM(pB0, pB1, alB, l_reg, pa0, pa1, pa2, pa3); SBAR();
    if (SDEPTH == 1 || j + 3 < NT) SLOAD(SE, (j + 1 + SDEPTH) * KVBLK); SBAR();
    pv_d0(o, vb0 + SHM_V, pa0, pa1, pa2, pa3); partialSM(pA0, pA1, m_reg, mnA, alA, C, THRS);
    __syncthreads(); SWAIT(); SWRITE(1, SO);
    RESC(alA); __syncthreads();
  }
  SBAR(); qkt<DQK>(pB0, pB1, K_lds + SHM_K, qr, r32, hi);
  finishSM(pA0, pA1, alA, l_reg, pa0, pa1, pa2, pa3); SBAR();
  pv_d0(o, vb0, pa0, pa1, pa2, pa3); partialSM(pB0, pB1, m_reg, mnB, alB, C, THRS);
  __syncthreads(); RESC(alB);
  finishSM(pB0, pB1, alB, l_reg, pa0, pa1, pa2, pa3); SBAR();
  pv_d0(o, vb0 + SHM_V, pa0, pa1, pa2, pa3);
  if (hi == 0) li_l[r32] = l_reg; asm volatile("s_waitcnt lgkmcnt(0)" ::: "memory");
  float rli[16];
#pragma unroll
  for (int r = 0; r < 16; ++r) rli[r] = __builtin_amdgcn_rcpf(li_l[crow(r, hi)]);
  float* Ow = Ob + (long)(wid * QBLK) * LDO;
#pragma unroll
  for (int r = 0; r < 16; ++r) { const int orow = crow(r, hi);
#pragma unroll
    for (int d0 = 0; d0 < 4; ++d0) Ow[(long)orow * LDO + d0 * 32 + r32] = o[d0][r] * rli[r]; }
  __syncthreads();
#undef SLOAD
#undef SWRITE
#undef SWAIT
#undef RESC
}

template <int DQK, int LDQ, int LDK, int LDO>
__device__ __forceinline__ void attn_simple_body(const bf16* __restrict__ Qb, const bf16* __restrict__ Kh, const bf16* __restrict__ Kr, const bf16* __restrict__ Vh,
                                                 const float* __restrict__ cs_rows, float* __restrict__ Ob, int seq, const float scale, ATT_LAS char* lds) {
  constexpr int SHM_V = KVBLK * DV * 2, SHM_K = KVBLK * DQK * 2, RB = DQK * 2, NQ = DQK / 16;
  constexpr bool ROPE = (DQK == 192);
  const float C = scale * LOG2E, THRS = 8.f / scale;
  int tid_ = threadIdx.x; asm volatile("" : "+v"(tid_));
  const int tid = tid_, wid = tid >> 6, lane = tid & 63, r32 = lane & 31, hi = lane >> 5;
  ATT_LAS char* V_lds = lds; ATT_LAS char* K_lds = lds + 2 * SHM_V;
  ATT_LAS float* ws = (ATT_LAS float*)(lds + 2 * SHM_V + 2 * SHM_K) + wid * 64; ATT_LAS float* li_l = ws; ATT_LAS float* al_l = ws + 32;
  float m_reg = -1e30f, l_reg = 0; f32x16 o[4] = {}; bf16x8 qr[NQ];
  const bf16* Qw = Qb + (long)(wid * QBLK + r32) * LDQ + hi * 8;
#pragma unroll
  for (int d0 = 0; d0 < NQ; ++d0) qr[d0] = *(const ATT_GAS bf16x8*)(Qw + d0 * 16);
  if constexpr (ROPE) {
    const float* cs = cs_rows + (long)(wid * QBLK + r32) * 64 + hi * 8;
#pragma unroll
    for (int g = 0; g < 2; ++g) {
      const f32x4 c0 = *(const ATT_GAS f32x4*)(cs + g * 16), c1 = *(const ATT_GAS f32x4*)(cs + g * 16 + 4);
      const f32x4 s0 = *(const ATT_GAS f32x4*)(cs + 32 + g * 16), s1 = *(const ATT_GAS f32x4*)(cs + 32 + g * 16 + 4);
      float y1[8], y2[8];
#pragma unroll
      for (int j = 0; j < 8; ++j) { const float co = j < 4 ? c0[j & 3] : c1[j & 3], si = j < 4 ? s0[j & 3] : s1[j & 3];
        const float x1 = bf2f(qr[8 + g][j]), x2 = bf2f(qr[10 + g][j]); y1[j] = x1 * co - x2 * si; y2[j] = x1 * si + x2 * co; }
      u32x4 w1 = {cvtpk(y1[0], y1[1]), cvtpk(y1[2], y1[3]), cvtpk(y1[4], y1[5]), cvtpk(y1[6], y1[7])};
      u32x4 w2 = {cvtpk(y2[0], y2[1]), cvtpk(y2[2], y2[3]), cvtpk(y2[4], y2[5]), cvtpk(y2[6], y2[7])};
      qr[8 + g] = *reinterpret_cast<bf16x8*>(&w1); qr[10 + g] = *reinterpret_cast<bf16x8*>(&w2);
    }
  }
  const int sr = tid >> 4, sc = (tid & 15) * 8, vst0 = v_st(sr, sc), vst1 = v_st(32 + sr, sc);
  const int rr = tid >> 3, rc = (tid & 7) * 8;
  const int vb0 = (int)(unsigned)(uintptr_t)V_lds + v_rd_base(lane);
  bf16x8 vs0, vs1, ks0, ks1, kr;
#define SLOAD(k0) do { vs0 = *(const ATT_GAS bf16x8*)(&Vh[(long)((k0) + sr) * LDK + sc]); vs1 = *(const ATT_GAS bf16x8*)(&Vh[(long)((k0) + 32 + sr) * LDK + sc]); \
    ks0 = *(const ATT_GAS bf16x8*)(&Kh[(long)((k0) + sr) * LDK + sc]); ks1 = *(const ATT_GAS bf16x8*)(&Kh[(long)((k0) + 32 + sr) * LDK + sc]); \
    if constexpr (ROPE) kr = *(const ATT_GAS bf16x8*)(&Kr[(long)((k0) + rr) * 64 + rc]); } while (0)
#define SWRITE(b) do { *reinterpret_cast<ATT_LAS bf16x8*>(V_lds + (b) * SHM_V + vst0) = vs0;          \
    *reinterpret_cast<ATT_LAS bf16x8*>(V_lds + (b) * SHM_V + vst1) = vs1; const int kc = sc * 2;               \
    *reinterpret_cast<ATT_LAS bf16x8*>(K_lds + (b) * SHM_K + kswz<RB>(sr, kc)) = ks0;                       \
    *reinterpret_cast<ATT_LAS bf16x8*>(K_lds + (b) * SHM_K + kswz<RB>(32 + sr, kc)) = ks1;                  \
    if constexpr (ROPE) *reinterpret_cast<ATT_LAS bf16x8*>(K_lds + (b) * SHM_K + kswz<RB>(rr, 256 + rc * 2)) = kr; } while (0)
#define RESC(a) do { if (__any((a) < 1.f)) { if (hi == 0) al_l[r32] = (a); asm volatile("s_waitcnt lgkmcnt(0)" ::: "memory"); \
    _Pragma("unroll") for (int d = 0; d < 4; ++d) _Pragma("unroll") for (int r = 0; r < 16; ++r) o[d][r] *= al_l[crow(r, hi)]; } } while (0)
  const int NT = seq / KVBLK;
  SLOAD(0); SWRITE(0); __syncthreads();
  for (int j = 0; j < NT; ++j) {
    const int b = j & 1;
    if (j + 1 < NT) SLOAD((j + 1) * KVBLK);
    f32x16 p0, p1; float mn, al; bf16x8 pa0, pa1, pa2, pa3;
    SBAR(); qkt<DQK>(p0, p1, K_lds + b * SHM_K, qr, r32, hi);
    partialSM(p0, p1, m_reg, mn, al, C, THRS); RESC(al);
    finishSM(p0, p1, al, l_reg, pa0, pa1, pa2, pa3); SBAR();
    pv_d0(o, vb0 + b * SHM_V, pa0, pa1, pa2, pa3);
    if (j + 1 < NT) SWRITE(b ^ 1);
    __syncthreads();
  }
  if (hi == 0) li_l[r32] = l_reg; asm volatile("s_waitcnt lgkmcnt(0)" ::: "memory");
  float rli[16];
#pragma unroll
  for (int r = 0; r < 16; ++r) rli[r] = __builtin_amdgcn_rcpf(li_l[crow(r, hi)]);
  float* Ow = Ob + (long)(wid * QBLK) * LDO;
#pragma unroll
  for (int r = 0; r < 16; ++r) { const int orow = crow(r, hi);
#pragma unroll
    for (int d0 = 0; d0 < 4; ++d0) Ow[(long)orow * LDO + d0 * 32 + r32] = o[d0][r] * rli[r]; }
  __syncthreads();
#undef SLOAD
#undef SWRITE
#undef RESC
}

template <int LDP>
__device__ __forceinline__ void dil_wave_unit(const bf16* __restrict__ P, int qc, int kc, int vc, int d, int r, int t0, int nT,
                                              float* __restrict__ O, int oc, float* __restrict__ ST  ,
                                              ATT_LAS char* vlds  , const ATT_LAS float* bias2, const float C, int lane_) {
  int lane = lane_; asm volatile("" : "+v"(lane));
  const int r32 = lane & 31, hi = lane >> 5;
  bf16x8 qr[8];
  { const bf16* qp = P + (long)(r + d * (t0 + r32)) * LDP + qc + hi * 8;
#pragma unroll
    for (int d0 = 0; d0 < 8; ++d0) qr[d0] = *(const ATT_GAS bf16x8*)(qp + d0 * 16); }
  f32x16 p[5];
#pragma unroll
  for (int kb = 0; kb < 5; ++kb) {
    int kt = t0 - 64 + kb * 32 + r32; kt = kt < 0 ? 0 : (kt > nT - 1 ? nT - 1 : kt);
    const bf16* kp = P + (long)(r + d * kt) * LDP + kc + hi * 8;
    bf16x8 kf[8];
#pragma unroll
    for (int d0 = 0; d0 < 8; ++d0) kf[d0] = *(const ATT_GAS bf16x8*)(kp + d0 * 16);
    p[kb] = f32x16{};
#pragma unroll
    for (int d0 = 0; d0 < 8; ++d0) p[kb] = __builtin_amdgcn_mfma_f32_32x32x16_bf16(kf[d0], qr[d0], p[kb], 0, 0, 0);
  }
  float m = -1e30f;
#pragma unroll
  for (int kb = 0; kb < 5; ++kb)
#pragma unroll
    for (int rg = 0; rg < 16; ++rg) {
      const int jj = kb * 32 + crow(rg, hi) - r32;
      const int kt = t0 - 64 + kb * 32 + crow(rg, hi);
      const bool valid = (jj >= 0) && (jj <= 128) && (kt >= 0) && (kt < nT);
      const int bi = jj < 0 ? 0 : (jj > 128 ? 128 : jj);
      const float s = fmaf(p[kb][rg], C, bias2[bi]);
      p[kb][rg] = valid ? s : -1e30f; m = fmaxf(m, p[kb][rg]);
    }
  { auto rr = __builtin_amdgcn_permlane32_swap(__float_as_uint(m), __float_as_uint(m), false, false); m = fmaxf(__uint_as_float(rr[0]), __uint_as_float(rr[1])); }
  float Z = 0.f;
#pragma unroll
  for (int kb = 0; kb < 5; ++kb)
#pragma unroll
    for (int rg = 0; rg < 16; ++rg) { p[kb][rg] = __builtin_amdgcn_exp2f(p[kb][rg] - m); Z += p[kb][rg]; }
  { auto rr = __builtin_amdgcn_permlane32_swap(__float_as_uint(Z), __float_as_uint(Z), false, false); Z = __uint_as_float(rr[0]) + __uint_as_float(rr[1]); }
  f32x16 o[4] = {};
  const int vb = (int)(unsigned)(uintptr_t)vlds + v_rd_base(lane);
#pragma unroll
  for (int kb = 0; kb < 5; ++kb) {
    bf16x8 vv[8];
#pragma unroll
    for (int i = 0; i < 8; ++i) { const int id = lane + 64 * i, row = id >> 4, c = (id & 15) * 8;
      int kt = t0 - 64 + kb * 32 + row; kt = kt < 0 ? 0 : (kt > nT - 1 ? nT - 1 : kt);
      vv[i] = *(const ATT_GAS bf16x8*)(P + (long)(r + d * kt) * LDP + vc + c); }
#pragma unroll
    for (int i = 0; i < 8; ++i) { const int id = lane + 64 * i, row = id >> 4, c = (id & 15) * 8;
      *reinterpret_cast<ATT_LAS bf16x8*>(vlds + v_st(row, c)) = vv[i]; }
    bf16x8 pa0, pa1; ATT_PK4(p[kb], 0, pa0); ATT_PK4(p[kb], 8, pa1);
    asm volatile("s_waitcnt lgkmcnt(0)" ::: "memory"); SBAR();
    pv32_one<0>(o[0], vb, pa0, pa1); pv32_one<1>(o[1], vb, pa0, pa1); pv32_one<2>(o[2], vb, pa0, pa1); pv32_one<3>(o[3], vb, pa0, pa1);
    SBAR();
  }
#pragma unroll
  for (int rg = 0; rg < 16; ++rg) { const long row = r + d * (t0 + crow(rg, hi));
#pragma unroll
    for (int d0 = 0; d0 < 4; ++d0) O[row * 768 + oc + d0 * 32 + r32] = o[d0][rg]; }
  if (hi == 0) { const long row = r + d * (t0 + r32); typedef float f32x2_ __attribute__((ext_vector_type(2))); *(ATT_GAS f32x2_*)(ST + row * 12) = (f32x2_){m, Z}; }
}
}
constexpr int S = 8192, D = 2048, NMEM = 256;
constexpr int DIN = 3392, DINP = 3584;
constexpr int PC_DIL = 768, PC_MEM = 3072;
constexpr int QR = 384, KVR = 128, AQ = 512;
constexpr int NUP = 2816;
constexpr int UC_KV = 1280;
constexpr int DFF = 5632, DFE = 7168, NE = 8;
constexpr int MP = 18432;
constexpr float EPS = 1e-6f;
constexpr int NWAVES = 8;

constexpr size_t al256(size_t x) { return (x + 255) / 256 * 256; }
constexpr size_t WS_CTL = 0, CTL_ZERO_BYTES = 1u << 20;
constexpr size_t WS_WIN = WS_CTL + CTL_ZERO_BYTES;
constexpr size_t WS_WUP = WS_WIN + al256((size_t)2 * DINP * D * 2);
constexpr size_t WS_WMEM = WS_WUP + al256((size_t)2 * NUP * AQ * 2);
constexpr size_t WS_WOUT = WS_WMEM + al256((size_t)2 * 1024 * D * 2);
constexpr size_t WS_WGU = WS_WOUT + al256((size_t)2 * D * D * 2);
constexpr size_t WS_WDN = WS_WGU + al256((size_t)2 * DFF * D * 2);
constexpr size_t WS_MGU = WS_WDN + al256((size_t)D * DFF * 2);
constexpr size_t WS_MDN = WS_MGU + al256((size_t)NE * 2 * DFE * D * 2);
constexpr size_t WS_XN = WS_MDN + al256((size_t)NE * D * DFE * 2);
constexpr size_t WS_MEMN = WS_XN + al256((size_t)S * D * 2);
constexpr size_t WS_MEMKV = WS_MEMN + al256((size_t)2 * NMEM * D * 2);
constexpr size_t WS_PROJ = WS_MEMKV + al256((size_t)2 * NMEM * 1024 * 2);
constexpr size_t WS_AQKV = WS_PROJ + al256((size_t)S * DINP * 2);
constexpr size_t WS_KROPE = WS_AQKV + al256((size_t)S * AQ * 2);
constexpr size_t WS_ROPECS = WS_KROPE + al256((size_t)S * 64 * 2);
constexpr size_t WS_QKVM = WS_ROPECS + al256((size_t)S * 64 * 4);
constexpr size_t WS_YPRE = WS_QKVM + al256((size_t)S * NUP * 2);
constexpr size_t WS_DILO = WS_YPRE + al256((size_t)S * D * 4);
constexpr size_t WS_DILS = WS_DILO + al256((size_t)3 * S * 768 * 4);
constexpr size_t WS_Y = WS_DILS + al256((size_t)3 * S * 12 * 4);
constexpr size_t WS_XA = WS_Y + al256((size_t)S * D * 2);
constexpr size_t WS_ROUTE = WS_XA + al256((size_t)S * D * 4);
constexpr size_t WS_XP = WS_ROUTE + al256((size_t)S * 32);
constexpr size_t WS_OUTP = WS_XP + al256((size_t)MP * D * 2);
constexpr size_t WS_ACTP = WS_OUTP + al256((size_t)MP * D * 2);
constexpr size_t WS_END = WS_ACTP + al256((size_t)MP * DFE * 2);
static_assert(WS_END <= 1879048192ull, "workspace map exceeds 4 x the largest input");
constexpr int CW_BAR = 16384;
constexpr int CW_QUEUE = 8192;
constexpr int CW_CNT = 8192 + 256;
constexpr int CW_CVT = 8192 + 320;
constexpr int CW_DONE = 8192 + 384;
constexpr int CW_TILEE = 8192 + 512;
constexpr int RING_BYTES = 131072;
constexpr int LDSCTL_OFF = RING_BYTES, MISC_OFF = LDSCTL_OFF + 320;
constexpr int BIAS_OFF = 114688;
constexpr int LDS_BYTES = 147456;

#define GAS __attribute__((address_space(1)))
#define LAS __attribute__((address_space(3)))
typedef unsigned short bf16;
typedef unsigned v4u __attribute__((ext_vector_type(4)));
typedef unsigned v2u __attribute__((ext_vector_type(2)));
typedef float f32x4 __attribute__((ext_vector_type(4)));
typedef short bf16x8 __attribute__((ext_vector_type(8)));
typedef GAS unsigned gu32;
#define RLX_AGENT __ATOMIC_RELAXED, __HIP_MEMORY_SCOPE_AGENT
#define LDS_WAIT() asm volatile("s_waitcnt lgkmcnt(0)" ::: "memory")
#define VM_WAIT() asm volatile("s_waitcnt vmcnt(0)" ::: "memory")
__device__ __forceinline__ unsigned f2bf(float f) { unsigned u = __builtin_bit_cast(unsigned, f); return (u + 0x7fffu + ((u >> 16) & 1u)) >> 16; }
__device__ __forceinline__ unsigned pk2(float lo, float hi) { return f2bf(lo) | (f2bf(hi) << 16); }
__device__ __forceinline__ float bflo(unsigned w) { return __uint_as_float(w << 16); }
__device__ __forceinline__ float bfhi(unsigned w) { return __uint_as_float(w & 0xffff0000u); }

#define XB_TMO      128
#define XB_XCNT(j)  (256  + 64 * (j))
#define XB_XSUB(j)  (1280 + 64 * (j))
#define XB_XGEN(j)  (2304 + 64 * (j))
#define XB_TOP      3328
#define XB_TOPGEN   3392
#define XCD_BAR_WORDS 3456
#define XB_SPIN_CAP (1u << 18)
__device__ __forceinline__ unsigned xb_ld(unsigned* p)              { return __hip_atomic_load(p, __ATOMIC_RELAXED, __HIP_MEMORY_SCOPE_AGENT); }
__device__ __forceinline__ unsigned xb_add(unsigned* p, unsigned v) { return __hip_atomic_fetch_add(p, v, __ATOMIC_RELAXED, __HIP_MEMORY_SCOPE_AGENT); }
__device__ __forceinline__ unsigned xb_xcc_id() { return (unsigned)__builtin_amdgcn_s_getreg((3 << 11) | 20) & 0xFu; }
#define XB_SPIN(cond, bar) do { unsigned _sp = 0; while (cond) { __builtin_amdgcn_s_sleep(1); \
    if ((++_sp & 255u) == 0u) { if (xb_ld(&(bar)[XB_TMO])) break; if (_sp > XB_SPIN_CAP) { atomicAdd(&(bar)[XB_TMO], 1u); break; } } } } while (0)
struct XcdBarrier { unsigned* bar; unsigned x; volatile LAS unsigned* st; };
__device__ __forceinline__ XcdBarrier xcd_barrier_post(unsigned* bar, volatile LAS unsigned* st) {
    XcdBarrier b; b.bar = bar; b.x = xb_xcc_id(); b.st = st;
    if (threadIdx.x == 0) (void)xb_add(&bar[XB_XCNT(b.x)], 1u);
    return b;
}
__device__ __forceinline__ void xcd_barrier_complete(unsigned* bar, unsigned x, unsigned& nloc, unsigned& nx) {
    const unsigned G = gridDim.x * gridDim.y * gridDim.z;
    unsigned sum, cnt, mine, sp = 0u;
    for (;;) {
        sum = 0u; cnt = 0u; mine = 0u;
#pragma unroll
        for (unsigned j = 0; j < 16; ++j) { const unsigned c = xb_ld(&bar[XB_XCNT(j)]); sum += c; cnt += (c > 0u) ? 1u : 0u; mine = (j == x) ? c : mine; }
        if (sum == G) break;
        __builtin_amdgcn_s_sleep(1);
        if ((++sp & 255u) == 0u) { if (xb_ld(&bar[XB_TMO])) break; if (sp > XB_SPIN_CAP) { atomicAdd(&bar[XB_TMO], 1u); break; } }
    }
    nloc = mine > 0u ? mine : 1u; nx = cnt > 0u ? cnt : 1u;
}
__device__ __forceinline__ void xcd_barrier(const XcdBarrier& b) {
    asm volatile("s_waitcnt vmcnt(0)" ::: "memory");
    __syncthreads();
    if (threadIdx.x == 0) {
        unsigned* bar = b.bar;
        __builtin_amdgcn_s_waitcnt(0);
        unsigned nloc = b.st[0], nx = b.st[1];
        if (nloc == 0u) { xcd_barrier_complete(bar, b.x, nloc, nx); b.st[0] = nloc; b.st[1] = nx; }
        const unsigned old = xb_add(&bar[XB_XSUB(b.x)], 1u);
        const unsigned gen = old / nloc;
        if (old + 1u == (gen + 1u) * nloc) {
            __builtin_amdgcn_fence(__ATOMIC_RELEASE, "agent");
            asm volatile("s_waitcnt vmcnt(0)" ::: "memory");
            const unsigned og = xb_add(&bar[XB_TOP], 1u);
            const unsigned tg = og / nx;
            if (og + 1u == (tg + 1u) * nx) xb_add(&bar[XB_TOPGEN], 1u);
            else XB_SPIN(xb_ld(&bar[XB_TOPGEN]) == tg, bar);
            __builtin_amdgcn_fence(__ATOMIC_ACQUIRE, "agent");
            xb_add(&bar[XB_XGEN(b.x)], 1u);
            asm volatile("s_waitcnt vmcnt(0)" ::: "memory");
        } else {
            XB_SPIN(xb_ld(&bar[XB_XGEN(b.x)]) == gen, bar);
            __builtin_amdgcn_fence(__ATOMIC_ACQUIRE, "agent");
            asm volatile("s_waitcnt vmcnt(0)" ::: "memory");
        }
    }
    __syncthreads();
}

struct Args {
    const float* in[23]; float* out; unsigned char* ws;
    float invf[32];
    int ph_lo, ph_hi, li, rep;
};
struct Frame {
    LAS unsigned char* lds;
    volatile LAS unsigned* MISC;
    gu32* ctl;
    int tid, lane, wave, G, gw, NGW;
    unsigned char* ws;
};
__device__ __forceinline__ float wave_sum(float v) {
#pragma unroll
    for (int o = 1; o < 64; o <<= 1) v += __shfl_xor(v, o);
    return v;
}
__device__ __forceinline__ float wave_max(float v) {
#pragma unroll
    for (int o = 1; o < 64; o <<= 1) v = fmaxf(v, __shfl_xor(v, o));
    return v;
}

__device__ __forceinline__ unsigned pk4_fp8(float a, float b, float c, float d) { int w = 0; w = __builtin_amdgcn_cvt_pk_fp8_f32(a, b, w, false); w = __builtin_amdgcn_cvt_pk_fp8_f32(c, d, w, true); return (unsigned)w; }
__device__ __forceinline__ void cvt_load(const float* __restrict__ W, int N, int k0, int n0, int lane, f32x4 (&v)[8]) {
    const int lr = lane >> 3, lc = (lane & 7) * 4;
#pragma unroll
    for (int i = 0; i < 8; ++i) v[i] = __builtin_nontemporal_load((const GAS f32x4*)(W + (size_t)(k0 + i * 8 + lr) * N + n0 + lc));
}
template <bool FP8>
__device__ __forceinline__ void cvt_finish(const f32x4 (&v)[8], int k0, void* __restrict__ dstv, int ldd, int drow0, int kdst0, LAS float* scr, int lane, float wsc) {
    const int lr = lane >> 3, lc = (lane & 7) * 4;
#pragma unroll
    for (int i = 0; i < 8; ++i) { LAS float* s = scr + (i * 8 + lr) * 33 + lc; s[0] = v[i][0]; s[1] = v[i][1]; s[2] = v[i][2]; s[3] = v[i][3]; }
    LDS_WAIT(); asm volatile("" ::: "memory");
    const int c = lane & 7;
#pragma unroll
    for (int j = 0; j < 4; ++j) { const int n = (lane >> 3) + 8 * j; const LAS float* s = scr + (8 * c) * 33 + n;
        if constexpr (FP8) { v2u o; o.x = pk4_fp8(s[0 * 33] * wsc, s[1 * 33] * wsc, s[2 * 33] * wsc, s[3 * 33] * wsc); o.y = pk4_fp8(s[4 * 33] * wsc, s[5 * 33] * wsc, s[6 * 33] * wsc, s[7 * 33] * wsc);
            __builtin_nontemporal_store(o, (GAS v2u*)((unsigned char*)dstv + (size_t)(drow0 + n) * ldd + kdst0 + k0 + 8 * c)); }
        else { v4u o; o.x = pk2(s[0 * 33], s[1 * 33]); o.y = pk2(s[2 * 33], s[3 * 33]); o.z = pk2(s[4 * 33], s[5 * 33]); o.w = pk2(s[6 * 33], s[7 * 33]);
            __builtin_nontemporal_store(o, (GAS v4u*)((bf16*)dstv + (size_t)(drow0 + n) * ldd + kdst0 + k0 + 8 * c)); } }
    LDS_WAIT(); asm volatile("" ::: "memory");
}
__device__ __forceinline__ int cvt_drow(int mode, int n0, int roff) { return mode == 0 ? n0 + roff : (mode == 1 ? (n0 >> 7) * 256 + (n0 & 127) : (mode == 2 ? (n0 >> 7) * 256 + 128 + (n0 & 127) : (n0 < 576 ? n0 : n0 + 192))); }
template <bool FP8>
__device__ __forceinline__ void cvt_job(Frame& F, const float* W, int K, int N, void* dst, int ldd, int kdst0, int mode, int roff, LAS float* scr, float wsc) {
    const int nnb = N / 32, nitems = (K / 64) * nnb;
    int it = F.gw; if (it >= nitems) return;
    f32x4 va[8], vb[8];
    cvt_load(W, N, (it / nnb) * 64, (it % nnb) * 32, F.lane, va);
    for (;;) {
        const int it1 = it + F.NGW; if (it1 < nitems) cvt_load(W, N, (it1 / nnb) * 64, (it1 % nnb) * 32, F.lane, vb);
        cvt_finish<FP8>(va, (it / nnb) * 64, dst, ldd, cvt_drow(mode, (it % nnb) * 32, roff), kdst0, scr, F.lane, wsc);
        if (it1 >= nitems) break;
        const int it2 = it1 + F.NGW; if (it2 < nitems) cvt_load(W, N, (it2 / nnb) * 64, (it2 % nnb) * 32, F.lane, va);
        cvt_finish<FP8>(vb, (it1 / nnb) * 64, dst, ldd, cvt_drow(mode, (it1 % nnb) * 32, roff), kdst0, scr, F.lane, wsc);
        if (it2 >= nitems) break;
        it = it2;
    }
}
__device__ __forceinline__ void rms_row_to_bf16(const float* xrow, const float* g, bf16* orow, int lane) {
    const GAS f32x4* xr = (const GAS f32x4*)xrow + lane; const GAS f32x4* gr = (const GAS f32x4*)g + lane;
    f32x4 v[8]; float s = 0.f;
#pragma unroll
    for (int j = 0; j < 8; ++j) { v[j] = xr[64 * j]; s += (v[j].x * v[j].x + v[j].y * v[j].y) + (v[j].z * v[j].z + v[j].w * v[j].w); }
    const float rstd = 1.f / sqrtf(wave_sum(s) * (1.f / D) + EPS);
    GAS v2u* o8 = (GAS v2u*)orow + lane;
#pragma unroll
    for (int j = 0; j < 8; ++j) { const f32x4 gg = gr[64 * j]; v2u w; w.x = pk2(v[j].x * rstd * gg.x, v[j].y * rstd * gg.y); w.y = pk2(v[j].z * rstd * gg.z, v[j].w * rstd * gg.w); o8[64 * j] = w; }
}
__device__ __forceinline__ void rms_row_to_fp8(const float* xrow, const float* g, unsigned char* orow, int lane) {
    const GAS f32x4* xr = (const GAS f32x4*)xrow + lane; const GAS f32x4* gr = (const GAS f32x4*)g + lane;
    f32x4 v[8]; float s = 0.f;
#pragma unroll
    for (int j = 0; j < 8; ++j) { v[j] = xr[64 * j]; s += (v[j].x * v[j].x + v[j].y * v[j].y) + (v[j].z * v[j].z + v[j].w * v[j].w); }
    const float rstd = 1.f / sqrtf(wave_sum(s) * (1.f / D) + EPS);
    GAS unsigned* o4 = (GAS unsigned*)orow + lane;
#pragma unroll
    for (int j = 0; j < 8; ++j) { const f32x4 gg = gr[64 * j]; o4[64 * j] = pk4_fp8(v[j].x * rstd * gg.x, v[j].y * rstd * gg.y, v[j].z * rstd * gg.z, v[j].w * rstd * gg.w); }
}
__device__ __forceinline__ void sincos_f64(float ang, float& c, float& s) {
    const double a = (double)ang, twopi = 6.283185307179586476925286766559, inv2pi = 0.15915494309189533576888376337251;
    const double q = __builtin_rint(a * inv2pi); const double r = a - q * twopi;
    const double r2 = r * r; double ss = 1.0, cc = 1.0;
#pragma unroll
    for (int k = 14; k >= 1; --k) { ss = 1.0 - r2 * (1.0 / (double)((2 * k) * (2 * k + 1))) * ss; cc = 1.0 - r2 * (1.0 / (double)((2 * k - 1) * (2 * k))) * cc; }
    s = (float)(r * ss); c = (float)cc;
}
__device__ const unsigned char DIL_BUCKET[3][129] = {
 {11,11,11,11,11,11,11,11,11,11,11,11,11,11,11,10,10,10,10,10,10,10,10,10,10,10,10,10,10,10,10,10,10,10,10,10,10,10,9,9,9,9,9,9,9,9,9,9,9,9,8,8,8,8,8,8,8,7,6,5,4,3,2,1,0,17,18,19,20,21,22,23,24,24,24,24,24,24,24,25,25,25,25,25,25,25,25,25,25,25,25,26,26,26,26,26,26,26,26,26,26,26,26,26,26,26,26,26,26,26,26,26,26,26,27,27,27,27,27,27,27,27,27,27,27,27,27,27,27},
 {13,13,13,13,13,13,13,13,13,13,13,13,13,13,13,13,13,13,13,13,13,13,13,12,12,12,12,12,12,12,12,12,12,12,12,12,12,12,12,12,12,12,11,11,11,11,11,11,11,11,11,11,10,10,10,10,10,10,9,9,9,8,8,4,0,20,24,24,25,25,25,26,26,26,26,26,26,27,27,27,27,27,27,27,27,27,27,28,28,28,28,28,28,28,28,28,28,28,28,28,28,28,28,28,28,28,29,29,29,29,29,29,29,29,29,29,29,29,29,29,29,29,29,29,29,29,29,29,29},
 {15,15,15,15,15,15,15,15,15,15,15,15,15,15,15,15,15,15,15,15,15,15,15,15,15,15,15,15,15,15,14,14,14,14,14,14,14,14,14,14,14,14,14,14,14,13,13,13,13,13,13,13,13,13,12,12,12,12,12,11,11,10,10,9,0,25,26,26,27,27,28,28,28,28,28,29,29,29,29,29,29,29,29,29,30,30,30,30,30,30,30,30,30,30,30,30,30,30,30,31,31,31,31,31,31,31,31,31,31,31,31,31,31,31,31,31,31,31,31,31,31,31,31,31,31,31,31,31,31}};

typedef float f32x2 __attribute__((ext_vector_type(2)));
#ifndef PH_MASK
#define PH_MASK 0xFFFFu
#endif
#ifndef REPEAT_PHASE
#define REPEAT_PHASE -1
#endif
#ifndef ATT_EN
#define ATT_EN 7
#endif
#define PEN(k) ((PH_MASK >> (k)) & 1u)
#ifndef FFN_FP8
#define FFN_FP8 3
#endif
constexpr bool F8D = (FFN_FP8 & 1) != 0, F8M = (FFN_FP8 & 2) != 0;
constexpr int EBD = F8D ? 1 : 2, EBM = F8M ? 1 : 2;
template <bool B> struct Sc { static constexpr float w_gu = B ? 32.f : 1.f, w_dn = B ? 64.f : 1.f, a_sc = B ? 4.f : 1.f, dn = 1.f / (w_dn * a_sc); };
template <bool B> using FfnEpi1 = typename std::conditional<B, pg8::EpiSwiGLU8, pg8::EpiSwiGLU>::type;
template <bool B> struct Epi1Maker;
template <> struct Epi1Maker<true> { static __device__ __forceinline__ pg8::EpiSwiGLU8 make(void* O, int ldc) { return pg8::EpiSwiGLU8{(unsigned char*)O, ldc, 1.f / Sc<true>::w_gu, Sc<true>::a_sc}; } };
template <> struct Epi1Maker<false> { static __device__ __forceinline__ pg8::EpiSwiGLU make(void* O, int ldc) { return pg8::EpiSwiGLU{(unsigned short*)O, ldc}; } };

constexpr int MOE_MAT_ITEMS = 7168, MOE_GU_ITEMS = 16 * MOE_MAT_ITEMS, MOE_NITEMS = 24 * MOE_MAT_ITEMS, MOE_CHUNK = 64, MOE_NCHUNK = MOE_NITEMS / MOE_CHUNK;
struct MoeItem { const float* W; void* dst; int N, k0, n0, ldd, drow0; float wsc; };
__device__ __forceinline__ MoeItem moe_item(const Args& args, unsigned char* ws, int idx) {
    MoeItem m;
    if (idx < MOE_GU_ITEMS) { const int mat = idx / MOE_MAT_ITEMS, local = idx % MOE_MAT_ITEMS, e = mat >> 1, up = mat & 1, kb = local / (DFE / 32), nb = local % (DFE / 32);
        m.W = args.in[19 + up] + (size_t)e * D * DFE; m.N = DFE; m.k0 = kb * 64; m.n0 = nb * 32; m.dst = ws + WS_MGU + (size_t)e * 2 * DFE * D * EBM; m.ldd = D;
        m.drow0 = (m.n0 >> 7) * 256 + up * 128 + (m.n0 & 127); m.wsc = Sc<F8M>::w_gu; }
    else { const int i2 = idx - MOE_GU_ITEMS, e = i2 / MOE_MAT_ITEMS, local = i2 % MOE_MAT_ITEMS, kb = local / (D / 32), nb = local % (D / 32);
        m.W = args.in[21] + (size_t)e * DFE * D; m.N = D; m.k0 = kb * 64; m.n0 = nb * 32; m.dst = ws + WS_MDN + (size_t)e * D * DFE * EBM; m.ldd = DFE; m.drow0 = m.n0; m.wsc = Sc<F8M>::w_dn; }
    return m;
}
__device__ __forceinline__ void moe_cvt_chunk(Frame& F, const Args& args, int c) {
    LAS float* scr = (LAS float*)(F.lds + F.wave * 16384);
    const int i0 = c * MOE_CHUNK + F.wave * 8;
    f32x4 va[8], vb[8], vc[8]; MoeItem ma, mb, mc;
#define MC_L(m, v, i) do { m = moe_item(args, F.ws, i0 + (i)); cvt_load(m.W, m.N, m.k0, m.n0, F.lane, v); } while (0)
#define MC_F(m, v) cvt_finish<F8M>(v, m.k0, m.dst, m.ldd, m.drow0, 0, scr, F.lane, m.wsc)
    MC_L(ma, va, 0); MC_L(mb, vb, 1); MC_L(mc, vc, 2);
    MC_F(ma, va); MC_L(ma, va, 3); MC_F(mb, vb); MC_L(mb, vb, 4); MC_F(mc, vc); MC_L(mc, vc, 5);
    MC_F(ma, va); MC_L(ma, va, 6); MC_F(mb, vb); MC_L(mb, vb, 7); MC_F(mc, vc); MC_F(ma, va); MC_F(mb, vb);
#undef MC_L
#undef MC_F
}
__device__ __forceinline__ void moe_cvt_fill(Frame& F, const Args& args, int ph) {
    for (;;) {
        if (F.tid == 0) { unsigned c = MOE_NCHUNK;
            if (ph < 0 || __hip_atomic_load(F.ctl + CW_DONE + ph, RLX_AGENT) < (unsigned)F.G) c = __hip_atomic_fetch_add(F.ctl + CW_CVT + (ph == -2 ? 16 : 0), 1u, RLX_AGENT);
            F.MISC[17] = c; }
        __syncthreads(); const unsigned c = F.MISC[17]; __syncthreads();
        if (c >= (unsigned)MOE_NCHUNK) break;
        moe_cvt_chunk(F, args, (int)c);
    }
}
#define FILL(ph) do { __syncthreads(); if (F.tid == 0) (void)__hip_atomic_fetch_add(F.ctl + CW_DONE + (ph), 1u, RLX_AGENT); moe_cvt_fill(F, args, (ph)); } while (0)
constexpr int PH_PER_LAYER = 11, N_PHASES = 1 + 2 * PH_PER_LAYER;
#ifndef MK_N_LAUNCHES
#define MK_N_LAUNCHES 1
#endif
constexpr int N_LAUNCHES = MK_N_LAUNCHES;

__global__ void __launch_bounds__(NWAVES * 64, 2) mk_fwd(Args args) {
    extern __shared__ __attribute__((aligned(16))) unsigned char lds[];
    Frame F;
    F.lds = (LAS unsigned char*)lds;
    F.MISC = (volatile LAS unsigned*)(F.lds + MISC_OFF);
    F.tid = threadIdx.x; F.lane = F.tid & 63; F.wave = __builtin_amdgcn_readfirstlane(F.tid >> 6);
    F.G = gridDim.x; F.gw = blockIdx.x * NWAVES + F.wave; F.NGW = F.G * NWAVES;
    F.ws = args.ws; F.ctl = (gu32*)(args.ws + WS_CTL);
    unsigned char* ws = args.ws;
    for (int u = F.tid; u < (LDS_BYTES - LDSCTL_OFF) / 4; u += NWAVES * 64) ((LAS unsigned*)(F.lds + LDSCTL_OFF))[u] = 0u;
    __syncthreads();
    XcdBarrier bar; bar.bar = (unsigned*)(F.ctl + CW_BAR) + args.li * 4096; bar.x = 0; bar.st = nullptr;
    if (N_LAUNCHES != N_PHASES) bar = xcd_barrier_post((unsigned*)(F.ctl + CW_BAR) + args.li * 4096, F.MISC + 8);
#define GRID_BAR() do { if (N_LAUNCHES != N_PHASES) xcd_barrier(bar); } while (0)
    const int lo = args.ph_lo, hi = args.ph_hi;
#define IN(k) (lo <= (k) && (k) < hi)
#define BOTH(k) (IN(k) && IN((k) + 1))

#define x_in (args.in[0])
#define XN8 ((unsigned char*)(ws + WS_XN))
#define WIN ((bf16*)(ws + WS_WIN))
#define WUP ((bf16*)(ws + WS_WUP))
#define WMEM ((bf16*)(ws + WS_WMEM))
#define WOUT ((bf16*)(ws + WS_WOUT))
#define WGU ((bf16*)(ws + WS_WGU))
#define WDN ((bf16*)(ws + WS_WDN))
#define MGU ((bf16*)(ws + WS_MGU))
#define MDN ((bf16*)(ws + WS_MDN))
#define XN ((bf16*)(ws + WS_XN))
#define MEMN ((bf16*)(ws + WS_MEMN))
#define MEMKV ((bf16*)(ws + WS_MEMKV))
#define PROJ ((bf16*)(ws + WS_PROJ))
#define AQKV ((bf16*)(ws + WS_AQKV))
#define KROPE ((bf16*)(ws + WS_KROPE))
#define ROPECS ((float*)(ws + WS_ROPECS))
#define QKVM ((bf16*)(ws + WS_QKVM))
#define YPRE ((float*)(ws + WS_YPRE))
#define DILO ((float*)(ws + WS_DILO))
#define DILS ((float*)(ws + WS_DILS))
#define Y ((bf16*)(ws + WS_Y))
#define XA ((float*)(ws + WS_XA))
#define ROUTE ((unsigned*)(ws + WS_ROUTE))
#define XP ((bf16*)(ws + WS_XP))
#define OUTP ((bf16*)(ws + WS_OUTP))
#define ACTP ((bf16*)(ws + WS_ACTP))
#define ACT ((bf16*)(ws + WS_ACTP))
#define PHASE_BEGIN() do { int t_ = threadIdx.x; asm volatile("" : "+v"(t_)); F.tid = t_; F.lane = t_ & 63; } while (0)

    if (PEN(0) && IN(0)) { PHASE_BEGIN();
        LAS float* scr = (LAS float*)(F.lds + F.wave * 16384);
        for (int rep = 0; rep < (REPEAT_PHASE == 0 ? 2 : 1); ++rep) {
        for (int l = 0; l < 2; ++l) {
            cvt_job<false>(F, args.in[5] + (size_t)l * D * DIN, D, DIN, WIN + (size_t)l * DINP * D, D, 0, 3, 0, scr, 1.f);
            cvt_job<false>(F, args.in[7] + (size_t)l * QR * 1152, QR, 1152, WUP + (size_t)l * NUP * AQ, AQ, 0, 0, 0, scr, 1.f);
            cvt_job<false>(F, args.in[9] + (size_t)l * KVR * 1536, KVR, 1536, WUP + (size_t)l * NUP * AQ, AQ, QR, 0, UC_KV, scr, 1.f);
            cvt_job<false>(F, args.in[11] + (size_t)l * D * 1024, D, 1024, WMEM + (size_t)l * 1024 * D, D, 0, 0, 0, scr, 1.f);
            cvt_job<false>(F, args.in[13] + (size_t)l * D * D, D, D, WOUT + (size_t)l * D * D, D, 0, 0, 0, scr, 1.f);
        }
        cvt_job<F8D>(F, args.in[15], D, DFF, WGU, D, 0, 1, 0, scr, Sc<F8D>::w_gu);
        cvt_job<F8D>(F, args.in[16], D, DFF, WGU, D, 0, 2, 0, scr, Sc<F8D>::w_gu);
        cvt_job<F8D>(F, args.in[17], DFF, D, WDN, DFF, 0, 0, 0, scr, Sc<F8D>::w_dn);
        }
        { const int* pos = (const int*)args.in[2];
          for (int idx = blockIdx.x * (NWAVES * 64) + F.tid; idx < S * 32; idx += F.G * NWAVES * 64) { const int row = idx >> 5, i = idx & 31;
              const float ang = (float)pos[row] * args.invf[i]; float c, s; sincos_f64(ang, c, s); ROPECS[row * 64 + i] = c; ROPECS[row * 64 + 32 + i] = s; } }
        for (int m = F.gw; m < 2 * NMEM; m += F.NGW) { const int l = m >> 8, r = m & 255; rms_row_to_bf16(args.in[1] + (size_t)r * D, args.in[10] + (size_t)l * D, MEMN + (size_t)m * D, F.lane); }
        for (int m = F.gw; m < S; m += F.NGW) rms_row_to_bf16(x_in + (size_t)m * D, args.in[4], XN + (size_t)m * D, F.lane);
        if (BOTH(0)) GRID_BAR();
    }

    for (int l = 0; l < 2; ++l) {
        const int pb = 1 + l * PH_PER_LAYER;
        if (PEN(1) && IN(pb + 0)) { PHASE_BEGIN();
            { pg8::Gemm g{XN, WIN + (size_t)l * DINP * D, 2 * D, 2 * D, D / 64}; pg8::InProjOrder So; So.so.init(S, DINP, F.G, (int)blockIdx.x); So.nextra = (l == 0) ? 8 : 0; So.A2 = MEMN; So.B2 = WMEM;
              pg8::EpiBf16Sel E{PROJ, DINP, MEMKV, 1024};
              pg8::gemm_phase<pg8::EpiBf16Sel, pg8::InProjOrder, true, true>(F.lds, g, So, E); }
            FILL(pb + 0);
            if (BOTH(pb + 0)) GRID_BAR();
        }
        if (PEN(2) && IN(pb + 1)) { PHASE_BEGIN();
            const float* gq = args.in[6] + l * QR; const float* gkv = args.in[8] + l * KVR;
            for (int m = F.gw; m < S; m += F.NGW) {
                const v4u w = *(const GAS v4u*)(PROJ + (size_t)m * DINP + F.lane * 8);
                float v[8] = {bflo(w.x), bfhi(w.x), bflo(w.y), bfhi(w.y), bflo(w.z), bfhi(w.z), bflo(w.w), bfhi(w.w)};
                float sq = 0.f;
#pragma unroll
                for (int j = 0; j < 8; ++j) sq += v[j] * v[j];
                const float sq_q = wave_sum(F.lane < 48 ? sq : 0.f), sq_kv = wave_sum(F.lane >= 48 ? sq : 0.f);
                const float rstd = F.lane < 48 ? 1.f / sqrtf(sq_q * (1.f / QR) + EPS) : 1.f / sqrtf(sq_kv * (1.f / KVR) + EPS);
                const float* gp = F.lane < 48 ? gq + F.lane * 8 : gkv + (F.lane - 48) * 8;
                const f32x4 g0 = *(const GAS f32x4*)gp, g1 = *(const GAS f32x4*)(gp + 4);
                v4u o; o.x = pk2(v[0] * rstd * g0.x, v[1] * rstd * g0.y); o.y = pk2(v[2] * rstd * g0.z, v[3] * rstd * g0.w);
                o.z = pk2(v[4] * rstd * g1.x, v[5] * rstd * g1.y); o.w = pk2(v[6] * rstd * g1.z, v[7] * rstd * g1.w);
                *(GAS v4u*)(AQKV + (size_t)m * AQ + F.lane * 8) = o;
                const int c = F.lane & 7;
                const v4u kw = *(const GAS v4u*)(PROJ + (size_t)m * DINP + 512 + c * 8);
                float kv[8] = {bflo(kw.x), bfhi(kw.x), bflo(kw.y), bfhi(kw.y), bflo(kw.z), bfhi(kw.z), bflo(kw.w), bfhi(kw.w)};
                float ko[8];
                const float* cs = ROPECS + (size_t)m * 64 + (c & 3) * 8;
#pragma unroll
                for (int j = 0; j < 8; ++j) { const float other = __shfl_xor(kv[j], 4); const float co = cs[j], si = cs[32 + j];
                    ko[j] = (c < 4) ? (kv[j] * co - other * si) : (other * si + kv[j] * co); }
                if (F.lane < 8) { v4u ow; ow.x = pk2(ko[0], ko[1]); ow.y = pk2(ko[2], ko[3]); ow.z = pk2(ko[4], ko[5]); ow.w = pk2(ko[6], ko[7]); *(GAS v4u*)(KROPE + (size_t)m * 64 + c * 8) = ow; }
            }
            if (BOTH(pb + 1)) GRID_BAR();
        }
        if (PEN(3) && IN(pb + 2)) { PHASE_BEGIN();
            pg8::Gemm g{AQKV, WUP + (size_t)l * NUP * AQ, 2 * AQ, 2 * AQ, AQ / 64}; pg8::StaticOrder So; So.init(S, NUP, F.G, (int)blockIdx.x);
            pg8::EpiBf16 E{QKVM, NUP, 1.f};
            pg8::gemm_phase<pg8::EpiBf16, pg8::StaticOrder, true, true>(F.lds, g, So, E);
            FILL(pb + 2);
            if (BOTH(pb + 2)) GRID_BAR();
        }
        if (PEN(4) && IN(pb + 3)) { PHASE_BEGIN();
            LAS float* BIAS = (LAS float*)(F.lds + BIAS_OFF);
            for (int i = F.tid; i < 3 * 6 * 129; i += NWAVES * 64) { const int b = i / (6 * 129), rem = i % (6 * 129), h = rem / 129, j = rem % 129;
                BIAS[(b * 6 + h) * 132 + j] = args.in[3][DIL_BUCKET[b][j] * 6 + h] * att::LOG2E; }
            __syncthreads();
            for (int rep = 0; rep < (REPEAT_PHASE == 4 ? 2 : 1); ++rep) {
            gu32* qhead = F.ctl + CW_QUEUE + 64 * l + 32 * rep;
            constexpr int NU_MLA = 6 * 32, NU_MEM = 4 * 32, NU_DIL = 3 * 6 * 32, NU = NU_MLA + NU_MEM + NU_DIL;
#define QPULL(u) do { if (F.tid == 0) F.MISC[16] = __hip_atomic_fetch_add(qhead, 1u, RLX_AGENT); __syncthreads(); u = (int)F.MISC[16]; __syncthreads(); } while (0)
            int u; QPULL(u);
            if (ATT_EN & 1) while (u < NU_MLA) {
                const int h = u >> 5, qb = u & 31;
                att::attn_simple_body<192, NUP, NUP, D>(QKVM + (size_t)qb * 256 * NUP + h * 192, QKVM + UC_KV + h * 256, KROPE, QKVM + UC_KV + h * 256 + 128,
                                                        ROPECS + (size_t)qb * 256 * 64, YPRE + (size_t)qb * 256 * D + h * 128, S, 0.07216878364870322f, (LAS char*)F.lds);
                QPULL(u);
            }
            if (ATT_EN & 2) while (u < NU_MLA + NU_MEM) {
                const int v = u - NU_MLA, h = v >> 5, qb = v & 31;
                const bf16* kv = MEMKV + (size_t)l * NMEM * 1024;
                att::attn_dense_body<128, DINP, 1024, D, 1>(PROJ + (size_t)qb * 256 * DINP + PC_MEM + h * 128, kv + h * 128, nullptr, kv + 512 + h * 128,
                                                            nullptr, YPRE + (size_t)qb * 256 * D + 1536 + h * 128, NMEM, 0.08838834764831845f, (LAS char*)F.lds);
                QPULL(u);
            }
            if (ATT_EN & 4) while (u < NU) {
                const int w = (u - NU_MLA - NU_MEM) * 8 + F.wave;
                const int b = w / 1536, h = (w % 1536) >> 8, tile = w & 255;
                const int d = b == 0 ? 1 : (b == 1 ? 4 : 16), nT = S / d, tpr = nT / 32;
                const int r = tile / tpr, t0 = (tile % tpr) * 32;
                att::dil_wave_unit<DINP>(PROJ, PC_DIL + h * 128, PC_DIL + 768 + h * 128, PC_DIL + 1536 + h * 128, d, r, t0, nT,
                                         DILO + (size_t)b * S * 768, h * 128, DILS + (size_t)b * S * 12 + h * 2,
                                         (LAS char*)F.lds + F.wave * 8192, BIAS + (b * 6 + h) * 132, 0.08838834764831845f * att::LOG2E, F.lane);
                QPULL(u);
            }
#undef QPULL
            }
            FILL(pb + 3);
            if (BOTH(pb + 3)) GRID_BAR();
        }
        if (PEN(5) && IN(pb + 4)) { PHASE_BEGIN();
            const float* gn = args.in[12] + (size_t)l * D;
            for (int m = F.gw; m < S; m += F.NGW) {
                const float* yr = YPRE + (size_t)m * D;
                f32x4 a[3]; float sa = 0.f;
#pragma unroll
                for (int j = 0; j < 3; ++j) { a[j] = *(const GAS f32x4*)(yr + (F.lane + 64 * j) * 4); sa += (a[j].x * a[j].x + a[j].y * a[j].y) + (a[j].z * a[j].z + a[j].w * a[j].w); }
                f32x4 c[2]; float sc = 0.f;
#pragma unroll
                for (int j = 0; j < 2; ++j) { c[j] = *(const GAS f32x4*)(yr + 1536 + (F.lane + 64 * j) * 4); sc += (c[j].x * c[j].x + c[j].y * c[j].y) + (c[j].z * c[j].z + c[j].w * c[j].w); }
                f32x4 bq[3]; float sb = 0.f;
#pragma unroll
                for (int j = 0; j < 3; ++j) { const int col = (F.lane + 64 * j) * 4, h = col >> 7;
                    float mm[3], zz[3];
#pragma unroll
                    for (int b = 0; b < 3; ++b) { const f32x2 st = *(const GAS f32x2*)(DILS + ((size_t)b * S + m) * 12 + h * 2); mm[b] = st.x; zz[b] = st.y; }
                    const float M = fmaxf(mm[0], fmaxf(mm[1], mm[2]));
                    float wgt[3], den = 0.f;
#pragma unroll
                    for (int b = 0; b < 3; ++b) { wgt[b] = __builtin_amdgcn_exp2f(mm[b] - M); den += wgt[b] * zz[b]; }
                    const float inv = 1.f / den; f32x4 acc = {0.f, 0.f, 0.f, 0.f};
#pragma unroll
                    for (int b = 0; b < 3; ++b) { const f32x4 ob = *(const GAS f32x4*)(DILO + ((size_t)b * S + m) * 768 + col); acc += ob * (wgt[b] * inv); }
                    bq[j] = acc; sb += (acc.x * acc.x + acc.y * acc.y) + (acc.z * acc.z + acc.w * acc.w); }
                const float ra = 1.f / sqrtf(wave_sum(sa) * (1.f / 768.f) + EPS), rb = 1.f / sqrtf(wave_sum(sb) * (1.f / 768.f) + EPS), rc = 1.f / sqrtf(wave_sum(sc) * (1.f / 512.f) + EPS);
                bf16* yo = Y + (size_t)m * D;
#pragma unroll
                for (int j = 0; j < 3; ++j) { const int col = (F.lane + 64 * j) * 4; const f32x4 g = *(const GAS f32x4*)(gn + col);
                    v2u w; w.x = pk2(a[j].x * ra * g.x, a[j].y * ra * g.y); w.y = pk2(a[j].z * ra * g.z, a[j].w * ra * g.w); *(GAS v2u*)(yo + col) = w; }
#pragma unroll
                for (int j = 0; j < 3; ++j) { const int col = (F.lane + 64 * j) * 4; const f32x4 g = *(const GAS f32x4*)(gn + 768 + col);
                    v2u w; w.x = pk2(bq[j].x * rb * g.x, bq[j].y * rb * g.y); w.y = pk2(bq[j].z * rb * g.z, bq[j].w * rb * g.w); *(GAS v2u*)(yo + 768 + col) = w; }
#pragma unroll
                for (int j = 0; j < 2; ++j) { const int col = (F.lane + 64 * j) * 4; const f32x4 g = *(const GAS f32x4*)(gn + 1536 + col);
                    v2u w; w.x = pk2(c[j].x * rc * g.x, c[j].y * rc * g.y); w.y = pk2(c[j].z * rc * g.z, c[j].w * rc * g.w); *(GAS v2u*)(yo + 1536 + col) = w; }
            }
            if (BOTH(pb + 4)) GRID_BAR();
        }
        if (PEN(6) && IN(pb + 5)) { PHASE_BEGIN();
            pg8::Gemm g{Y, WOUT + (size_t)l * D * D, 2 * D, 2 * D, D / 64}; pg8::StaticOrder So; So.init(S, D, F.G, (int)blockIdx.x);
            pg8::EpiResF32 E{l == 0 ? x_in : XA, args.rep ? YPRE : XA, D, 1.f};
            pg8::gemm_phase<pg8::EpiResF32, pg8::StaticOrder, true, true>(F.lds, g, So, E);
            if (BOTH(pb + 5)) GRID_BAR();
        }
        if (PEN(7) && IN(pb + 6)) { PHASE_BEGIN();
            const float* gf = args.in[14] + (size_t)l * D;
#if defined(PROBE_DEADLINE)
            if (l == 1 && blockIdx.x == 0 && F.tid == 0) F.ctl[CW_CVT + 16] = __hip_atomic_load(F.ctl + CW_CVT, RLX_AGENT);
#endif
            if (l == 0) { for (int m = F.gw; m < S; m += F.NGW) { if constexpr (F8D) rms_row_to_fp8(XA + (size_t)m * D, gf, XN8 + (size_t)m * D, F.lane); else rms_row_to_bf16(XA + (size_t)m * D, gf, XN + (size_t)m * D, F.lane); } }
            else {
                const float* Wr = args.in[18];
                for (int m = F.gw; m < S; m += F.NGW) {
                    const GAS f32x4* xr = (const GAS f32x4*)(XA + (size_t)m * D) + F.lane; const GAS f32x4* gr = (const GAS f32x4*)gf + F.lane;
                    f32x4 v[8]; float s = 0.f;
#pragma unroll
                    for (int j = 0; j < 8; ++j) { v[j] = xr[64 * j]; s += (v[j].x * v[j].x + v[j].y * v[j].y) + (v[j].z * v[j].z + v[j].w * v[j].w); }
                    const float rstd = 1.f / sqrtf(wave_sum(s) * (1.f / D) + EPS);
                    float lg[8] = {0.f, 0.f, 0.f, 0.f, 0.f, 0.f, 0.f, 0.f};
                    GAS v2u* o8 = (GAS v2u*)(XN + (size_t)m * D) + F.lane; GAS unsigned* o4 = (GAS unsigned*)(XN8 + (size_t)m * D) + F.lane;
#pragma unroll
                    for (int j = 0; j < 8; ++j) { const f32x4 gg = gr[64 * j]; const f32x4 hh = {v[j].x * rstd * gg.x, v[j].y * rstd * gg.y, v[j].z * rstd * gg.z, v[j].w * rstd * gg.w};
                        if constexpr (F8M) o4[64 * j] = pk4_fp8(hh.x, hh.y, hh.z, hh.w); else { v2u w; w.x = pk2(hh.x, hh.y); w.y = pk2(hh.z, hh.w); o8[64 * j] = w; }
                        const float* wr = Wr + (size_t)((F.lane + 64 * j) * 4) * NE;
#pragma unroll
                        for (int q = 0; q < 4; ++q) { const f32x4 w0 = *(const GAS f32x4*)(wr + q * NE), w1 = *(const GAS f32x4*)(wr + q * NE + 4); const float hv = hh[q];
                            lg[0] += hv * w0.x; lg[1] += hv * w0.y; lg[2] += hv * w0.z; lg[3] += hv * w0.w; lg[4] += hv * w1.x; lg[5] += hv * w1.y; lg[6] += hv * w1.z; lg[7] += hv * w1.w; } }
#pragma unroll
                    for (int e = 0; e < NE; ++e) lg[e] = wave_sum(lg[e]);
                    int e1 = 0; float v1 = lg[0];
#pragma unroll
                    for (int e = 1; e < NE; ++e) if (lg[e] > v1) { v1 = lg[e]; e1 = e; }
                    int e2 = -1; float v2 = -3.0e38f;
#pragma unroll
                    for (int e = 0; e < NE; ++e) if (e != e1 && lg[e] > v2) { v2 = lg[e]; e2 = e; }
                    const float g1 = 1.f / (1.f + __expf(v2 - v1)), g2 = 1.f - g1;
                    if (F.lane == 0) { const unsigned s1 = __hip_atomic_fetch_add(F.ctl + CW_CNT + e1, 1u, RLX_AGENT), s2 = __hip_atomic_fetch_add(F.ctl + CW_CNT + e2, 1u, RLX_AGENT);
                        v4u r0 = {(unsigned)e1, (unsigned)e2, s1, s2}; v4u r1 = {__float_as_uint(g1), __float_as_uint(g2), 0u, 0u};
                        *(GAS v4u*)(ROUTE + (size_t)m * 8) = r0; *(GAS v4u*)(ROUTE + (size_t)m * 8 + 4) = r1; }
                }
            }
            if (BOTH(pb + 6)) GRID_BAR();
        }
        if (PEN(8) && IN(pb + 7)) { PHASE_BEGIN();
            if (l == 1) {
                moe_cvt_fill(F, args, -1);
#if defined(PROBE_DEADLINE)
                for (int r_ = 0; r_ < PROBE_DEADLINE; ++r_) { __syncthreads(); moe_cvt_fill(F, args, -2); }
#endif
                int base[NE]; int tstart = 0;
#pragma unroll
                for (int e = 0; e < NE; ++e) { const int c = (int)__hip_atomic_load(F.ctl + CW_CNT + e, RLX_AGENT); base[e] = tstart * 256; const int nt = (c + 255) >> 8;
                    if (blockIdx.x == 0 && F.tid == 0) { for (int t = 0; t < nt; ++t) F.ctl[CW_TILEE + 1 + tstart + t] = (unsigned)e; }
                    tstart += nt; }
                if (blockIdx.x == 0 && F.tid == 0) F.ctl[CW_TILEE] = (unsigned)tstart;
                for (int m = F.gw; m < S; m += F.NGW) {
                    const v4u r0 = *(const GAS v4u*)(ROUTE + (size_t)m * 8);
                    int p1 = (int)r0.z, p2 = (int)r0.w;
#pragma unroll
                    for (int e = 0; e < NE; ++e) { if ((int)r0.x == e) p1 += base[e]; if ((int)r0.y == e) p2 += base[e]; }
                    if (F.lane == 0) { ROUTE[(size_t)m * 8 + 6] = (unsigned)p1; ROUTE[(size_t)m * 8 + 7] = (unsigned)p2; }
                    const unsigned char* srow = (const unsigned char*)XN8 + (size_t)m * D * EBM; unsigned char* xp = (unsigned char*)XP;
                    const GAS v4u* src = (const GAS v4u*)srow + F.lane; GAS v4u* d1 = (GAS v4u*)(xp + (size_t)p1 * D * EBM) + F.lane; GAS v4u* d2 = (GAS v4u*)(xp + (size_t)p2 * D * EBM) + F.lane;
#pragma unroll
                    for (int j = 0; j < 2 * EBM; ++j) { const v4u t = src[64 * j]; d1[64 * j] = t; d2[64 * j] = t; }
                }
            }
            if (BOTH(pb + 7) && l == 1) GRID_BAR();
        }
        if (PEN(9) && IN(pb + 8)) { PHASE_BEGIN();
            if (l == 0) { pg8::Gemm g{XN8, WGU, D * EBD, D * EBD, D * EBD / 128}; pg8::StaticOrder So; So.init(S, 2 * DFF, F.G, (int)blockIdx.x);
                FfnEpi1<F8D> E = Epi1Maker<F8D>::make(ACT, DFF);
                pg8::gemm_phase<FfnEpi1<F8D>, pg8::StaticOrder, true, true, F8D>(F.lds, g, So, E); }
            else { const int ntile = (int)__hip_atomic_load(F.ctl + CW_TILEE, RLX_AGENT);
                pg8::Gemm g{XP, MGU, D * EBM, D * EBM, D * EBM / 128}; pg8::MoeOrder So{F.G, (int)blockIdx.x, 2 * DFE / 256, ntile, 2 * DFE, (const int*)(F.ctl + CW_TILEE + 1)};
                FfnEpi1<F8M> E = Epi1Maker<F8M>::make(ACTP, DFE);
                pg8::gemm_phase<FfnEpi1<F8M>, pg8::MoeOrder, true, true, F8M>(F.lds, g, So, E); }
            if (BOTH(pb + 8)) GRID_BAR();
        }
        if (PEN(10) && IN(pb + 9)) { PHASE_BEGIN();
            if (l == 0) { pg8::Gemm g{ACT, WDN, DFF * EBD, DFF * EBD, DFF * EBD / 128}; pg8::StaticOrder So; So.init(S, D, F.G, (int)blockIdx.x);
                pg8::EpiResF32 E{XA, args.rep ? YPRE : XA, D, Sc<F8D>::dn};
                pg8::gemm_phase<pg8::EpiResF32, pg8::StaticOrder, true, true, F8D>(F.lds, g, So, E); }
            else { const int ntile = (int)__hip_atomic_load(F.ctl + CW_TILEE, RLX_AGENT);
                pg8::Gemm g{ACTP, MDN, DFE * EBM, DFE * EBM, DFE * EBM / 128}; pg8::MoeOrder So{F.G, (int)blockIdx.x, D / 256, ntile, D, (const int*)(F.ctl + CW_TILEE + 1)};
                pg8::EpiBf16 E{OUTP, D, Sc<F8M>::dn};
                pg8::gemm_phase<pg8::EpiBf16, pg8::MoeOrder, true, true, F8M>(F.lds, g, So, E); }
            if (BOTH(pb + 9)) GRID_BAR();
        }
        if (PEN(11) && IN(pb + 10)) { PHASE_BEGIN();
            if (l == 0) { for (int m = F.gw; m < S; m += F.NGW) rms_row_to_bf16(XA + (size_t)m * D, args.in[4] + D, XN + (size_t)m * D, F.lane); }
            else {
                const float* gfin = args.in[22];
                for (int m = F.gw; m < S; m += F.NGW) {
                    const v4u r1 = *(const GAS v4u*)(ROUTE + (size_t)m * 8 + 4);
                    const float g1 = __uint_as_float(r1.x), g2 = __uint_as_float(r1.y); const int p1 = (int)r1.z, p2 = (int)r1.w;
                    const GAS f32x4* xr = (const GAS f32x4*)(XA + (size_t)m * D) + F.lane;
                    const GAS v2u* o1 = (const GAS v2u*)(OUTP + (size_t)p1 * D) + F.lane; const GAS v2u* o2 = (const GAS v2u*)(OUTP + (size_t)p2 * D) + F.lane;
                    f32x4 v[8]; float s = 0.f;
#pragma unroll
                    for (int j = 0; j < 8; ++j) { const f32x4 xv = xr[64 * j]; const v2u a = o1[64 * j], b = o2[64 * j];
                        v[j].x = xv.x + g1 * bflo(a.x) + g2 * bflo(b.x); v[j].y = xv.y + g1 * bfhi(a.x) + g2 * bfhi(b.x);
                        v[j].z = xv.z + g1 * bflo(a.y) + g2 * bflo(b.y); v[j].w = xv.w + g1 * bfhi(a.y) + g2 * bfhi(b.y);
                        s += (v[j].x * v[j].x + v[j].y * v[j].y) + (v[j].z * v[j].z + v[j].w * v[j].w); }
                    const float rstd = 1.f / sqrtf(wave_sum(s) * (1.f / D) + EPS);
                    GAS f32x4* orow = (GAS f32x4*)(args.out + (size_t)m * D) + F.lane; const GAS f32x4* gr = (const GAS f32x4*)gfin + F.lane;
#pragma unroll
                    for (int j = 0; j < 8; ++j) { const f32x4 gg = gr[64 * j]; orow[64 * j] = (f32x4){v[j].x * rstd * gg.x, v[j].y * rstd * gg.y, v[j].z * rstd * gg.z, v[j].w * rstd * gg.w}; }
                }
            }
            if (BOTH(pb + 10) && l == 0) GRID_BAR();
        }
    }
#undef IN
#undef BOTH
#undef GRID_BAR
#undef WIN
#undef WUP
#undef WMEM
#undef WOUT
#undef WGU
#undef WDN
#undef MGU
#undef MDN
#undef XN
#undef MEMN
#undef MEMKV
#undef PROJ
#undef AQKV
#undef KROPE
#undef ROPECS
#undef QKVM
#undef YPRE
#undef DILO
#undef DILS
#undef Y
#undef XA
#undef ROUTE
#undef XP
#undef OUTP
#undef ACTP
#undef ACT
#undef x_in
#undef XN8
#undef PHASE_BEGIN
#undef FILL
}

extern "C" void kernel_launch(void* const* d_in, const int* in_sizes, int n_in, void* d_out, int out_size, void* d_ws, size_t ws_size, hipStream_t stream) {
    static int grid = 0;
    if (grid == 0) {
        if (n_in != 23 || in_sizes[0] != S * D || out_size != S * D || ws_size < WS_END) { fprintf(stderr, "kernel_launch: shape/workspace mismatch: n_in %d in0 %d out %d ws %zu (need %zu)\n", n_in, n_in > 0 ? in_sizes[0] : -1, out_size, ws_size, (size_t)WS_END); grid = -1; return; }
        int dev = 0, cus = 0, per_cu = 0;
        if (hipGetDevice(&dev) != hipSuccess || hipDeviceGetAttribute(&cus, hipDeviceAttributeMultiprocessorCount, dev) != hipSuccess) { fprintf(stderr, "kernel_launch: device query failed\n"); grid = -1; return; }
        if (hipFuncSetAttribute((const void*)mk_fwd, hipFuncAttributeMaxDynamicSharedMemorySize, LDS_BYTES) != hipSuccess) { fprintf(stderr, "kernel_launch: hipFuncSetAttribute failed\n"); grid = -1; return; }
        if (hipOccupancyMaxActiveBlocksPerMultiprocessor(&per_cu, (const void*)mk_fwd, NWAVES * 64, LDS_BYTES) != hipSuccess || per_cu < 1) { fprintf(stderr, "kernel_launch: occupancy query reports %d workgroups per CU\n", per_cu); }
        (void)hipGetLastError();
        grid = cus;
    }
    if (grid < 0) return;
    (void)hipMemsetAsync((char*)d_ws + WS_CTL, 0, CTL_ZERO_BYTES, stream);
    (void)hipMemsetAsync((char*)d_ws + WS_WIN, 0, (size_t)2 * DINP * D * 2, stream);
    (void)hipMemsetAsync((char*)d_ws + WS_WUP, 0, (size_t)2 * NUP * AQ * 2, stream);
    Args a{};
    for (int i = 0; i < 23; ++i) a.in[i] = (const float*)d_in[i];
    a.out = (float*)d_out; a.ws = (unsigned char*)d_ws;
    for (int i = 0; i < 32; ++i) a.invf[i] = 1.0f / powf(10000.0f, (float)i / 32.0f);
    int lo[8], hi[8], rp[8], nl = 0;
#if defined(PROBE_PHASE) && PROBE_PHASE >= 0
    lo[nl] = 0; hi[nl] = PROBE_PHASE + 1; rp[nl++] = 0;
    for (int r = 0; r < PROBE_REPS; ++r) { lo[nl] = PROBE_PHASE; hi[nl] = PROBE_PHASE + 1; rp[nl++] = 1; }
    if (PROBE_PHASE + 1 < N_PHASES) { lo[nl] = PROBE_PHASE + 1; hi[nl] = N_PHASES; rp[nl++] = 0; }
#else
    if (N_LAUNCHES == N_PHASES) { nl = 0; } else { lo[0] = 0; hi[0] = N_PHASES; rp[0] = 0; nl = 1; }
#endif
    const int total = (N_LAUNCHES == N_PHASES) ? N_PHASES : nl;
    for (int li = 0; li < total; ++li) {
        if (N_LAUNCHES == N_PHASES) { a.ph_lo = li; a.ph_hi = li + 1; a.li = 0; a.rep = 0; } else { a.ph_lo = lo[li]; a.ph_hi = hi[li]; a.li = li; a.rep = rp[li]; }
        hipLaunchKernelGGL(mk_fwd, dim3(grid), dim3(NWAVES * 64), LDS_BYTES, stream, a);
        const hipError_t le = hipPeekAtLastError();
        if (le != hipSuccess) { fprintf(stderr, "kernel_launch: launch %d failed: %s\n", li, hipGetErrorName(le)); break; }
    }
}
```

```cpp
#include <hip/hip_runtime.h>
#include <cstdio>
#include <cstdint>
#include <cmath>
#include <type_traits>
#ifndef MK_N_LAUNCHES
#define MK_N_LAUNCHES 1
#endif
#define REPEAT_PHASE -1
#define FFN_FP8 3
#define PROBE_PHASE -1
#define PROBE_REPS 3
#define FILLMASK 7
#define MLA_DMA 0
#define PROBE_ATT 7
#define GEMM_SP2 1
namespace pg8 {
#define PG8_LAS __attribute__((address_space(3)))
typedef unsigned short bf16_t;
typedef short bf16x8 __attribute__((ext_vector_type(8)));
typedef float f32x4 __attribute__((ext_vector_type(4)));
typedef unsigned u32x4 __attribute__((ext_vector_type(4)));
constexpr int BM = 256, BK = 64, HALF = 128, HTB = HALF * BK * 2  , STAGE_BYTES = 8 * HTB, NXCD = 8, WGM = 8;

__host__ __device__ __forceinline__ int lds_byte(int r, int c) { const int st = (r >> 4) * 2 + (c >> 5), rr = r & 15, cc = c & 31, ob = rr * 64 + cc * 2; return st * 1024 + (ob ^ (((ob >> 9) & 1) << 5)); }
__host__ __device__ __forceinline__ void stage_rc(int b, int& R, int& C) { const int st = b / 1024, sb = b % 1024, swz = sb ^ (((sb >> 9) & 1) << 5); R = (st >> 1) * 16 + swz / 64; C = (st & 1) * 32 + (swz % 64) / 2; }
__host__ __device__ __forceinline__ int perm32(int rho) { const int n = rho >> 4, i = rho & 15; return 8 * (i >> 2) + 4 * n + (i & 3); }

struct Unit { int pm, pn; };
struct Gemm { const void* A; const void* Bt; int lda, ldb, nt; };

struct StaticOrder {
    int nM, nN, nwg, G, c;
    __device__ void init(int M, int N, int G_, int c_) { nM = M / BM; nN = N / BM; nwg = nM * nN; G = G_; c = c_; }
    __device__ bool next(int i, Unit& u) const {
        const long L = (long)i * G + c; if (L >= nwg) return false;
        int wgid = (int)L; { const int q = nwg / NXCD, r = nwg % NXCD, xcd = wgid % NXCD, off = wgid / NXCD; wgid = (xcd < r ? xcd * (q + 1) : r * (q + 1) + (xcd - r) * q) + off; }
        const int nig = WGM * nN, gid = wgid / nig, fm = gid * WGM, gsz = (nM - fm) < WGM ? (nM - fm) : WGM;
        u.pm = fm + ((wgid % nig) % gsz); u.pn = (wgid % nig) / gsz; return true;
    }
    __device__ __forceinline__ const char* abase(const Gemm& g, const Unit& u) const { return (const char*)g.A + (size_t)u.pm * BM * g.lda; }
    __device__ __forceinline__ const char* bbase(const Gemm& g, const Unit& u) const { return (const char*)g.Bt + (size_t)u.pn * BM * g.ldb; }
};
struct InProjOrder {
    StaticOrder so; int nextra; const void* A2; const void* B2;
    __device__ bool next(int i, Unit& u) const { if (so.next(i, u)) return true; const long L = (long)i * so.G + so.c - so.nwg; if (L < 0 || L >= nextra) return false; u.pm = 32 + (int)(L >> 2); u.pn = (int)(L & 3); return true; }
    __device__ __forceinline__ const char* abase(const Gemm& g, const Unit& u) const { return u.pm < 32 ? (const char*)g.A + (size_t)u.pm * BM * g.lda : (const char*)A2 + (size_t)(u.pm - 32) * BM * g.lda; }
    __device__ __forceinline__ const char* bbase(const Gemm& g, const Unit& u) const { return u.pm < 32 ? (const char*)g.Bt + (size_t)u.pn * BM * g.ldb : (const char*)B2 + (size_t)((u.pm - 32) * 1024 + u.pn * BM) * g.ldb; }
};
struct MemOrder {
    int G, c;
    __device__ bool next(int i, Unit& u) const { const int L = c - (G - 8); if (i != 0 || L < 0 || L >= 8) return false; u.pm = L >> 2; u.pn = L & 3; return true; }
    __device__ __forceinline__ const char* abase(const Gemm& g, const Unit& u) const { return (const char*)g.A + (size_t)u.pm * BM * g.lda; }
    __device__ __forceinline__ const char* bbase(const Gemm& g, const Unit& u) const { return (const char*)g.Bt + (size_t)(u.pm * 1024 + u.pn * BM) * g.ldb; }
};
struct MoeOrder {
    int G, c, nN, ntile, nexp_rows; const int* tile_e;
    __device__ bool next(int i, Unit& u) const { const long L = (long)i * G + c; if (L >= (long)ntile * nN) return false; u.pm = (int)(L / nN); u.pn = (int)(L % nN); return true; }
    __device__ __forceinline__ const char* abase(const Gemm& g, const Unit& u) const { return (const char*)g.A + (size_t)u.pm * BM * g.lda; }
    __device__ __forceinline__ const char* bbase(const Gemm& g, const Unit& u) const { const int e = __builtin_amdgcn_readfirstlane(tile_e[u.pm]); return (const char*)g.Bt + ((size_t)e * nexp_rows + (size_t)u.pn * BM) * g.ldb; }
};

__device__ __forceinline__ unsigned cvt_pk_bf16(float lo, float hi) { unsigned r; asm volatile("v_cvt_pk_bf16_f32 %0, %1, %2" : "=v"(r) : "v"(lo), "v"(hi)); return r; }

struct EpiBf16 {
    static constexpr bool PERM = true;
    bf16_t* O; int ldc; float sc;
    __device__ __forceinline__ void operator()(const f32x4 (&acc)[2][2][4][2], const Unit& u, int wr, int wc, int fr, int fq) const {
        const int row0 = u.pm * BM + wr * 64 + fr, col0 = u.pn * BM + wc * 32 + 8 * fq;
#pragma unroll
        for (int ai = 0; ai < 2; ++ai)
#pragma unroll
            for (int m = 0; m < 4; ++m) { bf16_t* rowp = O + (size_t)(row0 + ai * HALF + m * 16) * ldc + col0;
#pragma unroll
                for (int bj = 0; bj < 2; ++bj) { const f32x4 v0 = acc[ai][bj][m][0] * sc, v1 = acc[ai][bj][m][1] * sc;
                    u32x4 w; w.x = cvt_pk_bf16(v0[0], v0[1]); w.y = cvt_pk_bf16(v0[2], v0[3]); w.z = cvt_pk_bf16(v1[0], v1[1]); w.w = cvt_pk_bf16(v1[2], v1[3]);
                    *(u32x4*)(rowp + bj * HALF) = w; } }
    }
};
struct EpiBf16Sel {
    static constexpr bool PERM = true;
    bf16_t* O; int ldc; bf16_t* O2; int ldc2;
    __device__ __forceinline__ void operator()(const f32x4 (&acc)[2][2][4][2], const Unit& u, int wr, int wc, int fr, int fq) const {
        const bool ex = u.pm >= 32; bf16_t* base = ex ? O2 : O; const int ld = ex ? ldc2 : ldc;
        const int row0 = (ex ? u.pm - 32 : u.pm) * BM + wr * 64 + fr, col0 = u.pn * BM + wc * 32 + 8 * fq;
#pragma unroll
        for (int ai = 0; ai < 2; ++ai)
#pragma unroll
            for (int m = 0; m < 4; ++m) { bf16_t* rowp = base + (size_t)(row0 + ai * HALF + m * 16) * ld + col0;
#pragma unroll
                for (int bj = 0; bj < 2; ++bj) { const f32x4 v0 = acc[ai][bj][m][0], v1 = acc[ai][bj][m][1];
                    u32x4 w; w.x = cvt_pk_bf16(v0[0], v0[1]); w.y = cvt_pk_bf16(v0[2], v0[3]); w.z = cvt_pk_bf16(v1[0], v1[1]); w.w = cvt_pk_bf16(v1[2], v1[3]);
                    *(u32x4*)(rowp + bj * HALF) = w; } }
    }
};
struct EpiResF32 {
    static constexpr bool PERM = false;
    const float* R; float* C; int ldc; float sc;
    __device__ __forceinline__ void operator()(const f32x4 (&acc)[2][2][4][2], const Unit& u, int wr, int wc, int fr, int fq) const {
        const int row0 = u.pm * BM + wr * 64 + fr, col0 = u.pn * BM + wc * 32 + 4 * fq;
#pragma unroll
        for (int ai = 0; ai < 2; ++ai)
#pragma unroll
            for (int m = 0; m < 4; ++m) { const size_t off = (size_t)(row0 + ai * HALF + m * 16) * ldc + col0;
#pragma unroll
                for (int bj = 0; bj < 2; ++bj)
#pragma unroll
                    for (int n = 0; n < 2; ++n) { const f32x4 r = *(const f32x4*)(R + off + bj * HALF + n * 16); *(f32x4*)(C + off + bj * HALF + n * 16) = r + acc[ai][bj][m][n] * sc; } }
    }
};
__device__ __forceinline__ float silu_mul(float g, float u) { return g * u * __builtin_amdgcn_rcpf(1.0f + __builtin_amdgcn_exp2f(-1.4426950408889634f * g)); }
struct EpiSwiGLU {
    static constexpr bool PERM = true;
    bf16_t* O; int ldc;
    __device__ __forceinline__ void operator()(const f32x4 (&acc)[2][2][4][2], const Unit& u, int wr, int wc, int fr, int fq) const {
        const int row0 = u.pm * BM + wr * 64 + fr, col0 = u.pn * HALF + wc * 32 + 8 * fq;
#pragma unroll
        for (int ai = 0; ai < 2; ++ai)
#pragma unroll
            for (int m = 0; m < 4; ++m) { bf16_t* rowp = O + (size_t)(row0 + ai * HALF + m * 16) * ldc + col0;
                const f32x4 g0 = acc[ai][0][m][0], g1 = acc[ai][0][m][1], u0 = acc[ai][1][m][0], u1 = acc[ai][1][m][1];
                u32x4 w; w.x = cvt_pk_bf16(silu_mul(g0[0], u0[0]), silu_mul(g0[1], u0[1])); w.y = cvt_pk_bf16(silu_mul(g0[2], u0[2]), silu_mul(g0[3], u0[3]));
                w.z = cvt_pk_bf16(silu_mul(g1[0], u1[0]), silu_mul(g1[1], u1[1])); w.w = cvt_pk_bf16(silu_mul(g1[2], u1[2]), silu_mul(g1[3], u1[3]));
                *(u32x4*)rowp = w; }
    }
};

typedef int v8i_t __attribute__((ext_vector_type(8)));
__device__ __forceinline__ v8i_t pg8_cat(bf16x8 lo, bf16x8 hi) { typedef int v4i_t __attribute__((ext_vector_type(4))); const v4i_t a = __builtin_bit_cast(v4i_t, lo), b = __builtin_bit_cast(v4i_t, hi); return (v8i_t){a.x, a.y, a.z, a.w, b.x, b.y, b.z, b.w}; }
struct EpiSwiGLU8 {
    static constexpr bool PERM = true;
    unsigned char* O; int ldc; float sc_in, sc_out;
    __device__ __forceinline__ void operator()(const f32x4 (&acc)[2][2][4][2], const Unit& u, int wr, int wc, int fr, int fq) const {
        const int row0 = u.pm * BM + wr * 64 + fr, col0 = u.pn * HALF + wc * 32 + 8 * fq;
#pragma unroll
        for (int ai = 0; ai < 2; ++ai)
#pragma unroll
            for (int m = 0; m < 4; ++m) { unsigned char* rowp = O + (size_t)(row0 + ai * HALF + m * 16) * ldc + col0;
                const f32x4 g0 = acc[ai][0][m][0] * sc_in, g1 = acc[ai][0][m][1] * sc_in, u0 = acc[ai][1][m][0] * (sc_in * sc_out), u1 = acc[ai][1][m][1] * (sc_in * sc_out);
                int w0 = 0, w1 = 0;
                w0 = __builtin_amdgcn_cvt_pk_fp8_f32(silu_mul(g0[0], u0[0]), silu_mul(g0[1], u0[1]), w0, false); w0 = __builtin_amdgcn_cvt_pk_fp8_f32(silu_mul(g0[2], u0[2]), silu_mul(g0[3], u0[3]), w0, true);
                w1 = __builtin_amdgcn_cvt_pk_fp8_f32(silu_mul(g1[0], u1[0]), silu_mul(g1[1], u1[1]), w1, false); w1 = __builtin_amdgcn_cvt_pk_fp8_f32(silu_mul(g1[2], u1[2]), silu_mul(g1[3], u1[3]), w1, true);
                typedef int v2i_t __attribute__((ext_vector_type(2))); *(v2i_t*)rowp = (v2i_t){w0, w1}; }
    }
};
__device__ __forceinline__ void pg8_mfma8(f32x4& c, v8i_t a, v8i_t b, int sc) { asm volatile("v_mfma_scale_f32_16x16x128_f8f6f4 %0, %1, %2, %0, %3, %3 op_sel_hi:[0,0,0]" : "+v"(c) : "v"(a), "v"(b), "v"(sc)); }
template <class Epi, class Sched, bool ALIGN_EPI = false, bool SP2 = false, bool FP8 = false>
__device__ __forceinline__ void gemm_phase(PG8_LAS unsigned char* lds, const Gemm g, const Sched& S, const Epi& E) {
    int tid_ = threadIdx.x; asm volatile("" : "+v"(tid_));
    const int tid = tid_, wid = __builtin_amdgcn_readfirstlane(tid >> 6), lane = tid & 63, wr = wid >> 2, wc = wid & 3, fr = lane & 15, fq = lane >> 4;
    const int nt = g.nt;
    unsigned voffA[2], voffB[2];
#pragma unroll
    for (int i = 0; i < 2; ++i) { int R, C; stage_rc(tid * 16 + i * 8192, R, C); const int Rb = Epi::PERM ? ((R & ~31) + perm32(R & 31)) : R;
        voffA[i] = (unsigned)(R * g.lda + C * 2); voffB[i] = (unsigned)(Rb * g.ldb + C * 2); }
    const size_t kstep = (size_t)(BK * 2);
    const size_t hstepA = (size_t)HALF * g.lda, hstepB = (size_t)HALF * g.ldb;
    const unsigned ldsw = (unsigned)wid * 1024u;
    const int aoff = lds_byte(wr * 64 + fr, fq * 8), boff = lds_byte(wc * 32 + fr, fq * 8);
#define PG8_SA(b, h) (((b) * 2 + (h)) * HTB)
#define PG8_SB(b, h) ((4 + (b) * 2 + (h)) * HTB)
#define PG8_STAGE(bufoff, gbase, voff) do { _Pragma("unroll") for (int _i = 0; _i < 2; ++_i) \
        __builtin_amdgcn_global_load_lds((const unsigned*)((const char*)(gbase) + (voff)[_i]), (PG8_LAS unsigned*)(lds + (bufoff) + ldsw + _i * 8192), 16, 0, 0); } while (0)
#define PG8_LDA(dst, b, h) do { _Pragma("unroll") for (int m = 0; m < 4; ++m) _Pragma("unroll") for (int k = 0; k < 2; ++k) dst[m][k] = *(const PG8_LAS bf16x8*)(lds + PG8_SA(b, h) + aoff + m * 2048 + k * 1024); } while (0)
#define PG8_LDB(dst, b, h) do { _Pragma("unroll") for (int n = 0; n < 2; ++n) _Pragma("unroll") for (int k = 0; k < 2; ++k) dst[n][k] = *(const PG8_LAS bf16x8*)(lds + PG8_SB(b, h) + boff + n * 2048 + k * 1024); } while (0)
#define PG8_MMA(ai, bj, At, Bt) do { __builtin_amdgcn_s_setprio(1); if constexpr (FP8) { _Pragma("unroll") for (int m = 0; m < 4; ++m) _Pragma("unroll") for (int n = 0; n < 2; ++n) \
        pg8_mfma8(acc[ai][bj][m][n], pg8_cat(Bt[n][0], Bt[n][1]), pg8_cat(At[m][0], At[m][1]), sc8); } else { \
        _Pragma("unroll") for (int m = 0; m < 4; ++m) _Pragma("unroll") for (int n = 0; n < 2; ++n) _Pragma("unroll") for (int k = 0; k < 2; ++k) \
        acc[ai][bj][m][n] = __builtin_amdgcn_mfma_f32_16x16x32_bf16(Bt[n][k], At[m][k], acc[ai][bj][m][n], 0, 0, 0); } __builtin_amdgcn_s_setprio(0); } while (0)
#define PG8_WAIT_V(n) asm volatile("s_waitcnt vmcnt(" #n ")" ::: "memory")
#define PG8_WAIT_L(n) asm volatile("s_waitcnt lgkmcnt(" #n ")" ::: "memory")
#define PG8_BAR __builtin_amdgcn_s_barrier()
#define PG8_SCHED __builtin_amdgcn_sched_barrier(0)
    Unit cur, nxt; int ui = 0;
    if (!S.next(0, cur)) return;
    int sc8 = 0x7F7F7F7F; asm volatile("" : "+v"(sc8));
    f32x4 acc[2][2][4][2];
#pragma unroll
    for (int a = 0; a < 2; ++a)
#pragma unroll
        for (int b = 0; b < 2; ++b)
#pragma unroll
            for (int m = 0; m < 4; ++m)
#pragma unroll
                for (int n = 0; n < 2; ++n) acc[a][b][m][n] = (f32x4){0.f, 0.f, 0.f, 0.f};
    bf16x8 At[4][2], B0[2][2], B1[2][2];
    const char* cA = S.abase(g, cur); const char* cB = S.bbase(g, cur);
    if constexpr (SP2) {
        PG8_STAGE(PG8_SB(0, 0), cB, voffB); PG8_STAGE(PG8_SB(0, 1), cB + hstepB, voffB); PG8_STAGE(PG8_SA(0, 0), cA, voffA); PG8_STAGE(PG8_SA(0, 1), cA + hstepA, voffA);
        if (wr == 1) PG8_BAR;
        PG8_WAIT_V(2); PG8_BAR;
        PG8_STAGE(PG8_SB(1, 0), cB + kstep, voffB); PG8_STAGE(PG8_SA(1, 0), cA + kstep, voffA); PG8_STAGE(PG8_SB(1, 1), cB + hstepB + kstep, voffB);
        PG8_WAIT_V(6); PG8_BAR;
    } else {
        PG8_STAGE(PG8_SB(0, 0), cB, voffB); PG8_STAGE(PG8_SA(0, 0), cA, voffA); PG8_STAGE(PG8_SB(0, 1), cB + hstepB, voffB); PG8_STAGE(PG8_SA(0, 1), cA + hstepA, voffA);
        if (wr == 1) PG8_BAR;
        PG8_WAIT_V(4); PG8_BAR;
        PG8_STAGE(PG8_SB(1, 0), cB + kstep, voffB); PG8_STAGE(PG8_SA(1, 0), cA + kstep, voffA); PG8_STAGE(PG8_SB(1, 1), cB + hstepB + kstep, voffB);
        PG8_WAIT_V(6); PG8_BAR;
    }
    for (;;) {
        const bool has_next = S.next(ui + 1, nxt);
        const char* nA = has_next ? S.abase(g, nxt) : cA; const char* nB = has_next ? S.bbase(g, nxt) : cB;
        for (int t = 0; t < nt; t += 2) {
            const bool last = (t == nt - 2);
            const char* a1 = cA + (size_t)(t + 1) * kstep;
            const char* a2 = last ? nA : cA + (size_t)(t + 2) * kstep; const char* b2 = last ? nB : cB + (size_t)(t + 2) * kstep;
            const char* a3 = a2 + kstep; const char* b3 = b2 + kstep;
            if constexpr (SP2) {
            PG8_LDB(B0, 0, 0); PG8_LDB(B1, 0, 1); PG8_SCHED; PG8_LDA(At, 0, 0); PG8_STAGE(PG8_SA(1, 1), a1 + hstepA, voffA);
            PG8_WAIT_V(8); PG8_WAIT_L(0); PG8_BAR; PG8_MMA(0, 0, At, B0); PG8_MMA(0, 1, At, B1); PG8_BAR; PG8_SCHED;
            PG8_LDA(At, 0, 1); PG8_STAGE(PG8_SB(0, 0), b2, voffB); PG8_STAGE(PG8_SB(0, 1), b2 + hstepB, voffB); PG8_STAGE(PG8_SA(0, 0), a2, voffA);
            PG8_WAIT_V(8); PG8_WAIT_L(0); PG8_BAR; PG8_MMA(1, 0, At, B0); PG8_MMA(1, 1, At, B1); PG8_BAR; PG8_SCHED;
            PG8_LDB(B0, 1, 0); PG8_LDB(B1, 1, 1); PG8_SCHED; PG8_LDA(At, 1, 0); PG8_STAGE(PG8_SA(0, 1), a2 + hstepA, voffA);
            PG8_WAIT_V(8); PG8_WAIT_L(0); PG8_BAR; PG8_MMA(0, 0, At, B0); PG8_MMA(0, 1, At, B1); PG8_BAR; PG8_SCHED;
            PG8_LDA(At, 1, 1); PG8_STAGE(PG8_SB(1, 0), b3, voffB); PG8_STAGE(PG8_SB(1, 1), b3 + hstepB, voffB); PG8_STAGE(PG8_SA(1, 0), a3, voffA);
            PG8_WAIT_V(8); PG8_WAIT_L(0); PG8_BAR; PG8_MMA(1, 0, At, B0); PG8_MMA(1, 1, At, B1); PG8_BAR; PG8_SCHED;
            } else {
            PG8_LDB(B0, 0, 0); PG8_SCHED; PG8_LDA(At, 0, 0); PG8_STAGE(PG8_SA(1, 1), a1 + hstepA, voffA);
            PG8_WAIT_L(8); PG8_BAR; PG8_WAIT_L(0); PG8_MMA(0, 0, At, B0); PG8_BAR; PG8_SCHED;
            PG8_LDB(B1, 0, 1); PG8_STAGE(PG8_SB(0, 0), b2, voffB);
            PG8_BAR; PG8_WAIT_L(0); PG8_MMA(0, 1, At, B1); PG8_BAR;
            PG8_LDA(At, 0, 1); PG8_STAGE(PG8_SA(0, 0), a2, voffA);
            PG8_BAR; PG8_WAIT_L(0); PG8_MMA(1, 0, At, B0); PG8_BAR; PG8_SCHED;
            PG8_STAGE(PG8_SB(0, 1), b2 + hstepB, voffB);
            PG8_WAIT_V(6); PG8_BAR; PG8_MMA(1, 1, At, B1); PG8_BAR;
            PG8_LDB(B0, 1, 0); PG8_SCHED; PG8_LDA(At, 1, 0); PG8_STAGE(PG8_SA(0, 1), a2 + hstepA, voffA);
            PG8_WAIT_L(8); PG8_BAR; PG8_WAIT_L(0); PG8_MMA(0, 0, At, B0); PG8_BAR; PG8_SCHED;
            PG8_LDB(B1, 1, 1); PG8_STAGE(PG8_SB(1, 0), b3, voffB);
            PG8_BAR; PG8_WAIT_L(0); PG8_MMA(0, 1, At, B1); PG8_BAR;
            PG8_LDA(At, 1, 1); PG8_STAGE(PG8_SA(1, 0), a3, voffA);
            PG8_BAR; PG8_WAIT_L(0); PG8_MMA(1, 0, At, B0); PG8_BAR; PG8_SCHED;
            PG8_STAGE(PG8_SB(1, 1), b3 + hstepB, voffB);
            PG8_WAIT_V(6); PG8_BAR; PG8_MMA(1, 1, At, B1); PG8_BAR;
            }
        }
        if constexpr (ALIGN_EPI) { if (wr == 0) PG8_BAR; }
        if constexpr (FP8) { PG8_SCHED; asm volatile("s_nop 15\n\ts_nop 7" ::: "memory"); PG8_SCHED; }
        E(acc, cur, wr, wc, fr, fq);
        if (!has_next) break;
#pragma unroll
        for (int a = 0; a < 2; ++a)
#pragma unroll
            for (int b = 0; b < 2; ++b)
#pragma unroll
                for (int m = 0; m < 4; ++m)
#pragma unroll
                    for (int n = 0; n < 2; ++n) acc[a][b][m][n] = (f32x4){0.f, 0.f, 0.f, 0.f};
        cur = nxt; cA = nA; cB = nB; ++ui;
        if constexpr (ALIGN_EPI) { if (wr == 1) PG8_BAR; }
    }
    PG8_WAIT_V(0);
    if constexpr (!ALIGN_EPI) { if (wr == 0) PG8_BAR; }
    PG8_BAR;
#undef PG8_SA
#undef PG8_SB
#undef PG8_STAGE
#undef PG8_LDA
#undef PG8_LDB
#undef PG8_MMA
#undef PG8_WAIT_V
#undef PG8_WAIT_L
#undef PG8_BAR
#undef PG8_SCHED
}
}
namespace att {
#define ATT_LAS __attribute__((address_space(3)))
#define ATT_GAS __attribute__((address_space(1)))
typedef unsigned short bf16;
using bf16x8 = __attribute__((ext_vector_type(8))) short;
using s16x4  = __attribute__((ext_vector_type(4))) short;
using f32x16 = __attribute__((ext_vector_type(16))) float;
using f32x4  = __attribute__((ext_vector_type(4))) float;
using u32x4  = __attribute__((ext_vector_type(4))) unsigned;
constexpr int NW = 8, QBLK = 32, KVBLK = 64, DV = 128;
constexpr float LOG2E = 1.4426950408889634f;
#define SBAR() __builtin_amdgcn_sched_barrier(0)
__device__ __forceinline__ int crow(int r, int hi) { return (r & 3) + 8 * (r >> 2) + 4 * hi; }
__device__ __forceinline__ unsigned cvtpk(float lo, float hi) { unsigned r; asm volatile("v_cvt_pk_bf16_f32 %0, %1, %2" : "=v"(r) : "v"(lo), "v"(hi)); return r; }
__device__ __forceinline__ float bf2f(short s) { return __uint_as_float(((unsigned)(unsigned short)s) << 16); }

__device__ __forceinline__ void partialSM(f32x16& p0, f32x16& p1, float& m_reg, float& mn, float& alpha, const float C, const float THRS) {
  float pmax = p0[0];
#pragma unroll
  for (int r = 1; r < 16; ++r) pmax = fmaxf(pmax, p0[r]);
#pragma unroll
  for (int r = 0; r < 16; ++r) pmax = fmaxf(pmax, p1[r]);
  { auto rr = __builtin_amdgcn_permlane32_swap(__float_as_uint(pmax), __float_as_uint(pmax), false, false);
    pmax = fmaxf(__uint_as_float(rr[0]), __uint_as_float(rr[1])); }
  if (__builtin_expect(__all(pmax - m_reg <= THRS), 1)) { mn = m_reg; alpha = 1.f; }
  else { mn = fmaxf(m_reg, pmax); alpha = __builtin_amdgcn_exp2f((m_reg - mn) * C); m_reg = mn; }
  float mnC = -mn * C;
#pragma unroll
  for (int r = 0; r < 16; ++r) p0[r] = fmaf(p0[r], C, mnC);
#pragma unroll
  for (int r = 0; r < 16; ++r) p1[r] = fmaf(p1[r], C, mnC);
#pragma unroll
  for (int r = 0; r < 16; ++r) p0[r] = __builtin_amdgcn_exp2f(p0[r]);
}
#define ATT_PK4(P, BASE, OUT) do { unsigned a0 = cvtpk(P[BASE + 0], P[BASE + 1]), a1 = cvtpk(P[BASE + 2], P[BASE + 3]);   \
    unsigned b0 = cvtpk(P[BASE + 4], P[BASE + 5]), b1 = cvtpk(P[BASE + 6], P[BASE + 7]);                              \
    auto r0 = __builtin_amdgcn_permlane32_swap(a0, b0, false, false); auto r1 = __builtin_amdgcn_permlane32_swap(a1, b1, false, false); \
    u32x4 w = {r0[0], r1[0], r0[1], r1[1]}; OUT = *reinterpret_cast<bf16x8*>(&w); } while (0)
__device__ __forceinline__ void finishSM(f32x16& p0, f32x16& p1, float alpha, float& l_reg, bf16x8& pa0, bf16x8& pa1, bf16x8& pa2, bf16x8& pa3) {
#pragma unroll
  for (int r = 0; r < 16; ++r) p1[r] = __builtin_amdgcn_exp2f(p1[r]);
  float ps = 0;
#pragma unroll
  for (int r = 0; r < 16; ++r) ps += p0[r];
#pragma unroll
  for (int r = 0; r < 16; ++r) ps += p1[r];
  { auto rr = __builtin_amdgcn_permlane32_swap(__float_as_uint(ps), __float_as_uint(ps), false, false);
    ps = __uint_as_float(rr[0]) + __uint_as_float(rr[1]); }
  l_reg = l_reg * alpha + ps;
  ATT_PK4(p0, 0, pa0); ATT_PK4(p0, 8, pa1); ATT_PK4(p1, 0, pa2); ATT_PK4(p1, 8, pa3);
}
template <int RB> __device__ __forceinline__ int kswz(int row, int colB) { return row * RB + (colB ^ ((row & 7) << 4)); }
template <int DQK> __device__ __forceinline__ void qkt(f32x16& p0, f32x16& p1, const ATT_LAS char* Ks, const bf16x8 (&qr)[DQK / 16], int r32, int hi) {
  p0 = f32x16{}; p1 = f32x16{};
#pragma unroll
  for (int d0 = 0; d0 < DQK / 16; ++d0) { const int cb = (d0 * 16 + hi * 8) * 2;
    bf16x8 b0 = *reinterpret_cast<const ATT_LAS bf16x8*>(Ks + kswz<DQK * 2>(r32, cb));
    bf16x8 b1 = *reinterpret_cast<const ATT_LAS bf16x8*>(Ks + kswz<DQK * 2>(32 + r32, cb));
    p0 = __builtin_amdgcn_mfma_f32_32x32x16_bf16(b0, qr[d0], p0, 0, 0, 0);
    p1 = __builtin_amdgcn_mfma_f32_32x32x16_bf16(b1, qr[d0], p1, 0, 0, 0); }
}
__device__ __forceinline__ int v_st(int k, int c) { const int kk = (k & ~0xC) | ((k & 4) << 1) | ((k & 8) >> 1); return ((kk >> 3) * 4 + (c >> 5)) * 512 + ((kk & 7) * 32 + (c & 31)) * 2; }
__device__ __forceinline__ int v_rd_base(int lane) { return ((lane & 3) << 3) | (((lane >> 2) & 3) << 6) | (((lane >> 4) & 1) << 5) | (((lane >> 5) & 1) << 8); }
constexpr int v_rd_off(int d0, int ks, int half) { return d0 * 512 + ks * 4096 + half * 2048; }
template <int OFF> __device__ __forceinline__ s16x4 tr_read(int vb) {
  s16x4 r; asm volatile("ds_read_b64_tr_b16 %0, %1 offset:%2" : "=&v"(r) : "v"(vb), "i"(OFF) : "memory"); return r;
}
#define ATT_PK(L, H) (bf16x8){L[0], L[1], L[2], L[3], H[0], H[1], H[2], H[3]}
template <int D0> __device__ __forceinline__ void pv_one(f32x16& od, int vb, bf16x8 pa0, bf16x8 pa1, bf16x8 pa2, bf16x8 pa3) {
  const s16x4 l0 = tr_read<v_rd_off(D0, 0, 0)>(vb), h0 = tr_read<v_rd_off(D0, 0, 1)>(vb), l1 = tr_read<v_rd_off(D0, 1, 0)>(vb), h1 = tr_read<v_rd_off(D0, 1, 1)>(vb);
  const s16x4 l2 = tr_read<v_rd_off(D0, 2, 0)>(vb), h2 = tr_read<v_rd_off(D0, 2, 1)>(vb), l3 = tr_read<v_rd_off(D0, 3, 0)>(vb), h3 = tr_read<v_rd_off(D0, 3, 1)>(vb);
  asm volatile("s_waitcnt lgkmcnt(0)" ::: "memory"); SBAR();
  od = __builtin_amdgcn_mfma_f32_32x32x16_bf16(pa0, ATT_PK(l0, h0), od, 0, 0, 0);
  od = __builtin_amdgcn_mfma_f32_32x32x16_bf16(pa1, ATT_PK(l1, h1), od, 0, 0, 0);
  od = __builtin_amdgcn_mfma_f32_32x32x16_bf16(pa2, ATT_PK(l2, h2), od, 0, 0, 0);
  od = __builtin_amdgcn_mfma_f32_32x32x16_bf16(pa3, ATT_PK(l3, h3), od, 0, 0, 0);
}
__device__ __forceinline__ void pv_d0(f32x16 (&o)[4], int vb, bf16x8 pa0, bf16x8 pa1, bf16x8 pa2, bf16x8 pa3) {
  pv_one<0>(o[0], vb, pa0, pa1, pa2, pa3); pv_one<1>(o[1], vb, pa0, pa1, pa2, pa3); pv_one<2>(o[2], vb, pa0, pa1, pa2, pa3); pv_one<3>(o[3], vb, pa0, pa1, pa2, pa3);
}
template <int D0> __device__ __forceinline__ void pv32_one(f32x16& od, int vb, bf16x8 pa0, bf16x8 pa1) {
  const s16x4 l0 = tr_read<v_rd_off(D0, 0, 0)>(vb), h0 = tr_read<v_rd_off(D0, 0, 1)>(vb), l1 = tr_read<v_rd_off(D0, 1, 0)>(vb), h1 = tr_read<v_rd_off(D0, 1, 1)>(vb);
  asm volatile("s_waitcnt lgkmcnt(0)" ::: "memory"); SBAR();
  od = __builtin_amdgcn_mfma_f32_32x32x16_bf16(pa0, ATT_PK(l0, h0), od, 0, 0, 0);
  od = __builtin_amdgcn_mfma_f32_32x32x16_bf16(pa1, ATT_PK(l1, h1), od, 0, 0, 0);
}

template <int DQK, int LDQ, int LDK, int LDO, int SDEPTH>
__device__ __forceinline__ void attn_dense_body(const bf16* __restrict__ Qb, const bf16* __restrict__ Kh, const bf16* __restrict__ Kr, const bf16* __restrict__ Vh,
                                                const float* __restrict__ cs_rows, float* __restrict__ Ob, int seq, const float scale, ATT_LAS char* lds) {
  constexpr int SHM_V = KVBLK * DV * 2, SHM_K = KVBLK * DQK * 2, RB = DQK * 2, NQ = DQK / 16;
  constexpr bool ROPE = (DQK == 192);
  const float C = scale * LOG2E, THRS = 8.f / scale;
  int tid_ = threadIdx.x; asm volatile("" : "+v"(tid_));
  const int tid = tid_, wid = tid >> 6, lane = tid & 63, r32 = lane & 31, hi = lane >> 5;
  ATT_LAS char* V_lds = lds; ATT_LAS char* K_lds = lds + 2 * SHM_V;
  ATT_LAS float* ws = (ATT_LAS float*)(lds + 2 * SHM_V + 2 * SHM_K) + wid * 64; ATT_LAS float* li_l = ws; ATT_LAS float* al_l = ws + 32;
  float m_reg = -1e30f, l_reg = 0; f32x16 o[4] = {}; bf16x8 qr[NQ];
  const bf16* Qw = Qb + (long)(wid * QBLK + r32) * LDQ + hi * 8;
#pragma unroll
  for (int d0 = 0; d0 < NQ; ++d0) qr[d0] = *(const ATT_GAS bf16x8*)(Qw + d0 * 16);
  if constexpr (ROPE) {
    const float* cs = cs_rows + (long)(wid * QBLK + r32) * 64 + hi * 8;
#pragma unroll
    for (int g = 0; g < 2; ++g) {
      const f32x4 c0 = *(const ATT_GAS f32x4*)(cs + g * 16), c1 = *(const ATT_GAS f32x4*)(cs + g * 16 + 4);
      const f32x4 s0 = *(const ATT_GAS f32x4*)(cs + 32 + g * 16), s1 = *(const ATT_GAS f32x4*)(cs + 32 + g * 16 + 4);
      float y1[8], y2[8];
#pragma unroll
      for (int j = 0; j < 8; ++j) { const float co = j < 4 ? c0[j & 3] : c1[j & 3], si = j < 4 ? s0[j & 3] : s1[j & 3];
        const float x1 = bf2f(qr[8 + g][j]), x2 = bf2f(qr[10 + g][j]); y1[j] = x1 * co - x2 * si; y2[j] = x1 * si + x2 * co; }
      u32x4 w1 = {cvtpk(y1[0], y1[1]), cvtpk(y1[2], y1[3]), cvtpk(y1[4], y1[5]), cvtpk(y1[6], y1[7])};
      u32x4 w2 = {cvtpk(y2[0], y2[1]), cvtpk(y2[2], y2[3]), cvtpk(y2[4], y2[5]), cvtpk(y2[6], y2[7])};
      qr[8 + g] = *reinterpret_cast<bf16x8*>(&w1); qr[10 + g] = *reinterpret_cast<bf16x8*>(&w2);
    }
  }
  const int sr = tid >> 4, sc = (tid & 15) * 8, vst0 = v_st(sr, sc), vst1 = v_st(32 + sr, sc);
  const int rr = tid >> 3, rc = (tid & 7) * 8;
  const int vb0 = (int)(unsigned)(uintptr_t)V_lds + v_rd_base(lane);
  struct Slot { bf16x8 vs0, vs1, ks0, ks1, kr; } sr_[SDEPTH];
#define SLOAD(i, k0) do { sr_[i].vs0 = *(const ATT_GAS bf16x8*)(&Vh[(long)((k0) + sr) * LDK + sc]); sr_[i].vs1 = *(const ATT_GAS bf16x8*)(&Vh[(long)((k0) + 32 + sr) * LDK + sc]); \
    sr_[i].ks0 = *(const ATT_GAS bf16x8*)(&Kh[(long)((k0) + sr) * LDK + sc]); sr_[i].ks1 = *(const ATT_GAS bf16x8*)(&Kh[(long)((k0) + 32 + sr) * LDK + sc]); \
    if constexpr (ROPE) sr_[i].kr = *(const ATT_GAS bf16x8*)(&Kr[(long)((k0) + rr) * 64 + rc]); } while (0)
#define SWRITE(b, i) do { *reinterpret_cast<ATT_LAS bf16x8*>(V_lds + (b) * SHM_V + vst0) = sr_[i].vs0;          \
    *reinterpret_cast<ATT_LAS bf16x8*>(V_lds + (b) * SHM_V + vst1) = sr_[i].vs1; const int kc = sc * 2;               \
    *reinterpret_cast<ATT_LAS bf16x8*>(K_lds + (b) * SHM_K + kswz<RB>(sr, kc)) = sr_[i].ks0;                       \
    *reinterpret_cast<ATT_LAS bf16x8*>(K_lds + (b) * SHM_K + kswz<RB>(32 + sr, kc)) = sr_[i].ks1;                  \
    if constexpr (ROPE) *reinterpret_cast<ATT_LAS bf16x8*>(K_lds + (b) * SHM_K + kswz<RB>(rr, 256 + rc * 2)) = sr_[i].kr; } while (0)
#define SWAIT() do { if constexpr (SDEPTH == 2) { if constexpr (ROPE) asm volatile("s_waitcnt vmcnt(5)" ::: "memory"); else asm volatile("s_waitcnt vmcnt(4)" ::: "memory"); } else asm volatile("s_waitcnt vmcnt(0)" ::: "memory"); } while (0)
#define RESC(a) do { if (__any((a) < 1.f)) { if (hi == 0) al_l[r32] = (a); asm volatile("s_waitcnt lgkmcnt(0)" ::: "memory"); \
    _Pragma("unroll") for (int d = 0; d < 4; ++d) _Pragma("unroll") for (int r = 0; r < 16; ++r) o[d][r] *= al_l[crow(r, hi)]; } } while (0)
  f32x16 pA0, pA1, pB0, pB1; float mnA, mnB, alA, alB; bf16x8 pa0, pa1, pa2, pa3; const int NT = seq / KVBLK;
  constexpr int SE = 0, SO = SDEPTH - 1;
  SLOAD(SE, 0); asm volatile("s_waitcnt vmcnt(0)" ::: "memory"); SWRITE(0, SE); __syncthreads();
  qkt<DQK>(pA0, pA1, K_lds, qr, r32, hi); partialSM(pA0, pA1, m_reg, mnA, alA, C, THRS);
  SLOAD(SO, KVBLK); if constexpr (SDEPTH == 2) { if (2 < NT) SLOAD(SE, 2 * KVBLK); }
  SWAIT(); SWRITE(1, SO); __syncthreads();
  for (int j = 1; j + 1 < NT; j += 2) {
    SBAR(); qkt<DQK>(pB0, pB1, K_lds + SHM_K, qr, r32, hi);
    finishSM(pA0, pA1, alA, l_reg, pa0, pa1, pa2, pa3); SBAR();
    SLOAD(SO, (j + SDEPTH) * KVBLK); SBAR();
    pv_d0(o, vb0, pa0, pa1, pa2, pa3); partialSM(pB0, pB1, m_reg, mnB, alB, C, THRS);
    __syncthreads(); SWAIT(); SWRITE(0, SE);
    RESC(alB); __syncthreads();
    SBAR(); qkt<DQK>(pA0, pA1, K_lds, qr, r32, hi);
    finishSM(pB0, pB1, alB, l_reg, pa0, pa1, pa2, pa3); SBAR();
    if (SDEPTH == 1 || j + 3 < NT) SLOAD(SE, (j + 1 + SDEPTH) * KVBLK); SBAR();
    pv_d0(o, vb0 + SHM_V, pa0, pa1, pa2, pa3); partialSM(pA0, pA1, m_reg, mnA, alA, C, THRS);
    __syncthreads(); SWAIT(); SWRITE(1, SO);
    RESC(alA); __syncthreads();
  }
  SBAR(); qkt<DQK>(pB0, pB1, K_lds + SHM_K, qr, r32, hi);
  finishSM(pA0, pA1, alA, l_reg, pa0, pa1, pa2, pa3); SBAR();
  pv_d0(o, vb0, pa0, pa1, pa2, pa3); partialSM(pB0, pB1, m_reg, mnB, alB, C, THRS);
  __syncthreads(); RESC(alB);
  finishSM(pB0, pB1, alB, l_reg, pa0, pa1, pa2, pa3); SBAR();
  pv_d0(o, vb0 + SHM_V, pa0, pa1, pa2, pa3);
  if (hi == 0) li_l[r32] = l_reg; asm volatile("s_waitcnt lgkmcnt(0)" ::: "memory");
  float rli[16];
#pragma unroll
  for (int r = 0; r < 16; ++r) rli[r] = __builtin_amdgcn_rcpf(li_l[crow(r, hi)]);
  float* Ow = Ob + (long)(wid * QBLK) * LDO;
#pragma unroll
  for (int r = 0; r < 16; ++r) { const int orow = crow(r, hi);
#pragma unroll
    for (int d0 = 0; d0 < 4; ++d0) Ow[(long)orow * LDO + d0 * 32 + r32] = o[d0][r] * rli[r]; }
  __syncthreads();
#undef SLOAD
#undef SWRITE
#undef SWAIT
#undef RESC
}

template <int DQK, int LDQ, int LDK, int LDO>
__device__ __forceinline__ void attn_simple_body(const bf16* __restrict__ Qb, const bf16* __restrict__ Kh, const bf16* __restrict__ Kr, const bf16* __restrict__ Vh,
                                                 const float* __restrict__ cs_rows, float* __restrict__ Ob, int seq, const float scale, ATT_LAS char* lds) {
  constexpr int SHM_V = KVBLK * DV * 2, SHM_K = KVBLK * DQK * 2, RB = DQK * 2, NQ = DQK / 16;
  constexpr bool ROPE = (DQK == 192);
  const float C = scale * LOG2E, THRS = 8.f / scale;
  int tid_ = threadIdx.x; asm volatile("" : "+v"(tid_));
  const int tid = tid_, wid = tid >> 6, lane = tid & 63, r32 = lane & 31, hi = lane >> 5;
  ATT_LAS char* V_lds = lds; ATT_LAS char* K_lds = lds + 2 * SHM_V;
  ATT_LAS float* ws = (ATT_LAS float*)(lds + 2 * SHM_V + 2 * SHM_K) + wid * 64; ATT_LAS float* li_l = ws; ATT_LAS float* al_l = ws + 32;
  float m_reg = -1e30f, l_reg = 0; f32x16 o[4] = {}; bf16x8 qr[NQ];
  const bf16* Qw = Qb + (long)(wid * QBLK + r32) * LDQ + hi * 8;
#pragma unroll
  for (int d0 = 0; d0 < NQ; ++d0) qr[d0] = *(const ATT_GAS bf16x8*)(Qw + d0 * 16);
  if constexpr (ROPE) {
    const float* cs = cs_rows + (long)(wid * QBLK + r32) * 64 + hi * 8;
#pragma unroll
    for (int g = 0; g < 2; ++g) {
      const f32x4 c0 = *(const ATT_GAS f32x4*)(cs + g * 16), c1 = *(const ATT_GAS f32x4*)(cs + g * 16 + 4);
      const f32x4 s0 = *(const ATT_GAS f32x4*)(cs + 32 + g * 16), s1 = *(const ATT_GAS f32x4*)(cs + 32 + g * 16 + 4);
      float y1[8], y2[8];
#pragma unroll
      for (int j = 0; j < 8; ++j) { const float co = j < 4 ? c0[j & 3] : c1[j & 3], si = j < 4 ? s0[j & 3] : s1[j & 3];
        const float x1 = bf2f(qr[8 + g][j]), x2 = bf2f(qr[10 + g][j]); y1[j] = x1 * co - x2 * si; y2[j] = x1 * si + x2 * co; }
      u32x4 w1 = {cvtpk(y1[0], y1[1]), cvtpk(y1[2], y1[3]), cvtpk(y1[4], y1[5]), cvtpk(y1[6], y1[7])};
      u32x4 w2 = {cvtpk(y2[0], y2[1]), cvtpk(y2[2], y2[3]), cvtpk(y2[4], y2[5]), cvtpk(y2[6], y2[7])};
      qr[8 + g] = *reinterpret_cast<bf16x8*>(&w1); qr[10 + g] = *reinterpret_cast<bf16x8*>(&w2);
    }
  }
  const int sr = tid >> 4, sc = (tid & 15) * 8, vst0 = v_st(sr, sc), vst1 = v_st(32 + sr, sc);
  const int rr = tid >> 3, rc = (tid & 7) * 8;
  const int vb0 = (int)(unsigned)(uintptr_t)V_lds + v_rd_base(lane);
  bf16x8 vs0, vs1, ks0, ks1, kr;
#define SLOAD(k0) do { vs0 = *(const ATT_GAS bf16x8*)(&Vh[(long)((k0) + sr) * LDK + sc]); vs1 = *(const ATT_GAS bf16x8*)(&Vh[(long)((k0) + 32 + sr) * LDK + sc]); \
    ks0 = *(const ATT_GAS bf16x8*)(&Kh[(long)((k0) + sr) * LDK + sc]); ks1 = *(const ATT_GAS bf16x8*)(&Kh[(long)((k0) + 32 + sr) * LDK + sc]); \
    if constexpr (ROPE) kr = *(const ATT_GAS bf16x8*)(&Kr[(long)((k0) + rr) * 64 + rc]); } while (0)
#define SWRITE(b) do { *reinterpret_cast<ATT_LAS bf16x8*>(V_lds + (b) * SHM_V + vst0) = vs0;          \
    *reinterpret_cast<ATT_LAS bf16x8*>(V_lds + (b) * SHM_V + vst1) = vs1; const int kc = sc * 2;               \
    *reinterpret_cast<ATT_LAS bf16x8*>(K_lds + (b) * SHM_K + kswz<RB>(sr, kc)) = ks0;                       \
    *reinterpret_cast<ATT_LAS bf16x8*>(K_lds + (b) * SHM_K + kswz<RB>(32 + sr, kc)) = ks1;                  \
    if constexpr (ROPE) *reinterpret_cast<ATT_LAS bf16x8*>(K_lds + (b) * SHM_K + kswz<RB>(rr, 256 + rc * 2)) = kr; } while (0)
#define RESC(a) do { if (__any((a) < 1.f)) { if (hi == 0) al_l[r32] = (a); asm volatile("s_waitcnt lgkmcnt(0)" ::: "memory"); \
    _Pragma("unroll") for (int d = 0; d < 4; ++d) _Pragma("unroll") for (int r = 0; r < 16; ++r) o[d][r] *= al_l[crow(r, hi)]; } } while (0)
  const int NT = seq / KVBLK;
  SLOAD(0); SWRITE(0); __syncthreads();
  for (int j = 0; j < NT; ++j) {
    const int b = j & 1;
    if (j + 1 < NT) SLOAD((j + 1) * KVBLK);
    f32x16 p0, p1; float mn, al; bf16x8 pa0, pa1, pa2, pa3;
    SBAR(); qkt<DQK>(p0, p1, K_lds + b * SHM_K, qr, r32, hi);
    partialSM(p0, p1, m_reg, mn, al, C, THRS); RESC(al);
    finishSM(p0, p1, al, l_reg, pa0, pa1, pa2, pa3); SBAR();
    pv_d0(o, vb0 + b * SHM_V, pa0, pa1, pa2, pa3);
    if (j + 1 < NT) SWRITE(b ^ 1);
    __syncthreads();
  }
  if (hi == 0) li_l[r32] = l_reg; asm volatile("s_waitcnt lgkmcnt(0)" ::: "memory");
  float rli[16];
#pragma unroll
  for (int r = 0; r < 16; ++r) rli[r] = __builtin_amdgcn_rcpf(li_l[crow(r, hi)]);
  float* Ow = Ob + (long)(wid * QBLK) * LDO;
#pragma unroll
  for (int r = 0; r < 16; ++r) { const int orow = crow(r, hi);
#pragma unroll
    for (int d0 = 0; d0 < 4; ++d0) Ow[(long)orow * LDO + d0 * 32 + r32] = o[d0][r] * rli[r]; }
  __syncthreads();
#undef SLOAD
#undef SWRITE
#undef RESC
}

template <int LDQ, int LDK, int LDO>
__device__ __forceinline__ void attn_dma_body(const bf16* __restrict__ Qb, const bf16* __restrict__ Kh, const bf16* __restrict__ Kr, const bf16* __restrict__ Vh,
                                              const float* __restrict__ cs_rows, float* __restrict__ Ob, int seq, const float scale, ATT_LAS char* lds) {
  constexpr int DQK = 192, SHM_V = KVBLK * DV * 2, SHM_K = KVBLK * DQK * 2, STG = SHM_K + SHM_V, RB = DQK * 2, NQ = DQK / 16;
  const float C = scale * LOG2E, THRS = 8.f / scale;
  int tid_ = threadIdx.x; asm volatile("" : "+v"(tid_));
  const int tid = tid_, wid = __builtin_amdgcn_readfirstlane(tid >> 6), lane = tid & 63, r32 = lane & 31, hi = lane >> 5;
  ATT_LAS float* ws = (ATT_LAS float*)(lds + 3 * STG) + wid * 64; ATT_LAS float* li_l = ws; ATT_LAS float* al_l = ws + 32;
  float m_reg = -1e30f, l_reg = 0; f32x16 o[4] = {}; bf16x8 qr[NQ];
  const bf16* Qw = Qb + (long)(wid * QBLK + r32) * LDQ + hi * 8;
#pragma unroll
  for (int d0 = 0; d0 < NQ; ++d0) qr[d0] = *(const ATT_GAS bf16x8*)(Qw + d0 * 16);
  { const float* cs = cs_rows + (long)(wid * QBLK + r32) * 64 + hi * 8;
#pragma unroll
    for (int g = 0; g < 2; ++g) {
      const f32x4 c0 = *(const ATT_GAS f32x4*)(cs + g * 16), c1 = *(const ATT_GAS f32x4*)(cs + g * 16 + 4);
      const f32x4 s0 = *(const ATT_GAS f32x4*)(cs + 32 + g * 16), s1 = *(const ATT_GAS f32x4*)(cs + 32 + g * 16 + 4);
      float y1[8], y2[8];
#pragma unroll
      for (int j = 0; j < 8; ++j) { const float co = j < 4 ? c0[j & 3] : c1[j & 3], si = j < 4 ? s0[j & 3] : s1[j & 3];
        const float x1 = bf2f(qr[8 + g][j]), x2 = bf2f(qr[10 + g][j]); y1[j] = x1 * co - x2 * si; y2[j] = x1 * si + x2 * co; }
      u32x4 w1 = {cvtpk(y1[0], y1[1]), cvtpk(y1[2], y1[3]), cvtpk(y1[4], y1[5]), cvtpk(y1[6], y1[7])};
      u32x4 w2 = {cvtpk(y2[0], y2[1]), cvtpk(y2[2], y2[3]), cvtpk(y2[4], y2[5]), cvtpk(y2[6], y2[7])};
      qr[8 + g] = *reinterpret_cast<bf16x8*>(&w1); qr[10 + g] = *reinterpret_cast<bf16x8*>(&w2);
    } }
  const char* ksrc[3]; int kstep[3];
#pragma unroll
  for (int d = 0; d < 3; ++d) { const int p = (wid * 3 + d) * 64 + lane, row = p / 24, cpos = p - row * 24, c = cpos ^ (row & 7);
    if (c < 16) { ksrc[d] = (const char*)(Kh + (long)row * LDK + c * 8); kstep[d] = KVBLK * LDK * 2; } else { ksrc[d] = (const char*)(Kr + (long)row * 64 + (c - 16) * 8); kstep[d] = KVBLK * 64 * 2; } }
  const char* vsrc[2];
#pragma unroll
  for (int d = 0; d < 2; ++d) { const int p = (wid * 2 + d) * 64 + lane, sub = p >> 5, q = p & 31, kk = (sub >> 2) * 8 + (q >> 2), col = (sub & 3) * 32 + (q & 3) * 8;
    const int key = (kk & ~0xC) | ((kk & 4) << 1) | ((kk & 8) >> 1); vsrc[d] = (const char*)(Vh + (long)key * LDK + col); }
#define DMA_TILE(t, stg) do { ATT_LAS char* sb_ = lds + (stg) * STG; \
    _Pragma("unroll") for (int d = 0; d < 3; ++d) __builtin_amdgcn_global_load_lds((const unsigned*)(ksrc[d] + (long)(t) * kstep[d]), (ATT_LAS unsigned*)(sb_ + (wid * 3 + d) * 1024), 16, 0, 0); \
    _Pragma("unroll") for (int d = 0; d < 2; ++d) __builtin_amdgcn_global_load_lds((const unsigned*)(vsrc[d] + (long)(t) * (KVBLK * LDK * 2)), (ATT_LAS unsigned*)(sb_ + SHM_K + (wid * 2 + d) * 1024), 16, 0, 0); } while (0)
#define RESC(a) do { if (__any((a) < 1.f)) { if (hi == 0) al_l[r32] = (a); asm volatile("s_waitcnt lgkmcnt(0)" ::: "memory"); \
    _Pragma("unroll") for (int d = 0; d < 4; ++d) _Pragma("unroll") for (int r = 0; r < 16; ++r) o[d][r] *= al_l[crow(r, hi)]; } } while (0)
  const int NT = seq / KVBLK, vbase = (int)(unsigned)(uintptr_t)lds + SHM_K + v_rd_base(lane);
  asm volatile("s_waitcnt vmcnt(0)" ::: "memory");
  DMA_TILE(0, 0); DMA_TILE(1, 1);
  asm volatile("s_waitcnt vmcnt(5)" ::: "memory"); __builtin_amdgcn_s_barrier(); asm volatile("" ::: "memory");
  int stg = 0;
  for (int j = 0; j < NT; ++j) {
    const int stg2 = stg >= 1 ? stg - 1 : 2;
    if (j + 2 < NT) DMA_TILE(j + 2, stg2);
    f32x16 p0, p1; float mn, al; bf16x8 pa0, pa1, pa2, pa3;
    SBAR(); qkt<DQK>(p0, p1, lds + stg * STG, qr, r32, hi);
    partialSM(p0, p1, m_reg, mn, al, C, THRS); RESC(al);
    finishSM(p0, p1, al, l_reg, pa0, pa1, pa2, pa3); SBAR();
    pv_d0(o, vbase + stg * STG, pa0, pa1, pa2, pa3);
    if (j + 2 < NT) asm volatile("s_waitcnt vmcnt(5)" ::: "memory"); else asm volatile("s_waitcnt vmcnt(0)" ::: "memory");
    asm volatile("s_waitcnt lgkmcnt(0)" ::: "memory"); __builtin_amdgcn_s_barrier(); asm volatile("" ::: "memory");
    stg = stg == 2 ? 0 : stg + 1;
  }
  if (hi == 0) li_l[r32] = l_reg; asm volatile("s_waitcnt lgkmcnt(0)" ::: "memory");
  float rli[16];
#pragma unroll
  for (int r = 0; r < 16; ++r) rli[r] = __builtin_amdgcn_rcpf(li_l[crow(r, hi)]);
  float* Ow = Ob + (long)(wid * QBLK) * LDO;
#pragma unroll
  for (int r = 0; r < 16; ++r) { const int orow = crow(r, hi);
#pragma unroll
    for (int d0 = 0; d0 < 4; ++d0) Ow[(long)orow * LDO + d0 * 32 + r32] = o[d0][r] * rli[r]; }
  __syncthreads();
#undef DMA_TILE
#undef RESC
}

template <int LDP>
__device__ __forceinline__ void dil_wave_unit(const bf16* __restrict__ P, int qc, int kc, int vc, int d, int r, int t0, int nT,
                                              float* __restrict__ O, int oc, float* __restrict__ ST  ,
                                              ATT_LAS char* vlds  , const ATT_LAS float* bias2, const float C, int lane_) {
  int lane = lane_; asm volatile("" : "+v"(lane));
  const int r32 = lane & 31, hi = lane >> 5;
  bf16x8 qr[8];
  { const bf16* qp = P + (long)(r + d * (t0 + r32)) * LDP + qc + hi * 8;
#pragma unroll
    for (int d0 = 0; d0 < 8; ++d0) qr[d0] = *(const ATT_GAS bf16x8*)(qp + d0 * 16); }
  bf16x8 kf[2][8];
#define DIL_LDK(kb, set) do { int kt_ = t0 - 64 + (kb) * 32 + r32; kt_ = kt_ < 0 ? 0 : (kt_ > nT - 1 ? nT - 1 : kt_); \
    const bf16* kp_ = P + (long)(r + d * kt_) * LDP + kc + hi * 8; \
    _Pragma("unroll") for (int d0 = 0; d0 < 8; ++d0) kf[set][d0] = *(const ATT_GAS bf16x8*)(kp_ + d0 * 16); } while (0)
  DIL_LDK(0, 0);
  f32x16 p[5];
#pragma unroll
  for (int kb = 0; kb < 5; ++kb) {
    if (kb + 1 < 5) DIL_LDK(kb + 1, (kb + 1) & 1);
    p[kb] = f32x16{};
#pragma unroll
    for (int d0 = 0; d0 < 8; ++d0) p[kb] = __builtin_amdgcn_mfma_f32_32x32x16_bf16(kf[kb & 1][d0], qr[d0], p[kb], 0, 0, 0);
  }
#undef DIL_LDK
  bf16x8 vv[2][8];
#define DIL_LDV(kb, set) do { _Pragma("unroll") for (int i = 0; i < 8; ++i) { const int id = lane + 64 * i, row = id >> 4, c = (id & 15) * 8; \
      int kt_ = t0 - 64 + (kb) * 32 + row; kt_ = kt_ < 0 ? 0 : (kt_ > nT - 1 ? nT - 1 : kt_); \
      vv[set][i] = *(const ATT_GAS bf16x8*)(P + (long)(r + d * kt_) * LDP + vc + c); } } while (0)
  DIL_LDV(0, 0);
  float m = -1e30f;
  { const int a_ = 4 * hi - r32 + 32, k_ = a_ & 3; const ATT_LAS f32x4* tp = (const ATT_LAS f32x4*)(bias2 + k_ * 196 + (a_ - k_));
    const bool interior = (t0 >= 64) && (t0 + 96 <= nT);
#pragma unroll
    for (int kb = 0; kb < 5; ++kb)
#pragma unroll
      for (int g = 0; g < 4; ++g) { const f32x4 bv = tp[kb * 8 + 2 * g];
#pragma unroll
        for (int e = 0; e < 4; ++e) { const int rg = 4 * g + e; float s = fmaf(p[kb][rg], C, bv[e]);
          if (!interior) { const int kt = t0 - 64 + kb * 32 + crow(rg, hi); s = (kt >= 0 && kt < nT) ? s : -1e30f; }
          p[kb][rg] = s; m = fmaxf(m, s); } } }
  { auto rr = __builtin_amdgcn_permlane32_swap(__float_as_uint(m), __float_as_uint(m), false, false); m = fmaxf(__uint_as_float(rr[0]), __uint_as_float(rr[1])); }
  float Z = 0.f;
#pragma unroll
  for (int kb = 0; kb < 5; ++kb)
#pragma unroll
    for (int rg = 0; rg < 16; ++rg) { p[kb][rg] = __builtin_amdgcn_exp2f(p[kb][rg] - m); Z += p[kb][rg]; }
  { auto rr = __builtin_amdgcn_permlane32_swap(__float_as_uint(Z), __float_as_uint(Z), false, false); Z = __uint_as_float(rr[0]) + __uint_as_float(rr[1]); }
  bf16x8 pa[5][2];
#pragma unroll
  for (int kb = 0; kb < 5; ++kb) { ATT_PK4(p[kb], 0, pa[kb][0]); ATT_PK4(p[kb], 8, pa[kb][1]); }
  f32x16 o[4] = {};
  const int vb = (int)(unsigned)(uintptr_t)vlds + v_rd_base(lane);
#pragma unroll
  for (int kb = 0; kb < 5; ++kb) {
    if (kb + 1 < 5) DIL_LDV(kb + 1, (kb + 1) & 1);
#pragma unroll
    for (int i = 0; i < 8; ++i) { const int id = lane + 64 * i, row = id >> 4, c = (id & 15) * 8;
      *reinterpret_cast<ATT_LAS bf16x8*>(vlds + v_st(row, c)) = vv[kb & 1][i]; }
    asm volatile("s_waitcnt lgkmcnt(0)" ::: "memory"); SBAR();
    pv32_one<0>(o[0], vb, pa[kb][0], pa[kb][1]); pv32_one<1>(o[1], vb, pa[kb][0], pa[kb][1]); pv32_one<2>(o[2], vb, pa[kb][0], pa[kb][1]); pv32_one<3>(o[3], vb, pa[kb][0], pa[kb][1]);
    SBAR();
  }
#undef DIL_LDV
#pragma unroll
  for (int rg = 0; rg < 16; ++rg) { const long row = r + d * (t0 + crow(rg, hi));
#pragma unroll
    for (int d0 = 0; d0 < 4; ++d0) O[row * 768 + oc + d0 * 32 + r32] = o[d0][rg]; }
  if (hi == 0) { const long row = r + d * (t0 + r32); typedef float f32x2_ __attribute__((ext_vector_type(2))); *(ATT_GAS f32x2_*)(ST + row * 12) = (f32x2_){m, Z}; }
}
template <int LDP>
__device__ __forceinline__ void dil_wg_unit(const bf16* __restrict__ P, int qc, int kc, int vc, int d, int r, int T0, int nT,
                                            float* __restrict__ O, int oc, float* __restrict__ ST, ATT_LAS char* lds, const ATT_LAS float* bias2, const float C) {
  int tid_ = threadIdx.x; asm volatile("" : "+v"(tid_));
  const int tid = tid_, wid = __builtin_amdgcn_readfirstlane(tid >> 6), lane = tid & 63, r32 = lane & 31, hi = lane >> 5, t0 = T0 + 32 * wid;
  { bf16x8 kk[12];
#pragma unroll
    for (int i = 0; i < 12; ++i) { const int id = tid + 512 * i, row = id >> 4, c = (id & 15) * 8; int kt = T0 - 64 + row; kt = kt < 0 ? 0 : (kt > nT - 1 ? nT - 1 : kt);
      kk[i] = *(const ATT_GAS bf16x8*)(P + (long)(r + d * kt) * LDP + kc + c); }
#pragma unroll
    for (int i = 0; i < 12; ++i) { const int id = tid + 512 * i, row = id >> 4, cB = (id & 15) * 16;
      *reinterpret_cast<ATT_LAS bf16x8*>(lds + kswz<256>(row, cB)) = kk[i]; } }
  bf16x8 qr[8];
  { const bf16* qp = P + (long)(r + d * (t0 + r32)) * LDP + qc + hi * 8;
#pragma unroll
    for (int d0 = 0; d0 < 8; ++d0) qr[d0] = *(const ATT_GAS bf16x8*)(qp + d0 * 16); }
  __syncthreads();
  bf16x8 vv[12];
#pragma unroll
  for (int i = 0; i < 12; ++i) { const int id = tid + 512 * i, row = id >> 4, c = (id & 15) * 8; int kt = T0 - 64 + row; kt = kt < 0 ? 0 : (kt > nT - 1 ? nT - 1 : kt);
    vv[i] = *(const ATT_GAS bf16x8*)(P + (long)(r + d * kt) * LDP + vc + c); }
  f32x16 p[5];
#pragma unroll
  for (int kb = 0; kb < 5; ++kb) { const int krow = 32 * wid + 32 * kb + r32;
    p[kb] = f32x16{};
#pragma unroll
    for (int d0 = 0; d0 < 8; ++d0) { const bf16x8 kf = *reinterpret_cast<const ATT_LAS bf16x8*>(lds + kswz<256>(krow, (d0 * 16 + hi * 8) * 2));
      p[kb] = __builtin_amdgcn_mfma_f32_32x32x16_bf16(kf, qr[d0], p[kb], 0, 0, 0); } }
  float m = -1e30f;
  { const int a_ = 4 * hi - r32 + 32, k_ = a_ & 3; const ATT_LAS f32x4* tp = (const ATT_LAS f32x4*)(bias2 + k_ * 196 + (a_ - k_));
    const bool interior = (t0 >= 64) && (t0 + 96 <= nT);
#pragma unroll
    for (int kb = 0; kb < 5; ++kb)
#pragma unroll
      for (int g = 0; g < 4; ++g) { const f32x4 bv = tp[kb * 8 + 2 * g];
#pragma unroll
        for (int e = 0; e < 4; ++e) { const int rg = 4 * g + e; float s = fmaf(p[kb][rg], C, bv[e]);
          if (!interior) { const int kt = t0 - 64 + kb * 32 + crow(rg, hi); s = (kt >= 0 && kt < nT) ? s : -1e30f; }
          p[kb][rg] = s; m = fmaxf(m, s); } } }
  { auto rr = __builtin_amdgcn_permlane32_swap(__float_as_uint(m), __float_as_uint(m), false, false); m = fmaxf(__uint_as_float(rr[0]), __uint_as_float(rr[1])); }
  float Z = 0.f;
#pragma unroll
  for (int kb = 0; kb < 5; ++kb)
#pragma unroll
    for (int rg = 0; rg < 16; ++rg) { p[kb][rg] = __builtin_amdgcn_exp2f(p[kb][rg] - m); Z += p[kb][rg]; }
  { auto rr = __builtin_amdgcn_permlane32_swap(__float_as_uint(Z), __float_as_uint(Z), false, false); Z = __uint_as_float(rr[0]) + __uint_as_float(rr[1]); }
  bf16x8 pa[5][2];
#pragma unroll
  for (int kb = 0; kb < 5; ++kb) { ATT_PK4(p[kb], 0, pa[kb][0]); ATT_PK4(p[kb], 8, pa[kb][1]); }
  __syncthreads();
#pragma unroll
  for (int i = 0; i < 12; ++i) { const int id = tid + 512 * i, row = id >> 4, c = (id & 15) * 8;
    *reinterpret_cast<ATT_LAS bf16x8*>(lds + (row >> 5) * 8192 + v_st(row & 31, c)) = vv[i]; }
  __syncthreads();
  f32x16 o[4] = {};
#pragma unroll
  for (int kb = 0; kb < 5; ++kb) { const int vb = (int)(unsigned)(uintptr_t)lds + (wid + kb) * 8192 + v_rd_base(lane);
    pv32_one<0>(o[0], vb, pa[kb][0], pa[kb][1]); pv32_one<1>(o[1], vb, pa[kb][0], pa[kb][1]); pv32_one<2>(o[2], vb, pa[kb][0], pa[kb][1]); pv32_one<3>(o[3], vb, pa[kb][0], pa[kb][1]); }
#pragma unroll
  for (int rg = 0; rg < 16; ++rg) { const long row = r + d * (t0 + crow(rg, hi));
#pragma unroll
    for (int d0 = 0; d0 < 4; ++d0) O[row * 768 + oc + d0 * 32 + r32] = o[d0][rg]; }
  if (hi == 0) { const long row = r + d * (t0 + r32); typedef float f32x2_ __attribute__((ext_vector_type(2))); *(ATT_GAS f32x2_*)(ST + row * 12) = (f32x2_){m, Z}; }
  __syncthreads();
}

#if defined(MLA_DMA) && MLA_DMA
#define MLA_BODY attn_dma_body
#else
template <int LDQ, int LDK, int LDO> __device__ __forceinline__ void attn_simple192(const bf16* Qb, const bf16* Kh, const bf16* Kr, const bf16* Vh, const float* cs, float* Ob, int seq, const float scale, ATT_LAS char* lds) { attn_simple_body<192, LDQ, LDK, LDO>(Qb, Kh, Kr, Vh, cs, Ob, seq, scale, lds); }
#define MLA_BODY attn_simple192
#endif
}
constexpr int S = 8192, D = 2048, NMEM = 256;
constexpr int DIN = 3392, DINP = 3584;
constexpr int PC_DIL = 768, PC_MEM = 3072;
constexpr int QR = 384, KVR = 128, AQ = 512;
constexpr int NUP = 2816;
constexpr int UC_KV = 1280;
constexpr int DFF = 5632, DFE = 7168, NE = 8;
constexpr int MP = 18432;
constexpr float EPS = 1e-6f;
constexpr int NWAVES = 8;

constexpr size_t al256(size_t x) { return (x + 255) / 256 * 256; }
constexpr size_t WS_CTL = 0, CTL_ZERO_BYTES = 1u << 20;
constexpr size_t WS_WIN = WS_CTL + CTL_ZERO_BYTES;
constexpr size_t WS_WUP = WS_WIN + al256((size_t)2 * DINP * D * 2);
constexpr size_t WS_WMEM = WS_WUP + al256((size_t)2 * NUP * AQ * 2);
constexpr size_t WS_WOUT = WS_WMEM + al256((size_t)2 * 1024 * D * 2);
constexpr size_t WS_WGU = WS_WOUT + al256((size_t)2 * D * D * 2);
constexpr size_t WS_WDN = WS_WGU + al256((size_t)2 * DFF * D * 2);
constexpr size_t WS_MGU = WS_WDN + al256((size_t)D * DFF * 2);
constexpr size_t WS_MDN = WS_MGU + al256((size_t)NE * 2 * DFE * D * 2);
constexpr size_t WS_XN = WS_MDN + al256((size_t)NE * D * DFE * 2);
constexpr size_t WS_MEMN = WS_XN + al256((size_t)S * D * 2);
constexpr size_t WS_MEMKV = WS_MEMN + al256((size_t)2 * NMEM * D * 2);
constexpr size_t WS_PROJ = WS_MEMKV + al256((size_t)2 * NMEM * 1024 * 2);
constexpr size_t WS_AQKV = WS_PROJ + al256((size_t)S * DINP * 2);
constexpr size_t WS_KROPE = WS_AQKV + al256((size_t)S * AQ * 2);
constexpr size_t WS_ROPECS = WS_KROPE + al256((size_t)S * 64 * 2);
constexpr size_t WS_QKVM = WS_ROPECS + al256((size_t)S * 64 * 4);
constexpr size_t WS_YPRE = WS_QKVM + al256((size_t)S * NUP * 2);
constexpr size_t WS_DILO = WS_YPRE + al256((size_t)S * D * 4);
constexpr size_t WS_DILS = WS_DILO + al256((size_t)3 * S * 768 * 4);
constexpr size_t WS_Y = WS_DILS + al256((size_t)3 * S * 12 * 4);
constexpr size_t WS_XA = WS_Y + al256((size_t)S * D * 2);
constexpr size_t WS_ROUTE = WS_XA + al256((size_t)S * D * 4);
constexpr size_t WS_XP = WS_ROUTE + al256((size_t)S * 32);
constexpr size_t WS_OUTP = WS_XP + al256((size_t)MP * D * 2);
constexpr size_t WS_ACTP = WS_OUTP + al256((size_t)MP * D * 2);
constexpr size_t WS_END = WS_ACTP + al256((size_t)MP * DFE * 2);
static_assert(WS_END <= 1879048192ull, "workspace map exceeds 4 x the largest input");
constexpr int CW_BAR = 16384;
constexpr int CW_QUEUE = 8192;
constexpr int CW_CNT = 8192 + 256;
constexpr int CW_QUEUE2 = 65536;
constexpr int CW_CVT = 8192 + 320;
constexpr int CW_DONE = 8192 + 384;
constexpr int CW_TILEE = 8192 + 512;
constexpr int RING_BYTES = 131072;
constexpr int LDSCTL_OFF = RING_BYTES, MISC_OFF = LDSCTL_OFF + 320;
constexpr int BIAS_OFF = 132096;
constexpr int LDS_BYTES = 147456;
static_assert(BIAS_OFF >= MISC_OFF + 128 && BIAS_OFF + 3 * 6 * 132 * 4 + 4 * 196 * 4 <= LDS_BYTES, "LDS map");

#define GAS __attribute__((address_space(1)))
#define LAS __attribute__((address_space(3)))
typedef unsigned short bf16;
typedef unsigned v4u __attribute__((ext_vector_type(4)));
typedef unsigned v2u __attribute__((ext_vector_type(2)));
typedef float f32x4 __attribute__((ext_vector_type(4)));
typedef short bf16x8 __attribute__((ext_vector_type(8)));
typedef GAS unsigned gu32;
#define RLX_AGENT __ATOMIC_RELAXED, __HIP_MEMORY_SCOPE_AGENT
#define LDS_WAIT() asm volatile("s_waitcnt lgkmcnt(0)" ::: "memory")
#define VM_WAIT() asm volatile("s_waitcnt vmcnt(0)" ::: "memory")
__device__ __forceinline__ unsigned f2bf(float f) { unsigned u = __builtin_bit_cast(unsigned, f); return (u + 0x7fffu + ((u >> 16) & 1u)) >> 16; }
__device__ __forceinline__ unsigned pk2(float lo, float hi) { return f2bf(lo) | (f2bf(hi) << 16); }
__device__ __forceinline__ float bflo(unsigned w) { return __uint_as_float(w << 16); }
__device__ __forceinline__ float bfhi(unsigned w) { return __uint_as_float(w & 0xffff0000u); }

#define XB_TMO      128
#define XB_XCNT(j)  (256  + 64 * (j))
#define XB_XSUB(j)  (1280 + 64 * (j))
#define XB_XGEN(j)  (2304 + 64 * (j))
#define XB_TOP      3328
#define XB_TOPGEN   3392
#define XCD_BAR_WORDS 3456
#define XB_SPIN_CAP (1u << 18)
__device__ __forceinline__ unsigned xb_ld(unsigned* p)              { return __hip_atomic_load(p, __ATOMIC_RELAXED, __HIP_MEMORY_SCOPE_AGENT); }
__device__ __forceinline__ unsigned xb_add(unsigned* p, unsigned v) { return __hip_atomic_fetch_add(p, v, __ATOMIC_RELAXED, __HIP_MEMORY_SCOPE_AGENT); }
__device__ __forceinline__ unsigned xb_xcc_id() { return (unsigned)__builtin_amdgcn_s_getreg((3 << 11) | 20) & 0xFu; }
#define XB_SPIN(cond, bar) do { unsigned _sp = 0; while (cond) { __builtin_amdgcn_s_sleep(1); \
    if ((++_sp & 255u) == 0u) { if (xb_ld(&(bar)[XB_TMO])) break; if (_sp > XB_SPIN_CAP) { atomicAdd(&(bar)[XB_TMO], 1u); break; } } } } while (0)
struct XcdBarrier { unsigned* bar; unsigned x; volatile LAS unsigned* st; };
__device__ __forceinline__ XcdBarrier xcd_barrier_post(unsigned* bar, volatile LAS unsigned* st) {
    XcdBarrier b; b.bar = bar; b.x = xb_xcc_id(); b.st = st;
    if (threadIdx.x == 0) (void)xb_add(&bar[XB_XCNT(b.x)], 1u);
    return b;
}
__device__ __forceinline__ void xcd_barrier_complete(unsigned* bar, unsigned x, unsigned& nloc, unsigned& nx) {
    const unsigned G = gridDim.x * gridDim.y * gridDim.z;
    unsigned sum, cnt, mine, sp = 0u;
    for (;;) {
        sum = 0u; cnt = 0u; mine = 0u;
#pragma unroll
        for (unsigned j = 0; j < 16; ++j) { const unsigned c = xb_ld(&bar[XB_XCNT(j)]); sum += c; cnt += (c > 0u) ? 1u : 0u; mine = (j == x) ? c : mine; }
        if (sum == G) break;
        __builtin_amdgcn_s_sleep(1);
        if ((++sp & 255u) == 0u) { if (xb_ld(&bar[XB_TMO])) break; if (sp > XB_SPIN_CAP) { atomicAdd(&bar[XB_TMO], 1u); break; } }
    }
    nloc = mine > 0u ? mine : 1u; nx = cnt > 0u ? cnt : 1u;
}
__device__ __forceinline__ void xcd_barrier(const XcdBarrier& b) {
    asm volatile("s_waitcnt vmcnt(0)" ::: "memory");
    __syncthreads();
    if (threadIdx.x == 0) {
        unsigned* bar = b.bar;
        __builtin_amdgcn_s_waitcnt(0);
        unsigned nloc = b.st[0], nx = b.st[1];
        if (nloc == 0u) { xcd_barrier_complete(bar, b.x, nloc, nx); b.st[0] = nloc; b.st[1] = nx; }
        const unsigned old = xb_add(&bar[XB_XSUB(b.x)], 1u);
        const unsigned gen = old / nloc;
        if (old + 1u == (gen + 1u) * nloc) {
            __builtin_amdgcn_fence(__ATOMIC_RELEASE, "agent");
            asm volatile("s_waitcnt vmcnt(0)" ::: "memory");
            const unsigned og = xb_add(&bar[XB_TOP], 1u);
            const unsigned tg = og / nx;
            if (og + 1u == (tg + 1u) * nx) xb_add(&bar[XB_TOPGEN], 1u);
            else XB_SPIN(xb_ld(&bar[XB_TOPGEN]) == tg, bar);
            __builtin_amdgcn_fence(__ATOMIC_ACQUIRE, "agent");
            xb_add(&bar[XB_XGEN(b.x)], 1u);
            asm volatile("s_waitcnt vmcnt(0)" ::: "memory");
        } else {
            XB_SPIN(xb_ld(&bar[XB_XGEN(b.x)]) == gen, bar);
            __builtin_amdgcn_fence(__ATOMIC_ACQUIRE, "agent");
            asm volatile("s_waitcnt vmcnt(0)" ::: "memory");
        }
    }
    __syncthreads();
}

struct Args {
    const float* in[23]; float* out; unsigned char* ws;
    float invf[32];
    int ph_lo, ph_hi, li, rep;
};
struct Frame {
    LAS unsigned char* lds;
    volatile LAS unsigned* MISC;
    gu32* ctl;
    int tid, lane, wave, G, gw, NGW;
    unsigned char* ws;
};
__device__ __forceinline__ float wave_sum(float v) {
#pragma unroll
    for (int o = 1; o < 64; o <<= 1) v += __shfl_xor(v, o);
    return v;
}
__device__ __forceinline__ float wave_max(float v) {
#pragma unroll
    for (int o = 1; o < 64; o <<= 1) v = fmaxf(v, __shfl_xor(v, o));
    return v;
}

__device__ __forceinline__ unsigned pk4_fp8(float a, float b, float c, float d) { int w = 0; w = __builtin_amdgcn_cvt_pk_fp8_f32(a, b, w, false); w = __builtin_amdgcn_cvt_pk_fp8_f32(c, d, w, true); return (unsigned)w; }
__device__ __forceinline__ void cvt_load(const float* __restrict__ W, int N, int k0, int n0, int lane, f32x4 (&v)[8]) {
    const int lr = lane >> 3, lc = (lane & 7) * 4;
#pragma unroll
    for (int i = 0; i < 8; ++i) v[i] = __builtin_nontemporal_load((const GAS f32x4*)(W + (size_t)(k0 + i * 8 + lr) * N + n0 + lc));
}
template <bool FP8>
__device__ __forceinline__ void cvt_finish(const f32x4 (&v)[8], int k0, void* __restrict__ dstv, int ldd, int drow0, int kdst0, LAS float* scr, int lane, float wsc) {
    const int lr = lane >> 3, lc = (lane & 7) * 4;
#pragma unroll
    for (int i = 0; i < 8; ++i) { LAS float* s = scr + (i * 8 + lr) * 33 + lc; s[0] = v[i][0]; s[1] = v[i][1]; s[2] = v[i][2]; s[3] = v[i][3]; }
    LDS_WAIT(); asm volatile("" ::: "memory");
    const int c = lane & 7;
#pragma unroll
    for (int j = 0; j < 4; ++j) { const int n = (lane >> 3) + 8 * j; const LAS float* s = scr + (8 * c) * 33 + n;
        if constexpr (FP8) { v2u o; o.x = pk4_fp8(s[0 * 33] * wsc, s[1 * 33] * wsc, s[2 * 33] * wsc, s[3 * 33] * wsc); o.y = pk4_fp8(s[4 * 33] * wsc, s[5 * 33] * wsc, s[6 * 33] * wsc, s[7 * 33] * wsc);
            __builtin_nontemporal_store(o, (GAS v2u*)((unsigned char*)dstv + (size_t)(drow0 + n) * ldd + kdst0 + k0 + 8 * c)); }
        else { v4u o; o.x = pk2(s[0 * 33], s[1 * 33]); o.y = pk2(s[2 * 33], s[3 * 33]); o.z = pk2(s[4 * 33], s[5 * 33]); o.w = pk2(s[6 * 33], s[7 * 33]);
            __builtin_nontemporal_store(o, (GAS v4u*)((bf16*)dstv + (size_t)(drow0 + n) * ldd + kdst0 + k0 + 8 * c)); } }
    LDS_WAIT(); asm volatile("" ::: "memory");
}
__device__ __forceinline__ int cvt_drow(int mode, int n0, int roff) { return mode == 0 ? n0 + roff : (mode == 1 ? (n0 >> 7) * 256 + (n0 & 127) : (mode == 2 ? (n0 >> 7) * 256 + 128 + (n0 & 127) : (n0 < 576 ? n0 : n0 + 192))); }
template <bool FP8>
__device__ __forceinline__ void cvt_job(Frame& F, const float* W, int K, int N, void* dst, int ldd, int kdst0, int mode, int roff, LAS float* scr, float wsc) {
    const int nnb = N / 32, nitems = (K / 64) * nnb;
    int it = F.gw; if (it >= nitems) return;
    f32x4 va[8], vb[8];
    cvt_load(W, N, (it / nnb) * 64, (it % nnb) * 32, F.lane, va);
    for (;;) {
        const int it1 = it + F.NGW; if (it1 < nitems) cvt_load(W, N, (it1 / nnb) * 64, (it1 % nnb) * 32, F.lane, vb);
        cvt_finish<FP8>(va, (it / nnb) * 64, dst, ldd, cvt_drow(mode, (it % nnb) * 32, roff), kdst0, scr, F.lane, wsc);
        if (it1 >= nitems) break;
        const int it2 = it1 + F.NGW; if (it2 < nitems) cvt_load(W, N, (it2 / nnb) * 64, (it2 % nnb) * 32, F.lane, va);
        cvt_finish<FP8>(vb, (it1 / nnb) * 64, dst, ldd, cvt_drow(mode, (it1 % nnb) * 32, roff), kdst0, scr, F.lane, wsc);
        if (it2 >= nitems) break;
        it = it2;
    }
}
__device__ __forceinline__ void rms_row_to_bf16(const float* xrow, const float* g, bf16* orow, int lane) {
    const GAS f32x4* xr = (const GAS f32x4*)xrow + lane; const GAS f32x4* gr = (const GAS f32x4*)g + lane;
    f32x4 v[8]; float s = 0.f;
#pragma unroll
    for (int j = 0; j < 8; ++j) { v[j] = xr[64 * j]; s += (v[j].x * v[j].x + v[j].y * v[j].y) + (v[j].z * v[j].z + v[j].w * v[j].w); }
    const float rstd = 1.f / sqrtf(wave_sum(s) * (1.f / D) + EPS);
    GAS v2u* o8 = (GAS v2u*)orow + lane;
#pragma unroll
    for (int j = 0; j < 8; ++j) { const f32x4 gg = gr[64 * j]; v2u w; w.x = pk2(v[j].x * rstd * gg.x, v[j].y * rstd * gg.y); w.y = pk2(v[j].z * rstd * gg.z, v[j].w * rstd * gg.w); o8[64 * j] = w; }
}
__device__ __forceinline__ void rms_row_to_fp8(const float* xrow, const float* g, unsigned char* orow, int lane) {
    const GAS f32x4* xr = (const GAS f32x4*)xrow + lane; const GAS f32x4* gr = (const GAS f32x4*)g + lane;
    f32x4 v[8]; float s = 0.f;
#pragma unroll
    for (int j = 0; j < 8; ++j) { v[j] = xr[64 * j]; s += (v[j].x * v[j].x + v[j].y * v[j].y) + (v[j].z * v[j].z + v[j].w * v[j].w); }
    const float rstd = 1.f / sqrtf(wave_sum(s) * (1.f / D) + EPS);
    GAS unsigned* o4 = (GAS unsigned*)orow + lane;
#pragma unroll
    for (int j = 0; j < 8; ++j) { const f32x4 gg = gr[64 * j]; o4[64 * j] = pk4_fp8(v[j].x * rstd * gg.x, v[j].y * rstd * gg.y, v[j].z * rstd * gg.z, v[j].w * rstd * gg.w); }
}
__device__ __forceinline__ void sincos_f64(float ang, float& c, float& s) {
    const double a = (double)ang, twopi = 6.283185307179586476925286766559, inv2pi = 0.15915494309189533576888376337251;
    const double q = __builtin_rint(a * inv2pi); const double r = a - q * twopi;
    const double r2 = r * r; double ss = 1.0, cc = 1.0;
#pragma unroll
    for (int k = 14; k >= 1; --k) { ss = 1.0 - r2 * (1.0 / (double)((2 * k) * (2 * k + 1))) * ss; cc = 1.0 - r2 * (1.0 / (double)((2 * k - 1) * (2 * k))) * cc; }
    s = (float)(r * ss); c = (float)cc;
}
__device__ const unsigned char DIL_BUCKET[3][129] = {
 {11,11,11,11,11,11,11,11,11,11,11,11,11,11,11,10,10,10,10,10,10,10,10,10,10,10,10,10,10,10,10,10,10,10,10,10,10,10,9,9,9,9,9,9,9,9,9,9,9,9,8,8,8,8,8,8,8,7,6,5,4,3,2,1,0,17,18,19,20,21,22,23,24,24,24,24,24,24,24,25,25,25,25,25,25,25,25,25,25,25,25,26,26,26,26,26,26,26,26,26,26,26,26,26,26,26,26,26,26,26,26,26,26,26,27,27,27,27,27,27,27,27,27,27,27,27,27,27,27},
 {13,13,13,13,13,13,13,13,13,13,13,13,13,13,13,13,13,13,13,13,13,13,13,12,12,12,12,12,12,12,12,12,12,12,12,12,12,12,12,12,12,12,11,11,11,11,11,11,11,11,11,11,10,10,10,10,10,10,9,9,9,8,8,4,0,20,24,24,25,25,25,26,26,26,26,26,26,27,27,27,27,27,27,27,27,27,27,28,28,28,28,28,28,28,28,28,28,28,28,28,28,28,28,28,28,28,29,29,29,29,29,29,29,29,29,29,29,29,29,29,29,29,29,29,29,29,29,29,29},
 {15,15,15,15,15,15,15,15,15,15,15,15,15,15,15,15,15,15,15,15,15,15,15,15,15,15,15,15,15,15,14,14,14,14,14,14,14,14,14,14,14,14,14,14,14,13,13,13,13,13,13,13,13,13,12,12,12,12,12,11,11,10,10,9,0,25,26,26,27,27,28,28,28,28,28,29,29,29,29,29,29,29,29,29,30,30,30,30,30,30,30,30,30,30,30,30,30,30,30,31,31,31,31,31,31,31,31,31,31,31,31,31,31,31,31,31,31,31,31,31,31,31,31,31,31,31,31,31,31}};

typedef float f32x2 __attribute__((ext_vector_type(2)));
#ifndef PH_MASK
#define PH_MASK 0xFFFFu
#endif
#ifndef REPEAT_PHASE
#define REPEAT_PHASE -1
#endif
#ifndef ATT_EN
#define ATT_EN 7
#endif
#define PEN(k) ((PH_MASK >> (k)) & 1u)
#ifndef FFN_FP8
#define FFN_FP8 3
#endif
constexpr bool F8D = (FFN_FP8 & 1) != 0, F8M = (FFN_FP8 & 2) != 0;
constexpr int EBD = F8D ? 1 : 2, EBM = F8M ? 1 : 2;
template <bool B> struct Sc { static constexpr float w_gu = B ? 32.f : 1.f, w_dn = B ? 64.f : 1.f, a_sc = B ? 4.f : 1.f, dn = 1.f / (w_dn * a_sc); };
template <bool B> using FfnEpi1 = typename std::conditional<B, pg8::EpiSwiGLU8, pg8::EpiSwiGLU>::type;
template <bool B> struct Epi1Maker;
template <> struct Epi1Maker<true> { static __device__ __forceinline__ pg8::EpiSwiGLU8 make(void* O, int ldc) { return pg8::EpiSwiGLU8{(unsigned char*)O, ldc, 1.f / Sc<true>::w_gu, Sc<true>::a_sc}; } };
template <> struct Epi1Maker<false> { static __device__ __forceinline__ pg8::EpiSwiGLU make(void* O, int ldc) { return pg8::EpiSwiGLU{(unsigned short*)O, ldc}; } };

constexpr int MOE_MAT_ITEMS = 7168, MOE_GU_ITEMS = 16 * MOE_MAT_ITEMS, MOE_NITEMS = 24 * MOE_MAT_ITEMS, MOE_CHUNK = 64, MOE_NCHUNK = MOE_NITEMS / MOE_CHUNK;
struct MoeItem { const float* W; void* dst; int N, k0, n0, ldd, drow0; float wsc; };
__device__ __forceinline__ MoeItem moe_item(const Args& args, unsigned char* ws, int idx) {
    MoeItem m;
    if (idx < MOE_GU_ITEMS) { const int mat = idx / MOE_MAT_ITEMS, local = idx % MOE_MAT_ITEMS, e = mat >> 1, up = mat & 1, kb = local / (DFE / 32), nb = local % (DFE / 32);
        m.W = args.in[19 + up] + (size_t)e * D * DFE; m.N = DFE; m.k0 = kb * 64; m.n0 = nb * 32; m.dst = ws + WS_MGU + (size_t)e * 2 * DFE * D * EBM; m.ldd = D;
        m.drow0 = (m.n0 >> 7) * 256 + up * 128 + (m.n0 & 127); m.wsc = Sc<F8M>::w_gu; }
    else { const int i2 = idx - MOE_GU_ITEMS, e = i2 / MOE_MAT_ITEMS, local = i2 % MOE_MAT_ITEMS, kb = local / (D / 32), nb = local % (D / 32);
        m.W = args.in[21] + (size_t)e * DFE * D; m.N = D; m.k0 = kb * 64; m.n0 = nb * 32; m.dst = ws + WS_MDN + (size_t)e * D * DFE * EBM; m.ldd = DFE; m.drow0 = m.n0; m.wsc = Sc<F8M>::w_dn; }
    return m;
}
__device__ __forceinline__ void moe_cvt_chunk(Frame& F, const Args& args, int c) {
    LAS float* scr = (LAS float*)(F.lds + F.wave * 16384);
    const int i0 = c * MOE_CHUNK + F.wave * 8;
    f32x4 va[8], vb[8], vc[8]; MoeItem ma, mb, mc;
#define MC_L(m, v, i) do { m = moe_item(args, F.ws, i0 + (i)); cvt_load(m.W, m.N, m.k0, m.n0, F.lane, v); } while (0)
#define MC_F(m, v) cvt_finish<F8M>(v, m.k0, m.dst, m.ldd, m.drow0, 0, scr, F.lane, m.wsc)
    MC_L(ma, va, 0); MC_L(mb, vb, 1); MC_L(mc, vc, 2);
    MC_F(ma, va); MC_L(ma, va, 3); MC_F(mb, vb); MC_L(mb, vb, 4); MC_F(mc, vc); MC_L(mc, vc, 5);
    MC_F(ma, va); MC_L(ma, va, 6); MC_F(mb, vb); MC_L(mb, vb, 7); MC_F(mc, vc); MC_F(ma, va); MC_F(mb, vb);
#undef MC_L
#undef MC_F
}
__device__ __forceinline__ void moe_cvt_fill(Frame& F, const Args& args, int ph) {
    for (;;) {
        if (F.tid == 0) { unsigned c = MOE_NCHUNK;
            if (ph < 0 || __hip_atomic_load(F.ctl + CW_DONE + ph, RLX_AGENT) < (unsigned)F.G) c = __hip_atomic_fetch_add(F.ctl + CW_CVT + (ph == -2 ? 16 : 0), 1u, RLX_AGENT);
            F.MISC[17] = c; }
        __syncthreads(); const unsigned c = F.MISC[17]; __syncthreads();
        if (c >= (unsigned)MOE_NCHUNK) break;
        moe_cvt_chunk(F, args, (int)c);
    }
}
#define FILL(ph) do { __syncthreads(); if (F.tid == 0) (void)__hip_atomic_fetch_add(F.ctl + CW_DONE + (ph), 1u, RLX_AGENT); moe_cvt_fill(F, args, (ph)); } while (0)
#ifndef MLA_DMA
#define MLA_DMA 1
#endif
#ifndef GEMM_SP2
#define GEMM_SP2 1
#endif
constexpr bool SP2V = (GEMM_SP2 != 0);
#ifndef PROBE_ATT
#define PROBE_ATT 7
#endif
#ifndef FILLMASK
#define FILLMASK 7
#endif
constexpr int PH_PER_LAYER = 11, N_PHASES = 1 + 2 * PH_PER_LAYER;
#ifndef MK_N_LAUNCHES
#define MK_N_LAUNCHES 1
#endif
constexpr int N_LAUNCHES = MK_N_LAUNCHES;

__global__ void __launch_bounds__(NWAVES * 64, 2) mk_fwd(Args args) {
    extern __shared__ __attribute__((aligned(16))) unsigned char lds[];
    Frame F;
    F.lds = (LAS unsigned char*)lds;
    F.MISC = (volatile LAS unsigned*)(F.lds + MISC_OFF);
    F.tid = threadIdx.x; F.lane = F.tid & 63; F.wave = __builtin_amdgcn_readfirstlane(F.tid >> 6);
    F.G = gridDim.x; F.gw = blockIdx.x * NWAVES + F.wave; F.NGW = F.G * NWAVES;
    F.ws = args.ws; F.ctl = (gu32*)(args.ws + WS_CTL);
    unsigned char* ws = args.ws;
    for (int u = F.tid; u < (LDS_BYTES - LDSCTL_OFF) / 4; u += NWAVES * 64) ((LAS unsigned*)(F.lds + LDSCTL_OFF))[u] = 0u;
    __syncthreads();
    XcdBarrier bar; bar.bar = (unsigned*)(F.ctl + CW_BAR) + args.li * 4096; bar.x = 0; bar.st = nullptr;
    if (N_LAUNCHES != N_PHASES) bar = xcd_barrier_post((unsigned*)(F.ctl + CW_BAR) + args.li * 4096, F.MISC + 8);
#define GRID_BAR() do { if (N_LAUNCHES != N_PHASES) xcd_barrier(bar); } while (0)
    const int lo = args.ph_lo, hi = args.ph_hi;
#define IN(k) (lo <= (k) && (k) < hi)
#define BOTH(k) (IN(k) && IN((k) + 1))

#define x_in (args.in[0])
#define XN8 ((unsigned char*)(ws + WS_XN))
#define WIN ((bf16*)(ws + WS_WIN))
#define WUP ((bf16*)(ws + WS_WUP))
#define WMEM ((bf16*)(ws + WS_WMEM))
#define WOUT ((bf16*)(ws + WS_WOUT))
#define WGU ((bf16*)(ws + WS_WGU))
#define WDN ((bf16*)(ws + WS_WDN))
#define MGU ((bf16*)(ws + WS_MGU))
#define MDN ((bf16*)(ws + WS_MDN))
#define XN ((bf16*)(ws + WS_XN))
#define MEMN ((bf16*)(ws + WS_MEMN))
#define MEMKV ((bf16*)(ws + WS_MEMKV))
#define PROJ ((bf16*)(ws + WS_PROJ))
#define AQKV ((bf16*)(ws + WS_AQKV))
#define KROPE ((bf16*)(ws + WS_KROPE))
#define ROPECS ((float*)(ws + WS_ROPECS))
#define QKVM ((bf16*)(ws + WS_QKVM))
#define YPRE ((float*)(ws + WS_YPRE))
#define DILO ((float*)(ws + WS_DILO))
#define DILS ((float*)(ws + WS_DILS))
#define Y ((bf16*)(ws + WS_Y))
#define XA ((float*)(ws + WS_XA))
#define ROUTE ((unsigned*)(ws + WS_ROUTE))
#define XP ((bf16*)(ws + WS_XP))
#define OUTP ((bf16*)(ws + WS_OUTP))
#define ACTP ((bf16*)(ws + WS_ACTP))
#define ACT ((bf16*)(ws + WS_ACTP))
#define PHASE_BEGIN() do { int t_ = threadIdx.x; asm volatile("" : "+v"(t_)); F.tid = t_; F.lane = t_ & 63; } while (0)

    if (PEN(0) && IN(0)) { PHASE_BEGIN();
        LAS float* scr = (LAS float*)(F.lds + F.wave * 16384);
        for (int rep = 0; rep < (REPEAT_PHASE == 0 ? 2 : 1); ++rep) {
        for (int l = 0; l < 2; ++l) {
            cvt_job<false>(F, args.in[5] + (size_t)l * D * DIN, D, DIN, WIN + (size_t)l * DINP * D, D, 0, 3, 0, scr, 1.f);
            cvt_job<false>(F, args.in[7] + (size_t)l * QR * 1152, QR, 1152, WUP + (size_t)l * NUP * AQ, AQ, 0, 0, 0, scr, 1.f);
            cvt_job<false>(F, args.in[9] + (size_t)l * KVR * 1536, KVR, 1536, WUP + (size_t)l * NUP * AQ, AQ, QR, 0, UC_KV, scr, 1.f);
            cvt_job<false>(F, args.in[11] + (size_t)l * D * 1024, D, 1024, WMEM + (size_t)l * 1024 * D, D, 0, 0, 0, scr, 1.f);
            cvt_job<false>(F, args.in[13] + (size_t)l * D * D, D, D, WOUT + (size_t)l * D * D, D, 0, 0, 0, scr, 1.f);
        }
        cvt_job<F8D>(F, args.in[15], D, DFF, WGU, D, 0, 1, 0, scr, Sc<F8D>::w_gu);
        cvt_job<F8D>(F, args.in[16], D, DFF, WGU, D, 0, 2, 0, scr, Sc<F8D>::w_gu);
        cvt_job<F8D>(F, args.in[17], DFF, D, WDN, DFF, 0, 0, 0, scr, Sc<F8D>::w_dn);
        }
        { const int* pos = (const int*)args.in[2];
          for (int idx = blockIdx.x * (NWAVES * 64) + F.tid; idx < S * 32; idx += F.G * NWAVES * 64) { const int row = idx >> 5, i = idx & 31;
              const float ang = (float)pos[row] * args.invf[i]; float c, s; sincos_f64(ang, c, s); ROPECS[row * 64 + i] = c; ROPECS[row * 64 + 32 + i] = s; } }
        for (int m = F.gw; m < 2 * NMEM; m += F.NGW) { const int l = m >> 8, r = m & 255; rms_row_to_bf16(args.in[1] + (size_t)r * D, args.in[10] + (size_t)l * D, MEMN + (size_t)m * D, F.lane); }
        for (int m = F.gw; m < S; m += F.NGW) rms_row_to_bf16(x_in + (size_t)m * D, args.in[4], XN + (size_t)m * D, F.lane);
        if (BOTH(0)) GRID_BAR();
    }

    for (int l = 0; l < 2; ++l) {
        const int pb = 1 + l * PH_PER_LAYER;
        if (PEN(1) && IN(pb + 0)) { PHASE_BEGIN();
            { pg8::Gemm g{XN, WIN + (size_t)l * DINP * D, 2 * D, 2 * D, D / 64}; pg8::InProjOrder So; So.so.init(S, DINP, F.G, (int)blockIdx.x); So.nextra = (l == 0) ? 8 : 0; So.A2 = MEMN; So.B2 = WMEM;
              pg8::EpiBf16Sel E{PROJ, DINP, MEMKV, 1024};
              pg8::gemm_phase<pg8::EpiBf16Sel, pg8::InProjOrder, true, SP2V>(F.lds, g, So, E); }
            if (FILLMASK & 1) FILL(pb + 0);
            if (BOTH(pb + 0)) GRID_BAR();
        }
        if (PEN(2) && IN(pb + 1)) { PHASE_BEGIN();
            const float* gq = args.in[6] + l * QR; const float* gkv = args.in[8] + l * KVR;
            for (int m = F.gw; m < S; m += F.NGW) {
                const v4u w = *(const GAS v4u*)(PROJ + (size_t)m * DINP + F.lane * 8);
                float v[8] = {bflo(w.x), bfhi(w.x), bflo(w.y), bfhi(w.y), bflo(w.z), bfhi(w.z), bflo(w.w), bfhi(w.w)};
                float sq = 0.f;
#pragma unroll
                for (int j = 0; j < 8; ++j) sq += v[j] * v[j];
                const float sq_q = wave_sum(F.lane < 48 ? sq : 0.f), sq_kv = wave_sum(F.lane >= 48 ? sq : 0.f);
                const float rstd = F.lane < 48 ? 1.f / sqrtf(sq_q * (1.f / QR) + EPS) : 1.f / sqrtf(sq_kv * (1.f / KVR) + EPS);
                const float* gp = F.lane < 48 ? gq + F.lane * 8 : gkv + (F.lane - 48) * 8;
                const f32x4 g0 = *(const GAS f32x4*)gp, g1 = *(const GAS f32x4*)(gp + 4);
                v4u o; o.x = pk2(v[0] * rstd * g0.x, v[1] * rstd * g0.y); o.y = pk2(v[2] * rstd * g0.z, v[3] * rstd * g0.w);
                o.z = pk2(v[4] * rstd * g1.x, v[5] * rstd * g1.y); o.w = pk2(v[6] * rstd * g1.z, v[7] * rstd * g1.w);
                *(GAS v4u*)(AQKV + (size_t)m * AQ + F.lane * 8) = o;
                const int c = F.lane & 7;
                const v4u kw = *(const GAS v4u*)(PROJ + (size_t)m * DINP + 512 + c * 8);
                float kv[8] = {bflo(kw.x), bfhi(kw.x), bflo(kw.y), bfhi(kw.y), bflo(kw.z), bfhi(kw.z), bflo(kw.w), bfhi(kw.w)};
                float ko[8];
                const float* cs = ROPECS + (size_t)m * 64 + (c & 3) * 8;
#pragma unroll
                for (int j = 0; j < 8; ++j) { const float other = __shfl_xor(kv[j], 4); const float co = cs[j], si = cs[32 + j];
                    ko[j] = (c < 4) ? (kv[j] * co - other * si) : (other * si + kv[j] * co); }
                if (F.lane < 8) { v4u ow; ow.x = pk2(ko[0], ko[1]); ow.y = pk2(ko[2], ko[3]); ow.z = pk2(ko[4], ko[5]); ow.w = pk2(ko[6], ko[7]); *(GAS v4u*)(KROPE + (size_t)m * 64 + c * 8) = ow; }
            }
            if (BOTH(pb + 1)) GRID_BAR();
        }
        if (PEN(3) && IN(pb + 2)) { PHASE_BEGIN();
            pg8::Gemm g{AQKV, WUP + (size_t)l * NUP * AQ, 2 * AQ, 2 * AQ, AQ / 64}; pg8::StaticOrder So; So.init(S, NUP, F.G, (int)blockIdx.x);
            pg8::EpiBf16 E{QKVM, NUP, 1.f};
            pg8::gemm_phase<pg8::EpiBf16, pg8::StaticOrder, true, SP2V>(F.lds, g, So, E);
            if (FILLMASK & 2) FILL(pb + 2);
            if (BOTH(pb + 2)) GRID_BAR();
        }
        if (PEN(4) && IN(pb + 3)) { PHASE_BEGIN();
            LAS float* BIAS = (LAS float*)(F.lds + BIAS_OFF);
            for (int i = F.tid; i < 3 * 6 * 129; i += NWAVES * 64) { const int b = i / (6 * 129), rem = i % (6 * 129), h = rem / 129, j = rem % 129;
                BIAS[(b * 6 + h) * 132 + j] = args.in[3][DIL_BUCKET[b][j] * 6 + h] * att::LOG2E; }
            __syncthreads();
            for (int rep = 0; rep < (REPEAT_PHASE == 4 ? 2 : 1); ++rep) {
            gu32* qhead = F.ctl + CW_QUEUE + 64 * l + 32 * rep + 4 * args.li;
            constexpr int NU_MLA = 6 * 32, NU_MEM = 4 * 32, NU_DIL = 3 * 6 * 32, NU = NU_MLA + NU_MEM + NU_DIL;
#define QPULL(u) do { if (F.tid == 0) F.MISC[16] = __hip_atomic_fetch_add(qhead, 1u, RLX_AGENT); __syncthreads(); u = (int)F.MISC[16]; __syncthreads(); } while (0)
            int u; QPULL(u);
            if ((ATT_EN & 1) && (!args.rep || (PROBE_ATT & 1))) while (u < NU_MLA) {
                const int h = u >> 5, qb = u & 31;
                att::MLA_BODY<NUP, NUP, D>(QKVM + (size_t)qb * 256 * NUP + h * 192, QKVM + UC_KV + h * 256, KROPE, QKVM + UC_KV + h * 256 + 128,
                                                        ROPECS + (size_t)qb * 256 * 64, YPRE + (size_t)qb * 256 * D + h * 128, S, 0.07216878364870322f, (LAS char*)F.lds);
                QPULL(u);
            }
            if (args.rep && !(PROBE_ATT & 1)) { while (u < NU_MLA) QPULL(u); }
            if ((ATT_EN & 2) && (!args.rep || (PROBE_ATT & 2))) while (u < NU_MLA + NU_MEM) {
                const int v = u - NU_MLA, h = v >> 5, qb = v & 31;
                const bf16* kv = MEMKV + (size_t)l * NMEM * 1024;
                att::attn_dense_body<128, DINP, 1024, D, 1>(PROJ + (size_t)qb * 256 * DINP + PC_MEM + h * 128, kv + h * 128, nullptr, kv + 512 + h * 128,
                                                            nullptr, YPRE + (size_t)qb * 256 * D + 1536 + h * 128, NMEM, 0.08838834764831845f, (LAS char*)F.lds);
                QPULL(u);
            }
            if (args.rep && !(PROBE_ATT & 2)) { while (u < NU_MLA + NU_MEM) QPULL(u); }
            if ((ATT_EN & 4) && (!args.rep || (PROBE_ATT & 4))) while (u < NU) {
                const int w = (u - NU_MLA - NU_MEM) * 8;
                const int b = w / 1536, h = (w % 1536) >> 8, tile = w & 255;
                const int d = b == 0 ? 1 : (b == 1 ? 4 : 16), nT = S / d, tpr = nT / 32;
                const int r = tile / tpr, t0 = (tile % tpr) * 32;
                LAS float* TB = (LAS float*)(F.lds + BIAS_OFF + 3 * 6 * 132 * 4);
                for (int i = F.tid; i < 4 * 196; i += NWAVES * 64) { const int k = i / 196, j = (i % 196) + k - 32; TB[i] = (j >= 0 && j <= 128) ? BIAS[(b * 6 + h) * 132 + j] : -1e30f; }
                __syncthreads();
                att::dil_wg_unit<DINP>(PROJ, PC_DIL + h * 128, PC_DIL + 768 + h * 128, PC_DIL + 1536 + h * 128, d, r, t0, nT,
                                       DILO + (size_t)b * S * 768, h * 128, DILS + (size_t)b * S * 12 + h * 2, (LAS char*)F.lds, TB, 0.08838834764831845f * att::LOG2E);
                QPULL(u);
            }
#undef QPULL
            }
            if (FILLMASK & 4) FILL(pb + 3);
            if (BOTH(pb + 3)) GRID_BAR();
        }
        if (PEN(5) && IN(pb + 4)) { PHASE_BEGIN();
            const float* gn = args.in[12] + (size_t)l * D;
            for (int m = F.gw; m < S; m += F.NGW) {
                const float* yr = YPRE + (size_t)m * D;
                f32x4 a[3]; float sa = 0.f;
#pragma unroll
                for (int j = 0; j < 3; ++j) { a[j] = *(const GAS f32x4*)(yr + (F.lane + 64 * j) * 4); sa += (a[j].x * a[j].x + a[j].y * a[j].y) + (a[j].z * a[j].z + a[j].w * a[j].w); }
                f32x4 c[2]; float sc = 0.f;
#pragma unroll
                for (int j = 0; j < 2; ++j) { c[j] = *(const GAS f32x4*)(yr + 1536 + (F.lane + 64 * j) * 4); sc += (c[j].x * c[j].x + c[j].y * c[j].y) + (c[j].z * c[j].z + c[j].w * c[j].w); }
                f32x4 bq[3]; float sb = 0.f;
#pragma unroll
                for (int j = 0; j < 3; ++j) { const int col = (F.lane + 64 * j) * 4, h = col >> 7;
                    float mm[3], zz[3];
#pragma unroll
                    for (int b = 0; b < 3; ++b) { const f32x2 st = *(const GAS f32x2*)(DILS + ((size_t)b * S + m) * 12 + h * 2); mm[b] = st.x; zz[b] = st.y; }
                    const float M = fmaxf(mm[0], fmaxf(mm[1], mm[2]));
                    float wgt[3], den = 0.f;
#pragma unroll
                    for (int b = 0; b < 3; ++b) { wgt[b] = __builtin_amdgcn_exp2f(mm[b] - M); den += wgt[b] * zz[b]; }
                    const float inv = 1.f / den; f32x4 acc = {0.f, 0.f, 0.f, 0.f};
#pragma unroll
                    for (int b = 0; b < 3; ++b) { const f32x4 ob = *(const GAS f32x4*)(DILO + ((size_t)b * S + m) * 768 + col); acc += ob * (wgt[b] * inv); }
                    bq[j] = acc; sb += (acc.x * acc.x + acc.y * acc.y) + (acc.z * acc.z + acc.w * acc.w); }
                const float ra = 1.f / sqrtf(wave_sum(sa) * (1.f / 768.f) + EPS), rb = 1.f / sqrtf(wave_sum(sb) * (1.f / 768.f) + EPS), rc = 1.f / sqrtf(wave_sum(sc) * (1.f / 512.f) + EPS);
                bf16* yo = Y + (size_t)m * D;
#pragma unroll
                for (int j = 0; j < 3; ++j) { const int col = (F.lane + 64 * j) * 4; const f32x4 g = *(const GAS f32x4*)(gn + col);
                    v2u w; w.x = pk2(a[j].x * ra * g.x, a[j].y * ra * g.y); w.y = pk2(a[j].z * ra * g.z, a[j].w * ra * g.w); *(GAS v2u*)(yo + col) = w; }
#pragma unroll
                for (int j = 0; j < 3; ++j) { const int col = (F.lane + 64 * j) * 4; const f32x4 g = *(const GAS f32x4*)(gn + 768 + col);
                    v2u w; w.x = pk2(bq[j].x * rb * g.x, bq[j].y * rb * g.y); w.y = pk2(bq[j].z * rb * g.z, bq[j].w * rb * g.w); *(GAS v2u*)(yo + 768 + col) = w; }
#pragma unroll
                for (int j = 0; j < 2; ++j) { const int col = (F.lane + 64 * j) * 4; const f32x4 g = *(const GAS f32x4*)(gn + 1536 + col);
                    v2u w; w.x = pk2(c[j].x * rc * g.x, c[j].y * rc * g.y); w.y = pk2(c[j].z * rc * g.z, c[j].w * rc * g.w); *(GAS v2u*)(yo + 1536 + col) = w; }
            }
            if (BOTH(pb + 4)) GRID_BAR();
        }
        if (PEN(6) && IN(pb + 5)) { PHASE_BEGIN();
            pg8::Gemm g{Y, WOUT + (size_t)l * D * D, 2 * D, 2 * D, D / 64}; pg8::StaticOrder So; So.init(S, D, F.G, (int)blockIdx.x);
            pg8::EpiResF32 E{l == 0 ? x_in : XA, args.rep ? YPRE : XA, D, 1.f};
            pg8::gemm_phase<pg8::EpiResF32, pg8::StaticOrder, true, SP2V>(F.lds, g, So, E);
            if (BOTH(pb + 5)) GRID_BAR();
        }
        if (PEN(7) && IN(pb + 6)) { PHASE_BEGIN();
            const float* gf = args.in[14] + (size_t)l * D;
#if defined(PROBE_DEADLINE)
            if (l == 1 && blockIdx.x == 0 && F.tid == 0) F.ctl[CW_CVT + 16] = __hip_atomic_load(F.ctl + CW_CVT, RLX_AGENT);
#endif
            if (l == 0) { for (int m = F.gw; m < S; m += F.NGW) { if constexpr (F8D) rms_row_to_fp8(XA + (size_t)m * D, gf, XN8 + (size_t)m * D, F.lane); else rms_row_to_bf16(XA + (size_t)m * D, gf, XN + (size_t)m * D, F.lane); } }
            else {
                const float* Wr = args.in[18];
                for (int m = F.gw; m < S; m += F.NGW) {
                    const GAS f32x4* xr = (const GAS f32x4*)(XA + (size_t)m * D) + F.lane; const GAS f32x4* gr = (const GAS f32x4*)gf + F.lane;
                    f32x4 v[8]; float s = 0.f;
#pragma unroll
                    for (int j = 0; j < 8; ++j) { v[j] = xr[64 * j]; s += (v[j].x * v[j].x + v[j].y * v[j].y) + (v[j].z * v[j].z + v[j].w * v[j].w); }
                    const float rstd = 1.f / sqrtf(wave_sum(s) * (1.f / D) + EPS);
                    float lg[8] = {0.f, 0.f, 0.f, 0.f, 0.f, 0.f, 0.f, 0.f};
                    GAS v2u* o8 = (GAS v2u*)(XN + (size_t)m * D) + F.lane; GAS unsigned* o4 = (GAS unsigned*)(XN8 + (size_t)m * D) + F.lane;
#pragma unroll
                    for (int j = 0; j < 8; ++j) { const f32x4 gg = gr[64 * j]; const f32x4 hh = {v[j].x * rstd * gg.x, v[j].y * rstd * gg.y, v[j].z * rstd * gg.z, v[j].w * rstd * gg.w};
                        if constexpr (F8M) o4[64 * j] = pk4_fp8(hh.x, hh.y, hh.z, hh.w); else { v2u w; w.x = pk2(hh.x, hh.y); w.y = pk2(hh.z, hh.w); o8[64 * j] = w; }
                        const float* wr = Wr + (size_t)((F.lane + 64 * j) * 4) * NE;
#pragma unroll
                        for (int q = 0; q < 4; ++q) { const f32x4 w0 = *(const GAS f32x4*)(wr + q * NE), w1 = *(const GAS f32x4*)(wr + q * NE + 4); const float hv = hh[q];
                            lg[0] += hv * w0.x; lg[1] += hv * w0.y; lg[2] += hv * w0.z; lg[3] += hv * w0.w; lg[4] += hv * w1.x; lg[5] += hv * w1.y; lg[6] += hv * w1.z; lg[7] += hv * w1.w; } }
#pragma unroll
                    for (int e = 0; e < NE; ++e) lg[e] = wave_sum(lg[e]);
                    int e1 = 0; float v1 = lg[0];
#pragma unroll
                    for (int e = 1; e < NE; ++e) if (lg[e] > v1) { v1 = lg[e]; e1 = e; }
                    int e2 = -1; float v2 = -3.0e38f;
#pragma unroll
                    for (int e = 0; e < NE; ++e) if (e != e1 && lg[e] > v2) { v2 = lg[e]; e2 = e; }
                    const float g1 = 1.f / (1.f + __expf(v2 - v1)), g2 = 1.f - g1;
                    if (F.lane == 0) { const unsigned s1 = __hip_atomic_fetch_add(F.ctl + CW_CNT + e1, 1u, RLX_AGENT), s2 = __hip_atomic_fetch_add(F.ctl + CW_CNT + e2, 1u, RLX_AGENT);
                        v4u r0 = {(unsigned)e1, (unsigned)e2, s1, s2}; v4u r1 = {__float_as_uint(g1), __float_as_uint(g2), 0u, 0u};
                        *(GAS v4u*)(ROUTE + (size_t)m * 8) = r0; *(GAS v4u*)(ROUTE + (size_t)m * 8 + 4) = r1; }
                }
            }
            if (BOTH(pb + 6)) GRID_BAR();
        }
        if (PEN(8) && IN(pb + 7)) { PHASE_BEGIN();
            if (l == 1) {
                moe_cvt_fill(F, args, -1);
#if defined(PROBE_DEADLINE)
                for (int r_ = 0; r_ < PROBE_DEADLINE; ++r_) { __syncthreads(); moe_cvt_fill(F, args, -2); }
#endif
                int base[NE]; int tstart = 0;
#pragma unroll
                for (int e = 0; e < NE; ++e) { const int c = (int)__hip_atomic_load(F.ctl + CW_CNT + e, RLX_AGENT); base[e] = tstart * 256; const int nt = (c + 255) >> 8;
                    if (blockIdx.x == 0 && F.tid == 0) { for (int t = 0; t < nt; ++t) F.ctl[CW_TILEE + 1 + tstart + t] = (unsigned)e; }
                    tstart += nt; }
                if (blockIdx.x == 0 && F.tid == 0) F.ctl[CW_TILEE] = (unsigned)tstart;
                for (int m = F.gw; m < S; m += F.NGW) {
                    const v4u r0 = *(const GAS v4u*)(ROUTE + (size_t)m * 8);
                    int p1 = (int)r0.z, p2 = (int)r0.w;
#pragma unroll
                    for (int e = 0; e < NE; ++e) { if ((int)r0.x == e) p1 += base[e]; if ((int)r0.y == e) p2 += base[e]; }
                    if (F.lane == 0) { ROUTE[(size_t)m * 8 + 6] = (unsigned)p1; ROUTE[(size_t)m * 8 + 7] = (unsigned)p2; }
                    const unsigned char* srow = (const unsigned char*)XN8 + (size_t)m * D * EBM; unsigned char* xp = (unsigned char*)XP;
                    const GAS v4u* src = (const GAS v4u*)srow + F.lane; GAS v4u* d1 = (GAS v4u*)(xp + (size_t)p1 * D * EBM) + F.lane; GAS v4u* d2 = (GAS v4u*)(xp + (size_t)p2 * D * EBM) + F.lane;
#pragma unroll
                    for (int j = 0; j < 2 * EBM; ++j) { const v4u t = src[64 * j]; d1[64 * j] = t; d2[64 * j] = t; }
                }
            }
            if (BOTH(pb + 7) && l == 1) GRID_BAR();
        }
        if (PEN(9) && IN(pb + 8)) { PHASE_BEGIN();
            if (l == 0) { pg8::Gemm g{XN8, WGU, D * EBD, D * EBD, D * EBD / 128}; pg8::StaticOrder So; So.init(S, 2 * DFF, F.G, (int)blockIdx.x);
                FfnEpi1<F8D> E = Epi1Maker<F8D>::make(ACT, DFF);
                pg8::gemm_phase<FfnEpi1<F8D>, pg8::StaticOrder, true, SP2V, F8D>(F.lds, g, So, E); }
            else { const int ntile = (int)__hip_atomic_load(F.ctl + CW_TILEE, RLX_AGENT);
                pg8::Gemm g{XP, MGU, D * EBM, D * EBM, D * EBM / 128}; pg8::MoeOrder So{F.G, (int)blockIdx.x, 2 * DFE / 256, ntile, 2 * DFE, (const int*)(F.ctl + CW_TILEE + 1)};
                FfnEpi1<F8M> E = Epi1Maker<F8M>::make(ACTP, DFE);
                pg8::gemm_phase<FfnEpi1<F8M>, pg8::MoeOrder, true, SP2V, F8M>(F.lds, g, So, E); }
            if (BOTH(pb + 8)) GRID_BAR();
        }
        if (PEN(10) && IN(pb + 9)) { PHASE_BEGIN();
            if (l == 0) { pg8::Gemm g{ACT, WDN, DFF * EBD, DFF * EBD, DFF * EBD / 128}; pg8::StaticOrder So; So.init(S, D, F.G, (int)blockIdx.x);
                pg8::EpiResF32 E{XA, args.rep ? YPRE : XA, D, Sc<F8D>::dn};
                pg8::gemm_phase<pg8::EpiResF32, pg8::StaticOrder, true, SP2V, F8D>(F.lds, g, So, E); }
            else { const int ntile = (int)__hip_atomic_load(F.ctl + CW_TILEE, RLX_AGENT);
                pg8::Gemm g{ACTP, MDN, DFE * EBM, DFE * EBM, DFE * EBM / 128}; pg8::MoeOrder So{F.G, (int)blockIdx.x, D / 256, ntile, D, (const int*)(F.ctl + CW_TILEE + 1)};
                pg8::EpiBf16 E{OUTP, D, Sc<F8M>::dn};
                pg8::gemm_phase<pg8::EpiBf16, pg8::MoeOrder, true, SP2V, F8M>(F.lds, g, So, E); }
            if (BOTH(pb + 9)) GRID_BAR();
        }
        if (PEN(11) && IN(pb + 10)) { PHASE_BEGIN();
            if (l == 0) { for (int m = F.gw; m < S; m += F.NGW) rms_row_to_bf16(XA + (size_t)m * D, args.in[4] + D, XN + (size_t)m * D, F.lane); }
            else {
                const float* gfin = args.in[22];
                for (int m = F.gw; m < S; m += F.NGW) {
                    const v4u r1 = *(const GAS v4u*)(ROUTE + (size_t)m * 8 + 4);
                    const float g1 = __uint_as_float(r1.x), g2 = __uint_as_float(r1.y); const int p1 = (int)r1.z, p2 = (int)r1.w;
                    const GAS f32x4* xr = (const GAS f32x4*)(XA + (size_t)m * D) + F.lane;
                    const GAS v2u* o1 = (const GAS v2u*)(OUTP + (size_t)p1 * D) + F.lane; const GAS v2u* o2 = (const GAS v2u*)(OUTP + (size_t)p2 * D) + F.lane;
                    f32x4 v[8]; float s = 0.f;
#pragma unroll
                    for (int j = 0; j < 8; ++j) { const f32x4 xv = xr[64 * j]; const v2u a = o1[64 * j], b = o2[64 * j];
                        v[j].x = xv.x + g1 * bflo(a.x) + g2 * bflo(b.x); v[j].y = xv.y + g1 * bfhi(a.x) + g2 * bfhi(b.x);
                        v[j].z = xv.z + g1 * bflo(a.y) + g2 * bflo(b.y); v[j].w = xv.w + g1 * bfhi(a.y) + g2 * bfhi(b.y);
                        s += (v[j].x * v[j].x + v[j].y * v[j].y) + (v[j].z * v[j].z + v[j].w * v[j].w); }
                    const float rstd = 1.f / sqrtf(wave_sum(s) * (1.f / D) + EPS);
                    GAS f32x4* orow = (GAS f32x4*)(args.out + (size_t)m * D) + F.lane; const GAS f32x4* gr = (const GAS f32x4*)gfin + F.lane;
#pragma unroll
                    for (int j = 0; j < 8; ++j) { const f32x4 gg = gr[64 * j]; orow[64 * j] = (f32x4){v[j].x * rstd * gg.x, v[j].y * rstd * gg.y, v[j].z * rstd * gg.z, v[j].w * rstd * gg.w}; }
                }
            }
            if (BOTH(pb + 10) && l == 0) GRID_BAR();
        }
    }
#undef IN
#undef BOTH
#undef GRID_BAR
#undef WIN
#undef WUP
#undef WMEM
#undef WOUT
#undef WGU
#undef WDN
#undef MGU
#undef MDN
#undef XN
#undef MEMN
#undef MEMKV
#undef PROJ
#undef AQKV
#undef KROPE
#undef ROPECS
#undef QKVM
#undef YPRE
#undef DILO
#undef DILS
#undef Y
#undef XA
#undef ROUTE
#undef XP
#undef OUTP
#undef ACTP
#undef ACT
#undef x_in
#undef XN8
#undef PHASE_BEGIN
#undef FILL
}

extern "C" void kernel_launch(void* const* d_in, const int* in_sizes, int n_in, void* d_out, int out_size, void* d_ws, size_t ws_size, hipStream_t stream) {
    static int grid = 0;
    if (grid == 0) {
        if (n_in != 23 || in_sizes[0] != S * D || out_size != S * D || ws_size < WS_END) { fprintf(stderr, "kernel_launch: shape/workspace mismatch: n_in %d in0 %d out %d ws %zu (need %zu)\n", n_in, n_in > 0 ? in_sizes[0] : -1, out_size, ws_size, (size_t)WS_END); grid = -1; return; }
        int dev = 0, cus = 0, per_cu = 0;
        if (hipGetDevice(&dev) != hipSuccess || hipDeviceGetAttribute(&cus, hipDeviceAttributeMultiprocessorCount, dev) != hipSuccess) { fprintf(stderr, "kernel_launch: device query failed\n"); grid = -1; return; }
        if (hipFuncSetAttribute((const void*)mk_fwd, hipFuncAttributeMaxDynamicSharedMemorySize, LDS_BYTES) != hipSuccess) { fprintf(stderr, "kernel_launch: hipFuncSetAttribute failed\n"); grid = -1; return; }
        if (hipOccupancyMaxActiveBlocksPerMultiprocessor(&per_cu, (const void*)mk_fwd, NWAVES * 64, LDS_BYTES) != hipSuccess || per_cu < 1) { fprintf(stderr, "kernel_launch: occupancy query reports %d workgroups per CU\n", per_cu); }
        (void)hipGetLastError();
        grid = cus;
    }
    if (grid < 0) return;
    (void)hipMemsetAsync((char*)d_ws + WS_CTL, 0, CTL_ZERO_BYTES, stream);
    (void)hipMemsetAsync((char*)d_ws + WS_WIN, 0, (size_t)2 * DINP * D * 2, stream);
    (void)hipMemsetAsync((char*)d_ws + WS_WUP, 0, (size_t)2 * NUP * AQ * 2, stream);
    Args a{};
    for (int i = 0; i < 23; ++i) a.in[i] = (const float*)d_in[i];
    a.out = (float*)d_out; a.ws = (unsigned char*)d_ws;
    for (int i = 0; i < 32; ++i) a.invf[i] = 1.0f / powf(10000.0f, (float)i / 32.0f);
    int lo[8], hi[8], rp[8], nl = 0;
#if defined(PROBE_PHASE) && PROBE_PHASE >= 0
    lo[nl] = 0; hi[nl] = PROBE_PHASE + 1; rp[nl++] = 0;
    for (int r = 0; r < PROBE_REPS; ++r) { lo[nl] = PROBE_PHASE; hi[nl] = PROBE_PHASE + 1; rp[nl++] = 1; }
    if (PROBE_PHASE + 1 < N_PHASES) { lo[nl] = PROBE_PHASE + 1; hi[nl] = N_PHASES; rp[nl++] = 0; }
#else
    if (N_LAUNCHES == N_PHASES) { nl = 0; } else { lo[0] = 0; hi[0] = N_PHASES; rp[0] = 0; nl = 1; }
#endif
    const int total = (N_LAUNCHES == N_PHASES) ? N_PHASES : nl;
    for (int li = 0; li < total; ++li) {
        if (N_LAUNCHES == N_PHASES) { a.ph_lo = li; a.ph_hi = li + 1; a.li = 0; a.rep = 0; } else { a.ph_lo = lo[li]; a.ph_hi = hi[li]; a.li = li; a.rep = rp[li]; }
        hipLaunchKernelGGL(mk_fwd, dim3(grid), dim3(NWAVES * 64), LDS_BYTES, stream, a);
        const hipError_t le = hipPeekAtLastError();
        if (le != hipSuccess) { fprintf(stderr, "kernel_launch: launch %d failed: %s\n", li, hipGetErrorName(le)); break; }
    }
}
```

```cpp
#include <hip/hip_runtime.h>
#include <cstdio>
#include <cstdint>
#include <cmath>
#include <type_traits>
#ifndef MK_N_LAUNCHES
#define MK_N_LAUNCHES 1
#endif
#define REPEAT_PHASE -1
#define FFN_FP8 3
#define PROBE_PHASE -1
#define PROBE_REPS 3
#define FILLMASK 7
#define MLA_DMA 0
#define PROBE_ATT 7
#define GEMM_SP2 1
#define CVT_FIRST 1
#define CVT_Q0 8
namespace pg8 {
#define PG8_LAS __attribute__((address_space(3)))
typedef unsigned short bf16_t;
typedef short bf16x8 __attribute__((ext_vector_type(8)));
typedef float f32x4 __attribute__((ext_vector_type(4)));
typedef unsigned u32x4 __attribute__((ext_vector_type(4)));
constexpr int BM = 256, BK = 64, HALF = 128, HTB = HALF * BK * 2  , STAGE_BYTES = 8 * HTB, NXCD = 8, WGM = 8;

__host__ __device__ __forceinline__ int lds_byte(int r, int c) { const int st = (r >> 4) * 2 + (c >> 5), rr = r & 15, cc = c & 31, ob = rr * 64 + cc * 2; return st * 1024 + (ob ^ (((ob >> 9) & 1) << 5)); }
__host__ __device__ __forceinline__ void stage_rc(int b, int& R, int& C) { const int st = b / 1024, sb = b % 1024, swz = sb ^ (((sb >> 9) & 1) << 5); R = (st >> 1) * 16 + swz / 64; C = (st & 1) * 32 + (swz % 64) / 2; }
__host__ __device__ __forceinline__ int perm32(int rho) { const int n = rho >> 4, i = rho & 15; return 8 * (i >> 2) + 4 * n + (i & 3); }

struct Unit { int pm, pn; };
struct Gemm { const void* A; const void* Bt; int lda, ldb, nt; };

struct StaticOrder {
    int nM, nN, nwg, G, c;
    __device__ void init(int M, int N, int G_, int c_) { nM = M / BM; nN = N / BM; nwg = nM * nN; G = G_; c = c_; }
    __device__ bool next(int i, Unit& u) const {
        const long L = (long)i * G + c; if (L >= nwg) return false;
        int wgid = (int)L; { const int q = nwg / NXCD, r = nwg % NXCD, xcd = wgid % NXCD, off = wgid / NXCD; wgid = (xcd < r ? xcd * (q + 1) : r * (q + 1) + (xcd - r) * q) + off; }
        const int nig = WGM * nN, gid = wgid / nig, fm = gid * WGM, gsz = (nM - fm) < WGM ? (nM - fm) : WGM;
        u.pm = fm + ((wgid % nig) % gsz); u.pn = (wgid % nig) / gsz; return true;
    }
    __device__ __forceinline__ const char* abase(const Gemm& g, const Unit& u) const { return (const char*)g.A + (size_t)u.pm * BM * g.lda; }
    __device__ __forceinline__ const char* bbase(const Gemm& g, const Unit& u) const { return (const char*)g.Bt + (size_t)u.pn * BM * g.ldb; }
};
struct InProjOrder {
    StaticOrder so; int nextra; const void* A2; const void* B2;
    __device__ bool next(int i, Unit& u) const { if (so.next(i, u)) return true; const long L = (long)i * so.G + so.c - so.nwg; if (L < 0 || L >= nextra) return false; u.pm = 32 + (int)(L >> 2); u.pn = (int)(L & 3); return true; }
    __device__ __forceinline__ const char* abase(const Gemm& g, const Unit& u) const { return u.pm < 32 ? (const char*)g.A + (size_t)u.pm * BM * g.lda : (const char*)A2 + (size_t)(u.pm - 32) * BM * g.lda; }
    __device__ __forceinline__ const char* bbase(const Gemm& g, const Unit& u) const { return u.pm < 32 ? (const char*)g.Bt + (size_t)u.pn * BM * g.ldb : (const char*)B2 + (size_t)((u.pm - 32) * 1024 + u.pn * BM) * g.ldb; }
};
struct MemOrder {
    int G, c;
    __device__ bool next(int i, Unit& u) const { const int L = c - (G - 8); if (i != 0 || L < 0 || L >= 8) return false; u.pm = L >> 2; u.pn = L & 3; return true; }
    __device__ __forceinline__ const char* abase(const Gemm& g, const Unit& u) const { return (const char*)g.A + (size_t)u.pm * BM * g.lda; }
    __device__ __forceinline__ const char* bbase(const Gemm& g, const Unit& u) const { return (const char*)g.Bt + (size_t)(u.pm * 1024 + u.pn * BM) * g.ldb; }
};
struct MoeOrder {
    int G, c, nN, ntile, nexp_rows; const int* tile_e;
    __device__ bool next(int i, Unit& u) const { const long L = (long)i * G + c; if (L >= (long)ntile * nN) return false; u.pm = (int)(L / nN); u.pn = (int)(L % nN); return true; }
    __device__ __forceinline__ const char* abase(const Gemm& g, const Unit& u) const { return (const char*)g.A + (size_t)u.pm * BM * g.lda; }
    __device__ __forceinline__ const char* bbase(const Gemm& g, const Unit& u) const { const int e = __builtin_amdgcn_readfirstlane(tile_e[u.pm]); return (const char*)g.Bt + ((size_t)e * nexp_rows + (size_t)u.pn * BM) * g.ldb; }
};

__device__ __forceinline__ unsigned cvt_pk_bf16(float lo, float hi) { unsigned r; asm volatile("v_cvt_pk_bf16_f32 %0, %1, %2" : "=v"(r) : "v"(lo), "v"(hi)); return r; }

struct EpiBf16 {
    static constexpr bool PERM = true;
    bf16_t* O; int ldc; float sc;
    __device__ __forceinline__ void operator()(const f32x4 (&acc)[2][2][4][2], const Unit& u, int wr, int wc, int fr, int fq) const {
        const int row0 = u.pm * BM + wr * 64 + fr, col0 = u.pn * BM + wc * 32 + 8 * fq;
#pragma unroll
        for (int ai = 0; ai < 2; ++ai)
#pragma unroll
            for (int m = 0; m < 4; ++m) { bf16_t* rowp = O + (size_t)(row0 + ai * HALF + m * 16) * ldc + col0;
#pragma unroll
                for (int bj = 0; bj < 2; ++bj) { const f32x4 v0 = acc[ai][bj][m][0] * sc, v1 = acc[ai][bj][m][1] * sc;
                    u32x4 w; w.x = cvt_pk_bf16(v0[0], v0[1]); w.y = cvt_pk_bf16(v0[2], v0[3]); w.z = cvt_pk_bf16(v1[0], v1[1]); w.w = cvt_pk_bf16(v1[2], v1[3]);
                    *(u32x4*)(rowp + bj * HALF) = w; } }
    }
};
struct EpiBf16Sel {
    static constexpr bool PERM = true;
    bf16_t* O; int ldc; bf16_t* O2; int ldc2;
    __device__ __forceinline__ void operator()(const f32x4 (&acc)[2][2][4][2], const Unit& u, int wr, int wc, int fr, int fq) const {
        const bool ex = u.pm >= 32; bf16_t* base = ex ? O2 : O; const int ld = ex ? ldc2 : ldc;
        const int row0 = (ex ? u.pm - 32 : u.pm) * BM + wr * 64 + fr, col0 = u.pn * BM + wc * 32 + 8 * fq;
#pragma unroll
        for (int ai = 0; ai < 2; ++ai)
#pragma unroll
            for (int m = 0; m < 4; ++m) { bf16_t* rowp = base + (size_t)(row0 + ai * HALF + m * 16) * ld + col0;
#pragma unroll
                for (int bj = 0; bj < 2; ++bj) { const f32x4 v0 = acc[ai][bj][m][0], v1 = acc[ai][bj][m][1];
                    u32x4 w; w.x = cvt_pk_bf16(v0[0], v0[1]); w.y = cvt_pk_bf16(v0[2], v0[3]); w.z = cvt_pk_bf16(v1[0], v1[1]); w.w = cvt_pk_bf16(v1[2], v1[3]);
                    *(u32x4*)(rowp + bj * HALF) = w; } }
    }
};
struct EpiResF32 {
    static constexpr bool PERM = false;
    const float* R; float* C; int ldc; float sc;
    __device__ __forceinline__ void operator()(const f32x4 (&acc)[2][2][4][2], const Unit& u, int wr, int wc, int fr, int fq) const {
        const int row0 = u.pm * BM + wr * 64 + fr, col0 = u.pn * BM + wc * 32 + 4 * fq;
#pragma unroll
        for (int ai = 0; ai < 2; ++ai)
#pragma unroll
            for (int m = 0; m < 4; ++m) { const size_t off = (size_t)(row0 + ai * HALF + m * 16) * ldc + col0;
#pragma unroll
                for (int bj = 0; bj < 2; ++bj)
#pragma unroll
                    for (int n = 0; n < 2; ++n) { const f32x4 r = *(const f32x4*)(R + off + bj * HALF + n * 16); *(f32x4*)(C + off + bj * HALF + n * 16) = r + acc[ai][bj][m][n] * sc; } }
    }
};
__device__ __forceinline__ float silu_mul(float g, float u) { return g * u * __builtin_amdgcn_rcpf(1.0f + __builtin_amdgcn_exp2f(-1.4426950408889634f * g)); }
struct EpiSwiGLU {
    static constexpr bool PERM = true;
    bf16_t* O; int ldc;
    __device__ __forceinline__ void operator()(const f32x4 (&acc)[2][2][4][2], const Unit& u, int wr, int wc, int fr, int fq) const {
        const int row0 = u.pm * BM + wr * 64 + fr, col0 = u.pn * HALF + wc * 32 + 8 * fq;
#pragma unroll
        for (int ai = 0; ai < 2; ++ai)
#pragma unroll
            for (int m = 0; m < 4; ++m) { bf16_t* rowp = O + (size_t)(row0 + ai * HALF + m * 16) * ldc + col0;
                const f32x4 g0 = acc[ai][0][m][0], g1 = acc[ai][0][m][1], u0 = acc[ai][1][m][0], u1 = acc[ai][1][m][1];
                u32x4 w; w.x = cvt_pk_bf16(silu_mul(g0[0], u0[0]), silu_mul(g0[1], u0[1])); w.y = cvt_pk_bf16(silu_mul(g0[2], u0[2]), silu_mul(g0[3], u0[3]));
                w.z = cvt_pk_bf16(silu_mul(g1[0], u1[0]), silu_mul(g1[1], u1[1])); w.w = cvt_pk_bf16(silu_mul(g1[2], u1[2]), silu_mul(g1[3], u1[3]));
                *(u32x4*)rowp = w; }
    }
};

typedef int v8i_t __attribute__((ext_vector_type(8)));
__device__ __forceinline__ v8i_t pg8_cat(bf16x8 lo, bf16x8 hi) { typedef int v4i_t __attribute__((ext_vector_type(4))); const v4i_t a = __builtin_bit_cast(v4i_t, lo), b = __builtin_bit_cast(v4i_t, hi); return (v8i_t){a.x, a.y, a.z, a.w, b.x, b.y, b.z, b.w}; }
struct EpiSwiGLU8 {
    static constexpr bool PERM = true;
    unsigned char* O; int ldc; float sc_in, sc_out;
    __device__ __forceinline__ void operator()(const f32x4 (&acc)[2][2][4][2], const Unit& u, int wr, int wc, int fr, int fq) const {
        const int row0 = u.pm * BM + wr * 64 + fr, col0 = u.pn * HALF + wc * 32 + 8 * fq;
#pragma unroll
        for (int ai = 0; ai < 2; ++ai)
#pragma unroll
            for (int m = 0; m < 4; ++m) { unsigned char* rowp = O + (size_t)(row0 + ai * HALF + m * 16) * ldc + col0;
                const f32x4 g0 = acc[ai][0][m][0] * sc_in, g1 = acc[ai][0][m][1] * sc_in, u0 = acc[ai][1][m][0] * (sc_in * sc_out), u1 = acc[ai][1][m][1] * (sc_in * sc_out);
                int w0 = 0, w1 = 0;
                w0 = __builtin_amdgcn_cvt_pk_fp8_f32(silu_mul(g0[0], u0[0]), silu_mul(g0[1], u0[1]), w0, false); w0 = __builtin_amdgcn_cvt_pk_fp8_f32(silu_mul(g0[2], u0[2]), silu_mul(g0[3], u0[3]), w0, true);
                w1 = __builtin_amdgcn_cvt_pk_fp8_f32(silu_mul(g1[0], u1[0]), silu_mul(g1[1], u1[1]), w1, false); w1 = __builtin_amdgcn_cvt_pk_fp8_f32(silu_mul(g1[2], u1[2]), silu_mul(g1[3], u1[3]), w1, true);
                typedef int v2i_t __attribute__((ext_vector_type(2))); *(v2i_t*)rowp = (v2i_t){w0, w1}; }
    }
};
__device__ __forceinline__ void pg8_mfma8(f32x4& c, v8i_t a, v8i_t b, int sc) { asm volatile("v_mfma_scale_f32_16x16x128_f8f6f4 %0, %1, %2, %0, %3, %3 op_sel_hi:[0,0,0]" : "+v"(c) : "v"(a), "v"(b), "v"(sc)); }
template <class Epi, class Sched, bool ALIGN_EPI = false, bool SP2 = false, bool FP8 = false>
__device__ __forceinline__ void gemm_phase(PG8_LAS unsigned char* lds, const Gemm g, const Sched& S, const Epi& E) {
    int tid_ = threadIdx.x; asm volatile("" : "+v"(tid_));
    const int tid = tid_, wid = __builtin_amdgcn_readfirstlane(tid >> 6), lane = tid & 63, wr = wid >> 2, wc = wid & 3, fr = lane & 15, fq = lane >> 4;
    const int nt = g.nt;
    unsigned voffA[2], voffB[2];
#pragma unroll
    for (int i = 0; i < 2; ++i) { int R, C; stage_rc(tid * 16 + i * 8192, R, C); const int Rb = Epi::PERM ? ((R & ~31) + perm32(R & 31)) : R;
        voffA[i] = (unsigned)(R * g.lda + C * 2); voffB[i] = (unsigned)(Rb * g.ldb + C * 2); }
    const size_t kstep = (size_t)(BK * 2);
    const size_t hstepA = (size_t)HALF * g.lda, hstepB = (size_t)HALF * g.ldb;
    const unsigned ldsw = (unsigned)wid * 1024u;
    const int aoff = lds_byte(wr * 64 + fr, fq * 8), boff = lds_byte(wc * 32 + fr, fq * 8);
#define PG8_SA(b, h) (((b) * 2 + (h)) * HTB)
#define PG8_SB(b, h) ((4 + (b) * 2 + (h)) * HTB)
#define PG8_STAGE(bufoff, gbase, voff) do { _Pragma("unroll") for (int _i = 0; _i < 2; ++_i) \
        __builtin_amdgcn_global_load_lds((const unsigned*)((const char*)(gbase) + (voff)[_i]), (PG8_LAS unsigned*)(lds + (bufoff) + ldsw + _i * 8192), 16, 0, 0); } while (0)
#define PG8_LDA(dst, b, h) do { _Pragma("unroll") for (int m = 0; m < 4; ++m) _Pragma("unroll") for (int k = 0; k < 2; ++k) dst[m][k] = *(const PG8_LAS bf16x8*)(lds + PG8_SA(b, h) + aoff + m * 2048 + k * 1024); } while (0)
#define PG8_LDB(dst, b, h) do { _Pragma("unroll") for (int n = 0; n < 2; ++n) _Pragma("unroll") for (int k = 0; k < 2; ++k) dst[n][k] = *(const PG8_LAS bf16x8*)(lds + PG8_SB(b, h) + boff + n * 2048 + k * 1024); } while (0)
#define PG8_MMA(ai, bj, At, Bt) do { __builtin_amdgcn_s_setprio(1); if constexpr (FP8) { _Pragma("unroll") for (int m = 0; m < 4; ++m) _Pragma("unroll") for (int n = 0; n < 2; ++n) \
        pg8_mfma8(acc[ai][bj][m][n], pg8_cat(Bt[n][0], Bt[n][1]), pg8_cat(At[m][0], At[m][1]), sc8); } else { \
        _Pragma("unroll") for (int m = 0; m < 4; ++m) _Pragma("unroll") for (int n = 0; n < 2; ++n) _Pragma("unroll") for (int k = 0; k < 2; ++k) \
        acc[ai][bj][m][n] = __builtin_amdgcn_mfma_f32_16x16x32_bf16(Bt[n][k], At[m][k], acc[ai][bj][m][n], 0, 0, 0); } __builtin_amdgcn_s_setprio(0); } while (0)
#define PG8_WAIT_V(n) asm volatile("s_waitcnt vmcnt(" #n ")" ::: "memory")
#define PG8_WAIT_L(n) asm volatile("s_waitcnt lgkmcnt(" #n ")" ::: "memory")
#define PG8_BAR __builtin_amdgcn_s_barrier()
#define PG8_SCHED __builtin_amdgcn_sched_barrier(0)
    Unit cur, nxt; int ui = 0;
    if (!S.next(0, cur)) return;
    int sc8 = 0x7F7F7F7F; asm volatile("" : "+v"(sc8));
    f32x4 acc[2][2][4][2];
#pragma unroll
    for (int a = 0; a < 2; ++a)
#pragma unroll
        for (int b = 0; b < 2; ++b)
#pragma unroll
            for (int m = 0; m < 4; ++m)
#pragma unroll
                for (int n = 0; n < 2; ++n) acc[a][b][m][n] = (f32x4){0.f, 0.f, 0.f, 0.f};
    bf16x8 At[4][2], B0[2][2], B1[2][2];
    const char* cA = S.abase(g, cur); const char* cB = S.bbase(g, cur);
    if constexpr (SP2) {
        PG8_STAGE(PG8_SB(0, 0), cB, voffB); PG8_STAGE(PG8_SB(0, 1), cB + hstepB, voffB); PG8_STAGE(PG8_SA(0, 0), cA, voffA); PG8_STAGE(PG8_SA(0, 1), cA + hstepA, voffA);
        if (wr == 1) PG8_BAR;
        PG8_WAIT_V(2); PG8_BAR;
        PG8_STAGE(PG8_SB(1, 0), cB + kstep, voffB); PG8_STAGE(PG8_SA(1, 0), cA + kstep, voffA); PG8_STAGE(PG8_SB(1, 1), cB + hstepB + kstep, voffB);
        PG8_WAIT_V(6); PG8_BAR;
    } else {
        PG8_STAGE(PG8_SB(0, 0), cB, voffB); PG8_STAGE(PG8_SA(0, 0), cA, voffA); PG8_STAGE(PG8_SB(0, 1), cB + hstepB, voffB); PG8_STAGE(PG8_SA(0, 1), cA + hstepA, voffA);
        if (wr == 1) PG8_BAR;
        PG8_WAIT_V(4); PG8_BAR;
        PG8_STAGE(PG8_SB(1, 0), cB + kstep, voffB); PG8_STAGE(PG8_SA(1, 0), cA + kstep, voffA); PG8_STAGE(PG8_SB(1, 1), cB + hstepB + kstep, voffB);
        PG8_WAIT_V(6); PG8_BAR;
    }
    for (;;) {
        const bool has_next = S.next(ui + 1, nxt);
        const char* nA = has_next ? S.abase(g, nxt) : cA; const char* nB = has_next ? S.bbase(g, nxt) : cB;
        for (int t = 0; t < nt; t += 2) {
            const bool last = (t == nt - 2);
            const char* a1 = cA + (size_t)(t + 1) * kstep;
            const char* a2 = last ? nA : cA + (size_t)(t + 2) * kstep; const char* b2 = last ? nB : cB + (size_t)(t + 2) * kstep;
            const char* a3 = a2 + kstep; const char* b3 = b2 + kstep;
            if constexpr (SP2) {
            PG8_LDB(B0, 0, 0); PG8_LDB(B1, 0, 1); PG8_SCHED; PG8_LDA(At, 0, 0); PG8_STAGE(PG8_SA(1, 1), a1 + hstepA, voffA);
            PG8_WAIT_V(8); PG8_WAIT_L(0); PG8_BAR; PG8_MMA(0, 0, At, B0); PG8_MMA(0, 1, At, B1); PG8_BAR; PG8_SCHED;
            PG8_LDA(At, 0, 1); PG8_STAGE(PG8_SB(0, 0), b2, voffB); PG8_STAGE(PG8_SB(0, 1), b2 + hstepB, voffB); PG8_STAGE(PG8_SA(0, 0), a2, voffA);
            PG8_WAIT_V(8); PG8_WAIT_L(0); PG8_BAR; PG8_MMA(1, 0, At, B0); PG8_MMA(1, 1, At, B1); PG8_BAR; PG8_SCHED;
            PG8_LDB(B0, 1, 0); PG8_LDB(B1, 1, 1); PG8_SCHED; PG8_LDA(At, 1, 0); PG8_STAGE(PG8_SA(0, 1), a2 + hstepA, voffA);
            PG8_WAIT_V(8); PG8_WAIT_L(0); PG8_BAR; PG8_MMA(0, 0, At, B0); PG8_MMA(0, 1, At, B1); PG8_BAR; PG8_SCHED;
            PG8_LDA(At, 1, 1); PG8_STAGE(PG8_SB(1, 0), b3, voffB); PG8_STAGE(PG8_SB(1, 1), b3 + hstepB, voffB); PG8_STAGE(PG8_SA(1, 0), a3, voffA);
            PG8_WAIT_V(8); PG8_WAIT_L(0); PG8_BAR; PG8_MMA(1, 0, At, B0); PG8_MMA(1, 1, At, B1); PG8_BAR; PG8_SCHED;
            } else {
            PG8_LDB(B0, 0, 0); PG8_SCHED; PG8_LDA(At, 0, 0); PG8_STAGE(PG8_SA(1, 1), a1 + hstepA, voffA);
            PG8_WAIT_L(8); PG8_BAR; PG8_WAIT_L(0); PG8_MMA(0, 0, At, B0); PG8_BAR; PG8_SCHED;
            PG8_LDB(B1, 0, 1); PG8_STAGE(PG8_SB(0, 0), b2, voffB);
            PG8_BAR; PG8_WAIT_L(0); PG8_MMA(0, 1, At, B1); PG8_BAR;
            PG8_LDA(At, 0, 1); PG8_STAGE(PG8_SA(0, 0), a2, voffA);
            PG8_BAR; PG8_WAIT_L(0); PG8_MMA(1, 0, At, B0); PG8_BAR; PG8_SCHED;
            PG8_STAGE(PG8_SB(0, 1), b2 + hstepB, voffB);
            PG8_WAIT_V(6); PG8_BAR; PG8_MMA(1, 1, At, B1); PG8_BAR;
            PG8_LDB(B0, 1, 0); PG8_SCHED; PG8_LDA(At, 1, 0); PG8_STAGE(PG8_SA(0, 1), a2 + hstepA, voffA);
            PG8_WAIT_L(8); PG8_BAR; PG8_WAIT_L(0); PG8_MMA(0, 0, At, B0); PG8_BAR; PG8_SCHED;
            PG8_LDB(B1, 1, 1); PG8_STAGE(PG8_SB(1, 0), b3, voffB);
            PG8_BAR; PG8_WAIT_L(0); PG8_MMA(0, 1, At, B1); PG8_BAR;
            PG8_LDA(At, 1, 1); PG8_STAGE(PG8_SA(1, 0), a3, voffA);
            PG8_BAR; PG8_WAIT_L(0); PG8_MMA(1, 0, At, B0); PG8_BAR; PG8_SCHED;
            PG8_STAGE(PG8_SB(1, 1), b3 + hstepB, voffB);
            PG8_WAIT_V(6); PG8_BAR; PG8_MMA(1, 1, At, B1); PG8_BAR;
            }
        }
        if constexpr (ALIGN_EPI) { if (wr == 0) PG8_BAR; }
        if constexpr (FP8) { PG8_SCHED; asm volatile("s_nop 15\n\ts_nop 7" ::: "memory"); PG8_SCHED; }
        E(acc, cur, wr, wc, fr, fq);
        if (!has_next) break;
#pragma unroll
        for (int a = 0; a < 2; ++a)
#pragma unroll
            for (int b = 0; b < 2; ++b)
#pragma unroll
                for (int m = 0; m < 4; ++m)
#pragma unroll
                    for (int n = 0; n < 2; ++n) acc[a][b][m][n] = (f32x4){0.f, 0.f, 0.f, 0.f};
        cur = nxt; cA = nA; cB = nB; ++ui;
        if constexpr (ALIGN_EPI) { if (wr == 1) PG8_BAR; }
    }
    PG8_WAIT_V(0);
    if constexpr (!ALIGN_EPI) { if (wr == 0) PG8_BAR; }
    PG8_BAR;
#undef PG8_SA
#undef PG8_SB
#undef PG8_STAGE
#undef PG8_LDA
#undef PG8_LDB
#undef PG8_MMA
#undef PG8_WAIT_V
#undef PG8_WAIT_L
#undef PG8_BAR
#undef PG8_SCHED
}
}
namespace att {
#define ATT_LAS __attribute__((address_space(3)))
#define ATT_GAS __attribute__((address_space(1)))
typedef unsigned short bf16;
using bf16x8 = __attribute__((ext_vector_type(8))) short;
using s16x4  = __attribute__((ext_vector_type(4))) short;
using f32x16 = __attribute__((ext_vector_type(16))) float;
using f32x4  = __attribute__((ext_vector_type(4))) float;
using u32x4  = __attribute__((ext_vector_type(4))) unsigned;
constexpr int NW = 8, QBLK = 32, KVBLK = 64, DV = 128;
constexpr float LOG2E = 1.4426950408889634f;
#define SBAR() __builtin_amdgcn_sched_barrier(0)
__device__ __forceinline__ int crow(int r, int hi) { return (r & 3) + 8 * (r >> 2) + 4 * hi; }
__device__ __forceinline__ unsigned cvtpk(float lo, float hi) { unsigned r; asm volatile("v_cvt_pk_bf16_f32 %0, %1, %2" : "=v"(r) : "v"(lo), "v"(hi)); return r; }
__device__ __forceinline__ float bf2f(short s) { return __uint_as_float(((unsigned)(unsigned short)s) << 16); }

__device__ __forceinline__ void partialSM(f32x16& p0, f32x16& p1, float& m_reg, float& mn, float& alpha, const float C, const float THRS) {
  float pmax = p0[0];
#pragma unroll
  for (int r = 1; r < 16; ++r) pmax = fmaxf(pmax, p0[r]);
#pragma unroll
  for (int r = 0; r < 16; ++r) pmax = fmaxf(pmax, p1[r]);
  { auto rr = __builtin_amdgcn_permlane32_swap(__float_as_uint(pmax), __float_as_uint(pmax), false, false);
    pmax = fmaxf(__uint_as_float(rr[0]), __uint_as_float(rr[1])); }
  if (__builtin_expect(__all(pmax - m_reg <= THRS), 1)) { mn = m_reg; alpha = 1.f; }
  else { mn = fmaxf(m_reg, pmax); alpha = __builtin_amdgcn_exp2f((m_reg - mn) * C); m_reg = mn; }
  float mnC = -mn * C;
#pragma unroll
  for (int r = 0; r < 16; ++r) p0[r] = fmaf(p0[r], C, mnC);
#pragma unroll
  for (int r = 0; r < 16; ++r) p1[r] = fmaf(p1[r], C, mnC);
#pragma unroll
  for (int r = 0; r < 16; ++r) p0[r] = __builtin_amdgcn_exp2f(p0[r]);
}
#define ATT_PK4(P, BASE, OUT) do { unsigned a0 = cvtpk(P[BASE + 0], P[BASE + 1]), a1 = cvtpk(P[BASE + 2], P[BASE + 3]);   \
    unsigned b0 = cvtpk(P[BASE + 4], P[BASE + 5]), b1 = cvtpk(P[BASE + 6], P[BASE + 7]);                              \
    auto r0 = __builtin_amdgcn_permlane32_swap(a0, b0, false, false); auto r1 = __builtin_amdgcn_permlane32_swap(a1, b1, false, false); \
    u32x4 w = {r0[0], r1[0], r0[1], r1[1]}; OUT = *reinterpret_cast<bf16x8*>(&w); } while (0)
__device__ __forceinline__ void finishSM(f32x16& p0, f32x16& p1, float alpha, float& l_reg, bf16x8& pa0, bf16x8& pa1, bf16x8& pa2, bf16x8& pa3) {
#pragma unroll
  for (int r = 0; r < 16; ++r) p1[r] = __builtin_amdgcn_exp2f(p1[r]);
  float ps = 0;
#pragma unroll
  for (int r = 0; r < 16; ++r) ps += p0[r];
#pragma unroll
  for (int r = 0; r < 16; ++r) ps += p1[r];
  { auto rr = __builtin_amdgcn_permlane32_swap(__float_as_uint(ps), __float_as_uint(ps), false, false);
    ps = __uint_as_float(rr[0]) + __uint_as_float(rr[1]); }
  l_reg = l_reg * alpha + ps;
  ATT_PK4(p0, 0, pa0); ATT_PK4(p0, 8, pa1); ATT_PK4(p1, 0, pa2); ATT_PK4(p1, 8, pa3);
}
template <int RB> __device__ __forceinline__ int kswz(int row, int colB) { return row * RB + (colB ^ ((row & 7) << 4)); }
template <int DQK> __device__ __forceinline__ void qkt(f32x16& p0, f32x16& p1, const ATT_LAS char* Ks, const bf16x8 (&qr)[DQK / 16], int r32, int hi) {
  p0 = f32x16{}; p1 = f32x16{};
#pragma unroll
  for (int d0 = 0; d0 < DQK / 16; ++d0) { const int cb = (d0 * 16 + hi * 8) * 2;
    bf16x8 b0 = *reinterpret_cast<const ATT_LAS bf16x8*>(Ks + kswz<DQK * 2>(r32, cb));
    bf16x8 b1 = *reinterpret_cast<const ATT_LAS bf16x8*>(Ks + kswz<DQK * 2>(32 + r32, cb));
    p0 = __builtin_amdgcn_mfma_f32_32x32x16_bf16(b0, qr[d0], p0, 0, 0, 0);
    p1 = __builtin_amdgcn_mfma_f32_32x32x16_bf16(b1, qr[d0], p1, 0, 0, 0); }
}
__device__ __forceinline__ void qkt192_lq(f32x16& p0, f32x16& p1, const ATT_LAS char* Ks, const bf16x8 (&qr)[8], const ATT_LAS char* Qs, int lane, int r32, int hi) {
  p0 = f32x16{}; p1 = f32x16{};
#pragma unroll
  for (int d0 = 0; d0 < 12; ++d0) { const int cb = (d0 * 16 + hi * 8) * 2;
    bf16x8 b0 = *reinterpret_cast<const ATT_LAS bf16x8*>(Ks + kswz<384>(r32, cb));
    bf16x8 b1 = *reinterpret_cast<const ATT_LAS bf16x8*>(Ks + kswz<384>(32 + r32, cb));
    const bf16x8 q = d0 < 8 ? qr[d0 < 8 ? d0 : 0] : *reinterpret_cast<const ATT_LAS bf16x8*>(Qs + ((d0 - 8) * 64 + lane) * 16);
    p0 = __builtin_amdgcn_mfma_f32_32x32x16_bf16(b0, q, p0, 0, 0, 0);
    p1 = __builtin_amdgcn_mfma_f32_32x32x16_bf16(b1, q, p1, 0, 0, 0); }
}
__device__ __forceinline__ int v_st(int k, int c) { const int kk = (k & ~0xC) | ((k & 4) << 1) | ((k & 8) >> 1); return ((kk >> 3) * 4 + (c >> 5)) * 512 + ((kk & 7) * 32 + (c & 31)) * 2; }
__device__ __forceinline__ int v_rd_base(int lane) { return ((lane & 3) << 3) | (((lane >> 2) & 3) << 6) | (((lane >> 4) & 1) << 5) | (((lane >> 5) & 1) << 8); }
constexpr int v_rd_off(int d0, int ks, int half) { return d0 * 512 + ks * 4096 + half * 2048; }
template <int OFF> __device__ __forceinline__ s16x4 tr_read(int vb) {
  s16x4 r; asm volatile("ds_read_b64_tr_b16 %0, %1 offset:%2" : "=&v"(r) : "v"(vb), "i"(OFF) : "memory"); return r;
}
#define ATT_PK(L, H) (bf16x8){L[0], L[1], L[2], L[3], H[0], H[1], H[2], H[3]}
template <int D0> __device__ __forceinline__ void pv_one(f32x16& od, int vb, bf16x8 pa0, bf16x8 pa1, bf16x8 pa2, bf16x8 pa3) {
  const s16x4 l0 = tr_read<v_rd_off(D0, 0, 0)>(vb), h0 = tr_read<v_rd_off(D0, 0, 1)>(vb), l1 = tr_read<v_rd_off(D0, 1, 0)>(vb), h1 = tr_read<v_rd_off(D0, 1, 1)>(vb);
  const s16x4 l2 = tr_read<v_rd_off(D0, 2, 0)>(vb), h2 = tr_read<v_rd_off(D0, 2, 1)>(vb), l3 = tr_read<v_rd_off(D0, 3, 0)>(vb), h3 = tr_read<v_rd_off(D0, 3, 1)>(vb);
  asm volatile("s_waitcnt lgkmcnt(0)" ::: "memory"); SBAR();
  od = __builtin_amdgcn_mfma_f32_32x32x16_bf16(pa0, ATT_PK(l0, h0), od, 0, 0, 0);
  od = __builtin_amdgcn_mfma_f32_32x32x16_bf16(pa1, ATT_PK(l1, h1), od, 0, 0, 0);
  od = __builtin_amdgcn_mfma_f32_32x32x16_bf16(pa2, ATT_PK(l2, h2), od, 0, 0, 0);
  od = __builtin_amdgcn_mfma_f32_32x32x16_bf16(pa3, ATT_PK(l3, h3), od, 0, 0, 0);
}
__device__ __forceinline__ void pv_d0(f32x16 (&o)[4], int vb, bf16x8 pa0, bf16x8 pa1, bf16x8 pa2, bf16x8 pa3) {
  pv_one<0>(o[0], vb, pa0, pa1, pa2, pa3); pv_one<1>(o[1], vb, pa0, pa1, pa2, pa3); pv_one<2>(o[2], vb, pa0, pa1, pa2, pa3); pv_one<3>(o[3], vb, pa0, pa1, pa2, pa3);
}
template <int D0> __device__ __forceinline__ void pv32_one(f32x16& od, int vb, bf16x8 pa0, bf16x8 pa1) {
  const s16x4 l0 = tr_read<v_rd_off(D0, 0, 0)>(vb), h0 = tr_read<v_rd_off(D0, 0, 1)>(vb), l1 = tr_read<v_rd_off(D0, 1, 0)>(vb), h1 = tr_read<v_rd_off(D0, 1, 1)>(vb);
  asm volatile("s_waitcnt lgkmcnt(0)" ::: "memory"); SBAR();
  od = __builtin_amdgcn_mfma_f32_32x32x16_bf16(pa0, ATT_PK(l0, h0), od, 0, 0, 0);
  od = __builtin_amdgcn_mfma_f32_32x32x16_bf16(pa1, ATT_PK(l1, h1), od, 0, 0, 0);
}

template <int DQK, int LDQ, int LDK, int LDO, int SDEPTH>
__device__ __forceinline__ void attn_dense_body(const bf16* __restrict__ Qb, const bf16* __restrict__ Kh, const bf16* __restrict__ Kr, const bf16* __restrict__ Vh,
                                                const float* __restrict__ cs_rows, float* __restrict__ Ob, int seq, const float scale, ATT_LAS char* lds) {
  constexpr int SHM_V = KVBLK * DV * 2, SHM_K = KVBLK * DQK * 2, RB = DQK * 2, NQ = DQK / 16;
  constexpr bool ROPE = (DQK == 192);
  const float C = scale * LOG2E, THRS = 8.f / scale;
  int tid_ = threadIdx.x; asm volatile("" : "+v"(tid_));
  const int tid = tid_, wid = tid >> 6, lane = tid & 63, r32 = lane & 31, hi = lane >> 5;
  ATT_LAS char* V_lds = lds; ATT_LAS char* K_lds = lds + 2 * SHM_V;
  ATT_LAS float* ws = (ATT_LAS float*)(lds + 2 * SHM_V + 2 * SHM_K) + wid * 64; ATT_LAS float* li_l = ws; ATT_LAS float* al_l = ws + 32;
  float m_reg = -1e30f, l_reg = 0; f32x16 o[4] = {}; bf16x8 qr[NQ];
  const bf16* Qw = Qb + (long)(wid * QBLK + r32) * LDQ + hi * 8;
#pragma unroll
  for (int d0 = 0; d0 < NQ; ++d0) qr[d0] = *(const ATT_GAS bf16x8*)(Qw + d0 * 16);
  if constexpr (ROPE) {
    const float* cs = cs_rows + (long)(wid * QBLK + r32) * 64 + hi * 8;
#pragma unroll
    for (int g = 0; g < 2; ++g) {
      const f32x4 c0 = *(const ATT_GAS f32x4*)(cs + g * 16), c1 = *(const ATT_GAS f32x4*)(cs + g * 16 + 4);
      const f32x4 s0 = *(const ATT_GAS f32x4*)(cs + 32 + g * 16), s1 = *(const ATT_GAS f32x4*)(cs + 32 + g * 16 + 4);
      float y1[8], y2[8];
#pragma unroll
      for (int j = 0; j < 8; ++j) { const float co = j < 4 ? c0[j & 3] : c1[j & 3], si = j < 4 ? s0[j & 3] : s1[j & 3];
        const float x1 = bf2f(qr[8 + g][j]), x2 = bf2f(qr[10 + g][j]); y1[j] = x1 * co - x2 * si; y2[j] = x1 * si + x2 * co; }
      u32x4 w1 = {cvtpk(y1[0], y1[1]), cvtpk(y1[2], y1[3]), cvtpk(y1[4], y1[5]), cvtpk(y1[6], y1[7])};
      u32x4 w2 = {cvtpk(y2[0], y2[1]), cvtpk(y2[2], y2[3]), cvtpk(y2[4], y2[5]), cvtpk(y2[6], y2[7])};
      qr[8 + g] = *reinterpret_cast<bf16x8*>(&w1); qr[10 + g] = *reinterpret_cast<bf16x8*>(&w2);
    }
  }
  const int sr = tid >> 4, sc = (tid & 15) * 8, vst0 = v_st(sr, sc), vst1 = v_st(32 + sr, sc);
  const int rr = tid >> 3, rc = (tid & 7) * 8;
  const int vb0 = (int)(unsigned)(uintptr_t)V_lds + v_rd_base(lane);
  struct Slot { bf16x8 vs0, vs1, ks0, ks1, kr; } sr_[SDEPTH];
#define SLOAD(i, k0) do { sr_[i].vs0 = *(const ATT_GAS bf16x8*)(&Vh[(long)((k0) + sr) * LDK + sc]); sr_[i].vs1 = *(const ATT_GAS bf16x8*)(&Vh[(long)((k0) + 32 + sr) * LDK + sc]); \
    sr_[i].ks0 = *(const ATT_GAS bf16x8*)(&Kh[(long)((k0) + sr) * LDK + sc]); sr_[i].ks1 = *(const ATT_GAS bf16x8*)(&Kh[(long)((k0) + 32 + sr) * LDK + sc]); \
    if constexpr (ROPE) sr_[i].kr = *(const ATT_GAS bf16x8*)(&Kr[(long)((k0) + rr) * 64 + rc]); } while (0)
#define SWRITE(b, i) do { *reinterpret_cast<ATT_LAS bf16x8*>(V_lds + (b) * SHM_V + vst0) = sr_[i].vs0;          \
    *reinterpret_cast<ATT_LAS bf16x8*>(V_lds + (b) * SHM_V + vst1) = sr_[i].vs1; const int kc = sc * 2;               \
    *reinterpret_cast<ATT_LAS bf16x8*>(K_lds + (b) * SHM_K + kswz<RB>(sr, kc)) = sr_[i].ks0;                       \
    *reinterpret_cast<ATT_LAS bf16x8*>(K_lds + (b) * SHM_K + kswz<RB>(32 + sr, kc)) = sr_[i].ks1;                  \
    if constexpr (ROPE) *reinterpret_cast<ATT_LAS bf16x8*>(K_lds + (b) * SHM_K + kswz<RB>(rr, 256 + rc * 2)) = sr_[i].kr; } while (0)
#define SWAIT() do { if constexpr (SDEPTH == 2) { if constexpr (ROPE) asm volatile("s_waitcnt vmcnt(5)" ::: "memory"); else asm volatile("s_waitcnt vmcnt(4)" ::: "memory"); } else asm volatile("s_waitcnt vmcnt(0)" ::: "memory"); } while (0)
#define RESC(a) do { if (__any((a) < 1.f)) { if (hi == 0) al_l[r32] = (a); asm volatile("s_waitcnt lgkmcnt(0)" ::: "memory"); \
    _Pragma("unroll") for (int d = 0; d < 4; ++d) _Pragma("unroll") for (int r = 0; r < 16; ++r) o[d][r] *= al_l[crow(r, hi)]; } } while (0)
  f32x16 pA0, pA1, pB0, pB1; float mnA, mnB, alA, alB; bf16x8 pa0, pa1, pa2, pa3; const int NT = seq / KVBLK;
  constexpr int SE = 0, SO = SDEPTH - 1;
  SLOAD(SE, 0); asm volatile("s_waitcnt vmcnt(0)" ::: "memory"); SWRITE(0, SE); __syncthreads();
  qkt<DQK>(pA0, pA1, K_lds, qr, r32, hi); partialSM(pA0, pA1, m_reg, mnA, alA, C, THRS);
  SLOAD(SO, KVBLK); if constexpr (SDEPTH == 2) { if (2 < NT) SLOAD(SE, 2 * KVBLK); }
  SWAIT(); SWRITE(1, SO); __syncthreads();
  for (int j = 1; j + 1 < NT; j += 2) {
    SBAR(); qkt<DQK>(pB0, pB1, K_lds + SHM_K, qr, r32, hi);
    finishSM(pA0, pA1, alA, l_reg, pa0, pa1, pa2, pa3); SBAR();
    SLOAD(SO, (j + SDEPTH) * KVBLK); SBAR();
    pv_d0(o, vb0, pa0, pa1, pa2, pa3); partialSM(pB0, pB1, m_reg, mnB, alB, C, THRS);
    __syncthreads(); SWAIT(); SWRITE(0, SE);
    RESC(alB); __syncthreads();
    SBAR(); qkt<DQK>(pA0, pA1, K_lds, qr, r32, hi);
    finishSM(pB0, pB1, alB, l_reg, pa0, pa1, pa2, pa3); SBAR();
    if (SDEPTH == 1 || j + 3 < NT) SLOAD(SE, (j + 1 + SDEPTH) * KVBLK); SBAR();
    pv_d0(o, vb0 + SHM_V, pa0, pa1, pa2, pa3); partialSM(pA0, pA1, m_reg, mnA, alA, C, THRS);
    __syncthreads(); SWAIT(); SWRITE(1, SO);
    RESC(alA); __syncthreads();
  }
  SBAR(); qkt<DQK>(pB0, pB1, K_lds + SHM_K, qr, r32, hi);
  finishSM(pA0, pA1, alA, l_reg, pa0, pa1, pa2, pa3); SBAR();
  pv_d0(o, vb0, pa0, pa1, pa2, pa3); partialSM(pB0, pB1, m_reg, mnB, alB, C, THRS);
  __syncthreads(); RESC(alB);
  finishSM(pB0, pB1, alB, l_reg, pa0, pa1, pa2, pa3); SBAR();
  pv_d0(o, vb0 + SHM_V, pa0, pa1, pa2, pa3);
  if (hi == 0) li_l[r32] = l_reg; asm volatile("s_waitcnt lgkmcnt(0)" ::: "memory");
  float rli[16];
#pragma unroll
  for (int r = 0; r < 16; ++r) rli[r] = __builtin_amdgcn_rcpf(li_l[crow(r, hi)]);
  float* Ow = Ob + (long)(wid * QBLK) * LDO;
#pragma unroll
  for (int r = 0; r < 16; ++r) { const int orow = crow(r, hi);
#pragma unroll
    for (int d0 = 0; d0 < 4; ++d0) Ow[(long)orow * LDO + d0 * 32 + r32] = o[d0][r] * rli[r]; }
  __syncthreads();
#undef SLOAD
#undef SWRITE
#undef SWAIT
#undef RESC
}

template <int LDQ, int LDK, int LDO>
__device__ __forceinline__ void attn_pipe192_body(const bf16* __restrict__ Qb, const bf16* __restrict__ Kh, const bf16* __restrict__ Kr, const bf16* __restrict__ Vh,
                                                const float* __restrict__ cs_rows, float* __restrict__ Ob, int seq, const float scale, ATT_LAS char* lds) {
  constexpr int DQK = 192, SDEPTH = 1, SHM_V = KVBLK * DV * 2, SHM_K = KVBLK * DQK * 2, RB = DQK * 2, NQ = DQK / 16;
  constexpr bool ROPE = true;
  const float C = scale * LOG2E, THRS = 8.f / scale;
  int tid_ = threadIdx.x; asm volatile("" : "+v"(tid_));
  const int tid = tid_, wid = tid >> 6, lane = tid & 63, r32 = lane & 31, hi = lane >> 5;
  ATT_LAS char* V_lds = lds; ATT_LAS char* K_lds = lds + 2 * SHM_V;
  ATT_LAS float* ws = (ATT_LAS float*)(lds + 2 * SHM_V + 2 * SHM_K) + wid * 64; ATT_LAS float* li_l = ws; ATT_LAS float* al_l = ws + 32;
  ATT_LAS char* Qs = lds + 2 * SHM_V + 2 * SHM_K + 2048 + wid * 4096;
  float m_reg = -1e30f, l_reg = 0; f32x16 o[4] = {}; bf16x8 qr8[8];
  const bf16* Qw = Qb + (long)(wid * QBLK + r32) * LDQ + hi * 8;
  { bf16x8 qr[NQ];
#pragma unroll
  for (int d0 = 0; d0 < NQ; ++d0) qr[d0] = *(const ATT_GAS bf16x8*)(Qw + d0 * 16);
  if constexpr (ROPE) {
    const float* cs = cs_rows + (long)(wid * QBLK + r32) * 64 + hi * 8;
#pragma unroll
    for (int g = 0; g < 2; ++g) {
      const f32x4 c0 = *(const ATT_GAS f32x4*)(cs + g * 16), c1 = *(const ATT_GAS f32x4*)(cs + g * 16 + 4);
      const f32x4 s0 = *(const ATT_GAS f32x4*)(cs + 32 + g * 16), s1 = *(const ATT_GAS f32x4*)(cs + 32 + g * 16 + 4);
      float y1[8], y2[8];
#pragma unroll
      for (int j = 0; j < 8; ++j) { const float co = j < 4 ? c0[j & 3] : c1[j & 3], si = j < 4 ? s0[j & 3] : s1[j & 3];
        const float x1 = bf2f(qr[8 + g][j]), x2 = bf2f(qr[10 + g][j]); y1[j] = x1 * co - x2 * si; y2[j] = x1 * si + x2 * co; }
      u32x4 w1 = {cvtpk(y1[0], y1[1]), cvtpk(y1[2], y1[3]), cvtpk(y1[4], y1[5]), cvtpk(y1[6], y1[7])};
      u32x4 w2 = {cvtpk(y2[0], y2[1]), cvtpk(y2[2], y2[3]), cvtpk(y2[4], y2[5]), cvtpk(y2[6], y2[7])};
      qr[8 + g] = *reinterpret_cast<bf16x8*>(&w1); qr[10 + g] = *reinterpret_cast<bf16x8*>(&w2);
    }
  }
#pragma unroll
  for (int d0 = 0; d0 < 8; ++d0) qr8[d0] = qr[d0];
#pragma unroll
  for (int d0 = 8; d0 < 12; ++d0) *reinterpret_cast<ATT_LAS bf16x8*>(Qs + ((d0 - 8) * 64 + lane) * 16) = qr[d0];
  }
  const int sr = tid >> 4, sc = (tid & 15) * 8, vst0 = v_st(sr, sc), vst1 = v_st(32 + sr, sc);
  const int rr = tid >> 3, rc = (tid & 7) * 8;
  const int vb0 = (int)(unsigned)(uintptr_t)V_lds + v_rd_base(lane);
  struct Slot { bf16x8 vs0, vs1, ks0, ks1, kr; } sr_[SDEPTH];
#define SLOADK(i, k0) do { sr_[i].ks0 = *(const ATT_GAS bf16x8*)(&Kh[(long)((k0) + sr) * LDK + sc]); sr_[i].ks1 = *(const ATT_GAS bf16x8*)(&Kh[(long)((k0) + 32 + sr) * LDK + sc]); } while (0)
#define SLOADV(i, k0) do { sr_[i].vs0 = *(const ATT_GAS bf16x8*)(&Vh[(long)((k0) + sr) * LDK + sc]); sr_[i].vs1 = *(const ATT_GAS bf16x8*)(&Vh[(long)((k0) + 32 + sr) * LDK + sc]); \
    if constexpr (ROPE) sr_[i].kr = *(const ATT_GAS bf16x8*)(&Kr[(long)((k0) + rr) * 64 + rc]); } while (0)
#define SLOAD(i, k0) do { SLOADK(i, k0); SLOADV(i, k0); } while (0)
#define SWRITE(b, i) do { *reinterpret_cast<ATT_LAS bf16x8*>(V_lds + (b) * SHM_V + vst0) = sr_[i].vs0;          \
    *reinterpret_cast<ATT_LAS bf16x8*>(V_lds + (b) * SHM_V + vst1) = sr_[i].vs1; const int kc = sc * 2;               \
    *reinterpret_cast<ATT_LAS bf16x8*>(K_lds + (b) * SHM_K + kswz<RB>(sr, kc)) = sr_[i].ks0;                       \
    *reinterpret_cast<ATT_LAS bf16x8*>(K_lds + (b) * SHM_K + kswz<RB>(32 + sr, kc)) = sr_[i].ks1;                  \
    if constexpr (ROPE) *reinterpret_cast<ATT_LAS bf16x8*>(K_lds + (b) * SHM_K + kswz<RB>(rr, 256 + rc * 2)) = sr_[i].kr; } while (0)
#define SWAIT() do { if constexpr (SDEPTH == 2) { if constexpr (ROPE) asm volatile("s_waitcnt vmcnt(5)" ::: "memory"); else asm volatile("s_waitcnt vmcnt(4)" ::: "memory"); } else asm volatile("s_waitcnt vmcnt(0)" ::: "memory"); } while (0)
#define RESC(a) do { if (__any((a) < 1.f)) { if (hi == 0) al_l[r32] = (a); asm volatile("s_waitcnt lgkmcnt(0)" ::: "memory"); \
    _Pragma("unroll") for (int d = 0; d < 4; ++d) _Pragma("unroll") for (int r = 0; r < 16; ++r) o[d][r] *= al_l[crow(r, hi)]; } } while (0)
  f32x16 pA0, pA1, pB0, pB1; float mnA, mnB, alA, alB; bf16x8 pa0, pa1, pa2, pa3; const int NT = seq / KVBLK;
  constexpr int SE = 0, SO = SDEPTH - 1;
  SLOAD(SE, 0); asm volatile("s_waitcnt vmcnt(0)" ::: "memory"); SWRITE(0, SE); __syncthreads();
  qkt192_lq(pA0, pA1, K_lds, qr8, Qs, lane, r32, hi); partialSM(pA0, pA1, m_reg, mnA, alA, C, THRS);
  SLOAD(SO, KVBLK); if constexpr (SDEPTH == 2) { if (2 < NT) SLOAD(SE, 2 * KVBLK); }
  SWAIT(); SWRITE(1, SO); __syncthreads();
  for (int j = 1; j + 1 < NT; j += 2) {
    SBAR(); qkt192_lq(pB0, pB1, K_lds + SHM_K, qr8, Qs, lane, r32, hi);
    finishSM(pA0, pA1, alA, l_reg, pa0, pa1, pa2, pa3); SBAR();
    SLOADK(SO, (j + SDEPTH) * KVBLK); SBAR();
    pv_d0(o, vb0, pa0, pa1, pa2, pa3); SBAR(); SLOADV(SO, (j + SDEPTH) * KVBLK); SBAR(); partialSM(pB0, pB1, m_reg, mnB, alB, C, THRS);
    __syncthreads(); SWAIT(); SWRITE(0, SE);
    RESC(alB); __syncthreads();
    SBAR(); qkt192_lq(pA0, pA1, K_lds, qr8, Qs, lane, r32, hi);
    finishSM(pB0, pB1, alB, l_reg, pa0, pa1, pa2, pa3); SBAR();
    SLOADK(SE, (j + 1 + SDEPTH) * KVBLK); SBAR();
    pv_d0(o, vb0 + SHM_V, pa0, pa1, pa2, pa3); SBAR(); SLOADV(SE, (j + 1 + SDEPTH) * KVBLK); SBAR(); partialSM(pA0, pA1, m_reg, mnA, alA, C, THRS);
    __syncthreads(); SWAIT(); SWRITE(1, SO);
    RESC(alA); __syncthreads();
  }
  SBAR(); qkt192_lq(pB0, pB1, K_lds + SHM_K, qr8, Qs, lane, r32, hi);
  finishSM(pA0, pA1, alA, l_reg, pa0, pa1, pa2, pa3); SBAR();
  pv_d0(o, vb0, pa0, pa1, pa2, pa3); partialSM(pB0, pB1, m_reg, mnB, alB, C, THRS);
  __syncthreads(); RESC(alB);
  finishSM(pB0, pB1, alB, l_reg, pa0, pa1, pa2, pa3); SBAR();
  pv_d0(o, vb0 + SHM_V, pa0, pa1, pa2, pa3);
  if (hi == 0) li_l[r32] = l_reg; asm volatile("s_waitcnt lgkmcnt(0)" ::: "memory");
  float rli[16];
#pragma unroll
  for (int r = 0; r < 16; ++r) rli[r] = __builtin_amdgcn_rcpf(li_l[crow(r, hi)]);
  float* Ow = Ob + (long)(wid * QBLK) * LDO;
#pragma unroll
  for (int r = 0; r < 16; ++r) { const int orow = crow(r, hi);
#pragma unroll
    for (int d0 = 0; d0 < 4; ++d0) Ow[(long)orow * LDO + d0 * 32 + r32] = o[d0][r] * rli[r]; }
  __syncthreads();
#undef SLOAD
#undef SLOADK
#undef SLOADV
#undef SWRITE
#undef SWAIT
#undef RESC
}

template <int DQK, int LDQ, int LDK, int LDO>
__device__ __forceinline__ void attn_simple_body(const bf16* __restrict__ Qb, const bf16* __restrict__ Kh, const bf16* __restrict__ Kr, const bf16* __restrict__ Vh,
                                                 const float* __restrict__ cs_rows, float* __restrict__ Ob, int seq, const float scale, ATT_LAS char* lds) {
  constexpr int SHM_V = KVBLK * DV * 2, SHM_K = KVBLK * DQK * 2, RB = DQK * 2, NQ = DQK / 16;
  constexpr bool ROPE = (DQK == 192);
  const float C = scale * LOG2E, THRS = 8.f / scale;
  int tid_ = threadIdx.x; asm volatile("" : "+v"(tid_));
  const int tid = tid_, wid = tid >> 6, lane = tid & 63, r32 = lane & 31, hi = lane >> 5;
  ATT_LAS char* V_lds = lds; ATT_LAS char* K_lds = lds + 2 * SHM_V;
  ATT_LAS float* ws = (ATT_LAS float*)(lds + 2 * SHM_V + 2 * SHM_K) + wid * 64; ATT_LAS float* li_l = ws; ATT_LAS float* al_l = ws + 32;
  float m_reg = -1e30f, l_reg = 0; f32x16 o[4] = {}; bf16x8 qr[NQ];
  const bf16* Qw = Qb + (long)(wid * QBLK + r32) * LDQ + hi * 8;
#pragma unroll
  for (int d0 = 0; d0 < NQ; ++d0) qr[d0] = *(const ATT_GAS bf16x8*)(Qw + d0 * 16);
  if constexpr (ROPE) {
    const float* cs = cs_rows + (long)(wid * QBLK + r32) * 64 + hi * 8;
#pragma unroll
    for (int g = 0; g < 2; ++g) {
      const f32x4 c0 = *(const ATT_GAS f32x4*)(cs + g * 16), c1 = *(const ATT_GAS f32x4*)(cs + g * 16 + 4);
      const f32x4 s0 = *(const ATT_GAS f32x4*)(cs + 32 + g * 16), s1 = *(const ATT_GAS f32x4*)(cs + 32 + g * 16 + 4);
      float y1[8], y2[8];
#pragma unroll
      for (int j = 0; j < 8; ++j) { const float co = j < 4 ? c0[j & 3] : c1[j & 3], si = j < 4 ? s0[j & 3] : s1[j & 3];
        const float x1 = bf2f(qr[8 + g][j]), x2 = bf2f(qr[10 + g][j]); y1[j] = x1 * co - x2 * si; y2[j] = x1 * si + x2 * co; }
      u32x4 w1 = {cvtpk(y1[0], y1[1]), cvtpk(y1[2], y1[3]), cvtpk(y1[4], y1[5]), cvtpk(y1[6], y1[7])};
      u32x4 w2 = {cvtpk(y2[0], y2[1]), cvtpk(y2[2], y2[3]), cvtpk(y2[4], y2[5]), cvtpk(y2[6], y2[7])};
      qr[8 + g] = *reinterpret_cast<bf16x8*>(&w1); qr[10 + g] = *reinterpret_cast<bf16x8*>(&w2);
    }
  }
  const int sr = tid >> 4, sc = (tid & 15) * 8, vst0 = v_st(sr, sc), vst1 = v_st(32 + sr, sc);
  const int rr = tid >> 3, rc = (tid & 7) * 8;
  const int vb0 = (int)(unsigned)(uintptr_t)V_lds + v_rd_base(lane);
  bf16x8 vs0, vs1, ks0, ks1, kr;
#define SLOAD(k0) do { vs0 = *(const ATT_GAS bf16x8*)(&Vh[(long)((k0) + sr) * LDK + sc]); vs1 = *(const ATT_GAS bf16x8*)(&Vh[(long)((k0) + 32 + sr) * LDK + sc]); \
    ks0 = *(const ATT_GAS bf16x8*)(&Kh[(long)((k0) + sr) * LDK + sc]); ks1 = *(const ATT_GAS bf16x8*)(&Kh[(long)((k0) + 32 + sr) * LDK + sc]); \
    if constexpr (ROPE) kr = *(const ATT_GAS bf16x8*)(&Kr[(long)((k0) + rr) * 64 + rc]); } while (0)
#define SWRITE(b) do { *reinterpret_cast<ATT_LAS bf16x8*>(V_lds + (b) * SHM_V + vst0) = vs0;          \
    *reinterpret_cast<ATT_LAS bf16x8*>(V_lds + (b) * SHM_V + vst1) = vs1; const int kc = sc * 2;               \
    *reinterpret_cast<ATT_LAS bf16x8*>(K_lds + (b) * SHM_K + kswz<RB>(sr, kc)) = ks0;                       \
    *reinterpret_cast<ATT_LAS bf16x8*>(K_lds + (b) * SHM_K + kswz<RB>(32 + sr, kc)) = ks1;                  \
    if constexpr (ROPE) *reinterpret_cast<ATT_LAS bf16x8*>(K_lds + (b) * SHM_K + kswz<RB>(rr, 256 + rc * 2)) = kr; } while (0)
#define RESC(a) do { if (__any((a) < 1.f)) { if (hi == 0) al_l[r32] = (a); asm volatile("s_waitcnt lgkmcnt(0)" ::: "memory"); \
    _Pragma("unroll") for (int d = 0; d < 4; ++d) _Pragma("unroll") for (int r = 0; r < 16; ++r) o[d][r] *= al_l[crow(r, hi)]; } } while (0)
  const int NT = seq / KVBLK;
  SLOAD(0); SWRITE(0); __syncthreads();
  for (int j = 0; j < NT; ++j) {
    const int b = j & 1;
    if (j + 1 < NT) SLOAD((j + 1) * KVBLK);
    f32x16 p0, p1; float mn, al; bf16x8 pa0, pa1, pa2, pa3;
    SBAR(); qkt<DQK>(p0, p1, K_lds + b * SHM_K, qr, r32, hi);
    partialSM(p0, p1, m_reg, mn, al, C, THRS); RESC(al);
    finishSM(p0, p1, al, l_reg, pa0, pa1, pa2, pa3); SBAR();
    pv_d0(o, vb0 + b * SHM_V, pa0, pa1, pa2, pa3);
    if (j + 1 < NT) SWRITE(b ^ 1);
    __syncthreads();
  }
  if (hi == 0) li_l[r32] = l_reg; asm volatile("s_waitcnt lgkmcnt(0)" ::: "memory");
  float rli[16];
#pragma unroll
  for (int r = 0; r < 16; ++r) rli[r] = __builtin_amdgcn_rcpf(li_l[crow(r, hi)]);
  float* Ow = Ob + (long)(wid * QBLK) * LDO;
#pragma unroll
  for (int r = 0; r < 16; ++r) { const int orow = crow(r, hi);
#pragma unroll
    for (int d0 = 0; d0 < 4; ++d0) Ow[(long)orow * LDO + d0 * 32 + r32] = o[d0][r] * rli[r]; }
  __syncthreads();
#undef SLOAD
#undef SWRITE
#undef RESC
}

template <int LDQ, int LDK, int LDO>
__device__ __forceinline__ void attn_dma_body(const bf16* __restrict__ Qb, const bf16* __restrict__ Kh, const bf16* __restrict__ Kr, const bf16* __restrict__ Vh,
                                              const float* __restrict__ cs_rows, float* __restrict__ Ob, int seq, const float scale, ATT_LAS char* lds) {
  constexpr int DQK = 192, SHM_V = KVBLK * DV * 2, SHM_K = KVBLK * DQK * 2, STG = SHM_K + SHM_V, RB = DQK * 2, NQ = DQK / 16;
  const float C = scale * LOG2E, THRS = 8.f / scale;
  int tid_ = threadIdx.x; asm volatile("" : "+v"(tid_));
  const int tid = tid_, wid = __builtin_amdgcn_readfirstlane(tid >> 6), lane = tid & 63, r32 = lane & 31, hi = lane >> 5;
  ATT_LAS float* ws = (ATT_LAS float*)(lds + 3 * STG) + wid * 64; ATT_LAS float* li_l = ws; ATT_LAS float* al_l = ws + 32;
  float m_reg = -1e30f, l_reg = 0; f32x16 o[4] = {}; bf16x8 qr[NQ];
  const bf16* Qw = Qb + (long)(wid * QBLK + r32) * LDQ + hi * 8;
#pragma unroll
  for (int d0 = 0; d0 < NQ; ++d0) qr[d0] = *(const ATT_GAS bf16x8*)(Qw + d0 * 16);
  { const float* cs = cs_rows + (long)(wid * QBLK + r32) * 64 + hi * 8;
#pragma unroll
    for (int g = 0; g < 2; ++g) {
      const f32x4 c0 = *(const ATT_GAS f32x4*)(cs + g * 16), c1 = *(const ATT_GAS f32x4*)(cs + g * 16 + 4);
      const f32x4 s0 = *(const ATT_GAS f32x4*)(cs + 32 + g * 16), s1 = *(const ATT_GAS f32x4*)(cs + 32 + g * 16 + 4);
      float y1[8], y2[8];
#pragma unroll
      for (int j = 0; j < 8; ++j) { const float co = j < 4 ? c0[j & 3] : c1[j & 3], si = j < 4 ? s0[j & 3] : s1[j & 3];
        const float x1 = bf2f(qr[8 + g][j]), x2 = bf2f(qr[10 + g][j]); y1[j] = x1 * co - x2 * si; y2[j] = x1 * si + x2 * co; }
      u32x4 w1 = {cvtpk(y1[0], y1[1]), cvtpk(y1[2], y1[3]), cvtpk(y1[4], y1[5]), cvtpk(y1[6], y1[7])};
      u32x4 w2 = {cvtpk(y2[0], y2[1]), cvtpk(y2[2], y2[3]), cvtpk(y2[4], y2[5]), cvtpk(y2[6], y2[7])};
      qr[8 + g] = *reinterpret_cast<bf16x8*>(&w1); qr[10 + g] = *reinterpret_cast<bf16x8*>(&w2);
    } }
  const char* ksrc[3]; int kstep[3];
#pragma unroll
  for (int d = 0; d < 3; ++d) { const int p = (wid * 3 + d) * 64 + lane, row = p / 24, cpos = p - row * 24, c = cpos ^ (row & 7);
    if (c < 16) { ksrc[d] = (const char*)(Kh + (long)row * LDK + c * 8); kstep[d] = KVBLK * LDK * 2; } else { ksrc[d] = (const char*)(Kr + (long)row * 64 + (c - 16) * 8); kstep[d] = KVBLK * 64 * 2; } }
  const char* vsrc[2];
#pragma unroll
  for (int d = 0; d < 2; ++d) { const int p = (wid * 2 + d) * 64 + lane, sub = p >> 5, q = p & 31, kk = (sub >> 2) * 8 + (q >> 2), col = (sub & 3) * 32 + (q & 3) * 8;
    const int key = (kk & ~0xC) | ((kk & 4) << 1) | ((kk & 8) >> 1); vsrc[d] = (const char*)(Vh + (long)key * LDK + col); }
#define DMA_TILE(t, stg) do { ATT_LAS char* sb_ = lds + (stg) * STG; \
    _Pragma("unroll") for (int d = 0; d < 3; ++d) __builtin_amdgcn_global_load_lds((const unsigned*)(ksrc[d] + (long)(t) * kstep[d]), (ATT_LAS unsigned*)(sb_ + (wid * 3 + d) * 1024), 16, 0, 0); \
    _Pragma("unroll") for (int d = 0; d < 2; ++d) __builtin_amdgcn_global_load_lds((const unsigned*)(vsrc[d] + (long)(t) * (KVBLK * LDK * 2)), (ATT_LAS unsigned*)(sb_ + SHM_K + (wid * 2 + d) * 1024), 16, 0, 0); } while (0)
#define RESC(a) do { if (__any((a) < 1.f)) { if (hi == 0) al_l[r32] = (a); asm volatile("s_waitcnt lgkmcnt(0)" ::: "memory"); \
    _Pragma("unroll") for (int d = 0; d < 4; ++d) _Pragma("unroll") for (int r = 0; r < 16; ++r) o[d][r] *= al_l[crow(r, hi)]; } } while (0)
  const int NT = seq / KVBLK, vbase = (int)(unsigned)(uintptr_t)lds + SHM_K + v_rd_base(lane);
  asm volatile("s_waitcnt vmcnt(0)" ::: "memory");
  DMA_TILE(0, 0); DMA_TILE(1, 1);
  asm volatile("s_waitcnt vmcnt(5)" ::: "memory"); __builtin_amdgcn_s_barrier(); asm volatile("" ::: "memory");
  int stg = 0;
  for (int j = 0; j < NT; ++j) {
    const int stg2 = stg >= 1 ? stg - 1 : 2;
    if (j + 2 < NT) DMA_TILE(j + 2, stg2);
    f32x16 p0, p1; float mn, al; bf16x8 pa0, pa1, pa2, pa3;
    SBAR(); qkt<DQK>(p0, p1, lds + stg * STG, qr, r32, hi);
    partialSM(p0, p1, m_reg, mn, al, C, THRS); RESC(al);
    finishSM(p0, p1, al, l_reg, pa0, pa1, pa2, pa3); SBAR();
    pv_d0(o, vbase + stg * STG, pa0, pa1, pa2, pa3);
    if (j + 2 < NT) asm volatile("s_waitcnt vmcnt(5)" ::: "memory"); else asm volatile("s_waitcnt vmcnt(0)" ::: "memory");
    asm volatile("s_waitcnt lgkmcnt(0)" ::: "memory"); __builtin_amdgcn_s_barrier(); asm volatile("" ::: "memory");
    stg = stg == 2 ? 0 : stg + 1;
  }
  if (hi == 0) li_l[r32] = l_reg; asm volatile("s_waitcnt lgkmcnt(0)" ::: "memory");
  float rli[16];
#pragma unroll
  for (int r = 0; r < 16; ++r) rli[r] = __builtin_amdgcn_rcpf(li_l[crow(r, hi)]);
  float* Ow = Ob + (long)(wid * QBLK) * LDO;
#pragma unroll
  for (int r = 0; r < 16; ++r) { const int orow = crow(r, hi);
#pragma unroll
    for (int d0 = 0; d0 < 4; ++d0) Ow[(long)orow * LDO + d0 * 32 + r32] = o[d0][r] * rli[r]; }
  __syncthreads();
#undef DMA_TILE
#undef RESC
}

template <int LDP>
__device__ __forceinline__ void dil_wave_unit(const bf16* __restrict__ P, int qc, int kc, int vc, int d, int r, int t0, int nT,
                                              float* __restrict__ O, int oc, float* __restrict__ ST  ,
                                              ATT_LAS char* vlds  , const ATT_LAS float* bias2, const float C, int lane_) {
  int lane = lane_; asm volatile("" : "+v"(lane));
  const int r32 = lane & 31, hi = lane >> 5;
  bf16x8 qr[8];
  { const bf16* qp = P + (long)(r + d * (t0 + r32)) * LDP + qc + hi * 8;
#pragma unroll
    for (int d0 = 0; d0 < 8; ++d0) qr[d0] = *(const ATT_GAS bf16x8*)(qp + d0 * 16); }
  bf16x8 kf[2][8];
#define DIL_LDK(kb, set) do { int kt_ = t0 - 64 + (kb) * 32 + r32; kt_ = kt_ < 0 ? 0 : (kt_ > nT - 1 ? nT - 1 : kt_); \
    const bf16* kp_ = P + (long)(r + d * kt_) * LDP + kc + hi * 8; \
    _Pragma("unroll") for (int d0 = 0; d0 < 8; ++d0) kf[set][d0] = *(const ATT_GAS bf16x8*)(kp_ + d0 * 16); } while (0)
  DIL_LDK(0, 0);
  f32x16 p[5];
#pragma unroll
  for (int kb = 0; kb < 5; ++kb) {
    if (kb + 1 < 5) DIL_LDK(kb + 1, (kb + 1) & 1);
    p[kb] = f32x16{};
#pragma unroll
    for (int d0 = 0; d0 < 8; ++d0) p[kb] = __builtin_amdgcn_mfma_f32_32x32x16_bf16(kf[kb & 1][d0], qr[d0], p[kb], 0, 0, 0);
  }
#undef DIL_LDK
  bf16x8 vv[2][8];
#define DIL_LDV(kb, set) do { _Pragma("unroll") for (int i = 0; i < 8; ++i) { const int id = lane + 64 * i, row = id >> 4, c = (id & 15) * 8; \
      int kt_ = t0 - 64 + (kb) * 32 + row; kt_ = kt_ < 0 ? 0 : (kt_ > nT - 1 ? nT - 1 : kt_); \
      vv[set][i] = *(const ATT_GAS bf16x8*)(P + (long)(r + d * kt_) * LDP + vc + c); } } while (0)
  DIL_LDV(0, 0);
  float m = -1e30f;
  { const int a_ = 4 * hi - r32 + 32, k_ = a_ & 3; const ATT_LAS f32x4* tp = (const ATT_LAS f32x4*)(bias2 + k_ * 196 + (a_ - k_));
    const bool interior = (t0 >= 64) && (t0 + 96 <= nT);
#pragma unroll
    for (int kb = 0; kb < 5; ++kb)
#pragma unroll
      for (int g = 0; g < 4; ++g) { const f32x4 bv = tp[kb * 8 + 2 * g];
#pragma unroll
        for (int e = 0; e < 4; ++e) { const int rg = 4 * g + e; float s = fmaf(p[kb][rg], C, bv[e]);
          if (!interior) { const int kt = t0 - 64 + kb * 32 + crow(rg, hi); s = (kt >= 0 && kt < nT) ? s : -1e30f; }
          p[kb][rg] = s; m = fmaxf(m, s); } } }
  { auto rr = __builtin_amdgcn_permlane32_swap(__float_as_uint(m), __float_as_uint(m), false, false); m = fmaxf(__uint_as_float(rr[0]), __uint_as_float(rr[1])); }
  float Z = 0.f;
#pragma unroll
  for (int kb = 0; kb < 5; ++kb)
#pragma unroll
    for (int rg = 0; rg < 16; ++rg) { p[kb][rg] = __builtin_amdgcn_exp2f(p[kb][rg] - m); Z += p[kb][rg]; }
  { auto rr = __builtin_amdgcn_permlane32_swap(__float_as_uint(Z), __float_as_uint(Z), false, false); Z = __uint_as_float(rr[0]) + __uint_as_float(rr[1]); }
  bf16x8 pa[5][2];
#pragma unroll
  for (int kb = 0; kb < 5; ++kb) { ATT_PK4(p[kb], 0, pa[kb][0]); ATT_PK4(p[kb], 8, pa[kb][1]); }
  f32x16 o[4] = {};
  const int vb = (int)(unsigned)(uintptr_t)vlds + v_rd_base(lane);
#pragma unroll
  for (int kb = 0; kb < 5; ++kb) {
    if (kb + 1 < 5) DIL_LDV(kb + 1, (kb + 1) & 1);
#pragma unroll
    for (int i = 0; i < 8; ++i) { const int id = lane + 64 * i, row = id >> 4, c = (id & 15) * 8;
      *reinterpret_cast<ATT_LAS bf16x8*>(vlds + v_st(row, c)) = vv[kb & 1][i]; }
    asm volatile("s_waitcnt lgkmcnt(0)" ::: "memory"); SBAR();
    pv32_one<0>(o[0], vb, pa[kb][0], pa[kb][1]); pv32_one<1>(o[1], vb, pa[kb][0], pa[kb][1]); pv32_one<2>(o[2], vb, pa[kb][0], pa[kb][1]); pv32_one<3>(o[3], vb, pa[kb][0], pa[kb][1]);
    SBAR();
  }
#undef DIL_LDV
#pragma unroll
  for (int rg = 0; rg < 16; ++rg) { const long row = r + d * (t0 + crow(rg, hi));
#pragma unroll
    for (int d0 = 0; d0 < 4; ++d0) O[row * 768 + oc + d0 * 32 + r32] = o[d0][rg]; }
  if (hi == 0) { const long row = r + d * (t0 + r32); typedef float f32x2_ __attribute__((ext_vector_type(2))); *(ATT_GAS f32x2_*)(ST + row * 12) = (f32x2_){m, Z}; }
}
template <int LDP>
__device__ __forceinline__ void dil_wg_unit(const bf16* __restrict__ P, int qc, int kc, int vc, int d, int r, int T0, int nT,
                                            float* __restrict__ O, int oc, float* __restrict__ ST, ATT_LAS char* lds, const ATT_LAS float* bias2, const float C) {
  int tid_ = threadIdx.x; asm volatile("" : "+v"(tid_));
  const int tid = tid_, wid = __builtin_amdgcn_readfirstlane(tid >> 6), lane = tid & 63, r32 = lane & 31, hi = lane >> 5, t0 = T0 + 32 * wid;
  { bf16x8 kk[12];
#pragma unroll
    for (int i = 0; i < 12; ++i) { const int id = tid + 512 * i, row = id >> 4, c = (id & 15) * 8; int kt = T0 - 64 + row; kt = kt < 0 ? 0 : (kt > nT - 1 ? nT - 1 : kt);
      kk[i] = *(const ATT_GAS bf16x8*)(P + (long)(r + d * kt) * LDP + kc + c); }
#pragma unroll
    for (int i = 0; i < 12; ++i) { const int id = tid + 512 * i, row = id >> 4, cB = (id & 15) * 16;
      *reinterpret_cast<ATT_LAS bf16x8*>(lds + kswz<256>(row, cB)) = kk[i]; } }
  bf16x8 qr[8];
  { const bf16* qp = P + (long)(r + d * (t0 + r32)) * LDP + qc + hi * 8;
#pragma unroll
    for (int d0 = 0; d0 < 8; ++d0) qr[d0] = *(const ATT_GAS bf16x8*)(qp + d0 * 16); }
  __syncthreads();
  bf16x8 vv[12];
#pragma unroll
  for (int i = 0; i < 12; ++i) { const int id = tid + 512 * i, row = id >> 4, c = (id & 15) * 8; int kt = T0 - 64 + row; kt = kt < 0 ? 0 : (kt > nT - 1 ? nT - 1 : kt);
    vv[i] = *(const ATT_GAS bf16x8*)(P + (long)(r + d * kt) * LDP + vc + c); }
  f32x16 p[5];
#pragma unroll
  for (int kb = 0; kb < 5; ++kb) { const int krow = 32 * wid + 32 * kb + r32;
    p[kb] = f32x16{};
#pragma unroll
    for (int d0 = 0; d0 < 8; ++d0) { const bf16x8 kf = *reinterpret_cast<const ATT_LAS bf16x8*>(lds + kswz<256>(krow, (d0 * 16 + hi * 8) * 2));
      p[kb] = __builtin_amdgcn_mfma_f32_32x32x16_bf16(kf, qr[d0], p[kb], 0, 0, 0); } }
  float m = -1e30f;
  { const int a_ = 4 * hi - r32 + 32, k_ = a_ & 3; const ATT_LAS f32x4* tp = (const ATT_LAS f32x4*)(bias2 + k_ * 196 + (a_ - k_));
    const bool interior = (t0 >= 64) && (t0 + 96 <= nT);
#pragma unroll
    for (int kb = 0; kb < 5; ++kb)
#pragma unroll
      for (int g = 0; g < 4; ++g) { const f32x4 bv = tp[kb * 8 + 2 * g];
#pragma unroll
        for (int e = 0; e < 4; ++e) { const int rg = 4 * g + e; float s = fmaf(p[kb][rg], C, bv[e]);
          if (!interior) { const int kt = t0 - 64 + kb * 32 + crow(rg, hi); s = (kt >= 0 && kt < nT) ? s : -1e30f; }
          p[kb][rg] = s; m = fmaxf(m, s); } } }
  { auto rr = __builtin_amdgcn_permlane32_swap(__float_as_uint(m), __float_as_uint(m), false, false); m = fmaxf(__uint_as_float(rr[0]), __uint_as_float(rr[1])); }
  float Z = 0.f;
#pragma unroll
  for (int kb = 0; kb < 5; ++kb)
#pragma unroll
    for (int rg = 0; rg < 16; ++rg) { p[kb][rg] = __builtin_amdgcn_exp2f(p[kb][rg] - m); Z += p[kb][rg]; }
  { auto rr = __builtin_amdgcn_permlane32_swap(__float_as_uint(Z), __float_as_uint(Z), false, false); Z = __uint_as_float(rr[0]) + __uint_as_float(rr[1]); }
  bf16x8 pa[5][2];
#pragma unroll
  for (int kb = 0; kb < 5; ++kb) { ATT_PK4(p[kb], 0, pa[kb][0]); ATT_PK4(p[kb], 8, pa[kb][1]); }
  __syncthreads();
#pragma unroll
  for (int i = 0; i < 12; ++i) { const int id = tid + 512 * i, row = id >> 4, c = (id & 15) * 8;
    *reinterpret_cast<ATT_LAS bf16x8*>(lds + (row >> 5) * 8192 + v_st(row & 31, c)) = vv[i]; }
  __syncthreads();
  f32x16 o[4] = {};
#pragma unroll
  for (int kb = 0; kb < 5; ++kb) { const int vb = (int)(unsigned)(uintptr_t)lds + (wid + kb) * 8192 + v_rd_base(lane);
    pv32_one<0>(o[0], vb, pa[kb][0], pa[kb][1]); pv32_one<1>(o[1], vb, pa[kb][0], pa[kb][1]); pv32_one<2>(o[2], vb, pa[kb][0], pa[kb][1]); pv32_one<3>(o[3], vb, pa[kb][0], pa[kb][1]); }
#pragma unroll
  for (int rg = 0; rg < 16; ++rg) { const long row = r + d * (t0 + crow(rg, hi));
#pragma unroll
    for (int d0 = 0; d0 < 4; ++d0) O[row * 768 + oc + d0 * 32 + r32] = o[d0][rg]; }
  if (hi == 0) { const long row = r + d * (t0 + r32); typedef float f32x2_ __attribute__((ext_vector_type(2))); *(ATT_GAS f32x2_*)(ST + row * 12) = (f32x2_){m, Z}; }
  __syncthreads();
}

#if defined(MLA_DMA) && MLA_DMA == 2
#define MLA_BODY attn_pipe192_body
#elif defined(MLA_DMA) && MLA_DMA
#define MLA_BODY attn_dma_body
#else
template <int LDQ, int LDK, int LDO> __device__ __forceinline__ void attn_simple192(const bf16* Qb, const bf16* Kh, const bf16* Kr, const bf16* Vh, const float* cs, float* Ob, int seq, const float scale, ATT_LAS char* lds) { attn_simple_body<192, LDQ, LDK, LDO>(Qb, Kh, Kr, Vh, cs, Ob, seq, scale, lds); }
#define MLA_BODY attn_simple192
#endif
}
constexpr int S = 8192, D = 2048, NMEM = 256;
constexpr int DIN = 3392, DINP = 3584;
constexpr int PC_DIL = 768, PC_MEM = 3072;
constexpr int QR = 384, KVR = 128, AQ = 512;
constexpr int NUP = 2816;
constexpr int UC_KV = 1280;
constexpr int DFF = 5632, DFE = 7168, NE = 8;
constexpr int MP = 18432;
constexpr float EPS = 1e-6f;
constexpr int NWAVES = 8;

constexpr size_t al256(size_t x) { return (x + 255) / 256 * 256; }
constexpr size_t WS_CTL = 0, CTL_ZERO_BYTES = 1u << 20;
constexpr size_t WS_WIN = WS_CTL + CTL_ZERO_BYTES;
constexpr size_t WS_WUP = WS_WIN + al256((size_t)2 * DINP * D * 2);
constexpr size_t WS_WMEM = WS_WUP + al256((size_t)2 * NUP * AQ * 2);
constexpr size_t WS_WOUT = WS_WMEM + al256((size_t)2 * 1024 * D * 2);
constexpr size_t WS_WGU = WS_WOUT + al256((size_t)2 * D * D * 2);
constexpr size_t WS_WDN = WS_WGU + al256((size_t)2 * DFF * D * 2);
constexpr size_t WS_MGU = WS_WDN + al256((size_t)D * DFF * 2);
constexpr size_t WS_MDN = WS_MGU + al256((size_t)NE * 2 * DFE * D * 2);
constexpr size_t WS_XN = WS_MDN + al256((size_t)NE * D * DFE * 2);
constexpr size_t WS_MEMN = WS_XN + al256((size_t)S * D * 2);
constexpr size_t WS_MEMKV = WS_MEMN + al256((size_t)2 * NMEM * D * 2);
constexpr size_t WS_PROJ = WS_MEMKV + al256((size_t)2 * NMEM * 1024 * 2);
constexpr size_t WS_AQKV = WS_PROJ + al256((size_t)S * DINP * 2);
constexpr size_t WS_KROPE = WS_AQKV + al256((size_t)S * AQ * 2);
constexpr size_t WS_ROPECS = WS_KROPE + al256((size_t)S * 64 * 2);
constexpr size_t WS_QKVM = WS_ROPECS + al256((size_t)S * 64 * 4);
constexpr size_t WS_YPRE = WS_QKVM + al256((size_t)S * NUP * 2);
constexpr size_t WS_DILO = WS_YPRE + al256((size_t)S * D * 4);
constexpr size_t WS_DILS = WS_DILO + al256((size_t)3 * S * 768 * 4);
constexpr size_t WS_Y = WS_DILS + al256((size_t)3 * S * 12 * 4);
constexpr size_t WS_XA = WS_Y + al256((size_t)S * D * 2);
constexpr size_t WS_ROUTE = WS_XA + al256((size_t)S * D * 4);
constexpr size_t WS_XP = WS_ROUTE + al256((size_t)S * 32);
constexpr size_t WS_OUTP = WS_XP + al256((size_t)MP * D * 2);
constexpr size_t WS_ACTP = WS_OUTP + al256((size_t)MP * D * 2);
constexpr size_t WS_END = WS_ACTP + al256((size_t)MP * DFE * 2);
static_assert(WS_END <= 1879048192ull, "workspace map exceeds 4 x the largest input");
constexpr int CW_BAR = 16384;
constexpr int CW_QUEUE = 8192;
constexpr int CW_CNT = 8192 + 256;
constexpr int CW_QUEUE2 = 65536;
constexpr int CW_CVT = 8192 + 320;
constexpr int CW_DONE = 8192 + 384;
constexpr int CW_TILEE = 8192 + 512;
constexpr int RING_BYTES = 131072;
constexpr int LDSCTL_OFF = RING_BYTES, MISC_OFF = LDSCTL_OFF + 320;
constexpr int BIAS_OFF = 132096;
constexpr int LDS_BYTES = 147456;
static_assert(BIAS_OFF >= MISC_OFF + 128 && BIAS_OFF + 3 * 6 * 132 * 4 + 4 * 196 * 4 <= LDS_BYTES, "LDS map");

#define GAS __attribute__((address_space(1)))
#define LAS __attribute__((address_space(3)))
typedef unsigned short bf16;
typedef unsigned v4u __attribute__((ext_vector_type(4)));
typedef unsigned v2u __attribute__((ext_vector_type(2)));
typedef float f32x4 __attribute__((ext_vector_type(4)));
typedef short bf16x8 __attribute__((ext_vector_type(8)));
typedef GAS unsigned gu32;
#define RLX_AGENT __ATOMIC_RELAXED, __HIP_MEMORY_SCOPE_AGENT
#define LDS_WAIT() asm volatile("s_waitcnt lgkmcnt(0)" ::: "memory")
#define VM_WAIT() asm volatile("s_waitcnt vmcnt(0)" ::: "memory")
__device__ __forceinline__ unsigned f2bf(float f) { unsigned u = __builtin_bit_cast(unsigned, f); return (u + 0x7fffu + ((u >> 16) & 1u)) >> 16; }
__device__ __forceinline__ unsigned pk2(float lo, float hi) { return f2bf(lo) | (f2bf(hi) << 16); }
__device__ __forceinline__ float bflo(unsigned w) { return __uint_as_float(w << 16); }
__device__ __forceinline__ float bfhi(unsigned w) { return __uint_as_float(w & 0xffff0000u); }

#define XB_TMO      128
#define XB_XCNT(j)  (256  + 64 * (j))
#define XB_XSUB(j)  (1280 + 64 * (j))
#define XB_XGEN(j)  (2304 + 64 * (j))
#define XB_TOP      3328
#define XB_TOPGEN   3392
#define XCD_BAR_WORDS 3456
#define XB_SPIN_CAP (1u << 18)
__device__ __forceinline__ unsigned xb_ld(unsigned* p)              { return __hip_atomic_load(p, __ATOMIC_RELAXED, __HIP_MEMORY_SCOPE_AGENT); }
__device__ __forceinline__ unsigned xb_add(unsigned* p, unsigned v) { return __hip_atomic_fetch_add(p, v, __ATOMIC_RELAXED, __HIP_MEMORY_SCOPE_AGENT); }
__device__ __forceinline__ unsigned xb_xcc_id() { return (unsigned)__builtin_amdgcn_s_getreg((3 << 11) | 20) & 0xFu; }
#define XB_SPIN(cond, bar) do { unsigned _sp = 0; while (cond) { __builtin_amdgcn_s_sleep(1); \
    if ((++_sp & 255u) == 0u) { if (xb_ld(&(bar)[XB_TMO])) break; if (_sp > XB_SPIN_CAP) { atomicAdd(&(bar)[XB_TMO], 1u); break; } } } } while (0)
struct XcdBarrier { unsigned* bar; unsigned x; volatile LAS unsigned* st; };
__device__ __forceinline__ XcdBarrier xcd_barrier_post(unsigned* bar, volatile LAS unsigned* st) {
    XcdBarrier b; b.bar = bar; b.x = xb_xcc_id(); b.st = st;
    if (threadIdx.x == 0) (void)xb_add(&bar[XB_XCNT(b.x)], 1u);
    return b;
}
__device__ __forceinline__ void xcd_barrier_complete(unsigned* bar, unsigned x, unsigned& nloc, unsigned& nx) {
    const unsigned G = gridDim.x * gridDim.y * gridDim.z;
    unsigned sum, cnt, mine, sp = 0u;
    for (;;) {
        sum = 0u; cnt = 0u; mine = 0u;
#pragma unroll
        for (unsigned j = 0; j < 16; ++j) { const unsigned c = xb_ld(&bar[XB_XCNT(j)]); sum += c; cnt += (c > 0u) ? 1u : 0u; mine = (j == x) ? c : mine; }
        if (sum == G) break;
        __builtin_amdgcn_s_sleep(1);
        if ((++sp & 255u) == 0u) { if (xb_ld(&bar[XB_TMO])) break; if (sp > XB_SPIN_CAP) { atomicAdd(&bar[XB_TMO], 1u); break; } }
    }
    nloc = mine > 0u ? mine : 1u; nx = cnt > 0u ? cnt : 1u;
}
__device__ __forceinline__ void xcd_barrier(const XcdBarrier& b) {
    asm volatile("s_waitcnt vmcnt(0)" ::: "memory");
    __syncthreads();
    if (threadIdx.x == 0) {
        unsigned* bar = b.bar;
        __builtin_amdgcn_s_waitcnt(0);
        unsigned nloc = b.st[0], nx = b.st[1];
        if (nloc == 0u) { xcd_barrier_complete(bar, b.x, nloc, nx); b.st[0] = nloc; b.st[1] = nx; }
        const unsigned old = xb_add(&bar[XB_XSUB(b.x)], 1u);
        const unsigned gen = old / nloc;
        if (old + 1u == (gen + 1u) * nloc) {
            __builtin_amdgcn_fence(__ATOMIC_RELEASE, "agent");
            asm volatile("s_waitcnt vmcnt(0)" ::: "memory");
            const unsigned og = xb_add(&bar[XB_TOP], 1u);
            const unsigned tg = og / nx;
            if (og + 1u == (tg + 1u) * nx) xb_add(&bar[XB_TOPGEN], 1u);
            else XB_SPIN(xb_ld(&bar[XB_TOPGEN]) == tg, bar);
            __builtin_amdgcn_fence(__ATOMIC_ACQUIRE, "agent");
            xb_add(&bar[XB_XGEN(b.x)], 1u);
            asm volatile("s_waitcnt vmcnt(0)" ::: "memory");
        } else {
            XB_SPIN(xb_ld(&bar[XB_XGEN(b.x)]) == gen, bar);
            __builtin_amdgcn_fence(__ATOMIC_ACQUIRE, "agent");
            asm volatile("s_waitcnt vmcnt(0)" ::: "memory");
        }
    }
    __syncthreads();
}

struct Args {
    const float* in[23]; float* out; unsigned char* ws;
    float invf[32];
    int ph_lo, ph_hi, li, rep;
};
struct Frame {
    LAS unsigned char* lds;
    volatile LAS unsigned* MISC;
    gu32* ctl;
    int tid, lane, wave, G, gw, NGW;
    unsigned char* ws;
};
__device__ __forceinline__ float wave_sum(float v) {
#pragma unroll
    for (int o = 1; o < 64; o <<= 1) v += __shfl_xor(v, o);
    return v;
}
__device__ __forceinline__ float wave_max(float v) {
#pragma unroll
    for (int o = 1; o < 64; o <<= 1) v = fmaxf(v, __shfl_xor(v, o));
    return v;
}

__device__ __forceinline__ unsigned pk4_fp8(float a, float b, float c, float d) { int w = 0; w = __builtin_amdgcn_cvt_pk_fp8_f32(a, b, w, false); w = __builtin_amdgcn_cvt_pk_fp8_f32(c, d, w, true); return (unsigned)w; }
__device__ __forceinline__ void cvt_load(const float* __restrict__ W, int N, int k0, int n0, int lane, f32x4 (&v)[8]) {
    const int lr = lane >> 3, lc = (lane & 7) * 4;
#pragma unroll
    for (int i = 0; i < 8; ++i) v[i] = __builtin_nontemporal_load((const GAS f32x4*)(W + (size_t)(k0 + i * 8 + lr) * N + n0 + lc));
}
template <bool FP8>
__device__ __forceinline__ void cvt_finish(const f32x4 (&v)[8], int k0, void* __restrict__ dstv, int ldd, int drow0, int kdst0, LAS float* scr, int lane, float wsc) {
    const int lr = lane >> 3, lc = (lane & 7) * 4;
#pragma unroll
    for (int i = 0; i < 8; ++i) { LAS float* s = scr + (i * 8 + lr) * 33 + lc; s[0] = v[i][0]; s[1] = v[i][1]; s[2] = v[i][2]; s[3] = v[i][3]; }
    LDS_WAIT(); asm volatile("" ::: "memory");
    const int c = lane & 7;
#pragma unroll
    for (int j = 0; j < 4; ++j) { const int n = (lane >> 3) + 8 * j; const LAS float* s = scr + (8 * c) * 33 + n;
        if constexpr (FP8) { v2u o; o.x = pk4_fp8(s[0 * 33] * wsc, s[1 * 33] * wsc, s[2 * 33] * wsc, s[3 * 33] * wsc); o.y = pk4_fp8(s[4 * 33] * wsc, s[5 * 33] * wsc, s[6 * 33] * wsc, s[7 * 33] * wsc);
            __builtin_nontemporal_store(o, (GAS v2u*)((unsigned char*)dstv + (size_t)(drow0 + n) * ldd + kdst0 + k0 + 8 * c)); }
        else { v4u o; o.x = pk2(s[0 * 33], s[1 * 33]); o.y = pk2(s[2 * 33], s[3 * 33]); o.z = pk2(s[4 * 33], s[5 * 33]); o.w = pk2(s[6 * 33], s[7 * 33]);
            __builtin_nontemporal_store(o, (GAS v4u*)((bf16*)dstv + (size_t)(drow0 + n) * ldd + kdst0 + k0 + 8 * c)); } }
    LDS_WAIT(); asm volatile("" ::: "memory");
}
__device__ __forceinline__ int cvt_drow(int mode, int n0, int roff) { return mode == 0 ? n0 + roff : (mode == 1 ? (n0 >> 7) * 256 + (n0 & 127) : (mode == 2 ? (n0 >> 7) * 256 + 128 + (n0 & 127) : (n0 < 576 ? n0 : n0 + 192))); }
template <bool FP8>
__device__ __forceinline__ void cvt_job(Frame& F, const float* W, int K, int N, void* dst, int ldd, int kdst0, int mode, int roff, LAS float* scr, float wsc) {
    const int nnb = N / 32, nitems = (K / 64) * nnb;
    int it = F.gw; if (it >= nitems) return;
    f32x4 va[8], vb[8];
    cvt_load(W, N, (it / nnb) * 64, (it % nnb) * 32, F.lane, va);
    for (;;) {
        const int it1 = it + F.NGW; if (it1 < nitems) cvt_load(W, N, (it1 / nnb) * 64, (it1 % nnb) * 32, F.lane, vb);
        cvt_finish<FP8>(va, (it / nnb) * 64, dst, ldd, cvt_drow(mode, (it % nnb) * 32, roff), kdst0, scr, F.lane, wsc);
        if (it1 >= nitems) break;
        const int it2 = it1 + F.NGW; if (it2 < nitems) cvt_load(W, N, (it2 / nnb) * 64, (it2 % nnb) * 32, F.lane, va);
        cvt_finish<FP8>(vb, (it1 / nnb) * 64, dst, ldd, cvt_drow(mode, (it1 % nnb) * 32, roff), kdst0, scr, F.lane, wsc);
        if (it2 >= nitems) break;
        it = it2;
    }
}
__device__ __forceinline__ void rms_row_to_bf16(const float* xrow, const float* g, bf16* orow, int lane) {
    const GAS f32x4* xr = (const GAS f32x4*)xrow + lane; const GAS f32x4* gr = (const GAS f32x4*)g + lane;
    f32x4 v[8]; float s = 0.f;
#pragma unroll
    for (int j = 0; j < 8; ++j) { v[j] = xr[64 * j]; s += (v[j].x * v[j].x + v[j].y * v[j].y) + (v[j].z * v[j].z + v[j].w * v[j].w); }
    const float rstd = 1.f / sqrtf(wave_sum(s) * (1.f / D) + EPS);
    GAS v2u* o8 = (GAS v2u*)orow + lane;
#pragma unroll
    for (int j = 0; j < 8; ++j) { const f32x4 gg = gr[64 * j]; v2u w; w.x = pk2(v[j].x * rstd * gg.x, v[j].y * rstd * gg.y); w.y = pk2(v[j].z * rstd * gg.z, v[j].w * rstd * gg.w); o8[64 * j] = w; }
}
__device__ __forceinline__ void rms_row_to_fp8(const float* xrow, const float* g, unsigned char* orow, int lane) {
    const GAS f32x4* xr = (const GAS f32x4*)xrow + lane; const GAS f32x4* gr = (const GAS f32x4*)g + lane;
    f32x4 v[8]; float s = 0.f;
#pragma unroll
    for (int j = 0; j < 8; ++j) { v[j] = xr[64 * j]; s += (v[j].x * v[j].x + v[j].y * v[j].y) + (v[j].z * v[j].z + v[j].w * v[j].w); }
    const float rstd = 1.f / sqrtf(wave_sum(s) * (1.f / D) + EPS);
    GAS unsigned* o4 = (GAS unsigned*)orow + lane;
#pragma unroll
    for (int j = 0; j < 8; ++j) { const f32x4 gg = gr[64 * j]; o4[64 * j] = pk4_fp8(v[j].x * rstd * gg.x, v[j].y * rstd * gg.y, v[j].z * rstd * gg.z, v[j].w * rstd * gg.w); }
}
__device__ __forceinline__ void sincos_f64(float ang, float& c, float& s) {
    const double a = (double)ang, twopi = 6.283185307179586476925286766559, inv2pi = 0.15915494309189533576888376337251;
    const double q = __builtin_rint(a * inv2pi); const double r = a - q * twopi;
    const double r2 = r * r; double ss = 1.0, cc = 1.0;
#pragma unroll
    for (int k = 14; k >= 1; --k) { ss = 1.0 - r2 * (1.0 / (double)((2 * k) * (2 * k + 1))) * ss; cc = 1.0 - r2 * (1.0 / (double)((2 * k - 1) * (2 * k))) * cc; }
    s = (float)(r * ss); c = (float)cc;
}
__device__ const unsigned char DIL_BUCKET[3][129] = {
 {11,11,11,11,11,11,11,11,11,11,11,11,11,11,11,10,10,10,10,10,10,10,10,10,10,10,10,10,10,10,10,10,10,10,10,10,10,10,9,9,9,9,9,9,9,9,9,9,9,9,8,8,8,8,8,8,8,7,6,5,4,3,2,1,0,17,18,19,20,21,22,23,24,24,24,24,24,24,24,25,25,25,25,25,25,25,25,25,25,25,25,26,26,26,26,26,26,26,26,26,26,26,26,26,26,26,26,26,26,26,26,26,26,26,27,27,27,27,27,27,27,27,27,27,27,27,27,27,27},
 {13,13,13,13,13,13,13,13,13,13,13,13,13,13,13,13,13,13,13,13,13,13,13,12,12,12,12,12,12,12,12,12,12,12,12,12,12,12,12,12,12,12,11,11,11,11,11,11,11,11,11,11,10,10,10,10,10,10,9,9,9,8,8,4,0,20,24,24,25,25,25,26,26,26,26,26,26,27,27,27,27,27,27,27,27,27,27,28,28,28,28,28,28,28,28,28,28,28,28,28,28,28,28,28,28,28,29,29,29,29,29,29,29,29,29,29,29,29,29,29,29,29,29,29,29,29,29,29,29},
 {15,15,15,15,15,15,15,15,15,15,15,15,15,15,15,15,15,15,15,15,15,15,15,15,15,15,15,15,15,15,14,14,14,14,14,14,14,14,14,14,14,14,14,14,14,13,13,13,13,13,13,13,13,13,12,12,12,12,12,11,11,10,10,9,0,25,26,26,27,27,28,28,28,28,28,29,29,29,29,29,29,29,29,29,30,30,30,30,30,30,30,30,30,30,30,30,30,30,30,31,31,31,31,31,31,31,31,31,31,31,31,31,31,31,31,31,31,31,31,31,31,31,31,31,31,31,31,31,31}};

typedef float f32x2 __attribute__((ext_vector_type(2)));
#ifndef PH_MASK
#define PH_MASK 0xFFFFu
#endif
#ifndef REPEAT_PHASE
#define REPEAT_PHASE -1
#endif
#ifndef ATT_EN
#define ATT_EN 7
#endif
#define PEN(k) ((PH_MASK >> (k)) & 1u)
#ifndef FFN_FP8
#define FFN_FP8 3
#endif
constexpr bool F8D = (FFN_FP8 & 1) != 0, F8M = (FFN_FP8 & 2) != 0;
constexpr int EBD = F8D ? 1 : 2, EBM = F8M ? 1 : 2;
template <bool B> struct Sc { static constexpr float w_gu = B ? 32.f : 1.f, w_dn = B ? 64.f : 1.f, a_sc = B ? 4.f : 1.f, dn = 1.f / (w_dn * a_sc); };
template <bool B> using FfnEpi1 = typename std::conditional<B, pg8::EpiSwiGLU8, pg8::EpiSwiGLU>::type;
template <bool B> struct Epi1Maker;
template <> struct Epi1Maker<true> { static __device__ __forceinline__ pg8::EpiSwiGLU8 make(void* O, int ldc) { return pg8::EpiSwiGLU8{(unsigned char*)O, ldc, 1.f / Sc<true>::w_gu, Sc<true>::a_sc}; } };
template <> struct Epi1Maker<false> { static __device__ __forceinline__ pg8::EpiSwiGLU make(void* O, int ldc) { return pg8::EpiSwiGLU{(unsigned short*)O, ldc}; } };

constexpr int MOE_MAT_ITEMS = 7168, MOE_GU_ITEMS = 16 * MOE_MAT_ITEMS, MOE_NITEMS = 24 * MOE_MAT_ITEMS, MOE_CHUNK = 64, MOE_NCHUNK = MOE_NITEMS / MOE_CHUNK;
struct MoeItem { const float* W; void* dst; int N, k0, n0, ldd, drow0; float wsc; };
typedef const __attribute__((address_space(4))) Args* KArgs;
__device__ __forceinline__ MoeItem moe_item(KArgs ka, unsigned char* ws, int idx) {
    MoeItem m;
    if (idx < MOE_GU_ITEMS) { const int mat = idx / MOE_MAT_ITEMS, local = idx % MOE_MAT_ITEMS, e = mat >> 1, up = mat & 1, kb = local / (DFE / 32), nb = local % (DFE / 32);
        m.W = ka->in[19 + up] + (size_t)e * D * DFE; m.N = DFE; m.k0 = kb * 64; m.n0 = nb * 32; m.dst = ws + WS_MGU + (size_t)e * 2 * DFE * D * EBM; m.ldd = D;
        m.drow0 = (m.n0 >> 7) * 256 + up * 128 + (m.n0 & 127); m.wsc = Sc<F8M>::w_gu; }
    else { const int i2 = idx - MOE_GU_ITEMS, e = i2 / MOE_MAT_ITEMS, local = i2 % MOE_MAT_ITEMS, kb = local / (D / 32), nb = local % (D / 32);
        m.W = ka->in[21] + (size_t)e * DFE * D; m.N = D; m.k0 = kb * 64; m.n0 = nb * 32; m.dst = ws + WS_MDN + (size_t)e * D * DFE * EBM; m.ldd = DFE; m.drow0 = m.n0; m.wsc = Sc<F8M>::w_dn; }
    return m;
}
__device__ __forceinline__ void moe_cvt_chunk(Frame& F, KArgs ka, int c) {
    LAS float* scr = (LAS float*)(F.lds + F.wave * 16384);
    const int i0 = c * MOE_CHUNK + F.wave * 8;
    f32x4 va[8], vb[8], vc[8]; MoeItem ma, mb, mc;
#define MC_L(m, v, i) do { m = moe_item(ka, F.ws, i0 + (i)); cvt_load(m.W, m.N, m.k0, m.n0, F.lane, v); } while (0)
#define MC_F(m, v) cvt_finish<F8M>(v, m.k0, m.dst, m.ldd, m.drow0, 0, scr, F.lane, m.wsc)
    MC_L(ma, va, 0); MC_L(mb, vb, 1); MC_L(mc, vc, 2);
    MC_F(ma, va); MC_L(ma, va, 3); MC_F(mb, vb); MC_L(mb, vb, 4); MC_F(mc, vc); MC_L(mc, vc, 5);
    MC_F(ma, va); MC_L(ma, va, 6); MC_F(mb, vb); MC_L(mb, vb, 7); MC_F(mc, vc); MC_F(ma, va); MC_F(mb, vb);
#undef MC_L
#undef MC_F
}
__device__ __forceinline__ void moe_cvt_fill(Frame& F, KArgs ka, int ph) {
    { int t_ = threadIdx.x; asm volatile("" : "+v"(t_)); F.tid = t_; F.lane = t_ & 63; }
    for (;;) {
        if (F.tid == 0) { unsigned c = MOE_NCHUNK;
            if (ph < 0 || __hip_atomic_load(F.ctl + CW_DONE + ph, RLX_AGENT) < (unsigned)F.G) c = __hip_atomic_fetch_add(F.ctl + CW_CVT + (ph == -2 ? 16 : 0), 1u, RLX_AGENT);
            F.MISC[17] = c; }
        __syncthreads(); const unsigned c = F.MISC[17]; __syncthreads();
        if (c >= (unsigned)MOE_NCHUNK) break;
        moe_cvt_chunk(F, ka, (int)c);
    }
}
#define FILL(ph) do { __syncthreads(); if (F.tid == 0) (void)__hip_atomic_fetch_add(F.ctl + CW_DONE + (ph), 1u, RLX_AGENT); moe_cvt_fill(F, ka, (ph)); } while (0)
#ifndef MLA_DMA
#define MLA_DMA 1
#endif
#ifndef GEMM_SP2
#define GEMM_SP2 1
#endif
constexpr bool SP2V = (GEMM_SP2 != 0);
#ifndef PROBE_ATT
#define PROBE_ATT 7
#endif
#ifndef FILLMASK
#define FILLMASK 7
#endif
constexpr int PH_PER_LAYER = 11, N_PHASES = 1 + 2 * PH_PER_LAYER;
#ifndef MK_N_LAUNCHES
#define MK_N_LAUNCHES 1
#endif
constexpr int N_LAUNCHES = MK_N_LAUNCHES;

__global__ void __launch_bounds__(NWAVES * 64, 2) mk_fwd(Args) {
    KArgs ka = (KArgs)__builtin_amdgcn_kernarg_segment_ptr(); asm volatile("" : "+s"(ka));
#define args (*ka)
    extern __shared__ __attribute__((aligned(16))) unsigned char lds[];
    Frame F;
    F.lds = (LAS unsigned char*)lds;
    F.MISC = (volatile LAS unsigned*)(F.lds + MISC_OFF);
    F.tid = threadIdx.x; F.lane = F.tid & 63; F.wave = __builtin_amdgcn_readfirstlane(F.tid >> 6);
    F.G = gridDim.x; F.gw = blockIdx.x * NWAVES + F.wave; F.NGW = F.G * NWAVES;
    F.ws = args.ws; F.ctl = (gu32*)(args.ws + WS_CTL);
    unsigned char* ws = args.ws;
    for (int u = F.tid; u < (LDS_BYTES - LDSCTL_OFF) / 4; u += NWAVES * 64) ((LAS unsigned*)(F.lds + LDSCTL_OFF))[u] = 0u;
    __syncthreads();
    XcdBarrier bar; bar.bar = (unsigned*)(F.ctl + CW_BAR) + args.li * 4096; bar.x = 0; bar.st = nullptr;
    if (N_LAUNCHES != N_PHASES) bar = xcd_barrier_post((unsigned*)(F.ctl + CW_BAR) + args.li * 4096, F.MISC + 8);
#define GRID_BAR() do { if (N_LAUNCHES != N_PHASES) xcd_barrier(bar); } while (0)
    const int lo = args.ph_lo, hi = args.ph_hi;
#define IN(k) (lo <= (k) && (k) < hi)
#define BOTH(k) (IN(k) && IN((k) + 1))

#define x_in (args.in[0])
#define XN8 ((unsigned char*)(ws + WS_XN))
#define WIN ((bf16*)(ws + WS_WIN))
#define WUP ((bf16*)(ws + WS_WUP))
#define WMEM ((bf16*)(ws + WS_WMEM))
#define WOUT ((bf16*)(ws + WS_WOUT))
#define WGU ((bf16*)(ws + WS_WGU))
#define WDN ((bf16*)(ws + WS_WDN))
#define MGU ((bf16*)(ws + WS_MGU))
#define MDN ((bf16*)(ws + WS_MDN))
#define XN ((bf16*)(ws + WS_XN))
#define MEMN ((bf16*)(ws + WS_MEMN))
#define MEMKV ((bf16*)(ws + WS_MEMKV))
#define PROJ ((bf16*)(ws + WS_PROJ))
#define AQKV ((bf16*)(ws + WS_AQKV))
#define KROPE ((bf16*)(ws + WS_KROPE))
#define ROPECS ((float*)(ws + WS_ROPECS))
#define QKVM ((bf16*)(ws + WS_QKVM))
#define YPRE ((float*)(ws + WS_YPRE))
#define DILO ((float*)(ws + WS_DILO))
#define DILS ((float*)(ws + WS_DILS))
#define Y ((bf16*)(ws + WS_Y))
#define XA ((float*)(ws + WS_XA))
#define ROUTE ((unsigned*)(ws + WS_ROUTE))
#define XP ((bf16*)(ws + WS_XP))
#define OUTP ((bf16*)(ws + WS_OUTP))
#define ACTP ((bf16*)(ws + WS_ACTP))
#define ACT ((bf16*)(ws + WS_ACTP))
#define PHASE_BEGIN() do { int t_ = threadIdx.x; asm volatile("" : "+v"(t_)); F.tid = t_; F.lane = t_ & 63; asm volatile("" : "+s"(ka)); } while (0)

    if (PEN(0) && IN(0)) { PHASE_BEGIN();
        LAS float* scr = (LAS float*)(F.lds + F.wave * 16384);
        { const v4u z = {0u, 0u, 0u, 0u}; const int gt = blockIdx.x * (NWAVES * 64) + F.tid, ngt = F.G * NWAVES * 64;
          for (int l = 0; l < 2; ++l) {
              GAS v4u* w = (GAS v4u*)(WIN + (size_t)l * DINP * D + (size_t)576 * D); for (int i = gt; i < 192 * D / 8; i += ngt) w[i] = z;
              GAS v4u* u = (GAS v4u*)(WUP + (size_t)l * NUP * AQ);
              for (int i = gt; i < NUP * 64; i += ngt) { const int row = i >> 6, c = i & 63; const bool zero = row < 1152 ? (c >= 48) : (row < 1280 ? true : (c < 48)); if (zero) u[i] = z; } } }
        for (int rep = 0; rep < (REPEAT_PHASE == 0 ? 2 : 1); ++rep) {
        for (int l = 0; l < 2; ++l) {
            cvt_job<false>(F, args.in[5] + (size_t)l * D * DIN, D, DIN, WIN + (size_t)l * DINP * D, D, 0, 3, 0, scr, 1.f);
            cvt_job<false>(F, args.in[7] + (size_t)l * QR * 1152, QR, 1152, WUP + (size_t)l * NUP * AQ, AQ, 0, 0, 0, scr, 1.f);
            cvt_job<false>(F, args.in[9] + (size_t)l * KVR * 1536, KVR, 1536, WUP + (size_t)l * NUP * AQ, AQ, QR, 0, UC_KV, scr, 1.f);
            cvt_job<false>(F, args.in[11] + (size_t)l * D * 1024, D, 1024, WMEM + (size_t)l * 1024 * D, D, 0, 0, 0, scr, 1.f);
            cvt_job<false>(F, args.in[13] + (size_t)l * D * D, D, D, WOUT + (size_t)l * D * D, D, 0, 0, 0, scr, 1.f);
        }
        cvt_job<F8D>(F, args.in[15], D, DFF, WGU, D, 0, 1, 0, scr, Sc<F8D>::w_gu);
        cvt_job<F8D>(F, args.in[16], D, DFF, WGU, D, 0, 2, 0, scr, Sc<F8D>::w_gu);
        cvt_job<F8D>(F, args.in[17], DFF, D, WDN, DFF, 0, 0, 0, scr, Sc<F8D>::w_dn);
        }
        { const int* pos = (const int*)args.in[2];
          for (int idx = blockIdx.x * (NWAVES * 64) + F.tid; idx < S * 32; idx += F.G * NWAVES * 64) { const int row = idx >> 5, i = idx & 31;
              const float ang = (float)pos[row] * args.invf[i]; float c, s; sincos_f64(ang, c, s); ROPECS[row * 64 + i] = c; ROPECS[row * 64 + 32 + i] = s; } }
        for (int m = F.gw; m < 2 * NMEM; m += F.NGW) { const int l = m >> 8, r = m & 255; rms_row_to_bf16(args.in[1] + (size_t)r * D, args.in[10] + (size_t)l * D, MEMN + (size_t)m * D, F.lane); }
        for (int m = F.gw; m < S; m += F.NGW) rms_row_to_bf16(x_in + (size_t)m * D, args.in[4], XN + (size_t)m * D, F.lane);
        if (BOTH(0)) GRID_BAR();
    }

    for (int l = 0; l < 2; ++l) {
        const int pb = 1 + l * PH_PER_LAYER;
        if (PEN(1) && IN(pb + 0)) { PHASE_BEGIN();
            { pg8::Gemm g{XN, WIN + (size_t)l * DINP * D, 2 * D, 2 * D, D / 64}; pg8::InProjOrder So; So.so.init(S, DINP, F.G, (int)blockIdx.x); So.nextra = (l == 0) ? 8 : 0; So.A2 = MEMN; So.B2 = WMEM;
              pg8::EpiBf16Sel E{PROJ, DINP, MEMKV, 1024};
              pg8::gemm_phase<pg8::EpiBf16Sel, pg8::InProjOrder, true, SP2V>(F.lds, g, So, E); }
            if (FILLMASK & 1) FILL(pb + 0);
            if (BOTH(pb + 0)) GRID_BAR();
        }
        if (PEN(2) && IN(pb + 1)) { PHASE_BEGIN();
            const float* gq = args.in[6] + l * QR; const float* gkv = args.in[8] + l * KVR;
            for (int m = F.gw; m < S; m += F.NGW) {
                const v4u w = *(const GAS v4u*)(PROJ + (size_t)m * DINP + F.lane * 8);
                float v[8] = {bflo(w.x), bfhi(w.x), bflo(w.y), bfhi(w.y), bflo(w.z), bfhi(w.z), bflo(w.w), bfhi(w.w)};
                float sq = 0.f;
#pragma unroll
                for (int j = 0; j < 8; ++j) sq += v[j] * v[j];
                const float sq_q = wave_sum(F.lane < 48 ? sq : 0.f), sq_kv = wave_sum(F.lane >= 48 ? sq : 0.f);
                const float rstd = F.lane < 48 ? 1.f / sqrtf(sq_q * (1.f / QR) + EPS) : 1.f / sqrtf(sq_kv * (1.f / KVR) + EPS);
                const float* gp = F.lane < 48 ? gq + F.lane * 8 : gkv + (F.lane - 48) * 8;
                const f32x4 g0 = *(const GAS f32x4*)gp, g1 = *(const GAS f32x4*)(gp + 4);
                v4u o; o.x = pk2(v[0] * rstd * g0.x, v[1] * rstd * g0.y); o.y = pk2(v[2] * rstd * g0.z, v[3] * rstd * g0.w);
                o.z = pk2(v[4] * rstd * g1.x, v[5] * rstd * g1.y); o.w = pk2(v[6] * rstd * g1.z, v[7] * rstd * g1.w);
                *(GAS v4u*)(AQKV + (size_t)m * AQ + F.lane * 8) = o;
                const int c = F.lane & 7;
                const v4u kw = *(const GAS v4u*)(PROJ + (size_t)m * DINP + 512 + c * 8);
                float kv[8] = {bflo(kw.x), bfhi(kw.x), bflo(kw.y), bfhi(kw.y), bflo(kw.z), bfhi(kw.z), bflo(kw.w), bfhi(kw.w)};
                float ko[8];
                const float* cs = ROPECS + (size_t)m * 64 + (c & 3) * 8;
#pragma unroll
                for (int j = 0; j < 8; ++j) { const float other = __shfl_xor(kv[j], 4); const float co = cs[j], si = cs[32 + j];
                    ko[j] = (c < 4) ? (kv[j] * co - other * si) : (other * si + kv[j] * co); }
                if (F.lane < 8) { v4u ow; ow.x = pk2(ko[0], ko[1]); ow.y = pk2(ko[2], ko[3]); ow.z = pk2(ko[4], ko[5]); ow.w = pk2(ko[6], ko[7]); *(GAS v4u*)(KROPE + (size_t)m * 64 + c * 8) = ow; }
            }
            if (BOTH(pb + 1)) GRID_BAR();
        }
        if (PEN(3) && IN(pb + 2)) { PHASE_BEGIN();
            pg8::Gemm g{AQKV, WUP + (size_t)l * NUP * AQ, 2 * AQ, 2 * AQ, AQ / 64}; pg8::StaticOrder So; So.init(S, NUP, F.G, (int)blockIdx.x);
            pg8::EpiBf16 E{QKVM, NUP, 1.f};
            pg8::gemm_phase<pg8::EpiBf16, pg8::StaticOrder, true, SP2V>(F.lds, g, So, E);
            if (FILLMASK & 2) FILL(pb + 2);
            if (BOTH(pb + 2)) GRID_BAR();
        }
        if (PEN(4) && IN(pb + 3)) { PHASE_BEGIN();
            LAS float* BIAS = (LAS float*)(F.lds + BIAS_OFF);
            for (int i = F.tid; i < 3 * 6 * 129; i += NWAVES * 64) { const int b = i / (6 * 129), rem = i % (6 * 129), h = rem / 129, j = rem % 129;
                BIAS[(b * 6 + h) * 132 + j] = args.in[3][DIL_BUCKET[b][j] * 6 + h] * att::LOG2E; }
            __syncthreads();
            for (int rep = 0; rep < (REPEAT_PHASE == 4 ? 2 : 1); ++rep) {
            gu32* qhead = F.ctl + CW_QUEUE + 64 * l + 32 * rep + 4 * args.li;
            constexpr int NU_MLA = 6 * 32, NU_MEM = 4 * 32, NU_DIL = 3 * 6 * 32, NU = NU_MLA + NU_MEM + NU_DIL;
#define QPULL(u) do { if (F.tid == 0) F.MISC[16] = __hip_atomic_fetch_add(qhead, 1u, RLX_AGENT); __syncthreads(); u = (int)F.MISC[16]; __syncthreads(); } while (0)
            int u; QPULL(u);
            if ((ATT_EN & 1) && (!args.rep || (PROBE_ATT & 1))) while (u < NU_MLA) {
                const int h = u >> 5, qb = u & 31;
                att::MLA_BODY<NUP, NUP, D>(QKVM + (size_t)qb * 256 * NUP + h * 192, QKVM + UC_KV + h * 256, KROPE, QKVM + UC_KV + h * 256 + 128,
                                                        ROPECS + (size_t)qb * 256 * 64, YPRE + (size_t)qb * 256 * D + h * 128, S, 0.07216878364870322f, (LAS char*)F.lds);
                QPULL(u);
            }
            if (args.rep && !(PROBE_ATT & 1)) { while (u < NU_MLA) QPULL(u); }
            if ((ATT_EN & 2) && (!args.rep || (PROBE_ATT & 2))) while (u < NU_MLA + NU_MEM) {
                const int v = u - NU_MLA, h = v >> 5, qb = v & 31;
                const bf16* kv = MEMKV + (size_t)l * NMEM * 1024;
                att::attn_dense_body<128, DINP, 1024, D, 1>(PROJ + (size_t)qb * 256 * DINP + PC_MEM + h * 128, kv + h * 128, nullptr, kv + 512 + h * 128,
                                                            nullptr, YPRE + (size_t)qb * 256 * D + 1536 + h * 128, NMEM, 0.08838834764831845f, (LAS char*)F.lds);
                QPULL(u);
            }
            if (args.rep && !(PROBE_ATT & 2)) { while (u < NU_MLA + NU_MEM) QPULL(u); }
            if ((ATT_EN & 4) && (!args.rep || (PROBE_ATT & 4))) while (u < NU) {
                const int w = (u - NU_MLA - NU_MEM) * 8;
                const int b = w / 1536, h = (w % 1536) >> 8, tile = w & 255;
                const int d = b == 0 ? 1 : (b == 1 ? 4 : 16), nT = S / d, tpr = nT / 32;
                const int r = tile / tpr, t0 = (tile % tpr) * 32;
                LAS float* TB = (LAS float*)(F.lds + BIAS_OFF + 3 * 6 * 132 * 4);
                for (int i = F.tid; i < 4 * 196; i += NWAVES * 64) { const int k = i / 196, j = (i % 196) + k - 32; TB[i] = (j >= 0 && j <= 128) ? BIAS[(b * 6 + h) * 132 + j] : -1e30f; }
                __syncthreads();
                att::dil_wg_unit<DINP>(PROJ, PC_DIL + h * 128, PC_DIL + 768 + h * 128, PC_DIL + 1536 + h * 128, d, r, t0, nT,
                                       DILO + (size_t)b * S * 768, h * 128, DILS + (size_t)b * S * 12 + h * 2, (LAS char*)F.lds, TB, 0.08838834764831845f * att::LOG2E);
                QPULL(u);
            }
#undef QPULL
            }
            if (FILLMASK & 4) FILL(pb + 3);
            if (BOTH(pb + 3)) GRID_BAR();
        }
        if (PEN(5) && IN(pb + 4)) { PHASE_BEGIN();
            const float* gn = args.in[12] + (size_t)l * D;
            for (int m = F.gw; m < S; m += F.NGW) {
                const float* yr = YPRE + (size_t)m * D;
                f32x4 a[3]; float sa = 0.f;
#pragma unroll
                for (int j = 0; j < 3; ++j) { a[j] = *(const GAS f32x4*)(yr + (F.lane + 64 * j) * 4); sa += (a[j].x * a[j].x + a[j].y * a[j].y) + (a[j].z * a[j].z + a[j].w * a[j].w); }
                f32x4 c[2]; float sc = 0.f;
#pragma unroll
                for (int j = 0; j < 2; ++j) { c[j] = *(const GAS f32x4*)(yr + 1536 + (F.lane + 64 * j) * 4); sc += (c[j].x * c[j].x + c[j].y * c[j].y) + (c[j].z * c[j].z + c[j].w * c[j].w); }
                f32x4 bq[3]; float sb = 0.f;
#pragma unroll
                for (int j = 0; j < 3; ++j) { const int col = (F.lane + 64 * j) * 4, h = col >> 7;
                    float mm[3], zz[3];
#pragma unroll
                    for (int b = 0; b < 3; ++b) { const f32x2 st = *(const GAS f32x2*)(DILS + ((size_t)b * S + m) * 12 + h * 2); mm[b] = st.x; zz[b] = st.y; }
                    const float M = fmaxf(mm[0], fmaxf(mm[1], mm[2]));
                    float wgt[3], den = 0.f;
#pragma unroll
                    for (int b = 0; b < 3; ++b) { wgt[b] = __builtin_amdgcn_exp2f(mm[b] - M); den += wgt[b] * zz[b]; }
                    const float inv = 1.f / den; f32x4 acc = {0.f, 0.f, 0.f, 0.f};
#pragma unroll
                    for (int b = 0; b < 3; ++b) { const f32x4 ob = *(const GAS f32x4*)(DILO + ((size_t)b * S + m) * 768 + col); acc += ob * (wgt[b] * inv); }
                    bq[j] = acc; sb += (acc.x * acc.x + acc.y * acc.y) + (acc.z * acc.z + acc.w * acc.w); }
                const float ra = 1.f / sqrtf(wave_sum(sa) * (1.f / 768.f) + EPS), rb = 1.f / sqrtf(wave_sum(sb) * (1.f / 768.f) + EPS), rc = 1.f / sqrtf(wave_sum(sc) * (1.f / 512.f) + EPS);
                bf16* yo = Y + (size_t)m * D;
#pragma unroll
                for (int j = 0; j < 3; ++j) { const int col = (F.lane + 64 * j) * 4; const f32x4 g = *(const GAS f32x4*)(gn + col);
                    v2u w; w.x = pk2(a[j].x * ra * g.x, a[j].y * ra * g.y); w.y = pk2(a[j].z * ra * g.z, a[j].w * ra * g.w); *(GAS v2u*)(yo + col) = w; }
#pragma unroll
                for (int j = 0; j < 3; ++j) { const int col = (F.lane + 64 * j) * 4; const f32x4 g = *(const GAS f32x4*)(gn + 768 + col);
                    v2u w; w.x = pk2(bq[j].x * rb * g.x, bq[j].y * rb * g.y); w.y = pk2(bq[j].z * rb * g.z, bq[j].w * rb * g.w); *(GAS v2u*)(yo + 768 + col) = w; }
#pragma unroll
                for (int j = 0; j < 2; ++j) { const int col = (F.lane + 64 * j) * 4; const f32x4 g = *(const GAS f32x4*)(gn + 1536 + col);
                    v2u w; w.x = pk2(c[j].x * rc * g.x, c[j].y * rc * g.y); w.y = pk2(c[j].z * rc * g.z, c[j].w * rc * g.w); *(GAS v2u*)(yo + 1536 + col) = w; }
            }
            if (BOTH(pb + 4)) GRID_BAR();
        }
        if (PEN(6) && IN(pb + 5)) { PHASE_BEGIN();
            pg8::Gemm g{Y, WOUT + (size_t)l * D * D, 2 * D, 2 * D, D / 64}; pg8::StaticOrder So; So.init(S, D, F.G, (int)blockIdx.x);
            pg8::EpiResF32 E{l == 0 ? x_in : XA, args.rep ? YPRE : XA, D, 1.f};
            pg8::gemm_phase<pg8::EpiResF32, pg8::StaticOrder, true, SP2V>(F.lds, g, So, E);
            if (BOTH(pb + 5)) GRID_BAR();
        }
        if (PEN(7) && IN(pb + 6)) { PHASE_BEGIN();
            const float* gf = args.in[14] + (size_t)l * D;
#if defined(PROBE_DEADLINE)
            if (l == 1 && blockIdx.x == 0 && F.tid == 0) F.ctl[CW_CVT + 16] = __hip_atomic_load(F.ctl + CW_CVT, RLX_AGENT);
#endif
            if (l == 0) { for (int m = F.gw; m < S; m += F.NGW) { if constexpr (F8D) rms_row_to_fp8(XA + (size_t)m * D, gf, XN8 + (size_t)m * D, F.lane); else rms_row_to_bf16(XA + (size_t)m * D, gf, XN + (size_t)m * D, F.lane); } }
            else {
                const float* Wr = args.in[18];
                for (int m = F.gw; m < S; m += F.NGW) {
                    const GAS f32x4* xr = (const GAS f32x4*)(XA + (size_t)m * D) + F.lane; const GAS f32x4* gr = (const GAS f32x4*)gf + F.lane;
                    f32x4 v[8]; float s = 0.f;
#pragma unroll
                    for (int j = 0; j < 8; ++j) { v[j] = xr[64 * j]; s += (v[j].x * v[j].x + v[j].y * v[j].y) + (v[j].z * v[j].z + v[j].w * v[j].w); }
                    const float rstd = 1.f / sqrtf(wave_sum(s) * (1.f / D) + EPS);
                    float lg[8] = {0.f, 0.f, 0.f, 0.f, 0.f, 0.f, 0.f, 0.f};
                    GAS v2u* o8 = (GAS v2u*)(XN + (size_t)m * D) + F.lane; GAS unsigned* o4 = (GAS unsigned*)(XN8 + (size_t)m * D) + F.lane;
#pragma unroll
                    for (int j = 0; j < 8; ++j) { const f32x4 gg = gr[64 * j]; const f32x4 hh = {v[j].x * rstd * gg.x, v[j].y * rstd * gg.y, v[j].z * rstd * gg.z, v[j].w * rstd * gg.w};
                        if constexpr (F8M) o4[64 * j] = pk4_fp8(hh.x, hh.y, hh.z, hh.w); else { v2u w; w.x = pk2(hh.x, hh.y); w.y = pk2(hh.z, hh.w); o8[64 * j] = w; }
                        const float* wr = Wr + (size_t)((F.lane + 64 * j) * 4) * NE;
#pragma unroll
                        for (int q = 0; q < 4; ++q) { const f32x4 w0 = *(const GAS f32x4*)(wr + q * NE), w1 = *(const GAS f32x4*)(wr + q * NE + 4); const float hv = hh[q];
                            lg[0] += hv * w0.x; lg[1] += hv * w0.y; lg[2] += hv * w0.z; lg[3] += hv * w0.w; lg[4] += hv * w1.x; lg[5] += hv * w1.y; lg[6] += hv * w1.z; lg[7] += hv * w1.w; } }
#pragma unroll
                    for (int e = 0; e < NE; ++e) lg[e] = wave_sum(lg[e]);
                    int e1 = 0; float v1 = lg[0];
#pragma unroll
                    for (int e = 1; e < NE; ++e) if (lg[e] > v1) { v1 = lg[e]; e1 = e; }
                    int e2 = -1; float v2 = -3.0e38f;
#pragma unroll
                    for (int e = 0; e < NE; ++e) if (e != e1 && lg[e] > v2) { v2 = lg[e]; e2 = e; }
                    const float g1 = 1.f / (1.f + __expf(v2 - v1)), g2 = 1.f - g1;
                    if (F.lane == 0) { const unsigned s1 = __hip_atomic_fetch_add(F.ctl + CW_CNT + e1, 1u, RLX_AGENT), s2 = __hip_atomic_fetch_add(F.ctl + CW_CNT + e2, 1u, RLX_AGENT);
                        v4u r0 = {(unsigned)e1, (unsigned)e2, s1, s2}; v4u r1 = {__float_as_uint(g1), __float_as_uint(g2), 0u, 0u};
                        *(GAS v4u*)(ROUTE + (size_t)m * 8) = r0; *(GAS v4u*)(ROUTE + (size_t)m * 8 + 4) = r1; }
                }
            }
            if (BOTH(pb + 6)) GRID_BAR();
        }
        if (PEN(8) && IN(pb + 7)) { PHASE_BEGIN();
            if (l == 1) {
                moe_cvt_fill(F, ka, -1);
#if defined(PROBE_DEADLINE)
                for (int r_ = 0; r_ < PROBE_DEADLINE; ++r_) { __syncthreads(); moe_cvt_fill(F, ka, -2); }
#endif
                int base[NE]; int tstart = 0;
#pragma unroll
                for (int e = 0; e < NE; ++e) { const int c = (int)__hip_atomic_load(F.ctl + CW_CNT + e, RLX_AGENT); base[e] = tstart * 256; const int nt = (c + 255) >> 8;
                    if (blockIdx.x == 0 && F.tid == 0) { for (int t = 0; t < nt; ++t) F.ctl[CW_TILEE + 1 + tstart + t] = (unsigned)e; }
                    tstart += nt; }
                if (blockIdx.x == 0 && F.tid == 0) F.ctl[CW_TILEE] = (unsigned)tstart;
                for (int m = F.gw; m < S; m += F.NGW) {
                    const v4u r0 = *(const GAS v4u*)(ROUTE + (size_t)m * 8);
                    int p1 = (int)r0.z, p2 = (int)r0.w;
#pragma unroll
                    for (int e = 0; e < NE; ++e) { if ((int)r0.x == e) p1 += base[e]; if ((int)r0.y == e) p2 += base[e]; }
                    if (F.lane == 0) { ROUTE[(size_t)m * 8 + 6] = (unsigned)p1; ROUTE[(size_t)m * 8 + 7] = (unsigned)p2; }
                    const unsigned char* srow = (const unsigned char*)XN8 + (size_t)m * D * EBM; unsigned char* xp = (unsigned char*)XP;
                    const GAS v4u* src = (const GAS v4u*)srow + F.lane; GAS v4u* d1 = (GAS v4u*)(xp + (size_t)p1 * D * EBM) + F.lane; GAS v4u* d2 = (GAS v4u*)(xp + (size_t)p2 * D * EBM) + F.lane;
#pragma unroll
                    for (int j = 0; j < 2 * EBM; ++j) { const v4u t = src[64 * j]; d1[64 * j] = t; d2[64 * j] = t; }
                }
            }
            if (BOTH(pb + 7) && l == 1) GRID_BAR();
        }
        if (PEN(9) && IN(pb + 8)) { PHASE_BEGIN();
            if (l == 0) { pg8::Gemm g{XN8, WGU, D * EBD, D * EBD, D * EBD / 128}; pg8::StaticOrder So; So.init(S, 2 * DFF, F.G, (int)blockIdx.x);
                FfnEpi1<F8D> E = Epi1Maker<F8D>::make(ACT, DFF);
                pg8::gemm_phase<FfnEpi1<F8D>, pg8::StaticOrder, true, SP2V, F8D>(F.lds, g, So, E); }
            else { const int ntile = (int)__hip_atomic_load(F.ctl + CW_TILEE, RLX_AGENT);
                pg8::Gemm g{XP, MGU, D * EBM, D * EBM, D * EBM / 128}; pg8::MoeOrder So{F.G, (int)blockIdx.x, 2 * DFE / 256, ntile, 2 * DFE, (const int*)(F.ctl + CW_TILEE + 1)};
                FfnEpi1<F8M> E = Epi1Maker<F8M>::make(ACTP, DFE);
                pg8::gemm_phase<FfnEpi1<F8M>, pg8::MoeOrder, true, SP2V, F8M>(F.lds, g, So, E); }
            if (BOTH(pb + 8)) GRID_BAR();
        }
        if (PEN(10) && IN(pb + 9)) { PHASE_BEGIN();
            if (l == 0) { pg8::Gemm g{ACT, WDN, DFF * EBD, DFF * EBD, DFF * EBD / 128}; pg8::StaticOrder So; So.init(S, D, F.G, (int)blockIdx.x);
                pg8::EpiResF32 E{XA, args.rep ? YPRE : XA, D, Sc<F8D>::dn};
                pg8::gemm_phase<pg8::EpiResF32, pg8::StaticOrder, true, SP2V, F8D>(F.lds, g, So, E); }
            else { const int ntile = (int)__hip_atomic_load(F.ctl + CW_TILEE, RLX_AGENT);
                pg8::Gemm g{ACTP, MDN, DFE * EBM, DFE * EBM, DFE * EBM / 128}; pg8::MoeOrder So{F.G, (int)blockIdx.x, D / 256, ntile, D, (const int*)(F.ctl + CW_TILEE + 1)};
                pg8::EpiBf16 E{OUTP, D, Sc<F8M>::dn};
                pg8::gemm_phase<pg8::EpiBf16, pg8::MoeOrder, true, SP2V, F8M>(F.lds, g, So, E); }
            if (BOTH(pb + 9)) GRID_BAR();
        }
        if (PEN(11) && IN(pb + 10)) { PHASE_BEGIN();
            if (l == 0) { for (int m = F.gw; m < S; m += F.NGW) rms_row_to_bf16(XA + (size_t)m * D, args.in[4] + D, XN + (size_t)m * D, F.lane); }
            else {
                const float* gfin = args.in[22];
                for (int m = F.gw; m < S; m += F.NGW) {
                    const v4u r1 = *(const GAS v4u*)(ROUTE + (size_t)m * 8 + 4);
                    const float g1 = __uint_as_float(r1.x), g2 = __uint_as_float(r1.y); const int p1 = (int)r1.z, p2 = (int)r1.w;
                    const GAS f32x4* xr = (const GAS f32x4*)(XA + (size_t)m * D) + F.lane;
                    const GAS v2u* o1 = (const GAS v2u*)(OUTP + (size_t)p1 * D) + F.lane; const GAS v2u* o2 = (const GAS v2u*)(OUTP + (size_t)p2 * D) + F.lane;
                    f32x4 v[8]; float s = 0.f;
#pragma unroll
                    for (int j = 0; j < 8; ++j) { const f32x4 xv = xr[64 * j]; const v2u a = o1[64 * j], b = o2[64 * j];
                        v[j].x = xv.x + g1 * bflo(a.x) + g2 * bflo(b.x); v[j].y = xv.y + g1 * bfhi(a.x) + g2 * bfhi(b.x);
                        v[j].z = xv.z + g1 * bflo(a.y) + g2 * bflo(b.y); v[j].w = xv.w + g1 * bfhi(a.y) + g2 * bfhi(b.y);
                        s += (v[j].x * v[j].x + v[j].y * v[j].y) + (v[j].z * v[j].z + v[j].w * v[j].w); }
                    const float rstd = 1.f / sqrtf(wave_sum(s) * (1.f / D) + EPS);
                    GAS f32x4* orow = (GAS f32x4*)(args.out + (size_t)m * D) + F.lane; const GAS f32x4* gr = (const GAS f32x4*)gfin + F.lane;
#pragma unroll
                    for (int j = 0; j < 8; ++j) { const f32x4 gg = gr[64 * j]; orow[64 * j] = (f32x4){v[j].x * rstd * gg.x, v[j].y * rstd * gg.y, v[j].z * rstd * gg.z, v[j].w * rstd * gg.w}; }
                }
            }
            if (BOTH(pb + 10) && l == 0) GRID_BAR();
        }
    }
#undef IN
#undef BOTH
#undef GRID_BAR
#undef WIN
#undef WUP
#undef WMEM
#undef WOUT
#undef WGU
#undef WDN
#undef MGU
#undef MDN
#undef XN
#undef MEMN
#undef MEMKV
#undef PROJ
#undef AQKV
#undef KROPE
#undef ROPECS
#undef QKVM
#undef YPRE
#undef DILO
#undef DILS
#undef Y
#undef XA
#undef ROUTE
#undef XP
#undef OUTP
#undef ACTP
#undef ACT
#undef x_in
#undef XN8
#undef PHASE_BEGIN
#undef args
#undef FILL
}

extern "C" void kernel_launch(void* const* d_in, const int* in_sizes, int n_in, void* d_out, int out_size, void* d_ws, size_t ws_size, hipStream_t stream) {
    static int grid = 0;
    if (grid == 0) {
        if (n_in != 23 || in_sizes[0] != S * D || out_size != S * D || ws_size < WS_END) { fprintf(stderr, "kernel_launch: shape/workspace mismatch: n_in %d in0 %d out %d ws %zu (need %zu)\n", n_in, n_in > 0 ? in_sizes[0] : -1, out_size, ws_size, (size_t)WS_END); grid = -1; return; }
        int dev = 0, cus = 0, per_cu = 0;
        if (hipGetDevice(&dev) != hipSuccess || hipDeviceGetAttribute(&cus, hipDeviceAttributeMultiprocessorCount, dev) != hipSuccess) { fprintf(stderr, "kernel_launch: device query failed\n"); grid = -1; return; }
        if (hipFuncSetAttribute((const void*)mk_fwd, hipFuncAttributeMaxDynamicSharedMemorySize, LDS_BYTES) != hipSuccess) { fprintf(stderr, "kernel_launch: hipFuncSetAttribute failed\n"); grid = -1; return; }
        if (hipOccupancyMaxActiveBlocksPerMultiprocessor(&per_cu, (const void*)mk_fwd, NWAVES * 64, LDS_BYTES) != hipSuccess || per_cu < 1) { fprintf(stderr, "kernel_launch: occupancy query reports %d workgroups per CU\n", per_cu); }
        (void)hipGetLastError();
        grid = cus;
    }
    if (grid < 0) return;
    (void)hipMemsetAsync((char*)d_ws + WS_CTL, 0, CTL_ZERO_BYTES, stream);
    Args a{};
    for (int i = 0; i < 23; ++i) a.in[i] = (const float*)d_in[i];
    a.out = (float*)d_out; a.ws = (unsigned char*)d_ws;
    for (int i = 0; i < 32; ++i) a.invf[i] = 1.0f / powf(10000.0f, (float)i / 32.0f);
    int lo[8], hi[8], rp[8], nl = 0;
#if defined(PROBE_PHASE) && PROBE_PHASE >= 0
    lo[nl] = 0; hi[nl] = PROBE_PHASE + 1; rp[nl++] = 0;
    for (int r = 0; r < PROBE_REPS; ++r) { lo[nl] = PROBE_PHASE; hi[nl] = PROBE_PHASE + 1; rp[nl++] = 1; }
    if (PROBE_PHASE + 1 < N_PHASES) { lo[nl] = PROBE_PHASE + 1; hi[nl] = N_PHASES; rp[nl++] = 0; }
#else
    if (N_LAUNCHES == N_PHASES) { nl = 0; } else { lo[0] = 0; hi[0] = N_PHASES; rp[0] = 0; nl = 1; }
#endif
    const int total = (N_LAUNCHES == N_PHASES) ? N_PHASES : nl;
    for (int li = 0; li < total; ++li) {
        if (N_LAUNCHES == N_PHASES) { a.ph_lo = li; a.ph_hi = li + 1; a.li = 0; a.rep = 0; } else { a.ph_lo = lo[li]; a.ph_hi = hi[li]; a.li = li; a.rep = rp[li]; }
        hipLaunchKernelGGL(mk_fwd, dim3(grid), dim3(NWAVES * 64), LDS_BYTES, stream, a);
        const hipError_t le = hipPeekAtLastError();
        if (le != hipSuccess) { fprintf(stderr, "kernel_launch: launch %d failed: %s\n", li, hipGetErrorName(le)); break; }
    }
}
```

```cpp
#include <hip/hip_runtime.h>
#include <cstdio>
#include <cstdint>
#include <cmath>
#include <type_traits>
#ifndef MK_N_LAUNCHES
#define MK_N_LAUNCHES 1
#endif
#define REPEAT_PHASE -1
#define FFN_FP8 3
#define PROBE_PHASE -1
#define PROBE_REPS 3
#define FILLMASK 7
#define MLA_DMA 0
#define PROBE_ATT 7
#define GEMM_SP2 1
#define MOE_TAIL 1
#define CVT_REG 0
#define CVT_FIRST 1
#define CVT_Q0 8
namespace pg8 {
#define PG8_LAS __attribute__((address_space(3)))
typedef unsigned short bf16_t;
typedef short bf16x8 __attribute__((ext_vector_type(8)));
typedef float f32x4 __attribute__((ext_vector_type(4)));
typedef unsigned u32x4 __attribute__((ext_vector_type(4)));
constexpr int BM = 256, BK = 64, HALF = 128, HTB = HALF * BK * 2  , STAGE_BYTES = 8 * HTB, NXCD = 8, WGM = 8;

__host__ __device__ __forceinline__ int lds_byte(int r, int c) { const int st = (r >> 4) * 2 + (c >> 5), rr = r & 15, cc = c & 31, ob = rr * 64 + cc * 2; return st * 1024 + (ob ^ (((ob >> 9) & 1) << 5)); }
__host__ __device__ __forceinline__ void stage_rc(int b, int& R, int& C) { const int st = b / 1024, sb = b % 1024, swz = sb ^ (((sb >> 9) & 1) << 5); R = (st >> 1) * 16 + swz / 64; C = (st & 1) * 32 + (swz % 64) / 2; }
__host__ __device__ __forceinline__ int perm32(int rho) { const int n = rho >> 4, i = rho & 15; return 8 * (i >> 2) + 4 * n + (i & 3); }

struct Unit { int pm, pn; };
struct Gemm { const void* A; const void* Bt; int lda, ldb, nt; };

struct StaticOrder {
    int nM, nN, nwg, G, c;
    __device__ void init(int M, int N, int G_, int c_) { nM = M / BM; nN = N / BM; nwg = nM * nN; G = G_; c = c_; }
    __device__ bool next(int i, Unit& u) const {
        const long L = (long)i * G + c; if (L >= nwg) return false;
        int wgid = (int)L; { const int q = nwg / NXCD, r = nwg % NXCD, xcd = wgid % NXCD, off = wgid / NXCD; wgid = (xcd < r ? xcd * (q + 1) : r * (q + 1) + (xcd - r) * q) + off; }
        const int nig = WGM * nN, gid = wgid / nig, fm = gid * WGM, gsz = (nM - fm) < WGM ? (nM - fm) : WGM;
        u.pm = fm + ((wgid % nig) % gsz); u.pn = (wgid % nig) / gsz; return true;
    }
    __device__ __forceinline__ const char* abase(const Gemm& g, const Unit& u) const { return (const char*)g.A + (size_t)u.pm * BM * g.lda; }
    __device__ __forceinline__ const char* bbase(const Gemm& g, const Unit& u) const { return (const char*)g.Bt + (size_t)u.pn * BM * g.ldb; }
};
struct InProjOrder {
    StaticOrder so; int nextra; const void* A2; const void* B2;
    __device__ bool next(int i, Unit& u) const { if (so.next(i, u)) return true; const long L = (long)i * so.G + so.c - so.nwg; if (L < 0 || L >= nextra) return false; u.pm = 32 + (int)(L >> 2); u.pn = (int)(L & 3); return true; }
    __device__ __forceinline__ const char* abase(const Gemm& g, const Unit& u) const { return u.pm < 32 ? (const char*)g.A + (size_t)u.pm * BM * g.lda : (const char*)A2 + (size_t)(u.pm - 32) * BM * g.lda; }
    __device__ __forceinline__ const char* bbase(const Gemm& g, const Unit& u) const { return u.pm < 32 ? (const char*)g.Bt + (size_t)u.pn * BM * g.ldb : (const char*)B2 + (size_t)((u.pm - 32) * 1024 + u.pn * BM) * g.ldb; }
};
struct MemOrder {
    int G, c;
    __device__ bool next(int i, Unit& u) const { const int L = c - (G - 8); if (i != 0 || L < 0 || L >= 8) return false; u.pm = L >> 2; u.pn = L & 3; return true; }
    __device__ __forceinline__ const char* abase(const Gemm& g, const Unit& u) const { return (const char*)g.A + (size_t)u.pm * BM * g.lda; }
    __device__ __forceinline__ const char* bbase(const Gemm& g, const Unit& u) const { return (const char*)g.Bt + (size_t)(u.pm * 1024 + u.pn * BM) * g.ldb; }
};
struct MoeOrder {
    int G, c, nN, ntile, nexp_rows; const int* tile_e;
    __device__ bool next(int i, Unit& u) const { const long L = (long)i * G + c; if (L >= (long)ntile * nN) return false; u.pm = (int)(L / nN); u.pn = (int)(L % nN); return true; }
    __device__ __forceinline__ const char* abase(const Gemm& g, const Unit& u) const { return (const char*)g.A + (size_t)u.pm * BM * g.lda; }
    __device__ __forceinline__ const char* bbase(const Gemm& g, const Unit& u) const { const int e = __builtin_amdgcn_readfirstlane(tile_e[u.pm]); return (const char*)g.Bt + ((size_t)e * nexp_rows + (size_t)u.pn * BM) * g.ldb; }
};

struct MoeTailOrder {
    int G, c, pm0, ntail, nexp_rows, kq_bytes; const int* tile_e;
    __device__ bool next(int i, Unit& u) const { const long L = (long)i * G + c; if (L >= (long)ntail * 32) return false; const int ks = (int)(L & 3), rest = (int)(L >> 2); u.pm = pm0 + (rest >> 3); u.pn = (rest & 7) + 8 * ks; return true; }
    __device__ __forceinline__ const char* abase(const Gemm& g, const Unit& u) const { return (const char*)g.A + (size_t)u.pm * BM * g.lda + (size_t)(u.pn >> 3) * kq_bytes; }
    __device__ __forceinline__ const char* bbase(const Gemm& g, const Unit& u) const { const int e = __builtin_amdgcn_readfirstlane(tile_e[u.pm]); return (const char*)g.Bt + ((size_t)e * nexp_rows + (size_t)(u.pn & 7) * BM) * g.ldb + (size_t)(u.pn >> 3) * kq_bytes; }
};

__device__ __forceinline__ unsigned cvt_pk_bf16(float lo, float hi) { unsigned r; asm volatile("v_cvt_pk_bf16_f32 %0, %1, %2" : "=v"(r) : "v"(lo), "v"(hi)); return r; }

struct EpiBf16 {
    static constexpr bool PERM = true;
    bf16_t* O; int ldc; float sc;
    __device__ __forceinline__ void operator()(const f32x4 (&acc)[2][2][4][2], const Unit& u, int wr, int wc, int fr, int fq) const {
        const int row0 = u.pm * BM + wr * 64 + fr, col0 = u.pn * BM + wc * 32 + 8 * fq;
#pragma unroll
        for (int ai = 0; ai < 2; ++ai)
#pragma unroll
            for (int m = 0; m < 4; ++m) { bf16_t* rowp = O + (size_t)(row0 + ai * HALF + m * 16) * ldc + col0;
#pragma unroll
                for (int bj = 0; bj < 2; ++bj) { const f32x4 v0 = acc[ai][bj][m][0] * sc, v1 = acc[ai][bj][m][1] * sc;
                    u32x4 w; w.x = cvt_pk_bf16(v0[0], v0[1]); w.y = cvt_pk_bf16(v0[2], v0[3]); w.z = cvt_pk_bf16(v1[0], v1[1]); w.w = cvt_pk_bf16(v1[2], v1[3]);
                    *(u32x4*)(rowp + bj * HALF) = w; } }
    }
};
struct EpiBf16Split {
    static constexpr bool PERM = true;
    bf16_t* O; int ldc; float sc; int pm0; size_t qstride;
    __device__ __forceinline__ void operator()(const f32x4 (&acc)[2][2][4][2], const Unit& u, int wr, int wc, int fr, int fq) const {
        const int row0 = (u.pm - pm0) * BM + wr * 64 + fr, col0 = (u.pn & 7) * BM + wc * 32 + 8 * fq; bf16_t* base = O + (size_t)(u.pn >> 3) * qstride;
#pragma unroll
        for (int ai = 0; ai < 2; ++ai)
#pragma unroll
            for (int m = 0; m < 4; ++m) { bf16_t* rowp = base + (size_t)(row0 + ai * HALF + m * 16) * ldc + col0;
#pragma unroll
                for (int bj = 0; bj < 2; ++bj) { const f32x4 v0 = acc[ai][bj][m][0] * sc, v1 = acc[ai][bj][m][1] * sc;
                    u32x4 w; w.x = cvt_pk_bf16(v0[0], v0[1]); w.y = cvt_pk_bf16(v0[2], v0[3]); w.z = cvt_pk_bf16(v1[0], v1[1]); w.w = cvt_pk_bf16(v1[2], v1[3]);
                    *(u32x4*)(rowp + bj * HALF) = w; } }
    }
};
struct EpiBf16Sel {
    static constexpr bool PERM = true;
    bf16_t* O; int ldc; bf16_t* O2; int ldc2;
    __device__ __forceinline__ void operator()(const f32x4 (&acc)[2][2][4][2], const Unit& u, int wr, int wc, int fr, int fq) const {
        const bool ex = u.pm >= 32; bf16_t* base = ex ? O2 : O; const int ld = ex ? ldc2 : ldc;
        const int row0 = (ex ? u.pm - 32 : u.pm) * BM + wr * 64 + fr, col0 = u.pn * BM + wc * 32 + 8 * fq;
#pragma unroll
        for (int ai = 0; ai < 2; ++ai)
#pragma unroll
            for (int m = 0; m < 4; ++m) { bf16_t* rowp = base + (size_t)(row0 + ai * HALF + m * 16) * ld + col0;
#pragma unroll
                for (int bj = 0; bj < 2; ++bj) { const f32x4 v0 = acc[ai][bj][m][0], v1 = acc[ai][bj][m][1];
                    u32x4 w; w.x = cvt_pk_bf16(v0[0], v0[1]); w.y = cvt_pk_bf16(v0[2], v0[3]); w.z = cvt_pk_bf16(v1[0], v1[1]); w.w = cvt_pk_bf16(v1[2], v1[3]);
                    *(u32x4*)(rowp + bj * HALF) = w; } }
    }
};
struct EpiResF32 {
    static constexpr bool PERM = false;
    const float* R; float* C; int ldc; float sc;
    __device__ __forceinline__ void operator()(const f32x4 (&acc)[2][2][4][2], const Unit& u, int wr, int wc, int fr, int fq) const {
        const int row0 = u.pm * BM + wr * 64 + fr, col0 = u.pn * BM + wc * 32 + 4 * fq;
#pragma unroll
        for (int ai = 0; ai < 2; ++ai)
#pragma unroll
            for (int m = 0; m < 4; ++m) { const size_t off = (size_t)(row0 + ai * HALF + m * 16) * ldc + col0;
#pragma unroll
                for (int bj = 0; bj < 2; ++bj)
#pragma unroll
                    for (int n = 0; n < 2; ++n) { const f32x4 r = *(const f32x4*)(R + off + bj * HALF + n * 16); *(f32x4*)(C + off + bj * HALF + n * 16) = r + acc[ai][bj][m][n] * sc; } }
    }
};
__device__ __forceinline__ float silu_mul(float g, float u) { return g * u * __builtin_amdgcn_rcpf(1.0f + __builtin_amdgcn_exp2f(-1.4426950408889634f * g)); }
struct EpiSwiGLU {
    static constexpr bool PERM = true;
    bf16_t* O; int ldc;
    __device__ __forceinline__ void operator()(const f32x4 (&acc)[2][2][4][2], const Unit& u, int wr, int wc, int fr, int fq) const {
        const int row0 = u.pm * BM + wr * 64 + fr, col0 = u.pn * HALF + wc * 32 + 8 * fq;
#pragma unroll
        for (int ai = 0; ai < 2; ++ai)
#pragma unroll
            for (int m = 0; m < 4; ++m) { bf16_t* rowp = O + (size_t)(row0 + ai * HALF + m * 16) * ldc + col0;
                const f32x4 g0 = acc[ai][0][m][0], g1 = acc[ai][0][m][1], u0 = acc[ai][1][m][0], u1 = acc[ai][1][m][1];
                u32x4 w; w.x = cvt_pk_bf16(silu_mul(g0[0], u0[0]), silu_mul(g0[1], u0[1])); w.y = cvt_pk_bf16(silu_mul(g0[2], u0[2]), silu_mul(g0[3], u0[3]));
                w.z = cvt_pk_bf16(silu_mul(g1[0], u1[0]), silu_mul(g1[1], u1[1])); w.w = cvt_pk_bf16(silu_mul(g1[2], u1[2]), silu_mul(g1[3], u1[3]));
                *(u32x4*)rowp = w; }
    }
};

typedef int v8i_t __attribute__((ext_vector_type(8)));
__device__ __forceinline__ v8i_t pg8_cat(bf16x8 lo, bf16x8 hi) { typedef int v4i_t __attribute__((ext_vector_type(4))); const v4i_t a = __builtin_bit_cast(v4i_t, lo), b = __builtin_bit_cast(v4i_t, hi); return (v8i_t){a.x, a.y, a.z, a.w, b.x, b.y, b.z, b.w}; }
struct EpiSwiGLU8 {
    static constexpr bool PERM = true;
    unsigned char* O; int ldc; float sc_in, sc_out;
    __device__ __forceinline__ void operator()(const f32x4 (&acc)[2][2][4][2], const Unit& u, int wr, int wc, int fr, int fq) const {
        const int row0 = u.pm * BM + wr * 64 + fr, col0 = u.pn * HALF + wc * 32 + 8 * fq;
#pragma unroll
        for (int ai = 0; ai < 2; ++ai)
#pragma unroll
            for (int m = 0; m < 4; ++m) { unsigned char* rowp = O + (size_t)(row0 + ai * HALF + m * 16) * ldc + col0;
                const f32x4 g0 = acc[ai][0][m][0] * sc_in, g1 = acc[ai][0][m][1] * sc_in, u0 = acc[ai][1][m][0] * (sc_in * sc_out), u1 = acc[ai][1][m][1] * (sc_in * sc_out);
                int w0 = 0, w1 = 0;
                w0 = __builtin_amdgcn_cvt_pk_fp8_f32(silu_mul(g0[0], u0[0]), silu_mul(g0[1], u0[1]), w0, false); w0 = __builtin_amdgcn_cvt_pk_fp8_f32(silu_mul(g0[2], u0[2]), silu_mul(g0[3], u0[3]), w0, true);
                w1 = __builtin_amdgcn_cvt_pk_fp8_f32(silu_mul(g1[0], u1[0]), silu_mul(g1[1], u1[1]), w1, false); w1 = __builtin_amdgcn_cvt_pk_fp8_f32(silu_mul(g1[2], u1[2]), silu_mul(g1[3], u1[3]), w1, true);
                typedef int v2i_t __attribute__((ext_vector_type(2))); *(v2i_t*)rowp = (v2i_t){w0, w1}; }
    }
};
__device__ __forceinline__ void pg8_mfma8(f32x4& c, v8i_t a, v8i_t b, int sc) { asm volatile("v_mfma_scale_f32_16x16x128_f8f6f4 %0, %1, %2, %0, %3, %3 op_sel_hi:[0,0,0]" : "+v"(c) : "v"(a), "v"(b), "v"(sc)); }
template <class Epi, class Sched, bool ALIGN_EPI = false, bool SP2 = false, bool FP8 = false>
__device__ __forceinline__ void gemm_phase(PG8_LAS unsigned char* lds, const Gemm g, const Sched& S, const Epi& E) {
    int tid_ = threadIdx.x; asm volatile("" : "+v"(tid_));
    const int tid = tid_, wid = __builtin_amdgcn_readfirstlane(tid >> 6), lane = tid & 63, wr = wid >> 2, wc = wid & 3, fr = lane & 15, fq = lane >> 4;
    const int nt = g.nt;
    unsigned voffA[2], voffB[2];
#pragma unroll
    for (int i = 0; i < 2; ++i) { int R, C; stage_rc(tid * 16 + i * 8192, R, C); const int Rb = Epi::PERM ? ((R & ~31) + perm32(R & 31)) : R;
        voffA[i] = (unsigned)(R * g.lda + C * 2); voffB[i] = (unsigned)(Rb * g.ldb + C * 2); }
    const size_t kstep = (size_t)(BK * 2);
    const size_t hstepA = (size_t)HALF * g.lda, hstepB = (size_t)HALF * g.ldb;
    const unsigned ldsw = (unsigned)wid * 1024u;
    const int aoff = lds_byte(wr * 64 + fr, fq * 8), boff = lds_byte(wc * 32 + fr, fq * 8);
#define PG8_SA(b, h) (((b) * 2 + (h)) * HTB)
#define PG8_SB(b, h) ((4 + (b) * 2 + (h)) * HTB)
#define PG8_STAGE(bufoff, gbase, voff) do { _Pragma("unroll") for (int _i = 0; _i < 2; ++_i) \
        __builtin_amdgcn_global_load_lds((const unsigned*)((const char*)(gbase) + (voff)[_i]), (PG8_LAS unsigned*)(lds + (bufoff) + ldsw + _i * 8192), 16, 0, 0); } while (0)
#define PG8_LDA(dst, b, h) do { _Pragma("unroll") for (int m = 0; m < 4; ++m) _Pragma("unroll") for (int k = 0; k < 2; ++k) dst[m][k] = *(const PG8_LAS bf16x8*)(lds + PG8_SA(b, h) + aoff + m * 2048 + k * 1024); } while (0)
#define PG8_LDB(dst, b, h) do { _Pragma("unroll") for (int n = 0; n < 2; ++n) _Pragma("unroll") for (int k = 0; k < 2; ++k) dst[n][k] = *(const PG8_LAS bf16x8*)(lds + PG8_SB(b, h) + boff + n * 2048 + k * 1024); } while (0)
#define PG8_MMA(ai, bj, At, Bt) do { __builtin_amdgcn_s_setprio(1); if constexpr (FP8) { _Pragma("unroll") for (int m = 0; m < 4; ++m) _Pragma("unroll") for (int n = 0; n < 2; ++n) \
        pg8_mfma8(acc[ai][bj][m][n], pg8_cat(Bt[n][0], Bt[n][1]), pg8_cat(At[m][0], At[m][1]), sc8); } else { \
        _Pragma("unroll") for (int m = 0; m < 4; ++m) _Pragma("unroll") for (int n = 0; n < 2; ++n) _Pragma("unroll") for (int k = 0; k < 2; ++k) \
        acc[ai][bj][m][n] = __builtin_amdgcn_mfma_f32_16x16x32_bf16(Bt[n][k], At[m][k], acc[ai][bj][m][n], 0, 0, 0); } __builtin_amdgcn_s_setprio(0); } while (0)
#define PG8_WAIT_V(n) asm volatile("s_waitcnt vmcnt(" #n ")" ::: "memory")
#define PG8_WAIT_L(n) asm volatile("s_waitcnt lgkmcnt(" #n ")" ::: "memory")
#define PG8_BAR __builtin_amdgcn_s_barrier()
#define PG8_SCHED __builtin_amdgcn_sched_barrier(0)
    Unit cur, nxt; int ui = 0;
    if (!S.next(0, cur)) return;
    int sc8 = 0x7F7F7F7F; asm volatile("" : "+v"(sc8));
    f32x4 acc[2][2][4][2];
#pragma unroll
    for (int a = 0; a < 2; ++a)
#pragma unroll
        for (int b = 0; b < 2; ++b)
#pragma unroll
            for (int m = 0; m < 4; ++m)
#pragma unroll
                for (int n = 0; n < 2; ++n) acc[a][b][m][n] = (f32x4){0.f, 0.f, 0.f, 0.f};
    bf16x8 At[4][2], B0[2][2], B1[2][2];
    const char* cA = S.abase(g, cur); const char* cB = S.bbase(g, cur);
    if constexpr (SP2) {
        PG8_STAGE(PG8_SB(0, 0), cB, voffB); PG8_STAGE(PG8_SB(0, 1), cB + hstepB, voffB); PG8_STAGE(PG8_SA(0, 0), cA, voffA); PG8_STAGE(PG8_SA(0, 1), cA + hstepA, voffA);
        if (wr == 1) PG8_BAR;
        PG8_WAIT_V(2); PG8_BAR;
        PG8_STAGE(PG8_SB(1, 0), cB + kstep, voffB); PG8_STAGE(PG8_SA(1, 0), cA + kstep, voffA); PG8_STAGE(PG8_SB(1, 1), cB + hstepB + kstep, voffB);
        PG8_WAIT_V(6); PG8_BAR;
    } else {
        PG8_STAGE(PG8_SB(0, 0), cB, voffB); PG8_STAGE(PG8_SA(0, 0), cA, voffA); PG8_STAGE(PG8_SB(0, 1), cB + hstepB, voffB); PG8_STAGE(PG8_SA(0, 1), cA + hstepA, voffA);
        if (wr == 1) PG8_BAR;
        PG8_WAIT_V(4); PG8_BAR;
        PG8_STAGE(PG8_SB(1, 0), cB + kstep, voffB); PG8_STAGE(PG8_SA(1, 0), cA + kstep, voffA); PG8_STAGE(PG8_SB(1, 1), cB + hstepB + kstep, voffB);
        PG8_WAIT_V(6); PG8_BAR;
    }
    for (;;) {
        const bool has_next = S.next(ui + 1, nxt);
        const char* nA = has_next ? S.abase(g, nxt) : cA; const char* nB = has_next ? S.bbase(g, nxt) : cB;
        for (int t = 0; t < nt; t += 2) {
            const bool last = (t == nt - 2);
            const char* a1 = cA + (size_t)(t + 1) * kstep;
            const char* a2 = last ? nA : cA + (size_t)(t + 2) * kstep; const char* b2 = last ? nB : cB + (size_t)(t + 2) * kstep;
            const char* a3 = a2 + kstep; const char* b3 = b2 + kstep;
            if constexpr (SP2) {
            PG8_LDB(B0, 0, 0); PG8_LDB(B1, 0, 1); PG8_SCHED; PG8_LDA(At, 0, 0); PG8_STAGE(PG8_SA(1, 1), a1 + hstepA, voffA);
            PG8_WAIT_V(8); PG8_WAIT_L(0); PG8_BAR; PG8_MMA(0, 0, At, B0); PG8_MMA(0, 1, At, B1); PG8_BAR; PG8_SCHED;
            PG8_LDA(At, 0, 1); PG8_STAGE(PG8_SB(0, 0), b2, voffB); PG8_STAGE(PG8_SB(0, 1), b2 + hstepB, voffB); PG8_STAGE(PG8_SA(0, 0), a2, voffA);
            PG8_WAIT_V(8); PG8_WAIT_L(0); PG8_BAR; PG8_MMA(1, 0, At, B0); PG8_MMA(1, 1, At, B1); PG8_BAR; PG8_SCHED;
            PG8_LDB(B0, 1, 0); PG8_LDB(B1, 1, 1); PG8_SCHED; PG8_LDA(At, 1, 0); PG8_STAGE(PG8_SA(0, 1), a2 + hstepA, voffA);
            PG8_WAIT_V(8); PG8_WAIT_L(0); PG8_BAR; PG8_MMA(0, 0, At, B0); PG8_MMA(0, 1, At, B1); PG8_BAR; PG8_SCHED;
            PG8_LDA(At, 1, 1); PG8_STAGE(PG8_SB(1, 0), b3, voffB); PG8_STAGE(PG8_SB(1, 1), b3 + hstepB, voffB); PG8_STAGE(PG8_SA(1, 0), a3, voffA);
            PG8_WAIT_V(8); PG8_WAIT_L(0); PG8_BAR; PG8_MMA(1, 0, At, B0); PG8_MMA(1, 1, At, B1); PG8_BAR; PG8_SCHED;
            } else {
            PG8_LDB(B0, 0, 0); PG8_SCHED; PG8_LDA(At, 0, 0); PG8_STAGE(PG8_SA(1, 1), a1 + hstepA, voffA);
            PG8_WAIT_L(8); PG8_BAR; PG8_WAIT_L(0); PG8_MMA(0, 0, At, B0); PG8_BAR; PG8_SCHED;
            PG8_LDB(B1, 0, 1); PG8_STAGE(PG8_SB(0, 0), b2, voffB);
            PG8_BAR; PG8_WAIT_L(0); PG8_MMA(0, 1, At, B1); PG8_BAR;
            PG8_LDA(At, 0, 1); PG8_STAGE(PG8_SA(0, 0), a2, voffA);
            PG8_BAR; PG8_WAIT_L(0); PG8_MMA(1, 0, At, B0); PG8_BAR; PG8_SCHED;
            PG8_STAGE(PG8_SB(0, 1), b2 + hstepB, voffB);
            PG8_WAIT_V(6); PG8_BAR; PG8_MMA(1, 1, At, B1); PG8_BAR;
            PG8_LDB(B0, 1, 0); PG8_SCHED; PG8_LDA(At, 1, 0); PG8_STAGE(PG8_SA(0, 1), a2 + hstepA, voffA);
            PG8_WAIT_L(8); PG8_BAR; PG8_WAIT_L(0); PG8_MMA(0, 0, At, B0); PG8_BAR; PG8_SCHED;
            PG8_LDB(B1, 1, 1); PG8_STAGE(PG8_SB(1, 0), b3, voffB);
            PG8_BAR; PG8_WAIT_L(0); PG8_MMA(0, 1, At, B1); PG8_BAR;
            PG8_LDA(At, 1, 1); PG8_STAGE(PG8_SA(1, 0), a3, voffA);
            PG8_BAR; PG8_WAIT_L(0); PG8_MMA(1, 0, At, B0); PG8_BAR; PG8_SCHED;
            PG8_STAGE(PG8_SB(1, 1), b3 + hstepB, voffB);
            PG8_WAIT_V(6); PG8_BAR; PG8_MMA(1, 1, At, B1); PG8_BAR;
            }
        }
        if constexpr (ALIGN_EPI) { if (wr == 0) PG8_BAR; }
        if constexpr (FP8) { PG8_SCHED; asm volatile("s_nop 15\n\ts_nop 7" ::: "memory"); PG8_SCHED; }
        E(acc, cur, wr, wc, fr, fq);
        if (!has_next) break;
#pragma unroll
        for (int a = 0; a < 2; ++a)
#pragma unroll
            for (int b = 0; b < 2; ++b)
#pragma unroll
                for (int m = 0; m < 4; ++m)
#pragma unroll
                    for (int n = 0; n < 2; ++n) acc[a][b][m][n] = (f32x4){0.f, 0.f, 0.f, 0.f};
        cur = nxt; cA = nA; cB = nB; ++ui;
        if constexpr (ALIGN_EPI) { if (wr == 1) PG8_BAR; }
    }
    PG8_WAIT_V(0);
    if constexpr (!ALIGN_EPI) { if (wr == 0) PG8_BAR; }
    PG8_BAR;
#undef PG8_SA
#undef PG8_SB
#undef PG8_STAGE
#undef PG8_LDA
#undef PG8_LDB
#undef PG8_MMA
#undef PG8_WAIT_V
#undef PG8_WAIT_L
#undef PG8_BAR
#undef PG8_SCHED
}
}
namespace att {
#define ATT_LAS __attribute__((address_space(3)))
#define ATT_GAS __attribute__((address_space(1)))
typedef unsigned short bf16;
using bf16x8 = __attribute__((ext_vector_type(8))) short;
using s16x4  = __attribute__((ext_vector_type(4))) short;
using f32x16 = __attribute__((ext_vector_type(16))) float;
using f32x4  = __attribute__((ext_vector_type(4))) float;
using u32x4  = __attribute__((ext_vector_type(4))) unsigned;
constexpr int NW = 8, QBLK = 32, KVBLK = 64, DV = 128;
constexpr float LOG2E = 1.4426950408889634f;
#define SBAR() __builtin_amdgcn_sched_barrier(0)
__device__ __forceinline__ int crow(int r, int hi) { return (r & 3) + 8 * (r >> 2) + 4 * hi; }
__device__ __forceinline__ unsigned cvtpk(float lo, float hi) { unsigned r; asm volatile("v_cvt_pk_bf16_f32 %0, %1, %2" : "=v"(r) : "v"(lo), "v"(hi)); return r; }
__device__ __forceinline__ float bf2f(short s) { return __uint_as_float(((unsigned)(unsigned short)s) << 16); }

__device__ __forceinline__ void partialSM(f32x16& p0, f32x16& p1, float& m_reg, float& mn, float& alpha, const float C, const float THRS) {
  float pmax = p0[0];
#pragma unroll
  for (int r = 1; r < 16; ++r) pmax = fmaxf(pmax, p0[r]);
#pragma unroll
  for (int r = 0; r < 16; ++r) pmax = fmaxf(pmax, p1[r]);
  { auto rr = __builtin_amdgcn_permlane32_swap(__float_as_uint(pmax), __float_as_uint(pmax), false, false);
    pmax = fmaxf(__uint_as_float(rr[0]), __uint_as_float(rr[1])); }
  if (__builtin_expect(__all(pmax - m_reg <= THRS), 1)) { mn = m_reg; alpha = 1.f; }
  else { mn = fmaxf(m_reg, pmax); alpha = __builtin_amdgcn_exp2f((m_reg - mn) * C); m_reg = mn; }
  float mnC = -mn * C;
#pragma unroll
  for (int r = 0; r < 16; ++r) p0[r] = fmaf(p0[r], C, mnC);
#pragma unroll
  for (int r = 0; r < 16; ++r) p1[r] = fmaf(p1[r], C, mnC);
#pragma unroll
  for (int r = 0; r < 16; ++r) p0[r] = __builtin_amdgcn_exp2f(p0[r]);
}
#define ATT_PK4(P, BASE, OUT) do { unsigned a0 = cvtpk(P[BASE + 0], P[BASE + 1]), a1 = cvtpk(P[BASE + 2], P[BASE + 3]);   \
    unsigned b0 = cvtpk(P[BASE + 4], P[BASE + 5]), b1 = cvtpk(P[BASE + 6], P[BASE + 7]);                              \
    auto r0 = __builtin_amdgcn_permlane32_swap(a0, b0, false, false); auto r1 = __builtin_amdgcn_permlane32_swap(a1, b1, false, false); \
    u32x4 w = {r0[0], r1[0], r0[1], r1[1]}; OUT = *reinterpret_cast<bf16x8*>(&w); } while (0)
__device__ __forceinline__ void finishSM(f32x16& p0, f32x16& p1, float alpha, float& l_reg, bf16x8& pa0, bf16x8& pa1, bf16x8& pa2, bf16x8& pa3) {
#pragma unroll
  for (int r = 0; r < 16; ++r) p1[r] = __builtin_amdgcn_exp2f(p1[r]);
  float ps = 0;
#pragma unroll
  for (int r = 0; r < 16; ++r) ps += p0[r];
#pragma unroll
  for (int r = 0; r < 16; ++r) ps += p1[r];
  { auto rr = __builtin_amdgcn_permlane32_swap(__float_as_uint(ps), __float_as_uint(ps), false, false);
    ps = __uint_as_float(rr[0]) + __uint_as_float(rr[1]); }
  l_reg = l_reg * alpha + ps;
  ATT_PK4(p0, 0, pa0); ATT_PK4(p0, 8, pa1); ATT_PK4(p1, 0, pa2); ATT_PK4(p1, 8, pa3);
}
template <int RB> __device__ __forceinline__ int kswz(int row, int colB) { return row * RB + (colB ^ ((row & 7) << 4)); }
template <int DQK> __device__ __forceinline__ void qkt(f32x16& p0, f32x16& p1, const ATT_LAS char* Ks, const bf16x8 (&qr)[DQK / 16], int r32, int hi) {
  p0 = f32x16{}; p1 = f32x16{};
#pragma unroll
  for (int d0 = 0; d0 < DQK / 16; ++d0) { const int cb = (d0 * 16 + hi * 8) * 2;
    bf16x8 b0 = *reinterpret_cast<const ATT_LAS bf16x8*>(Ks + kswz<DQK * 2>(r32, cb));
    bf16x8 b1 = *reinterpret_cast<const ATT_LAS bf16x8*>(Ks + kswz<DQK * 2>(32 + r32, cb));
    p0 = __builtin_amdgcn_mfma_f32_32x32x16_bf16(b0, qr[d0], p0, 0, 0, 0);
    p1 = __builtin_amdgcn_mfma_f32_32x32x16_bf16(b1, qr[d0], p1, 0, 0, 0); }
}
__device__ __forceinline__ void qkt192_lq(f32x16& p0, f32x16& p1, const ATT_LAS char* Ks, const bf16x8 (&qr)[8], const ATT_LAS char* Qs, int lane, int r32, int hi) {
  p0 = f32x16{}; p1 = f32x16{};
#pragma unroll
  for (int d0 = 0; d0 < 12; ++d0) { const int cb = (d0 * 16 + hi * 8) * 2;
    bf16x8 b0 = *reinterpret_cast<const ATT_LAS bf16x8*>(Ks + kswz<384>(r32, cb));
    bf16x8 b1 = *reinterpret_cast<const ATT_LAS bf16x8*>(Ks + kswz<384>(32 + r32, cb));
    const bf16x8 q = d0 < 8 ? qr[d0 < 8 ? d0 : 0] : *reinterpret_cast<const ATT_LAS bf16x8*>(Qs + ((d0 - 8) * 64 + lane) * 16);
    p0 = __builtin_amdgcn_mfma_f32_32x32x16_bf16(b0, q, p0, 0, 0, 0);
    p1 = __builtin_amdgcn_mfma_f32_32x32x16_bf16(b1, q, p1, 0, 0, 0); }
}
__device__ __forceinline__ int v_st(int k, int c) { const int kk = (k & ~0xC) | ((k & 4) << 1) | ((k & 8) >> 1); return ((kk >> 3) * 4 + (c >> 5)) * 512 + ((kk & 7) * 32 + (c & 31)) * 2; }
__device__ __forceinline__ int v_rd_base(int lane) { return ((lane & 3) << 3) | (((lane >> 2) & 3) << 6) | (((lane >> 4) & 1) << 5) | (((lane >> 5) & 1) << 8); }
constexpr int v_rd_off(int d0, int ks, int half) { return d0 * 512 + ks * 4096 + half * 2048; }
template <int OFF> __device__ __forceinline__ s16x4 tr_read(int vb) {
  s16x4 r; asm volatile("ds_read_b64_tr_b16 %0, %1 offset:%2" : "=&v"(r) : "v"(vb), "i"(OFF) : "memory"); return r;
}
#define ATT_PK(L, H) (bf16x8){L[0], L[1], L[2], L[3], H[0], H[1], H[2], H[3]}
template <int D0> __device__ __forceinline__ void pv_one(f32x16& od, int vb, bf16x8 pa0, bf16x8 pa1, bf16x8 pa2, bf16x8 pa3) {
  const s16x4 l0 = tr_read<v_rd_off(D0, 0, 0)>(vb), h0 = tr_read<v_rd_off(D0, 0, 1)>(vb), l1 = tr_read<v_rd_off(D0, 1, 0)>(vb), h1 = tr_read<v_rd_off(D0, 1, 1)>(vb);
  const s16x4 l2 = tr_read<v_rd_off(D0, 2, 0)>(vb), h2 = tr_read<v_rd_off(D0, 2, 1)>(vb), l3 = tr_read<v_rd_off(D0, 3, 0)>(vb), h3 = tr_read<v_rd_off(D0, 3, 1)>(vb);
  asm volatile("s_waitcnt lgkmcnt(0)" ::: "memory"); SBAR();
  od = __builtin_amdgcn_mfma_f32_32x32x16_bf16(pa0, ATT_PK(l0, h0), od, 0, 0, 0);
  od = __builtin_amdgcn_mfma_f32_32x32x16_bf16(pa1, ATT_PK(l1, h1), od, 0, 0, 0);
  od = __builtin_amdgcn_mfma_f32_32x32x16_bf16(pa2, ATT_PK(l2, h2), od, 0, 0, 0);
  od = __builtin_amdgcn_mfma_f32_32x32x16_bf16(pa3, ATT_PK(l3, h3), od, 0, 0, 0);
}
__device__ __forceinline__ void pv_d0(f32x16 (&o)[4], int vb, bf16x8 pa0, bf16x8 pa1, bf16x8 pa2, bf16x8 pa3) {
  pv_one<0>(o[0], vb, pa0, pa1, pa2, pa3); pv_one<1>(o[1], vb, pa0, pa1, pa2, pa3); pv_one<2>(o[2], vb, pa0, pa1, pa2, pa3); pv_one<3>(o[3], vb, pa0, pa1, pa2, pa3);
}
template <int D0> __device__ __forceinline__ void pv32_one(f32x16& od, int vb, bf16x8 pa0, bf16x8 pa1) {
  const s16x4 l0 = tr_read<v_rd_off(D0, 0, 0)>(vb), h0 = tr_read<v_rd_off(D0, 0, 1)>(vb), l1 = tr_read<v_rd_off(D0, 1, 0)>(vb), h1 = tr_read<v_rd_off(D0, 1, 1)>(vb);
  asm volatile("s_waitcnt lgkmcnt(0)" ::: "memory"); SBAR();
  od = __builtin_amdgcn_mfma_f32_32x32x16_bf16(pa0, ATT_PK(l0, h0), od, 0, 0, 0);
  od = __builtin_amdgcn_mfma_f32_32x32x16_bf16(pa1, ATT_PK(l1, h1), od, 0, 0, 0);
}

template <int DQK, int LDQ, int LDK, int LDO, int SDEPTH>
__device__ __forceinline__ void attn_dense_body(const bf16* __restrict__ Qb, const bf16* __restrict__ Kh, const bf16* __restrict__ Kr, const bf16* __restrict__ Vh,
                                                const float* __restrict__ cs_rows, float* __restrict__ Ob, int seq, const float scale, ATT_LAS char* lds) {
  constexpr int SHM_V = KVBLK * DV * 2, SHM_K = KVBLK * DQK * 2, RB = DQK * 2, NQ = DQK / 16;
  constexpr bool ROPE = (DQK == 192);
  const float C = scale * LOG2E, THRS = 8.f / scale;
  int tid_ = threadIdx.x; asm volatile("" : "+v"(tid_));
  const int tid = tid_, wid = tid >> 6, lane = tid & 63, r32 = lane & 31, hi = lane >> 5;
  ATT_LAS char* V_lds = lds; ATT_LAS char* K_lds = lds + 2 * SHM_V;
  ATT_LAS float* ws = (ATT_LAS float*)(lds + 2 * SHM_V + 2 * SHM_K) + wid * 64; ATT_LAS float* li_l = ws; ATT_LAS float* al_l = ws + 32;
  float m_reg = -1e30f, l_reg = 0; f32x16 o[4] = {}; bf16x8 qr[NQ];
  const bf16* Qw = Qb + (long)(wid * QBLK + r32) * LDQ + hi * 8;
#pragma unroll
  for (int d0 = 0; d0 < NQ; ++d0) qr[d0] = *(const ATT_GAS bf16x8*)(Qw + d0 * 16);
  if constexpr (ROPE) {
    const float* cs = cs_rows + (long)(wid * QBLK + r32) * 64 + hi * 8;
#pragma unroll
    for (int g = 0; g < 2; ++g) {
      const f32x4 c0 = *(const ATT_GAS f32x4*)(cs + g * 16), c1 = *(const ATT_GAS f32x4*)(cs + g * 16 + 4);
      const f32x4 s0 = *(const ATT_GAS f32x4*)(cs + 32 + g * 16), s1 = *(const ATT_GAS f32x4*)(cs + 32 + g * 16 + 4);
      float y1[8], y2[8];
#pragma unroll
      for (int j = 0; j < 8; ++j) { const float co = j < 4 ? c0[j & 3] : c1[j & 3], si = j < 4 ? s0[j & 3] : s1[j & 3];
        const float x1 = bf2f(qr[8 + g][j]), x2 = bf2f(qr[10 + g][j]); y1[j] = x1 * co - x2 * si; y2[j] = x1 * si + x2 * co; }
      u32x4 w1 = {cvtpk(y1[0], y1[1]), cvtpk(y1[2], y1[3]), cvtpk(y1[4], y1[5]), cvtpk(y1[6], y1[7])};
      u32x4 w2 = {cvtpk(y2[0], y2[1]), cvtpk(y2[2], y2[3]), cvtpk(y2[4], y2[5]), cvtpk(y2[6], y2[7])};
      qr[8 + g] = *reinterpret_cast<bf16x8*>(&w1); qr[10 + g] = *reinterpret_cast<bf16x8*>(&w2);
    }
  }
  const int sr = tid >> 4, sc = (tid & 15) * 8, vst0 = v_st(sr, sc), vst1 = v_st(32 + sr, sc);
  const int rr = tid >> 3, rc = (tid & 7) * 8;
  const int vb0 = (int)(unsigned)(uintptr_t)V_lds + v_rd_base(lane);
  struct Slot { bf16x8 vs0, vs1, ks0, ks1, kr; } sr_[SDEPTH];
#define SLOAD(i, k0) do { sr_[i].vs0 = *(const ATT_GAS bf16x8*)(&Vh[(long)((k0) + sr) * LDK + sc]); sr_[i].vs1 = *(const ATT_GAS bf16x8*)(&Vh[(long)((k0) + 32 + sr) * LDK + sc]); \
    sr_[i].ks0 = *(const ATT_GAS bf16x8*)(&Kh[(long)((k0) + sr) * LDK + sc]); sr_[i].ks1 = *(const ATT_GAS bf16x8*)(&Kh[(long)((k0) + 32 + sr) * LDK + sc]); \
    if constexpr (ROPE) sr_[i].kr = *(const ATT_GAS bf16x8*)(&Kr[(long)((k0) + rr) * 64 + rc]); } while (0)
#define SWRITE(b, i) do { *reinterpret_cast<ATT_LAS bf16x8*>(V_lds + (b) * SHM_V + vst0) = sr_[i].vs0;          \
    *reinterpret_cast<ATT_LAS bf16x8*>(V_lds + (b) * SHM_V + vst1) = sr_[i].vs1; const int kc = sc * 2;               \
    *reinterpret_cast<ATT_LAS bf16x8*>(K_lds + (b) * SHM_K + kswz<RB>(sr, kc)) = sr_[i].ks0;                       \
    *reinterpret_cast<ATT_LAS bf16x8*>(K_lds + (b) * SHM_K + kswz<RB>(32 + sr, kc)) = sr_[i].ks1;                  \
    if constexpr (ROPE) *reinterpret_cast<ATT_LAS bf16x8*>(K_lds + (b) * SHM_K + kswz<RB>(rr, 256 + rc * 2)) = sr_[i].kr; } while (0)
#define SWAIT() do { if constexpr (SDEPTH == 2) { if constexpr (ROPE) asm volatile("s_waitcnt vmcnt(5)" ::: "memory"); else asm volatile("s_waitcnt vmcnt(4)" ::: "memory"); } else asm volatile("s_waitcnt vmcnt(0)" ::: "memory"); } while (0)
#define RESC(a) do { if (__any((a) < 1.f)) { if (hi == 0) al_l[r32] = (a); asm volatile("s_waitcnt lgkmcnt(0)" ::: "memory"); \
    _Pragma("unroll") for (int d = 0; d < 4; ++d) _Pragma("unroll") for (int r = 0; r < 16; ++r) o[d][r] *= al_l[crow(r, hi)]; } } while (0)
  f32x16 pA0, pA1, pB0, pB1; float mnA, mnB, alA, alB; bf16x8 pa0, pa1, pa2, pa3; const int NT = seq / KVBLK;
  constexpr int SE = 0, SO = SDEPTH - 1;
  SLOAD(SE, 0); asm volatile("s_waitcnt vmcnt(0)" ::: "memory"); SWRITE(0, SE); __syncthreads();
  qkt<DQK>(pA0, pA1, K_lds, qr, r32, hi); partialSM(pA0, pA1, m_reg, mnA, alA, C, THRS);
  SLOAD(SO, KVBLK); if constexpr (SDEPTH == 2) { if (2 < NT) SLOAD(SE, 2 * KVBLK); }
  SWAIT(); SWRITE(1, SO); __syncthreads();
  for (int j = 1; j + 1 < NT; j += 2) {
    SBAR(); qkt<DQK>(pB0, pB1, K_lds + SHM_K, qr, r32, hi);
    finishSM(pA0, pA1, alA, l_reg, pa0, pa1, pa2, pa3); SBAR();
    SLOAD(SO, (j + SDEPTH) * KVBLK); SBAR();
    pv_d0(o, vb0, pa0, pa1, pa2, pa3); partialSM(pB0, pB1, m_reg, mnB, alB, C, THRS);
    __syncthreads(); SWAIT(); SWRITE(0, SE);
    RESC(alB); __syncthreads();
    SBAR(); qkt<DQK>(pA0, pA1, K_lds, qr, r32, hi);
    finishSM(pB0, pB1, alB, l_reg, pa0, pa1, pa2, pa3); SBAR();
    if (SDEPTH == 1 || j + 3 < NT) SLOAD(SE, (j + 1 + SDEPTH) * KVBLK); SBAR();
    pv_d0(o, vb0 + SHM_V, pa0, pa1, pa2, pa3); partialSM(pA0, pA1, m_reg, mnA, alA, C, THRS);
    __syncthreads(); SWAIT(); SWRITE(1, SO);
    RESC(alA); __syncthreads();
  }
  SBAR(); qkt<DQK>(pB0, pB1, K_lds + SHM_K, qr, r32, hi);
  finishSM(pA0, pA1, alA, l_reg, pa0, pa1, pa2, pa3); SBAR();
  pv_d0(o, vb0, pa0, pa1, pa2, pa3); partialSM(pB0, pB1, m_reg, mnB, alB, C, THRS);
  __syncthreads(); RESC(alB);
  finishSM(pB0, pB1, alB, l_reg, pa0, pa1, pa2, pa3); SBAR();
  pv_d0(o, vb0 + SHM_V, pa0, pa1, pa2, pa3);
  if (hi == 0) li_l[r32] = l_reg; asm volatile("s_waitcnt lgkmcnt(0)" ::: "memory");
  float rli[16];
#pragma unroll
  for (int r = 0; r < 16; ++r) rli[r] = __builtin_amdgcn_rcpf(li_l[crow(r, hi)]);
  float* Ow = Ob + (long)(wid * QBLK) * LDO;
#pragma unroll
  for (int r = 0; r < 16; ++r) { const int orow = crow(r, hi);
#pragma unroll
    for (int d0 = 0; d0 < 4; ++d0) Ow[(long)orow * LDO + d0 * 32 + r32] = o[d0][r] * rli[r]; }
  __syncthreads();
#undef SLOAD
#undef SWRITE
#undef SWAIT
#undef RESC
}

template <int LDQ, int LDK, int LDO>
__device__ __forceinline__ void attn_pipe192_body(const bf16* __restrict__ Qb, const bf16* __restrict__ Kh, const bf16* __restrict__ Kr, const bf16* __restrict__ Vh,
                                                const float* __restrict__ cs_rows, float* __restrict__ Ob, int seq, const float scale, ATT_LAS char* lds) {
  constexpr int DQK = 192, SDEPTH = 1, SHM_V = KVBLK * DV * 2, SHM_K = KVBLK * DQK * 2, RB = DQK * 2, NQ = DQK / 16;
  constexpr bool ROPE = true;
  const float C = scale * LOG2E, THRS = 8.f / scale;
  int tid_ = threadIdx.x; asm volatile("" : "+v"(tid_));
  const int tid = tid_, wid = tid >> 6, lane = tid & 63, r32 = lane & 31, hi = lane >> 5;
  ATT_LAS char* V_lds = lds; ATT_LAS char* K_lds = lds + 2 * SHM_V;
  ATT_LAS float* ws = (ATT_LAS float*)(lds + 2 * SHM_V + 2 * SHM_K) + wid * 64; ATT_LAS float* li_l = ws; ATT_LAS float* al_l = ws + 32;
  ATT_LAS char* Qs = lds + 2 * SHM_V + 2 * SHM_K + 2048 + wid * 4096;
  float m_reg = -1e30f, l_reg = 0; f32x16 o[4] = {}; bf16x8 qr8[8];
  const bf16* Qw = Qb + (long)(wid * QBLK + r32) * LDQ + hi * 8;
  { bf16x8 qr[NQ];
#pragma unroll
  for (int d0 = 0; d0 < NQ; ++d0) qr[d0] = *(const ATT_GAS bf16x8*)(Qw + d0 * 16);
  if constexpr (ROPE) {
    const float* cs = cs_rows + (long)(wid * QBLK + r32) * 64 + hi * 8;
#pragma unroll
    for (int g = 0; g < 2; ++g) {
      const f32x4 c0 = *(const ATT_GAS f32x4*)(cs + g * 16), c1 = *(const ATT_GAS f32x4*)(cs + g * 16 + 4);
      const f32x4 s0 = *(const ATT_GAS f32x4*)(cs + 32 + g * 16), s1 = *(const ATT_GAS f32x4*)(cs + 32 + g * 16 + 4);
      float y1[8], y2[8];
#pragma unroll
      for (int j = 0; j < 8; ++j) { const float co = j < 4 ? c0[j & 3] : c1[j & 3], si = j < 4 ? s0[j & 3] : s1[j & 3];
        const float x1 = bf2f(qr[8 + g][j]), x2 = bf2f(qr[10 + g][j]); y1[j] = x1 * co - x2 * si; y2[j] = x1 * si + x2 * co; }
      u32x4 w1 = {cvtpk(y1[0], y1[1]), cvtpk(y1[2], y1[3]), cvtpk(y1[4], y1[5]), cvtpk(y1[6], y1[7])};
      u32x4 w2 = {cvtpk(y2[0], y2[1]), cvtpk(y2[2], y2[3]), cvtpk(y2[4], y2[5]), cvtpk(y2[6], y2[7])};
      qr[8 + g] = *reinterpret_cast<bf16x8*>(&w1); qr[10 + g] = *reinterpret_cast<bf16x8*>(&w2);
    }
  }
#pragma unroll
  for (int d0 = 0; d0 < 8; ++d0) qr8[d0] = qr[d0];
#pragma unroll
  for (int d0 = 8; d0 < 12; ++d0) *reinterpret_cast<ATT_LAS bf16x8*>(Qs + ((d0 - 8) * 64 + lane) * 16) = qr[d0];
  }
  const int sr = tid >> 4, sc = (tid & 15) * 8, vst0 = v_st(sr, sc), vst1 = v_st(32 + sr, sc);
  const int rr = tid >> 3, rc = (tid & 7) * 8;
  const int vb0 = (int)(unsigned)(uintptr_t)V_lds + v_rd_base(lane);
  struct Slot { bf16x8 vs0, vs1, ks0, ks1, kr; } sr_[SDEPTH];
#define SLOADK(i, k0) do { sr_[i].ks0 = *(const ATT_GAS bf16x8*)(&Kh[(long)((k0) + sr) * LDK + sc]); sr_[i].ks1 = *(const ATT_GAS bf16x8*)(&Kh[(long)((k0) + 32 + sr) * LDK + sc]); } while (0)
#define SLOADV(i, k0) do { sr_[i].vs0 = *(const ATT_GAS bf16x8*)(&Vh[(long)((k0) + sr) * LDK + sc]); sr_[i].vs1 = *(const ATT_GAS bf16x8*)(&Vh[(long)((k0) + 32 + sr) * LDK + sc]); \
    if constexpr (ROPE) sr_[i].kr = *(const ATT_GAS bf16x8*)(&Kr[(long)((k0) + rr) * 64 + rc]); } while (0)
#define SLOAD(i, k0) do { SLOADK(i, k0); SLOADV(i, k0); } while (0)
#define SWRITE(b, i) do { *reinterpret_cast<ATT_LAS bf16x8*>(V_lds + (b) * SHM_V + vst0) = sr_[i].vs0;          \
    *reinterpret_cast<ATT_LAS bf16x8*>(V_lds + (b) * SHM_V + vst1) = sr_[i].vs1; const int kc = sc * 2;               \
    *reinterpret_cast<ATT_LAS bf16x8*>(K_lds + (b) * SHM_K + kswz<RB>(sr, kc)) = sr_[i].ks0;                       \
    *reinterpret_cast<ATT_LAS bf16x8*>(K_lds + (b) * SHM_K + kswz<RB>(32 + sr, kc)) = sr_[i].ks1;                  \
    if constexpr (ROPE) *reinterpret_cast<ATT_LAS bf16x8*>(K_lds + (b) * SHM_K + kswz<RB>(rr, 256 + rc * 2)) = sr_[i].kr; } while (0)
#define SWAIT() do { if constexpr (SDEPTH == 2) { if constexpr (ROPE) asm volatile("s_waitcnt vmcnt(5)" ::: "memory"); else asm volatile("s_waitcnt vmcnt(4)" ::: "memory"); } else asm volatile("s_waitcnt vmcnt(0)" ::: "memory"); } while (0)
#define RESC(a) do { if (__any((a) < 1.f)) { if (hi == 0) al_l[r32] = (a); asm volatile("s_waitcnt lgkmcnt(0)" ::: "memory"); \
    _Pragma("unroll") for (int d = 0; d < 4; ++d) _Pragma("unroll") for (int r = 0; r < 16; ++r) o[d][r] *= al_l[crow(r, hi)]; } } while (0)
  f32x16 pA0, pA1, pB0, pB1; float mnA, mnB, alA, alB; bf16x8 pa0, pa1, pa2, pa3; const int NT = seq / KVBLK;
  constexpr int SE = 0, SO = SDEPTH - 1;
  SLOAD(SE, 0); asm volatile("s_waitcnt vmcnt(0)" ::: "memory"); SWRITE(0, SE); __syncthreads();
  qkt192_lq(pA0, pA1, K_lds, qr8, Qs, lane, r32, hi); partialSM(pA0, pA1, m_reg, mnA, alA, C, THRS);
  SLOAD(SO, KVBLK); if constexpr (SDEPTH == 2) { if (2 < NT) SLOAD(SE, 2 * KVBLK); }
  SWAIT(); SWRITE(1, SO); __syncthreads();
  for (int j = 1; j + 1 < NT; j += 2) {
    SBAR(); qkt192_lq(pB0, pB1, K_lds + SHM_K, qr8, Qs, lane, r32, hi);
    finishSM(pA0, pA1, alA, l_reg, pa0, pa1, pa2, pa3); SBAR();
    SLOADK(SO, (j + SDEPTH) * KVBLK); SBAR();
    pv_d0(o, vb0, pa0, pa1, pa2, pa3); SBAR(); SLOADV(SO, (j + SDEPTH) * KVBLK); SBAR(); partialSM(pB0, pB1, m_reg, mnB, alB, C, THRS);
    __syncthreads(); SWAIT(); SWRITE(0, SE);
    RESC(alB); __syncthreads();
    SBAR(); qkt192_lq(pA0, pA1, K_lds, qr8, Qs, lane, r32, hi);
    finishSM(pB0, pB1, alB, l_reg, pa0, pa1, pa2, pa3); SBAR();
    SLOADK(SE, (j + 1 + SDEPTH) * KVBLK); SBAR();
    pv_d0(o, vb0 + SHM_V, pa0, pa1, pa2, pa3); SBAR(); SLOADV(SE, (j + 1 + SDEPTH) * KVBLK); SBAR(); partialSM(pA0, pA1, m_reg, mnA, alA, C, THRS);
    __syncthreads(); SWAIT(); SWRITE(1, SO);
    RESC(alA); __syncthreads();
  }
  SBAR(); qkt192_lq(pB0, pB1, K_lds + SHM_K, qr8, Qs, lane, r32, hi);
  finishSM(pA0, pA1, alA, l_reg, pa0, pa1, pa2, pa3); SBAR();
  pv_d0(o, vb0, pa0, pa1, pa2, pa3); partialSM(pB0, pB1, m_reg, mnB, alB, C, THRS);
  __syncthreads(); RESC(alB);
  finishSM(pB0, pB1, alB, l_reg, pa0, pa1, pa2, pa3); SBAR();
  pv_d0(o, vb0 + SHM_V, pa0, pa1, pa2, pa3);
  if (hi == 0) li_l[r32] = l_reg; asm volatile("s_waitcnt lgkmcnt(0)" ::: "memory");
  float rli[16];
#pragma unroll
  for (int r = 0; r < 16; ++r) rli[r] = __builtin_amdgcn_rcpf(li_l[crow(r, hi)]);
  float* Ow = Ob + (long)(wid * QBLK) * LDO;
#pragma unroll
  for (int r = 0; r < 16; ++r) { const int orow = crow(r, hi);
#pragma unroll
    for (int d0 = 0; d0 < 4; ++d0) Ow[(long)orow * LDO + d0 * 32 + r32] = o[d0][r] * rli[r]; }
  __syncthreads();
#undef SLOAD
#undef SLOADK
#undef SLOADV
#undef SWRITE
#undef SWAIT
#undef RESC
}

template <int DQK, int LDQ, int LDK, int LDO>
__device__ __forceinline__ void attn_simple_body(const bf16* __restrict__ Qb, const bf16* __restrict__ Kh, const bf16* __restrict__ Kr, const bf16* __restrict__ Vh,
                                                 const float* __restrict__ cs_rows, float* __restrict__ Ob, int seq, const float scale, ATT_LAS char* lds) {
  constexpr int SHM_V = KVBLK * DV * 2, SHM_K = KVBLK * DQK * 2, RB = DQK * 2, NQ = DQK / 16;
  constexpr bool ROPE = (DQK == 192);
  const float C = scale * LOG2E, THRS = 8.f / scale;
  int tid_ = threadIdx.x; asm volatile("" : "+v"(tid_));
  const int tid = tid_, wid = tid >> 6, lane = tid & 63, r32 = lane & 31, hi = lane >> 5;
  ATT_LAS char* V_lds = lds; ATT_LAS char* K_lds = lds + 2 * SHM_V;
  ATT_LAS float* ws = (ATT_LAS float*)(lds + 2 * SHM_V + 2 * SHM_K) + wid * 64; ATT_LAS float* li_l = ws; ATT_LAS float* al_l = ws + 32;
  float m_reg = -1e30f, l_reg = 0; f32x16 o[4] = {}; bf16x8 qr[NQ];
  const bf16* Qw = Qb + (long)(wid * QBLK + r32) * LDQ + hi * 8;
#pragma unroll
  for (int d0 = 0; d0 < NQ; ++d0) qr[d0] = *(const ATT_GAS bf16x8*)(Qw + d0 * 16);
  if constexpr (ROPE) {
    const float* cs = cs_rows + (long)(wid * QBLK + r32) * 64 + hi * 8;
#pragma unroll
    for (int g = 0; g < 2; ++g) {
      const f32x4 c0 = *(const ATT_GAS f32x4*)(cs + g * 16), c1 = *(const ATT_GAS f32x4*)(cs + g * 16 + 4);
      const f32x4 s0 = *(const ATT_GAS f32x4*)(cs + 32 + g * 16), s1 = *(const ATT_GAS f32x4*)(cs + 32 + g * 16 + 4);
      float y1[8], y2[8];
#pragma unroll
      for (int j = 0; j < 8; ++j) { const float co = j < 4 ? c0[j & 3] : c1[j & 3], si = j < 4 ? s0[j & 3] : s1[j & 3];
        const float x1 = bf2f(qr[8 + g][j]), x2 = bf2f(qr[10 + g][j]); y1[j] = x1 * co - x2 * si; y2[j] = x1 * si + x2 * co; }
      u32x4 w1 = {cvtpk(y1[0], y1[1]), cvtpk(y1[2], y1[3]), cvtpk(y1[4], y1[5]), cvtpk(y1[6], y1[7])};
      u32x4 w2 = {cvtpk(y2[0], y2[1]), cvtpk(y2[2], y2[3]), cvtpk(y2[4], y2[5]), cvtpk(y2[6], y2[7])};
      qr[8 + g] = *reinterpret_cast<bf16x8*>(&w1); qr[10 + g] = *reinterpret_cast<bf16x8*>(&w2);
    }
  }
  const int sr = tid >> 4, sc = (tid & 15) * 8, vst0 = v_st(sr, sc), vst1 = v_st(32 + sr, sc);
  const int rr = tid >> 3, rc = (tid & 7) * 8;
  const int vb0 = (int)(unsigned)(uintptr_t)V_lds + v_rd_base(lane);
  bf16x8 vs0, vs1, ks0, ks1, kr;
#define SLOAD(k0) do { vs0 = *(const ATT_GAS bf16x8*)(&Vh[(long)((k0) + sr) * LDK + sc]); vs1 = *(const ATT_GAS bf16x8*)(&Vh[(long)((k0) + 32 + sr) * LDK + sc]); \
    ks0 = *(const ATT_GAS bf16x8*)(&Kh[(long)((k0) + sr) * LDK + sc]); ks1 = *(const ATT_GAS bf16x8*)(&Kh[(long)((k0) + 32 + sr) * LDK + sc]); \
    if constexpr (ROPE) kr = *(const ATT_GAS bf16x8*)(&Kr[(long)((k0) + rr) * 64 + rc]); } while (0)
#define SWRITE(b) do { *reinterpret_cast<ATT_LAS bf16x8*>(V_lds + (b) * SHM_V + vst0) = vs0;          \
    *reinterpret_cast<ATT_LAS bf16x8*>(V_lds + (b) * SHM_V + vst1) = vs1; const int kc = sc * 2;               \
    *reinterpret_cast<ATT_LAS bf16x8*>(K_lds + (b) * SHM_K + kswz<RB>(sr, kc)) = ks0;                       \
    *reinterpret_cast<ATT_LAS bf16x8*>(K_lds + (b) * SHM_K + kswz<RB>(32 + sr, kc)) = ks1;                  \
    if constexpr (ROPE) *reinterpret_cast<ATT_LAS bf16x8*>(K_lds + (b) * SHM_K + kswz<RB>(rr, 256 + rc * 2)) = kr; } while (0)
#define RESC(a) do { if (__any((a) < 1.f)) { if (hi == 0) al_l[r32] = (a); asm volatile("s_waitcnt lgkmcnt(0)" ::: "memory"); \
    _Pragma("unroll") for (int d = 0; d < 4; ++d) _Pragma("unroll") for (int r = 0; r < 16; ++r) o[d][r] *= al_l[crow(r, hi)]; } } while (0)
  const int NT = seq / KVBLK;
  SLOAD(0); SWRITE(0); __syncthreads();
  for (int j = 0; j < NT; ++j) {
    const int b = j & 1;
    if (j + 1 < NT) SLOAD((j + 1) * KVBLK);
    f32x16 p0, p1; float mn, al; bf16x8 pa0, pa1, pa2, pa3;
    SBAR(); qkt<DQK>(p0, p1, K_lds + b * SHM_K, qr, r32, hi);
    partialSM(p0, p1, m_reg, mn, al, C, THRS); RESC(al);
    finishSM(p0, p1, al, l_reg, pa0, pa1, pa2, pa3); SBAR();
    pv_d0(o, vb0 + b * SHM_V, pa0, pa1, pa2, pa3);
    if (j + 1 < NT) SWRITE(b ^ 1);
    __syncthreads();
  }
  if (hi == 0) li_l[r32] = l_reg; asm volatile("s_waitcnt lgkmcnt(0)" ::: "memory");
  float rli[16];
#pragma unroll
  for (int r = 0; r < 16; ++r) rli[r] = __builtin_amdgcn_rcpf(li_l[crow(r, hi)]);
  float* Ow = Ob + (long)(wid * QBLK) * LDO;
#pragma unroll
  for (int r = 0; r < 16; ++r) { const int orow = crow(r, hi);
#pragma unroll
    for (int d0 = 0; d0 < 4; ++d0) Ow[(long)orow * LDO + d0 * 32 + r32] = o[d0][r] * rli[r]; }
  __syncthreads();
#undef SLOAD
#undef SWRITE
#undef RESC
}

template <int LDQ, int LDK, int LDO>
__device__ __forceinline__ void attn_dma_body(const bf16* __restrict__ Qb, const bf16* __restrict__ Kh, const bf16* __restrict__ Kr, const bf16* __restrict__ Vh,
                                              const float* __restrict__ cs_rows, float* __restrict__ Ob, int seq, const float scale, ATT_LAS char* lds) {
  constexpr int DQK = 192, SHM_V = KVBLK * DV * 2, SHM_K = KVBLK * DQK * 2, STG = SHM_K + SHM_V, RB = DQK * 2, NQ = DQK / 16;
  const float C = scale * LOG2E, THRS = 8.f / scale;
  int tid_ = threadIdx.x; asm volatile("" : "+v"(tid_));
  const int tid = tid_, wid = __builtin_amdgcn_readfirstlane(tid >> 6), lane = tid & 63, r32 = lane & 31, hi = lane >> 5;
  ATT_LAS float* ws = (ATT_LAS float*)(lds + 3 * STG) + wid * 64; ATT_LAS float* li_l = ws; ATT_LAS float* al_l = ws + 32;
  float m_reg = -1e30f, l_reg = 0; f32x16 o[4] = {}; bf16x8 qr[NQ];
  const bf16* Qw = Qb + (long)(wid * QBLK + r32) * LDQ + hi * 8;
#pragma unroll
  for (int d0 = 0; d0 < NQ; ++d0) qr[d0] = *(const ATT_GAS bf16x8*)(Qw + d0 * 16);
  { const float* cs = cs_rows + (long)(wid * QBLK + r32) * 64 + hi * 8;
#pragma unroll
    for (int g = 0; g < 2; ++g) {
      const f32x4 c0 = *(const ATT_GAS f32x4*)(cs + g * 16), c1 = *(const ATT_GAS f32x4*)(cs + g * 16 + 4);
      const f32x4 s0 = *(const ATT_GAS f32x4*)(cs + 32 + g * 16), s1 = *(const ATT_GAS f32x4*)(cs + 32 + g * 16 + 4);
      float y1[8], y2[8];
#pragma unroll
      for (int j = 0; j < 8; ++j) { const float co = j < 4 ? c0[j & 3] : c1[j & 3], si = j < 4 ? s0[j & 3] : s1[j & 3];
        const float x1 = bf2f(qr[8 + g][j]), x2 = bf2f(qr[10 + g][j]); y1[j] = x1 * co - x2 * si; y2[j] = x1 * si + x2 * co; }
      u32x4 w1 = {cvtpk(y1[0], y1[1]), cvtpk(y1[2], y1[3]), cvtpk(y1[4], y1[5]), cvtpk(y1[6], y1[7])};
      u32x4 w2 = {cvtpk(y2[0], y2[1]), cvtpk(y2[2], y2[3]), cvtpk(y2[4], y2[5]), cvtpk(y2[6], y2[7])};
      qr[8 + g] = *reinterpret_cast<bf16x8*>(&w1); qr[10 + g] = *reinterpret_cast<bf16x8*>(&w2);
    } }
  const char* ksrc[3]; int kstep[3];
#pragma unroll
  for (int d = 0; d < 3; ++d) { const int p = (wid * 3 + d) * 64 + lane, row = p / 24, cpos = p - row * 24, c = cpos ^ (row & 7);
    if (c < 16) { ksrc[d] = (const char*)(Kh + (long)row * LDK + c * 8); kstep[d] = KVBLK * LDK * 2; } else { ksrc[d] = (const char*)(Kr + (long)row * 64 + (c - 16) * 8); kstep[d] = KVBLK * 64 * 2; } }
  const char* vsrc[2];
#pragma unroll
  for (int d = 0; d < 2; ++d) { const int p = (wid * 2 + d) * 64 + lane, sub = p >> 5, q = p & 31, kk = (sub >> 2) * 8 + (q >> 2), col = (sub & 3) * 32 + (q & 3) * 8;
    const int key = (kk & ~0xC) | ((kk & 4) << 1) | ((kk & 8) >> 1); vsrc[d] = (const char*)(Vh + (long)key * LDK + col); }
#define DMA_TILE(t, stg) do { ATT_LAS char* sb_ = lds + (stg) * STG; \
    _Pragma("unroll") for (int d = 0; d < 3; ++d) __builtin_amdgcn_global_load_lds((const unsigned*)(ksrc[d] + (long)(t) * kstep[d]), (ATT_LAS unsigned*)(sb_ + (wid * 3 + d) * 1024), 16, 0, 0); \
    _Pragma("unroll") for (int d = 0; d < 2; ++d) __builtin_amdgcn_global_load_lds((const unsigned*)(vsrc[d] + (long)(t) * (KVBLK * LDK * 2)), (ATT_LAS unsigned*)(sb_ + SHM_K + (wid * 2 + d) * 1024), 16, 0, 0); } while (0)
#define RESC(a) do { if (__any((a) < 1.f)) { if (hi == 0) al_l[r32] = (a); asm volatile("s_waitcnt lgkmcnt(0)" ::: "memory"); \
    _Pragma("unroll") for (int d = 0; d < 4; ++d) _Pragma("unroll") for (int r = 0; r < 16; ++r) o[d][r] *= al_l[crow(r, hi)]; } } while (0)
  const int NT = seq / KVBLK, vbase = (int)(unsigned)(uintptr_t)lds + SHM_K + v_rd_base(lane);
  asm volatile("s_waitcnt vmcnt(0)" ::: "memory");
  DMA_TILE(0, 0); DMA_TILE(1, 1);
  asm volatile("s_waitcnt vmcnt(5)" ::: "memory"); __builtin_amdgcn_s_barrier(); asm volatile("" ::: "memory");
  int stg = 0;
  for (int j = 0; j < NT; ++j) {
    const int stg2 = stg >= 1 ? stg - 1 : 2;
    if (j + 2 < NT) DMA_TILE(j + 2, stg2);
    f32x16 p0, p1; float mn, al; bf16x8 pa0, pa1, pa2, pa3;
    SBAR(); qkt<DQK>(p0, p1, lds + stg * STG, qr, r32, hi);
    partialSM(p0, p1, m_reg, mn, al, C, THRS); RESC(al);
    finishSM(p0, p1, al, l_reg, pa0, pa1, pa2, pa3); SBAR();
    pv_d0(o, vbase + stg * STG, pa0, pa1, pa2, pa3);
    if (j + 2 < NT) asm volatile("s_waitcnt vmcnt(5)" ::: "memory"); else asm volatile("s_waitcnt vmcnt(0)" ::: "memory");
    asm volatile("s_waitcnt lgkmcnt(0)" ::: "memory"); __builtin_amdgcn_s_barrier(); asm volatile("" ::: "memory");
    stg = stg == 2 ? 0 : stg + 1;
  }
  if (hi == 0) li_l[r32] = l_reg; asm volatile("s_waitcnt lgkmcnt(0)" ::: "memory");
  float rli[16];
#pragma unroll
  for (int r = 0; r < 16; ++r) rli[r] = __builtin_amdgcn_rcpf(li_l[crow(r, hi)]);
  float* Ow = Ob + (long)(wid * QBLK) * LDO;
#pragma unroll
  for (int r = 0; r < 16; ++r) { const int orow = crow(r, hi);
#pragma unroll
    for (int d0 = 0; d0 < 4; ++d0) Ow[(long)orow * LDO + d0 * 32 + r32] = o[d0][r] * rli[r]; }
  __syncthreads();
#undef DMA_TILE
#undef RESC
}

template <int LDP>
__device__ __forceinline__ void dil_wave_unit(const bf16* __restrict__ P, int qc, int kc, int vc, int d, int r, int t0, int nT,
                                              float* __restrict__ O, int oc, float* __restrict__ ST  ,
                                              ATT_LAS char* vlds  , const ATT_LAS float* bias2, const float C, int lane_) {
  int lane = lane_; asm volatile("" : "+v"(lane));
  const int r32 = lane & 31, hi = lane >> 5;
  bf16x8 qr[8];
  { const bf16* qp = P + (long)(r + d * (t0 + r32)) * LDP + qc + hi * 8;
#pragma unroll
    for (int d0 = 0; d0 < 8; ++d0) qr[d0] = *(const ATT_GAS bf16x8*)(qp + d0 * 16); }
  bf16x8 kf[2][8];
#define DIL_LDK(kb, set) do { int kt_ = t0 - 64 + (kb) * 32 + r32; kt_ = kt_ < 0 ? 0 : (kt_ > nT - 1 ? nT - 1 : kt_); \
    const bf16* kp_ = P + (long)(r + d * kt_) * LDP + kc + hi * 8; \
    _Pragma("unroll") for (int d0 = 0; d0 < 8; ++d0) kf[set][d0] = *(const ATT_GAS bf16x8*)(kp_ + d0 * 16); } while (0)
  DIL_LDK(0, 0);
  f32x16 p[5];
#pragma unroll
  for (int kb = 0; kb < 5; ++kb) {
    if (kb + 1 < 5) DIL_LDK(kb + 1, (kb + 1) & 1);
    p[kb] = f32x16{};
#pragma unroll
    for (int d0 = 0; d0 < 8; ++d0) p[kb] = __builtin_amdgcn_mfma_f32_32x32x16_bf16(kf[kb & 1][d0], qr[d0], p[kb], 0, 0, 0);
  }
#undef DIL_LDK
  bf16x8 vv[2][8];
#define DIL_LDV(kb, set) do { _Pragma("unroll") for (int i = 0; i < 8; ++i) { const int id = lane + 64 * i, row = id >> 4, c = (id & 15) * 8; \
      int kt_ = t0 - 64 + (kb) * 32 + row; kt_ = kt_ < 0 ? 0 : (kt_ > nT - 1 ? nT - 1 : kt_); \
      vv[set][i] = *(const ATT_GAS bf16x8*)(P + (long)(r + d * kt_) * LDP + vc + c); } } while (0)
  DIL_LDV(0, 0);
  float m = -1e30f;
  { const int a_ = 4 * hi - r32 + 32, k_ = a_ & 3; const ATT_LAS f32x4* tp = (const ATT_LAS f32x4*)(bias2 + k_ * 196 + (a_ - k_));
    const bool interior = (t0 >= 64) && (t0 + 96 <= nT);
#pragma unroll
    for (int kb = 0; kb < 5; ++kb)
#pragma unroll
      for (int g = 0; g < 4; ++g) { const f32x4 bv = tp[kb * 8 + 2 * g];
#pragma unroll
        for (int e = 0; e < 4; ++e) { const int rg = 4 * g + e; float s = fmaf(p[kb][rg], C, bv[e]);
          if (!interior) { const int kt = t0 - 64 + kb * 32 + crow(rg, hi); s = (kt >= 0 && kt < nT) ? s : -1e30f; }
          p[kb][rg] = s; m = fmaxf(m, s); } } }
  { auto rr = __builtin_amdgcn_permlane32_swap(__float_as_uint(m), __float_as_uint(m), false, false); m = fmaxf(__uint_as_float(rr[0]), __uint_as_float(rr[1])); }
  float Z = 0.f;
#pragma unroll
  for (int kb = 0; kb < 5; ++kb)
#pragma unroll
    for (int rg = 0; rg < 16; ++rg) { p[kb][rg] = __builtin_amdgcn_exp2f(p[kb][rg] - m); Z += p[kb][rg]; }
  { auto rr = __builtin_amdgcn_permlane32_swap(__float_as_uint(Z), __float_as_uint(Z), false, false); Z = __uint_as_float(rr[0]) + __uint_as_float(rr[1]); }
  bf16x8 pa[5][2];
#pragma unroll
  for (int kb = 0; kb < 5; ++kb) { ATT_PK4(p[kb], 0, pa[kb][0]); ATT_PK4(p[kb], 8, pa[kb][1]); }
  f32x16 o[4] = {};
  const int vb = (int)(unsigned)(uintptr_t)vlds + v_rd_base(lane);
#pragma unroll
  for (int kb = 0; kb < 5; ++kb) {
    if (kb + 1 < 5) DIL_LDV(kb + 1, (kb + 1) & 1);
#pragma unroll
    for (int i = 0; i < 8; ++i) { const int id = lane + 64 * i, row = id >> 4, c = (id & 15) * 8;
      *reinterpret_cast<ATT_LAS bf16x8*>(vlds + v_st(row, c)) = vv[kb & 1][i]; }
    asm volatile("s_waitcnt lgkmcnt(0)" ::: "memory"); SBAR();
    pv32_one<0>(o[0], vb, pa[kb][0], pa[kb][1]); pv32_one<1>(o[1], vb, pa[kb][0], pa[kb][1]); pv32_one<2>(o[2], vb, pa[kb][0], pa[kb][1]); pv32_one<3>(o[3], vb, pa[kb][0], pa[kb][1]);
    SBAR();
  }
#undef DIL_LDV
#pragma unroll
  for (int rg = 0; rg < 16; ++rg) { const long row = r + d * (t0 + crow(rg, hi));
#pragma unroll
    for (int d0 = 0; d0 < 4; ++d0) O[row * 768 + oc + d0 * 32 + r32] = o[d0][rg]; }
  if (hi == 0) { const long row = r + d * (t0 + r32); typedef float f32x2_ __attribute__((ext_vector_type(2))); *(ATT_GAS f32x2_*)(ST + row * 12) = (f32x2_){m, Z}; }
}
template <int LDP>
__device__ __forceinline__ void dil_wg_unit(const bf16* __restrict__ P, int qc, int kc, int vc, int d, int r, int T0, int nT,
                                            float* __restrict__ O, int oc, float* __restrict__ ST, ATT_LAS char* lds, const ATT_LAS float* bias2, const float C) {
  int tid_ = threadIdx.x; asm volatile("" : "+v"(tid_));
  const int tid = tid_, wid = __builtin_amdgcn_readfirstlane(tid >> 6), lane = tid & 63, r32 = lane & 31, hi = lane >> 5, t0 = T0 + 32 * wid;
  { bf16x8 kk[12];
#pragma unroll
    for (int i = 0; i < 12; ++i) { const int id = tid + 512 * i, row = id >> 4, c = (id & 15) * 8; int kt = T0 - 64 + row; kt = kt < 0 ? 0 : (kt > nT - 1 ? nT - 1 : kt);
      kk[i] = *(const ATT_GAS bf16x8*)(P + (long)(r + d * kt) * LDP + kc + c); }
#pragma unroll
    for (int i = 0; i < 12; ++i) { const int id = tid + 512 * i, row = id >> 4, cB = (id & 15) * 16;
      *reinterpret_cast<ATT_LAS bf16x8*>(lds + kswz<256>(row, cB)) = kk[i]; } }
  bf16x8 qr[8];
  { const bf16* qp = P + (long)(r + d * (t0 + r32)) * LDP + qc + hi * 8;
#pragma unroll
    for (int d0 = 0; d0 < 8; ++d0) qr[d0] = *(const ATT_GAS bf16x8*)(qp + d0 * 16); }
  __syncthreads();
  bf16x8 vv[12];
#pragma unroll
  for (int i = 0; i < 12; ++i) { const int id = tid + 512 * i, row = id >> 4, c = (id & 15) * 8; int kt = T0 - 64 + row; kt = kt < 0 ? 0 : (kt > nT - 1 ? nT - 1 : kt);
    vv[i] = *(const ATT_GAS bf16x8*)(P + (long)(r + d * kt) * LDP + vc + c); }
  f32x16 p[5];
#pragma unroll
  for (int kb = 0; kb < 5; ++kb) { const int krow = 32 * wid + 32 * kb + r32;
    p[kb] = f32x16{};
#pragma unroll
    for (int d0 = 0; d0 < 8; ++d0) { const bf16x8 kf = *reinterpret_cast<const ATT_LAS bf16x8*>(lds + kswz<256>(krow, (d0 * 16 + hi * 8) * 2));
      p[kb] = __builtin_amdgcn_mfma_f32_32x32x16_bf16(kf, qr[d0], p[kb], 0, 0, 0); } }
  float m = -1e30f;
  { const int a_ = 4 * hi - r32 + 32, k_ = a_ & 3; const ATT_LAS f32x4* tp = (const ATT_LAS f32x4*)(bias2 + k_ * 196 + (a_ - k_));
    const bool interior = (t0 >= 64) && (t0 + 96 <= nT);
#pragma unroll
    for (int kb = 0; kb < 5; ++kb)
#pragma unroll
      for (int g = 0; g < 4; ++g) { const f32x4 bv = tp[kb * 8 + 2 * g];
#pragma unroll
        for (int e = 0; e < 4; ++e) { const int rg = 4 * g + e; float s = fmaf(p[kb][rg], C, bv[e]);
          if (!interior) { const int kt = t0 - 64 + kb * 32 + crow(rg, hi); s = (kt >= 0 && kt < nT) ? s : -1e30f; }
          p[kb][rg] = s; m = fmaxf(m, s); } } }
  { auto rr = __builtin_amdgcn_permlane32_swap(__float_as_uint(m), __float_as_uint(m), false, false); m = fmaxf(__uint_as_float(rr[0]), __uint_as_float(rr[1])); }
  float Z = 0.f;
#pragma unroll
  for (int kb = 0; kb < 5; ++kb)
#pragma unroll
    for (int rg = 0; rg < 16; ++rg) { p[kb][rg] = __builtin_amdgcn_exp2f(p[kb][rg] - m); Z += p[kb][rg]; }
  { auto rr = __builtin_amdgcn_permlane32_swap(__float_as_uint(Z), __float_as_uint(Z), false, false); Z = __uint_as_float(rr[0]) + __uint_as_float(rr[1]); }
  bf16x8 pa[5][2];
#pragma unroll
  for (int kb = 0; kb < 5; ++kb) { ATT_PK4(p[kb], 0, pa[kb][0]); ATT_PK4(p[kb], 8, pa[kb][1]); }
  __syncthreads();
#pragma unroll
  for (int i = 0; i < 12; ++i) { const int id = tid + 512 * i, row = id >> 4, c = (id & 15) * 8;
    *reinterpret_cast<ATT_LAS bf16x8*>(lds + (row >> 5) * 8192 + v_st(row & 31, c)) = vv[i]; }
  __syncthreads();
  f32x16 o[4] = {};
#pragma unroll
  for (int kb = 0; kb < 5; ++kb) { const int vb = (int)(unsigned)(uintptr_t)lds + (wid + kb) * 8192 + v_rd_base(lane);
    pv32_one<0>(o[0], vb, pa[kb][0], pa[kb][1]); pv32_one<1>(o[1], vb, pa[kb][0], pa[kb][1]); pv32_one<2>(o[2], vb, pa[kb][0], pa[kb][1]); pv32_one<3>(o[3], vb, pa[kb][0], pa[kb][1]); }
#pragma unroll
  for (int rg = 0; rg < 16; ++rg) { const long row = r + d * (t0 + crow(rg, hi));
#pragma unroll
    for (int d0 = 0; d0 < 4; ++d0) O[row * 768 + oc + d0 * 32 + r32] = o[d0][rg]; }
  if (hi == 0) { const long row = r + d * (t0 + r32); typedef float f32x2_ __attribute__((ext_vector_type(2))); *(ATT_GAS f32x2_*)(ST + row * 12) = (f32x2_){m, Z}; }
  __syncthreads();
}

#if defined(MLA_DMA) && MLA_DMA == 2
#define MLA_BODY attn_pipe192_body
#elif defined(MLA_DMA) && MLA_DMA
#define MLA_BODY attn_dma_body
#else
template <int LDQ, int LDK, int LDO> __device__ __forceinline__ void attn_simple192(const bf16* Qb, const bf16* Kh, const bf16* Kr, const bf16* Vh, const float* cs, float* Ob, int seq, const float scale, ATT_LAS char* lds) { attn_simple_body<192, LDQ, LDK, LDO>(Qb, Kh, Kr, Vh, cs, Ob, seq, scale, lds); }
#define MLA_BODY attn_simple192
#endif
}
constexpr int S = 8192, D = 2048, NMEM = 256;
constexpr int DIN = 3392, DINP = 3584;
constexpr int PC_DIL = 768, PC_MEM = 3072;
constexpr int QR = 384, KVR = 128, AQ = 512;
constexpr int NUP = 2816;
constexpr int UC_KV = 1280;
constexpr int DFF = 5632, DFE = 7168, NE = 8;
constexpr int MP = 18432;
constexpr float EPS = 1e-6f;
constexpr int NWAVES = 8;

constexpr size_t al256(size_t x) { return (x + 255) / 256 * 256; }
constexpr size_t WS_CTL = 0, CTL_ZERO_BYTES = 1u << 20;
constexpr size_t WS_WIN = WS_CTL + CTL_ZERO_BYTES;
constexpr size_t WS_WUP = WS_WIN + al256((size_t)2 * DINP * D * 2);
constexpr size_t WS_WMEM = WS_WUP + al256((size_t)2 * NUP * AQ * 2);
constexpr size_t WS_WOUT = WS_WMEM + al256((size_t)2 * 1024 * D * 2);
constexpr size_t WS_WGU = WS_WOUT + al256((size_t)2 * D * D * 2);
constexpr size_t WS_WDN = WS_WGU + al256((size_t)2 * DFF * D * 2);
constexpr size_t WS_MGU = WS_WDN + al256((size_t)D * DFF * 2);
constexpr size_t WS_MDN = WS_MGU + al256((size_t)NE * 2 * DFE * D * 2);
constexpr size_t WS_XN = WS_MDN + al256((size_t)NE * D * DFE * 2);
constexpr size_t WS_MEMN = WS_XN + al256((size_t)S * D * 2);
constexpr size_t WS_MEMKV = WS_MEMN + al256((size_t)2 * NMEM * D * 2);
constexpr size_t WS_PROJ = WS_MEMKV + al256((size_t)2 * NMEM * 1024 * 2);
constexpr size_t WS_AQKV = WS_PROJ + al256((size_t)S * DINP * 2);
constexpr size_t WS_KROPE = WS_AQKV + al256((size_t)S * AQ * 2);
constexpr size_t WS_ROPECS = WS_KROPE + al256((size_t)S * 64 * 2);
constexpr size_t WS_QKVM = WS_ROPECS + al256((size_t)S * 64 * 4);
constexpr size_t WS_YPRE = WS_QKVM + al256((size_t)S * NUP * 2);
constexpr size_t WS_DILO = WS_YPRE + al256((size_t)S * D * 4);
constexpr size_t WS_DILS = WS_DILO + al256((size_t)3 * S * 768 * 4);
constexpr size_t WS_Y = WS_DILS + al256((size_t)3 * S * 12 * 4);
constexpr size_t WS_XA = WS_Y + al256((size_t)S * D * 2);
constexpr size_t WS_ROUTE = WS_XA + al256((size_t)S * D * 4);
constexpr size_t WS_XP = WS_ROUTE + al256((size_t)S * 32);
constexpr size_t WS_OUTP = WS_XP + al256((size_t)MP * D * 2);
constexpr size_t WS_ACTP = WS_OUTP + al256((size_t)MP * D * 2);
constexpr size_t WS_OUTQ = WS_ACTP + al256((size_t)MP * DFE * 2);
constexpr size_t WS_END = WS_OUTQ + al256((size_t)4 * 2048 * D * 2);
static_assert(WS_END <= 1879048192ull, "workspace map exceeds 4 x the largest input");
constexpr int CW_BAR = 16384;
constexpr int CW_QUEUE = 8192;
constexpr int CW_CNT = 8192 + 256;
constexpr int CW_QUEUE2 = 65536;
constexpr int CW_CVT = 8192 + 320;
constexpr int CW_DONE = 8192 + 384;
constexpr int CW_TILEE = 8192 + 512;
constexpr int RING_BYTES = 131072;
constexpr int LDSCTL_OFF = RING_BYTES, MISC_OFF = LDSCTL_OFF + 320;
constexpr int BIAS_OFF = 132096;
constexpr int LDS_BYTES = 147456;
static_assert(BIAS_OFF >= MISC_OFF + 128 && BIAS_OFF + 3 * 6 * 132 * 4 + 4 * 196 * 4 <= LDS_BYTES, "LDS map");

#define GAS __attribute__((address_space(1)))
#define LAS __attribute__((address_space(3)))
typedef unsigned short bf16;
typedef unsigned v4u __attribute__((ext_vector_type(4)));
typedef unsigned v2u __attribute__((ext_vector_type(2)));
typedef float f32x4 __attribute__((ext_vector_type(4)));
typedef short bf16x8 __attribute__((ext_vector_type(8)));
typedef GAS unsigned gu32;
#define RLX_AGENT __ATOMIC_RELAXED, __HIP_MEMORY_SCOPE_AGENT
#define LDS_WAIT() asm volatile("s_waitcnt lgkmcnt(0)" ::: "memory")
#define VM_WAIT() asm volatile("s_waitcnt vmcnt(0)" ::: "memory")
__device__ __forceinline__ unsigned f2bf(float f) { unsigned u = __builtin_bit_cast(unsigned, f); return (u + 0x7fffu + ((u >> 16) & 1u)) >> 16; }
__device__ __forceinline__ unsigned pk2(float lo, float hi) { return f2bf(lo) | (f2bf(hi) << 16); }
__device__ __forceinline__ float bflo(unsigned w) { return __uint_as_float(w << 16); }
__device__ __forceinline__ float bfhi(unsigned w) { return __uint_as_float(w & 0xffff0000u); }

#define XB_TMO      128
#define XB_XCNT(j)  (256  + 64 * (j))
#define XB_XSUB(j)  (1280 + 64 * (j))
#define XB_XGEN(j)  (2304 + 64 * (j))
#define XB_TOP      3328
#define XB_TOPGEN   3392
#define XCD_BAR_WORDS 3456
#define XB_SPIN_CAP (1u << 18)
__device__ __forceinline__ unsigned xb_ld(unsigned* p)              { return __hip_atomic_load(p, __ATOMIC_RELAXED, __HIP_MEMORY_SCOPE_AGENT); }
__device__ __forceinline__ unsigned xb_add(unsigned* p, unsigned v) { return __hip_atomic_fetch_add(p, v, __ATOMIC_RELAXED, __HIP_MEMORY_SCOPE_AGENT); }
__device__ __forceinline__ unsigned xb_xcc_id() { return (unsigned)__builtin_amdgcn_s_getreg((3 << 11) | 20) & 0xFu; }
#define XB_SPIN(cond, bar) do { unsigned _sp = 0; while (cond) { __builtin_amdgcn_s_sleep(1); \
    if ((++_sp & 255u) == 0u) { if (xb_ld(&(bar)[XB_TMO])) break; if (_sp > XB_SPIN_CAP) { atomicAdd(&(bar)[XB_TMO], 1u); break; } } } } while (0)
struct XcdBarrier { unsigned* bar; unsigned x; volatile LAS unsigned* st; };
__device__ __forceinline__ XcdBarrier xcd_barrier_post(unsigned* bar, volatile LAS unsigned* st) {
    XcdBarrier b; b.bar = bar; b.x = xb_xcc_id(); b.st = st;
    if (threadIdx.x == 0) (void)xb_add(&bar[XB_XCNT(b.x)], 1u);
    return b;
}
__device__ __forceinline__ void xcd_barrier_complete(unsigned* bar, unsigned x, unsigned& nloc, unsigned& nx) {
    const unsigned G = gridDim.x * gridDim.y * gridDim.z;
    unsigned sum, cnt, mine, sp = 0u;
    for (;;) {
        sum = 0u; cnt = 0u; mine = 0u;
#pragma unroll
        for (unsigned j = 0; j < 16; ++j) { const unsigned c = xb_ld(&bar[XB_XCNT(j)]); sum += c; cnt += (c > 0u) ? 1u : 0u; mine = (j == x) ? c : mine; }
        if (sum == G) break;
        __builtin_amdgcn_s_sleep(1);
        if ((++sp & 255u) == 0u) { if (xb_ld(&bar[XB_TMO])) break; if (sp > XB_SPIN_CAP) { atomicAdd(&bar[XB_TMO], 1u); break; } }
    }
    nloc = mine > 0u ? mine : 1u; nx = cnt > 0u ? cnt : 1u;
}
__device__ __forceinline__ void xcd_barrier(const XcdBarrier& b) {
    asm volatile("s_waitcnt vmcnt(0)" ::: "memory");
    __syncthreads();
    if (threadIdx.x == 0) {
        unsigned* bar = b.bar;
        __builtin_amdgcn_s_waitcnt(0);
        unsigned nloc = b.st[0], nx = b.st[1];
        if (nloc == 0u) { xcd_barrier_complete(bar, b.x, nloc, nx); b.st[0] = nloc; b.st[1] = nx; }
        const unsigned old = xb_add(&bar[XB_XSUB(b.x)], 1u);
        const unsigned gen = old / nloc;
        if (old + 1u == (gen + 1u) * nloc) {
            __builtin_amdgcn_fence(__ATOMIC_RELEASE, "agent");
            asm volatile("s_waitcnt vmcnt(0)" ::: "memory");
            const unsigned og = xb_add(&bar[XB_TOP], 1u);
            const unsigned tg = og / nx;
            if (og + 1u == (tg + 1u) * nx) xb_add(&bar[XB_TOPGEN], 1u);
            else XB_SPIN(xb_ld(&bar[XB_TOPGEN]) == tg, bar);
            __builtin_amdgcn_fence(__ATOMIC_ACQUIRE, "agent");
            xb_add(&bar[XB_XGEN(b.x)], 1u);
            asm volatile("s_waitcnt vmcnt(0)" ::: "memory");
        } else {
            XB_SPIN(xb_ld(&bar[XB_XGEN(b.x)]) == gen, bar);
            __builtin_amdgcn_fence(__ATOMIC_ACQUIRE, "agent");
            asm volatile("s_waitcnt vmcnt(0)" ::: "memory");
        }
    }
    __syncthreads();
}

struct Args {
    const float* in[23]; float* out; unsigned char* ws;
    float invf[32];
    int ph_lo, ph_hi, li, rep;
};
struct Frame {
    LAS unsigned char* lds;
    volatile LAS unsigned* MISC;
    gu32* ctl;
    int tid, lane, wave, G, gw, NGW;
    unsigned char* ws;
};
__device__ __forceinline__ float wave_sum(float v) {
#pragma unroll
    for (int o = 1; o < 64; o <<= 1) v += __shfl_xor(v, o);
    return v;
}
__device__ __forceinline__ float wave_max(float v) {
#pragma unroll
    for (int o = 1; o < 64; o <<= 1) v = fmaxf(v, __shfl_xor(v, o));
    return v;
}

__device__ __forceinline__ unsigned pk4_fp8(float a, float b, float c, float d) { int w = 0; w = __builtin_amdgcn_cvt_pk_fp8_f32(a, b, w, false); w = __builtin_amdgcn_cvt_pk_fp8_f32(c, d, w, true); return (unsigned)w; }
#if defined(CVT_REG) && CVT_REG
__device__ __forceinline__ void cvt_load(const float* __restrict__ W, int N, int k0, int n0, int lane, f32x4 (&v)[8]) {
    const GAS float* p = (const GAS float*)(W + (size_t)(k0 + (lane >> 5) * 32) * N + n0 + (lane & 31));
#pragma unroll
    for (int i = 0; i < 8; ++i)
#pragma unroll
        for (int e = 0; e < 4; ++e) v[i][e] = __builtin_nontemporal_load(p + (size_t)(i * 4 + e) * N);
}
template <bool FP8>
__device__ __forceinline__ void cvt_finish(const f32x4 (&v)[8], int k0, void* __restrict__ dstv, int ldd, int drow0, int kdst0, LAS float* scr, int lane, float wsc) {
    const int n = lane & 31, kh = (lane >> 5) * 32;
    if constexpr (FP8) { GAS v4u* d = (GAS v4u*)((unsigned char*)dstv + (size_t)(drow0 + n) * ldd + kdst0 + k0 + kh);
#pragma unroll
        for (int j = 0; j < 2; ++j) { v4u o;
            o.x = pk4_fp8(v[4 * j][0] * wsc, v[4 * j][1] * wsc, v[4 * j][2] * wsc, v[4 * j][3] * wsc); o.y = pk4_fp8(v[4 * j + 1][0] * wsc, v[4 * j + 1][1] * wsc, v[4 * j + 1][2] * wsc, v[4 * j + 1][3] * wsc);
            o.z = pk4_fp8(v[4 * j + 2][0] * wsc, v[4 * j + 2][1] * wsc, v[4 * j + 2][2] * wsc, v[4 * j + 2][3] * wsc); o.w = pk4_fp8(v[4 * j + 3][0] * wsc, v[4 * j + 3][1] * wsc, v[4 * j + 3][2] * wsc, v[4 * j + 3][3] * wsc);
            __builtin_nontemporal_store(o, d + j); } }
    else { GAS v4u* d = (GAS v4u*)((bf16*)dstv + (size_t)(drow0 + n) * ldd + kdst0 + k0 + kh);
#pragma unroll
        for (int j = 0; j < 4; ++j) { v4u o; o.x = pk2(v[2 * j][0], v[2 * j][1]); o.y = pk2(v[2 * j][2], v[2 * j][3]); o.z = pk2(v[2 * j + 1][0], v[2 * j + 1][1]); o.w = pk2(v[2 * j + 1][2], v[2 * j + 1][3]);
            __builtin_nontemporal_store(o, d + j); } }
}
#else
__device__ __forceinline__ void cvt_load(const float* __restrict__ W, int N, int k0, int n0, int lane, f32x4 (&v)[8]) {
    const int lr = lane >> 3, lc = (lane & 7) * 4;
#pragma unroll
    for (int i = 0; i < 8; ++i) v[i] = __builtin_nontemporal_load((const GAS f32x4*)(W + (size_t)(k0 + i * 8 + lr) * N + n0 + lc));
}
template <bool FP8>
__device__ __forceinline__ void cvt_finish(const f32x4 (&v)[8], int k0, void* __restrict__ dstv, int ldd, int drow0, int kdst0, LAS float* scr, int lane, float wsc) {
    const int lr = lane >> 3, lc = (lane & 7) * 4;
#pragma unroll
    for (int i = 0; i < 8; ++i) { LAS float* s = scr + (i * 8 + lr) * 33 + lc; s[0] = v[i][0]; s[1] = v[i][1]; s[2] = v[i][2]; s[3] = v[i][3]; }
    LDS_WAIT(); asm volatile("" ::: "memory");
    const int c = lane & 7;
#pragma unroll
    for (int j = 0; j < 4; ++j) { const int n = (lane >> 3) + 8 * j; const LAS float* s = scr + (8 * c) * 33 + n;
        if constexpr (FP8) { v2u o; o.x = pk4_fp8(s[0 * 33] * wsc, s[1 * 33] * wsc, s[2 * 33] * wsc, s[3 * 33] * wsc); o.y = pk4_fp8(s[4 * 33] * wsc, s[5 * 33] * wsc, s[6 * 33] * wsc, s[7 * 33] * wsc);
            __builtin_nontemporal_store(o, (GAS v2u*)((unsigned char*)dstv + (size_t)(drow0 + n) * ldd + kdst0 + k0 + 8 * c)); }
        else { v4u o; o.x = pk2(s[0 * 33], s[1 * 33]); o.y = pk2(s[2 * 33], s[3 * 33]); o.z = pk2(s[4 * 33], s[5 * 33]); o.w = pk2(s[6 * 33], s[7 * 33]);
            __builtin_nontemporal_store(o, (GAS v4u*)((bf16*)dstv + (size_t)(drow0 + n) * ldd + kdst0 + k0 + 8 * c)); } }
    LDS_WAIT(); asm volatile("" ::: "memory");
}
#endif
__device__ __forceinline__ int cvt_drow(int mode, int n0, int roff) { return mode == 0 ? n0 + roff : (mode == 1 ? (n0 >> 7) * 256 + (n0 & 127) : (mode == 2 ? (n0 >> 7) * 256 + 128 + (n0 & 127) : (n0 < 576 ? n0 : n0 + 192))); }
template <bool FP8>
__device__ __forceinline__ void cvt_job(Frame& F, const float* W, int K, int N, void* dst, int ldd, int kdst0, int mode, int roff, LAS float* scr, float wsc) {
    const int nnb = N / 32, nitems = (K / 64) * nnb;
    int it = F.gw; if (it >= nitems) return;
    f32x4 va[8], vb[8];
    cvt_load(W, N, (it / nnb) * 64, (it % nnb) * 32, F.lane, va);
    for (;;) {
        const int it1 = it + F.NGW; if (it1 < nitems) cvt_load(W, N, (it1 / nnb) * 64, (it1 % nnb) * 32, F.lane, vb);
        cvt_finish<FP8>(va, (it / nnb) * 64, dst, ldd, cvt_drow(mode, (it % nnb) * 32, roff), kdst0, scr, F.lane, wsc);
        if (it1 >= nitems) break;
        const int it2 = it1 + F.NGW; if (it2 < nitems) cvt_load(W, N, (it2 / nnb) * 64, (it2 % nnb) * 32, F.lane, va);
        cvt_finish<FP8>(vb, (it1 / nnb) * 64, dst, ldd, cvt_drow(mode, (it1 % nnb) * 32, roff), kdst0, scr, F.lane, wsc);
        if (it2 >= nitems) break;
        it = it2;
    }
}
__device__ __forceinline__ void rms_row_to_bf16(const float* xrow, const float* g, bf16* orow, int lane) {
    const GAS f32x4* xr = (const GAS f32x4*)xrow + lane; const GAS f32x4* gr = (const GAS f32x4*)g + lane;
    f32x4 v[8]; float s = 0.f;
#pragma unroll
    for (int j = 0; j < 8; ++j) { v[j] = xr[64 * j]; s += (v[j].x * v[j].x + v[j].y * v[j].y) + (v[j].z * v[j].z + v[j].w * v[j].w); }
    const float rstd = 1.f / sqrtf(wave_sum(s) * (1.f / D) + EPS);
    GAS v2u* o8 = (GAS v2u*)orow + lane;
#pragma unroll
    for (int j = 0; j < 8; ++j) { const f32x4 gg = gr[64 * j]; v2u w; w.x = pk2(v[j].x * rstd * gg.x, v[j].y * rstd * gg.y); w.y = pk2(v[j].z * rstd * gg.z, v[j].w * rstd * gg.w); o8[64 * j] = w; }
}
__device__ __forceinline__ void rms_row_to_fp8(const float* xrow, const float* g, unsigned char* orow, int lane) {
    const GAS f32x4* xr = (const GAS f32x4*)xrow + lane; const GAS f32x4* gr = (const GAS f32x4*)g + lane;
    f32x4 v[8]; float s = 0.f;
#pragma unroll
    for (int j = 0; j < 8; ++j) { v[j] = xr[64 * j]; s += (v[j].x * v[j].x + v[j].y * v[j].y) + (v[j].z * v[j].z + v[j].w * v[j].w); }
    const float rstd = 1.f / sqrtf(wave_sum(s) * (1.f / D) + EPS);
    GAS unsigned* o4 = (GAS unsigned*)orow + lane;
#pragma unroll
    for (int j = 0; j < 8; ++j) { const f32x4 gg = gr[64 * j]; o4[64 * j] = pk4_fp8(v[j].x * rstd * gg.x, v[j].y * rstd * gg.y, v[j].z * rstd * gg.z, v[j].w * rstd * gg.w); }
}
__device__ __forceinline__ void sincos_f64(float ang, float& c, float& s) {
    const double a = (double)ang, twopi = 6.283185307179586476925286766559, inv2pi = 0.15915494309189533576888376337251;
    const double q = __builtin_rint(a * inv2pi); const double r = a - q * twopi;
    const double r2 = r * r; double ss = 1.0, cc = 1.0;
#pragma unroll
    for (int k = 14; k >= 1; --k) { ss = 1.0 - r2 * (1.0 / (double)((2 * k) * (2 * k + 1))) * ss; cc = 1.0 - r2 * (1.0 / (double)((2 * k - 1) * (2 * k))) * cc; }
    s = (float)(r * ss); c = (float)cc;
}
__device__ const unsigned char DIL_BUCKET[3][129] = {
 {11,11,11,11,11,11,11,11,11,11,11,11,11,11,11,10,10,10,10,10,10,10,10,10,10,10,10,10,10,10,10,10,10,10,10,10,10,10,9,9,9,9,9,9,9,9,9,9,9,9,8,8,8,8,8,8,8,7,6,5,4,3,2,1,0,17,18,19,20,21,22,23,24,24,24,24,24,24,24,25,25,25,25,25,25,25,25,25,25,25,25,26,26,26,26,26,26,26,26,26,26,26,26,26,26,26,26,26,26,26,26,26,26,26,27,27,27,27,27,27,27,27,27,27,27,27,27,27,27},
 {13,13,13,13,13,13,13,13,13,13,13,13,13,13,13,13,13,13,13,13,13,13,13,12,12,12,12,12,12,12,12,12,12,12,12,12,12,12,12,12,12,12,11,11,11,11,11,11,11,11,11,11,10,10,10,10,10,10,9,9,9,8,8,4,0,20,24,24,25,25,25,26,26,26,26,26,26,27,27,27,27,27,27,27,27,27,27,28,28,28,28,28,28,28,28,28,28,28,28,28,28,28,28,28,28,28,29,29,29,29,29,29,29,29,29,29,29,29,29,29,29,29,29,29,29,29,29,29,29},
 {15,15,15,15,15,15,15,15,15,15,15,15,15,15,15,15,15,15,15,15,15,15,15,15,15,15,15,15,15,15,14,14,14,14,14,14,14,14,14,14,14,14,14,14,14,13,13,13,13,13,13,13,13,13,12,12,12,12,12,11,11,10,10,9,0,25,26,26,27,27,28,28,28,28,28,29,29,29,29,29,29,29,29,29,30,30,30,30,30,30,30,30,30,30,30,30,30,30,30,31,31,31,31,31,31,31,31,31,31,31,31,31,31,31,31,31,31,31,31,31,31,31,31,31,31,31,31,31,31}};

typedef float f32x2 __attribute__((ext_vector_type(2)));
#ifndef PH_MASK
#define PH_MASK 0xFFFFu
#endif
#ifndef REPEAT_PHASE
#define REPEAT_PHASE -1
#endif
#ifndef ATT_EN
#define ATT_EN 7
#endif
#define PEN(k) ((PH_MASK >> (k)) & 1u)
#ifndef FFN_FP8
#define FFN_FP8 3
#endif
constexpr bool F8D = (FFN_FP8 & 1) != 0, F8M = (FFN_FP8 & 2) != 0;
constexpr int EBD = F8D ? 1 : 2, EBM = F8M ? 1 : 2;
template <bool B> struct Sc { static constexpr float w_gu = B ? 32.f : 1.f, w_dn = B ? 64.f : 1.f, a_sc = B ? 4.f : 1.f, dn = 1.f / (w_dn * a_sc); };
template <bool B> using FfnEpi1 = typename std::conditional<B, pg8::EpiSwiGLU8, pg8::EpiSwiGLU>::type;
template <bool B> struct Epi1Maker;
template <> struct Epi1Maker<true> { static __device__ __forceinline__ pg8::EpiSwiGLU8 make(void* O, int ldc) { return pg8::EpiSwiGLU8{(unsigned char*)O, ldc, 1.f / Sc<true>::w_gu, Sc<true>::a_sc}; } };
template <> struct Epi1Maker<false> { static __device__ __forceinline__ pg8::EpiSwiGLU make(void* O, int ldc) { return pg8::EpiSwiGLU{(unsigned short*)O, ldc}; } };

constexpr int MOE_MAT_ITEMS = 7168, MOE_GU_ITEMS = 16 * MOE_MAT_ITEMS, MOE_NITEMS = 24 * MOE_MAT_ITEMS, MOE_CHUNK = 64, MOE_NCHUNK = MOE_NITEMS / MOE_CHUNK;
struct MoeItem { const float* W; void* dst; int N, k0, n0, ldd, drow0; float wsc; };
typedef const __attribute__((address_space(4))) Args* KArgs;
__device__ __forceinline__ MoeItem moe_item(KArgs ka, unsigned char* ws, int idx) {
    MoeItem m;
    if (idx < MOE_GU_ITEMS) { const int mat = idx / MOE_MAT_ITEMS, local = idx % MOE_MAT_ITEMS, e = mat >> 1, up = mat & 1, kb = local / (DFE / 32), nb = local % (DFE / 32);
        m.W = ka->in[19 + up] + (size_t)e * D * DFE; m.N = DFE; m.k0 = kb * 64; m.n0 = nb * 32; m.dst = ws + WS_MGU + (size_t)e * 2 * DFE * D * EBM; m.ldd = D;
        m.drow0 = (m.n0 >> 7) * 256 + up * 128 + (m.n0 & 127); m.wsc = Sc<F8M>::w_gu; }
    else { const int i2 = idx - MOE_GU_ITEMS, e = i2 / MOE_MAT_ITEMS, local = i2 % MOE_MAT_ITEMS, kb = local / (D / 32), nb = local % (D / 32);
        m.W = ka->in[21] + (size_t)e * DFE * D; m.N = D; m.k0 = kb * 64; m.n0 = nb * 32; m.dst = ws + WS_MDN + (size_t)e * D * DFE * EBM; m.ldd = DFE; m.drow0 = m.n0; m.wsc = Sc<F8M>::w_dn; }
    return m;
}
__device__ __forceinline__ void moe_cvt_chunk(Frame& F, KArgs ka, int c) {
    LAS float* scr = (LAS float*)(F.lds + F.wave * 16384);
    const int i0 = c * MOE_CHUNK + F.wave * 8;
    f32x4 va[8], vb[8], vc[8]; MoeItem ma, mb, mc;
#define MC_L(m, v, i) do { m = moe_item(ka, F.ws, i0 + (i)); cvt_load(m.W, m.N, m.k0, m.n0, F.lane, v); } while (0)
#define MC_F(m, v) cvt_finish<F8M>(v, m.k0, m.dst, m.ldd, m.drow0, 0, scr, F.lane, m.wsc)
    MC_L(ma, va, 0); MC_L(mb, vb, 1); MC_L(mc, vc, 2);
    MC_F(ma, va); MC_L(ma, va, 3); MC_F(mb, vb); MC_L(mb, vb, 4); MC_F(mc, vc); MC_L(mc, vc, 5);
    MC_F(ma, va); MC_L(ma, va, 6); MC_F(mb, vb); MC_L(mb, vb, 7); MC_F(mc, vc); MC_F(ma, va); MC_F(mb, vb);
#undef MC_L
#undef MC_F
}
__device__ __forceinline__ void moe_cvt_fill(Frame& F, KArgs ka, int ph) {
    { int t_ = threadIdx.x; asm volatile("" : "+v"(t_)); F.tid = t_; F.lane = t_ & 63; }
    for (;;) {
        if (F.tid == 0) { unsigned c = MOE_NCHUNK;
            if (ph < 0 || __hip_atomic_load(F.ctl + CW_DONE + ph, RLX_AGENT) < (unsigned)F.G) c = __hip_atomic_fetch_add(F.ctl + CW_CVT + (ph == -2 ? 16 : 0), 1u, RLX_AGENT);
            F.MISC[17] = c; }
        __syncthreads(); const unsigned c = F.MISC[17]; __syncthreads();
        if (c >= (unsigned)MOE_NCHUNK) break;
        moe_cvt_chunk(F, ka, (int)c);
    }
}
#define FILL(ph) do { __syncthreads(); if (F.tid == 0) (void)__hip_atomic_fetch_add(F.ctl + CW_DONE + (ph), 1u, RLX_AGENT); moe_cvt_fill(F, ka, (ph)); } while (0)
#ifndef MLA_DMA
#define MLA_DMA 1
#endif
#ifndef MOE_TAIL
#define MOE_TAIL 1
#endif
#ifndef GEMM_SP2
#define GEMM_SP2 1
#endif
constexpr bool SP2V = (GEMM_SP2 != 0);
#ifndef PROBE_ATT
#define PROBE_ATT 7
#endif
#ifndef FILLMASK
#define FILLMASK 7
#endif
constexpr int PH_PER_LAYER = 11, N_PHASES = 1 + 2 * PH_PER_LAYER;
#ifndef MK_N_LAUNCHES
#define MK_N_LAUNCHES 1
#endif
constexpr int N_LAUNCHES = MK_N_LAUNCHES;

__global__ void __launch_bounds__(NWAVES * 64, 2) mk_fwd(Args) {
    KArgs ka = (KArgs)__builtin_amdgcn_kernarg_segment_ptr(); asm volatile("" : "+s"(ka));
#define args (*ka)
    extern __shared__ __attribute__((aligned(16))) unsigned char lds[];
    Frame F;
    F.lds = (LAS unsigned char*)lds;
    F.MISC = (volatile LAS unsigned*)(F.lds + MISC_OFF);
    F.tid = threadIdx.x; F.lane = F.tid & 63; F.wave = __builtin_amdgcn_readfirstlane(F.tid >> 6);
    F.G = gridDim.x; F.gw = blockIdx.x * NWAVES + F.wave; F.NGW = F.G * NWAVES;
    F.ws = args.ws; F.ctl = (gu32*)(args.ws + WS_CTL);
    unsigned char* ws = args.ws;
    for (int u = F.tid; u < (LDS_BYTES - LDSCTL_OFF) / 4; u += NWAVES * 64) ((LAS unsigned*)(F.lds + LDSCTL_OFF))[u] = 0u;
    __syncthreads();
    XcdBarrier bar; bar.bar = (unsigned*)(F.ctl + CW_BAR) + args.li * 4096; bar.x = 0; bar.st = nullptr;
    if (N_LAUNCHES != N_PHASES) bar = xcd_barrier_post((unsigned*)(F.ctl + CW_BAR) + args.li * 4096, F.MISC + 8);
#define GRID_BAR() do { if (N_LAUNCHES != N_PHASES) xcd_barrier(bar); } while (0)
    const int lo = args.ph_lo, hi = args.ph_hi;
#define IN(k) (lo <= (k) && (k) < hi)
#define BOTH(k) (IN(k) && IN((k) + 1))

#define x_in (args.in[0])
#define XN8 ((unsigned char*)(ws + WS_XN))
#define WIN ((bf16*)(ws + WS_WIN))
#define WUP ((bf16*)(ws + WS_WUP))
#define WMEM ((bf16*)(ws + WS_WMEM))
#define WOUT ((bf16*)(ws + WS_WOUT))
#define WGU ((bf16*)(ws + WS_WGU))
#define WDN ((bf16*)(ws + WS_WDN))
#define MGU ((bf16*)(ws + WS_MGU))
#define MDN ((bf16*)(ws + WS_MDN))
#define XN ((bf16*)(ws + WS_XN))
#define MEMN ((bf16*)(ws + WS_MEMN))
#define MEMKV ((bf16*)(ws + WS_MEMKV))
#define PROJ ((bf16*)(ws + WS_PROJ))
#define AQKV ((bf16*)(ws + WS_AQKV))
#define KROPE ((bf16*)(ws + WS_KROPE))
#define ROPECS ((float*)(ws + WS_ROPECS))
#define QKVM ((bf16*)(ws + WS_QKVM))
#define YPRE ((float*)(ws + WS_YPRE))
#define DILO ((float*)(ws + WS_DILO))
#define DILS ((float*)(ws + WS_DILS))
#define Y ((bf16*)(ws + WS_Y))
#define XA ((float*)(ws + WS_XA))
#define ROUTE ((unsigned*)(ws + WS_ROUTE))
#define XP ((bf16*)(ws + WS_XP))
#define OUTP ((bf16*)(ws + WS_OUTP))
#define OUTQ ((bf16*)(ws + WS_OUTQ))
#define ACTP ((bf16*)(ws + WS_ACTP))
#define ACT ((bf16*)(ws + WS_ACTP))
#define PHASE_BEGIN() do { int t_ = threadIdx.x; asm volatile("" : "+v"(t_)); F.tid = t_; F.lane = t_ & 63; asm volatile("" : "+s"(ka)); } while (0)

    if (PEN(0) && IN(0)) { PHASE_BEGIN();
        LAS float* scr = (LAS float*)(F.lds + F.wave * 16384);
        { const v4u z = {0u, 0u, 0u, 0u}; const int gt = blockIdx.x * (NWAVES * 64) + F.tid, ngt = F.G * NWAVES * 64;
          for (int l = 0; l < 2; ++l) {
              GAS v4u* w = (GAS v4u*)(WIN + (size_t)l * DINP * D + (size_t)576 * D); for (int i = gt; i < 192 * D / 8; i += ngt) w[i] = z;
              GAS v4u* u = (GAS v4u*)(WUP + (size_t)l * NUP * AQ);
              for (int i = gt; i < NUP * 64; i += ngt) { const int row = i >> 6, c = i & 63; const bool zero = row < 1152 ? (c >= 48) : (row < 1280 ? true : (c < 48)); if (zero) u[i] = z; } } }
        for (int rep = 0; rep < (REPEAT_PHASE == 0 ? 2 : 1); ++rep) {
        for (int l = 0; l < 2; ++l) {
            cvt_job<false>(F, args.in[5] + (size_t)l * D * DIN, D, DIN, WIN + (size_t)l * DINP * D, D, 0, 3, 0, scr, 1.f);
            cvt_job<false>(F, args.in[7] + (size_t)l * QR * 1152, QR, 1152, WUP + (size_t)l * NUP * AQ, AQ, 0, 0, 0, scr, 1.f);
            cvt_job<false>(F, args.in[9] + (size_t)l * KVR * 1536, KVR, 1536, WUP + (size_t)l * NUP * AQ, AQ, QR, 0, UC_KV, scr, 1.f);
            cvt_job<false>(F, args.in[11] + (size_t)l * D * 1024, D, 1024, WMEM + (size_t)l * 1024 * D, D, 0, 0, 0, scr, 1.f);
            cvt_job<false>(F, args.in[13] + (size_t)l * D * D, D, D, WOUT + (size_t)l * D * D, D, 0, 0, 0, scr, 1.f);
        }
        cvt_job<F8D>(F, args.in[15], D, DFF, WGU, D, 0, 1, 0, scr, Sc<F8D>::w_gu);
        cvt_job<F8D>(F, args.in[16], D, DFF, WGU, D, 0, 2, 0, scr, Sc<F8D>::w_gu);
        cvt_job<F8D>(F, args.in[17], DFF, D, WDN, DFF, 0, 0, 0, scr, Sc<F8D>::w_dn);
        }
        { const int* pos = (const int*)args.in[2];
          for (int idx = blockIdx.x * (NWAVES * 64) + F.tid; idx < S * 32; idx += F.G * NWAVES * 64) { const int row = idx >> 5, i = idx & 31;
              const float ang = (float)pos[row] * args.invf[i]; float c, s; sincos_f64(ang, c, s); ROPECS[row * 64 + i] = c; ROPECS[row * 64 + 32 + i] = s; } }
        for (int m = F.gw; m < 2 * NMEM; m += F.NGW) { const int l = m >> 8, r = m & 255; rms_row_to_bf16(args.in[1] + (size_t)r * D, args.in[10] + (size_t)l * D, MEMN + (size_t)m * D, F.lane); }
        for (int m = F.gw; m < S; m += F.NGW) rms_row_to_bf16(x_in + (size_t)m * D, args.in[4], XN + (size_t)m * D, F.lane);
        if (BOTH(0)) GRID_BAR();
    }

    for (int l = 0; l < 2; ++l) {
        const int pb = 1 + l * PH_PER_LAYER;
        if (PEN(1) && IN(pb + 0)) { PHASE_BEGIN();
            { pg8::Gemm g{XN, WIN + (size_t)l * DINP * D, 2 * D, 2 * D, D / 64}; pg8::InProjOrder So; So.so.init(S, DINP, F.G, (int)blockIdx.x); So.nextra = (l == 0) ? 8 : 0; So.A2 = MEMN; So.B2 = WMEM;
              pg8::EpiBf16Sel E{PROJ, DINP, MEMKV, 1024};
              pg8::gemm_phase<pg8::EpiBf16Sel, pg8::InProjOrder, true, SP2V>(F.lds, g, So, E); }
            if (FILLMASK & 1) FILL(pb + 0);
            if (BOTH(pb + 0)) GRID_BAR();
        }
        if (PEN(2) && IN(pb + 1)) { PHASE_BEGIN();
            const float* gq = args.in[6] + l * QR; const float* gkv = args.in[8] + l * KVR;
            for (int m = F.gw; m < S; m += F.NGW) {
                const v4u w = *(const GAS v4u*)(PROJ + (size_t)m * DINP + F.lane * 8);
                float v[8] = {bflo(w.x), bfhi(w.x), bflo(w.y), bfhi(w.y), bflo(w.z), bfhi(w.z), bflo(w.w), bfhi(w.w)};
                float sq = 0.f;
#pragma unroll
                for (int j = 0; j < 8; ++j) sq += v[j] * v[j];
                const float sq_q = wave_sum(F.lane < 48 ? sq : 0.f), sq_kv = wave_sum(F.lane >= 48 ? sq : 0.f);
                const float rstd = F.lane < 48 ? 1.f / sqrtf(sq_q * (1.f / QR) + EPS) : 1.f / sqrtf(sq_kv * (1.f / KVR) + EPS);
                const float* gp = F.lane < 48 ? gq + F.lane * 8 : gkv + (F.lane - 48) * 8;
                const f32x4 g0 = *(const GAS f32x4*)gp, g1 = *(const GAS f32x4*)(gp + 4);
                v4u o; o.x = pk2(v[0] * rstd * g0.x, v[1] * rstd * g0.y); o.y = pk2(v[2] * rstd * g0.z, v[3] * rstd * g0.w);
                o.z = pk2(v[4] * rstd * g1.x, v[5] * rstd * g1.y); o.w = pk2(v[6] * rstd * g1.z, v[7] * rstd * g1.w);
                *(GAS v4u*)(AQKV + (size_t)m * AQ + F.lane * 8) = o;
                const int c = F.lane & 7;
                const v4u kw = *(const GAS v4u*)(PROJ + (size_t)m * DINP + 512 + c * 8);
                float kv[8] = {bflo(kw.x), bfhi(kw.x), bflo(kw.y), bfhi(kw.y), bflo(kw.z), bfhi(kw.z), bflo(kw.w), bfhi(kw.w)};
                float ko[8];
                const float* cs = ROPECS + (size_t)m * 64 + (c & 3) * 8;
#pragma unroll
                for (int j = 0; j < 8; ++j) { const float other = __shfl_xor(kv[j], 4); const float co = cs[j], si = cs[32 + j];
                    ko[j] = (c < 4) ? (kv[j] * co - other * si) : (other * si + kv[j] * co); }
                if (F.lane < 8) { v4u ow; ow.x = pk2(ko[0], ko[1]); ow.y = pk2(ko[2], ko[3]); ow.z = pk2(ko[4], ko[5]); ow.w = pk2(ko[6], ko[7]); *(GAS v4u*)(KROPE + (size_t)m * 64 + c * 8) = ow; }
            }
            if (BOTH(pb + 1)) GRID_BAR();
        }
        if (PEN(3) && IN(pb + 2)) { PHASE_BEGIN();
            pg8::Gemm g{AQKV, WUP + (size_t)l * NUP * AQ, 2 * AQ, 2 * AQ, AQ / 64}; pg8::StaticOrder So; So.init(S, NUP, F.G, (int)blockIdx.x);
            pg8::EpiBf16 E{QKVM, NUP, 1.f};
            pg8::gemm_phase<pg8::EpiBf16, pg8::StaticOrder, true, SP2V>(F.lds, g, So, E);
            if (FILLMASK & 2) FILL(pb + 2);
            if (BOTH(pb + 2)) GRID_BAR();
        }
        if (PEN(4) && IN(pb + 3)) { PHASE_BEGIN();
            LAS float* BIAS = (LAS float*)(F.lds + BIAS_OFF);
            for (int i = F.tid; i < 3 * 6 * 129; i += NWAVES * 64) { const int b = i / (6 * 129), rem = i % (6 * 129), h = rem / 129, j = rem % 129;
                BIAS[(b * 6 + h) * 132 + j] = args.in[3][DIL_BUCKET[b][j] * 6 + h] * att::LOG2E; }
            __syncthreads();
            for (int rep = 0; rep < (REPEAT_PHASE == 4 ? 2 : 1); ++rep) {
            gu32* qhead = F.ctl + CW_QUEUE + 64 * l + 32 * rep + 4 * args.li;
            constexpr int NU_MLA = 6 * 32, NU_MEM = 4 * 32, NU_DIL = 3 * 6 * 32, NU = NU_MLA + NU_MEM + NU_DIL;
#define QPULL(u) do { if (F.tid == 0) F.MISC[16] = __hip_atomic_fetch_add(qhead, 1u, RLX_AGENT); __syncthreads(); u = (int)F.MISC[16]; __syncthreads(); } while (0)
            int u; QPULL(u);
            if ((ATT_EN & 1) && (!args.rep || (PROBE_ATT & 1))) while (u < NU_MLA) {
                const int h = u >> 5, qb = u & 31;
                att::MLA_BODY<NUP, NUP, D>(QKVM + (size_t)qb * 256 * NUP + h * 192, QKVM + UC_KV + h * 256, KROPE, QKVM + UC_KV + h * 256 + 128,
                                                        ROPECS + (size_t)qb * 256 * 64, YPRE + (size_t)qb * 256 * D + h * 128, S, 0.07216878364870322f, (LAS char*)F.lds);
                QPULL(u);
            }
            if (args.rep && !(PROBE_ATT & 1)) { while (u < NU_MLA) QPULL(u); }
            if ((ATT_EN & 2) && (!args.rep || (PROBE_ATT & 2))) while (u < NU_MLA + NU_MEM) {
                const int v = u - NU_MLA, h = v >> 5, qb = v & 31;
                const bf16* kv = MEMKV + (size_t)l * NMEM * 1024;
                att::attn_dense_body<128, DINP, 1024, D, 1>(PROJ + (size_t)qb * 256 * DINP + PC_MEM + h * 128, kv + h * 128, nullptr, kv + 512 + h * 128,
                                                            nullptr, YPRE + (size_t)qb * 256 * D + 1536 + h * 128, NMEM, 0.08838834764831845f, (LAS char*)F.lds);
                QPULL(u);
            }
            if (args.rep && !(PROBE_ATT & 2)) { while (u < NU_MLA + NU_MEM) QPULL(u); }
            if ((ATT_EN & 4) && (!args.rep || (PROBE_ATT & 4))) while (u < NU) {
                const int w = (u - NU_MLA - NU_MEM) * 8;
                const int b = w / 1536, h = (w % 1536) >> 8, tile = w & 255;
                const int d = b == 0 ? 1 : (b == 1 ? 4 : 16), nT = S / d, tpr = nT / 32;
                const int r = tile / tpr, t0 = (tile % tpr) * 32;
                LAS float* TB = (LAS float*)(F.lds + BIAS_OFF + 3 * 6 * 132 * 4);
                for (int i = F.tid; i < 4 * 196; i += NWAVES * 64) { const int k = i / 196, j = (i % 196) + k - 32; TB[i] = (j >= 0 && j <= 128) ? BIAS[(b * 6 + h) * 132 + j] : -1e30f; }
                __syncthreads();
                att::dil_wg_unit<DINP>(PROJ, PC_DIL + h * 128, PC_DIL + 768 + h * 128, PC_DIL + 1536 + h * 128, d, r, t0, nT,
                                       DILO + (size_t)b * S * 768, h * 128, DILS + (size_t)b * S * 12 + h * 2, (LAS char*)F.lds, TB, 0.08838834764831845f * att::LOG2E);
                QPULL(u);
            }
#undef QPULL
            }
            if (FILLMASK & 4) FILL(pb + 3);
            if (BOTH(pb + 3)) GRID_BAR();
        }
        if (PEN(5) && IN(pb + 4)) { PHASE_BEGIN();
            const float* gn = args.in[12] + (size_t)l * D;
            for (int m = F.gw; m < S; m += F.NGW) {
                const float* yr = YPRE + (size_t)m * D;
                f32x4 a[3]; float sa = 0.f;
#pragma unroll
                for (int j = 0; j < 3; ++j) { a[j] = *(const GAS f32x4*)(yr + (F.lane + 64 * j) * 4); sa += (a[j].x * a[j].x + a[j].y * a[j].y) + (a[j].z * a[j].z + a[j].w * a[j].w); }
                f32x4 c[2]; float sc = 0.f;
#pragma unroll
                for (int j = 0; j < 2; ++j) { c[j] = *(const GAS f32x4*)(yr + 1536 + (F.lane + 64 * j) * 4); sc += (c[j].x * c[j].x + c[j].y * c[j].y) + (c[j].z * c[j].z + c[j].w * c[j].w); }
                f32x4 bq[3]; float sb = 0.f;
#pragma unroll
                for (int j = 0; j < 3; ++j) { const int col = (F.lane + 64 * j) * 4, h = col >> 7;
                    float mm[3], zz[3];
#pragma unroll
                    for (int b = 0; b < 3; ++b) { const f32x2 st = *(const GAS f32x2*)(DILS + ((size_t)b * S + m) * 12 + h * 2); mm[b] = st.x; zz[b] = st.y; }
                    const float M = fmaxf(mm[0], fmaxf(mm[1], mm[2]));
                    float wgt[3], den = 0.f;
#pragma unroll
                    for (int b = 0; b < 3; ++b) { wgt[b] = __builtin_amdgcn_exp2f(mm[b] - M); den += wgt[b] * zz[b]; }
                    const float inv = 1.f / den; f32x4 acc = {0.f, 0.f, 0.f, 0.f};
#pragma unroll
                    for (int b = 0; b < 3; ++b) { const f32x4 ob = *(const GAS f32x4*)(DILO + ((size_t)b * S + m) * 768 + col); acc += ob * (wgt[b] * inv); }
                    bq[j] = acc; sb += (acc.x * acc.x + acc.y * acc.y) + (acc.z * acc.z + acc.w * acc.w); }
                const float ra = 1.f / sqrtf(wave_sum(sa) * (1.f / 768.f) + EPS), rb = 1.f / sqrtf(wave_sum(sb) * (1.f / 768.f) + EPS), rc = 1.f / sqrtf(wave_sum(sc) * (1.f / 512.f) + EPS);
                bf16* yo = Y + (size_t)m * D;
#pragma unroll
                for (int j = 0; j < 3; ++j) { const int col = (F.lane + 64 * j) * 4; const f32x4 g = *(const GAS f32x4*)(gn + col);
                    v2u w; w.x = pk2(a[j].x * ra * g.x, a[j].y * ra * g.y); w.y = pk2(a[j].z * ra * g.z, a[j].w * ra * g.w); *(GAS v2u*)(yo + col) = w; }
#pragma unroll
                for (int j = 0; j < 3; ++j) { const int col = (F.lane + 64 * j) * 4; const f32x4 g = *(const GAS f32x4*)(gn + 768 + col);
                    v2u w; w.x = pk2(bq[j].x * rb * g.x, bq[j].y * rb * g.y); w.y = pk2(bq[j].z * rb * g.z, bq[j].w * rb * g.w); *(GAS v2u*)(yo + 768 + col) = w; }
#pragma unroll
                for (int j = 0; j < 2; ++j) { const int col = (F.lane + 64 * j) * 4; const f32x4 g = *(const GAS f32x4*)(gn + 1536 + col);
                    v2u w; w.x = pk2(c[j].x * rc * g.x, c[j].y * rc * g.y); w.y = pk2(c[j].z * rc * g.z, c[j].w * rc * g.w); *(GAS v2u*)(yo + 1536 + col) = w; }
            }
            if (BOTH(pb + 4)) GRID_BAR();
        }
        if (PEN(6) && IN(pb + 5)) { PHASE_BEGIN();
            pg8::Gemm g{Y, WOUT + (size_t)l * D * D, 2 * D, 2 * D, D / 64}; pg8::StaticOrder So; So.init(S, D, F.G, (int)blockIdx.x);
            pg8::EpiResF32 E{l == 0 ? x_in : XA, args.rep ? YPRE : XA, D, 1.f};
            pg8::gemm_phase<pg8::EpiResF32, pg8::StaticOrder, true, SP2V>(F.lds, g, So, E);
            if (BOTH(pb + 5)) GRID_BAR();
        }
        if (PEN(7) && IN(pb + 6)) { PHASE_BEGIN();
            const float* gf = args.in[14] + (size_t)l * D;
#if defined(PROBE_DEADLINE)
            if (l == 1 && blockIdx.x == 0 && F.tid == 0) F.ctl[CW_CVT + 16] = __hip_atomic_load(F.ctl + CW_CVT, RLX_AGENT);
#endif
            if (l == 0) { for (int m = F.gw; m < S; m += F.NGW) { if constexpr (F8D) rms_row_to_fp8(XA + (size_t)m * D, gf, XN8 + (size_t)m * D, F.lane); else rms_row_to_bf16(XA + (size_t)m * D, gf, XN + (size_t)m * D, F.lane); } }
            else {
                const float* Wr = args.in[18];
                for (int m = F.gw; m < S; m += F.NGW) {
                    const GAS f32x4* xr = (const GAS f32x4*)(XA + (size_t)m * D) + F.lane; const GAS f32x4* gr = (const GAS f32x4*)gf + F.lane;
                    f32x4 v[8]; float s = 0.f;
#pragma unroll
                    for (int j = 0; j < 8; ++j) { v[j] = xr[64 * j]; s += (v[j].x * v[j].x + v[j].y * v[j].y) + (v[j].z * v[j].z + v[j].w * v[j].w); }
                    const float rstd = 1.f / sqrtf(wave_sum(s) * (1.f / D) + EPS);
                    float lg[8] = {0.f, 0.f, 0.f, 0.f, 0.f, 0.f, 0.f, 0.f};
                    GAS v2u* o8 = (GAS v2u*)(XN + (size_t)m * D) + F.lane; GAS unsigned* o4 = (GAS unsigned*)(XN8 + (size_t)m * D) + F.lane;
#pragma unroll
                    for (int j = 0; j < 8; ++j) { const f32x4 gg = gr[64 * j]; const f32x4 hh = {v[j].x * rstd * gg.x, v[j].y * rstd * gg.y, v[j].z * rstd * gg.z, v[j].w * rstd * gg.w};
                        if constexpr (F8M) o4[64 * j] = pk4_fp8(hh.x, hh.y, hh.z, hh.w); else { v2u w; w.x = pk2(hh.x, hh.y); w.y = pk2(hh.z, hh.w); o8[64 * j] = w; }
                        const float* wr = Wr + (size_t)((F.lane + 64 * j) * 4) * NE;
#pragma unroll
                        for (int q = 0; q < 4; ++q) { const f32x4 w0 = *(const GAS f32x4*)(wr + q * NE), w1 = *(const GAS f32x4*)(wr + q * NE + 4); const float hv = hh[q];
                            lg[0] += hv * w0.x; lg[1] += hv * w0.y; lg[2] += hv * w0.z; lg[3] += hv * w0.w; lg[4] += hv * w1.x; lg[5] += hv * w1.y; lg[6] += hv * w1.z; lg[7] += hv * w1.w; } }
#pragma unroll
                    for (int e = 0; e < NE; ++e) lg[e] = wave_sum(lg[e]);
                    int e1 = 0; float v1 = lg[0];
#pragma unroll
                    for (int e = 1; e < NE; ++e) if (lg[e] > v1) { v1 = lg[e]; e1 = e; }
                    int e2 = -1; float v2 = -3.0e38f;
#pragma unroll
                    for (int e = 0; e < NE; ++e) if (e != e1 && lg[e] > v2) { v2 = lg[e]; e2 = e; }
                    const float g1 = 1.f / (1.f + __expf(v2 - v1)), g2 = 1.f - g1;
                    if (F.lane == 0) { const unsigned s1 = __hip_atomic_fetch_add(F.ctl + CW_CNT + e1, 1u, RLX_AGENT), s2 = __hip_atomic_fetch_add(F.ctl + CW_CNT + e2, 1u, RLX_AGENT);
                        v4u r0 = {(unsigned)e1, (unsigned)e2, s1, s2}; v4u r1 = {__float_as_uint(g1), __float_as_uint(g2), 0u, 0u};
                        *(GAS v4u*)(ROUTE + (size_t)m * 8) = r0; *(GAS v4u*)(ROUTE + (size_t)m * 8 + 4) = r1; }
                }
            }
            if (BOTH(pb + 6)) GRID_BAR();
        }
        if (PEN(8) && IN(pb + 7)) { PHASE_BEGIN();
            if (l == 1) {
                moe_cvt_fill(F, ka, -1);
#if defined(PROBE_DEADLINE)
                for (int r_ = 0; r_ < PROBE_DEADLINE; ++r_) { __syncthreads(); moe_cvt_fill(F, ka, -2); }
#endif
                int base[NE]; int tstart = 0;
#pragma unroll
                for (int e = 0; e < NE; ++e) { const int c = (int)__hip_atomic_load(F.ctl + CW_CNT + e, RLX_AGENT); base[e] = tstart * 256; const int nt = (c + 255) >> 8;
                    if (blockIdx.x == 0 && F.tid == 0) { for (int t = 0; t < nt; ++t) F.ctl[CW_TILEE + 1 + tstart + t] = (unsigned)e; }
                    tstart += nt; }
                if (blockIdx.x == 0 && F.tid == 0) F.ctl[CW_TILEE] = (unsigned)tstart;
                for (int m = F.gw; m < S; m += F.NGW) {
                    const v4u r0 = *(const GAS v4u*)(ROUTE + (size_t)m * 8);
                    int p1 = (int)r0.z, p2 = (int)r0.w;
#pragma unroll
                    for (int e = 0; e < NE; ++e) { if ((int)r0.x == e) p1 += base[e]; if ((int)r0.y == e) p2 += base[e]; }
                    if (F.lane == 0) { ROUTE[(size_t)m * 8 + 6] = (unsigned)p1; ROUTE[(size_t)m * 8 + 7] = (unsigned)p2; }
                    const unsigned char* srow = (const unsigned char*)XN8 + (size_t)m * D * EBM; unsigned char* xp = (unsigned char*)XP;
                    const GAS v4u* src = (const GAS v4u*)srow + F.lane; GAS v4u* d1 = (GAS v4u*)(xp + (size_t)p1 * D * EBM) + F.lane; GAS v4u* d2 = (GAS v4u*)(xp + (size_t)p2 * D * EBM) + F.lane;
#pragma unroll
                    for (int j = 0; j < 2 * EBM; ++j) { const v4u t = src[64 * j]; d1[64 * j] = t; d2[64 * j] = t; }
                }
            }
            if (BOTH(pb + 7) && l == 1) GRID_BAR();
        }
        if (PEN(9) && IN(pb + 8)) { PHASE_BEGIN();
            if (l == 0) { pg8::Gemm g{XN8, WGU, D * EBD, D * EBD, D * EBD / 128}; pg8::StaticOrder So; So.init(S, 2 * DFF, F.G, (int)blockIdx.x);
                FfnEpi1<F8D> E = Epi1Maker<F8D>::make(ACT, DFF);
                pg8::gemm_phase<FfnEpi1<F8D>, pg8::StaticOrder, true, SP2V, F8D>(F.lds, g, So, E); }
            else { const int ntile = (int)__hip_atomic_load(F.ctl + CW_TILEE, RLX_AGENT);
                pg8::Gemm g{XP, MGU, D * EBM, D * EBM, D * EBM / 128}; pg8::MoeOrder So{F.G, (int)blockIdx.x, 2 * DFE / 256, ntile, 2 * DFE, (const int*)(F.ctl + CW_TILEE + 1)};
                FfnEpi1<F8M> E = Epi1Maker<F8M>::make(ACTP, DFE);
                pg8::gemm_phase<FfnEpi1<F8M>, pg8::MoeOrder, true, SP2V, F8M>(F.lds, g, So, E); }
            if (BOTH(pb + 8)) GRID_BAR();
        }
        if (PEN(10) && IN(pb + 9)) { PHASE_BEGIN();
            if (l == 0) { pg8::Gemm g{ACT, WDN, DFF * EBD, DFF * EBD, DFF * EBD / 128}; pg8::StaticOrder So; So.init(S, D, F.G, (int)blockIdx.x);
                pg8::EpiResF32 E{XA, args.rep ? YPRE : XA, D, Sc<F8D>::dn};
                pg8::gemm_phase<pg8::EpiResF32, pg8::StaticOrder, true, SP2V, F8D>(F.lds, g, So, E); }
            else { const int ntile = (int)__hip_atomic_load(F.ctl + CW_TILEE, RLX_AGENT);
                const int pm0 = MOE_TAIL ? ((2 * F.G / 8) < ntile ? (2 * F.G / 8) : ntile) : ntile;
                { pg8::Gemm g{ACTP, MDN, DFE * EBM, DFE * EBM, DFE * EBM / 128}; pg8::MoeOrder So{F.G, (int)blockIdx.x, D / 256, pm0, D, (const int*)(F.ctl + CW_TILEE + 1)};
                  pg8::EpiBf16 E{OUTP, D, Sc<F8M>::dn};
                  pg8::gemm_phase<pg8::EpiBf16, pg8::MoeOrder, true, SP2V, F8M>(F.lds, g, So, E); }
                if (MOE_TAIL && ntile > pm0) { pg8::Gemm g{ACTP, MDN, DFE * EBM, DFE * EBM, DFE * EBM / 512}; pg8::MoeTailOrder So{F.G, (int)blockIdx.x, pm0, ntile - pm0, D, DFE * EBM / 4, (const int*)(F.ctl + CW_TILEE + 1)};
                  pg8::EpiBf16Split E{OUTQ, D, Sc<F8M>::dn, pm0, (size_t)2048 * D};
                  pg8::gemm_phase<pg8::EpiBf16Split, pg8::MoeTailOrder, true, SP2V, F8M>(F.lds, g, So, E); } }
            if (BOTH(pb + 9)) GRID_BAR();
        }
        if (PEN(11) && IN(pb + 10)) { PHASE_BEGIN();
            if (l == 0) { for (int m = F.gw; m < S; m += F.NGW) rms_row_to_bf16(XA + (size_t)m * D, args.in[4] + D, XN + (size_t)m * D, F.lane); }
            else {
                const float* gfin = args.in[22];
                const int ntile_f = (int)__hip_atomic_load(F.ctl + CW_TILEE, RLX_AGENT); const int prow0 = (MOE_TAIL ? ((2 * F.G / 8) < ntile_f ? (2 * F.G / 8) : ntile_f) : ntile_f) * 256;
                for (int m = F.gw; m < S; m += F.NGW) {
                    const v4u r1 = *(const GAS v4u*)(ROUTE + (size_t)m * 8 + 4);
                    const float g1 = __uint_as_float(r1.x), g2 = __uint_as_float(r1.y); const int p1 = (int)r1.z, p2 = (int)r1.w;
                    const GAS f32x4* xr = (const GAS f32x4*)(XA + (size_t)m * D) + F.lane;
                    const GAS v2u* o1 = (const GAS v2u*)(OUTP + (size_t)p1 * D) + F.lane; const GAS v2u* o2 = (const GAS v2u*)(OUTP + (size_t)p2 * D) + F.lane;
                    const bool t1 = p1 >= prow0, t2 = p2 >= prow0;
                    const GAS v2u* q1 = (const GAS v2u*)(OUTQ + (size_t)(t1 ? p1 - prow0 : 0) * D) + F.lane; const GAS v2u* q2 = (const GAS v2u*)(OUTQ + (size_t)(t2 ? p2 - prow0 : 0) * D) + F.lane;
                    f32x4 v[8]; float s = 0.f;
#pragma unroll
                    for (int j = 0; j < 8; ++j) { const f32x4 xv = xr[64 * j]; f32x4 ea, eb;
                        if (!t1) { const v2u a = o1[64 * j]; ea = (f32x4){bflo(a.x), bfhi(a.x), bflo(a.y), bfhi(a.y)}; }
                        else { ea = (f32x4){0.f, 0.f, 0.f, 0.f};
#pragma unroll
                            for (int k = 0; k < 4; ++k) { const v2u a = q1[(size_t)k * (2048 * D / 4) + 64 * j]; ea += (f32x4){bflo(a.x), bfhi(a.x), bflo(a.y), bfhi(a.y)}; } }
                        if (!t2) { const v2u b = o2[64 * j]; eb = (f32x4){bflo(b.x), bfhi(b.x), bflo(b.y), bfhi(b.y)}; }
                        else { eb = (f32x4){0.f, 0.f, 0.f, 0.f};
#pragma unroll
                            for (int k = 0; k < 4; ++k) { const v2u b = q2[(size_t)k * (2048 * D / 4) + 64 * j]; eb += (f32x4){bflo(b.x), bfhi(b.x), bflo(b.y), bfhi(b.y)}; } }
                        v[j] = xv + ea * g1 + eb * g2;
                        s += (v[j].x * v[j].x + v[j].y * v[j].y) + (v[j].z * v[j].z + v[j].w * v[j].w); }
                    const float rstd = 1.f / sqrtf(wave_sum(s) * (1.f / D) + EPS);
                    GAS f32x4* orow = (GAS f32x4*)(args.out + (size_t)m * D) + F.lane; const GAS f32x4* gr = (const GAS f32x4*)gfin + F.lane;
#pragma unroll
                    for (int j = 0; j < 8; ++j) { const f32x4 gg = gr[64 * j]; orow[64 * j] = (f32x4){v[j].x * rstd * gg.x, v[j].y * rstd * gg.y, v[j].z * rstd * gg.z, v[j].w * rstd * gg.w}; }
                }
            }
            if (BOTH(pb + 10) && l == 0) GRID_BAR();
        }
    }
#undef IN
#undef BOTH
#undef GRID_BAR
#undef WIN
#undef WUP
#undef WMEM
#undef WOUT
#undef WGU
#undef WDN
#undef MGU
#undef MDN
#undef XN
#undef MEMN
#undef MEMKV
#undef PROJ
#undef AQKV
#undef KROPE
#undef ROPECS
#undef QKVM
#undef YPRE
#undef DILO
#undef DILS
#undef Y
#undef XA
#undef ROUTE
#undef XP
#undef OUTP
#undef OUTQ
#undef ACTP
#undef ACT
#undef x_in
#undef XN8
#undef PHASE_BEGIN
#undef args
#undef FILL
}

extern "C" void kernel_launch(void* const* d_in, const int* in_sizes, int n_in, void* d_out, int out_size, void* d_ws, size_t ws_size, hipStream_t stream) {
    static int grid = 0;
    if (grid == 0) {
        if (n_in != 23 || in_sizes[0] != S * D || out_size != S * D || ws_size < WS_END) { fprintf(stderr, "kernel_launch: shape/workspace mismatch: n_in %d in0 %d out %d ws %zu (need %zu)\n", n_in, n_in > 0 ? in_sizes[0] : -1, out_size, ws_size, (size_t)WS_END); grid = -1; return; }
        int dev = 0, cus = 0, per_cu = 0;
        if (hipGetDevice(&dev) != hipSuccess || hipDeviceGetAttribute(&cus, hipDeviceAttributeMultiprocessorCount, dev) != hipSuccess) { fprintf(stderr, "kernel_launch: device query failed\n"); grid = -1; return; }
        if (hipFuncSetAttribute((const void*)mk_fwd, hipFuncAttributeMaxDynamicSharedMemorySize, LDS_BYTES) != hipSuccess) { fprintf(stderr, "kernel_launch: hipFuncSetAttribute failed\n"); grid = -1; return; }
        if (hipOccupancyMaxActiveBlocksPerMultiprocessor(&per_cu, (const void*)mk_fwd, NWAVES * 64, LDS_BYTES) != hipSuccess || per_cu < 1) { fprintf(stderr, "kernel_launch: occupancy query reports %d workgroups per CU\n", per_cu); }
        (void)hipGetLastError();
        grid = cus;
    }
    if (grid < 0) return;
    (void)hipMemsetAsync((char*)d_ws + WS_CTL, 0, CTL_ZERO_BYTES, stream);
    Args a{};
    for (int i = 0; i < 23; ++i) a.in[i] = (const float*)d_in[i];
    a.out = (float*)d_out; a.ws = (unsigned char*)d_ws;
    for (int i = 0; i < 32; ++i) a.invf[i] = 1.0f / powf(10000.0f, (float)i / 32.0f);
    int lo[8], hi[8], rp[8], nl = 0;
#if defined(PROBE_PHASE) && PROBE_PHASE >= 0
    lo[nl] = 0; hi[nl] = PROBE_PHASE + 1; rp[nl++] = 0;
    for (int r = 0; r < PROBE_REPS; ++r) { lo[nl] = PROBE_PHASE; hi[nl] = PROBE_PHASE + 1; rp[nl++] = 1; }
    if (PROBE_PHASE + 1 < N_PHASES) { lo[nl] = PROBE_PHASE + 1; hi[nl] = N_PHASES; rp[nl++] = 0; }
#else
    if (N_LAUNCHES == N_PHASES) { nl = 0; } else { lo[0] = 0; hi[0] = N_PHASES; rp[0] = 0; nl = 1; }
#endif
    const int total = (N_LAUNCHES == N_PHASES) ? N_PHASES : nl;
    for (int li = 0; li < total; ++li) {
        if (N_LAUNCHES == N_PHASES) { a.ph_lo = li; a.ph_hi = li + 1; a.li = 0; a.rep = 0; } else { a.ph_lo = lo[li]; a.ph_hi = hi[li]; a.li = li; a.rep = rp[li]; }
        hipLaunchKernelGGL(mk_fwd, dim3(grid), dim3(NWAVES * 64), LDS_BYTES, stream, a);
        const hipError_t le = hipPeekAtLastError();
        if (le != hipSuccess) { fprintf(stderr, "kernel_launch: launch %d failed: %s\n", li, hipGetErrorName(le)); break; }
    }
}
```

```cpp
#include <hip/hip_runtime.h>
#include <cstdio>
#include <cstdint>
#include <cmath>
#include <type_traits>
#ifndef MK_N_LAUNCHES
#define MK_N_LAUNCHES 1
#endif
#define REPEAT_PHASE -1
#define FFN_FP8 3
#define PROBE_PHASE -1
#define PROBE_REPS 3
#define FILLMASK 7
#define MLA_DMA 0
#define PROBE_ATT 7
#define GEMM_SP2 1
#define ATT_OBF16 1
#define MOE_TAIL 1
#define CVT_REG 0
#define CVT_BYTE_T 1
#define CVT_FIRST 1
#define CVT_Q0 8
namespace pg8 {
#define PG8_LAS __attribute__((address_space(3)))
typedef unsigned short bf16_t;
typedef short bf16x8 __attribute__((ext_vector_type(8)));
typedef float f32x4 __attribute__((ext_vector_type(4)));
typedef unsigned u32x4 __attribute__((ext_vector_type(4)));
constexpr int BM = 256, BK = 64, HALF = 128, HTB = HALF * BK * 2  , STAGE_BYTES = 8 * HTB, NXCD = 8, WGM = 8;

__host__ __device__ __forceinline__ int lds_byte(int r, int c) { const int st = (r >> 4) * 2 + (c >> 5), rr = r & 15, cc = c & 31, ob = rr * 64 + cc * 2; return st * 1024 + (ob ^ (((ob >> 9) & 1) << 5)); }
__host__ __device__ __forceinline__ void stage_rc(int b, int& R, int& C) { const int st = b / 1024, sb = b % 1024, swz = sb ^ (((sb >> 9) & 1) << 5); R = (st >> 1) * 16 + swz / 64; C = (st & 1) * 32 + (swz % 64) / 2; }
__host__ __device__ __forceinline__ int perm32(int rho) { const int n = rho >> 4, i = rho & 15; return 8 * (i >> 2) + 4 * n + (i & 3); }

struct Unit { int pm, pn; };
struct Gemm { const void* A; const void* Bt; int lda, ldb, nt; };

struct StaticOrder {
    int nM, nN, nwg, G, c;
    __device__ void init(int M, int N, int G_, int c_) { nM = M / BM; nN = N / BM; nwg = nM * nN; G = G_; c = c_; }
    __device__ bool next(int i, Unit& u) const {
        const long L = (long)i * G + c; if (L >= nwg) return false;
        int wgid = (int)L; { const int q = nwg / NXCD, r = nwg % NXCD, xcd = wgid % NXCD, off = wgid / NXCD; wgid = (xcd < r ? xcd * (q + 1) : r * (q + 1) + (xcd - r) * q) + off; }
        const int nig = WGM * nN, gid = wgid / nig, fm = gid * WGM, gsz = (nM - fm) < WGM ? (nM - fm) : WGM;
        u.pm = fm + ((wgid % nig) % gsz); u.pn = (wgid % nig) / gsz; return true;
    }
    __device__ __forceinline__ const char* abase(const Gemm& g, const Unit& u) const { return (const char*)g.A + (size_t)u.pm * BM * g.lda; }
    __device__ __forceinline__ const char* bbase(const Gemm& g, const Unit& u) const { return (const char*)g.Bt + (size_t)u.pn * BM * g.ldb; }
};
struct InProjOrder {
    StaticOrder so; int nextra; const void* A2; const void* B2;
    __device__ bool next(int i, Unit& u) const { if (so.next(i, u)) return true; const long L = (long)i * so.G + so.c - so.nwg; if (L < 0 || L >= nextra) return false; u.pm = 32 + (int)(L >> 2); u.pn = (int)(L & 3); return true; }
    __device__ __forceinline__ const char* abase(const Gemm& g, const Unit& u) const { return u.pm < 32 ? (const char*)g.A + (size_t)u.pm * BM * g.lda : (const char*)A2 + (size_t)(u.pm - 32) * BM * g.lda; }
    __device__ __forceinline__ const char* bbase(const Gemm& g, const Unit& u) const { return u.pm < 32 ? (const char*)g.Bt + (size_t)u.pn * BM * g.ldb : (const char*)B2 + (size_t)((u.pm - 32) * 1024 + u.pn * BM) * g.ldb; }
};
struct MemOrder {
    int G, c;
    __device__ bool next(int i, Unit& u) const { const int L = c - (G - 8); if (i != 0 || L < 0 || L >= 8) return false; u.pm = L >> 2; u.pn = L & 3; return true; }
    __device__ __forceinline__ const char* abase(const Gemm& g, const Unit& u) const { return (const char*)g.A + (size_t)u.pm * BM * g.lda; }
    __device__ __forceinline__ const char* bbase(const Gemm& g, const Unit& u) const { return (const char*)g.Bt + (size_t)(u.pm * 1024 + u.pn * BM) * g.ldb; }
};
struct MoeOrder {
    int G, c, nN, ntile, nexp_rows; const int* tile_e;
    __device__ bool next(int i, Unit& u) const { const long L = (long)i * G + c; if (L >= (long)ntile * nN) return false; u.pm = (int)(L / nN); u.pn = (int)(L % nN); return true; }
    __device__ __forceinline__ const char* abase(const Gemm& g, const Unit& u) const { return (const char*)g.A + (size_t)u.pm * BM * g.lda; }
    __device__ __forceinline__ const char* bbase(const Gemm& g, const Unit& u) const { const int e = __builtin_amdgcn_readfirstlane(tile_e[u.pm]); return (const char*)g.Bt + ((size_t)e * nexp_rows + (size_t)u.pn * BM) * g.ldb; }
};

struct MoeTailOrder {
    int G, c, pm0, ntail, nexp_rows, kq_bytes; const int* tile_e;
    __device__ bool next(int i, Unit& u) const { const long L = (long)i * G + c; if (L >= (long)ntail * 32) return false; const int ks = (int)(L & 3), rest = (int)(L >> 2); u.pm = pm0 + (rest >> 3); u.pn = (rest & 7) + 8 * ks; return true; }
    __device__ __forceinline__ const char* abase(const Gemm& g, const Unit& u) const { return (const char*)g.A + (size_t)u.pm * BM * g.lda + (size_t)(u.pn >> 3) * kq_bytes; }
    __device__ __forceinline__ const char* bbase(const Gemm& g, const Unit& u) const { const int e = __builtin_amdgcn_readfirstlane(tile_e[u.pm]); return (const char*)g.Bt + ((size_t)e * nexp_rows + (size_t)(u.pn & 7) * BM) * g.ldb + (size_t)(u.pn >> 3) * kq_bytes; }
};

__device__ __forceinline__ unsigned cvt_pk_bf16(float lo, float hi) { unsigned r; asm volatile("v_cvt_pk_bf16_f32 %0, %1, %2" : "=v"(r) : "v"(lo), "v"(hi)); return r; }

struct EpiBf16 {
    static constexpr bool PERM = true;
    bf16_t* O; int ldc; float sc;
    __device__ __forceinline__ void operator()(const f32x4 (&acc)[2][2][4][2], const Unit& u, int wr, int wc, int fr, int fq) const {
        const int row0 = u.pm * BM + wr * 64 + fr, col0 = u.pn * BM + wc * 32 + 8 * fq;
#pragma unroll
        for (int ai = 0; ai < 2; ++ai)
#pragma unroll
            for (int m = 0; m < 4; ++m) { bf16_t* rowp = O + (size_t)(row0 + ai * HALF + m * 16) * ldc + col0;
#pragma unroll
                for (int bj = 0; bj < 2; ++bj) { const f32x4 v0 = acc[ai][bj][m][0] * sc, v1 = acc[ai][bj][m][1] * sc;
                    u32x4 w; w.x = cvt_pk_bf16(v0[0], v0[1]); w.y = cvt_pk_bf16(v0[2], v0[3]); w.z = cvt_pk_bf16(v1[0], v1[1]); w.w = cvt_pk_bf16(v1[2], v1[3]);
                    *(u32x4*)(rowp + bj * HALF) = w; } }
    }
};
struct EpiBf16Split {
    static constexpr bool PERM = true;
    bf16_t* O; int ldc; float sc; int pm0; size_t qstride;
    __device__ __forceinline__ void operator()(const f32x4 (&acc)[2][2][4][2], const Unit& u, int wr, int wc, int fr, int fq) const {
        const int row0 = (u.pm - pm0) * BM + wr * 64 + fr, col0 = (u.pn & 7) * BM + wc * 32 + 8 * fq; bf16_t* base = O + (size_t)(u.pn >> 3) * qstride;
#pragma unroll
        for (int ai = 0; ai < 2; ++ai)
#pragma unroll
            for (int m = 0; m < 4; ++m) { bf16_t* rowp = base + (size_t)(row0 + ai * HALF + m * 16) * ldc + col0;
#pragma unroll
                for (int bj = 0; bj < 2; ++bj) { const f32x4 v0 = acc[ai][bj][m][0] * sc, v1 = acc[ai][bj][m][1] * sc;
                    u32x4 w; w.x = cvt_pk_bf16(v0[0], v0[1]); w.y = cvt_pk_bf16(v0[2], v0[3]); w.z = cvt_pk_bf16(v1[0], v1[1]); w.w = cvt_pk_bf16(v1[2], v1[3]);
                    *(u32x4*)(rowp + bj * HALF) = w; } }
    }
};
struct EpiBf16Sel {
    static constexpr bool PERM = true;
    bf16_t* O; int ldc; bf16_t* O2; int ldc2;
    __device__ __forceinline__ void operator()(const f32x4 (&acc)[2][2][4][2], const Unit& u, int wr, int wc, int fr, int fq) const {
        const bool ex = u.pm >= 32; bf16_t* base = ex ? O2 : O; const int ld = ex ? ldc2 : ldc;
        const int row0 = (ex ? u.pm - 32 : u.pm) * BM + wr * 64 + fr, col0 = u.pn * BM + wc * 32 + 8 * fq;
#pragma unroll
        for (int ai = 0; ai < 2; ++ai)
#pragma unroll
            for (int m = 0; m < 4; ++m) { bf16_t* rowp = base + (size_t)(row0 + ai * HALF + m * 16) * ld + col0;
#pragma unroll
                for (int bj = 0; bj < 2; ++bj) { const f32x4 v0 = acc[ai][bj][m][0], v1 = acc[ai][bj][m][1];
                    u32x4 w; w.x = cvt_pk_bf16(v0[0], v0[1]); w.y = cvt_pk_bf16(v0[2], v0[3]); w.z = cvt_pk_bf16(v1[0], v1[1]); w.w = cvt_pk_bf16(v1[2], v1[3]);
                    *(u32x4*)(rowp + bj * HALF) = w; } }
    }
};
struct EpiResF32 {
    static constexpr bool PERM = false;
    const float* R; float* C; int ldc; float sc;
    __device__ __forceinline__ void operator()(const f32x4 (&acc)[2][2][4][2], const Unit& u, int wr, int wc, int fr, int fq) const {
        const int row0 = u.pm * BM + wr * 64 + fr, col0 = u.pn * BM + wc * 32 + 4 * fq;
#pragma unroll
        for (int ai = 0; ai < 2; ++ai)
#pragma unroll
            for (int m = 0; m < 4; ++m) { const size_t off = (size_t)(row0 + ai * HALF + m * 16) * ldc + col0;
#pragma unroll
                for (int bj = 0; bj < 2; ++bj)
#pragma unroll
                    for (int n = 0; n < 2; ++n) { const f32x4 r = *(const f32x4*)(R + off + bj * HALF + n * 16); *(f32x4*)(C + off + bj * HALF + n * 16) = r + acc[ai][bj][m][n] * sc; } }
    }
};
__device__ __forceinline__ float silu_mul(float g, float u) { return g * u * __builtin_amdgcn_rcpf(1.0f + __builtin_amdgcn_exp2f(-1.4426950408889634f * g)); }
struct EpiSwiGLU {
    static constexpr bool PERM = true;
    bf16_t* O; int ldc;
    __device__ __forceinline__ void operator()(const f32x4 (&acc)[2][2][4][2], const Unit& u, int wr, int wc, int fr, int fq) const {
        const int row0 = u.pm * BM + wr * 64 + fr, col0 = u.pn * HALF + wc * 32 + 8 * fq;
#pragma unroll
        for (int ai = 0; ai < 2; ++ai)
#pragma unroll
            for (int m = 0; m < 4; ++m) { bf16_t* rowp = O + (size_t)(row0 + ai * HALF + m * 16) * ldc + col0;
                const f32x4 g0 = acc[ai][0][m][0], g1 = acc[ai][0][m][1], u0 = acc[ai][1][m][0], u1 = acc[ai][1][m][1];
                u32x4 w; w.x = cvt_pk_bf16(silu_mul(g0[0], u0[0]), silu_mul(g0[1], u0[1])); w.y = cvt_pk_bf16(silu_mul(g0[2], u0[2]), silu_mul(g0[3], u0[3]));
                w.z = cvt_pk_bf16(silu_mul(g1[0], u1[0]), silu_mul(g1[1], u1[1])); w.w = cvt_pk_bf16(silu_mul(g1[2], u1[2]), silu_mul(g1[3], u1[3]));
                *(u32x4*)rowp = w; }
    }
};

typedef int v8i_t __attribute__((ext_vector_type(8)));
__device__ __forceinline__ v8i_t pg8_cat(bf16x8 lo, bf16x8 hi) { typedef int v4i_t __attribute__((ext_vector_type(4))); const v4i_t a = __builtin_bit_cast(v4i_t, lo), b = __builtin_bit_cast(v4i_t, hi); return (v8i_t){a.x, a.y, a.z, a.w, b.x, b.y, b.z, b.w}; }
struct EpiSwiGLU8 {
    static constexpr bool PERM = true;
    unsigned char* O; int ldc; float sc_in, sc_out;
    __device__ __forceinline__ void operator()(const f32x4 (&acc)[2][2][4][2], const Unit& u, int wr, int wc, int fr, int fq) const {
        const int row0 = u.pm * BM + wr * 64 + fr, col0 = u.pn * HALF + wc * 32 + 8 * fq;
#pragma unroll
        for (int ai = 0; ai < 2; ++ai)
#pragma unroll
            for (int m = 0; m < 4; ++m) { unsigned char* rowp = O + (size_t)(row0 + ai * HALF + m * 16) * ldc + col0;
                const f32x4 g0 = acc[ai][0][m][0] * sc_in, g1 = acc[ai][0][m][1] * sc_in, u0 = acc[ai][1][m][0] * (sc_in * sc_out), u1 = acc[ai][1][m][1] * (sc_in * sc_out);
                int w0 = 0, w1 = 0;
                w0 = __builtin_amdgcn_cvt_pk_fp8_f32(silu_mul(g0[0], u0[0]), silu_mul(g0[1], u0[1]), w0, false); w0 = __builtin_amdgcn_cvt_pk_fp8_f32(silu_mul(g0[2], u0[2]), silu_mul(g0[3], u0[3]), w0, true);
                w1 = __builtin_amdgcn_cvt_pk_fp8_f32(silu_mul(g1[0], u1[0]), silu_mul(g1[1], u1[1]), w1, false); w1 = __builtin_amdgcn_cvt_pk_fp8_f32(silu_mul(g1[2], u1[2]), silu_mul(g1[3], u1[3]), w1, true);
                typedef int v2i_t __attribute__((ext_vector_type(2))); *(v2i_t*)rowp = (v2i_t){w0, w1}; }
    }
};
__device__ __forceinline__ void pg8_mfma8(f32x4& c, v8i_t a, v8i_t b, int sc) { asm volatile("v_mfma_scale_f32_16x16x128_f8f6f4 %0, %1, %2, %0, %3, %3 op_sel_hi:[0,0,0]" : "+v"(c) : "v"(a), "v"(b), "v"(sc)); }
template <class Epi, class Sched, bool ALIGN_EPI = false, bool SP2 = false, bool FP8 = false>
__device__ __forceinline__ void gemm_phase(PG8_LAS unsigned char* lds, const Gemm g, const Sched& S, const Epi& E) {
    int tid_ = threadIdx.x; asm volatile("" : "+v"(tid_));
    const int tid = tid_, wid = __builtin_amdgcn_readfirstlane(tid >> 6), lane = tid & 63, wr = wid >> 2, wc = wid & 3, fr = lane & 15, fq = lane >> 4;
    const int nt = g.nt;
    unsigned voffA[2], voffB[2];
#pragma unroll
    for (int i = 0; i < 2; ++i) { int R, C; stage_rc(tid * 16 + i * 8192, R, C); const int Rb = Epi::PERM ? ((R & ~31) + perm32(R & 31)) : R;
        voffA[i] = (unsigned)(R * g.lda + C * 2); voffB[i] = (unsigned)(Rb * g.ldb + C * 2); }
    const size_t kstep = (size_t)(BK * 2);
    const size_t hstepA = (size_t)HALF * g.lda, hstepB = (size_t)HALF * g.ldb;
    const unsigned ldsw = (unsigned)wid * 1024u;
    const int aoff = lds_byte(wr * 64 + fr, fq * 8), boff = lds_byte(wc * 32 + fr, fq * 8);
#define PG8_SA(b, h) (((b) * 2 + (h)) * HTB)
#define PG8_SB(b, h) ((4 + (b) * 2 + (h)) * HTB)
#define PG8_STAGE(bufoff, gbase, voff) do { _Pragma("unroll") for (int _i = 0; _i < 2; ++_i) \
        __builtin_amdgcn_global_load_lds((const unsigned*)((const char*)(gbase) + (voff)[_i]), (PG8_LAS unsigned*)(lds + (bufoff) + ldsw + _i * 8192), 16, 0, 0); } while (0)
#define PG8_LDA(dst, b, h) do { _Pragma("unroll") for (int m = 0; m < 4; ++m) _Pragma("unroll") for (int k = 0; k < 2; ++k) dst[m][k] = *(const PG8_LAS bf16x8*)(lds + PG8_SA(b, h) + aoff + m * 2048 + k * 1024); } while (0)
#define PG8_LDB(dst, b, h) do { _Pragma("unroll") for (int n = 0; n < 2; ++n) _Pragma("unroll") for (int k = 0; k < 2; ++k) dst[n][k] = *(const PG8_LAS bf16x8*)(lds + PG8_SB(b, h) + boff + n * 2048 + k * 1024); } while (0)
#define PG8_MMA(ai, bj, At, Bt) do { __builtin_amdgcn_s_setprio(1); if constexpr (FP8) { _Pragma("unroll") for (int m = 0; m < 4; ++m) _Pragma("unroll") for (int n = 0; n < 2; ++n) \
        pg8_mfma8(acc[ai][bj][m][n], pg8_cat(Bt[n][0], Bt[n][1]), pg8_cat(At[m][0], At[m][1]), sc8); } else { \
        _Pragma("unroll") for (int m = 0; m < 4; ++m) _Pragma("unroll") for (int n = 0; n < 2; ++n) _Pragma("unroll") for (int k = 0; k < 2; ++k) \
        acc[ai][bj][m][n] = __builtin_amdgcn_mfma_f32_16x16x32_bf16(Bt[n][k], At[m][k], acc[ai][bj][m][n], 0, 0, 0); } __builtin_amdgcn_s_setprio(0); } while (0)
#define PG8_WAIT_V(n) asm volatile("s_waitcnt vmcnt(" #n ")" ::: "memory")
#define PG8_WAIT_L(n) asm volatile("s_waitcnt lgkmcnt(" #n ")" ::: "memory")
#define PG8_BAR __builtin_amdgcn_s_barrier()
#define PG8_SCHED __builtin_amdgcn_sched_barrier(0)
    Unit cur, nxt; int ui = 0;
    if (!S.next(0, cur)) return;
    int sc8 = 0x7F7F7F7F; asm volatile("" : "+v"(sc8));
    f32x4 acc[2][2][4][2];
#pragma unroll
    for (int a = 0; a < 2; ++a)
#pragma unroll
        for (int b = 0; b < 2; ++b)
#pragma unroll
            for (int m = 0; m < 4; ++m)
#pragma unroll
                for (int n = 0; n < 2; ++n) acc[a][b][m][n] = (f32x4){0.f, 0.f, 0.f, 0.f};
    bf16x8 At[4][2], B0[2][2], B1[2][2];
    const char* cA = S.abase(g, cur); const char* cB = S.bbase(g, cur);
    if constexpr (SP2) {
        PG8_STAGE(PG8_SB(0, 0), cB, voffB); PG8_STAGE(PG8_SB(0, 1), cB + hstepB, voffB); PG8_STAGE(PG8_SA(0, 0), cA, voffA); PG8_STAGE(PG8_SA(0, 1), cA + hstepA, voffA);
        if (wr == 1) PG8_BAR;
        PG8_WAIT_V(2); PG8_BAR;
        PG8_STAGE(PG8_SB(1, 0), cB + kstep, voffB); PG8_STAGE(PG8_SA(1, 0), cA + kstep, voffA); PG8_STAGE(PG8_SB(1, 1), cB + hstepB + kstep, voffB);
        PG8_WAIT_V(6); PG8_BAR;
    } else {
        PG8_STAGE(PG8_SB(0, 0), cB, voffB); PG8_STAGE(PG8_SA(0, 0), cA, voffA); PG8_STAGE(PG8_SB(0, 1), cB + hstepB, voffB); PG8_STAGE(PG8_SA(0, 1), cA + hstepA, voffA);
        if (wr == 1) PG8_BAR;
        PG8_WAIT_V(4); PG8_BAR;
        PG8_STAGE(PG8_SB(1, 0), cB + kstep, voffB); PG8_STAGE(PG8_SA(1, 0), cA + kstep, voffA); PG8_STAGE(PG8_SB(1, 1), cB + hstepB + kstep, voffB);
        PG8_WAIT_V(6); PG8_BAR;
    }
    for (;;) {
        const bool has_next = S.next(ui + 1, nxt);
        const char* nA = has_next ? S.abase(g, nxt) : cA; const char* nB = has_next ? S.bbase(g, nxt) : cB;
        for (int t = 0; t < nt; t += 2) {
            const bool last = (t == nt - 2);
            const char* a1 = cA + (size_t)(t + 1) * kstep;
            const char* a2 = last ? nA : cA + (size_t)(t + 2) * kstep; const char* b2 = last ? nB : cB + (size_t)(t + 2) * kstep;
            const char* a3 = a2 + kstep; const char* b3 = b2 + kstep;
            if constexpr (SP2) {
            PG8_LDB(B0, 0, 0); PG8_LDB(B1, 0, 1); PG8_SCHED; PG8_LDA(At, 0, 0); PG8_STAGE(PG8_SA(1, 1), a1 + hstepA, voffA);
            PG8_WAIT_V(8); PG8_WAIT_L(0); PG8_BAR; PG8_MMA(0, 0, At, B0); PG8_MMA(0, 1, At, B1); PG8_BAR; PG8_SCHED;
            PG8_LDA(At, 0, 1); PG8_STAGE(PG8_SB(0, 0), b2, voffB); PG8_STAGE(PG8_SB(0, 1), b2 + hstepB, voffB); PG8_STAGE(PG8_SA(0, 0), a2, voffA);
            PG8_WAIT_V(8); PG8_WAIT_L(0); PG8_BAR; PG8_MMA(1, 0, At, B0); PG8_MMA(1, 1, At, B1); PG8_BAR; PG8_SCHED;
            PG8_LDB(B0, 1, 0); PG8_LDB(B1, 1, 1); PG8_SCHED; PG8_LDA(At, 1, 0); PG8_STAGE(PG8_SA(0, 1), a2 + hstepA, voffA);
            PG8_WAIT_V(8); PG8_WAIT_L(0); PG8_BAR; PG8_MMA(0, 0, At, B0); PG8_MMA(0, 1, At, B1); PG8_BAR; PG8_SCHED;
            PG8_LDA(At, 1, 1); PG8_STAGE(PG8_SB(1, 0), b3, voffB); PG8_STAGE(PG8_SB(1, 1), b3 + hstepB, voffB); PG8_STAGE(PG8_SA(1, 0), a3, voffA);
            PG8_WAIT_V(8); PG8_WAIT_L(0); PG8_BAR; PG8_MMA(1, 0, At, B0); PG8_MMA(1, 1, At, B1); PG8_BAR; PG8_SCHED;
            } else {
            PG8_LDB(B0, 0, 0); PG8_SCHED; PG8_LDA(At, 0, 0); PG8_STAGE(PG8_SA(1, 1), a1 + hstepA, voffA);
            PG8_WAIT_L(8); PG8_BAR; PG8_WAIT_L(0); PG8_MMA(0, 0, At, B0); PG8_BAR; PG8_SCHED;
            PG8_LDB(B1, 0, 1); PG8_STAGE(PG8_SB(0, 0), b2, voffB);
            PG8_BAR; PG8_WAIT_L(0); PG8_MMA(0, 1, At, B1); PG8_BAR;
            PG8_LDA(At, 0, 1); PG8_STAGE(PG8_SA(0, 0), a2, voffA);
            PG8_BAR; PG8_WAIT_L(0); PG8_MMA(1, 0, At, B0); PG8_BAR; PG8_SCHED;
            PG8_STAGE(PG8_SB(0, 1), b2 + hstepB, voffB);
            PG8_WAIT_V(6); PG8_BAR; PG8_MMA(1, 1, At, B1); PG8_BAR;
            PG8_LDB(B0, 1, 0); PG8_SCHED; PG8_LDA(At, 1, 0); PG8_STAGE(PG8_SA(0, 1), a2 + hstepA, voffA);
            PG8_WAIT_L(8); PG8_BAR; PG8_WAIT_L(0); PG8_MMA(0, 0, At, B0); PG8_BAR; PG8_SCHED;
            PG8_LDB(B1, 1, 1); PG8_STAGE(PG8_SB(1, 0), b3, voffB);
            PG8_BAR; PG8_WAIT_L(0); PG8_MMA(0, 1, At, B1); PG8_BAR;
            PG8_LDA(At, 1, 1); PG8_STAGE(PG8_SA(1, 0), a3, voffA);
            PG8_BAR; PG8_WAIT_L(0); PG8_MMA(1, 0, At, B0); PG8_BAR; PG8_SCHED;
            PG8_STAGE(PG8_SB(1, 1), b3 + hstepB, voffB);
            PG8_WAIT_V(6); PG8_BAR; PG8_MMA(1, 1, At, B1); PG8_BAR;
            }
        }
        if constexpr (ALIGN_EPI) { if (wr == 0) PG8_BAR; }
        if constexpr (FP8) { PG8_SCHED; asm volatile("s_nop 15\n\ts_nop 7" ::: "memory"); PG8_SCHED; }
        E(acc, cur, wr, wc, fr, fq);
        if (!has_next) break;
#pragma unroll
        for (int a = 0; a < 2; ++a)
#pragma unroll
            for (int b = 0; b < 2; ++b)
#pragma unroll
                for (int m = 0; m < 4; ++m)
#pragma unroll
                    for (int n = 0; n < 2; ++n) acc[a][b][m][n] = (f32x4){0.f, 0.f, 0.f, 0.f};
        cur = nxt; cA = nA; cB = nB; ++ui;
        if constexpr (ALIGN_EPI) { if (wr == 1) PG8_BAR; }
    }
    PG8_WAIT_V(0);
    if constexpr (!ALIGN_EPI) { if (wr == 0) PG8_BAR; }
    PG8_BAR;
#undef PG8_SA
#undef PG8_SB
#undef PG8_STAGE
#undef PG8_LDA
#undef PG8_LDB
#undef PG8_MMA
#undef PG8_WAIT_V
#undef PG8_WAIT_L
#undef PG8_BAR
#undef PG8_SCHED
}
}
namespace att {
#define ATT_LAS __attribute__((address_space(3)))
#define ATT_GAS __attribute__((address_space(1)))
typedef unsigned short bf16;
using bf16x8 = __attribute__((ext_vector_type(8))) short;
using s16x4  = __attribute__((ext_vector_type(4))) short;
using f32x16 = __attribute__((ext_vector_type(16))) float;
using f32x4  = __attribute__((ext_vector_type(4))) float;
using u32x4  = __attribute__((ext_vector_type(4))) unsigned;
constexpr int NW = 8, QBLK = 32, KVBLK = 64, DV = 128;
constexpr float LOG2E = 1.4426950408889634f;
#if defined(ATT_OBF16) && ATT_OBF16
typedef unsigned short OT;
#else
typedef float OT;
#endif
#define SBAR() __builtin_amdgcn_sched_barrier(0)
__device__ __forceinline__ int crow(int r, int hi) { return (r & 3) + 8 * (r >> 2) + 4 * hi; }
__device__ __forceinline__ unsigned cvtpk(float lo, float hi) { unsigned r; asm volatile("v_cvt_pk_bf16_f32 %0, %1, %2" : "=v"(r) : "v"(lo), "v"(hi)); return r; }
__device__ __forceinline__ float bf2f(short s) { return __uint_as_float(((unsigned)(unsigned short)s) << 16); }
__device__ __forceinline__ void st_o(float* p, float v) { *p = v; }
__device__ __forceinline__ void st_o(unsigned short* p, float v) { *p = (unsigned short)(cvtpk(v, v) & 0xffffu); }

__device__ __forceinline__ void partialSM(f32x16& p0, f32x16& p1, float& m_reg, float& mn, float& alpha, const float C, const float THRS) {
  float pmax = p0[0];
#pragma unroll
  for (int r = 1; r < 16; ++r) pmax = fmaxf(pmax, p0[r]);
#pragma unroll
  for (int r = 0; r < 16; ++r) pmax = fmaxf(pmax, p1[r]);
  { auto rr = __builtin_amdgcn_permlane32_swap(__float_as_uint(pmax), __float_as_uint(pmax), false, false);
    pmax = fmaxf(__uint_as_float(rr[0]), __uint_as_float(rr[1])); }
  if (__builtin_expect(__all(pmax - m_reg <= THRS), 1)) { mn = m_reg; alpha = 1.f; }
  else { mn = fmaxf(m_reg, pmax); alpha = __builtin_amdgcn_exp2f((m_reg - mn) * C); m_reg = mn; }
  float mnC = -mn * C;
#pragma unroll
  for (int r = 0; r < 16; ++r) p0[r] = fmaf(p0[r], C, mnC);
#pragma unroll
  for (int r = 0; r < 16; ++r) p1[r] = fmaf(p1[r], C, mnC);
#pragma unroll
  for (int r = 0; r < 16; ++r) p0[r] = __builtin_amdgcn_exp2f(p0[r]);
}
#define ATT_PK4(P, BASE, OUT) do { unsigned a0 = cvtpk(P[BASE + 0], P[BASE + 1]), a1 = cvtpk(P[BASE + 2], P[BASE + 3]);   \
    unsigned b0 = cvtpk(P[BASE + 4], P[BASE + 5]), b1 = cvtpk(P[BASE + 6], P[BASE + 7]);                              \
    auto r0 = __builtin_amdgcn_permlane32_swap(a0, b0, false, false); auto r1 = __builtin_amdgcn_permlane32_swap(a1, b1, false, false); \
    u32x4 w = {r0[0], r1[0], r0[1], r1[1]}; OUT = *reinterpret_cast<bf16x8*>(&w); } while (0)
__device__ __forceinline__ void finishSM(f32x16& p0, f32x16& p1, float alpha, float& l_reg, bf16x8& pa0, bf16x8& pa1, bf16x8& pa2, bf16x8& pa3) {
#pragma unroll
  for (int r = 0; r < 16; ++r) p1[r] = __builtin_amdgcn_exp2f(p1[r]);
  float ps = 0;
#pragma unroll
  for (int r = 0; r < 16; ++r) ps += p0[r];
#pragma unroll
  for (int r = 0; r < 16; ++r) ps += p1[r];
  { auto rr = __builtin_amdgcn_permlane32_swap(__float_as_uint(ps), __float_as_uint(ps), false, false);
    ps = __uint_as_float(rr[0]) + __uint_as_float(rr[1]); }
  l_reg = l_reg * alpha + ps;
  ATT_PK4(p0, 0, pa0); ATT_PK4(p0, 8, pa1); ATT_PK4(p1, 0, pa2); ATT_PK4(p1, 8, pa3);
}
template <int RB> __device__ __forceinline__ int kswz(int row, int colB) { return row * RB + (colB ^ ((row & 7) << 4)); }
template <int DQK> __device__ __forceinline__ void qkt(f32x16& p0, f32x16& p1, const ATT_LAS char* Ks, const bf16x8 (&qr)[DQK / 16], int r32, int hi) {
  p0 = f32x16{}; p1 = f32x16{};
#pragma unroll
  for (int d0 = 0; d0 < DQK / 16; ++d0) { const int cb = (d0 * 16 + hi * 8) * 2;
    bf16x8 b0 = *reinterpret_cast<const ATT_LAS bf16x8*>(Ks + kswz<DQK * 2>(r32, cb));
    bf16x8 b1 = *reinterpret_cast<const ATT_LAS bf16x8*>(Ks + kswz<DQK * 2>(32 + r32, cb));
    p0 = __builtin_amdgcn_mfma_f32_32x32x16_bf16(b0, qr[d0], p0, 0, 0, 0);
    p1 = __builtin_amdgcn_mfma_f32_32x32x16_bf16(b1, qr[d0], p1, 0, 0, 0); }
}
__device__ __forceinline__ void qkt192_lq(f32x16& p0, f32x16& p1, const ATT_LAS char* Ks, const bf16x8 (&qr)[8], const ATT_LAS char* Qs, int lane, int r32, int hi) {
  p0 = f32x16{}; p1 = f32x16{};
#pragma unroll
  for (int d0 = 0; d0 < 12; ++d0) { const int cb = (d0 * 16 + hi * 8) * 2;
    bf16x8 b0 = *reinterpret_cast<const ATT_LAS bf16x8*>(Ks + kswz<384>(r32, cb));
    bf16x8 b1 = *reinterpret_cast<const ATT_LAS bf16x8*>(Ks + kswz<384>(32 + r32, cb));
    const bf16x8 q = d0 < 8 ? qr[d0 < 8 ? d0 : 0] : *reinterpret_cast<const ATT_LAS bf16x8*>(Qs + ((d0 - 8) * 64 + lane) * 16);
    p0 = __builtin_amdgcn_mfma_f32_32x32x16_bf16(b0, q, p0, 0, 0, 0);
    p1 = __builtin_amdgcn_mfma_f32_32x32x16_bf16(b1, q, p1, 0, 0, 0); }
}
__device__ __forceinline__ int v_st(int k, int c) { const int kk = (k & ~0xC) | ((k & 4) << 1) | ((k & 8) >> 1); return ((kk >> 3) * 4 + (c >> 5)) * 512 + ((kk & 7) * 32 + (c & 31)) * 2; }
__device__ __forceinline__ int v_rd_base(int lane) { return ((lane & 3) << 3) | (((lane >> 2) & 3) << 6) | (((lane >> 4) & 1) << 5) | (((lane >> 5) & 1) << 8); }
constexpr int v_rd_off(int d0, int ks, int half) { return d0 * 512 + ks * 4096 + half * 2048; }
template <int OFF> __device__ __forceinline__ s16x4 tr_read(int vb) {
  s16x4 r; asm volatile("ds_read_b64_tr_b16 %0, %1 offset:%2" : "=&v"(r) : "v"(vb), "i"(OFF) : "memory"); return r;
}
#define ATT_PK(L, H) (bf16x8){L[0], L[1], L[2], L[3], H[0], H[1], H[2], H[3]}
template <int D0> __device__ __forceinline__ void pv_one(f32x16& od, int vb, bf16x8 pa0, bf16x8 pa1, bf16x8 pa2, bf16x8 pa3) {
  const s16x4 l0 = tr_read<v_rd_off(D0, 0, 0)>(vb), h0 = tr_read<v_rd_off(D0, 0, 1)>(vb), l1 = tr_read<v_rd_off(D0, 1, 0)>(vb), h1 = tr_read<v_rd_off(D0, 1, 1)>(vb);
  const s16x4 l2 = tr_read<v_rd_off(D0, 2, 0)>(vb), h2 = tr_read<v_rd_off(D0, 2, 1)>(vb), l3 = tr_read<v_rd_off(D0, 3, 0)>(vb), h3 = tr_read<v_rd_off(D0, 3, 1)>(vb);
  asm volatile("s_waitcnt lgkmcnt(0)" ::: "memory"); SBAR();
  od = __builtin_amdgcn_mfma_f32_32x32x16_bf16(pa0, ATT_PK(l0, h0), od, 0, 0, 0);
  od = __builtin_amdgcn_mfma_f32_32x32x16_bf16(pa1, ATT_PK(l1, h1), od, 0, 0, 0);
  od = __builtin_amdgcn_mfma_f32_32x32x16_bf16(pa2, ATT_PK(l2, h2), od, 0, 0, 0);
  od = __builtin_amdgcn_mfma_f32_32x32x16_bf16(pa3, ATT_PK(l3, h3), od, 0, 0, 0);
}
__device__ __forceinline__ void pv_d0(f32x16 (&o)[4], int vb, bf16x8 pa0, bf16x8 pa1, bf16x8 pa2, bf16x8 pa3) {
  pv_one<0>(o[0], vb, pa0, pa1, pa2, pa3); pv_one<1>(o[1], vb, pa0, pa1, pa2, pa3); pv_one<2>(o[2], vb, pa0, pa1, pa2, pa3); pv_one<3>(o[3], vb, pa0, pa1, pa2, pa3);
}
template <int D0> __device__ __forceinline__ void pv32_one(f32x16& od, int vb, bf16x8 pa0, bf16x8 pa1) {
  const s16x4 l0 = tr_read<v_rd_off(D0, 0, 0)>(vb), h0 = tr_read<v_rd_off(D0, 0, 1)>(vb), l1 = tr_read<v_rd_off(D0, 1, 0)>(vb), h1 = tr_read<v_rd_off(D0, 1, 1)>(vb);
  asm volatile("s_waitcnt lgkmcnt(0)" ::: "memory"); SBAR();
  od = __builtin_amdgcn_mfma_f32_32x32x16_bf16(pa0, ATT_PK(l0, h0), od, 0, 0, 0);
  od = __builtin_amdgcn_mfma_f32_32x32x16_bf16(pa1, ATT_PK(l1, h1), od, 0, 0, 0);
}

template <int DQK, int LDQ, int LDK, int LDO, int SDEPTH>
__device__ __forceinline__ void attn_dense_body(const bf16* __restrict__ Qb, const bf16* __restrict__ Kh, const bf16* __restrict__ Kr, const bf16* __restrict__ Vh,
                                                const float* __restrict__ cs_rows, OT* __restrict__ Ob, int seq, const float scale, ATT_LAS char* lds) {
  constexpr int SHM_V = KVBLK * DV * 2, SHM_K = KVBLK * DQK * 2, RB = DQK * 2, NQ = DQK / 16;
  constexpr bool ROPE = (DQK == 192);
  const float C = scale * LOG2E, THRS = 8.f / scale;
  int tid_ = threadIdx.x; asm volatile("" : "+v"(tid_));
  const int tid = tid_, wid = tid >> 6, lane = tid & 63, r32 = lane & 31, hi = lane >> 5;
  ATT_LAS char* V_lds = lds; ATT_LAS char* K_lds = lds + 2 * SHM_V;
  ATT_LAS float* ws = (ATT_LAS float*)(lds + 2 * SHM_V + 2 * SHM_K) + wid * 64; ATT_LAS float* li_l = ws; ATT_LAS float* al_l = ws + 32;
  float m_reg = -1e30f, l_reg = 0; f32x16 o[4] = {}; bf16x8 qr[NQ];
  const bf16* Qw = Qb + (long)(wid * QBLK + r32) * LDQ + hi * 8;
#pragma unroll
  for (int d0 = 0; d0 < NQ; ++d0) qr[d0] = *(const ATT_GAS bf16x8*)(Qw + d0 * 16);
  if constexpr (ROPE) {
    const float* cs = cs_rows + (long)(wid * QBLK + r32) * 64 + hi * 8;
#pragma unroll
    for (int g = 0; g < 2; ++g) {
      const f32x4 c0 = *(const ATT_GAS f32x4*)(cs + g * 16), c1 = *(const ATT_GAS f32x4*)(cs + g * 16 + 4);
      const f32x4 s0 = *(const ATT_GAS f32x4*)(cs + 32 + g * 16), s1 = *(const ATT_GAS f32x4*)(cs + 32 + g * 16 + 4);
      float y1[8], y2[8];
#pragma unroll
      for (int j = 0; j < 8; ++j) { const float co = j < 4 ? c0[j & 3] : c1[j & 3], si = j < 4 ? s0[j & 3] : s1[j & 3];
        const float x1 = bf2f(qr[8 + g][j]), x2 = bf2f(qr[10 + g][j]); y1[j] = x1 * co - x2 * si; y2[j] = x1 * si + x2 * co; }
      u32x4 w1 = {cvtpk(y1[0], y1[1]), cvtpk(y1[2], y1[3]), cvtpk(y1[4], y1[5]), cvtpk(y1[6], y1[7])};
      u32x4 w2 = {cvtpk(y2[0], y2[1]), cvtpk(y2[2], y2[3]), cvtpk(y2[4], y2[5]), cvtpk(y2[6], y2[7])};
      qr[8 + g] = *reinterpret_cast<bf16x8*>(&w1); qr[10 + g] = *reinterpret_cast<bf16x8*>(&w2);
    }
  }
  const int sr = tid >> 4, sc = (tid & 15) * 8, vst0 = v_st(sr, sc), vst1 = v_st(32 + sr, sc);
  const int rr = tid >> 3, rc = (tid & 7) * 8;
  const int vb0 = (int)(unsigned)(uintptr_t)V_lds + v_rd_base(lane);
  struct Slot { bf16x8 vs0, vs1, ks0, ks1, kr; } sr_[SDEPTH];
#define SLOAD(i, k0) do { sr_[i].vs0 = *(const ATT_GAS bf16x8*)(&Vh[(long)((k0) + sr) * LDK + sc]); sr_[i].vs1 = *(const ATT_GAS bf16x8*)(&Vh[(long)((k0) + 32 + sr) * LDK + sc]); \
    sr_[i].ks0 = *(const ATT_GAS bf16x8*)(&Kh[(long)((k0) + sr) * LDK + sc]); sr_[i].ks1 = *(const ATT_GAS bf16x8*)(&Kh[(long)((k0) + 32 + sr) * LDK + sc]); \
    if constexpr (ROPE) sr_[i].kr = *(const ATT_GAS bf16x8*)(&Kr[(long)((k0) + rr) * 64 + rc]); } while (0)
#define SWRITE(b, i) do { *reinterpret_cast<ATT_LAS bf16x8*>(V_lds + (b) * SHM_V + vst0) = sr_[i].vs0;          \
    *reinterpret_cast<ATT_LAS bf16x8*>(V_lds + (b) * SHM_V + vst1) = sr_[i].vs1; const int kc = sc * 2;               \
    *reinterpret_cast<ATT_LAS bf16x8*>(K_lds + (b) * SHM_K + kswz<RB>(sr, kc)) = sr_[i].ks0;                       \
    *reinterpret_cast<ATT_LAS bf16x8*>(K_lds + (b) * SHM_K + kswz<RB>(32 + sr, kc)) = sr_[i].ks1;                  \
    if constexpr (ROPE) *reinterpret_cast<ATT_LAS bf16x8*>(K_lds + (b) * SHM_K + kswz<RB>(rr, 256 + rc * 2)) = sr_[i].kr; } while (0)
#define SWAIT() do { if constexpr (SDEPTH == 2) { if constexpr (ROPE) asm volatile("s_waitcnt vmcnt(5)" ::: "memory"); else asm volatile("s_waitcnt vmcnt(4)" ::: "memory"); } else asm volatile("s_waitcnt vmcnt(0)" ::: "memory"); } while (0)
#define RESC(a) do { if (__any((a) < 1.f)) { if (hi == 0) al_l[r32] = (a); asm volatile("s_waitcnt lgkmcnt(0)" ::: "memory"); \
    _Pragma("unroll") for (int d = 0; d < 4; ++d) _Pragma("unroll") for (int r = 0; r < 16; ++r) o[d][r] *= al_l[crow(r, hi)]; } } while (0)
  f32x16 pA0, pA1, pB0, pB1; float mnA, mnB, alA, alB; bf16x8 pa0, pa1, pa2, pa3; const int NT = seq / KVBLK;
  constexpr int SE = 0, SO = SDEPTH - 1;
  SLOAD(SE, 0); asm volatile("s_waitcnt vmcnt(0)" ::: "memory"); SWRITE(0, SE); __syncthreads();
  qkt<DQK>(pA0, pA1, K_lds, qr, r32, hi); partialSM(pA0, pA1, m_reg, mnA, alA, C, THRS);
  SLOAD(SO, KVBLK); if constexpr (SDEPTH == 2) { if (2 < NT) SLOAD(SE, 2 * KVBLK); }
  SWAIT(); SWRITE(1, SO); __syncthreads();
  for (int j = 1; j + 1 < NT; j += 2) {
    SBAR(); qkt<DQK>(pB0, pB1, K_lds + SHM_K, qr, r32, hi);
    finishSM(pA0, pA1, alA, l_reg, pa0, pa1, pa2, pa3); SBAR();
    SLOAD(SO, (j + SDEPTH) * KVBLK); SBAR();
    pv_d0(o, vb0, pa0, pa1, pa2, pa3); partialSM(pB0, pB1, m_reg, mnB, alB, C, THRS);
    __syncthreads(); SWAIT(); SWRITE(0, SE);
    RESC(alB); __syncthreads();
    SBAR(); qkt<DQK>(pA0, pA1, K_lds, qr, r32, hi);
    finishSM(pB0, pB1, alB, l_reg, pa0, pa1, pa2, pa3); SBAR();
    if (SDEPTH == 1 || j + 3 < NT) SLOAD(SE, (j + 1 + SDEPTH) * KVBLK); SBAR();
    pv_d0(o, vb0 + SHM_V, pa0, pa1, pa2, pa3); partialSM(pA0, pA1, m_reg, mnA, alA, C, THRS);
    __syncthreads(); SWAIT(); SWRITE(1, SO);
    RESC(alA); __syncthreads();
  }
  SBAR(); qkt<DQK>(pB0, pB1, K_lds + SHM_K, qr, r32, hi);
  finishSM(pA0, pA1, alA, l_reg, pa0, pa1, pa2, pa3); SBAR();
  pv_d0(o, vb0, pa0, pa1, pa2, pa3); partialSM(pB0, pB1, m_reg, mnB, alB, C, THRS);
  __syncthreads(); RESC(alB);
  finishSM(pB0, pB1, alB, l_reg, pa0, pa1, pa2, pa3); SBAR();
  pv_d0(o, vb0 + SHM_V, pa0, pa1, pa2, pa3);
  if (hi == 0) li_l[r32] = l_reg; asm volatile("s_waitcnt lgkmcnt(0)" ::: "memory");
  float rli[16];
#pragma unroll
  for (int r = 0; r < 16; ++r) rli[r] = __builtin_amdgcn_rcpf(li_l[crow(r, hi)]);
  OT* Ow = Ob + (long)(wid * QBLK) * LDO;
#pragma unroll
  for (int r = 0; r < 16; ++r) { const int orow = crow(r, hi);
#pragma unroll
    for (int d0 = 0; d0 < 4; ++d0) st_o(&Ow[(long)orow * LDO + d0 * 32 + r32], o[d0][r] * rli[r]); }
  __syncthreads();
#undef SLOAD
#undef SWRITE
#undef SWAIT
#undef RESC
}

template <int LDQ, int LDK, int LDO>
__device__ __forceinline__ void attn_pipe192_body(const bf16* __restrict__ Qb, const bf16* __restrict__ Kh, const bf16* __restrict__ Kr, const bf16* __restrict__ Vh,
                                                const float* __restrict__ cs_rows, OT* __restrict__ Ob, int seq, const float scale, ATT_LAS char* lds) {
  constexpr int DQK = 192, SDEPTH = 1, SHM_V = KVBLK * DV * 2, SHM_K = KVBLK * DQK * 2, RB = DQK * 2, NQ = DQK / 16;
  constexpr bool ROPE = true;
  const float C = scale * LOG2E, THRS = 8.f / scale;
  int tid_ = threadIdx.x; asm volatile("" : "+v"(tid_));
  const int tid = tid_, wid = tid >> 6, lane = tid & 63, r32 = lane & 31, hi = lane >> 5;
  ATT_LAS char* V_lds = lds; ATT_LAS char* K_lds = lds + 2 * SHM_V;
  ATT_LAS float* ws = (ATT_LAS float*)(lds + 2 * SHM_V + 2 * SHM_K) + wid * 64; ATT_LAS float* li_l = ws; ATT_LAS float* al_l = ws + 32;
  ATT_LAS char* Qs = lds + 2 * SHM_V + 2 * SHM_K + 2048 + wid * 4096;
  float m_reg = -1e30f, l_reg = 0; f32x16 o[4] = {}; bf16x8 qr8[8];
  const bf16* Qw = Qb + (long)(wid * QBLK + r32) * LDQ + hi * 8;
  { bf16x8 qr[NQ];
#pragma unroll
  for (int d0 = 0; d0 < NQ; ++d0) qr[d0] = *(const ATT_GAS bf16x8*)(Qw + d0 * 16);
  if constexpr (ROPE) {
    const float* cs = cs_rows + (long)(wid * QBLK + r32) * 64 + hi * 8;
#pragma unroll
    for (int g = 0; g < 2; ++g) {
      const f32x4 c0 = *(const ATT_GAS f32x4*)(cs + g * 16), c1 = *(const ATT_GAS f32x4*)(cs + g * 16 + 4);
      const f32x4 s0 = *(const ATT_GAS f32x4*)(cs + 32 + g * 16), s1 = *(const ATT_GAS f32x4*)(cs + 32 + g * 16 + 4);
      float y1[8], y2[8];
#pragma unroll
      for (int j = 0; j < 8; ++j) { const float co = j < 4 ? c0[j & 3] : c1[j & 3], si = j < 4 ? s0[j & 3] : s1[j & 3];
        const float x1 = bf2f(qr[8 + g][j]), x2 = bf2f(qr[10 + g][j]); y1[j] = x1 * co - x2 * si; y2[j] = x1 * si + x2 * co; }
      u32x4 w1 = {cvtpk(y1[0], y1[1]), cvtpk(y1[2], y1[3]), cvtpk(y1[4], y1[5]), cvtpk(y1[6], y1[7])};
      u32x4 w2 = {cvtpk(y2[0], y2[1]), cvtpk(y2[2], y2[3]), cvtpk(y2[4], y2[5]), cvtpk(y2[6], y2[7])};
      qr[8 + g] = *reinterpret_cast<bf16x8*>(&w1); qr[10 + g] = *reinterpret_cast<bf16x8*>(&w2);
    }
  }
#pragma unroll
  for (int d0 = 0; d0 < 8; ++d0) qr8[d0] = qr[d0];
#pragma unroll
  for (int d0 = 8; d0 < 12; ++d0) *reinterpret_cast<ATT_LAS bf16x8*>(Qs + ((d0 - 8) * 64 + lane) * 16) = qr[d0];
  }
  const int sr = tid >> 4, sc = (tid & 15) * 8, vst0 = v_st(sr, sc), vst1 = v_st(32 + sr, sc);
  const int rr = tid >> 3, rc = (tid & 7) * 8;
  const int vb0 = (int)(unsigned)(uintptr_t)V_lds + v_rd_base(lane);
  struct Slot { bf16x8 vs0, vs1, ks0, ks1, kr; } sr_[SDEPTH];
#define SLOADK(i, k0) do { sr_[i].ks0 = *(const ATT_GAS bf16x8*)(&Kh[(long)((k0) + sr) * LDK + sc]); sr_[i].ks1 = *(const ATT_GAS bf16x8*)(&Kh[(long)((k0) + 32 + sr) * LDK + sc]); } while (0)
#define SLOADV(i, k0) do { sr_[i].vs0 = *(const ATT_GAS bf16x8*)(&Vh[(long)((k0) + sr) * LDK + sc]); sr_[i].vs1 = *(const ATT_GAS bf16x8*)(&Vh[(long)((k0) + 32 + sr) * LDK + sc]); \
    if constexpr (ROPE) sr_[i].kr = *(const ATT_GAS bf16x8*)(&Kr[(long)((k0) + rr) * 64 + rc]); } while (0)
#define SLOAD(i, k0) do { SLOADK(i, k0); SLOADV(i, k0); } while (0)
#define SWRITE(b, i) do { *reinterpret_cast<ATT_LAS bf16x8*>(V_lds + (b) * SHM_V + vst0) = sr_[i].vs0;          \
    *reinterpret_cast<ATT_LAS bf16x8*>(V_lds + (b) * SHM_V + vst1) = sr_[i].vs1; const int kc = sc * 2;               \
    *reinterpret_cast<ATT_LAS bf16x8*>(K_lds + (b) * SHM_K + kswz<RB>(sr, kc)) = sr_[i].ks0;                       \
    *reinterpret_cast<ATT_LAS bf16x8*>(K_lds + (b) * SHM_K + kswz<RB>(32 + sr, kc)) = sr_[i].ks1;                  \
    if constexpr (ROPE) *reinterpret_cast<ATT_LAS bf16x8*>(K_lds + (b) * SHM_K + kswz<RB>(rr, 256 + rc * 2)) = sr_[i].kr; } while (0)
#define SWAIT() do { if constexpr (SDEPTH == 2) { if constexpr (ROPE) asm volatile("s_waitcnt vmcnt(5)" ::: "memory"); else asm volatile("s_waitcnt vmcnt(4)" ::: "memory"); } else asm volatile("s_waitcnt vmcnt(0)" ::: "memory"); } while (0)
#define RESC(a) do { if (__any((a) < 1.f)) { if (hi == 0) al_l[r32] = (a); asm volatile("s_waitcnt lgkmcnt(0)" ::: "memory"); \
    _Pragma("unroll") for (int d = 0; d < 4; ++d) _Pragma("unroll") for (int r = 0; r < 16; ++r) o[d][r] *= al_l[crow(r, hi)]; } } while (0)
  f32x16 pA0, pA1, pB0, pB1; float mnA, mnB, alA, alB; bf16x8 pa0, pa1, pa2, pa3; const int NT = seq / KVBLK;
  constexpr int SE = 0, SO = SDEPTH - 1;
  SLOAD(SE, 0); asm volatile("s_waitcnt vmcnt(0)" ::: "memory"); SWRITE(0, SE); __syncthreads();
  qkt192_lq(pA0, pA1, K_lds, qr8, Qs, lane, r32, hi); partialSM(pA0, pA1, m_reg, mnA, alA, C, THRS);
  SLOAD(SO, KVBLK); if constexpr (SDEPTH == 2) { if (2 < NT) SLOAD(SE, 2 * KVBLK); }
  SWAIT(); SWRITE(1, SO); __syncthreads();
  for (int j = 1; j + 1 < NT; j += 2) {
    SBAR(); qkt192_lq(pB0, pB1, K_lds + SHM_K, qr8, Qs, lane, r32, hi);
    finishSM(pA0, pA1, alA, l_reg, pa0, pa1, pa2, pa3); SBAR();
    SLOADK(SO, (j + SDEPTH) * KVBLK); SBAR();
    pv_d0(o, vb0, pa0, pa1, pa2, pa3); SBAR(); SLOADV(SO, (j + SDEPTH) * KVBLK); SBAR(); partialSM(pB0, pB1, m_reg, mnB, alB, C, THRS);
    __syncthreads(); SWAIT(); SWRITE(0, SE);
    RESC(alB); __syncthreads();
    SBAR(); qkt192_lq(pA0, pA1, K_lds, qr8, Qs, lane, r32, hi);
    finishSM(pB0, pB1, alB, l_reg, pa0, pa1, pa2, pa3); SBAR();
    SLOADK(SE, (j + 1 + SDEPTH) * KVBLK); SBAR();
    pv_d0(o, vb0 + SHM_V, pa0, pa1, pa2, pa3); SBAR(); SLOADV(SE, (j + 1 + SDEPTH) * KVBLK); SBAR(); partialSM(pA0, pA1, m_reg, mnA, alA, C, THRS);
    __syncthreads(); SWAIT(); SWRITE(1, SO);
    RESC(alA); __syncthreads();
  }
  SBAR(); qkt192_lq(pB0, pB1, K_lds + SHM_K, qr8, Qs, lane, r32, hi);
  finishSM(pA0, pA1, alA, l_reg, pa0, pa1, pa2, pa3); SBAR();
  pv_d0(o, vb0, pa0, pa1, pa2, pa3); partialSM(pB0, pB1, m_reg, mnB, alB, C, THRS);
  __syncthreads(); RESC(alB);
  finishSM(pB0, pB1, alB, l_reg, pa0, pa1, pa2, pa3); SBAR();
  pv_d0(o, vb0 + SHM_V, pa0, pa1, pa2, pa3);
  if (hi == 0) li_l[r32] = l_reg; asm volatile("s_waitcnt lgkmcnt(0)" ::: "memory");
  float rli[16];
#pragma unroll
  for (int r = 0; r < 16; ++r) rli[r] = __builtin_amdgcn_rcpf(li_l[crow(r, hi)]);
  OT* Ow = Ob + (long)(wid * QBLK) * LDO;
#pragma unroll
  for (int r = 0; r < 16; ++r) { const int orow = crow(r, hi);
#pragma unroll
    for (int d0 = 0; d0 < 4; ++d0) st_o(&Ow[(long)orow * LDO + d0 * 32 + r32], o[d0][r] * rli[r]); }
  __syncthreads();
#undef SLOAD
#undef SLOADK
#undef SLOADV
#undef SWRITE
#undef SWAIT
#undef RESC
}

template <int DQK, int LDQ, int LDK, int LDO>
__device__ __forceinline__ void attn_simple_body(const bf16* __restrict__ Qb, const bf16* __restrict__ Kh, const bf16* __restrict__ Kr, const bf16* __restrict__ Vh,
                                                 const float* __restrict__ cs_rows, OT* __restrict__ Ob, int seq, const float scale, ATT_LAS char* lds) {
  constexpr int SHM_V = KVBLK * DV * 2, SHM_K = KVBLK * DQK * 2, RB = DQK * 2, NQ = DQK / 16;
  constexpr bool ROPE = (DQK == 192);
  const float C = scale * LOG2E, THRS = 8.f / scale;
  int tid_ = threadIdx.x; asm volatile("" : "+v"(tid_));
  const int tid = tid_, wid = tid >> 6, lane = tid & 63, r32 = lane & 31, hi = lane >> 5;
  ATT_LAS char* V_lds = lds; ATT_LAS char* K_lds = lds + 2 * SHM_V;
  ATT_LAS float* ws = (ATT_LAS float*)(lds + 2 * SHM_V + 2 * SHM_K) + wid * 64; ATT_LAS float* li_l = ws; ATT_LAS float* al_l = ws + 32;
  float m_reg = -1e30f, l_reg = 0; f32x16 o[4] = {}; bf16x8 qr[NQ];
  const bf16* Qw = Qb + (long)(wid * QBLK + r32) * LDQ + hi * 8;
#pragma unroll
  for (int d0 = 0; d0 < NQ; ++d0) qr[d0] = *(const ATT_GAS bf16x8*)(Qw + d0 * 16);
  if constexpr (ROPE) {
    const float* cs = cs_rows + (long)(wid * QBLK + r32) * 64 + hi * 8;
#pragma unroll
    for (int g = 0; g < 2; ++g) {
      const f32x4 c0 = *(const ATT_GAS f32x4*)(cs + g * 16), c1 = *(const ATT_GAS f32x4*)(cs + g * 16 + 4);
      const f32x4 s0 = *(const ATT_GAS f32x4*)(cs + 32 + g * 16), s1 = *(const ATT_GAS f32x4*)(cs + 32 + g * 16 + 4);
      float y1[8], y2[8];
#pragma unroll
      for (int j = 0; j < 8; ++j) { const float co = j < 4 ? c0[j & 3] : c1[j & 3], si = j < 4 ? s0[j & 3] : s1[j & 3];
        const float x1 = bf2f(qr[8 + g][j]), x2 = bf2f(qr[10 + g][j]); y1[j] = x1 * co - x2 * si; y2[j] = x1 * si + x2 * co; }
      u32x4 w1 = {cvtpk(y1[0], y1[1]), cvtpk(y1[2], y1[3]), cvtpk(y1[4], y1[5]), cvtpk(y1[6], y1[7])};
      u32x4 w2 = {cvtpk(y2[0], y2[1]), cvtpk(y2[2], y2[3]), cvtpk(y2[4], y2[5]), cvtpk(y2[6], y2[7])};
      qr[8 + g] = *reinterpret_cast<bf16x8*>(&w1); qr[10 + g] = *reinterpret_cast<bf16x8*>(&w2);
    }
  }
  const int sr = tid >> 4, sc = (tid & 15) * 8, vst0 = v_st(sr, sc), vst1 = v_st(32 + sr, sc);
  const int rr = tid >> 3, rc = (tid & 7) * 8;
  const int vb0 = (int)(unsigned)(uintptr_t)V_lds + v_rd_base(lane);
  bf16x8 vs0, vs1, ks0, ks1, kr;
#define SLOAD(k0) do { vs0 = *(const ATT_GAS bf16x8*)(&Vh[(long)((k0) + sr) * LDK + sc]); vs1 = *(const ATT_GAS bf16x8*)(&Vh[(long)((k0) + 32 + sr) * LDK + sc]); \
    ks0 = *(const ATT_GAS bf16x8*)(&Kh[(long)((k0) + sr) * LDK + sc]); ks1 = *(const ATT_GAS bf16x8*)(&Kh[(long)((k0) + 32 + sr) * LDK + sc]); \
    if constexpr (ROPE) kr = *(const ATT_GAS bf16x8*)(&Kr[(long)((k0) + rr) * 64 + rc]); } while (0)
#define SWRITE(b) do { *reinterpret_cast<ATT_LAS bf16x8*>(V_lds + (b) * SHM_V + vst0) = vs0;          \
    *reinterpret_cast<ATT_LAS bf16x8*>(V_lds + (b) * SHM_V + vst1) = vs1; const int kc = sc * 2;               \
    *reinterpret_cast<ATT_LAS bf16x8*>(K_lds + (b) * SHM_K + kswz<RB>(sr, kc)) = ks0;                       \
    *reinterpret_cast<ATT_LAS bf16x8*>(K_lds + (b) * SHM_K + kswz<RB>(32 + sr, kc)) = ks1;                  \
    if constexpr (ROPE) *reinterpret_cast<ATT_LAS bf16x8*>(K_lds + (b) * SHM_K + kswz<RB>(rr, 256 + rc * 2)) = kr; } while (0)
#define RESC(a) do { if (__any((a) < 1.f)) { if (hi == 0) al_l[r32] = (a); asm volatile("s_waitcnt lgkmcnt(0)" ::: "memory"); \
    _Pragma("unroll") for (int d = 0; d < 4; ++d) _Pragma("unroll") for (int r = 0; r < 16; ++r) o[d][r] *= al_l[crow(r, hi)]; } } while (0)
  const int NT = seq / KVBLK;
  SLOAD(0); SWRITE(0); __syncthreads();
  for (int j = 0; j < NT; ++j) {
    const int b = j & 1;
    if (j + 1 < NT) SLOAD((j + 1) * KVBLK);
    f32x16 p0, p1; float mn, al; bf16x8 pa0, pa1, pa2, pa3;
    SBAR(); qkt<DQK>(p0, p1, K_lds + b * SHM_K, qr, r32, hi);
    partialSM(p0, p1, m_reg, mn, al, C, THRS); RESC(al);
    finishSM(p0, p1, al, l_reg, pa0, pa1, pa2, pa3); SBAR();
    pv_d0(o, vb0 + b * SHM_V, pa0, pa1, pa2, pa3);
    if (j + 1 < NT) SWRITE(b ^ 1);
    __syncthreads();
  }
  if (hi == 0) li_l[r32] = l_reg; asm volatile("s_waitcnt lgkmcnt(0)" ::: "memory");
  float rli[16];
#pragma unroll
  for (int r = 0; r < 16; ++r) rli[r] = __builtin_amdgcn_rcpf(li_l[crow(r, hi)]);
  OT* Ow = Ob + (long)(wid * QBLK) * LDO;
#pragma unroll
  for (int r = 0; r < 16; ++r) { const int orow = crow(r, hi);
#pragma unroll
    for (int d0 = 0; d0 < 4; ++d0) st_o(&Ow[(long)orow * LDO + d0 * 32 + r32], o[d0][r] * rli[r]); }
  __syncthreads();
#undef SLOAD
#undef SWRITE
#undef RESC
}

template <int LDQ, int LDK, int LDO>
__device__ __forceinline__ void attn_dma_body(const bf16* __restrict__ Qb, const bf16* __restrict__ Kh, const bf16* __restrict__ Kr, const bf16* __restrict__ Vh,
                                              const float* __restrict__ cs_rows, OT* __restrict__ Ob, int seq, const float scale, ATT_LAS char* lds) {
  constexpr int DQK = 192, SHM_V = KVBLK * DV * 2, SHM_K = KVBLK * DQK * 2, STG = SHM_K + SHM_V, RB = DQK * 2, NQ = DQK / 16;
  const float C = scale * LOG2E, THRS = 8.f / scale;
  int tid_ = threadIdx.x; asm volatile("" : "+v"(tid_));
  const int tid = tid_, wid = __builtin_amdgcn_readfirstlane(tid >> 6), lane = tid & 63, r32 = lane & 31, hi = lane >> 5;
  ATT_LAS float* ws = (ATT_LAS float*)(lds + 3 * STG) + wid * 64; ATT_LAS float* li_l = ws; ATT_LAS float* al_l = ws + 32;
  float m_reg = -1e30f, l_reg = 0; f32x16 o[4] = {}; bf16x8 qr[NQ];
  const bf16* Qw = Qb + (long)(wid * QBLK + r32) * LDQ + hi * 8;
#pragma unroll
  for (int d0 = 0; d0 < NQ; ++d0) qr[d0] = *(const ATT_GAS bf16x8*)(Qw + d0 * 16);
  { const float* cs = cs_rows + (long)(wid * QBLK + r32) * 64 + hi * 8;
#pragma unroll
    for (int g = 0; g < 2; ++g) {
      const f32x4 c0 = *(const ATT_GAS f32x4*)(cs + g * 16), c1 = *(const ATT_GAS f32x4*)(cs + g * 16 + 4);
      const f32x4 s0 = *(const ATT_GAS f32x4*)(cs + 32 + g * 16), s1 = *(const ATT_GAS f32x4*)(cs + 32 + g * 16 + 4);
      float y1[8], y2[8];
#pragma unroll
      for (int j = 0; j < 8; ++j) { const float co = j < 4 ? c0[j & 3] : c1[j & 3], si = j < 4 ? s0[j & 3] : s1[j & 3];
        const float x1 = bf2f(qr[8 + g][j]), x2 = bf2f(qr[10 + g][j]); y1[j] = x1 * co - x2 * si; y2[j] = x1 * si + x2 * co; }
      u32x4 w1 = {cvtpk(y1[0], y1[1]), cvtpk(y1[2], y1[3]), cvtpk(y1[4], y1[5]), cvtpk(y1[6], y1[7])};
      u32x4 w2 = {cvtpk(y2[0], y2[1]), cvtpk(y2[2], y2[3]), cvtpk(y2[4], y2[5]), cvtpk(y2[6], y2[7])};
      qr[8 + g] = *reinterpret_cast<bf16x8*>(&w1); qr[10 + g] = *reinterpret_cast<bf16x8*>(&w2);
    } }
  const char* ksrc[3]; int kstep[3];
#pragma unroll
  for (int d = 0; d < 3; ++d) { const int p = (wid * 3 + d) * 64 + lane, row = p / 24, cpos = p - row * 24, c = cpos ^ (row & 7);
    if (c < 16) { ksrc[d] = (const char*)(Kh + (long)row * LDK + c * 8); kstep[d] = KVBLK * LDK * 2; } else { ksrc[d] = (const char*)(Kr + (long)row * 64 + (c - 16) * 8); kstep[d] = KVBLK * 64 * 2; } }
  const char* vsrc[2];
#pragma unroll
  for (int d = 0; d < 2; ++d) { const int p = (wid * 2 + d) * 64 + lane, sub = p >> 5, q = p & 31, kk = (sub >> 2) * 8 + (q >> 2), col = (sub & 3) * 32 + (q & 3) * 8;
    const int key = (kk & ~0xC) | ((kk & 4) << 1) | ((kk & 8) >> 1); vsrc[d] = (const char*)(Vh + (long)key * LDK + col); }
#define DMA_TILE(t, stg) do { ATT_LAS char* sb_ = lds + (stg) * STG; \
    _Pragma("unroll") for (int d = 0; d < 3; ++d) __builtin_amdgcn_global_load_lds((const unsigned*)(ksrc[d] + (long)(t) * kstep[d]), (ATT_LAS unsigned*)(sb_ + (wid * 3 + d) * 1024), 16, 0, 0); \
    _Pragma("unroll") for (int d = 0; d < 2; ++d) __builtin_amdgcn_global_load_lds((const unsigned*)(vsrc[d] + (long)(t) * (KVBLK * LDK * 2)), (ATT_LAS unsigned*)(sb_ + SHM_K + (wid * 2 + d) * 1024), 16, 0, 0); } while (0)
#define RESC(a) do { if (__any((a) < 1.f)) { if (hi == 0) al_l[r32] = (a); asm volatile("s_waitcnt lgkmcnt(0)" ::: "memory"); \
    _Pragma("unroll") for (int d = 0; d < 4; ++d) _Pragma("unroll") for (int r = 0; r < 16; ++r) o[d][r] *= al_l[crow(r, hi)]; } } while (0)
  const int NT = seq / KVBLK, vbase = (int)(unsigned)(uintptr_t)lds + SHM_K + v_rd_base(lane);
  asm volatile("s_waitcnt vmcnt(0)" ::: "memory");
  DMA_TILE(0, 0); DMA_TILE(1, 1);
  asm volatile("s_waitcnt vmcnt(5)" ::: "memory"); __builtin_amdgcn_s_barrier(); asm volatile("" ::: "memory");
  int stg = 0;
  for (int j = 0; j < NT; ++j) {
    const int stg2 = stg >= 1 ? stg - 1 : 2;
    if (j + 2 < NT) DMA_TILE(j + 2, stg2);
    f32x16 p0, p1; float mn, al; bf16x8 pa0, pa1, pa2, pa3;
    SBAR(); qkt<DQK>(p0, p1, lds + stg * STG, qr, r32, hi);
    partialSM(p0, p1, m_reg, mn, al, C, THRS); RESC(al);
    finishSM(p0, p1, al, l_reg, pa0, pa1, pa2, pa3); SBAR();
    pv_d0(o, vbase + stg * STG, pa0, pa1, pa2, pa3);
    if (j + 2 < NT) asm volatile("s_waitcnt vmcnt(5)" ::: "memory"); else asm volatile("s_waitcnt vmcnt(0)" ::: "memory");
    asm volatile("s_waitcnt lgkmcnt(0)" ::: "memory"); __builtin_amdgcn_s_barrier(); asm volatile("" ::: "memory");
    stg = stg == 2 ? 0 : stg + 1;
  }
  if (hi == 0) li_l[r32] = l_reg; asm volatile("s_waitcnt lgkmcnt(0)" ::: "memory");
  float rli[16];
#pragma unroll
  for (int r = 0; r < 16; ++r) rli[r] = __builtin_amdgcn_rcpf(li_l[crow(r, hi)]);
  OT* Ow = Ob + (long)(wid * QBLK) * LDO;
#pragma unroll
  for (int r = 0; r < 16; ++r) { const int orow = crow(r, hi);
#pragma unroll
    for (int d0 = 0; d0 < 4; ++d0) st_o(&Ow[(long)orow * LDO + d0 * 32 + r32], o[d0][r] * rli[r]); }
  __syncthreads();
#undef DMA_TILE
#undef RESC
}

template <int LDP>
__device__ __forceinline__ void dil_wave_unit(const bf16* __restrict__ P, int qc, int kc, int vc, int d, int r, int t0, int nT,
                                              OT* __restrict__ O, int oc, float* __restrict__ ST  ,
                                              ATT_LAS char* vlds  , const ATT_LAS float* bias2, const float C, int lane_) {
  int lane = lane_; asm volatile("" : "+v"(lane));
  const int r32 = lane & 31, hi = lane >> 5;
  bf16x8 qr[8];
  { const bf16* qp = P + (long)(r + d * (t0 + r32)) * LDP + qc + hi * 8;
#pragma unroll
    for (int d0 = 0; d0 < 8; ++d0) qr[d0] = *(const ATT_GAS bf16x8*)(qp + d0 * 16); }
  bf16x8 kf[2][8];
#define DIL_LDK(kb, set) do { int kt_ = t0 - 64 + (kb) * 32 + r32; kt_ = kt_ < 0 ? 0 : (kt_ > nT - 1 ? nT - 1 : kt_); \
    const bf16* kp_ = P + (long)(r + d * kt_) * LDP + kc + hi * 8; \
    _Pragma("unroll") for (int d0 = 0; d0 < 8; ++d0) kf[set][d0] = *(const ATT_GAS bf16x8*)(kp_ + d0 * 16); } while (0)
  DIL_LDK(0, 0);
  f32x16 p[5];
#pragma unroll
  for (int kb = 0; kb < 5; ++kb) {
    if (kb + 1 < 5) DIL_LDK(kb + 1, (kb + 1) & 1);
    p[kb] = f32x16{};
#pragma unroll
    for (int d0 = 0; d0 < 8; ++d0) p[kb] = __builtin_amdgcn_mfma_f32_32x32x16_bf16(kf[kb & 1][d0], qr[d0], p[kb], 0, 0, 0);
  }
#undef DIL_LDK
  bf16x8 vv[2][8];
#define DIL_LDV(kb, set) do { _Pragma("unroll") for (int i = 0; i < 8; ++i) { const int id = lane + 64 * i, row = id >> 4, c = (id & 15) * 8; \
      int kt_ = t0 - 64 + (kb) * 32 + row; kt_ = kt_ < 0 ? 0 : (kt_ > nT - 1 ? nT - 1 : kt_); \
      vv[set][i] = *(const ATT_GAS bf16x8*)(P + (long)(r + d * kt_) * LDP + vc + c); } } while (0)
  DIL_LDV(0, 0);
  float m = -1e30f;
  { const int a_ = 4 * hi - r32 + 32, k_ = a_ & 3; const ATT_LAS f32x4* tp = (const ATT_LAS f32x4*)(bias2 + k_ * 196 + (a_ - k_));
    const bool interior = (t0 >= 64) && (t0 + 96 <= nT);
#pragma unroll
    for (int kb = 0; kb < 5; ++kb)
#pragma unroll
      for (int g = 0; g < 4; ++g) { const f32x4 bv = tp[kb * 8 + 2 * g];
#pragma unroll
        for (int e = 0; e < 4; ++e) { const int rg = 4 * g + e; float s = fmaf(p[kb][rg], C, bv[e]);
          if (!interior) { const int kt = t0 - 64 + kb * 32 + crow(rg, hi); s = (kt >= 0 && kt < nT) ? s : -1e30f; }
          p[kb][rg] = s; m = fmaxf(m, s); } } }
  { auto rr = __builtin_amdgcn_permlane32_swap(__float_as_uint(m), __float_as_uint(m), false, false); m = fmaxf(__uint_as_float(rr[0]), __uint_as_float(rr[1])); }
  float Z = 0.f;
#pragma unroll
  for (int kb = 0; kb < 5; ++kb)
#pragma unroll
    for (int rg = 0; rg < 16; ++rg) { p[kb][rg] = __builtin_amdgcn_exp2f(p[kb][rg] - m); Z += p[kb][rg]; }
  { auto rr = __builtin_amdgcn_permlane32_swap(__float_as_uint(Z), __float_as_uint(Z), false, false); Z = __uint_as_float(rr[0]) + __uint_as_float(rr[1]); }
  bf16x8 pa[5][2];
#pragma unroll
  for (int kb = 0; kb < 5; ++kb) { ATT_PK4(p[kb], 0, pa[kb][0]); ATT_PK4(p[kb], 8, pa[kb][1]); }
  f32x16 o[4] = {};
  const int vb = (int)(unsigned)(uintptr_t)vlds + v_rd_base(lane);
#pragma unroll
  for (int kb = 0; kb < 5; ++kb) {
    if (kb + 1 < 5) DIL_LDV(kb + 1, (kb + 1) & 1);
#pragma unroll
    for (int i = 0; i < 8; ++i) { const int id = lane + 64 * i, row = id >> 4, c = (id & 15) * 8;
      *reinterpret_cast<ATT_LAS bf16x8*>(vlds + v_st(row, c)) = vv[kb & 1][i]; }
    asm volatile("s_waitcnt lgkmcnt(0)" ::: "memory"); SBAR();
    pv32_one<0>(o[0], vb, pa[kb][0], pa[kb][1]); pv32_one<1>(o[1], vb, pa[kb][0], pa[kb][1]); pv32_one<2>(o[2], vb, pa[kb][0], pa[kb][1]); pv32_one<3>(o[3], vb, pa[kb][0], pa[kb][1]);
    SBAR();
  }
#undef DIL_LDV
#pragma unroll
  for (int rg = 0; rg < 16; ++rg) { const long row = r + d * (t0 + crow(rg, hi));
#pragma unroll
    for (int d0 = 0; d0 < 4; ++d0) st_o(&O[row * 768 + oc + d0 * 32 + r32], o[d0][rg]); }
  if (hi == 0) { const long row = r + d * (t0 + r32); typedef float f32x2_ __attribute__((ext_vector_type(2))); *(ATT_GAS f32x2_*)(ST + row * 12) = (f32x2_){m, Z}; }
}
template <int LDP>
__device__ __forceinline__ void dil_wg_unit(const bf16* __restrict__ P, int qc, int kc, int vc, int d, int r, int T0, int nT,
                                            OT* __restrict__ O, int oc, float* __restrict__ ST, ATT_LAS char* lds, const ATT_LAS float* bias2, const float C) {
  int tid_ = threadIdx.x; asm volatile("" : "+v"(tid_));
  const int tid = tid_, wid = __builtin_amdgcn_readfirstlane(tid >> 6), lane = tid & 63, r32 = lane & 31, hi = lane >> 5, t0 = T0 + 32 * wid;
  { bf16x8 kk[12];
#pragma unroll
    for (int i = 0; i < 12; ++i) { const int id = tid + 512 * i, row = id >> 4, c = (id & 15) * 8; int kt = T0 - 64 + row; kt = kt < 0 ? 0 : (kt > nT - 1 ? nT - 1 : kt);
      kk[i] = *(const ATT_GAS bf16x8*)(P + (long)(r + d * kt) * LDP + kc + c); }
#pragma unroll
    for (int i = 0; i < 12; ++i) { const int id = tid + 512 * i, row = id >> 4, cB = (id & 15) * 16;
      *reinterpret_cast<ATT_LAS bf16x8*>(lds + kswz<256>(row, cB)) = kk[i]; } }
  bf16x8 qr[8];
  { const bf16* qp = P + (long)(r + d * (t0 + r32)) * LDP + qc + hi * 8;
#pragma unroll
    for (int d0 = 0; d0 < 8; ++d0) qr[d0] = *(const ATT_GAS bf16x8*)(qp + d0 * 16); }
  __syncthreads();
  bf16x8 vv[12];
#pragma unroll
  for (int i = 0; i < 12; ++i) { const int id = tid + 512 * i, row = id >> 4, c = (id & 15) * 8; int kt = T0 - 64 + row; kt = kt < 0 ? 0 : (kt > nT - 1 ? nT - 1 : kt);
    vv[i] = *(const ATT_GAS bf16x8*)(P + (long)(r + d * kt) * LDP + vc + c); }
  f32x16 p[5];
#pragma unroll
  for (int kb = 0; kb < 5; ++kb) { const int krow = 32 * wid + 32 * kb + r32;
    p[kb] = f32x16{};
#pragma unroll
    for (int d0 = 0; d0 < 8; ++d0) { const bf16x8 kf = *reinterpret_cast<const ATT_LAS bf16x8*>(lds + kswz<256>(krow, (d0 * 16 + hi * 8) * 2));
      p[kb] = __builtin_amdgcn_mfma_f32_32x32x16_bf16(kf, qr[d0], p[kb], 0, 0, 0); } }
  float m = -1e30f;
  { const int a_ = 4 * hi - r32 + 32, k_ = a_ & 3; const ATT_LAS f32x4* tp = (const ATT_LAS f32x4*)(bias2 + k_ * 196 + (a_ - k_));
    const bool interior = (t0 >= 64) && (t0 + 96 <= nT);
#pragma unroll
    for (int kb = 0; kb < 5; ++kb)
#pragma unroll
      for (int g = 0; g < 4; ++g) { const f32x4 bv = tp[kb * 8 + 2 * g];
#pragma unroll
        for (int e = 0; e < 4; ++e) { const int rg = 4 * g + e; float s = fmaf(p[kb][rg], C, bv[e]);
          if (!interior) { const int kt = t0 - 64 + kb * 32 + crow(rg, hi); s = (kt >= 0 && kt < nT) ? s : -1e30f; }
          p[kb][rg] = s; m = fmaxf(m, s); } } }
  { auto rr = __builtin_amdgcn_permlane32_swap(__float_as_uint(m), __float_as_uint(m), false, false); m = fmaxf(__uint_as_float(rr[0]), __uint_as_float(rr[1])); }
  float Z = 0.f;
#pragma unroll
  for (int kb = 0; kb < 5; ++kb)
#pragma unroll
    for (int rg = 0; rg < 16; ++rg) { p[kb][rg] = __builtin_amdgcn_exp2f(p[kb][rg] - m); Z += p[kb][rg]; }
  { auto rr = __builtin_amdgcn_permlane32_swap(__float_as_uint(Z), __float_as_uint(Z), false, false); Z = __uint_as_float(rr[0]) + __uint_as_float(rr[1]); }
  bf16x8 pa[5][2];
#pragma unroll
  for (int kb = 0; kb < 5; ++kb) { ATT_PK4(p[kb], 0, pa[kb][0]); ATT_PK4(p[kb], 8, pa[kb][1]); }
  __syncthreads();
#pragma unroll
  for (int i = 0; i < 12; ++i) { const int id = tid + 512 * i, row = id >> 4, c = (id & 15) * 8;
    *reinterpret_cast<ATT_LAS bf16x8*>(lds + (row >> 5) * 8192 + v_st(row & 31, c)) = vv[i]; }
  __syncthreads();
  f32x16 o[4] = {};
#pragma unroll
  for (int kb = 0; kb < 5; ++kb) { const int vb = (int)(unsigned)(uintptr_t)lds + (wid + kb) * 8192 + v_rd_base(lane);
    pv32_one<0>(o[0], vb, pa[kb][0], pa[kb][1]); pv32_one<1>(o[1], vb, pa[kb][0], pa[kb][1]); pv32_one<2>(o[2], vb, pa[kb][0], pa[kb][1]); pv32_one<3>(o[3], vb, pa[kb][0], pa[kb][1]); }
#pragma unroll
  for (int rg = 0; rg < 16; ++rg) { const long row = r + d * (t0 + crow(rg, hi));
#pragma unroll
    for (int d0 = 0; d0 < 4; ++d0) st_o(&O[row * 768 + oc + d0 * 32 + r32], o[d0][rg]); }
  if (hi == 0) { const long row = r + d * (t0 + r32); typedef float f32x2_ __attribute__((ext_vector_type(2))); *(ATT_GAS f32x2_*)(ST + row * 12) = (f32x2_){m, Z}; }
  __syncthreads();
}

#if defined(MLA_DMA) && MLA_DMA == 2
#define MLA_BODY attn_pipe192_body
#elif defined(MLA_DMA) && MLA_DMA
#define MLA_BODY attn_dma_body
#else
template <int LDQ, int LDK, int LDO> __device__ __forceinline__ void attn_simple192(const bf16* Qb, const bf16* Kh, const bf16* Kr, const bf16* Vh, const float* cs, OT* Ob, int seq, const float scale, ATT_LAS char* lds) { attn_simple_body<192, LDQ, LDK, LDO>(Qb, Kh, Kr, Vh, cs, Ob, seq, scale, lds); }
#define MLA_BODY attn_simple192
#endif
}
constexpr int S = 8192, D = 2048, NMEM = 256;
constexpr int DIN = 3392, DINP = 3584;
constexpr int PC_DIL = 768, PC_MEM = 3072;
constexpr int QR = 384, KVR = 128, AQ = 512;
constexpr int NUP = 2816;
constexpr int UC_KV = 1280;
constexpr int DFF = 5632, DFE = 7168, NE = 8;
constexpr int MP = 18432;
constexpr float EPS = 1e-6f;
constexpr int NWAVES = 8;

constexpr size_t al256(size_t x) { return (x + 255) / 256 * 256; }
constexpr size_t WS_CTL = 0, CTL_ZERO_BYTES = 1u << 20;
constexpr size_t WS_WIN = WS_CTL + CTL_ZERO_BYTES;
constexpr size_t WS_WUP = WS_WIN + al256((size_t)2 * DINP * D * 2);
constexpr size_t WS_WMEM = WS_WUP + al256((size_t)2 * NUP * AQ * 2);
constexpr size_t WS_WOUT = WS_WMEM + al256((size_t)2 * 1024 * D * 2);
constexpr size_t WS_WGU = WS_WOUT + al256((size_t)2 * D * D * 2);
constexpr size_t WS_WDN = WS_WGU + al256((size_t)2 * DFF * D * 2);
constexpr size_t WS_MGU = WS_WDN + al256((size_t)D * DFF * 2);
constexpr size_t WS_MDN = WS_MGU + al256((size_t)NE * 2 * DFE * D * 2);
constexpr size_t WS_XN = WS_MDN + al256((size_t)NE * D * DFE * 2);
constexpr size_t WS_MEMN = WS_XN + al256((size_t)S * D * 2);
constexpr size_t WS_MEMKV = WS_MEMN + al256((size_t)2 * NMEM * D * 2);
constexpr size_t WS_PROJ = WS_MEMKV + al256((size_t)2 * NMEM * 1024 * 2);
constexpr size_t WS_AQKV = WS_PROJ + al256((size_t)S * DINP * 2);
constexpr size_t WS_KROPE = WS_AQKV + al256((size_t)S * AQ * 2);
constexpr size_t WS_ROPECS = WS_KROPE + al256((size_t)S * 64 * 2);
constexpr size_t WS_QKVM = WS_ROPECS + al256((size_t)S * 64 * 4);
constexpr size_t WS_YPRE = WS_QKVM + al256((size_t)S * NUP * 2);
constexpr size_t WS_DILO = WS_YPRE + al256((size_t)S * D * 4);
constexpr size_t WS_DILS = WS_DILO + al256((size_t)3 * S * 768 * 4);
constexpr size_t WS_Y = WS_DILS + al256((size_t)3 * S * 12 * 4);
constexpr size_t WS_XA = WS_Y + al256((size_t)S * D * 2);
constexpr size_t WS_ROUTE = WS_XA + al256((size_t)S * D * 4);
constexpr size_t WS_XP = WS_ROUTE + al256((size_t)S * 32);
constexpr size_t WS_OUTP = WS_XP + al256((size_t)MP * D * 2);
constexpr size_t WS_ACTP = WS_OUTP + al256((size_t)MP * D * 2);
constexpr size_t WS_OUTQ = WS_ACTP + al256((size_t)MP * DFE * 2);
constexpr size_t WS_END = WS_OUTQ + al256((size_t)4 * 2048 * D * 2);
static_assert(WS_END <= 1879048192ull, "workspace map exceeds 4 x the largest input");
constexpr int CW_BAR = 16384;
constexpr int CW_QUEUE = 8192;
constexpr int CW_CNT = 8192 + 256;
constexpr int CW_QUEUE2 = 65536;
constexpr int CW_CVT = 8192 + 320;
constexpr int CW_DONE = 8192 + 384;
constexpr int CW_TILEE = 8192 + 512;
constexpr int RING_BYTES = 131072;
constexpr int LDSCTL_OFF = RING_BYTES, MISC_OFF = LDSCTL_OFF + 320;
constexpr int BIAS_OFF = 132096;
constexpr int LDS_BYTES = 147456;
static_assert(BIAS_OFF >= MISC_OFF + 128 && BIAS_OFF + 3 * 6 * 132 * 4 + 4 * 196 * 4 <= LDS_BYTES, "LDS map");

#define GAS __attribute__((address_space(1)))
#define LAS __attribute__((address_space(3)))
typedef unsigned short bf16;
typedef unsigned v4u __attribute__((ext_vector_type(4)));
typedef unsigned v2u __attribute__((ext_vector_type(2)));
typedef float f32x4 __attribute__((ext_vector_type(4)));
typedef short bf16x8 __attribute__((ext_vector_type(8)));
typedef GAS unsigned gu32;
#define RLX_AGENT __ATOMIC_RELAXED, __HIP_MEMORY_SCOPE_AGENT
#define LDS_WAIT() asm volatile("s_waitcnt lgkmcnt(0)" ::: "memory")
#define VM_WAIT() asm volatile("s_waitcnt vmcnt(0)" ::: "memory")
__device__ __forceinline__ unsigned f2bf(float f) { unsigned u = __builtin_bit_cast(unsigned, f); return (u + 0x7fffu + ((u >> 16) & 1u)) >> 16; }
__device__ __forceinline__ unsigned pk2(float lo, float hi) { return f2bf(lo) | (f2bf(hi) << 16); }
__device__ __forceinline__ float bflo(unsigned w) { return __uint_as_float(w << 16); }
__device__ __forceinline__ float bfhi(unsigned w) { return __uint_as_float(w & 0xffff0000u); }

#define XB_TMO      128
#define XB_XCNT(j)  (256  + 64 * (j))
#define XB_XSUB(j)  (1280 + 64 * (j))
#define XB_XGEN(j)  (2304 + 64 * (j))
#define XB_TOP      3328
#define XB_TOPGEN   3392
#define XCD_BAR_WORDS 3456
#define XB_SPIN_CAP (1u << 18)
__device__ __forceinline__ unsigned xb_ld(unsigned* p)              { return __hip_atomic_load(p, __ATOMIC_RELAXED, __HIP_MEMORY_SCOPE_AGENT); }
__device__ __forceinline__ unsigned xb_add(unsigned* p, unsigned v) { return __hip_atomic_fetch_add(p, v, __ATOMIC_RELAXED, __HIP_MEMORY_SCOPE_AGENT); }
__device__ __forceinline__ unsigned xb_xcc_id() { return (unsigned)__builtin_amdgcn_s_getreg((3 << 11) | 20) & 0xFu; }
#define XB_SPIN(cond, bar) do { unsigned _sp = 0; while (cond) { __builtin_amdgcn_s_sleep(1); \
    if ((++_sp & 255u) == 0u) { if (xb_ld(&(bar)[XB_TMO])) break; if (_sp > XB_SPIN_CAP) { atomicAdd(&(bar)[XB_TMO], 1u); break; } } } } while (0)
struct XcdBarrier { unsigned* bar; unsigned x; volatile LAS unsigned* st; };
__device__ __forceinline__ XcdBarrier xcd_barrier_post(unsigned* bar, volatile LAS unsigned* st) {
    XcdBarrier b; b.bar = bar; b.x = xb_xcc_id(); b.st = st;
    if (threadIdx.x == 0) (void)xb_add(&bar[XB_XCNT(b.x)], 1u);
    return b;
}
__device__ __forceinline__ void xcd_barrier_complete(unsigned* bar, unsigned x, unsigned& nloc, unsigned& nx) {
    const unsigned G = gridDim.x * gridDim.y * gridDim.z;
    unsigned sum, cnt, mine, sp = 0u;
    for (;;) {
        sum = 0u; cnt = 0u; mine = 0u;
#pragma unroll
        for (unsigned j = 0; j < 16; ++j) { const unsigned c = xb_ld(&bar[XB_XCNT(j)]); sum += c; cnt += (c > 0u) ? 1u : 0u; mine = (j == x) ? c : mine; }
        if (sum == G) break;
        __builtin_amdgcn_s_sleep(1);
        if ((++sp & 255u) == 0u) { if (xb_ld(&bar[XB_TMO])) break; if (sp > XB_SPIN_CAP) { atomicAdd(&bar[XB_TMO], 1u); break; } }
    }
    nloc = mine > 0u ? mine : 1u; nx = cnt > 0u ? cnt : 1u;
}
__device__ __forceinline__ void xcd_barrier(const XcdBarrier& b) {
    asm volatile("s_waitcnt vmcnt(0)" ::: "memory");
    __syncthreads();
    if (threadIdx.x == 0) {
        unsigned* bar = b.bar;
        __builtin_amdgcn_s_waitcnt(0);
        unsigned nloc = b.st[0], nx = b.st[1];
        if (nloc == 0u) { xcd_barrier_complete(bar, b.x, nloc, nx); b.st[0] = nloc; b.st[1] = nx; }
        const unsigned old = xb_add(&bar[XB_XSUB(b.x)], 1u);
        const unsigned gen = old / nloc;
        if (old + 1u == (gen + 1u) * nloc) {
            __builtin_amdgcn_fence(__ATOMIC_RELEASE, "agent");
            asm volatile("s_waitcnt vmcnt(0)" ::: "memory");
            const unsigned og = xb_add(&bar[XB_TOP], 1u);
            const unsigned tg = og / nx;
            if (og + 1u == (tg + 1u) * nx) xb_add(&bar[XB_TOPGEN], 1u);
            else XB_SPIN(xb_ld(&bar[XB_TOPGEN]) == tg, bar);
            __builtin_amdgcn_fence(__ATOMIC_ACQUIRE, "agent");
            xb_add(&bar[XB_XGEN(b.x)], 1u);
            asm volatile("s_waitcnt vmcnt(0)" ::: "memory");
        } else {
            XB_SPIN(xb_ld(&bar[XB_XGEN(b.x)]) == gen, bar);
            __builtin_amdgcn_fence(__ATOMIC_ACQUIRE, "agent");
            asm volatile("s_waitcnt vmcnt(0)" ::: "memory");
        }
    }
    __syncthreads();
}

struct Args {
    const float* in[23]; float* out; unsigned char* ws;
    float invf[32];
    int ph_lo, ph_hi, li, rep;
};
struct Frame {
    LAS unsigned char* lds;
    volatile LAS unsigned* MISC;
    gu32* ctl;
    int tid, lane, wave, G, gw, NGW;
    unsigned char* ws;
};
__device__ __forceinline__ float wave_sum(float v) {
#pragma unroll
    for (int o = 1; o < 64; o <<= 1) v += __shfl_xor(v, o);
    return v;
}
__device__ __forceinline__ float wave_max(float v) {
#pragma unroll
    for (int o = 1; o < 64; o <<= 1) v = fmaxf(v, __shfl_xor(v, o));
    return v;
}

__device__ __forceinline__ unsigned pk4_fp8(float a, float b, float c, float d) { int w = 0; w = __builtin_amdgcn_cvt_pk_fp8_f32(a, b, w, false); w = __builtin_amdgcn_cvt_pk_fp8_f32(c, d, w, true); return (unsigned)w; }
#if defined(CVT_REG) && CVT_REG
__device__ __forceinline__ void cvt_load(const float* __restrict__ W, int N, int k0, int n0, int lane, f32x4 (&v)[8]) {
    const GAS float* p = (const GAS float*)(W + (size_t)(k0 + (lane >> 5) * 32) * N + n0 + (lane & 31));
#pragma unroll
    for (int i = 0; i < 8; ++i)
#pragma unroll
        for (int e = 0; e < 4; ++e) v[i][e] = __builtin_nontemporal_load(p + (size_t)(i * 4 + e) * N);
}
template <bool FP8>
__device__ __forceinline__ void cvt_finish(const f32x4 (&v)[8], int k0, void* __restrict__ dstv, int ldd, int drow0, int kdst0, LAS float* scr, int lane, float wsc) {
    const int n = lane & 31, kh = (lane >> 5) * 32;
    if constexpr (FP8) { GAS v4u* d = (GAS v4u*)((unsigned char*)dstv + (size_t)(drow0 + n) * ldd + kdst0 + k0 + kh);
#pragma unroll
        for (int j = 0; j < 2; ++j) { v4u o;
            o.x = pk4_fp8(v[4 * j][0] * wsc, v[4 * j][1] * wsc, v[4 * j][2] * wsc, v[4 * j][3] * wsc); o.y = pk4_fp8(v[4 * j + 1][0] * wsc, v[4 * j + 1][1] * wsc, v[4 * j + 1][2] * wsc, v[4 * j + 1][3] * wsc);
            o.z = pk4_fp8(v[4 * j + 2][0] * wsc, v[4 * j + 2][1] * wsc, v[4 * j + 2][2] * wsc, v[4 * j + 2][3] * wsc); o.w = pk4_fp8(v[4 * j + 3][0] * wsc, v[4 * j + 3][1] * wsc, v[4 * j + 3][2] * wsc, v[4 * j + 3][3] * wsc);
            __builtin_nontemporal_store(o, d + j); } }
    else { GAS v4u* d = (GAS v4u*)((bf16*)dstv + (size_t)(drow0 + n) * ldd + kdst0 + k0 + kh);
#pragma unroll
        for (int j = 0; j < 4; ++j) { v4u o; o.x = pk2(v[2 * j][0], v[2 * j][1]); o.y = pk2(v[2 * j][2], v[2 * j][3]); o.z = pk2(v[2 * j + 1][0], v[2 * j + 1][1]); o.w = pk2(v[2 * j + 1][2], v[2 * j + 1][3]);
            __builtin_nontemporal_store(o, d + j); } }
}
#else
__device__ __forceinline__ void cvt_load(const float* __restrict__ W, int N, int k0, int n0, int lane, f32x4 (&v)[8]) {
    const int lr = lane >> 3, lc = (lane & 7) * 4;
#pragma unroll
    for (int i = 0; i < 8; ++i) v[i] = __builtin_nontemporal_load((const GAS f32x4*)(W + (size_t)(k0 + i * 8 + lr) * N + n0 + lc));
}
template <bool FP8>
__device__ __forceinline__ void cvt_finish(const f32x4 (&v)[8], int k0, void* __restrict__ dstv, int ldd, int drow0, int kdst0, LAS float* scr, int lane, float wsc) {
    const int lr = lane >> 3, lc = (lane & 7) * 4;
#pragma unroll
    for (int i = 0; i < 8; ++i) { LAS float* s = scr + (i * 8 + lr) * 33 + lc; s[0] = v[i][0]; s[1] = v[i][1]; s[2] = v[i][2]; s[3] = v[i][3]; }
    LDS_WAIT(); asm volatile("" ::: "memory");
    const int c = lane & 7;
#pragma unroll
    for (int j = 0; j < 4; ++j) { const int n = (lane >> 3) + 8 * j; const LAS float* s = scr + (8 * c) * 33 + n;
        if constexpr (FP8) { v2u o; o.x = pk4_fp8(s[0 * 33] * wsc, s[1 * 33] * wsc, s[2 * 33] * wsc, s[3 * 33] * wsc); o.y = pk4_fp8(s[4 * 33] * wsc, s[5 * 33] * wsc, s[6 * 33] * wsc, s[7 * 33] * wsc);
            __builtin_nontemporal_store(o, (GAS v2u*)((unsigned char*)dstv + (size_t)(drow0 + n) * ldd + kdst0 + k0 + 8 * c)); }
        else { v4u o; o.x = pk2(s[0 * 33], s[1 * 33]); o.y = pk2(s[2 * 33], s[3 * 33]); o.z = pk2(s[4 * 33], s[5 * 33]); o.w = pk2(s[6 * 33], s[7 * 33]);
            __builtin_nontemporal_store(o, (GAS v4u*)((bf16*)dstv + (size_t)(drow0 + n) * ldd + kdst0 + k0 + 8 * c)); } }
    LDS_WAIT(); asm volatile("" ::: "memory");
}
#endif
__device__ __forceinline__ int cvt_drow(int mode, int n0, int roff) { return mode == 0 ? n0 + roff : (mode == 1 ? (n0 >> 7) * 256 + (n0 & 127) : (mode == 2 ? (n0 >> 7) * 256 + 128 + (n0 & 127) : (n0 < 576 ? n0 : n0 + 192))); }
template <bool FP8>
__device__ __forceinline__ void cvt_job(Frame& F, const float* W, int K, int N, void* dst, int ldd, int kdst0, int mode, int roff, LAS float* scr, float wsc) {
    const int nnb = N / 32, nitems = (K / 64) * nnb;
    int it = F.gw; if (it >= nitems) return;
    f32x4 va[8], vb[8];
    cvt_load(W, N, (it / nnb) * 64, (it % nnb) * 32, F.lane, va);
    for (;;) {
        const int it1 = it + F.NGW; if (it1 < nitems) cvt_load(W, N, (it1 / nnb) * 64, (it1 % nnb) * 32, F.lane, vb);
        cvt_finish<FP8>(va, (it / nnb) * 64, dst, ldd, cvt_drow(mode, (it % nnb) * 32, roff), kdst0, scr, F.lane, wsc);
        if (it1 >= nitems) break;
        const int it2 = it1 + F.NGW; if (it2 < nitems) cvt_load(W, N, (it2 / nnb) * 64, (it2 % nnb) * 32, F.lane, va);
        cvt_finish<FP8>(vb, (it1 / nnb) * 64, dst, ldd, cvt_drow(mode, (it1 % nnb) * 32, roff), kdst0, scr, F.lane, wsc);
        if (it2 >= nitems) break;
        it = it2;
    }
}
__device__ __forceinline__ void rms_row_to_bf16(const float* xrow, const float* g, bf16* orow, int lane) {
    const GAS f32x4* xr = (const GAS f32x4*)xrow + lane; const GAS f32x4* gr = (const GAS f32x4*)g + lane;
    f32x4 v[8]; float s = 0.f;
#pragma unroll
    for (int j = 0; j < 8; ++j) { v[j] = xr[64 * j]; s += (v[j].x * v[j].x + v[j].y * v[j].y) + (v[j].z * v[j].z + v[j].w * v[j].w); }
    const float rstd = 1.f / sqrtf(wave_sum(s) * (1.f / D) + EPS);
    GAS v2u* o8 = (GAS v2u*)orow + lane;
#pragma unroll
    for (int j = 0; j < 8; ++j) { const f32x4 gg = gr[64 * j]; v2u w; w.x = pk2(v[j].x * rstd * gg.x, v[j].y * rstd * gg.y); w.y = pk2(v[j].z * rstd * gg.z, v[j].w * rstd * gg.w); o8[64 * j] = w; }
}
__device__ __forceinline__ void rms_row_to_fp8(const float* xrow, const float* g, unsigned char* orow, int lane) {
    const GAS f32x4* xr = (const GAS f32x4*)xrow + lane; const GAS f32x4* gr = (const GAS f32x4*)g + lane;
    f32x4 v[8]; float s = 0.f;
#pragma unroll
    for (int j = 0; j < 8; ++j) { v[j] = xr[64 * j]; s += (v[j].x * v[j].x + v[j].y * v[j].y) + (v[j].z * v[j].z + v[j].w * v[j].w); }
    const float rstd = 1.f / sqrtf(wave_sum(s) * (1.f / D) + EPS);
    GAS unsigned* o4 = (GAS unsigned*)orow + lane;
#pragma unroll
    for (int j = 0; j < 8; ++j) { const f32x4 gg = gr[64 * j]; o4[64 * j] = pk4_fp8(v[j].x * rstd * gg.x, v[j].y * rstd * gg.y, v[j].z * rstd * gg.z, v[j].w * rstd * gg.w); }
}
__device__ __forceinline__ void sincos_f64(float ang, float& c, float& s) {
    const double a = (double)ang, twopi = 6.283185307179586476925286766559, inv2pi = 0.15915494309189533576888376337251;
    const double q = __builtin_rint(a * inv2pi); const double r = a - q * twopi;
    const double r2 = r * r; double ss = 1.0, cc = 1.0;
#pragma unroll
    for (int k = 14; k >= 1; --k) { ss = 1.0 - r2 * (1.0 / (double)((2 * k) * (2 * k + 1))) * ss; cc = 1.0 - r2 * (1.0 / (double)((2 * k - 1) * (2 * k))) * cc; }
    s = (float)(r * ss); c = (float)cc;
}
__device__ const unsigned char DIL_BUCKET[3][129] = {
 {11,11,11,11,11,11,11,11,11,11,11,11,11,11,11,10,10,10,10,10,10,10,10,10,10,10,10,10,10,10,10,10,10,10,10,10,10,10,9,9,9,9,9,9,9,9,9,9,9,9,8,8,8,8,8,8,8,7,6,5,4,3,2,1,0,17,18,19,20,21,22,23,24,24,24,24,24,24,24,25,25,25,25,25,25,25,25,25,25,25,25,26,26,26,26,26,26,26,26,26,26,26,26,26,26,26,26,26,26,26,26,26,26,26,27,27,27,27,27,27,27,27,27,27,27,27,27,27,27},
 {13,13,13,13,13,13,13,13,13,13,13,13,13,13,13,13,13,13,13,13,13,13,13,12,12,12,12,12,12,12,12,12,12,12,12,12,12,12,12,12,12,12,11,11,11,11,11,11,11,11,11,11,10,10,10,10,10,10,9,9,9,8,8,4,0,20,24,24,25,25,25,26,26,26,26,26,26,27,27,27,27,27,27,27,27,27,27,28,28,28,28,28,28,28,28,28,28,28,28,28,28,28,28,28,28,28,29,29,29,29,29,29,29,29,29,29,29,29,29,29,29,29,29,29,29,29,29,29,29},
 {15,15,15,15,15,15,15,15,15,15,15,15,15,15,15,15,15,15,15,15,15,15,15,15,15,15,15,15,15,15,14,14,14,14,14,14,14,14,14,14,14,14,14,14,14,13,13,13,13,13,13,13,13,13,12,12,12,12,12,11,11,10,10,9,0,25,26,26,27,27,28,28,28,28,28,29,29,29,29,29,29,29,29,29,30,30,30,30,30,30,30,30,30,30,30,30,30,30,30,31,31,31,31,31,31,31,31,31,31,31,31,31,31,31,31,31,31,31,31,31,31,31,31,31,31,31,31,31,31}};

typedef float f32x2 __attribute__((ext_vector_type(2)));
__device__ __forceinline__ f32x4 ld_o4(const float* p) { return *(const GAS f32x4*)p; }
__device__ __forceinline__ f32x4 ld_o4(const unsigned short* p) { const v2u w = *(const GAS v2u*)p; return (f32x4){bflo(w.x), bfhi(w.x), bflo(w.y), bfhi(w.y)}; }
#ifndef PH_MASK
#define PH_MASK 0xFFFFu
#endif
#ifndef REPEAT_PHASE
#define REPEAT_PHASE -1
#endif
#ifndef ATT_EN
#define ATT_EN 7
#endif
#define PEN(k) ((PH_MASK >> (k)) & 1u)
#ifndef FFN_FP8
#define FFN_FP8 3
#endif
constexpr bool F8D = (FFN_FP8 & 1) != 0, F8M = (FFN_FP8 & 2) != 0;
constexpr int EBD = F8D ? 1 : 2, EBM = F8M ? 1 : 2;
template <bool B> struct Sc { static constexpr float w_gu = B ? 32.f : 1.f, w_dn = B ? 64.f : 1.f, a_sc = B ? 4.f : 1.f, dn = 1.f / (w_dn * a_sc); };
template <bool B> using FfnEpi1 = typename std::conditional<B, pg8::EpiSwiGLU8, pg8::EpiSwiGLU>::type;
template <bool B> struct Epi1Maker;
template <> struct Epi1Maker<true> { static __device__ __forceinline__ pg8::EpiSwiGLU8 make(void* O, int ldc) { return pg8::EpiSwiGLU8{(unsigned char*)O, ldc, 1.f / Sc<true>::w_gu, Sc<true>::a_sc}; } };
template <> struct Epi1Maker<false> { static __device__ __forceinline__ pg8::EpiSwiGLU make(void* O, int ldc) { return pg8::EpiSwiGLU{(unsigned short*)O, ldc}; } };

constexpr int MOE_MAT_ITEMS = 7168, MOE_GU_ITEMS = 16 * MOE_MAT_ITEMS, MOE_NITEMS = 24 * MOE_MAT_ITEMS, MOE_CHUNK = 64, MOE_NCHUNK = MOE_NITEMS / MOE_CHUNK;
struct MoeItem { const float* W; void* dst; int N, k0, n0, ldd, drow0; float wsc; };
typedef const __attribute__((address_space(4))) Args* KArgs;
__device__ __forceinline__ MoeItem moe_item(KArgs ka, unsigned char* ws, int idx) {
    MoeItem m;
    if (idx < MOE_GU_ITEMS) { const int mat = idx / MOE_MAT_ITEMS, local = idx % MOE_MAT_ITEMS, e = mat >> 1, up = mat & 1, kb = local / (DFE / 32), nb = local % (DFE / 32);
        m.W = ka->in[19 + up] + (size_t)e * D * DFE; m.N = DFE; m.k0 = kb * 64; m.n0 = nb * 32; m.dst = ws + WS_MGU + (size_t)e * 2 * DFE * D * EBM; m.ldd = D;
        m.drow0 = (m.n0 >> 7) * 256 + up * 128 + (m.n0 & 127); m.wsc = Sc<F8M>::w_gu; }
    else { const int i2 = idx - MOE_GU_ITEMS, e = i2 / MOE_MAT_ITEMS, local = i2 % MOE_MAT_ITEMS, kb = local / (D / 32), nb = local % (D / 32);
        m.W = ka->in[21] + (size_t)e * DFE * D; m.N = D; m.k0 = kb * 64; m.n0 = nb * 32; m.dst = ws + WS_MDN + (size_t)e * D * DFE * EBM; m.ldd = DFE; m.drow0 = m.n0; m.wsc = Sc<F8M>::w_dn; }
    return m;
}
__device__ __forceinline__ void moe_cvt_chunk(Frame& F, KArgs ka, int c) {
    LAS float* scr = (LAS float*)(F.lds + F.wave * 16384);
    const int i0 = c * MOE_CHUNK + F.wave * 8;
    f32x4 va[8], vb[8], vc[8]; MoeItem ma, mb, mc;
#define MC_L(m, v, i) do { m = moe_item(ka, F.ws, i0 + (i)); cvt_load(m.W, m.N, m.k0, m.n0, F.lane, v); } while (0)
#define MC_F(m, v) cvt_finish<F8M>(v, m.k0, m.dst, m.ldd, m.drow0, 0, scr, F.lane, m.wsc)
    MC_L(ma, va, 0); MC_L(mb, vb, 1); MC_L(mc, vc, 2);
    MC_F(ma, va); MC_L(ma, va, 3); MC_F(mb, vb); MC_L(mb, vb, 4); MC_F(mc, vc); MC_L(mc, vc, 5);
    MC_F(ma, va); MC_L(ma, va, 6); MC_F(mb, vb); MC_L(mb, vb, 7); MC_F(mc, vc); MC_F(ma, va); MC_F(mb, vb);
#undef MC_L
#undef MC_F
}
__device__ __forceinline__ void moe_cvt_fill(Frame& F, KArgs ka, int ph) {
    { int t_ = threadIdx.x; asm volatile("" : "+v"(t_)); F.tid = t_; F.lane = t_ & 63; }
    for (;;) {
        if (F.tid == 0) { unsigned c = MOE_NCHUNK;
            if (ph < 0 || __hip_atomic_load(F.ctl + CW_DONE + ph, RLX_AGENT) < (unsigned)F.G) c = __hip_atomic_fetch_add(F.ctl + CW_CVT + (ph == -2 ? 16 : 0), 1u, RLX_AGENT);
            F.MISC[17] = c; }
        __syncthreads(); const unsigned c = F.MISC[17]; __syncthreads();
        if (c >= (unsigned)MOE_NCHUNK) break;
        moe_cvt_chunk(F, ka, (int)c);
    }
}
#define FILL(ph) do { __syncthreads(); if (F.tid == 0) (void)__hip_atomic_fetch_add(F.ctl + CW_DONE + (ph), 1u, RLX_AGENT); moe_cvt_fill(F, ka, (ph)); } while (0)
#ifndef MLA_DMA
#define MLA_DMA 1
#endif
#ifndef MOE_TAIL
#define MOE_TAIL 1
#endif
#ifndef GEMM_SP2
#define GEMM_SP2 1
#endif
constexpr bool SP2V = (GEMM_SP2 != 0);
#ifndef PROBE_ATT
#define PROBE_ATT 7
#endif
#ifndef FILLMASK
#define FILLMASK 7
#endif
constexpr int PH_PER_LAYER = 11, N_PHASES = 1 + 2 * PH_PER_LAYER;
#ifndef MK_N_LAUNCHES
#define MK_N_LAUNCHES 1
#endif
constexpr int N_LAUNCHES = MK_N_LAUNCHES;

__global__ void __launch_bounds__(NWAVES * 64, 2) mk_fwd(Args) {
    KArgs ka = (KArgs)__builtin_amdgcn_kernarg_segment_ptr(); asm volatile("" : "+s"(ka));
#define args (*ka)
    extern __shared__ __attribute__((aligned(16))) unsigned char lds[];
    Frame F;
    F.lds = (LAS unsigned char*)lds;
    F.MISC = (volatile LAS unsigned*)(F.lds + MISC_OFF);
    F.tid = threadIdx.x; F.lane = F.tid & 63; F.wave = __builtin_amdgcn_readfirstlane(F.tid >> 6);
    F.G = gridDim.x; F.gw = blockIdx.x * NWAVES + F.wave; F.NGW = F.G * NWAVES;
    F.ws = args.ws; F.ctl = (gu32*)(args.ws + WS_CTL);
    unsigned char* ws = args.ws;
    for (int u = F.tid; u < (LDS_BYTES - LDSCTL_OFF) / 4; u += NWAVES * 64) ((LAS unsigned*)(F.lds + LDSCTL_OFF))[u] = 0u;
    __syncthreads();
    XcdBarrier bar; bar.bar = (unsigned*)(F.ctl + CW_BAR) + args.li * 4096; bar.x = 0; bar.st = nullptr;
    if (N_LAUNCHES != N_PHASES) bar = xcd_barrier_post((unsigned*)(F.ctl + CW_BAR) + args.li * 4096, F.MISC + 8);
#define GRID_BAR() do { if (N_LAUNCHES != N_PHASES) xcd_barrier(bar); } while (0)
    const int lo = args.ph_lo, hi = args.ph_hi;
#define IN(k) (lo <= (k) && (k) < hi)
#define BOTH(k) (IN(k) && IN((k) + 1))

#define x_in (args.in[0])
#define XN8 ((unsigned char*)(ws + WS_XN))
#define WIN ((bf16*)(ws + WS_WIN))
#define WUP ((bf16*)(ws + WS_WUP))
#define WMEM ((bf16*)(ws + WS_WMEM))
#define WOUT ((bf16*)(ws + WS_WOUT))
#define WGU ((bf16*)(ws + WS_WGU))
#define WDN ((bf16*)(ws + WS_WDN))
#define MGU ((bf16*)(ws + WS_MGU))
#define MDN ((bf16*)(ws + WS_MDN))
#define XN ((bf16*)(ws + WS_XN))
#define MEMN ((bf16*)(ws + WS_MEMN))
#define MEMKV ((bf16*)(ws + WS_MEMKV))
#define PROJ ((bf16*)(ws + WS_PROJ))
#define AQKV ((bf16*)(ws + WS_AQKV))
#define KROPE ((bf16*)(ws + WS_KROPE))
#define ROPECS ((float*)(ws + WS_ROPECS))
#define QKVM ((bf16*)(ws + WS_QKVM))
#define YPRE ((att::OT*)(ws + WS_YPRE))
#define YPREF ((float*)(ws + WS_YPRE))
#define DILO ((att::OT*)(ws + WS_DILO))
#define DILS ((float*)(ws + WS_DILS))
#define Y ((bf16*)(ws + WS_Y))
#define XA ((float*)(ws + WS_XA))
#define ROUTE ((unsigned*)(ws + WS_ROUTE))
#define XP ((bf16*)(ws + WS_XP))
#define OUTP ((bf16*)(ws + WS_OUTP))
#define OUTQ ((bf16*)(ws + WS_OUTQ))
#define ACTP ((bf16*)(ws + WS_ACTP))
#define ACT ((bf16*)(ws + WS_ACTP))
#define PHASE_BEGIN() do { int t_ = threadIdx.x; asm volatile("" : "+v"(t_)); F.tid = t_; F.lane = t_ & 63; asm volatile("" : "+s"(ka)); } while (0)

    if (PEN(0) && IN(0)) { PHASE_BEGIN();
        LAS float* scr = (LAS float*)(F.lds + F.wave * 16384);
        { const v4u z = {0u, 0u, 0u, 0u}; const int gt = blockIdx.x * (NWAVES * 64) + F.tid, ngt = F.G * NWAVES * 64;
          for (int l = 0; l < 2; ++l) {
              GAS v4u* w = (GAS v4u*)(WIN + (size_t)l * DINP * D + (size_t)576 * D); for (int i = gt; i < 192 * D / 8; i += ngt) w[i] = z;
              GAS v4u* u = (GAS v4u*)(WUP + (size_t)l * NUP * AQ);
              for (int i = gt; i < NUP * 64; i += ngt) { const int row = i >> 6, c = i & 63; const bool zero = row < 1152 ? (c >= 48) : (row < 1280 ? true : (c < 48)); if (zero) u[i] = z; } } }
        for (int rep = 0; rep < (REPEAT_PHASE == 0 ? 2 : 1); ++rep) {
        for (int l = 0; l < 2; ++l) {
            cvt_job<false>(F, args.in[5] + (size_t)l * D * DIN, D, DIN, WIN + (size_t)l * DINP * D, D, 0, 3, 0, scr, 1.f);
            cvt_job<false>(F, args.in[7] + (size_t)l * QR * 1152, QR, 1152, WUP + (size_t)l * NUP * AQ, AQ, 0, 0, 0, scr, 1.f);
            cvt_job<false>(F, args.in[9] + (size_t)l * KVR * 1536, KVR, 1536, WUP + (size_t)l * NUP * AQ, AQ, QR, 0, UC_KV, scr, 1.f);
            cvt_job<false>(F, args.in[11] + (size_t)l * D * 1024, D, 1024, WMEM + (size_t)l * 1024 * D, D, 0, 0, 0, scr, 1.f);
            cvt_job<false>(F, args.in[13] + (size_t)l * D * D, D, D, WOUT + (size_t)l * D * D, D, 0, 0, 0, scr, 1.f);
        }
        cvt_job<F8D>(F, args.in[15], D, DFF, WGU, D, 0, 1, 0, scr, Sc<F8D>::w_gu);
        cvt_job<F8D>(F, args.in[16], D, DFF, WGU, D, 0, 2, 0, scr, Sc<F8D>::w_gu);
        cvt_job<F8D>(F, args.in[17], DFF, D, WDN, DFF, 0, 0, 0, scr, Sc<F8D>::w_dn);
        }
        { const int* pos = (const int*)args.in[2];
          for (int idx = blockIdx.x * (NWAVES * 64) + F.tid; idx < S * 32; idx += F.G * NWAVES * 64) { const int row = idx >> 5, i = idx & 31;
              const float ang = (float)pos[row] * args.invf[i]; float c, s; sincos_f64(ang, c, s); ROPECS[row * 64 + i] = c; ROPECS[row * 64 + 32 + i] = s; } }
        for (int m = F.gw; m < 2 * NMEM; m += F.NGW) { const int l = m >> 8, r = m & 255; rms_row_to_bf16(args.in[1] + (size_t)r * D, args.in[10] + (size_t)l * D, MEMN + (size_t)m * D, F.lane); }
        for (int m = F.gw; m < S; m += F.NGW) rms_row_to_bf16(x_in + (size_t)m * D, args.in[4], XN + (size_t)m * D, F.lane);
        if (BOTH(0)) GRID_BAR();
    }

    for (int l = 0; l < 2; ++l) {
        const int pb = 1 + l * PH_PER_LAYER;
        if (PEN(1) && IN(pb + 0)) { PHASE_BEGIN();
            { pg8::Gemm g{XN, WIN + (size_t)l * DINP * D, 2 * D, 2 * D, D / 64}; pg8::InProjOrder So; So.so.init(S, DINP, F.G, (int)blockIdx.x); So.nextra = (l == 0) ? 8 : 0; So.A2 = MEMN; So.B2 = WMEM;
              pg8::EpiBf16Sel E{PROJ, DINP, MEMKV, 1024};
              pg8::gemm_phase<pg8::EpiBf16Sel, pg8::InProjOrder, true, SP2V>(F.lds, g, So, E); }
            if (FILLMASK & 1) FILL(pb + 0);
            if (BOTH(pb + 0)) GRID_BAR();
        }
        if (PEN(2) && IN(pb + 1)) { PHASE_BEGIN();
            const float* gq = args.in[6] + l * QR; const float* gkv = args.in[8] + l * KVR;
            for (int m = F.gw; m < S; m += F.NGW) {
                const v4u w = *(const GAS v4u*)(PROJ + (size_t)m * DINP + F.lane * 8);
                float v[8] = {bflo(w.x), bfhi(w.x), bflo(w.y), bfhi(w.y), bflo(w.z), bfhi(w.z), bflo(w.w), bfhi(w.w)};
                float sq = 0.f;
#pragma unroll
                for (int j = 0; j < 8; ++j) sq += v[j] * v[j];
                const float sq_q = wave_sum(F.lane < 48 ? sq : 0.f), sq_kv = wave_sum(F.lane >= 48 ? sq : 0.f);
                const float rstd = F.lane < 48 ? 1.f / sqrtf(sq_q * (1.f / QR) + EPS) : 1.f / sqrtf(sq_kv * (1.f / KVR) + EPS);
                const float* gp = F.lane < 48 ? gq + F.lane * 8 : gkv + (F.lane - 48) * 8;
                const f32x4 g0 = *(const GAS f32x4*)gp, g1 = *(const GAS f32x4*)(gp + 4);
                v4u o; o.x = pk2(v[0] * rstd * g0.x, v[1] * rstd * g0.y); o.y = pk2(v[2] * rstd * g0.z, v[3] * rstd * g0.w);
                o.z = pk2(v[4] * rstd * g1.x, v[5] * rstd * g1.y); o.w = pk2(v[6] * rstd * g1.z, v[7] * rstd * g1.w);
                *(GAS v4u*)(AQKV + (size_t)m * AQ + F.lane * 8) = o;
                const int c = F.lane & 7;
                const v4u kw = *(const GAS v4u*)(PROJ + (size_t)m * DINP + 512 + c * 8);
                float kv[8] = {bflo(kw.x), bfhi(kw.x), bflo(kw.y), bfhi(kw.y), bflo(kw.z), bfhi(kw.z), bflo(kw.w), bfhi(kw.w)};
                float ko[8];
                const float* cs = ROPECS + (size_t)m * 64 + (c & 3) * 8;
#pragma unroll
                for (int j = 0; j < 8; ++j) { const float other = __shfl_xor(kv[j], 4); const float co = cs[j], si = cs[32 + j];
                    ko[j] = (c < 4) ? (kv[j] * co - other * si) : (other * si + kv[j] * co); }
                if (F.lane < 8) { v4u ow; ow.x = pk2(ko[0], ko[1]); ow.y = pk2(ko[2], ko[3]); ow.z = pk2(ko[4], ko[5]); ow.w = pk2(ko[6], ko[7]); *(GAS v4u*)(KROPE + (size_t)m * 64 + c * 8) = ow; }
            }
            if (BOTH(pb + 1)) GRID_BAR();
        }
        if (PEN(3) && IN(pb + 2)) { PHASE_BEGIN();
            pg8::Gemm g{AQKV, WUP + (size_t)l * NUP * AQ, 2 * AQ, 2 * AQ, AQ / 64}; pg8::StaticOrder So; So.init(S, NUP, F.G, (int)blockIdx.x);
            pg8::EpiBf16 E{QKVM, NUP, 1.f};
            pg8::gemm_phase<pg8::EpiBf16, pg8::StaticOrder, true, SP2V>(F.lds, g, So, E);
            if (FILLMASK & 2) FILL(pb + 2);
            if (BOTH(pb + 2)) GRID_BAR();
        }
        if (PEN(4) && IN(pb + 3)) { PHASE_BEGIN();
            LAS float* BIAS = (LAS float*)(F.lds + BIAS_OFF);
            for (int i = F.tid; i < 3 * 6 * 129; i += NWAVES * 64) { const int b = i / (6 * 129), rem = i % (6 * 129), h = rem / 129, j = rem % 129;
                BIAS[(b * 6 + h) * 132 + j] = args.in[3][DIL_BUCKET[b][j] * 6 + h] * att::LOG2E; }
            __syncthreads();
            for (int rep = 0; rep < (REPEAT_PHASE == 4 ? 2 : 1); ++rep) {
            gu32* qhead = F.ctl + CW_QUEUE + 64 * l + 32 * rep + 4 * args.li;
            constexpr int NU_MLA = 6 * 32, NU_MEM = 4 * 32, NU_DIL = 3 * 6 * 32, NU = NU_MLA + NU_MEM + NU_DIL;
#define QPULL(u) do { if (F.tid == 0) F.MISC[16] = __hip_atomic_fetch_add(qhead, 1u, RLX_AGENT); __syncthreads(); u = (int)F.MISC[16]; __syncthreads(); } while (0)
            int u; QPULL(u);
            if ((ATT_EN & 1) && (!args.rep || (PROBE_ATT & 1))) while (u < NU_MLA) {
                const int h = u >> 5, qb = u & 31;
                att::MLA_BODY<NUP, NUP, D>(QKVM + (size_t)qb * 256 * NUP + h * 192, QKVM + UC_KV + h * 256, KROPE, QKVM + UC_KV + h * 256 + 128,
                                                        ROPECS + (size_t)qb * 256 * 64, YPRE + (size_t)qb * 256 * D + h * 128, S, 0.07216878364870322f, (LAS char*)F.lds);
                QPULL(u);
            }
            if (args.rep && !(PROBE_ATT & 1)) { while (u < NU_MLA) QPULL(u); }
            if ((ATT_EN & 2) && (!args.rep || (PROBE_ATT & 2))) while (u < NU_MLA + NU_MEM) {
                const int v = u - NU_MLA, h = v >> 5, qb = v & 31;
                const bf16* kv = MEMKV + (size_t)l * NMEM * 1024;
                att::attn_dense_body<128, DINP, 1024, D, 1>(PROJ + (size_t)qb * 256 * DINP + PC_MEM + h * 128, kv + h * 128, nullptr, kv + 512 + h * 128,
                                                            nullptr, YPRE + (size_t)qb * 256 * D + 1536 + h * 128, NMEM, 0.08838834764831845f, (LAS char*)F.lds);
                QPULL(u);
            }
            if (args.rep && !(PROBE_ATT & 2)) { while (u < NU_MLA + NU_MEM) QPULL(u); }
            if ((ATT_EN & 4) && (!args.rep || (PROBE_ATT & 4))) while (u < NU) {
                const int w = (u - NU_MLA - NU_MEM) * 8;
                const int b = w / 1536, h = (w % 1536) >> 8, tile = w & 255;
                const int d = b == 0 ? 1 : (b == 1 ? 4 : 16), nT = S / d, tpr = nT / 32;
                const int r = tile / tpr, t0 = (tile % tpr) * 32;
                LAS float* TB = (LAS float*)(F.lds + BIAS_OFF + 3 * 6 * 132 * 4);
                for (int i = F.tid; i < 4 * 196; i += NWAVES * 64) { const int k = i / 196, j = (i % 196) + k - 32; TB[i] = (j >= 0 && j <= 128) ? BIAS[(b * 6 + h) * 132 + j] : -1e30f; }
                __syncthreads();
                att::dil_wg_unit<DINP>(PROJ, PC_DIL + h * 128, PC_DIL + 768 + h * 128, PC_DIL + 1536 + h * 128, d, r, t0, nT,
                                       DILO + (size_t)b * S * 768, h * 128, DILS + (size_t)b * S * 12 + h * 2, (LAS char*)F.lds, TB, 0.08838834764831845f * att::LOG2E);
                QPULL(u);
            }
#undef QPULL
            }
            if (FILLMASK & 4) FILL(pb + 3);
            if (BOTH(pb + 3)) GRID_BAR();
        }
        if (PEN(5) && IN(pb + 4)) { PHASE_BEGIN();
            const float* gn = args.in[12] + (size_t)l * D;
            for (int m = F.gw; m < S; m += F.NGW) {
                const att::OT* yr = YPRE + (size_t)m * D;
                f32x4 a[3]; float sa = 0.f;
#pragma unroll
                for (int j = 0; j < 3; ++j) { a[j] = ld_o4(yr + (F.lane + 64 * j) * 4); sa += (a[j].x * a[j].x + a[j].y * a[j].y) + (a[j].z * a[j].z + a[j].w * a[j].w); }
                f32x4 c[2]; float sc = 0.f;
#pragma unroll
                for (int j = 0; j < 2; ++j) { c[j] = ld_o4(yr + 1536 + (F.lane + 64 * j) * 4); sc += (c[j].x * c[j].x + c[j].y * c[j].y) + (c[j].z * c[j].z + c[j].w * c[j].w); }
                f32x4 bq[3]; float sb = 0.f;
#pragma unroll
                for (int j = 0; j < 3; ++j) { const int col = (F.lane + 64 * j) * 4, h = col >> 7;
                    float mm[3], zz[3];
#pragma unroll
                    for (int b = 0; b < 3; ++b) { const f32x2 st = *(const GAS f32x2*)(DILS + ((size_t)b * S + m) * 12 + h * 2); mm[b] = st.x; zz[b] = st.y; }
                    const float M = fmaxf(mm[0], fmaxf(mm[1], mm[2]));
                    float wgt[3], den = 0.f;
#pragma unroll
                    for (int b = 0; b < 3; ++b) { wgt[b] = __builtin_amdgcn_exp2f(mm[b] - M); den += wgt[b] * zz[b]; }
                    const float inv = 1.f / den; f32x4 acc = {0.f, 0.f, 0.f, 0.f};
#pragma unroll
                    for (int b = 0; b < 3; ++b) { const f32x4 ob = ld_o4(DILO + ((size_t)b * S + m) * 768 + col); acc += ob * (wgt[b] * inv); }
                    bq[j] = acc; sb += (acc.x * acc.x + acc.y * acc.y) + (acc.z * acc.z + acc.w * acc.w); }
                const float ra = 1.f / sqrtf(wave_sum(sa) * (1.f / 768.f) + EPS), rb = 1.f / sqrtf(wave_sum(sb) * (1.f / 768.f) + EPS), rc = 1.f / sqrtf(wave_sum(sc) * (1.f / 512.f) + EPS);
                bf16* yo = Y + (size_t)m * D;
#pragma unroll
                for (int j = 0; j < 3; ++j) { const int col = (F.lane + 64 * j) * 4; const f32x4 g = *(const GAS f32x4*)(gn + col);
                    v2u w; w.x = pk2(a[j].x * ra * g.x, a[j].y * ra * g.y); w.y = pk2(a[j].z * ra * g.z, a[j].w * ra * g.w); *(GAS v2u*)(yo + col) = w; }
#pragma unroll
                for (int j = 0; j < 3; ++j) { const int col = (F.lane + 64 * j) * 4; const f32x4 g = *(const GAS f32x4*)(gn + 768 + col);
                    v2u w; w.x = pk2(bq[j].x * rb * g.x, bq[j].y * rb * g.y); w.y = pk2(bq[j].z * rb * g.z, bq[j].w * rb * g.w); *(GAS v2u*)(yo + 768 + col) = w; }
#pragma unroll
                for (int j = 0; j < 2; ++j) { const int col = (F.lane + 64 * j) * 4; const f32x4 g = *(const GAS f32x4*)(gn + 1536 + col);
                    v2u w; w.x = pk2(c[j].x * rc * g.x, c[j].y * rc * g.y); w.y = pk2(c[j].z * rc * g.z, c[j].w * rc * g.w); *(GAS v2u*)(yo + 1536 + col) = w; }
            }
            if (BOTH(pb + 4)) GRID_BAR();
        }
        if (PEN(6) && IN(pb + 5)) { PHASE_BEGIN();
            pg8::Gemm g{Y, WOUT + (size_t)l * D * D, 2 * D, 2 * D, D / 64}; pg8::StaticOrder So; So.init(S, D, F.G, (int)blockIdx.x);
            pg8::EpiResF32 E{l == 0 ? x_in : XA, args.rep ? YPREF : XA, D, 1.f};
            pg8::gemm_phase<pg8::EpiResF32, pg8::StaticOrder, true, SP2V>(F.lds, g, So, E);
            if (BOTH(pb + 5)) GRID_BAR();
        }
        if (PEN(7) && IN(pb + 6)) { PHASE_BEGIN();
            const float* gf = args.in[14] + (size_t)l * D;
#if defined(PROBE_DEADLINE)
            if (l == 1 && blockIdx.x == 0 && F.tid == 0) F.ctl[CW_CVT + 16] = __hip_atomic_load(F.ctl + CW_CVT, RLX_AGENT);
#endif
            if (l == 0) { for (int m = F.gw; m < S; m += F.NGW) { if constexpr (F8D) rms_row_to_fp8(XA + (size_t)m * D, gf, XN8 + (size_t)m * D, F.lane); else rms_row_to_bf16(XA + (size_t)m * D, gf, XN + (size_t)m * D, F.lane); } }
            else {
                const float* Wr = args.in[18];
                for (int m = F.gw; m < S; m += F.NGW) {
                    const GAS f32x4* xr = (const GAS f32x4*)(XA + (size_t)m * D) + F.lane; const GAS f32x4* gr = (const GAS f32x4*)gf + F.lane;
                    f32x4 v[8]; float s = 0.f;
#pragma unroll
                    for (int j = 0; j < 8; ++j) { v[j] = xr[64 * j]; s += (v[j].x * v[j].x + v[j].y * v[j].y) + (v[j].z * v[j].z + v[j].w * v[j].w); }
                    const float rstd = 1.f / sqrtf(wave_sum(s) * (1.f / D) + EPS);
                    float lg[8] = {0.f, 0.f, 0.f, 0.f, 0.f, 0.f, 0.f, 0.f};
                    GAS v2u* o8 = (GAS v2u*)(XN + (size_t)m * D) + F.lane; GAS unsigned* o4 = (GAS unsigned*)(XN8 + (size_t)m * D) + F.lane;
#pragma unroll
                    for (int j = 0; j < 8; ++j) { const f32x4 gg = gr[64 * j]; const f32x4 hh = {v[j].x * rstd * gg.x, v[j].y * rstd * gg.y, v[j].z * rstd * gg.z, v[j].w * rstd * gg.w};
                        if constexpr (F8M) o4[64 * j] = pk4_fp8(hh.x, hh.y, hh.z, hh.w); else { v2u w; w.x = pk2(hh.x, hh.y); w.y = pk2(hh.z, hh.w); o8[64 * j] = w; }
                        const float* wr = Wr + (size_t)((F.lane + 64 * j) * 4) * NE;
#pragma unroll
                        for (int q = 0; q < 4; ++q) { const f32x4 w0 = *(const GAS f32x4*)(wr + q * NE), w1 = *(const GAS f32x4*)(wr + q * NE + 4); const float hv = hh[q];
                            lg[0] += hv * w0.x; lg[1] += hv * w0.y; lg[2] += hv * w0.z; lg[3] += hv * w0.w; lg[4] += hv * w1.x; lg[5] += hv * w1.y; lg[6] += hv * w1.z; lg[7] += hv * w1.w; } }
#pragma unroll
                    for (int e = 0; e < NE; ++e) lg[e] = wave_sum(lg[e]);
                    int e1 = 0; float v1 = lg[0];
#pragma unroll
                    for (int e = 1; e < NE; ++e) if (lg[e] > v1) { v1 = lg[e]; e1 = e; }
                    int e2 = -1; float v2 = -3.0e38f;
#pragma unroll
                    for (int e = 0; e < NE; ++e) if (e != e1 && lg[e] > v2) { v2 = lg[e]; e2 = e; }
                    const float g1 = 1.f / (1.f + __expf(v2 - v1)), g2 = 1.f - g1;
                    if (F.lane == 0) { const unsigned s1 = __hip_atomic_fetch_add(F.ctl + CW_CNT + e1, 1u, RLX_AGENT), s2 = __hip_atomic_fetch_add(F.ctl + CW_CNT + e2, 1u, RLX_AGENT);
                        v4u r0 = {(unsigned)e1, (unsigned)e2, s1, s2}; v4u r1 = {__float_as_uint(g1), __float_as_uint(g2), 0u, 0u};
                        *(GAS v4u*)(ROUTE + (size_t)m * 8) = r0; *(GAS v4u*)(ROUTE + (size_t)m * 8 + 4) = r1; }
                }
            }
            if (BOTH(pb + 6)) GRID_BAR();
        }
        if (PEN(8) && IN(pb + 7)) { PHASE_BEGIN();
            if (l == 1) {
                moe_cvt_fill(F, ka, -1);
#if defined(PROBE_DEADLINE)
                for (int r_ = 0; r_ < PROBE_DEADLINE; ++r_) { __syncthreads(); moe_cvt_fill(F, ka, -2); }
#endif
                int base[NE]; int tstart = 0;
#pragma unroll
                for (int e = 0; e < NE; ++e) { const int c = (int)__hip_atomic_load(F.ctl + CW_CNT + e, RLX_AGENT); base[e] = tstart * 256; const int nt = (c + 255) >> 8;
                    if (blockIdx.x == 0 && F.tid == 0) { for (int t = 0; t < nt; ++t) F.ctl[CW_TILEE + 1 + tstart + t] = (unsigned)e; }
                    tstart += nt; }
                if (blockIdx.x == 0 && F.tid == 0) F.ctl[CW_TILEE] = (unsigned)tstart;
                for (int m = F.gw; m < S; m += F.NGW) {
                    const v4u r0 = *(const GAS v4u*)(ROUTE + (size_t)m * 8);
                    int p1 = (int)r0.z, p2 = (int)r0.w;
#pragma unroll
                    for (int e = 0; e < NE; ++e) { if ((int)r0.x == e) p1 += base[e]; if ((int)r0.y == e) p2 += base[e]; }
                    if (F.lane == 0) { ROUTE[(size_t)m * 8 + 6] = (unsigned)p1; ROUTE[(size_t)m * 8 + 7] = (unsigned)p2; }
                    const unsigned char* srow = (const unsigned char*)XN8 + (size_t)m * D * EBM; unsigned char* xp = (unsigned char*)XP;
                    const GAS v4u* src = (const GAS v4u*)srow + F.lane; GAS v4u* d1 = (GAS v4u*)(xp + (size_t)p1 * D * EBM) + F.lane; GAS v4u* d2 = (GAS v4u*)(xp + (size_t)p2 * D * EBM) + F.lane;
#pragma unroll
                    for (int j = 0; j < 2 * EBM; ++j) { const v4u t = src[64 * j]; d1[64 * j] = t; d2[64 * j] = t; }
                }
            }
            if (BOTH(pb + 7) && l == 1) GRID_BAR();
        }
        if (PEN(9) && IN(pb + 8)) { PHASE_BEGIN();
            if (l == 0) { pg8::Gemm g{XN8, WGU, D * EBD, D * EBD, D * EBD / 128}; pg8::StaticOrder So; So.init(S, 2 * DFF, F.G, (int)blockIdx.x);
                FfnEpi1<F8D> E = Epi1Maker<F8D>::make(ACT, DFF);
                pg8::gemm_phase<FfnEpi1<F8D>, pg8::StaticOrder, true, SP2V, F8D>(F.lds, g, So, E); }
            else { const int ntile = (int)__hip_atomic_load(F.ctl + CW_TILEE, RLX_AGENT);
                pg8::Gemm g{XP, MGU, D * EBM, D * EBM, D * EBM / 128}; pg8::MoeOrder So{F.G, (int)blockIdx.x, 2 * DFE / 256, ntile, 2 * DFE, (const int*)(F.ctl + CW_TILEE + 1)};
                FfnEpi1<F8M> E = Epi1Maker<F8M>::make(ACTP, DFE);
                pg8::gemm_phase<FfnEpi1<F8M>, pg8::MoeOrder, true, SP2V, F8M>(F.lds, g, So, E); }
            if (BOTH(pb + 8)) GRID_BAR();
        }
        if (PEN(10) && IN(pb + 9)) { PHASE_BEGIN();
            if (l == 0) { pg8::Gemm g{ACT, WDN, DFF * EBD, DFF * EBD, DFF * EBD / 128}; pg8::StaticOrder So; So.init(S, D, F.G, (int)blockIdx.x);
                pg8::EpiResF32 E{XA, args.rep ? YPREF : XA, D, Sc<F8D>::dn};
                pg8::gemm_phase<pg8::EpiResF32, pg8::StaticOrder, true, SP2V, F8D>(F.lds, g, So, E); }
            else { const int ntile = (int)__hip_atomic_load(F.ctl + CW_TILEE, RLX_AGENT);
                const int pm0 = MOE_TAIL ? ((2 * F.G / 8) < ntile ? (2 * F.G / 8) : ntile) : ntile;
                { pg8::Gemm g{ACTP, MDN, DFE * EBM, DFE * EBM, DFE * EBM / 128}; pg8::MoeOrder So{F.G, (int)blockIdx.x, D / 256, pm0, D, (const int*)(F.ctl + CW_TILEE + 1)};
                  pg8::EpiBf16 E{OUTP, D, Sc<F8M>::dn};
                  pg8::gemm_phase<pg8::EpiBf16, pg8::MoeOrder, true, SP2V, F8M>(F.lds, g, So, E); }
                if (MOE_TAIL && ntile > pm0) { pg8::Gemm g{ACTP, MDN, DFE * EBM, DFE * EBM, DFE * EBM / 512}; pg8::MoeTailOrder So{F.G, (int)blockIdx.x, pm0, ntile - pm0, D, DFE * EBM / 4, (const int*)(F.ctl + CW_TILEE + 1)};
                  pg8::EpiBf16Split E{OUTQ, D, Sc<F8M>::dn, pm0, (size_t)2048 * D};
                  pg8::gemm_phase<pg8::EpiBf16Split, pg8::MoeTailOrder, true, SP2V, F8M>(F.lds, g, So, E); } }
            if (BOTH(pb + 9)) GRID_BAR();
        }
        if (PEN(11) && IN(pb + 10)) { PHASE_BEGIN();
            if (l == 0) { for (int m = F.gw; m < S; m += F.NGW) rms_row_to_bf16(XA + (size_t)m * D, args.in[4] + D, XN + (size_t)m * D, F.lane); }
            else {
                const float* gfin = args.in[22];
                const int ntile_f = (int)__hip_atomic_load(F.ctl + CW_TILEE, RLX_AGENT); const int prow0 = (MOE_TAIL ? ((2 * F.G / 8) < ntile_f ? (2 * F.G / 8) : ntile_f) : ntile_f) * 256;
                for (int m = F.gw; m < S; m += F.NGW) {
                    const v4u r1 = *(const GAS v4u*)(ROUTE + (size_t)m * 8 + 4);
                    const float g1 = __uint_as_float(r1.x), g2 = __uint_as_float(r1.y); const int p1 = (int)r1.z, p2 = (int)r1.w;
                    const GAS f32x4* xr = (const GAS f32x4*)(XA + (size_t)m * D) + F.lane;
                    const GAS v2u* o1 = (const GAS v2u*)(OUTP + (size_t)p1 * D) + F.lane; const GAS v2u* o2 = (const GAS v2u*)(OUTP + (size_t)p2 * D) + F.lane;
                    const bool t1 = p1 >= prow0, t2 = p2 >= prow0;
                    const GAS v2u* q1 = (const GAS v2u*)(OUTQ + (size_t)(t1 ? p1 - prow0 : 0) * D) + F.lane; const GAS v2u* q2 = (const GAS v2u*)(OUTQ + (size_t)(t2 ? p2 - prow0 : 0) * D) + F.lane;
                    f32x4 v[8]; float s = 0.f;
#pragma unroll
                    for (int j = 0; j < 8; ++j) { const f32x4 xv = xr[64 * j]; f32x4 ea, eb;
                        if (!t1) { const v2u a = o1[64 * j]; ea = (f32x4){bflo(a.x), bfhi(a.x), bflo(a.y), bfhi(a.y)}; }
                        else { ea = (f32x4){0.f, 0.f, 0.f, 0.f};
#pragma unroll
                            for (int k = 0; k < 4; ++k) { const v2u a = q1[(size_t)k * (2048 * D / 4) + 64 * j]; ea += (f32x4){bflo(a.x), bfhi(a.x), bflo(a.y), bfhi(a.y)}; } }
                        if (!t2) { const v2u b = o2[64 * j]; eb = (f32x4){bflo(b.x), bfhi(b.x), bflo(b.y), bfhi(b.y)}; }
                        else { eb = (f32x4){0.f, 0.f, 0.f, 0.f};
#pragma unroll
                            for (int k = 0; k < 4; ++k) { const v2u b = q2[(size_t)k * (2048 * D / 4) + 64 * j]; eb += (f32x4){bflo(b.x), bfhi(b.x), bflo(b.y), bfhi(b.y)}; } }
                        v[j] = xv + ea * g1 + eb * g2;
                        s += (v[j].x * v[j].x + v[j].y * v[j].y) + (v[j].z * v[j].z + v[j].w * v[j].w); }
                    const float rstd = 1.f / sqrtf(wave_sum(s) * (1.f / D) + EPS);
                    GAS f32x4* orow = (GAS f32x4*)(args.out + (size_t)m * D) + F.lane; const GAS f32x4* gr = (const GAS f32x4*)gfin + F.lane;
#pragma unroll
                    for (int j = 0; j < 8; ++j) { const f32x4 gg = gr[64 * j]; orow[64 * j] = (f32x4){v[j].x * rstd * gg.x, v[j].y * rstd * gg.y, v[j].z * rstd * gg.z, v[j].w * rstd * gg.w}; }
                }
            }
            if (BOTH(pb + 10) && l == 0) GRID_BAR();
        }
    }
#undef IN
#undef BOTH
#undef GRID_BAR
#undef WIN
#undef WUP
#undef WMEM
#undef WOUT
#undef WGU
#undef WDN
#undef MGU
#undef MDN
#undef XN
#undef MEMN
#undef MEMKV
#undef PROJ
#undef AQKV
#undef KROPE
#undef ROPECS
#undef QKVM
#undef YPRE
#undef YPREF
#undef DILO
#undef DILS
#undef Y
#undef XA
#undef ROUTE
#undef XP
#undef OUTP
#undef OUTQ
#undef ACTP
#undef ACT
#undef x_in
#undef XN8
#undef PHASE_BEGIN
#undef args
#undef FILL
}

extern "C" void kernel_launch(void* const* d_in, const int* in_sizes, int n_in, void* d_out, int out_size, void* d_ws, size_t ws_size, hipStream_t stream) {
    static int grid = 0;
    if (grid == 0) {
        if (n_in != 23 || in_sizes[0] != S * D || out_size != S * D || ws_size < WS_END) { fprintf(stderr, "kernel_launch: shape/workspace mismatch: n_in %d in0 %d out %d ws %zu (need %zu)\n", n_in, n_in > 0 ? in_sizes[0] : -1, out_size, ws_size, (size_t)WS_END); grid = -1; return; }
        int dev = 0, cus = 0, per_cu = 0;
        if (hipGetDevice(&dev) != hipSuccess || hipDeviceGetAttribute(&cus, hipDeviceAttributeMultiprocessorCount, dev) != hipSuccess) { fprintf(stderr, "kernel_launch: device query failed\n"); grid = -1; return; }
        if (hipFuncSetAttribute((const void*)mk_fwd, hipFuncAttributeMaxDynamicSharedMemorySize, LDS_BYTES) != hipSuccess) { fprintf(stderr, "kernel_launch: hipFuncSetAttribute failed\n"); grid = -1; return; }
        if (hipOccupancyMaxActiveBlocksPerMultiprocessor(&per_cu, (const void*)mk_fwd, NWAVES * 64, LDS_BYTES) != hipSuccess || per_cu < 1) { fprintf(stderr, "kernel_launch: occupancy query reports %d workgroups per CU\n", per_cu); }
        (void)hipGetLastError();
        grid = cus;
    }
    if (grid < 0) return;
    (void)hipMemsetAsync((char*)d_ws + WS_CTL, 0, CTL_ZERO_BYTES, stream);
    Args a{};
    for (int i = 0; i < 23; ++i) a.in[i] = (const float*)d_in[i];
    a.out = (float*)d_out; a.ws = (unsigned char*)d_ws;
    for (int i = 0; i < 32; ++i) a.invf[i] = 1.0f / powf(10000.0f, (float)i / 32.0f);
    int lo[8], hi[8], rp[8], nl = 0;
#if defined(PROBE_PHASE) && PROBE_PHASE >= 0
    lo[nl] = 0; hi[nl] = PROBE_PHASE + 1; rp[nl++] = 0;
    for (int r = 0; r < PROBE_REPS; ++r) { lo[nl] = PROBE_PHASE; hi[nl] = PROBE_PHASE + 1; rp[nl++] = 1; }
    if (PROBE_PHASE + 1 < N_PHASES) { lo[nl] = PROBE_PHASE + 1; hi[nl] = N_PHASES; rp[nl++] = 0; }
#else
    if (N_LAUNCHES == N_PHASES) { nl = 0; } else { lo[0] = 0; hi[0] = N_PHASES; rp[0] = 0; nl = 1; }
#endif
    const int total = (N_LAUNCHES == N_PHASES) ? N_PHASES : nl;
    for (int li = 0; li < total; ++li) {
        if (N_LAUNCHES == N_PHASES) { a.ph_lo = li; a.ph_hi = li + 1; a.li = 0; a.rep = 0; } else { a.ph_lo = lo[li]; a.ph_hi = hi[li]; a.li = li; a.rep = rp[li]; }
        hipLaunchKernelGGL(mk_fwd, dim3(grid), dim3(NWAVES * 64), LDS_BYTES, stream, a);
        const hipError_t le = hipPeekAtLastError();
        if (le != hipSuccess) { fprintf(stderr, "kernel_launch: launch %d failed: %s\n", li, hipGetErrorName(le)); break; }
    }
}
```

```cpp
#include <hip/hip_runtime.h>
#include <cstdio>
#include <cstdint>
#include <cmath>
#include <type_traits>
#ifndef MK_N_LAUNCHES
#define MK_N_LAUNCHES 1
#endif
#define REPEAT_PHASE -1
#define FFN_FP8 3
#define PROBE_PHASE -1
#define PROBE_REPS 3
#define FILLMASK 7
#define MLA_DMA 0
#define PROBE_ATT 7
#define GEMM_SP2 1
#define XA_BF16 1
#define ATT_OBF16 1
#define MOE_TAIL 1
#define CVT_REG 0
#define CVT_BYTE_T 1
#define CVT_FIRST 1
#define CVT_Q0 8
namespace pg8 {
#define PG8_LAS __attribute__((address_space(3)))
typedef unsigned short bf16_t;
typedef short bf16x8 __attribute__((ext_vector_type(8)));
typedef float f32x4 __attribute__((ext_vector_type(4)));
typedef unsigned u32x4 __attribute__((ext_vector_type(4)));
constexpr int BM = 256, BK = 64, HALF = 128, HTB = HALF * BK * 2  , STAGE_BYTES = 8 * HTB, NXCD = 8, WGM = 8;

__host__ __device__ __forceinline__ int lds_byte(int r, int c) { const int st = (r >> 4) * 2 + (c >> 5), rr = r & 15, cc = c & 31, ob = rr * 64 + cc * 2; return st * 1024 + (ob ^ (((ob >> 9) & 1) << 5)); }
__host__ __device__ __forceinline__ void stage_rc(int b, int& R, int& C) { const int st = b / 1024, sb = b % 1024, swz = sb ^ (((sb >> 9) & 1) << 5); R = (st >> 1) * 16 + swz / 64; C = (st & 1) * 32 + (swz % 64) / 2; }
__host__ __device__ __forceinline__ int perm32(int rho) { const int n = rho >> 4, i = rho & 15; return 8 * (i >> 2) + 4 * n + (i & 3); }

struct Unit { int pm, pn; };
struct Gemm { const void* A; const void* Bt; int lda, ldb, nt; };

struct StaticOrder {
    int nM, nN, nwg, G, c;
    __device__ void init(int M, int N, int G_, int c_) { nM = M / BM; nN = N / BM; nwg = nM * nN; G = G_; c = c_; }
    __device__ bool next(int i, Unit& u) const {
        const long L = (long)i * G + c; if (L >= nwg) return false;
        int wgid = (int)L; { const int q = nwg / NXCD, r = nwg % NXCD, xcd = wgid % NXCD, off = wgid / NXCD; wgid = (xcd < r ? xcd * (q + 1) : r * (q + 1) + (xcd - r) * q) + off; }
        const int nig = WGM * nN, gid = wgid / nig, fm = gid * WGM, gsz = (nM - fm) < WGM ? (nM - fm) : WGM;
        u.pm = fm + ((wgid % nig) % gsz); u.pn = (wgid % nig) / gsz; return true;
    }
    __device__ __forceinline__ const char* abase(const Gemm& g, const Unit& u) const { return (const char*)g.A + (size_t)u.pm * BM * g.lda; }
    __device__ __forceinline__ const char* bbase(const Gemm& g, const Unit& u) const { return (const char*)g.Bt + (size_t)u.pn * BM * g.ldb; }
};
struct InProjOrder {
    StaticOrder so; int nextra; const void* A2; const void* B2;
    __device__ bool next(int i, Unit& u) const { if (so.next(i, u)) return true; const long L = (long)i * so.G + so.c - so.nwg; if (L < 0 || L >= nextra) return false; u.pm = 32 + (int)(L >> 2); u.pn = (int)(L & 3); return true; }
    __device__ __forceinline__ const char* abase(const Gemm& g, const Unit& u) const { return u.pm < 32 ? (const char*)g.A + (size_t)u.pm * BM * g.lda : (const char*)A2 + (size_t)(u.pm - 32) * BM * g.lda; }
    __device__ __forceinline__ const char* bbase(const Gemm& g, const Unit& u) const { return u.pm < 32 ? (const char*)g.Bt + (size_t)u.pn * BM * g.ldb : (const char*)B2 + (size_t)((u.pm - 32) * 1024 + u.pn * BM) * g.ldb; }
};
struct MemOrder {
    int G, c;
    __device__ bool next(int i, Unit& u) const { const int L = c - (G - 8); if (i != 0 || L < 0 || L >= 8) return false; u.pm = L >> 2; u.pn = L & 3; return true; }
    __device__ __forceinline__ const char* abase(const Gemm& g, const Unit& u) const { return (const char*)g.A + (size_t)u.pm * BM * g.lda; }
    __device__ __forceinline__ const char* bbase(const Gemm& g, const Unit& u) const { return (const char*)g.Bt + (size_t)(u.pm * 1024 + u.pn * BM) * g.ldb; }
};
struct MoeOrder {
    int G, c, nN, ntile, nexp_rows; const int* tile_e;
    __device__ bool next(int i, Unit& u) const { const long L = (long)i * G + c; if (L >= (long)ntile * nN) return false; u.pm = (int)(L / nN); u.pn = (int)(L % nN); return true; }
    __device__ __forceinline__ const char* abase(const Gemm& g, const Unit& u) const { return (const char*)g.A + (size_t)u.pm * BM * g.lda; }
    __device__ __forceinline__ const char* bbase(const Gemm& g, const Unit& u) const { const int e = __builtin_amdgcn_readfirstlane(tile_e[u.pm]); return (const char*)g.Bt + ((size_t)e * nexp_rows + (size_t)u.pn * BM) * g.ldb; }
};

struct MoeTailOrder {
    int G, c, pm0, ntail, nexp_rows, kq_bytes; const int* tile_e;
    __device__ bool next(int i, Unit& u) const { const long L = (long)i * G + c; if (L >= (long)ntail * 32) return false; const int ks = (int)(L & 3), rest = (int)(L >> 2); u.pm = pm0 + (rest >> 3); u.pn = (rest & 7) + 8 * ks; return true; }
    __device__ __forceinline__ const char* abase(const Gemm& g, const Unit& u) const { return (const char*)g.A + (size_t)u.pm * BM * g.lda + (size_t)(u.pn >> 3) * kq_bytes; }
    __device__ __forceinline__ const char* bbase(const Gemm& g, const Unit& u) const { const int e = __builtin_amdgcn_readfirstlane(tile_e[u.pm]); return (const char*)g.Bt + ((size_t)e * nexp_rows + (size_t)(u.pn & 7) * BM) * g.ldb + (size_t)(u.pn >> 3) * kq_bytes; }
};

__device__ __forceinline__ unsigned cvt_pk_bf16(float lo, float hi) { unsigned r; asm volatile("v_cvt_pk_bf16_f32 %0, %1, %2" : "=v"(r) : "v"(lo), "v"(hi)); return r; }

struct EpiBf16 {
    static constexpr bool PERM = true;
    bf16_t* O; int ldc; float sc;
    __device__ __forceinline__ void operator()(const f32x4 (&acc)[2][2][4][2], const Unit& u, int wr, int wc, int fr, int fq) const {
        const int row0 = u.pm * BM + wr * 64 + fr, col0 = u.pn * BM + wc * 32 + 8 * fq;
#pragma unroll
        for (int ai = 0; ai < 2; ++ai)
#pragma unroll
            for (int m = 0; m < 4; ++m) { bf16_t* rowp = O + (size_t)(row0 + ai * HALF + m * 16) * ldc + col0;
#pragma unroll
                for (int bj = 0; bj < 2; ++bj) { const f32x4 v0 = acc[ai][bj][m][0] * sc, v1 = acc[ai][bj][m][1] * sc;
                    u32x4 w; w.x = cvt_pk_bf16(v0[0], v0[1]); w.y = cvt_pk_bf16(v0[2], v0[3]); w.z = cvt_pk_bf16(v1[0], v1[1]); w.w = cvt_pk_bf16(v1[2], v1[3]);
                    *(u32x4*)(rowp + bj * HALF) = w; } }
    }
};
struct EpiBf16Split {
    static constexpr bool PERM = true;
    bf16_t* O; int ldc; float sc; int pm0; size_t qstride;
    __device__ __forceinline__ void operator()(const f32x4 (&acc)[2][2][4][2], const Unit& u, int wr, int wc, int fr, int fq) const {
        const int row0 = (u.pm - pm0) * BM + wr * 64 + fr, col0 = (u.pn & 7) * BM + wc * 32 + 8 * fq; bf16_t* base = O + (size_t)(u.pn >> 3) * qstride;
#pragma unroll
        for (int ai = 0; ai < 2; ++ai)
#pragma unroll
            for (int m = 0; m < 4; ++m) { bf16_t* rowp = base + (size_t)(row0 + ai * HALF + m * 16) * ldc + col0;
#pragma unroll
                for (int bj = 0; bj < 2; ++bj) { const f32x4 v0 = acc[ai][bj][m][0] * sc, v1 = acc[ai][bj][m][1] * sc;
                    u32x4 w; w.x = cvt_pk_bf16(v0[0], v0[1]); w.y = cvt_pk_bf16(v0[2], v0[3]); w.z = cvt_pk_bf16(v1[0], v1[1]); w.w = cvt_pk_bf16(v1[2], v1[3]);
                    *(u32x4*)(rowp + bj * HALF) = w; } }
    }
};
struct EpiBf16Sel {
    static constexpr bool PERM = true;
    bf16_t* O; int ldc; bf16_t* O2; int ldc2;
    __device__ __forceinline__ void operator()(const f32x4 (&acc)[2][2][4][2], const Unit& u, int wr, int wc, int fr, int fq) const {
        const bool ex = u.pm >= 32; bf16_t* base = ex ? O2 : O; const int ld = ex ? ldc2 : ldc;
        const int row0 = (ex ? u.pm - 32 : u.pm) * BM + wr * 64 + fr, col0 = u.pn * BM + wc * 32 + 8 * fq;
#pragma unroll
        for (int ai = 0; ai < 2; ++ai)
#pragma unroll
            for (int m = 0; m < 4; ++m) { bf16_t* rowp = base + (size_t)(row0 + ai * HALF + m * 16) * ld + col0;
#pragma unroll
                for (int bj = 0; bj < 2; ++bj) { const f32x4 v0 = acc[ai][bj][m][0], v1 = acc[ai][bj][m][1];
                    u32x4 w; w.x = cvt_pk_bf16(v0[0], v0[1]); w.y = cvt_pk_bf16(v0[2], v0[3]); w.z = cvt_pk_bf16(v1[0], v1[1]); w.w = cvt_pk_bf16(v1[2], v1[3]);
                    *(u32x4*)(rowp + bj * HALF) = w; } }
    }
};
struct EpiResF32 {
    static constexpr bool PERM = false;
    const float* R; float* C; int ldc; float sc;
    __device__ __forceinline__ void operator()(const f32x4 (&acc)[2][2][4][2], const Unit& u, int wr, int wc, int fr, int fq) const {
        const int row0 = u.pm * BM + wr * 64 + fr, col0 = u.pn * BM + wc * 32 + 4 * fq;
#pragma unroll
        for (int ai = 0; ai < 2; ++ai)
#pragma unroll
            for (int m = 0; m < 4; ++m) { const size_t off = (size_t)(row0 + ai * HALF + m * 16) * ldc + col0;
#pragma unroll
                for (int bj = 0; bj < 2; ++bj)
#pragma unroll
                    for (int n = 0; n < 2; ++n) { const f32x4 r = *(const f32x4*)(R + off + bj * HALF + n * 16); *(f32x4*)(C + off + bj * HALF + n * 16) = r + acc[ai][bj][m][n] * sc; } }
    }
};
struct EpiResB16 {
    static constexpr bool PERM = true;
    const void* R; bool r32; bf16_t* C; int ldc; float sc;
    __device__ __forceinline__ void operator()(const f32x4 (&acc)[2][2][4][2], const Unit& u, int wr, int wc, int fr, int fq) const {
        const int row0 = u.pm * BM + wr * 64 + fr, col0 = u.pn * BM + wc * 32 + 8 * fq;
#pragma unroll
        for (int ai = 0; ai < 2; ++ai)
#pragma unroll
            for (int m = 0; m < 4; ++m) { const size_t off = (size_t)(row0 + ai * HALF + m * 16) * ldc + col0;
#pragma unroll
                for (int bj = 0; bj < 2; ++bj) { f32x4 r0, r1;
                    if (r32) { r0 = *(const f32x4*)((const float*)R + off + bj * HALF); r1 = *(const f32x4*)((const float*)R + off + bj * HALF + 4); }
                    else { const u32x4 w = *(const u32x4*)((const bf16_t*)R + off + bj * HALF);
                        r0 = (f32x4){__uint_as_float(w.x << 16), __uint_as_float(w.x & 0xffff0000u), __uint_as_float(w.y << 16), __uint_as_float(w.y & 0xffff0000u)};
                        r1 = (f32x4){__uint_as_float(w.z << 16), __uint_as_float(w.z & 0xffff0000u), __uint_as_float(w.w << 16), __uint_as_float(w.w & 0xffff0000u)}; }
                    const f32x4 v0 = r0 + acc[ai][bj][m][0] * sc, v1 = r1 + acc[ai][bj][m][1] * sc;
                    u32x4 o; o.x = cvt_pk_bf16(v0[0], v0[1]); o.y = cvt_pk_bf16(v0[2], v0[3]); o.z = cvt_pk_bf16(v1[0], v1[1]); o.w = cvt_pk_bf16(v1[2], v1[3]);
                    *(u32x4*)(C + off + bj * HALF) = o; } }
    }
};
__device__ __forceinline__ float silu_mul(float g, float u) { return g * u * __builtin_amdgcn_rcpf(1.0f + __builtin_amdgcn_exp2f(-1.4426950408889634f * g)); }
struct EpiSwiGLU {
    static constexpr bool PERM = true;
    bf16_t* O; int ldc;
    __device__ __forceinline__ void operator()(const f32x4 (&acc)[2][2][4][2], const Unit& u, int wr, int wc, int fr, int fq) const {
        const int row0 = u.pm * BM + wr * 64 + fr, col0 = u.pn * HALF + wc * 32 + 8 * fq;
#pragma unroll
        for (int ai = 0; ai < 2; ++ai)
#pragma unroll
            for (int m = 0; m < 4; ++m) { bf16_t* rowp = O + (size_t)(row0 + ai * HALF + m * 16) * ldc + col0;
                const f32x4 g0 = acc[ai][0][m][0], g1 = acc[ai][0][m][1], u0 = acc[ai][1][m][0], u1 = acc[ai][1][m][1];
                u32x4 w; w.x = cvt_pk_bf16(silu_mul(g0[0], u0[0]), silu_mul(g0[1], u0[1])); w.y = cvt_pk_bf16(silu_mul(g0[2], u0[2]), silu_mul(g0[3], u0[3]));
                w.z = cvt_pk_bf16(silu_mul(g1[0], u1[0]), silu_mul(g1[1], u1[1])); w.w = cvt_pk_bf16(silu_mul(g1[2], u1[2]), silu_mul(g1[3], u1[3]));
                *(u32x4*)rowp = w; }
    }
};

typedef int v8i_t __attribute__((ext_vector_type(8)));
__device__ __forceinline__ v8i_t pg8_cat(bf16x8 lo, bf16x8 hi) { typedef int v4i_t __attribute__((ext_vector_type(4))); const v4i_t a = __builtin_bit_cast(v4i_t, lo), b = __builtin_bit_cast(v4i_t, hi); return (v8i_t){a.x, a.y, a.z, a.w, b.x, b.y, b.z, b.w}; }
struct EpiSwiGLU8 {
    static constexpr bool PERM = true;
    unsigned char* O; int ldc; float sc_in, sc_out;
    __device__ __forceinline__ void operator()(const f32x4 (&acc)[2][2][4][2], const Unit& u, int wr, int wc, int fr, int fq) const {
        const int row0 = u.pm * BM + wr * 64 + fr, col0 = u.pn * HALF + wc * 32 + 8 * fq;
#pragma unroll
        for (int ai = 0; ai < 2; ++ai)
#pragma unroll
            for (int m = 0; m < 4; ++m) { unsigned char* rowp = O + (size_t)(row0 + ai * HALF + m * 16) * ldc + col0;
                const f32x4 g0 = acc[ai][0][m][0] * sc_in, g1 = acc[ai][0][m][1] * sc_in, u0 = acc[ai][1][m][0] * (sc_in * sc_out), u1 = acc[ai][1][m][1] * (sc_in * sc_out);
                int w0 = 0, w1 = 0;
                w0 = __builtin_amdgcn_cvt_pk_fp8_f32(silu_mul(g0[0], u0[0]), silu_mul(g0[1], u0[1]), w0, false); w0 = __builtin_amdgcn_cvt_pk_fp8_f32(silu_mul(g0[2], u0[2]), silu_mul(g0[3], u0[3]), w0, true);
                w1 = __builtin_amdgcn_cvt_pk_fp8_f32(silu_mul(g1[0], u1[0]), silu_mul(g1[1], u1[1]), w1, false); w1 = __builtin_amdgcn_cvt_pk_fp8_f32(silu_mul(g1[2], u1[2]), silu_mul(g1[3], u1[3]), w1, true);
                typedef int v2i_t __attribute__((ext_vector_type(2))); *(v2i_t*)rowp = (v2i_t){w0, w1}; }
    }
};
__device__ __forceinline__ void pg8_mfma8(f32x4& c, v8i_t a, v8i_t b, int sc) { asm volatile("v_mfma_scale_f32_16x16x128_f8f6f4 %0, %1, %2, %0, %3, %3 op_sel_hi:[0,0,0]" : "+v"(c) : "v"(a), "v"(b), "v"(sc)); }
template <class Epi, class Sched, bool ALIGN_EPI = false, bool SP2 = false, bool FP8 = false>
__device__ __forceinline__ void gemm_phase(PG8_LAS unsigned char* lds, const Gemm g, const Sched& S, const Epi& E) {
    int tid_ = threadIdx.x; asm volatile("" : "+v"(tid_));
    const int tid = tid_, wid = __builtin_amdgcn_readfirstlane(tid >> 6), lane = tid & 63, wr = wid >> 2, wc = wid & 3, fr = lane & 15, fq = lane >> 4;
    const int nt = g.nt;
    unsigned voffA[2], voffB[2];
#pragma unroll
    for (int i = 0; i < 2; ++i) { int R, C; stage_rc(tid * 16 + i * 8192, R, C); const int Rb = Epi::PERM ? ((R & ~31) + perm32(R & 31)) : R;
        voffA[i] = (unsigned)(R * g.lda + C * 2); voffB[i] = (unsigned)(Rb * g.ldb + C * 2); }
    const size_t kstep = (size_t)(BK * 2);
    const size_t hstepA = (size_t)HALF * g.lda, hstepB = (size_t)HALF * g.ldb;
    const unsigned ldsw = (unsigned)wid * 1024u;
    const int aoff = lds_byte(wr * 64 + fr, fq * 8), boff = lds_byte(wc * 32 + fr, fq * 8);
#define PG8_SA(b, h) (((b) * 2 + (h)) * HTB)
#define PG8_SB(b, h) ((4 + (b) * 2 + (h)) * HTB)
#define PG8_STAGE(bufoff, gbase, voff) do { _Pragma("unroll") for (int _i = 0; _i < 2; ++_i) \
        __builtin_amdgcn_global_load_lds((const unsigned*)((const char*)(gbase) + (voff)[_i]), (PG8_LAS unsigned*)(lds + (bufoff) + ldsw + _i * 8192), 16, 0, 0); } while (0)
#define PG8_LDA(dst, b, h) do { _Pragma("unroll") for (int m = 0; m < 4; ++m) _Pragma("unroll") for (int k = 0; k < 2; ++k) dst[m][k] = *(const PG8_LAS bf16x8*)(lds + PG8_SA(b, h) + aoff + m * 2048 + k * 1024); } while (0)
#define PG8_LDB(dst, b, h) do { _Pragma("unroll") for (int n = 0; n < 2; ++n) _Pragma("unroll") for (int k = 0; k < 2; ++k) dst[n][k] = *(const PG8_LAS bf16x8*)(lds + PG8_SB(b, h) + boff + n * 2048 + k * 1024); } while (0)
#define PG8_MMA(ai, bj, At, Bt) do { __builtin_amdgcn_s_setprio(1); if constexpr (FP8) { _Pragma("unroll") for (int m = 0; m < 4; ++m) _Pragma("unroll") for (int n = 0; n < 2; ++n) \
        pg8_mfma8(acc[ai][bj][m][n], pg8_cat(Bt[n][0], Bt[n][1]), pg8_cat(At[m][0], At[m][1]), sc8); } else { \
        _Pragma("unroll") for (int m = 0; m < 4; ++m) _Pragma("unroll") for (int n = 0; n < 2; ++n) _Pragma("unroll") for (int k = 0; k < 2; ++k) \
        acc[ai][bj][m][n] = __builtin_amdgcn_mfma_f32_16x16x32_bf16(Bt[n][k], At[m][k], acc[ai][bj][m][n], 0, 0, 0); } __builtin_amdgcn_s_setprio(0); } while (0)
#define PG8_WAIT_V(n) asm volatile("s_waitcnt vmcnt(" #n ")" ::: "memory")
#define PG8_WAIT_L(n) asm volatile("s_waitcnt lgkmcnt(" #n ")" ::: "memory")
#define PG8_BAR __builtin_amdgcn_s_barrier()
#define PG8_SCHED __builtin_amdgcn_sched_barrier(0)
    Unit cur, nxt; int ui = 0;
    if (!S.next(0, cur)) return;
    int sc8 = 0x7F7F7F7F; asm volatile("" : "+v"(sc8));
    f32x4 acc[2][2][4][2];
#pragma unroll
    for (int a = 0; a < 2; ++a)
#pragma unroll
        for (int b = 0; b < 2; ++b)
#pragma unroll
            for (int m = 0; m < 4; ++m)
#pragma unroll
                for (int n = 0; n < 2; ++n) acc[a][b][m][n] = (f32x4){0.f, 0.f, 0.f, 0.f};
    bf16x8 At[4][2], B0[2][2], B1[2][2];
    const char* cA = S.abase(g, cur); const char* cB = S.bbase(g, cur);
    if constexpr (SP2) {
        PG8_STAGE(PG8_SB(0, 0), cB, voffB); PG8_STAGE(PG8_SB(0, 1), cB + hstepB, voffB); PG8_STAGE(PG8_SA(0, 0), cA, voffA); PG8_STAGE(PG8_SA(0, 1), cA + hstepA, voffA);
        if (wr == 1) PG8_BAR;
        PG8_WAIT_V(2); PG8_BAR;
        PG8_STAGE(PG8_SB(1, 0), cB + kstep, voffB); PG8_STAGE(PG8_SA(1, 0), cA + kstep, voffA); PG8_STAGE(PG8_SB(1, 1), cB + hstepB + kstep, voffB);
        PG8_WAIT_V(6); PG8_BAR;
    } else {
        PG8_STAGE(PG8_SB(0, 0), cB, voffB); PG8_STAGE(PG8_SA(0, 0), cA, voffA); PG8_STAGE(PG8_SB(0, 1), cB + hstepB, voffB); PG8_STAGE(PG8_SA(0, 1), cA + hstepA, voffA);
        if (wr == 1) PG8_BAR;
        PG8_WAIT_V(4); PG8_BAR;
        PG8_STAGE(PG8_SB(1, 0), cB + kstep, voffB); PG8_STAGE(PG8_SA(1, 0), cA + kstep, voffA); PG8_STAGE(PG8_SB(1, 1), cB + hstepB + kstep, voffB);
        PG8_WAIT_V(6); PG8_BAR;
    }
    for (;;) {
        const bool has_next = S.next(ui + 1, nxt);
        const char* nA = has_next ? S.abase(g, nxt) : cA; const char* nB = has_next ? S.bbase(g, nxt) : cB;
        for (int t = 0; t < nt; t += 2) {
            const bool last = (t == nt - 2);
            const char* a1 = cA + (size_t)(t + 1) * kstep;
            const char* a2 = last ? nA : cA + (size_t)(t + 2) * kstep; const char* b2 = last ? nB : cB + (size_t)(t + 2) * kstep;
            const char* a3 = a2 + kstep; const char* b3 = b2 + kstep;
            if constexpr (SP2) {
            PG8_LDB(B0, 0, 0); PG8_LDB(B1, 0, 1); PG8_SCHED; PG8_LDA(At, 0, 0); PG8_STAGE(PG8_SA(1, 1), a1 + hstepA, voffA);
            PG8_WAIT_V(8); PG8_WAIT_L(0); PG8_BAR; PG8_MMA(0, 0, At, B0); PG8_MMA(0, 1, At, B1); PG8_BAR; PG8_SCHED;
            PG8_LDA(At, 0, 1); PG8_STAGE(PG8_SB(0, 0), b2, voffB); PG8_STAGE(PG8_SB(0, 1), b2 + hstepB, voffB); PG8_STAGE(PG8_SA(0, 0), a2, voffA);
            PG8_WAIT_V(8); PG8_WAIT_L(0); PG8_BAR; PG8_MMA(1, 0, At, B0); PG8_MMA(1, 1, At, B1); PG8_BAR; PG8_SCHED;
            PG8_LDB(B0, 1, 0); PG8_LDB(B1, 1, 1); PG8_SCHED; PG8_LDA(At, 1, 0); PG8_STAGE(PG8_SA(0, 1), a2 + hstepA, voffA);
            PG8_WAIT_V(8); PG8_WAIT_L(0); PG8_BAR; PG8_MMA(0, 0, At, B0); PG8_MMA(0, 1, At, B1); PG8_BAR; PG8_SCHED;
            PG8_LDA(At, 1, 1); PG8_STAGE(PG8_SB(1, 0), b3, voffB); PG8_STAGE(PG8_SB(1, 1), b3 + hstepB, voffB); PG8_STAGE(PG8_SA(1, 0), a3, voffA);
            PG8_WAIT_V(8); PG8_WAIT_L(0); PG8_BAR; PG8_MMA(1, 0, At, B0); PG8_MMA(1, 1, At, B1); PG8_BAR; PG8_SCHED;
            } else {
            PG8_LDB(B0, 0, 0); PG8_SCHED; PG8_LDA(At, 0, 0); PG8_STAGE(PG8_SA(1, 1), a1 + hstepA, voffA);
            PG8_WAIT_L(8); PG8_BAR; PG8_WAIT_L(0); PG8_MMA(0, 0, At, B0); PG8_BAR; PG8_SCHED;
            PG8_LDB(B1, 0, 1); PG8_STAGE(PG8_SB(0, 0), b2, voffB);
            PG8_BAR; PG8_WAIT_L(0); PG8_MMA(0, 1, At, B1); PG8_BAR;
            PG8_LDA(At, 0, 1); PG8_STAGE(PG8_SA(0, 0), a2, voffA);
            PG8_BAR; PG8_WAIT_L(0); PG8_MMA(1, 0, At, B0); PG8_BAR; PG8_SCHED;
            PG8_STAGE(PG8_SB(0, 1), b2 + hstepB, voffB);
            PG8_WAIT_V(6); PG8_BAR; PG8_MMA(1, 1, At, B1); PG8_BAR;
            PG8_LDB(B0, 1, 0); PG8_SCHED; PG8_LDA(At, 1, 0); PG8_STAGE(PG8_SA(0, 1), a2 + hstepA, voffA);
            PG8_WAIT_L(8); PG8_BAR; PG8_WAIT_L(0); PG8_MMA(0, 0, At, B0); PG8_BAR; PG8_SCHED;
            PG8_LDB(B1, 1, 1); PG8_STAGE(PG8_SB(1, 0), b3, voffB);
            PG8_BAR; PG8_WAIT_L(0); PG8_MMA(0, 1, At, B1); PG8_BAR;
            PG8_LDA(At, 1, 1); PG8_STAGE(PG8_SA(1, 0), a3, voffA);
            PG8_BAR; PG8_WAIT_L(0); PG8_MMA(1, 0, At, B0); PG8_BAR; PG8_SCHED;
            PG8_STAGE(PG8_SB(1, 1), b3 + hstepB, voffB);
            PG8_WAIT_V(6); PG8_BAR; PG8_MMA(1, 1, At, B1); PG8_BAR;
            }
        }
        if constexpr (ALIGN_EPI) { if (wr == 0) PG8_BAR; }
        if constexpr (FP8) { PG8_SCHED; asm volatile("s_nop 15\n\ts_nop 7" ::: "memory"); PG8_SCHED; }
        E(acc, cur, wr, wc, fr, fq);
        if (!has_next) break;
#pragma unroll
        for (int a = 0; a < 2; ++a)
#pragma unroll
            for (int b = 0; b < 2; ++b)
#pragma unroll
                for (int m = 0; m < 4; ++m)
#pragma unroll
                    for (int n = 0; n < 2; ++n) acc[a][b][m][n] = (f32x4){0.f, 0.f, 0.f, 0.f};
        cur = nxt; cA = nA; cB = nB; ++ui;
        if constexpr (ALIGN_EPI) { if (wr == 1) PG8_BAR; }
    }
    PG8_WAIT_V(0);
    if constexpr (!ALIGN_EPI) { if (wr == 0) PG8_BAR; }
    PG8_BAR;
#undef PG8_SA
#undef PG8_SB
#undef PG8_STAGE
#undef PG8_LDA
#undef PG8_LDB
#undef PG8_MMA
#undef PG8_WAIT_V
#undef PG8_WAIT_L
#undef PG8_BAR
#undef PG8_SCHED
}
}
namespace att {
#define ATT_LAS __attribute__((address_space(3)))
#define ATT_GAS __attribute__((address_space(1)))
typedef unsigned short bf16;
using bf16x8 = __attribute__((ext_vector_type(8))) short;
using s16x4  = __attribute__((ext_vector_type(4))) short;
using f32x16 = __attribute__((ext_vector_type(16))) float;
using f32x4  = __attribute__((ext_vector_type(4))) float;
using u32x4  = __attribute__((ext_vector_type(4))) unsigned;
constexpr int NW = 8, QBLK = 32, KVBLK = 64, DV = 128;
constexpr float LOG2E = 1.4426950408889634f;
#if defined(ATT_OBF16) && ATT_OBF16
typedef unsigned short OT;
#else
typedef float OT;
#endif
#define SBAR() __builtin_amdgcn_sched_barrier(0)
__device__ __forceinline__ int crow(int r, int hi) { return (r & 3) + 8 * (r >> 2) + 4 * hi; }
__device__ __forceinline__ unsigned cvtpk(float lo, float hi) { unsigned r; asm volatile("v_cvt_pk_bf16_f32 %0, %1, %2" : "=v"(r) : "v"(lo), "v"(hi)); return r; }
__device__ __forceinline__ float bf2f(short s) { return __uint_as_float(((unsigned)(unsigned short)s) << 16); }
__device__ __forceinline__ void st_o(float* p, float v) { *p = v; }
__device__ __forceinline__ void st_o(unsigned short* p, float v) { *p = (unsigned short)(cvtpk(v, v) & 0xffffu); }

__device__ __forceinline__ void partialSM(f32x16& p0, f32x16& p1, float& m_reg, float& mn, float& alpha, const float C, const float THRS) {
  float pmax = p0[0];
#pragma unroll
  for (int r = 1; r < 16; ++r) pmax = fmaxf(pmax, p0[r]);
#pragma unroll
  for (int r = 0; r < 16; ++r) pmax = fmaxf(pmax, p1[r]);
  { auto rr = __builtin_amdgcn_permlane32_swap(__float_as_uint(pmax), __float_as_uint(pmax), false, false);
    pmax = fmaxf(__uint_as_float(rr[0]), __uint_as_float(rr[1])); }
  if (__builtin_expect(__all(pmax - m_reg <= THRS), 1)) { mn = m_reg; alpha = 1.f; }
  else { mn = fmaxf(m_reg, pmax); alpha = __builtin_amdgcn_exp2f((m_reg - mn) * C); m_reg = mn; }
  float mnC = -mn * C;
#pragma unroll
  for (int r = 0; r < 16; ++r) p0[r] = fmaf(p0[r], C, mnC);
#pragma unroll
  for (int r = 0; r < 16; ++r) p1[r] = fmaf(p1[r], C, mnC);
#pragma unroll
  for (int r = 0; r < 16; ++r) p0[r] = __builtin_amdgcn_exp2f(p0[r]);
}
#define ATT_PK4(P, BASE, OUT) do { unsigned a0 = cvtpk(P[BASE + 0], P[BASE + 1]), a1 = cvtpk(P[BASE + 2], P[BASE + 3]);   \
    unsigned b0 = cvtpk(P[BASE + 4], P[BASE + 5]), b1 = cvtpk(P[BASE + 6], P[BASE + 7]);                              \
    auto r0 = __builtin_amdgcn_permlane32_swap(a0, b0, false, false); auto r1 = __builtin_amdgcn_permlane32_swap(a1, b1, false, false); \
    u32x4 w = {r0[0], r1[0], r0[1], r1[1]}; OUT = *reinterpret_cast<bf16x8*>(&w); } while (0)
__device__ __forceinline__ void finishSM(f32x16& p0, f32x16& p1, float alpha, float& l_reg, bf16x8& pa0, bf16x8& pa1, bf16x8& pa2, bf16x8& pa3) {
#pragma unroll
  for (int r = 0; r < 16; ++r) p1[r] = __builtin_amdgcn_exp2f(p1[r]);
  float ps = 0;
#pragma unroll
  for (int r = 0; r < 16; ++r) ps += p0[r];
#pragma unroll
  for (int r = 0; r < 16; ++r) ps += p1[r];
  { auto rr = __builtin_amdgcn_permlane32_swap(__float_as_uint(ps), __float_as_uint(ps), false, false);
    ps = __uint_as_float(rr[0]) + __uint_as_float(rr[1]); }
  l_reg = l_reg * alpha + ps;
  ATT_PK4(p0, 0, pa0); ATT_PK4(p0, 8, pa1); ATT_PK4(p1, 0, pa2); ATT_PK4(p1, 8, pa3);
}
template <int RB> __device__ __forceinline__ int kswz(int row, int colB) { return row * RB + (colB ^ ((row & 7) << 4)); }
template <int DQK> __device__ __forceinline__ void qkt(f32x16& p0, f32x16& p1, const ATT_LAS char* Ks, const bf16x8 (&qr)[DQK / 16], int r32, int hi) {
  p0 = f32x16{}; p1 = f32x16{};
#pragma unroll
  for (int d0 = 0; d0 < DQK / 16; ++d0) { const int cb = (d0 * 16 + hi * 8) * 2;
    bf16x8 b0 = *reinterpret_cast<const ATT_LAS bf16x8*>(Ks + kswz<DQK * 2>(r32, cb));
    bf16x8 b1 = *reinterpret_cast<const ATT_LAS bf16x8*>(Ks + kswz<DQK * 2>(32 + r32, cb));
    p0 = __builtin_amdgcn_mfma_f32_32x32x16_bf16(b0, qr[d0], p0, 0, 0, 0);
    p1 = __builtin_amdgcn_mfma_f32_32x32x16_bf16(b1, qr[d0], p1, 0, 0, 0); }
}
__device__ __forceinline__ void qkt192_lq(f32x16& p0, f32x16& p1, const ATT_LAS char* Ks, const bf16x8 (&qr)[8], const ATT_LAS char* Qs, int lane, int r32, int hi) {
  p0 = f32x16{}; p1 = f32x16{};
#pragma unroll
  for (int d0 = 0; d0 < 12; ++d0) { const int cb = (d0 * 16 + hi * 8) * 2;
    bf16x8 b0 = *reinterpret_cast<const ATT_LAS bf16x8*>(Ks + kswz<384>(r32, cb));
    bf16x8 b1 = *reinterpret_cast<const ATT_LAS bf16x8*>(Ks + kswz<384>(32 + r32, cb));
    const bf16x8 q = d0 < 8 ? qr[d0 < 8 ? d0 : 0] : *reinterpret_cast<const ATT_LAS bf16x8*>(Qs + ((d0 - 8) * 64 + lane) * 16);
    p0 = __builtin_amdgcn_mfma_f32_32x32x16_bf16(b0, q, p0, 0, 0, 0);
    p1 = __builtin_amdgcn_mfma_f32_32x32x16_bf16(b1, q, p1, 0, 0, 0); }
}
__device__ __forceinline__ int v_st(int k, int c) { const int kk = (k & ~0xC) | ((k & 4) << 1) | ((k & 8) >> 1); return ((kk >> 3) * 4 + (c >> 5)) * 512 + ((kk & 7) * 32 + (c & 31)) * 2; }
__device__ __forceinline__ int v_rd_base(int lane) { return ((lane & 3) << 3) | (((lane >> 2) & 3) << 6) | (((lane >> 4) & 1) << 5) | (((lane >> 5) & 1) << 8); }
constexpr int v_rd_off(int d0, int ks, int half) { return d0 * 512 + ks * 4096 + half * 2048; }
template <int OFF> __device__ __forceinline__ s16x4 tr_read(int vb) {
  s16x4 r; asm volatile("ds_read_b64_tr_b16 %0, %1 offset:%2" : "=&v"(r) : "v"(vb), "i"(OFF) : "memory"); return r;
}
#define ATT_PK(L, H) (bf16x8){L[0], L[1], L[2], L[3], H[0], H[1], H[2], H[3]}
template <int D0> __device__ __forceinline__ void pv_one(f32x16& od, int vb, bf16x8 pa0, bf16x8 pa1, bf16x8 pa2, bf16x8 pa3) {
  const s16x4 l0 = tr_read<v_rd_off(D0, 0, 0)>(vb), h0 = tr_read<v_rd_off(D0, 0, 1)>(vb), l1 = tr_read<v_rd_off(D0, 1, 0)>(vb), h1 = tr_read<v_rd_off(D0, 1, 1)>(vb);
  const s16x4 l2 = tr_read<v_rd_off(D0, 2, 0)>(vb), h2 = tr_read<v_rd_off(D0, 2, 1)>(vb), l3 = tr_read<v_rd_off(D0, 3, 0)>(vb), h3 = tr_read<v_rd_off(D0, 3, 1)>(vb);
  asm volatile("s_waitcnt lgkmcnt(0)" ::: "memory"); SBAR();
  od = __builtin_amdgcn_mfma_f32_32x32x16_bf16(pa0, ATT_PK(l0, h0), od, 0, 0, 0);
  od = __builtin_amdgcn_mfma_f32_32x32x16_bf16(pa1, ATT_PK(l1, h1), od, 0, 0, 0);
  od = __builtin_amdgcn_mfma_f32_32x32x16_bf16(pa2, ATT_PK(l2, h2), od, 0, 0, 0);
  od = __builtin_amdgcn_mfma_f32_32x32x16_bf16(pa3, ATT_PK(l3, h3), od, 0, 0, 0);
}
__device__ __forceinline__ void pv_d0(f32x16 (&o)[4], int vb, bf16x8 pa0, bf16x8 pa1, bf16x8 pa2, bf16x8 pa3) {
  pv_one<0>(o[0], vb, pa0, pa1, pa2, pa3); pv_one<1>(o[1], vb, pa0, pa1, pa2, pa3); pv_one<2>(o[2], vb, pa0, pa1, pa2, pa3); pv_one<3>(o[3], vb, pa0, pa1, pa2, pa3);
}
template <int D0> __device__ __forceinline__ void pv32_one(f32x16& od, int vb, bf16x8 pa0, bf16x8 pa1) {
  const s16x4 l0 = tr_read<v_rd_off(D0, 0, 0)>(vb), h0 = tr_read<v_rd_off(D0, 0, 1)>(vb), l1 = tr_read<v_rd_off(D0, 1, 0)>(vb), h1 = tr_read<v_rd_off(D0, 1, 1)>(vb);
  asm volatile("s_waitcnt lgkmcnt(0)" ::: "memory"); SBAR();
  od = __builtin_amdgcn_mfma_f32_32x32x16_bf16(pa0, ATT_PK(l0, h0), od, 0, 0, 0);
  od = __builtin_amdgcn_mfma_f32_32x32x16_bf16(pa1, ATT_PK(l1, h1), od, 0, 0, 0);
}

template <int DQK, int LDQ, int LDK, int LDO, int SDEPTH>
__device__ __forceinline__ void attn_dense_body(const bf16* __restrict__ Qb, const bf16* __restrict__ Kh, const bf16* __restrict__ Kr, const bf16* __restrict__ Vh,
                                                const float* __restrict__ cs_rows, OT* __restrict__ Ob, int seq, const float scale, ATT_LAS char* lds) {
  constexpr int SHM_V = KVBLK * DV * 2, SHM_K = KVBLK * DQK * 2, RB = DQK * 2, NQ = DQK / 16;
  constexpr bool ROPE = (DQK == 192);
  const float C = scale * LOG2E, THRS = 8.f / scale;
  int tid_ = threadIdx.x; asm volatile("" : "+v"(tid_));
  const int tid = tid_, wid = tid >> 6, lane = tid & 63, r32 = lane & 31, hi = lane >> 5;
  ATT_LAS char* V_lds = lds; ATT_LAS char* K_lds = lds + 2 * SHM_V;
  ATT_LAS float* ws = (ATT_LAS float*)(lds + 2 * SHM_V + 2 * SHM_K) + wid * 64; ATT_LAS float* li_l = ws; ATT_LAS float* al_l = ws + 32;
  float m_reg = -1e30f, l_reg = 0; f32x16 o[4] = {}; bf16x8 qr[NQ];
  const bf16* Qw = Qb + (long)(wid * QBLK + r32) * LDQ + hi * 8;
#pragma unroll
  for (int d0 = 0; d0 < NQ; ++d0) qr[d0] = *(const ATT_GAS bf16x8*)(Qw + d0 * 16);
  if constexpr (ROPE) {
    const float* cs = cs_rows + (long)(wid * QBLK + r32) * 64 + hi * 8;
#pragma unroll
    for (int g = 0; g < 2; ++g) {
      const f32x4 c0 = *(const ATT_GAS f32x4*)(cs + g * 16), c1 = *(const ATT_GAS f32x4*)(cs + g * 16 + 4);
      const f32x4 s0 = *(const ATT_GAS f32x4*)(cs + 32 + g * 16), s1 = *(const ATT_GAS f32x4*)(cs + 32 + g * 16 + 4);
      float y1[8], y2[8];
#pragma unroll
      for (int j = 0; j < 8; ++j) { const float co = j < 4 ? c0[j & 3] : c1[j & 3], si = j < 4 ? s0[j & 3] : s1[j & 3];
        const float x1 = bf2f(qr[8 + g][j]), x2 = bf2f(qr[10 + g][j]); y1[j] = x1 * co - x2 * si; y2[j] = x1 * si + x2 * co; }
      u32x4 w1 = {cvtpk(y1[0], y1[1]), cvtpk(y1[2], y1[3]), cvtpk(y1[4], y1[5]), cvtpk(y1[6], y1[7])};
      u32x4 w2 = {cvtpk(y2[0], y2[1]), cvtpk(y2[2], y2[3]), cvtpk(y2[4], y2[5]), cvtpk(y2[6], y2[7])};
      qr[8 + g] = *reinterpret_cast<bf16x8*>(&w1); qr[10 + g] = *reinterpret_cast<bf16x8*>(&w2);
    }
  }
  const int sr = tid >> 4, sc = (tid & 15) * 8, vst0 = v_st(sr, sc), vst1 = v_st(32 + sr, sc);
  const int rr = tid >> 3, rc = (tid & 7) * 8;
  const int vb0 = (int)(unsigned)(uintptr_t)V_lds + v_rd_base(lane);
  struct Slot { bf16x8 vs0, vs1, ks0, ks1, kr; } sr_[SDEPTH];
#define SLOAD(i, k0) do { sr_[i].vs0 = *(const ATT_GAS bf16x8*)(&Vh[(long)((k0) + sr) * LDK + sc]); sr_[i].vs1 = *(const ATT_GAS bf16x8*)(&Vh[(long)((k0) + 32 + sr) * LDK + sc]); \
    sr_[i].ks0 = *(const ATT_GAS bf16x8*)(&Kh[(long)((k0) + sr) * LDK + sc]); sr_[i].ks1 = *(const ATT_GAS bf16x8*)(&Kh[(long)((k0) + 32 + sr) * LDK + sc]); \
    if constexpr (ROPE) sr_[i].kr = *(const ATT_GAS bf16x8*)(&Kr[(long)((k0) + rr) * 64 + rc]); } while (0)
#define SWRITE(b, i) do { *reinterpret_cast<ATT_LAS bf16x8*>(V_lds + (b) * SHM_V + vst0) = sr_[i].vs0;          \
    *reinterpret_cast<ATT_LAS bf16x8*>(V_lds + (b) * SHM_V + vst1) = sr_[i].vs1; const int kc = sc * 2;               \
    *reinterpret_cast<ATT_LAS bf16x8*>(K_lds + (b) * SHM_K + kswz<RB>(sr, kc)) = sr_[i].ks0;                       \
    *reinterpret_cast<ATT_LAS bf16x8*>(K_lds + (b) * SHM_K + kswz<RB>(32 + sr, kc)) = sr_[i].ks1;                  \
    if constexpr (ROPE) *reinterpret_cast<ATT_LAS bf16x8*>(K_lds + (b) * SHM_K + kswz<RB>(rr, 256 + rc * 2)) = sr_[i].kr; } while (0)
#define SWAIT() do { if constexpr (SDEPTH == 2) { if constexpr (ROPE) asm volatile("s_waitcnt vmcnt(5)" ::: "memory"); else asm volatile("s_waitcnt vmcnt(4)" ::: "memory"); } else asm volatile("s_waitcnt vmcnt(0)" ::: "memory"); } while (0)
#define RESC(a) do { if (__any((a) < 1.f)) { if (hi == 0) al_l[r32] = (a); asm volatile("s_waitcnt lgkmcnt(0)" ::: "memory"); \
    _Pragma("unroll") for (int d = 0; d < 4; ++d) _Pragma("unroll") for (int r = 0; r < 16; ++r) o[d][r] *= al_l[crow(r, hi)]; } } while (0)
  f32x16 pA0, pA1, pB0, pB1; float mnA, mnB, alA, alB; bf16x8 pa0, pa1, pa2, pa3; const int NT = seq / KVBLK;
  constexpr int SE = 0, SO = SDEPTH - 1;
  SLOAD(SE, 0); asm volatile("s_waitcnt vmcnt(0)" ::: "memory"); SWRITE(0, SE); __syncthreads();
  qkt<DQK>(pA0, pA1, K_lds, qr, r32, hi); partialSM(pA0, pA1, m_reg, mnA, alA, C, THRS);
  SLOAD(SO, KVBLK); if constexpr (SDEPTH == 2) { if (2 < NT) SLOAD(SE, 2 * KVBLK); }
  SWAIT(); SWRITE(1, SO); __syncthreads();
  for (int j = 1; j + 1 < NT; j += 2) {
    SBAR(); qkt<DQK>(pB0, pB1, K_lds + SHM_K, qr, r32, hi);
    finishSM(pA0, pA1, alA, l_reg, pa0, pa1, pa2, pa3); SBAR();
    SLOAD(SO, (j + SDEPTH) * KVBLK); SBAR();
    pv_d0(o, vb0, pa0, pa1, pa2, pa3); partialSM(pB0, pB1, m_reg, mnB, alB, C, THRS);
    __syncthreads(); SWAIT(); SWRITE(0, SE);
    RESC(alB); __syncthreads();
    SBAR(); qkt<DQK>(pA0, pA1, K_lds, qr, r32, hi);
    finishSM(pB0, pB1, alB, l_reg, pa0, pa1, pa2, pa3); SBAR();
    if (SDEPTH == 1 || j + 3 < NT) SLOAD(SE, (j + 1 + SDEPTH) * KVBLK); SBAR();
    pv_d0(o, vb0 + SHM_V, pa0, pa1, pa2, pa3); partialSM(pA0, pA1, m_reg, mnA, alA, C, THRS);
    __syncthreads(); SWAIT(); SWRITE(1, SO);
    RESC(alA); __syncthreads();
  }
  SBAR(); qkt<DQK>(pB0, pB1, K_lds + SHM_K, qr, r32, hi);
  finishSM(pA0, pA1, alA, l_reg, pa0, pa1, pa2, pa3); SBAR();
  pv_d0(o, vb0, pa0, pa1, pa2, pa3); partialSM(pB0, pB1, m_reg, mnB, alB, C, THRS);
  __syncthreads(); RESC(alB);
  finishSM(pB0, pB1, alB, l_reg, pa0, pa1, pa2, pa3); SBAR();
  pv_d0(o, vb0 + SHM_V, pa0, pa1, pa2, pa3);
  if (hi == 0) li_l[r32] = l_reg; asm volatile("s_waitcnt lgkmcnt(0)" ::: "memory");
  float rli[16];
#pragma unroll
  for (int r = 0; r < 16; ++r) rli[r] = __builtin_amdgcn_rcpf(li_l[crow(r, hi)]);
  OT* Ow = Ob + (long)(wid * QBLK) * LDO;
#pragma unroll
  for (int r = 0; r < 16; ++r) { const int orow = crow(r, hi);
#pragma unroll
    for (int d0 = 0; d0 < 4; ++d0) st_o(&Ow[(long)orow * LDO + d0 * 32 + r32], o[d0][r] * rli[r]); }
  __syncthreads();
#undef SLOAD
#undef SWRITE
#undef SWAIT
#undef RESC
}

template <int LDQ, int LDK, int LDO>
__device__ __forceinline__ void attn_pipe192_body(const bf16* __restrict__ Qb, const bf16* __restrict__ Kh, const bf16* __restrict__ Kr, const bf16* __restrict__ Vh,
                                                const float* __restrict__ cs_rows, OT* __restrict__ Ob, int seq, const float scale, ATT_LAS char* lds) {
  constexpr int DQK = 192, SDEPTH = 1, SHM_V = KVBLK * DV * 2, SHM_K = KVBLK * DQK * 2, RB = DQK * 2, NQ = DQK / 16;
  constexpr bool ROPE = true;
  const float C = scale * LOG2E, THRS = 8.f / scale;
  int tid_ = threadIdx.x; asm volatile("" : "+v"(tid_));
  const int tid = tid_, wid = tid >> 6, lane = tid & 63, r32 = lane & 31, hi = lane >> 5;
  ATT_LAS char* V_lds = lds; ATT_LAS char* K_lds = lds + 2 * SHM_V;
  ATT_LAS float* ws = (ATT_LAS float*)(lds + 2 * SHM_V + 2 * SHM_K) + wid * 64; ATT_LAS float* li_l = ws; ATT_LAS float* al_l = ws + 32;
  ATT_LAS char* Qs = lds + 2 * SHM_V + 2 * SHM_K + 2048 + wid * 4096;
  float m_reg = -1e30f, l_reg = 0; f32x16 o[4] = {}; bf16x8 qr8[8];
  const bf16* Qw = Qb + (long)(wid * QBLK + r32) * LDQ + hi * 8;
  { bf16x8 qr[NQ];
#pragma unroll
  for (int d0 = 0; d0 < NQ; ++d0) qr[d0] = *(const ATT_GAS bf16x8*)(Qw + d0 * 16);
  if constexpr (ROPE) {
    const float* cs = cs_rows + (long)(wid * QBLK + r32) * 64 + hi * 8;
#pragma unroll
    for (int g = 0; g < 2; ++g) {
      const f32x4 c0 = *(const ATT_GAS f32x4*)(cs + g * 16), c1 = *(const ATT_GAS f32x4*)(cs + g * 16 + 4);
      const f32x4 s0 = *(const ATT_GAS f32x4*)(cs + 32 + g * 16), s1 = *(const ATT_GAS f32x4*)(cs + 32 + g * 16 + 4);
      float y1[8], y2[8];
#pragma unroll
      for (int j = 0; j < 8; ++j) { const float co = j < 4 ? c0[j & 3] : c1[j & 3], si = j < 4 ? s0[j & 3] : s1[j & 3];
        const float x1 = bf2f(qr[8 + g][j]), x2 = bf2f(qr[10 + g][j]); y1[j] = x1 * co - x2 * si; y2[j] = x1 * si + x2 * co; }
      u32x4 w1 = {cvtpk(y1[0], y1[1]), cvtpk(y1[2], y1[3]), cvtpk(y1[4], y1[5]), cvtpk(y1[6], y1[7])};
      u32x4 w2 = {cvtpk(y2[0], y2[1]), cvtpk(y2[2], y2[3]), cvtpk(y2[4], y2[5]), cvtpk(y2[6], y2[7])};
      qr[8 + g] = *reinterpret_cast<bf16x8*>(&w1); qr[10 + g] = *reinterpret_cast<bf16x8*>(&w2);
    }
  }
#pragma unroll
  for (int d0 = 0; d0 < 8; ++d0) qr8[d0] = qr[d0];
#pragma unroll
  for (int d0 = 8; d0 < 12; ++d0) *reinterpret_cast<ATT_LAS bf16x8*>(Qs + ((d0 - 8) * 64 + lane) * 16) = qr[d0];
  }
  const int sr = tid >> 4, sc = (tid & 15) * 8, vst0 = v_st(sr, sc), vst1 = v_st(32 + sr, sc);
  const int rr = tid >> 3, rc = (tid & 7) * 8;
  const int vb0 = (int)(unsigned)(uintptr_t)V_lds + v_rd_base(lane);
  struct Slot { bf16x8 vs0, vs1, ks0, ks1, kr; } sr_[SDEPTH];
#define SLOADK(i, k0) do { sr_[i].ks0 = *(const ATT_GAS bf16x8*)(&Kh[(long)((k0) + sr) * LDK + sc]); sr_[i].ks1 = *(const ATT_GAS bf16x8*)(&Kh[(long)((k0) + 32 + sr) * LDK + sc]); } while (0)
#define SLOADV(i, k0) do { sr_[i].vs0 = *(const ATT_GAS bf16x8*)(&Vh[(long)((k0) + sr) * LDK + sc]); sr_[i].vs1 = *(const ATT_GAS bf16x8*)(&Vh[(long)((k0) + 32 + sr) * LDK + sc]); \
    if constexpr (ROPE) sr_[i].kr = *(const ATT_GAS bf16x8*)(&Kr[(long)((k0) + rr) * 64 + rc]); } while (0)
#define SLOAD(i, k0) do { SLOADK(i, k0); SLOADV(i, k0); } while (0)
#define SWRITE(b, i) do { *reinterpret_cast<ATT_LAS bf16x8*>(V_lds + (b) * SHM_V + vst0) = sr_[i].vs0;          \
    *reinterpret_cast<ATT_LAS bf16x8*>(V_lds + (b) * SHM_V + vst1) = sr_[i].vs1; const int kc = sc * 2;               \
    *reinterpret_cast<ATT_LAS bf16x8*>(K_lds + (b) * SHM_K + kswz<RB>(sr, kc)) = sr_[i].ks0;                       \
    *reinterpret_cast<ATT_LAS bf16x8*>(K_lds + (b) * SHM_K + kswz<RB>(32 + sr, kc)) = sr_[i].ks1;                  \
    if constexpr (ROPE) *reinterpret_cast<ATT_LAS bf16x8*>(K_lds + (b) * SHM_K + kswz<RB>(rr, 256 + rc * 2)) = sr_[i].kr; } while (0)
#define SWAIT() do { if constexpr (SDEPTH == 2) { if constexpr (ROPE) asm volatile("s_waitcnt vmcnt(5)" ::: "memory"); else asm volatile("s_waitcnt vmcnt(4)" ::: "memory"); } else asm volatile("s_waitcnt vmcnt(0)" ::: "memory"); } while (0)
#define RESC(a) do { if (__any((a) < 1.f)) { if (hi == 0) al_l[r32] = (a); asm volatile("s_waitcnt lgkmcnt(0)" ::: "memory"); \
    _Pragma("unroll") for (int d = 0; d < 4; ++d) _Pragma("unroll") for (int r = 0; r < 16; ++r) o[d][r] *= al_l[crow(r, hi)]; } } while (0)
  f32x16 pA0, pA1, pB0, pB1; float mnA, mnB, alA, alB; bf16x8 pa0, pa1, pa2, pa3; const int NT = seq / KVBLK;
  constexpr int SE = 0, SO = SDEPTH - 1;
  SLOAD(SE, 0); asm volatile("s_waitcnt vmcnt(0)" ::: "memory"); SWRITE(0, SE); __syncthreads();
  qkt192_lq(pA0, pA1, K_lds, qr8, Qs, lane, r32, hi); partialSM(pA0, pA1, m_reg, mnA, alA, C, THRS);
  SLOAD(SO, KVBLK); if constexpr (SDEPTH == 2) { if (2 < NT) SLOAD(SE, 2 * KVBLK); }
  SWAIT(); SWRITE(1, SO); __syncthreads();
  for (int j = 1; j + 1 < NT; j += 2) {
    SBAR(); qkt192_lq(pB0, pB1, K_lds + SHM_K, qr8, Qs, lane, r32, hi);
    finishSM(pA0, pA1, alA, l_reg, pa0, pa1, pa2, pa3); SBAR();
    SLOADK(SO, (j + SDEPTH) * KVBLK); SBAR();
    pv_d0(o, vb0, pa0, pa1, pa2, pa3); SBAR(); SLOADV(SO, (j + SDEPTH) * KVBLK); SBAR(); partialSM(pB0, pB1, m_reg, mnB, alB, C, THRS);
    __syncthreads(); SWAIT(); SWRITE(0, SE);
    RESC(alB); __syncthreads();
    SBAR(); qkt192_lq(pA0, pA1, K_lds, qr8, Qs, lane, r32, hi);
    finishSM(pB0, pB1, alB, l_reg, pa0, pa1, pa2, pa3); SBAR();
    SLOADK(SE, (j + 1 + SDEPTH) * KVBLK); SBAR();
    pv_d0(o, vb0 + SHM_V, pa0, pa1, pa2, pa3); SBAR(); SLOADV(SE, (j + 1 + SDEPTH) * KVBLK); SBAR(); partialSM(pA0, pA1, m_reg, mnA, alA, C, THRS);
    __syncthreads(); SWAIT(); SWRITE(1, SO);
    RESC(alA); __syncthreads();
  }
  SBAR(); qkt192_lq(pB0, pB1, K_lds + SHM_K, qr8, Qs, lane, r32, hi);
  finishSM(pA0, pA1, alA, l_reg, pa0, pa1, pa2, pa3); SBAR();
  pv_d0(o, vb0, pa0, pa1, pa2, pa3); partialSM(pB0, pB1, m_reg, mnB, alB, C, THRS);
  __syncthreads(); RESC(alB);
  finishSM(pB0, pB1, alB, l_reg, pa0, pa1, pa2, pa3); SBAR();
  pv_d0(o, vb0 + SHM_V, pa0, pa1, pa2, pa3);
  if (hi == 0) li_l[r32] = l_reg; asm volatile("s_waitcnt lgkmcnt(0)" ::: "memory");
  float rli[16];
#pragma unroll
  for (int r = 0; r < 16; ++r) rli[r] = __builtin_amdgcn_rcpf(li_l[crow(r, hi)]);
  OT* Ow = Ob + (long)(wid * QBLK) * LDO;
#pragma unroll
  for (int r = 0; r < 16; ++r) { const int orow = crow(r, hi);
#pragma unroll
    for (int d0 = 0; d0 < 4; ++d0) st_o(&Ow[(long)orow * LDO + d0 * 32 + r32], o[d0][r] * rli[r]); }
  __syncthreads();
#undef SLOAD
#undef SLOADK
#undef SLOADV
#undef SWRITE
#undef SWAIT
#undef RESC
}

template <int DQK, int LDQ, int LDK, int LDO>
__device__ __forceinline__ void attn_simple_body(const bf16* __restrict__ Qb, const bf16* __restrict__ Kh, const bf16* __restrict__ Kr, const bf16* __restrict__ Vh,
                                                 const float* __restrict__ cs_rows, OT* __restrict__ Ob, int seq, const float scale, ATT_LAS char* lds) {
  constexpr int SHM_V = KVBLK * DV * 2, SHM_K = KVBLK * DQK * 2, RB = DQK * 2, NQ = DQK / 16;
  constexpr bool ROPE = (DQK == 192);
  const float C = scale * LOG2E, THRS = 8.f / scale;
  int tid_ = threadIdx.x; asm volatile("" : "+v"(tid_));
  const int tid = tid_, wid = tid >> 6, lane = tid & 63, r32 = lane & 31, hi = lane >> 5;
  ATT_LAS char* V_lds = lds; ATT_LAS char* K_lds = lds + 2 * SHM_V;
  ATT_LAS float* ws = (ATT_LAS float*)(lds + 2 * SHM_V + 2 * SHM_K) + wid * 64; ATT_LAS float* li_l = ws; ATT_LAS float* al_l = ws + 32;
  float m_reg = -1e30f, l_reg = 0; f32x16 o[4] = {}; bf16x8 qr[NQ];
  const bf16* Qw = Qb + (long)(wid * QBLK + r32) * LDQ + hi * 8;
#pragma unroll
  for (int d0 = 0; d0 < NQ; ++d0) qr[d0] = *(const ATT_GAS bf16x8*)(Qw + d0 * 16);
  if constexpr (ROPE) {
    const float* cs = cs_rows + (long)(wid * QBLK + r32) * 64 + hi * 8;
#pragma unroll
    for (int g = 0; g < 2; ++g) {
      const f32x4 c0 = *(const ATT_GAS f32x4*)(cs + g * 16), c1 = *(const ATT_GAS f32x4*)(cs + g * 16 + 4);
      const f32x4 s0 = *(const ATT_GAS f32x4*)(cs + 32 + g * 16), s1 = *(const ATT_GAS f32x4*)(cs + 32 + g * 16 + 4);
      float y1[8], y2[8];
#pragma unroll
      for (int j = 0; j < 8; ++j) { const float co = j < 4 ? c0[j & 3] : c1[j & 3], si = j < 4 ? s0[j & 3] : s1[j & 3];
        const float x1 = bf2f(qr[8 + g][j]), x2 = bf2f(qr[10 + g][j]); y1[j] = x1 * co - x2 * si; y2[j] = x1 * si + x2 * co; }
      u32x4 w1 = {cvtpk(y1[0], y1[1]), cvtpk(y1[2], y1[3]), cvtpk(y1[4], y1[5]), cvtpk(y1[6], y1[7])};
      u32x4 w2 = {cvtpk(y2[0], y2[1]), cvtpk(y2[2], y2[3]), cvtpk(y2[4], y2[5]), cvtpk(y2[6], y2[7])};
      qr[8 + g] = *reinterpret_cast<bf16x8*>(&w1); qr[10 + g] = *reinterpret_cast<bf16x8*>(&w2);
    }
  }
  const int sr = tid >> 4, sc = (tid & 15) * 8, vst0 = v_st(sr, sc), vst1 = v_st(32 + sr, sc);
  const int rr = tid >> 3, rc = (tid & 7) * 8;
  const int vb0 = (int)(unsigned)(uintptr_t)V_lds + v_rd_base(lane);
  bf16x8 vs0, vs1, ks0, ks1, kr;
#define SLOAD(k0) do { vs0 = *(const ATT_GAS bf16x8*)(&Vh[(long)((k0) + sr) * LDK + sc]); vs1 = *(const ATT_GAS bf16x8*)(&Vh[(long)((k0) + 32 + sr) * LDK + sc]); \
    ks0 = *(const ATT_GAS bf16x8*)(&Kh[(long)((k0) + sr) * LDK + sc]); ks1 = *(const ATT_GAS bf16x8*)(&Kh[(long)((k0) + 32 + sr) * LDK + sc]); \
    if constexpr (ROPE) kr = *(const ATT_GAS bf16x8*)(&Kr[(long)((k0) + rr) * 64 + rc]); } while (0)
#define SWRITE(b) do { *reinterpret_cast<ATT_LAS bf16x8*>(V_lds + (b) * SHM_V + vst0) = vs0;          \
    *reinterpret_cast<ATT_LAS bf16x8*>(V_lds + (b) * SHM_V + vst1) = vs1; const int kc = sc * 2;               \
    *reinterpret_cast<ATT_LAS bf16x8*>(K_lds + (b) * SHM_K + kswz<RB>(sr, kc)) = ks0;                       \
    *reinterpret_cast<ATT_LAS bf16x8*>(K_lds + (b) * SHM_K + kswz<RB>(32 + sr, kc)) = ks1;                  \
    if constexpr (ROPE) *reinterpret_cast<ATT_LAS bf16x8*>(K_lds + (b) * SHM_K + kswz<RB>(rr, 256 + rc * 2)) = kr; } while (0)
#define RESC(a) do { if (__any((a) < 1.f)) { if (hi == 0) al_l[r32] = (a); asm volatile("s_waitcnt lgkmcnt(0)" ::: "memory"); \
    _Pragma("unroll") for (int d = 0; d < 4; ++d) _Pragma("unroll") for (int r = 0; r < 16; ++r) o[d][r] *= al_l[crow(r, hi)]; } } while (0)
  const int NT = seq / KVBLK;
  SLOAD(0); SWRITE(0); __syncthreads();
  for (int j = 0; j < NT; ++j) {
    const int b = j & 1;
    if (j + 1 < NT) SLOAD((j + 1) * KVBLK);
    f32x16 p0, p1; float mn, al; bf16x8 pa0, pa1, pa2, pa3;
    SBAR(); qkt<DQK>(p0, p1, K_lds + b * SHM_K, qr, r32, hi);
    partialSM(p0, p1, m_reg, mn, al, C, THRS); RESC(al);
    finishSM(p0, p1, al, l_reg, pa0, pa1, pa2, pa3); SBAR();
    pv_d0(o, vb0 + b * SHM_V, pa0, pa1, pa2, pa3);
    if (j + 1 < NT) SWRITE(b ^ 1);
    __syncthreads();
  }
  if (hi == 0) li_l[r32] = l_reg; asm volatile("s_waitcnt lgkmcnt(0)" ::: "memory");
  float rli[16];
#pragma unroll
  for (int r = 0; r < 16; ++r) rli[r] = __builtin_amdgcn_rcpf(li_l[crow(r, hi)]);
  OT* Ow = Ob + (long)(wid * QBLK) * LDO;
#pragma unroll
  for (int r = 0; r < 16; ++r) { const int orow = crow(r, hi);
#pragma unroll
    for (int d0 = 0; d0 < 4; ++d0) st_o(&Ow[(long)orow * LDO + d0 * 32 + r32], o[d0][r] * rli[r]); }
  __syncthreads();
#undef SLOAD
#undef SWRITE
#undef RESC
}

template <int LDQ, int LDK, int LDO>
__device__ __forceinline__ void attn_dma_body(const bf16* __restrict__ Qb, const bf16* __restrict__ Kh, const bf16* __restrict__ Kr, const bf16* __restrict__ Vh,
                                              const float* __restrict__ cs_rows, OT* __restrict__ Ob, int seq, const float scale, ATT_LAS char* lds) {
  constexpr int DQK = 192, SHM_V = KVBLK * DV * 2, SHM_K = KVBLK * DQK * 2, STG = SHM_K + SHM_V, RB = DQK * 2, NQ = DQK / 16;
  const float C = scale * LOG2E, THRS = 8.f / scale;
  int tid_ = threadIdx.x; asm volatile("" : "+v"(tid_));
  const int tid = tid_, wid = __builtin_amdgcn_readfirstlane(tid >> 6), lane = tid & 63, r32 = lane & 31, hi = lane >> 5;
  ATT_LAS float* ws = (ATT_LAS float*)(lds + 3 * STG) + wid * 64; ATT_LAS float* li_l = ws; ATT_LAS float* al_l = ws + 32;
  float m_reg = -1e30f, l_reg = 0; f32x16 o[4] = {}; bf16x8 qr[NQ];
  const bf16* Qw = Qb + (long)(wid * QBLK + r32) * LDQ + hi * 8;
#pragma unroll
  for (int d0 = 0; d0 < NQ; ++d0) qr[d0] = *(const ATT_GAS bf16x8*)(Qw + d0 * 16);
  { const float* cs = cs_rows + (long)(wid * QBLK + r32) * 64 + hi * 8;
#pragma unroll
    for (int g = 0; g < 2; ++g) {
      const f32x4 c0 = *(const ATT_GAS f32x4*)(cs + g * 16), c1 = *(const ATT_GAS f32x4*)(cs + g * 16 + 4);
      const f32x4 s0 = *(const ATT_GAS f32x4*)(cs + 32 + g * 16), s1 = *(const ATT_GAS f32x4*)(cs + 32 + g * 16 + 4);
      float y1[8], y2[8];
#pragma unroll
      for (int j = 0; j < 8; ++j) { const float co = j < 4 ? c0[j & 3] : c1[j & 3], si = j < 4 ? s0[j & 3] : s1[j & 3];
        const float x1 = bf2f(qr[8 + g][j]), x2 = bf2f(qr[10 + g][j]); y1[j] = x1 * co - x2 * si; y2[j] = x1 * si + x2 * co; }
      u32x4 w1 = {cvtpk(y1[0], y1[1]), cvtpk(y1[2], y1[3]), cvtpk(y1[4], y1[5]), cvtpk(y1[6], y1[7])};
      u32x4 w2 = {cvtpk(y2[0], y2[1]), cvtpk(y2[2], y2[3]), cvtpk(y2[4], y2[5]), cvtpk(y2[6], y2[7])};
      qr[8 + g] = *reinterpret_cast<bf16x8*>(&w1); qr[10 + g] = *reinterpret_cast<bf16x8*>(&w2);
    } }
  const char* ksrc[3]; int kstep[3];
#pragma unroll
  for (int d = 0; d < 3; ++d) { const int p = (wid * 3 + d) * 64 + lane, row = p / 24, cpos = p - row * 24, c = cpos ^ (row & 7);
    if (c < 16) { ksrc[d] = (const char*)(Kh + (long)row * LDK + c * 8); kstep[d] = KVBLK * LDK * 2; } else { ksrc[d] = (const char*)(Kr + (long)row * 64 + (c - 16) * 8); kstep[d] = KVBLK * 64 * 2; } }
  const char* vsrc[2];
#pragma unroll
  for (int d = 0; d < 2; ++d) { const int p = (wid * 2 + d) * 64 + lane, sub = p >> 5, q = p & 31, kk = (sub >> 2) * 8 + (q >> 2), col = (sub & 3) * 32 + (q & 3) * 8;
    const int key = (kk & ~0xC) | ((kk & 4) << 1) | ((kk & 8) >> 1); vsrc[d] = (const char*)(Vh + (long)key * LDK + col); }
#define DMA_TILE(t, stg) do { ATT_LAS char* sb_ = lds + (stg) * STG; \
    _Pragma("unroll") for (int d = 0; d < 3; ++d) __builtin_amdgcn_global_load_lds((const unsigned*)(ksrc[d] + (long)(t) * kstep[d]), (ATT_LAS unsigned*)(sb_ + (wid * 3 + d) * 1024), 16, 0, 0); \
    _Pragma("unroll") for (int d = 0; d < 2; ++d) __builtin_amdgcn_global_load_lds((const unsigned*)(vsrc[d] + (long)(t) * (KVBLK * LDK * 2)), (ATT_LAS unsigned*)(sb_ + SHM_K + (wid * 2 + d) * 1024), 16, 0, 0); } while (0)
#define RESC(a) do { if (__any((a) < 1.f)) { if (hi == 0) al_l[r32] = (a); asm volatile("s_waitcnt lgkmcnt(0)" ::: "memory"); \
    _Pragma("unroll") for (int d = 0; d < 4; ++d) _Pragma("unroll") for (int r = 0; r < 16; ++r) o[d][r] *= al_l[crow(r, hi)]; } } while (0)
  const int NT = seq / KVBLK, vbase = (int)(unsigned)(uintptr_t)lds + SHM_K + v_rd_base(lane);
  asm volatile("s_waitcnt vmcnt(0)" ::: "memory");
  DMA_TILE(0, 0); DMA_TILE(1, 1);
  asm volatile("s_waitcnt vmcnt(5)" ::: "memory"); __builtin_amdgcn_s_barrier(); asm volatile("" ::: "memory");
  int stg = 0;
  for (int j = 0; j < NT; ++j) {
    const int stg2 = stg >= 1 ? stg - 1 : 2;
    if (j + 2 < NT) DMA_TILE(j + 2, stg2);
    f32x16 p0, p1; float mn, al; bf16x8 pa0, pa1, pa2, pa3;
    SBAR(); qkt<DQK>(p0, p1, lds + stg * STG, qr, r32, hi);
    partialSM(p0, p1, m_reg, mn, al, C, THRS); RESC(al);
    finishSM(p0, p1, al, l_reg, pa0, pa1, pa2, pa3); SBAR();
    pv_d0(o, vbase + stg * STG, pa0, pa1, pa2, pa3);
    if (j + 2 < NT) asm volatile("s_waitcnt vmcnt(5)" ::: "memory"); else asm volatile("s_waitcnt vmcnt(0)" ::: "memory");
    asm volatile("s_waitcnt lgkmcnt(0)" ::: "memory"); __builtin_amdgcn_s_barrier(); asm volatile("" ::: "memory");
    stg = stg == 2 ? 0 : stg + 1;
  }
  if (hi == 0) li_l[r32] = l_reg; asm volatile("s_waitcnt lgkmcnt(0)" ::: "memory");
  float rli[16];
#pragma unroll
  for (int r = 0; r < 16; ++r) rli[r] = __builtin_amdgcn_rcpf(li_l[crow(r, hi)]);
  OT* Ow = Ob + (long)(wid * QBLK) * LDO;
#pragma unroll
  for (int r = 0; r < 16; ++r) { const int orow = crow(r, hi);
#pragma unroll
    for (int d0 = 0; d0 < 4; ++d0) st_o(&Ow[(long)orow * LDO + d0 * 32 + r32], o[d0][r] * rli[r]); }
  __syncthreads();
#undef DMA_TILE
#undef RESC
}

template <int LDP>
__device__ __forceinline__ void dil_wave_unit(const bf16* __restrict__ P, int qc, int kc, int vc, int d, int r, int t0, int nT,
                                              OT* __restrict__ O, int oc, float* __restrict__ ST  ,
                                              ATT_LAS char* vlds  , const ATT_LAS float* bias2, const float C, int lane_) {
  int lane = lane_; asm volatile("" : "+v"(lane));
  const int r32 = lane & 31, hi = lane >> 5;
  bf16x8 qr[8];
  { const bf16* qp = P + (long)(r + d * (t0 + r32)) * LDP + qc + hi * 8;
#pragma unroll
    for (int d0 = 0; d0 < 8; ++d0) qr[d0] = *(const ATT_GAS bf16x8*)(qp + d0 * 16); }
  bf16x8 kf[2][8];
#define DIL_LDK(kb, set) do { int kt_ = t0 - 64 + (kb) * 32 + r32; kt_ = kt_ < 0 ? 0 : (kt_ > nT - 1 ? nT - 1 : kt_); \
    const bf16* kp_ = P + (long)(r + d * kt_) * LDP + kc + hi * 8; \
    _Pragma("unroll") for (int d0 = 0; d0 < 8; ++d0) kf[set][d0] = *(const ATT_GAS bf16x8*)(kp_ + d0 * 16); } while (0)
  DIL_LDK(0, 0);
  f32x16 p[5];
#pragma unroll
  for (int kb = 0; kb < 5; ++kb) {
    if (kb + 1 < 5) DIL_LDK(kb + 1, (kb + 1) & 1);
    p[kb] = f32x16{};
#pragma unroll
    for (int d0 = 0; d0 < 8; ++d0) p[kb] = __builtin_amdgcn_mfma_f32_32x32x16_bf16(kf[kb & 1][d0], qr[d0], p[kb], 0, 0, 0);
  }
#undef DIL_LDK
  bf16x8 vv[2][8];
#define DIL_LDV(kb, set) do { _Pragma("unroll") for (int i = 0; i < 8; ++i) { const int id = lane + 64 * i, row = id >> 4, c = (id & 15) * 8; \
      int kt_ = t0 - 64 + (kb) * 32 + row; kt_ = kt_ < 0 ? 0 : (kt_ > nT - 1 ? nT - 1 : kt_); \
      vv[set][i] = *(const ATT_GAS bf16x8*)(P + (long)(r + d * kt_) * LDP + vc + c); } } while (0)
  DIL_LDV(0, 0);
  float m = -1e30f;
  { const int a_ = 4 * hi - r32 + 32, k_ = a_ & 3; const ATT_LAS f32x4* tp = (const ATT_LAS f32x4*)(bias2 + k_ * 196 + (a_ - k_));
    const bool interior = (t0 >= 64) && (t0 + 96 <= nT);
#pragma unroll
    for (int kb = 0; kb < 5; ++kb)
#pragma unroll
      for (int g = 0; g < 4; ++g) { const f32x4 bv = tp[kb * 8 + 2 * g];
#pragma unroll
        for (int e = 0; e < 4; ++e) { const int rg = 4 * g + e; float s = fmaf(p[kb][rg], C, bv[e]);
          if (!interior) { const int kt = t0 - 64 + kb * 32 + crow(rg, hi); s = (kt >= 0 && kt < nT) ? s : -1e30f; }
          p[kb][rg] = s; m = fmaxf(m, s); } } }
  { auto rr = __builtin_amdgcn_permlane32_swap(__float_as_uint(m), __float_as_uint(m), false, false); m = fmaxf(__uint_as_float(rr[0]), __uint_as_float(rr[1])); }
  float Z = 0.f;
#pragma unroll
  for (int kb = 0; kb < 5; ++kb)
#pragma unroll
    for (int rg = 0; rg < 16; ++rg) { p[kb][rg] = __builtin_amdgcn_exp2f(p[kb][rg] - m); Z += p[kb][rg]; }
  { auto rr = __builtin_amdgcn_permlane32_swap(__float_as_uint(Z), __float_as_uint(Z), false, false); Z = __uint_as_float(rr[0]) + __uint_as_float(rr[1]); }
  bf16x8 pa[5][2];
#pragma unroll
  for (int kb = 0; kb < 5; ++kb) { ATT_PK4(p[kb], 0, pa[kb][0]); ATT_PK4(p[kb], 8, pa[kb][1]); }
  f32x16 o[4] = {};
  const int vb = (int)(unsigned)(uintptr_t)vlds + v_rd_base(lane);
#pragma unroll
  for (int kb = 0; kb < 5; ++kb) {
    if (kb + 1 < 5) DIL_LDV(kb + 1, (kb + 1) & 1);
#pragma unroll
    for (int i = 0; i < 8; ++i) { const int id = lane + 64 * i, row = id >> 4, c = (id & 15) * 8;
      *reinterpret_cast<ATT_LAS bf16x8*>(vlds + v_st(row, c)) = vv[kb & 1][i]; }
    asm volatile("s_waitcnt lgkmcnt(0)" ::: "memory"); SBAR();
    pv32_one<0>(o[0], vb, pa[kb][0], pa[kb][1]); pv32_one<1>(o[1], vb, pa[kb][0], pa[kb][1]); pv32_one<2>(o[2], vb, pa[kb][0], pa[kb][1]); pv32_one<3>(o[3], vb, pa[kb][0], pa[kb][1]);
    SBAR();
  }
#undef DIL_LDV
#pragma unroll
  for (int rg = 0; rg < 16; ++rg) { const long row = r + d * (t0 + crow(rg, hi));
#pragma unroll
    for (int d0 = 0; d0 < 4; ++d0) st_o(&O[row * 768 + oc + d0 * 32 + r32], o[d0][rg]); }
  if (hi == 0) { const long row = r + d * (t0 + r32); typedef float f32x2_ __attribute__((ext_vector_type(2))); *(ATT_GAS f32x2_*)(ST + row * 12) = (f32x2_){m, Z}; }
}
template <int LDP>
__device__ __forceinline__ void dil_wg_unit(const bf16* __restrict__ P, int qc, int kc, int vc, int d, int r, int T0, int nT,
                                            OT* __restrict__ O, int oc, float* __restrict__ ST, ATT_LAS char* lds, const ATT_LAS float* bias2, const float C) {
  int tid_ = threadIdx.x; asm volatile("" : "+v"(tid_));
  const int tid = tid_, wid = __builtin_amdgcn_readfirstlane(tid >> 6), lane = tid & 63, r32 = lane & 31, hi = lane >> 5, t0 = T0 + 32 * wid;
  { bf16x8 kk[12];
#pragma unroll
    for (int i = 0; i < 12; ++i) { const int id = tid + 512 * i, row = id >> 4, c = (id & 15) * 8; int kt = T0 - 64 + row; kt = kt < 0 ? 0 : (kt > nT - 1 ? nT - 1 : kt);
      kk[i] = *(const ATT_GAS bf16x8*)(P + (long)(r + d * kt) * LDP + kc + c); }
#pragma unroll
    for (int i = 0; i < 12; ++i) { const int id = tid + 512 * i, row = id >> 4, cB = (id & 15) * 16;
      *reinterpret_cast<ATT_LAS bf16x8*>(lds + kswz<256>(row, cB)) = kk[i]; } }
  bf16x8 qr[8];
  { const bf16* qp = P + (long)(r + d * (t0 + r32)) * LDP + qc + hi * 8;
#pragma unroll
    for (int d0 = 0; d0 < 8; ++d0) qr[d0] = *(const ATT_GAS bf16x8*)(qp + d0 * 16); }
  __syncthreads();
  bf16x8 vv[12];
#pragma unroll
  for (int i = 0; i < 12; ++i) { const int id = tid + 512 * i, row = id >> 4, c = (id & 15) * 8; int kt = T0 - 64 + row; kt = kt < 0 ? 0 : (kt > nT - 1 ? nT - 1 : kt);
    vv[i] = *(const ATT_GAS bf16x8*)(P + (long)(r + d * kt) * LDP + vc + c); }
  f32x16 p[5];
#pragma unroll
  for (int kb = 0; kb < 5; ++kb) { const int krow = 32 * wid + 32 * kb + r32;
    p[kb] = f32x16{};
#pragma unroll
    for (int d0 = 0; d0 < 8; ++d0) { const bf16x8 kf = *reinterpret_cast<const ATT_LAS bf16x8*>(lds + kswz<256>(krow, (d0 * 16 + hi * 8) * 2));
      p[kb] = __builtin_amdgcn_mfma_f32_32x32x16_bf16(kf, qr[d0], p[kb], 0, 0, 0); } }
  float m = -1e30f;
  { const int a_ = 4 * hi - r32 + 32, k_ = a_ & 3; const ATT_LAS f32x4* tp = (const ATT_LAS f32x4*)(bias2 + k_ * 196 + (a_ - k_));
    const bool interior = (t0 >= 64) && (t0 + 96 <= nT);
#pragma unroll
    for (int kb = 0; kb < 5; ++kb)
#pragma unroll
      for (int g = 0; g < 4; ++g) { const f32x4 bv = tp[kb * 8 + 2 * g];
#pragma unroll
        for (int e = 0; e < 4; ++e) { const int rg = 4 * g + e; float s = fmaf(p[kb][rg], C, bv[e]);
          if (!interior) { const int kt = t0 - 64 + kb * 32 + crow(rg, hi); s = (kt >= 0 && kt < nT) ? s : -1e30f; }
          p[kb][rg] = s; m = fmaxf(m, s); } } }
  { auto rr = __builtin_amdgcn_permlane32_swap(__float_as_uint(m), __float_as_uint(m), false, false); m = fmaxf(__uint_as_float(rr[0]), __uint_as_float(rr[1])); }
  float Z = 0.f;
#pragma unroll
  for (int kb = 0; kb < 5; ++kb)
#pragma unroll
    for (int rg = 0; rg < 16; ++rg) { p[kb][rg] = __builtin_amdgcn_exp2f(p[kb][rg] - m); Z += p[kb][rg]; }
  { auto rr = __builtin_amdgcn_permlane32_swap(__float_as_uint(Z), __float_as_uint(Z), false, false); Z = __uint_as_float(rr[0]) + __uint_as_float(rr[1]); }
  bf16x8 pa[5][2];
#pragma unroll
  for (int kb = 0; kb < 5; ++kb) { ATT_PK4(p[kb], 0, pa[kb][0]); ATT_PK4(p[kb], 8, pa[kb][1]); }
  __syncthreads();
#pragma unroll
  for (int i = 0; i < 12; ++i) { const int id = tid + 512 * i, row = id >> 4, c = (id & 15) * 8;
    *reinterpret_cast<ATT_LAS bf16x8*>(lds + (row >> 5) * 8192 + v_st(row & 31, c)) = vv[i]; }
  __syncthreads();
  f32x16 o[4] = {};
#pragma unroll
  for (int kb = 0; kb < 5; ++kb) { const int vb = (int)(unsigned)(uintptr_t)lds + (wid + kb) * 8192 + v_rd_base(lane);
    pv32_one<0>(o[0], vb, pa[kb][0], pa[kb][1]); pv32_one<1>(o[1], vb, pa[kb][0], pa[kb][1]); pv32_one<2>(o[2], vb, pa[kb][0], pa[kb][1]); pv32_one<3>(o[3], vb, pa[kb][0], pa[kb][1]); }
#pragma unroll
  for (int rg = 0; rg < 16; ++rg) { const long row = r + d * (t0 + crow(rg, hi));
#pragma unroll
    for (int d0 = 0; d0 < 4; ++d0) st_o(&O[row * 768 + oc + d0 * 32 + r32], o[d0][rg]); }
  if (hi == 0) { const long row = r + d * (t0 + r32); typedef float f32x2_ __attribute__((ext_vector_type(2))); *(ATT_GAS f32x2_*)(ST + row * 12) = (f32x2_){m, Z}; }
  __syncthreads();
}

#if defined(MLA_DMA) && MLA_DMA == 2
#define MLA_BODY attn_pipe192_body
#elif defined(MLA_DMA) && MLA_DMA
#define MLA_BODY attn_dma_body
#else
template <int LDQ, int LDK, int LDO> __device__ __forceinline__ void attn_simple192(const bf16* Qb, const bf16* Kh, const bf16* Kr, const bf16* Vh, const float* cs, OT* Ob, int seq, const float scale, ATT_LAS char* lds) { attn_simple_body<192, LDQ, LDK, LDO>(Qb, Kh, Kr, Vh, cs, Ob, seq, scale, lds); }
#define MLA_BODY attn_simple192
#endif
}
constexpr int S = 8192, D = 2048, NMEM = 256;
constexpr int DIN = 3392, DINP = 3584;
constexpr int PC_DIL = 768, PC_MEM = 3072;
constexpr int QR = 384, KVR = 128, AQ = 512;
constexpr int NUP = 2816;
constexpr int UC_KV = 1280;
constexpr int DFF = 5632, DFE = 7168, NE = 8;
constexpr int MP = 18432;
constexpr float EPS = 1e-6f;
constexpr int NWAVES = 8;

constexpr size_t al256(size_t x) { return (x + 255) / 256 * 256; }
constexpr size_t WS_CTL = 0, CTL_ZERO_BYTES = 1u << 20;
constexpr size_t WS_WIN = WS_CTL + CTL_ZERO_BYTES;
constexpr size_t WS_WUP = WS_WIN + al256((size_t)2 * DINP * D * 2);
constexpr size_t WS_WMEM = WS_WUP + al256((size_t)2 * NUP * AQ * 2);
constexpr size_t WS_WOUT = WS_WMEM + al256((size_t)2 * 1024 * D * 2);
constexpr size_t WS_WGU = WS_WOUT + al256((size_t)2 * D * D * 2);
constexpr size_t WS_WDN = WS_WGU + al256((size_t)2 * DFF * D * 2);
constexpr size_t WS_MGU = WS_WDN + al256((size_t)D * DFF * 2);
constexpr size_t WS_MDN = WS_MGU + al256((size_t)NE * 2 * DFE * D * 2);
constexpr size_t WS_XN = WS_MDN + al256((size_t)NE * D * DFE * 2);
constexpr size_t WS_MEMN = WS_XN + al256((size_t)S * D * 2);
constexpr size_t WS_MEMKV = WS_MEMN + al256((size_t)2 * NMEM * D * 2);
constexpr size_t WS_PROJ = WS_MEMKV + al256((size_t)2 * NMEM * 1024 * 2);
constexpr size_t WS_AQKV = WS_PROJ + al256((size_t)S * DINP * 2);
constexpr size_t WS_KROPE = WS_AQKV + al256((size_t)S * AQ * 2);
constexpr size_t WS_ROPECS = WS_KROPE + al256((size_t)S * 64 * 2);
constexpr size_t WS_QKVM = WS_ROPECS + al256((size_t)S * 64 * 4);
constexpr size_t WS_YPRE = WS_QKVM + al256((size_t)S * NUP * 2);
constexpr size_t WS_DILO = WS_YPRE + al256((size_t)S * D * 4);
constexpr size_t WS_DILS = WS_DILO + al256((size_t)3 * S * 768 * 4);
constexpr size_t WS_Y = WS_DILS + al256((size_t)3 * S * 12 * 4);
constexpr size_t WS_XA = WS_Y + al256((size_t)S * D * 2);
constexpr size_t WS_ROUTE = WS_XA + al256((size_t)S * D * 4);
constexpr size_t WS_XP = WS_ROUTE + al256((size_t)S * 32);
constexpr size_t WS_OUTP = WS_XP + al256((size_t)MP * D * 2);
constexpr size_t WS_ACTP = WS_OUTP + al256((size_t)MP * D * 2);
constexpr size_t WS_OUTQ = WS_ACTP + al256((size_t)MP * DFE * 2);
constexpr size_t WS_END = WS_OUTQ + al256((size_t)4 * 2048 * D * 2);
static_assert(WS_END <= 1879048192ull, "workspace map exceeds 4 x the largest input");
constexpr int CW_BAR = 16384;
constexpr int CW_QUEUE = 8192;
constexpr int CW_CNT = 8192 + 256;
constexpr int CW_QUEUE2 = 65536;
constexpr int CW_CVT = 8192 + 320;
constexpr int CW_DONE = 8192 + 384;
constexpr int CW_TILEE = 8192 + 512;
constexpr int RING_BYTES = 131072;
constexpr int LDSCTL_OFF = RING_BYTES, MISC_OFF = LDSCTL_OFF + 320;
constexpr int BIAS_OFF = 132096;
constexpr int LDS_BYTES = 147456;
static_assert(BIAS_OFF >= MISC_OFF + 128 && BIAS_OFF + 3 * 6 * 132 * 4 + 4 * 196 * 4 <= LDS_BYTES, "LDS map");

#define GAS __attribute__((address_space(1)))
#define LAS __attribute__((address_space(3)))
typedef unsigned short bf16;
typedef unsigned v4u __attribute__((ext_vector_type(4)));
typedef unsigned v2u __attribute__((ext_vector_type(2)));
typedef float f32x4 __attribute__((ext_vector_type(4)));
typedef short bf16x8 __attribute__((ext_vector_type(8)));
typedef GAS unsigned gu32;
#define RLX_AGENT __ATOMIC_RELAXED, __HIP_MEMORY_SCOPE_AGENT
#define LDS_WAIT() asm volatile("s_waitcnt lgkmcnt(0)" ::: "memory")
#define VM_WAIT() asm volatile("s_waitcnt vmcnt(0)" ::: "memory")
__device__ __forceinline__ unsigned f2bf(float f) { unsigned u = __builtin_bit_cast(unsigned, f); return (u + 0x7fffu + ((u >> 16) & 1u)) >> 16; }
__device__ __forceinline__ unsigned pk2(float lo, float hi) { return f2bf(lo) | (f2bf(hi) << 16); }
__device__ __forceinline__ float bflo(unsigned w) { return __uint_as_float(w << 16); }
__device__ __forceinline__ float bfhi(unsigned w) { return __uint_as_float(w & 0xffff0000u); }

#define XB_TMO      128
#define XB_XCNT(j)  (256  + 64 * (j))
#define XB_XSUB(j)  (1280 + 64 * (j))
#define XB_XGEN(j)  (2304 + 64 * (j))
#define XB_TOP      3328
#define XB_TOPGEN   3392
#define XCD_BAR_WORDS 3456
#define XB_SPIN_CAP (1u << 18)
__device__ __forceinline__ unsigned xb_ld(unsigned* p)              { return __hip_atomic_load(p, __ATOMIC_RELAXED, __HIP_MEMORY_SCOPE_AGENT); }
__device__ __forceinline__ unsigned xb_add(unsigned* p, unsigned v) { return __hip_atomic_fetch_add(p, v, __ATOMIC_RELAXED, __HIP_MEMORY_SCOPE_AGENT); }
__device__ __forceinline__ unsigned xb_xcc_id() { return (unsigned)__builtin_amdgcn_s_getreg((3 << 11) | 20) & 0xFu; }
#define XB_SPIN(cond, bar) do { unsigned _sp = 0; while (cond) { __builtin_amdgcn_s_sleep(1); \
    if ((++_sp & 255u) == 0u) { if (xb_ld(&(bar)[XB_TMO])) break; if (_sp > XB_SPIN_CAP) { atomicAdd(&(bar)[XB_TMO], 1u); break; } } } } while (0)
struct XcdBarrier { unsigned* bar; unsigned x; volatile LAS unsigned* st; };
__device__ __forceinline__ XcdBarrier xcd_barrier_post(unsigned* bar, volatile LAS unsigned* st) {
    XcdBarrier b; b.bar = bar; b.x = xb_xcc_id(); b.st = st;
    if (threadIdx.x == 0) (void)xb_add(&bar[XB_XCNT(b.x)], 1u);
    return b;
}
__device__ __forceinline__ void xcd_barrier_complete(unsigned* bar, unsigned x, unsigned& nloc, unsigned& nx) {
    const unsigned G = gridDim.x * gridDim.y * gridDim.z;
    unsigned sum, cnt, mine, sp = 0u;
    for (;;) {
        sum = 0u; cnt = 0u; mine = 0u;
#pragma unroll
        for (unsigned j = 0; j < 16; ++j) { const unsigned c = xb_ld(&bar[XB_XCNT(j)]); sum += c; cnt += (c > 0u) ? 1u : 0u; mine = (j == x) ? c : mine; }
        if (sum == G) break;
        __builtin_amdgcn_s_sleep(1);
        if ((++sp & 255u) == 0u) { if (xb_ld(&bar[XB_TMO])) break; if (sp > XB_SPIN_CAP) { atomicAdd(&bar[XB_TMO], 1u); break; } }
    }
    nloc = mine > 0u ? mine : 1u; nx = cnt > 0u ? cnt : 1u;
}
__device__ __forceinline__ void xcd_barrier(const XcdBarrier& b) {
    asm volatile("s_waitcnt vmcnt(0)" ::: "memory");
    __syncthreads();
    if (threadIdx.x == 0) {
        unsigned* bar = b.bar;
        __builtin_amdgcn_s_waitcnt(0);
        unsigned nloc = b.st[0], nx = b.st[1];
        if (nloc == 0u) { xcd_barrier_complete(bar, b.x, nloc, nx); b.st[0] = nloc; b.st[1] = nx; }
        const unsigned old = xb_add(&bar[XB_XSUB(b.x)], 1u);
        const unsigned gen = old / nloc;
        if (old + 1u == (gen + 1u) * nloc) {
            __builtin_amdgcn_fence(__ATOMIC_RELEASE, "agent");
            asm volatile("s_waitcnt vmcnt(0)" ::: "memory");
            const unsigned og = xb_add(&bar[XB_TOP], 1u);
            const unsigned tg = og / nx;
            if (og + 1u == (tg + 1u) * nx) xb_add(&bar[XB_TOPGEN], 1u);
            else XB_SPIN(xb_ld(&bar[XB_TOPGEN]) == tg, bar);
            __builtin_amdgcn_fence(__ATOMIC_ACQUIRE, "agent");
            xb_add(&bar[XB_XGEN(b.x)], 1u);
            asm volatile("s_waitcnt vmcnt(0)" ::: "memory");
        } else {
            XB_SPIN(xb_ld(&bar[XB_XGEN(b.x)]) == gen, bar);
            __builtin_amdgcn_fence(__ATOMIC_ACQUIRE, "agent");
            asm volatile("s_waitcnt vmcnt(0)" ::: "memory");
        }
    }
    __syncthreads();
}

struct Args {
    const float* in[23]; float* out; unsigned char* ws;
    float invf[32];
    int ph_lo, ph_hi, li, rep;
};
struct Frame {
    LAS unsigned char* lds;
    volatile LAS unsigned* MISC;
    gu32* ctl;
    int tid, lane, wave, G, gw, NGW;
    unsigned char* ws;
};
__device__ __forceinline__ float wave_sum(float v) {
#pragma unroll
    for (int o = 1; o < 64; o <<= 1) v += __shfl_xor(v, o);
    return v;
}
__device__ __forceinline__ float wave_max(float v) {
#pragma unroll
    for (int o = 1; o < 64; o <<= 1) v = fmaxf(v, __shfl_xor(v, o));
    return v;
}

__device__ __forceinline__ unsigned pk4_fp8(float a, float b, float c, float d) { int w = 0; w = __builtin_amdgcn_cvt_pk_fp8_f32(a, b, w, false); w = __builtin_amdgcn_cvt_pk_fp8_f32(c, d, w, true); return (unsigned)w; }
#if defined(CVT_REG) && CVT_REG
__device__ __forceinline__ void cvt_load(const float* __restrict__ W, int N, int k0, int n0, int lane, f32x4 (&v)[8]) {
    const GAS float* p = (const GAS float*)(W + (size_t)(k0 + (lane >> 5) * 32) * N + n0 + (lane & 31));
#pragma unroll
    for (int i = 0; i < 8; ++i)
#pragma unroll
        for (int e = 0; e < 4; ++e) v[i][e] = __builtin_nontemporal_load(p + (size_t)(i * 4 + e) * N);
}
template <bool FP8>
__device__ __forceinline__ void cvt_finish(const f32x4 (&v)[8], int k0, void* __restrict__ dstv, int ldd, int drow0, int kdst0, LAS float* scr, int lane, float wsc) {
    const int n = lane & 31, kh = (lane >> 5) * 32;
    if constexpr (FP8) { GAS v4u* d = (GAS v4u*)((unsigned char*)dstv + (size_t)(drow0 + n) * ldd + kdst0 + k0 + kh);
#pragma unroll
        for (int j = 0; j < 2; ++j) { v4u o;
            o.x = pk4_fp8(v[4 * j][0] * wsc, v[4 * j][1] * wsc, v[4 * j][2] * wsc, v[4 * j][3] * wsc); o.y = pk4_fp8(v[4 * j + 1][0] * wsc, v[4 * j + 1][1] * wsc, v[4 * j + 1][2] * wsc, v[4 * j + 1][3] * wsc);
            o.z = pk4_fp8(v[4 * j + 2][0] * wsc, v[4 * j + 2][1] * wsc, v[4 * j + 2][2] * wsc, v[4 * j + 2][3] * wsc); o.w = pk4_fp8(v[4 * j + 3][0] * wsc, v[4 * j + 3][1] * wsc, v[4 * j + 3][2] * wsc, v[4 * j + 3][3] * wsc);
            __builtin_nontemporal_store(o, d + j); } }
    else { GAS v4u* d = (GAS v4u*)((bf16*)dstv + (size_t)(drow0 + n) * ldd + kdst0 + k0 + kh);
#pragma unroll
        for (int j = 0; j < 4; ++j) { v4u o; o.x = pk2(v[2 * j][0], v[2 * j][1]); o.y = pk2(v[2 * j][2], v[2 * j][3]); o.z = pk2(v[2 * j + 1][0], v[2 * j + 1][1]); o.w = pk2(v[2 * j + 1][2], v[2 * j + 1][3]);
            __builtin_nontemporal_store(o, d + j); } }
}
#else
__device__ __forceinline__ void cvt_load(const float* __restrict__ W, int N, int k0, int n0, int lane, f32x4 (&v)[8]) {
    const int lr = lane >> 3, lc = (lane & 7) * 4;
#pragma unroll
    for (int i = 0; i < 8; ++i) v[i] = __builtin_nontemporal_load((const GAS f32x4*)(W + (size_t)(k0 + i * 8 + lr) * N + n0 + lc));
}
template <bool FP8>
__device__ __forceinline__ void cvt_finish(const f32x4 (&v)[8], int k0, void* __restrict__ dstv, int ldd, int drow0, int kdst0, LAS float* scr, int lane, float wsc) {
    const int lr = lane >> 3, lc = (lane & 7) * 4;
#pragma unroll
    for (int i = 0; i < 8; ++i) { LAS float* s = scr + (i * 8 + lr) * 33 + lc; s[0] = v[i][0]; s[1] = v[i][1]; s[2] = v[i][2]; s[3] = v[i][3]; }
    LDS_WAIT(); asm volatile("" ::: "memory");
    const int c = lane & 7;
#pragma unroll
    for (int j = 0; j < 4; ++j) { const int n = (lane >> 3) + 8 * j; const LAS float* s = scr + (8 * c) * 33 + n;
        if constexpr (FP8) { v2u o; o.x = pk4_fp8(s[0 * 33] * wsc, s[1 * 33] * wsc, s[2 * 33] * wsc, s[3 * 33] * wsc); o.y = pk4_fp8(s[4 * 33] * wsc, s[5 * 33] * wsc, s[6 * 33] * wsc, s[7 * 33] * wsc);
            __builtin_nontemporal_store(o, (GAS v2u*)((unsigned char*)dstv + (size_t)(drow0 + n) * ldd + kdst0 + k0 + 8 * c)); }
        else { v4u o; o.x = pk2(s[0 * 33], s[1 * 33]); o.y = pk2(s[2 * 33], s[3 * 33]); o.z = pk2(s[4 * 33], s[5 * 33]); o.w = pk2(s[6 * 33], s[7 * 33]);
            __builtin_nontemporal_store(o, (GAS v4u*)((bf16*)dstv + (size_t)(drow0 + n) * ldd + kdst0 + k0 + 8 * c)); } }
    LDS_WAIT(); asm volatile("" ::: "memory");
}
#endif
__device__ __forceinline__ int cvt_drow(int mode, int n0, int roff) { return mode == 0 ? n0 + roff : (mode == 1 ? (n0 >> 7) * 256 + (n0 & 127) : (mode == 2 ? (n0 >> 7) * 256 + 128 + (n0 & 127) : (n0 < 576 ? n0 : n0 + 192))); }
template <bool FP8>
__device__ __forceinline__ void cvt_job(Frame& F, const float* W, int K, int N, void* dst, int ldd, int kdst0, int mode, int roff, LAS float* scr, float wsc) {
    const int nnb = N / 32, nitems = (K / 64) * nnb;
    int it = F.gw; if (it >= nitems) return;
    f32x4 va[8], vb[8];
    cvt_load(W, N, (it / nnb) * 64, (it % nnb) * 32, F.lane, va);
    for (;;) {
        const int it1 = it + F.NGW; if (it1 < nitems) cvt_load(W, N, (it1 / nnb) * 64, (it1 % nnb) * 32, F.lane, vb);
        cvt_finish<FP8>(va, (it / nnb) * 64, dst, ldd, cvt_drow(mode, (it % nnb) * 32, roff), kdst0, scr, F.lane, wsc);
        if (it1 >= nitems) break;
        const int it2 = it1 + F.NGW; if (it2 < nitems) cvt_load(W, N, (it2 / nnb) * 64, (it2 % nnb) * 32, F.lane, va);
        cvt_finish<FP8>(vb, (it1 / nnb) * 64, dst, ldd, cvt_drow(mode, (it1 % nnb) * 32, roff), kdst0, scr, F.lane, wsc);
        if (it2 >= nitems) break;
        it = it2;
    }
}
#if defined(XA_BF16) && XA_BF16
typedef unsigned short XT;
#else
typedef float XT;
#endif
__device__ __forceinline__ f32x4 ld_x4(const float* row, int e) { return *(const GAS f32x4*)(row + e); }
__device__ __forceinline__ f32x4 ld_x4(const unsigned short* row, int e) { const v2u w = *(const GAS v2u*)(row + e); return (f32x4){bflo(w.x), bfhi(w.x), bflo(w.y), bfhi(w.y)}; }
template <class TX> __device__ __forceinline__ void rms_row_to_bf16(const TX* xrow, const float* g, bf16* orow, int lane) {
    const GAS f32x4* gr = (const GAS f32x4*)g + lane;
    f32x4 v[8]; float s = 0.f;
#pragma unroll
    for (int j = 0; j < 8; ++j) { v[j] = ld_x4(xrow, (lane + 64 * j) * 4); s += (v[j].x * v[j].x + v[j].y * v[j].y) + (v[j].z * v[j].z + v[j].w * v[j].w); }
    const float rstd = 1.f / sqrtf(wave_sum(s) * (1.f / D) + EPS);
    GAS v2u* o8 = (GAS v2u*)orow + lane;
#pragma unroll
    for (int j = 0; j < 8; ++j) { const f32x4 gg = gr[64 * j]; v2u w; w.x = pk2(v[j].x * rstd * gg.x, v[j].y * rstd * gg.y); w.y = pk2(v[j].z * rstd * gg.z, v[j].w * rstd * gg.w); o8[64 * j] = w; }
}
template <class TX> __device__ __forceinline__ void rms_row_to_fp8(const TX* xrow, const float* g, unsigned char* orow, int lane) {
    const GAS f32x4* gr = (const GAS f32x4*)g + lane;
    f32x4 v[8]; float s = 0.f;
#pragma unroll
    for (int j = 0; j < 8; ++j) { v[j] = ld_x4(xrow, (lane + 64 * j) * 4); s += (v[j].x * v[j].x + v[j].y * v[j].y) + (v[j].z * v[j].z + v[j].w * v[j].w); }
    const float rstd = 1.f / sqrtf(wave_sum(s) * (1.f / D) + EPS);
    GAS unsigned* o4 = (GAS unsigned*)orow + lane;
#pragma unroll
    for (int j = 0; j < 8; ++j) { const f32x4 gg = gr[64 * j]; o4[64 * j] = pk4_fp8(v[j].x * rstd * gg.x, v[j].y * rstd * gg.y, v[j].z * rstd * gg.z, v[j].w * rstd * gg.w); }
}
__device__ __forceinline__ void sincos_f64(float ang, float& c, float& s) {
    const double a = (double)ang, twopi = 6.283185307179586476925286766559, inv2pi = 0.15915494309189533576888376337251;
    const double q = __builtin_rint(a * inv2pi); const double r = a - q * twopi;
    const double r2 = r * r; double ss = 1.0, cc = 1.0;
#pragma unroll
    for (int k = 14; k >= 1; --k) { ss = 1.0 - r2 * (1.0 / (double)((2 * k) * (2 * k + 1))) * ss; cc = 1.0 - r2 * (1.0 / (double)((2 * k - 1) * (2 * k))) * cc; }
    s = (float)(r * ss); c = (float)cc;
}
__device__ const unsigned char DIL_BUCKET[3][129] = {
 {11,11,11,11,11,11,11,11,11,11,11,11,11,11,11,10,10,10,10,10,10,10,10,10,10,10,10,10,10,10,10,10,10,10,10,10,10,10,9,9,9,9,9,9,9,9,9,9,9,9,8,8,8,8,8,8,8,7,6,5,4,3,2,1,0,17,18,19,20,21,22,23,24,24,24,24,24,24,24,25,25,25,25,25,25,25,25,25,25,25,25,26,26,26,26,26,26,26,26,26,26,26,26,26,26,26,26,26,26,26,26,26,26,26,27,27,27,27,27,27,27,27,27,27,27,27,27,27,27},
 {13,13,13,13,13,13,13,13,13,13,13,13,13,13,13,13,13,13,13,13,13,13,13,12,12,12,12,12,12,12,12,12,12,12,12,12,12,12,12,12,12,12,11,11,11,11,11,11,11,11,11,11,10,10,10,10,10,10,9,9,9,8,8,4,0,20,24,24,25,25,25,26,26,26,26,26,26,27,27,27,27,27,27,27,27,27,27,28,28,28,28,28,28,28,28,28,28,28,28,28,28,28,28,28,28,28,29,29,29,29,29,29,29,29,29,29,29,29,29,29,29,29,29,29,29,29,29,29,29},
 {15,15,15,15,15,15,15,15,15,15,15,15,15,15,15,15,15,15,15,15,15,15,15,15,15,15,15,15,15,15,14,14,14,14,14,14,14,14,14,14,14,14,14,14,14,13,13,13,13,13,13,13,13,13,12,12,12,12,12,11,11,10,10,9,0,25,26,26,27,27,28,28,28,28,28,29,29,29,29,29,29,29,29,29,30,30,30,30,30,30,30,30,30,30,30,30,30,30,30,31,31,31,31,31,31,31,31,31,31,31,31,31,31,31,31,31,31,31,31,31,31,31,31,31,31,31,31,31,31}};

typedef float f32x2 __attribute__((ext_vector_type(2)));
#if defined(XA_BF16) && XA_BF16
typedef pg8::EpiResB16 ResEpi;
__device__ __forceinline__ ResEpi make_res(const void* R, bool r32, void* C, float sc) { return ResEpi{R, r32, (unsigned short*)C, D, sc}; }
#else
typedef pg8::EpiResF32 ResEpi;
__device__ __forceinline__ ResEpi make_res(const void* R, bool, void* C, float sc) { return ResEpi{(const float*)R, (float*)C, D, sc}; }
#endif
__device__ __forceinline__ f32x4 ld_o4(const float* p) { return *(const GAS f32x4*)p; }
__device__ __forceinline__ f32x4 ld_o4(const unsigned short* p) { const v2u w = *(const GAS v2u*)p; return (f32x4){bflo(w.x), bfhi(w.x), bflo(w.y), bfhi(w.y)}; }
#ifndef PH_MASK
#define PH_MASK 0xFFFFu
#endif
#ifndef REPEAT_PHASE
#define REPEAT_PHASE -1
#endif
#ifndef ATT_EN
#define ATT_EN 7
#endif
#define PEN(k) ((PH_MASK >> (k)) & 1u)
#ifndef FFN_FP8
#define FFN_FP8 3
#endif
constexpr bool F8D = (FFN_FP8 & 1) != 0, F8M = (FFN_FP8 & 2) != 0;
constexpr int EBD = F8D ? 1 : 2, EBM = F8M ? 1 : 2;
template <bool B> struct Sc { static constexpr float w_gu = B ? 32.f : 1.f, w_dn = B ? 64.f : 1.f, a_sc = B ? 4.f : 1.f, dn = 1.f / (w_dn * a_sc); };
template <bool B> using FfnEpi1 = typename std::conditional<B, pg8::EpiSwiGLU8, pg8::EpiSwiGLU>::type;
template <bool B> struct Epi1Maker;
template <> struct Epi1Maker<true> { static __device__ __forceinline__ pg8::EpiSwiGLU8 make(void* O, int ldc) { return pg8::EpiSwiGLU8{(unsigned char*)O, ldc, 1.f / Sc<true>::w_gu, Sc<true>::a_sc}; } };
template <> struct Epi1Maker<false> { static __device__ __forceinline__ pg8::EpiSwiGLU make(void* O, int ldc) { return pg8::EpiSwiGLU{(unsigned short*)O, ldc}; } };

constexpr int MOE_MAT_ITEMS = 7168, MOE_GU_ITEMS = 16 * MOE_MAT_ITEMS, MOE_NITEMS = 24 * MOE_MAT_ITEMS, MOE_CHUNK = 64, MOE_NCHUNK = MOE_NITEMS / MOE_CHUNK;
struct MoeItem { const float* W; void* dst; int N, k0, n0, ldd, drow0; float wsc; };
typedef const __attribute__((address_space(4))) Args* KArgs;
__device__ __forceinline__ MoeItem moe_item(KArgs ka, unsigned char* ws, int idx) {
    MoeItem m;
    if (idx < MOE_GU_ITEMS) { const int mat = idx / MOE_MAT_ITEMS, local = idx % MOE_MAT_ITEMS, e = mat >> 1, up = mat & 1, kb = local / (DFE / 32), nb = local % (DFE / 32);
        m.W = ka->in[19 + up] + (size_t)e * D * DFE; m.N = DFE; m.k0 = kb * 64; m.n0 = nb * 32; m.dst = ws + WS_MGU + (size_t)e * 2 * DFE * D * EBM; m.ldd = D;
        m.drow0 = (m.n0 >> 7) * 256 + up * 128 + (m.n0 & 127); m.wsc = Sc<F8M>::w_gu; }
    else { const int i2 = idx - MOE_GU_ITEMS, e = i2 / MOE_MAT_ITEMS, local = i2 % MOE_MAT_ITEMS, kb = local / (D / 32), nb = local % (D / 32);
        m.W = ka->in[21] + (size_t)e * DFE * D; m.N = D; m.k0 = kb * 64; m.n0 = nb * 32; m.dst = ws + WS_MDN + (size_t)e * D * DFE * EBM; m.ldd = DFE; m.drow0 = m.n0; m.wsc = Sc<F8M>::w_dn; }
    return m;
}
__device__ __forceinline__ void moe_cvt_chunk(Frame& F, KArgs ka, int c) {
    LAS float* scr = (LAS float*)(F.lds + F.wave * 16384);
    const int i0 = c * MOE_CHUNK + F.wave * 8;
    f32x4 va[8], vb[8], vc[8]; MoeItem ma, mb, mc;
#define MC_L(m, v, i) do { m = moe_item(ka, F.ws, i0 + (i)); cvt_load(m.W, m.N, m.k0, m.n0, F.lane, v); } while (0)
#define MC_F(m, v) cvt_finish<F8M>(v, m.k0, m.dst, m.ldd, m.drow0, 0, scr, F.lane, m.wsc)
    MC_L(ma, va, 0); MC_L(mb, vb, 1); MC_L(mc, vc, 2);
    MC_F(ma, va); MC_L(ma, va, 3); MC_F(mb, vb); MC_L(mb, vb, 4); MC_F(mc, vc); MC_L(mc, vc, 5);
    MC_F(ma, va); MC_L(ma, va, 6); MC_F(mb, vb); MC_L(mb, vb, 7); MC_F(mc, vc); MC_F(ma, va); MC_F(mb, vb);
#undef MC_L
#undef MC_F
}
__device__ __forceinline__ void moe_cvt_fill(Frame& F, KArgs ka, int ph) {
    { int t_ = threadIdx.x; asm volatile("" : "+v"(t_)); F.tid = t_; F.lane = t_ & 63; }
    for (;;) {
        if (F.tid == 0) { unsigned c = MOE_NCHUNK;
            if (ph < 0 || __hip_atomic_load(F.ctl + CW_DONE + ph, RLX_AGENT) < (unsigned)F.G) c = __hip_atomic_fetch_add(F.ctl + CW_CVT + (ph == -2 ? 16 : 0), 1u, RLX_AGENT);
            F.MISC[17] = c; }
        __syncthreads(); const unsigned c = F.MISC[17]; __syncthreads();
        if (c >= (unsigned)MOE_NCHUNK) break;
        moe_cvt_chunk(F, ka, (int)c);
    }
}
#define FILL(ph) do { __syncthreads(); if (F.tid == 0) (void)__hip_atomic_fetch_add(F.ctl + CW_DONE + (ph), 1u, RLX_AGENT); moe_cvt_fill(F, ka, (ph)); } while (0)
#ifndef MLA_DMA
#define MLA_DMA 1
#endif
#ifndef MOE_TAIL
#define MOE_TAIL 1
#endif
#ifndef GEMM_SP2
#define GEMM_SP2 1
#endif
constexpr bool SP2V = (GEMM_SP2 != 0);
#ifndef PROBE_ATT
#define PROBE_ATT 7
#endif
#ifndef FILLMASK
#define FILLMASK 7
#endif
constexpr int PH_PER_LAYER = 11, N_PHASES = 1 + 2 * PH_PER_LAYER;
#ifndef MK_N_LAUNCHES
#define MK_N_LAUNCHES 1
#endif
constexpr int N_LAUNCHES = MK_N_LAUNCHES;

__global__ void __launch_bounds__(NWAVES * 64, 2) mk_fwd(Args) {
    KArgs ka = (KArgs)__builtin_amdgcn_kernarg_segment_ptr(); asm volatile("" : "+s"(ka));
#define args (*ka)
    extern __shared__ __attribute__((aligned(16))) unsigned char lds[];
    Frame F;
    F.lds = (LAS unsigned char*)lds;
    F.MISC = (volatile LAS unsigned*)(F.lds + MISC_OFF);
    F.tid = threadIdx.x; F.lane = F.tid & 63; F.wave = __builtin_amdgcn_readfirstlane(F.tid >> 6);
    F.G = gridDim.x; F.gw = blockIdx.x * NWAVES + F.wave; F.NGW = F.G * NWAVES;
    F.ws = args.ws; F.ctl = (gu32*)(args.ws + WS_CTL);
    unsigned char* ws = args.ws;
    for (int u = F.tid; u < (LDS_BYTES - LDSCTL_OFF) / 4; u += NWAVES * 64) ((LAS unsigned*)(F.lds + LDSCTL_OFF))[u] = 0u;
    __syncthreads();
    XcdBarrier bar; bar.bar = (unsigned*)(F.ctl + CW_BAR) + args.li * 4096; bar.x = 0; bar.st = nullptr;
    if (N_LAUNCHES != N_PHASES) bar = xcd_barrier_post((unsigned*)(F.ctl + CW_BAR) + args.li * 4096, F.MISC + 8);
#define GRID_BAR() do { if (N_LAUNCHES != N_PHASES) xcd_barrier(bar); } while (0)
    const int lo = args.ph_lo, hi = args.ph_hi;
#define IN(k) (lo <= (k) && (k) < hi)
#define BOTH(k) (IN(k) && IN((k) + 1))

#define x_in (args.in[0])
#define XN8 ((unsigned char*)(ws + WS_XN))
#define WIN ((bf16*)(ws + WS_WIN))
#define WUP ((bf16*)(ws + WS_WUP))
#define WMEM ((bf16*)(ws + WS_WMEM))
#define WOUT ((bf16*)(ws + WS_WOUT))
#define WGU ((bf16*)(ws + WS_WGU))
#define WDN ((bf16*)(ws + WS_WDN))
#define MGU ((bf16*)(ws + WS_MGU))
#define MDN ((bf16*)(ws + WS_MDN))
#define XN ((bf16*)(ws + WS_XN))
#define MEMN ((bf16*)(ws + WS_MEMN))
#define MEMKV ((bf16*)(ws + WS_MEMKV))
#define PROJ ((bf16*)(ws + WS_PROJ))
#define AQKV ((bf16*)(ws + WS_AQKV))
#define KROPE ((bf16*)(ws + WS_KROPE))
#define ROPECS ((float*)(ws + WS_ROPECS))
#define QKVM ((bf16*)(ws + WS_QKVM))
#define YPRE ((att::OT*)(ws + WS_YPRE))
#define YPREF ((float*)(ws + WS_YPRE))
#define DILO ((att::OT*)(ws + WS_DILO))
#define DILS ((float*)(ws + WS_DILS))
#define Y ((bf16*)(ws + WS_Y))
#define XA ((XT*)(ws + WS_XA))
#define ROUTE ((unsigned*)(ws + WS_ROUTE))
#define XP ((bf16*)(ws + WS_XP))
#define OUTP ((bf16*)(ws + WS_OUTP))
#define OUTQ ((bf16*)(ws + WS_OUTQ))
#define ACTP ((bf16*)(ws + WS_ACTP))
#define ACT ((bf16*)(ws + WS_ACTP))
#define PHASE_BEGIN() do { int t_ = threadIdx.x; asm volatile("" : "+v"(t_)); F.tid = t_; F.lane = t_ & 63; asm volatile("" : "+s"(ka)); } while (0)

    if (PEN(0) && IN(0)) { PHASE_BEGIN();
        LAS float* scr = (LAS float*)(F.lds + F.wave * 16384);
        { const v4u z = {0u, 0u, 0u, 0u}; const int gt = blockIdx.x * (NWAVES * 64) + F.tid, ngt = F.G * NWAVES * 64;
          for (int l = 0; l < 2; ++l) {
              GAS v4u* w = (GAS v4u*)(WIN + (size_t)l * DINP * D + (size_t)576 * D); for (int i = gt; i < 192 * D / 8; i += ngt) w[i] = z;
              GAS v4u* u = (GAS v4u*)(WUP + (size_t)l * NUP * AQ);
              for (int i = gt; i < NUP * 64; i += ngt) { const int row = i >> 6, c = i & 63; const bool zero = row < 1152 ? (c >= 48) : (row < 1280 ? true : (c < 48)); if (zero) u[i] = z; } } }
        for (int rep = 0; rep < (REPEAT_PHASE == 0 ? 2 : 1); ++rep) {
        for (int l = 0; l < 2; ++l) {
            cvt_job<false>(F, args.in[5] + (size_t)l * D * DIN, D, DIN, WIN + (size_t)l * DINP * D, D, 0, 3, 0, scr, 1.f);
            cvt_job<false>(F, args.in[7] + (size_t)l * QR * 1152, QR, 1152, WUP + (size_t)l * NUP * AQ, AQ, 0, 0, 0, scr, 1.f);
            cvt_job<false>(F, args.in[9] + (size_t)l * KVR * 1536, KVR, 1536, WUP + (size_t)l * NUP * AQ, AQ, QR, 0, UC_KV, scr, 1.f);
            cvt_job<false>(F, args.in[11] + (size_t)l * D * 1024, D, 1024, WMEM + (size_t)l * 1024 * D, D, 0, 0, 0, scr, 1.f);
            cvt_job<false>(F, args.in[13] + (size_t)l * D * D, D, D, WOUT + (size_t)l * D * D, D, 0, 0, 0, scr, 1.f);
        }
        cvt_job<F8D>(F, args.in[15], D, DFF, WGU, D, 0, 1, 0, scr, Sc<F8D>::w_gu);
        cvt_job<F8D>(F, args.in[16], D, DFF, WGU, D, 0, 2, 0, scr, Sc<F8D>::w_gu);
        cvt_job<F8D>(F, args.in[17], DFF, D, WDN, DFF, 0, 0, 0, scr, Sc<F8D>::w_dn);
        }
        { const int* pos = (const int*)args.in[2];
          for (int idx = blockIdx.x * (NWAVES * 64) + F.tid; idx < S * 32; idx += F.G * NWAVES * 64) { const int row = idx >> 5, i = idx & 31;
              const float ang = (float)pos[row] * args.invf[i]; float c, s; sincos_f64(ang, c, s); ROPECS[row * 64 + i] = c; ROPECS[row * 64 + 32 + i] = s; } }
        for (int m = F.gw; m < 2 * NMEM; m += F.NGW) { const int l = m >> 8, r = m & 255; rms_row_to_bf16(args.in[1] + (size_t)r * D, args.in[10] + (size_t)l * D, MEMN + (size_t)m * D, F.lane); }
        for (int m = F.gw; m < S; m += F.NGW) rms_row_to_bf16(x_in + (size_t)m * D, args.in[4], XN + (size_t)m * D, F.lane);
        if (BOTH(0)) GRID_BAR();
    }

    for (int l = 0; l < 2; ++l) {
        const int pb = 1 + l * PH_PER_LAYER;
        if (PEN(1) && IN(pb + 0)) { PHASE_BEGIN();
            { pg8::Gemm g{XN, WIN + (size_t)l * DINP * D, 2 * D, 2 * D, D / 64}; pg8::InProjOrder So; So.so.init(S, DINP, F.G, (int)blockIdx.x); So.nextra = (l == 0) ? 8 : 0; So.A2 = MEMN; So.B2 = WMEM;
              pg8::EpiBf16Sel E{PROJ, DINP, MEMKV, 1024};
              pg8::gemm_phase<pg8::EpiBf16Sel, pg8::InProjOrder, true, SP2V>(F.lds, g, So, E); }
            if (FILLMASK & 1) FILL(pb + 0);
            if (BOTH(pb + 0)) GRID_BAR();
        }
        if (PEN(2) && IN(pb + 1)) { PHASE_BEGIN();
            const float* gq = args.in[6] + l * QR; const float* gkv = args.in[8] + l * KVR;
            for (int m = F.gw; m < S; m += F.NGW) {
                const v4u w = *(const GAS v4u*)(PROJ + (size_t)m * DINP + F.lane * 8);
                float v[8] = {bflo(w.x), bfhi(w.x), bflo(w.y), bfhi(w.y), bflo(w.z), bfhi(w.z), bflo(w.w), bfhi(w.w)};
                float sq = 0.f;
#pragma unroll
                for (int j = 0; j < 8; ++j) sq += v[j] * v[j];
                const float sq_q = wave_sum(F.lane < 48 ? sq : 0.f), sq_kv = wave_sum(F.lane >= 48 ? sq : 0.f);
                const float rstd = F.lane < 48 ? 1.f / sqrtf(sq_q * (1.f / QR) + EPS) : 1.f / sqrtf(sq_kv * (1.f / KVR) + EPS);
                const float* gp = F.lane < 48 ? gq + F.lane * 8 : gkv + (F.lane - 48) * 8;
                const f32x4 g0 = *(const GAS f32x4*)gp, g1 = *(const GAS f32x4*)(gp + 4);
                v4u o; o.x = pk2(v[0] * rstd * g0.x, v[1] * rstd * g0.y); o.y = pk2(v[2] * rstd * g0.z, v[3] * rstd * g0.w);
                o.z = pk2(v[4] * rstd * g1.x, v[5] * rstd * g1.y); o.w = pk2(v[6] * rstd * g1.z, v[7] * rstd * g1.w);
                *(GAS v4u*)(AQKV + (size_t)m * AQ + F.lane * 8) = o;
                const int c = F.lane & 7;
                const v4u kw = *(const GAS v4u*)(PROJ + (size_t)m * DINP + 512 + c * 8);
                float kv[8] = {bflo(kw.x), bfhi(kw.x), bflo(kw.y), bfhi(kw.y), bflo(kw.z), bfhi(kw.z), bflo(kw.w), bfhi(kw.w)};
                float ko[8];
                const float* cs = ROPECS + (size_t)m * 64 + (c & 3) * 8;
#pragma unroll
                for (int j = 0; j < 8; ++j) { const float other = __shfl_xor(kv[j], 4); const float co = cs[j], si = cs[32 + j];
                    ko[j] = (c < 4) ? (kv[j] * co - other * si) : (other * si + kv[j] * co); }
                if (F.lane < 8) { v4u ow; ow.x = pk2(ko[0], ko[1]); ow.y = pk2(ko[2], ko[3]); ow.z = pk2(ko[4], ko[5]); ow.w = pk2(ko[6], ko[7]); *(GAS v4u*)(KROPE + (size_t)m * 64 + c * 8) = ow; }
            }
            if (BOTH(pb + 1)) GRID_BAR();
        }
        if (PEN(3) && IN(pb + 2)) { PHASE_BEGIN();
            pg8::Gemm g{AQKV, WUP + (size_t)l * NUP * AQ, 2 * AQ, 2 * AQ, AQ / 64}; pg8::StaticOrder So; So.init(S, NUP, F.G, (int)blockIdx.x);
            pg8::EpiBf16 E{QKVM, NUP, 1.f};
            pg8::gemm_phase<pg8::EpiBf16, pg8::StaticOrder, true, SP2V>(F.lds, g, So, E);
            if (FILLMASK & 2) FILL(pb + 2);
            if (BOTH(pb + 2)) GRID_BAR();
        }
        if (PEN(4) && IN(pb + 3)) { PHASE_BEGIN();
            LAS float* BIAS = (LAS float*)(F.lds + BIAS_OFF);
            for (int i = F.tid; i < 3 * 6 * 129; i += NWAVES * 64) { const int b = i / (6 * 129), rem = i % (6 * 129), h = rem / 129, j = rem % 129;
                BIAS[(b * 6 + h) * 132 + j] = args.in[3][DIL_BUCKET[b][j] * 6 + h] * att::LOG2E; }
            __syncthreads();
            for (int rep = 0; rep < (REPEAT_PHASE == 4 ? 2 : 1); ++rep) {
            gu32* qhead = F.ctl + CW_QUEUE + 64 * l + 32 * rep + 4 * args.li;
            constexpr int NU_MLA = 6 * 32, NU_MEM = 4 * 32, NU_DIL = 3 * 6 * 32, NU = NU_MLA + NU_MEM + NU_DIL;
#define QPULL(u) do { if (F.tid == 0) F.MISC[16] = __hip_atomic_fetch_add(qhead, 1u, RLX_AGENT); __syncthreads(); u = (int)F.MISC[16]; __syncthreads(); } while (0)
            int u; QPULL(u);
            if ((ATT_EN & 1) && (!args.rep || (PROBE_ATT & 1))) while (u < NU_MLA) {
                const int h = u >> 5, qb = u & 31;
                att::MLA_BODY<NUP, NUP, D>(QKVM + (size_t)qb * 256 * NUP + h * 192, QKVM + UC_KV + h * 256, KROPE, QKVM + UC_KV + h * 256 + 128,
                                                        ROPECS + (size_t)qb * 256 * 64, YPRE + (size_t)qb * 256 * D + h * 128, S, 0.07216878364870322f, (LAS char*)F.lds);
                QPULL(u);
            }
            if (args.rep && !(PROBE_ATT & 1)) { while (u < NU_MLA) QPULL(u); }
            if ((ATT_EN & 2) && (!args.rep || (PROBE_ATT & 2))) while (u < NU_MLA + NU_MEM) {
                const int v = u - NU_MLA, h = v >> 5, qb = v & 31;
                const bf16* kv = MEMKV + (size_t)l * NMEM * 1024;
                att::attn_dense_body<128, DINP, 1024, D, 1>(PROJ + (size_t)qb * 256 * DINP + PC_MEM + h * 128, kv + h * 128, nullptr, kv + 512 + h * 128,
                                                            nullptr, YPRE + (size_t)qb * 256 * D + 1536 + h * 128, NMEM, 0.08838834764831845f, (LAS char*)F.lds);
                QPULL(u);
            }
            if (args.rep && !(PROBE_ATT & 2)) { while (u < NU_MLA + NU_MEM) QPULL(u); }
            if ((ATT_EN & 4) && (!args.rep || (PROBE_ATT & 4))) while (u < NU) {
                const int w = (u - NU_MLA - NU_MEM) * 8;
                const int b = w / 1536, h = (w % 1536) >> 8, tile = w & 255;
                const int d = b == 0 ? 1 : (b == 1 ? 4 : 16), nT = S / d, tpr = nT / 32;
                const int r = tile / tpr, t0 = (tile % tpr) * 32;
                LAS float* TB = (LAS float*)(F.lds + BIAS_OFF + 3 * 6 * 132 * 4);
                for (int i = F.tid; i < 4 * 196; i += NWAVES * 64) { const int k = i / 196, j = (i % 196) + k - 32; TB[i] = (j >= 0 && j <= 128) ? BIAS[(b * 6 + h) * 132 + j] : -1e30f; }
                __syncthreads();
                att::dil_wg_unit<DINP>(PROJ, PC_DIL + h * 128, PC_DIL + 768 + h * 128, PC_DIL + 1536 + h * 128, d, r, t0, nT,
                                       DILO + (size_t)b * S * 768, h * 128, DILS + (size_t)b * S * 12 + h * 2, (LAS char*)F.lds, TB, 0.08838834764831845f * att::LOG2E);
                QPULL(u);
            }
#undef QPULL
            }
            if (FILLMASK & 4) FILL(pb + 3);
            if (BOTH(pb + 3)) GRID_BAR();
        }
        if (PEN(5) && IN(pb + 4)) { PHASE_BEGIN();
            const float* gn = args.in[12] + (size_t)l * D;
            for (int m = F.gw; m < S; m += F.NGW) {
                const att::OT* yr = YPRE + (size_t)m * D;
                f32x4 a[3]; float sa = 0.f;
#pragma unroll
                for (int j = 0; j < 3; ++j) { a[j] = ld_o4(yr + (F.lane + 64 * j) * 4); sa += (a[j].x * a[j].x + a[j].y * a[j].y) + (a[j].z * a[j].z + a[j].w * a[j].w); }
                f32x4 c[2]; float sc = 0.f;
#pragma unroll
                for (int j = 0; j < 2; ++j) { c[j] = ld_o4(yr + 1536 + (F.lane + 64 * j) * 4); sc += (c[j].x * c[j].x + c[j].y * c[j].y) + (c[j].z * c[j].z + c[j].w * c[j].w); }
                f32x4 bq[3]; float sb = 0.f;
#pragma unroll
                for (int j = 0; j < 3; ++j) { const int col = (F.lane + 64 * j) * 4, h = col >> 7;
                    float mm[3], zz[3];
#pragma unroll
                    for (int b = 0; b < 3; ++b) { const f32x2 st = *(const GAS f32x2*)(DILS + ((size_t)b * S + m) * 12 + h * 2); mm[b] = st.x; zz[b] = st.y; }
                    const float M = fmaxf(mm[0], fmaxf(mm[1], mm[2]));
                    float wgt[3], den = 0.f;
#pragma unroll
                    for (int b = 0; b < 3; ++b) { wgt[b] = __builtin_amdgcn_exp2f(mm[b] - M); den += wgt[b] * zz[b]; }
                    const float inv = 1.f / den; f32x4 acc = {0.f, 0.f, 0.f, 0.f};
#pragma unroll
                    for (int b = 0; b < 3; ++b) { const f32x4 ob = ld_o4(DILO + ((size_t)b * S + m) * 768 + col); acc += ob * (wgt[b] * inv); }
                    bq[j] = acc; sb += (acc.x * acc.x + acc.y * acc.y) + (acc.z * acc.z + acc.w * acc.w); }
                const float ra = 1.f / sqrtf(wave_sum(sa) * (1.f / 768.f) + EPS), rb = 1.f / sqrtf(wave_sum(sb) * (1.f / 768.f) + EPS), rc = 1.f / sqrtf(wave_sum(sc) * (1.f / 512.f) + EPS);
                bf16* yo = Y + (size_t)m * D;
#pragma unroll
                for (int j = 0; j < 3; ++j) { const int col = (F.lane + 64 * j) * 4; const f32x4 g = *(const GAS f32x4*)(gn + col);
                    v2u w; w.x = pk2(a[j].x * ra * g.x, a[j].y * ra * g.y); w.y = pk2(a[j].z * ra * g.z, a[j].w * ra * g.w); *(GAS v2u*)(yo + col) = w; }
#pragma unroll
                for (int j = 0; j < 3; ++j) { const int col = (F.lane + 64 * j) * 4; const f32x4 g = *(const GAS f32x4*)(gn + 768 + col);
                    v2u w; w.x = pk2(bq[j].x * rb * g.x, bq[j].y * rb * g.y); w.y = pk2(bq[j].z * rb * g.z, bq[j].w * rb * g.w); *(GAS v2u*)(yo + 768 + col) = w; }
#pragma unroll
                for (int j = 0; j < 2; ++j) { const int col = (F.lane + 64 * j) * 4; const f32x4 g = *(const GAS f32x4*)(gn + 1536 + col);
                    v2u w; w.x = pk2(c[j].x * rc * g.x, c[j].y * rc * g.y); w.y = pk2(c[j].z * rc * g.z, c[j].w * rc * g.w); *(GAS v2u*)(yo + 1536 + col) = w; }
            }
            if (BOTH(pb + 4)) GRID_BAR();
        }
        if (PEN(6) && IN(pb + 5)) { PHASE_BEGIN();
            pg8::Gemm g{Y, WOUT + (size_t)l * D * D, 2 * D, 2 * D, D / 64}; pg8::StaticOrder So; So.init(S, D, F.G, (int)blockIdx.x);
            ResEpi E = make_res(l == 0 ? (const void*)x_in : (const void*)XA, l == 0, args.rep ? (void*)YPREF : (void*)XA, 1.f);
            pg8::gemm_phase<ResEpi, pg8::StaticOrder, true, SP2V>(F.lds, g, So, E);
            if (BOTH(pb + 5)) GRID_BAR();
        }
        if (PEN(7) && IN(pb + 6)) { PHASE_BEGIN();
            const float* gf = args.in[14] + (size_t)l * D;
#if defined(PROBE_DEADLINE)
            if (l == 1 && blockIdx.x == 0 && F.tid == 0) F.ctl[CW_CVT + 16] = __hip_atomic_load(F.ctl + CW_CVT, RLX_AGENT);
#endif
            if (l == 0) { for (int m = F.gw; m < S; m += F.NGW) { if constexpr (F8D) rms_row_to_fp8(XA + (size_t)m * D, gf, XN8 + (size_t)m * D, F.lane); else rms_row_to_bf16(XA + (size_t)m * D, gf, XN + (size_t)m * D, F.lane); } }
            else {
                const float* Wr = args.in[18];
                for (int m = F.gw; m < S; m += F.NGW) {
                    const XT* xrow = XA + (size_t)m * D; const GAS f32x4* gr = (const GAS f32x4*)gf + F.lane;
                    f32x4 v[8]; float s = 0.f;
#pragma unroll
                    for (int j = 0; j < 8; ++j) { v[j] = ld_x4(xrow, (F.lane + 64 * j) * 4); s += (v[j].x * v[j].x + v[j].y * v[j].y) + (v[j].z * v[j].z + v[j].w * v[j].w); }
                    const float rstd = 1.f / sqrtf(wave_sum(s) * (1.f / D) + EPS);
                    float lg[8] = {0.f, 0.f, 0.f, 0.f, 0.f, 0.f, 0.f, 0.f};
                    GAS v2u* o8 = (GAS v2u*)(XN + (size_t)m * D) + F.lane; GAS unsigned* o4 = (GAS unsigned*)(XN8 + (size_t)m * D) + F.lane;
#pragma unroll
                    for (int j = 0; j < 8; ++j) { const f32x4 gg = gr[64 * j]; const f32x4 hh = {v[j].x * rstd * gg.x, v[j].y * rstd * gg.y, v[j].z * rstd * gg.z, v[j].w * rstd * gg.w};
                        if constexpr (F8M) o4[64 * j] = pk4_fp8(hh.x, hh.y, hh.z, hh.w); else { v2u w; w.x = pk2(hh.x, hh.y); w.y = pk2(hh.z, hh.w); o8[64 * j] = w; }
                        const float* wr = Wr + (size_t)((F.lane + 64 * j) * 4) * NE;
#pragma unroll
                        for (int q = 0; q < 4; ++q) { const f32x4 w0 = *(const GAS f32x4*)(wr + q * NE), w1 = *(const GAS f32x4*)(wr + q * NE + 4); const float hv = hh[q];
                            lg[0] += hv * w0.x; lg[1] += hv * w0.y; lg[2] += hv * w0.z; lg[3] += hv * w0.w; lg[4] += hv * w1.x; lg[5] += hv * w1.y; lg[6] += hv * w1.z; lg[7] += hv * w1.w; } }
#pragma unroll
                    for (int e = 0; e < NE; ++e) lg[e] = wave_sum(lg[e]);
                    int e1 = 0; float v1 = lg[0];
#pragma unroll
                    for (int e = 1; e < NE; ++e) if (lg[e] > v1) { v1 = lg[e]; e1 = e; }
                    int e2 = -1; float v2 = -3.0e38f;
#pragma unroll
                    for (int e = 0; e < NE; ++e) if (e != e1 && lg[e] > v2) { v2 = lg[e]; e2 = e; }
                    const float g1 = 1.f / (1.f + __expf(v2 - v1)), g2 = 1.f - g1;
                    if (F.lane == 0) { const unsigned s1 = __hip_atomic_fetch_add(F.ctl + CW_CNT + e1, 1u, RLX_AGENT), s2 = __hip_atomic_fetch_add(F.ctl + CW_CNT + e2, 1u, RLX_AGENT);
                        v4u r0 = {(unsigned)e1, (unsigned)e2, s1, s2}; v4u r1 = {__float_as_uint(g1), __float_as_uint(g2), 0u, 0u};
                        *(GAS v4u*)(ROUTE + (size_t)m * 8) = r0; *(GAS v4u*)(ROUTE + (size_t)m * 8 + 4) = r1; }
                }
            }
            if (BOTH(pb + 6)) GRID_BAR();
        }
        if (PEN(8) && IN(pb + 7)) { PHASE_BEGIN();
            if (l == 1) {
                moe_cvt_fill(F, ka, -1);
#if defined(PROBE_DEADLINE)
                for (int r_ = 0; r_ < PROBE_DEADLINE; ++r_) { __syncthreads(); moe_cvt_fill(F, ka, -2); }
#endif
                int base[NE]; int tstart = 0;
#pragma unroll
                for (int e = 0; e < NE; ++e) { const int c = (int)__hip_atomic_load(F.ctl + CW_CNT + e, RLX_AGENT); base[e] = tstart * 256; const int nt = (c + 255) >> 8;
                    if (blockIdx.x == 0 && F.tid == 0) { for (int t = 0; t < nt; ++t) F.ctl[CW_TILEE + 1 + tstart + t] = (unsigned)e; }
                    tstart += nt; }
                if (blockIdx.x == 0 && F.tid == 0) F.ctl[CW_TILEE] = (unsigned)tstart;
                for (int m = F.gw; m < S; m += F.NGW) {
                    const v4u r0 = *(const GAS v4u*)(ROUTE + (size_t)m * 8);
                    int p1 = (int)r0.z, p2 = (int)r0.w;
#pragma unroll
                    for (int e = 0; e < NE; ++e) { if ((int)r0.x == e) p1 += base[e]; if ((int)r0.y == e) p2 += base[e]; }
                    if (F.lane == 0) { ROUTE[(size_t)m * 8 + 6] = (unsigned)p1; ROUTE[(size_t)m * 8 + 7] = (unsigned)p2; }
                    const unsigned char* srow = (const unsigned char*)XN8 + (size_t)m * D * EBM; unsigned char* xp = (unsigned char*)XP;
                    const GAS v4u* src = (const GAS v4u*)srow + F.lane; GAS v4u* d1 = (GAS v4u*)(xp + (size_t)p1 * D * EBM) + F.lane; GAS v4u* d2 = (GAS v4u*)(xp + (size_t)p2 * D * EBM) + F.lane;
#pragma unroll
                    for (int j = 0; j < 2 * EBM; ++j) { const v4u t = src[64 * j]; d1[64 * j] = t; d2[64 * j] = t; }
                }
            }
            if (BOTH(pb + 7) && l == 1) GRID_BAR();
        }
        if (PEN(9) && IN(pb + 8)) { PHASE_BEGIN();
            if (l == 0) { pg8::Gemm g{XN8, WGU, D * EBD, D * EBD, D * EBD / 128}; pg8::StaticOrder So; So.init(S, 2 * DFF, F.G, (int)blockIdx.x);
                FfnEpi1<F8D> E = Epi1Maker<F8D>::make(ACT, DFF);
                pg8::gemm_phase<FfnEpi1<F8D>, pg8::StaticOrder, true, SP2V, F8D>(F.lds, g, So, E); }
            else { const int ntile = (int)__hip_atomic_load(F.ctl + CW_TILEE, RLX_AGENT);
                pg8::Gemm g{XP, MGU, D * EBM, D * EBM, D * EBM / 128}; pg8::MoeOrder So{F.G, (int)blockIdx.x, 2 * DFE / 256, ntile, 2 * DFE, (const int*)(F.ctl + CW_TILEE + 1)};
                FfnEpi1<F8M> E = Epi1Maker<F8M>::make(ACTP, DFE);
                pg8::gemm_phase<FfnEpi1<F8M>, pg8::MoeOrder, true, SP2V, F8M>(F.lds, g, So, E); }
            if (BOTH(pb + 8)) GRID_BAR();
        }
        if (PEN(10) && IN(pb + 9)) { PHASE_BEGIN();
            if (l == 0) { pg8::Gemm g{ACT, WDN, DFF * EBD, DFF * EBD, DFF * EBD / 128}; pg8::StaticOrder So; So.init(S, D, F.G, (int)blockIdx.x);
                ResEpi E = make_res((const void*)XA, false, args.rep ? (void*)YPREF : (void*)XA, Sc<F8D>::dn);
                pg8::gemm_phase<ResEpi, pg8::StaticOrder, true, SP2V, F8D>(F.lds, g, So, E); }
            else { const int ntile = (int)__hip_atomic_load(F.ctl + CW_TILEE, RLX_AGENT);
                const int pm0 = MOE_TAIL ? ((2 * F.G / 8) < ntile ? (2 * F.G / 8) : ntile) : ntile;
                { pg8::Gemm g{ACTP, MDN, DFE * EBM, DFE * EBM, DFE * EBM / 128}; pg8::MoeOrder So{F.G, (int)blockIdx.x, D / 256, pm0, D, (const int*)(F.ctl + CW_TILEE + 1)};
                  pg8::EpiBf16 E{OUTP, D, Sc<F8M>::dn};
                  pg8::gemm_phase<pg8::EpiBf16, pg8::MoeOrder, true, SP2V, F8M>(F.lds, g, So, E); }
                if (MOE_TAIL && ntile > pm0) { pg8::Gemm g{ACTP, MDN, DFE * EBM, DFE * EBM, DFE * EBM / 512}; pg8::MoeTailOrder So{F.G, (int)blockIdx.x, pm0, ntile - pm0, D, DFE * EBM / 4, (const int*)(F.ctl + CW_TILEE + 1)};
                  pg8::EpiBf16Split E{OUTQ, D, Sc<F8M>::dn, pm0, (size_t)2048 * D};
                  pg8::gemm_phase<pg8::EpiBf16Split, pg8::MoeTailOrder, true, SP2V, F8M>(F.lds, g, So, E); } }
            if (BOTH(pb + 9)) GRID_BAR();
        }
        if (PEN(11) && IN(pb + 10)) { PHASE_BEGIN();
            if (l == 0) { for (int m = F.gw; m < S; m += F.NGW) rms_row_to_bf16(XA + (size_t)m * D, args.in[4] + D, XN + (size_t)m * D, F.lane); }
            else {
                const float* gfin = args.in[22];
                const int ntile_f = (int)__hip_atomic_load(F.ctl + CW_TILEE, RLX_AGENT); const int prow0 = (MOE_TAIL ? ((2 * F.G / 8) < ntile_f ? (2 * F.G / 8) : ntile_f) : ntile_f) * 256;
                for (int m = F.gw; m < S; m += F.NGW) {
                    const v4u r1 = *(const GAS v4u*)(ROUTE + (size_t)m * 8 + 4);
                    const float g1 = __uint_as_float(r1.x), g2 = __uint_as_float(r1.y); const int p1 = (int)r1.z, p2 = (int)r1.w;
                    const XT* xrow = XA + (size_t)m * D;
                    const GAS v2u* o1 = (const GAS v2u*)(OUTP + (size_t)p1 * D) + F.lane; const GAS v2u* o2 = (const GAS v2u*)(OUTP + (size_t)p2 * D) + F.lane;
                    const bool t1 = p1 >= prow0, t2 = p2 >= prow0;
                    const GAS v2u* q1 = (const GAS v2u*)(OUTQ + (size_t)(t1 ? p1 - prow0 : 0) * D) + F.lane; const GAS v2u* q2 = (const GAS v2u*)(OUTQ + (size_t)(t2 ? p2 - prow0 : 0) * D) + F.lane;
                    f32x4 v[8]; float s = 0.f;
#pragma unroll
                    for (int j = 0; j < 8; ++j) { const f32x4 xv = ld_x4(xrow, (F.lane + 64 * j) * 4); f32x4 ea, eb;
                        if (!t1) { const v2u a = o1[64 * j]; ea = (f32x4){bflo(a.x), bfhi(a.x), bflo(a.y), bfhi(a.y)}; }
                        else { ea = (f32x4){0.f, 0.f, 0.f, 0.f};
#pragma unroll
                            for (int k = 0; k < 4; ++k) { const v2u a = q1[(size_t)k * (2048 * D / 4) + 64 * j]; ea += (f32x4){bflo(a.x), bfhi(a.x), bflo(a.y), bfhi(a.y)}; } }
                        if (!t2) { const v2u b = o2[64 * j]; eb = (f32x4){bflo(b.x), bfhi(b.x), bflo(b.y), bfhi(b.y)}; }
                        else { eb = (f32x4){0.f, 0.f, 0.f, 0.f};
#pragma unroll
                            for (int k = 0; k < 4; ++k) { const v2u b = q2[(size_t)k * (2048 * D / 4) + 64 * j]; eb += (f32x4){bflo(b.x), bfhi(b.x), bflo(b.y), bfhi(b.y)}; } }
                        v[j] = xv + ea * g1 + eb * g2;
                        s += (v[j].x * v[j].x + v[j].y * v[j].y) + (v[j].z * v[j].z + v[j].w * v[j].w); }
                    const float rstd = 1.f / sqrtf(wave_sum(s) * (1.f / D) + EPS);
                    GAS f32x4* orow = (GAS f32x4*)(args.out + (size_t)m * D) + F.lane; const GAS f32x4* gr = (const GAS f32x4*)gfin + F.lane;
#pragma unroll
                    for (int j = 0; j < 8; ++j) { const f32x4 gg = gr[64 * j]; orow[64 * j] = (f32x4){v[j].x * rstd * gg.x, v[j].y * rstd * gg.y, v[j].z * rstd * gg.z, v[j].w * rstd * gg.w}; }
                }
            }
            if (BOTH(pb + 10) && l == 0) GRID_BAR();
        }
    }
#undef IN
#undef BOTH
#undef GRID_BAR
#undef WIN
#undef WUP
#undef WMEM
#undef WOUT
#undef WGU
#undef WDN
#undef MGU
#undef MDN
#undef XN
#undef MEMN
#undef MEMKV
#undef PROJ
#undef AQKV
#undef KROPE
#undef ROPECS
#undef QKVM
#undef YPRE
#undef YPREF
#undef DILO
#undef DILS
#undef Y
#undef XA
#undef ROUTE
#undef XP
#undef OUTP
#undef OUTQ
#undef ACTP
#undef ACT
#undef x_in
#undef XN8
#undef PHASE_BEGIN
#undef args
#undef FILL
}

extern "C" void kernel_launch(void* const* d_in, const int* in_sizes, int n_in, void* d_out, int out_size, void* d_ws, size_t ws_size, hipStream_t stream) {
    static int grid = 0;
    if (grid == 0) {
        if (n_in != 23 || in_sizes[0] != S * D || out_size != S * D || ws_size < WS_END) { fprintf(stderr, "kernel_launch: shape/workspace mismatch: n_in %d in0 %d out %d ws %zu (need %zu)\n", n_in, n_in > 0 ? in_sizes[0] : -1, out_size, ws_size, (size_t)WS_END); grid = -1; return; }
        int dev = 0, cus = 0, per_cu = 0;
        if (hipGetDevice(&dev) != hipSuccess || hipDeviceGetAttribute(&cus, hipDeviceAttributeMultiprocessorCount, dev) != hipSuccess) { fprintf(stderr, "kernel_launch: device query failed\n"); grid = -1; return; }
        if (hipFuncSetAttribute((const void*)mk_fwd, hipFuncAttributeMaxDynamicSharedMemorySize, LDS_BYTES) != hipSuccess) { fprintf(stderr, "kernel_launch: hipFuncSetAttribute failed\n"); grid = -1; return; }
        if (hipOccupancyMaxActiveBlocksPerMultiprocessor(&per_cu, (const void*)mk_fwd, NWAVES * 64, LDS_BYTES) != hipSuccess || per_cu < 1) { fprintf(stderr, "kernel_launch: occupancy query reports %d workgroups per CU\n", per_cu); }
        (void)hipGetLastError();
        grid = cus;
    }
    if (grid < 0) return;
    (void)hipMemsetAsync((char*)d_ws + WS_CTL, 0, CTL_ZERO_BYTES, stream);
    Args a{};
    for (int i = 0; i < 23; ++i) a.in[i] = (const float*)d_in[i];
    a.out = (float*)d_out; a.ws = (unsigned char*)d_ws;
    for (int i = 0; i < 32; ++i) a.invf[i] = 1.0f / powf(10000.0f, (float)i / 32.0f);
    int lo[8], hi[8], rp[8], nl = 0;
#if defined(PROBE_PHASE) && PROBE_PHASE >= 0
    lo[nl] = 0; hi[nl] = PROBE_PHASE + 1; rp[nl++] = 0;
    for (int r = 0; r < PROBE_REPS; ++r) { lo[nl] = PROBE_PHASE; hi[nl] = PROBE_PHASE + 1; rp[nl++] = 1; }
    if (PROBE_PHASE + 1 < N_PHASES) { lo[nl] = PROBE_PHASE + 1; hi[nl] = N_PHASES; rp[nl++] = 0; }
#else
    if (N_LAUNCHES == N_PHASES) { nl = 0; } else { lo[0] = 0; hi[0] = N_PHASES; rp[0] = 0; nl = 1; }
#endif
    const int total = (N_LAUNCHES == N_PHASES) ? N_PHASES : nl;
    for (int li = 0; li < total; ++li) {
        if (N_LAUNCHES == N_PHASES) { a.ph_lo = li; a.ph_hi = li + 1; a.li = 0; a.rep = 0; } else { a.ph_lo = lo[li]; a.ph_hi = hi[li]; a.li = li; a.rep = rp[li]; }
        hipLaunchKernelGGL(mk_fwd, dim3(grid), dim3(NWAVES * 64), LDS_BYTES, stream, a);
        const hipError_t le = hipPeekAtLastError();
        if (le != hipSuccess) { fprintf(stderr, "kernel_launch: launch %d failed: %s\n", li, hipGetErrorName(le)); break; }
    }
}
```

```cpp
#include <hip/hip_runtime.h>
#include <cstdio>
#include <cstdint>
#include <cmath>
#include <type_traits>
#ifndef MK_N_LAUNCHES
#define MK_N_LAUNCHES 1
#endif
#define REPEAT_PHASE -1
#define FFN_FP8 3
#define PROBE_PHASE -1
#define PROBE_REPS 3
#define FILLMASK 5
#define MLA_DMA 0
#define PROBE_ATT 7
#define GEMM_SP2 1
#define EARLY_Q 1
#define CVT_CHUNK 32
#define CONV_WGS 1
#define NCV_G 28
#define NCV_U 64
#define NCV_T 64
#define NCV_A 48
#define XA_BF16 0
#define ATT_OBF16 1
#define MOE_TAIL 1
#define CVT_REG 0
#define CVT_BYTE_T 1
#define CVT_FIRST 1
#define CVT_Q0 8
namespace pg8 {
#define PG8_LAS __attribute__((address_space(3)))
typedef unsigned short bf16_t;
typedef short bf16x8 __attribute__((ext_vector_type(8)));
typedef float f32x4 __attribute__((ext_vector_type(4)));
typedef unsigned u32x4 __attribute__((ext_vector_type(4)));
constexpr int BM = 256, BK = 64, HALF = 128, HTB = HALF * BK * 2  , STAGE_BYTES = 8 * HTB, NXCD = 8, WGM = 8;

__host__ __device__ __forceinline__ int lds_byte(int r, int c) { const int st = (r >> 4) * 2 + (c >> 5), rr = r & 15, cc = c & 31, ob = rr * 64 + cc * 2; return st * 1024 + (ob ^ (((ob >> 9) & 1) << 5)); }
__host__ __device__ __forceinline__ void stage_rc(int b, int& R, int& C) { const int st = b / 1024, sb = b % 1024, swz = sb ^ (((sb >> 9) & 1) << 5); R = (st >> 1) * 16 + swz / 64; C = (st & 1) * 32 + (swz % 64) / 2; }
__host__ __device__ __forceinline__ int perm32(int rho) { const int n = rho >> 4, i = rho & 15; return 8 * (i >> 2) + 4 * n + (i & 3); }

struct Unit { int pm, pn; };
struct Gemm { const void* A; const void* Bt; int lda, ldb, nt; };

struct StaticOrder {
    int nM, nN, nwg, G, c;
    __device__ void init(int M, int N, int G_, int c_) { nM = M / BM; nN = N / BM; nwg = nM * nN; G = G_; c = c_; }
    __device__ bool next(int i, Unit& u) const {
        const long L = (long)i * G + c; if (L >= nwg) return false;
        int wgid = (int)L; { const int q = nwg / NXCD, r = nwg % NXCD, xcd = wgid % NXCD, off = wgid / NXCD; wgid = (xcd < r ? xcd * (q + 1) : r * (q + 1) + (xcd - r) * q) + off; }
        const int nig = WGM * nN, gid = wgid / nig, fm = gid * WGM, gsz = (nM - fm) < WGM ? (nM - fm) : WGM;
        u.pm = fm + ((wgid % nig) % gsz); u.pn = (wgid % nig) / gsz; return true;
    }
    __device__ __forceinline__ const char* abase(const Gemm& g, const Unit& u) const { return (const char*)g.A + (size_t)u.pm * BM * g.lda; }
    __device__ __forceinline__ const char* bbase(const Gemm& g, const Unit& u) const { return (const char*)g.Bt + (size_t)u.pn * BM * g.ldb; }
};
struct InProjOrder {
    StaticOrder so; int nextra; const void* A2; const void* B2;
    __device__ bool next(int i, Unit& u) const { if (so.next(i, u)) return true; const long L = (long)i * so.G + so.c - so.nwg; if (L < 0 || L >= nextra) return false; u.pm = 32 + (int)(L >> 2); u.pn = (int)(L & 3); return true; }
    __device__ __forceinline__ const char* abase(const Gemm& g, const Unit& u) const { return u.pm < 32 ? (const char*)g.A + (size_t)u.pm * BM * g.lda : (const char*)A2 + (size_t)(u.pm - 32) * BM * g.lda; }
    __device__ __forceinline__ const char* bbase(const Gemm& g, const Unit& u) const { return u.pm < 32 ? (const char*)g.Bt + (size_t)u.pn * BM * g.ldb : (const char*)B2 + (size_t)((u.pm - 32) * 1024 + u.pn * BM) * g.ldb; }
};
struct MemOrder {
    int G, c;
    __device__ bool next(int i, Unit& u) const { const int L = c - (G - 8); if (i != 0 || L < 0 || L >= 8) return false; u.pm = L >> 2; u.pn = L & 3; return true; }
    __device__ __forceinline__ const char* abase(const Gemm& g, const Unit& u) const { return (const char*)g.A + (size_t)u.pm * BM * g.lda; }
    __device__ __forceinline__ const char* bbase(const Gemm& g, const Unit& u) const { return (const char*)g.Bt + (size_t)(u.pm * 1024 + u.pn * BM) * g.ldb; }
};
struct MoeOrder {
    int G, c, nN, ntile, nexp_rows; const int* tile_e;
    __device__ bool next(int i, Unit& u) const { const long L = (long)i * G + c; if (L >= (long)ntile * nN) return false; u.pm = (int)(L / nN); u.pn = (int)(L % nN); return true; }
    __device__ __forceinline__ const char* abase(const Gemm& g, const Unit& u) const { return (const char*)g.A + (size_t)u.pm * BM * g.lda; }
    __device__ __forceinline__ const char* bbase(const Gemm& g, const Unit& u) const { const int e = __builtin_amdgcn_readfirstlane(tile_e[u.pm]); return (const char*)g.Bt + ((size_t)e * nexp_rows + (size_t)u.pn * BM) * g.ldb; }
};

struct MoeTailOrder {
    int G, c, pm0, ntail, nexp_rows, kq_bytes; const int* tile_e;
    __device__ bool next(int i, Unit& u) const { const long L = (long)i * G + c; if (L >= (long)ntail * 32) return false; const int ks = (int)(L & 3), rest = (int)(L >> 2); u.pm = pm0 + (rest >> 3); u.pn = (rest & 7) + 8 * ks; return true; }
    __device__ __forceinline__ const char* abase(const Gemm& g, const Unit& u) const { return (const char*)g.A + (size_t)u.pm * BM * g.lda + (size_t)(u.pn >> 3) * kq_bytes; }
    __device__ __forceinline__ const char* bbase(const Gemm& g, const Unit& u) const { const int e = __builtin_amdgcn_readfirstlane(tile_e[u.pm]); return (const char*)g.Bt + ((size_t)e * nexp_rows + (size_t)(u.pn & 7) * BM) * g.ldb + (size_t)(u.pn >> 3) * kq_bytes; }
};

__device__ __forceinline__ unsigned cvt_pk_bf16(float lo, float hi) { unsigned r; asm volatile("v_cvt_pk_bf16_f32 %0, %1, %2" : "=v"(r) : "v"(lo), "v"(hi)); return r; }

struct EpiBf16 {
    static constexpr bool PERM = true;
    bf16_t* O; int ldc; float sc;
    __device__ __forceinline__ void operator()(const f32x4 (&acc)[2][2][4][2], const Unit& u, int wr, int wc, int fr, int fq) const {
        const int row0 = u.pm * BM + wr * 64 + fr, col0 = u.pn * BM + wc * 32 + 8 * fq;
#pragma unroll
        for (int ai = 0; ai < 2; ++ai)
#pragma unroll
            for (int m = 0; m < 4; ++m) { bf16_t* rowp = O + (size_t)(row0 + ai * HALF + m * 16) * ldc + col0;
#pragma unroll
                for (int bj = 0; bj < 2; ++bj) { const f32x4 v0 = acc[ai][bj][m][0] * sc, v1 = acc[ai][bj][m][1] * sc;
                    u32x4 w; w.x = cvt_pk_bf16(v0[0], v0[1]); w.y = cvt_pk_bf16(v0[2], v0[3]); w.z = cvt_pk_bf16(v1[0], v1[1]); w.w = cvt_pk_bf16(v1[2], v1[3]);
                    *(u32x4*)(rowp + bj * HALF) = w; } }
    }
};
struct EpiBf16Split {
    static constexpr bool PERM = true;
    bf16_t* O; int ldc; float sc; int pm0; size_t qstride;
    __device__ __forceinline__ void operator()(const f32x4 (&acc)[2][2][4][2], const Unit& u, int wr, int wc, int fr, int fq) const {
        const int row0 = (u.pm - pm0) * BM + wr * 64 + fr, col0 = (u.pn & 7) * BM + wc * 32 + 8 * fq; bf16_t* base = O + (size_t)(u.pn >> 3) * qstride;
#pragma unroll
        for (int ai = 0; ai < 2; ++ai)
#pragma unroll
            for (int m = 0; m < 4; ++m) { bf16_t* rowp = base + (size_t)(row0 + ai * HALF + m * 16) * ldc + col0;
#pragma unroll
                for (int bj = 0; bj < 2; ++bj) { const f32x4 v0 = acc[ai][bj][m][0] * sc, v1 = acc[ai][bj][m][1] * sc;
                    u32x4 w; w.x = cvt_pk_bf16(v0[0], v0[1]); w.y = cvt_pk_bf16(v0[2], v0[3]); w.z = cvt_pk_bf16(v1[0], v1[1]); w.w = cvt_pk_bf16(v1[2], v1[3]);
                    *(u32x4*)(rowp + bj * HALF) = w; } }
    }
};
struct EpiBf16Sel {
    static constexpr bool PERM = true;
    bf16_t* O; int ldc; bf16_t* O2; int ldc2;
    __device__ __forceinline__ void operator()(const f32x4 (&acc)[2][2][4][2], const Unit& u, int wr, int wc, int fr, int fq) const {
        const bool ex = u.pm >= 32; bf16_t* base = ex ? O2 : O; const int ld = ex ? ldc2 : ldc;
        const int row0 = (ex ? u.pm - 32 : u.pm) * BM + wr * 64 + fr, col0 = u.pn * BM + wc * 32 + 8 * fq;
#pragma unroll
        for (int ai = 0; ai < 2; ++ai)
#pragma unroll
            for (int m = 0; m < 4; ++m) { bf16_t* rowp = base + (size_t)(row0 + ai * HALF + m * 16) * ld + col0;
#pragma unroll
                for (int bj = 0; bj < 2; ++bj) { const f32x4 v0 = acc[ai][bj][m][0], v1 = acc[ai][bj][m][1];
                    u32x4 w; w.x = cvt_pk_bf16(v0[0], v0[1]); w.y = cvt_pk_bf16(v0[2], v0[3]); w.z = cvt_pk_bf16(v1[0], v1[1]); w.w = cvt_pk_bf16(v1[2], v1[3]);
                    *(u32x4*)(rowp + bj * HALF) = w; } }
    }
};
struct EpiResF32 {
    static constexpr bool PERM = false;
    const float* R; float* C; int ldc; float sc;
    __device__ __forceinline__ void operator()(const f32x4 (&acc)[2][2][4][2], const Unit& u, int wr, int wc, int fr, int fq) const {
        const int row0 = u.pm * BM + wr * 64 + fr, col0 = u.pn * BM + wc * 32 + 4 * fq;
#pragma unroll
        for (int ai = 0; ai < 2; ++ai)
#pragma unroll
            for (int m = 0; m < 4; ++m) { const size_t off = (size_t)(row0 + ai * HALF + m * 16) * ldc + col0;
#pragma unroll
                for (int bj = 0; bj < 2; ++bj)
#pragma unroll
                    for (int n = 0; n < 2; ++n) { const f32x4 r = *(const f32x4*)(R + off + bj * HALF + n * 16); *(f32x4*)(C + off + bj * HALF + n * 16) = r + acc[ai][bj][m][n] * sc; } }
    }
};
__device__ __forceinline__ float silu_mul(float g, float u) { return g * u * __builtin_amdgcn_rcpf(1.0f + __builtin_amdgcn_exp2f(-1.4426950408889634f * g)); }
struct EpiSwiGLU {
    static constexpr bool PERM = true;
    bf16_t* O; int ldc;
    __device__ __forceinline__ void operator()(const f32x4 (&acc)[2][2][4][2], const Unit& u, int wr, int wc, int fr, int fq) const {
        const int row0 = u.pm * BM + wr * 64 + fr, col0 = u.pn * HALF + wc * 32 + 8 * fq;
#pragma unroll
        for (int ai = 0; ai < 2; ++ai)
#pragma unroll
            for (int m = 0; m < 4; ++m) { bf16_t* rowp = O + (size_t)(row0 + ai * HALF + m * 16) * ldc + col0;
                const f32x4 g0 = acc[ai][0][m][0], g1 = acc[ai][0][m][1], u0 = acc[ai][1][m][0], u1 = acc[ai][1][m][1];
                u32x4 w; w.x = cvt_pk_bf16(silu_mul(g0[0], u0[0]), silu_mul(g0[1], u0[1])); w.y = cvt_pk_bf16(silu_mul(g0[2], u0[2]), silu_mul(g0[3], u0[3]));
                w.z = cvt_pk_bf16(silu_mul(g1[0], u1[0]), silu_mul(g1[1], u1[1])); w.w = cvt_pk_bf16(silu_mul(g1[2], u1[2]), silu_mul(g1[3], u1[3]));
                *(u32x4*)rowp = w; }
    }
};

typedef int v8i_t __attribute__((ext_vector_type(8)));
__device__ __forceinline__ v8i_t pg8_cat(bf16x8 lo, bf16x8 hi) { typedef int v4i_t __attribute__((ext_vector_type(4))); const v4i_t a = __builtin_bit_cast(v4i_t, lo), b = __builtin_bit_cast(v4i_t, hi); return (v8i_t){a.x, a.y, a.z, a.w, b.x, b.y, b.z, b.w}; }
struct EpiSwiGLU8 {
    static constexpr bool PERM = true;
    unsigned char* O; int ldc; float sc_in, sc_out;
    __device__ __forceinline__ void operator()(const f32x4 (&acc)[2][2][4][2], const Unit& u, int wr, int wc, int fr, int fq) const {
        const int row0 = u.pm * BM + wr * 64 + fr, col0 = u.pn * HALF + wc * 32 + 8 * fq;
#pragma unroll
        for (int ai = 0; ai < 2; ++ai)
#pragma unroll
            for (int m = 0; m < 4; ++m) { unsigned char* rowp = O + (size_t)(row0 + ai * HALF + m * 16) * ldc + col0;
                const f32x4 g0 = acc[ai][0][m][0] * sc_in, g1 = acc[ai][0][m][1] * sc_in, u0 = acc[ai][1][m][0] * (sc_in * sc_out), u1 = acc[ai][1][m][1] * (sc_in * sc_out);
                int w0 = 0, w1 = 0;
                w0 = __builtin_amdgcn_cvt_pk_fp8_f32(silu_mul(g0[0], u0[0]), silu_mul(g0[1], u0[1]), w0, false); w0 = __builtin_amdgcn_cvt_pk_fp8_f32(silu_mul(g0[2], u0[2]), silu_mul(g0[3], u0[3]), w0, true);
                w1 = __builtin_amdgcn_cvt_pk_fp8_f32(silu_mul(g1[0], u1[0]), silu_mul(g1[1], u1[1]), w1, false); w1 = __builtin_amdgcn_cvt_pk_fp8_f32(silu_mul(g1[2], u1[2]), silu_mul(g1[3], u1[3]), w1, true);
                typedef int v2i_t __attribute__((ext_vector_type(2))); *(v2i_t*)rowp = (v2i_t){w0, w1}; }
    }
};
__device__ __forceinline__ void pg8_mfma8(f32x4& c, v8i_t a, v8i_t b, int sc) { asm volatile("v_mfma_scale_f32_16x16x128_f8f6f4 %0, %1, %2, %0, %3, %3 op_sel_hi:[0,0,0]" : "+v"(c) : "v"(a), "v"(b), "v"(sc)); }
template <class Epi, class Sched, bool ALIGN_EPI = false, bool SP2 = false, bool FP8 = false>
__device__ __forceinline__ void gemm_phase(PG8_LAS unsigned char* lds, const Gemm g, const Sched& S, const Epi& E) {
    int tid_ = threadIdx.x; asm volatile("" : "+v"(tid_));
    const int tid = tid_, wid = __builtin_amdgcn_readfirstlane(tid >> 6), lane = tid & 63, wr = wid >> 2, wc = wid & 3, fr = lane & 15, fq = lane >> 4;
    const int nt = g.nt;
    unsigned voffA[2], voffB[2];
#pragma unroll
    for (int i = 0; i < 2; ++i) { int R, C; stage_rc(tid * 16 + i * 8192, R, C); const int Rb = Epi::PERM ? ((R & ~31) + perm32(R & 31)) : R;
        voffA[i] = (unsigned)(R * g.lda + C * 2); voffB[i] = (unsigned)(Rb * g.ldb + C * 2); }
    const size_t kstep = (size_t)(BK * 2);
    const size_t hstepA = (size_t)HALF * g.lda, hstepB = (size_t)HALF * g.ldb;
    const unsigned ldsw = (unsigned)wid * 1024u;
    const int aoff = lds_byte(wr * 64 + fr, fq * 8), boff = lds_byte(wc * 32 + fr, fq * 8);
#define PG8_SA(b, h) (((b) * 2 + (h)) * HTB)
#define PG8_SB(b, h) ((4 + (b) * 2 + (h)) * HTB)
#define PG8_STAGE(bufoff, gbase, voff) do { _Pragma("unroll") for (int _i = 0; _i < 2; ++_i) \
        __builtin_amdgcn_global_load_lds((const unsigned*)((const char*)(gbase) + (voff)[_i]), (PG8_LAS unsigned*)(lds + (bufoff) + ldsw + _i * 8192), 16, 0, 0); } while (0)
#define PG8_LDA(dst, b, h) do { _Pragma("unroll") for (int m = 0; m < 4; ++m) _Pragma("unroll") for (int k = 0; k < 2; ++k) dst[m][k] = *(const PG8_LAS bf16x8*)(lds + PG8_SA(b, h) + aoff + m * 2048 + k * 1024); } while (0)
#define PG8_LDB(dst, b, h) do { _Pragma("unroll") for (int n = 0; n < 2; ++n) _Pragma("unroll") for (int k = 0; k < 2; ++k) dst[n][k] = *(const PG8_LAS bf16x8*)(lds + PG8_SB(b, h) + boff + n * 2048 + k * 1024); } while (0)
#define PG8_MMA(ai, bj, At, Bt) do { __builtin_amdgcn_s_setprio(1); if constexpr (FP8) { _Pragma("unroll") for (int m = 0; m < 4; ++m) _Pragma("unroll") for (int n = 0; n < 2; ++n) \
        pg8_mfma8(acc[ai][bj][m][n], pg8_cat(Bt[n][0], Bt[n][1]), pg8_cat(At[m][0], At[m][1]), sc8); } else { \
        _Pragma("unroll") for (int m = 0; m < 4; ++m) _Pragma("unroll") for (int n = 0; n < 2; ++n) _Pragma("unroll") for (int k = 0; k < 2; ++k) \
        acc[ai][bj][m][n] = __builtin_amdgcn_mfma_f32_16x16x32_bf16(Bt[n][k], At[m][k], acc[ai][bj][m][n], 0, 0, 0); } __builtin_amdgcn_s_setprio(0); } while (0)
#define PG8_WAIT_V(n) asm volatile("s_waitcnt vmcnt(" #n ")" ::: "memory")
#define PG8_WAIT_L(n) asm volatile("s_waitcnt lgkmcnt(" #n ")" ::: "memory")
#define PG8_BAR __builtin_amdgcn_s_barrier()
#define PG8_SCHED __builtin_amdgcn_sched_barrier(0)
    Unit cur, nxt; int ui = 0;
    if (!S.next(0, cur)) return;
    int sc8 = 0x7F7F7F7F; asm volatile("" : "+v"(sc8));
    f32x4 acc[2][2][4][2];
#pragma unroll
    for (int a = 0; a < 2; ++a)
#pragma unroll
        for (int b = 0; b < 2; ++b)
#pragma unroll
            for (int m = 0; m < 4; ++m)
#pragma unroll
                for (int n = 0; n < 2; ++n) acc[a][b][m][n] = (f32x4){0.f, 0.f, 0.f, 0.f};
    bf16x8 At[4][2], B0[2][2], B1[2][2];
    const char* cA = S.abase(g, cur); const char* cB = S.bbase(g, cur);
    if constexpr (SP2) {
        PG8_STAGE(PG8_SB(0, 0), cB, voffB); PG8_STAGE(PG8_SB(0, 1), cB + hstepB, voffB); PG8_STAGE(PG8_SA(0, 0), cA, voffA); PG8_STAGE(PG8_SA(0, 1), cA + hstepA, voffA);
        if (wr == 1) PG8_BAR;
        PG8_WAIT_V(2); PG8_BAR;
        PG8_STAGE(PG8_SB(1, 0), cB + kstep, voffB); PG8_STAGE(PG8_SA(1, 0), cA + kstep, voffA); PG8_STAGE(PG8_SB(1, 1), cB + hstepB + kstep, voffB);
        PG8_WAIT_V(6); PG8_BAR;
    } else {
        PG8_STAGE(PG8_SB(0, 0), cB, voffB); PG8_STAGE(PG8_SA(0, 0), cA, voffA); PG8_STAGE(PG8_SB(0, 1), cB + hstepB, voffB); PG8_STAGE(PG8_SA(0, 1), cA + hstepA, voffA);
        if (wr == 1) PG8_BAR;
        PG8_WAIT_V(4); PG8_BAR;
        PG8_STAGE(PG8_SB(1, 0), cB + kstep, voffB); PG8_STAGE(PG8_SA(1, 0), cA + kstep, voffA); PG8_STAGE(PG8_SB(1, 1), cB + hstepB + kstep, voffB);
        PG8_WAIT_V(6); PG8_BAR;
    }
    for (;;) {
        const bool has_next = S.next(ui + 1, nxt);
        const char* nA = has_next ? S.abase(g, nxt) : cA; const char* nB = has_next ? S.bbase(g, nxt) : cB;
        for (int t = 0; t < nt; t += 2) {
            const bool last = (t == nt - 2);
            const char* a1 = cA + (size_t)(t + 1) * kstep;
            const char* a2 = last ? nA : cA + (size_t)(t + 2) * kstep; const char* b2 = last ? nB : cB + (size_t)(t + 2) * kstep;
            const char* a3 = a2 + kstep; const char* b3 = b2 + kstep;
            if constexpr (SP2) {
            PG8_LDB(B0, 0, 0); PG8_LDB(B1, 0, 1); PG8_SCHED; PG8_LDA(At, 0, 0); PG8_STAGE(PG8_SA(1, 1), a1 + hstepA, voffA);
            PG8_WAIT_V(8); PG8_WAIT_L(0); PG8_BAR; PG8_MMA(0, 0, At, B0); PG8_MMA(0, 1, At, B1); PG8_BAR; PG8_SCHED;
            PG8_LDA(At, 0, 1); PG8_STAGE(PG8_SB(0, 0), b2, voffB); PG8_STAGE(PG8_SB(0, 1), b2 + hstepB, voffB); PG8_STAGE(PG8_SA(0, 0), a2, voffA);
            PG8_WAIT_V(8); PG8_WAIT_L(0); PG8_BAR; PG8_MMA(1, 0, At, B0); PG8_MMA(1, 1, At, B1); PG8_BAR; PG8_SCHED;
            PG8_LDB(B0, 1, 0); PG8_LDB(B1, 1, 1); PG8_SCHED; PG8_LDA(At, 1, 0); PG8_STAGE(PG8_SA(0, 1), a2 + hstepA, voffA);
            PG8_WAIT_V(8); PG8_WAIT_L(0); PG8_BAR; PG8_MMA(0, 0, At, B0); PG8_MMA(0, 1, At, B1); PG8_BAR; PG8_SCHED;
            PG8_LDA(At, 1, 1); PG8_STAGE(PG8_SB(1, 0), b3, voffB); PG8_STAGE(PG8_SB(1, 1), b3 + hstepB, voffB); PG8_STAGE(PG8_SA(1, 0), a3, voffA);
            PG8_WAIT_V(8); PG8_WAIT_L(0); PG8_BAR; PG8_MMA(1, 0, At, B0); PG8_MMA(1, 1, At, B1); PG8_BAR; PG8_SCHED;
            } else {
            PG8_LDB(B0, 0, 0); PG8_SCHED; PG8_LDA(At, 0, 0); PG8_STAGE(PG8_SA(1, 1), a1 + hstepA, voffA);
            PG8_WAIT_L(8); PG8_BAR; PG8_WAIT_L(0); PG8_MMA(0, 0, At, B0); PG8_BAR; PG8_SCHED;
            PG8_LDB(B1, 0, 1); PG8_STAGE(PG8_SB(0, 0), b2, voffB);
            PG8_BAR; PG8_WAIT_L(0); PG8_MMA(0, 1, At, B1); PG8_BAR;
            PG8_LDA(At, 0, 1); PG8_STAGE(PG8_SA(0, 0), a2, voffA);
            PG8_BAR; PG8_WAIT_L(0); PG8_MMA(1, 0, At, B0); PG8_BAR; PG8_SCHED;
            PG8_STAGE(PG8_SB(0, 1), b2 + hstepB, voffB);
            PG8_WAIT_V(6); PG8_BAR; PG8_MMA(1, 1, At, B1); PG8_BAR;
            PG8_LDB(B0, 1, 0); PG8_SCHED; PG8_LDA(At, 1, 0); PG8_STAGE(PG8_SA(0, 1), a2 + hstepA, voffA);
            PG8_WAIT_L(8); PG8_BAR; PG8_WAIT_L(0); PG8_MMA(0, 0, At, B0); PG8_BAR; PG8_SCHED;
            PG8_LDB(B1, 1, 1); PG8_STAGE(PG8_SB(1, 0), b3, voffB);
            PG8_BAR; PG8_WAIT_L(0); PG8_MMA(0, 1, At, B1); PG8_BAR;
            PG8_LDA(At, 1, 1); PG8_STAGE(PG8_SA(1, 0), a3, voffA);
            PG8_BAR; PG8_WAIT_L(0); PG8_MMA(1, 0, At, B0); PG8_BAR; PG8_SCHED;
            PG8_STAGE(PG8_SB(1, 1), b3 + hstepB, voffB);
            PG8_WAIT_V(6); PG8_BAR; PG8_MMA(1, 1, At, B1); PG8_BAR;
            }
        }
        if constexpr (ALIGN_EPI) { if (wr == 0) PG8_BAR; }
        if constexpr (FP8) { PG8_SCHED; asm volatile("s_nop 15\n\ts_nop 7" ::: "memory"); PG8_SCHED; }
        E(acc, cur, wr, wc, fr, fq);
        if (!has_next) break;
#pragma unroll
        for (int a = 0; a < 2; ++a)
#pragma unroll
            for (int b = 0; b < 2; ++b)
#pragma unroll
                for (int m = 0; m < 4; ++m)
#pragma unroll
                    for (int n = 0; n < 2; ++n) acc[a][b][m][n] = (f32x4){0.f, 0.f, 0.f, 0.f};
        cur = nxt; cA = nA; cB = nB; ++ui;
        if constexpr (ALIGN_EPI) { if (wr == 1) PG8_BAR; }
    }
    PG8_WAIT_V(0);
    if constexpr (!ALIGN_EPI) { if (wr == 0) PG8_BAR; }
    PG8_BAR;
#undef PG8_SA
#undef PG8_SB
#undef PG8_STAGE
#undef PG8_LDA
#undef PG8_LDB
#undef PG8_MMA
#undef PG8_WAIT_V
#undef PG8_WAIT_L
#undef PG8_BAR
#undef PG8_SCHED
}
}
namespace att {
#define ATT_LAS __attribute__((address_space(3)))
#define ATT_GAS __attribute__((address_space(1)))
typedef unsigned short bf16;
using bf16x8 = __attribute__((ext_vector_type(8))) short;
using s16x4  = __attribute__((ext_vector_type(4))) short;
using f32x16 = __attribute__((ext_vector_type(16))) float;
using f32x4  = __attribute__((ext_vector_type(4))) float;
using u32x4  = __attribute__((ext_vector_type(4))) unsigned;
constexpr int NW = 8, QBLK = 32, KVBLK = 64, DV = 128;
constexpr float LOG2E = 1.4426950408889634f;
#if defined(ATT_OBF16) && ATT_OBF16
typedef unsigned short OT;
#else
typedef float OT;
#endif
#define SBAR() __builtin_amdgcn_sched_barrier(0)
__device__ __forceinline__ int crow(int r, int hi) { return (r & 3) + 8 * (r >> 2) + 4 * hi; }
__device__ __forceinline__ unsigned cvtpk(float lo, float hi) { unsigned r; asm volatile("v_cvt_pk_bf16_f32 %0, %1, %2" : "=v"(r) : "v"(lo), "v"(hi)); return r; }
__device__ __forceinline__ float bf2f(short s) { return __uint_as_float(((unsigned)(unsigned short)s) << 16); }
__device__ __forceinline__ void st_o(float* p, float v) { *p = v; }
__device__ __forceinline__ void st_o(unsigned short* p, float v) { *p = (unsigned short)(cvtpk(v, v) & 0xffffu); }

__device__ __forceinline__ void partialSM(f32x16& p0, f32x16& p1, float& m_reg, float& mn, float& alpha, const float C, const float THRS) {
  float pmax = p0[0];
#pragma unroll
  for (int r = 1; r < 16; ++r) pmax = fmaxf(pmax, p0[r]);
#pragma unroll
  for (int r = 0; r < 16; ++r) pmax = fmaxf(pmax, p1[r]);
  { auto rr = __builtin_amdgcn_permlane32_swap(__float_as_uint(pmax), __float_as_uint(pmax), false, false);
    pmax = fmaxf(__uint_as_float(rr[0]), __uint_as_float(rr[1])); }
  if (__builtin_expect(__all(pmax - m_reg <= THRS), 1)) { mn = m_reg; alpha = 1.f; }
  else { mn = fmaxf(m_reg, pmax); alpha = __builtin_amdgcn_exp2f((m_reg - mn) * C); m_reg = mn; }
  float mnC = -mn * C;
#pragma unroll
  for (int r = 0; r < 16; ++r) p0[r] = fmaf(p0[r], C, mnC);
#pragma unroll
  for (int r = 0; r < 16; ++r) p1[r] = fmaf(p1[r], C, mnC);
#pragma unroll
  for (int r = 0; r < 16; ++r) p0[r] = __builtin_amdgcn_exp2f(p0[r]);
}
#define ATT_PK4(P, BASE, OUT) do { unsigned a0 = cvtpk(P[BASE + 0], P[BASE + 1]), a1 = cvtpk(P[BASE + 2], P[BASE + 3]);   \
    unsigned b0 = cvtpk(P[BASE + 4], P[BASE + 5]), b1 = cvtpk(P[BASE + 6], P[BASE + 7]);                              \
    auto r0 = __builtin_amdgcn_permlane32_swap(a0, b0, false, false); auto r1 = __builtin_amdgcn_permlane32_swap(a1, b1, false, false); \
    u32x4 w = {r0[0], r1[0], r0[1], r1[1]}; OUT = *reinterpret_cast<bf16x8*>(&w); } while (0)
__device__ __forceinline__ void finishSM(f32x16& p0, f32x16& p1, float alpha, float& l_reg, bf16x8& pa0, bf16x8& pa1, bf16x8& pa2, bf16x8& pa3) {
#pragma unroll
  for (int r = 0; r < 16; ++r) p1[r] = __builtin_amdgcn_exp2f(p1[r]);
  float ps = 0;
#pragma unroll
  for (int r = 0; r < 16; ++r) ps += p0[r];
#pragma unroll
  for (int r = 0; r < 16; ++r) ps += p1[r];
  { auto rr = __builtin_amdgcn_permlane32_swap(__float_as_uint(ps), __float_as_uint(ps), false, false);
    ps = __uint_as_float(rr[0]) + __uint_as_float(rr[1]); }
  l_reg = l_reg * alpha + ps;
  ATT_PK4(p0, 0, pa0); ATT_PK4(p0, 8, pa1); ATT_PK4(p1, 0, pa2); ATT_PK4(p1, 8, pa3);
}
template <int RB> __device__ __forceinline__ int kswz(int row, int colB) { return row * RB + (colB ^ ((row & 7) << 4)); }
template <int DQK> __device__ __forceinline__ void qkt(f32x16& p0, f32x16& p1, const ATT_LAS char* Ks, const bf16x8 (&qr)[DQK / 16], int r32, int hi) {
  p0 = f32x16{}; p1 = f32x16{};
#pragma unroll
  for (int d0 = 0; d0 < DQK / 16; ++d0) { const int cb = (d0 * 16 + hi * 8) * 2;
    bf16x8 b0 = *reinterpret_cast<const ATT_LAS bf16x8*>(Ks + kswz<DQK * 2>(r32, cb));
    bf16x8 b1 = *reinterpret_cast<const ATT_LAS bf16x8*>(Ks + kswz<DQK * 2>(32 + r32, cb));
    p0 = __builtin_amdgcn_mfma_f32_32x32x16_bf16(b0, qr[d0], p0, 0, 0, 0);
    p1 = __builtin_amdgcn_mfma_f32_32x32x16_bf16(b1, qr[d0], p1, 0, 0, 0); }
}
__device__ __forceinline__ void qkt192_lq(f32x16& p0, f32x16& p1, const ATT_LAS char* Ks, const bf16x8 (&qr)[8], const ATT_LAS char* Qs, int lane, int r32, int hi) {
  p0 = f32x16{}; p1 = f32x16{};
#pragma unroll
  for (int d0 = 0; d0 < 12; ++d0) { const int cb = (d0 * 16 + hi * 8) * 2;
    bf16x8 b0 = *reinterpret_cast<const ATT_LAS bf16x8*>(Ks + kswz<384>(r32, cb));
    bf16x8 b1 = *reinterpret_cast<const ATT_LAS bf16x8*>(Ks + kswz<384>(32 + r32, cb));
    const bf16x8 q = d0 < 8 ? qr[d0 < 8 ? d0 : 0] : *reinterpret_cast<const ATT_LAS bf16x8*>(Qs + ((d0 - 8) * 64 + lane) * 16);
    p0 = __builtin_amdgcn_mfma_f32_32x32x16_bf16(b0, q, p0, 0, 0, 0);
    p1 = __builtin_amdgcn_mfma_f32_32x32x16_bf16(b1, q, p1, 0, 0, 0); }
}
__device__ __forceinline__ int v_st(int k, int c) { const int kk = (k & ~0xC) | ((k & 4) << 1) | ((k & 8) >> 1); return ((kk >> 3) * 4 + (c >> 5)) * 512 + ((kk & 7) * 32 + (c & 31)) * 2; }
__device__ __forceinline__ int v_rd_base(int lane) { return ((lane & 3) << 3) | (((lane >> 2) & 3) << 6) | (((lane >> 4) & 1) << 5) | (((lane >> 5) & 1) << 8); }
constexpr int v_rd_off(int d0, int ks, int half) { return d0 * 512 + ks * 4096 + half * 2048; }
template <int OFF> __device__ __forceinline__ s16x4 tr_read(int vb) {
  s16x4 r; asm volatile("ds_read_b64_tr_b16 %0, %1 offset:%2" : "=&v"(r) : "v"(vb), "i"(OFF) : "memory"); return r;
}
#define ATT_PK(L, H) (bf16x8){L[0], L[1], L[2], L[3], H[0], H[1], H[2], H[3]}
template <int D0> __device__ __forceinline__ void pv_one(f32x16& od, int vb, bf16x8 pa0, bf16x8 pa1, bf16x8 pa2, bf16x8 pa3) {
  const s16x4 l0 = tr_read<v_rd_off(D0, 0, 0)>(vb), h0 = tr_read<v_rd_off(D0, 0, 1)>(vb), l1 = tr_read<v_rd_off(D0, 1, 0)>(vb), h1 = tr_read<v_rd_off(D0, 1, 1)>(vb);
  const s16x4 l2 = tr_read<v_rd_off(D0, 2, 0)>(vb), h2 = tr_read<v_rd_off(D0, 2, 1)>(vb), l3 = tr_read<v_rd_off(D0, 3, 0)>(vb), h3 = tr_read<v_rd_off(D0, 3, 1)>(vb);
  asm volatile("s_waitcnt lgkmcnt(0)" ::: "memory"); SBAR();
  od = __builtin_amdgcn_mfma_f32_32x32x16_bf16(pa0, ATT_PK(l0, h0), od, 0, 0, 0);
  od = __builtin_amdgcn_mfma_f32_32x32x16_bf16(pa1, ATT_PK(l1, h1), od, 0, 0, 0);
  od = __builtin_amdgcn_mfma_f32_32x32x16_bf16(pa2, ATT_PK(l2, h2), od, 0, 0, 0);
  od = __builtin_amdgcn_mfma_f32_32x32x16_bf16(pa3, ATT_PK(l3, h3), od, 0, 0, 0);
}
__device__ __forceinline__ void pv_d0(f32x16 (&o)[4], int vb, bf16x8 pa0, bf16x8 pa1, bf16x8 pa2, bf16x8 pa3) {
  pv_one<0>(o[0], vb, pa0, pa1, pa2, pa3); pv_one<1>(o[1], vb, pa0, pa1, pa2, pa3); pv_one<2>(o[2], vb, pa0, pa1, pa2, pa3); pv_one<3>(o[3], vb, pa0, pa1, pa2, pa3);
}
template <int D0> __device__ __forceinline__ void pv32_one(f32x16& od, int vb, bf16x8 pa0, bf16x8 pa1) {
  const s16x4 l0 = tr_read<v_rd_off(D0, 0, 0)>(vb), h0 = tr_read<v_rd_off(D0, 0, 1)>(vb), l1 = tr_read<v_rd_off(D0, 1, 0)>(vb), h1 = tr_read<v_rd_off(D0, 1, 1)>(vb);
  asm volatile("s_waitcnt lgkmcnt(0)" ::: "memory"); SBAR();
  od = __builtin_amdgcn_mfma_f32_32x32x16_bf16(pa0, ATT_PK(l0, h0), od, 0, 0, 0);
  od = __builtin_amdgcn_mfma_f32_32x32x16_bf16(pa1, ATT_PK(l1, h1), od, 0, 0, 0);
}

template <int DQK, int LDQ, int LDK, int LDO, int SDEPTH>
__device__ __forceinline__ void attn_dense_body(const bf16* __restrict__ Qb, const bf16* __restrict__ Kh, const bf16* __restrict__ Kr, const bf16* __restrict__ Vh,
                                                const float* __restrict__ cs_rows, OT* __restrict__ Ob, int seq, const float scale, ATT_LAS char* lds) {
  constexpr int SHM_V = KVBLK * DV * 2, SHM_K = KVBLK * DQK * 2, RB = DQK * 2, NQ = DQK / 16;
  constexpr bool ROPE = (DQK == 192);
  const float C = scale * LOG2E, THRS = 8.f / scale;
  int tid_ = threadIdx.x; asm volatile("" : "+v"(tid_));
  const int tid = tid_, wid = tid >> 6, lane = tid & 63, r32 = lane & 31, hi = lane >> 5;
  ATT_LAS char* V_lds = lds; ATT_LAS char* K_lds = lds + 2 * SHM_V;
  ATT_LAS float* ws = (ATT_LAS float*)(lds + 2 * SHM_V + 2 * SHM_K) + wid * 64; ATT_LAS float* li_l = ws; ATT_LAS float* al_l = ws + 32;
  float m_reg = -1e30f, l_reg = 0; f32x16 o[4] = {}; bf16x8 qr[NQ];
  const bf16* Qw = Qb + (long)(wid * QBLK + r32) * LDQ + hi * 8;
#pragma unroll
  for (int d0 = 0; d0 < NQ; ++d0) qr[d0] = *(const ATT_GAS bf16x8*)(Qw + d0 * 16);
  if constexpr (ROPE) {
    const float* cs = cs_rows + (long)(wid * QBLK + r32) * 64 + hi * 8;
#pragma unroll
    for (int g = 0; g < 2; ++g) {
      const f32x4 c0 = *(const ATT_GAS f32x4*)(cs + g * 16), c1 = *(const ATT_GAS f32x4*)(cs + g * 16 + 4);
      const f32x4 s0 = *(const ATT_GAS f32x4*)(cs + 32 + g * 16), s1 = *(const ATT_GAS f32x4*)(cs + 32 + g * 16 + 4);
      float y1[8], y2[8];
#pragma unroll
      for (int j = 0; j < 8; ++j) { const float co = j < 4 ? c0[j & 3] : c1[j & 3], si = j < 4 ? s0[j & 3] : s1[j & 3];
        const float x1 = bf2f(qr[8 + g][j]), x2 = bf2f(qr[10 + g][j]); y1[j] = x1 * co - x2 * si; y2[j] = x1 * si + x2 * co; }
      u32x4 w1 = {cvtpk(y1[0], y1[1]), cvtpk(y1[2], y1[3]), cvtpk(y1[4], y1[5]), cvtpk(y1[6], y1[7])};
      u32x4 w2 = {cvtpk(y2[0], y2[1]), cvtpk(y2[2], y2[3]), cvtpk(y2[4], y2[5]), cvtpk(y2[6], y2[7])};
      qr[8 + g] = *reinterpret_cast<bf16x8*>(&w1); qr[10 + g] = *reinterpret_cast<bf16x8*>(&w2);
    }
  }
  const int sr = tid >> 4, sc = (tid & 15) * 8, vst0 = v_st(sr, sc), vst1 = v_st(32 + sr, sc);
  const int rr = tid >> 3, rc = (tid & 7) * 8;
  const int vb0 = (int)(unsigned)(uintptr_t)V_lds + v_rd_base(lane);
  struct Slot { bf16x8 vs0, vs1, ks0, ks1, kr; } sr_[SDEPTH];
#define SLOAD(i, k0) do { sr_[i].vs0 = *(const ATT_GAS bf16x8*)(&Vh[(long)((k0) + sr) * LDK + sc]); sr_[i].vs1 = *(const ATT_GAS bf16x8*)(&Vh[(long)((k0) + 32 + sr) * LDK + sc]); \
    sr_[i].ks0 = *(const ATT_GAS bf16x8*)(&Kh[(long)((k0) + sr) * LDK + sc]); sr_[i].ks1 = *(const ATT_GAS bf16x8*)(&Kh[(long)((k0) + 32 + sr) * LDK + sc]); \
    if constexpr (ROPE) sr_[i].kr = *(const ATT_GAS bf16x8*)(&Kr[(long)((k0) + rr) * 64 + rc]); } while (0)
#define SWRITE(b, i) do { *reinterpret_cast<ATT_LAS bf16x8*>(V_lds + (b) * SHM_V + vst0) = sr_[i].vs0;          \
    *reinterpret_cast<ATT_LAS bf16x8*>(V_lds + (b) * SHM_V + vst1) = sr_[i].vs1; const int kc = sc * 2;               \
    *reinterpret_cast<ATT_LAS bf16x8*>(K_lds + (b) * SHM_K + kswz<RB>(sr, kc)) = sr_[i].ks0;                       \
    *reinterpret_cast<ATT_LAS bf16x8*>(K_lds + (b) * SHM_K + kswz<RB>(32 + sr, kc)) = sr_[i].ks1;                  \
    if constexpr (ROPE) *reinterpret_cast<ATT_LAS bf16x8*>(K_lds + (b) * SHM_K + kswz<RB>(rr, 256 + rc * 2)) = sr_[i].kr; } while (0)
#define SWAIT() do { if constexpr (SDEPTH == 2) { if constexpr (ROPE) asm volatile("s_waitcnt vmcnt(5)" ::: "memory"); else asm volatile("s_waitcnt vmcnt(4)" ::: "memory"); } else asm volatile("s_waitcnt vmcnt(0)" ::: "memory"); } while (0)
#define RESC(a) do { if (__any((a) < 1.f)) { if (hi == 0) al_l[r32] = (a); asm volatile("s_waitcnt lgkmcnt(0)" ::: "memory"); \
    _Pragma("unroll") for (int d = 0; d < 4; ++d) _Pragma("unroll") for (int r = 0; r < 16; ++r) o[d][r] *= al_l[crow(r, hi)]; } } while (0)
  f32x16 pA0, pA1, pB0, pB1; float mnA, mnB, alA, alB; bf16x8 pa0, pa1, pa2, pa3; const int NT = seq / KVBLK;
  constexpr int SE = 0, SO = SDEPTH - 1;
  SLOAD(SE, 0); asm volatile("s_waitcnt vmcnt(0)" ::: "memory"); SWRITE(0, SE); __syncthreads();
  qkt<DQK>(pA0, pA1, K_lds, qr, r32, hi); partialSM(pA0, pA1, m_reg, mnA, alA, C, THRS);
  SLOAD(SO, KVBLK); if constexpr (SDEPTH == 2) { if (2 < NT) SLOAD(SE, 2 * KVBLK); }
  SWAIT(); SWRITE(1, SO); __syncthreads();
  for (int j = 1; j + 1 < NT; j += 2) {
    SBAR(); qkt<DQK>(pB0, pB1, K_lds + SHM_K, qr, r32, hi);
    finishSM(pA0, pA1, alA, l_reg, pa0, pa1, pa2, pa3); SBAR();
    SLOAD(SO, (j + SDEPTH) * KVBLK); SBAR();
    pv_d0(o, vb0, pa0, pa1, pa2, pa3); partialSM(pB0, pB1, m_reg, mnB, alB, C, THRS);
    __syncthreads(); SWAIT(); SWRITE(0, SE);
    RESC(alB); __syncthreads();
    SBAR(); qkt<DQK>(pA0, pA1, K_lds, qr, r32, hi);
    finishSM(pB0, pB1, alB, l_reg, pa0, pa1, pa2, pa3); SBAR();
    if (SDEPTH == 1 || j + 3 < NT) SLOAD(SE, (j + 1 + SDEPTH) * KVBLK); SBAR();
    pv_d0(o, vb0 + SHM_V, pa0, pa1, pa2, pa3); partialSM(pA0, pA1, m_reg, mnA, alA, C, THRS);
    __syncthreads(); SWAIT(); SWRITE(1, SO);
    RESC(alA); __syncthreads();
  }
  SBAR(); qkt<DQK>(pB0, pB1, K_lds + SHM_K, qr, r32, hi);
  finishSM(pA0, pA1, alA, l_reg, pa0, pa1, pa2, pa3); SBAR();
  pv_d0(o, vb0, pa0, pa1, pa2, pa3); partialSM(pB0, pB1, m_reg, mnB, alB, C, THRS);
  __syncthreads(); RESC(alB);
  finishSM(pB0, pB1, alB, l_reg, pa0, pa1, pa2, pa3); SBAR();
  pv_d0(o, vb0 + SHM_V, pa0, pa1, pa2, pa3);
  if (hi == 0) li_l[r32] = l_reg; asm volatile("s_waitcnt lgkmcnt(0)" ::: "memory");
  float rli[16];
#pragma unroll
  for (int r = 0; r < 16; ++r) rli[r] = __builtin_amdgcn_rcpf(li_l[crow(r, hi)]);
  OT* Ow = Ob + (long)(wid * QBLK) * LDO;
#pragma unroll
  for (int r = 0; r < 16; ++r) { const int orow = crow(r, hi);
#pragma unroll
    for (int d0 = 0; d0 < 4; ++d0) st_o(&Ow[(long)orow * LDO + d0 * 32 + r32], o[d0][r] * rli[r]); }
  __syncthreads();
#undef SLOAD
#undef SWRITE
#undef SWAIT
#undef RESC
}

template <int LDQ, int LDK, int LDO>
__device__ __forceinline__ void attn_pipe192_body(const bf16* __restrict__ Qb, const bf16* __restrict__ Kh, const bf16* __restrict__ Kr, const bf16* __restrict__ Vh,
                                                const float* __restrict__ cs_rows, OT* __restrict__ Ob, int seq, const float scale, ATT_LAS char* lds) {
  constexpr int DQK = 192, SDEPTH = 1, SHM_V = KVBLK * DV * 2, SHM_K = KVBLK * DQK * 2, RB = DQK * 2, NQ = DQK / 16;
  constexpr bool ROPE = true;
  const float C = scale * LOG2E, THRS = 8.f / scale;
  int tid_ = threadIdx.x; asm volatile("" : "+v"(tid_));
  const int tid = tid_, wid = tid >> 6, lane = tid & 63, r32 = lane & 31, hi = lane >> 5;
  ATT_LAS char* V_lds = lds; ATT_LAS char* K_lds = lds + 2 * SHM_V;
  ATT_LAS float* ws = (ATT_LAS float*)(lds + 2 * SHM_V + 2 * SHM_K) + wid * 64; ATT_LAS float* li_l = ws; ATT_LAS float* al_l = ws + 32;
  ATT_LAS char* Qs = lds + 2 * SHM_V + 2 * SHM_K + 2048 + wid * 4096;
  float m_reg = -1e30f, l_reg = 0; f32x16 o[4] = {}; bf16x8 qr8[8];
  const bf16* Qw = Qb + (long)(wid * QBLK + r32) * LDQ + hi * 8;
  { bf16x8 qr[NQ];
#pragma unroll
  for (int d0 = 0; d0 < NQ; ++d0) qr[d0] = *(const ATT_GAS bf16x8*)(Qw + d0 * 16);
  if constexpr (ROPE) {
    const float* cs = cs_rows + (long)(wid * QBLK + r32) * 64 + hi * 8;
#pragma unroll
    for (int g = 0; g < 2; ++g) {
      const f32x4 c0 = *(const ATT_GAS f32x4*)(cs + g * 16), c1 = *(const ATT_GAS f32x4*)(cs + g * 16 + 4);
      const f32x4 s0 = *(const ATT_GAS f32x4*)(cs + 32 + g * 16), s1 = *(const ATT_GAS f32x4*)(cs + 32 + g * 16 + 4);
      float y1[8], y2[8];
#pragma unroll
      for (int j = 0; j < 8; ++j) { const float co = j < 4 ? c0[j & 3] : c1[j & 3], si = j < 4 ? s0[j & 3] : s1[j & 3];
        const float x1 = bf2f(qr[8 + g][j]), x2 = bf2f(qr[10 + g][j]); y1[j] = x1 * co - x2 * si; y2[j] = x1 * si + x2 * co; }
      u32x4 w1 = {cvtpk(y1[0], y1[1]), cvtpk(y1[2], y1[3]), cvtpk(y1[4], y1[5]), cvtpk(y1[6], y1[7])};
      u32x4 w2 = {cvtpk(y2[0], y2[1]), cvtpk(y2[2], y2[3]), cvtpk(y2[4], y2[5]), cvtpk(y2[6], y2[7])};
      qr[8 + g] = *reinterpret_cast<bf16x8*>(&w1); qr[10 + g] = *reinterpret_cast<bf16x8*>(&w2);
    }
  }
#pragma unroll
  for (int d0 = 0; d0 < 8; ++d0) qr8[d0] = qr[d0];
#pragma unroll
  for (int d0 = 8; d0 < 12; ++d0) *reinterpret_cast<ATT_LAS bf16x8*>(Qs + ((d0 - 8) * 64 + lane) * 16) = qr[d0];
  }
  const int sr = tid >> 4, sc = (tid & 15) * 8, vst0 = v_st(sr, sc), vst1 = v_st(32 + sr, sc);
  const int rr = tid >> 3, rc = (tid & 7) * 8;
  const int vb0 = (int)(unsigned)(uintptr_t)V_lds + v_rd_base(lane);
  struct Slot { bf16x8 vs0, vs1, ks0, ks1, kr; } sr_[SDEPTH];
#define SLOADK(i, k0) do { sr_[i].ks0 = *(const ATT_GAS bf16x8*)(&Kh[(long)((k0) + sr) * LDK + sc]); sr_[i].ks1 = *(const ATT_GAS bf16x8*)(&Kh[(long)((k0) + 32 + sr) * LDK + sc]); } while (0)
#define SLOADV(i, k0) do { sr_[i].vs0 = *(const ATT_GAS bf16x8*)(&Vh[(long)((k0) + sr) * LDK + sc]); sr_[i].vs1 = *(const ATT_GAS bf16x8*)(&Vh[(long)((k0) + 32 + sr) * LDK + sc]); \
    if constexpr (ROPE) sr_[i].kr = *(const ATT_GAS bf16x8*)(&Kr[(long)((k0) + rr) * 64 + rc]); } while (0)
#define SLOAD(i, k0) do { SLOADK(i, k0); SLOADV(i, k0); } while (0)
#define SWRITE(b, i) do { *reinterpret_cast<ATT_LAS bf16x8*>(V_lds + (b) * SHM_V + vst0) = sr_[i].vs0;          \
    *reinterpret_cast<ATT_LAS bf16x8*>(V_lds + (b) * SHM_V + vst1) = sr_[i].vs1; const int kc = sc * 2;               \
    *reinterpret_cast<ATT_LAS bf16x8*>(K_lds + (b) * SHM_K + kswz<RB>(sr, kc)) = sr_[i].ks0;                       \
    *reinterpret_cast<ATT_LAS bf16x8*>(K_lds + (b) * SHM_K + kswz<RB>(32 + sr, kc)) = sr_[i].ks1;                  \
    if constexpr (ROPE) *reinterpret_cast<ATT_LAS bf16x8*>(K_lds + (b) * SHM_K + kswz<RB>(rr, 256 + rc * 2)) = sr_[i].kr; } while (0)
#define SWAIT() do { if constexpr (SDEPTH == 2) { if constexpr (ROPE) asm volatile("s_waitcnt vmcnt(5)" ::: "memory"); else asm volatile("s_waitcnt vmcnt(4)" ::: "memory"); } else asm volatile("s_waitcnt vmcnt(0)" ::: "memory"); } while (0)
#define RESC(a) do { if (__any((a) < 1.f)) { if (hi == 0) al_l[r32] = (a); asm volatile("s_waitcnt lgkmcnt(0)" ::: "memory"); \
    _Pragma("unroll") for (int d = 0; d < 4; ++d) _Pragma("unroll") for (int r = 0; r < 16; ++r) o[d][r] *= al_l[crow(r, hi)]; } } while (0)
  f32x16 pA0, pA1, pB0, pB1; float mnA, mnB, alA, alB; bf16x8 pa0, pa1, pa2, pa3; const int NT = seq / KVBLK;
  constexpr int SE = 0, SO = SDEPTH - 1;
  SLOAD(SE, 0); asm volatile("s_waitcnt vmcnt(0)" ::: "memory"); SWRITE(0, SE); __syncthreads();
  qkt192_lq(pA0, pA1, K_lds, qr8, Qs, lane, r32, hi); partialSM(pA0, pA1, m_reg, mnA, alA, C, THRS);
  SLOAD(SO, KVBLK); if constexpr (SDEPTH == 2) { if (2 < NT) SLOAD(SE, 2 * KVBLK); }
  SWAIT(); SWRITE(1, SO); __syncthreads();
  for (int j = 1; j + 1 < NT; j += 2) {
    SBAR(); qkt192_lq(pB0, pB1, K_lds + SHM_K, qr8, Qs, lane, r32, hi);
    finishSM(pA0, pA1, alA, l_reg, pa0, pa1, pa2, pa3); SBAR();
    SLOADK(SO, (j + SDEPTH) * KVBLK); SBAR();
    pv_d0(o, vb0, pa0, pa1, pa2, pa3); SBAR(); SLOADV(SO, (j + SDEPTH) * KVBLK); SBAR(); partialSM(pB0, pB1, m_reg, mnB, alB, C, THRS);
    __syncthreads(); SWAIT(); SWRITE(0, SE);
    RESC(alB); __syncthreads();
    SBAR(); qkt192_lq(pA0, pA1, K_lds, qr8, Qs, lane, r32, hi);
    finishSM(pB0, pB1, alB, l_reg, pa0, pa1, pa2, pa3); SBAR();
    SLOADK(SE, (j + 1 + SDEPTH) * KVBLK); SBAR();
    pv_d0(o, vb0 + SHM_V, pa0, pa1, pa2, pa3); SBAR(); SLOADV(SE, (j + 1 + SDEPTH) * KVBLK); SBAR(); partialSM(pA0, pA1, m_reg, mnA, alA, C, THRS);
    __syncthreads(); SWAIT(); SWRITE(1, SO);
    RESC(alA); __syncthreads();
  }
  SBAR(); qkt192_lq(pB0, pB1, K_lds + SHM_K, qr8, Qs, lane, r32, hi);
  finishSM(pA0, pA1, alA, l_reg, pa0, pa1, pa2, pa3); SBAR();
  pv_d0(o, vb0, pa0, pa1, pa2, pa3); partialSM(pB0, pB1, m_reg, mnB, alB, C, THRS);
  __syncthreads(); RESC(alB);
  finishSM(pB0, pB1, alB, l_reg, pa0, pa1, pa2, pa3); SBAR();
  pv_d0(o, vb0 + SHM_V, pa0, pa1, pa2, pa3);
  if (hi == 0) li_l[r32] = l_reg; asm volatile("s_waitcnt lgkmcnt(0)" ::: "memory");
  float rli[16];
#pragma unroll
  for (int r = 0; r < 16; ++r) rli[r] = __builtin_amdgcn_rcpf(li_l[crow(r, hi)]);
  OT* Ow = Ob + (long)(wid * QBLK) * LDO;
#pragma unroll
  for (int r = 0; r < 16; ++r) { const int orow = crow(r, hi);
#pragma unroll
    for (int d0 = 0; d0 < 4; ++d0) st_o(&Ow[(long)orow * LDO + d0 * 32 + r32], o[d0][r] * rli[r]); }
  __syncthreads();
#undef SLOAD
#undef SLOADK
#undef SLOADV
#undef SWRITE
#undef SWAIT
#undef RESC
}

template <int DQK, int LDQ, int LDK, int LDO>
__device__ __forceinline__ void attn_simple_body(const bf16* __restrict__ Qb, const bf16* __restrict__ Kh, const bf16* __restrict__ Kr, const bf16* __restrict__ Vh,
                                                 const float* __restrict__ cs_rows, OT* __restrict__ Ob, int seq, const float scale, ATT_LAS char* lds) {
  constexpr int SHM_V = KVBLK * DV * 2, SHM_K = KVBLK * DQK * 2, RB = DQK * 2, NQ = DQK / 16;
  constexpr bool ROPE = (DQK == 192);
  const float C = scale * LOG2E, THRS = 8.f / scale;
  int tid_ = threadIdx.x; asm volatile("" : "+v"(tid_));
  const int tid = tid_, wid = tid >> 6, lane = tid & 63, r32 = lane & 31, hi = lane >> 5;
  ATT_LAS char* V_lds = lds; ATT_LAS char* K_lds = lds + 2 * SHM_V;
  ATT_LAS float* ws = (ATT_LAS float*)(lds + 2 * SHM_V + 2 * SHM_K) + wid * 64; ATT_LAS float* li_l = ws; ATT_LAS float* al_l = ws + 32;
  float m_reg = -1e30f, l_reg = 0; f32x16 o[4] = {}; bf16x8 qr[NQ];
  const bf16* Qw = Qb + (long)(wid * QBLK + r32) * LDQ + hi * 8;
#pragma unroll
  for (int d0 = 0; d0 < NQ; ++d0) qr[d0] = *(const ATT_GAS bf16x8*)(Qw + d0 * 16);
  if constexpr (ROPE) {
    const float* cs = cs_rows + (long)(wid * QBLK + r32) * 64 + hi * 8;
#pragma unroll
    for (int g = 0; g < 2; ++g) {
      const f32x4 c0 = *(const ATT_GAS f32x4*)(cs + g * 16), c1 = *(const ATT_GAS f32x4*)(cs + g * 16 + 4);
      const f32x4 s0 = *(const ATT_GAS f32x4*)(cs + 32 + g * 16), s1 = *(const ATT_GAS f32x4*)(cs + 32 + g * 16 + 4);
      float y1[8], y2[8];
#pragma unroll
      for (int j = 0; j < 8; ++j) { const float co = j < 4 ? c0[j & 3] : c1[j & 3], si = j < 4 ? s0[j & 3] : s1[j & 3];
        const float x1 = bf2f(qr[8 + g][j]), x2 = bf2f(qr[10 + g][j]); y1[j] = x1 * co - x2 * si; y2[j] = x1 * si + x2 * co; }
      u32x4 w1 = {cvtpk(y1[0], y1[1]), cvtpk(y1[2], y1[3]), cvtpk(y1[4], y1[5]), cvtpk(y1[6], y1[7])};
      u32x4 w2 = {cvtpk(y2[0], y2[1]), cvtpk(y2[2], y2[3]), cvtpk(y2[4], y2[5]), cvtpk(y2[6], y2[7])};
      qr[8 + g] = *reinterpret_cast<bf16x8*>(&w1); qr[10 + g] = *reinterpret_cast<bf16x8*>(&w2);
    }
  }
  const int sr = tid >> 4, sc = (tid & 15) * 8, vst0 = v_st(sr, sc), vst1 = v_st(32 + sr, sc);
  const int rr = tid >> 3, rc = (tid & 7) * 8;
  const int vb0 = (int)(unsigned)(uintptr_t)V_lds + v_rd_base(lane);
  bf16x8 vs0, vs1, ks0, ks1, kr;
#define SLOAD(k0) do { vs0 = *(const ATT_GAS bf16x8*)(&Vh[(long)((k0) + sr) * LDK + sc]); vs1 = *(const ATT_GAS bf16x8*)(&Vh[(long)((k0) + 32 + sr) * LDK + sc]); \
    ks0 = *(const ATT_GAS bf16x8*)(&Kh[(long)((k0) + sr) * LDK + sc]); ks1 = *(const ATT_GAS bf16x8*)(&Kh[(long)((k0) + 32 + sr) * LDK + sc]); \
    if constexpr (ROPE) kr = *(const ATT_GAS bf16x8*)(&Kr[(long)((k0) + rr) * 64 + rc]); } while (0)
#define SWRITE(b) do { *reinterpret_cast<ATT_LAS bf16x8*>(V_lds + (b) * SHM_V + vst0) = vs0;          \
    *reinterpret_cast<ATT_LAS bf16x8*>(V_lds + (b) * SHM_V + vst1) = vs1; const int kc = sc * 2;               \
    *reinterpret_cast<ATT_LAS bf16x8*>(K_lds + (b) * SHM_K + kswz<RB>(sr, kc)) = ks0;                       \
    *reinterpret_cast<ATT_LAS bf16x8*>(K_lds + (b) * SHM_K + kswz<RB>(32 + sr, kc)) = ks1;                  \
    if constexpr (ROPE) *reinterpret_cast<ATT_LAS bf16x8*>(K_lds + (b) * SHM_K + kswz<RB>(rr, 256 + rc * 2)) = kr; } while (0)
#define RESC(a) do { if (__any((a) < 1.f)) { if (hi == 0) al_l[r32] = (a); asm volatile("s_waitcnt lgkmcnt(0)" ::: "memory"); \
    _Pragma("unroll") for (int d = 0; d < 4; ++d) _Pragma("unroll") for (int r = 0; r < 16; ++r) o[d][r] *= al_l[crow(r, hi)]; } } while (0)
  const int NT = seq / KVBLK;
  SLOAD(0); SWRITE(0); __syncthreads();
  for (int j = 0; j < NT; ++j) {
    const int b = j & 1;
    if (j + 1 < NT) SLOAD((j + 1) * KVBLK);
    f32x16 p0, p1; float mn, al; bf16x8 pa0, pa1, pa2, pa3;
    SBAR(); qkt<DQK>(p0, p1, K_lds + b * SHM_K, qr, r32, hi);
    partialSM(p0, p1, m_reg, mn, al, C, THRS); RESC(al);
    finishSM(p0, p1, al, l_reg, pa0, pa1, pa2, pa3); SBAR();
    pv_d0(o, vb0 + b * SHM_V, pa0, pa1, pa2, pa3);
    if (j + 1 < NT) SWRITE(b ^ 1);
    __syncthreads();
  }
  if (hi == 0) li_l[r32] = l_reg; asm volatile("s_waitcnt lgkmcnt(0)" ::: "memory");
  float rli[16];
#pragma unroll
  for (int r = 0; r < 16; ++r) rli[r] = __builtin_amdgcn_rcpf(li_l[crow(r, hi)]);
  OT* Ow = Ob + (long)(wid * QBLK) * LDO;
#pragma unroll
  for (int r = 0; r < 16; ++r) { const int orow = crow(r, hi);
#pragma unroll
    for (int d0 = 0; d0 < 4; ++d0) st_o(&Ow[(long)orow * LDO + d0 * 32 + r32], o[d0][r] * rli[r]); }
  __syncthreads();
#undef SLOAD
#undef SWRITE
#undef RESC
}

template <int LDQ, int LDK, int LDO>
__device__ __forceinline__ void attn_dma_body(const bf16* __restrict__ Qb, const bf16* __restrict__ Kh, const bf16* __restrict__ Kr, const bf16* __restrict__ Vh,
                                              const float* __restrict__ cs_rows, OT* __restrict__ Ob, int seq, const float scale, ATT_LAS char* lds) {
  constexpr int DQK = 192, SHM_V = KVBLK * DV * 2, SHM_K = KVBLK * DQK * 2, STG = SHM_K + SHM_V, RB = DQK * 2, NQ = DQK / 16;
  const float C = scale * LOG2E, THRS = 8.f / scale;
  int tid_ = threadIdx.x; asm volatile("" : "+v"(tid_));
  const int tid = tid_, wid = __builtin_amdgcn_readfirstlane(tid >> 6), lane = tid & 63, r32 = lane & 31, hi = lane >> 5;
  ATT_LAS float* ws = (ATT_LAS float*)(lds + 3 * STG) + wid * 64; ATT_LAS float* li_l = ws; ATT_LAS float* al_l = ws + 32;
  float m_reg = -1e30f, l_reg = 0; f32x16 o[4] = {}; bf16x8 qr[NQ];
  const bf16* Qw = Qb + (long)(wid * QBLK + r32) * LDQ + hi * 8;
#pragma unroll
  for (int d0 = 0; d0 < NQ; ++d0) qr[d0] = *(const ATT_GAS bf16x8*)(Qw + d0 * 16);
  { const float* cs = cs_rows + (long)(wid * QBLK + r32) * 64 + hi * 8;
#pragma unroll
    for (int g = 0; g < 2; ++g) {
      const f32x4 c0 = *(const ATT_GAS f32x4*)(cs + g * 16), c1 = *(const ATT_GAS f32x4*)(cs + g * 16 + 4);
      const f32x4 s0 = *(const ATT_GAS f32x4*)(cs + 32 + g * 16), s1 = *(const ATT_GAS f32x4*)(cs + 32 + g * 16 + 4);
      float y1[8], y2[8];
#pragma unroll
      for (int j = 0; j < 8; ++j) { const float co = j < 4 ? c0[j & 3] : c1[j & 3], si = j < 4 ? s0[j & 3] : s1[j & 3];
        const float x1 = bf2f(qr[8 + g][j]), x2 = bf2f(qr[10 + g][j]); y1[j] = x1 * co - x2 * si; y2[j] = x1 * si + x2 * co; }
      u32x4 w1 = {cvtpk(y1[0], y1[1]), cvtpk(y1[2], y1[3]), cvtpk(y1[4], y1[5]), cvtpk(y1[6], y1[7])};
      u32x4 w2 = {cvtpk(y2[0], y2[1]), cvtpk(y2[2], y2[3]), cvtpk(y2[4], y2[5]), cvtpk(y2[6], y2[7])};
      qr[8 + g] = *reinterpret_cast<bf16x8*>(&w1); qr[10 + g] = *reinterpret_cast<bf16x8*>(&w2);
    } }
  const char* ksrc[3]; int kstep[3];
#pragma unroll
  for (int d = 0; d < 3; ++d) { const int p = (wid * 3 + d) * 64 + lane, row = p / 24, cpos = p - row * 24, c = cpos ^ (row & 7);
    if (c < 16) { ksrc[d] = (const char*)(Kh + (long)row * LDK + c * 8); kstep[d] = KVBLK * LDK * 2; } else { ksrc[d] = (const char*)(Kr + (long)row * 64 + (c - 16) * 8); kstep[d] = KVBLK * 64 * 2; } }
  const char* vsrc[2];
#pragma unroll
  for (int d = 0; d < 2; ++d) { const int p = (wid * 2 + d) * 64 + lane, sub = p >> 5, q = p & 31, kk = (sub >> 2) * 8 + (q >> 2), col = (sub & 3) * 32 + (q & 3) * 8;
    const int key = (kk & ~0xC) | ((kk & 4) << 1) | ((kk & 8) >> 1); vsrc[d] = (const char*)(Vh + (long)key * LDK + col); }
#define DMA_TILE(t, stg) do { ATT_LAS char* sb_ = lds + (stg) * STG; \
    _Pragma("unroll") for (int d = 0; d < 3; ++d) __builtin_amdgcn_global_load_lds((const unsigned*)(ksrc[d] + (long)(t) * kstep[d]), (ATT_LAS unsigned*)(sb_ + (wid * 3 + d) * 1024), 16, 0, 0); \
    _Pragma("unroll") for (int d = 0; d < 2; ++d) __builtin_amdgcn_global_load_lds((const unsigned*)(vsrc[d] + (long)(t) * (KVBLK * LDK * 2)), (ATT_LAS unsigned*)(sb_ + SHM_K + (wid * 2 + d) * 1024), 16, 0, 0); } while (0)
#define RESC(a) do { if (__any((a) < 1.f)) { if (hi == 0) al_l[r32] = (a); asm volatile("s_waitcnt lgkmcnt(0)" ::: "memory"); \
    _Pragma("unroll") for (int d = 0; d < 4; ++d) _Pragma("unroll") for (int r = 0; r < 16; ++r) o[d][r] *= al_l[crow(r, hi)]; } } while (0)
  const int NT = seq / KVBLK, vbase = (int)(unsigned)(uintptr_t)lds + SHM_K + v_rd_base(lane);
  asm volatile("s_waitcnt vmcnt(0)" ::: "memory");
  DMA_TILE(0, 0); DMA_TILE(1, 1);
  asm volatile("s_waitcnt vmcnt(5)" ::: "memory"); __builtin_amdgcn_s_barrier(); asm volatile("" ::: "memory");
  int stg = 0;
  for (int j = 0; j < NT; ++j) {
    const int stg2 = stg >= 1 ? stg - 1 : 2;
    if (j + 2 < NT) DMA_TILE(j + 2, stg2);
    f32x16 p0, p1; float mn, al; bf16x8 pa0, pa1, pa2, pa3;
    SBAR(); qkt<DQK>(p0, p1, lds + stg * STG, qr, r32, hi);
    partialSM(p0, p1, m_reg, mn, al, C, THRS); RESC(al);
    finishSM(p0, p1, al, l_reg, pa0, pa1, pa2, pa3); SBAR();
    pv_d0(o, vbase + stg * STG, pa0, pa1, pa2, pa3);
    if (j + 2 < NT) asm volatile("s_waitcnt vmcnt(5)" ::: "memory"); else asm volatile("s_waitcnt vmcnt(0)" ::: "memory");
    asm volatile("s_waitcnt lgkmcnt(0)" ::: "memory"); __builtin_amdgcn_s_barrier(); asm volatile("" ::: "memory");
    stg = stg == 2 ? 0 : stg + 1;
  }
  if (hi == 0) li_l[r32] = l_reg; asm volatile("s_waitcnt lgkmcnt(0)" ::: "memory");
  float rli[16];
#pragma unroll
  for (int r = 0; r < 16; ++r) rli[r] = __builtin_amdgcn_rcpf(li_l[crow(r, hi)]);
  OT* Ow = Ob + (long)(wid * QBLK) * LDO;
#pragma unroll
  for (int r = 0; r < 16; ++r) { const int orow = crow(r, hi);
#pragma unroll
    for (int d0 = 0; d0 < 4; ++d0) st_o(&Ow[(long)orow * LDO + d0 * 32 + r32], o[d0][r] * rli[r]); }
  __syncthreads();
#undef DMA_TILE
#undef RESC
}

template <int LDP>
__device__ __forceinline__ void dil_wave_unit(const bf16* __restrict__ P, int qc, int kc, int vc, int d, int r, int t0, int nT,
                                              OT* __restrict__ O, int oc, float* __restrict__ ST  ,
                                              ATT_LAS char* vlds  , const ATT_LAS float* bias2, const float C, int lane_) {
  int lane = lane_; asm volatile("" : "+v"(lane));
  const int r32 = lane & 31, hi = lane >> 5;
  bf16x8 qr[8];
  { const bf16* qp = P + (long)(r + d * (t0 + r32)) * LDP + qc + hi * 8;
#pragma unroll
    for (int d0 = 0; d0 < 8; ++d0) qr[d0] = *(const ATT_GAS bf16x8*)(qp + d0 * 16); }
  bf16x8 kf[2][8];
#define DIL_LDK(kb, set) do { int kt_ = t0 - 64 + (kb) * 32 + r32; kt_ = kt_ < 0 ? 0 : (kt_ > nT - 1 ? nT - 1 : kt_); \
    const bf16* kp_ = P + (long)(r + d * kt_) * LDP + kc + hi * 8; \
    _Pragma("unroll") for (int d0 = 0; d0 < 8; ++d0) kf[set][d0] = *(const ATT_GAS bf16x8*)(kp_ + d0 * 16); } while (0)
  DIL_LDK(0, 0);
  f32x16 p[5];
#pragma unroll
  for (int kb = 0; kb < 5; ++kb) {
    if (kb + 1 < 5) DIL_LDK(kb + 1, (kb + 1) & 1);
    p[kb] = f32x16{};
#pragma unroll
    for (int d0 = 0; d0 < 8; ++d0) p[kb] = __builtin_amdgcn_mfma_f32_32x32x16_bf16(kf[kb & 1][d0], qr[d0], p[kb], 0, 0, 0);
  }
#undef DIL_LDK
  bf16x8 vv[2][8];
#define DIL_LDV(kb, set) do { _Pragma("unroll") for (int i = 0; i < 8; ++i) { const int id = lane + 64 * i, row = id >> 4, c = (id & 15) * 8; \
      int kt_ = t0 - 64 + (kb) * 32 + row; kt_ = kt_ < 0 ? 0 : (kt_ > nT - 1 ? nT - 1 : kt_); \
      vv[set][i] = *(const ATT_GAS bf16x8*)(P + (long)(r + d * kt_) * LDP + vc + c); } } while (0)
  DIL_LDV(0, 0);
  float m = -1e30f;
  { const int a_ = 4 * hi - r32 + 32, k_ = a_ & 3; const ATT_LAS f32x4* tp = (const ATT_LAS f32x4*)(bias2 + k_ * 196 + (a_ - k_));
    const bool interior = (t0 >= 64) && (t0 + 96 <= nT);
#pragma unroll
    for (int kb = 0; kb < 5; ++kb)
#pragma unroll
      for (int g = 0; g < 4; ++g) { const f32x4 bv = tp[kb * 8 + 2 * g];
#pragma unroll
        for (int e = 0; e < 4; ++e) { const int rg = 4 * g + e; float s = fmaf(p[kb][rg], C, bv[e]);
          if (!interior) { const int kt = t0 - 64 + kb * 32 + crow(rg, hi); s = (kt >= 0 && kt < nT) ? s : -1e30f; }
          p[kb][rg] = s; m = fmaxf(m, s); } } }
  { auto rr = __builtin_amdgcn_permlane32_swap(__float_as_uint(m), __float_as_uint(m), false, false); m = fmaxf(__uint_as_float(rr[0]), __uint_as_float(rr[1])); }
  float Z = 0.f;
#pragma unroll
  for (int kb = 0; kb < 5; ++kb)
#pragma unroll
    for (int rg = 0; rg < 16; ++rg) { p[kb][rg] = __builtin_amdgcn_exp2f(p[kb][rg] - m); Z += p[kb][rg]; }
  { auto rr = __builtin_amdgcn_permlane32_swap(__float_as_uint(Z), __float_as_uint(Z), false, false); Z = __uint_as_float(rr[0]) + __uint_as_float(rr[1]); }
  bf16x8 pa[5][2];
#pragma unroll
  for (int kb = 0; kb < 5; ++kb) { ATT_PK4(p[kb], 0, pa[kb][0]); ATT_PK4(p[kb], 8, pa[kb][1]); }
  f32x16 o[4] = {};
  const int vb = (int)(unsigned)(uintptr_t)vlds + v_rd_base(lane);
#pragma unroll
  for (int kb = 0; kb < 5; ++kb) {
    if (kb + 1 < 5) DIL_LDV(kb + 1, (kb + 1) & 1);
#pragma unroll
    for (int i = 0; i < 8; ++i) { const int id = lane + 64 * i, row = id >> 4, c = (id & 15) * 8;
      *reinterpret_cast<ATT_LAS bf16x8*>(vlds + v_st(row, c)) = vv[kb & 1][i]; }
    asm volatile("s_waitcnt lgkmcnt(0)" ::: "memory"); SBAR();
    pv32_one<0>(o[0], vb, pa[kb][0], pa[kb][1]); pv32_one<1>(o[1], vb, pa[kb][0], pa[kb][1]); pv32_one<2>(o[2], vb, pa[kb][0], pa[kb][1]); pv32_one<3>(o[3], vb, pa[kb][0], pa[kb][1]);
    SBAR();
  }
#undef DIL_LDV
#pragma unroll
  for (int rg = 0; rg < 16; ++rg) { const long row = r + d * (t0 + crow(rg, hi));
#pragma unroll
    for (int d0 = 0; d0 < 4; ++d0) st_o(&O[row * 768 + oc + d0 * 32 + r32], o[d0][rg]); }
  if (hi == 0) { const long row = r + d * (t0 + r32); typedef float f32x2_ __attribute__((ext_vector_type(2))); *(ATT_GAS f32x2_*)(ST + row * 12) = (f32x2_){m, Z}; }
}
template <int LDP>
__device__ __forceinline__ void dil_wg_unit(const bf16* __restrict__ P, int qc, int kc, int vc, int d, int r, int T0, int nT,
                                            OT* __restrict__ O, int oc, float* __restrict__ ST, ATT_LAS char* lds, const ATT_LAS float* bias2, const float C) {
  int tid_ = threadIdx.x; asm volatile("" : "+v"(tid_));
  const int tid = tid_, wid = __builtin_amdgcn_readfirstlane(tid >> 6), lane = tid & 63, r32 = lane & 31, hi = lane >> 5, t0 = T0 + 32 * wid;
  { bf16x8 kk[12];
#pragma unroll
    for (int i = 0; i < 12; ++i) { const int id = tid + 512 * i, row = id >> 4, c = (id & 15) * 8; int kt = T0 - 64 + row; kt = kt < 0 ? 0 : (kt > nT - 1 ? nT - 1 : kt);
      kk[i] = *(const ATT_GAS bf16x8*)(P + (long)(r + d * kt) * LDP + kc + c); }
#pragma unroll
    for (int i = 0; i < 12; ++i) { const int id = tid + 512 * i, row = id >> 4, cB = (id & 15) * 16;
      *reinterpret_cast<ATT_LAS bf16x8*>(lds + kswz<256>(row, cB)) = kk[i]; } }
  bf16x8 qr[8];
  { const bf16* qp = P + (long)(r + d * (t0 + r32)) * LDP + qc + hi * 8;
#pragma unroll
    for (int d0 = 0; d0 < 8; ++d0) qr[d0] = *(const ATT_GAS bf16x8*)(qp + d0 * 16); }
  __syncthreads();
  bf16x8 vv[12];
#pragma unroll
  for (int i = 0; i < 12; ++i) { const int id = tid + 512 * i, row = id >> 4, c = (id & 15) * 8; int kt = T0 - 64 + row; kt = kt < 0 ? 0 : (kt > nT - 1 ? nT - 1 : kt);
    vv[i] = *(const ATT_GAS bf16x8*)(P + (long)(r + d * kt) * LDP + vc + c); }
  f32x16 p[5];
#pragma unroll
  for (int kb = 0; kb < 5; ++kb) { const int krow = 32 * wid + 32 * kb + r32;
    p[kb] = f32x16{};
#pragma unroll
    for (int d0 = 0; d0 < 8; ++d0) { const bf16x8 kf = *reinterpret_cast<const ATT_LAS bf16x8*>(lds + kswz<256>(krow, (d0 * 16 + hi * 8) * 2));
      p[kb] = __builtin_amdgcn_mfma_f32_32x32x16_bf16(kf, qr[d0], p[kb], 0, 0, 0); } }
  float m = -1e30f;
  { const int a_ = 4 * hi - r32 + 32, k_ = a_ & 3; const ATT_LAS f32x4* tp = (const ATT_LAS f32x4*)(bias2 + k_ * 196 + (a_ - k_));
    const bool interior = (t0 >= 64) && (t0 + 96 <= nT);
#pragma unroll
    for (int kb = 0; kb < 5; ++kb)
#pragma unroll
      for (int g = 0; g < 4; ++g) { const f32x4 bv = tp[kb * 8 + 2 * g];
#pragma unroll
        for (int e = 0; e < 4; ++e) { const int rg = 4 * g + e; float s = fmaf(p[kb][rg], C, bv[e]);
          if (!interior) { const int kt = t0 - 64 + kb * 32 + crow(rg, hi); s = (kt >= 0 && kt < nT) ? s : -1e30f; }
          p[kb][rg] = s; m = fmaxf(m, s); } } }
  { auto rr = __builtin_amdgcn_permlane32_swap(__float_as_uint(m), __float_as_uint(m), false, false); m = fmaxf(__uint_as_float(rr[0]), __uint_as_float(rr[1])); }
  float Z = 0.f;
#pragma unroll
  for (int kb = 0; kb < 5; ++kb)
#pragma unroll
    for (int rg = 0; rg < 16; ++rg) { p[kb][rg] = __builtin_amdgcn_exp2f(p[kb][rg] - m); Z += p[kb][rg]; }
  { auto rr = __builtin_amdgcn_permlane32_swap(__float_as_uint(Z), __float_as_uint(Z), false, false); Z = __uint_as_float(rr[0]) + __uint_as_float(rr[1]); }
  bf16x8 pa[5][2];
#pragma unroll
  for (int kb = 0; kb < 5; ++kb) { ATT_PK4(p[kb], 0, pa[kb][0]); ATT_PK4(p[kb], 8, pa[kb][1]); }
  __syncthreads();
#pragma unroll
  for (int i = 0; i < 12; ++i) { const int id = tid + 512 * i, row = id >> 4, c = (id & 15) * 8;
    *reinterpret_cast<ATT_LAS bf16x8*>(lds + (row >> 5) * 8192 + v_st(row & 31, c)) = vv[i]; }
  __syncthreads();
  f32x16 o[4] = {};
#pragma unroll
  for (int kb = 0; kb < 5; ++kb) { const int vb = (int)(unsigned)(uintptr_t)lds + (wid + kb) * 8192 + v_rd_base(lane);
    pv32_one<0>(o[0], vb, pa[kb][0], pa[kb][1]); pv32_one<1>(o[1], vb, pa[kb][0], pa[kb][1]); pv32_one<2>(o[2], vb, pa[kb][0], pa[kb][1]); pv32_one<3>(o[3], vb, pa[kb][0], pa[kb][1]); }
#pragma unroll
  for (int rg = 0; rg < 16; ++rg) { const long row = r + d * (t0 + crow(rg, hi));
#pragma unroll
    for (int d0 = 0; d0 < 4; ++d0) st_o(&O[row * 768 + oc + d0 * 32 + r32], o[d0][rg]); }
  if (hi == 0) { const long row = r + d * (t0 + r32); typedef float f32x2_ __attribute__((ext_vector_type(2))); *(ATT_GAS f32x2_*)(ST + row * 12) = (f32x2_){m, Z}; }
  __syncthreads();
}

#if defined(MLA_DMA) && MLA_DMA == 2
#define MLA_BODY attn_pipe192_body
#elif defined(MLA_DMA) && MLA_DMA
#define MLA_BODY attn_dma_body
#else
template <int LDQ, int LDK, int LDO> __device__ __forceinline__ void attn_simple192(const bf16* Qb, const bf16* Kh, const bf16* Kr, const bf16* Vh, const float* cs, OT* Ob, int seq, const float scale, ATT_LAS char* lds) { attn_simple_body<192, LDQ, LDK, LDO>(Qb, Kh, Kr, Vh, cs, Ob, seq, scale, lds); }
#define MLA_BODY attn_simple192
#endif
}
constexpr int S = 8192, D = 2048, NMEM = 256;
constexpr int DIN = 3392, DINP = 3584;
constexpr int PC_DIL = 768, PC_MEM = 3072;
constexpr int QR = 384, KVR = 128, AQ = 512;
constexpr int NUP = 2816;
constexpr int UC_KV = 1280;
constexpr int DFF = 5632, DFE = 7168, NE = 8;
constexpr int MP = 18432;
constexpr float EPS = 1e-6f;
constexpr int NWAVES = 8;

constexpr size_t al256(size_t x) { return (x + 255) / 256 * 256; }
constexpr size_t WS_CTL = 0, CTL_ZERO_BYTES = 1u << 20;
constexpr size_t WS_WIN = WS_CTL + CTL_ZERO_BYTES;
constexpr size_t WS_WUP = WS_WIN + al256((size_t)2 * DINP * D * 2);
constexpr size_t WS_WMEM = WS_WUP + al256((size_t)2 * NUP * AQ * 2);
constexpr size_t WS_WOUT = WS_WMEM + al256((size_t)2 * 1024 * D * 2);
constexpr size_t WS_WGU = WS_WOUT + al256((size_t)2 * D * D * 2);
constexpr size_t WS_WDN = WS_WGU + al256((size_t)2 * DFF * D * 2);
constexpr size_t WS_MGU = WS_WDN + al256((size_t)D * DFF * 2);
constexpr size_t WS_MDN = WS_MGU + al256((size_t)NE * 2 * DFE * D * 2);
constexpr size_t WS_XN = WS_MDN + al256((size_t)NE * D * DFE * 2);
constexpr size_t WS_MEMN = WS_XN + al256((size_t)S * D * 2);
constexpr size_t WS_MEMKV = WS_MEMN + al256((size_t)2 * NMEM * D * 2);
constexpr size_t WS_PROJ = WS_MEMKV + al256((size_t)2 * NMEM * 1024 * 2);
constexpr size_t WS_AQKV = WS_PROJ + al256((size_t)S * DINP * 2);
constexpr size_t WS_KROPE = WS_AQKV + al256((size_t)S * AQ * 2);
constexpr size_t WS_ROPECS = WS_KROPE + al256((size_t)S * 64 * 2);
constexpr size_t WS_QKVM = WS_ROPECS + al256((size_t)S * 64 * 4);
constexpr size_t WS_YPRE = WS_QKVM + al256((size_t)S * NUP * 2);
constexpr size_t WS_DILO = WS_YPRE + al256((size_t)S * D * 4);
constexpr size_t WS_DILS = WS_DILO + al256((size_t)3 * S * 768 * 4);
constexpr size_t WS_Y = WS_DILS + al256((size_t)3 * S * 12 * 4);
constexpr size_t WS_XA = WS_Y + al256((size_t)S * D * 2);
constexpr size_t WS_ROUTE = WS_XA + al256((size_t)S * D * 4);
constexpr size_t WS_XP = WS_ROUTE + al256((size_t)S * 32);
constexpr size_t WS_OUTP = WS_XP + al256((size_t)MP * D * 2);
constexpr size_t WS_ACTP = WS_OUTP + al256((size_t)MP * D * 2);
constexpr size_t WS_OUTQ = WS_ACTP + al256((size_t)MP * DFE * 2);
constexpr size_t WS_END = WS_OUTQ + al256((size_t)4 * 2048 * D * 2);
static_assert(WS_END <= 1879048192ull, "workspace map exceeds 4 x the largest input");
constexpr int CW_BAR = 16384;
constexpr int CW_QUEUE = 8192;
constexpr int CW_CNT = 8192 + 256;
constexpr int CW_QUEUE2 = 65536;
constexpr int CW_CVT = 8192 + 320;
constexpr int CW_DONE = 8192 + 384;
constexpr int CW_CNTW = 53248;
constexpr int CW_TS = 12288;
constexpr int CW_TILEE = 8192 + 512;
constexpr int RING_BYTES = 131072;
constexpr int LDSCTL_OFF = RING_BYTES, MISC_OFF = LDSCTL_OFF + 320;
constexpr int BIAS_OFF = 132096;
constexpr int LDS_BYTES = 147456;
static_assert(BIAS_OFF >= MISC_OFF + 128 && BIAS_OFF + 3 * 6 * 132 * 4 + 4 * 196 * 4 <= LDS_BYTES, "LDS map");

#define GAS __attribute__((address_space(1)))
#define LAS __attribute__((address_space(3)))
typedef unsigned short bf16;
typedef unsigned v4u __attribute__((ext_vector_type(4)));
typedef unsigned v2u __attribute__((ext_vector_type(2)));
typedef float f32x4 __attribute__((ext_vector_type(4)));
typedef short bf16x8 __attribute__((ext_vector_type(8)));
typedef GAS unsigned gu32;
#define RLX_AGENT __ATOMIC_RELAXED, __HIP_MEMORY_SCOPE_AGENT
#define LDS_WAIT() asm volatile("s_waitcnt lgkmcnt(0)" ::: "memory")
#define VM_WAIT() asm volatile("s_waitcnt vmcnt(0)" ::: "memory")
__device__ __forceinline__ unsigned f2bf(float f) { unsigned u = __builtin_bit_cast(unsigned, f); return (u + 0x7fffu + ((u >> 16) & 1u)) >> 16; }
__device__ __forceinline__ unsigned pk2(float lo, float hi) { return f2bf(lo) | (f2bf(hi) << 16); }
__device__ __forceinline__ float bflo(unsigned w) { return __uint_as_float(w << 16); }
__device__ __forceinline__ float bfhi(unsigned w) { return __uint_as_float(w & 0xffff0000u); }

#define XB_TMO      128
#define XB_XCNT(j)  (256  + 64 * (j))
#define XB_XSUB(j)  (1280 + 64 * (j))
#define XB_XGEN(j)  (2304 + 64 * (j))
#define XB_TOP      3328
#define XB_TOPGEN   3392
#define XCD_BAR_WORDS 3456
#define XB_SPIN_CAP (1u << 18)
__device__ __forceinline__ unsigned xb_ld(unsigned* p)              { return __hip_atomic_load(p, __ATOMIC_RELAXED, __HIP_MEMORY_SCOPE_AGENT); }
__device__ __forceinline__ unsigned xb_add(unsigned* p, unsigned v) { return __hip_atomic_fetch_add(p, v, __ATOMIC_RELAXED, __HIP_MEMORY_SCOPE_AGENT); }
__device__ __forceinline__ unsigned xb_xcc_id() { return (unsigned)__builtin_amdgcn_s_getreg((3 << 11) | 20) & 0xFu; }
#define XB_SPIN(cond, bar) do { unsigned _sp = 0; while (cond) { __builtin_amdgcn_s_sleep(1); \
    if ((++_sp & 255u) == 0u) { if (xb_ld(&(bar)[XB_TMO])) break; if (_sp > XB_SPIN_CAP) { atomicAdd(&(bar)[XB_TMO], 1u); break; } } } } while (0)
struct XcdBarrier { unsigned* bar; unsigned x; volatile LAS unsigned* st; };
__device__ __forceinline__ XcdBarrier xcd_barrier_post(unsigned* bar, volatile LAS unsigned* st) {
    XcdBarrier b; b.bar = bar; b.x = xb_xcc_id(); b.st = st;
    if (threadIdx.x == 0) (void)xb_add(&bar[XB_XCNT(b.x)], 1u);
    return b;
}
__device__ __forceinline__ void xcd_barrier_complete(unsigned* bar, unsigned x, unsigned& nloc, unsigned& nx) {
    const unsigned G = gridDim.x * gridDim.y * gridDim.z;
    unsigned sum, cnt, mine, sp = 0u;
    for (;;) {
        sum = 0u; cnt = 0u; mine = 0u;
#pragma unroll
        for (unsigned j = 0; j < 16; ++j) { const unsigned c = xb_ld(&bar[XB_XCNT(j)]); sum += c; cnt += (c > 0u) ? 1u : 0u; mine = (j == x) ? c : mine; }
        if (sum == G) break;
        __builtin_amdgcn_s_sleep(1);
        if ((++sp & 255u) == 0u) { if (xb_ld(&bar[XB_TMO])) break; if (sp > XB_SPIN_CAP) { atomicAdd(&bar[XB_TMO], 1u); break; } }
    }
    nloc = mine > 0u ? mine : 1u; nx = cnt > 0u ? cnt : 1u;
}
__device__ __forceinline__ void xcd_barrier(const XcdBarrier& b) {
    asm volatile("s_waitcnt vmcnt(0)" ::: "memory");
    __syncthreads();
    if (threadIdx.x == 0) {
        unsigned* bar = b.bar;
        __builtin_amdgcn_s_waitcnt(0);
        unsigned nloc = b.st[0], nx = b.st[1];
        if (nloc == 0u) { xcd_barrier_complete(bar, b.x, nloc, nx); b.st[0] = nloc; b.st[1] = nx; }
        const unsigned old = xb_add(&bar[XB_XSUB(b.x)], 1u);
        const unsigned gen = old / nloc;
        if (old + 1u == (gen + 1u) * nloc) {
            __builtin_amdgcn_fence(__ATOMIC_RELEASE, "agent");
            asm volatile("s_waitcnt vmcnt(0)" ::: "memory");
            const unsigned og = xb_add(&bar[XB_TOP], 1u);
            const unsigned tg = og / nx;
            if (og + 1u == (tg + 1u) * nx) xb_add(&bar[XB_TOPGEN], 1u);
            else XB_SPIN(xb_ld(&bar[XB_TOPGEN]) == tg, bar);
            __builtin_amdgcn_fence(__ATOMIC_ACQUIRE, "agent");
            xb_add(&bar[XB_XGEN(b.x)], 1u);
            asm volatile("s_waitcnt vmcnt(0)" ::: "memory");
        } else {
            XB_SPIN(xb_ld(&bar[XB_XGEN(b.x)]) == gen, bar);
            __builtin_amdgcn_fence(__ATOMIC_ACQUIRE, "agent");
            asm volatile("s_waitcnt vmcnt(0)" ::: "memory");
        }
    }
    __syncthreads();
}

struct Args {
    const float* in[23]; float* out; unsigned char* ws;
    float invf[32];
    int ph_lo, ph_hi, li, rep;
};
struct Frame {
    LAS unsigned char* lds;
    volatile LAS unsigned* MISC;
    gu32* ctl;
    int tid, lane, wave, G, gw, NGW;
    unsigned char* ws;
};
__device__ __forceinline__ float wave_sum(float v) {
#pragma unroll
    for (int o = 1; o < 64; o <<= 1) v += __shfl_xor(v, o);
    return v;
}
__device__ __forceinline__ float wave_max(float v) {
#pragma unroll
    for (int o = 1; o < 64; o <<= 1) v = fmaxf(v, __shfl_xor(v, o));
    return v;
}

__device__ __forceinline__ unsigned pk4_fp8(float a, float b, float c, float d) { int w = 0; w = __builtin_amdgcn_cvt_pk_fp8_f32(a, b, w, false); w = __builtin_amdgcn_cvt_pk_fp8_f32(c, d, w, true); return (unsigned)w; }
#if defined(CVT_REG) && CVT_REG
__device__ __forceinline__ void cvt_load(const float* __restrict__ W, int N, int k0, int n0, int lane, f32x4 (&v)[8]) {
    const GAS float* p = (const GAS float*)(W + (size_t)(k0 + (lane >> 5) * 32) * N + n0 + (lane & 31));
#pragma unroll
    for (int i = 0; i < 8; ++i)
#pragma unroll
        for (int e = 0; e < 4; ++e) v[i][e] = __builtin_nontemporal_load(p + (size_t)(i * 4 + e) * N);
}
template <bool FP8>
__device__ __forceinline__ void cvt_finish(const f32x4 (&v)[8], int k0, void* __restrict__ dstv, int ldd, int drow0, int kdst0, LAS float* scr, int lane, float wsc) {
    const int n = lane & 31, kh = (lane >> 5) * 32;
    if constexpr (FP8) { GAS v4u* d = (GAS v4u*)((unsigned char*)dstv + (size_t)(drow0 + n) * ldd + kdst0 + k0 + kh);
#pragma unroll
        for (int j = 0; j < 2; ++j) { v4u o;
            o.x = pk4_fp8(v[4 * j][0] * wsc, v[4 * j][1] * wsc, v[4 * j][2] * wsc, v[4 * j][3] * wsc); o.y = pk4_fp8(v[4 * j + 1][0] * wsc, v[4 * j + 1][1] * wsc, v[4 * j + 1][2] * wsc, v[4 * j + 1][3] * wsc);
            o.z = pk4_fp8(v[4 * j + 2][0] * wsc, v[4 * j + 2][1] * wsc, v[4 * j + 2][2] * wsc, v[4 * j + 2][3] * wsc); o.w = pk4_fp8(v[4 * j + 3][0] * wsc, v[4 * j + 3][1] * wsc, v[4 * j + 3][2] * wsc, v[4 * j + 3][3] * wsc);
            __builtin_nontemporal_store(o, d + j); } }
    else { GAS v4u* d = (GAS v4u*)((bf16*)dstv + (size_t)(drow0 + n) * ldd + kdst0 + k0 + kh);
#pragma unroll
        for (int j = 0; j < 4; ++j) { v4u o; o.x = pk2(v[2 * j][0], v[2 * j][1]); o.y = pk2(v[2 * j][2], v[2 * j][3]); o.z = pk2(v[2 * j + 1][0], v[2 * j + 1][1]); o.w = pk2(v[2 * j + 1][2], v[2 * j + 1][3]);
            __builtin_nontemporal_store(o, d + j); } }
}
#else
__device__ __forceinline__ void cvt_load(const float* __restrict__ W, int N, int k0, int n0, int lane, f32x4 (&v)[8]) {
    const int lr = lane >> 3, lc = (lane & 7) * 4;
#pragma unroll
    for (int i = 0; i < 8; ++i) v[i] = __builtin_nontemporal_load((const GAS f32x4*)(W + (size_t)(k0 + i * 8 + lr) * N + n0 + lc));
}
template <bool FP8>
__device__ __forceinline__ void cvt_finish(const f32x4 (&v)[8], int k0, void* __restrict__ dstv, int ldd, int drow0, int kdst0, LAS float* scr, int lane, float wsc) {
    const int lr = lane >> 3, lc = (lane & 7) * 4;
#pragma unroll
    for (int i = 0; i < 8; ++i) { LAS float* s = scr + (i * 8 + lr) * 33 + lc; s[0] = v[i][0]; s[1] = v[i][1]; s[2] = v[i][2]; s[3] = v[i][3]; }
    LDS_WAIT(); asm volatile("" ::: "memory");
    const int c = lane & 7;
#pragma unroll
    for (int j = 0; j < 4; ++j) { const int n = (lane >> 3) + 8 * j; const LAS float* s = scr + (8 * c) * 33 + n;
        if constexpr (FP8) { v2u o; o.x = pk4_fp8(s[0 * 33] * wsc, s[1 * 33] * wsc, s[2 * 33] * wsc, s[3 * 33] * wsc); o.y = pk4_fp8(s[4 * 33] * wsc, s[5 * 33] * wsc, s[6 * 33] * wsc, s[7 * 33] * wsc);
            __builtin_nontemporal_store(o, (GAS v2u*)((unsigned char*)dstv + (size_t)(drow0 + n) * ldd + kdst0 + k0 + 8 * c)); }
        else { v4u o; o.x = pk2(s[0 * 33], s[1 * 33]); o.y = pk2(s[2 * 33], s[3 * 33]); o.z = pk2(s[4 * 33], s[5 * 33]); o.w = pk2(s[6 * 33], s[7 * 33]);
            __builtin_nontemporal_store(o, (GAS v4u*)((bf16*)dstv + (size_t)(drow0 + n) * ldd + kdst0 + k0 + 8 * c)); } }
    LDS_WAIT(); asm volatile("" ::: "memory");
}
#endif
__device__ __forceinline__ int cvt_drow(int mode, int n0, int roff) { return mode == 0 ? n0 + roff : (mode == 1 ? (n0 >> 7) * 256 + (n0 & 127) : (mode == 2 ? (n0 >> 7) * 256 + 128 + (n0 & 127) : (n0 < 576 ? n0 : n0 + 192))); }
template <bool FP8>
__device__ __forceinline__ void cvt_job(Frame& F, const float* W, int K, int N, void* dst, int ldd, int kdst0, int mode, int roff, LAS float* scr, float wsc) {
    const int nnb = N / 32, nitems = (K / 64) * nnb;
    int it = F.gw; if (it >= nitems) return;
    f32x4 va[8], vb[8];
    cvt_load(W, N, (it / nnb) * 64, (it % nnb) * 32, F.lane, va);
    for (;;) {
        const int it1 = it + F.NGW; if (it1 < nitems) cvt_load(W, N, (it1 / nnb) * 64, (it1 % nnb) * 32, F.lane, vb);
        cvt_finish<FP8>(va, (it / nnb) * 64, dst, ldd, cvt_drow(mode, (it % nnb) * 32, roff), kdst0, scr, F.lane, wsc);
        if (it1 >= nitems) break;
        const int it2 = it1 + F.NGW; if (it2 < nitems) cvt_load(W, N, (it2 / nnb) * 64, (it2 % nnb) * 32, F.lane, va);
        cvt_finish<FP8>(vb, (it1 / nnb) * 64, dst, ldd, cvt_drow(mode, (it1 % nnb) * 32, roff), kdst0, scr, F.lane, wsc);
        if (it2 >= nitems) break;
        it = it2;
    }
}
__device__ __forceinline__ void rms_row_to_bf16(const float* xrow, const float* g, bf16* orow, int lane) {
    const GAS f32x4* xr = (const GAS f32x4*)xrow + lane; const GAS f32x4* gr = (const GAS f32x4*)g + lane;
    f32x4 v[8]; float s = 0.f;
#pragma unroll
    for (int j = 0; j < 8; ++j) { v[j] = xr[64 * j]; s += (v[j].x * v[j].x + v[j].y * v[j].y) + (v[j].z * v[j].z + v[j].w * v[j].w); }
    const float rstd = 1.f / sqrtf(wave_sum(s) * (1.f / D) + EPS);
    GAS v2u* o8 = (GAS v2u*)orow + lane;
#pragma unroll
    for (int j = 0; j < 8; ++j) { const f32x4 gg = gr[64 * j]; v2u w; w.x = pk2(v[j].x * rstd * gg.x, v[j].y * rstd * gg.y); w.y = pk2(v[j].z * rstd * gg.z, v[j].w * rstd * gg.w); o8[64 * j] = w; }
}
__device__ __forceinline__ void rms_row_to_fp8(const float* xrow, const float* g, unsigned char* orow, int lane) {
    const GAS f32x4* xr = (const GAS f32x4*)xrow + lane; const GAS f32x4* gr = (const GAS f32x4*)g + lane;
    f32x4 v[8]; float s = 0.f;
#pragma unroll
    for (int j = 0; j < 8; ++j) { v[j] = xr[64 * j]; s += (v[j].x * v[j].x + v[j].y * v[j].y) + (v[j].z * v[j].z + v[j].w * v[j].w); }
    const float rstd = 1.f / sqrtf(wave_sum(s) * (1.f / D) + EPS);
    GAS unsigned* o4 = (GAS unsigned*)orow + lane;
#pragma unroll
    for (int j = 0; j < 8; ++j) { const f32x4 gg = gr[64 * j]; o4[64 * j] = pk4_fp8(v[j].x * rstd * gg.x, v[j].y * rstd * gg.y, v[j].z * rstd * gg.z, v[j].w * rstd * gg.w); }
}
__device__ __forceinline__ void sincos_f64(float ang, float& c, float& s) {
    const double a = (double)ang, twopi = 6.283185307179586476925286766559, inv2pi = 0.15915494309189533576888376337251;
    const double q = __builtin_rint(a * inv2pi); const double r = a - q * twopi;
    const double r2 = r * r; double ss = 1.0, cc = 1.0;
#pragma unroll
    for (int k = 14; k >= 1; --k) { ss = 1.0 - r2 * (1.0 / (double)((2 * k) * (2 * k + 1))) * ss; cc = 1.0 - r2 * (1.0 / (double)((2 * k - 1) * (2 * k))) * cc; }
    s = (float)(r * ss); c = (float)cc;
}
__device__ const unsigned char DIL_BUCKET[3][129] = {
 {11,11,11,11,11,11,11,11,11,11,11,11,11,11,11,10,10,10,10,10,10,10,10,10,10,10,10,10,10,10,10,10,10,10,10,10,10,10,9,9,9,9,9,9,9,9,9,9,9,9,8,8,8,8,8,8,8,7,6,5,4,3,2,1,0,17,18,19,20,21,22,23,24,24,24,24,24,24,24,25,25,25,25,25,25,25,25,25,25,25,25,26,26,26,26,26,26,26,26,26,26,26,26,26,26,26,26,26,26,26,26,26,26,26,27,27,27,27,27,27,27,27,27,27,27,27,27,27,27},
 {13,13,13,13,13,13,13,13,13,13,13,13,13,13,13,13,13,13,13,13,13,13,13,12,12,12,12,12,12,12,12,12,12,12,12,12,12,12,12,12,12,12,11,11,11,11,11,11,11,11,11,11,10,10,10,10,10,10,9,9,9,8,8,4,0,20,24,24,25,25,25,26,26,26,26,26,26,27,27,27,27,27,27,27,27,27,27,28,28,28,28,28,28,28,28,28,28,28,28,28,28,28,28,28,28,28,29,29,29,29,29,29,29,29,29,29,29,29,29,29,29,29,29,29,29,29,29,29,29},
 {15,15,15,15,15,15,15,15,15,15,15,15,15,15,15,15,15,15,15,15,15,15,15,15,15,15,15,15,15,15,14,14,14,14,14,14,14,14,14,14,14,14,14,14,14,13,13,13,13,13,13,13,13,13,12,12,12,12,12,11,11,10,10,9,0,25,26,26,27,27,28,28,28,28,28,29,29,29,29,29,29,29,29,29,30,30,30,30,30,30,30,30,30,30,30,30,30,30,30,31,31,31,31,31,31,31,31,31,31,31,31,31,31,31,31,31,31,31,31,31,31,31,31,31,31,31,31,31,31}};

typedef float f32x2 __attribute__((ext_vector_type(2)));
__device__ __forceinline__ f32x4 ld_o4(const float* p) { return *(const GAS f32x4*)p; }
__device__ __forceinline__ f32x4 ld_o4(const unsigned short* p) { const v2u w = *(const GAS v2u*)p; return (f32x4){bflo(w.x), bfhi(w.x), bflo(w.y), bfhi(w.y)}; }
#ifndef EARLY_Q
#define EARLY_Q 1
#endif
#ifndef CVT_CHUNK
#define CVT_CHUNK 64
#endif
#ifndef PH_MASK
#define PH_MASK 0xFFFFu
#endif
#ifndef REPEAT_PHASE
#define REPEAT_PHASE -1
#endif
#ifndef ATT_EN
#define ATT_EN 7
#endif
#define PEN(k) ((PH_MASK >> (k)) & 1u)
#ifndef FFN_FP8
#define FFN_FP8 3
#endif
constexpr bool F8D = (FFN_FP8 & 1) != 0, F8M = (FFN_FP8 & 2) != 0;
constexpr int EBD = F8D ? 1 : 2, EBM = F8M ? 1 : 2;
template <bool B> struct Sc { static constexpr float w_gu = B ? 32.f : 1.f, w_dn = B ? 64.f : 1.f, a_sc = B ? 4.f : 1.f, dn = 1.f / (w_dn * a_sc); };
template <bool B> using FfnEpi1 = typename std::conditional<B, pg8::EpiSwiGLU8, pg8::EpiSwiGLU>::type;
template <bool B> struct Epi1Maker;
template <> struct Epi1Maker<true> { static __device__ __forceinline__ pg8::EpiSwiGLU8 make(void* O, int ldc) { return pg8::EpiSwiGLU8{(unsigned char*)O, ldc, 1.f / Sc<true>::w_gu, Sc<true>::a_sc}; } };
template <> struct Epi1Maker<false> { static __device__ __forceinline__ pg8::EpiSwiGLU make(void* O, int ldc) { return pg8::EpiSwiGLU{(unsigned short*)O, ldc}; } };

constexpr int MOE_MAT_ITEMS = 7168, MOE_GU_ITEMS = 16 * MOE_MAT_ITEMS, MOE_NITEMS = 24 * MOE_MAT_ITEMS, MOE_CHUNK = CVT_CHUNK;
constexpr int EJ0 = 2048, EJ1 = EJ0 + 5632, EJ2 = EJ1 + 5632, EJ3 = EJ2 + 5632, EJ4 = EJ3 + 3392, EJ5 = EJ4 + 216, EJ6 = EJ5 + 96, EJ7 = EJ6 + 2048;
constexpr int EARLY_ITEMS = EARLY_Q ? (EJ7 + MOE_CHUNK - 1) / MOE_CHUNK * MOE_CHUNK : 0, EARLY_NCHUNK = EARLY_ITEMS / MOE_CHUNK, MOE_NCHUNK = EARLY_NCHUNK + MOE_NITEMS / MOE_CHUNK;
struct MoeItem { const float* W; void* dst; int N, k0, n0, ldd, drow0, kdst0; float wsc; bool fp8; };
typedef const __attribute__((address_space(4))) Args* KArgs;
__device__ __forceinline__ void item_kn(MoeItem& m, int local, int N) { const int nnb = N / 32, kb = local / nnb, nb = local % nnb; m.N = N; m.k0 = kb * 64; m.n0 = nb * 32; }
__device__ __forceinline__ MoeItem moe_item(KArgs ka, unsigned char* ws, int idx0) {
    MoeItem m; m.kdst0 = 0; m.wsc = 1.f; m.fp8 = false;
    if (idx0 < EARLY_ITEMS) {
        if (idx0 < EJ0)      { item_kn(m, idx0, D); m.W = ka->in[13]; m.dst = ws + WS_WOUT; m.ldd = D; m.drow0 = m.n0; }
        else if (idx0 < EJ2) { const int up = idx0 >= EJ1; item_kn(m, idx0 - (up ? EJ1 : EJ0), DFF); m.W = ka->in[15 + up]; m.dst = ws + WS_WGU; m.ldd = D; m.drow0 = (m.n0 >> 7) * 256 + up * 128 + (m.n0 & 127); m.wsc = Sc<F8D>::w_gu; m.fp8 = F8D; }
        else if (idx0 < EJ3) { item_kn(m, idx0 - EJ2, D); m.W = ka->in[17]; m.dst = ws + WS_WDN; m.ldd = DFF; m.drow0 = m.n0; m.wsc = Sc<F8D>::w_dn; m.fp8 = F8D; }
        else if (idx0 < EJ4) { item_kn(m, idx0 - EJ3, DIN); m.W = ka->in[5] + (size_t)D * DIN; m.dst = ws + WS_WIN + (size_t)DINP * D * 2; m.ldd = D; m.drow0 = m.n0 < 576 ? m.n0 : m.n0 + 192; }
        else if (idx0 < EJ5) { item_kn(m, idx0 - EJ4, 1152); m.W = ka->in[7] + (size_t)QR * 1152; m.dst = ws + WS_WUP + (size_t)NUP * AQ * 2; m.ldd = AQ; m.drow0 = m.n0; }
        else if (idx0 < EJ6) { item_kn(m, idx0 - EJ5, 1536); m.W = ka->in[9] + (size_t)KVR * 1536; m.dst = ws + WS_WUP + (size_t)NUP * AQ * 2; m.ldd = AQ; m.drow0 = m.n0 + UC_KV; m.kdst0 = QR; }
        else if (idx0 < EJ7) { item_kn(m, idx0 - EJ6, D); m.W = ka->in[13] + (size_t)D * D; m.dst = ws + WS_WOUT + (size_t)D * D * 2; m.ldd = D; m.drow0 = m.n0; }
        else { m.W = nullptr; m.dst = nullptr; m.N = 0; m.k0 = 0; m.n0 = 0; m.ldd = 0; m.drow0 = 0; }
        return m; }
    const int idx = idx0 - EARLY_ITEMS; m.fp8 = F8M;
    if (idx < MOE_GU_ITEMS) { const int mat = idx / MOE_MAT_ITEMS, local = idx % MOE_MAT_ITEMS, e = mat >> 1, up = mat & 1, kb = local / (DFE / 32), nb = local % (DFE / 32);
        m.W = ka->in[19 + up] + (size_t)e * D * DFE; m.N = DFE; m.k0 = kb * 64; m.n0 = nb * 32; m.dst = ws + WS_MGU + (size_t)e * 2 * DFE * D * EBM; m.ldd = D;
        m.drow0 = (m.n0 >> 7) * 256 + up * 128 + (m.n0 & 127); m.wsc = Sc<F8M>::w_gu; }
    else { const int i2 = idx - MOE_GU_ITEMS, e = i2 / MOE_MAT_ITEMS, local = i2 % MOE_MAT_ITEMS, kb = local / (D / 32), nb = local % (D / 32);
        m.W = ka->in[21] + (size_t)e * DFE * D; m.N = D; m.k0 = kb * 64; m.n0 = nb * 32; m.dst = ws + WS_MDN + (size_t)e * D * DFE * EBM; m.ldd = DFE; m.drow0 = m.n0; m.wsc = Sc<F8M>::w_dn; }
    return m;
}
__device__ __forceinline__ void moe_cvt_chunk(Frame& F, KArgs ka, int c) {
    LAS float* scr = (LAS float*)(F.lds + F.wave * 16384);
    const int i0 = c * MOE_CHUNK + F.wave * (MOE_CHUNK / 8);
    f32x4 va[8], vb[8], vc[8]; MoeItem ma, mb, mc;
#define MC_L(m, v, i) do { m = moe_item(ka, F.ws, i0 + (i)); if (m.W) cvt_load(m.W, m.N, m.k0, m.n0, F.lane, v); } while (0)
#define MC_F(m, v) do { if (m.W) { if (m.fp8) cvt_finish<true>(v, m.k0, m.dst, m.ldd, m.drow0, m.kdst0, scr, F.lane, m.wsc); else cvt_finish<false>(v, m.k0, m.dst, m.ldd, m.drow0, m.kdst0, scr, F.lane, m.wsc); } } while (0)
    MC_L(ma, va, 0); MC_L(mb, vb, 1); MC_L(mc, vc, 2);
    if constexpr (MOE_CHUNK == 64) {
        MC_F(ma, va); MC_L(ma, va, 3); MC_F(mb, vb); MC_L(mb, vb, 4); MC_F(mc, vc); MC_L(mc, vc, 5);
        MC_F(ma, va); MC_L(ma, va, 6); MC_F(mb, vb); MC_L(mb, vb, 7); MC_F(mc, vc); MC_F(ma, va); MC_F(mb, vb);
    } else {
        MC_F(ma, va); MC_L(ma, va, 3); MC_F(mb, vb); MC_F(mc, vc); MC_F(ma, va);
    }
#undef MC_L
#undef MC_F
}
__device__ __forceinline__ void moe_cvt_fill(Frame& F, KArgs ka, int ph, int limit = 0) {
    { int t_ = threadIdx.x; asm volatile("" : "+v"(t_)); F.tid = t_; F.lane = t_ & 63; }
    for (;;) {
        if (F.tid == 0) { unsigned c = MOE_NCHUNK;
            if (ph < 0 || __hip_atomic_load(F.ctl + CW_DONE + ph, RLX_AGENT) < (unsigned)F.G) {
                if (limit <= 0 || __hip_atomic_load(F.ctl + CW_CVT, RLX_AGENT) < (unsigned)limit) c = __hip_atomic_fetch_add(F.ctl + CW_CVT + (ph == -2 ? 16 : 0), 1u, RLX_AGENT); }
            F.MISC[17] = c; }
        __syncthreads(); const unsigned c = F.MISC[17]; __syncthreads();
        if (c >= (unsigned)MOE_NCHUNK) break;
        moe_cvt_chunk(F, ka, (int)c);
        if (limit > 0 && c + 1 >= (unsigned)limit) {   }
    }
}
#define FILL(ph) do { __syncthreads(); if (F.tid == 0) (void)__hip_atomic_fetch_add(F.ctl + CW_DONE + (ph), 1u, RLX_AGENT); moe_cvt_fill(F, ka, (ph)); } while (0)
#ifndef MLA_DMA
#define MLA_DMA 1
#endif
#ifndef MOE_TAIL
#define MOE_TAIL 1
#endif
#ifndef GEMM_SP2
#define GEMM_SP2 1
#endif
constexpr bool SP2V = (GEMM_SP2 != 0);
#ifndef PROBE_ATT
#define PROBE_ATT 7
#endif
#ifndef FILLMASK
#define FILLMASK 7
#endif
constexpr int PH_PER_LAYER = 11, N_PHASES = 1 + 2 * PH_PER_LAYER;
#ifndef MK_N_LAUNCHES
#define MK_N_LAUNCHES 1
#endif
constexpr int N_LAUNCHES = MK_N_LAUNCHES;

__global__ void __launch_bounds__(NWAVES * 64, 2) mk_fwd(Args) {
    KArgs ka = (KArgs)__builtin_amdgcn_kernarg_segment_ptr(); asm volatile("" : "+s"(ka));
#define args (*ka)
    extern __shared__ __attribute__((aligned(16))) unsigned char lds[];
    Frame F;
    F.lds = (LAS unsigned char*)lds;
    F.MISC = (volatile LAS unsigned*)(F.lds + MISC_OFF);
    F.tid = threadIdx.x; F.lane = F.tid & 63; F.wave = __builtin_amdgcn_readfirstlane(F.tid >> 6);
    F.G = gridDim.x; F.gw = blockIdx.x * NWAVES + F.wave; F.NGW = F.G * NWAVES;
    F.ws = args.ws; F.ctl = (gu32*)(args.ws + WS_CTL);
    unsigned char* ws = args.ws;
    for (int u = F.tid; u < (LDS_BYTES - LDSCTL_OFF) / 4; u += NWAVES * 64) ((LAS unsigned*)(F.lds + LDSCTL_OFF))[u] = 0u;
    __syncthreads();
    XcdBarrier bar; bar.bar = (unsigned*)(F.ctl + CW_BAR) + args.li * 4096; bar.x = 0; bar.st = nullptr;
    if (N_LAUNCHES != N_PHASES) bar = xcd_barrier_post((unsigned*)(F.ctl + CW_BAR) + args.li * 4096, F.MISC + 8);
#define GRID_BAR() do { if (N_LAUNCHES != N_PHASES) xcd_barrier(bar); } while (0)
    const int lo = args.ph_lo, hi = args.ph_hi;
#define IN(k) (lo <= (k) && (k) < hi)
#define BOTH(k) (IN(k) && IN((k) + 1))

#define x_in (args.in[0])
#define XN8 ((unsigned char*)(ws + WS_XN))
#define WIN ((bf16*)(ws + WS_WIN))
#define WUP ((bf16*)(ws + WS_WUP))
#define WMEM ((bf16*)(ws + WS_WMEM))
#define WOUT ((bf16*)(ws + WS_WOUT))
#define WGU ((bf16*)(ws + WS_WGU))
#define WDN ((bf16*)(ws + WS_WDN))
#define MGU ((bf16*)(ws + WS_MGU))
#define MDN ((bf16*)(ws + WS_MDN))
#define XN ((bf16*)(ws + WS_XN))
#define MEMN ((bf16*)(ws + WS_MEMN))
#define MEMKV ((bf16*)(ws + WS_MEMKV))
#define PROJ ((bf16*)(ws + WS_PROJ))
#define AQKV ((bf16*)(ws + WS_AQKV))
#define KROPE ((bf16*)(ws + WS_KROPE))
#define ROPECS ((float*)(ws + WS_ROPECS))
#define QKVM ((bf16*)(ws + WS_QKVM))
#define YPRE ((att::OT*)(ws + WS_YPRE))
#define YPREF ((float*)(ws + WS_YPRE))
#define DILO ((att::OT*)(ws + WS_DILO))
#define DILS ((float*)(ws + WS_DILS))
#define Y ((bf16*)(ws + WS_Y))
#define XA ((float*)(ws + WS_XA))
#define ROUTE ((unsigned*)(ws + WS_ROUTE))
#define XP ((bf16*)(ws + WS_XP))
#define OUTP ((bf16*)(ws + WS_OUTP))
#define OUTQ ((bf16*)(ws + WS_OUTQ))
#define ACTP ((bf16*)(ws + WS_ACTP))
#define ACT ((bf16*)(ws + WS_ACTP))
#if defined(PROBE_T)
#define TSTAMP_AT(p) do { if (threadIdx.x == 0) { ((volatile LAS unsigned*)(F.lds + 131520))[(p)] = (unsigned)__builtin_amdgcn_s_memrealtime(); ((volatile LAS unsigned*)(F.lds + 131520))[32 + (p)] = (unsigned)__builtin_amdgcn_s_memtime(); } } while (0)
#else
#define TSTAMP_AT(p) do { } while (0)
#endif
#define PHASE_BEGIN() do { int t_ = threadIdx.x; asm volatile("" : "+v"(t_)); F.tid = t_; F.lane = t_ & 63; asm volatile("" : "+s"(ka)); } while (0)

    if (PEN(0) && IN(0)) { PHASE_BEGIN(); TSTAMP_AT(0);
        LAS float* scr = (LAS float*)(F.lds + F.wave * 16384);
        { const v4u z = {0u, 0u, 0u, 0u}; const int gt = blockIdx.x * (NWAVES * 64) + F.tid, ngt = F.G * NWAVES * 64;
          for (int l = 0; l < 2; ++l) {
              GAS v4u* w = (GAS v4u*)(WIN + (size_t)l * DINP * D + (size_t)576 * D); for (int i = gt; i < 192 * D / 8; i += ngt) w[i] = z;
              GAS v4u* u = (GAS v4u*)(WUP + (size_t)l * NUP * AQ);
              for (int i = gt; i < NUP * 64; i += ngt) { const int row = i >> 6, c = i & 63; const bool zero = row < 1152 ? (c >= 48) : (row < 1280 ? true : (c < 48)); if (zero) u[i] = z; } } }
        for (int rep = 0; rep < (REPEAT_PHASE == 0 ? 2 : 1); ++rep) {
        for (int l = 0; l < (EARLY_Q ? 1 : 2); ++l) {
            cvt_job<false>(F, args.in[5] + (size_t)l * D * DIN, D, DIN, WIN + (size_t)l * DINP * D, D, 0, 3, 0, scr, 1.f);
            cvt_job<false>(F, args.in[7] + (size_t)l * QR * 1152, QR, 1152, WUP + (size_t)l * NUP * AQ, AQ, 0, 0, 0, scr, 1.f);
            cvt_job<false>(F, args.in[9] + (size_t)l * KVR * 1536, KVR, 1536, WUP + (size_t)l * NUP * AQ, AQ, QR, 0, UC_KV, scr, 1.f);
            if (!EARLY_Q) cvt_job<false>(F, args.in[13] + (size_t)l * D * D, D, D, WOUT + (size_t)l * D * D, D, 0, 0, 0, scr, 1.f);
        }
        for (int l = 0; l < 2; ++l) cvt_job<false>(F, args.in[11] + (size_t)l * D * 1024, D, 1024, WMEM + (size_t)l * 1024 * D, D, 0, 0, 0, scr, 1.f);
        if (!EARLY_Q) {
        cvt_job<F8D>(F, args.in[15], D, DFF, WGU, D, 0, 1, 0, scr, Sc<F8D>::w_gu);
        cvt_job<F8D>(F, args.in[16], D, DFF, WGU, D, 0, 2, 0, scr, Sc<F8D>::w_gu);
        cvt_job<F8D>(F, args.in[17], DFF, D, WDN, DFF, 0, 0, 0, scr, Sc<F8D>::w_dn);
        }
        }
        { const int* pos = (const int*)args.in[2];
          for (int idx = blockIdx.x * (NWAVES * 64) + F.tid; idx < S * 32; idx += F.G * NWAVES * 64) { const int row = idx >> 5, i = idx & 31;
              const float ang = (float)pos[row] * args.invf[i]; float c, s; sincos_f64(ang, c, s); ROPECS[row * 64 + i] = c; ROPECS[row * 64 + 32 + i] = s; } }
        for (int m = F.gw; m < 2 * NMEM; m += F.NGW) { const int l = m >> 8, r = m & 255; rms_row_to_bf16(args.in[1] + (size_t)r * D, args.in[10] + (size_t)l * D, MEMN + (size_t)m * D, F.lane); }
        for (int m = F.gw; m < S; m += F.NGW) rms_row_to_bf16(x_in + (size_t)m * D, args.in[4], XN + (size_t)m * D, F.lane);
        if (BOTH(0)) GRID_BAR();
    }

    for (int l = 0; l < 2; ++l) {
        const int pb = 1 + l * PH_PER_LAYER;
        if (PEN(1) && IN(pb + 0)) { PHASE_BEGIN(); TSTAMP_AT(pb + 0);
            { pg8::Gemm g{XN, WIN + (size_t)l * DINP * D, 2 * D, 2 * D, D / 64}; pg8::InProjOrder So; So.so.init(S, DINP, F.G, (int)blockIdx.x); So.nextra = (l == 0) ? 8 : 0; So.A2 = MEMN; So.B2 = WMEM;
              pg8::EpiBf16Sel E{PROJ, DINP, MEMKV, 1024};
              pg8::gemm_phase<pg8::EpiBf16Sel, pg8::InProjOrder, true, SP2V>(F.lds, g, So, E); }
            if (FILLMASK & 1) FILL(pb + 0);
            if (BOTH(pb + 0)) GRID_BAR();
        }
        if (PEN(2) && IN(pb + 1)) { PHASE_BEGIN(); TSTAMP_AT(pb + 1);
            const float* gq = args.in[6] + l * QR; const float* gkv = args.in[8] + l * KVR;
            for (int m = F.gw; m < S; m += F.NGW) {
                const v4u w = *(const GAS v4u*)(PROJ + (size_t)m * DINP + F.lane * 8);
                float v[8] = {bflo(w.x), bfhi(w.x), bflo(w.y), bfhi(w.y), bflo(w.z), bfhi(w.z), bflo(w.w), bfhi(w.w)};
                float sq = 0.f;
#pragma unroll
                for (int j = 0; j < 8; ++j) sq += v[j] * v[j];
                const float sq_q = wave_sum(F.lane < 48 ? sq : 0.f), sq_kv = wave_sum(F.lane >= 48 ? sq : 0.f);
                const float rstd = F.lane < 48 ? 1.f / sqrtf(sq_q * (1.f / QR) + EPS) : 1.f / sqrtf(sq_kv * (1.f / KVR) + EPS);
                const float* gp = F.lane < 48 ? gq + F.lane * 8 : gkv + (F.lane - 48) * 8;
                const f32x4 g0 = *(const GAS f32x4*)gp, g1 = *(const GAS f32x4*)(gp + 4);
                v4u o; o.x = pk2(v[0] * rstd * g0.x, v[1] * rstd * g0.y); o.y = pk2(v[2] * rstd * g0.z, v[3] * rstd * g0.w);
                o.z = pk2(v[4] * rstd * g1.x, v[5] * rstd * g1.y); o.w = pk2(v[6] * rstd * g1.z, v[7] * rstd * g1.w);
                *(GAS v4u*)(AQKV + (size_t)m * AQ + F.lane * 8) = o;
                const int c = F.lane & 7;
                const v4u kw = *(const GAS v4u*)(PROJ + (size_t)m * DINP + 512 + c * 8);
                float kv[8] = {bflo(kw.x), bfhi(kw.x), bflo(kw.y), bfhi(kw.y), bflo(kw.z), bfhi(kw.z), bflo(kw.w), bfhi(kw.w)};
                float ko[8];
                const float* cs = ROPECS + (size_t)m * 64 + (c & 3) * 8;
#pragma unroll
                for (int j = 0; j < 8; ++j) { const float other = __shfl_xor(kv[j], 4); const float co = cs[j], si = cs[32 + j];
                    ko[j] = (c < 4) ? (kv[j] * co - other * si) : (other * si + kv[j] * co); }
                if (F.lane < 8) { v4u ow; ow.x = pk2(ko[0], ko[1]); ow.y = pk2(ko[2], ko[3]); ow.z = pk2(ko[4], ko[5]); ow.w = pk2(ko[6], ko[7]); *(GAS v4u*)(KROPE + (size_t)m * 64 + c * 8) = ow; }
            }
            if (BOTH(pb + 1)) GRID_BAR();
        }
        if (PEN(3) && IN(pb + 2)) { PHASE_BEGIN(); TSTAMP_AT(pb + 2);
            pg8::Gemm g{AQKV, WUP + (size_t)l * NUP * AQ, 2 * AQ, 2 * AQ, AQ / 64}; pg8::StaticOrder So; So.init(S, NUP, F.G, (int)blockIdx.x);
            pg8::EpiBf16 E{QKVM, NUP, 1.f};
            pg8::gemm_phase<pg8::EpiBf16, pg8::StaticOrder, true, SP2V>(F.lds, g, So, E);
            if (FILLMASK & 2) FILL(pb + 2);
            if (BOTH(pb + 2)) GRID_BAR();
        }
        if (PEN(4) && IN(pb + 3)) { PHASE_BEGIN(); TSTAMP_AT(pb + 3);
            LAS float* BIAS = (LAS float*)(F.lds + BIAS_OFF);
            for (int i = F.tid; i < 3 * 6 * 129; i += NWAVES * 64) { const int b = i / (6 * 129), rem = i % (6 * 129), h = rem / 129, j = rem % 129;
                BIAS[(b * 6 + h) * 132 + j] = args.in[3][DIL_BUCKET[b][j] * 6 + h] * att::LOG2E; }
            __syncthreads();
            for (int rep = 0; rep < (REPEAT_PHASE == 4 ? 2 : 1); ++rep) {
            gu32* qhead = F.ctl + CW_QUEUE + 64 * l + 32 * rep + 4 * args.li;
            constexpr int NU_MLA = 6 * 32, NU_MEM = 4 * 32, NU_DIL = 3 * 6 * 32, NU = NU_MLA + NU_MEM + NU_DIL;
#define QPULL(u) do { if (F.tid == 0) F.MISC[16] = __hip_atomic_fetch_add(qhead, 1u, RLX_AGENT); __syncthreads(); u = (int)F.MISC[16]; __syncthreads(); } while (0)
            int u; QPULL(u);
            if ((ATT_EN & 1) && (!args.rep || (PROBE_ATT & 1))) while (u < NU_MLA) {
                const int h = u >> 5, qb = u & 31;
                att::MLA_BODY<NUP, NUP, D>(QKVM + (size_t)qb * 256 * NUP + h * 192, QKVM + UC_KV + h * 256, KROPE, QKVM + UC_KV + h * 256 + 128,
                                                        ROPECS + (size_t)qb * 256 * 64, YPRE + (size_t)qb * 256 * D + h * 128, S, 0.07216878364870322f, (LAS char*)F.lds);
                QPULL(u);
            }
            if (args.rep && !(PROBE_ATT & 1)) { while (u < NU_MLA) QPULL(u); }
            if ((ATT_EN & 2) && (!args.rep || (PROBE_ATT & 2))) while (u < NU_MLA + NU_MEM) {
                const int v = u - NU_MLA, h = v >> 5, qb = v & 31;
                const bf16* kv = MEMKV + (size_t)l * NMEM * 1024;
                att::attn_dense_body<128, DINP, 1024, D, 1>(PROJ + (size_t)qb * 256 * DINP + PC_MEM + h * 128, kv + h * 128, nullptr, kv + 512 + h * 128,
                                                            nullptr, YPRE + (size_t)qb * 256 * D + 1536 + h * 128, NMEM, 0.08838834764831845f, (LAS char*)F.lds);
                QPULL(u);
            }
            if (args.rep && !(PROBE_ATT & 2)) { while (u < NU_MLA + NU_MEM) QPULL(u); }
            if ((ATT_EN & 4) && (!args.rep || (PROBE_ATT & 4))) while (u < NU) {
                const int w = (u - NU_MLA - NU_MEM) * 8;
                const int b = w / 1536, h = (w % 1536) >> 8, tile = w & 255;
                const int d = b == 0 ? 1 : (b == 1 ? 4 : 16), nT = S / d, tpr = nT / 32;
                const int r = tile / tpr, t0 = (tile % tpr) * 32;
                LAS float* TB = (LAS float*)(F.lds + BIAS_OFF + 3 * 6 * 132 * 4);
                for (int i = F.tid; i < 4 * 196; i += NWAVES * 64) { const int k = i / 196, j = (i % 196) + k - 32; TB[i] = (j >= 0 && j <= 128) ? BIAS[(b * 6 + h) * 132 + j] : -1e30f; }
                __syncthreads();
                att::dil_wg_unit<DINP>(PROJ, PC_DIL + h * 128, PC_DIL + 768 + h * 128, PC_DIL + 1536 + h * 128, d, r, t0, nT,
                                       DILO + (size_t)b * S * 768, h * 128, DILS + (size_t)b * S * 12 + h * 2, (LAS char*)F.lds, TB, 0.08838834764831845f * att::LOG2E);
                QPULL(u);
            }
#undef QPULL
            }
            if (FILLMASK & 4) FILL(pb + 3);
            if (BOTH(pb + 3)) GRID_BAR();
        }
        if (PEN(5) && IN(pb + 4)) { PHASE_BEGIN(); TSTAMP_AT(pb + 4);
            if (EARLY_Q && l == 0) moe_cvt_fill(F, ka, -1, EARLY_NCHUNK);
            const float* gn = args.in[12] + (size_t)l * D;
            for (int m = F.gw; m < S; m += F.NGW) {
                const att::OT* yr = YPRE + (size_t)m * D;
                f32x4 a[3]; float sa = 0.f;
#pragma unroll
                for (int j = 0; j < 3; ++j) { a[j] = ld_o4(yr + (F.lane + 64 * j) * 4); sa += (a[j].x * a[j].x + a[j].y * a[j].y) + (a[j].z * a[j].z + a[j].w * a[j].w); }
                f32x4 c[2]; float sc = 0.f;
#pragma unroll
                for (int j = 0; j < 2; ++j) { c[j] = ld_o4(yr + 1536 + (F.lane + 64 * j) * 4); sc += (c[j].x * c[j].x + c[j].y * c[j].y) + (c[j].z * c[j].z + c[j].w * c[j].w); }
                f32x4 bq[3]; float sb = 0.f;
#pragma unroll
                for (int j = 0; j < 3; ++j) { const int col = (F.lane + 64 * j) * 4, h = col >> 7;
                    float mm[3], zz[3];
#pragma unroll
                    for (int b = 0; b < 3; ++b) { const f32x2 st = *(const GAS f32x2*)(DILS + ((size_t)b * S + m) * 12 + h * 2); mm[b] = st.x; zz[b] = st.y; }
                    const float M = fmaxf(mm[0], fmaxf(mm[1], mm[2]));
                    float wgt[3], den = 0.f;
#pragma unroll
                    for (int b = 0; b < 3; ++b) { wgt[b] = __builtin_amdgcn_exp2f(mm[b] - M); den += wgt[b] * zz[b]; }
                    const float inv = 1.f / den; f32x4 acc = {0.f, 0.f, 0.f, 0.f};
#pragma unroll
                    for (int b = 0; b < 3; ++b) { const f32x4 ob = ld_o4(DILO + ((size_t)b * S + m) * 768 + col); acc += ob * (wgt[b] * inv); }
                    bq[j] = acc; sb += (acc.x * acc.x + acc.y * acc.y) + (acc.z * acc.z + acc.w * acc.w); }
                const float ra = 1.f / sqrtf(wave_sum(sa) * (1.f / 768.f) + EPS), rb = 1.f / sqrtf(wave_sum(sb) * (1.f / 768.f) + EPS), rc = 1.f / sqrtf(wave_sum(sc) * (1.f / 512.f) + EPS);
                bf16* yo = Y + (size_t)m * D;
#pragma unroll
                for (int j = 0; j < 3; ++j) { const int col = (F.lane + 64 * j) * 4; const f32x4 g = *(const GAS f32x4*)(gn + col);
                    v2u w; w.x = pk2(a[j].x * ra * g.x, a[j].y * ra * g.y); w.y = pk2(a[j].z * ra * g.z, a[j].w * ra * g.w); *(GAS v2u*)(yo + col) = w; }
#pragma unroll
                for (int j = 0; j < 3; ++j) { const int col = (F.lane + 64 * j) * 4; const f32x4 g = *(const GAS f32x4*)(gn + 768 + col);
                    v2u w; w.x = pk2(bq[j].x * rb * g.x, bq[j].y * rb * g.y); w.y = pk2(bq[j].z * rb * g.z, bq[j].w * rb * g.w); *(GAS v2u*)(yo + 768 + col) = w; }
#pragma unroll
                for (int j = 0; j < 2; ++j) { const int col = (F.lane + 64 * j) * 4; const f32x4 g = *(const GAS f32x4*)(gn + 1536 + col);
                    v2u w; w.x = pk2(c[j].x * rc * g.x, c[j].y * rc * g.y); w.y = pk2(c[j].z * rc * g.z, c[j].w * rc * g.w); *(GAS v2u*)(yo + 1536 + col) = w; }
            }
            if (BOTH(pb + 4)) GRID_BAR();
        }
        if (PEN(6) && IN(pb + 5)) { PHASE_BEGIN(); TSTAMP_AT(pb + 5);
            pg8::Gemm g{Y, WOUT + (size_t)l * D * D, 2 * D, 2 * D, D / 64}; pg8::StaticOrder So; So.init(S, D, F.G, (int)blockIdx.x);
            pg8::EpiResF32 E{l == 0 ? x_in : XA, args.rep ? YPREF : XA, D, 1.f};
            pg8::gemm_phase<pg8::EpiResF32, pg8::StaticOrder, true, SP2V>(F.lds, g, So, E);
            if (BOTH(pb + 5)) GRID_BAR();
        }
        if (PEN(7) && IN(pb + 6)) { PHASE_BEGIN(); TSTAMP_AT(pb + 6);
            const float* gf = args.in[14] + (size_t)l * D;
#if defined(PROBE_DEADLINE)
            if (l == 1 && blockIdx.x == 0 && F.tid == 0) F.ctl[CW_CVT + 16] = __hip_atomic_load(F.ctl + CW_CVT, RLX_AGENT);
#endif
            if (l == 0) { for (int m = F.gw; m < S; m += F.NGW) { if constexpr (F8D) rms_row_to_fp8(XA + (size_t)m * D, gf, XN8 + (size_t)m * D, F.lane); else rms_row_to_bf16(XA + (size_t)m * D, gf, XN + (size_t)m * D, F.lane); } }
            else {
                const float* Wr = args.in[18];
                LAS unsigned* LC = (LAS unsigned*)F.lds;
                if (F.tid < NE) LC[F.tid] = 0u;
                LAS f32x4* WL = (LAS f32x4*)(F.lds + 1024);
                for (int i = F.tid; i < 2048 * 2; i += NWAVES * 64) { const int half = i & 1, idx = i >> 1, ln = idx & 63, jq = idx >> 6, j = jq >> 2, q = jq & 3, k = (ln + 64 * j) * 4 + q;
                    WL[i] = *(const GAS f32x4*)(Wr + (size_t)k * NE + half * 4); }
                __syncthreads();
                for (int m = F.gw; m < S; m += F.NGW) {
                    const GAS f32x4* xr = (const GAS f32x4*)(XA + (size_t)m * D) + F.lane; const GAS f32x4* gr = (const GAS f32x4*)gf + F.lane;
                    f32x4 v[8]; float s = 0.f;
#pragma unroll
                    for (int j = 0; j < 8; ++j) { v[j] = xr[64 * j]; s += (v[j].x * v[j].x + v[j].y * v[j].y) + (v[j].z * v[j].z + v[j].w * v[j].w); }
                    const float rstd = 1.f / sqrtf(wave_sum(s) * (1.f / D) + EPS);
                    float lg[8] = {0.f, 0.f, 0.f, 0.f, 0.f, 0.f, 0.f, 0.f};
                    GAS v2u* o8 = (GAS v2u*)(XN + (size_t)m * D) + F.lane; GAS unsigned* o4 = (GAS unsigned*)(XN8 + (size_t)m * D) + F.lane;
#pragma unroll
                    for (int j = 0; j < 8; ++j) { const f32x4 gg = gr[64 * j]; const f32x4 hh = {v[j].x * rstd * gg.x, v[j].y * rstd * gg.y, v[j].z * rstd * gg.z, v[j].w * rstd * gg.w};
                        if constexpr (F8M) o4[64 * j] = pk4_fp8(hh.x, hh.y, hh.z, hh.w); else { v2u w; w.x = pk2(hh.x, hh.y); w.y = pk2(hh.z, hh.w); o8[64 * j] = w; }
#pragma unroll
                        for (int q = 0; q < 4; ++q) { const f32x4 w0 = WL[(((j * 4 + q) * 64) + F.lane) * 2], w1 = WL[(((j * 4 + q) * 64) + F.lane) * 2 + 1]; const float hv = hh[q];
                            lg[0] += hv * w0.x; lg[1] += hv * w0.y; lg[2] += hv * w0.z; lg[3] += hv * w0.w; lg[4] += hv * w1.x; lg[5] += hv * w1.y; lg[6] += hv * w1.z; lg[7] += hv * w1.w; } }
#pragma unroll
                    for (int e = 0; e < NE; ++e) lg[e] = wave_sum(lg[e]);
                    int e1 = 0; float v1 = lg[0];
#pragma unroll
                    for (int e = 1; e < NE; ++e) if (lg[e] > v1) { v1 = lg[e]; e1 = e; }
                    int e2 = -1; float v2 = -3.0e38f;
#pragma unroll
                    for (int e = 0; e < NE; ++e) if (e != e1 && lg[e] > v2) { v2 = lg[e]; e2 = e; }
                    const float g1 = 1.f / (1.f + __expf(v2 - v1)), g2 = 1.f - g1;
                    if (F.lane == 0) { const unsigned s1 = __hip_atomic_fetch_add(LC + e1, 1u, __ATOMIC_RELAXED, __HIP_MEMORY_SCOPE_WORKGROUP), s2 = __hip_atomic_fetch_add(LC + e2, 1u, __ATOMIC_RELAXED, __HIP_MEMORY_SCOPE_WORKGROUP);
                        v4u r0 = {(unsigned)e1, (unsigned)e2, s1, s2}; v4u r1 = {__float_as_uint(g1), __float_as_uint(g2), 0u, 0u};
                        *(GAS v4u*)(ROUTE + (size_t)m * 8) = r0; *(GAS v4u*)(ROUTE + (size_t)m * 8 + 4) = r1; }
                }
                __syncthreads();
                if (F.tid < NE) F.ctl[CW_CNTW + blockIdx.x * NE + F.tid] = LC[F.tid];
            }
            if (BOTH(pb + 6)) GRID_BAR();
        }
        if (PEN(8) && IN(pb + 7)) { PHASE_BEGIN(); TSTAMP_AT(pb + 7);
            if (l == 1) {
                moe_cvt_fill(F, ka, -1);
#if defined(PROBE_DEADLINE)
                for (int r_ = 0; r_ < PROBE_DEADLINE; ++r_) { __syncthreads(); moe_cvt_fill(F, ka, -2); }
#endif
                { LAS unsigned* LT = (LAS unsigned*)F.lds;
                  int tot = 0, bel = 0;
                  for (int w = F.lane; w < F.G; w += 64) { const int c = (int)F.ctl[CW_CNTW + w * NE + F.wave]; tot += c; bel += (w < (int)blockIdx.x) ? c : 0; }
#pragma unroll
                  for (int o = 1; o < 64; o <<= 1) { tot += __shfl_xor(tot, o); bel += __shfl_xor(bel, o); }
                  __syncthreads();
                  if (F.lane == 0) { LT[F.wave] = (unsigned)tot; LT[NE + F.wave] = (unsigned)bel; }
                  __syncthreads(); }
                int base[NE]; int tstart = 0;
#pragma unroll
                for (int e = 0; e < NE; ++e) { const int c = (int)((LAS unsigned*)F.lds)[e]; base[e] = tstart * 256 + (int)((LAS unsigned*)F.lds)[NE + e]; const int nt = (c + 255) >> 8;
                    if (blockIdx.x == 0 && F.tid == 0) { for (int t = 0; t < nt; ++t) F.ctl[CW_TILEE + 1 + tstart + t] = (unsigned)e; }
                    tstart += nt; }
                if (blockIdx.x == 0 && F.tid == 0) F.ctl[CW_TILEE] = (unsigned)tstart;
                for (int m = F.gw; m < S; m += F.NGW) {
                    const v4u r0 = *(const GAS v4u*)(ROUTE + (size_t)m * 8);
                    int p1 = (int)r0.z, p2 = (int)r0.w;
#pragma unroll
                    for (int e = 0; e < NE; ++e) { if ((int)r0.x == e) p1 += base[e]; if ((int)r0.y == e) p2 += base[e]; }
                    if (F.lane == 0) { ROUTE[(size_t)m * 8 + 6] = (unsigned)p1; ROUTE[(size_t)m * 8 + 7] = (unsigned)p2; }
                    const unsigned char* srow = (const unsigned char*)XN8 + (size_t)m * D * EBM; unsigned char* xp = (unsigned char*)XP;
                    const GAS v4u* src = (const GAS v4u*)srow + F.lane; GAS v4u* d1 = (GAS v4u*)(xp + (size_t)p1 * D * EBM) + F.lane; GAS v4u* d2 = (GAS v4u*)(xp + (size_t)p2 * D * EBM) + F.lane;
#pragma unroll
                    for (int j = 0; j < 2 * EBM; ++j) { const v4u t = src[64 * j]; d1[64 * j] = t; d2[64 * j] = t; }
                }
            }
            if (BOTH(pb + 7) && l == 1) GRID_BAR();
        }
        if (PEN(9) && IN(pb + 8)) { PHASE_BEGIN(); TSTAMP_AT(pb + 8);
            if (l == 0) { pg8::Gemm g{XN8, WGU, D * EBD, D * EBD, D * EBD / 128}; pg8::StaticOrder So; So.init(S, 2 * DFF, F.G, (int)blockIdx.x);
                FfnEpi1<F8D> E = Epi1Maker<F8D>::make(ACT, DFF);
                pg8::gemm_phase<FfnEpi1<F8D>, pg8::StaticOrder, true, SP2V, F8D>(F.lds, g, So, E); }
            else { const int ntile = (int)__hip_atomic_load(F.ctl + CW_TILEE, RLX_AGENT);
                pg8::Gemm g{XP, MGU, D * EBM, D * EBM, D * EBM / 128}; pg8::MoeOrder So{F.G, (int)blockIdx.x, 2 * DFE / 256, ntile, 2 * DFE, (const int*)(F.ctl + CW_TILEE + 1)};
                FfnEpi1<F8M> E = Epi1Maker<F8M>::make(ACTP, DFE);
                pg8::gemm_phase<FfnEpi1<F8M>, pg8::MoeOrder, true, SP2V, F8M>(F.lds, g, So, E); }
            if (BOTH(pb + 8)) GRID_BAR();
        }
        if (PEN(10) && IN(pb + 9)) { PHASE_BEGIN(); TSTAMP_AT(pb + 9);
            if (l == 0) { pg8::Gemm g{ACT, WDN, DFF * EBD, DFF * EBD, DFF * EBD / 128}; pg8::StaticOrder So; So.init(S, D, F.G, (int)blockIdx.x);
                pg8::EpiResF32 E{XA, args.rep ? YPREF : XA, D, Sc<F8D>::dn};
                pg8::gemm_phase<pg8::EpiResF32, pg8::StaticOrder, true, SP2V, F8D>(F.lds, g, So, E); }
            else { const int ntile = (int)__hip_atomic_load(F.ctl + CW_TILEE, RLX_AGENT);
                const int pm0 = MOE_TAIL ? ((2 * F.G / 8) < ntile ? (2 * F.G / 8) : ntile) : ntile;
                { pg8::Gemm g{ACTP, MDN, DFE * EBM, DFE * EBM, DFE * EBM / 128}; pg8::MoeOrder So{F.G, (int)blockIdx.x, D / 256, pm0, D, (const int*)(F.ctl + CW_TILEE + 1)};
                  pg8::EpiBf16 E{OUTP, D, Sc<F8M>::dn};
                  pg8::gemm_phase<pg8::EpiBf16, pg8::MoeOrder, true, SP2V, F8M>(F.lds, g, So, E); }
                if (MOE_TAIL && ntile > pm0) { pg8::Gemm g{ACTP, MDN, DFE * EBM, DFE * EBM, DFE * EBM / 512}; pg8::MoeTailOrder So{F.G, (int)blockIdx.x, pm0, ntile - pm0, D, DFE * EBM / 4, (const int*)(F.ctl + CW_TILEE + 1)};
                  pg8::EpiBf16Split E{OUTQ, D, Sc<F8M>::dn, pm0, (size_t)2048 * D};
                  pg8::gemm_phase<pg8::EpiBf16Split, pg8::MoeTailOrder, true, SP2V, F8M>(F.lds, g, So, E); } }
            if (BOTH(pb + 9)) GRID_BAR();
        }
        if (PEN(11) && IN(pb + 10)) { PHASE_BEGIN(); TSTAMP_AT(pb + 10);
            if (l == 0) { for (int m = F.gw; m < S; m += F.NGW) rms_row_to_bf16(XA + (size_t)m * D, args.in[4] + D, XN + (size_t)m * D, F.lane); }
            else {
                const float* gfin = args.in[22];
                const int ntile_f = (int)__hip_atomic_load(F.ctl + CW_TILEE, RLX_AGENT); const int prow0 = (MOE_TAIL ? ((2 * F.G / 8) < ntile_f ? (2 * F.G / 8) : ntile_f) : ntile_f) * 256;
                for (int m = F.gw; m < S; m += F.NGW) {
                    const v4u r1 = *(const GAS v4u*)(ROUTE + (size_t)m * 8 + 4);
                    const float g1 = __uint_as_float(r1.x), g2 = __uint_as_float(r1.y); const int p1 = (int)r1.z, p2 = (int)r1.w;
                    const GAS f32x4* xr = (const GAS f32x4*)(XA + (size_t)m * D) + F.lane;
                    const GAS v2u* o1 = (const GAS v2u*)(OUTP + (size_t)p1 * D) + F.lane; const GAS v2u* o2 = (const GAS v2u*)(OUTP + (size_t)p2 * D) + F.lane;
                    const bool t1 = p1 >= prow0, t2 = p2 >= prow0;
                    const GAS v2u* q1 = (const GAS v2u*)(OUTQ + (size_t)(t1 ? p1 - prow0 : 0) * D) + F.lane; const GAS v2u* q2 = (const GAS v2u*)(OUTQ + (size_t)(t2 ? p2 - prow0 : 0) * D) + F.lane;
                    f32x4 v[8]; float s = 0.f;
                    if (!t1 && !t2) {
#pragma unroll
                        for (int j = 0; j < 8; ++j) { const f32x4 xv = xr[64 * j]; const v2u a = o1[64 * j], b = o2[64 * j];
                            v[j] = xv + (f32x4){bflo(a.x), bfhi(a.x), bflo(a.y), bfhi(a.y)} * g1 + (f32x4){bflo(b.x), bfhi(b.x), bflo(b.y), bfhi(b.y)} * g2;
                            s += (v[j].x * v[j].x + v[j].y * v[j].y) + (v[j].z * v[j].z + v[j].w * v[j].w); }
                    } else
#pragma unroll
                    for (int j = 0; j < 8; ++j) { const f32x4 xv = xr[64 * j]; f32x4 ea, eb;
                        if (!t1) { const v2u a = o1[64 * j]; ea = (f32x4){bflo(a.x), bfhi(a.x), bflo(a.y), bfhi(a.y)}; }
                        else { ea = (f32x4){0.f, 0.f, 0.f, 0.f};
#pragma unroll
                            for (int k = 0; k < 4; ++k) { const v2u a = q1[(size_t)k * (2048 * D / 4) + 64 * j]; ea += (f32x4){bflo(a.x), bfhi(a.x), bflo(a.y), bfhi(a.y)}; } }
                        if (!t2) { const v2u b = o2[64 * j]; eb = (f32x4){bflo(b.x), bfhi(b.x), bflo(b.y), bfhi(b.y)}; }
                        else { eb = (f32x4){0.f, 0.f, 0.f, 0.f};
#pragma unroll
                            for (int k = 0; k < 4; ++k) { const v2u b = q2[(size_t)k * (2048 * D / 4) + 64 * j]; eb += (f32x4){bflo(b.x), bfhi(b.x), bflo(b.y), bfhi(b.y)}; } }
                        v[j] = xv + ea * g1 + eb * g2;
                        s += (v[j].x * v[j].x + v[j].y * v[j].y) + (v[j].z * v[j].z + v[j].w * v[j].w); }
                    const float rstd = 1.f / sqrtf(wave_sum(s) * (1.f / D) + EPS);
                    GAS f32x4* orow = (GAS f32x4*)(args.out + (size_t)m * D) + F.lane; const GAS f32x4* gr = (const GAS f32x4*)gfin + F.lane;
#pragma unroll
                    for (int j = 0; j < 8; ++j) { const f32x4 gg = gr[64 * j]; orow[64 * j] = (f32x4){v[j].x * rstd * gg.x, v[j].y * rstd * gg.y, v[j].z * rstd * gg.z, v[j].w * rstd * gg.w}; }
                }
            }
            if (BOTH(pb + 10) && l == 0) GRID_BAR();
        }
    }
#if defined(PROBE_T)
    if (blockIdx.x == 0 && threadIdx.x == 0) { const unsigned t_end = (unsigned)__builtin_amdgcn_s_memrealtime(); volatile LAS unsigned* ts_ = (volatile LAS unsigned*)(F.lds + 131520); ts_[N_PHASES] = t_end;
#if defined(PROBE_CLK)
        ts_[32 + N_PHASES] = (unsigned)__builtin_amdgcn_s_memtime(); const unsigned dt = (ts_[32 + PROBE_T + 1] - ts_[32 + PROBE_T]) / (16u * PROBE_TK);
#else
        const unsigned dt = ts_[PROBE_T + 1] - ts_[PROBE_T];
#endif
        while ((unsigned)__builtin_amdgcn_s_memrealtime() - t_end < (unsigned)PROBE_TK * dt) __builtin_amdgcn_s_sleep(32); }
#endif
#undef IN
#undef BOTH
#undef GRID_BAR
#undef WIN
#undef WUP
#undef WMEM
#undef WOUT
#undef WGU
#undef WDN
#undef MGU
#undef MDN
#undef XN
#undef MEMN
#undef MEMKV
#undef PROJ
#undef AQKV
#undef KROPE
#undef ROPECS
#undef QKVM
#undef YPRE
#undef YPREF
#undef DILO
#undef DILS
#undef Y
#undef XA
#undef ROUTE
#undef XP
#undef OUTP
#undef OUTQ
#undef ACTP
#undef ACT
#undef x_in
#undef XN8
#undef PHASE_BEGIN
#undef args
#undef FILL
}

extern "C" void kernel_launch(void* const* d_in, const int* in_sizes, int n_in, void* d_out, int out_size, void* d_ws, size_t ws_size, hipStream_t stream) {
    static int grid = 0;
    if (grid == 0) {
        if (n_in != 23 || in_sizes[0] != S * D || out_size != S * D || ws_size < WS_END) { fprintf(stderr, "kernel_launch: shape/workspace mismatch: n_in %d in0 %d out %d ws %zu (need %zu)\n", n_in, n_in > 0 ? in_sizes[0] : -1, out_size, ws_size, (size_t)WS_END); grid = -1; return; }
        int dev = 0, cus = 0, per_cu = 0;
        if (hipGetDevice(&dev) != hipSuccess || hipDeviceGetAttribute(&cus, hipDeviceAttributeMultiprocessorCount, dev) != hipSuccess) { fprintf(stderr, "kernel_launch: device query failed\n"); grid = -1; return; }
        if (hipFuncSetAttribute((const void*)mk_fwd, hipFuncAttributeMaxDynamicSharedMemorySize, LDS_BYTES) != hipSuccess) { fprintf(stderr, "kernel_launch: hipFuncSetAttribute failed\n"); grid = -1; return; }
        if (hipOccupancyMaxActiveBlocksPerMultiprocessor(&per_cu, (const void*)mk_fwd, NWAVES * 64, LDS_BYTES) != hipSuccess || per_cu < 1) { fprintf(stderr, "kernel_launch: occupancy query reports %d workgroups per CU\n", per_cu); }
        (void)hipGetLastError();
        grid = cus;
    }
    if (grid < 0) return;
    (void)hipMemsetAsync((char*)d_ws + WS_CTL, 0, CTL_ZERO_BYTES, stream);
    Args a{};
    for (int i = 0; i < 23; ++i) a.in[i] = (const float*)d_in[i];
    a.out = (float*)d_out; a.ws = (unsigned char*)d_ws;
    for (int i = 0; i < 32; ++i) a.invf[i] = 1.0f / powf(10000.0f, (float)i / 32.0f);
    int lo[8], hi[8], rp[8], nl = 0;
#if defined(PROBE_PHASE) && PROBE_PHASE >= 0
    lo[nl] = 0; hi[nl] = PROBE_PHASE + 1; rp[nl++] = 0;
    for (int r = 0; r < PROBE_REPS; ++r) { lo[nl] = PROBE_PHASE; hi[nl] = PROBE_PHASE + 1; rp[nl++] = 1; }
    if (PROBE_PHASE + 1 < N_PHASES) { lo[nl] = PROBE_PHASE + 1; hi[nl] = N_PHASES; rp[nl++] = 0; }
#else
    if (N_LAUNCHES == N_PHASES) { nl = 0; } else { lo[0] = 0; hi[0] = N_PHASES; rp[0] = 0; nl = 1; }
#endif
    const int total = (N_LAUNCHES == N_PHASES) ? N_PHASES : nl;
    for (int li = 0; li < total; ++li) {
        if (N_LAUNCHES == N_PHASES) { a.ph_lo = li; a.ph_hi = li + 1; a.li = 0; a.rep = 0; } else { a.ph_lo = lo[li]; a.ph_hi = hi[li]; a.li = li; a.rep = rp[li]; }
        hipLaunchKernelGGL(mk_fwd, dim3(grid), dim3(NWAVES * 64), LDS_BYTES, stream, a);
        const hipError_t le = hipPeekAtLastError();
        if (le != hipSuccess) { fprintf(stderr, "kernel_launch: launch %d failed: %s\n", li, hipGetErrorName(le)); break; }
    }
}
```

```cpp
#include <hip/hip_runtime.h>
#include <cstdio>
#include <cstdint>
#include <cmath>
#include <type_traits>
#ifndef MK_N_LAUNCHES
#define MK_N_LAUNCHES 1
#endif
#define REPEAT_PHASE -1
#define FFN_FP8 3
#define PROBE_PHASE -1
#define PROBE_REPS 3
#define FILLMASK 5
#define MLA_DMA 0
#define PROBE_ATT 7
#define GEMM_SP2 1
#define PRE_ROWS 4
#define COMB_ROWS 2
#define CVT_CHUNK 32
#define CONV_WGS 1
#define NCV_G 28
#define NCV_U 64
#define NCV_T 64
#define NCV_A 48
#define XA_BF16 0
#define ATT_OBF16 1
#define MOE_TAIL 1
#define CVT_REG 0
#define CVT_BYTE_T 1
#define CVT_FIRST 1
#define CVT_Q0 8
namespace pg8 {
#define PG8_LAS __attribute__((address_space(3)))
typedef unsigned short bf16_t;
typedef short bf16x8 __attribute__((ext_vector_type(8)));
typedef float f32x4 __attribute__((ext_vector_type(4)));
typedef unsigned u32x4 __attribute__((ext_vector_type(4)));
constexpr int BM = 256, BK = 64, HALF = 128, HTB = HALF * BK * 2  , STAGE_BYTES = 8 * HTB, NXCD = 8, WGM = 8;

__host__ __device__ __forceinline__ int lds_byte(int r, int c) { const int st = (r >> 4) * 2 + (c >> 5), rr = r & 15, cc = c & 31, ob = rr * 64 + cc * 2; return st * 1024 + (ob ^ (((ob >> 9) & 1) << 5)); }
__host__ __device__ __forceinline__ void stage_rc(int b, int& R, int& C) { const int st = b / 1024, sb = b % 1024, swz = sb ^ (((sb >> 9) & 1) << 5); R = (st >> 1) * 16 + swz / 64; C = (st & 1) * 32 + (swz % 64) / 2; }
__host__ __device__ __forceinline__ int perm32(int rho) { const int n = rho >> 4, i = rho & 15; return 8 * (i >> 2) + 4 * n + (i & 3); }

struct Unit { int pm, pn; };
struct Gemm { const void* A; const void* Bt; int lda, ldb, nt; };

struct StaticOrder {
    int nM, nN, nwg, G, c;
    __device__ void init(int M, int N, int G_, int c_) { nM = M / BM; nN = N / BM; nwg = nM * nN; G = G_; c = c_; }
    __device__ bool next(int i, Unit& u) const {
        const long L = (long)i * G + c; if (L >= nwg) return false;
        int wgid = (int)L; { const int q = nwg / NXCD, r = nwg % NXCD, xcd = wgid % NXCD, off = wgid / NXCD; wgid = (xcd < r ? xcd * (q + 1) : r * (q + 1) + (xcd - r) * q) + off; }
        const int nig = WGM * nN, gid = wgid / nig, fm = gid * WGM, gsz = (nM - fm) < WGM ? (nM - fm) : WGM;
        u.pm = fm + ((wgid % nig) % gsz); u.pn = (wgid % nig) / gsz; return true;
    }
    __device__ __forceinline__ const char* abase(const Gemm& g, const Unit& u) const { return (const char*)g.A + (size_t)u.pm * BM * g.lda; }
    __device__ __forceinline__ const char* bbase(const Gemm& g, const Unit& u) const { return (const char*)g.Bt + (size_t)u.pn * BM * g.ldb; }
};
struct InProjOrder {
    StaticOrder so; int nextra; const void* A2; const void* B2;
    __device__ bool next(int i, Unit& u) const { if (so.next(i, u)) return true; const long L = (long)i * so.G + so.c - so.nwg; if (L < 0 || L >= nextra) return false; u.pm = 32 + (int)(L >> 2); u.pn = (int)(L & 3); return true; }
    __device__ __forceinline__ const char* abase(const Gemm& g, const Unit& u) const { return u.pm < 32 ? (const char*)g.A + (size_t)u.pm * BM * g.lda : (const char*)A2 + (size_t)(u.pm - 32) * BM * g.lda; }
    __device__ __forceinline__ const char* bbase(const Gemm& g, const Unit& u) const { return u.pm < 32 ? (const char*)g.Bt + (size_t)u.pn * BM * g.ldb : (const char*)B2 + (size_t)((u.pm - 32) * 1024 + u.pn * BM) * g.ldb; }
};
struct MemOrder {
    int G, c;
    __device__ bool next(int i, Unit& u) const { const int L = c - (G - 8); if (i != 0 || L < 0 || L >= 8) return false; u.pm = L >> 2; u.pn = L & 3; return true; }
    __device__ __forceinline__ const char* abase(const Gemm& g, const Unit& u) const { return (const char*)g.A + (size_t)u.pm * BM * g.lda; }
    __device__ __forceinline__ const char* bbase(const Gemm& g, const Unit& u) const { return (const char*)g.Bt + (size_t)(u.pm * 1024 + u.pn * BM) * g.ldb; }
};
struct MoeOrder {
    int G, c, nN, ntile, nexp_rows; const int* tile_e;
    __device__ bool next(int i, Unit& u) const { const long L = (long)i * G + c; if (L >= (long)ntile * nN) return false; u.pm = (int)(L / nN); u.pn = (int)(L % nN); return true; }
    __device__ __forceinline__ const char* abase(const Gemm& g, const Unit& u) const { return (const char*)g.A + (size_t)u.pm * BM * g.lda; }
    __device__ __forceinline__ const char* bbase(const Gemm& g, const Unit& u) const { const int e = __builtin_amdgcn_readfirstlane(tile_e[u.pm]); return (const char*)g.Bt + ((size_t)e * nexp_rows + (size_t)u.pn * BM) * g.ldb; }
};

struct MoeTailOrder {
    int G, c, pm0, ntail, nexp_rows, kq_bytes; const int* tile_e;
    __device__ bool next(int i, Unit& u) const { const long L = (long)i * G + c; if (L >= (long)ntail * 32) return false; const int ks = (int)(L & 3), rest = (int)(L >> 2); u.pm = pm0 + (rest >> 3); u.pn = (rest & 7) + 8 * ks; return true; }
    __device__ __forceinline__ const char* abase(const Gemm& g, const Unit& u) const { return (const char*)g.A + (size_t)u.pm * BM * g.lda + (size_t)(u.pn >> 3) * kq_bytes; }
    __device__ __forceinline__ const char* bbase(const Gemm& g, const Unit& u) const { const int e = __builtin_amdgcn_readfirstlane(tile_e[u.pm]); return (const char*)g.Bt + ((size_t)e * nexp_rows + (size_t)(u.pn & 7) * BM) * g.ldb + (size_t)(u.pn >> 3) * kq_bytes; }
};

__device__ __forceinline__ unsigned cvt_pk_bf16(float lo, float hi) { unsigned r; asm volatile("v_cvt_pk_bf16_f32 %0, %1, %2" : "=v"(r) : "v"(lo), "v"(hi)); return r; }

struct EpiBf16 {
    static constexpr bool PERM = true;
    bf16_t* O; int ldc; float sc;
    __device__ __forceinline__ void operator()(const f32x4 (&acc)[2][2][4][2], const Unit& u, int wr, int wc, int fr, int fq) const {
        const int row0 = u.pm * BM + wr * 64 + fr, col0 = u.pn * BM + wc * 32 + 8 * fq;
#pragma unroll
        for (int ai = 0; ai < 2; ++ai)
#pragma unroll
            for (int m = 0; m < 4; ++m) { bf16_t* rowp = O + (size_t)(row0 + ai * HALF + m * 16) * ldc + col0;
#pragma unroll
                for (int bj = 0; bj < 2; ++bj) { const f32x4 v0 = acc[ai][bj][m][0] * sc, v1 = acc[ai][bj][m][1] * sc;
                    u32x4 w; w.x = cvt_pk_bf16(v0[0], v0[1]); w.y = cvt_pk_bf16(v0[2], v0[3]); w.z = cvt_pk_bf16(v1[0], v1[1]); w.w = cvt_pk_bf16(v1[2], v1[3]);
                    *(u32x4*)(rowp + bj * HALF) = w; } }
    }
};
struct EpiBf16Split {
    static constexpr bool PERM = true;
    bf16_t* O; int ldc; float sc; int pm0; size_t qstride;
    __device__ __forceinline__ void operator()(const f32x4 (&acc)[2][2][4][2], const Unit& u, int wr, int wc, int fr, int fq) const {
        const int row0 = (u.pm - pm0) * BM + wr * 64 + fr, col0 = (u.pn & 7) * BM + wc * 32 + 8 * fq; bf16_t* base = O + (size_t)(u.pn >> 3) * qstride;
#pragma unroll
        for (int ai = 0; ai < 2; ++ai)
#pragma unroll
            for (int m = 0; m < 4; ++m) { bf16_t* rowp = base + (size_t)(row0 + ai * HALF + m * 16) * ldc + col0;
#pragma unroll
                for (int bj = 0; bj < 2; ++bj) { const f32x4 v0 = acc[ai][bj][m][0] * sc, v1 = acc[ai][bj][m][1] * sc;
                    u32x4 w; w.x = cvt_pk_bf16(v0[0], v0[1]); w.y = cvt_pk_bf16(v0[2], v0[3]); w.z = cvt_pk_bf16(v1[0], v1[1]); w.w = cvt_pk_bf16(v1[2], v1[3]);
                    *(u32x4*)(rowp + bj * HALF) = w; } }
    }
};
struct EpiBf16Sel {
    static constexpr bool PERM = true;
    bf16_t* O; int ldc; bf16_t* O2; int ldc2;
    __device__ __forceinline__ void operator()(const f32x4 (&acc)[2][2][4][2], const Unit& u, int wr, int wc, int fr, int fq) const {
        const bool ex = u.pm >= 32; bf16_t* base = ex ? O2 : O; const int ld = ex ? ldc2 : ldc;
        const int row0 = (ex ? u.pm - 32 : u.pm) * BM + wr * 64 + fr, col0 = u.pn * BM + wc * 32 + 8 * fq;
#pragma unroll
        for (int ai = 0; ai < 2; ++ai)
#pragma unroll
            for (int m = 0; m < 4; ++m) { bf16_t* rowp = base + (size_t)(row0 + ai * HALF + m * 16) * ld + col0;
#pragma unroll
                for (int bj = 0; bj < 2; ++bj) { const f32x4 v0 = acc[ai][bj][m][0], v1 = acc[ai][bj][m][1];
                    u32x4 w; w.x = cvt_pk_bf16(v0[0], v0[1]); w.y = cvt_pk_bf16(v0[2], v0[3]); w.z = cvt_pk_bf16(v1[0], v1[1]); w.w = cvt_pk_bf16(v1[2], v1[3]);
                    *(u32x4*)(rowp + bj * HALF) = w; } }
    }
};
struct EpiResF32 {
    static constexpr bool PERM = false;
    const float* R; float* C; int ldc; float sc;
    __device__ __forceinline__ void operator()(const f32x4 (&acc)[2][2][4][2], const Unit& u, int wr, int wc, int fr, int fq) const {
        const int row0 = u.pm * BM + wr * 64 + fr, col0 = u.pn * BM + wc * 32 + 4 * fq;
#pragma unroll
        for (int ai = 0; ai < 2; ++ai)
#pragma unroll
            for (int m = 0; m < 4; ++m) { const size_t off = (size_t)(row0 + ai * HALF + m * 16) * ldc + col0;
#pragma unroll
                for (int bj = 0; bj < 2; ++bj)
#pragma unroll
                    for (int n = 0; n < 2; ++n) { const f32x4 r = *(const f32x4*)(R + off + bj * HALF + n * 16); *(f32x4*)(C + off + bj * HALF + n * 16) = r + acc[ai][bj][m][n] * sc; } }
    }
};
__device__ __forceinline__ float silu_mul(float g, float u) { return g * u * __builtin_amdgcn_rcpf(1.0f + __builtin_amdgcn_exp2f(-1.4426950408889634f * g)); }
struct EpiSwiGLU {
    static constexpr bool PERM = true;
    bf16_t* O; int ldc;
    __device__ __forceinline__ void operator()(const f32x4 (&acc)[2][2][4][2], const Unit& u, int wr, int wc, int fr, int fq) const {
        const int row0 = u.pm * BM + wr * 64 + fr, col0 = u.pn * HALF + wc * 32 + 8 * fq;
#pragma unroll
        for (int ai = 0; ai < 2; ++ai)
#pragma unroll
            for (int m = 0; m < 4; ++m) { bf16_t* rowp = O + (size_t)(row0 + ai * HALF + m * 16) * ldc + col0;
                const f32x4 g0 = acc[ai][0][m][0], g1 = acc[ai][0][m][1], u0 = acc[ai][1][m][0], u1 = acc[ai][1][m][1];
                u32x4 w; w.x = cvt_pk_bf16(silu_mul(g0[0], u0[0]), silu_mul(g0[1], u0[1])); w.y = cvt_pk_bf16(silu_mul(g0[2], u0[2]), silu_mul(g0[3], u0[3]));
                w.z = cvt_pk_bf16(silu_mul(g1[0], u1[0]), silu_mul(g1[1], u1[1])); w.w = cvt_pk_bf16(silu_mul(g1[2], u1[2]), silu_mul(g1[3], u1[3]));
                *(u32x4*)rowp = w; }
    }
};

typedef int v8i_t __attribute__((ext_vector_type(8)));
__device__ __forceinline__ v8i_t pg8_cat(bf16x8 lo, bf16x8 hi) { typedef int v4i_t __attribute__((ext_vector_type(4))); const v4i_t a = __builtin_bit_cast(v4i_t, lo), b = __builtin_bit_cast(v4i_t, hi); return (v8i_t){a.x, a.y, a.z, a.w, b.x, b.y, b.z, b.w}; }
struct EpiSwiGLU8 {
    static constexpr bool PERM = true;
    unsigned char* O; int ldc; float sc_in, sc_out;
    __device__ __forceinline__ void operator()(const f32x4 (&acc)[2][2][4][2], const Unit& u, int wr, int wc, int fr, int fq) const {
        const int row0 = u.pm * BM + wr * 64 + fr, col0 = u.pn * HALF + wc * 32 + 8 * fq;
#pragma unroll
        for (int ai = 0; ai < 2; ++ai)
#pragma unroll
            for (int m = 0; m < 4; ++m) { unsigned char* rowp = O + (size_t)(row0 + ai * HALF + m * 16) * ldc + col0;
                const f32x4 g0 = acc[ai][0][m][0] * sc_in, g1 = acc[ai][0][m][1] * sc_in, u0 = acc[ai][1][m][0] * (sc_in * sc_out), u1 = acc[ai][1][m][1] * (sc_in * sc_out);
                int w0 = 0, w1 = 0;
                w0 = __builtin_amdgcn_cvt_pk_fp8_f32(silu_mul(g0[0], u0[0]), silu_mul(g0[1], u0[1]), w0, false); w0 = __builtin_amdgcn_cvt_pk_fp8_f32(silu_mul(g0[2], u0[2]), silu_mul(g0[3], u0[3]), w0, true);
                w1 = __builtin_amdgcn_cvt_pk_fp8_f32(silu_mul(g1[0], u1[0]), silu_mul(g1[1], u1[1]), w1, false); w1 = __builtin_amdgcn_cvt_pk_fp8_f32(silu_mul(g1[2], u1[2]), silu_mul(g1[3], u1[3]), w1, true);
                typedef int v2i_t __attribute__((ext_vector_type(2))); *(v2i_t*)rowp = (v2i_t){w0, w1}; }
    }
};
__device__ __forceinline__ void pg8_mfma8(f32x4& c, v8i_t a, v8i_t b, int sc) { asm volatile("v_mfma_scale_f32_16x16x128_f8f6f4 %0, %1, %2, %0, %3, %3 op_sel_hi:[0,0,0]" : "+v"(c) : "v"(a), "v"(b), "v"(sc)); }
template <class Epi, class Sched, bool ALIGN_EPI = false, bool SP2 = false, bool FP8 = false>
__device__ __forceinline__ void gemm_phase(PG8_LAS unsigned char* lds, const Gemm g, const Sched& S, const Epi& E) {
    int tid_ = threadIdx.x; asm volatile("" : "+v"(tid_));
    const int tid = tid_, wid = __builtin_amdgcn_readfirstlane(tid >> 6), lane = tid & 63, wr = wid >> 2, wc = wid & 3, fr = lane & 15, fq = lane >> 4;
    const int nt = g.nt;
    unsigned voffA[2], voffB[2];
#pragma unroll
    for (int i = 0; i < 2; ++i) { int R, C; stage_rc(tid * 16 + i * 8192, R, C); const int Rb = Epi::PERM ? ((R & ~31) + perm32(R & 31)) : R;
        voffA[i] = (unsigned)(R * g.lda + C * 2); voffB[i] = (unsigned)(Rb * g.ldb + C * 2); }
    const size_t kstep = (size_t)(BK * 2);
    const size_t hstepA = (size_t)HALF * g.lda, hstepB = (size_t)HALF * g.ldb;
    const unsigned ldsw = (unsigned)wid * 1024u;
    const int aoff = lds_byte(wr * 64 + fr, fq * 8), boff = lds_byte(wc * 32 + fr, fq * 8);
#define PG8_SA(b, h) (((b) * 2 + (h)) * HTB)
#define PG8_SB(b, h) ((4 + (b) * 2 + (h)) * HTB)
#define PG8_STAGE(bufoff, gbase, voff) do { _Pragma("unroll") for (int _i = 0; _i < 2; ++_i) \
        __builtin_amdgcn_global_load_lds((const unsigned*)((const char*)(gbase) + (voff)[_i]), (PG8_LAS unsigned*)(lds + (bufoff) + ldsw + _i * 8192), 16, 0, 0); } while (0)
#define PG8_LDA(dst, b, h) do { _Pragma("unroll") for (int m = 0; m < 4; ++m) _Pragma("unroll") for (int k = 0; k < 2; ++k) dst[m][k] = *(const PG8_LAS bf16x8*)(lds + PG8_SA(b, h) + aoff + m * 2048 + k * 1024); } while (0)
#define PG8_LDB(dst, b, h) do { _Pragma("unroll") for (int n = 0; n < 2; ++n) _Pragma("unroll") for (int k = 0; k < 2; ++k) dst[n][k] = *(const PG8_LAS bf16x8*)(lds + PG8_SB(b, h) + boff + n * 2048 + k * 1024); } while (0)
#define PG8_MMA(ai, bj, At, Bt) do { __builtin_amdgcn_s_setprio(1); if constexpr (FP8) { _Pragma("unroll") for (int m = 0; m < 4; ++m) _Pragma("unroll") for (int n = 0; n < 2; ++n) \
        pg8_mfma8(acc[ai][bj][m][n], pg8_cat(Bt[n][0], Bt[n][1]), pg8_cat(At[m][0], At[m][1]), sc8); } else { \
        _Pragma("unroll") for (int m = 0; m < 4; ++m) _Pragma("unroll") for (int n = 0; n < 2; ++n) _Pragma("unroll") for (int k = 0; k < 2; ++k) \
        acc[ai][bj][m][n] = __builtin_amdgcn_mfma_f32_16x16x32_bf16(Bt[n][k], At[m][k], acc[ai][bj][m][n], 0, 0, 0); } __builtin_amdgcn_s_setprio(0); } while (0)
#define PG8_WAIT_V(n) asm volatile("s_waitcnt vmcnt(" #n ")" ::: "memory")
#define PG8_WAIT_L(n) asm volatile("s_waitcnt lgkmcnt(" #n ")" ::: "memory")
#define PG8_BAR __builtin_amdgcn_s_barrier()
#define PG8_SCHED __builtin_amdgcn_sched_barrier(0)
    Unit cur, nxt; int ui = 0;
    if (!S.next(0, cur)) return;
    int sc8 = 0x7F7F7F7F; asm volatile("" : "+v"(sc8));
    f32x4 acc[2][2][4][2];
#pragma unroll
    for (int a = 0; a < 2; ++a)
#pragma unroll
        for (int b = 0; b < 2; ++b)
#pragma unroll
            for (int m = 0; m < 4; ++m)
#pragma unroll
                for (int n = 0; n < 2; ++n) acc[a][b][m][n] = (f32x4){0.f, 0.f, 0.f, 0.f};
    bf16x8 At[4][2], B0[2][2], B1[2][2];
    const char* cA = S.abase(g, cur); const char* cB = S.bbase(g, cur);
    if constexpr (SP2) {
        PG8_STAGE(PG8_SB(0, 0), cB, voffB); PG8_STAGE(PG8_SB(0, 1), cB + hstepB, voffB); PG8_STAGE(PG8_SA(0, 0), cA, voffA); PG8_STAGE(PG8_SA(0, 1), cA + hstepA, voffA);
        if (wr == 1) PG8_BAR;
        PG8_WAIT_V(2); PG8_BAR;
        PG8_STAGE(PG8_SB(1, 0), cB + kstep, voffB); PG8_STAGE(PG8_SA(1, 0), cA + kstep, voffA); PG8_STAGE(PG8_SB(1, 1), cB + hstepB + kstep, voffB);
        PG8_WAIT_V(6); PG8_BAR;
    } else {
        PG8_STAGE(PG8_SB(0, 0), cB, voffB); PG8_STAGE(PG8_SA(0, 0), cA, voffA); PG8_STAGE(PG8_SB(0, 1), cB + hstepB, voffB); PG8_STAGE(PG8_SA(0, 1), cA + hstepA, voffA);
        if (wr == 1) PG8_BAR;
        PG8_WAIT_V(4); PG8_BAR;
        PG8_STAGE(PG8_SB(1, 0), cB + kstep, voffB); PG8_STAGE(PG8_SA(1, 0), cA + kstep, voffA); PG8_STAGE(PG8_SB(1, 1), cB + hstepB + kstep, voffB);
        PG8_WAIT_V(6); PG8_BAR;
    }
    for (;;) {
        const bool has_next = S.next(ui + 1, nxt);
        const char* nA = has_next ? S.abase(g, nxt) : cA; const char* nB = has_next ? S.bbase(g, nxt) : cB;
        for (int t = 0; t < nt; t += 2) {
            const bool last = (t == nt - 2);
            const char* a1 = cA + (size_t)(t + 1) * kstep;
            const char* a2 = last ? nA : cA + (size_t)(t + 2) * kstep; const char* b2 = last ? nB : cB + (size_t)(t + 2) * kstep;
            const char* a3 = a2 + kstep; const char* b3 = b2 + kstep;
            if constexpr (SP2) {
            PG8_LDB(B0, 0, 0); PG8_LDB(B1, 0, 1); PG8_SCHED; PG8_LDA(At, 0, 0); PG8_STAGE(PG8_SA(1, 1), a1 + hstepA, voffA);
            PG8_WAIT_V(8); PG8_WAIT_L(0); PG8_BAR; PG8_MMA(0, 0, At, B0); PG8_MMA(0, 1, At, B1); PG8_BAR; PG8_SCHED;
            PG8_LDA(At, 0, 1); PG8_STAGE(PG8_SB(0, 0), b2, voffB); PG8_STAGE(PG8_SB(0, 1), b2 + hstepB, voffB); PG8_STAGE(PG8_SA(0, 0), a2, voffA);
            PG8_WAIT_V(8); PG8_WAIT_L(0); PG8_BAR; PG8_MMA(1, 0, At, B0); PG8_MMA(1, 1, At, B1); PG8_BAR; PG8_SCHED;
            PG8_LDB(B0, 1, 0); PG8_LDB(B1, 1, 1); PG8_SCHED; PG8_LDA(At, 1, 0); PG8_STAGE(PG8_SA(0, 1), a2 + hstepA, voffA);
            PG8_WAIT_V(8); PG8_WAIT_L(0); PG8_BAR; PG8_MMA(0, 0, At, B0); PG8_MMA(0, 1, At, B1); PG8_BAR; PG8_SCHED;
            PG8_LDA(At, 1, 1); PG8_STAGE(PG8_SB(1, 0), b3, voffB); PG8_STAGE(PG8_SB(1, 1), b3 + hstepB, voffB); PG8_STAGE(PG8_SA(1, 0), a3, voffA);
            PG8_WAIT_V(8); PG8_WAIT_L(0); PG8_BAR; PG8_MMA(1, 0, At, B0); PG8_MMA(1, 1, At, B1); PG8_BAR; PG8_SCHED;
            } else {
            PG8_LDB(B0, 0, 0); PG8_SCHED; PG8_LDA(At, 0, 0); PG8_STAGE(PG8_SA(1, 1), a1 + hstepA, voffA);
            PG8_WAIT_L(8); PG8_BAR; PG8_WAIT_L(0); PG8_MMA(0, 0, At, B0); PG8_BAR; PG8_SCHED;
            PG8_LDB(B1, 0, 1); PG8_STAGE(PG8_SB(0, 0), b2, voffB);
            PG8_BAR; PG8_WAIT_L(0); PG8_MMA(0, 1, At, B1); PG8_BAR;
            PG8_LDA(At, 0, 1); PG8_STAGE(PG8_SA(0, 0), a2, voffA);
            PG8_BAR; PG8_WAIT_L(0); PG8_MMA(1, 0, At, B0); PG8_BAR; PG8_SCHED;
            PG8_STAGE(PG8_SB(0, 1), b2 + hstepB, voffB);
            PG8_WAIT_V(6); PG8_BAR; PG8_MMA(1, 1, At, B1); PG8_BAR;
            PG8_LDB(B0, 1, 0); PG8_SCHED; PG8_LDA(At, 1, 0); PG8_STAGE(PG8_SA(0, 1), a2 + hstepA, voffA);
            PG8_WAIT_L(8); PG8_BAR; PG8_WAIT_L(0); PG8_MMA(0, 0, At, B0); PG8_BAR; PG8_SCHED;
            PG8_LDB(B1, 1, 1); PG8_STAGE(PG8_SB(1, 0), b3, voffB);
            PG8_BAR; PG8_WAIT_L(0); PG8_MMA(0, 1, At, B1); PG8_BAR;
            PG8_LDA(At, 1, 1); PG8_STAGE(PG8_SA(1, 0), a3, voffA);
            PG8_BAR; PG8_WAIT_L(0); PG8_MMA(1, 0, At, B0); PG8_BAR; PG8_SCHED;
            PG8_STAGE(PG8_SB(1, 1), b3 + hstepB, voffB);
            PG8_WAIT_V(6); PG8_BAR; PG8_MMA(1, 1, At, B1); PG8_BAR;
            }
        }
        if constexpr (ALIGN_EPI) { if (wr == 0) PG8_BAR; }
        if constexpr (FP8) { PG8_SCHED; asm volatile("s_nop 15\n\ts_nop 7" ::: "memory"); PG8_SCHED; }
        E(acc, cur, wr, wc, fr, fq);
        if (!has_next) break;
#pragma unroll
        for (int a = 0; a < 2; ++a)
#pragma unroll
            for (int b = 0; b < 2; ++b)
#pragma unroll
                for (int m = 0; m < 4; ++m)
#pragma unroll
                    for (int n = 0; n < 2; ++n) acc[a][b][m][n] = (f32x4){0.f, 0.f, 0.f, 0.f};
        cur = nxt; cA = nA; cB = nB; ++ui;
        if constexpr (ALIGN_EPI) { if (wr == 1) PG8_BAR; }
    }
    PG8_WAIT_V(0);
    if constexpr (!ALIGN_EPI) { if (wr == 0) PG8_BAR; }
    PG8_BAR;
#undef PG8_SA
#undef PG8_SB
#undef PG8_STAGE
#undef PG8_LDA
#undef PG8_LDB
#undef PG8_MMA
#undef PG8_WAIT_V
#undef PG8_WAIT_L
#undef PG8_BAR
#undef PG8_SCHED
}
}
namespace att {
#define ATT_LAS __attribute__((address_space(3)))
#define ATT_GAS __attribute__((address_space(1)))
typedef unsigned short bf16;
using bf16x8 = __attribute__((ext_vector_type(8))) short;
using s16x4  = __attribute__((ext_vector_type(4))) short;
using f32x16 = __attribute__((ext_vector_type(16))) float;
using f32x4  = __attribute__((ext_vector_type(4))) float;
using u32x4  = __attribute__((ext_vector_type(4))) unsigned;
constexpr int NW = 8, QBLK = 32, KVBLK = 64, DV = 128;
constexpr float LOG2E = 1.4426950408889634f;
#if defined(ATT_OBF16) && ATT_OBF16
typedef unsigned short OT;
#else
typedef float OT;
#endif
#define SBAR() __builtin_amdgcn_sched_barrier(0)
__device__ __forceinline__ int crow(int r, int hi) { return (r & 3) + 8 * (r >> 2) + 4 * hi; }
__device__ __forceinline__ unsigned cvtpk(float lo, float hi) { unsigned r; asm volatile("v_cvt_pk_bf16_f32 %0, %1, %2" : "=v"(r) : "v"(lo), "v"(hi)); return r; }
__device__ __forceinline__ float bf2f(short s) { return __uint_as_float(((unsigned)(unsigned short)s) << 16); }
__device__ __forceinline__ void st_o(float* p, float v) { *p = v; }
__device__ __forceinline__ void st_o(unsigned short* p, float v) { *p = (unsigned short)(cvtpk(v, v) & 0xffffu); }

__device__ __forceinline__ void partialSM(f32x16& p0, f32x16& p1, float& m_reg, float& mn, float& alpha, const float C, const float THRS) {
  float pmax = p0[0];
#pragma unroll
  for (int r = 1; r < 16; ++r) pmax = fmaxf(pmax, p0[r]);
#pragma unroll
  for (int r = 0; r < 16; ++r) pmax = fmaxf(pmax, p1[r]);
  { auto rr = __builtin_amdgcn_permlane32_swap(__float_as_uint(pmax), __float_as_uint(pmax), false, false);
    pmax = fmaxf(__uint_as_float(rr[0]), __uint_as_float(rr[1])); }
  if (__builtin_expect(__all(pmax - m_reg <= THRS), 1)) { mn = m_reg; alpha = 1.f; }
  else { mn = fmaxf(m_reg, pmax); alpha = __builtin_amdgcn_exp2f((m_reg - mn) * C); m_reg = mn; }
  float mnC = -mn * C;
#pragma unroll
  for (int r = 0; r < 16; ++r) p0[r] = fmaf(p0[r], C, mnC);
#pragma unroll
  for (int r = 0; r < 16; ++r) p1[r] = fmaf(p1[r], C, mnC);
#pragma unroll
  for (int r = 0; r < 16; ++r) p0[r] = __builtin_amdgcn_exp2f(p0[r]);
}
#define ATT_PK4(P, BASE, OUT) do { unsigned a0 = cvtpk(P[BASE + 0], P[BASE + 1]), a1 = cvtpk(P[BASE + 2], P[BASE + 3]);   \
    unsigned b0 = cvtpk(P[BASE + 4], P[BASE + 5]), b1 = cvtpk(P[BASE + 6], P[BASE + 7]);                              \
    auto r0 = __builtin_amdgcn_permlane32_swap(a0, b0, false, false); auto r1 = __builtin_amdgcn_permlane32_swap(a1, b1, false, false); \
    u32x4 w = {r0[0], r1[0], r0[1], r1[1]}; OUT = *reinterpret_cast<bf16x8*>(&w); } while (0)
__device__ __forceinline__ void finishSM(f32x16& p0, f32x16& p1, float alpha, float& l_reg, bf16x8& pa0, bf16x8& pa1, bf16x8& pa2, bf16x8& pa3) {
#pragma unroll
  for (int r = 0; r < 16; ++r) p1[r] = __builtin_amdgcn_exp2f(p1[r]);
  float ps = 0;
#pragma unroll
  for (int r = 0; r < 16; ++r) ps += p0[r];
#pragma unroll
  for (int r = 0; r < 16; ++r) ps += p1[r];
  { auto rr = __builtin_amdgcn_permlane32_swap(__float_as_uint(ps), __float_as_uint(ps), false, false);
    ps = __uint_as_float(rr[0]) + __uint_as_float(rr[1]); }
  l_reg = l_reg * alpha + ps;
  ATT_PK4(p0, 0, pa0); ATT_PK4(p0, 8, pa1); ATT_PK4(p1, 0, pa2); ATT_PK4(p1, 8, pa3);
}
template <int RB> __device__ __forceinline__ int kswz(int row, int colB) { return row * RB + (colB ^ ((row & 7) << 4)); }
template <int DQK> __device__ __forceinline__ void qkt(f32x16& p0, f32x16& p1, const ATT_LAS char* Ks, const bf16x8 (&qr)[DQK / 16], int r32, int hi) {
  p0 = f32x16{}; p1 = f32x16{};
#pragma unroll
  for (int d0 = 0; d0 < DQK / 16; ++d0) { const int cb = (d0 * 16 + hi * 8) * 2;
    bf16x8 b0 = *reinterpret_cast<const ATT_LAS bf16x8*>(Ks + kswz<DQK * 2>(r32, cb));
    bf16x8 b1 = *reinterpret_cast<const ATT_LAS bf16x8*>(Ks + kswz<DQK * 2>(32 + r32, cb));
    p0 = __builtin_amdgcn_mfma_f32_32x32x16_bf16(b0, qr[d0], p0, 0, 0, 0);
    p1 = __builtin_amdgcn_mfma_f32_32x32x16_bf16(b1, qr[d0], p1, 0, 0, 0); }
}
__device__ __forceinline__ void qkt192_lq(f32x16& p0, f32x16& p1, const ATT_LAS char* Ks, const bf16x8 (&qr)[8], const ATT_LAS char* Qs, int lane, int r32, int hi) {
  p0 = f32x16{}; p1 = f32x16{};
#pragma unroll
  for (int d0 = 0; d0 < 12; ++d0) { const int cb = (d0 * 16 + hi * 8) * 2;
    bf16x8 b0 = *reinterpret_cast<const ATT_LAS bf16x8*>(Ks + kswz<384>(r32, cb));
    bf16x8 b1 = *reinterpret_cast<const ATT_LAS bf16x8*>(Ks + kswz<384>(32 + r32, cb));
    const bf16x8 q = d0 < 8 ? qr[d0 < 8 ? d0 : 0] : *reinterpret_cast<const ATT_LAS bf16x8*>(Qs + ((d0 - 8) * 64 + lane) * 16);
    p0 = __builtin_amdgcn_mfma_f32_32x32x16_bf16(b0, q, p0, 0, 0, 0);
    p1 = __builtin_amdgcn_mfma_f32_32x32x16_bf16(b1, q, p1, 0, 0, 0); }
}
__device__ __forceinline__ int v_st(int k, int c) { const int kk = (k & ~0xC) | ((k & 4) << 1) | ((k & 8) >> 1); return ((kk >> 3) * 4 + (c >> 5)) * 512 + ((kk & 7) * 32 + (c & 31)) * 2; }
__device__ __forceinline__ int v_rd_base(int lane) { return ((lane & 3) << 3) | (((lane >> 2) & 3) << 6) | (((lane >> 4) & 1) << 5) | (((lane >> 5) & 1) << 8); }
constexpr int v_rd_off(int d0, int ks, int half) { return d0 * 512 + ks * 4096 + half * 2048; }
template <int OFF> __device__ __forceinline__ s16x4 tr_read(int vb) {
  s16x4 r; asm volatile("ds_read_b64_tr_b16 %0, %1 offset:%2" : "=&v"(r) : "v"(vb), "i"(OFF) : "memory"); return r;
}
#define ATT_PK(L, H) (bf16x8){L[0], L[1], L[2], L[3], H[0], H[1], H[2], H[3]}
template <int D0> __device__ __forceinline__ void pv_one(f32x16& od, int vb, bf16x8 pa0, bf16x8 pa1, bf16x8 pa2, bf16x8 pa3) {
  const s16x4 l0 = tr_read<v_rd_off(D0, 0, 0)>(vb), h0 = tr_read<v_rd_off(D0, 0, 1)>(vb), l1 = tr_read<v_rd_off(D0, 1, 0)>(vb), h1 = tr_read<v_rd_off(D0, 1, 1)>(vb);
  const s16x4 l2 = tr_read<v_rd_off(D0, 2, 0)>(vb), h2 = tr_read<v_rd_off(D0, 2, 1)>(vb), l3 = tr_read<v_rd_off(D0, 3, 0)>(vb), h3 = tr_read<v_rd_off(D0, 3, 1)>(vb);
  asm volatile("s_waitcnt lgkmcnt(0)" ::: "memory"); SBAR();
  od = __builtin_amdgcn_mfma_f32_32x32x16_bf16(pa0, ATT_PK(l0, h0), od, 0, 0, 0);
  od = __builtin_amdgcn_mfma_f32_32x32x16_bf16(pa1, ATT_PK(l1, h1), od, 0, 0, 0);
  od = __builtin_amdgcn_mfma_f32_32x32x16_bf16(pa2, ATT_PK(l2, h2), od, 0, 0, 0);
  od = __builtin_amdgcn_mfma_f32_32x32x16_bf16(pa3, ATT_PK(l3, h3), od, 0, 0, 0);
}
__device__ __forceinline__ void pv_d0(f32x16 (&o)[4], int vb, bf16x8 pa0, bf16x8 pa1, bf16x8 pa2, bf16x8 pa3) {
  pv_one<0>(o[0], vb, pa0, pa1, pa2, pa3); pv_one<1>(o[1], vb, pa0, pa1, pa2, pa3); pv_one<2>(o[2], vb, pa0, pa1, pa2, pa3); pv_one<3>(o[3], vb, pa0, pa1, pa2, pa3);
}
template <int D0> __device__ __forceinline__ void pv32_one(f32x16& od, int vb, bf16x8 pa0, bf16x8 pa1) {
  const s16x4 l0 = tr_read<v_rd_off(D0, 0, 0)>(vb), h0 = tr_read<v_rd_off(D0, 0, 1)>(vb), l1 = tr_read<v_rd_off(D0, 1, 0)>(vb), h1 = tr_read<v_rd_off(D0, 1, 1)>(vb);
  asm volatile("s_waitcnt lgkmcnt(0)" ::: "memory"); SBAR();
  od = __builtin_amdgcn_mfma_f32_32x32x16_bf16(pa0, ATT_PK(l0, h0), od, 0, 0, 0);
  od = __builtin_amdgcn_mfma_f32_32x32x16_bf16(pa1, ATT_PK(l1, h1), od, 0, 0, 0);
}

template <int DQK, int LDQ, int LDK, int LDO, int SDEPTH>
__device__ __forceinline__ void attn_dense_body(const bf16* __restrict__ Qb, const bf16* __restrict__ Kh, const bf16* __restrict__ Kr, const bf16* __restrict__ Vh,
                                                const float* __restrict__ cs_rows, OT* __restrict__ Ob, int seq, const float scale, ATT_LAS char* lds) {
  constexpr int SHM_V = KVBLK * DV * 2, SHM_K = KVBLK * DQK * 2, RB = DQK * 2, NQ = DQK / 16;
  constexpr bool ROPE = (DQK == 192);
  const float C = scale * LOG2E, THRS = 8.f / scale;
  int tid_ = threadIdx.x; asm volatile("" : "+v"(tid_));
  const int tid = tid_, wid = tid >> 6, lane = tid & 63, r32 = lane & 31, hi = lane >> 5;
  ATT_LAS char* V_lds = lds; ATT_LAS char* K_lds = lds + 2 * SHM_V;
  ATT_LAS float* ws = (ATT_LAS float*)(lds + 2 * SHM_V + 2 * SHM_K) + wid * 64; ATT_LAS float* li_l = ws; ATT_LAS float* al_l = ws + 32;
  float m_reg = -1e30f, l_reg = 0; f32x16 o[4] = {}; bf16x8 qr[NQ];
  const bf16* Qw = Qb + (long)(wid * QBLK + r32) * LDQ + hi * 8;
#pragma unroll
  for (int d0 = 0; d0 < NQ; ++d0) qr[d0] = *(const ATT_GAS bf16x8*)(Qw + d0 * 16);
  if constexpr (ROPE) {
    const float* cs = cs_rows + (long)(wid * QBLK + r32) * 64 + hi * 8;
#pragma unroll
    for (int g = 0; g < 2; ++g) {
      const f32x4 c0 = *(const ATT_GAS f32x4*)(cs + g * 16), c1 = *(const ATT_GAS f32x4*)(cs + g * 16 + 4);
      const f32x4 s0 = *(const ATT_GAS f32x4*)(cs + 32 + g * 16), s1 = *(const ATT_GAS f32x4*)(cs + 32 + g * 16 + 4);
      float y1[8], y2[8];
#pragma unroll
      for (int j = 0; j < 8; ++j) { const float co = j < 4 ? c0[j & 3] : c1[j & 3], si = j < 4 ? s0[j & 3] : s1[j & 3];
        const float x1 = bf2f(qr[8 + g][j]), x2 = bf2f(qr[10 + g][j]); y1[j] = x1 * co - x2 * si; y2[j] = x1 * si + x2 * co; }
      u32x4 w1 = {cvtpk(y1[0], y1[1]), cvtpk(y1[2], y1[3]), cvtpk(y1[4], y1[5]), cvtpk(y1[6], y1[7])};
      u32x4 w2 = {cvtpk(y2[0], y2[1]), cvtpk(y2[2], y2[3]), cvtpk(y2[4], y2[5]), cvtpk(y2[6], y2[7])};
      qr[8 + g] = *reinterpret_cast<bf16x8*>(&w1); qr[10 + g] = *reinterpret_cast<bf16x8*>(&w2);
    }
  }
  const int sr = tid >> 4, sc = (tid & 15) * 8, vst0 = v_st(sr, sc), vst1 = v_st(32 + sr, sc);
  const int rr = tid >> 3, rc = (tid & 7) * 8;
  const int vb0 = (int)(unsigned)(uintptr_t)V_lds + v_rd_base(lane);
  struct Slot { bf16x8 vs0, vs1, ks0, ks1, kr; } sr_[SDEPTH];
#define SLOAD(i, k0) do { sr_[i].vs0 = *(const ATT_GAS bf16x8*)(&Vh[(long)((k0) + sr) * LDK + sc]); sr_[i].vs1 = *(const ATT_GAS bf16x8*)(&Vh[(long)((k0) + 32 + sr) * LDK + sc]); \
    sr_[i].ks0 = *(const ATT_GAS bf16x8*)(&Kh[(long)((k0) + sr) * LDK + sc]); sr_[i].ks1 = *(const ATT_GAS bf16x8*)(&Kh[(long)((k0) + 32 + sr) * LDK + sc]); \
    if constexpr (ROPE) sr_[i].kr = *(const ATT_GAS bf16x8*)(&Kr[(long)((k0) + rr) * 64 + rc]); } while (0)
#define SWRITE(b, i) do { *reinterpret_cast<ATT_LAS bf16x8*>(V_lds + (b) * SHM_V + vst0) = sr_[i].vs0;          \
    *reinterpret_cast<ATT_LAS bf16x8*>(V_lds + (b) * SHM_V + vst1) = sr_[i].vs1; const int kc = sc * 2;               \
    *reinterpret_cast<ATT_LAS bf16x8*>(K_lds + (b) * SHM_K + kswz<RB>(sr, kc)) = sr_[i].ks0;                       \
    *reinterpret_cast<ATT_LAS bf16x8*>(K_lds + (b) * SHM_K + kswz<RB>(32 + sr, kc)) = sr_[i].ks1;                  \
    if constexpr (ROPE) *reinterpret_cast<ATT_LAS bf16x8*>(K_lds + (b) * SHM_K + kswz<RB>(rr, 256 + rc * 2)) = sr_[i].kr; } while (0)
#define SWAIT() do { if constexpr (SDEPTH == 2) { if constexpr (ROPE) asm volatile("s_waitcnt vmcnt(5)" ::: "memory"); else asm volatile("s_waitcnt vmcnt(4)" ::: "memory"); } else asm volatile("s_waitcnt vmcnt(0)" ::: "memory"); } while (0)
#define RESC(a) do { if (__any((a) < 1.f)) { if (hi == 0) al_l[r32] = (a); asm volatile("s_waitcnt lgkmcnt(0)" ::: "memory"); \
    _Pragma("unroll") for (int d = 0; d < 4; ++d) _Pragma("unroll") for (int r = 0; r < 16; ++r) o[d][r] *= al_l[crow(r, hi)]; } } while (0)
  f32x16 pA0, pA1, pB0, pB1; float mnA, mnB, alA, alB; bf16x8 pa0, pa1, pa2, pa3; const int NT = seq / KVBLK;
  constexpr int SE = 0, SO = SDEPTH - 1;
  SLOAD(SE, 0); asm volatile("s_waitcnt vmcnt(0)" ::: "memory"); SWRITE(0, SE); __syncthreads();
  qkt<DQK>(pA0, pA1, K_lds, qr, r32, hi); partialSM(pA0, pA1, m_reg, mnA, alA, C, THRS);
  SLOAD(SO, KVBLK); if constexpr (SDEPTH == 2) { if (2 < NT) SLOAD(SE, 2 * KVBLK); }
  SWAIT(); SWRITE(1, SO); __syncthreads();
  for (int j = 1; j + 1 < NT; j += 2) {
    SBAR(); qkt<DQK>(pB0, pB1, K_lds + SHM_K, qr, r32, hi);
    finishSM(pA0, pA1, alA, l_reg, pa0, pa1, pa2, pa3); SBAR();
    SLOAD(SO, (j + SDEPTH) * KVBLK); SBAR();
    pv_d0(o, vb0, pa0, pa1, pa2, pa3); partialSM(pB0, pB1, m_reg, mnB, alB, C, THRS);
    __syncthreads(); SWAIT(); SWRITE(0, SE);
    RESC(alB); __syncthreads();
    SBAR(); qkt<DQK>(pA0, pA1, K_lds, qr, r32, hi);
    finishSM(pB0, pB1, alB, l_reg, pa0, pa1, pa2, pa3); SBAR();
    if (SDEPTH == 1 || j + 3 < NT) SLOAD(SE, (j + 1 + SDEPTH) * KVBLK); SBAR();
    pv_d0(o, vb0 + SHM_V, pa0, pa1, pa2, pa3); partialSM(pA0, pA1, m_reg, mnA, alA, C, THRS);
    __syncthreads(); SWAIT(); SWRITE(1, SO);
    RESC(alA); __syncthreads();
  }
  SBAR(); qkt<DQK>(pB0, pB1, K_lds + SHM_K, qr, r32, hi);
  finishSM(pA0, pA1, alA, l_reg, pa0, pa1, pa2, pa3); SBAR();
  pv_d0(o, vb0, pa0, pa1, pa2, pa3); partialSM(pB0, pB1, m_reg, mnB, alB, C, THRS);
  __syncthreads(); RESC(alB);
  finishSM(pB0, pB1, alB, l_reg, pa0, pa1, pa2, pa3); SBAR();
  pv_d0(o, vb0 + SHM_V, pa0, pa1, pa2, pa3);
  if (hi == 0) li_l[r32] = l_reg; asm volatile("s_waitcnt lgkmcnt(0)" ::: "memory");
  float rli[16];
#pragma unroll
  for (int r = 0; r < 16; ++r) rli[r] = __builtin_amdgcn_rcpf(li_l[crow(r, hi)]);
  OT* Ow = Ob + (long)(wid * QBLK) * LDO;
#pragma unroll
  for (int r = 0; r < 16; ++r) { const int orow = crow(r, hi);
#pragma unroll
    for (int d0 = 0; d0 < 4; ++d0) st_o(&Ow[(long)orow * LDO + d0 * 32 + r32], o[d0][r] * rli[r]); }
  __syncthreads();
#undef SLOAD
#undef SWRITE
#undef SWAIT
#undef RESC
}

template <int LDQ, int LDK, int LDO>
__device__ __forceinline__ void attn_pipe192_body(const bf16* __restrict__ Qb, const bf16* __restrict__ Kh, const bf16* __restrict__ Kr, const bf16* __restrict__ Vh,
                                                const float* __restrict__ cs_rows, OT* __restrict__ Ob, int seq, const float scale, ATT_LAS char* lds) {
  constexpr int DQK = 192, SDEPTH = 1, SHM_V = KVBLK * DV * 2, SHM_K = KVBLK * DQK * 2, RB = DQK * 2, NQ = DQK / 16;
  constexpr bool ROPE = true;
  const float C = scale * LOG2E, THRS = 8.f / scale;
  int tid_ = threadIdx.x; asm volatile("" : "+v"(tid_));
  const int tid = tid_, wid = tid >> 6, lane = tid & 63, r32 = lane & 31, hi = lane >> 5;
  ATT_LAS char* V_lds = lds; ATT_LAS char* K_lds = lds + 2 * SHM_V;
  ATT_LAS float* ws = (ATT_LAS float*)(lds + 2 * SHM_V + 2 * SHM_K) + wid * 64; ATT_LAS float* li_l = ws; ATT_LAS float* al_l = ws + 32;
  ATT_LAS char* Qs = lds + 2 * SHM_V + 2 * SHM_K + 2048 + wid * 4096;
  float m_reg = -1e30f, l_reg = 0; f32x16 o[4] = {}; bf16x8 qr8[8];
  const bf16* Qw = Qb + (long)(wid * QBLK + r32) * LDQ + hi * 8;
  { bf16x8 qr[NQ];
#pragma unroll
  for (int d0 = 0; d0 < NQ; ++d0) qr[d0] = *(const ATT_GAS bf16x8*)(Qw + d0 * 16);
  if constexpr (ROPE) {
    const float* cs = cs_rows + (long)(wid * QBLK + r32) * 64 + hi * 8;
#pragma unroll
    for (int g = 0; g < 2; ++g) {
      const f32x4 c0 = *(const ATT_GAS f32x4*)(cs + g * 16), c1 = *(const ATT_GAS f32x4*)(cs + g * 16 + 4);
      const f32x4 s0 = *(const ATT_GAS f32x4*)(cs + 32 + g * 16), s1 = *(const ATT_GAS f32x4*)(cs + 32 + g * 16 + 4);
      float y1[8], y2[8];
#pragma unroll
      for (int j = 0; j < 8; ++j) { const float co = j < 4 ? c0[j & 3] : c1[j & 3], si = j < 4 ? s0[j & 3] : s1[j & 3];
        const float x1 = bf2f(qr[8 + g][j]), x2 = bf2f(qr[10 + g][j]); y1[j] = x1 * co - x2 * si; y2[j] = x1 * si + x2 * co; }
      u32x4 w1 = {cvtpk(y1[0], y1[1]), cvtpk(y1[2], y1[3]), cvtpk(y1[4], y1[5]), cvtpk(y1[6], y1[7])};
      u32x4 w2 = {cvtpk(y2[0], y2[1]), cvtpk(y2[2], y2[3]), cvtpk(y2[4], y2[5]), cvtpk(y2[6], y2[7])};
      qr[8 + g] = *reinterpret_cast<bf16x8*>(&w1); qr[10 + g] = *reinterpret_cast<bf16x8*>(&w2);
    }
  }
#pragma unroll
  for (int d0 = 0; d0 < 8; ++d0) qr8[d0] = qr[d0];
#pragma unroll
  for (int d0 = 8; d0 < 12; ++d0) *reinterpret_cast<ATT_LAS bf16x8*>(Qs + ((d0 - 8) * 64 + lane) * 16) = qr[d0];
  }
  const int sr = tid >> 4, sc = (tid & 15) * 8, vst0 = v_st(sr, sc), vst1 = v_st(32 + sr, sc);
  const int rr = tid >> 3, rc = (tid & 7) * 8;
  const int vb0 = (int)(unsigned)(uintptr_t)V_lds + v_rd_base(lane);
  struct Slot { bf16x8 vs0, vs1, ks0, ks1, kr; } sr_[SDEPTH];
#define SLOADK(i, k0) do { sr_[i].ks0 = *(const ATT_GAS bf16x8*)(&Kh[(long)((k0) + sr) * LDK + sc]); sr_[i].ks1 = *(const ATT_GAS bf16x8*)(&Kh[(long)((k0) + 32 + sr) * LDK + sc]); } while (0)
#define SLOADV(i, k0) do { sr_[i].vs0 = *(const ATT_GAS bf16x8*)(&Vh[(long)((k0) + sr) * LDK + sc]); sr_[i].vs1 = *(const ATT_GAS bf16x8*)(&Vh[(long)((k0) + 32 + sr) * LDK + sc]); \
    if constexpr (ROPE) sr_[i].kr = *(const ATT_GAS bf16x8*)(&Kr[(long)((k0) + rr) * 64 + rc]); } while (0)
#define SLOAD(i, k0) do { SLOADK(i, k0); SLOADV(i, k0); } while (0)
#define SWRITE(b, i) do { *reinterpret_cast<ATT_LAS bf16x8*>(V_lds + (b) * SHM_V + vst0) = sr_[i].vs0;          \
    *reinterpret_cast<ATT_LAS bf16x8*>(V_lds + (b) * SHM_V + vst1) = sr_[i].vs1; const int kc = sc * 2;               \
    *reinterpret_cast<ATT_LAS bf16x8*>(K_lds + (b) * SHM_K + kswz<RB>(sr, kc)) = sr_[i].ks0;                       \
    *reinterpret_cast<ATT_LAS bf16x8*>(K_lds + (b) * SHM_K + kswz<RB>(32 + sr, kc)) = sr_[i].ks1;                  \
    if constexpr (ROPE) *reinterpret_cast<ATT_LAS bf16x8*>(K_lds + (b) * SHM_K + kswz<RB>(rr, 256 + rc * 2)) = sr_[i].kr; } while (0)
#define SWAIT() do { if constexpr (SDEPTH == 2) { if constexpr (ROPE) asm volatile("s_waitcnt vmcnt(5)" ::: "memory"); else asm volatile("s_waitcnt vmcnt(4)" ::: "memory"); } else asm volatile("s_waitcnt vmcnt(0)" ::: "memory"); } while (0)
#define RESC(a) do { if (__any((a) < 1.f)) { if (hi == 0) al_l[r32] = (a); asm volatile("s_waitcnt lgkmcnt(0)" ::: "memory"); \
    _Pragma("unroll") for (int d = 0; d < 4; ++d) _Pragma("unroll") for (int r = 0; r < 16; ++r) o[d][r] *= al_l[crow(r, hi)]; } } while (0)
  f32x16 pA0, pA1, pB0, pB1; float mnA, mnB, alA, alB; bf16x8 pa0, pa1, pa2, pa3; const int NT = seq / KVBLK;
  constexpr int SE = 0, SO = SDEPTH - 1;
  SLOAD(SE, 0); asm volatile("s_waitcnt vmcnt(0)" ::: "memory"); SWRITE(0, SE); __syncthreads();
  qkt192_lq(pA0, pA1, K_lds, qr8, Qs, lane, r32, hi); partialSM(pA0, pA1, m_reg, mnA, alA, C, THRS);
  SLOAD(SO, KVBLK); if constexpr (SDEPTH == 2) { if (2 < NT) SLOAD(SE, 2 * KVBLK); }
  SWAIT(); SWRITE(1, SO); __syncthreads();
  for (int j = 1; j + 1 < NT; j += 2) {
    SBAR(); qkt192_lq(pB0, pB1, K_lds + SHM_K, qr8, Qs, lane, r32, hi);
    finishSM(pA0, pA1, alA, l_reg, pa0, pa1, pa2, pa3); SBAR();
    SLOADK(SO, (j + SDEPTH) * KVBLK); SBAR();
    pv_d0(o, vb0, pa0, pa1, pa2, pa3); SBAR(); SLOADV(SO, (j + SDEPTH) * KVBLK); SBAR(); partialSM(pB0, pB1, m_reg, mnB, alB, C, THRS);
    __syncthreads(); SWAIT(); SWRITE(0, SE);
    RESC(alB); __syncthreads();
    SBAR(); qkt192_lq(pA0, pA1, K_lds, qr8, Qs, lane, r32, hi);
    finishSM(pB0, pB1, alB, l_reg, pa0, pa1, pa2, pa3); SBAR();
    SLOADK(SE, (j + 1 + SDEPTH) * KVBLK); SBAR();
    pv_d0(o, vb0 + SHM_V, pa0, pa1, pa2, pa3); SBAR(); SLOADV(SE, (j + 1 + SDEPTH) * KVBLK); SBAR(); partialSM(pA0, pA1, m_reg, mnA, alA, C, THRS);
    __syncthreads(); SWAIT(); SWRITE(1, SO);
    RESC(alA); __syncthreads();
  }
  SBAR(); qkt192_lq(pB0, pB1, K_lds + SHM_K, qr8, Qs, lane, r32, hi);
  finishSM(pA0, pA1, alA, l_reg, pa0, pa1, pa2, pa3); SBAR();
  pv_d0(o, vb0, pa0, pa1, pa2, pa3); partialSM(pB0, pB1, m_reg, mnB, alB, C, THRS);
  __syncthreads(); RESC(alB);
  finishSM(pB0, pB1, alB, l_reg, pa0, pa1, pa2, pa3); SBAR();
  pv_d0(o, vb0 + SHM_V, pa0, pa1, pa2, pa3);
  if (hi == 0) li_l[r32] = l_reg; asm volatile("s_waitcnt lgkmcnt(0)" ::: "memory");
  float rli[16];
#pragma unroll
  for (int r = 0; r < 16; ++r) rli[r] = __builtin_amdgcn_rcpf(li_l[crow(r, hi)]);
  OT* Ow = Ob + (long)(wid * QBLK) * LDO;
#pragma unroll
  for (int r = 0; r < 16; ++r) { const int orow = crow(r, hi);
#pragma unroll
    for (int d0 = 0; d0 < 4; ++d0) st_o(&Ow[(long)orow * LDO + d0 * 32 + r32], o[d0][r] * rli[r]); }
  __syncthreads();
#undef SLOAD
#undef SLOADK
#undef SLOADV
#undef SWRITE
#undef SWAIT
#undef RESC
}

template <int DQK, int LDQ, int LDK, int LDO>
__device__ __forceinline__ void attn_simple_body(const bf16* __restrict__ Qb, const bf16* __restrict__ Kh, const bf16* __restrict__ Kr, const bf16* __restrict__ Vh,
                                                 const float* __restrict__ cs_rows, OT* __restrict__ Ob, int seq, const float scale, ATT_LAS char* lds) {
  constexpr int SHM_V = KVBLK * DV * 2, SHM_K = KVBLK * DQK * 2, RB = DQK * 2, NQ = DQK / 16;
  constexpr bool ROPE = (DQK == 192);
  const float C = scale * LOG2E, THRS = 8.f / scale;
  int tid_ = threadIdx.x; asm volatile("" : "+v"(tid_));
  const int tid = tid_, wid = tid >> 6, lane = tid & 63, r32 = lane & 31, hi = lane >> 5;
  ATT_LAS char* V_lds = lds; ATT_LAS char* K_lds = lds + 2 * SHM_V;
  ATT_LAS float* ws = (ATT_LAS float*)(lds + 2 * SHM_V + 2 * SHM_K) + wid * 64; ATT_LAS float* li_l = ws; ATT_LAS float* al_l = ws + 32;
  float m_reg = -1e30f, l_reg = 0; f32x16 o[4] = {}; bf16x8 qr[NQ];
  const bf16* Qw = Qb + (long)(wid * QBLK + r32) * LDQ + hi * 8;
#pragma unroll
  for (int d0 = 0; d0 < NQ; ++d0) qr[d0] = *(const ATT_GAS bf16x8*)(Qw + d0 * 16);
  if constexpr (ROPE) {
    const float* cs = cs_rows + (long)(wid * QBLK + r32) * 64 + hi * 8;
#pragma unroll
    for (int g = 0; g < 2; ++g) {
      const f32x4 c0 = *(const ATT_GAS f32x4*)(cs + g * 16), c1 = *(const ATT_GAS f32x4*)(cs + g * 16 + 4);
      const f32x4 s0 = *(const ATT_GAS f32x4*)(cs + 32 + g * 16), s1 = *(const ATT_GAS f32x4*)(cs + 32 + g * 16 + 4);
      float y1[8], y2[8];
#pragma unroll
      for (int j = 0; j < 8; ++j) { const float co = j < 4 ? c0[j & 3] : c1[j & 3], si = j < 4 ? s0[j & 3] : s1[j & 3];
        const float x1 = bf2f(qr[8 + g][j]), x2 = bf2f(qr[10 + g][j]); y1[j] = x1 * co - x2 * si; y2[j] = x1 * si + x2 * co; }
      u32x4 w1 = {cvtpk(y1[0], y1[1]), cvtpk(y1[2], y1[3]), cvtpk(y1[4], y1[5]), cvtpk(y1[6], y1[7])};
      u32x4 w2 = {cvtpk(y2[0], y2[1]), cvtpk(y2[2], y2[3]), cvtpk(y2[4], y2[5]), cvtpk(y2[6], y2[7])};
      qr[8 + g] = *reinterpret_cast<bf16x8*>(&w1); qr[10 + g] = *reinterpret_cast<bf16x8*>(&w2);
    }
  }
  const int sr = tid >> 4, sc = (tid & 15) * 8, vst0 = v_st(sr, sc), vst1 = v_st(32 + sr, sc);
  const int rr = tid >> 3, rc = (tid & 7) * 8;
  const int vb0 = (int)(unsigned)(uintptr_t)V_lds + v_rd_base(lane);
  bf16x8 vs0, vs1, ks0, ks1, kr;
#define SLOAD(k0) do { vs0 = *(const ATT_GAS bf16x8*)(&Vh[(long)((k0) + sr) * LDK + sc]); vs1 = *(const ATT_GAS bf16x8*)(&Vh[(long)((k0) + 32 + sr) * LDK + sc]); \
    ks0 = *(const ATT_GAS bf16x8*)(&Kh[(long)((k0) + sr) * LDK + sc]); ks1 = *(const ATT_GAS bf16x8*)(&Kh[(long)((k0) + 32 + sr) * LDK + sc]); \
    if constexpr (ROPE) kr = *(const ATT_GAS bf16x8*)(&Kr[(long)((k0) + rr) * 64 + rc]); } while (0)
#define SWRITE(b) do { *reinterpret_cast<ATT_LAS bf16x8*>(V_lds + (b) * SHM_V + vst0) = vs0;          \
    *reinterpret_cast<ATT_LAS bf16x8*>(V_lds + (b) * SHM_V + vst1) = vs1; const int kc = sc * 2;               \
    *reinterpret_cast<ATT_LAS bf16x8*>(K_lds + (b) * SHM_K + kswz<RB>(sr, kc)) = ks0;                       \
    *reinterpret_cast<ATT_LAS bf16x8*>(K_lds + (b) * SHM_K + kswz<RB>(32 + sr, kc)) = ks1;                  \
    if constexpr (ROPE) *reinterpret_cast<ATT_LAS bf16x8*>(K_lds + (b) * SHM_K + kswz<RB>(rr, 256 + rc * 2)) = kr; } while (0)
#define RESC(a) do { if (__any((a) < 1.f)) { if (hi == 0) al_l[r32] = (a); asm volatile("s_waitcnt lgkmcnt(0)" ::: "memory"); \
    _Pragma("unroll") for (int d = 0; d < 4; ++d) _Pragma("unroll") for (int r = 0; r < 16; ++r) o[d][r] *= al_l[crow(r, hi)]; } } while (0)
  const int NT = seq / KVBLK;
  SLOAD(0); SWRITE(0); __syncthreads();
  for (int j = 0; j < NT; ++j) {
    const int b = j & 1;
    if (j + 1 < NT) SLOAD((j + 1) * KVBLK);
    f32x16 p0, p1; float mn, al; bf16x8 pa0, pa1, pa2, pa3;
    SBAR(); qkt<DQK>(p0, p1, K_lds + b * SHM_K, qr, r32, hi);
    partialSM(p0, p1, m_reg, mn, al, C, THRS); RESC(al);
    finishSM(p0, p1, al, l_reg, pa0, pa1, pa2, pa3); SBAR();
    pv_d0(o, vb0 + b * SHM_V, pa0, pa1, pa2, pa3);
    if (j + 1 < NT) SWRITE(b ^ 1);
    __syncthreads();
  }
  if (hi == 0) li_l[r32] = l_reg; asm volatile("s_waitcnt lgkmcnt(0)" ::: "memory");
  float rli[16];
#pragma unroll
  for (int r = 0; r < 16; ++r) rli[r] = __builtin_amdgcn_rcpf(li_l[crow(r, hi)]);
  OT* Ow = Ob + (long)(wid * QBLK) * LDO;
#pragma unroll
  for (int r = 0; r < 16; ++r) { const int orow = crow(r, hi);
#pragma unroll
    for (int d0 = 0; d0 < 4; ++d0) st_o(&Ow[(long)orow * LDO + d0 * 32 + r32], o[d0][r] * rli[r]); }
  __syncthreads();
#undef SLOAD
#undef SWRITE
#undef RESC
}

template <int LDQ, int LDK, int LDO>
__device__ __forceinline__ void attn_dma_body(const bf16* __restrict__ Qb, const bf16* __restrict__ Kh, const bf16* __restrict__ Kr, const bf16* __restrict__ Vh,
                                              const float* __restrict__ cs_rows, OT* __restrict__ Ob, int seq, const float scale, ATT_LAS char* lds) {
  constexpr int DQK = 192, SHM_V = KVBLK * DV * 2, SHM_K = KVBLK * DQK * 2, STG = SHM_K + SHM_V, RB = DQK * 2, NQ = DQK / 16;
  const float C = scale * LOG2E, THRS = 8.f / scale;
  int tid_ = threadIdx.x; asm volatile("" : "+v"(tid_));
  const int tid = tid_, wid = __builtin_amdgcn_readfirstlane(tid >> 6), lane = tid & 63, r32 = lane & 31, hi = lane >> 5;
  ATT_LAS float* ws = (ATT_LAS float*)(lds + 3 * STG) + wid * 64; ATT_LAS float* li_l = ws; ATT_LAS float* al_l = ws + 32;
  float m_reg = -1e30f, l_reg = 0; f32x16 o[4] = {}; bf16x8 qr[NQ];
  const bf16* Qw = Qb + (long)(wid * QBLK + r32) * LDQ + hi * 8;
#pragma unroll
  for (int d0 = 0; d0 < NQ; ++d0) qr[d0] = *(const ATT_GAS bf16x8*)(Qw + d0 * 16);
  { const float* cs = cs_rows + (long)(wid * QBLK + r32) * 64 + hi * 8;
#pragma unroll
    for (int g = 0; g < 2; ++g) {
      const f32x4 c0 = *(const ATT_GAS f32x4*)(cs + g * 16), c1 = *(const ATT_GAS f32x4*)(cs + g * 16 + 4);
      const f32x4 s0 = *(const ATT_GAS f32x4*)(cs + 32 + g * 16), s1 = *(const ATT_GAS f32x4*)(cs + 32 + g * 16 + 4);
      float y1[8], y2[8];
#pragma unroll
      for (int j = 0; j < 8; ++j) { const float co = j < 4 ? c0[j & 3] : c1[j & 3], si = j < 4 ? s0[j & 3] : s1[j & 3];
        const float x1 = bf2f(qr[8 + g][j]), x2 = bf2f(qr[10 + g][j]); y1[j] = x1 * co - x2 * si; y2[j] = x1 * si + x2 * co; }
      u32x4 w1 = {cvtpk(y1[0], y1[1]), cvtpk(y1[2], y1[3]), cvtpk(y1[4], y1[5]), cvtpk(y1[6], y1[7])};
      u32x4 w2 = {cvtpk(y2[0], y2[1]), cvtpk(y2[2], y2[3]), cvtpk(y2[4], y2[5]), cvtpk(y2[6], y2[7])};
      qr[8 + g] = *reinterpret_cast<bf16x8*>(&w1); qr[10 + g] = *reinterpret_cast<bf16x8*>(&w2);
    } }
  const char* ksrc[3]; int kstep[3];
#pragma unroll
  for (int d = 0; d < 3; ++d) { const int p = (wid * 3 + d) * 64 + lane, row = p / 24, cpos = p - row * 24, c = cpos ^ (row & 7);
    if (c < 16) { ksrc[d] = (const char*)(Kh + (long)row * LDK + c * 8); kstep[d] = KVBLK * LDK * 2; } else { ksrc[d] = (const char*)(Kr + (long)row * 64 + (c - 16) * 8); kstep[d] = KVBLK * 64 * 2; } }
  const char* vsrc[2];
#pragma unroll
  for (int d = 0; d < 2; ++d) { const int p = (wid * 2 + d) * 64 + lane, sub = p >> 5, q = p & 31, kk = (sub >> 2) * 8 + (q >> 2), col = (sub & 3) * 32 + (q & 3) * 8;
    const int key = (kk & ~0xC) | ((kk & 4) << 1) | ((kk & 8) >> 1); vsrc[d] = (const char*)(Vh + (long)key * LDK + col); }
#define DMA_TILE(t, stg) do { ATT_LAS char* sb_ = lds + (stg) * STG; \
    _Pragma("unroll") for (int d = 0; d < 3; ++d) __builtin_amdgcn_global_load_lds((const unsigned*)(ksrc[d] + (long)(t) * kstep[d]), (ATT_LAS unsigned*)(sb_ + (wid * 3 + d) * 1024), 16, 0, 0); \
    _Pragma("unroll") for (int d = 0; d < 2; ++d) __builtin_amdgcn_global_load_lds((const unsigned*)(vsrc[d] + (long)(t) * (KVBLK * LDK * 2)), (ATT_LAS unsigned*)(sb_ + SHM_K + (wid * 2 + d) * 1024), 16, 0, 0); } while (0)
#define RESC(a) do { if (__any((a) < 1.f)) { if (hi == 0) al_l[r32] = (a); asm volatile("s_waitcnt lgkmcnt(0)" ::: "memory"); \
    _Pragma("unroll") for (int d = 0; d < 4; ++d) _Pragma("unroll") for (int r = 0; r < 16; ++r) o[d][r] *= al_l[crow(r, hi)]; } } while (0)
  const int NT = seq / KVBLK, vbase = (int)(unsigned)(uintptr_t)lds + SHM_K + v_rd_base(lane);
  asm volatile("s_waitcnt vmcnt(0)" ::: "memory");
  DMA_TILE(0, 0); DMA_TILE(1, 1);
  asm volatile("s_waitcnt vmcnt(5)" ::: "memory"); __builtin_amdgcn_s_barrier(); asm volatile("" ::: "memory");
  int stg = 0;
  for (int j = 0; j < NT; ++j) {
    const int stg2 = stg >= 1 ? stg - 1 : 2;
    if (j + 2 < NT) DMA_TILE(j + 2, stg2);
    f32x16 p0, p1; float mn, al; bf16x8 pa0, pa1, pa2, pa3;
    SBAR(); qkt<DQK>(p0, p1, lds + stg * STG, qr, r32, hi);
    partialSM(p0, p1, m_reg, mn, al, C, THRS); RESC(al);
    finishSM(p0, p1, al, l_reg, pa0, pa1, pa2, pa3); SBAR();
    pv_d0(o, vbase + stg * STG, pa0, pa1, pa2, pa3);
    if (j + 2 < NT) asm volatile("s_waitcnt vmcnt(5)" ::: "memory"); else asm volatile("s_waitcnt vmcnt(0)" ::: "memory");
    asm volatile("s_waitcnt lgkmcnt(0)" ::: "memory"); __builtin_amdgcn_s_barrier(); asm volatile("" ::: "memory");
    stg = stg == 2 ? 0 : stg + 1;
  }
  if (hi == 0) li_l[r32] = l_reg; asm volatile("s_waitcnt lgkmcnt(0)" ::: "memory");
  float rli[16];
#pragma unroll
  for (int r = 0; r < 16; ++r) rli[r] = __builtin_amdgcn_rcpf(li_l[crow(r, hi)]);
  OT* Ow = Ob + (long)(wid * QBLK) * LDO;
#pragma unroll
  for (int r = 0; r < 16; ++r) { const int orow = crow(r, hi);
#pragma unroll
    for (int d0 = 0; d0 < 4; ++d0) st_o(&Ow[(long)orow * LDO + d0 * 32 + r32], o[d0][r] * rli[r]); }
  __syncthreads();
#undef DMA_TILE
#undef RESC
}

template <int LDP>
__device__ __forceinline__ void dil_wave_unit(const bf16* __restrict__ P, int qc, int kc, int vc, int d, int r, int t0, int nT,
                                              OT* __restrict__ O, int oc, float* __restrict__ ST  ,
                                              ATT_LAS char* vlds  , const ATT_LAS float* bias2, const float C, int lane_) {
  int lane = lane_; asm volatile("" : "+v"(lane));
  const int r32 = lane & 31, hi = lane >> 5;
  bf16x8 qr[8];
  { const bf16* qp = P + (long)(r + d * (t0 + r32)) * LDP + qc + hi * 8;
#pragma unroll
    for (int d0 = 0; d0 < 8; ++d0) qr[d0] = *(const ATT_GAS bf16x8*)(qp + d0 * 16); }
  bf16x8 kf[2][8];
#define DIL_LDK(kb, set) do { int kt_ = t0 - 64 + (kb) * 32 + r32; kt_ = kt_ < 0 ? 0 : (kt_ > nT - 1 ? nT - 1 : kt_); \
    const bf16* kp_ = P + (long)(r + d * kt_) * LDP + kc + hi * 8; \
    _Pragma("unroll") for (int d0 = 0; d0 < 8; ++d0) kf[set][d0] = *(const ATT_GAS bf16x8*)(kp_ + d0 * 16); } while (0)
  DIL_LDK(0, 0);
  f32x16 p[5];
#pragma unroll
  for (int kb = 0; kb < 5; ++kb) {
    if (kb + 1 < 5) DIL_LDK(kb + 1, (kb + 1) & 1);
    p[kb] = f32x16{};
#pragma unroll
    for (int d0 = 0; d0 < 8; ++d0) p[kb] = __builtin_amdgcn_mfma_f32_32x32x16_bf16(kf[kb & 1][d0], qr[d0], p[kb], 0, 0, 0);
  }
#undef DIL_LDK
  bf16x8 vv[2][8];
#define DIL_LDV(kb, set) do { _Pragma("unroll") for (int i = 0; i < 8; ++i) { const int id = lane + 64 * i, row = id >> 4, c = (id & 15) * 8; \
      int kt_ = t0 - 64 + (kb) * 32 + row; kt_ = kt_ < 0 ? 0 : (kt_ > nT - 1 ? nT - 1 : kt_); \
      vv[set][i] = *(const ATT_GAS bf16x8*)(P + (long)(r + d * kt_) * LDP + vc + c); } } while (0)
  DIL_LDV(0, 0);
  float m = -1e30f;
  { const int a_ = 4 * hi - r32 + 32, k_ = a_ & 3; const ATT_LAS f32x4* tp = (const ATT_LAS f32x4*)(bias2 + k_ * 196 + (a_ - k_));
    const bool interior = (t0 >= 64) && (t0 + 96 <= nT);
#pragma unroll
    for (int kb = 0; kb < 5; ++kb)
#pragma unroll
      for (int g = 0; g < 4; ++g) { const f32x4 bv = tp[kb * 8 + 2 * g];
#pragma unroll
        for (int e = 0; e < 4; ++e) { const int rg = 4 * g + e; float s = fmaf(p[kb][rg], C, bv[e]);
          if (!interior) { const int kt = t0 - 64 + kb * 32 + crow(rg, hi); s = (kt >= 0 && kt < nT) ? s : -1e30f; }
          p[kb][rg] = s; m = fmaxf(m, s); } } }
  { auto rr = __builtin_amdgcn_permlane32_swap(__float_as_uint(m), __float_as_uint(m), false, false); m = fmaxf(__uint_as_float(rr[0]), __uint_as_float(rr[1])); }
  float Z = 0.f;
#pragma unroll
  for (int kb = 0; kb < 5; ++kb)
#pragma unroll
    for (int rg = 0; rg < 16; ++rg) { p[kb][rg] = __builtin_amdgcn_exp2f(p[kb][rg] - m); Z += p[kb][rg]; }
  { auto rr = __builtin_amdgcn_permlane32_swap(__float_as_uint(Z), __float_as_uint(Z), false, false); Z = __uint_as_float(rr[0]) + __uint_as_float(rr[1]); }
  bf16x8 pa[5][2];
#pragma unroll
  for (int kb = 0; kb < 5; ++kb) { ATT_PK4(p[kb], 0, pa[kb][0]); ATT_PK4(p[kb], 8, pa[kb][1]); }
  f32x16 o[4] = {};
  const int vb = (int)(unsigned)(uintptr_t)vlds + v_rd_base(lane);
#pragma unroll
  for (int kb = 0; kb < 5; ++kb) {
    if (kb + 1 < 5) DIL_LDV(kb + 1, (kb + 1) & 1);
#pragma unroll
    for (int i = 0; i < 8; ++i) { const int id = lane + 64 * i, row = id >> 4, c = (id & 15) * 8;
      *reinterpret_cast<ATT_LAS bf16x8*>(vlds + v_st(row, c)) = vv[kb & 1][i]; }
    asm volatile("s_waitcnt lgkmcnt(0)" ::: "memory"); SBAR();
    pv32_one<0>(o[0], vb, pa[kb][0], pa[kb][1]); pv32_one<1>(o[1], vb, pa[kb][0], pa[kb][1]); pv32_one<2>(o[2], vb, pa[kb][0], pa[kb][1]); pv32_one<3>(o[3], vb, pa[kb][0], pa[kb][1]);
    SBAR();
  }
#undef DIL_LDV
#pragma unroll
  for (int rg = 0; rg < 16; ++rg) { const long row = r + d * (t0 + crow(rg, hi));
#pragma unroll
    for (int d0 = 0; d0 < 4; ++d0) st_o(&O[row * 768 + oc + d0 * 32 + r32], o[d0][rg]); }
  if (hi == 0) { const long row = r + d * (t0 + r32); typedef float f32x2_ __attribute__((ext_vector_type(2))); *(ATT_GAS f32x2_*)(ST + row * 12) = (f32x2_){m, Z}; }
}
template <int LDP>
__device__ __forceinline__ void dil_wg_unit(const bf16* __restrict__ P, int qc, int kc, int vc, int d, int r, int T0, int nT,
                                            OT* __restrict__ O, int oc, float* __restrict__ ST, ATT_LAS char* lds, const ATT_LAS float* bias2, const float C) {
  int tid_ = threadIdx.x; asm volatile("" : "+v"(tid_));
  const int tid = tid_, wid = __builtin_amdgcn_readfirstlane(tid >> 6), lane = tid & 63, r32 = lane & 31, hi = lane >> 5, t0 = T0 + 32 * wid;
  { bf16x8 kk[12];
#pragma unroll
    for (int i = 0; i < 12; ++i) { const int id = tid + 512 * i, row = id >> 4, c = (id & 15) * 8; int kt = T0 - 64 + row; kt = kt < 0 ? 0 : (kt > nT - 1 ? nT - 1 : kt);
      kk[i] = *(const ATT_GAS bf16x8*)(P + (long)(r + d * kt) * LDP + kc + c); }
#pragma unroll
    for (int i = 0; i < 12; ++i) { const int id = tid + 512 * i, row = id >> 4, cB = (id & 15) * 16;
      *reinterpret_cast<ATT_LAS bf16x8*>(lds + kswz<256>(row, cB)) = kk[i]; } }
  bf16x8 qr[8];
  { const bf16* qp = P + (long)(r + d * (t0 + r32)) * LDP + qc + hi * 8;
#pragma unroll
    for (int d0 = 0; d0 < 8; ++d0) qr[d0] = *(const ATT_GAS bf16x8*)(qp + d0 * 16); }
  __syncthreads();
  bf16x8 vv[12];
#pragma unroll
  for (int i = 0; i < 12; ++i) { const int id = tid + 512 * i, row = id >> 4, c = (id & 15) * 8; int kt = T0 - 64 + row; kt = kt < 0 ? 0 : (kt > nT - 1 ? nT - 1 : kt);
    vv[i] = *(const ATT_GAS bf16x8*)(P + (long)(r + d * kt) * LDP + vc + c); }
  f32x16 p[5];
#pragma unroll
  for (int kb = 0; kb < 5; ++kb) { const int krow = 32 * wid + 32 * kb + r32;
    p[kb] = f32x16{};
#pragma unroll
    for (int d0 = 0; d0 < 8; ++d0) { const bf16x8 kf = *reinterpret_cast<const ATT_LAS bf16x8*>(lds + kswz<256>(krow, (d0 * 16 + hi * 8) * 2));
      p[kb] = __builtin_amdgcn_mfma_f32_32x32x16_bf16(kf, qr[d0], p[kb], 0, 0, 0); } }
  float m = -1e30f;
  { const int a_ = 4 * hi - r32 + 32, k_ = a_ & 3; const ATT_LAS f32x4* tp = (const ATT_LAS f32x4*)(bias2 + k_ * 196 + (a_ - k_));
    const bool interior = (t0 >= 64) && (t0 + 96 <= nT);
#pragma unroll
    for (int kb = 0; kb < 5; ++kb)
#pragma unroll
      for (int g = 0; g < 4; ++g) { const f32x4 bv = tp[kb * 8 + 2 * g];
#pragma unroll
        for (int e = 0; e < 4; ++e) { const int rg = 4 * g + e; float s = fmaf(p[kb][rg], C, bv[e]);
          if (!interior) { const int kt = t0 - 64 + kb * 32 + crow(rg, hi); s = (kt >= 0 && kt < nT) ? s : -1e30f; }
          p[kb][rg] = s; m = fmaxf(m, s); } } }
  { auto rr = __builtin_amdgcn_permlane32_swap(__float_as_uint(m), __float_as_uint(m), false, false); m = fmaxf(__uint_as_float(rr[0]), __uint_as_float(rr[1])); }
  float Z = 0.f;
#pragma unroll
  for (int kb = 0; kb < 5; ++kb)
#pragma unroll
    for (int rg = 0; rg < 16; ++rg) { p[kb][rg] = __builtin_amdgcn_exp2f(p[kb][rg] - m); Z += p[kb][rg]; }
  { auto rr = __builtin_amdgcn_permlane32_swap(__float_as_uint(Z), __float_as_uint(Z), false, false); Z = __uint_as_float(rr[0]) + __uint_as_float(rr[1]); }
  bf16x8 pa[5][2];
#pragma unroll
  for (int kb = 0; kb < 5; ++kb) { ATT_PK4(p[kb], 0, pa[kb][0]); ATT_PK4(p[kb], 8, pa[kb][1]); }
  __syncthreads();
#pragma unroll
  for (int i = 0; i < 12; ++i) { const int id = tid + 512 * i, row = id >> 4, c = (id & 15) * 8;
    *reinterpret_cast<ATT_LAS bf16x8*>(lds + (row >> 5) * 8192 + v_st(row & 31, c)) = vv[i]; }
  __syncthreads();
  f32x16 o[4] = {};
#pragma unroll
  for (int kb = 0; kb < 5; ++kb) { const int vb = (int)(unsigned)(uintptr_t)lds + (wid + kb) * 8192 + v_rd_base(lane);
    pv32_one<0>(o[0], vb, pa[kb][0], pa[kb][1]); pv32_one<1>(o[1], vb, pa[kb][0], pa[kb][1]); pv32_one<2>(o[2], vb, pa[kb][0], pa[kb][1]); pv32_one<3>(o[3], vb, pa[kb][0], pa[kb][1]); }
#pragma unroll
  for (int rg = 0; rg < 16; ++rg) { const long row = r + d * (t0 + crow(rg, hi));
#pragma unroll
    for (int d0 = 0; d0 < 4; ++d0) st_o(&O[row * 768 + oc + d0 * 32 + r32], o[d0][rg]); }
  if (hi == 0) { const long row = r + d * (t0 + r32); typedef float f32x2_ __attribute__((ext_vector_type(2))); *(ATT_GAS f32x2_*)(ST + row * 12) = (f32x2_){m, Z}; }
  __syncthreads();
}

#if defined(MLA_DMA) && MLA_DMA == 2
#define MLA_BODY attn_pipe192_body
#elif defined(MLA_DMA) && MLA_DMA
#define MLA_BODY attn_dma_body
#else
template <int LDQ, int LDK, int LDO> __device__ __forceinline__ void attn_simple192(const bf16* Qb, const bf16* Kh, const bf16* Kr, const bf16* Vh, const float* cs, OT* Ob, int seq, const float scale, ATT_LAS char* lds) { attn_simple_body<192, LDQ, LDK, LDO>(Qb, Kh, Kr, Vh, cs, Ob, seq, scale, lds); }
#define MLA_BODY attn_simple192
#endif
}
constexpr int S = 8192, D = 2048, NMEM = 256;
constexpr int DIN = 3392, DINP = 3584;
constexpr int PC_DIL = 768, PC_MEM = 3072;
constexpr int QR = 384, KVR = 128, AQ = 512;
constexpr int NUP = 2816;
constexpr int UC_KV = 1280;
constexpr int DFF = 5632, DFE = 7168, NE = 8;
constexpr int MP = 18432;
constexpr float EPS = 1e-6f;
constexpr int NWAVES = 8;

constexpr size_t al256(size_t x) { return (x + 255) / 256 * 256; }
constexpr size_t WS_CTL = 0, CTL_ZERO_BYTES = 1u << 20;
constexpr size_t WS_WIN = WS_CTL + CTL_ZERO_BYTES;
constexpr size_t WS_WUP = WS_WIN + al256((size_t)2 * DINP * D * 2);
constexpr size_t WS_WMEM = WS_WUP + al256((size_t)2 * NUP * AQ * 2);
constexpr size_t WS_WOUT = WS_WMEM + al256((size_t)2 * 1024 * D * 2);
constexpr size_t WS_WGU = WS_WOUT + al256((size_t)2 * D * D * 2);
constexpr size_t WS_WDN = WS_WGU + al256((size_t)2 * DFF * D * 2);
constexpr size_t WS_MGU = WS_WDN + al256((size_t)D * DFF * 2);
constexpr size_t WS_MDN = WS_MGU + al256((size_t)NE * 2 * DFE * D * 2);
constexpr size_t WS_XN = WS_MDN + al256((size_t)NE * D * DFE * 2);
constexpr size_t WS_MEMN = WS_XN + al256((size_t)S * D * 2);
constexpr size_t WS_MEMKV = WS_MEMN + al256((size_t)2 * NMEM * D * 2);
constexpr size_t WS_PROJ = WS_MEMKV + al256((size_t)2 * NMEM * 1024 * 2);
constexpr size_t WS_AQKV = WS_PROJ + al256((size_t)S * DINP * 2);
constexpr size_t WS_KROPE = WS_AQKV + al256((size_t)S * AQ * 2);
constexpr size_t WS_ROPECS = WS_KROPE + al256((size_t)S * 64 * 2);
constexpr size_t WS_QKVM = WS_ROPECS + al256((size_t)S * 64 * 4);
constexpr size_t WS_YPRE = WS_QKVM + al256((size_t)S * NUP * 2);
constexpr size_t WS_DILO = WS_YPRE + al256((size_t)S * D * 4);
constexpr size_t WS_DILS = WS_DILO + al256((size_t)3 * S * 768 * 4);
constexpr size_t WS_Y = WS_DILS + al256((size_t)3 * S * 12 * 4);
constexpr size_t WS_XA = WS_Y + al256((size_t)S * D * 2);
constexpr size_t WS_ROUTE = WS_XA + al256((size_t)S * D * 4);
constexpr size_t WS_XP = WS_ROUTE + al256((size_t)S * 32);
constexpr size_t WS_OUTP = WS_XP + al256((size_t)MP * D * 2);
constexpr size_t WS_ACTP = WS_OUTP + al256((size_t)MP * D * 2);
constexpr size_t WS_OUTQ = WS_ACTP + al256((size_t)MP * DFE * 2);
constexpr size_t WS_END = WS_OUTQ + al256((size_t)4 * 2048 * D * 2);
static_assert(WS_END <= 1879048192ull, "workspace map exceeds 4 x the largest input");
constexpr int CW_BAR = 16384;
constexpr int CW_QUEUE = 8192;
constexpr int CW_CNT = 8192 + 256;
constexpr int CW_QUEUE2 = 65536;
constexpr int CW_CVT = 8192 + 320;
constexpr int CW_DONE = 8192 + 384;
constexpr int CW_CNTW = 53248;
constexpr int CW_TS = 12288;
constexpr int CW_TILEE = 8192 + 512;
constexpr int RING_BYTES = 131072;
constexpr int LDSCTL_OFF = RING_BYTES, MISC_OFF = LDSCTL_OFF + 320;
constexpr int BIAS_OFF = 132096;
constexpr int LDS_BYTES = 147456;
static_assert(BIAS_OFF >= MISC_OFF + 128 && BIAS_OFF + 3 * 6 * 132 * 4 + 4 * 196 * 4 <= LDS_BYTES, "LDS map");

#define GAS __attribute__((address_space(1)))
#define LAS __attribute__((address_space(3)))
typedef unsigned short bf16;
typedef unsigned v4u __attribute__((ext_vector_type(4)));
typedef unsigned v2u __attribute__((ext_vector_type(2)));
typedef float f32x4 __attribute__((ext_vector_type(4)));
typedef short bf16x8 __attribute__((ext_vector_type(8)));
typedef GAS unsigned gu32;
#define RLX_AGENT __ATOMIC_RELAXED, __HIP_MEMORY_SCOPE_AGENT
#define LDS_WAIT() asm volatile("s_waitcnt lgkmcnt(0)" ::: "memory")
#define VM_WAIT() asm volatile("s_waitcnt vmcnt(0)" ::: "memory")
__device__ __forceinline__ unsigned f2bf(float f) { unsigned u = __builtin_bit_cast(unsigned, f); return (u + 0x7fffu + ((u >> 16) & 1u)) >> 16; }
__device__ __forceinline__ unsigned pk2(float lo, float hi) { return f2bf(lo) | (f2bf(hi) << 16); }
__device__ __forceinline__ float bflo(unsigned w) { return __uint_as_float(w << 16); }
__device__ __forceinline__ float bfhi(unsigned w) { return __uint_as_float(w & 0xffff0000u); }

#define XB_TMO      128
#define XB_XCNT(j)  (256  + 64 * (j))
#define XB_XSUB(j)  (1280 + 64 * (j))
#define XB_XGEN(j)  (2304 + 64 * (j))
#define XB_TOP      3328
#define XB_TOPGEN   3392
#define XCD_BAR_WORDS 3456
#define XB_SPIN_CAP (1u << 18)
__device__ __forceinline__ unsigned xb_ld(unsigned* p)              { return __hip_atomic_load(p, __ATOMIC_RELAXED, __HIP_MEMORY_SCOPE_AGENT); }
__device__ __forceinline__ unsigned xb_add(unsigned* p, unsigned v) { return __hip_atomic_fetch_add(p, v, __ATOMIC_RELAXED, __HIP_MEMORY_SCOPE_AGENT); }
__device__ __forceinline__ unsigned xb_xcc_id() { return (unsigned)__builtin_amdgcn_s_getreg((3 << 11) | 20) & 0xFu; }
#define XB_SPIN(cond, bar) do { unsigned _sp = 0; while (cond) { __builtin_amdgcn_s_sleep(1); \
    if ((++_sp & 255u) == 0u) { if (xb_ld(&(bar)[XB_TMO])) break; if (_sp > XB_SPIN_CAP) { atomicAdd(&(bar)[XB_TMO], 1u); break; } } } } while (0)
struct XcdBarrier { unsigned* bar; unsigned x; volatile LAS unsigned* st; };
__device__ __forceinline__ XcdBarrier xcd_barrier_post(unsigned* bar, volatile LAS unsigned* st) {
    XcdBarrier b; b.bar = bar; b.x = xb_xcc_id(); b.st = st;
    if (threadIdx.x == 0) (void)xb_add(&bar[XB_XCNT(b.x)], 1u);
    return b;
}
__device__ __forceinline__ void xcd_barrier_complete(unsigned* bar, unsigned x, unsigned& nloc, unsigned& nx) {
    const unsigned G = gridDim.x * gridDim.y * gridDim.z;
    unsigned sum, cnt, mine, sp = 0u;
    for (;;) {
        sum = 0u; cnt = 0u; mine = 0u;
#pragma unroll
        for (unsigned j = 0; j < 16; ++j) { const unsigned c = xb_ld(&bar[XB_XCNT(j)]); sum += c; cnt += (c > 0u) ? 1u : 0u; mine = (j == x) ? c : mine; }
        if (sum == G) break;
        __builtin_amdgcn_s_sleep(1);
        if ((++sp & 255u) == 0u) { if (xb_ld(&bar[XB_TMO])) break; if (sp > XB_SPIN_CAP) { atomicAdd(&bar[XB_TMO], 1u); break; } }
    }
    nloc = mine > 0u ? mine : 1u; nx = cnt > 0u ? cnt : 1u;
}
__device__ __forceinline__ void xcd_barrier(const XcdBarrier& b) {
    asm volatile("s_waitcnt vmcnt(0)" ::: "memory");
    __syncthreads();
    if (threadIdx.x == 0) {
        unsigned* bar = b.bar;
        __builtin_amdgcn_s_waitcnt(0);
        unsigned nloc = b.st[0], nx = b.st[1];
        if (nloc == 0u) { xcd_barrier_complete(bar, b.x, nloc, nx); b.st[0] = nloc; b.st[1] = nx; }
        const unsigned old = xb_add(&bar[XB_XSUB(b.x)], 1u);
        const unsigned gen = old / nloc;
        if (old + 1u == (gen + 1u) * nloc) {
            __builtin_amdgcn_fence(__ATOMIC_RELEASE, "agent");
            asm volatile("s_waitcnt vmcnt(0)" ::: "memory");
            const unsigned og = xb_add(&bar[XB_TOP], 1u);
            const unsigned tg = og / nx;
            if (og + 1u == (tg + 1u) * nx) xb_add(&bar[XB_TOPGEN], 1u);
            else XB_SPIN(xb_ld(&bar[XB_TOPGEN]) == tg, bar);
            __builtin_amdgcn_fence(__ATOMIC_ACQUIRE, "agent");
            xb_add(&bar[XB_XGEN(b.x)], 1u);
            asm volatile("s_waitcnt vmcnt(0)" ::: "memory");
        } else {
            XB_SPIN(xb_ld(&bar[XB_XGEN(b.x)]) == gen, bar);
            __builtin_amdgcn_fence(__ATOMIC_ACQUIRE, "agent");
            asm volatile("s_waitcnt vmcnt(0)" ::: "memory");
        }
    }
    __syncthreads();
}

struct Args {
    const float* in[23]; float* out; unsigned char* ws;
    float invf[32];
    int ph_lo, ph_hi, li, rep;
};
struct Frame {
    LAS unsigned char* lds;
    volatile LAS unsigned* MISC;
    gu32* ctl;
    int tid, lane, wave, G, gw, NGW;
    unsigned char* ws;
};
__device__ __forceinline__ float wave_sum(float v) {
#pragma unroll
    for (int o = 1; o < 64; o <<= 1) v += __shfl_xor(v, o);
    return v;
}
__device__ __forceinline__ float wave_max(float v) {
#pragma unroll
    for (int o = 1; o < 64; o <<= 1) v = fmaxf(v, __shfl_xor(v, o));
    return v;
}

__device__ __forceinline__ unsigned pk4_fp8(float a, float b, float c, float d) { int w = 0; w = __builtin_amdgcn_cvt_pk_fp8_f32(a, b, w, false); w = __builtin_amdgcn_cvt_pk_fp8_f32(c, d, w, true); return (unsigned)w; }
#if defined(CVT_REG) && CVT_REG
__device__ __forceinline__ void cvt_load(const float* __restrict__ W, int N, int k0, int n0, int lane, f32x4 (&v)[8]) {
    const GAS float* p = (const GAS float*)(W + (size_t)(k0 + (lane >> 5) * 32) * N + n0 + (lane & 31));
#pragma unroll
    for (int i = 0; i < 8; ++i)
#pragma unroll
        for (int e = 0; e < 4; ++e) v[i][e] = __builtin_nontemporal_load(p + (size_t)(i * 4 + e) * N);
}
template <bool FP8>
__device__ __forceinline__ void cvt_finish(const f32x4 (&v)[8], int k0, void* __restrict__ dstv, int ldd, int drow0, int kdst0, LAS float* scr, int lane, float wsc) {
    const int n = lane & 31, kh = (lane >> 5) * 32;
    if constexpr (FP8) { GAS v4u* d = (GAS v4u*)((unsigned char*)dstv + (size_t)(drow0 + n) * ldd + kdst0 + k0 + kh);
#pragma unroll
        for (int j = 0; j < 2; ++j) { v4u o;
            o.x = pk4_fp8(v[4 * j][0] * wsc, v[4 * j][1] * wsc, v[4 * j][2] * wsc, v[4 * j][3] * wsc); o.y = pk4_fp8(v[4 * j + 1][0] * wsc, v[4 * j + 1][1] * wsc, v[4 * j + 1][2] * wsc, v[4 * j + 1][3] * wsc);
            o.z = pk4_fp8(v[4 * j + 2][0] * wsc, v[4 * j + 2][1] * wsc, v[4 * j + 2][2] * wsc, v[4 * j + 2][3] * wsc); o.w = pk4_fp8(v[4 * j + 3][0] * wsc, v[4 * j + 3][1] * wsc, v[4 * j + 3][2] * wsc, v[4 * j + 3][3] * wsc);
            __builtin_nontemporal_store(o, d + j); } }
    else { GAS v4u* d = (GAS v4u*)((bf16*)dstv + (size_t)(drow0 + n) * ldd + kdst0 + k0 + kh);
#pragma unroll
        for (int j = 0; j < 4; ++j) { v4u o; o.x = pk2(v[2 * j][0], v[2 * j][1]); o.y = pk2(v[2 * j][2], v[2 * j][3]); o.z = pk2(v[2 * j + 1][0], v[2 * j + 1][1]); o.w = pk2(v[2 * j + 1][2], v[2 * j + 1][3]);
            __builtin_nontemporal_store(o, d + j); } }
}
#else
__device__ __forceinline__ void cvt_load(const float* __restrict__ W, int N, int k0, int n0, int lane, f32x4 (&v)[8]) {
    const int lr = lane >> 3, lc = (lane & 7) * 4;
#pragma unroll
    for (int i = 0; i < 8; ++i) v[i] = __builtin_nontemporal_load((const GAS f32x4*)(W + (size_t)(k0 + i * 8 + lr) * N + n0 + lc));
}
template <bool FP8>
__device__ __forceinline__ void cvt_finish(const f32x4 (&v)[8], int k0, void* __restrict__ dstv, int ldd, int drow0, int kdst0, LAS float* scr, int lane, float wsc) {
    const int lr = lane >> 3, lc = (lane & 7) * 4;
#pragma unroll
    for (int i = 0; i < 8; ++i) { LAS float* s = scr + (i * 8 + lr) * 33 + lc; s[0] = v[i][0]; s[1] = v[i][1]; s[2] = v[i][2]; s[3] = v[i][3]; }
    LDS_WAIT(); asm volatile("" ::: "memory");
    const int c = lane & 7;
#pragma unroll
    for (int j = 0; j < 4; ++j) { const int n = (lane >> 3) + 8 * j; const LAS float* s = scr + (8 * c) * 33 + n;
        if constexpr (FP8) { v2u o; o.x = pk4_fp8(s[0 * 33] * wsc, s[1 * 33] * wsc, s[2 * 33] * wsc, s[3 * 33] * wsc); o.y = pk4_fp8(s[4 * 33] * wsc, s[5 * 33] * wsc, s[6 * 33] * wsc, s[7 * 33] * wsc);
            __builtin_nontemporal_store(o, (GAS v2u*)((unsigned char*)dstv + (size_t)(drow0 + n) * ldd + kdst0 + k0 + 8 * c)); }
        else { v4u o; o.x = pk2(s[0 * 33], s[1 * 33]); o.y = pk2(s[2 * 33], s[3 * 33]); o.z = pk2(s[4 * 33], s[5 * 33]); o.w = pk2(s[6 * 33], s[7 * 33]);
            __builtin_nontemporal_store(o, (GAS v4u*)((bf16*)dstv + (size_t)(drow0 + n) * ldd + kdst0 + k0 + 8 * c)); } }
    LDS_WAIT(); asm volatile("" ::: "memory");
}
#endif
__device__ __forceinline__ int cvt_drow(int mode, int n0, int roff) { return mode == 0 ? n0 + roff : (mode == 1 ? (n0 >> 7) * 256 + (n0 & 127) : (mode == 2 ? (n0 >> 7) * 256 + 128 + (n0 & 127) : (n0 < 576 ? n0 : n0 + 192))); }
template <bool FP8>
__device__ __forceinline__ void cvt_job(Frame& F, const float* W, int K, int N, void* dst, int ldd, int kdst0, int mode, int roff, LAS float* scr, float wsc) {
    const int nnb = N / 32, nitems = (K / 64) * nnb;
    int it = F.gw; if (it >= nitems) return;
    f32x4 va[8], vb[8];
    cvt_load(W, N, (it / nnb) * 64, (it % nnb) * 32, F.lane, va);
    for (;;) {
        const int it1 = it + F.NGW; if (it1 < nitems) cvt_load(W, N, (it1 / nnb) * 64, (it1 % nnb) * 32, F.lane, vb);
        cvt_finish<FP8>(va, (it / nnb) * 64, dst, ldd, cvt_drow(mode, (it % nnb) * 32, roff), kdst0, scr, F.lane, wsc);
        if (it1 >= nitems) break;
        const int it2 = it1 + F.NGW; if (it2 < nitems) cvt_load(W, N, (it2 / nnb) * 64, (it2 % nnb) * 32, F.lane, va);
        cvt_finish<FP8>(vb, (it1 / nnb) * 64, dst, ldd, cvt_drow(mode, (it1 % nnb) * 32, roff), kdst0, scr, F.lane, wsc);
        if (it2 >= nitems) break;
        it = it2;
    }
}
__device__ __forceinline__ void rms_row_to_bf16(const float* xrow, const float* g, bf16* orow, int lane) {
    const GAS f32x4* xr = (const GAS f32x4*)xrow + lane; const GAS f32x4* gr = (const GAS f32x4*)g + lane;
    f32x4 v[8]; float s = 0.f;
#pragma unroll
    for (int j = 0; j < 8; ++j) { v[j] = xr[64 * j]; s += (v[j].x * v[j].x + v[j].y * v[j].y) + (v[j].z * v[j].z + v[j].w * v[j].w); }
    const float rstd = 1.f / sqrtf(wave_sum(s) * (1.f / D) + EPS);
    GAS v2u* o8 = (GAS v2u*)orow + lane;
#pragma unroll
    for (int j = 0; j < 8; ++j) { const f32x4 gg = gr[64 * j]; v2u w; w.x = pk2(v[j].x * rstd * gg.x, v[j].y * rstd * gg.y); w.y = pk2(v[j].z * rstd * gg.z, v[j].w * rstd * gg.w); o8[64 * j] = w; }
}
__device__ __forceinline__ void rms_row_to_fp8(const float* xrow, const float* g, unsigned char* orow, int lane) {
    const GAS f32x4* xr = (const GAS f32x4*)xrow + lane; const GAS f32x4* gr = (const GAS f32x4*)g + lane;
    f32x4 v[8]; float s = 0.f;
#pragma unroll
    for (int j = 0; j < 8; ++j) { v[j] = xr[64 * j]; s += (v[j].x * v[j].x + v[j].y * v[j].y) + (v[j].z * v[j].z + v[j].w * v[j].w); }
    const float rstd = 1.f / sqrtf(wave_sum(s) * (1.f / D) + EPS);
    GAS unsigned* o4 = (GAS unsigned*)orow + lane;
#pragma unroll
    for (int j = 0; j < 8; ++j) { const f32x4 gg = gr[64 * j]; o4[64 * j] = pk4_fp8(v[j].x * rstd * gg.x, v[j].y * rstd * gg.y, v[j].z * rstd * gg.z, v[j].w * rstd * gg.w); }
}
__device__ __forceinline__ void sincos_f64(float ang, float& c, float& s) {
    const double a = (double)ang, twopi = 6.283185307179586476925286766559, inv2pi = 0.15915494309189533576888376337251;
    const double q = __builtin_rint(a * inv2pi); const double r = a - q * twopi;
    const double r2 = r * r; double ss = 1.0, cc = 1.0;
#pragma unroll
    for (int k = 14; k >= 1; --k) { ss = 1.0 - r2 * (1.0 / (double)((2 * k) * (2 * k + 1))) * ss; cc = 1.0 - r2 * (1.0 / (double)((2 * k - 1) * (2 * k))) * cc; }
    s = (float)(r * ss); c = (float)cc;
}
__device__ const unsigned char DIL_BUCKET[3][129] = {
 {11,11,11,11,11,11,11,11,11,11,11,11,11,11,11,10,10,10,10,10,10,10,10,10,10,10,10,10,10,10,10,10,10,10,10,10,10,10,9,9,9,9,9,9,9,9,9,9,9,9,8,8,8,8,8,8,8,7,6,5,4,3,2,1,0,17,18,19,20,21,22,23,24,24,24,24,24,24,24,25,25,25,25,25,25,25,25,25,25,25,25,26,26,26,26,26,26,26,26,26,26,26,26,26,26,26,26,26,26,26,26,26,26,26,27,27,27,27,27,27,27,27,27,27,27,27,27,27,27},
 {13,13,13,13,13,13,13,13,13,13,13,13,13,13,13,13,13,13,13,13,13,13,13,12,12,12,12,12,12,12,12,12,12,12,12,12,12,12,12,12,12,12,11,11,11,11,11,11,11,11,11,11,10,10,10,10,10,10,9,9,9,8,8,4,0,20,24,24,25,25,25,26,26,26,26,26,26,27,27,27,27,27,27,27,27,27,27,28,28,28,28,28,28,28,28,28,28,28,28,28,28,28,28,28,28,28,29,29,29,29,29,29,29,29,29,29,29,29,29,29,29,29,29,29,29,29,29,29,29},
 {15,15,15,15,15,15,15,15,15,15,15,15,15,15,15,15,15,15,15,15,15,15,15,15,15,15,15,15,15,15,14,14,14,14,14,14,14,14,14,14,14,14,14,14,14,13,13,13,13,13,13,13,13,13,12,12,12,12,12,11,11,10,10,9,0,25,26,26,27,27,28,28,28,28,28,29,29,29,29,29,29,29,29,29,30,30,30,30,30,30,30,30,30,30,30,30,30,30,30,31,31,31,31,31,31,31,31,31,31,31,31,31,31,31,31,31,31,31,31,31,31,31,31,31,31,31,31,31,31}};

typedef float f32x2 __attribute__((ext_vector_type(2)));
#ifndef PRE_ROWS
#define PRE_ROWS 4
#endif
#ifndef COMB_ROWS
#define COMB_ROWS 2
#endif
__device__ __forceinline__ f32x4 ld_r4(const float* p) { return *(const GAS f32x4*)p; }
__device__ __forceinline__ v2u ld_r4(const unsigned short* p) { return *(const GAS v2u*)p; }
__device__ __forceinline__ f32x4 cv4(f32x4 r) { return r; }
__device__ __forceinline__ f32x4 cv4(v2u w) { return (f32x4){bflo(w.x), bfhi(w.x), bflo(w.y), bfhi(w.y)}; }
__device__ __forceinline__ f32x4 ld_o4(const float* p) { return *(const GAS f32x4*)p; }
__device__ __forceinline__ f32x4 ld_o4(const unsigned short* p) { const v2u w = *(const GAS v2u*)p; return (f32x4){bflo(w.x), bfhi(w.x), bflo(w.y), bfhi(w.y)}; }
#ifndef CVT_CHUNK
#define CVT_CHUNK 64
#endif
#ifndef PH_MASK
#define PH_MASK 0xFFFFu
#endif
#ifndef REPEAT_PHASE
#define REPEAT_PHASE -1
#endif
#ifndef ATT_EN
#define ATT_EN 7
#endif
#define PEN(k) ((PH_MASK >> (k)) & 1u)
#ifndef FFN_FP8
#define FFN_FP8 3
#endif
constexpr bool F8D = (FFN_FP8 & 1) != 0, F8M = (FFN_FP8 & 2) != 0;
constexpr int EBD = F8D ? 1 : 2, EBM = F8M ? 1 : 2;
template <bool B> struct Sc { static constexpr float w_gu = B ? 32.f : 1.f, w_dn = B ? 64.f : 1.f, a_sc = B ? 4.f : 1.f, dn = 1.f / (w_dn * a_sc); };
template <bool B> using FfnEpi1 = typename std::conditional<B, pg8::EpiSwiGLU8, pg8::EpiSwiGLU>::type;
template <bool B> struct Epi1Maker;
template <> struct Epi1Maker<true> { static __device__ __forceinline__ pg8::EpiSwiGLU8 make(void* O, int ldc) { return pg8::EpiSwiGLU8{(unsigned char*)O, ldc, 1.f / Sc<true>::w_gu, Sc<true>::a_sc}; } };
template <> struct Epi1Maker<false> { static __device__ __forceinline__ pg8::EpiSwiGLU make(void* O, int ldc) { return pg8::EpiSwiGLU{(unsigned short*)O, ldc}; } };

constexpr int MOE_MAT_ITEMS = 7168, MOE_GU_ITEMS = 16 * MOE_MAT_ITEMS, MOE_NITEMS = 24 * MOE_MAT_ITEMS, MOE_CHUNK = CVT_CHUNK, MOE_NCHUNK = MOE_NITEMS / MOE_CHUNK;
struct MoeItem { const float* W; void* dst; int N, k0, n0, ldd, drow0; float wsc; };
typedef const __attribute__((address_space(4))) Args* KArgs;
__device__ __forceinline__ MoeItem moe_item(KArgs ka, unsigned char* ws, int idx) {
    MoeItem m;
    if (idx < MOE_GU_ITEMS) { const int mat = idx / MOE_MAT_ITEMS, local = idx % MOE_MAT_ITEMS, e = mat >> 1, up = mat & 1, kb = local / (DFE / 32), nb = local % (DFE / 32);
        m.W = ka->in[19 + up] + (size_t)e * D * DFE; m.N = DFE; m.k0 = kb * 64; m.n0 = nb * 32; m.dst = ws + WS_MGU + (size_t)e * 2 * DFE * D * EBM; m.ldd = D;
        m.drow0 = (m.n0 >> 7) * 256 + up * 128 + (m.n0 & 127); m.wsc = Sc<F8M>::w_gu; }
    else { const int i2 = idx - MOE_GU_ITEMS, e = i2 / MOE_MAT_ITEMS, local = i2 % MOE_MAT_ITEMS, kb = local / (D / 32), nb = local % (D / 32);
        m.W = ka->in[21] + (size_t)e * DFE * D; m.N = D; m.k0 = kb * 64; m.n0 = nb * 32; m.dst = ws + WS_MDN + (size_t)e * D * DFE * EBM; m.ldd = DFE; m.drow0 = m.n0; m.wsc = Sc<F8M>::w_dn; }
    return m;
}
__device__ __forceinline__ void moe_cvt_chunk(Frame& F, KArgs ka, int c) {
    LAS float* scr = (LAS float*)(F.lds + F.wave * 16384);
    const int i0 = c * MOE_CHUNK + F.wave * (MOE_CHUNK / 8);
    f32x4 va[8], vb[8], vc[8]; MoeItem ma, mb, mc;
#define MC_L(m, v, i) do { m = moe_item(ka, F.ws, i0 + (i)); cvt_load(m.W, m.N, m.k0, m.n0, F.lane, v); } while (0)
#define MC_F(m, v) cvt_finish<F8M>(v, m.k0, m.dst, m.ldd, m.drow0, 0, scr, F.lane, m.wsc)
    MC_L(ma, va, 0); MC_L(mb, vb, 1); MC_L(mc, vc, 2);
    if constexpr (MOE_CHUNK == 64) {
        MC_F(ma, va); MC_L(ma, va, 3); MC_F(mb, vb); MC_L(mb, vb, 4); MC_F(mc, vc); MC_L(mc, vc, 5);
        MC_F(ma, va); MC_L(ma, va, 6); MC_F(mb, vb); MC_L(mb, vb, 7); MC_F(mc, vc); MC_F(ma, va); MC_F(mb, vb);
    } else {
        MC_F(ma, va); MC_L(ma, va, 3); MC_F(mb, vb); MC_F(mc, vc); MC_F(ma, va);
    }
#undef MC_L
#undef MC_F
}
__device__ __forceinline__ void moe_cvt_fill(Frame& F, KArgs ka, int ph) {
    { int t_ = threadIdx.x; asm volatile("" : "+v"(t_)); F.tid = t_; F.lane = t_ & 63; }
    for (;;) {
        if (F.tid == 0) { unsigned c = MOE_NCHUNK;
            if (ph < 0 || __hip_atomic_load(F.ctl + CW_DONE + ph, RLX_AGENT) < (unsigned)F.G) c = __hip_atomic_fetch_add(F.ctl + CW_CVT + (ph == -2 ? 16 : 0), 1u, RLX_AGENT);
            F.MISC[17] = c; }
        __syncthreads(); const unsigned c = F.MISC[17]; __syncthreads();
        if (c >= (unsigned)MOE_NCHUNK) break;
        moe_cvt_chunk(F, ka, (int)c);
    }
}
#define FILL(ph) do { __syncthreads(); if (F.tid == 0) (void)__hip_atomic_fetch_add(F.ctl + CW_DONE + (ph), 1u, RLX_AGENT); moe_cvt_fill(F, ka, (ph)); } while (0)
#ifndef MLA_DMA
#define MLA_DMA 1
#endif
#ifndef MOE_TAIL
#define MOE_TAIL 1
#endif
#ifndef GEMM_SP2
#define GEMM_SP2 1
#endif
constexpr bool SP2V = (GEMM_SP2 != 0);
#ifndef PROBE_ATT
#define PROBE_ATT 7
#endif
#ifndef FILLMASK
#define FILLMASK 7
#endif
constexpr int PH_PER_LAYER = 11, N_PHASES = 1 + 2 * PH_PER_LAYER;
#ifndef MK_N_LAUNCHES
#define MK_N_LAUNCHES 1
#endif
constexpr int N_LAUNCHES = MK_N_LAUNCHES;

__global__ void __launch_bounds__(NWAVES * 64, 2) mk_fwd(Args) {
    KArgs ka = (KArgs)__builtin_amdgcn_kernarg_segment_ptr(); asm volatile("" : "+s"(ka));
#define args (*ka)
    extern __shared__ __attribute__((aligned(16))) unsigned char lds[];
    Frame F;
    F.lds = (LAS unsigned char*)lds;
    F.MISC = (volatile LAS unsigned*)(F.lds + MISC_OFF);
    F.tid = threadIdx.x; F.lane = F.tid & 63; F.wave = __builtin_amdgcn_readfirstlane(F.tid >> 6);
    F.G = gridDim.x; F.gw = blockIdx.x * NWAVES + F.wave; F.NGW = F.G * NWAVES;
    F.ws = args.ws; F.ctl = (gu32*)(args.ws + WS_CTL);
    unsigned char* ws = args.ws;
    for (int u = F.tid; u < (LDS_BYTES - LDSCTL_OFF) / 4; u += NWAVES * 64) ((LAS unsigned*)(F.lds + LDSCTL_OFF))[u] = 0u;
    __syncthreads();
    XcdBarrier bar; bar.bar = (unsigned*)(F.ctl + CW_BAR) + args.li * 4096; bar.x = 0; bar.st = nullptr;
    if (N_LAUNCHES != N_PHASES) bar = xcd_barrier_post((unsigned*)(F.ctl + CW_BAR) + args.li * 4096, F.MISC + 8);
#define GRID_BAR() do { if (N_LAUNCHES != N_PHASES) xcd_barrier(bar); } while (0)
    const int lo = args.ph_lo, hi = args.ph_hi;
#define IN(k) (lo <= (k) && (k) < hi)
#define BOTH(k) (IN(k) && IN((k) + 1))

#define x_in (args.in[0])
#define XN8 ((unsigned char*)(ws + WS_XN))
#define WIN ((bf16*)(ws + WS_WIN))
#define WUP ((bf16*)(ws + WS_WUP))
#define WMEM ((bf16*)(ws + WS_WMEM))
#define WOUT ((bf16*)(ws + WS_WOUT))
#define WGU ((bf16*)(ws + WS_WGU))
#define WDN ((bf16*)(ws + WS_WDN))
#define MGU ((bf16*)(ws + WS_MGU))
#define MDN ((bf16*)(ws + WS_MDN))
#define XN ((bf16*)(ws + WS_XN))
#define MEMN ((bf16*)(ws + WS_MEMN))
#define MEMKV ((bf16*)(ws + WS_MEMKV))
#define PROJ ((bf16*)(ws + WS_PROJ))
#define AQKV ((bf16*)(ws + WS_AQKV))
#define KROPE ((bf16*)(ws + WS_KROPE))
#define ROPECS ((float*)(ws + WS_ROPECS))
#define QKVM ((bf16*)(ws + WS_QKVM))
#define YPRE ((att::OT*)(ws + WS_YPRE))
#define YPREF ((float*)(ws + WS_YPRE))
#define DILO ((att::OT*)(ws + WS_DILO))
#define DILS ((float*)(ws + WS_DILS))
#define Y ((bf16*)(ws + WS_Y))
#define XA ((float*)(ws + WS_XA))
#define ROUTE ((unsigned*)(ws + WS_ROUTE))
#define XP ((bf16*)(ws + WS_XP))
#define OUTP ((bf16*)(ws + WS_OUTP))
#define OUTQ ((bf16*)(ws + WS_OUTQ))
#define ACTP ((bf16*)(ws + WS_ACTP))
#define ACT ((bf16*)(ws + WS_ACTP))
#if defined(PROBE_T)
#define TSTAMP_AT(p) do { if (threadIdx.x == 0) { ((volatile LAS unsigned*)(F.lds + 131520))[(p)] = (unsigned)__builtin_amdgcn_s_memrealtime(); ((volatile LAS unsigned*)(F.lds + 131520))[32 + (p)] = (unsigned)__builtin_amdgcn_s_memtime(); } } while (0)
#else
#define TSTAMP_AT(p) do { } while (0)
#endif
#define PHASE_BEGIN() do { int t_ = threadIdx.x; asm volatile("" : "+v"(t_)); F.tid = t_; F.lane = t_ & 63; asm volatile("" : "+s"(ka)); } while (0)

    if (PEN(0) && IN(0)) { PHASE_BEGIN(); TSTAMP_AT(0);
        LAS float* scr = (LAS float*)(F.lds + F.wave * 16384);
        { const v4u z = {0u, 0u, 0u, 0u}; const int gt = blockIdx.x * (NWAVES * 64) + F.tid, ngt = F.G * NWAVES * 64;
          for (int l = 0; l < 2; ++l) {
              GAS v4u* w = (GAS v4u*)(WIN + (size_t)l * DINP * D + (size_t)576 * D); for (int i = gt; i < 192 * D / 8; i += ngt) w[i] = z;
              GAS v4u* u = (GAS v4u*)(WUP + (size_t)l * NUP * AQ);
              for (int i = gt; i < NUP * 64; i += ngt) { const int row = i >> 6, c = i & 63; const bool zero = row < 1152 ? (c >= 48) : (row < 1280 ? true : (c < 48)); if (zero) u[i] = z; } } }
        for (int rep = 0; rep < (REPEAT_PHASE == 0 ? 2 : 1); ++rep) {
        for (int l = 0; l < 2; ++l) {
            cvt_job<false>(F, args.in[5] + (size_t)l * D * DIN, D, DIN, WIN + (size_t)l * DINP * D, D, 0, 3, 0, scr, 1.f);
            cvt_job<false>(F, args.in[7] + (size_t)l * QR * 1152, QR, 1152, WUP + (size_t)l * NUP * AQ, AQ, 0, 0, 0, scr, 1.f);
            cvt_job<false>(F, args.in[9] + (size_t)l * KVR * 1536, KVR, 1536, WUP + (size_t)l * NUP * AQ, AQ, QR, 0, UC_KV, scr, 1.f);
            cvt_job<false>(F, args.in[11] + (size_t)l * D * 1024, D, 1024, WMEM + (size_t)l * 1024 * D, D, 0, 0, 0, scr, 1.f);
            cvt_job<false>(F, args.in[13] + (size_t)l * D * D, D, D, WOUT + (size_t)l * D * D, D, 0, 0, 0, scr, 1.f);
        }
        cvt_job<F8D>(F, args.in[15], D, DFF, WGU, D, 0, 1, 0, scr, Sc<F8D>::w_gu);
        cvt_job<F8D>(F, args.in[16], D, DFF, WGU, D, 0, 2, 0, scr, Sc<F8D>::w_gu);
        cvt_job<F8D>(F, args.in[17], DFF, D, WDN, DFF, 0, 0, 0, scr, Sc<F8D>::w_dn);
        }
        { const int* pos = (const int*)args.in[2];
          for (int idx = blockIdx.x * (NWAVES * 64) + F.tid; idx < S * 32; idx += F.G * NWAVES * 64) { const int row = idx >> 5, i = idx & 31;
              const float ang = (float)pos[row] * args.invf[i]; float c, s; sincos_f64(ang, c, s); ROPECS[row * 64 + i] = c; ROPECS[row * 64 + 32 + i] = s; } }
        for (int m = F.gw; m < 2 * NMEM; m += F.NGW) { const int l = m >> 8, r = m & 255; rms_row_to_bf16(args.in[1] + (size_t)r * D, args.in[10] + (size_t)l * D, MEMN + (size_t)m * D, F.lane); }
        for (int m = F.gw; m < S; m += F.NGW) rms_row_to_bf16(x_in + (size_t)m * D, args.in[4], XN + (size_t)m * D, F.lane);
        if (BOTH(0)) GRID_BAR();
    }

    for (int l = 0; l < 2; ++l) {
        const int pb = 1 + l * PH_PER_LAYER;
        if (PEN(1) && IN(pb + 0)) { PHASE_BEGIN(); TSTAMP_AT(pb + 0);
            { pg8::Gemm g{XN, WIN + (size_t)l * DINP * D, 2 * D, 2 * D, D / 64}; pg8::InProjOrder So; So.so.init(S, DINP, F.G, (int)blockIdx.x); So.nextra = (l == 0) ? 8 : 0; So.A2 = MEMN; So.B2 = WMEM;
              pg8::EpiBf16Sel E{PROJ, DINP, MEMKV, 1024};
              pg8::gemm_phase<pg8::EpiBf16Sel, pg8::InProjOrder, true, SP2V>(F.lds, g, So, E); }
            if (FILLMASK & 1) FILL(pb + 0);
            if (BOTH(pb + 0)) GRID_BAR();
        }
        if (PEN(2) && IN(pb + 1)) { PHASE_BEGIN(); TSTAMP_AT(pb + 1);
            const float* gq = args.in[6] + l * QR; const float* gkv = args.in[8] + l * KVR;
            const float* gp = F.lane < 48 ? gq + F.lane * 8 : gkv + (F.lane - 48) * 8;
            const f32x4 g0 = *(const GAS f32x4*)gp, g1 = *(const GAS f32x4*)(gp + 4);
            const int c = F.lane & 7;
            constexpr int PR = PRE_ROWS;
            for (int m0 = F.gw; m0 < S; m0 += PR * F.NGW) {
                v4u w_[PR], kw_[PR]; f32x4 cs_[PR][4];
#pragma unroll
                for (int r = 0; r < PR; ++r) { const int mr = m0 + r * F.NGW, m = mr < S ? mr : m0;
                    w_[r] = *(const GAS v4u*)(PROJ + (size_t)m * DINP + F.lane * 8);
                    kw_[r] = *(const GAS v4u*)(PROJ + (size_t)m * DINP + 512 + c * 8);
                    const float* cs = ROPECS + (size_t)m * 64 + (c & 3) * 8;
                    cs_[r][0] = *(const GAS f32x4*)cs; cs_[r][1] = *(const GAS f32x4*)(cs + 4); cs_[r][2] = *(const GAS f32x4*)(cs + 32); cs_[r][3] = *(const GAS f32x4*)(cs + 36); }
#pragma unroll
                for (int r = 0; r < PR; ++r) { const int m = m0 + r * F.NGW; if (m >= S) break;
                    const v4u w = w_[r];
                    float v[8] = {bflo(w.x), bfhi(w.x), bflo(w.y), bfhi(w.y), bflo(w.z), bfhi(w.z), bflo(w.w), bfhi(w.w)};
                    float sq = 0.f;
#pragma unroll
                    for (int j = 0; j < 8; ++j) sq += v[j] * v[j];
                    const float sq_q = wave_sum(F.lane < 48 ? sq : 0.f), sq_kv = wave_sum(F.lane >= 48 ? sq : 0.f);
                    const float rstd = F.lane < 48 ? 1.f / sqrtf(sq_q * (1.f / QR) + EPS) : 1.f / sqrtf(sq_kv * (1.f / KVR) + EPS);
                    v4u o; o.x = pk2(v[0] * rstd * g0.x, v[1] * rstd * g0.y); o.y = pk2(v[2] * rstd * g0.z, v[3] * rstd * g0.w);
                    o.z = pk2(v[4] * rstd * g1.x, v[5] * rstd * g1.y); o.w = pk2(v[6] * rstd * g1.z, v[7] * rstd * g1.w);
                    *(GAS v4u*)(AQKV + (size_t)m * AQ + F.lane * 8) = o;
                    const v4u kw = kw_[r];
                    float kv[8] = {bflo(kw.x), bfhi(kw.x), bflo(kw.y), bfhi(kw.y), bflo(kw.z), bfhi(kw.z), bflo(kw.w), bfhi(kw.w)};
                    float ko[8];
#pragma unroll
                    for (int j = 0; j < 8; ++j) { const float other = __shfl_xor(kv[j], 4); const float co = cs_[r][j >> 2][j & 3], si = cs_[r][2 + (j >> 2)][j & 3];
                        ko[j] = (c < 4) ? (kv[j] * co - other * si) : (other * si + kv[j] * co); }
                    if (F.lane < 8) { v4u ow; ow.x = pk2(ko[0], ko[1]); ow.y = pk2(ko[2], ko[3]); ow.z = pk2(ko[4], ko[5]); ow.w = pk2(ko[6], ko[7]); *(GAS v4u*)(KROPE + (size_t)m * 64 + c * 8) = ow; }
                }
            }
            if (BOTH(pb + 1)) GRID_BAR();
        }
        if (PEN(3) && IN(pb + 2)) { PHASE_BEGIN(); TSTAMP_AT(pb + 2);
            pg8::Gemm g{AQKV, WUP + (size_t)l * NUP * AQ, 2 * AQ, 2 * AQ, AQ / 64}; pg8::StaticOrder So; So.init(S, NUP, F.G, (int)blockIdx.x);
            pg8::EpiBf16 E{QKVM, NUP, 1.f};
            pg8::gemm_phase<pg8::EpiBf16, pg8::StaticOrder, true, SP2V>(F.lds, g, So, E);
            if (FILLMASK & 2) FILL(pb + 2);
            if (BOTH(pb + 2)) GRID_BAR();
        }
        if (PEN(4) && IN(pb + 3)) { PHASE_BEGIN(); TSTAMP_AT(pb + 3);
            LAS float* BIAS = (LAS float*)(F.lds + BIAS_OFF);
            for (int i = F.tid; i < 3 * 6 * 129; i += NWAVES * 64) { const int b = i / (6 * 129), rem = i % (6 * 129), h = rem / 129, j = rem % 129;
                BIAS[(b * 6 + h) * 132 + j] = args.in[3][DIL_BUCKET[b][j] * 6 + h] * att::LOG2E; }
            __syncthreads();
            for (int rep = 0; rep < (REPEAT_PHASE == 4 ? 2 : 1); ++rep) {
            gu32* qhead = F.ctl + CW_QUEUE + 64 * l + 32 * rep + 4 * args.li;
            constexpr int NU_MLA = 6 * 32, NU_MEM = 4 * 32, NU_DIL = 3 * 6 * 32, NU = NU_MLA + NU_MEM + NU_DIL;
#define QPULL(u) do { if (F.tid == 0) F.MISC[16] = __hip_atomic_fetch_add(qhead, 1u, RLX_AGENT); __syncthreads(); u = (int)F.MISC[16]; __syncthreads(); } while (0)
            int u; QPULL(u);
            if ((ATT_EN & 1) && (!args.rep || (PROBE_ATT & 1))) while (u < NU_MLA) {
                const int h = u >> 5, qb = u & 31;
                att::MLA_BODY<NUP, NUP, D>(QKVM + (size_t)qb * 256 * NUP + h * 192, QKVM + UC_KV + h * 256, KROPE, QKVM + UC_KV + h * 256 + 128,
                                                        ROPECS + (size_t)qb * 256 * 64, YPRE + (size_t)qb * 256 * D + h * 128, S, 0.07216878364870322f, (LAS char*)F.lds);
                QPULL(u);
            }
            if (args.rep && !(PROBE_ATT & 1)) { while (u < NU_MLA) QPULL(u); }
            if ((ATT_EN & 2) && (!args.rep || (PROBE_ATT & 2))) while (u < NU_MLA + NU_MEM) {
                const int v = u - NU_MLA, h = v >> 5, qb = v & 31;
                const bf16* kv = MEMKV + (size_t)l * NMEM * 1024;
                att::attn_dense_body<128, DINP, 1024, D, 1>(PROJ + (size_t)qb * 256 * DINP + PC_MEM + h * 128, kv + h * 128, nullptr, kv + 512 + h * 128,
                                                            nullptr, YPRE + (size_t)qb * 256 * D + 1536 + h * 128, NMEM, 0.08838834764831845f, (LAS char*)F.lds);
                QPULL(u);
            }
            if (args.rep && !(PROBE_ATT & 2)) { while (u < NU_MLA + NU_MEM) QPULL(u); }
            if ((ATT_EN & 4) && (!args.rep || (PROBE_ATT & 4))) while (u < NU) {
                const int w = (u - NU_MLA - NU_MEM) * 8;
                const int b = w / 1536, h = (w % 1536) >> 8, tile = w & 255;
                const int d = b == 0 ? 1 : (b == 1 ? 4 : 16), nT = S / d, tpr = nT / 32;
                const int r = tile / tpr, t0 = (tile % tpr) * 32;
                LAS float* TB = (LAS float*)(F.lds + BIAS_OFF + 3 * 6 * 132 * 4);
                for (int i = F.tid; i < 4 * 196; i += NWAVES * 64) { const int k = i / 196, j = (i % 196) + k - 32; TB[i] = (j >= 0 && j <= 128) ? BIAS[(b * 6 + h) * 132 + j] : -1e30f; }
                __syncthreads();
                att::dil_wg_unit<DINP>(PROJ, PC_DIL + h * 128, PC_DIL + 768 + h * 128, PC_DIL + 1536 + h * 128, d, r, t0, nT,
                                       DILO + (size_t)b * S * 768, h * 128, DILS + (size_t)b * S * 12 + h * 2, (LAS char*)F.lds, TB, 0.08838834764831845f * att::LOG2E);
                QPULL(u);
            }
#undef QPULL
            }
            if (FILLMASK & 4) FILL(pb + 3);
            if (BOTH(pb + 3)) GRID_BAR();
        }
        if (PEN(5) && IN(pb + 4)) { PHASE_BEGIN(); TSTAMP_AT(pb + 4);
            const float* gn = args.in[12] + (size_t)l * D;
            constexpr int CR = COMB_ROWS;
            typedef decltype(ld_r4((const att::OT*)nullptr)) RawO;
            for (int m0 = F.gw; m0 < S; m0 += CR * F.NGW) {
                RawO ya[CR][3], yc[CR][2], ob[CR][3][3]; f32x2 st[CR][3][3];
#pragma unroll
                for (int r = 0; r < CR; ++r) { const int mr = m0 + r * F.NGW, m = mr < S ? mr : m0; const att::OT* yr = YPRE + (size_t)m * D;
#pragma unroll
                    for (int j = 0; j < 3; ++j) ya[r][j] = ld_r4(yr + (F.lane + 64 * j) * 4);
#pragma unroll
                    for (int j = 0; j < 2; ++j) yc[r][j] = ld_r4(yr + 1536 + (F.lane + 64 * j) * 4);
#pragma unroll
                    for (int j = 0; j < 3; ++j) { const int col = (F.lane + 64 * j) * 4, h = col >> 7;
#pragma unroll
                        for (int b = 0; b < 3; ++b) { st[r][j][b] = *(const GAS f32x2*)(DILS + ((size_t)b * S + m) * 12 + h * 2); ob[r][j][b] = ld_r4(DILO + ((size_t)b * S + m) * 768 + col); } } }
#pragma unroll
                for (int r = 0; r < CR; ++r) { const int m = m0 + r * F.NGW; if (m >= S) break;
                    f32x4 a[3]; float sa = 0.f;
#pragma unroll
                    for (int j = 0; j < 3; ++j) { a[j] = cv4(ya[r][j]); sa += (a[j].x * a[j].x + a[j].y * a[j].y) + (a[j].z * a[j].z + a[j].w * a[j].w); }
                    f32x4 c[2]; float sc = 0.f;
#pragma unroll
                    for (int j = 0; j < 2; ++j) { c[j] = cv4(yc[r][j]); sc += (c[j].x * c[j].x + c[j].y * c[j].y) + (c[j].z * c[j].z + c[j].w * c[j].w); }
                    f32x4 bq[3]; float sb = 0.f;
#pragma unroll
                    for (int j = 0; j < 3; ++j) {
                        const float M = fmaxf(st[r][j][0].x, fmaxf(st[r][j][1].x, st[r][j][2].x));
                        float wgt[3], den = 0.f;
#pragma unroll
                        for (int b = 0; b < 3; ++b) { wgt[b] = __builtin_amdgcn_exp2f(st[r][j][b].x - M); den += wgt[b] * st[r][j][b].y; }
                        const float inv = 1.f / den; f32x4 acc = {0.f, 0.f, 0.f, 0.f};
#pragma unroll
                        for (int b = 0; b < 3; ++b) acc += cv4(ob[r][j][b]) * (wgt[b] * inv);
                        bq[j] = acc; sb += (acc.x * acc.x + acc.y * acc.y) + (acc.z * acc.z + acc.w * acc.w); }
                    const float ra = 1.f / sqrtf(wave_sum(sa) * (1.f / 768.f) + EPS), rb = 1.f / sqrtf(wave_sum(sb) * (1.f / 768.f) + EPS), rc = 1.f / sqrtf(wave_sum(sc) * (1.f / 512.f) + EPS);
                    bf16* yo = Y + (size_t)m * D;
#pragma unroll
                    for (int j = 0; j < 3; ++j) { const int col = (F.lane + 64 * j) * 4; const f32x4 g = *(const GAS f32x4*)(gn + col);
                        v2u w; w.x = pk2(a[j].x * ra * g.x, a[j].y * ra * g.y); w.y = pk2(a[j].z * ra * g.z, a[j].w * ra * g.w); *(GAS v2u*)(yo + col) = w; }
#pragma unroll
                    for (int j = 0; j < 3; ++j) { const int col = (F.lane + 64 * j) * 4; const f32x4 g = *(const GAS f32x4*)(gn + 768 + col);
                        v2u w; w.x = pk2(bq[j].x * rb * g.x, bq[j].y * rb * g.y); w.y = pk2(bq[j].z * rb * g.z, bq[j].w * rb * g.w); *(GAS v2u*)(yo + 768 + col) = w; }
#pragma unroll
                    for (int j = 0; j < 2; ++j) { const int col = (F.lane + 64 * j) * 4; const f32x4 g = *(const GAS f32x4*)(gn + 1536 + col);
                        v2u w; w.x = pk2(c[j].x * rc * g.x, c[j].y * rc * g.y); w.y = pk2(c[j].z * rc * g.z, c[j].w * rc * g.w); *(GAS v2u*)(yo + 1536 + col) = w; }
                }
            }
            if (BOTH(pb + 4)) GRID_BAR();
        }
        if (PEN(6) && IN(pb + 5)) { PHASE_BEGIN(); TSTAMP_AT(pb + 5);
            pg8::Gemm g{Y, WOUT + (size_t)l * D * D, 2 * D, 2 * D, D / 64}; pg8::StaticOrder So; So.init(S, D, F.G, (int)blockIdx.x);
            pg8::EpiResF32 E{l == 0 ? x_in : XA, args.rep ? YPREF : XA, D, 1.f};
            pg8::gemm_phase<pg8::EpiResF32, pg8::StaticOrder, true, SP2V>(F.lds, g, So, E);
            if (BOTH(pb + 5)) GRID_BAR();
        }
        if (PEN(7) && IN(pb + 6)) { PHASE_BEGIN(); TSTAMP_AT(pb + 6);
            const float* gf = args.in[14] + (size_t)l * D;
#if defined(PROBE_DEADLINE)
            if (l == 1 && blockIdx.x == 0 && F.tid == 0) F.ctl[CW_CVT + 16] = __hip_atomic_load(F.ctl + CW_CVT, RLX_AGENT);
#endif
            if (l == 0) { for (int m = F.gw; m < S; m += F.NGW) { if constexpr (F8D) rms_row_to_fp8(XA + (size_t)m * D, gf, XN8 + (size_t)m * D, F.lane); else rms_row_to_bf16(XA + (size_t)m * D, gf, XN + (size_t)m * D, F.lane); } }
            else {
                const float* Wr = args.in[18];
                LAS unsigned* LC = (LAS unsigned*)F.lds;
                if (F.tid < NE) LC[F.tid] = 0u;
                LAS f32x4* WL = (LAS f32x4*)(F.lds + 1024);
                for (int i = F.tid; i < 2048 * 2; i += NWAVES * 64) { const int half = i & 1, idx = i >> 1, ln = idx & 63, jq = idx >> 6, j = jq >> 2, q = jq & 3, k = (ln + 64 * j) * 4 + q;
                    WL[i] = *(const GAS f32x4*)(Wr + (size_t)k * NE + half * 4); }
                __syncthreads();
                for (int m = F.gw; m < S; m += F.NGW) {
                    const GAS f32x4* xr = (const GAS f32x4*)(XA + (size_t)m * D) + F.lane; const GAS f32x4* gr = (const GAS f32x4*)gf + F.lane;
                    f32x4 v[8]; float s = 0.f;
#pragma unroll
                    for (int j = 0; j < 8; ++j) { v[j] = xr[64 * j]; s += (v[j].x * v[j].x + v[j].y * v[j].y) + (v[j].z * v[j].z + v[j].w * v[j].w); }
                    const float rstd = 1.f / sqrtf(wave_sum(s) * (1.f / D) + EPS);
                    float lg[8] = {0.f, 0.f, 0.f, 0.f, 0.f, 0.f, 0.f, 0.f};
                    GAS v2u* o8 = (GAS v2u*)(XN + (size_t)m * D) + F.lane; GAS unsigned* o4 = (GAS unsigned*)(XN8 + (size_t)m * D) + F.lane;
#pragma unroll
                    for (int j = 0; j < 8; ++j) { const f32x4 gg = gr[64 * j]; const f32x4 hh = {v[j].x * rstd * gg.x, v[j].y * rstd * gg.y, v[j].z * rstd * gg.z, v[j].w * rstd * gg.w};
                        if constexpr (F8M) o4[64 * j] = pk4_fp8(hh.x, hh.y, hh.z, hh.w); else { v2u w; w.x = pk2(hh.x, hh.y); w.y = pk2(hh.z, hh.w); o8[64 * j] = w; }
#pragma unroll
                        for (int q = 0; q < 4; ++q) { const f32x4 w0 = WL[(((j * 4 + q) * 64) + F.lane) * 2], w1 = WL[(((j * 4 + q) * 64) + F.lane) * 2 + 1]; const float hv = hh[q];
                            lg[0] += hv * w0.x; lg[1] += hv * w0.y; lg[2] += hv * w0.z; lg[3] += hv * w0.w; lg[4] += hv * w1.x; lg[5] += hv * w1.y; lg[6] += hv * w1.z; lg[7] += hv * w1.w; } }
#pragma unroll
                    for (int e = 0; e < NE; ++e) lg[e] = wave_sum(lg[e]);
                    int e1 = 0; float v1 = lg[0];
#pragma unroll
                    for (int e = 1; e < NE; ++e) if (lg[e] > v1) { v1 = lg[e]; e1 = e; }
                    int e2 = -1; float v2 = -3.0e38f;
#pragma unroll
                    for (int e = 0; e < NE; ++e) if (e != e1 && lg[e] > v2) { v2 = lg[e]; e2 = e; }
                    const float g1 = 1.f / (1.f + __expf(v2 - v1)), g2 = 1.f - g1;
                    if (F.lane == 0) { const unsigned s1 = __hip_atomic_fetch_add(LC + e1, 1u, __ATOMIC_RELAXED, __HIP_MEMORY_SCOPE_WORKGROUP), s2 = __hip_atomic_fetch_add(LC + e2, 1u, __ATOMIC_RELAXED, __HIP_MEMORY_SCOPE_WORKGROUP);
                        v4u r0 = {(unsigned)e1, (unsigned)e2, s1, s2}; v4u r1 = {__float_as_uint(g1), __float_as_uint(g2), 0u, 0u};
                        *(GAS v4u*)(ROUTE + (size_t)m * 8) = r0; *(GAS v4u*)(ROUTE + (size_t)m * 8 + 4) = r1; }
                }
                __syncthreads();
                if (F.tid < NE) F.ctl[CW_CNTW + blockIdx.x * NE + F.tid] = LC[F.tid];
            }
            if (BOTH(pb + 6)) GRID_BAR();
        }
        if (PEN(8) && IN(pb + 7)) { PHASE_BEGIN(); TSTAMP_AT(pb + 7);
            if (l == 1) {
                moe_cvt_fill(F, ka, -1);
#if defined(PROBE_DEADLINE)
                for (int r_ = 0; r_ < PROBE_DEADLINE; ++r_) { __syncthreads(); moe_cvt_fill(F, ka, -2); }
#endif
                { LAS unsigned* LT = (LAS unsigned*)F.lds;
                  int tot = 0, bel = 0;
                  for (int w = F.lane; w < F.G; w += 64) { const int c = (int)F.ctl[CW_CNTW + w * NE + F.wave]; tot += c; bel += (w < (int)blockIdx.x) ? c : 0; }
#pragma unroll
                  for (int o = 1; o < 64; o <<= 1) { tot += __shfl_xor(tot, o); bel += __shfl_xor(bel, o); }
                  __syncthreads();
                  if (F.lane == 0) { LT[F.wave] = (unsigned)tot; LT[NE + F.wave] = (unsigned)bel; }
                  __syncthreads(); }
                int base[NE]; int tstart = 0;
#pragma unroll
                for (int e = 0; e < NE; ++e) { const int c = (int)((LAS unsigned*)F.lds)[e]; base[e] = tstart * 256 + (int)((LAS unsigned*)F.lds)[NE + e]; const int nt = (c + 255) >> 8;
                    if (blockIdx.x == 0 && F.tid == 0) { for (int t = 0; t < nt; ++t) F.ctl[CW_TILEE + 1 + tstart + t] = (unsigned)e; }
                    tstart += nt; }
                if (blockIdx.x == 0 && F.tid == 0) F.ctl[CW_TILEE] = (unsigned)tstart;
                for (int m = F.gw; m < S; m += F.NGW) {
                    const v4u r0 = *(const GAS v4u*)(ROUTE + (size_t)m * 8);
                    int p1 = (int)r0.z, p2 = (int)r0.w;
#pragma unroll
                    for (int e = 0; e < NE; ++e) { if ((int)r0.x == e) p1 += base[e]; if ((int)r0.y == e) p2 += base[e]; }
                    if (F.lane == 0) { ROUTE[(size_t)m * 8 + 6] = (unsigned)p1; ROUTE[(size_t)m * 8 + 7] = (unsigned)p2; }
                    const unsigned char* srow = (const unsigned char*)XN8 + (size_t)m * D * EBM; unsigned char* xp = (unsigned char*)XP;
                    const GAS v4u* src = (const GAS v4u*)srow + F.lane; GAS v4u* d1 = (GAS v4u*)(xp + (size_t)p1 * D * EBM) + F.lane; GAS v4u* d2 = (GAS v4u*)(xp + (size_t)p2 * D * EBM) + F.lane;
#pragma unroll
                    for (int j = 0; j < 2 * EBM; ++j) { const v4u t = src[64 * j]; d1[64 * j] = t; d2[64 * j] = t; }
                }
            }
            if (BOTH(pb + 7) && l == 1) GRID_BAR();
        }
        if (PEN(9) && IN(pb + 8)) { PHASE_BEGIN(); TSTAMP_AT(pb + 8);
            if (l == 0) { pg8::Gemm g{XN8, WGU, D * EBD, D * EBD, D * EBD / 128}; pg8::StaticOrder So; So.init(S, 2 * DFF, F.G, (int)blockIdx.x);
                FfnEpi1<F8D> E = Epi1Maker<F8D>::make(ACT, DFF);
                pg8::gemm_phase<FfnEpi1<F8D>, pg8::StaticOrder, true, SP2V, F8D>(F.lds, g, So, E); }
            else { const int ntile = (int)__hip_atomic_load(F.ctl + CW_TILEE, RLX_AGENT);
                pg8::Gemm g{XP, MGU, D * EBM, D * EBM, D * EBM / 128}; pg8::MoeOrder So{F.G, (int)blockIdx.x, 2 * DFE / 256, ntile, 2 * DFE, (const int*)(F.ctl + CW_TILEE + 1)};
                FfnEpi1<F8M> E = Epi1Maker<F8M>::make(ACTP, DFE);
                pg8::gemm_phase<FfnEpi1<F8M>, pg8::MoeOrder, true, SP2V, F8M>(F.lds, g, So, E); }
            if (BOTH(pb + 8)) GRID_BAR();
        }
        if (PEN(10) && IN(pb + 9)) { PHASE_BEGIN(); TSTAMP_AT(pb + 9);
            if (l == 0) { pg8::Gemm g{ACT, WDN, DFF * EBD, DFF * EBD, DFF * EBD / 128}; pg8::StaticOrder So; So.init(S, D, F.G, (int)blockIdx.x);
                pg8::EpiResF32 E{XA, args.rep ? YPREF : XA, D, Sc<F8D>::dn};
                pg8::gemm_phase<pg8::EpiResF32, pg8::StaticOrder, true, SP2V, F8D>(F.lds, g, So, E); }
            else { const int ntile = (int)__hip_atomic_load(F.ctl + CW_TILEE, RLX_AGENT);
                const int pm0 = MOE_TAIL ? ((2 * F.G / 8) < ntile ? (2 * F.G / 8) : ntile) : ntile;
                { pg8::Gemm g{ACTP, MDN, DFE * EBM, DFE * EBM, DFE * EBM / 128}; pg8::MoeOrder So{F.G, (int)blockIdx.x, D / 256, pm0, D, (const int*)(F.ctl + CW_TILEE + 1)};
                  pg8::EpiBf16 E{OUTP, D, Sc<F8M>::dn};
                  pg8::gemm_phase<pg8::EpiBf16, pg8::MoeOrder, true, SP2V, F8M>(F.lds, g, So, E); }
                if (MOE_TAIL && ntile > pm0) { pg8::Gemm g{ACTP, MDN, DFE * EBM, DFE * EBM, DFE * EBM / 512}; pg8::MoeTailOrder So{F.G, (int)blockIdx.x, pm0, ntile - pm0, D, DFE * EBM / 4, (const int*)(F.ctl + CW_TILEE + 1)};
                  pg8::EpiBf16Split E{OUTQ, D, Sc<F8M>::dn, pm0, (size_t)2048 * D};
                  pg8::gemm_phase<pg8::EpiBf16Split, pg8::MoeTailOrder, true, SP2V, F8M>(F.lds, g, So, E); } }
            if (BOTH(pb + 9)) GRID_BAR();
        }
        if (PEN(11) && IN(pb + 10)) { PHASE_BEGIN(); TSTAMP_AT(pb + 10);
            if (l == 0) { for (int m = F.gw; m < S; m += F.NGW) rms_row_to_bf16(XA + (size_t)m * D, args.in[4] + D, XN + (size_t)m * D, F.lane); }
            else {
                const float* gfin = args.in[22];
                const int ntile_f = (int)__hip_atomic_load(F.ctl + CW_TILEE, RLX_AGENT); const int prow0 = (MOE_TAIL ? ((2 * F.G / 8) < ntile_f ? (2 * F.G / 8) : ntile_f) : ntile_f) * 256;
                for (int m = F.gw; m < S; m += F.NGW) {
                    const v4u r1 = *(const GAS v4u*)(ROUTE + (size_t)m * 8 + 4);
                    const float g1 = __uint_as_float(r1.x), g2 = __uint_as_float(r1.y); const int p1 = (int)r1.z, p2 = (int)r1.w;
                    const GAS f32x4* xr = (const GAS f32x4*)(XA + (size_t)m * D) + F.lane;
                    const GAS v2u* o1 = (const GAS v2u*)(OUTP + (size_t)p1 * D) + F.lane; const GAS v2u* o2 = (const GAS v2u*)(OUTP + (size_t)p2 * D) + F.lane;
                    const bool t1 = p1 >= prow0, t2 = p2 >= prow0;
                    const GAS v2u* q1 = (const GAS v2u*)(OUTQ + (size_t)(t1 ? p1 - prow0 : 0) * D) + F.lane; const GAS v2u* q2 = (const GAS v2u*)(OUTQ + (size_t)(t2 ? p2 - prow0 : 0) * D) + F.lane;
                    f32x4 v[8]; float s = 0.f;
                    if (!t1 && !t2) {
#pragma unroll
                        for (int j = 0; j < 8; ++j) { const f32x4 xv = xr[64 * j]; const v2u a = o1[64 * j], b = o2[64 * j];
                            v[j] = xv + (f32x4){bflo(a.x), bfhi(a.x), bflo(a.y), bfhi(a.y)} * g1 + (f32x4){bflo(b.x), bfhi(b.x), bflo(b.y), bfhi(b.y)} * g2;
                            s += (v[j].x * v[j].x + v[j].y * v[j].y) + (v[j].z * v[j].z + v[j].w * v[j].w); }
                    } else
#pragma unroll
                    for (int j = 0; j < 8; ++j) { const f32x4 xv = xr[64 * j]; f32x4 ea, eb;
                        if (!t1) { const v2u a = o1[64 * j]; ea = (f32x4){bflo(a.x), bfhi(a.x), bflo(a.y), bfhi(a.y)}; }
                        else { ea = (f32x4){0.f, 0.f, 0.f, 0.f};
#pragma unroll
                            for (int k = 0; k < 4; ++k) { const v2u a = q1[(size_t)k * (2048 * D / 4) + 64 * j]; ea += (f32x4){bflo(a.x), bfhi(a.x), bflo(a.y), bfhi(a.y)}; } }
                        if (!t2) { const v2u b = o2[64 * j]; eb = (f32x4){bflo(b.x), bfhi(b.x), bflo(b.y), bfhi(b.y)}; }
                        else { eb = (f32x4){0.f, 0.f, 0.f, 0.f};
#pragma unroll
                            for (int k = 0; k < 4; ++k) { const v2u b = q2[(size_t)k * (2048 * D / 4) + 64 * j]; eb += (f32x4){bflo(b.x), bfhi(b.x), bflo(b.y), bfhi(b.y)}; } }
                        v[j] = xv + ea * g1 + eb * g2;
                        s += (v[j].x * v[j].x + v[j].y * v[j].y) + (v[j].z * v[j].z + v[j].w * v[j].w); }
                    const float rstd = 1.f / sqrtf(wave_sum(s) * (1.f / D) + EPS);
                    GAS f32x4* orow = (GAS f32x4*)(args.out + (size_t)m * D) + F.lane; const GAS f32x4* gr = (const GAS f32x4*)gfin + F.lane;
#pragma unroll
                    for (int j = 0; j < 8; ++j) { const f32x4 gg = gr[64 * j]; orow[64 * j] = (f32x4){v[j].x * rstd * gg.x, v[j].y * rstd * gg.y, v[j].z * rstd * gg.z, v[j].w * rstd * gg.w}; }
                }
            }
            if (BOTH(pb + 10) && l == 0) GRID_BAR();
        }
    }
#if defined(PROBE_T)
    if (blockIdx.x == 0 && threadIdx.x == 0) { const unsigned t_end = (unsigned)__builtin_amdgcn_s_memrealtime(); volatile LAS unsigned* ts_ = (volatile LAS unsigned*)(F.lds + 131520); ts_[N_PHASES] = t_end;
#if defined(PROBE_CLK)
        ts_[32 + N_PHASES] = (unsigned)__builtin_amdgcn_s_memtime(); const unsigned dt = (ts_[32 + PROBE_T + 1] - ts_[32 + PROBE_T]) / (16u * PROBE_TK);
#else
        const unsigned dt = ts_[PROBE_T + 1] - ts_[PROBE_T];
#endif
        while ((unsigned)__builtin_amdgcn_s_memrealtime() - t_end < (unsigned)PROBE_TK * dt) __builtin_amdgcn_s_sleep(32); }
#endif
#undef IN
#undef BOTH
#undef GRID_BAR
#undef WIN
#undef WUP
#undef WMEM
#undef WOUT
#undef WGU
#undef WDN
#undef MGU
#undef MDN
#undef XN
#undef MEMN
#undef MEMKV
#undef PROJ
#undef AQKV
#undef KROPE
#undef ROPECS
#undef QKVM
#undef YPRE
#undef YPREF
#undef DILO
#undef DILS
#undef Y
#undef XA
#undef ROUTE
#undef XP
#undef OUTP
#undef OUTQ
#undef ACTP
#undef ACT
#undef x_in
#undef XN8
#undef PHASE_BEGIN
#undef args
#undef FILL
}

extern "C" void kernel_launch(void* const* d_in, const int* in_sizes, int n_in, void* d_out, int out_size, void* d_ws, size_t ws_size, hipStream_t stream) {
    static int grid = 0;
    if (grid == 0) {
        if (n_in != 23 || in_sizes[0] != S * D || out_size != S * D || ws_size < WS_END) { fprintf(stderr, "kernel_launch: shape/workspace mismatch: n_in %d in0 %d out %d ws %zu (need %zu)\n", n_in, n_in > 0 ? in_sizes[0] : -1, out_size, ws_size, (size_t)WS_END); grid = -1; return; }
        int dev = 0, cus = 0, per_cu = 0;
        if (hipGetDevice(&dev) != hipSuccess || hipDeviceGetAttribute(&cus, hipDeviceAttributeMultiprocessorCount, dev) != hipSuccess) { fprintf(stderr, "kernel_launch: device query failed\n"); grid = -1; return; }
        if (hipFuncSetAttribute((const void*)mk_fwd, hipFuncAttributeMaxDynamicSharedMemorySize, LDS_BYTES) != hipSuccess) { fprintf(stderr, "kernel_launch: hipFuncSetAttribute failed\n"); grid = -1; return; }
        if (hipOccupancyMaxActiveBlocksPerMultiprocessor(&per_cu, (const void*)mk_fwd, NWAVES * 64, LDS_BYTES) != hipSuccess || per_cu < 1) { fprintf(stderr, "kernel_launch: occupancy query reports %d workgroups per CU\n", per_cu); }
        (void)hipGetLastError();
        grid = cus;
    }
    if (grid < 0) return;
    (void)hipMemsetAsync((char*)d_ws + WS_CTL, 0, CTL_ZERO_BYTES, stream);
    Args a{};
    for (int i = 0; i < 23; ++i) a.in[i] = (const float*)d_in[i];
    a.out = (float*)d_out; a.ws = (unsigned char*)d_ws;
    for (int i = 0; i < 32; ++i) a.invf[i] = 1.0f / powf(10000.0f, (float)i / 32.0f);
    int lo[8], hi[8], rp[8], nl = 0;
#if defined(PROBE_PHASE) && PROBE_PHASE >= 0
    lo[nl] = 0; hi[nl] = PROBE_PHASE + 1; rp[nl++] = 0;
    for (int r = 0; r < PROBE_REPS; ++r) { lo[nl] = PROBE_PHASE; hi[nl] = PROBE_PHASE + 1; rp[nl++] = 1; }
    if (PROBE_PHASE + 1 < N_PHASES) { lo[nl] = PROBE_PHASE + 1; hi[nl] = N_PHASES; rp[nl++] = 0; }
#else
    if (N_LAUNCHES == N_PHASES) { nl = 0; } else { lo[0] = 0; hi[0] = N_PHASES; rp[0] = 0; nl = 1; }
#endif
    const int total = (N_LAUNCHES == N_PHASES) ? N_PHASES : nl;
    for (int li = 0; li < total; ++li) {
        if (N_LAUNCHES == N_PHASES) { a.ph_lo = li; a.ph_hi = li + 1; a.li = 0; a.rep = 0; } else { a.ph_lo = lo[li]; a.ph_hi = hi[li]; a.li = li; a.rep = rp[li]; }
        hipLaunchKernelGGL(mk_fwd, dim3(grid), dim3(NWAVES * 64), LDS_BYTES, stream, a);
        const hipError_t le = hipPeekAtLastError();
        if (le != hipSuccess) { fprintf(stderr, "kernel_launch: launch %d failed: %s\n", li, hipGetErrorName(le)); break; }
    }
}
```

```cpp
#include <hip/hip_runtime.h>
#include <cstdio>
#include <cstdint>
#include <cmath>
#include <type_traits>
#ifndef MK_N_LAUNCHES
#define MK_N_LAUNCHES 1
#endif
#define REPEAT_PHASE -1
#define FFN_FP8 3
#define PROBE_PHASE -1
#define PROBE_REPS 3
#define FILLMASK 5
#define MLA_DMA 0
#define PROBE_ATT 7
#define GEMM_SP2 1
#define BAR_FLAGS 2
#define PRE_ROWS 4
#define COMB_ROWS 2
#define CVT_CHUNK 32
#define CONV_WGS 1
#define NCV_G 28
#define NCV_U 64
#define NCV_T 64
#define NCV_A 48
#define XA_BF16 0
#define ATT_OBF16 1
#define MOE_TAIL 1
#define CVT_REG 0
#define CVT_BYTE_T 1
#define CVT_FIRST 1
#define CVT_Q0 8
namespace pg8 {
#define PG8_LAS __attribute__((address_space(3)))
typedef unsigned short bf16_t;
typedef short bf16x8 __attribute__((ext_vector_type(8)));
typedef float f32x4 __attribute__((ext_vector_type(4)));
typedef unsigned u32x4 __attribute__((ext_vector_type(4)));
constexpr int BM = 256, BK = 64, HALF = 128, HTB = HALF * BK * 2  , STAGE_BYTES = 8 * HTB, NXCD = 8, WGM = 8;

__host__ __device__ __forceinline__ int lds_byte(int r, int c) { const int st = (r >> 4) * 2 + (c >> 5), rr = r & 15, cc = c & 31, ob = rr * 64 + cc * 2; return st * 1024 + (ob ^ (((ob >> 9) & 1) << 5)); }
__host__ __device__ __forceinline__ void stage_rc(int b, int& R, int& C) { const int st = b / 1024, sb = b % 1024, swz = sb ^ (((sb >> 9) & 1) << 5); R = (st >> 1) * 16 + swz / 64; C = (st & 1) * 32 + (swz % 64) / 2; }
__host__ __device__ __forceinline__ int perm32(int rho) { const int n = rho >> 4, i = rho & 15; return 8 * (i >> 2) + 4 * n + (i & 3); }

struct Unit { int pm, pn; };
struct Gemm { const void* A; const void* Bt; int lda, ldb, nt; };

struct StaticOrder {
    int nM, nN, nwg, G, c;
    __device__ void init(int M, int N, int G_, int c_) { nM = M / BM; nN = N / BM; nwg = nM * nN; G = G_; c = c_; }
    __device__ bool next(int i, Unit& u) const {
        const long L = (long)i * G + c; if (L >= nwg) return false;
        int wgid = (int)L; { const int q = nwg / NXCD, r = nwg % NXCD, xcd = wgid % NXCD, off = wgid / NXCD; wgid = (xcd < r ? xcd * (q + 1) : r * (q + 1) + (xcd - r) * q) + off; }
        const int nig = WGM * nN, gid = wgid / nig, fm = gid * WGM, gsz = (nM - fm) < WGM ? (nM - fm) : WGM;
        u.pm = fm + ((wgid % nig) % gsz); u.pn = (wgid % nig) / gsz; return true;
    }
    __device__ __forceinline__ const char* abase(const Gemm& g, const Unit& u) const { return (const char*)g.A + (size_t)u.pm * BM * g.lda; }
    __device__ __forceinline__ const char* bbase(const Gemm& g, const Unit& u) const { return (const char*)g.Bt + (size_t)u.pn * BM * g.ldb; }
};
struct InProjOrder {
    StaticOrder so; int nextra; const void* A2; const void* B2;
    __device__ bool next(int i, Unit& u) const { if (so.next(i, u)) return true; const long L = (long)i * so.G + so.c - so.nwg; if (L < 0 || L >= nextra) return false; u.pm = 32 + (int)(L >> 2); u.pn = (int)(L & 3); return true; }
    __device__ __forceinline__ const char* abase(const Gemm& g, const Unit& u) const { return u.pm < 32 ? (const char*)g.A + (size_t)u.pm * BM * g.lda : (const char*)A2 + (size_t)(u.pm - 32) * BM * g.lda; }
    __device__ __forceinline__ const char* bbase(const Gemm& g, const Unit& u) const { return u.pm < 32 ? (const char*)g.Bt + (size_t)u.pn * BM * g.ldb : (const char*)B2 + (size_t)((u.pm - 32) * 1024 + u.pn * BM) * g.ldb; }
};
struct MemOrder {
    int G, c;
    __device__ bool next(int i, Unit& u) const { const int L = c - (G - 8); if (i != 0 || L < 0 || L >= 8) return false; u.pm = L >> 2; u.pn = L & 3; return true; }
    __device__ __forceinline__ const char* abase(const Gemm& g, const Unit& u) const { return (const char*)g.A + (size_t)u.pm * BM * g.lda; }
    __device__ __forceinline__ const char* bbase(const Gemm& g, const Unit& u) const { return (const char*)g.Bt + (size_t)(u.pm * 1024 + u.pn * BM) * g.ldb; }
};
struct MoeOrder {
    int G, c, nN, ntile, nexp_rows; const int* tile_e;
    __device__ bool next(int i, Unit& u) const { const long L = (long)i * G + c; if (L >= (long)ntile * nN) return false; u.pm = (int)(L / nN); u.pn = (int)(L % nN); return true; }
    __device__ __forceinline__ const char* abase(const Gemm& g, const Unit& u) const { return (const char*)g.A + (size_t)u.pm * BM * g.lda; }
    __device__ __forceinline__ const char* bbase(const Gemm& g, const Unit& u) const { const int e = __builtin_amdgcn_readfirstlane(tile_e[u.pm]); return (const char*)g.Bt + ((size_t)e * nexp_rows + (size_t)u.pn * BM) * g.ldb; }
};

struct MoeTailOrder {
    int G, c, pm0, ntail, nexp_rows, kq_bytes; const int* tile_e;
    __device__ bool next(int i, Unit& u) const { const long L = (long)i * G + c; if (L >= (long)ntail * 32) return false; const int ks = (int)(L & 3), rest = (int)(L >> 2); u.pm = pm0 + (rest >> 3); u.pn = (rest & 7) + 8 * ks; return true; }
    __device__ __forceinline__ const char* abase(const Gemm& g, const Unit& u) const { return (const char*)g.A + (size_t)u.pm * BM * g.lda + (size_t)(u.pn >> 3) * kq_bytes; }
    __device__ __forceinline__ const char* bbase(const Gemm& g, const Unit& u) const { const int e = __builtin_amdgcn_readfirstlane(tile_e[u.pm]); return (const char*)g.Bt + ((size_t)e * nexp_rows + (size_t)(u.pn & 7) * BM) * g.ldb + (size_t)(u.pn >> 3) * kq_bytes; }
};

__device__ __forceinline__ unsigned cvt_pk_bf16(float lo, float hi) { unsigned r; asm volatile("v_cvt_pk_bf16_f32 %0, %1, %2" : "=v"(r) : "v"(lo), "v"(hi)); return r; }

struct EpiBf16 {
    static constexpr bool PERM = true;
    bf16_t* O; int ldc; float sc;
    __device__ __forceinline__ void operator()(const f32x4 (&acc)[2][2][4][2], const Unit& u, int wr, int wc, int fr, int fq) const {
        const int row0 = u.pm * BM + wr * 64 + fr, col0 = u.pn * BM + wc * 32 + 8 * fq;
#pragma unroll
        for (int ai = 0; ai < 2; ++ai)
#pragma unroll
            for (int m = 0; m < 4; ++m) { bf16_t* rowp = O + (size_t)(row0 + ai * HALF + m * 16) * ldc + col0;
#pragma unroll
                for (int bj = 0; bj < 2; ++bj) { const f32x4 v0 = acc[ai][bj][m][0] * sc, v1 = acc[ai][bj][m][1] * sc;
                    u32x4 w; w.x = cvt_pk_bf16(v0[0], v0[1]); w.y = cvt_pk_bf16(v0[2], v0[3]); w.z = cvt_pk_bf16(v1[0], v1[1]); w.w = cvt_pk_bf16(v1[2], v1[3]);
                    *(u32x4*)(rowp + bj * HALF) = w; } }
    }
};
struct EpiBf16Split {
    static constexpr bool PERM = true;
    bf16_t* O; int ldc; float sc; int pm0; size_t qstride;
    __device__ __forceinline__ void operator()(const f32x4 (&acc)[2][2][4][2], const Unit& u, int wr, int wc, int fr, int fq) const {
        const int row0 = (u.pm - pm0) * BM + wr * 64 + fr, col0 = (u.pn & 7) * BM + wc * 32 + 8 * fq; bf16_t* base = O + (size_t)(u.pn >> 3) * qstride;
#pragma unroll
        for (int ai = 0; ai < 2; ++ai)
#pragma unroll
            for (int m = 0; m < 4; ++m) { bf16_t* rowp = base + (size_t)(row0 + ai * HALF + m * 16) * ldc + col0;
#pragma unroll
                for (int bj = 0; bj < 2; ++bj) { const f32x4 v0 = acc[ai][bj][m][0] * sc, v1 = acc[ai][bj][m][1] * sc;
                    u32x4 w; w.x = cvt_pk_bf16(v0[0], v0[1]); w.y = cvt_pk_bf16(v0[2], v0[3]); w.z = cvt_pk_bf16(v1[0], v1[1]); w.w = cvt_pk_bf16(v1[2], v1[3]);
                    *(u32x4*)(rowp + bj * HALF) = w; } }
    }
};
struct EpiBf16Sel {
    static constexpr bool PERM = true;
    bf16_t* O; int ldc; bf16_t* O2; int ldc2;
    __device__ __forceinline__ void operator()(const f32x4 (&acc)[2][2][4][2], const Unit& u, int wr, int wc, int fr, int fq) const {
        const bool ex = u.pm >= 32; bf16_t* base = ex ? O2 : O; const int ld = ex ? ldc2 : ldc;
        const int row0 = (ex ? u.pm - 32 : u.pm) * BM + wr * 64 + fr, col0 = u.pn * BM + wc * 32 + 8 * fq;
#pragma unroll
        for (int ai = 0; ai < 2; ++ai)
#pragma unroll
            for (int m = 0; m < 4; ++m) { bf16_t* rowp = base + (size_t)(row0 + ai * HALF + m * 16) * ld + col0;
#pragma unroll
                for (int bj = 0; bj < 2; ++bj) { const f32x4 v0 = acc[ai][bj][m][0], v1 = acc[ai][bj][m][1];
                    u32x4 w; w.x = cvt_pk_bf16(v0[0], v0[1]); w.y = cvt_pk_bf16(v0[2], v0[3]); w.z = cvt_pk_bf16(v1[0], v1[1]); w.w = cvt_pk_bf16(v1[2], v1[3]);
                    *(u32x4*)(rowp + bj * HALF) = w; } }
    }
};
struct EpiResF32 {
    static constexpr bool PERM = false;
    const float* R; float* C; int ldc; float sc;
    __device__ __forceinline__ void operator()(const f32x4 (&acc)[2][2][4][2], const Unit& u, int wr, int wc, int fr, int fq) const {
        const int row0 = u.pm * BM + wr * 64 + fr, col0 = u.pn * BM + wc * 32 + 4 * fq;
#pragma unroll
        for (int ai = 0; ai < 2; ++ai)
#pragma unroll
            for (int m = 0; m < 4; ++m) { const size_t off = (size_t)(row0 + ai * HALF + m * 16) * ldc + col0;
#pragma unroll
                for (int bj = 0; bj < 2; ++bj)
#pragma unroll
                    for (int n = 0; n < 2; ++n) { const f32x4 r = *(const f32x4*)(R + off + bj * HALF + n * 16); *(f32x4*)(C + off + bj * HALF + n * 16) = r + acc[ai][bj][m][n] * sc; } }
    }
};
__device__ __forceinline__ float silu_mul(float g, float u) { return g * u * __builtin_amdgcn_rcpf(1.0f + __builtin_amdgcn_exp2f(-1.4426950408889634f * g)); }
struct EpiSwiGLU {
    static constexpr bool PERM = true;
    bf16_t* O; int ldc;
    __device__ __forceinline__ void operator()(const f32x4 (&acc)[2][2][4][2], const Unit& u, int wr, int wc, int fr, int fq) const {
        const int row0 = u.pm * BM + wr * 64 + fr, col0 = u.pn * HALF + wc * 32 + 8 * fq;
#pragma unroll
        for (int ai = 0; ai < 2; ++ai)
#pragma unroll
            for (int m = 0; m < 4; ++m) { bf16_t* rowp = O + (size_t)(row0 + ai * HALF + m * 16) * ldc + col0;
                const f32x4 g0 = acc[ai][0][m][0], g1 = acc[ai][0][m][1], u0 = acc[ai][1][m][0], u1 = acc[ai][1][m][1];
                u32x4 w; w.x = cvt_pk_bf16(silu_mul(g0[0], u0[0]), silu_mul(g0[1], u0[1])); w.y = cvt_pk_bf16(silu_mul(g0[2], u0[2]), silu_mul(g0[3], u0[3]));
                w.z = cvt_pk_bf16(silu_mul(g1[0], u1[0]), silu_mul(g1[1], u1[1])); w.w = cvt_pk_bf16(silu_mul(g1[2], u1[2]), silu_mul(g1[3], u1[3]));
                *(u32x4*)rowp = w; }
    }
};

typedef int v8i_t __attribute__((ext_vector_type(8)));
__device__ __forceinline__ v8i_t pg8_cat(bf16x8 lo, bf16x8 hi) { typedef int v4i_t __attribute__((ext_vector_type(4))); const v4i_t a = __builtin_bit_cast(v4i_t, lo), b = __builtin_bit_cast(v4i_t, hi); return (v8i_t){a.x, a.y, a.z, a.w, b.x, b.y, b.z, b.w}; }
struct EpiSwiGLU8 {
    static constexpr bool PERM = true;
    unsigned char* O; int ldc; float sc_in, sc_out;
    __device__ __forceinline__ void operator()(const f32x4 (&acc)[2][2][4][2], const Unit& u, int wr, int wc, int fr, int fq) const {
        const int row0 = u.pm * BM + wr * 64 + fr, col0 = u.pn * HALF + wc * 32 + 8 * fq;
#pragma unroll
        for (int ai = 0; ai < 2; ++ai)
#pragma unroll
            for (int m = 0; m < 4; ++m) { unsigned char* rowp = O + (size_t)(row0 + ai * HALF + m * 16) * ldc + col0;
                const f32x4 g0 = acc[ai][0][m][0] * sc_in, g1 = acc[ai][0][m][1] * sc_in, u0 = acc[ai][1][m][0] * (sc_in * sc_out), u1 = acc[ai][1][m][1] * (sc_in * sc_out);
                int w0 = 0, w1 = 0;
                w0 = __builtin_amdgcn_cvt_pk_fp8_f32(silu_mul(g0[0], u0[0]), silu_mul(g0[1], u0[1]), w0, false); w0 = __builtin_amdgcn_cvt_pk_fp8_f32(silu_mul(g0[2], u0[2]), silu_mul(g0[3], u0[3]), w0, true);
                w1 = __builtin_amdgcn_cvt_pk_fp8_f32(silu_mul(g1[0], u1[0]), silu_mul(g1[1], u1[1]), w1, false); w1 = __builtin_amdgcn_cvt_pk_fp8_f32(silu_mul(g1[2], u1[2]), silu_mul(g1[3], u1[3]), w1, true);
                typedef int v2i_t __attribute__((ext_vector_type(2))); *(v2i_t*)rowp = (v2i_t){w0, w1}; }
    }
};
__device__ __forceinline__ void pg8_mfma8(f32x4& c, v8i_t a, v8i_t b, int sc) { asm volatile("v_mfma_scale_f32_16x16x128_f8f6f4 %0, %1, %2, %0, %3, %3 op_sel_hi:[0,0,0]" : "+v"(c) : "v"(a), "v"(b), "v"(sc)); }
template <class Epi, class Sched, bool ALIGN_EPI = false, bool SP2 = false, bool FP8 = false>
__device__ __forceinline__ void gemm_phase(PG8_LAS unsigned char* lds, const Gemm g, const Sched& S, const Epi& E) {
    int tid_ = threadIdx.x; asm volatile("" : "+v"(tid_));
    const int tid = tid_, wid = __builtin_amdgcn_readfirstlane(tid >> 6), lane = tid & 63, wr = wid >> 2, wc = wid & 3, fr = lane & 15, fq = lane >> 4;
    const int nt = g.nt;
    unsigned voffA[2], voffB[2];
#pragma unroll
    for (int i = 0; i < 2; ++i) { int R, C; stage_rc(tid * 16 + i * 8192, R, C); const int Rb = Epi::PERM ? ((R & ~31) + perm32(R & 31)) : R;
        voffA[i] = (unsigned)(R * g.lda + C * 2); voffB[i] = (unsigned)(Rb * g.ldb + C * 2); }
    const size_t kstep = (size_t)(BK * 2);
    const size_t hstepA = (size_t)HALF * g.lda, hstepB = (size_t)HALF * g.ldb;
    const unsigned ldsw = (unsigned)wid * 1024u;
    const int aoff = lds_byte(wr * 64 + fr, fq * 8), boff = lds_byte(wc * 32 + fr, fq * 8);
#define PG8_SA(b, h) (((b) * 2 + (h)) * HTB)
#define PG8_SB(b, h) ((4 + (b) * 2 + (h)) * HTB)
#define PG8_STAGE(bufoff, gbase, voff) do { _Pragma("unroll") for (int _i = 0; _i < 2; ++_i) \
        __builtin_amdgcn_global_load_lds((const unsigned*)((const char*)(gbase) + (voff)[_i]), (PG8_LAS unsigned*)(lds + (bufoff) + ldsw + _i * 8192), 16, 0, 0); } while (0)
#define PG8_LDA(dst, b, h) do { _Pragma("unroll") for (int m = 0; m < 4; ++m) _Pragma("unroll") for (int k = 0; k < 2; ++k) dst[m][k] = *(const PG8_LAS bf16x8*)(lds + PG8_SA(b, h) + aoff + m * 2048 + k * 1024); } while (0)
#define PG8_LDB(dst, b, h) do { _Pragma("unroll") for (int n = 0; n < 2; ++n) _Pragma("unroll") for (int k = 0; k < 2; ++k) dst[n][k] = *(const PG8_LAS bf16x8*)(lds + PG8_SB(b, h) + boff + n * 2048 + k * 1024); } while (0)
#define PG8_MMA(ai, bj, At, Bt) do { __builtin_amdgcn_s_setprio(1); if constexpr (FP8) { _Pragma("unroll") for (int m = 0; m < 4; ++m) _Pragma("unroll") for (int n = 0; n < 2; ++n) \
        pg8_mfma8(acc[ai][bj][m][n], pg8_cat(Bt[n][0], Bt[n][1]), pg8_cat(At[m][0], At[m][1]), sc8); } else { \
        _Pragma("unroll") for (int m = 0; m < 4; ++m) _Pragma("unroll") for (int n = 0; n < 2; ++n) _Pragma("unroll") for (int k = 0; k < 2; ++k) \
        acc[ai][bj][m][n] = __builtin_amdgcn_mfma_f32_16x16x32_bf16(Bt[n][k], At[m][k], acc[ai][bj][m][n], 0, 0, 0); } __builtin_amdgcn_s_setprio(0); } while (0)
#define PG8_WAIT_V(n) asm volatile("s_waitcnt vmcnt(" #n ")" ::: "memory")
#define PG8_WAIT_L(n) asm volatile("s_waitcnt lgkmcnt(" #n ")" ::: "memory")
#define PG8_BAR __builtin_amdgcn_s_barrier()
#define PG8_SCHED __builtin_amdgcn_sched_barrier(0)
    Unit cur, nxt; int ui = 0;
    if (!S.next(0, cur)) return;
    int sc8 = 0x7F7F7F7F; asm volatile("" : "+v"(sc8));
    f32x4 acc[2][2][4][2];
#pragma unroll
    for (int a = 0; a < 2; ++a)
#pragma unroll
        for (int b = 0; b < 2; ++b)
#pragma unroll
            for (int m = 0; m < 4; ++m)
#pragma unroll
                for (int n = 0; n < 2; ++n) acc[a][b][m][n] = (f32x4){0.f, 0.f, 0.f, 0.f};
    bf16x8 At[4][2], B0[2][2], B1[2][2];
    const char* cA = S.abase(g, cur); const char* cB = S.bbase(g, cur);
    if constexpr (SP2) {
        PG8_STAGE(PG8_SB(0, 0), cB, voffB); PG8_STAGE(PG8_SB(0, 1), cB + hstepB, voffB); PG8_STAGE(PG8_SA(0, 0), cA, voffA); PG8_STAGE(PG8_SA(0, 1), cA + hstepA, voffA);
        if (wr == 1) PG8_BAR;
        PG8_WAIT_V(2); PG8_BAR;
        PG8_STAGE(PG8_SB(1, 0), cB + kstep, voffB); PG8_STAGE(PG8_SA(1, 0), cA + kstep, voffA); PG8_STAGE(PG8_SB(1, 1), cB + hstepB + kstep, voffB);
        PG8_WAIT_V(6); PG8_BAR;
    } else {
        PG8_STAGE(PG8_SB(0, 0), cB, voffB); PG8_STAGE(PG8_SA(0, 0), cA, voffA); PG8_STAGE(PG8_SB(0, 1), cB + hstepB, voffB); PG8_STAGE(PG8_SA(0, 1), cA + hstepA, voffA);
        if (wr == 1) PG8_BAR;
        PG8_WAIT_V(4); PG8_BAR;
        PG8_STAGE(PG8_SB(1, 0), cB + kstep, voffB); PG8_STAGE(PG8_SA(1, 0), cA + kstep, voffA); PG8_STAGE(PG8_SB(1, 1), cB + hstepB + kstep, voffB);
        PG8_WAIT_V(6); PG8_BAR;
    }
    for (;;) {
        const bool has_next = S.next(ui + 1, nxt);
        const char* nA = has_next ? S.abase(g, nxt) : cA; const char* nB = has_next ? S.bbase(g, nxt) : cB;
        for (int t = 0; t < nt; t += 2) {
            const bool last = (t == nt - 2);
            const char* a1 = cA + (size_t)(t + 1) * kstep;
            const char* a2 = last ? nA : cA + (size_t)(t + 2) * kstep; const char* b2 = last ? nB : cB + (size_t)(t + 2) * kstep;
            const char* a3 = a2 + kstep; const char* b3 = b2 + kstep;
            if constexpr (SP2) {
            PG8_LDB(B0, 0, 0); PG8_LDB(B1, 0, 1); PG8_SCHED; PG8_LDA(At, 0, 0); PG8_STAGE(PG8_SA(1, 1), a1 + hstepA, voffA);
            PG8_WAIT_V(8); PG8_WAIT_L(0); PG8_BAR; PG8_MMA(0, 0, At, B0); PG8_MMA(0, 1, At, B1); PG8_BAR; PG8_SCHED;
            PG8_LDA(At, 0, 1); PG8_STAGE(PG8_SB(0, 0), b2, voffB); PG8_STAGE(PG8_SB(0, 1), b2 + hstepB, voffB); PG8_STAGE(PG8_SA(0, 0), a2, voffA);
            PG8_WAIT_V(8); PG8_WAIT_L(0); PG8_BAR; PG8_MMA(1, 0, At, B0); PG8_MMA(1, 1, At, B1); PG8_BAR; PG8_SCHED;
            PG8_LDB(B0, 1, 0); PG8_LDB(B1, 1, 1); PG8_SCHED; PG8_LDA(At, 1, 0); PG8_STAGE(PG8_SA(0, 1), a2 + hstepA, voffA);
            PG8_WAIT_V(8); PG8_WAIT_L(0); PG8_BAR; PG8_MMA(0, 0, At, B0); PG8_MMA(0, 1, At, B1); PG8_BAR; PG8_SCHED;
            PG8_LDA(At, 1, 1); PG8_STAGE(PG8_SB(1, 0), b3, voffB); PG8_STAGE(PG8_SB(1, 1), b3 + hstepB, voffB); PG8_STAGE(PG8_SA(1, 0), a3, voffA);
            PG8_WAIT_V(8); PG8_WAIT_L(0); PG8_BAR; PG8_MMA(1, 0, At, B0); PG8_MMA(1, 1, At, B1); PG8_BAR; PG8_SCHED;
            } else {
            PG8_LDB(B0, 0, 0); PG8_SCHED; PG8_LDA(At, 0, 0); PG8_STAGE(PG8_SA(1, 1), a1 + hstepA, voffA);
            PG8_WAIT_L(8); PG8_BAR; PG8_WAIT_L(0); PG8_MMA(0, 0, At, B0); PG8_BAR; PG8_SCHED;
            PG8_LDB(B1, 0, 1); PG8_STAGE(PG8_SB(0, 0), b2, voffB);
            PG8_BAR; PG8_WAIT_L(0); PG8_MMA(0, 1, At, B1); PG8_BAR;
            PG8_LDA(At, 0, 1); PG8_STAGE(PG8_SA(0, 0), a2, voffA);
            PG8_BAR; PG8_WAIT_L(0); PG8_MMA(1, 0, At, B0); PG8_BAR; PG8_SCHED;
            PG8_STAGE(PG8_SB(0, 1), b2 + hstepB, voffB);
            PG8_WAIT_V(6); PG8_BAR; PG8_MMA(1, 1, At, B1); PG8_BAR;
            PG8_LDB(B0, 1, 0); PG8_SCHED; PG8_LDA(At, 1, 0); PG8_STAGE(PG8_SA(0, 1), a2 + hstepA, voffA);
            PG8_WAIT_L(8); PG8_BAR; PG8_WAIT_L(0); PG8_MMA(0, 0, At, B0); PG8_BAR; PG8_SCHED;
            PG8_LDB(B1, 1, 1); PG8_STAGE(PG8_SB(1, 0), b3, voffB);
            PG8_BAR; PG8_WAIT_L(0); PG8_MMA(0, 1, At, B1); PG8_BAR;
            PG8_LDA(At, 1, 1); PG8_STAGE(PG8_SA(1, 0), a3, voffA);
            PG8_BAR; PG8_WAIT_L(0); PG8_MMA(1, 0, At, B0); PG8_BAR; PG8_SCHED;
            PG8_STAGE(PG8_SB(1, 1), b3 + hstepB, voffB);
            PG8_WAIT_V(6); PG8_BAR; PG8_MMA(1, 1, At, B1); PG8_BAR;
            }
        }
        if constexpr (ALIGN_EPI) { if (wr == 0) PG8_BAR; }
        if constexpr (FP8) { PG8_SCHED; asm volatile("s_nop 15\n\ts_nop 7" ::: "memory"); PG8_SCHED; }
        E(acc, cur, wr, wc, fr, fq);
        if (!has_next) break;
#pragma unroll
        for (int a = 0; a < 2; ++a)
#pragma unroll
            for (int b = 0; b < 2; ++b)
#pragma unroll
                for (int m = 0; m < 4; ++m)
#pragma unroll
                    for (int n = 0; n < 2; ++n) acc[a][b][m][n] = (f32x4){0.f, 0.f, 0.f, 0.f};
        cur = nxt; cA = nA; cB = nB; ++ui;
        if constexpr (ALIGN_EPI) { if (wr == 1) PG8_BAR; }
    }
    PG8_WAIT_V(0);
    if constexpr (!ALIGN_EPI) { if (wr == 0) PG8_BAR; }
    PG8_BAR;
#undef PG8_SA
#undef PG8_SB
#undef PG8_STAGE
#undef PG8_LDA
#undef PG8_LDB
#undef PG8_MMA
#undef PG8_WAIT_V
#undef PG8_WAIT_L
#undef PG8_BAR
#undef PG8_SCHED
}
}
namespace att {
#define ATT_LAS __attribute__((address_space(3)))
#define ATT_GAS __attribute__((address_space(1)))
typedef unsigned short bf16;
using bf16x8 = __attribute__((ext_vector_type(8))) short;
using s16x4  = __attribute__((ext_vector_type(4))) short;
using f32x16 = __attribute__((ext_vector_type(16))) float;
using f32x4  = __attribute__((ext_vector_type(4))) float;
using u32x4  = __attribute__((ext_vector_type(4))) unsigned;
constexpr int NW = 8, QBLK = 32, KVBLK = 64, DV = 128;
constexpr float LOG2E = 1.4426950408889634f;
#if defined(ATT_OBF16) && ATT_OBF16
typedef unsigned short OT;
#else
typedef float OT;
#endif
#define SBAR() __builtin_amdgcn_sched_barrier(0)
__device__ __forceinline__ int crow(int r, int hi) { return (r & 3) + 8 * (r >> 2) + 4 * hi; }
__device__ __forceinline__ unsigned cvtpk(float lo, float hi) { unsigned r; asm volatile("v_cvt_pk_bf16_f32 %0, %1, %2" : "=v"(r) : "v"(lo), "v"(hi)); return r; }
__device__ __forceinline__ float bf2f(short s) { return __uint_as_float(((unsigned)(unsigned short)s) << 16); }
__device__ __forceinline__ void st_o(float* p, float v) { *p = v; }
__device__ __forceinline__ void st_o(unsigned short* p, float v) { *p = (unsigned short)(cvtpk(v, v) & 0xffffu); }

__device__ __forceinline__ void partialSM(f32x16& p0, f32x16& p1, float& m_reg, float& mn, float& alpha, const float C, const float THRS) {
  float pmax = p0[0];
#pragma unroll
  for (int r = 1; r < 16; ++r) pmax = fmaxf(pmax, p0[r]);
#pragma unroll
  for (int r = 0; r < 16; ++r) pmax = fmaxf(pmax, p1[r]);
  { auto rr = __builtin_amdgcn_permlane32_swap(__float_as_uint(pmax), __float_as_uint(pmax), false, false);
    pmax = fmaxf(__uint_as_float(rr[0]), __uint_as_float(rr[1])); }
  if (__builtin_expect(__all(pmax - m_reg <= THRS), 1)) { mn = m_reg; alpha = 1.f; }
  else { mn = fmaxf(m_reg, pmax); alpha = __builtin_amdgcn_exp2f((m_reg - mn) * C); m_reg = mn; }
  float mnC = -mn * C;
#pragma unroll
  for (int r = 0; r < 16; ++r) p0[r] = fmaf(p0[r], C, mnC);
#pragma unroll
  for (int r = 0; r < 16; ++r) p1[r] = fmaf(p1[r], C, mnC);
#pragma unroll
  for (int r = 0; r < 16; ++r) p0[r] = __builtin_amdgcn_exp2f(p0[r]);
}
#define ATT_PK4(P, BASE, OUT) do { unsigned a0 = cvtpk(P[BASE + 0], P[BASE + 1]), a1 = cvtpk(P[BASE + 2], P[BASE + 3]);   \
    unsigned b0 = cvtpk(P[BASE + 4], P[BASE + 5]), b1 = cvtpk(P[BASE + 6], P[BASE + 7]);                              \
    auto r0 = __builtin_amdgcn_permlane32_swap(a0, b0, false, false); auto r1 = __builtin_amdgcn_permlane32_swap(a1, b1, false, false); \
    u32x4 w = {r0[0], r1[0], r0[1], r1[1]}; OUT = *reinterpret_cast<bf16x8*>(&w); } while (0)
__device__ __forceinline__ void finishSM(f32x16& p0, f32x16& p1, float alpha, float& l_reg, bf16x8& pa0, bf16x8& pa1, bf16x8& pa2, bf16x8& pa3) {
#pragma unroll
  for (int r = 0; r < 16; ++r) p1[r] = __builtin_amdgcn_exp2f(p1[r]);
  float ps = 0;
#pragma unroll
  for (int r = 0; r < 16; ++r) ps += p0[r];
#pragma unroll
  for (int r = 0; r < 16; ++r) ps += p1[r];
  { auto rr = __builtin_amdgcn_permlane32_swap(__float_as_uint(ps), __float_as_uint(ps), false, false);
    ps = __uint_as_float(rr[0]) + __uint_as_float(rr[1]); }
  l_reg = l_reg * alpha + ps;
  ATT_PK4(p0, 0, pa0); ATT_PK4(p0, 8, pa1); ATT_PK4(p1, 0, pa2); ATT_PK4(p1, 8, pa3);
}
template <int RB> __device__ __forceinline__ int kswz(int row, int colB) { return row * RB + (colB ^ ((row & 7) << 4)); }
template <int DQK> __device__ __forceinline__ void qkt(f32x16& p0, f32x16& p1, const ATT_LAS char* Ks, const bf16x8 (&qr)[DQK / 16], int r32, int hi) {
  p0 = f32x16{}; p1 = f32x16{};
#pragma unroll
  for (int d0 = 0; d0 < DQK / 16; ++d0) { const int cb = (d0 * 16 + hi * 8) * 2;
    bf16x8 b0 = *reinterpret_cast<const ATT_LAS bf16x8*>(Ks + kswz<DQK * 2>(r32, cb));
    bf16x8 b1 = *reinterpret_cast<const ATT_LAS bf16x8*>(Ks + kswz<DQK * 2>(32 + r32, cb));
    p0 = __builtin_amdgcn_mfma_f32_32x32x16_bf16(b0, qr[d0], p0, 0, 0, 0);
    p1 = __builtin_amdgcn_mfma_f32_32x32x16_bf16(b1, qr[d0], p1, 0, 0, 0); }
}
__device__ __forceinline__ void qkt192_lq(f32x16& p0, f32x16& p1, const ATT_LAS char* Ks, const bf16x8 (&qr)[8], const ATT_LAS char* Qs, int lane, int r32, int hi) {
  p0 = f32x16{}; p1 = f32x16{};
#pragma unroll
  for (int d0 = 0; d0 < 12; ++d0) { const int cb = (d0 * 16 + hi * 8) * 2;
    bf16x8 b0 = *reinterpret_cast<const ATT_LAS bf16x8*>(Ks + kswz<384>(r32, cb));
    bf16x8 b1 = *reinterpret_cast<const ATT_LAS bf16x8*>(Ks + kswz<384>(32 + r32, cb));
    const bf16x8 q = d0 < 8 ? qr[d0 < 8 ? d0 : 0] : *reinterpret_cast<const ATT_LAS bf16x8*>(Qs + ((d0 - 8) * 64 + lane) * 16);
    p0 = __builtin_amdgcn_mfma_f32_32x32x16_bf16(b0, q, p0, 0, 0, 0);
    p1 = __builtin_amdgcn_mfma_f32_32x32x16_bf16(b1, q, p1, 0, 0, 0); }
}
__device__ __forceinline__ int v_st(int k, int c) { const int kk = (k & ~0xC) | ((k & 4) << 1) | ((k & 8) >> 1); return ((kk >> 3) * 4 + (c >> 5)) * 512 + ((kk & 7) * 32 + (c & 31)) * 2; }
__device__ __forceinline__ int v_rd_base(int lane) { return ((lane & 3) << 3) | (((lane >> 2) & 3) << 6) | (((lane >> 4) & 1) << 5) | (((lane >> 5) & 1) << 8); }
constexpr int v_rd_off(int d0, int ks, int half) { return d0 * 512 + ks * 4096 + half * 2048; }
template <int OFF> __device__ __forceinline__ s16x4 tr_read(int vb) {
  s16x4 r; asm volatile("ds_read_b64_tr_b16 %0, %1 offset:%2" : "=&v"(r) : "v"(vb), "i"(OFF) : "memory"); return r;
}
#define ATT_PK(L, H) (bf16x8){L[0], L[1], L[2], L[3], H[0], H[1], H[2], H[3]}
template <int D0> __device__ __forceinline__ void pv_one(f32x16& od, int vb, bf16x8 pa0, bf16x8 pa1, bf16x8 pa2, bf16x8 pa3) {
  const s16x4 l0 = tr_read<v_rd_off(D0, 0, 0)>(vb), h0 = tr_read<v_rd_off(D0, 0, 1)>(vb), l1 = tr_read<v_rd_off(D0, 1, 0)>(vb), h1 = tr_read<v_rd_off(D0, 1, 1)>(vb);
  const s16x4 l2 = tr_read<v_rd_off(D0, 2, 0)>(vb), h2 = tr_read<v_rd_off(D0, 2, 1)>(vb), l3 = tr_read<v_rd_off(D0, 3, 0)>(vb), h3 = tr_read<v_rd_off(D0, 3, 1)>(vb);
  asm volatile("s_waitcnt lgkmcnt(0)" ::: "memory"); SBAR();
  od = __builtin_amdgcn_mfma_f32_32x32x16_bf16(pa0, ATT_PK(l0, h0), od, 0, 0, 0);
  od = __builtin_amdgcn_mfma_f32_32x32x16_bf16(pa1, ATT_PK(l1, h1), od, 0, 0, 0);
  od = __builtin_amdgcn_mfma_f32_32x32x16_bf16(pa2, ATT_PK(l2, h2), od, 0, 0, 0);
  od = __builtin_amdgcn_mfma_f32_32x32x16_bf16(pa3, ATT_PK(l3, h3), od, 0, 0, 0);
}
__device__ __forceinline__ void pv_d0(f32x16 (&o)[4], int vb, bf16x8 pa0, bf16x8 pa1, bf16x8 pa2, bf16x8 pa3) {
  pv_one<0>(o[0], vb, pa0, pa1, pa2, pa3); pv_one<1>(o[1], vb, pa0, pa1, pa2, pa3); pv_one<2>(o[2], vb, pa0, pa1, pa2, pa3); pv_one<3>(o[3], vb, pa0, pa1, pa2, pa3);
}
template <int D0> __device__ __forceinline__ void pv32_one(f32x16& od, int vb, bf16x8 pa0, bf16x8 pa1) {
  const s16x4 l0 = tr_read<v_rd_off(D0, 0, 0)>(vb), h0 = tr_read<v_rd_off(D0, 0, 1)>(vb), l1 = tr_read<v_rd_off(D0, 1, 0)>(vb), h1 = tr_read<v_rd_off(D0, 1, 1)>(vb);
  asm volatile("s_waitcnt lgkmcnt(0)" ::: "memory"); SBAR();
  od = __builtin_amdgcn_mfma_f32_32x32x16_bf16(pa0, ATT_PK(l0, h0), od, 0, 0, 0);
  od = __builtin_amdgcn_mfma_f32_32x32x16_bf16(pa1, ATT_PK(l1, h1), od, 0, 0, 0);
}

template <int DQK, int LDQ, int LDK, int LDO, int SDEPTH>
__device__ __forceinline__ void attn_dense_body(const bf16* __restrict__ Qb, const bf16* __restrict__ Kh, const bf16* __restrict__ Kr, const bf16* __restrict__ Vh,
                                                const float* __restrict__ cs_rows, OT* __restrict__ Ob, int seq, const float scale, ATT_LAS char* lds) {
  constexpr int SHM_V = KVBLK * DV * 2, SHM_K = KVBLK * DQK * 2, RB = DQK * 2, NQ = DQK / 16;
  constexpr bool ROPE = (DQK == 192);
  const float C = scale * LOG2E, THRS = 8.f / scale;
  int tid_ = threadIdx.x; asm volatile("" : "+v"(tid_));
  const int tid = tid_, wid = tid >> 6, lane = tid & 63, r32 = lane & 31, hi = lane >> 5;
  ATT_LAS char* V_lds = lds; ATT_LAS char* K_lds = lds + 2 * SHM_V;
  ATT_LAS float* ws = (ATT_LAS float*)(lds + 2 * SHM_V + 2 * SHM_K) + wid * 64; ATT_LAS float* li_l = ws; ATT_LAS float* al_l = ws + 32;
  float m_reg = -1e30f, l_reg = 0; f32x16 o[4] = {}; bf16x8 qr[NQ];
  const bf16* Qw = Qb + (long)(wid * QBLK + r32) * LDQ + hi * 8;
#pragma unroll
  for (int d0 = 0; d0 < NQ; ++d0) qr[d0] = *(const ATT_GAS bf16x8*)(Qw + d0 * 16);
  if constexpr (ROPE) {
    const float* cs = cs_rows + (long)(wid * QBLK + r32) * 64 + hi * 8;
#pragma unroll
    for (int g = 0; g < 2; ++g) {
      const f32x4 c0 = *(const ATT_GAS f32x4*)(cs + g * 16), c1 = *(const ATT_GAS f32x4*)(cs + g * 16 + 4);
      const f32x4 s0 = *(const ATT_GAS f32x4*)(cs + 32 + g * 16), s1 = *(const ATT_GAS f32x4*)(cs + 32 + g * 16 + 4);
      float y1[8], y2[8];
#pragma unroll
      for (int j = 0; j < 8; ++j) { const float co = j < 4 ? c0[j & 3] : c1[j & 3], si = j < 4 ? s0[j & 3] : s1[j & 3];
        const float x1 = bf2f(qr[8 + g][j]), x2 = bf2f(qr[10 + g][j]); y1[j] = x1 * co - x2 * si; y2[j] = x1 * si + x2 * co; }
      u32x4 w1 = {cvtpk(y1[0], y1[1]), cvtpk(y1[2], y1[3]), cvtpk(y1[4], y1[5]), cvtpk(y1[6], y1[7])};
      u32x4 w2 = {cvtpk(y2[0], y2[1]), cvtpk(y2[2], y2[3]), cvtpk(y2[4], y2[5]), cvtpk(y2[6], y2[7])};
      qr[8 + g] = *reinterpret_cast<bf16x8*>(&w1); qr[10 + g] = *reinterpret_cast<bf16x8*>(&w2);
    }
  }
  const int sr = tid >> 4, sc = (tid & 15) * 8, vst0 = v_st(sr, sc), vst1 = v_st(32 + sr, sc);
  const int rr = tid >> 3, rc = (tid & 7) * 8;
  const int vb0 = (int)(unsigned)(uintptr_t)V_lds + v_rd_base(lane);
  struct Slot { bf16x8 vs0, vs1, ks0, ks1, kr; } sr_[SDEPTH];
#define SLOAD(i, k0) do { sr_[i].vs0 = *(const ATT_GAS bf16x8*)(&Vh[(long)((k0) + sr) * LDK + sc]); sr_[i].vs1 = *(const ATT_GAS bf16x8*)(&Vh[(long)((k0) + 32 + sr) * LDK + sc]); \
    sr_[i].ks0 = *(const ATT_GAS bf16x8*)(&Kh[(long)((k0) + sr) * LDK + sc]); sr_[i].ks1 = *(const ATT_GAS bf16x8*)(&Kh[(long)((k0) + 32 + sr) * LDK + sc]); \
    if constexpr (ROPE) sr_[i].kr = *(const ATT_GAS bf16x8*)(&Kr[(long)((k0) + rr) * 64 + rc]); } while (0)
#define SWRITE(b, i) do { *reinterpret_cast<ATT_LAS bf16x8*>(V_lds + (b) * SHM_V + vst0) = sr_[i].vs0;          \
    *reinterpret_cast<ATT_LAS bf16x8*>(V_lds + (b) * SHM_V + vst1) = sr_[i].vs1; const int kc = sc * 2;               \
    *reinterpret_cast<ATT_LAS bf16x8*>(K_lds + (b) * SHM_K + kswz<RB>(sr, kc)) = sr_[i].ks0;                       \
    *reinterpret_cast<ATT_LAS bf16x8*>(K_lds + (b) * SHM_K + kswz<RB>(32 + sr, kc)) = sr_[i].ks1;                  \
    if constexpr (ROPE) *reinterpret_cast<ATT_LAS bf16x8*>(K_lds + (b) * SHM_K + kswz<RB>(rr, 256 + rc * 2)) = sr_[i].kr; } while (0)
#define SWAIT() do { if constexpr (SDEPTH == 2) { if constexpr (ROPE) asm volatile("s_waitcnt vmcnt(5)" ::: "memory"); else asm volatile("s_waitcnt vmcnt(4)" ::: "memory"); } else asm volatile("s_waitcnt vmcnt(0)" ::: "memory"); } while (0)
#define RESC(a) do { if (__any((a) < 1.f)) { if (hi == 0) al_l[r32] = (a); asm volatile("s_waitcnt lgkmcnt(0)" ::: "memory"); \
    _Pragma("unroll") for (int d = 0; d < 4; ++d) _Pragma("unroll") for (int r = 0; r < 16; ++r) o[d][r] *= al_l[crow(r, hi)]; } } while (0)
  f32x16 pA0, pA1, pB0, pB1; float mnA, mnB, alA, alB; bf16x8 pa0, pa1, pa2, pa3; const int NT = seq / KVBLK;
  constexpr int SE = 0, SO = SDEPTH - 1;
  SLOAD(SE, 0); asm volatile("s_waitcnt vmcnt(0)" ::: "memory"); SWRITE(0, SE); __syncthreads();
  qkt<DQK>(pA0, pA1, K_lds, qr, r32, hi); partialSM(pA0, pA1, m_reg, mnA, alA, C, THRS);
  SLOAD(SO, KVBLK); if constexpr (SDEPTH == 2) { if (2 < NT) SLOAD(SE, 2 * KVBLK); }
  SWAIT(); SWRITE(1, SO); __syncthreads();
  for (int j = 1; j + 1 < NT; j += 2) {
    SBAR(); qkt<DQK>(pB0, pB1, K_lds + SHM_K, qr, r32, hi);
    finishSM(pA0, pA1, alA, l_reg, pa0, pa1, pa2, pa3); SBAR();
    SLOAD(SO, (j + SDEPTH) * KVBLK); SBAR();
    pv_d0(o, vb0, pa0, pa1, pa2, pa3); partialSM(pB0, pB1, m_reg, mnB, alB, C, THRS);
    __syncthreads(); SWAIT(); SWRITE(0, SE);
    RESC(alB); __syncthreads();
    SBAR(); qkt<DQK>(pA0, pA1, K_lds, qr, r32, hi);
    finishSM(pB0, pB1, alB, l_reg, pa0, pa1, pa2, pa3); SBAR();
    if (SDEPTH == 1 || j + 3 < NT) SLOAD(SE, (j + 1 + SDEPTH) * KVBLK); SBAR();
    pv_d0(o, vb0 + SHM_V, pa0, pa1, pa2, pa3); partialSM(pA0, pA1, m_reg, mnA, alA, C, THRS);
    __syncthreads(); SWAIT(); SWRITE(1, SO);
    RESC(alA); __syncthreads();
  }
  SBAR(); qkt<DQK>(pB0, pB1, K_lds + SHM_K, qr, r32, hi);
  finishSM(pA0, pA1, alA, l_reg, pa0, pa1, pa2, pa3); SBAR();
  pv_d0(o, vb0, pa0, pa1, pa2, pa3); partialSM(pB0, pB1, m_reg, mnB, alB, C, THRS);
  __syncthreads(); RESC(alB);
  finishSM(pB0, pB1, alB, l_reg, pa0, pa1, pa2, pa3); SBAR();
  pv_d0(o, vb0 + SHM_V, pa0, pa1, pa2, pa3);
  if (hi == 0) li_l[r32] = l_reg; asm volatile("s_waitcnt lgkmcnt(0)" ::: "memory");
  float rli[16];
#pragma unroll
  for (int r = 0; r < 16; ++r) rli[r] = __builtin_amdgcn_rcpf(li_l[crow(r, hi)]);
  OT* Ow = Ob + (long)(wid * QBLK) * LDO;
#pragma unroll
  for (int r = 0; r < 16; ++r) { const int orow = crow(r, hi);
#pragma unroll
    for (int d0 = 0; d0 < 4; ++d0) st_o(&Ow[(long)orow * LDO + d0 * 32 + r32], o[d0][r] * rli[r]); }
  __syncthreads();
#undef SLOAD
#undef SWRITE
#undef SWAIT
#undef RESC
}

template <int LDQ, int LDK, int LDO>
__device__ __forceinline__ void attn_pipe192_body(const bf16* __restrict__ Qb, const bf16* __restrict__ Kh, const bf16* __restrict__ Kr, const bf16* __restrict__ Vh,
                                                const float* __restrict__ cs_rows, OT* __restrict__ Ob, int seq, const float scale, ATT_LAS char* lds) {
  constexpr int DQK = 192, SDEPTH = 1, SHM_V = KVBLK * DV * 2, SHM_K = KVBLK * DQK * 2, RB = DQK * 2, NQ = DQK / 16;
  constexpr bool ROPE = true;
  const float C = scale * LOG2E, THRS = 8.f / scale;
  int tid_ = threadIdx.x; asm volatile("" : "+v"(tid_));
  const int tid = tid_, wid = tid >> 6, lane = tid & 63, r32 = lane & 31, hi = lane >> 5;
  ATT_LAS char* V_lds = lds; ATT_LAS char* K_lds = lds + 2 * SHM_V;
  ATT_LAS float* ws = (ATT_LAS float*)(lds + 2 * SHM_V + 2 * SHM_K) + wid * 64; ATT_LAS float* li_l = ws; ATT_LAS float* al_l = ws + 32;
  ATT_LAS char* Qs = lds + 2 * SHM_V + 2 * SHM_K + 2048 + wid * 4096;
  float m_reg = -1e30f, l_reg = 0; f32x16 o[4] = {}; bf16x8 qr8[8];
  const bf16* Qw = Qb + (long)(wid * QBLK + r32) * LDQ + hi * 8;
  { bf16x8 qr[NQ];
#pragma unroll
  for (int d0 = 0; d0 < NQ; ++d0) qr[d0] = *(const ATT_GAS bf16x8*)(Qw + d0 * 16);
  if constexpr (ROPE) {
    const float* cs = cs_rows + (long)(wid * QBLK + r32) * 64 + hi * 8;
#pragma unroll
    for (int g = 0; g < 2; ++g) {
      const f32x4 c0 = *(const ATT_GAS f32x4*)(cs + g * 16), c1 = *(const ATT_GAS f32x4*)(cs + g * 16 + 4);
      const f32x4 s0 = *(const ATT_GAS f32x4*)(cs + 32 + g * 16), s1 = *(const ATT_GAS f32x4*)(cs + 32 + g * 16 + 4);
      float y1[8], y2[8];
#pragma unroll
      for (int j = 0; j < 8; ++j) { const float co = j < 4 ? c0[j & 3] : c1[j & 3], si = j < 4 ? s0[j & 3] : s1[j & 3];
        const float x1 = bf2f(qr[8 + g][j]), x2 = bf2f(qr[10 + g][j]); y1[j] = x1 * co - x2 * si; y2[j] = x1 * si + x2 * co; }
      u32x4 w1 = {cvtpk(y1[0], y1[1]), cvtpk(y1[2], y1[3]), cvtpk(y1[4], y1[5]), cvtpk(y1[6], y1[7])};
      u32x4 w2 = {cvtpk(y2[0], y2[1]), cvtpk(y2[2], y2[3]), cvtpk(y2[4], y2[5]), cvtpk(y2[6], y2[7])};
      qr[8 + g] = *reinterpret_cast<bf16x8*>(&w1); qr[10 + g] = *reinterpret_cast<bf16x8*>(&w2);
    }
  }
#pragma unroll
  for (int d0 = 0; d0 < 8; ++d0) qr8[d0] = qr[d0];
#pragma unroll
  for (int d0 = 8; d0 < 12; ++d0) *reinterpret_cast<ATT_LAS bf16x8*>(Qs + ((d0 - 8) * 64 + lane) * 16) = qr[d0];
  }
  const int sr = tid >> 4, sc = (tid & 15) * 8, vst0 = v_st(sr, sc), vst1 = v_st(32 + sr, sc);
  const int rr = tid >> 3, rc = (tid & 7) * 8;
  const int vb0 = (int)(unsigned)(uintptr_t)V_lds + v_rd_base(lane);
  struct Slot { bf16x8 vs0, vs1, ks0, ks1, kr; } sr_[SDEPTH];
#define SLOADK(i, k0) do { sr_[i].ks0 = *(const ATT_GAS bf16x8*)(&Kh[(long)((k0) + sr) * LDK + sc]); sr_[i].ks1 = *(const ATT_GAS bf16x8*)(&Kh[(long)((k0) + 32 + sr) * LDK + sc]); } while (0)
#define SLOADV(i, k0) do { sr_[i].vs0 = *(const ATT_GAS bf16x8*)(&Vh[(long)((k0) + sr) * LDK + sc]); sr_[i].vs1 = *(const ATT_GAS bf16x8*)(&Vh[(long)((k0) + 32 + sr) * LDK + sc]); \
    if constexpr (ROPE) sr_[i].kr = *(const ATT_GAS bf16x8*)(&Kr[(long)((k0) + rr) * 64 + rc]); } while (0)
#define SLOAD(i, k0) do { SLOADK(i, k0); SLOADV(i, k0); } while (0)
#define SWRITE(b, i) do { *reinterpret_cast<ATT_LAS bf16x8*>(V_lds + (b) * SHM_V + vst0) = sr_[i].vs0;          \
    *reinterpret_cast<ATT_LAS bf16x8*>(V_lds + (b) * SHM_V + vst1) = sr_[i].vs1; const int kc = sc * 2;               \
    *reinterpret_cast<ATT_LAS bf16x8*>(K_lds + (b) * SHM_K + kswz<RB>(sr, kc)) = sr_[i].ks0;                       \
    *reinterpret_cast<ATT_LAS bf16x8*>(K_lds + (b) * SHM_K + kswz<RB>(32 + sr, kc)) = sr_[i].ks1;                  \
    if constexpr (ROPE) *reinterpret_cast<ATT_LAS bf16x8*>(K_lds + (b) * SHM_K + kswz<RB>(rr, 256 + rc * 2)) = sr_[i].kr; } while (0)
#define SWAIT() do { if constexpr (SDEPTH == 2) { if constexpr (ROPE) asm volatile("s_waitcnt vmcnt(5)" ::: "memory"); else asm volatile("s_waitcnt vmcnt(4)" ::: "memory"); } else asm volatile("s_waitcnt vmcnt(0)" ::: "memory"); } while (0)
#define RESC(a) do { if (__any((a) < 1.f)) { if (hi == 0) al_l[r32] = (a); asm volatile("s_waitcnt lgkmcnt(0)" ::: "memory"); \
    _Pragma("unroll") for (int d = 0; d < 4; ++d) _Pragma("unroll") for (int r = 0; r < 16; ++r) o[d][r] *= al_l[crow(r, hi)]; } } while (0)
  f32x16 pA0, pA1, pB0, pB1; float mnA, mnB, alA, alB; bf16x8 pa0, pa1, pa2, pa3; const int NT = seq / KVBLK;
  constexpr int SE = 0, SO = SDEPTH - 1;
  SLOAD(SE, 0); asm volatile("s_waitcnt vmcnt(0)" ::: "memory"); SWRITE(0, SE); __syncthreads();
  qkt192_lq(pA0, pA1, K_lds, qr8, Qs, lane, r32, hi); partialSM(pA0, pA1, m_reg, mnA, alA, C, THRS);
  SLOAD(SO, KVBLK); if constexpr (SDEPTH == 2) { if (2 < NT) SLOAD(SE, 2 * KVBLK); }
  SWAIT(); SWRITE(1, SO); __syncthreads();
  for (int j = 1; j + 1 < NT; j += 2) {
    SBAR(); qkt192_lq(pB0, pB1, K_lds + SHM_K, qr8, Qs, lane, r32, hi);
    finishSM(pA0, pA1, alA, l_reg, pa0, pa1, pa2, pa3); SBAR();
    SLOADK(SO, (j + SDEPTH) * KVBLK); SBAR();
    pv_d0(o, vb0, pa0, pa1, pa2, pa3); SBAR(); SLOADV(SO, (j + SDEPTH) * KVBLK); SBAR(); partialSM(pB0, pB1, m_reg, mnB, alB, C, THRS);
    __syncthreads(); SWAIT(); SWRITE(0, SE);
    RESC(alB); __syncthreads();
    SBAR(); qkt192_lq(pA0, pA1, K_lds, qr8, Qs, lane, r32, hi);
    finishSM(pB0, pB1, alB, l_reg, pa0, pa1, pa2, pa3); SBAR();
    SLOADK(SE, (j + 1 + SDEPTH) * KVBLK); SBAR();
    pv_d0(o, vb0 + SHM_V, pa0, pa1, pa2, pa3); SBAR(); SLOADV(SE, (j + 1 + SDEPTH) * KVBLK); SBAR(); partialSM(pA0, pA1, m_reg, mnA, alA, C, THRS);
    __syncthreads(); SWAIT(); SWRITE(1, SO);
    RESC(alA); __syncthreads();
  }
  SBAR(); qkt192_lq(pB0, pB1, K_lds + SHM_K, qr8, Qs, lane, r32, hi);
  finishSM(pA0, pA1, alA, l_reg, pa0, pa1, pa2, pa3); SBAR();
  pv_d0(o, vb0, pa0, pa1, pa2, pa3); partialSM(pB0, pB1, m_reg, mnB, alB, C, THRS);
  __syncthreads(); RESC(alB);
  finishSM(pB0, pB1, alB, l_reg, pa0, pa1, pa2, pa3); SBAR();
  pv_d0(o, vb0 + SHM_V, pa0, pa1, pa2, pa3);
  if (hi == 0) li_l[r32] = l_reg; asm volatile("s_waitcnt lgkmcnt(0)" ::: "memory");
  float rli[16];
#pragma unroll
  for (int r = 0; r < 16; ++r) rli[r] = __builtin_amdgcn_rcpf(li_l[crow(r, hi)]);
  OT* Ow = Ob + (long)(wid * QBLK) * LDO;
#pragma unroll
  for (int r = 0; r < 16; ++r) { const int orow = crow(r, hi);
#pragma unroll
    for (int d0 = 0; d0 < 4; ++d0) st_o(&Ow[(long)orow * LDO + d0 * 32 + r32], o[d0][r] * rli[r]); }
  __syncthreads();
#undef SLOAD
#undef SLOADK
#undef SLOADV
#undef SWRITE
#undef SWAIT
#undef RESC
}

template <int DQK, int LDQ, int LDK, int LDO>
__device__ __forceinline__ void attn_simple_body(const bf16* __restrict__ Qb, const bf16* __restrict__ Kh, const bf16* __restrict__ Kr, const bf16* __restrict__ Vh,
                                                 const float* __restrict__ cs_rows, OT* __restrict__ Ob, int seq, const float scale, ATT_LAS char* lds) {
  constexpr int SHM_V = KVBLK * DV * 2, SHM_K = KVBLK * DQK * 2, RB = DQK * 2, NQ = DQK / 16;
  constexpr bool ROPE = (DQK == 192);
  const float C = scale * LOG2E, THRS = 8.f / scale;
  int tid_ = threadIdx.x; asm volatile("" : "+v"(tid_));
  const int tid = tid_, wid = tid >> 6, lane = tid & 63, r32 = lane & 31, hi = lane >> 5;
  ATT_LAS char* V_lds = lds; ATT_LAS char* K_lds = lds + 2 * SHM_V;
  ATT_LAS float* ws = (ATT_LAS float*)(lds + 2 * SHM_V + 2 * SHM_K) + wid * 64; ATT_LAS float* li_l = ws; ATT_LAS float* al_l = ws + 32;
  float m_reg = -1e30f, l_reg = 0; f32x16 o[4] = {}; bf16x8 qr[NQ];
  const bf16* Qw = Qb + (long)(wid * QBLK + r32) * LDQ + hi * 8;
#pragma unroll
  for (int d0 = 0; d0 < NQ; ++d0) qr[d0] = *(const ATT_GAS bf16x8*)(Qw + d0 * 16);
  if constexpr (ROPE) {
    const float* cs = cs_rows + (long)(wid * QBLK + r32) * 64 + hi * 8;
#pragma unroll
    for (int g = 0; g < 2; ++g) {
      const f32x4 c0 = *(const ATT_GAS f32x4*)(cs + g * 16), c1 = *(const ATT_GAS f32x4*)(cs + g * 16 + 4);
      const f32x4 s0 = *(const ATT_GAS f32x4*)(cs + 32 + g * 16), s1 = *(const ATT_GAS f32x4*)(cs + 32 + g * 16 + 4);
      float y1[8], y2[8];
#pragma unroll
      for (int j = 0; j < 8; ++j) { const float co = j < 4 ? c0[j & 3] : c1[j & 3], si = j < 4 ? s0[j & 3] : s1[j & 3];
        const float x1 = bf2f(qr[8 + g][j]), x2 = bf2f(qr[10 + g][j]); y1[j] = x1 * co - x2 * si; y2[j] = x1 * si + x2 * co; }
      u32x4 w1 = {cvtpk(y1[0], y1[1]), cvtpk(y1[2], y1[3]), cvtpk(y1[4], y1[5]), cvtpk(y1[6], y1[7])};
      u32x4 w2 = {cvtpk(y2[0], y2[1]), cvtpk(y2[2], y2[3]), cvtpk(y2[4], y2[5]), cvtpk(y2[6], y2[7])};
      qr[8 + g] = *reinterpret_cast<bf16x8*>(&w1); qr[10 + g] = *reinterpret_cast<bf16x8*>(&w2);
    }
  }
  const int sr = tid >> 4, sc = (tid & 15) * 8, vst0 = v_st(sr, sc), vst1 = v_st(32 + sr, sc);
  const int rr = tid >> 3, rc = (tid & 7) * 8;
  const int vb0 = (int)(unsigned)(uintptr_t)V_lds + v_rd_base(lane);
  bf16x8 vs0, vs1, ks0, ks1, kr;
#define SLOAD(k0) do { vs0 = *(const ATT_GAS bf16x8*)(&Vh[(long)((k0) + sr) * LDK + sc]); vs1 = *(const ATT_GAS bf16x8*)(&Vh[(long)((k0) + 32 + sr) * LDK + sc]); \
    ks0 = *(const ATT_GAS bf16x8*)(&Kh[(long)((k0) + sr) * LDK + sc]); ks1 = *(const ATT_GAS bf16x8*)(&Kh[(long)((k0) + 32 + sr) * LDK + sc]); \
    if constexpr (ROPE) kr = *(const ATT_GAS bf16x8*)(&Kr[(long)((k0) + rr) * 64 + rc]); } while (0)
#define SWRITE(b) do { *reinterpret_cast<ATT_LAS bf16x8*>(V_lds + (b) * SHM_V + vst0) = vs0;          \
    *reinterpret_cast<ATT_LAS bf16x8*>(V_lds + (b) * SHM_V + vst1) = vs1; const int kc = sc * 2;               \
    *reinterpret_cast<ATT_LAS bf16x8*>(K_lds + (b) * SHM_K + kswz<RB>(sr, kc)) = ks0;                       \
    *reinterpret_cast<ATT_LAS bf16x8*>(K_lds + (b) * SHM_K + kswz<RB>(32 + sr, kc)) = ks1;                  \
    if constexpr (ROPE) *reinterpret_cast<ATT_LAS bf16x8*>(K_lds + (b) * SHM_K + kswz<RB>(rr, 256 + rc * 2)) = kr; } while (0)
#define RESC(a) do { if (__any((a) < 1.f)) { if (hi == 0) al_l[r32] = (a); asm volatile("s_waitcnt lgkmcnt(0)" ::: "memory"); \
    _Pragma("unroll") for (int d = 0; d < 4; ++d) _Pragma("unroll") for (int r = 0; r < 16; ++r) o[d][r] *= al_l[crow(r, hi)]; } } while (0)
  const int NT = seq / KVBLK;
  SLOAD(0); SWRITE(0); __syncthreads();
  for (int j = 0; j < NT; ++j) {
    const int b = j & 1;
    if (j + 1 < NT) SLOAD((j + 1) * KVBLK);
    f32x16 p0, p1; float mn, al; bf16x8 pa0, pa1, pa2, pa3;
    SBAR(); qkt<DQK>(p0, p1, K_lds + b * SHM_K, qr, r32, hi);
    partialSM(p0, p1, m_reg, mn, al, C, THRS); RESC(al);
    finishSM(p0, p1, al, l_reg, pa0, pa1, pa2, pa3); SBAR();
    pv_d0(o, vb0 + b * SHM_V, pa0, pa1, pa2, pa3);
    if (j + 1 < NT) SWRITE(b ^ 1);
    __syncthreads();
  }
  if (hi == 0) li_l[r32] = l_reg; asm volatile("s_waitcnt lgkmcnt(0)" ::: "memory");
  float rli[16];
#pragma unroll
  for (int r = 0; r < 16; ++r) rli[r] = __builtin_amdgcn_rcpf(li_l[crow(r, hi)]);
  OT* Ow = Ob + (long)(wid * QBLK) * LDO;
#pragma unroll
  for (int r = 0; r < 16; ++r) { const int orow = crow(r, hi);
#pragma unroll
    for (int d0 = 0; d0 < 4; ++d0) st_o(&Ow[(long)orow * LDO + d0 * 32 + r32], o[d0][r] * rli[r]); }
  __syncthreads();
#undef SLOAD
#undef SWRITE
#undef RESC
}

template <int LDQ, int LDK, int LDO>
__device__ __forceinline__ void attn_dma_body(const bf16* __restrict__ Qb, const bf16* __restrict__ Kh, const bf16* __restrict__ Kr, const bf16* __restrict__ Vh,
                                              const float* __restrict__ cs_rows, OT* __restrict__ Ob, int seq, const float scale, ATT_LAS char* lds) {
  constexpr int DQK = 192, SHM_V = KVBLK * DV * 2, SHM_K = KVBLK * DQK * 2, STG = SHM_K + SHM_V, RB = DQK * 2, NQ = DQK / 16;
  const float C = scale * LOG2E, THRS = 8.f / scale;
  int tid_ = threadIdx.x; asm volatile("" : "+v"(tid_));
  const int tid = tid_, wid = __builtin_amdgcn_readfirstlane(tid >> 6), lane = tid & 63, r32 = lane & 31, hi = lane >> 5;
  ATT_LAS float* ws = (ATT_LAS float*)(lds + 3 * STG) + wid * 64; ATT_LAS float* li_l = ws; ATT_LAS float* al_l = ws + 32;
  float m_reg = -1e30f, l_reg = 0; f32x16 o[4] = {}; bf16x8 qr[NQ];
  const bf16* Qw = Qb + (long)(wid * QBLK + r32) * LDQ + hi * 8;
#pragma unroll
  for (int d0 = 0; d0 < NQ; ++d0) qr[d0] = *(const ATT_GAS bf16x8*)(Qw + d0 * 16);
  { const float* cs = cs_rows + (long)(wid * QBLK + r32) * 64 + hi * 8;
#pragma unroll
    for (int g = 0; g < 2; ++g) {
      const f32x4 c0 = *(const ATT_GAS f32x4*)(cs + g * 16), c1 = *(const ATT_GAS f32x4*)(cs + g * 16 + 4);
      const f32x4 s0 = *(const ATT_GAS f32x4*)(cs + 32 + g * 16), s1 = *(const ATT_GAS f32x4*)(cs + 32 + g * 16 + 4);
      float y1[8], y2[8];
#pragma unroll
      for (int j = 0; j < 8; ++j) { const float co = j < 4 ? c0[j & 3] : c1[j & 3], si = j < 4 ? s0[j & 3] : s1[j & 3];
        const float x1 = bf2f(qr[8 + g][j]), x2 = bf2f(qr[10 + g][j]); y1[j] = x1 * co - x2 * si; y2[j] = x1 * si + x2 * co; }
      u32x4 w1 = {cvtpk(y1[0], y1[1]), cvtpk(y1[2], y1[3]), cvtpk(y1[4], y1[5]), cvtpk(y1[6], y1[7])};
      u32x4 w2 = {cvtpk(y2[0], y2[1]), cvtpk(y2[2], y2[3]), cvtpk(y2[4], y2[5]), cvtpk(y2[6], y2[7])};
      qr[8 + g] = *reinterpret_cast<bf16x8*>(&w1); qr[10 + g] = *reinterpret_cast<bf16x8*>(&w2);
    } }
  const char* ksrc[3]; int kstep[3];
#pragma unroll
  for (int d = 0; d < 3; ++d) { const int p = (wid * 3 + d) * 64 + lane, row = p / 24, cpos = p - row * 24, c = cpos ^ (row & 7);
    if (c < 16) { ksrc[d] = (const char*)(Kh + (long)row * LDK + c * 8); kstep[d] = KVBLK * LDK * 2; } else { ksrc[d] = (const char*)(Kr + (long)row * 64 + (c - 16) * 8); kstep[d] = KVBLK * 64 * 2; } }
  const char* vsrc[2];
#pragma unroll
  for (int d = 0; d < 2; ++d) { const int p = (wid * 2 + d) * 64 + lane, sub = p >> 5, q = p & 31, kk = (sub >> 2) * 8 + (q >> 2), col = (sub & 3) * 32 + (q & 3) * 8;
    const int key = (kk & ~0xC) | ((kk & 4) << 1) | ((kk & 8) >> 1); vsrc[d] = (const char*)(Vh + (long)key * LDK + col); }
#define DMA_TILE(t, stg) do { ATT_LAS char* sb_ = lds + (stg) * STG; \
    _Pragma("unroll") for (int d = 0; d < 3; ++d) __builtin_amdgcn_global_load_lds((const unsigned*)(ksrc[d] + (long)(t) * kstep[d]), (ATT_LAS unsigned*)(sb_ + (wid * 3 + d) * 1024), 16, 0, 0); \
    _Pragma("unroll") for (int d = 0; d < 2; ++d) __builtin_amdgcn_global_load_lds((const unsigned*)(vsrc[d] + (long)(t) * (KVBLK * LDK * 2)), (ATT_LAS unsigned*)(sb_ + SHM_K + (wid * 2 + d) * 1024), 16, 0, 0); } while (0)
#define RESC(a) do { if (__any((a) < 1.f)) { if (hi == 0) al_l[r32] = (a); asm volatile("s_waitcnt lgkmcnt(0)" ::: "memory"); \
    _Pragma("unroll") for (int d = 0; d < 4; ++d) _Pragma("unroll") for (int r = 0; r < 16; ++r) o[d][r] *= al_l[crow(r, hi)]; } } while (0)
  const int NT = seq / KVBLK, vbase = (int)(unsigned)(uintptr_t)lds + SHM_K + v_rd_base(lane);
  asm volatile("s_waitcnt vmcnt(0)" ::: "memory");
  DMA_TILE(0, 0); DMA_TILE(1, 1);
  asm volatile("s_waitcnt vmcnt(5)" ::: "memory"); __builtin_amdgcn_s_barrier(); asm volatile("" ::: "memory");
  int stg = 0;
  for (int j = 0; j < NT; ++j) {
    const int stg2 = stg >= 1 ? stg - 1 : 2;
    if (j + 2 < NT) DMA_TILE(j + 2, stg2);
    f32x16 p0, p1; float mn, al; bf16x8 pa0, pa1, pa2, pa3;
    SBAR(); qkt<DQK>(p0, p1, lds + stg * STG, qr, r32, hi);
    partialSM(p0, p1, m_reg, mn, al, C, THRS); RESC(al);
    finishSM(p0, p1, al, l_reg, pa0, pa1, pa2, pa3); SBAR();
    pv_d0(o, vbase + stg * STG, pa0, pa1, pa2, pa3);
    if (j + 2 < NT) asm volatile("s_waitcnt vmcnt(5)" ::: "memory"); else asm volatile("s_waitcnt vmcnt(0)" ::: "memory");
    asm volatile("s_waitcnt lgkmcnt(0)" ::: "memory"); __builtin_amdgcn_s_barrier(); asm volatile("" ::: "memory");
    stg = stg == 2 ? 0 : stg + 1;
  }
  if (hi == 0) li_l[r32] = l_reg; asm volatile("s_waitcnt lgkmcnt(0)" ::: "memory");
  float rli[16];
#pragma unroll
  for (int r = 0; r < 16; ++r) rli[r] = __builtin_amdgcn_rcpf(li_l[crow(r, hi)]);
  OT* Ow = Ob + (long)(wid * QBLK) * LDO;
#pragma unroll
  for (int r = 0; r < 16; ++r) { const int orow = crow(r, hi);
#pragma unroll
    for (int d0 = 0; d0 < 4; ++d0) st_o(&Ow[(long)orow * LDO + d0 * 32 + r32], o[d0][r] * rli[r]); }
  __syncthreads();
#undef DMA_TILE
#undef RESC
}

template <int LDP>
__device__ __forceinline__ void dil_wave_unit(const bf16* __restrict__ P, int qc, int kc, int vc, int d, int r, int t0, int nT,
                                              OT* __restrict__ O, int oc, float* __restrict__ ST  ,
                                              ATT_LAS char* vlds  , const ATT_LAS float* bias2, const float C, int lane_) {
  int lane = lane_; asm volatile("" : "+v"(lane));
  const int r32 = lane & 31, hi = lane >> 5;
  bf16x8 qr[8];
  { const bf16* qp = P + (long)(r + d * (t0 + r32)) * LDP + qc + hi * 8;
#pragma unroll
    for (int d0 = 0; d0 < 8; ++d0) qr[d0] = *(const ATT_GAS bf16x8*)(qp + d0 * 16); }
  bf16x8 kf[2][8];
#define DIL_LDK(kb, set) do { int kt_ = t0 - 64 + (kb) * 32 + r32; kt_ = kt_ < 0 ? 0 : (kt_ > nT - 1 ? nT - 1 : kt_); \
    const bf16* kp_ = P + (long)(r + d * kt_) * LDP + kc + hi * 8; \
    _Pragma("unroll") for (int d0 = 0; d0 < 8; ++d0) kf[set][d0] = *(const ATT_GAS bf16x8*)(kp_ + d0 * 16); } while (0)
  DIL_LDK(0, 0);
  f32x16 p[5];
#pragma unroll
  for (int kb = 0; kb < 5; ++kb) {
    if (kb + 1 < 5) DIL_LDK(kb + 1, (kb + 1) & 1);
    p[kb] = f32x16{};
#pragma unroll
    for (int d0 = 0; d0 < 8; ++d0) p[kb] = __builtin_amdgcn_mfma_f32_32x32x16_bf16(kf[kb & 1][d0], qr[d0], p[kb], 0, 0, 0);
  }
#undef DIL_LDK
  bf16x8 vv[2][8];
#define DIL_LDV(kb, set) do { _Pragma("unroll") for (int i = 0; i < 8; ++i) { const int id = lane + 64 * i, row = id >> 4, c = (id & 15) * 8; \
      int kt_ = t0 - 64 + (kb) * 32 + row; kt_ = kt_ < 0 ? 0 : (kt_ > nT - 1 ? nT - 1 : kt_); \
      vv[set][i] = *(const ATT_GAS bf16x8*)(P + (long)(r + d * kt_) * LDP + vc + c); } } while (0)
  DIL_LDV(0, 0);
  float m = -1e30f;
  { const int a_ = 4 * hi - r32 + 32, k_ = a_ & 3; const ATT_LAS f32x4* tp = (const ATT_LAS f32x4*)(bias2 + k_ * 196 + (a_ - k_));
    const bool interior = (t0 >= 64) && (t0 + 96 <= nT);
#pragma unroll
    for (int kb = 0; kb < 5; ++kb)
#pragma unroll
      for (int g = 0; g < 4; ++g) { const f32x4 bv = tp[kb * 8 + 2 * g];
#pragma unroll
        for (int e = 0; e < 4; ++e) { const int rg = 4 * g + e; float s = fmaf(p[kb][rg], C, bv[e]);
          if (!interior) { const int kt = t0 - 64 + kb * 32 + crow(rg, hi); s = (kt >= 0 && kt < nT) ? s : -1e30f; }
          p[kb][rg] = s; m = fmaxf(m, s); } } }
  { auto rr = __builtin_amdgcn_permlane32_swap(__float_as_uint(m), __float_as_uint(m), false, false); m = fmaxf(__uint_as_float(rr[0]), __uint_as_float(rr[1])); }
  float Z = 0.f;
#pragma unroll
  for (int kb = 0; kb < 5; ++kb)
#pragma unroll
    for (int rg = 0; rg < 16; ++rg) { p[kb][rg] = __builtin_amdgcn_exp2f(p[kb][rg] - m); Z += p[kb][rg]; }
  { auto rr = __builtin_amdgcn_permlane32_swap(__float_as_uint(Z), __float_as_uint(Z), false, false); Z = __uint_as_float(rr[0]) + __uint_as_float(rr[1]); }
  bf16x8 pa[5][2];
#pragma unroll
  for (int kb = 0; kb < 5; ++kb) { ATT_PK4(p[kb], 0, pa[kb][0]); ATT_PK4(p[kb], 8, pa[kb][1]); }
  f32x16 o[4] = {};
  const int vb = (int)(unsigned)(uintptr_t)vlds + v_rd_base(lane);
#pragma unroll
  for (int kb = 0; kb < 5; ++kb) {
    if (kb + 1 < 5) DIL_LDV(kb + 1, (kb + 1) & 1);
#pragma unroll
    for (int i = 0; i < 8; ++i) { const int id = lane + 64 * i, row = id >> 4, c = (id & 15) * 8;
      *reinterpret_cast<ATT_LAS bf16x8*>(vlds + v_st(row, c)) = vv[kb & 1][i]; }
    asm volatile("s_waitcnt lgkmcnt(0)" ::: "memory"); SBAR();
    pv32_one<0>(o[0], vb, pa[kb][0], pa[kb][1]); pv32_one<1>(o[1], vb, pa[kb][0], pa[kb][1]); pv32_one<2>(o[2], vb, pa[kb][0], pa[kb][1]); pv32_one<3>(o[3], vb, pa[kb][0], pa[kb][1]);
    SBAR();
  }
#undef DIL_LDV
#pragma unroll
  for (int rg = 0; rg < 16; ++rg) { const long row = r + d * (t0 + crow(rg, hi));
#pragma unroll
    for (int d0 = 0; d0 < 4; ++d0) st_o(&O[row * 768 + oc + d0 * 32 + r32], o[d0][rg]); }
  if (hi == 0) { const long row = r + d * (t0 + r32); typedef float f32x2_ __attribute__((ext_vector_type(2))); *(ATT_GAS f32x2_*)(ST + row * 12) = (f32x2_){m, Z}; }
}
template <int LDP>
__device__ __forceinline__ void dil_wg_unit(const bf16* __restrict__ P, int qc, int kc, int vc, int d, int r, int T0, int nT,
                                            OT* __restrict__ O, int oc, float* __restrict__ ST, ATT_LAS char* lds, const ATT_LAS float* bias2, const float C) {
  int tid_ = threadIdx.x; asm volatile("" : "+v"(tid_));
  const int tid = tid_, wid = __builtin_amdgcn_readfirstlane(tid >> 6), lane = tid & 63, r32 = lane & 31, hi = lane >> 5, t0 = T0 + 32 * wid;
  { bf16x8 kk[12];
#pragma unroll
    for (int i = 0; i < 12; ++i) { const int id = tid + 512 * i, row = id >> 4, c = (id & 15) * 8; int kt = T0 - 64 + row; kt = kt < 0 ? 0 : (kt > nT - 1 ? nT - 1 : kt);
      kk[i] = *(const ATT_GAS bf16x8*)(P + (long)(r + d * kt) * LDP + kc + c); }
#pragma unroll
    for (int i = 0; i < 12; ++i) { const int id = tid + 512 * i, row = id >> 4, cB = (id & 15) * 16;
      *reinterpret_cast<ATT_LAS bf16x8*>(lds + kswz<256>(row, cB)) = kk[i]; } }
  bf16x8 qr[8];
  { const bf16* qp = P + (long)(r + d * (t0 + r32)) * LDP + qc + hi * 8;
#pragma unroll
    for (int d0 = 0; d0 < 8; ++d0) qr[d0] = *(const ATT_GAS bf16x8*)(qp + d0 * 16); }
  __syncthreads();
  bf16x8 vv[12];
#pragma unroll
  for (int i = 0; i < 12; ++i) { const int id = tid + 512 * i, row = id >> 4, c = (id & 15) * 8; int kt = T0 - 64 + row; kt = kt < 0 ? 0 : (kt > nT - 1 ? nT - 1 : kt);
    vv[i] = *(const ATT_GAS bf16x8*)(P + (long)(r + d * kt) * LDP + vc + c); }
  f32x16 p[5];
#pragma unroll
  for (int kb = 0; kb < 5; ++kb) { const int krow = 32 * wid + 32 * kb + r32;
    p[kb] = f32x16{};
#pragma unroll
    for (int d0 = 0; d0 < 8; ++d0) { const bf16x8 kf = *reinterpret_cast<const ATT_LAS bf16x8*>(lds + kswz<256>(krow, (d0 * 16 + hi * 8) * 2));
      p[kb] = __builtin_amdgcn_mfma_f32_32x32x16_bf16(kf, qr[d0], p[kb], 0, 0, 0); } }
  float m = -1e30f;
  { const int a_ = 4 * hi - r32 + 32, k_ = a_ & 3; const ATT_LAS f32x4* tp = (const ATT_LAS f32x4*)(bias2 + k_ * 196 + (a_ - k_));
    const bool interior = (t0 >= 64) && (t0 + 96 <= nT);
#pragma unroll
    for (int kb = 0; kb < 5; ++kb)
#pragma unroll
      for (int g = 0; g < 4; ++g) { const f32x4 bv = tp[kb * 8 + 2 * g];
#pragma unroll
        for (int e = 0; e < 4; ++e) { const int rg = 4 * g + e; float s = fmaf(p[kb][rg], C, bv[e]);
          if (!interior) { const int kt = t0 - 64 + kb * 32 + crow(rg, hi); s = (kt >= 0 && kt < nT) ? s : -1e30f; }
          p[kb][rg] = s; m = fmaxf(m, s); } } }
  { auto rr = __builtin_amdgcn_permlane32_swap(__float_as_uint(m), __float_as_uint(m), false, false); m = fmaxf(__uint_as_float(rr[0]), __uint_as_float(rr[1])); }
  float Z = 0.f;
#pragma unroll
  for (int kb = 0; kb < 5; ++kb)
#pragma unroll
    for (int rg = 0; rg < 16; ++rg) { p[kb][rg] = __builtin_amdgcn_exp2f(p[kb][rg] - m); Z += p[kb][rg]; }
  { auto rr = __builtin_amdgcn_permlane32_swap(__float_as_uint(Z), __float_as_uint(Z), false, false); Z = __uint_as_float(rr[0]) + __uint_as_float(rr[1]); }
  bf16x8 pa[5][2];
#pragma unroll
  for (int kb = 0; kb < 5; ++kb) { ATT_PK4(p[kb], 0, pa[kb][0]); ATT_PK4(p[kb], 8, pa[kb][1]); }
  __syncthreads();
#pragma unroll
  for (int i = 0; i < 12; ++i) { const int id = tid + 512 * i, row = id >> 4, c = (id & 15) * 8;
    *reinterpret_cast<ATT_LAS bf16x8*>(lds + (row >> 5) * 8192 + v_st(row & 31, c)) = vv[i]; }
  __syncthreads();
  f32x16 o[4] = {};
#pragma unroll
  for (int kb = 0; kb < 5; ++kb) { const int vb = (int)(unsigned)(uintptr_t)lds + (wid + kb) * 8192 + v_rd_base(lane);
    pv32_one<0>(o[0], vb, pa[kb][0], pa[kb][1]); pv32_one<1>(o[1], vb, pa[kb][0], pa[kb][1]); pv32_one<2>(o[2], vb, pa[kb][0], pa[kb][1]); pv32_one<3>(o[3], vb, pa[kb][0], pa[kb][1]); }
#pragma unroll
  for (int rg = 0; rg < 16; ++rg) { const long row = r + d * (t0 + crow(rg, hi));
#pragma unroll
    for (int d0 = 0; d0 < 4; ++d0) st_o(&O[row * 768 + oc + d0 * 32 + r32], o[d0][rg]); }
  if (hi == 0) { const long row = r + d * (t0 + r32); typedef float f32x2_ __attribute__((ext_vector_type(2))); *(ATT_GAS f32x2_*)(ST + row * 12) = (f32x2_){m, Z}; }
  __syncthreads();
}

#if defined(MLA_DMA) && MLA_DMA == 2
#define MLA_BODY attn_pipe192_body
#elif defined(MLA_DMA) && MLA_DMA
#define MLA_BODY attn_dma_body
#else
template <int LDQ, int LDK, int LDO> __device__ __forceinline__ void attn_simple192(const bf16* Qb, const bf16* Kh, const bf16* Kr, const bf16* Vh, const float* cs, OT* Ob, int seq, const float scale, ATT_LAS char* lds) { attn_simple_body<192, LDQ, LDK, LDO>(Qb, Kh, Kr, Vh, cs, Ob, seq, scale, lds); }
#define MLA_BODY attn_simple192
#endif
}
constexpr int S = 8192, D = 2048, NMEM = 256;
constexpr int DIN = 3392, DINP = 3584;
constexpr int PC_DIL = 768, PC_MEM = 3072;
constexpr int QR = 384, KVR = 128, AQ = 512;
constexpr int NUP = 2816;
constexpr int UC_KV = 1280;
constexpr int DFF = 5632, DFE = 7168, NE = 8;
constexpr int MP = 18432;
constexpr float EPS = 1e-6f;
constexpr int NWAVES = 8;

constexpr size_t al256(size_t x) { return (x + 255) / 256 * 256; }
constexpr size_t WS_CTL = 0, CTL_ZERO_BYTES = 1u << 20;
constexpr size_t WS_WIN = WS_CTL + CTL_ZERO_BYTES;
constexpr size_t WS_WUP = WS_WIN + al256((size_t)2 * DINP * D * 2);
constexpr size_t WS_WMEM = WS_WUP + al256((size_t)2 * NUP * AQ * 2);
constexpr size_t WS_WOUT = WS_WMEM + al256((size_t)2 * 1024 * D * 2);
constexpr size_t WS_WGU = WS_WOUT + al256((size_t)2 * D * D * 2);
constexpr size_t WS_WDN = WS_WGU + al256((size_t)2 * DFF * D * 2);
constexpr size_t WS_MGU = WS_WDN + al256((size_t)D * DFF * 2);
constexpr size_t WS_MDN = WS_MGU + al256((size_t)NE * 2 * DFE * D * 2);
constexpr size_t WS_XN = WS_MDN + al256((size_t)NE * D * DFE * 2);
constexpr size_t WS_MEMN = WS_XN + al256((size_t)S * D * 2);
constexpr size_t WS_MEMKV = WS_MEMN + al256((size_t)2 * NMEM * D * 2);
constexpr size_t WS_PROJ = WS_MEMKV + al256((size_t)2 * NMEM * 1024 * 2);
constexpr size_t WS_AQKV = WS_PROJ + al256((size_t)S * DINP * 2);
constexpr size_t WS_KROPE = WS_AQKV + al256((size_t)S * AQ * 2);
constexpr size_t WS_ROPECS = WS_KROPE + al256((size_t)S * 64 * 2);
constexpr size_t WS_QKVM = WS_ROPECS + al256((size_t)S * 64 * 4);
constexpr size_t WS_YPRE = WS_QKVM + al256((size_t)S * NUP * 2);
constexpr size_t WS_DILO = WS_YPRE + al256((size_t)S * D * 4);
constexpr size_t WS_DILS = WS_DILO + al256((size_t)3 * S * 768 * 4);
constexpr size_t WS_Y = WS_DILS + al256((size_t)3 * S * 12 * 4);
constexpr size_t WS_XA = WS_Y + al256((size_t)S * D * 2);
constexpr size_t WS_ROUTE = WS_XA + al256((size_t)S * D * 4);
constexpr size_t WS_XP = WS_ROUTE + al256((size_t)S * 32);
constexpr size_t WS_OUTP = WS_XP + al256((size_t)MP * D * 2);
constexpr size_t WS_ACTP = WS_OUTP + al256((size_t)MP * D * 2);
constexpr size_t WS_OUTQ = WS_ACTP + al256((size_t)MP * DFE * 2);
constexpr size_t WS_END = WS_OUTQ + al256((size_t)4 * 2048 * D * 2);
static_assert(WS_END <= 1879048192ull, "workspace map exceeds 4 x the largest input");
constexpr int CW_BAR = 16384;
constexpr int CW_QUEUE = 8192;
constexpr int CW_CNT = 8192 + 256;
constexpr int CW_QUEUE2 = 65536;
constexpr int CW_CVT = 8192 + 320;
constexpr int CW_DONE = 8192 + 384;
constexpr int CW_CNTW = 53248;
constexpr int CW_TS = 12288;
constexpr int CW_TILEE = 8192 + 512;
constexpr int RING_BYTES = 131072;
constexpr int LDSCTL_OFF = RING_BYTES, MISC_OFF = LDSCTL_OFF + 320;
constexpr int BIAS_OFF = 132096;
constexpr int LDS_BYTES = 147456;
static_assert(BIAS_OFF >= MISC_OFF + 128 && BIAS_OFF + 3 * 6 * 132 * 4 + 4 * 196 * 4 <= LDS_BYTES, "LDS map");

#define GAS __attribute__((address_space(1)))
#define LAS __attribute__((address_space(3)))
typedef unsigned short bf16;
typedef unsigned v4u __attribute__((ext_vector_type(4)));
typedef unsigned v2u __attribute__((ext_vector_type(2)));
typedef float f32x4 __attribute__((ext_vector_type(4)));
typedef short bf16x8 __attribute__((ext_vector_type(8)));
typedef GAS unsigned gu32;
#define RLX_AGENT __ATOMIC_RELAXED, __HIP_MEMORY_SCOPE_AGENT
#define LDS_WAIT() asm volatile("s_waitcnt lgkmcnt(0)" ::: "memory")
#define VM_WAIT() asm volatile("s_waitcnt vmcnt(0)" ::: "memory")
__device__ __forceinline__ unsigned f2bf(float f) { unsigned u = __builtin_bit_cast(unsigned, f); return (u + 0x7fffu + ((u >> 16) & 1u)) >> 16; }
__device__ __forceinline__ unsigned pk2(float lo, float hi) { return f2bf(lo) | (f2bf(hi) << 16); }
__device__ __forceinline__ float bflo(unsigned w) { return __uint_as_float(w << 16); }
__device__ __forceinline__ float bfhi(unsigned w) { return __uint_as_float(w & 0xffff0000u); }

#ifndef BAR_FLAGS
#define BAR_FLAGS 1
#endif
#define XB_TMO      128
#define XB_XCNT(j)  (256  + 64 * (j))
#define XB_XSUB(j)  (1280 + 64 * (j))
#define XB_XGEN(j)  (2304 + 64 * (j))
#define XB_TOP      3328
#define XB_TOPGEN   3392
#define XCD_BAR_WORDS 3456
#define XB_SPIN_CAP (1u << 18)
__device__ __forceinline__ unsigned xb_ld(unsigned* p)              { return __hip_atomic_load(p, __ATOMIC_RELAXED, __HIP_MEMORY_SCOPE_AGENT); }
__device__ __forceinline__ unsigned xb_add(unsigned* p, unsigned v) { return __hip_atomic_fetch_add(p, v, __ATOMIC_RELAXED, __HIP_MEMORY_SCOPE_AGENT); }
__device__ __forceinline__ unsigned xb_xcc_id() { return (unsigned)__builtin_amdgcn_s_getreg((3 << 11) | 20) & 0xFu; }
#define XB_SPIN(cond, bar) do { unsigned _sp = 0; while (cond) { __builtin_amdgcn_s_sleep(1); \
    if ((++_sp & 255u) == 0u) { if (xb_ld(&(bar)[XB_TMO])) break; if (_sp > XB_SPIN_CAP) { atomicAdd(&(bar)[XB_TMO], 1u); break; } } } } while (0)
struct XcdBarrier { unsigned* bar; unsigned x; volatile LAS unsigned* st; };
__device__ __forceinline__ XcdBarrier xcd_barrier_post(unsigned* bar, volatile LAS unsigned* st) {
    XcdBarrier b; b.bar = bar; b.x = xb_xcc_id(); b.st = st;
    if (threadIdx.x == 0) (void)xb_add(&bar[XB_XCNT(b.x)], 1u);
    return b;
}
__device__ __forceinline__ void xcd_barrier_complete(unsigned* bar, unsigned x, unsigned& nloc, unsigned& nx, unsigned& mask) {
    const unsigned G = gridDim.x * gridDim.y * gridDim.z;
    unsigned sum, cnt, mine, msk, sp = 0u;
    for (;;) {
        sum = 0u; cnt = 0u; mine = 0u; msk = 0u;
#pragma unroll
        for (unsigned j = 0; j < 16; ++j) { const unsigned c = xb_ld(&bar[XB_XCNT(j)]); sum += c; cnt += (c > 0u) ? 1u : 0u; msk |= (c > 0u) ? (1u << j) : 0u; mine = (j == x) ? c : mine; }
        if (sum == G) break;
        __builtin_amdgcn_s_sleep(1);
        if ((++sp & 255u) == 0u) { if (xb_ld(&bar[XB_TMO])) break; if (sp > XB_SPIN_CAP) { atomicAdd(&bar[XB_TMO], 1u); break; } }
    }
    nloc = mine > 0u ? mine : 1u; nx = cnt > 0u ? cnt : 1u; mask = msk;
}
#if BAR_FLAGS
#define XB_XFLAG(j) (3456 + (j))
template <int MODE = 0>
__device__ __forceinline__ void xcd_barrier(const XcdBarrier& b) {
    asm volatile("s_waitcnt vmcnt(0)" ::: "memory");
    __syncthreads();
    if (threadIdx.x < 64) {
        unsigned* bar = b.bar; const unsigned lane = threadIdx.x;
        unsigned gen1 = 0u, mask = 0u; bool leader = false;
        if (lane == 0) {
            __builtin_amdgcn_s_waitcnt(0);
#if BAR_FLAGS == 2
            asm volatile("buffer_inv sc1" ::: "memory");
#endif
            unsigned nloc = b.st[0], nx = b.st[1]; mask = b.st[2];
            if (nloc == 0u) { xcd_barrier_complete(bar, b.x, nloc, nx, mask); b.st[0] = nloc; b.st[1] = nx; b.st[2] = mask; }
            const unsigned old = xb_add(&bar[XB_XSUB(b.x)], 1u);
            const unsigned gen = old / nloc; gen1 = gen + 1u;
            if (old + 1u == gen1 * nloc) { leader = true;
                if (!(MODE & 1)) __builtin_amdgcn_fence(__ATOMIC_RELEASE, "agent");
                asm volatile("s_waitcnt vmcnt(0)" ::: "memory");
#if BAR_FLAGS == 2
                asm volatile("buffer_inv sc1\n\ts_waitcnt vmcnt(0)" ::: "memory");
#endif
                __hip_atomic_store(&bar[XB_XFLAG(b.x)], gen1, __ATOMIC_RELAXED, __HIP_MEMORY_SCOPE_AGENT);
            }
        }
        gen1 = (unsigned)__builtin_amdgcn_readfirstlane((int)gen1); mask = (unsigned)__builtin_amdgcn_readfirstlane((int)mask);
        unsigned sp = 0u;
        for (;;) {
            bool ok = true;
            if (lane < 16) { const unsigned f = xb_ld(&bar[XB_XFLAG(lane)]); ok = (((mask >> lane) & 1u) == 0u) || ((int)(f - gen1) >= 0); }
            if (__all(ok)) break;
            __builtin_amdgcn_s_sleep(1);
            if ((++sp & 255u) == 0u) { if (xb_ld(&bar[XB_TMO])) break; if (sp > XB_SPIN_CAP) { if (lane == 0) atomicAdd(&bar[XB_TMO], 1u); break; } }
        }
#if BAR_FLAGS != 2
        if (!(MODE & 2)) { if (!(MODE & 4) || __builtin_amdgcn_readfirstlane((int)leader)) __builtin_amdgcn_fence(__ATOMIC_ACQUIRE, "agent"); }
#endif
        asm volatile("s_waitcnt vmcnt(0)" ::: "memory");
    }
    __syncthreads();
}
#else
__device__ __forceinline__ void xcd_barrier(const XcdBarrier& b) {
    asm volatile("s_waitcnt vmcnt(0)" ::: "memory");
    __syncthreads();
    if (threadIdx.x == 0) {
        unsigned* bar = b.bar;
        __builtin_amdgcn_s_waitcnt(0);
        unsigned nloc = b.st[0], nx = b.st[1], mask_;
        if (nloc == 0u) { xcd_barrier_complete(bar, b.x, nloc, nx, mask_); b.st[0] = nloc; b.st[1] = nx; }
        const unsigned old = xb_add(&bar[XB_XSUB(b.x)], 1u);
        const unsigned gen = old / nloc;
        if (old + 1u == (gen + 1u) * nloc) {
            __builtin_amdgcn_fence(__ATOMIC_RELEASE, "agent");
            asm volatile("s_waitcnt vmcnt(0)" ::: "memory");
            const unsigned og = xb_add(&bar[XB_TOP], 1u);
            const unsigned tg = og / nx;
            if (og + 1u == (tg + 1u) * nx) xb_add(&bar[XB_TOPGEN], 1u);
            else XB_SPIN(xb_ld(&bar[XB_TOPGEN]) == tg, bar);
            __builtin_amdgcn_fence(__ATOMIC_ACQUIRE, "agent");
            xb_add(&bar[XB_XGEN(b.x)], 1u);
            asm volatile("s_waitcnt vmcnt(0)" ::: "memory");
        } else {
            XB_SPIN(xb_ld(&bar[XB_XGEN(b.x)]) == gen, bar);
            __builtin_amdgcn_fence(__ATOMIC_ACQUIRE, "agent");
            asm volatile("s_waitcnt vmcnt(0)" ::: "memory");
        }
    }
    __syncthreads();
}
#endif

struct Args {
    const float* in[23]; float* out; unsigned char* ws;
    float invf[32];
    int ph_lo, ph_hi, li, rep;
};
struct Frame {
    LAS unsigned char* lds;
    volatile LAS unsigned* MISC;
    gu32* ctl;
    int tid, lane, wave, G, gw, NGW;
    unsigned char* ws;
};
__device__ __forceinline__ float wave_sum(float v) {
#pragma unroll
    for (int o = 1; o < 64; o <<= 1) v += __shfl_xor(v, o);
    return v;
}
__device__ __forceinline__ float wave_max(float v) {
#pragma unroll
    for (int o = 1; o < 64; o <<= 1) v = fmaxf(v, __shfl_xor(v, o));
    return v;
}

__device__ __forceinline__ unsigned pk4_fp8(float a, float b, float c, float d) { int w = 0; w = __builtin_amdgcn_cvt_pk_fp8_f32(a, b, w, false); w = __builtin_amdgcn_cvt_pk_fp8_f32(c, d, w, true); return (unsigned)w; }
#if defined(CVT_REG) && CVT_REG
__device__ __forceinline__ void cvt_load(const float* __restrict__ W, int N, int k0, int n0, int lane, f32x4 (&v)[8]) {
    const GAS float* p = (const GAS float*)(W + (size_t)(k0 + (lane >> 5) * 32) * N + n0 + (lane & 31));
#pragma unroll
    for (int i = 0; i < 8; ++i)
#pragma unroll
        for (int e = 0; e < 4; ++e) v[i][e] = __builtin_nontemporal_load(p + (size_t)(i * 4 + e) * N);
}
template <bool FP8>
__device__ __forceinline__ void cvt_finish(const f32x4 (&v)[8], int k0, void* __restrict__ dstv, int ldd, int drow0, int kdst0, LAS float* scr, int lane, float wsc) {
    const int n = lane & 31, kh = (lane >> 5) * 32;
    if constexpr (FP8) { GAS v4u* d = (GAS v4u*)((unsigned char*)dstv + (size_t)(drow0 + n) * ldd + kdst0 + k0 + kh);
#pragma unroll
        for (int j = 0; j < 2; ++j) { v4u o;
            o.x = pk4_fp8(v[4 * j][0] * wsc, v[4 * j][1] * wsc, v[4 * j][2] * wsc, v[4 * j][3] * wsc); o.y = pk4_fp8(v[4 * j + 1][0] * wsc, v[4 * j + 1][1] * wsc, v[4 * j + 1][2] * wsc, v[4 * j + 1][3] * wsc);
            o.z = pk4_fp8(v[4 * j + 2][0] * wsc, v[4 * j + 2][1] * wsc, v[4 * j + 2][2] * wsc, v[4 * j + 2][3] * wsc); o.w = pk4_fp8(v[4 * j + 3][0] * wsc, v[4 * j + 3][1] * wsc, v[4 * j + 3][2] * wsc, v[4 * j + 3][3] * wsc);
            __builtin_nontemporal_store(o, d + j); } }
    else { GAS v4u* d = (GAS v4u*)((bf16*)dstv + (size_t)(drow0 + n) * ldd + kdst0 + k0 + kh);
#pragma unroll
        for (int j = 0; j < 4; ++j) { v4u o; o.x = pk2(v[2 * j][0], v[2 * j][1]); o.y = pk2(v[2 * j][2], v[2 * j][3]); o.z = pk2(v[2 * j + 1][0], v[2 * j + 1][1]); o.w = pk2(v[2 * j + 1][2], v[2 * j + 1][3]);
            __builtin_nontemporal_store(o, d + j); } }
}
#else
__device__ __forceinline__ void cvt_load(const float* __restrict__ W, int N, int k0, int n0, int lane, f32x4 (&v)[8]) {
    const int lr = lane >> 3, lc = (lane & 7) * 4;
#pragma unroll
    for (int i = 0; i < 8; ++i) v[i] = __builtin_nontemporal_load((const GAS f32x4*)(W + (size_t)(k0 + i * 8 + lr) * N + n0 + lc));
}
template <bool FP8>
__device__ __forceinline__ void cvt_finish(const f32x4 (&v)[8], int k0, void* __restrict__ dstv, int ldd, int drow0, int kdst0, LAS float* scr, int lane, float wsc) {
    const int lr = lane >> 3, lc = (lane & 7) * 4;
#pragma unroll
    for (int i = 0; i < 8; ++i) { LAS float* s = scr + (i * 8 + lr) * 33 + lc; s[0] = v[i][0]; s[1] = v[i][1]; s[2] = v[i][2]; s[3] = v[i][3]; }
    LDS_WAIT(); asm volatile("" ::: "memory");
    const int c = lane & 7;
#pragma unroll
    for (int j = 0; j < 4; ++j) { const int n = (lane >> 3) + 8 * j; const LAS float* s = scr + (8 * c) * 33 + n;
        if constexpr (FP8) { v2u o; o.x = pk4_fp8(s[0 * 33] * wsc, s[1 * 33] * wsc, s[2 * 33] * wsc, s[3 * 33] * wsc); o.y = pk4_fp8(s[4 * 33] * wsc, s[5 * 33] * wsc, s[6 * 33] * wsc, s[7 * 33] * wsc);
            __builtin_nontemporal_store(o, (GAS v2u*)((unsigned char*)dstv + (size_t)(drow0 + n) * ldd + kdst0 + k0 + 8 * c)); }
        else { v4u o; o.x = pk2(s[0 * 33], s[1 * 33]); o.y = pk2(s[2 * 33], s[3 * 33]); o.z = pk2(s[4 * 33], s[5 * 33]); o.w = pk2(s[6 * 33], s[7 * 33]);
            __builtin_nontemporal_store(o, (GAS v4u*)((bf16*)dstv + (size_t)(drow0 + n) * ldd + kdst0 + k0 + 8 * c)); } }
    LDS_WAIT(); asm volatile("" ::: "memory");
}
#endif
__device__ __forceinline__ int cvt_drow(int mode, int n0, int roff) { return mode == 0 ? n0 + roff : (mode == 1 ? (n0 >> 7) * 256 + (n0 & 127) : (mode == 2 ? (n0 >> 7) * 256 + 128 + (n0 & 127) : (n0 < 576 ? n0 : n0 + 192))); }
template <bool FP8>
__device__ __forceinline__ void cvt_job(Frame& F, const float* W, int K, int N, void* dst, int ldd, int kdst0, int mode, int roff, LAS float* scr, float wsc) {
    const int nnb = N / 32, nitems = (K / 64) * nnb;
    int it = F.gw; if (it >= nitems) return;
    f32x4 va[8], vb[8];
    cvt_load(W, N, (it / nnb) * 64, (it % nnb) * 32, F.lane, va);
    for (;;) {
        const int it1 = it + F.NGW; if (it1 < nitems) cvt_load(W, N, (it1 / nnb) * 64, (it1 % nnb) * 32, F.lane, vb);
        cvt_finish<FP8>(va, (it / nnb) * 64, dst, ldd, cvt_drow(mode, (it % nnb) * 32, roff), kdst0, scr, F.lane, wsc);
        if (it1 >= nitems) break;
        const int it2 = it1 + F.NGW; if (it2 < nitems) cvt_load(W, N, (it2 / nnb) * 64, (it2 % nnb) * 32, F.lane, va);
        cvt_finish<FP8>(vb, (it1 / nnb) * 64, dst, ldd, cvt_drow(mode, (it1 % nnb) * 32, roff), kdst0, scr, F.lane, wsc);
        if (it2 >= nitems) break;
        it = it2;
    }
}
__device__ __forceinline__ void rms_row_to_bf16(const float* xrow, const float* g, bf16* orow, int lane) {
    const GAS f32x4* xr = (const GAS f32x4*)xrow + lane; const GAS f32x4* gr = (const GAS f32x4*)g + lane;
    f32x4 v[8]; float s = 0.f;
#pragma unroll
    for (int j = 0; j < 8; ++j) { v[j] = xr[64 * j]; s += (v[j].x * v[j].x + v[j].y * v[j].y) + (v[j].z * v[j].z + v[j].w * v[j].w); }
    const float rstd = 1.f / sqrtf(wave_sum(s) * (1.f / D) + EPS);
    GAS v2u* o8 = (GAS v2u*)orow + lane;
#pragma unroll
    for (int j = 0; j < 8; ++j) { const f32x4 gg = gr[64 * j]; v2u w; w.x = pk2(v[j].x * rstd * gg.x, v[j].y * rstd * gg.y); w.y = pk2(v[j].z * rstd * gg.z, v[j].w * rstd * gg.w); o8[64 * j] = w; }
}
__device__ __forceinline__ void rms_row_to_fp8(const float* xrow, const float* g, unsigned char* orow, int lane) {
    const GAS f32x4* xr = (const GAS f32x4*)xrow + lane; const GAS f32x4* gr = (const GAS f32x4*)g + lane;
    f32x4 v[8]; float s = 0.f;
#pragma unroll
    for (int j = 0; j < 8; ++j) { v[j] = xr[64 * j]; s += (v[j].x * v[j].x + v[j].y * v[j].y) + (v[j].z * v[j].z + v[j].w * v[j].w); }
    const float rstd = 1.f / sqrtf(wave_sum(s) * (1.f / D) + EPS);
    GAS unsigned* o4 = (GAS unsigned*)orow + lane;
#pragma unroll
    for (int j = 0; j < 8; ++j) { const f32x4 gg = gr[64 * j]; o4[64 * j] = pk4_fp8(v[j].x * rstd * gg.x, v[j].y * rstd * gg.y, v[j].z * rstd * gg.z, v[j].w * rstd * gg.w); }
}
__device__ __forceinline__ void sincos_f64(float ang, float& c, float& s) {
    const double a = (double)ang, twopi = 6.283185307179586476925286766559, inv2pi = 0.15915494309189533576888376337251;
    const double q = __builtin_rint(a * inv2pi); const double r = a - q * twopi;
    const double r2 = r * r; double ss = 1.0, cc = 1.0;
#pragma unroll
    for (int k = 14; k >= 1; --k) { ss = 1.0 - r2 * (1.0 / (double)((2 * k) * (2 * k + 1))) * ss; cc = 1.0 - r2 * (1.0 / (double)((2 * k - 1) * (2 * k))) * cc; }
    s = (float)(r * ss); c = (float)cc;
}
__device__ const unsigned char DIL_BUCKET[3][129] = {
 {11,11,11,11,11,11,11,11,11,11,11,11,11,11,11,10,10,10,10,10,10,10,10,10,10,10,10,10,10,10,10,10,10,10,10,10,10,10,9,9,9,9,9,9,9,9,9,9,9,9,8,8,8,8,8,8,8,7,6,5,4,3,2,1,0,17,18,19,20,21,22,23,24,24,24,24,24,24,24,25,25,25,25,25,25,25,25,25,25,25,25,26,26,26,26,26,26,26,26,26,26,26,26,26,26,26,26,26,26,26,26,26,26,26,27,27,27,27,27,27,27,27,27,27,27,27,27,27,27},
 {13,13,13,13,13,13,13,13,13,13,13,13,13,13,13,13,13,13,13,13,13,13,13,12,12,12,12,12,12,12,12,12,12,12,12,12,12,12,12,12,12,12,11,11,11,11,11,11,11,11,11,11,10,10,10,10,10,10,9,9,9,8,8,4,0,20,24,24,25,25,25,26,26,26,26,26,26,27,27,27,27,27,27,27,27,27,27,28,28,28,28,28,28,28,28,28,28,28,28,28,28,28,28,28,28,28,29,29,29,29,29,29,29,29,29,29,29,29,29,29,29,29,29,29,29,29,29,29,29},
 {15,15,15,15,15,15,15,15,15,15,15,15,15,15,15,15,15,15,15,15,15,15,15,15,15,15,15,15,15,15,14,14,14,14,14,14,14,14,14,14,14,14,14,14,14,13,13,13,13,13,13,13,13,13,12,12,12,12,12,11,11,10,10,9,0,25,26,26,27,27,28,28,28,28,28,29,29,29,29,29,29,29,29,29,30,30,30,30,30,30,30,30,30,30,30,30,30,30,30,31,31,31,31,31,31,31,31,31,31,31,31,31,31,31,31,31,31,31,31,31,31,31,31,31,31,31,31,31,31}};

typedef float f32x2 __attribute__((ext_vector_type(2)));
#ifndef PRE_ROWS
#define PRE_ROWS 4
#endif
#ifndef COMB_ROWS
#define COMB_ROWS 2
#endif
__device__ __forceinline__ f32x4 ld_r4(const float* p) { return *(const GAS f32x4*)p; }
__device__ __forceinline__ v2u ld_r4(const unsigned short* p) { return *(const GAS v2u*)p; }
__device__ __forceinline__ f32x4 cv4(f32x4 r) { return r; }
__device__ __forceinline__ f32x4 cv4(v2u w) { return (f32x4){bflo(w.x), bfhi(w.x), bflo(w.y), bfhi(w.y)}; }
__device__ __forceinline__ f32x4 ld_o4(const float* p) { return *(const GAS f32x4*)p; }
__device__ __forceinline__ f32x4 ld_o4(const unsigned short* p) { const v2u w = *(const GAS v2u*)p; return (f32x4){bflo(w.x), bfhi(w.x), bflo(w.y), bfhi(w.y)}; }
#ifndef CVT_CHUNK
#define CVT_CHUNK 64
#endif
#ifndef PH_MASK
#define PH_MASK 0xFFFFu
#endif
#ifndef REPEAT_PHASE
#define REPEAT_PHASE -1
#endif
#ifndef ATT_EN
#define ATT_EN 7
#endif
#define PEN(k) ((PH_MASK >> (k)) & 1u)
#ifndef FFN_FP8
#define FFN_FP8 3
#endif
constexpr bool F8D = (FFN_FP8 & 1) != 0, F8M = (FFN_FP8 & 2) != 0;
constexpr int EBD = F8D ? 1 : 2, EBM = F8M ? 1 : 2;
template <bool B> struct Sc { static constexpr float w_gu = B ? 32.f : 1.f, w_dn = B ? 64.f : 1.f, a_sc = B ? 4.f : 1.f, dn = 1.f / (w_dn * a_sc); };
template <bool B> using FfnEpi1 = typename std::conditional<B, pg8::EpiSwiGLU8, pg8::EpiSwiGLU>::type;
template <bool B> struct Epi1Maker;
template <> struct Epi1Maker<true> { static __device__ __forceinline__ pg8::EpiSwiGLU8 make(void* O, int ldc) { return pg8::EpiSwiGLU8{(unsigned char*)O, ldc, 1.f / Sc<true>::w_gu, Sc<true>::a_sc}; } };
template <> struct Epi1Maker<false> { static __device__ __forceinline__ pg8::EpiSwiGLU make(void* O, int ldc) { return pg8::EpiSwiGLU{(unsigned short*)O, ldc}; } };

constexpr int MOE_MAT_ITEMS = 7168, MOE_GU_ITEMS = 16 * MOE_MAT_ITEMS, MOE_NITEMS = 24 * MOE_MAT_ITEMS, MOE_CHUNK = CVT_CHUNK, MOE_NCHUNK = MOE_NITEMS / MOE_CHUNK;
struct MoeItem { const float* W; void* dst; int N, k0, n0, ldd, drow0; float wsc; };
typedef const __attribute__((address_space(4))) Args* KArgs;
__device__ __forceinline__ MoeItem moe_item(KArgs ka, unsigned char* ws, int idx) {
    MoeItem m;
    if (idx < MOE_GU_ITEMS) { const int mat = idx / MOE_MAT_ITEMS, local = idx % MOE_MAT_ITEMS, e = mat >> 1, up = mat & 1, kb = local / (DFE / 32), nb = local % (DFE / 32);
        m.W = ka->in[19 + up] + (size_t)e * D * DFE; m.N = DFE; m.k0 = kb * 64; m.n0 = nb * 32; m.dst = ws + WS_MGU + (size_t)e * 2 * DFE * D * EBM; m.ldd = D;
        m.drow0 = (m.n0 >> 7) * 256 + up * 128 + (m.n0 & 127); m.wsc = Sc<F8M>::w_gu; }
    else { const int i2 = idx - MOE_GU_ITEMS, e = i2 / MOE_MAT_ITEMS, local = i2 % MOE_MAT_ITEMS, kb = local / (D / 32), nb = local % (D / 32);
        m.W = ka->in[21] + (size_t)e * DFE * D; m.N = D; m.k0 = kb * 64; m.n0 = nb * 32; m.dst = ws + WS_MDN + (size_t)e * D * DFE * EBM; m.ldd = DFE; m.drow0 = m.n0; m.wsc = Sc<F8M>::w_dn; }
    return m;
}
__device__ __forceinline__ void moe_cvt_chunk(Frame& F, KArgs ka, int c) {
    LAS float* scr = (LAS float*)(F.lds + F.wave * 16384);
    const int i0 = c * MOE_CHUNK + F.wave * (MOE_CHUNK / 8);
    f32x4 va[8], vb[8], vc[8]; MoeItem ma, mb, mc;
#define MC_L(m, v, i) do { m = moe_item(ka, F.ws, i0 + (i)); cvt_load(m.W, m.N, m.k0, m.n0, F.lane, v); } while (0)
#define MC_F(m, v) cvt_finish<F8M>(v, m.k0, m.dst, m.ldd, m.drow0, 0, scr, F.lane, m.wsc)
    MC_L(ma, va, 0); MC_L(mb, vb, 1); MC_L(mc, vc, 2);
    if constexpr (MOE_CHUNK == 64) {
        MC_F(ma, va); MC_L(ma, va, 3); MC_F(mb, vb); MC_L(mb, vb, 4); MC_F(mc, vc); MC_L(mc, vc, 5);
        MC_F(ma, va); MC_L(ma, va, 6); MC_F(mb, vb); MC_L(mb, vb, 7); MC_F(mc, vc); MC_F(ma, va); MC_F(mb, vb);
    } else {
        MC_F(ma, va); MC_L(ma, va, 3); MC_F(mb, vb); MC_F(mc, vc); MC_F(ma, va);
    }
#undef MC_L
#undef MC_F
}
__device__ __forceinline__ void moe_cvt_fill(Frame& F, KArgs ka, int ph) {
    { int t_ = threadIdx.x; asm volatile("" : "+v"(t_)); F.tid = t_; F.lane = t_ & 63; }
    for (;;) {
        if (F.tid == 0) { unsigned c = MOE_NCHUNK;
            if (ph < 0 || __hip_atomic_load(F.ctl + CW_DONE + ph, RLX_AGENT) < (unsigned)F.G) c = __hip_atomic_fetch_add(F.ctl + CW_CVT + (ph == -2 ? 16 : 0), 1u, RLX_AGENT);
            F.MISC[17] = c; }
        __syncthreads(); const unsigned c = F.MISC[17]; __syncthreads();
        if (c >= (unsigned)MOE_NCHUNK) break;
        moe_cvt_chunk(F, ka, (int)c);
    }
}
#define FILL(ph) do { __syncthreads(); if (F.tid == 0) (void)__hip_atomic_fetch_add(F.ctl + CW_DONE + (ph), 1u, RLX_AGENT); moe_cvt_fill(F, ka, (ph)); } while (0)
#ifndef MLA_DMA
#define MLA_DMA 1
#endif
#ifndef MOE_TAIL
#define MOE_TAIL 1
#endif
#ifndef GEMM_SP2
#define GEMM_SP2 1
#endif
constexpr bool SP2V = (GEMM_SP2 != 0);
#ifndef PROBE_ATT
#define PROBE_ATT 7
#endif
#ifndef FILLMASK
#define FILLMASK 7
#endif
constexpr int PH_PER_LAYER = 11, N_PHASES = 1 + 2 * PH_PER_LAYER;
#ifndef MK_N_LAUNCHES
#define MK_N_LAUNCHES 1
#endif
constexpr int N_LAUNCHES = MK_N_LAUNCHES;

__global__ void __launch_bounds__(NWAVES * 64, 2) mk_fwd(Args) {
    KArgs ka = (KArgs)__builtin_amdgcn_kernarg_segment_ptr(); asm volatile("" : "+s"(ka));
#define args (*ka)
    extern __shared__ __attribute__((aligned(16))) unsigned char lds[];
    Frame F;
    F.lds = (LAS unsigned char*)lds;
    F.MISC = (volatile LAS unsigned*)(F.lds + MISC_OFF);
    F.tid = threadIdx.x; F.lane = F.tid & 63; F.wave = __builtin_amdgcn_readfirstlane(F.tid >> 6);
    F.G = gridDim.x; F.gw = blockIdx.x * NWAVES + F.wave; F.NGW = F.G * NWAVES;
    F.ws = args.ws; F.ctl = (gu32*)(args.ws + WS_CTL);
    unsigned char* ws = args.ws;
    for (int u = F.tid; u < (LDS_BYTES - LDSCTL_OFF) / 4; u += NWAVES * 64) ((LAS unsigned*)(F.lds + LDSCTL_OFF))[u] = 0u;
    __syncthreads();
    XcdBarrier bar; bar.bar = (unsigned*)(F.ctl + CW_BAR) + args.li * 4096; bar.x = 0; bar.st = nullptr;
    if (N_LAUNCHES != N_PHASES) bar = xcd_barrier_post((unsigned*)(F.ctl + CW_BAR) + args.li * 4096, F.MISC + 8);
#define GRID_BAR() do { if (N_LAUNCHES != N_PHASES) xcd_barrier(bar); } while (0)
    const int lo = args.ph_lo, hi = args.ph_hi;
#define IN(k) (lo <= (k) && (k) < hi)
#define BOTH(k) (IN(k) && IN((k) + 1))

#define x_in (args.in[0])
#define XN8 ((unsigned char*)(ws + WS_XN))
#define WIN ((bf16*)(ws + WS_WIN))
#define WUP ((bf16*)(ws + WS_WUP))
#define WMEM ((bf16*)(ws + WS_WMEM))
#define WOUT ((bf16*)(ws + WS_WOUT))
#define WGU ((bf16*)(ws + WS_WGU))
#define WDN ((bf16*)(ws + WS_WDN))
#define MGU ((bf16*)(ws + WS_MGU))
#define MDN ((bf16*)(ws + WS_MDN))
#define XN ((bf16*)(ws + WS_XN))
#define MEMN ((bf16*)(ws + WS_MEMN))
#define MEMKV ((bf16*)(ws + WS_MEMKV))
#define PROJ ((bf16*)(ws + WS_PROJ))
#define AQKV ((bf16*)(ws + WS_AQKV))
#define KROPE ((bf16*)(ws + WS_KROPE))
#define ROPECS ((float*)(ws + WS_ROPECS))
#define QKVM ((bf16*)(ws + WS_QKVM))
#define YPRE ((att::OT*)(ws + WS_YPRE))
#define YPREF ((float*)(ws + WS_YPRE))
#define DILO ((att::OT*)(ws + WS_DILO))
#define DILS ((float*)(ws + WS_DILS))
#define Y ((bf16*)(ws + WS_Y))
#define XA ((float*)(ws + WS_XA))
#define ROUTE ((unsigned*)(ws + WS_ROUTE))
#define XP ((bf16*)(ws + WS_XP))
#define OUTP ((bf16*)(ws + WS_OUTP))
#define OUTQ ((bf16*)(ws + WS_OUTQ))
#define ACTP ((bf16*)(ws + WS_ACTP))
#define ACT ((bf16*)(ws + WS_ACTP))
#if defined(PROBE_T)
#define TSTAMP_AT(p) do { if (threadIdx.x == 0) { ((volatile LAS unsigned*)(F.lds + 131520))[(p)] = (unsigned)__builtin_amdgcn_s_memrealtime(); ((volatile LAS unsigned*)(F.lds + 131520))[32 + (p)] = (unsigned)__builtin_amdgcn_s_memtime(); } } while (0)
#else
#define TSTAMP_AT(p) do { } while (0)
#endif
#define PHASE_BEGIN() do { int t_ = threadIdx.x; asm volatile("" : "+v"(t_)); F.tid = t_; F.lane = t_ & 63; asm volatile("" : "+s"(ka)); } while (0)

    if (PEN(0) && IN(0)) { PHASE_BEGIN(); TSTAMP_AT(0);
        LAS float* scr = (LAS float*)(F.lds + F.wave * 16384);
        { const v4u z = {0u, 0u, 0u, 0u}; const int gt = blockIdx.x * (NWAVES * 64) + F.tid, ngt = F.G * NWAVES * 64;
          for (int l = 0; l < 2; ++l) {
              GAS v4u* w = (GAS v4u*)(WIN + (size_t)l * DINP * D + (size_t)576 * D); for (int i = gt; i < 192 * D / 8; i += ngt) w[i] = z;
              GAS v4u* u = (GAS v4u*)(WUP + (size_t)l * NUP * AQ);
              for (int i = gt; i < NUP * 64; i += ngt) { const int row = i >> 6, c = i & 63; const bool zero = row < 1152 ? (c >= 48) : (row < 1280 ? true : (c < 48)); if (zero) u[i] = z; } } }
        for (int rep = 0; rep < (REPEAT_PHASE == 0 ? 2 : 1); ++rep) {
        for (int l = 0; l < 2; ++l) {
            cvt_job<false>(F, args.in[5] + (size_t)l * D * DIN, D, DIN, WIN + (size_t)l * DINP * D, D, 0, 3, 0, scr, 1.f);
            cvt_job<false>(F, args.in[7] + (size_t)l * QR * 1152, QR, 1152, WUP + (size_t)l * NUP * AQ, AQ, 0, 0, 0, scr, 1.f);
            cvt_job<false>(F, args.in[9] + (size_t)l * KVR * 1536, KVR, 1536, WUP + (size_t)l * NUP * AQ, AQ, QR, 0, UC_KV, scr, 1.f);
            cvt_job<false>(F, args.in[11] + (size_t)l * D * 1024, D, 1024, WMEM + (size_t)l * 1024 * D, D, 0, 0, 0, scr, 1.f);
            cvt_job<false>(F, args.in[13] + (size_t)l * D * D, D, D, WOUT + (size_t)l * D * D, D, 0, 0, 0, scr, 1.f);
        }
        cvt_job<F8D>(F, args.in[15], D, DFF, WGU, D, 0, 1, 0, scr, Sc<F8D>::w_gu);
        cvt_job<F8D>(F, args.in[16], D, DFF, WGU, D, 0, 2, 0, scr, Sc<F8D>::w_gu);
        cvt_job<F8D>(F, args.in[17], DFF, D, WDN, DFF, 0, 0, 0, scr, Sc<F8D>::w_dn);
        }
        { const int* pos = (const int*)args.in[2];
          for (int idx = blockIdx.x * (NWAVES * 64) + F.tid; idx < S * 32; idx += F.G * NWAVES * 64) { const int row = idx >> 5, i = idx & 31;
              const float ang = (float)pos[row] * args.invf[i]; float c, s; sincos_f64(ang, c, s); ROPECS[row * 64 + i] = c; ROPECS[row * 64 + 32 + i] = s; } }
        for (int m = F.gw; m < 2 * NMEM; m += F.NGW) { const int l = m >> 8, r = m & 255; rms_row_to_bf16(args.in[1] + (size_t)r * D, args.in[10] + (size_t)l * D, MEMN + (size_t)m * D, F.lane); }
        for (int m = F.gw; m < S; m += F.NGW) rms_row_to_bf16(x_in + (size_t)m * D, args.in[4], XN + (size_t)m * D, F.lane);
        if (BOTH(0)) GRID_BAR();
    }

    for (int l = 0; l < 2; ++l) {
        const int pb = 1 + l * PH_PER_LAYER;
        if (PEN(1) && IN(pb + 0)) { PHASE_BEGIN(); TSTAMP_AT(pb + 0);
            { pg8::Gemm g{XN, WIN + (size_t)l * DINP * D, 2 * D, 2 * D, D / 64}; pg8::InProjOrder So; So.so.init(S, DINP, F.G, (int)blockIdx.x); So.nextra = (l == 0) ? 8 : 0; So.A2 = MEMN; So.B2 = WMEM;
              pg8::EpiBf16Sel E{PROJ, DINP, MEMKV, 1024};
              pg8::gemm_phase<pg8::EpiBf16Sel, pg8::InProjOrder, true, SP2V>(F.lds, g, So, E); }
            if (FILLMASK & 1) FILL(pb + 0);
            if (BOTH(pb + 0)) GRID_BAR();
        }
        if (PEN(2) && IN(pb + 1)) { PHASE_BEGIN(); TSTAMP_AT(pb + 1);
            const float* gq = args.in[6] + l * QR; const float* gkv = args.in[8] + l * KVR;
            const float* gp = F.lane < 48 ? gq + F.lane * 8 : gkv + (F.lane - 48) * 8;
            const f32x4 g0 = *(const GAS f32x4*)gp, g1 = *(const GAS f32x4*)(gp + 4);
            const int c = F.lane & 7;
            constexpr int PR = PRE_ROWS;
            for (int m0 = F.gw; m0 < S; m0 += PR * F.NGW) {
                v4u w_[PR], kw_[PR]; f32x4 cs_[PR][4];
#pragma unroll
                for (int r = 0; r < PR; ++r) { const int mr = m0 + r * F.NGW, m = mr < S ? mr : m0;
                    w_[r] = *(const GAS v4u*)(PROJ + (size_t)m * DINP + F.lane * 8);
                    kw_[r] = *(const GAS v4u*)(PROJ + (size_t)m * DINP + 512 + c * 8);
                    const float* cs = ROPECS + (size_t)m * 64 + (c & 3) * 8;
                    cs_[r][0] = *(const GAS f32x4*)cs; cs_[r][1] = *(const GAS f32x4*)(cs + 4); cs_[r][2] = *(const GAS f32x4*)(cs + 32); cs_[r][3] = *(const GAS f32x4*)(cs + 36); }
#pragma unroll
                for (int r = 0; r < PR; ++r) { const int m = m0 + r * F.NGW; if (m >= S) break;
                    const v4u w = w_[r];
                    float v[8] = {bflo(w.x), bfhi(w.x), bflo(w.y), bfhi(w.y), bflo(w.z), bfhi(w.z), bflo(w.w), bfhi(w.w)};
                    float sq = 0.f;
#pragma unroll
                    for (int j = 0; j < 8; ++j) sq += v[j] * v[j];
                    const float sq_q = wave_sum(F.lane < 48 ? sq : 0.f), sq_kv = wave_sum(F.lane >= 48 ? sq : 0.f);
                    const float rstd = F.lane < 48 ? 1.f / sqrtf(sq_q * (1.f / QR) + EPS) : 1.f / sqrtf(sq_kv * (1.f / KVR) + EPS);
                    v4u o; o.x = pk2(v[0] * rstd * g0.x, v[1] * rstd * g0.y); o.y = pk2(v[2] * rstd * g0.z, v[3] * rstd * g0.w);
                    o.z = pk2(v[4] * rstd * g1.x, v[5] * rstd * g1.y); o.w = pk2(v[6] * rstd * g1.z, v[7] * rstd * g1.w);
                    *(GAS v4u*)(AQKV + (size_t)m * AQ + F.lane * 8) = o;
                    const v4u kw = kw_[r];
                    float kv[8] = {bflo(kw.x), bfhi(kw.x), bflo(kw.y), bfhi(kw.y), bflo(kw.z), bfhi(kw.z), bflo(kw.w), bfhi(kw.w)};
                    float ko[8];
#pragma unroll
                    for (int j = 0; j < 8; ++j) { const float other = __shfl_xor(kv[j], 4); const float co = cs_[r][j >> 2][j & 3], si = cs_[r][2 + (j >> 2)][j & 3];
                        ko[j] = (c < 4) ? (kv[j] * co - other * si) : (other * si + kv[j] * co); }
                    if (F.lane < 8) { v4u ow; ow.x = pk2(ko[0], ko[1]); ow.y = pk2(ko[2], ko[3]); ow.z = pk2(ko[4], ko[5]); ow.w = pk2(ko[6], ko[7]); *(GAS v4u*)(KROPE + (size_t)m * 64 + c * 8) = ow; }
                }
            }
            if (BOTH(pb + 1)) GRID_BAR();
        }
        if (PEN(3) && IN(pb + 2)) { PHASE_BEGIN(); TSTAMP_AT(pb + 2);
            pg8::Gemm g{AQKV, WUP + (size_t)l * NUP * AQ, 2 * AQ, 2 * AQ, AQ / 64}; pg8::StaticOrder So; So.init(S, NUP, F.G, (int)blockIdx.x);
            pg8::EpiBf16 E{QKVM, NUP, 1.f};
            pg8::gemm_phase<pg8::EpiBf16, pg8::StaticOrder, true, SP2V>(F.lds, g, So, E);
            if (FILLMASK & 2) FILL(pb + 2);
            if (BOTH(pb + 2)) GRID_BAR();
        }
        if (PEN(4) && IN(pb + 3)) { PHASE_BEGIN(); TSTAMP_AT(pb + 3);
            LAS float* BIAS = (LAS float*)(F.lds + BIAS_OFF);
            for (int i = F.tid; i < 3 * 6 * 129; i += NWAVES * 64) { const int b = i / (6 * 129), rem = i % (6 * 129), h = rem / 129, j = rem % 129;
                BIAS[(b * 6 + h) * 132 + j] = args.in[3][DIL_BUCKET[b][j] * 6 + h] * att::LOG2E; }
            __syncthreads();
            for (int rep = 0; rep < (REPEAT_PHASE == 4 ? 2 : 1); ++rep) {
            gu32* qhead = F.ctl + CW_QUEUE + 64 * l + 32 * rep + 4 * args.li;
            constexpr int NU_MLA = 6 * 32, NU_MEM = 4 * 32, NU_DIL = 3 * 6 * 32, NU = NU_MLA + NU_MEM + NU_DIL;
#define QPULL(u) do { if (F.tid == 0) F.MISC[16] = __hip_atomic_fetch_add(qhead, 1u, RLX_AGENT); __syncthreads(); u = (int)F.MISC[16]; __syncthreads(); } while (0)
            int u; QPULL(u);
            if ((ATT_EN & 1) && (!args.rep || (PROBE_ATT & 1))) while (u < NU_MLA) {
                const int h = u >> 5, qb = u & 31;
                att::MLA_BODY<NUP, NUP, D>(QKVM + (size_t)qb * 256 * NUP + h * 192, QKVM + UC_KV + h * 256, KROPE, QKVM + UC_KV + h * 256 + 128,
                                                        ROPECS + (size_t)qb * 256 * 64, YPRE + (size_t)qb * 256 * D + h * 128, S, 0.07216878364870322f, (LAS char*)F.lds);
                QPULL(u);
            }
            if (args.rep && !(PROBE_ATT & 1)) { while (u < NU_MLA) QPULL(u); }
            if ((ATT_EN & 2) && (!args.rep || (PROBE_ATT & 2))) while (u < NU_MLA + NU_MEM) {
                const int v = u - NU_MLA, h = v >> 5, qb = v & 31;
                const bf16* kv = MEMKV + (size_t)l * NMEM * 1024;
                att::attn_dense_body<128, DINP, 1024, D, 1>(PROJ + (size_t)qb * 256 * DINP + PC_MEM + h * 128, kv + h * 128, nullptr, kv + 512 + h * 128,
                                                            nullptr, YPRE + (size_t)qb * 256 * D + 1536 + h * 128, NMEM, 0.08838834764831845f, (LAS char*)F.lds);
                QPULL(u);
            }
            if (args.rep && !(PROBE_ATT & 2)) { while (u < NU_MLA + NU_MEM) QPULL(u); }
            if ((ATT_EN & 4) && (!args.rep || (PROBE_ATT & 4))) while (u < NU) {
                const int w = (u - NU_MLA - NU_MEM) * 8;
                const int b = w / 1536, h = (w % 1536) >> 8, tile = w & 255;
                const int d = b == 0 ? 1 : (b == 1 ? 4 : 16), nT = S / d, tpr = nT / 32;
                const int r = tile / tpr, t0 = (tile % tpr) * 32;
                LAS float* TB = (LAS float*)(F.lds + BIAS_OFF + 3 * 6 * 132 * 4);
                for (int i = F.tid; i < 4 * 196; i += NWAVES * 64) { const int k = i / 196, j = (i % 196) + k - 32; TB[i] = (j >= 0 && j <= 128) ? BIAS[(b * 6 + h) * 132 + j] : -1e30f; }
                __syncthreads();
                att::dil_wg_unit<DINP>(PROJ, PC_DIL + h * 128, PC_DIL + 768 + h * 128, PC_DIL + 1536 + h * 128, d, r, t0, nT,
                                       DILO + (size_t)b * S * 768, h * 128, DILS + (size_t)b * S * 12 + h * 2, (LAS char*)F.lds, TB, 0.08838834764831845f * att::LOG2E);
                QPULL(u);
            }
#undef QPULL
            }
            if (FILLMASK & 4) FILL(pb + 3);
            if (BOTH(pb + 3)) GRID_BAR();
        }
        if (PEN(5) && IN(pb + 4)) { PHASE_BEGIN(); TSTAMP_AT(pb + 4);
            const float* gn = args.in[12] + (size_t)l * D;
            constexpr int CR = COMB_ROWS;
            typedef decltype(ld_r4((const att::OT*)nullptr)) RawO;
            for (int m0 = F.gw; m0 < S; m0 += CR * F.NGW) {
                RawO ya[CR][3], yc[CR][2], ob[CR][3][3]; f32x2 st[CR][3][3];
#pragma unroll
                for (int r = 0; r < CR; ++r) { const int mr = m0 + r * F.NGW, m = mr < S ? mr : m0; const att::OT* yr = YPRE + (size_t)m * D;
#pragma unroll
                    for (int j = 0; j < 3; ++j) ya[r][j] = ld_r4(yr + (F.lane + 64 * j) * 4);
#pragma unroll
                    for (int j = 0; j < 2; ++j) yc[r][j] = ld_r4(yr + 1536 + (F.lane + 64 * j) * 4);
#pragma unroll
                    for (int j = 0; j < 3; ++j) { const int col = (F.lane + 64 * j) * 4, h = col >> 7;
#pragma unroll
                        for (int b = 0; b < 3; ++b) { st[r][j][b] = *(const GAS f32x2*)(DILS + ((size_t)b * S + m) * 12 + h * 2); ob[r][j][b] = ld_r4(DILO + ((size_t)b * S + m) * 768 + col); } } }
#pragma unroll
                for (int r = 0; r < CR; ++r) { const int m = m0 + r * F.NGW; if (m >= S) break;
                    f32x4 a[3]; float sa = 0.f;
#pragma unroll
                    for (int j = 0; j < 3; ++j) { a[j] = cv4(ya[r][j]); sa += (a[j].x * a[j].x + a[j].y * a[j].y) + (a[j].z * a[j].z + a[j].w * a[j].w); }
                    f32x4 c[2]; float sc = 0.f;
#pragma unroll
                    for (int j = 0; j < 2; ++j) { c[j] = cv4(yc[r][j]); sc += (c[j].x * c[j].x + c[j].y * c[j].y) + (c[j].z * c[j].z + c[j].w * c[j].w); }
                    f32x4 bq[3]; float sb = 0.f;
#pragma unroll
                    for (int j = 0; j < 3; ++j) {
                        const float M = fmaxf(st[r][j][0].x, fmaxf(st[r][j][1].x, st[r][j][2].x));
                        float wgt[3], den = 0.f;
#pragma unroll
                        for (int b = 0; b < 3; ++b) { wgt[b] = __builtin_amdgcn_exp2f(st[r][j][b].x - M); den += wgt[b] * st[r][j][b].y; }
                        const float inv = 1.f / den; f32x4 acc = {0.f, 0.f, 0.f, 0.f};
#pragma unroll
                        for (int b = 0; b < 3; ++b) acc += cv4(ob[r][j][b]) * (wgt[b] * inv);
                        bq[j] = acc; sb += (acc.x * acc.x + acc.y * acc.y) + (acc.z * acc.z + acc.w * acc.w); }
                    const float ra = 1.f / sqrtf(wave_sum(sa) * (1.f / 768.f) + EPS), rb = 1.f / sqrtf(wave_sum(sb) * (1.f / 768.f) + EPS), rc = 1.f / sqrtf(wave_sum(sc) * (1.f / 512.f) + EPS);
                    bf16* yo = Y + (size_t)m * D;
#pragma unroll
                    for (int j = 0; j < 3; ++j) { const int col = (F.lane + 64 * j) * 4; const f32x4 g = *(const GAS f32x4*)(gn + col);
                        v2u w; w.x = pk2(a[j].x * ra * g.x, a[j].y * ra * g.y); w.y = pk2(a[j].z * ra * g.z, a[j].w * ra * g.w); *(GAS v2u*)(yo + col) = w; }
#pragma unroll
                    for (int j = 0; j < 3; ++j) { const int col = (F.lane + 64 * j) * 4; const f32x4 g = *(const GAS f32x4*)(gn + 768 + col);
                        v2u w; w.x = pk2(bq[j].x * rb * g.x, bq[j].y * rb * g.y); w.y = pk2(bq[j].z * rb * g.z, bq[j].w * rb * g.w); *(GAS v2u*)(yo + 768 + col) = w; }
#pragma unroll
                    for (int j = 0; j < 2; ++j) { const int col = (F.lane + 64 * j) * 4; const f32x4 g = *(const GAS f32x4*)(gn + 1536 + col);
                        v2u w; w.x = pk2(c[j].x * rc * g.x, c[j].y * rc * g.y); w.y = pk2(c[j].z * rc * g.z, c[j].w * rc * g.w); *(GAS v2u*)(yo + 1536 + col) = w; }
                }
            }
            if (BOTH(pb + 4)) GRID_BAR();
        }
        if (PEN(6) && IN(pb + 5)) { PHASE_BEGIN(); TSTAMP_AT(pb + 5);
            pg8::Gemm g{Y, WOUT + (size_t)l * D * D, 2 * D, 2 * D, D / 64}; pg8::StaticOrder So; So.init(S, D, F.G, (int)blockIdx.x);
            pg8::EpiResF32 E{l == 0 ? x_in : XA, args.rep ? YPREF : XA, D, 1.f};
            pg8::gemm_phase<pg8::EpiResF32, pg8::StaticOrder, true, SP2V>(F.lds, g, So, E);
            if (BOTH(pb + 5)) GRID_BAR();
        }
        if (PEN(7) && IN(pb + 6)) { PHASE_BEGIN(); TSTAMP_AT(pb + 6);
            const float* gf = args.in[14] + (size_t)l * D;
#if defined(PROBE_DEADLINE)
            if (l == 1 && blockIdx.x == 0 && F.tid == 0) F.ctl[CW_CVT + 16] = __hip_atomic_load(F.ctl + CW_CVT, RLX_AGENT);
#endif
            if (l == 0) { for (int m = F.gw; m < S; m += F.NGW) { if constexpr (F8D) rms_row_to_fp8(XA + (size_t)m * D, gf, XN8 + (size_t)m * D, F.lane); else rms_row_to_bf16(XA + (size_t)m * D, gf, XN + (size_t)m * D, F.lane); } }
            else {
                const float* Wr = args.in[18];
                LAS unsigned* LC = (LAS unsigned*)F.lds;
                if (F.tid < NE) LC[F.tid] = 0u;
                LAS f32x4* WL = (LAS f32x4*)(F.lds + 1024);
                for (int i = F.tid; i < 2048 * 2; i += NWAVES * 64) { const int half = i & 1, idx = i >> 1, ln = idx & 63, jq = idx >> 6, j = jq >> 2, q = jq & 3, k = (ln + 64 * j) * 4 + q;
                    WL[i] = *(const GAS f32x4*)(Wr + (size_t)k * NE + half * 4); }
                __syncthreads();
                for (int m = F.gw; m < S; m += F.NGW) {
                    const GAS f32x4* xr = (const GAS f32x4*)(XA + (size_t)m * D) + F.lane; const GAS f32x4* gr = (const GAS f32x4*)gf + F.lane;
                    f32x4 v[8]; float s = 0.f;
#pragma unroll
                    for (int j = 0; j < 8; ++j) { v[j] = xr[64 * j]; s += (v[j].x * v[j].x + v[j].y * v[j].y) + (v[j].z * v[j].z + v[j].w * v[j].w); }
                    const float rstd = 1.f / sqrtf(wave_sum(s) * (1.f / D) + EPS);
                    float lg[8] = {0.f, 0.f, 0.f, 0.f, 0.f, 0.f, 0.f, 0.f};
                    GAS v2u* o8 = (GAS v2u*)(XN + (size_t)m * D) + F.lane; GAS unsigned* o4 = (GAS unsigned*)(XN8 + (size_t)m * D) + F.lane;
#pragma unroll
                    for (int j = 0; j < 8; ++j) { const f32x4 gg = gr[64 * j]; const f32x4 hh = {v[j].x * rstd * gg.x, v[j].y * rstd * gg.y, v[j].z * rstd * gg.z, v[j].w * rstd * gg.w};
                        if constexpr (F8M) o4[64 * j] = pk4_fp8(hh.x, hh.y, hh.z, hh.w); else { v2u w; w.x = pk2(hh.x, hh.y); w.y = pk2(hh.z, hh.w); o8[64 * j] = w; }
#pragma unroll
                        for (int q = 0; q < 4; ++q) { const f32x4 w0 = WL[(((j * 4 + q) * 64) + F.lane) * 2], w1 = WL[(((j * 4 + q) * 64) + F.lane) * 2 + 1]; const float hv = hh[q];
                            lg[0] += hv * w0.x; lg[1] += hv * w0.y; lg[2] += hv * w0.z; lg[3] += hv * w0.w; lg[4] += hv * w1.x; lg[5] += hv * w1.y; lg[6] += hv * w1.z; lg[7] += hv * w1.w; } }
#pragma unroll
                    for (int e = 0; e < NE; ++e) lg[e] = wave_sum(lg[e]);
                    int e1 = 0; float v1 = lg[0];
#pragma unroll
                    for (int e = 1; e < NE; ++e) if (lg[e] > v1) { v1 = lg[e]; e1 = e; }
                    int e2 = -1; float v2 = -3.0e38f;
#pragma unroll
                    for (int e = 0; e < NE; ++e) if (e != e1 && lg[e] > v2) { v2 = lg[e]; e2 = e; }
                    const float g1 = 1.f / (1.f + __expf(v2 - v1)), g2 = 1.f - g1;
                    if (F.lane == 0) { const unsigned s1 = __hip_atomic_fetch_add(LC + e1, 1u, __ATOMIC_RELAXED, __HIP_MEMORY_SCOPE_WORKGROUP), s2 = __hip_atomic_fetch_add(LC + e2, 1u, __ATOMIC_RELAXED, __HIP_MEMORY_SCOPE_WORKGROUP);
                        v4u r0 = {(unsigned)e1, (unsigned)e2, s1, s2}; v4u r1 = {__float_as_uint(g1), __float_as_uint(g2), 0u, 0u};
                        *(GAS v4u*)(ROUTE + (size_t)m * 8) = r0; *(GAS v4u*)(ROUTE + (size_t)m * 8 + 4) = r1; }
                }
                __syncthreads();
                if (F.tid < NE) F.ctl[CW_CNTW + blockIdx.x * NE + F.tid] = LC[F.tid];
            }
            if (BOTH(pb + 6)) GRID_BAR();
        }
        if (PEN(8) && IN(pb + 7)) { PHASE_BEGIN(); TSTAMP_AT(pb + 7);
            if (l == 1) {
                moe_cvt_fill(F, ka, -1);
#if defined(PROBE_DEADLINE)
                for (int r_ = 0; r_ < PROBE_DEADLINE; ++r_) { __syncthreads(); moe_cvt_fill(F, ka, -2); }
#endif
                { LAS unsigned* LT = (LAS unsigned*)F.lds;
                  int tot = 0, bel = 0;
                  for (int w = F.lane; w < F.G; w += 64) { const int c = (int)F.ctl[CW_CNTW + w * NE + F.wave]; tot += c; bel += (w < (int)blockIdx.x) ? c : 0; }
#pragma unroll
                  for (int o = 1; o < 64; o <<= 1) { tot += __shfl_xor(tot, o); bel += __shfl_xor(bel, o); }
                  __syncthreads();
                  if (F.lane == 0) { LT[F.wave] = (unsigned)tot; LT[NE + F.wave] = (unsigned)bel; }
                  __syncthreads(); }
                int base[NE]; int tstart = 0;
#pragma unroll
                for (int e = 0; e < NE; ++e) { const int c = (int)((LAS unsigned*)F.lds)[e]; base[e] = tstart * 256 + (int)((LAS unsigned*)F.lds)[NE + e]; const int nt = (c + 255) >> 8;
                    if (blockIdx.x == 0 && F.tid == 0) { for (int t = 0; t < nt; ++t) F.ctl[CW_TILEE + 1 + tstart + t] = (unsigned)e; }
                    tstart += nt; }
                if (blockIdx.x == 0 && F.tid == 0) F.ctl[CW_TILEE] = (unsigned)tstart;
                for (int m = F.gw; m < S; m += F.NGW) {
                    const v4u r0 = *(const GAS v4u*)(ROUTE + (size_t)m * 8);
                    int p1 = (int)r0.z, p2 = (int)r0.w;
#pragma unroll
                    for (int e = 0; e < NE; ++e) { if ((int)r0.x == e) p1 += base[e]; if ((int)r0.y == e) p2 += base[e]; }
                    if (F.lane == 0) { ROUTE[(size_t)m * 8 + 6] = (unsigned)p1; ROUTE[(size_t)m * 8 + 7] = (unsigned)p2; }
                    const unsigned char* srow = (const unsigned char*)XN8 + (size_t)m * D * EBM; unsigned char* xp = (unsigned char*)XP;
                    const GAS v4u* src = (const GAS v4u*)srow + F.lane; GAS v4u* d1 = (GAS v4u*)(xp + (size_t)p1 * D * EBM) + F.lane; GAS v4u* d2 = (GAS v4u*)(xp + (size_t)p2 * D * EBM) + F.lane;
#pragma unroll
                    for (int j = 0; j < 2 * EBM; ++j) { const v4u t = src[64 * j]; d1[64 * j] = t; d2[64 * j] = t; }
                }
            }
            if (BOTH(pb + 7) && l == 1) GRID_BAR();
        }
        if (PEN(9) && IN(pb + 8)) { PHASE_BEGIN(); TSTAMP_AT(pb + 8);
            if (l == 0) { pg8::Gemm g{XN8, WGU, D * EBD, D * EBD, D * EBD / 128}; pg8::StaticOrder So; So.init(S, 2 * DFF, F.G, (int)blockIdx.x);
                FfnEpi1<F8D> E = Epi1Maker<F8D>::make(ACT, DFF);
                pg8::gemm_phase<FfnEpi1<F8D>, pg8::StaticOrder, true, SP2V, F8D>(F.lds, g, So, E); }
            else { const int ntile = (int)__hip_atomic_load(F.ctl + CW_TILEE, RLX_AGENT);
                pg8::Gemm g{XP, MGU, D * EBM, D * EBM, D * EBM / 128}; pg8::MoeOrder So{F.G, (int)blockIdx.x, 2 * DFE / 256, ntile, 2 * DFE, (const int*)(F.ctl + CW_TILEE + 1)};
                FfnEpi1<F8M> E = Epi1Maker<F8M>::make(ACTP, DFE);
                pg8::gemm_phase<FfnEpi1<F8M>, pg8::MoeOrder, true, SP2V, F8M>(F.lds, g, So, E); }
            if (BOTH(pb + 8)) GRID_BAR();
        }
        if (PEN(10) && IN(pb + 9)) { PHASE_BEGIN(); TSTAMP_AT(pb + 9);
            if (l == 0) { pg8::Gemm g{ACT, WDN, DFF * EBD, DFF * EBD, DFF * EBD / 128}; pg8::StaticOrder So; So.init(S, D, F.G, (int)blockIdx.x);
                pg8::EpiResF32 E{XA, args.rep ? YPREF : XA, D, Sc<F8D>::dn};
                pg8::gemm_phase<pg8::EpiResF32, pg8::StaticOrder, true, SP2V, F8D>(F.lds, g, So, E); }
            else { const int ntile = (int)__hip_atomic_load(F.ctl + CW_TILEE, RLX_AGENT);
                const int pm0 = MOE_TAIL ? ((2 * F.G / 8) < ntile ? (2 * F.G / 8) : ntile) : ntile;
                { pg8::Gemm g{ACTP, MDN, DFE * EBM, DFE * EBM, DFE * EBM / 128}; pg8::MoeOrder So{F.G, (int)blockIdx.x, D / 256, pm0, D, (const int*)(F.ctl + CW_TILEE + 1)};
                  pg8::EpiBf16 E{OUTP, D, Sc<F8M>::dn};
                  pg8::gemm_phase<pg8::EpiBf16, pg8::MoeOrder, true, SP2V, F8M>(F.lds, g, So, E); }
                if (MOE_TAIL && ntile > pm0) { pg8::Gemm g{ACTP, MDN, DFE * EBM, DFE * EBM, DFE * EBM / 512}; pg8::MoeTailOrder So{F.G, (int)blockIdx.x, pm0, ntile - pm0, D, DFE * EBM / 4, (const int*)(F.ctl + CW_TILEE + 1)};
                  pg8::EpiBf16Split E{OUTQ, D, Sc<F8M>::dn, pm0, (size_t)2048 * D};
                  pg8::gemm_phase<pg8::EpiBf16Split, pg8::MoeTailOrder, true, SP2V, F8M>(F.lds, g, So, E); } }
            if (BOTH(pb + 9)) GRID_BAR();
        }
        if (PEN(11) && IN(pb + 10)) { PHASE_BEGIN(); TSTAMP_AT(pb + 10);
            if (l == 0) { for (int m = F.gw; m < S; m += F.NGW) rms_row_to_bf16(XA + (size_t)m * D, args.in[4] + D, XN + (size_t)m * D, F.lane); }
            else {
                const float* gfin = args.in[22];
                const int ntile_f = (int)__hip_atomic_load(F.ctl + CW_TILEE, RLX_AGENT); const int prow0 = (MOE_TAIL ? ((2 * F.G / 8) < ntile_f ? (2 * F.G / 8) : ntile_f) : ntile_f) * 256;
                for (int m = F.gw; m < S; m += F.NGW) {
                    const v4u r1 = *(const GAS v4u*)(ROUTE + (size_t)m * 8 + 4);
                    const float g1 = __uint_as_float(r1.x), g2 = __uint_as_float(r1.y); const int p1 = (int)r1.z, p2 = (int)r1.w;
                    const GAS f32x4* xr = (const GAS f32x4*)(XA + (size_t)m * D) + F.lane;
                    const GAS v2u* o1 = (const GAS v2u*)(OUTP + (size_t)p1 * D) + F.lane; const GAS v2u* o2 = (const GAS v2u*)(OUTP + (size_t)p2 * D) + F.lane;
                    const bool t1 = p1 >= prow0, t2 = p2 >= prow0;
                    const GAS v2u* q1 = (const GAS v2u*)(OUTQ + (size_t)(t1 ? p1 - prow0 : 0) * D) + F.lane; const GAS v2u* q2 = (const GAS v2u*)(OUTQ + (size_t)(t2 ? p2 - prow0 : 0) * D) + F.lane;
                    f32x4 v[8]; float s = 0.f;
                    if (!t1 && !t2) {
#pragma unroll
                        for (int j = 0; j < 8; ++j) { const f32x4 xv = xr[64 * j]; const v2u a = o1[64 * j], b = o2[64 * j];
                            v[j] = xv + (f32x4){bflo(a.x), bfhi(a.x), bflo(a.y), bfhi(a.y)} * g1 + (f32x4){bflo(b.x), bfhi(b.x), bflo(b.y), bfhi(b.y)} * g2;
                            s += (v[j].x * v[j].x + v[j].y * v[j].y) + (v[j].z * v[j].z + v[j].w * v[j].w); }
                    } else
#pragma unroll
                    for (int j = 0; j < 8; ++j) { const f32x4 xv = xr[64 * j]; f32x4 ea, eb;
                        if (!t1) { const v2u a = o1[64 * j]; ea = (f32x4){bflo(a.x), bfhi(a.x), bflo(a.y), bfhi(a.y)}; }
                        else { ea = (f32x4){0.f, 0.f, 0.f, 0.f};
#pragma unroll
                            for (int k = 0; k < 4; ++k) { const v2u a = q1[(size_t)k * (2048 * D / 4) + 64 * j]; ea += (f32x4){bflo(a.x), bfhi(a.x), bflo(a.y), bfhi(a.y)}; } }
                        if (!t2) { const v2u b = o2[64 * j]; eb = (f32x4){bflo(b.x), bfhi(b.x), bflo(b.y), bfhi(b.y)}; }
                        else { eb = (f32x4){0.f, 0.f, 0.f, 0.f};
#pragma unroll
                            for (int k = 0; k < 4; ++k) { const v2u b = q2[(size_t)k * (2048 * D / 4) + 64 * j]; eb += (f32x4){bflo(b.x), bfhi(b.x), bflo(b.y), bfhi(b.y)}; } }
                        v[j] = xv + ea * g1 + eb * g2;
                        s += (v[j].x * v[j].x + v[j].y * v[j].y) + (v[j].z * v[j].z + v[j].w * v[j].w); }
                    const float rstd = 1.f / sqrtf(wave_sum(s) * (1.f / D) + EPS);
                    GAS f32x4* orow = (GAS f32x4*)(args.out + (size_t)m * D) + F.lane; const GAS f32x4* gr = (const GAS f32x4*)gfin + F.lane;
#pragma unroll
                    for (int j = 0; j < 8; ++j) { const f32x4 gg = gr[64 * j]; orow[64 * j] = (f32x4){v[j].x * rstd * gg.x, v[j].y * rstd * gg.y, v[j].z * rstd * gg.z, v[j].w * rstd * gg.w}; }
                }
            }
            if (BOTH(pb + 10) && l == 0) GRID_BAR();
        }
    }
#if defined(PROBE_BARS)
    for (int i_ = 0; i_ < PROBE_BARS; ++i_) xcd_barrier<PROBE_BARMODE>(bar);
#endif
#if defined(PROBE_T)
    if (blockIdx.x == 0 && threadIdx.x == 0) { const unsigned t_end = (unsigned)__builtin_amdgcn_s_memrealtime(); volatile LAS unsigned* ts_ = (volatile LAS unsigned*)(F.lds + 131520); ts_[N_PHASES] = t_end;
#if defined(PROBE_CLK)
        ts_[32 + N_PHASES] = (unsigned)__builtin_amdgcn_s_memtime(); const unsigned dt = (ts_[32 + PROBE_T + 1] - ts_[32 + PROBE_T]) / (16u * PROBE_TK);
#else
        const unsigned dt = ts_[PROBE_T + 1] - ts_[PROBE_T];
#endif
        while ((unsigned)__builtin_amdgcn_s_memrealtime() - t_end < (unsigned)PROBE_TK * dt) __builtin_amdgcn_s_sleep(32); }
#endif
#undef IN
#undef BOTH
#undef GRID_BAR
#undef WIN
#undef WUP
#undef WMEM
#undef WOUT
#undef WGU
#undef WDN
#undef MGU
#undef MDN
#undef XN
#undef MEMN
#undef MEMKV
#undef PROJ
#undef AQKV
#undef KROPE
#undef ROPECS
#undef QKVM
#undef YPRE
#undef YPREF
#undef DILO
#undef DILS
#undef Y
#undef XA
#undef ROUTE
#undef XP
#undef OUTP
#undef OUTQ
#undef ACTP
#undef ACT
#undef x_in
#undef XN8
#undef PHASE_BEGIN
#undef args
#undef FILL
}

extern "C" void kernel_launch(void* const* d_in, const int* in_sizes, int n_in, void* d_out, int out_size, void* d_ws, size_t ws_size, hipStream_t stream) {
    static int grid = 0;
    if (grid == 0) {
        if (n_in != 23 || in_sizes[0] != S * D || out_size != S * D || ws_size < WS_END) { fprintf(stderr, "kernel_launch: shape/workspace mismatch: n_in %d in0 %d out %d ws %zu (need %zu)\n", n_in, n_in > 0 ? in_sizes[0] : -1, out_size, ws_size, (size_t)WS_END); grid = -1; return; }
        int dev = 0, cus = 0, per_cu = 0;
        if (hipGetDevice(&dev) != hipSuccess || hipDeviceGetAttribute(&cus, hipDeviceAttributeMultiprocessorCount, dev) != hipSuccess) { fprintf(stderr, "kernel_launch: device query failed\n"); grid = -1; return; }
        if (hipFuncSetAttribute((const void*)mk_fwd, hipFuncAttributeMaxDynamicSharedMemorySize, LDS_BYTES) != hipSuccess) { fprintf(stderr, "kernel_launch: hipFuncSetAttribute failed\n"); grid = -1; return; }
        if (hipOccupancyMaxActiveBlocksPerMultiprocessor(&per_cu, (const void*)mk_fwd, NWAVES * 64, LDS_BYTES) != hipSuccess || per_cu < 1) { fprintf(stderr, "kernel_launch: occupancy query reports %d workgroups per CU\n", per_cu); }
        (void)hipGetLastError();
        grid = cus;
    }
    if (grid < 0) return;
    (void)hipMemsetAsync((char*)d_ws + WS_CTL, 0, CTL_ZERO_BYTES, stream);
    Args a{};
    for (int i = 0; i < 23; ++i) a.in[i] = (const float*)d_in[i];
    a.out = (float*)d_out; a.ws = (unsigned char*)d_ws;
    for (int i = 0; i < 32; ++i) a.invf[i] = 1.0f / powf(10000.0f, (float)i / 32.0f);
    int lo[8], hi[8], rp[8], nl = 0;
#if defined(PROBE_PHASE) && PROBE_PHASE >= 0
    lo[nl] = 0; hi[nl] = PROBE_PHASE + 1; rp[nl++] = 0;
    for (int r = 0; r < PROBE_REPS; ++r) { lo[nl] = PROBE_PHASE; hi[nl] = PROBE_PHASE + 1; rp[nl++] = 1; }
    if (PROBE_PHASE + 1 < N_PHASES) { lo[nl] = PROBE_PHASE + 1; hi[nl] = N_PHASES; rp[nl++] = 0; }
#else
    if (N_LAUNCHES == N_PHASES) { nl = 0; } else { lo[0] = 0; hi[0] = N_PHASES; rp[0] = 0; nl = 1; }
#endif
    const int total = (N_LAUNCHES == N_PHASES) ? N_PHASES : nl;
    for (int li = 0; li < total; ++li) {
        if (N_LAUNCHES == N_PHASES) { a.ph_lo = li; a.ph_hi = li + 1; a.li = 0; a.rep = 0; } else { a.ph_lo = lo[li]; a.ph_hi = hi[li]; a.li = li; a.rep = rp[li]; }
        hipLaunchKernelGGL(mk_fwd, dim3(grid), dim3(NWAVES * 64), LDS_BYTES, stream, a);
        const hipError_t le = hipPeekAtLastError();
        if (le != hipSuccess) { fprintf(stderr, "kernel_launch: launch %d failed: %s\n", li, hipGetErrorName(le)); break; }
    }
}
```

```cpp
#include <hip/hip_runtime.h>
#include <cstdio>
#include <cstdint>
#include <cmath>
#include <type_traits>
#ifndef MK_N_LAUNCHES
#define MK_N_LAUNCHES 1
#endif
#define REPEAT_PHASE -1
#define FFN_FP8 3
#define PROBE_PHASE -1
#define PROBE_REPS 3
#define FILLMASK 13
#define MLA_DMA 0
#define PROBE_ATT 7
#define GEMM_SP2 1
#define BAR_FLAGS 2
#define PRE_ROWS 4
#define COMB_ROWS 2
#define CVT_CHUNK 32
#define CONV_WGS 1
#define NCV_G 28
#define NCV_U 64
#define NCV_T 64
#define NCV_A 48
#define XA_BF16 0
#define ATT_OBF16 1
#define MOE_TAIL 1
#define CVT_REG 0
#define CVT_BYTE_T 1
#define CVT_FIRST 1
#define CVT_Q0 8
namespace pg8 {
#define PG8_LAS __attribute__((address_space(3)))
typedef unsigned short bf16_t;
typedef short bf16x8 __attribute__((ext_vector_type(8)));
typedef float f32x4 __attribute__((ext_vector_type(4)));
typedef unsigned u32x4 __attribute__((ext_vector_type(4)));
constexpr int BM = 256, BK = 64, HALF = 128, HTB = HALF * BK * 2  , STAGE_BYTES = 8 * HTB, NXCD = 8, WGM = 8;

__host__ __device__ __forceinline__ int lds_byte(int r, int c) { const int st = (r >> 4) * 2 + (c >> 5), rr = r & 15, cc = c & 31, ob = rr * 64 + cc * 2; return st * 1024 + (ob ^ (((ob >> 9) & 1) << 5)); }
__host__ __device__ __forceinline__ void stage_rc(int b, int& R, int& C) { const int st = b / 1024, sb = b % 1024, swz = sb ^ (((sb >> 9) & 1) << 5); R = (st >> 1) * 16 + swz / 64; C = (st & 1) * 32 + (swz % 64) / 2; }
__host__ __device__ __forceinline__ int perm32(int rho) { const int n = rho >> 4, i = rho & 15; return 8 * (i >> 2) + 4 * n + (i & 3); }

struct Unit { int pm, pn; };
struct Gemm { const void* A; const void* Bt; int lda, ldb, nt; };

struct StaticOrder {
    int nM, nN, nwg, G, c;
    __device__ void init(int M, int N, int G_, int c_) { nM = M / BM; nN = N / BM; nwg = nM * nN; G = G_; c = c_; }
    __device__ bool next(int i, Unit& u) const {
        const long L = (long)i * G + c; if (L >= nwg) return false;
        int wgid = (int)L; { const int q = nwg / NXCD, r = nwg % NXCD, xcd = wgid % NXCD, off = wgid / NXCD; wgid = (xcd < r ? xcd * (q + 1) : r * (q + 1) + (xcd - r) * q) + off; }
        const int nig = WGM * nN, gid = wgid / nig, fm = gid * WGM, gsz = (nM - fm) < WGM ? (nM - fm) : WGM;
        u.pm = fm + ((wgid % nig) % gsz); u.pn = (wgid % nig) / gsz; return true;
    }
    __device__ __forceinline__ const char* abase(const Gemm& g, const Unit& u) const { return (const char*)g.A + (size_t)u.pm * BM * g.lda; }
    __device__ __forceinline__ const char* bbase(const Gemm& g, const Unit& u) const { return (const char*)g.Bt + (size_t)u.pn * BM * g.ldb; }
};
struct InProjOrder {
    StaticOrder so; int nextra; const void* A2; const void* B2;
    __device__ bool next(int i, Unit& u) const { if (so.next(i, u)) return true; const long L = (long)i * so.G + so.c - so.nwg; if (L < 0 || L >= nextra) return false; u.pm = 32 + (int)(L >> 2); u.pn = (int)(L & 3); return true; }
    __device__ __forceinline__ const char* abase(const Gemm& g, const Unit& u) const { return u.pm < 32 ? (const char*)g.A + (size_t)u.pm * BM * g.lda : (const char*)A2 + (size_t)(u.pm - 32) * BM * g.lda; }
    __device__ __forceinline__ const char* bbase(const Gemm& g, const Unit& u) const { return u.pm < 32 ? (const char*)g.Bt + (size_t)u.pn * BM * g.ldb : (const char*)B2 + (size_t)((u.pm - 32) * 1024 + u.pn * BM) * g.ldb; }
};
struct MemOrder {
    int G, c;
    __device__ bool next(int i, Unit& u) const { const int L = c - (G - 8); if (i != 0 || L < 0 || L >= 8) return false; u.pm = L >> 2; u.pn = L & 3; return true; }
    __device__ __forceinline__ const char* abase(const Gemm& g, const Unit& u) const { return (const char*)g.A + (size_t)u.pm * BM * g.lda; }
    __device__ __forceinline__ const char* bbase(const Gemm& g, const Unit& u) const { return (const char*)g.Bt + (size_t)(u.pm * 1024 + u.pn * BM) * g.ldb; }
};
struct MoeOrder {
    int G, c, nN, ntile, nexp_rows; const int* tile_e;
    __device__ bool next(int i, Unit& u) const { const long L = (long)i * G + c; if (L >= (long)ntile * nN) return false; u.pm = (int)(L / nN); u.pn = (int)(L % nN); return true; }
    __device__ __forceinline__ const char* abase(const Gemm& g, const Unit& u) const { return (const char*)g.A + (size_t)u.pm * BM * g.lda; }
    __device__ __forceinline__ const char* bbase(const Gemm& g, const Unit& u) const { const int e = __builtin_amdgcn_readfirstlane(tile_e[u.pm]); return (const char*)g.Bt + ((size_t)e * nexp_rows + (size_t)u.pn * BM) * g.ldb; }
};

struct MoeTailOrder {
    int G, c, pm0, ntail, nexp_rows, kq_bytes; const int* tile_e;
    __device__ bool next(int i, Unit& u) const { const long L = (long)i * G + c; if (L >= (long)ntail * 32) return false; const int ks = (int)(L & 3), rest = (int)(L >> 2); u.pm = pm0 + (rest >> 3); u.pn = (rest & 7) + 8 * ks; return true; }
    __device__ __forceinline__ const char* abase(const Gemm& g, const Unit& u) const { return (const char*)g.A + (size_t)u.pm * BM * g.lda + (size_t)(u.pn >> 3) * kq_bytes; }
    __device__ __forceinline__ const char* bbase(const Gemm& g, const Unit& u) const { const int e = __builtin_amdgcn_readfirstlane(tile_e[u.pm]); return (const char*)g.Bt + ((size_t)e * nexp_rows + (size_t)(u.pn & 7) * BM) * g.ldb + (size_t)(u.pn >> 3) * kq_bytes; }
};

__device__ __forceinline__ unsigned cvt_pk_bf16(float lo, float hi) { unsigned r; asm volatile("v_cvt_pk_bf16_f32 %0, %1, %2" : "=v"(r) : "v"(lo), "v"(hi)); return r; }

struct EpiBf16 {
    static constexpr bool PERM = true;
    bf16_t* O; int ldc; float sc;
    __device__ __forceinline__ void operator()(const f32x4 (&acc)[2][2][4][2], const Unit& u, int wr, int wc, int fr, int fq) const {
        const int row0 = u.pm * BM + wr * 64 + fr, col0 = u.pn * BM + wc * 32 + 8 * fq;
#pragma unroll
        for (int ai = 0; ai < 2; ++ai)
#pragma unroll
            for (int m = 0; m < 4; ++m) { bf16_t* rowp = O + (size_t)(row0 + ai * HALF + m * 16) * ldc + col0;
#pragma unroll
                for (int bj = 0; bj < 2; ++bj) { const f32x4 v0 = acc[ai][bj][m][0] * sc, v1 = acc[ai][bj][m][1] * sc;
                    u32x4 w; w.x = cvt_pk_bf16(v0[0], v0[1]); w.y = cvt_pk_bf16(v0[2], v0[3]); w.z = cvt_pk_bf16(v1[0], v1[1]); w.w = cvt_pk_bf16(v1[2], v1[3]);
                    *(u32x4*)(rowp + bj * HALF) = w; } }
    }
};
struct EpiBf16Split {
    static constexpr bool PERM = true;
    bf16_t* O; int ldc; float sc; int pm0; size_t qstride;
    __device__ __forceinline__ void operator()(const f32x4 (&acc)[2][2][4][2], const Unit& u, int wr, int wc, int fr, int fq) const {
        const int row0 = (u.pm - pm0) * BM + wr * 64 + fr, col0 = (u.pn & 7) * BM + wc * 32 + 8 * fq; bf16_t* base = O + (size_t)(u.pn >> 3) * qstride;
#pragma unroll
        for (int ai = 0; ai < 2; ++ai)
#pragma unroll
            for (int m = 0; m < 4; ++m) { bf16_t* rowp = base + (size_t)(row0 + ai * HALF + m * 16) * ldc + col0;
#pragma unroll
                for (int bj = 0; bj < 2; ++bj) { const f32x4 v0 = acc[ai][bj][m][0] * sc, v1 = acc[ai][bj][m][1] * sc;
                    u32x4 w; w.x = cvt_pk_bf16(v0[0], v0[1]); w.y = cvt_pk_bf16(v0[2], v0[3]); w.z = cvt_pk_bf16(v1[0], v1[1]); w.w = cvt_pk_bf16(v1[2], v1[3]);
                    *(u32x4*)(rowp + bj * HALF) = w; } }
    }
};
struct EpiBf16Sel {
    static constexpr bool PERM = true;
    bf16_t* O; int ldc; bf16_t* O2; int ldc2;
    __device__ __forceinline__ void operator()(const f32x4 (&acc)[2][2][4][2], const Unit& u, int wr, int wc, int fr, int fq) const {
        const bool ex = u.pm >= 32; bf16_t* base = ex ? O2 : O; const int ld = ex ? ldc2 : ldc;
        const int row0 = (ex ? u.pm - 32 : u.pm) * BM + wr * 64 + fr, col0 = u.pn * BM + wc * 32 + 8 * fq;
#pragma unroll
        for (int ai = 0; ai < 2; ++ai)
#pragma unroll
            for (int m = 0; m < 4; ++m) { bf16_t* rowp = base + (size_t)(row0 + ai * HALF + m * 16) * ld + col0;
#pragma unroll
                for (int bj = 0; bj < 2; ++bj) { const f32x4 v0 = acc[ai][bj][m][0], v1 = acc[ai][bj][m][1];
                    u32x4 w; w.x = cvt_pk_bf16(v0[0], v0[1]); w.y = cvt_pk_bf16(v0[2], v0[3]); w.z = cvt_pk_bf16(v1[0], v1[1]); w.w = cvt_pk_bf16(v1[2], v1[3]);
                    *(u32x4*)(rowp + bj * HALF) = w; } }
    }
};
struct EpiResF32 {
    static constexpr bool PERM = false;
    const float* R; float* C; int ldc; float sc;
    __device__ __forceinline__ void operator()(const f32x4 (&acc)[2][2][4][2], const Unit& u, int wr, int wc, int fr, int fq) const {
        const int row0 = u.pm * BM + wr * 64 + fr, col0 = u.pn * BM + wc * 32 + 4 * fq;
#pragma unroll
        for (int ai = 0; ai < 2; ++ai)
#pragma unroll
            for (int m = 0; m < 4; ++m) { const size_t off = (size_t)(row0 + ai * HALF + m * 16) * ldc + col0;
#pragma unroll
                for (int bj = 0; bj < 2; ++bj)
#pragma unroll
                    for (int n = 0; n < 2; ++n) { const f32x4 r = *(const f32x4*)(R + off + bj * HALF + n * 16); *(f32x4*)(C + off + bj * HALF + n * 16) = r + acc[ai][bj][m][n] * sc; } }
    }
};
__device__ __forceinline__ float silu_mul(float g, float u) { return g * u * __builtin_amdgcn_rcpf(1.0f + __builtin_amdgcn_exp2f(-1.4426950408889634f * g)); }
struct EpiSwiGLU {
    static constexpr bool PERM = true;
    bf16_t* O; int ldc;
    __device__ __forceinline__ void operator()(const f32x4 (&acc)[2][2][4][2], const Unit& u, int wr, int wc, int fr, int fq) const {
        const int row0 = u.pm * BM + wr * 64 + fr, col0 = u.pn * HALF + wc * 32 + 8 * fq;
#pragma unroll
        for (int ai = 0; ai < 2; ++ai)
#pragma unroll
            for (int m = 0; m < 4; ++m) { bf16_t* rowp = O + (size_t)(row0 + ai * HALF + m * 16) * ldc + col0;
                const f32x4 g0 = acc[ai][0][m][0], g1 = acc[ai][0][m][1], u0 = acc[ai][1][m][0], u1 = acc[ai][1][m][1];
                u32x4 w; w.x = cvt_pk_bf16(silu_mul(g0[0], u0[0]), silu_mul(g0[1], u0[1])); w.y = cvt_pk_bf16(silu_mul(g0[2], u0[2]), silu_mul(g0[3], u0[3]));
                w.z = cvt_pk_bf16(silu_mul(g1[0], u1[0]), silu_mul(g1[1], u1[1])); w.w = cvt_pk_bf16(silu_mul(g1[2], u1[2]), silu_mul(g1[3], u1[3]));
                *(u32x4*)rowp = w; }
    }
};

typedef int v8i_t __attribute__((ext_vector_type(8)));
__device__ __forceinline__ v8i_t pg8_cat(bf16x8 lo, bf16x8 hi) { typedef int v4i_t __attribute__((ext_vector_type(4))); const v4i_t a = __builtin_bit_cast(v4i_t, lo), b = __builtin_bit_cast(v4i_t, hi); return (v8i_t){a.x, a.y, a.z, a.w, b.x, b.y, b.z, b.w}; }
struct EpiSwiGLU8 {
    static constexpr bool PERM = true;
    unsigned char* O; int ldc; float sc_in, sc_out;
    __device__ __forceinline__ void operator()(const f32x4 (&acc)[2][2][4][2], const Unit& u, int wr, int wc, int fr, int fq) const {
        const int row0 = u.pm * BM + wr * 64 + fr, col0 = u.pn * HALF + wc * 32 + 8 * fq;
#pragma unroll
        for (int ai = 0; ai < 2; ++ai)
#pragma unroll
            for (int m = 0; m < 4; ++m) { unsigned char* rowp = O + (size_t)(row0 + ai * HALF + m * 16) * ldc + col0;
                const f32x4 g0 = acc[ai][0][m][0] * sc_in, g1 = acc[ai][0][m][1] * sc_in, u0 = acc[ai][1][m][0] * (sc_in * sc_out), u1 = acc[ai][1][m][1] * (sc_in * sc_out);
                int w0 = 0, w1 = 0;
                w0 = __builtin_amdgcn_cvt_pk_fp8_f32(silu_mul(g0[0], u0[0]), silu_mul(g0[1], u0[1]), w0, false); w0 = __builtin_amdgcn_cvt_pk_fp8_f32(silu_mul(g0[2], u0[2]), silu_mul(g0[3], u0[3]), w0, true);
                w1 = __builtin_amdgcn_cvt_pk_fp8_f32(silu_mul(g1[0], u1[0]), silu_mul(g1[1], u1[1]), w1, false); w1 = __builtin_amdgcn_cvt_pk_fp8_f32(silu_mul(g1[2], u1[2]), silu_mul(g1[3], u1[3]), w1, true);
                typedef int v2i_t __attribute__((ext_vector_type(2))); *(v2i_t*)rowp = (v2i_t){w0, w1}; }
    }
};
__device__ __forceinline__ void pg8_mfma8(f32x4& c, v8i_t a, v8i_t b, int sc) { asm volatile("v_mfma_scale_f32_16x16x128_f8f6f4 %0, %1, %2, %0, %3, %3 op_sel_hi:[0,0,0]" : "+v"(c) : "v"(a), "v"(b), "v"(sc)); }
template <class Epi, class Sched, bool ALIGN_EPI = false, bool SP2 = false, bool FP8 = false>
__device__ __forceinline__ void gemm_phase(PG8_LAS unsigned char* lds, const Gemm g, const Sched& S, const Epi& E) {
    int tid_ = threadIdx.x; asm volatile("" : "+v"(tid_));
    const int tid = tid_, wid = __builtin_amdgcn_readfirstlane(tid >> 6), lane = tid & 63, wr = wid >> 2, wc = wid & 3, fr = lane & 15, fq = lane >> 4;
    const int nt = g.nt;
    unsigned voffA[2], voffB[2];
#pragma unroll
    for (int i = 0; i < 2; ++i) { int R, C; stage_rc(tid * 16 + i * 8192, R, C); const int Rb = Epi::PERM ? ((R & ~31) + perm32(R & 31)) : R;
        voffA[i] = (unsigned)(R * g.lda + C * 2); voffB[i] = (unsigned)(Rb * g.ldb + C * 2); }
    const size_t kstep = (size_t)(BK * 2);
    const size_t hstepA = (size_t)HALF * g.lda, hstepB = (size_t)HALF * g.ldb;
    const unsigned ldsw = (unsigned)wid * 1024u;
    const int aoff = lds_byte(wr * 64 + fr, fq * 8), boff = lds_byte(wc * 32 + fr, fq * 8);
#define PG8_SA(b, h) (((b) * 2 + (h)) * HTB)
#define PG8_SB(b, h) ((4 + (b) * 2 + (h)) * HTB)
#define PG8_STAGE(bufoff, gbase, voff) do { _Pragma("unroll") for (int _i = 0; _i < 2; ++_i) \
        __builtin_amdgcn_global_load_lds((const unsigned*)((const char*)(gbase) + (voff)[_i]), (PG8_LAS unsigned*)(lds + (bufoff) + ldsw + _i * 8192), 16, 0, 0); } while (0)
#define PG8_LDA(dst, b, h) do { _Pragma("unroll") for (int m = 0; m < 4; ++m) _Pragma("unroll") for (int k = 0; k < 2; ++k) dst[m][k] = *(const PG8_LAS bf16x8*)(lds + PG8_SA(b, h) + aoff + m * 2048 + k * 1024); } while (0)
#define PG8_LDB(dst, b, h) do { _Pragma("unroll") for (int n = 0; n < 2; ++n) _Pragma("unroll") for (int k = 0; k < 2; ++k) dst[n][k] = *(const PG8_LAS bf16x8*)(lds + PG8_SB(b, h) + boff + n * 2048 + k * 1024); } while (0)
#define PG8_MMA(ai, bj, At, Bt) do { __builtin_amdgcn_s_setprio(1); if constexpr (FP8) { _Pragma("unroll") for (int m = 0; m < 4; ++m) _Pragma("unroll") for (int n = 0; n < 2; ++n) \
        pg8_mfma8(acc[ai][bj][m][n], pg8_cat(Bt[n][0], Bt[n][1]), pg8_cat(At[m][0], At[m][1]), sc8); } else { \
        _Pragma("unroll") for (int m = 0; m < 4; ++m) _Pragma("unroll") for (int n = 0; n < 2; ++n) _Pragma("unroll") for (int k = 0; k < 2; ++k) \
        acc[ai][bj][m][n] = __builtin_amdgcn_mfma_f32_16x16x32_bf16(Bt[n][k], At[m][k], acc[ai][bj][m][n], 0, 0, 0); } __builtin_amdgcn_s_setprio(0); } while (0)
#define PG8_WAIT_V(n) asm volatile("s_waitcnt vmcnt(" #n ")" ::: "memory")
#define PG8_WAIT_L(n) asm volatile("s_waitcnt lgkmcnt(" #n ")" ::: "memory")
#define PG8_BAR __builtin_amdgcn_s_barrier()
#define PG8_SCHED __builtin_amdgcn_sched_barrier(0)
    Unit cur, nxt; int ui = 0;
    if (!S.next(0, cur)) return;
    int sc8 = 0x7F7F7F7F; asm volatile("" : "+v"(sc8));
    f32x4 acc[2][2][4][2];
#pragma unroll
    for (int a = 0; a < 2; ++a)
#pragma unroll
        for (int b = 0; b < 2; ++b)
#pragma unroll
            for (int m = 0; m < 4; ++m)
#pragma unroll
                for (int n = 0; n < 2; ++n) acc[a][b][m][n] = (f32x4){0.f, 0.f, 0.f, 0.f};
    bf16x8 At[4][2], B0[2][2], B1[2][2];
    const char* cA = S.abase(g, cur); const char* cB = S.bbase(g, cur);
    if constexpr (SP2) {
        PG8_STAGE(PG8_SB(0, 0), cB, voffB); PG8_STAGE(PG8_SB(0, 1), cB + hstepB, voffB); PG8_STAGE(PG8_SA(0, 0), cA, voffA); PG8_STAGE(PG8_SA(0, 1), cA + hstepA, voffA);
        if (wr == 1) PG8_BAR;
        PG8_WAIT_V(2); PG8_BAR;
        PG8_STAGE(PG8_SB(1, 0), cB + kstep, voffB); PG8_STAGE(PG8_SA(1, 0), cA + kstep, voffA); PG8_STAGE(PG8_SB(1, 1), cB + hstepB + kstep, voffB);
        PG8_WAIT_V(6); PG8_BAR;
    } else {
        PG8_STAGE(PG8_SB(0, 0), cB, voffB); PG8_STAGE(PG8_SA(0, 0), cA, voffA); PG8_STAGE(PG8_SB(0, 1), cB + hstepB, voffB); PG8_STAGE(PG8_SA(0, 1), cA + hstepA, voffA);
        if (wr == 1) PG8_BAR;
        PG8_WAIT_V(4); PG8_BAR;
        PG8_STAGE(PG8_SB(1, 0), cB + kstep, voffB); PG8_STAGE(PG8_SA(1, 0), cA + kstep, voffA); PG8_STAGE(PG8_SB(1, 1), cB + hstepB + kstep, voffB);
        PG8_WAIT_V(6); PG8_BAR;
    }
    for (;;) {
        const bool has_next = S.next(ui + 1, nxt);
        const char* nA = has_next ? S.abase(g, nxt) : cA; const char* nB = has_next ? S.bbase(g, nxt) : cB;
        for (int t = 0; t < nt; t += 2) {
            const bool last = (t == nt - 2);
            const char* a1 = cA + (size_t)(t + 1) * kstep;
            const char* a2 = last ? nA : cA + (size_t)(t + 2) * kstep; const char* b2 = last ? nB : cB + (size_t)(t + 2) * kstep;
            const char* a3 = a2 + kstep; const char* b3 = b2 + kstep;
            if constexpr (SP2) {
            PG8_LDB(B0, 0, 0); PG8_LDB(B1, 0, 1); PG8_SCHED; PG8_LDA(At, 0, 0); PG8_STAGE(PG8_SA(1, 1), a1 + hstepA, voffA);
            PG8_WAIT_V(8); PG8_WAIT_L(0); PG8_BAR; PG8_MMA(0, 0, At, B0); PG8_MMA(0, 1, At, B1); PG8_BAR; PG8_SCHED;
            PG8_LDA(At, 0, 1); PG8_STAGE(PG8_SB(0, 0), b2, voffB); PG8_STAGE(PG8_SB(0, 1), b2 + hstepB, voffB); PG8_STAGE(PG8_SA(0, 0), a2, voffA);
            PG8_WAIT_V(8); PG8_WAIT_L(0); PG8_BAR; PG8_MMA(1, 0, At, B0); PG8_MMA(1, 1, At, B1); PG8_BAR; PG8_SCHED;
            PG8_LDB(B0, 1, 0); PG8_LDB(B1, 1, 1); PG8_SCHED; PG8_LDA(At, 1, 0); PG8_STAGE(PG8_SA(0, 1), a2 + hstepA, voffA);
            PG8_WAIT_V(8); PG8_WAIT_L(0); PG8_BAR; PG8_MMA(0, 0, At, B0); PG8_MMA(0, 1, At, B1); PG8_BAR; PG8_SCHED;
            PG8_LDA(At, 1, 1); PG8_STAGE(PG8_SB(1, 0), b3, voffB); PG8_STAGE(PG8_SB(1, 1), b3 + hstepB, voffB); PG8_STAGE(PG8_SA(1, 0), a3, voffA);
            PG8_WAIT_V(8); PG8_WAIT_L(0); PG8_BAR; PG8_MMA(1, 0, At, B0); PG8_MMA(1, 1, At, B1); PG8_BAR; PG8_SCHED;
            } else {
            PG8_LDB(B0, 0, 0); PG8_SCHED; PG8_LDA(At, 0, 0); PG8_STAGE(PG8_SA(1, 1), a1 + hstepA, voffA);
            PG8_WAIT_L(8); PG8_BAR; PG8_WAIT_L(0); PG8_MMA(0, 0, At, B0); PG8_BAR; PG8_SCHED;
            PG8_LDB(B1, 0, 1); PG8_STAGE(PG8_SB(0, 0), b2, voffB);
            PG8_BAR; PG8_WAIT_L(0); PG8_MMA(0, 1, At, B1); PG8_BAR;
            PG8_LDA(At, 0, 1); PG8_STAGE(PG8_SA(0, 0), a2, voffA);
            PG8_BAR; PG8_WAIT_L(0); PG8_MMA(1, 0, At, B0); PG8_BAR; PG8_SCHED;
            PG8_STAGE(PG8_SB(0, 1), b2 + hstepB, voffB);
            PG8_WAIT_V(6); PG8_BAR; PG8_MMA(1, 1, At, B1); PG8_BAR;
            PG8_LDB(B0, 1, 0); PG8_SCHED; PG8_LDA(At, 1, 0); PG8_STAGE(PG8_SA(0, 1), a2 + hstepA, voffA);
            PG8_WAIT_L(8); PG8_BAR; PG8_WAIT_L(0); PG8_MMA(0, 0, At, B0); PG8_BAR; PG8_SCHED;
            PG8_LDB(B1, 1, 1); PG8_STAGE(PG8_SB(1, 0), b3, voffB);
            PG8_BAR; PG8_WAIT_L(0); PG8_MMA(0, 1, At, B1); PG8_BAR;
            PG8_LDA(At, 1, 1); PG8_STAGE(PG8_SA(1, 0), a3, voffA);
            PG8_BAR; PG8_WAIT_L(0); PG8_MMA(1, 0, At, B0); PG8_BAR; PG8_SCHED;
            PG8_STAGE(PG8_SB(1, 1), b3 + hstepB, voffB);
            PG8_WAIT_V(6); PG8_BAR; PG8_MMA(1, 1, At, B1); PG8_BAR;
            }
        }
        if constexpr (ALIGN_EPI) { if (wr == 0) PG8_BAR; }
        if constexpr (FP8) { PG8_SCHED; asm volatile("s_nop 15\n\ts_nop 7" ::: "memory"); PG8_SCHED; }
        E(acc, cur, wr, wc, fr, fq);
        if (!has_next) break;
#pragma unroll
        for (int a = 0; a < 2; ++a)
#pragma unroll
            for (int b = 0; b < 2; ++b)
#pragma unroll
                for (int m = 0; m < 4; ++m)
#pragma unroll
                    for (int n = 0; n < 2; ++n) acc[a][b][m][n] = (f32x4){0.f, 0.f, 0.f, 0.f};
        cur = nxt; cA = nA; cB = nB; ++ui;
        if constexpr (ALIGN_EPI) { if (wr == 1) PG8_BAR; }
    }
    PG8_WAIT_V(0);
    if constexpr (!ALIGN_EPI) { if (wr == 0) PG8_BAR; }
    PG8_BAR;
#undef PG8_SA
#undef PG8_SB
#undef PG8_STAGE
#undef PG8_LDA
#undef PG8_LDB
#undef PG8_MMA
#undef PG8_WAIT_V
#undef PG8_WAIT_L
#undef PG8_BAR
#undef PG8_SCHED
}
}
namespace att {
#define ATT_LAS __attribute__((address_space(3)))
#define ATT_GAS __attribute__((address_space(1)))
typedef unsigned short bf16;
using bf16x8 = __attribute__((ext_vector_type(8))) short;
using s16x4  = __attribute__((ext_vector_type(4))) short;
using f32x16 = __attribute__((ext_vector_type(16))) float;
using f32x4  = __attribute__((ext_vector_type(4))) float;
using u32x4  = __attribute__((ext_vector_type(4))) unsigned;
constexpr int NW = 8, QBLK = 32, KVBLK = 64, DV = 128;
constexpr float LOG2E = 1.4426950408889634f;
#if defined(ATT_OBF16) && ATT_OBF16
typedef unsigned short OT;
#else
typedef float OT;
#endif
#define SBAR() __builtin_amdgcn_sched_barrier(0)
__device__ __forceinline__ int crow(int r, int hi) { return (r & 3) + 8 * (r >> 2) + 4 * hi; }
__device__ __forceinline__ unsigned cvtpk(float lo, float hi) { unsigned r; asm volatile("v_cvt_pk_bf16_f32 %0, %1, %2" : "=v"(r) : "v"(lo), "v"(hi)); return r; }
__device__ __forceinline__ float bf2f(short s) { return __uint_as_float(((unsigned)(unsigned short)s) << 16); }
__device__ __forceinline__ void st_o(float* p, float v) { *p = v; }
__device__ __forceinline__ void st_o(unsigned short* p, float v) { *p = (unsigned short)(cvtpk(v, v) & 0xffffu); }

__device__ __forceinline__ void partialSM(f32x16& p0, f32x16& p1, float& m_reg, float& mn, float& alpha, const float C, const float THRS) {
  float pmax = p0[0];
#pragma unroll
  for (int r = 1; r < 16; ++r) pmax = fmaxf(pmax, p0[r]);
#pragma unroll
  for (int r = 0; r < 16; ++r) pmax = fmaxf(pmax, p1[r]);
  { auto rr = __builtin_amdgcn_permlane32_swap(__float_as_uint(pmax), __float_as_uint(pmax), false, false);
    pmax = fmaxf(__uint_as_float(rr[0]), __uint_as_float(rr[1])); }
  if (__builtin_expect(__all(pmax - m_reg <= THRS), 1)) { mn = m_reg; alpha = 1.f; }
  else { mn = fmaxf(m_reg, pmax); alpha = __builtin_amdgcn_exp2f((m_reg - mn) * C); m_reg = mn; }
  float mnC = -mn * C;
#pragma unroll
  for (int r = 0; r < 16; ++r) p0[r] = fmaf(p0[r], C, mnC);
#pragma unroll
  for (int r = 0; r < 16; ++r) p1[r] = fmaf(p1[r], C, mnC);
#pragma unroll
  for (int r = 0; r < 16; ++r) p0[r] = __builtin_amdgcn_exp2f(p0[r]);
}
#define ATT_PK4(P, BASE, OUT) do { unsigned a0 = cvtpk(P[BASE + 0], P[BASE + 1]), a1 = cvtpk(P[BASE + 2], P[BASE + 3]);   \
    unsigned b0 = cvtpk(P[BASE + 4], P[BASE + 5]), b1 = cvtpk(P[BASE + 6], P[BASE + 7]);                              \
    auto r0 = __builtin_amdgcn_permlane32_swap(a0, b0, false, false); auto r1 = __builtin_amdgcn_permlane32_swap(a1, b1, false, false); \
    u32x4 w = {r0[0], r1[0], r0[1], r1[1]}; OUT = *reinterpret_cast<bf16x8*>(&w); } while (0)
__device__ __forceinline__ void finishSM(f32x16& p0, f32x16& p1, float alpha, float& l_reg, bf16x8& pa0, bf16x8& pa1, bf16x8& pa2, bf16x8& pa3) {
#pragma unroll
  for (int r = 0; r < 16; ++r) p1[r] = __builtin_amdgcn_exp2f(p1[r]);
  float ps = 0;
#pragma unroll
  for (int r = 0; r < 16; ++r) ps += p0[r];
#pragma unroll
  for (int r = 0; r < 16; ++r) ps += p1[r];
  { auto rr = __builtin_amdgcn_permlane32_swap(__float_as_uint(ps), __float_as_uint(ps), false, false);
    ps = __uint_as_float(rr[0]) + __uint_as_float(rr[1]); }
  l_reg = l_reg * alpha + ps;
  ATT_PK4(p0, 0, pa0); ATT_PK4(p0, 8, pa1); ATT_PK4(p1, 0, pa2); ATT_PK4(p1, 8, pa3);
}
template <int RB> __device__ __forceinline__ int kswz(int row, int colB) { return row * RB + (colB ^ ((row & 7) << 4)); }
template <int DQK> __device__ __forceinline__ void qkt(f32x16& p0, f32x16& p1, const ATT_LAS char* Ks, const bf16x8 (&qr)[DQK / 16], int r32, int hi) {
  p0 = f32x16{}; p1 = f32x16{};
#pragma unroll
  for (int d0 = 0; d0 < DQK / 16; ++d0) { const int cb = (d0 * 16 + hi * 8) * 2;
    bf16x8 b0 = *reinterpret_cast<const ATT_LAS bf16x8*>(Ks + kswz<DQK * 2>(r32, cb));
    bf16x8 b1 = *reinterpret_cast<const ATT_LAS bf16x8*>(Ks + kswz<DQK * 2>(32 + r32, cb));
    p0 = __builtin_amdgcn_mfma_f32_32x32x16_bf16(b0, qr[d0], p0, 0, 0, 0);
    p1 = __builtin_amdgcn_mfma_f32_32x32x16_bf16(b1, qr[d0], p1, 0, 0, 0); }
}
__device__ __forceinline__ void qkt192_lq(f32x16& p0, f32x16& p1, const ATT_LAS char* Ks, const bf16x8 (&qr)[8], const ATT_LAS char* Qs, int lane, int r32, int hi) {
  p0 = f32x16{}; p1 = f32x16{};
#pragma unroll
  for (int d0 = 0; d0 < 12; ++d0) { const int cb = (d0 * 16 + hi * 8) * 2;
    bf16x8 b0 = *reinterpret_cast<const ATT_LAS bf16x8*>(Ks + kswz<384>(r32, cb));
    bf16x8 b1 = *reinterpret_cast<const ATT_LAS bf16x8*>(Ks + kswz<384>(32 + r32, cb));
    const bf16x8 q = d0 < 8 ? qr[d0 < 8 ? d0 : 0] : *reinterpret_cast<const ATT_LAS bf16x8*>(Qs + ((d0 - 8) * 64 + lane) * 16);
    p0 = __builtin_amdgcn_mfma_f32_32x32x16_bf16(b0, q, p0, 0, 0, 0);
    p1 = __builtin_amdgcn_mfma_f32_32x32x16_bf16(b1, q, p1, 0, 0, 0); }
}
__device__ __forceinline__ int v_st(int k, int c) { const int kk = (k & ~0xC) | ((k & 4) << 1) | ((k & 8) >> 1); return ((kk >> 3) * 4 + (c >> 5)) * 512 + ((kk & 7) * 32 + (c & 31)) * 2; }
__device__ __forceinline__ int v_rd_base(int lane) { return ((lane & 3) << 3) | (((lane >> 2) & 3) << 6) | (((lane >> 4) & 1) << 5) | (((lane >> 5) & 1) << 8); }
constexpr int v_rd_off(int d0, int ks, int half) { return d0 * 512 + ks * 4096 + half * 2048; }
template <int OFF> __device__ __forceinline__ s16x4 tr_read(int vb) {
  s16x4 r; asm volatile("ds_read_b64_tr_b16 %0, %1 offset:%2" : "=&v"(r) : "v"(vb), "i"(OFF) : "memory"); return r;
}
#define ATT_PK(L, H) (bf16x8){L[0], L[1], L[2], L[3], H[0], H[1], H[2], H[3]}
template <int D0> __device__ __forceinline__ void pv_one(f32x16& od, int vb, bf16x8 pa0, bf16x8 pa1, bf16x8 pa2, bf16x8 pa3) {
  const s16x4 l0 = tr_read<v_rd_off(D0, 0, 0)>(vb), h0 = tr_read<v_rd_off(D0, 0, 1)>(vb), l1 = tr_read<v_rd_off(D0, 1, 0)>(vb), h1 = tr_read<v_rd_off(D0, 1, 1)>(vb);
  const s16x4 l2 = tr_read<v_rd_off(D0, 2, 0)>(vb), h2 = tr_read<v_rd_off(D0, 2, 1)>(vb), l3 = tr_read<v_rd_off(D0, 3, 0)>(vb), h3 = tr_read<v_rd_off(D0, 3, 1)>(vb);
  asm volatile("s_waitcnt lgkmcnt(0)" ::: "memory"); SBAR();
  od = __builtin_amdgcn_mfma_f32_32x32x16_bf16(pa0, ATT_PK(l0, h0), od, 0, 0, 0);
  od = __builtin_amdgcn_mfma_f32_32x32x16_bf16(pa1, ATT_PK(l1, h1), od, 0, 0, 0);
  od = __builtin_amdgcn_mfma_f32_32x32x16_bf16(pa2, ATT_PK(l2, h2), od, 0, 0, 0);
  od = __builtin_amdgcn_mfma_f32_32x32x16_bf16(pa3, ATT_PK(l3, h3), od, 0, 0, 0);
}
__device__ __forceinline__ void pv_d0(f32x16 (&o)[4], int vb, bf16x8 pa0, bf16x8 pa1, bf16x8 pa2, bf16x8 pa3) {
  pv_one<0>(o[0], vb, pa0, pa1, pa2, pa3); pv_one<1>(o[1], vb, pa0, pa1, pa2, pa3); pv_one<2>(o[2], vb, pa0, pa1, pa2, pa3); pv_one<3>(o[3], vb, pa0, pa1, pa2, pa3);
}
template <int D0> __device__ __forceinline__ void pv32_one(f32x16& od, int vb, bf16x8 pa0, bf16x8 pa1) {
  const s16x4 l0 = tr_read<v_rd_off(D0, 0, 0)>(vb), h0 = tr_read<v_rd_off(D0, 0, 1)>(vb), l1 = tr_read<v_rd_off(D0, 1, 0)>(vb), h1 = tr_read<v_rd_off(D0, 1, 1)>(vb);
  asm volatile("s_waitcnt lgkmcnt(0)" ::: "memory"); SBAR();
  od = __builtin_amdgcn_mfma_f32_32x32x16_bf16(pa0, ATT_PK(l0, h0), od, 0, 0, 0);
  od = __builtin_amdgcn_mfma_f32_32x32x16_bf16(pa1, ATT_PK(l1, h1), od, 0, 0, 0);
}

template <int DQK, int LDQ, int LDK, int LDO, int SDEPTH>
__device__ __forceinline__ void attn_dense_body(const bf16* __restrict__ Qb, const bf16* __restrict__ Kh, const bf16* __restrict__ Kr, const bf16* __restrict__ Vh,
                                                const float* __restrict__ cs_rows, OT* __restrict__ Ob, int seq, const float scale, ATT_LAS char* lds) {
  constexpr int SHM_V = KVBLK * DV * 2, SHM_K = KVBLK * DQK * 2, RB = DQK * 2, NQ = DQK / 16;
  constexpr bool ROPE = (DQK == 192);
  const float C = scale * LOG2E, THRS = 8.f / scale;
  int tid_ = threadIdx.x; asm volatile("" : "+v"(tid_));
  const int tid = tid_, wid = tid >> 6, lane = tid & 63, r32 = lane & 31, hi = lane >> 5;
  ATT_LAS char* V_lds = lds; ATT_LAS char* K_lds = lds + 2 * SHM_V;
  ATT_LAS float* ws = (ATT_LAS float*)(lds + 2 * SHM_V + 2 * SHM_K) + wid * 64; ATT_LAS float* li_l = ws; ATT_LAS float* al_l = ws + 32;
  float m_reg = -1e30f, l_reg = 0; f32x16 o[4] = {}; bf16x8 qr[NQ];
  const bf16* Qw = Qb + (long)(wid * QBLK + r32) * LDQ + hi * 8;
#pragma unroll
  for (int d0 = 0; d0 < NQ; ++d0) qr[d0] = *(const ATT_GAS bf16x8*)(Qw + d0 * 16);
  if constexpr (ROPE) {
    const float* cs = cs_rows + (long)(wid * QBLK + r32) * 64 + hi * 8;
#pragma unroll
    for (int g = 0; g < 2; ++g) {
      const f32x4 c0 = *(const ATT_GAS f32x4*)(cs + g * 16), c1 = *(const ATT_GAS f32x4*)(cs + g * 16 + 4);
      const f32x4 s0 = *(const ATT_GAS f32x4*)(cs + 32 + g * 16), s1 = *(const ATT_GAS f32x4*)(cs + 32 + g * 16 + 4);
      float y1[8], y2[8];
#pragma unroll
      for (int j = 0; j < 8; ++j) { const float co = j < 4 ? c0[j & 3] : c1[j & 3], si = j < 4 ? s0[j & 3] : s1[j & 3];
        const float x1 = bf2f(qr[8 + g][j]), x2 = bf2f(qr[10 + g][j]); y1[j] = x1 * co - x2 * si; y2[j] = x1 * si + x2 * co; }
      u32x4 w1 = {cvtpk(y1[0], y1[1]), cvtpk(y1[2], y1[3]), cvtpk(y1[4], y1[5]), cvtpk(y1[6], y1[7])};
      u32x4 w2 = {cvtpk(y2[0], y2[1]), cvtpk(y2[2], y2[3]), cvtpk(y2[4], y2[5]), cvtpk(y2[6], y2[7])};
      qr[8 + g] = *reinterpret_cast<bf16x8*>(&w1); qr[10 + g] = *reinterpret_cast<bf16x8*>(&w2);
    }
  }
  const int sr = tid >> 4, sc = (tid & 15) * 8, vst0 = v_st(sr, sc), vst1 = v_st(32 + sr, sc);
  const int rr = tid >> 3, rc = (tid & 7) * 8;
  const int vb0 = (int)(unsigned)(uintptr_t)V_lds + v_rd_base(lane);
  struct Slot { bf16x8 vs0, vs1, ks0, ks1, kr; } sr_[SDEPTH];
#define SLOAD(i, k0) do { sr_[i].vs0 = *(const ATT_GAS bf16x8*)(&Vh[(long)((k0) + sr) * LDK + sc]); sr_[i].vs1 = *(const ATT_GAS bf16x8*)(&Vh[(long)((k0) + 32 + sr) * LDK + sc]); \
    sr_[i].ks0 = *(const ATT_GAS bf16x8*)(&Kh[(long)((k0) + sr) * LDK + sc]); sr_[i].ks1 = *(const ATT_GAS bf16x8*)(&Kh[(long)((k0) + 32 + sr) * LDK + sc]); \
    if constexpr (ROPE) sr_[i].kr = *(const ATT_GAS bf16x8*)(&Kr[(long)((k0) + rr) * 64 + rc]); } while (0)
#define SWRITE(b, i) do { *reinterpret_cast<ATT_LAS bf16x8*>(V_lds + (b) * SHM_V + vst0) = sr_[i].vs0;          \
    *reinterpret_cast<ATT_LAS bf16x8*>(V_lds + (b) * SHM_V + vst1) = sr_[i].vs1; const int kc = sc * 2;               \
    *reinterpret_cast<ATT_LAS bf16x8*>(K_lds + (b) * SHM_K + kswz<RB>(sr, kc)) = sr_[i].ks0;                       \
    *reinterpret_cast<ATT_LAS bf16x8*>(K_lds + (b) * SHM_K + kswz<RB>(32 + sr, kc)) = sr_[i].ks1;                  \
    if constexpr (ROPE) *reinterpret_cast<ATT_LAS bf16x8*>(K_lds + (b) * SHM_K + kswz<RB>(rr, 256 + rc * 2)) = sr_[i].kr; } while (0)
#define SWAIT() do { if constexpr (SDEPTH == 2) { if constexpr (ROPE) asm volatile("s_waitcnt vmcnt(5)" ::: "memory"); else asm volatile("s_waitcnt vmcnt(4)" ::: "memory"); } else asm volatile("s_waitcnt vmcnt(0)" ::: "memory"); } while (0)
#define RESC(a) do { if (__any((a) < 1.f)) { if (hi == 0) al_l[r32] = (a); asm volatile("s_waitcnt lgkmcnt(0)" ::: "memory"); \
    _Pragma("unroll") for (int d = 0; d < 4; ++d) _Pragma("unroll") for (int r = 0; r < 16; ++r) o[d][r] *= al_l[crow(r, hi)]; } } while (0)
  f32x16 pA0, pA1, pB0, pB1; float mnA, mnB, alA, alB; bf16x8 pa0, pa1, pa2, pa3; const int NT = seq / KVBLK;
  constexpr int SE = 0, SO = SDEPTH - 1;
  SLOAD(SE, 0); asm volatile("s_waitcnt vmcnt(0)" ::: "memory"); SWRITE(0, SE); __syncthreads();
  qkt<DQK>(pA0, pA1, K_lds, qr, r32, hi); partialSM(pA0, pA1, m_reg, mnA, alA, C, THRS);
  SLOAD(SO, KVBLK); if constexpr (SDEPTH == 2) { if (2 < NT) SLOAD(SE, 2 * KVBLK); }
  SWAIT(); SWRITE(1, SO); __syncthreads();
  for (int j = 1; j + 1 < NT; j += 2) {
    SBAR(); qkt<DQK>(pB0, pB1, K_lds + SHM_K, qr, r32, hi);
    finishSM(pA0, pA1, alA, l_reg, pa0, pa1, pa2, pa3); SBAR();
    SLOAD(SO, (j + SDEPTH) * KVBLK); SBAR();
    pv_d0(o, vb0, pa0, pa1, pa2, pa3); partialSM(pB0, pB1, m_reg, mnB, alB, C, THRS);
    __syncthreads(); SWAIT(); SWRITE(0, SE);
    RESC(alB); __syncthreads();
    SBAR(); qkt<DQK>(pA0, pA1, K_lds, qr, r32, hi);
    finishSM(pB0, pB1, alB, l_reg, pa0, pa1, pa2, pa3); SBAR();
    if (SDEPTH == 1 || j + 3 < NT) SLOAD(SE, (j + 1 + SDEPTH) * KVBLK); SBAR();
    pv_d0(o, vb0 + SHM_V, pa0, pa1, pa2, pa3); partialSM(pA0, pA1, m_reg, mnA, alA, C, THRS);
    __syncthreads(); SWAIT(); SWRITE(1, SO);
    RESC(alA); __syncthreads();
  }
  SBAR(); qkt<DQK>(pB0, pB1, K_lds + SHM_K, qr, r32, hi);
  finishSM(pA0, pA1, alA, l_reg, pa0, pa1, pa2, pa3); SBAR();
  pv_d0(o, vb0, pa0, pa1, pa2, pa3); partialSM(pB0, pB1, m_reg, mnB, alB, C, THRS);
  __syncthreads(); RESC(alB);
  finishSM(pB0, pB1, alB, l_reg, pa0, pa1, pa2, pa3); SBAR();
  pv_d0(o, vb0 + SHM_V, pa0, pa1, pa2, pa3);
  if (hi == 0) li_l[r32] = l_reg; asm volatile("s_waitcnt lgkmcnt(0)" ::: "memory");
  float rli[16];
#pragma unroll
  for (int r = 0; r < 16; ++r) rli[r] = __builtin_amdgcn_rcpf(li_l[crow(r, hi)]);
  OT* Ow = Ob + (long)(wid * QBLK) * LDO;
#pragma unroll
  for (int r = 0; r < 16; ++r) { const int orow = crow(r, hi);
#pragma unroll
    for (int d0 = 0; d0 < 4; ++d0) st_o(&Ow[(long)orow * LDO + d0 * 32 + r32], o[d0][r] * rli[r]); }
  __syncthreads();
#undef SLOAD
#undef SWRITE
#undef SWAIT
#undef RESC
}

template <int LDQ, int LDK, int LDO>
__device__ __forceinline__ void attn_pipe192_body(const bf16* __restrict__ Qb, const bf16* __restrict__ Kh, const bf16* __restrict__ Kr, const bf16* __restrict__ Vh,
                                                const float* __restrict__ cs_rows, OT* __restrict__ Ob, int seq, const float scale, ATT_LAS char* lds) {
  constexpr int DQK = 192, SDEPTH = 1, SHM_V = KVBLK * DV * 2, SHM_K = KVBLK * DQK * 2, RB = DQK * 2, NQ = DQK / 16;
  constexpr bool ROPE = true;
  const float C = scale * LOG2E, THRS = 8.f / scale;
  int tid_ = threadIdx.x; asm volatile("" : "+v"(tid_));
  const int tid = tid_, wid = tid >> 6, lane = tid & 63, r32 = lane & 31, hi = lane >> 5;
  ATT_LAS char* V_lds = lds; ATT_LAS char* K_lds = lds + 2 * SHM_V;
  ATT_LAS float* ws = (ATT_LAS float*)(lds + 2 * SHM_V + 2 * SHM_K) + wid * 64; ATT_LAS float* li_l = ws; ATT_LAS float* al_l = ws + 32;
  ATT_LAS char* Qs = lds + 2 * SHM_V + 2 * SHM_K + 2048 + wid * 4096;
  float m_reg = -1e30f, l_reg = 0; f32x16 o[4] = {}; bf16x8 qr8[8];
  const bf16* Qw = Qb + (long)(wid * QBLK + r32) * LDQ + hi * 8;
  { bf16x8 qr[NQ];
#pragma unroll
  for (int d0 = 0; d0 < NQ; ++d0) qr[d0] = *(const ATT_GAS bf16x8*)(Qw + d0 * 16);
  if constexpr (ROPE) {
    const float* cs = cs_rows + (long)(wid * QBLK + r32) * 64 + hi * 8;
#pragma unroll
    for (int g = 0; g < 2; ++g) {
      const f32x4 c0 = *(const ATT_GAS f32x4*)(cs + g * 16), c1 = *(const ATT_GAS f32x4*)(cs + g * 16 + 4);
      const f32x4 s0 = *(const ATT_GAS f32x4*)(cs + 32 + g * 16), s1 = *(const ATT_GAS f32x4*)(cs + 32 + g * 16 + 4);
      float y1[8], y2[8];
#pragma unroll
      for (int j = 0; j < 8; ++j) { const float co = j < 4 ? c0[j & 3] : c1[j & 3], si = j < 4 ? s0[j & 3] : s1[j & 3];
        const float x1 = bf2f(qr[8 + g][j]), x2 = bf2f(qr[10 + g][j]); y1[j] = x1 * co - x2 * si; y2[j] = x1 * si + x2 * co; }
      u32x4 w1 = {cvtpk(y1[0], y1[1]), cvtpk(y1[2], y1[3]), cvtpk(y1[4], y1[5]), cvtpk(y1[6], y1[7])};
      u32x4 w2 = {cvtpk(y2[0], y2[1]), cvtpk(y2[2], y2[3]), cvtpk(y2[4], y2[5]), cvtpk(y2[6], y2[7])};
      qr[8 + g] = *reinterpret_cast<bf16x8*>(&w1); qr[10 + g] = *reinterpret_cast<bf16x8*>(&w2);
    }
  }
#pragma unroll
  for (int d0 = 0; d0 < 8; ++d0) qr8[d0] = qr[d0];
#pragma unroll
  for (int d0 = 8; d0 < 12; ++d0) *reinterpret_cast<ATT_LAS bf16x8*>(Qs + ((d0 - 8) * 64 + lane) * 16) = qr[d0];
  }
  const int sr = tid >> 4, sc = (tid & 15) * 8, vst0 = v_st(sr, sc), vst1 = v_st(32 + sr, sc);
  const int rr = tid >> 3, rc = (tid & 7) * 8;
  const int vb0 = (int)(unsigned)(uintptr_t)V_lds + v_rd_base(lane);
  struct Slot { bf16x8 vs0, vs1, ks0, ks1, kr; } sr_[SDEPTH];
#define SLOADK(i, k0) do { sr_[i].ks0 = *(const ATT_GAS bf16x8*)(&Kh[(long)((k0) + sr) * LDK + sc]); sr_[i].ks1 = *(const ATT_GAS bf16x8*)(&Kh[(long)((k0) + 32 + sr) * LDK + sc]); } while (0)
#define SLOADV(i, k0) do { sr_[i].vs0 = *(const ATT_GAS bf16x8*)(&Vh[(long)((k0) + sr) * LDK + sc]); sr_[i].vs1 = *(const ATT_GAS bf16x8*)(&Vh[(long)((k0) + 32 + sr) * LDK + sc]); \
    if constexpr (ROPE) sr_[i].kr = *(const ATT_GAS bf16x8*)(&Kr[(long)((k0) + rr) * 64 + rc]); } while (0)
#define SLOAD(i, k0) do { SLOADK(i, k0); SLOADV(i, k0); } while (0)
#define SWRITE(b, i) do { *reinterpret_cast<ATT_LAS bf16x8*>(V_lds + (b) * SHM_V + vst0) = sr_[i].vs0;          \
    *reinterpret_cast<ATT_LAS bf16x8*>(V_lds + (b) * SHM_V + vst1) = sr_[i].vs1; const int kc = sc * 2;               \
    *reinterpret_cast<ATT_LAS bf16x8*>(K_lds + (b) * SHM_K + kswz<RB>(sr, kc)) = sr_[i].ks0;                       \
    *reinterpret_cast<ATT_LAS bf16x8*>(K_lds + (b) * SHM_K + kswz<RB>(32 + sr, kc)) = sr_[i].ks1;                  \
    if constexpr (ROPE) *reinterpret_cast<ATT_LAS bf16x8*>(K_lds + (b) * SHM_K + kswz<RB>(rr, 256 + rc * 2)) = sr_[i].kr; } while (0)
#define SWAIT() do { if constexpr (SDEPTH == 2) { if constexpr (ROPE) asm volatile("s_waitcnt vmcnt(5)" ::: "memory"); else asm volatile("s_waitcnt vmcnt(4)" ::: "memory"); } else asm volatile("s_waitcnt vmcnt(0)" ::: "memory"); } while (0)
#define RESC(a) do { if (__any((a) < 1.f)) { if (hi == 0) al_l[r32] = (a); asm volatile("s_waitcnt lgkmcnt(0)" ::: "memory"); \
    _Pragma("unroll") for (int d = 0; d < 4; ++d) _Pragma("unroll") for (int r = 0; r < 16; ++r) o[d][r] *= al_l[crow(r, hi)]; } } while (0)
  f32x16 pA0, pA1, pB0, pB1; float mnA, mnB, alA, alB; bf16x8 pa0, pa1, pa2, pa3; const int NT = seq / KVBLK;
  constexpr int SE = 0, SO = SDEPTH - 1;
  SLOAD(SE, 0); asm volatile("s_waitcnt vmcnt(0)" ::: "memory"); SWRITE(0, SE); __syncthreads();
  qkt192_lq(pA0, pA1, K_lds, qr8, Qs, lane, r32, hi); partialSM(pA0, pA1, m_reg, mnA, alA, C, THRS);
  SLOAD(SO, KVBLK); if constexpr (SDEPTH == 2) { if (2 < NT) SLOAD(SE, 2 * KVBLK); }
  SWAIT(); SWRITE(1, SO); __syncthreads();
  for (int j = 1; j + 1 < NT; j += 2) {
    SBAR(); qkt192_lq(pB0, pB1, K_lds + SHM_K, qr8, Qs, lane, r32, hi);
    finishSM(pA0, pA1, alA, l_reg, pa0, pa1, pa2, pa3); SBAR();
    SLOADK(SO, (j + SDEPTH) * KVBLK); SBAR();
    pv_d0(o, vb0, pa0, pa1, pa2, pa3); SBAR(); SLOADV(SO, (j + SDEPTH) * KVBLK); SBAR(); partialSM(pB0, pB1, m_reg, mnB, alB, C, THRS);
    __syncthreads(); SWAIT(); SWRITE(0, SE);
    RESC(alB); __syncthreads();
    SBAR(); qkt192_lq(pA0, pA1, K_lds, qr8, Qs, lane, r32, hi);
    finishSM(pB0, pB1, alB, l_reg, pa0, pa1, pa2, pa3); SBAR();
    SLOADK(SE, (j + 1 + SDEPTH) * KVBLK); SBAR();
    pv_d0(o, vb0 + SHM_V, pa0, pa1, pa2, pa3); SBAR(); SLOADV(SE, (j + 1 + SDEPTH) * KVBLK); SBAR(); partialSM(pA0, pA1, m_reg, mnA, alA, C, THRS);
    __syncthreads(); SWAIT(); SWRITE(1, SO);
    RESC(alA); __syncthreads();
  }
  SBAR(); qkt192_lq(pB0, pB1, K_lds + SHM_K, qr8, Qs, lane, r32, hi);
  finishSM(pA0, pA1, alA, l_reg, pa0, pa1, pa2, pa3); SBAR();
  pv_d0(o, vb0, pa0, pa1, pa2, pa3); partialSM(pB0, pB1, m_reg, mnB, alB, C, THRS);
  __syncthreads(); RESC(alB);
  finishSM(pB0, pB1, alB, l_reg, pa0, pa1, pa2, pa3); SBAR();
  pv_d0(o, vb0 + SHM_V, pa0, pa1, pa2, pa3);
  if (hi == 0) li_l[r32] = l_reg; asm volatile("s_waitcnt lgkmcnt(0)" ::: "memory");
  float rli[16];
#pragma unroll
  for (int r = 0; r < 16; ++r) rli[r] = __builtin_amdgcn_rcpf(li_l[crow(r, hi)]);
  OT* Ow = Ob + (long)(wid * QBLK) * LDO;
#pragma unroll
  for (int r = 0; r < 16; ++r) { const int orow = crow(r, hi);
#pragma unroll
    for (int d0 = 0; d0 < 4; ++d0) st_o(&Ow[(long)orow * LDO + d0 * 32 + r32], o[d0][r] * rli[r]); }
  __syncthreads();
#undef SLOAD
#undef SLOADK
#undef SLOADV
#undef SWRITE
#undef SWAIT
#undef RESC
}

template <int DQK, int LDQ, int LDK, int LDO>
__device__ __forceinline__ void attn_simple_body(const bf16* __restrict__ Qb, const bf16* __restrict__ Kh, const bf16* __restrict__ Kr, const bf16* __restrict__ Vh,
                                                 const float* __restrict__ cs_rows, OT* __restrict__ Ob, int seq, const float scale, ATT_LAS char* lds) {
  constexpr int SHM_V = KVBLK * DV * 2, SHM_K = KVBLK * DQK * 2, RB = DQK * 2, NQ = DQK / 16;
  constexpr bool ROPE = (DQK == 192);
  const float C = scale * LOG2E, THRS = 8.f / scale;
  int tid_ = threadIdx.x; asm volatile("" : "+v"(tid_));
  const int tid = tid_, wid = tid >> 6, lane = tid & 63, r32 = lane & 31, hi = lane >> 5;
  ATT_LAS char* V_lds = lds; ATT_LAS char* K_lds = lds + 2 * SHM_V;
  ATT_LAS float* ws = (ATT_LAS float*)(lds + 2 * SHM_V + 2 * SHM_K) + wid * 64; ATT_LAS float* li_l = ws; ATT_LAS float* al_l = ws + 32;
  float m_reg = -1e30f, l_reg = 0; f32x16 o[4] = {}; bf16x8 qr[NQ];
  const bf16* Qw = Qb + (long)(wid * QBLK + r32) * LDQ + hi * 8;
#pragma unroll
  for (int d0 = 0; d0 < NQ; ++d0) qr[d0] = *(const ATT_GAS bf16x8*)(Qw + d0 * 16);
  if constexpr (ROPE) {
    const float* cs = cs_rows + (long)(wid * QBLK + r32) * 64 + hi * 8;
#pragma unroll
    for (int g = 0; g < 2; ++g) {
      const f32x4 c0 = *(const ATT_GAS f32x4*)(cs + g * 16), c1 = *(const ATT_GAS f32x4*)(cs + g * 16 + 4);
      const f32x4 s0 = *(const ATT_GAS f32x4*)(cs + 32 + g * 16), s1 = *(const ATT_GAS f32x4*)(cs + 32 + g * 16 + 4);
      float y1[8], y2[8];
#pragma unroll
      for (int j = 0; j < 8; ++j) { const float co = j < 4 ? c0[j & 3] : c1[j & 3], si = j < 4 ? s0[j & 3] : s1[j & 3];
        const float x1 = bf2f(qr[8 + g][j]), x2 = bf2f(qr[10 + g][j]); y1[j] = x1 * co - x2 * si; y2[j] = x1 * si + x2 * co; }
      u32x4 w1 = {cvtpk(y1[0], y1[1]), cvtpk(y1[2], y1[3]), cvtpk(y1[4], y1[5]), cvtpk(y1[6], y1[7])};
      u32x4 w2 = {cvtpk(y2[0], y2[1]), cvtpk(y2[2], y2[3]), cvtpk(y2[4], y2[5]), cvtpk(y2[6], y2[7])};
      qr[8 + g] = *reinterpret_cast<bf16x8*>(&w1); qr[10 + g] = *reinterpret_cast<bf16x8*>(&w2);
    }
  }
  const int sr = tid >> 4, sc = (tid & 15) * 8, vst0 = v_st(sr, sc), vst1 = v_st(32 + sr, sc);
  const int rr = tid >> 3, rc = (tid & 7) * 8;
  const int vb0 = (int)(unsigned)(uintptr_t)V_lds + v_rd_base(lane);
  bf16x8 vs0, vs1, ks0, ks1, kr;
#define SLOAD(k0) do { vs0 = *(const ATT_GAS bf16x8*)(&Vh[(long)((k0) + sr) * LDK + sc]); vs1 = *(const ATT_GAS bf16x8*)(&Vh[(long)((k0) + 32 + sr) * LDK + sc]); \
    ks0 = *(const ATT_GAS bf16x8*)(&Kh[(long)((k0) + sr) * LDK + sc]); ks1 = *(const ATT_GAS bf16x8*)(&Kh[(long)((k0) + 32 + sr) * LDK + sc]); \
    if constexpr (ROPE) kr = *(const ATT_GAS bf16x8*)(&Kr[(long)((k0) + rr) * 64 + rc]); } while (0)
#define SWRITE(b) do { *reinterpret_cast<ATT_LAS bf16x8*>(V_lds + (b) * SHM_V + vst0) = vs0;          \
    *reinterpret_cast<ATT_LAS bf16x8*>(V_lds + (b) * SHM_V + vst1) = vs1; const int kc = sc * 2;               \
    *reinterpret_cast<ATT_LAS bf16x8*>(K_lds + (b) * SHM_K + kswz<RB>(sr, kc)) = ks0;                       \
    *reinterpret_cast<ATT_LAS bf16x8*>(K_lds + (b) * SHM_K + kswz<RB>(32 + sr, kc)) = ks1;                  \
    if constexpr (ROPE) *reinterpret_cast<ATT_LAS bf16x8*>(K_lds + (b) * SHM_K + kswz<RB>(rr, 256 + rc * 2)) = kr; } while (0)
#define RESC(a) do { if (__any((a) < 1.f)) { if (hi == 0) al_l[r32] = (a); asm volatile("s_waitcnt lgkmcnt(0)" ::: "memory"); \
    _Pragma("unroll") for (int d = 0; d < 4; ++d) _Pragma("unroll") for (int r = 0; r < 16; ++r) o[d][r] *= al_l[crow(r, hi)]; } } while (0)
  const int NT = seq / KVBLK;
  SLOAD(0); SWRITE(0); __syncthreads();
  for (int j = 0; j < NT; ++j) {
    const int b = j & 1;
    if (j + 1 < NT) SLOAD((j + 1) * KVBLK);
    f32x16 p0, p1; float mn, al; bf16x8 pa0, pa1, pa2, pa3;
    SBAR(); qkt<DQK>(p0, p1, K_lds + b * SHM_K, qr, r32, hi);
    partialSM(p0, p1, m_reg, mn, al, C, THRS); RESC(al);
    finishSM(p0, p1, al, l_reg, pa0, pa1, pa2, pa3); SBAR();
    pv_d0(o, vb0 + b * SHM_V, pa0, pa1, pa2, pa3);
    if (j + 1 < NT) SWRITE(b ^ 1);
    __syncthreads();
  }
  if (hi == 0) li_l[r32] = l_reg; asm volatile("s_waitcnt lgkmcnt(0)" ::: "memory");
  float rli[16];
#pragma unroll
  for (int r = 0; r < 16; ++r) rli[r] = __builtin_amdgcn_rcpf(li_l[crow(r, hi)]);
  OT* Ow = Ob + (long)(wid * QBLK) * LDO;
#pragma unroll
  for (int r = 0; r < 16; ++r) { const int orow = crow(r, hi);
#pragma unroll
    for (int d0 = 0; d0 < 4; ++d0) st_o(&Ow[(long)orow * LDO + d0 * 32 + r32], o[d0][r] * rli[r]); }
  __syncthreads();
#undef SLOAD
#undef SWRITE
#undef RESC
}

template <int LDQ, int LDK, int LDO>
__device__ __forceinline__ void attn_dma_body(const bf16* __restrict__ Qb, const bf16* __restrict__ Kh, const bf16* __restrict__ Kr, const bf16* __restrict__ Vh,
                                              const float* __restrict__ cs_rows, OT* __restrict__ Ob, int seq, const float scale, ATT_LAS char* lds) {
  constexpr int DQK = 192, SHM_V = KVBLK * DV * 2, SHM_K = KVBLK * DQK * 2, STG = SHM_K + SHM_V, RB = DQK * 2, NQ = DQK / 16;
  const float C = scale * LOG2E, THRS = 8.f / scale;
  int tid_ = threadIdx.x; asm volatile("" : "+v"(tid_));
  const int tid = tid_, wid = __builtin_amdgcn_readfirstlane(tid >> 6), lane = tid & 63, r32 = lane & 31, hi = lane >> 5;
  ATT_LAS float* ws = (ATT_LAS float*)(lds + 3 * STG) + wid * 64; ATT_LAS float* li_l = ws; ATT_LAS float* al_l = ws + 32;
  float m_reg = -1e30f, l_reg = 0; f32x16 o[4] = {}; bf16x8 qr[NQ];
  const bf16* Qw = Qb + (long)(wid * QBLK + r32) * LDQ + hi * 8;
#pragma unroll
  for (int d0 = 0; d0 < NQ; ++d0) qr[d0] = *(const ATT_GAS bf16x8*)(Qw + d0 * 16);
  { const float* cs = cs_rows + (long)(wid * QBLK + r32) * 64 + hi * 8;
#pragma unroll
    for (int g = 0; g < 2; ++g) {
      const f32x4 c0 = *(const ATT_GAS f32x4*)(cs + g * 16), c1 = *(const ATT_GAS f32x4*)(cs + g * 16 + 4);
      const f32x4 s0 = *(const ATT_GAS f32x4*)(cs + 32 + g * 16), s1 = *(const ATT_GAS f32x4*)(cs + 32 + g * 16 + 4);
      float y1[8], y2[8];
#pragma unroll
      for (int j = 0; j < 8; ++j) { const float co = j < 4 ? c0[j & 3] : c1[j & 3], si = j < 4 ? s0[j & 3] : s1[j & 3];
        const float x1 = bf2f(qr[8 + g][j]), x2 = bf2f(qr[10 + g][j]); y1[j] = x1 * co - x2 * si; y2[j] = x1 * si + x2 * co; }
      u32x4 w1 = {cvtpk(y1[0], y1[1]), cvtpk(y1[2], y1[3]), cvtpk(y1[4], y1[5]), cvtpk(y1[6], y1[7])};
      u32x4 w2 = {cvtpk(y2[0], y2[1]), cvtpk(y2[2], y2[3]), cvtpk(y2[4], y2[5]), cvtpk(y2[6], y2[7])};
      qr[8 + g] = *reinterpret_cast<bf16x8*>(&w1); qr[10 + g] = *reinterpret_cast<bf16x8*>(&w2);
    } }
  const char* ksrc[3]; int kstep[3];
#pragma unroll
  for (int d = 0; d < 3; ++d) { const int p = (wid * 3 + d) * 64 + lane, row = p / 24, cpos = p - row * 24, c = cpos ^ (row & 7);
    if (c < 16) { ksrc[d] = (const char*)(Kh + (long)row * LDK + c * 8); kstep[d] = KVBLK * LDK * 2; } else { ksrc[d] = (const char*)(Kr + (long)row * 64 + (c - 16) * 8); kstep[d] = KVBLK * 64 * 2; } }
  const char* vsrc[2];
#pragma unroll
  for (int d = 0; d < 2; ++d) { const int p = (wid * 2 + d) * 64 + lane, sub = p >> 5, q = p & 31, kk = (sub >> 2) * 8 + (q >> 2), col = (sub & 3) * 32 + (q & 3) * 8;
    const int key = (kk & ~0xC) | ((kk & 4) << 1) | ((kk & 8) >> 1); vsrc[d] = (const char*)(Vh + (long)key * LDK + col); }
#define DMA_TILE(t, stg) do { ATT_LAS char* sb_ = lds + (stg) * STG; \
    _Pragma("unroll") for (int d = 0; d < 3; ++d) __builtin_amdgcn_global_load_lds((const unsigned*)(ksrc[d] + (long)(t) * kstep[d]), (ATT_LAS unsigned*)(sb_ + (wid * 3 + d) * 1024), 16, 0, 0); \
    _Pragma("unroll") for (int d = 0; d < 2; ++d) __builtin_amdgcn_global_load_lds((const unsigned*)(vsrc[d] + (long)(t) * (KVBLK * LDK * 2)), (ATT_LAS unsigned*)(sb_ + SHM_K + (wid * 2 + d) * 1024), 16, 0, 0); } while (0)
#define RESC(a) do { if (__any((a) < 1.f)) { if (hi == 0) al_l[r32] = (a); asm volatile("s_waitcnt lgkmcnt(0)" ::: "memory"); \
    _Pragma("unroll") for (int d = 0; d < 4; ++d) _Pragma("unroll") for (int r = 0; r < 16; ++r) o[d][r] *= al_l[crow(r, hi)]; } } while (0)
  const int NT = seq / KVBLK, vbase = (int)(unsigned)(uintptr_t)lds + SHM_K + v_rd_base(lane);
  asm volatile("s_waitcnt vmcnt(0)" ::: "memory");
  DMA_TILE(0, 0); DMA_TILE(1, 1);
  asm volatile("s_waitcnt vmcnt(5)" ::: "memory"); __builtin_amdgcn_s_barrier(); asm volatile("" ::: "memory");
  int stg = 0;
  for (int j = 0; j < NT; ++j) {
    const int stg2 = stg >= 1 ? stg - 1 : 2;
    if (j + 2 < NT) DMA_TILE(j + 2, stg2);
    f32x16 p0, p1; float mn, al; bf16x8 pa0, pa1, pa2, pa3;
    SBAR(); qkt<DQK>(p0, p1, lds + stg * STG, qr, r32, hi);
    partialSM(p0, p1, m_reg, mn, al, C, THRS); RESC(al);
    finishSM(p0, p1, al, l_reg, pa0, pa1, pa2, pa3); SBAR();
    pv_d0(o, vbase + stg * STG, pa0, pa1, pa2, pa3);
    if (j + 2 < NT) asm volatile("s_waitcnt vmcnt(5)" ::: "memory"); else asm volatile("s_waitcnt vmcnt(0)" ::: "memory");
    asm volatile("s_waitcnt lgkmcnt(0)" ::: "memory"); __builtin_amdgcn_s_barrier(); asm volatile("" ::: "memory");
    stg = stg == 2 ? 0 : stg + 1;
  }
  if (hi == 0) li_l[r32] = l_reg; asm volatile("s_waitcnt lgkmcnt(0)" ::: "memory");
  float rli[16];
#pragma unroll
  for (int r = 0; r < 16; ++r) rli[r] = __builtin_amdgcn_rcpf(li_l[crow(r, hi)]);
  OT* Ow = Ob + (long)(wid * QBLK) * LDO;
#pragma unroll
  for (int r = 0; r < 16; ++r) { const int orow = crow(r, hi);
#pragma unroll
    for (int d0 = 0; d0 < 4; ++d0) st_o(&Ow[(long)orow * LDO + d0 * 32 + r32], o[d0][r] * rli[r]); }
  __syncthreads();
#undef DMA_TILE
#undef RESC
}

template <int LDP>
__device__ __forceinline__ void dil_wave_unit(const bf16* __restrict__ P, int qc, int kc, int vc, int d, int r, int t0, int nT,
                                              OT* __restrict__ O, int oc, float* __restrict__ ST  ,
                                              ATT_LAS char* vlds  , const ATT_LAS float* bias2, const float C, int lane_) {
  int lane = lane_; asm volatile("" : "+v"(lane));
  const int r32 = lane & 31, hi = lane >> 5;
  bf16x8 qr[8];
  { const bf16* qp = P + (long)(r + d * (t0 + r32)) * LDP + qc + hi * 8;
#pragma unroll
    for (int d0 = 0; d0 < 8; ++d0) qr[d0] = *(const ATT_GAS bf16x8*)(qp + d0 * 16); }
  bf16x8 kf[2][8];
#define DIL_LDK(kb, set) do { int kt_ = t0 - 64 + (kb) * 32 + r32; kt_ = kt_ < 0 ? 0 : (kt_ > nT - 1 ? nT - 1 : kt_); \
    const bf16* kp_ = P + (long)(r + d * kt_) * LDP + kc + hi * 8; \
    _Pragma("unroll") for (int d0 = 0; d0 < 8; ++d0) kf[set][d0] = *(const ATT_GAS bf16x8*)(kp_ + d0 * 16); } while (0)
  DIL_LDK(0, 0);
  f32x16 p[5];
#pragma unroll
  for (int kb = 0; kb < 5; ++kb) {
    if (kb + 1 < 5) DIL_LDK(kb + 1, (kb + 1) & 1);
    p[kb] = f32x16{};
#pragma unroll
    for (int d0 = 0; d0 < 8; ++d0) p[kb] = __builtin_amdgcn_mfma_f32_32x32x16_bf16(kf[kb & 1][d0], qr[d0], p[kb], 0, 0, 0);
  }
#undef DIL_LDK
  bf16x8 vv[2][8];
#define DIL_LDV(kb, set) do { _Pragma("unroll") for (int i = 0; i < 8; ++i) { const int id = lane + 64 * i, row = id >> 4, c = (id & 15) * 8; \
      int kt_ = t0 - 64 + (kb) * 32 + row; kt_ = kt_ < 0 ? 0 : (kt_ > nT - 1 ? nT - 1 : kt_); \
      vv[set][i] = *(const ATT_GAS bf16x8*)(P + (long)(r + d * kt_) * LDP + vc + c); } } while (0)
  DIL_LDV(0, 0);
  float m = -1e30f;
  { const int a_ = 4 * hi - r32 + 32, k_ = a_ & 3; const ATT_LAS f32x4* tp = (const ATT_LAS f32x4*)(bias2 + k_ * 196 + (a_ - k_));
    const bool interior = (t0 >= 64) && (t0 + 96 <= nT);
#pragma unroll
    for (int kb = 0; kb < 5; ++kb)
#pragma unroll
      for (int g = 0; g < 4; ++g) { const f32x4 bv = tp[kb * 8 + 2 * g];
#pragma unroll
        for (int e = 0; e < 4; ++e) { const int rg = 4 * g + e; float s = fmaf(p[kb][rg], C, bv[e]);
          if (!interior) { const int kt = t0 - 64 + kb * 32 + crow(rg, hi); s = (kt >= 0 && kt < nT) ? s : -1e30f; }
          p[kb][rg] = s; m = fmaxf(m, s); } } }
  { auto rr = __builtin_amdgcn_permlane32_swap(__float_as_uint(m), __float_as_uint(m), false, false); m = fmaxf(__uint_as_float(rr[0]), __uint_as_float(rr[1])); }
  float Z = 0.f;
#pragma unroll
  for (int kb = 0; kb < 5; ++kb)
#pragma unroll
    for (int rg = 0; rg < 16; ++rg) { p[kb][rg] = __builtin_amdgcn_exp2f(p[kb][rg] - m); Z += p[kb][rg]; }
  { auto rr = __builtin_amdgcn_permlane32_swap(__float_as_uint(Z), __float_as_uint(Z), false, false); Z = __uint_as_float(rr[0]) + __uint_as_float(rr[1]); }
  bf16x8 pa[5][2];
#pragma unroll
  for (int kb = 0; kb < 5; ++kb) { ATT_PK4(p[kb], 0, pa[kb][0]); ATT_PK4(p[kb], 8, pa[kb][1]); }
  f32x16 o[4] = {};
  const int vb = (int)(unsigned)(uintptr_t)vlds + v_rd_base(lane);
#pragma unroll
  for (int kb = 0; kb < 5; ++kb) {
    if (kb + 1 < 5) DIL_LDV(kb + 1, (kb + 1) & 1);
#pragma unroll
    for (int i = 0; i < 8; ++i) { const int id = lane + 64 * i, row = id >> 4, c = (id & 15) * 8;
      *reinterpret_cast<ATT_LAS bf16x8*>(vlds + v_st(row, c)) = vv[kb & 1][i]; }
    asm volatile("s_waitcnt lgkmcnt(0)" ::: "memory"); SBAR();
    pv32_one<0>(o[0], vb, pa[kb][0], pa[kb][1]); pv32_one<1>(o[1], vb, pa[kb][0], pa[kb][1]); pv32_one<2>(o[2], vb, pa[kb][0], pa[kb][1]); pv32_one<3>(o[3], vb, pa[kb][0], pa[kb][1]);
    SBAR();
  }
#undef DIL_LDV
#pragma unroll
  for (int rg = 0; rg < 16; ++rg) { const long row = r + d * (t0 + crow(rg, hi));
#pragma unroll
    for (int d0 = 0; d0 < 4; ++d0) st_o(&O[row * 768 + oc + d0 * 32 + r32], o[d0][rg]); }
  if (hi == 0) { const long row = r + d * (t0 + r32); typedef float f32x2_ __attribute__((ext_vector_type(2))); *(ATT_GAS f32x2_*)(ST + row * 12) = (f32x2_){m, Z}; }
}
template <int LDP>
__device__ __forceinline__ void dil_wg_unit(const bf16* __restrict__ P, int qc, int kc, int vc, int d, int r, int T0, int nT,
                                            OT* __restrict__ O, int oc, float* __restrict__ ST, ATT_LAS char* lds, const ATT_LAS float* bias2, const float C) {
  int tid_ = threadIdx.x; asm volatile("" : "+v"(tid_));
  const int tid = tid_, wid = __builtin_amdgcn_readfirstlane(tid >> 6), lane = tid & 63, r32 = lane & 31, hi = lane >> 5, t0 = T0 + 32 * wid;
  { bf16x8 kk[12];
#pragma unroll
    for (int i = 0; i < 12; ++i) { const int id = tid + 512 * i, row = id >> 4, c = (id & 15) * 8; int kt = T0 - 64 + row; kt = kt < 0 ? 0 : (kt > nT - 1 ? nT - 1 : kt);
      kk[i] = *(const ATT_GAS bf16x8*)(P + (long)(r + d * kt) * LDP + kc + c); }
#pragma unroll
    for (int i = 0; i < 12; ++i) { const int id = tid + 512 * i, row = id >> 4, cB = (id & 15) * 16;
      *reinterpret_cast<ATT_LAS bf16x8*>(lds + kswz<256>(row, cB)) = kk[i]; } }
  bf16x8 qr[8];
  { const bf16* qp = P + (long)(r + d * (t0 + r32)) * LDP + qc + hi * 8;
#pragma unroll
    for (int d0 = 0; d0 < 8; ++d0) qr[d0] = *(const ATT_GAS bf16x8*)(qp + d0 * 16); }
  __syncthreads();
  bf16x8 vv[12];
#pragma unroll
  for (int i = 0; i < 12; ++i) { const int id = tid + 512 * i, row = id >> 4, c = (id & 15) * 8; int kt = T0 - 64 + row; kt = kt < 0 ? 0 : (kt > nT - 1 ? nT - 1 : kt);
    vv[i] = *(const ATT_GAS bf16x8*)(P + (long)(r + d * kt) * LDP + vc + c); }
  f32x16 p[5];
#pragma unroll
  for (int kb = 0; kb < 5; ++kb) { const int krow = 32 * wid + 32 * kb + r32;
    p[kb] = f32x16{};
#pragma unroll
    for (int d0 = 0; d0 < 8; ++d0) { const bf16x8 kf = *reinterpret_cast<const ATT_LAS bf16x8*>(lds + kswz<256>(krow, (d0 * 16 + hi * 8) * 2));
      p[kb] = __builtin_amdgcn_mfma_f32_32x32x16_bf16(kf, qr[d0], p[kb], 0, 0, 0); } }
  float m = -1e30f;
  { const int a_ = 4 * hi - r32 + 32, k_ = a_ & 3; const ATT_LAS f32x4* tp = (const ATT_LAS f32x4*)(bias2 + k_ * 196 + (a_ - k_));
    const bool interior = (t0 >= 64) && (t0 + 96 <= nT);
#pragma unroll
    for (int kb = 0; kb < 5; ++kb)
#pragma unroll
      for (int g = 0; g < 4; ++g) { const f32x4 bv = tp[kb * 8 + 2 * g];
#pragma unroll
        for (int e = 0; e < 4; ++e) { const int rg = 4 * g + e; float s = fmaf(p[kb][rg], C, bv[e]);
          if (!interior) { const int kt = t0 - 64 + kb * 32 + crow(rg, hi); s = (kt >= 0 && kt < nT) ? s : -1e30f; }
          p[kb][rg] = s; m = fmaxf(m, s); } } }
  { auto rr = __builtin_amdgcn_permlane32_swap(__float_as_uint(m), __float_as_uint(m), false, false); m = fmaxf(__uint_as_float(rr[0]), __uint_as_float(rr[1])); }
  float Z = 0.f;
#pragma unroll
  for (int kb = 0; kb < 5; ++kb)
#pragma unroll
    for (int rg = 0; rg < 16; ++rg) { p[kb][rg] = __builtin_amdgcn_exp2f(p[kb][rg] - m); Z += p[kb][rg]; }
  { auto rr = __builtin_amdgcn_permlane32_swap(__float_as_uint(Z), __float_as_uint(Z), false, false); Z = __uint_as_float(rr[0]) + __uint_as_float(rr[1]); }
  bf16x8 pa[5][2];
#pragma unroll
  for (int kb = 0; kb < 5; ++kb) { ATT_PK4(p[kb], 0, pa[kb][0]); ATT_PK4(p[kb], 8, pa[kb][1]); }
  __syncthreads();
#pragma unroll
  for (int i = 0; i < 12; ++i) { const int id = tid + 512 * i, row = id >> 4, c = (id & 15) * 8;
    *reinterpret_cast<ATT_LAS bf16x8*>(lds + (row >> 5) * 8192 + v_st(row & 31, c)) = vv[i]; }
  __syncthreads();
  f32x16 o[4] = {};
#pragma unroll
  for (int kb = 0; kb < 5; ++kb) { const int vb = (int)(unsigned)(uintptr_t)lds + (wid + kb) * 8192 + v_rd_base(lane);
    pv32_one<0>(o[0], vb, pa[kb][0], pa[kb][1]); pv32_one<1>(o[1], vb, pa[kb][0], pa[kb][1]); pv32_one<2>(o[2], vb, pa[kb][0], pa[kb][1]); pv32_one<3>(o[3], vb, pa[kb][0], pa[kb][1]); }
#pragma unroll
  for (int rg = 0; rg < 16; ++rg) { const long row = r + d * (t0 + crow(rg, hi));
#pragma unroll
    for (int d0 = 0; d0 < 4; ++d0) st_o(&O[row * 768 + oc + d0 * 32 + r32], o[d0][rg]); }
  if (hi == 0) { const long row = r + d * (t0 + r32); typedef float f32x2_ __attribute__((ext_vector_type(2))); *(ATT_GAS f32x2_*)(ST + row * 12) = (f32x2_){m, Z}; }
  __syncthreads();
}

#if defined(MLA_DMA) && MLA_DMA == 2
#define MLA_BODY attn_pipe192_body
#elif defined(MLA_DMA) && MLA_DMA
#define MLA_BODY attn_dma_body
#else
template <int LDQ, int LDK, int LDO> __device__ __forceinline__ void attn_simple192(const bf16* Qb, const bf16* Kh, const bf16* Kr, const bf16* Vh, const float* cs, OT* Ob, int seq, const float scale, ATT_LAS char* lds) { attn_simple_body<192, LDQ, LDK, LDO>(Qb, Kh, Kr, Vh, cs, Ob, seq, scale, lds); }
#define MLA_BODY attn_simple192
#endif
}
constexpr int S = 8192, D = 2048, NMEM = 256;
constexpr int DIN = 3392, DINP = 3584;
constexpr int PC_DIL = 768, PC_MEM = 3072;
constexpr int QR = 384, KVR = 128, AQ = 512;
constexpr int NUP = 2816;
constexpr int UC_KV = 1280;
constexpr int DFF = 5632, DFE = 7168, NE = 8;
constexpr int MP = 18432;
constexpr float EPS = 1e-6f;
constexpr int NWAVES = 8;

constexpr size_t al256(size_t x) { return (x + 255) / 256 * 256; }
constexpr size_t WS_CTL = 0, CTL_ZERO_BYTES = 1u << 20;
constexpr size_t WS_WIN = WS_CTL + CTL_ZERO_BYTES;
constexpr size_t WS_WUP = WS_WIN + al256((size_t)2 * DINP * D * 2);
constexpr size_t WS_WMEM = WS_WUP + al256((size_t)2 * NUP * AQ * 2);
constexpr size_t WS_WOUT = WS_WMEM + al256((size_t)2 * 1024 * D * 2);
constexpr size_t WS_WGU = WS_WOUT + al256((size_t)2 * D * D * 2);
constexpr size_t WS_WDN = WS_WGU + al256((size_t)2 * DFF * D * 2);
constexpr size_t WS_MGU = WS_WDN + al256((size_t)D * DFF * 2);
constexpr size_t WS_MDN = WS_MGU + al256((size_t)NE * 2 * DFE * D * 2);
constexpr size_t WS_XN = WS_MDN + al256((size_t)NE * D * DFE * 2);
constexpr size_t WS_MEMN = WS_XN + al256((size_t)S * D * 2);
constexpr size_t WS_MEMKV = WS_MEMN + al256((size_t)2 * NMEM * D * 2);
constexpr size_t WS_PROJ = WS_MEMKV + al256((size_t)2 * NMEM * 1024 * 2);
constexpr size_t WS_AQKV = WS_PROJ + al256((size_t)S * DINP * 2);
constexpr size_t WS_KROPE = WS_AQKV + al256((size_t)S * AQ * 2);
constexpr size_t WS_ROPECS = WS_KROPE + al256((size_t)S * 64 * 2);
constexpr size_t WS_QKVM = WS_ROPECS + al256((size_t)S * 64 * 4);
constexpr size_t WS_YPRE = WS_QKVM + al256((size_t)S * NUP * 2);
constexpr size_t WS_DILO = WS_YPRE + al256((size_t)S * D * 4);
constexpr size_t WS_DILS = WS_DILO + al256((size_t)3 * S * 768 * 4);
constexpr size_t WS_Y = WS_DILS + al256((size_t)3 * S * 12 * 4);
constexpr size_t WS_XA = WS_Y + al256((size_t)S * D * 2);
constexpr size_t WS_ROUTE = WS_XA + al256((size_t)S * D * 4);
constexpr size_t WS_XP = WS_ROUTE + al256((size_t)S * 32);
constexpr size_t WS_OUTP = WS_XP + al256((size_t)MP * D * 2);
constexpr size_t WS_ACTP = WS_OUTP + al256((size_t)MP * D * 2);
constexpr size_t WS_OUTQ = WS_ACTP + al256((size_t)MP * DFE * 2);
constexpr size_t WS_END = WS_OUTQ + al256((size_t)4 * 2048 * D * 2);
static_assert(WS_END <= 1879048192ull, "workspace map exceeds 4 x the largest input");
constexpr int CW_BAR = 16384;
constexpr int CW_QUEUE = 8192;
constexpr int CW_CNT = 8192 + 256;
constexpr int CW_QUEUE2 = 65536;
constexpr int CW_CVT = 8192 + 320;
constexpr int CW_DONE = 8192 + 384;
constexpr int CW_CNTW = 53248;
constexpr int CW_TS = 12288;
constexpr int CW_TILEE = 8192 + 512;
constexpr int RING_BYTES = 131072;
constexpr int LDSCTL_OFF = RING_BYTES, MISC_OFF = LDSCTL_OFF + 320;
constexpr int BIAS_OFF = 132096;
constexpr int LDS_BYTES = 147456;
static_assert(BIAS_OFF >= MISC_OFF + 128 && BIAS_OFF + 3 * 6 * 132 * 4 + 4 * 196 * 4 <= LDS_BYTES, "LDS map");

#define GAS __attribute__((address_space(1)))
#define LAS __attribute__((address_space(3)))
typedef unsigned short bf16;
typedef unsigned v4u __attribute__((ext_vector_type(4)));
typedef unsigned v2u __attribute__((ext_vector_type(2)));
typedef float f32x4 __attribute__((ext_vector_type(4)));
typedef short bf16x8 __attribute__((ext_vector_type(8)));
typedef GAS unsigned gu32;
#define RLX_AGENT __ATOMIC_RELAXED, __HIP_MEMORY_SCOPE_AGENT
#define LDS_WAIT() asm volatile("s_waitcnt lgkmcnt(0)" ::: "memory")
#define VM_WAIT() asm volatile("s_waitcnt vmcnt(0)" ::: "memory")
__device__ __forceinline__ unsigned f2bf(float f) { unsigned u = __builtin_bit_cast(unsigned, f); return (u + 0x7fffu + ((u >> 16) & 1u)) >> 16; }
__device__ __forceinline__ unsigned pk2(float lo, float hi) { return f2bf(lo) | (f2bf(hi) << 16); }
__device__ __forceinline__ float bflo(unsigned w) { return __uint_as_float(w << 16); }
__device__ __forceinline__ float bfhi(unsigned w) { return __uint_as_float(w & 0xffff0000u); }

#ifndef BAR_FLAGS
#define BAR_FLAGS 1
#endif
#define XB_TMO      128
#define XB_XCNT(j)  (256  + 64 * (j))
#define XB_XSUB(j)  (1280 + 64 * (j))
#define XB_XGEN(j)  (2304 + 64 * (j))
#define XB_TOP      3328
#define XB_TOPGEN   3392
#define XCD_BAR_WORDS 3456
#define XB_SPIN_CAP (1u << 18)
__device__ __forceinline__ unsigned xb_ld(unsigned* p)              { return __hip_atomic_load(p, __ATOMIC_RELAXED, __HIP_MEMORY_SCOPE_AGENT); }
__device__ __forceinline__ unsigned xb_add(unsigned* p, unsigned v) { return __hip_atomic_fetch_add(p, v, __ATOMIC_RELAXED, __HIP_MEMORY_SCOPE_AGENT); }
__device__ __forceinline__ unsigned xb_xcc_id() { return (unsigned)__builtin_amdgcn_s_getreg((3 << 11) | 20) & 0xFu; }
#define XB_SPIN(cond, bar) do { unsigned _sp = 0; while (cond) { __builtin_amdgcn_s_sleep(1); \
    if ((++_sp & 255u) == 0u) { if (xb_ld(&(bar)[XB_TMO])) break; if (_sp > XB_SPIN_CAP) { atomicAdd(&(bar)[XB_TMO], 1u); break; } } } } while (0)
struct XcdBarrier { unsigned* bar; unsigned x; volatile LAS unsigned* st; };
__device__ __forceinline__ XcdBarrier xcd_barrier_post(unsigned* bar, volatile LAS unsigned* st) {
    XcdBarrier b; b.bar = bar; b.x = xb_xcc_id(); b.st = st;
    if (threadIdx.x == 0) (void)xb_add(&bar[XB_XCNT(b.x)], 1u);
    return b;
}
__device__ __forceinline__ void xcd_barrier_complete(unsigned* bar, unsigned x, unsigned& nloc, unsigned& nx, unsigned& mask) {
    const unsigned G = gridDim.x * gridDim.y * gridDim.z;
    unsigned sum, cnt, mine, msk, sp = 0u;
    for (;;) {
        sum = 0u; cnt = 0u; mine = 0u; msk = 0u;
#pragma unroll
        for (unsigned j = 0; j < 16; ++j) { const unsigned c = xb_ld(&bar[XB_XCNT(j)]); sum += c; cnt += (c > 0u) ? 1u : 0u; msk |= (c > 0u) ? (1u << j) : 0u; mine = (j == x) ? c : mine; }
        if (sum == G) break;
        __builtin_amdgcn_s_sleep(1);
        if ((++sp & 255u) == 0u) { if (xb_ld(&bar[XB_TMO])) break; if (sp > XB_SPIN_CAP) { atomicAdd(&bar[XB_TMO], 1u); break; } }
    }
    nloc = mine > 0u ? mine : 1u; nx = cnt > 0u ? cnt : 1u; mask = msk;
}
#if BAR_FLAGS
#define XB_XFLAG(j) (3456 + (j))
template <int MODE = 0>
__device__ __forceinline__ void xcd_barrier(const XcdBarrier& b) {
    asm volatile("s_waitcnt vmcnt(0)" ::: "memory");
    __syncthreads();
    if (threadIdx.x < 64) {
        unsigned* bar = b.bar; const unsigned lane = threadIdx.x;
        unsigned gen1 = 0u, mask = 0u; bool leader = false;
        if (lane == 0) {
            __builtin_amdgcn_s_waitcnt(0);
#if BAR_FLAGS == 2
            asm volatile("buffer_inv sc1" ::: "memory");
#endif
            unsigned nloc = b.st[0], nx = b.st[1]; mask = b.st[2];
            if (nloc == 0u) { xcd_barrier_complete(bar, b.x, nloc, nx, mask); b.st[0] = nloc; b.st[1] = nx; b.st[2] = mask; }
            const unsigned old = xb_add(&bar[XB_XSUB(b.x)], 1u);
            const unsigned gen = old / nloc; gen1 = gen + 1u;
            if (old + 1u == gen1 * nloc) { leader = true;
                if (!(MODE & 1)) __builtin_amdgcn_fence(__ATOMIC_RELEASE, "agent");
                asm volatile("s_waitcnt vmcnt(0)" ::: "memory");
#if BAR_FLAGS == 2
                asm volatile("buffer_inv sc1\n\ts_waitcnt vmcnt(0)" ::: "memory");
#endif
                __hip_atomic_store(&bar[XB_XFLAG(b.x)], gen1, __ATOMIC_RELAXED, __HIP_MEMORY_SCOPE_AGENT);
            }
        }
        gen1 = (unsigned)__builtin_amdgcn_readfirstlane((int)gen1); mask = (unsigned)__builtin_amdgcn_readfirstlane((int)mask);
        unsigned sp = 0u;
        for (;;) {
            bool ok = true;
            if (lane < 16) { const unsigned f = xb_ld(&bar[XB_XFLAG(lane)]); ok = (((mask >> lane) & 1u) == 0u) || ((int)(f - gen1) >= 0); }
            if (__all(ok)) break;
            __builtin_amdgcn_s_sleep(1);
            if ((++sp & 255u) == 0u) { if (xb_ld(&bar[XB_TMO])) break; if (sp > XB_SPIN_CAP) { if (lane == 0) atomicAdd(&bar[XB_TMO], 1u); break; } }
        }
#if BAR_FLAGS != 2
        if (!(MODE & 2)) { if (!(MODE & 4) || __builtin_amdgcn_readfirstlane((int)leader)) __builtin_amdgcn_fence(__ATOMIC_ACQUIRE, "agent"); }
#endif
        asm volatile("s_waitcnt vmcnt(0)" ::: "memory");
    }
    __syncthreads();
}
#else
__device__ __forceinline__ void xcd_barrier(const XcdBarrier& b) {
    asm volatile("s_waitcnt vmcnt(0)" ::: "memory");
    __syncthreads();
    if (threadIdx.x == 0) {
        unsigned* bar = b.bar;
        __builtin_amdgcn_s_waitcnt(0);
        unsigned nloc = b.st[0], nx = b.st[1], mask_;
        if (nloc == 0u) { xcd_barrier_complete(bar, b.x, nloc, nx, mask_); b.st[0] = nloc; b.st[1] = nx; }
        const unsigned old = xb_add(&bar[XB_XSUB(b.x)], 1u);
        const unsigned gen = old / nloc;
        if (old + 1u == (gen + 1u) * nloc) {
            __builtin_amdgcn_fence(__ATOMIC_RELEASE, "agent");
            asm volatile("s_waitcnt vmcnt(0)" ::: "memory");
            const unsigned og = xb_add(&bar[XB_TOP], 1u);
            const unsigned tg = og / nx;
            if (og + 1u == (tg + 1u) * nx) xb_add(&bar[XB_TOPGEN], 1u);
            else XB_SPIN(xb_ld(&bar[XB_TOPGEN]) == tg, bar);
            __builtin_amdgcn_fence(__ATOMIC_ACQUIRE, "agent");
            xb_add(&bar[XB_XGEN(b.x)], 1u);
            asm volatile("s_waitcnt vmcnt(0)" ::: "memory");
        } else {
            XB_SPIN(xb_ld(&bar[XB_XGEN(b.x)]) == gen, bar);
            __builtin_amdgcn_fence(__ATOMIC_ACQUIRE, "agent");
            asm volatile("s_waitcnt vmcnt(0)" ::: "memory");
        }
    }
    __syncthreads();
}
#endif

struct Args {
    const float* in[23]; float* out; unsigned char* ws;
    float invf[32];
    int ph_lo, ph_hi, li, rep;
};
struct Frame {
    LAS unsigned char* lds;
    volatile LAS unsigned* MISC;
    gu32* ctl;
    int tid, lane, wave, G, gw, NGW;
    unsigned char* ws;
};
__device__ __forceinline__ float wave_sum(float v) {
#pragma unroll
    for (int o = 1; o < 64; o <<= 1) v += __shfl_xor(v, o);
    return v;
}
__device__ __forceinline__ float wave_max(float v) {
#pragma unroll
    for (int o = 1; o < 64; o <<= 1) v = fmaxf(v, __shfl_xor(v, o));
    return v;
}

__device__ __forceinline__ unsigned pk4_fp8(float a, float b, float c, float d) { int w = 0; w = __builtin_amdgcn_cvt_pk_fp8_f32(a, b, w, false); w = __builtin_amdgcn_cvt_pk_fp8_f32(c, d, w, true); return (unsigned)w; }
#if defined(CVT_REG) && CVT_REG
__device__ __forceinline__ void cvt_load(const float* __restrict__ W, int N, int k0, int n0, int lane, f32x4 (&v)[8]) {
    const GAS float* p = (const GAS float*)(W + (size_t)(k0 + (lane >> 5) * 32) * N + n0 + (lane & 31));
#pragma unroll
    for (int i = 0; i < 8; ++i)
#pragma unroll
        for (int e = 0; e < 4; ++e) v[i][e] = __builtin_nontemporal_load(p + (size_t)(i * 4 + e) * N);
}
template <bool FP8>
__device__ __forceinline__ void cvt_finish(const f32x4 (&v)[8], int k0, void* __restrict__ dstv, int ldd, int drow0, int kdst0, LAS float* scr, int lane, float wsc) {
    const int n = lane & 31, kh = (lane >> 5) * 32;
    if constexpr (FP8) { GAS v4u* d = (GAS v4u*)((unsigned char*)dstv + (size_t)(drow0 + n) * ldd + kdst0 + k0 + kh);
#pragma unroll
        for (int j = 0; j < 2; ++j) { v4u o;
            o.x = pk4_fp8(v[4 * j][0] * wsc, v[4 * j][1] * wsc, v[4 * j][2] * wsc, v[4 * j][3] * wsc); o.y = pk4_fp8(v[4 * j + 1][0] * wsc, v[4 * j + 1][1] * wsc, v[4 * j + 1][2] * wsc, v[4 * j + 1][3] * wsc);
            o.z = pk4_fp8(v[4 * j + 2][0] * wsc, v[4 * j + 2][1] * wsc, v[4 * j + 2][2] * wsc, v[4 * j + 2][3] * wsc); o.w = pk4_fp8(v[4 * j + 3][0] * wsc, v[4 * j + 3][1] * wsc, v[4 * j + 3][2] * wsc, v[4 * j + 3][3] * wsc);
            __builtin_nontemporal_store(o, d + j); } }
    else { GAS v4u* d = (GAS v4u*)((bf16*)dstv + (size_t)(drow0 + n) * ldd + kdst0 + k0 + kh);
#pragma unroll
        for (int j = 0; j < 4; ++j) { v4u o; o.x = pk2(v[2 * j][0], v[2 * j][1]); o.y = pk2(v[2 * j][2], v[2 * j][3]); o.z = pk2(v[2 * j + 1][0], v[2 * j + 1][1]); o.w = pk2(v[2 * j + 1][2], v[2 * j + 1][3]);
            __builtin_nontemporal_store(o, d + j); } }
}
#else
__device__ __forceinline__ void cvt_load(const float* __restrict__ W, int N, int k0, int n0, int lane, f32x4 (&v)[8]) {
    const int lr = lane >> 3, lc = (lane & 7) * 4;
#pragma unroll
    for (int i = 0; i < 8; ++i) v[i] = __builtin_nontemporal_load((const GAS f32x4*)(W + (size_t)(k0 + i * 8 + lr) * N + n0 + lc));
}
template <bool FP8>
__device__ __forceinline__ void cvt_finish(const f32x4 (&v)[8], int k0, void* __restrict__ dstv, int ldd, int drow0, int kdst0, LAS float* scr, int lane, float wsc) {
    const int lr = lane >> 3, lc = (lane & 7) * 4;
#pragma unroll
    for (int i = 0; i < 8; ++i) { LAS float* s = scr + (i * 8 + lr) * 33 + lc; s[0] = v[i][0]; s[1] = v[i][1]; s[2] = v[i][2]; s[3] = v[i][3]; }
    LDS_WAIT(); asm volatile("" ::: "memory");
    const int c = lane & 7;
#pragma unroll
    for (int j = 0; j < 4; ++j) { const int n = (lane >> 3) + 8 * j; const LAS float* s = scr + (8 * c) * 33 + n;
        if constexpr (FP8) { v2u o; o.x = pk4_fp8(s[0 * 33] * wsc, s[1 * 33] * wsc, s[2 * 33] * wsc, s[3 * 33] * wsc); o.y = pk4_fp8(s[4 * 33] * wsc, s[5 * 33] * wsc, s[6 * 33] * wsc, s[7 * 33] * wsc);
            __builtin_nontemporal_store(o, (GAS v2u*)((unsigned char*)dstv + (size_t)(drow0 + n) * ldd + kdst0 + k0 + 8 * c)); }
        else { v4u o; o.x = pk2(s[0 * 33], s[1 * 33]); o.y = pk2(s[2 * 33], s[3 * 33]); o.z = pk2(s[4 * 33], s[5 * 33]); o.w = pk2(s[6 * 33], s[7 * 33]);
            __builtin_nontemporal_store(o, (GAS v4u*)((bf16*)dstv + (size_t)(drow0 + n) * ldd + kdst0 + k0 + 8 * c)); } }
    LDS_WAIT(); asm volatile("" ::: "memory");
}
#endif
__device__ __forceinline__ int cvt_drow(int mode, int n0, int roff) { return mode == 0 ? n0 + roff : (mode == 1 ? (n0 >> 7) * 256 + (n0 & 127) : (mode == 2 ? (n0 >> 7) * 256 + 128 + (n0 & 127) : (n0 < 576 ? n0 : n0 + 192))); }
template <bool FP8>
__device__ __forceinline__ void cvt_job(Frame& F, const float* W, int K, int N, void* dst, int ldd, int kdst0, int mode, int roff, LAS float* scr, float wsc) {
    const int nnb = N / 32, nitems = (K / 64) * nnb;
    int it = F.gw; if (it >= nitems) return;
    f32x4 va[8], vb[8];
    cvt_load(W, N, (it / nnb) * 64, (it % nnb) * 32, F.lane, va);
    for (;;) {
        const int it1 = it + F.NGW; if (it1 < nitems) cvt_load(W, N, (it1 / nnb) * 64, (it1 % nnb) * 32, F.lane, vb);
        cvt_finish<FP8>(va, (it / nnb) * 64, dst, ldd, cvt_drow(mode, (it % nnb) * 32, roff), kdst0, scr, F.lane, wsc);
        if (it1 >= nitems) break;
        const int it2 = it1 + F.NGW; if (it2 < nitems) cvt_load(W, N, (it2 / nnb) * 64, (it2 % nnb) * 32, F.lane, va);
        cvt_finish<FP8>(vb, (it1 / nnb) * 64, dst, ldd, cvt_drow(mode, (it1 % nnb) * 32, roff), kdst0, scr, F.lane, wsc);
        if (it2 >= nitems) break;
        it = it2;
    }
}
__device__ __forceinline__ void rms_row_to_bf16(const float* xrow, const float* g, bf16* orow, int lane) {
    const GAS f32x4* xr = (const GAS f32x4*)xrow + lane; const GAS f32x4* gr = (const GAS f32x4*)g + lane;
    f32x4 v[8]; float s = 0.f;
#pragma unroll
    for (int j = 0; j < 8; ++j) { v[j] = xr[64 * j]; s += (v[j].x * v[j].x + v[j].y * v[j].y) + (v[j].z * v[j].z + v[j].w * v[j].w); }
    const float rstd = 1.f / sqrtf(wave_sum(s) * (1.f / D) + EPS);
    GAS v2u* o8 = (GAS v2u*)orow + lane;
#pragma unroll
    for (int j = 0; j < 8; ++j) { const f32x4 gg = gr[64 * j]; v2u w; w.x = pk2(v[j].x * rstd * gg.x, v[j].y * rstd * gg.y); w.y = pk2(v[j].z * rstd * gg.z, v[j].w * rstd * gg.w); o8[64 * j] = w; }
}
__device__ __forceinline__ void rms_row_to_fp8(const float* xrow, const float* g, unsigned char* orow, int lane) {
    const GAS f32x4* xr = (const GAS f32x4*)xrow + lane; const GAS f32x4* gr = (const GAS f32x4*)g + lane;
    f32x4 v[8]; float s = 0.f;
#pragma unroll
    for (int j = 0; j < 8; ++j) { v[j] = xr[64 * j]; s += (v[j].x * v[j].x + v[j].y * v[j].y) + (v[j].z * v[j].z + v[j].w * v[j].w); }
    const float rstd = 1.f / sqrtf(wave_sum(s) * (1.f / D) + EPS);
    GAS unsigned* o4 = (GAS unsigned*)orow + lane;
#pragma unroll
    for (int j = 0; j < 8; ++j) { const f32x4 gg = gr[64 * j]; o4[64 * j] = pk4_fp8(v[j].x * rstd * gg.x, v[j].y * rstd * gg.y, v[j].z * rstd * gg.z, v[j].w * rstd * gg.w); }
}
__device__ __forceinline__ void sincos_f64(float ang, float& c, float& s) {
    const double a = (double)ang, twopi = 6.283185307179586476925286766559, inv2pi = 0.15915494309189533576888376337251;
    const double q = __builtin_rint(a * inv2pi); const double r = a - q * twopi;
    const double r2 = r * r; double ss = 1.0, cc = 1.0;
#pragma unroll
    for (int k = 14; k >= 1; --k) { ss = 1.0 - r2 * (1.0 / (double)((2 * k) * (2 * k + 1))) * ss; cc = 1.0 - r2 * (1.0 / (double)((2 * k - 1) * (2 * k))) * cc; }
    s = (float)(r * ss); c = (float)cc;
}
__device__ const unsigned char DIL_BUCKET[3][129] = {
 {11,11,11,11,11,11,11,11,11,11,11,11,11,11,11,10,10,10,10,10,10,10,10,10,10,10,10,10,10,10,10,10,10,10,10,10,10,10,9,9,9,9,9,9,9,9,9,9,9,9,8,8,8,8,8,8,8,7,6,5,4,3,2,1,0,17,18,19,20,21,22,23,24,24,24,24,24,24,24,25,25,25,25,25,25,25,25,25,25,25,25,26,26,26,26,26,26,26,26,26,26,26,26,26,26,26,26,26,26,26,26,26,26,26,27,27,27,27,27,27,27,27,27,27,27,27,27,27,27},
 {13,13,13,13,13,13,13,13,13,13,13,13,13,13,13,13,13,13,13,13,13,13,13,12,12,12,12,12,12,12,12,12,12,12,12,12,12,12,12,12,12,12,11,11,11,11,11,11,11,11,11,11,10,10,10,10,10,10,9,9,9,8,8,4,0,20,24,24,25,25,25,26,26,26,26,26,26,27,27,27,27,27,27,27,27,27,27,28,28,28,28,28,28,28,28,28,28,28,28,28,28,28,28,28,28,28,29,29,29,29,29,29,29,29,29,29,29,29,29,29,29,29,29,29,29,29,29,29,29},
 {15,15,15,15,15,15,15,15,15,15,15,15,15,15,15,15,15,15,15,15,15,15,15,15,15,15,15,15,15,15,14,14,14,14,14,14,14,14,14,14,14,14,14,14,14,13,13,13,13,13,13,13,13,13,12,12,12,12,12,11,11,10,10,9,0,25,26,26,27,27,28,28,28,28,28,29,29,29,29,29,29,29,29,29,30,30,30,30,30,30,30,30,30,30,30,30,30,30,30,31,31,31,31,31,31,31,31,31,31,31,31,31,31,31,31,31,31,31,31,31,31,31,31,31,31,31,31,31,31}};

typedef float f32x2 __attribute__((ext_vector_type(2)));
#ifndef PRE_ROWS
#define PRE_ROWS 4
#endif
#ifndef COMB_ROWS
#define COMB_ROWS 2
#endif
__device__ __forceinline__ f32x4 ld_r4(const float* p) { return *(const GAS f32x4*)p; }
__device__ __forceinline__ v2u ld_r4(const unsigned short* p) { return *(const GAS v2u*)p; }
__device__ __forceinline__ f32x4 cv4(f32x4 r) { return r; }
__device__ __forceinline__ f32x4 cv4(v2u w) { return (f32x4){bflo(w.x), bfhi(w.x), bflo(w.y), bfhi(w.y)}; }
__device__ __forceinline__ f32x4 ld_o4(const float* p) { return *(const GAS f32x4*)p; }
__device__ __forceinline__ f32x4 ld_o4(const unsigned short* p) { const v2u w = *(const GAS v2u*)p; return (f32x4){bflo(w.x), bfhi(w.x), bflo(w.y), bfhi(w.y)}; }
#ifndef CVT_CHUNK
#define CVT_CHUNK 64
#endif
#ifndef PH_MASK
#define PH_MASK 0xFFFFu
#endif
#ifndef REPEAT_PHASE
#define REPEAT_PHASE -1
#endif
#ifndef ATT_EN
#define ATT_EN 7
#endif
#define PEN(k) ((PH_MASK >> (k)) & 1u)
#ifndef FFN_FP8
#define FFN_FP8 3
#endif
constexpr bool F8D = (FFN_FP8 & 1) != 0, F8M = (FFN_FP8 & 2) != 0;
constexpr int EBD = F8D ? 1 : 2, EBM = F8M ? 1 : 2;
template <bool B> struct Sc { static constexpr float w_gu = B ? 32.f : 1.f, w_dn = B ? 64.f : 1.f, a_sc = B ? 4.f : 1.f, dn = 1.f / (w_dn * a_sc); };
template <bool B> using FfnEpi1 = typename std::conditional<B, pg8::EpiSwiGLU8, pg8::EpiSwiGLU>::type;
template <bool B> struct Epi1Maker;
template <> struct Epi1Maker<true> { static __device__ __forceinline__ pg8::EpiSwiGLU8 make(void* O, int ldc) { return pg8::EpiSwiGLU8{(unsigned char*)O, ldc, 1.f / Sc<true>::w_gu, Sc<true>::a_sc}; } };
template <> struct Epi1Maker<false> { static __device__ __forceinline__ pg8::EpiSwiGLU make(void* O, int ldc) { return pg8::EpiSwiGLU{(unsigned short*)O, ldc}; } };

constexpr int MOE_MAT_ITEMS = 7168, MOE_GU_ITEMS = 16 * MOE_MAT_ITEMS, MOE_NITEMS = 24 * MOE_MAT_ITEMS, MOE_CHUNK = CVT_CHUNK, MOE_NCHUNK = MOE_NITEMS / MOE_CHUNK;
struct MoeItem { const float* W; void* dst; int N, k0, n0, ldd, drow0; float wsc; };
typedef const __attribute__((address_space(4))) Args* KArgs;
__device__ __forceinline__ MoeItem moe_item(KArgs ka, unsigned char* ws, int idx) {
    MoeItem m;
    if (idx < MOE_GU_ITEMS) { const int mat = idx / MOE_MAT_ITEMS, local = idx % MOE_MAT_ITEMS, e = mat >> 1, up = mat & 1, kb = local / (DFE / 32), nb = local % (DFE / 32);
        m.W = ka->in[19 + up] + (size_t)e * D * DFE; m.N = DFE; m.k0 = kb * 64; m.n0 = nb * 32; m.dst = ws + WS_MGU + (size_t)e * 2 * DFE * D * EBM; m.ldd = D;
        m.drow0 = (m.n0 >> 7) * 256 + up * 128 + (m.n0 & 127); m.wsc = Sc<F8M>::w_gu; }
    else { const int i2 = idx - MOE_GU_ITEMS, e = i2 / MOE_MAT_ITEMS, local = i2 % MOE_MAT_ITEMS, kb = local / (D / 32), nb = local % (D / 32);
        m.W = ka->in[21] + (size_t)e * DFE * D; m.N = D; m.k0 = kb * 64; m.n0 = nb * 32; m.dst = ws + WS_MDN + (size_t)e * D * DFE * EBM; m.ldd = DFE; m.drow0 = m.n0; m.wsc = Sc<F8M>::w_dn; }
    return m;
}
__device__ __forceinline__ void moe_cvt_chunk(Frame& F, KArgs ka, int c) {
    LAS float* scr = (LAS float*)(F.lds + F.wave * 16384);
    const int i0 = c * MOE_CHUNK + F.wave * (MOE_CHUNK / 8);
    f32x4 va[8], vb[8], vc[8]; MoeItem ma, mb, mc;
#define MC_L(m, v, i) do { m = moe_item(ka, F.ws, i0 + (i)); cvt_load(m.W, m.N, m.k0, m.n0, F.lane, v); } while (0)
#define MC_F(m, v) cvt_finish<F8M>(v, m.k0, m.dst, m.ldd, m.drow0, 0, scr, F.lane, m.wsc)
    MC_L(ma, va, 0); MC_L(mb, vb, 1); MC_L(mc, vc, 2);
    if constexpr (MOE_CHUNK == 64) {
        MC_F(ma, va); MC_L(ma, va, 3); MC_F(mb, vb); MC_L(mb, vb, 4); MC_F(mc, vc); MC_L(mc, vc, 5);
        MC_F(ma, va); MC_L(ma, va, 6); MC_F(mb, vb); MC_L(mb, vb, 7); MC_F(mc, vc); MC_F(ma, va); MC_F(mb, vb);
    } else {
        MC_F(ma, va); MC_L(ma, va, 3); MC_F(mb, vb); MC_F(mc, vc); MC_F(ma, va);
    }
#undef MC_L
#undef MC_F
}
__device__ __forceinline__ void moe_cvt_fill(Frame& F, KArgs ka, int ph) {
    { int t_ = threadIdx.x; asm volatile("" : "+v"(t_)); F.tid = t_; F.lane = t_ & 63; }
    for (;;) {
        if (F.tid == 0) { unsigned c = MOE_NCHUNK;
            if (ph < 0 || __hip_atomic_load(F.ctl + CW_DONE + ph, RLX_AGENT) < (unsigned)F.G) c = __hip_atomic_fetch_add(F.ctl + CW_CVT + (ph == -2 ? 16 : 0), 1u, RLX_AGENT);
            F.MISC[17] = c; }
        __syncthreads(); const unsigned c = F.MISC[17]; __syncthreads();
        if (c >= (unsigned)MOE_NCHUNK) break;
        moe_cvt_chunk(F, ka, (int)c);
    }
}
#define FILL(ph) do { __syncthreads(); if (F.tid == 0) (void)__hip_atomic_fetch_add(F.ctl + CW_DONE + (ph), 1u, RLX_AGENT); moe_cvt_fill(F, ka, (ph)); } while (0)
#ifndef MLA_DMA
#define MLA_DMA 1
#endif
#ifndef MOE_TAIL
#define MOE_TAIL 1
#endif
#ifndef GEMM_SP2
#define GEMM_SP2 1
#endif
constexpr bool SP2V = (GEMM_SP2 != 0);
#ifndef PROBE_ATT
#define PROBE_ATT 7
#endif
#ifndef FILLMASK
#define FILLMASK 7
#endif
constexpr int PH_PER_LAYER = 11, N_PHASES = 1 + 2 * PH_PER_LAYER;
#ifndef MK_N_LAUNCHES
#define MK_N_LAUNCHES 1
#endif
constexpr int N_LAUNCHES = MK_N_LAUNCHES;

__global__ void __launch_bounds__(NWAVES * 64, 2) mk_fwd(Args) {
    KArgs ka = (KArgs)__builtin_amdgcn_kernarg_segment_ptr(); asm volatile("" : "+s"(ka));
#define args (*ka)
    extern __shared__ __attribute__((aligned(16))) unsigned char lds[];
    Frame F;
    F.lds = (LAS unsigned char*)lds;
    F.MISC = (volatile LAS unsigned*)(F.lds + MISC_OFF);
    F.tid = threadIdx.x; F.lane = F.tid & 63; F.wave = __builtin_amdgcn_readfirstlane(F.tid >> 6);
    F.G = gridDim.x; F.gw = blockIdx.x * NWAVES + F.wave; F.NGW = F.G * NWAVES;
    F.ws = args.ws; F.ctl = (gu32*)(args.ws + WS_CTL);
    unsigned char* ws = args.ws;
    for (int u = F.tid; u < (LDS_BYTES - LDSCTL_OFF) / 4; u += NWAVES * 64) ((LAS unsigned*)(F.lds + LDSCTL_OFF))[u] = 0u;
    __syncthreads();
    XcdBarrier bar; bar.bar = (unsigned*)(F.ctl + CW_BAR) + args.li * 4096; bar.x = 0; bar.st = nullptr;
    if (N_LAUNCHES != N_PHASES) bar = xcd_barrier_post((unsigned*)(F.ctl + CW_BAR) + args.li * 4096, F.MISC + 8);
#define GRID_BAR() do { if (N_LAUNCHES != N_PHASES) xcd_barrier(bar); } while (0)
    const int lo = args.ph_lo, hi = args.ph_hi;
#define IN(k) (lo <= (k) && (k) < hi)
#define BOTH(k) (IN(k) && IN((k) + 1))

#define x_in (args.in[0])
#define XN8 ((unsigned char*)(ws + WS_XN))
#define WIN ((bf16*)(ws + WS_WIN))
#define WUP ((bf16*)(ws + WS_WUP))
#define WMEM ((bf16*)(ws + WS_WMEM))
#define WOUT ((bf16*)(ws + WS_WOUT))
#define WGU ((bf16*)(ws + WS_WGU))
#define WDN ((bf16*)(ws + WS_WDN))
#define MGU ((bf16*)(ws + WS_MGU))
#define MDN ((bf16*)(ws + WS_MDN))
#define XN ((bf16*)(ws + WS_XN))
#define MEMN ((bf16*)(ws + WS_MEMN))
#define MEMKV ((bf16*)(ws + WS_MEMKV))
#define PROJ ((bf16*)(ws + WS_PROJ))
#define AQKV ((bf16*)(ws + WS_AQKV))
#define KROPE ((bf16*)(ws + WS_KROPE))
#define ROPECS ((float*)(ws + WS_ROPECS))
#define QKVM ((bf16*)(ws + WS_QKVM))
#define YPRE ((att::OT*)(ws + WS_YPRE))
#define YPREF ((float*)(ws + WS_YPRE))
#define DILO ((att::OT*)(ws + WS_DILO))
#define DILS ((float*)(ws + WS_DILS))
#define Y ((bf16*)(ws + WS_Y))
#define XA ((float*)(ws + WS_XA))
#define ROUTE ((unsigned*)(ws + WS_ROUTE))
#define XP ((bf16*)(ws + WS_XP))
#define OUTP ((bf16*)(ws + WS_OUTP))
#define OUTQ ((bf16*)(ws + WS_OUTQ))
#define ACTP ((bf16*)(ws + WS_ACTP))
#define ACT ((bf16*)(ws + WS_ACTP))
#if defined(PROBE_T)
#define TSTAMP_AT(p) do { if (threadIdx.x == 0) { ((volatile LAS unsigned*)(F.lds + 131520))[(p)] = (unsigned)__builtin_amdgcn_s_memrealtime(); ((volatile LAS unsigned*)(F.lds + 131520))[32 + (p)] = (unsigned)__builtin_amdgcn_s_memtime(); } } while (0)
#else
#define TSTAMP_AT(p) do { } while (0)
#endif
#define PHASE_BEGIN() do { int t_ = threadIdx.x; asm volatile("" : "+v"(t_)); F.tid = t_; F.lane = t_ & 63; asm volatile("" : "+s"(ka)); } while (0)

    if (PEN(0) && IN(0)) { PHASE_BEGIN(); TSTAMP_AT(0);
        LAS float* scr = (LAS float*)(F.lds + F.wave * 16384);
        { const v4u z = {0u, 0u, 0u, 0u}; const int gt = blockIdx.x * (NWAVES * 64) + F.tid, ngt = F.G * NWAVES * 64;
          for (int l = 0; l < 2; ++l) {
              GAS v4u* w = (GAS v4u*)(WIN + (size_t)l * DINP * D + (size_t)576 * D); for (int i = gt; i < 192 * D / 8; i += ngt) w[i] = z;
              GAS v4u* u = (GAS v4u*)(WUP + (size_t)l * NUP * AQ);
              for (int i = gt; i < NUP * 64; i += ngt) { const int row = i >> 6, c = i & 63; const bool zero = row < 1152 ? (c >= 48) : (row < 1280 ? true : (c < 48)); if (zero) u[i] = z; } } }
        for (int rep = 0; rep < (REPEAT_PHASE == 0 ? 2 : 1); ++rep) {
        for (int l = 0; l < 2; ++l) {
            cvt_job<false>(F, args.in[5] + (size_t)l * D * DIN, D, DIN, WIN + (size_t)l * DINP * D, D, 0, 3, 0, scr, 1.f);
            cvt_job<false>(F, args.in[7] + (size_t)l * QR * 1152, QR, 1152, WUP + (size_t)l * NUP * AQ, AQ, 0, 0, 0, scr, 1.f);
            cvt_job<false>(F, args.in[9] + (size_t)l * KVR * 1536, KVR, 1536, WUP + (size_t)l * NUP * AQ, AQ, QR, 0, UC_KV, scr, 1.f);
            cvt_job<false>(F, args.in[11] + (size_t)l * D * 1024, D, 1024, WMEM + (size_t)l * 1024 * D, D, 0, 0, 0, scr, 1.f);
            cvt_job<false>(F, args.in[13] + (size_t)l * D * D, D, D, WOUT + (size_t)l * D * D, D, 0, 0, 0, scr, 1.f);
        }
        cvt_job<F8D>(F, args.in[15], D, DFF, WGU, D, 0, 1, 0, scr, Sc<F8D>::w_gu);
        cvt_job<F8D>(F, args.in[16], D, DFF, WGU, D, 0, 2, 0, scr, Sc<F8D>::w_gu);
        cvt_job<F8D>(F, args.in[17], DFF, D, WDN, DFF, 0, 0, 0, scr, Sc<F8D>::w_dn);
        }
        { const int* pos = (const int*)args.in[2];
          for (int idx = blockIdx.x * (NWAVES * 64) + F.tid; idx < S * 32; idx += F.G * NWAVES * 64) { const int row = idx >> 5, i = idx & 31;
              const float ang = (float)pos[row] * args.invf[i]; float c, s; sincos_f64(ang, c, s); ROPECS[row * 64 + i] = c; ROPECS[row * 64 + 32 + i] = s; } }
        for (int m = F.gw; m < 2 * NMEM; m += F.NGW) { const int l = m >> 8, r = m & 255; rms_row_to_bf16(args.in[1] + (size_t)r * D, args.in[10] + (size_t)l * D, MEMN + (size_t)m * D, F.lane); }
        for (int m = F.gw; m < S; m += F.NGW) rms_row_to_bf16(x_in + (size_t)m * D, args.in[4], XN + (size_t)m * D, F.lane);
        if (BOTH(0)) GRID_BAR();
    }

    for (int l = 0; l < 2; ++l) {
        const int pb = 1 + l * PH_PER_LAYER;
        if (PEN(1) && IN(pb + 0)) { PHASE_BEGIN(); TSTAMP_AT(pb + 0);
            { pg8::Gemm g{XN, WIN + (size_t)l * DINP * D, 2 * D, 2 * D, D / 64}; pg8::InProjOrder So; So.so.init(S, DINP, F.G, (int)blockIdx.x); So.nextra = (l == 0) ? 8 : 0; So.A2 = MEMN; So.B2 = WMEM;
              pg8::EpiBf16Sel E{PROJ, DINP, MEMKV, 1024};
              pg8::gemm_phase<pg8::EpiBf16Sel, pg8::InProjOrder, true, SP2V>(F.lds, g, So, E); }
            if (FILLMASK & 1) FILL(pb + 0);
            if (BOTH(pb + 0)) GRID_BAR();
        }
        if (PEN(2) && IN(pb + 1)) { PHASE_BEGIN(); TSTAMP_AT(pb + 1);
            const float* gq = args.in[6] + l * QR; const float* gkv = args.in[8] + l * KVR;
            const float* gp = F.lane < 48 ? gq + F.lane * 8 : gkv + (F.lane - 48) * 8;
            const f32x4 g0 = *(const GAS f32x4*)gp, g1 = *(const GAS f32x4*)(gp + 4);
            const int c = F.lane & 7;
            constexpr int PR = PRE_ROWS;
            for (int m0 = F.gw; m0 < S; m0 += PR * F.NGW) {
                v4u w_[PR], kw_[PR]; f32x4 cs_[PR][4];
#pragma unroll
                for (int r = 0; r < PR; ++r) { const int mr = m0 + r * F.NGW, m = mr < S ? mr : m0;
                    w_[r] = *(const GAS v4u*)(PROJ + (size_t)m * DINP + F.lane * 8);
                    kw_[r] = *(const GAS v4u*)(PROJ + (size_t)m * DINP + 512 + c * 8);
                    const float* cs = ROPECS + (size_t)m * 64 + (c & 3) * 8;
                    cs_[r][0] = *(const GAS f32x4*)cs; cs_[r][1] = *(const GAS f32x4*)(cs + 4); cs_[r][2] = *(const GAS f32x4*)(cs + 32); cs_[r][3] = *(const GAS f32x4*)(cs + 36); }
#pragma unroll
                for (int r = 0; r < PR; ++r) { const int m = m0 + r * F.NGW; if (m >= S) break;
                    const v4u w = w_[r];
                    float v[8] = {bflo(w.x), bfhi(w.x), bflo(w.y), bfhi(w.y), bflo(w.z), bfhi(w.z), bflo(w.w), bfhi(w.w)};
                    float sq = 0.f;
#pragma unroll
                    for (int j = 0; j < 8; ++j) sq += v[j] * v[j];
                    const float sq_q = wave_sum(F.lane < 48 ? sq : 0.f), sq_kv = wave_sum(F.lane >= 48 ? sq : 0.f);
                    const float rstd = F.lane < 48 ? 1.f / sqrtf(sq_q * (1.f / QR) + EPS) : 1.f / sqrtf(sq_kv * (1.f / KVR) + EPS);
                    v4u o; o.x = pk2(v[0] * rstd * g0.x, v[1] * rstd * g0.y); o.y = pk2(v[2] * rstd * g0.z, v[3] * rstd * g0.w);
                    o.z = pk2(v[4] * rstd * g1.x, v[5] * rstd * g1.y); o.w = pk2(v[6] * rstd * g1.z, v[7] * rstd * g1.w);
                    *(GAS v4u*)(AQKV + (size_t)m * AQ + F.lane * 8) = o;
                    const v4u kw = kw_[r];
                    float kv[8] = {bflo(kw.x), bfhi(kw.x), bflo(kw.y), bfhi(kw.y), bflo(kw.z), bfhi(kw.z), bflo(kw.w), bfhi(kw.w)};
                    float ko[8];
#pragma unroll
                    for (int j = 0; j < 8; ++j) { const float other = __shfl_xor(kv[j], 4); const float co = cs_[r][j >> 2][j & 3], si = cs_[r][2 + (j >> 2)][j & 3];
                        ko[j] = (c < 4) ? (kv[j] * co - other * si) : (other * si + kv[j] * co); }
                    if (F.lane < 8) { v4u ow; ow.x = pk2(ko[0], ko[1]); ow.y = pk2(ko[2], ko[3]); ow.z = pk2(ko[4], ko[5]); ow.w = pk2(ko[6], ko[7]); *(GAS v4u*)(KROPE + (size_t)m * 64 + c * 8) = ow; }
                }
            }
            if (BOTH(pb + 1)) GRID_BAR();
        }
        if (PEN(3) && IN(pb + 2)) { PHASE_BEGIN(); TSTAMP_AT(pb + 2);
            pg8::Gemm g{AQKV, WUP + (size_t)l * NUP * AQ, 2 * AQ, 2 * AQ, AQ / 64}; pg8::StaticOrder So; So.init(S, NUP, F.G, (int)blockIdx.x);
            pg8::EpiBf16 E{QKVM, NUP, 1.f};
            pg8::gemm_phase<pg8::EpiBf16, pg8::StaticOrder, true, SP2V>(F.lds, g, So, E);
            if (FILLMASK & 2) FILL(pb + 2);
            if (BOTH(pb + 2)) GRID_BAR();
        }
        if (PEN(4) && IN(pb + 3)) { PHASE_BEGIN(); TSTAMP_AT(pb + 3);
            LAS float* BIAS = (LAS float*)(F.lds + BIAS_OFF);
            for (int i = F.tid; i < 3 * 6 * 129; i += NWAVES * 64) { const int b = i / (6 * 129), rem = i % (6 * 129), h = rem / 129, j = rem % 129;
                BIAS[(b * 6 + h) * 132 + j] = args.in[3][DIL_BUCKET[b][j] * 6 + h] * att::LOG2E; }
            __syncthreads();
            for (int rep = 0; rep < (REPEAT_PHASE == 4 ? 2 : 1); ++rep) {
            gu32* qhead = F.ctl + CW_QUEUE + 64 * l + 32 * rep + 4 * args.li;
            constexpr int NU_MLA = 6 * 32, NU_MEM = 4 * 32, NU_DIL = 3 * 6 * 32, NU = NU_MLA + NU_MEM + NU_DIL;
#define QPULL(u) do { if (F.tid == 0) F.MISC[16] = __hip_atomic_fetch_add(qhead, 1u, RLX_AGENT); __syncthreads(); u = (int)F.MISC[16]; __syncthreads(); } while (0)
            int u; QPULL(u);
            if ((ATT_EN & 1) && (!args.rep || (PROBE_ATT & 1))) while (u < NU_MLA) {
                const int h = u >> 5, qb = u & 31;
                att::MLA_BODY<NUP, NUP, D>(QKVM + (size_t)qb * 256 * NUP + h * 192, QKVM + UC_KV + h * 256, KROPE, QKVM + UC_KV + h * 256 + 128,
                                                        ROPECS + (size_t)qb * 256 * 64, YPRE + (size_t)qb * 256 * D + h * 128, S, 0.07216878364870322f, (LAS char*)F.lds);
                QPULL(u);
            }
            if (args.rep && !(PROBE_ATT & 1)) { while (u < NU_MLA) QPULL(u); }
            if ((ATT_EN & 2) && (!args.rep || (PROBE_ATT & 2))) while (u < NU_MLA + NU_MEM) {
                const int v = u - NU_MLA, h = v >> 5, qb = v & 31;
                const bf16* kv = MEMKV + (size_t)l * NMEM * 1024;
                att::attn_dense_body<128, DINP, 1024, D, 1>(PROJ + (size_t)qb * 256 * DINP + PC_MEM + h * 128, kv + h * 128, nullptr, kv + 512 + h * 128,
                                                            nullptr, YPRE + (size_t)qb * 256 * D + 1536 + h * 128, NMEM, 0.08838834764831845f, (LAS char*)F.lds);
                QPULL(u);
            }
            if (args.rep && !(PROBE_ATT & 2)) { while (u < NU_MLA + NU_MEM) QPULL(u); }
            if ((ATT_EN & 4) && (!args.rep || (PROBE_ATT & 4))) while (u < NU) {
                const int w = (u - NU_MLA - NU_MEM) * 8;
                const int b = w / 1536, h = (w % 1536) >> 8, tile = w & 255;
                const int d = b == 0 ? 1 : (b == 1 ? 4 : 16), nT = S / d, tpr = nT / 32;
                const int r = tile / tpr, t0 = (tile % tpr) * 32;
                LAS float* TB = (LAS float*)(F.lds + BIAS_OFF + 3 * 6 * 132 * 4);
                for (int i = F.tid; i < 4 * 196; i += NWAVES * 64) { const int k = i / 196, j = (i % 196) + k - 32; TB[i] = (j >= 0 && j <= 128) ? BIAS[(b * 6 + h) * 132 + j] : -1e30f; }
                __syncthreads();
                att::dil_wg_unit<DINP>(PROJ, PC_DIL + h * 128, PC_DIL + 768 + h * 128, PC_DIL + 1536 + h * 128, d, r, t0, nT,
                                       DILO + (size_t)b * S * 768, h * 128, DILS + (size_t)b * S * 12 + h * 2, (LAS char*)F.lds, TB, 0.08838834764831845f * att::LOG2E);
                QPULL(u);
            }
#undef QPULL
            }
            if (FILLMASK & 4) FILL(pb + 3);
            if (BOTH(pb + 3)) GRID_BAR();
        }
        if (PEN(5) && IN(pb + 4)) { PHASE_BEGIN(); TSTAMP_AT(pb + 4);
            const float* gn = args.in[12] + (size_t)l * D;
            constexpr int CR = COMB_ROWS;
            typedef decltype(ld_r4((const att::OT*)nullptr)) RawO;
            for (int m0 = F.gw; m0 < S; m0 += CR * F.NGW) {
                RawO ya[CR][3], yc[CR][2], ob[CR][3][3]; f32x2 st[CR][3][3];
#pragma unroll
                for (int r = 0; r < CR; ++r) { const int mr = m0 + r * F.NGW, m = mr < S ? mr : m0; const att::OT* yr = YPRE + (size_t)m * D;
#pragma unroll
                    for (int j = 0; j < 3; ++j) ya[r][j] = ld_r4(yr + (F.lane + 64 * j) * 4);
#pragma unroll
                    for (int j = 0; j < 2; ++j) yc[r][j] = ld_r4(yr + 1536 + (F.lane + 64 * j) * 4);
#pragma unroll
                    for (int j = 0; j < 3; ++j) { const int col = (F.lane + 64 * j) * 4, h = col >> 7;
#pragma unroll
                        for (int b = 0; b < 3; ++b) { st[r][j][b] = *(const GAS f32x2*)(DILS + ((size_t)b * S + m) * 12 + h * 2); ob[r][j][b] = ld_r4(DILO + ((size_t)b * S + m) * 768 + col); } } }
#pragma unroll
                for (int r = 0; r < CR; ++r) { const int m = m0 + r * F.NGW; if (m >= S) break;
                    f32x4 a[3]; float sa = 0.f;
#pragma unroll
                    for (int j = 0; j < 3; ++j) { a[j] = cv4(ya[r][j]); sa += (a[j].x * a[j].x + a[j].y * a[j].y) + (a[j].z * a[j].z + a[j].w * a[j].w); }
                    f32x4 c[2]; float sc = 0.f;
#pragma unroll
                    for (int j = 0; j < 2; ++j) { c[j] = cv4(yc[r][j]); sc += (c[j].x * c[j].x + c[j].y * c[j].y) + (c[j].z * c[j].z + c[j].w * c[j].w); }
                    f32x4 bq[3]; float sb = 0.f;
#pragma unroll
                    for (int j = 0; j < 3; ++j) {
                        const float M = fmaxf(st[r][j][0].x, fmaxf(st[r][j][1].x, st[r][j][2].x));
                        float wgt[3], den = 0.f;
#pragma unroll
                        for (int b = 0; b < 3; ++b) { wgt[b] = __builtin_amdgcn_exp2f(st[r][j][b].x - M); den += wgt[b] * st[r][j][b].y; }
                        const float inv = 1.f / den; f32x4 acc = {0.f, 0.f, 0.f, 0.f};
#pragma unroll
                        for (int b = 0; b < 3; ++b) acc += cv4(ob[r][j][b]) * (wgt[b] * inv);
                        bq[j] = acc; sb += (acc.x * acc.x + acc.y * acc.y) + (acc.z * acc.z + acc.w * acc.w); }
                    const float ra = 1.f / sqrtf(wave_sum(sa) * (1.f / 768.f) + EPS), rb = 1.f / sqrtf(wave_sum(sb) * (1.f / 768.f) + EPS), rc = 1.f / sqrtf(wave_sum(sc) * (1.f / 512.f) + EPS);
                    bf16* yo = Y + (size_t)m * D;
#pragma unroll
                    for (int j = 0; j < 3; ++j) { const int col = (F.lane + 64 * j) * 4; const f32x4 g = *(const GAS f32x4*)(gn + col);
                        v2u w; w.x = pk2(a[j].x * ra * g.x, a[j].y * ra * g.y); w.y = pk2(a[j].z * ra * g.z, a[j].w * ra * g.w); *(GAS v2u*)(yo + col) = w; }
#pragma unroll
                    for (int j = 0; j < 3; ++j) { const int col = (F.lane + 64 * j) * 4; const f32x4 g = *(const GAS f32x4*)(gn + 768 + col);
                        v2u w; w.x = pk2(bq[j].x * rb * g.x, bq[j].y * rb * g.y); w.y = pk2(bq[j].z * rb * g.z, bq[j].w * rb * g.w); *(GAS v2u*)(yo + 768 + col) = w; }
#pragma unroll
                    for (int j = 0; j < 2; ++j) { const int col = (F.lane + 64 * j) * 4; const f32x4 g = *(const GAS f32x4*)(gn + 1536 + col);
                        v2u w; w.x = pk2(c[j].x * rc * g.x, c[j].y * rc * g.y); w.y = pk2(c[j].z * rc * g.z, c[j].w * rc * g.w); *(GAS v2u*)(yo + 1536 + col) = w; }
                }
            }
            if (BOTH(pb + 4)) GRID_BAR();
        }
        if (PEN(6) && IN(pb + 5)) { PHASE_BEGIN(); TSTAMP_AT(pb + 5);
            pg8::Gemm g{Y, WOUT + (size_t)l * D * D, 2 * D, 2 * D, D / 64}; pg8::StaticOrder So; So.init(S, D, F.G, (int)blockIdx.x);
            pg8::EpiResF32 E{l == 0 ? x_in : XA, args.rep ? YPREF : XA, D, 1.f};
            pg8::gemm_phase<pg8::EpiResF32, pg8::StaticOrder, true, SP2V>(F.lds, g, So, E);
            if (BOTH(pb + 5)) GRID_BAR();
        }
        if (PEN(7) && IN(pb + 6)) { PHASE_BEGIN(); TSTAMP_AT(pb + 6);
            const float* gf = args.in[14] + (size_t)l * D;
#if defined(PROBE_DEADLINE)
            if (l == 1 && blockIdx.x == 0 && F.tid == 0) F.ctl[CW_CVT + 16] = __hip_atomic_load(F.ctl + CW_CVT, RLX_AGENT);
#endif
            if (l == 0) { for (int m = F.gw; m < S; m += F.NGW) { if constexpr (F8D) rms_row_to_fp8(XA + (size_t)m * D, gf, XN8 + (size_t)m * D, F.lane); else rms_row_to_bf16(XA + (size_t)m * D, gf, XN + (size_t)m * D, F.lane); } }
            else {
                const float* Wr = args.in[18];
                LAS unsigned* LC = (LAS unsigned*)F.lds;
                if (F.tid < NE) LC[F.tid] = 0u;
                LAS f32x4* WL = (LAS f32x4*)(F.lds + 1024);
                for (int i = F.tid; i < 2048 * 2; i += NWAVES * 64) { const int half = i & 1, idx = i >> 1, ln = idx & 63, jq = idx >> 6, j = jq >> 2, q = jq & 3, k = (ln + 64 * j) * 4 + q;
                    WL[i] = *(const GAS f32x4*)(Wr + (size_t)k * NE + half * 4); }
                __syncthreads();
                for (int m = F.gw; m < S; m += F.NGW) {
                    const GAS f32x4* xr = (const GAS f32x4*)(XA + (size_t)m * D) + F.lane; const GAS f32x4* gr = (const GAS f32x4*)gf + F.lane;
                    f32x4 v[8]; float s = 0.f;
#pragma unroll
                    for (int j = 0; j < 8; ++j) { v[j] = xr[64 * j]; s += (v[j].x * v[j].x + v[j].y * v[j].y) + (v[j].z * v[j].z + v[j].w * v[j].w); }
                    const float rstd = 1.f / sqrtf(wave_sum(s) * (1.f / D) + EPS);
                    float lg[8] = {0.f, 0.f, 0.f, 0.f, 0.f, 0.f, 0.f, 0.f};
                    GAS v2u* o8 = (GAS v2u*)(XN + (size_t)m * D) + F.lane; GAS unsigned* o4 = (GAS unsigned*)(XN8 + (size_t)m * D) + F.lane;
#pragma unroll
                    for (int j = 0; j < 8; ++j) { const f32x4 gg = gr[64 * j]; const f32x4 hh = {v[j].x * rstd * gg.x, v[j].y * rstd * gg.y, v[j].z * rstd * gg.z, v[j].w * rstd * gg.w};
                        if constexpr (F8M) o4[64 * j] = pk4_fp8(hh.x, hh.y, hh.z, hh.w); else { v2u w; w.x = pk2(hh.x, hh.y); w.y = pk2(hh.z, hh.w); o8[64 * j] = w; }
#pragma unroll
                        for (int q = 0; q < 4; ++q) { const f32x4 w0 = WL[(((j * 4 + q) * 64) + F.lane) * 2], w1 = WL[(((j * 4 + q) * 64) + F.lane) * 2 + 1]; const float hv = hh[q];
                            lg[0] += hv * w0.x; lg[1] += hv * w0.y; lg[2] += hv * w0.z; lg[3] += hv * w0.w; lg[4] += hv * w1.x; lg[5] += hv * w1.y; lg[6] += hv * w1.z; lg[7] += hv * w1.w; } }
#pragma unroll
                    for (int e = 0; e < NE; ++e) lg[e] = wave_sum(lg[e]);
                    int e1 = 0; float v1 = lg[0];
#pragma unroll
                    for (int e = 1; e < NE; ++e) if (lg[e] > v1) { v1 = lg[e]; e1 = e; }
                    int e2 = -1; float v2 = -3.0e38f;
#pragma unroll
                    for (int e = 0; e < NE; ++e) if (e != e1 && lg[e] > v2) { v2 = lg[e]; e2 = e; }
                    const float g1 = 1.f / (1.f + __expf(v2 - v1)), g2 = 1.f - g1;
                    if (F.lane == 0) { const unsigned s1 = __hip_atomic_fetch_add(LC + e1, 1u, __ATOMIC_RELAXED, __HIP_MEMORY_SCOPE_WORKGROUP), s2 = __hip_atomic_fetch_add(LC + e2, 1u, __ATOMIC_RELAXED, __HIP_MEMORY_SCOPE_WORKGROUP);
                        v4u r0 = {(unsigned)e1, (unsigned)e2, s1, s2}; v4u r1 = {__float_as_uint(g1), __float_as_uint(g2), 0u, 0u};
                        *(GAS v4u*)(ROUTE + (size_t)m * 8) = r0; *(GAS v4u*)(ROUTE + (size_t)m * 8 + 4) = r1; }
                }
                __syncthreads();
                if (F.tid < NE) F.ctl[CW_CNTW + blockIdx.x * NE + F.tid] = LC[F.tid];
            }
            if (BOTH(pb + 6)) GRID_BAR();
        }
        if (PEN(8) && IN(pb + 7)) { PHASE_BEGIN(); TSTAMP_AT(pb + 7);
            if (l == 1) {
                moe_cvt_fill(F, ka, -1);
#if defined(PROBE_DEADLINE)
                for (int r_ = 0; r_ < PROBE_DEADLINE; ++r_) { __syncthreads(); moe_cvt_fill(F, ka, -2); }
#endif
                { LAS unsigned* LT = (LAS unsigned*)F.lds;
                  int tot = 0, bel = 0;
                  for (int w = F.lane; w < F.G; w += 64) { const int c = (int)F.ctl[CW_CNTW + w * NE + F.wave]; tot += c; bel += (w < (int)blockIdx.x) ? c : 0; }
#pragma unroll
                  for (int o = 1; o < 64; o <<= 1) { tot += __shfl_xor(tot, o); bel += __shfl_xor(bel, o); }
                  __syncthreads();
                  if (F.lane == 0) { LT[F.wave] = (unsigned)tot; LT[NE + F.wave] = (unsigned)bel; }
                  __syncthreads(); }
                int base[NE]; int tstart = 0;
#pragma unroll
                for (int e = 0; e < NE; ++e) { const int c = (int)((LAS unsigned*)F.lds)[e]; base[e] = tstart * 256 + (int)((LAS unsigned*)F.lds)[NE + e]; const int nt = (c + 255) >> 8;
                    if (blockIdx.x == 0 && F.tid == 0) { for (int t = 0; t < nt; ++t) F.ctl[CW_TILEE + 1 + tstart + t] = (unsigned)e; }
                    tstart += nt; }
                if (blockIdx.x == 0 && F.tid == 0) F.ctl[CW_TILEE] = (unsigned)tstart;
                for (int m = F.gw; m < S; m += F.NGW) {
                    const v4u r0 = *(const GAS v4u*)(ROUTE + (size_t)m * 8);
                    int p1 = (int)r0.z, p2 = (int)r0.w;
#pragma unroll
                    for (int e = 0; e < NE; ++e) { if ((int)r0.x == e) p1 += base[e]; if ((int)r0.y == e) p2 += base[e]; }
                    if (F.lane == 0) { ROUTE[(size_t)m * 8 + 6] = (unsigned)p1; ROUTE[(size_t)m * 8 + 7] = (unsigned)p2; }
                    const unsigned char* srow = (const unsigned char*)XN8 + (size_t)m * D * EBM; unsigned char* xp = (unsigned char*)XP;
                    const GAS v4u* src = (const GAS v4u*)srow + F.lane; GAS v4u* d1 = (GAS v4u*)(xp + (size_t)p1 * D * EBM) + F.lane; GAS v4u* d2 = (GAS v4u*)(xp + (size_t)p2 * D * EBM) + F.lane;
#pragma unroll
                    for (int j = 0; j < 2 * EBM; ++j) { const v4u t = src[64 * j]; d1[64 * j] = t; d2[64 * j] = t; }
                }
            }
            if (BOTH(pb + 7) && l == 1) GRID_BAR();
        }
        if (PEN(9) && IN(pb + 8)) { PHASE_BEGIN(); TSTAMP_AT(pb + 8);
            if (l == 0) { pg8::Gemm g{XN8, WGU, D * EBD, D * EBD, D * EBD / 128}; pg8::StaticOrder So; So.init(S, 2 * DFF, F.G, (int)blockIdx.x);
                FfnEpi1<F8D> E = Epi1Maker<F8D>::make(ACT, DFF);
                pg8::gemm_phase<FfnEpi1<F8D>, pg8::StaticOrder, true, SP2V, F8D>(F.lds, g, So, E);
                if (FILLMASK & 8) FILL(pb + 8); }
            else { const int ntile = (int)__hip_atomic_load(F.ctl + CW_TILEE, RLX_AGENT);
                pg8::Gemm g{XP, MGU, D * EBM, D * EBM, D * EBM / 128}; pg8::MoeOrder So{F.G, (int)blockIdx.x, 2 * DFE / 256, ntile, 2 * DFE, (const int*)(F.ctl + CW_TILEE + 1)};
                FfnEpi1<F8M> E = Epi1Maker<F8M>::make(ACTP, DFE);
                pg8::gemm_phase<FfnEpi1<F8M>, pg8::MoeOrder, true, SP2V, F8M>(F.lds, g, So, E); }
            if (BOTH(pb + 8)) GRID_BAR();
        }
        if (PEN(10) && IN(pb + 9)) { PHASE_BEGIN(); TSTAMP_AT(pb + 9);
            if (l == 0) { pg8::Gemm g{ACT, WDN, DFF * EBD, DFF * EBD, DFF * EBD / 128}; pg8::StaticOrder So; So.init(S, D, F.G, (int)blockIdx.x);
                pg8::EpiResF32 E{XA, args.rep ? YPREF : XA, D, Sc<F8D>::dn};
                pg8::gemm_phase<pg8::EpiResF32, pg8::StaticOrder, true, SP2V, F8D>(F.lds, g, So, E); }
            else { const int ntile = (int)__hip_atomic_load(F.ctl + CW_TILEE, RLX_AGENT);
                const int pm0 = MOE_TAIL ? ((2 * F.G / 8) < ntile ? (2 * F.G / 8) : ntile) : ntile;
                { pg8::Gemm g{ACTP, MDN, DFE * EBM, DFE * EBM, DFE * EBM / 128}; pg8::MoeOrder So{F.G, (int)blockIdx.x, D / 256, pm0, D, (const int*)(F.ctl + CW_TILEE + 1)};
                  pg8::EpiBf16 E{OUTP, D, Sc<F8M>::dn};
                  pg8::gemm_phase<pg8::EpiBf16, pg8::MoeOrder, true, SP2V, F8M>(F.lds, g, So, E); }
                if (MOE_TAIL && ntile > pm0) { pg8::Gemm g{ACTP, MDN, DFE * EBM, DFE * EBM, DFE * EBM / 512}; pg8::MoeTailOrder So{F.G, (int)blockIdx.x, pm0, ntile - pm0, D, DFE * EBM / 4, (const int*)(F.ctl + CW_TILEE + 1)};
                  pg8::EpiBf16Split E{OUTQ, D, Sc<F8M>::dn, pm0, (size_t)2048 * D};
                  pg8::gemm_phase<pg8::EpiBf16Split, pg8::MoeTailOrder, true, SP2V, F8M>(F.lds, g, So, E); } }
            if (BOTH(pb + 9)) GRID_BAR();
        }
        if (PEN(11) && IN(pb + 10)) { PHASE_BEGIN(); TSTAMP_AT(pb + 10);
            if (l == 0) { for (int m = F.gw; m < S; m += F.NGW) rms_row_to_bf16(XA + (size_t)m * D, args.in[4] + D, XN + (size_t)m * D, F.lane); }
            else {
                const float* gfin = args.in[22];
                const int ntile_f = (int)__hip_atomic_load(F.ctl + CW_TILEE, RLX_AGENT); const int prow0 = (MOE_TAIL ? ((2 * F.G / 8) < ntile_f ? (2 * F.G / 8) : ntile_f) : ntile_f) * 256;
                for (int m = F.gw; m < S; m += F.NGW) {
                    const v4u r1 = *(const GAS v4u*)(ROUTE + (size_t)m * 8 + 4);
                    const float g1 = __uint_as_float(r1.x), g2 = __uint_as_float(r1.y); const int p1 = (int)r1.z, p2 = (int)r1.w;
                    const GAS f32x4* xr = (const GAS f32x4*)(XA + (size_t)m * D) + F.lane;
                    const GAS v2u* o1 = (const GAS v2u*)(OUTP + (size_t)p1 * D) + F.lane; const GAS v2u* o2 = (const GAS v2u*)(OUTP + (size_t)p2 * D) + F.lane;
                    const bool t1 = p1 >= prow0, t2 = p2 >= prow0;
                    const GAS v2u* q1 = (const GAS v2u*)(OUTQ + (size_t)(t1 ? p1 - prow0 : 0) * D) + F.lane; const GAS v2u* q2 = (const GAS v2u*)(OUTQ + (size_t)(t2 ? p2 - prow0 : 0) * D) + F.lane;
                    f32x4 v[8]; float s = 0.f;
                    if (!t1 && !t2) {
#pragma unroll
                        for (int j = 0; j < 8; ++j) { const f32x4 xv = xr[64 * j]; const v2u a = o1[64 * j], b = o2[64 * j];
                            v[j] = xv + (f32x4){bflo(a.x), bfhi(a.x), bflo(a.y), bfhi(a.y)} * g1 + (f32x4){bflo(b.x), bfhi(b.x), bflo(b.y), bfhi(b.y)} * g2;
                            s += (v[j].x * v[j].x + v[j].y * v[j].y) + (v[j].z * v[j].z + v[j].w * v[j].w); }
                    } else
#pragma unroll
                    for (int j = 0; j < 8; ++j) { const f32x4 xv = xr[64 * j]; f32x4 ea, eb;
                        if (!t1) { const v2u a = o1[64 * j]; ea = (f32x4){bflo(a.x), bfhi(a.x), bflo(a.y), bfhi(a.y)}; }
                        else { ea = (f32x4){0.f, 0.f, 0.f, 0.f};
#pragma unroll
                            for (int k = 0; k < 4; ++k) { const v2u a = q1[(size_t)k * (2048 * D / 4) + 64 * j]; ea += (f32x4){bflo(a.x), bfhi(a.x), bflo(a.y), bfhi(a.y)}; } }
                        if (!t2) { const v2u b = o2[64 * j]; eb = (f32x4){bflo(b.x), bfhi(b.x), bflo(b.y), bfhi(b.y)}; }
                        else { eb = (f32x4){0.f, 0.f, 0.f, 0.f};
#pragma unroll
                            for (int k = 0; k < 4; ++k) { const v2u b = q2[(size_t)k * (2048 * D / 4) + 64 * j]; eb += (f32x4){bflo(b.x), bfhi(b.x), bflo(b.y), bfhi(b.y)}; } }
                        v[j] = xv + ea * g1 + eb * g2;
                        s += (v[j].x * v[j].x + v[j].y * v[j].y) + (v[j].z * v[j].z + v[j].w * v[j].w); }
                    const float rstd = 1.f / sqrtf(wave_sum(s) * (1.f / D) + EPS);
                    GAS f32x4* orow = (GAS f32x4*)(args.out + (size_t)m * D) + F.lane; const GAS f32x4* gr = (const GAS f32x4*)gfin + F.lane;
#pragma unroll
                    for (int j = 0; j < 8; ++j) { const f32x4 gg = gr[64 * j]; orow[64 * j] = (f32x4){v[j].x * rstd * gg.x, v[j].y * rstd * gg.y, v[j].z * rstd * gg.z, v[j].w * rstd * gg.w}; }
                }
            }
            if (BOTH(pb + 10) && l == 0) GRID_BAR();
        }
    }
#if defined(PROBE_BARS)
    for (int i_ = 0; i_ < PROBE_BARS; ++i_) xcd_barrier<PROBE_BARMODE>(bar);
#endif
#if defined(PROBE_T)
    if (blockIdx.x == 0 && threadIdx.x == 0) { const unsigned t_end = (unsigned)__builtin_amdgcn_s_memrealtime(); volatile LAS unsigned* ts_ = (volatile LAS unsigned*)(F.lds + 131520); ts_[N_PHASES] = t_end;
#if defined(PROBE_CLK)
        ts_[32 + N_PHASES] = (unsigned)__builtin_amdgcn_s_memtime(); const unsigned dt = (ts_[32 + PROBE_T + 1] - ts_[32 + PROBE_T]) / (16u * PROBE_TK);
#else
        const unsigned dt = ts_[PROBE_T + 1] - ts_[PROBE_T];
#endif
        while ((unsigned)__builtin_amdgcn_s_memrealtime() - t_end < (unsigned)PROBE_TK * dt) __builtin_amdgcn_s_sleep(32); }
#endif
#undef IN
#undef BOTH
#undef GRID_BAR
#undef WIN
#undef WUP
#undef WMEM
#undef WOUT
#undef WGU
#undef WDN
#undef MGU
#undef MDN
#undef XN
#undef MEMN
#undef MEMKV
#undef PROJ
#undef AQKV
#undef KROPE
#undef ROPECS
#undef QKVM
#undef YPRE
#undef YPREF
#undef DILO
#undef DILS
#undef Y
#undef XA
#undef ROUTE
#undef XP
#undef OUTP
#undef OUTQ
#undef ACTP
#undef ACT
#undef x_in
#undef XN8
#undef PHASE_BEGIN
#undef args
#undef FILL
}

extern "C" void kernel_launch(void* const* d_in, const int* in_sizes, int n_in, void* d_out, int out_size, void* d_ws, size_t ws_size, hipStream_t stream) {
    static int grid = 0;
    if (grid == 0) {
        if (n_in != 23 || in_sizes[0] != S * D || out_size != S * D || ws_size < WS_END) { fprintf(stderr, "kernel_launch: shape/workspace mismatch: n_in %d in0 %d out %d ws %zu (need %zu)\n", n_in, n_in > 0 ? in_sizes[0] : -1, out_size, ws_size, (size_t)WS_END); grid = -1; return; }
        int dev = 0, cus = 0, per_cu = 0;
        if (hipGetDevice(&dev) != hipSuccess || hipDeviceGetAttribute(&cus, hipDeviceAttributeMultiprocessorCount, dev) != hipSuccess) { fprintf(stderr, "kernel_launch: device query failed\n"); grid = -1; return; }
        if (hipFuncSetAttribute((const void*)mk_fwd, hipFuncAttributeMaxDynamicSharedMemorySize, LDS_BYTES) != hipSuccess) { fprintf(stderr, "kernel_launch: hipFuncSetAttribute failed\n"); grid = -1; return; }
        if (hipOccupancyMaxActiveBlocksPerMultiprocessor(&per_cu, (const void*)mk_fwd, NWAVES * 64, LDS_BYTES) != hipSuccess || per_cu < 1) { fprintf(stderr, "kernel_launch: occupancy query reports %d workgroups per CU\n", per_cu); }
        (void)hipGetLastError();
        grid = cus;
    }
    if (grid < 0) return;
    (void)hipMemsetAsync((char*)d_ws + WS_CTL, 0, CTL_ZERO_BYTES, stream);
    Args a{};
    for (int i = 0; i < 23; ++i) a.in[i] = (const float*)d_in[i];
    a.out = (float*)d_out; a.ws = (unsigned char*)d_ws;
    for (int i = 0; i < 32; ++i) a.invf[i] = 1.0f / powf(10000.0f, (float)i / 32.0f);
    int lo[8], hi[8], rp[8], nl = 0;
#if defined(PROBE_PHASE) && PROBE_PHASE >= 0
    lo[nl] = 0; hi[nl] = PROBE_PHASE + 1; rp[nl++] = 0;
    for (int r = 0; r < PROBE_REPS; ++r) { lo[nl] = PROBE_PHASE; hi[nl] = PROBE_PHASE + 1; rp[nl++] = 1; }
    if (PROBE_PHASE + 1 < N_PHASES) { lo[nl] = PROBE_PHASE + 1; hi[nl] = N_PHASES; rp[nl++] = 0; }
#else
    if (N_LAUNCHES == N_PHASES) { nl = 0; } else { lo[0] = 0; hi[0] = N_PHASES; rp[0] = 0; nl = 1; }
#endif
    const int total = (N_LAUNCHES == N_PHASES) ? N_PHASES : nl;
    for (int li = 0; li < total; ++li) {
        if (N_LAUNCHES == N_PHASES) { a.ph_lo = li; a.ph_hi = li + 1; a.li = 0; a.rep = 0; } else { a.ph_lo = lo[li]; a.ph_hi = hi[li]; a.li = li; a.rep = rp[li]; }
        hipLaunchKernelGGL(mk_fwd, dim3(grid), dim3(NWAVES * 64), LDS_BYTES, stream, a);
        const hipError_t le = hipPeekAtLastError();
        if (le != hipSuccess) { fprintf(stderr, "kernel_launch: launch %d failed: %s\n", li, hipGetErrorName(le)); break; }
    }
}
```

```cpp
#include <hip/hip_runtime.h>
#include <cstdio>
#include <cstdint>
#include <cmath>
#include <type_traits>
#ifndef MK_N_LAUNCHES
#define MK_N_LAUNCHES 1
#endif
#define REPEAT_PHASE -1
#define FFN_FP8 3
#define PROBE_PHASE -1
#define PROBE_REPS 3
#define FILLMASK 13
#define MLA_DMA 0
#define PROBE_ATT 7
#define GEMM_SP2 1
#define UP_EXACT 1
#define BAR_FLAGS 2
#define PRE_ROWS 4
#define COMB_ROWS 2
#define CVT_CHUNK 32
#define CONV_WGS 1
#define NCV_G 28
#define NCV_U 64
#define NCV_T 64
#define NCV_A 48
#define XA_BF16 0
#define ATT_OBF16 1
#define MOE_TAIL 1
#define CVT_REG 0
#define CVT_BYTE_T 1
#define CVT_FIRST 1
#define CVT_Q0 8
namespace pg8 {
#define PG8_LAS __attribute__((address_space(3)))
typedef unsigned short bf16_t;
typedef short bf16x8 __attribute__((ext_vector_type(8)));
typedef float f32x4 __attribute__((ext_vector_type(4)));
typedef unsigned u32x4 __attribute__((ext_vector_type(4)));
constexpr int BM = 256, BK = 64, HALF = 128, HTB = HALF * BK * 2  , STAGE_BYTES = 8 * HTB, NXCD = 8, WGM = 8;

__host__ __device__ __forceinline__ int lds_byte(int r, int c) { const int st = (r >> 4) * 2 + (c >> 5), rr = r & 15, cc = c & 31, ob = rr * 64 + cc * 2; return st * 1024 + (ob ^ (((ob >> 9) & 1) << 5)); }
__host__ __device__ __forceinline__ void stage_rc(int b, int& R, int& C) { const int st = b / 1024, sb = b % 1024, swz = sb ^ (((sb >> 9) & 1) << 5); R = (st >> 1) * 16 + swz / 64; C = (st & 1) * 32 + (swz % 64) / 2; }
__host__ __device__ __forceinline__ int perm32(int rho) { const int n = rho >> 4, i = rho & 15; return 8 * (i >> 2) + 4 * n + (i & 3); }

struct Unit { int pm, pn; };
struct Gemm { const void* A; const void* Bt; int lda, ldb, nt; };

struct StaticOrder {
    int nM, nN, nwg, G, c;
    __device__ void init(int M, int N, int G_, int c_) { nM = M / BM; nN = N / BM; nwg = nM * nN; G = G_; c = c_; }
    __device__ bool next(int i, Unit& u) const {
        const long L = (long)i * G + c; if (L >= nwg) return false;
        int wgid = (int)L; { const int q = nwg / NXCD, r = nwg % NXCD, xcd = wgid % NXCD, off = wgid / NXCD; wgid = (xcd < r ? xcd * (q + 1) : r * (q + 1) + (xcd - r) * q) + off; }
        const int nig = WGM * nN, gid = wgid / nig, fm = gid * WGM, gsz = (nM - fm) < WGM ? (nM - fm) : WGM;
        u.pm = fm + ((wgid % nig) % gsz); u.pn = (wgid % nig) / gsz; return true;
    }
    __device__ __forceinline__ const char* abase(const Gemm& g, const Unit& u) const { return (const char*)g.A + (size_t)u.pm * BM * g.lda; }
    __device__ __forceinline__ const char* bbase(const Gemm& g, const Unit& u) const { return (const char*)g.Bt + (size_t)u.pn * BM * g.ldb; }
    __device__ __forceinline__ int unit_nt(const Gemm& g, const Unit&) const { return g.nt; }
};
struct InProjOrder {
    StaticOrder so; int nextra; const void* A2; const void* B2;
    __device__ bool next(int i, Unit& u) const { if (so.next(i, u)) return true; const long L = (long)i * so.G + so.c - so.nwg; if (L < 0 || L >= nextra) return false; u.pm = 32 + (int)(L >> 2); u.pn = (int)(L & 3); return true; }
    __device__ __forceinline__ const char* abase(const Gemm& g, const Unit& u) const { return u.pm < 32 ? (const char*)g.A + (size_t)u.pm * BM * g.lda : (const char*)A2 + (size_t)(u.pm - 32) * BM * g.lda; }
    __device__ __forceinline__ const char* bbase(const Gemm& g, const Unit& u) const { return u.pm < 32 ? (const char*)g.Bt + (size_t)u.pn * BM * g.ldb : (const char*)B2 + (size_t)((u.pm - 32) * 1024 + u.pn * BM) * g.ldb; }
    __device__ __forceinline__ int unit_nt(const Gemm& g, const Unit&) const { return g.nt; }
};
struct MemOrder {
    int G, c;
    __device__ bool next(int i, Unit& u) const { const int L = c - (G - 8); if (i != 0 || L < 0 || L >= 8) return false; u.pm = L >> 2; u.pn = L & 3; return true; }
    __device__ __forceinline__ const char* abase(const Gemm& g, const Unit& u) const { return (const char*)g.A + (size_t)u.pm * BM * g.lda; }
    __device__ __forceinline__ const char* bbase(const Gemm& g, const Unit& u) const { return (const char*)g.Bt + (size_t)(u.pm * 1024 + u.pn * BM) * g.ldb; }
    __device__ __forceinline__ int unit_nt(const Gemm& g, const Unit&) const { return g.nt; }
};
struct MoeOrder {
    int G, c, nN, ntile, nexp_rows; const int* tile_e;
    __device__ bool next(int i, Unit& u) const { const long L = (long)i * G + c; if (L >= (long)ntile * nN) return false; u.pm = (int)(L / nN); u.pn = (int)(L % nN); return true; }
    __device__ __forceinline__ const char* abase(const Gemm& g, const Unit& u) const { return (const char*)g.A + (size_t)u.pm * BM * g.lda; }
    __device__ __forceinline__ const char* bbase(const Gemm& g, const Unit& u) const { const int e = __builtin_amdgcn_readfirstlane(tile_e[u.pm]); return (const char*)g.Bt + ((size_t)e * nexp_rows + (size_t)u.pn * BM) * g.ldb; }
    __device__ __forceinline__ int unit_nt(const Gemm& g, const Unit&) const { return g.nt; }
};

struct MoeTailOrder {
    int G, c, pm0, ntail, nexp_rows, kq_bytes; const int* tile_e;
    __device__ bool next(int i, Unit& u) const { const long L = (long)i * G + c; if (L >= (long)ntail * 32) return false; const int ks = (int)(L & 3), rest = (int)(L >> 2); u.pm = pm0 + (rest >> 3); u.pn = (rest & 7) + 8 * ks; return true; }
    __device__ __forceinline__ const char* abase(const Gemm& g, const Unit& u) const { return (const char*)g.A + (size_t)u.pm * BM * g.lda + (size_t)(u.pn >> 3) * kq_bytes; }
    __device__ __forceinline__ const char* bbase(const Gemm& g, const Unit& u) const { const int e = __builtin_amdgcn_readfirstlane(tile_e[u.pm]); return (const char*)g.Bt + ((size_t)e * nexp_rows + (size_t)(u.pn & 7) * BM) * g.ldb + (size_t)(u.pn >> 3) * kq_bytes; }
    __device__ __forceinline__ int unit_nt(const Gemm& g, const Unit&) const { return g.nt; }
};

struct UpProjOrder {
    int G, c;
    __device__ bool next(int i, Unit& u) const { const int L = i * G + c; if (L >= 352) return false;
        int nA = 352 - G; nA = nA < 0 ? 0 : (nA > 192 ? 192 : nA);
        if (L >= nA && L < nA + 160) { const int j = L - nA; u.pm = j & 31; u.pn = j >> 5; }
        else { const int j = L < nA ? L : L - 160; u.pm = j & 31; u.pn = 5 + (j >> 5); }
        return true; }
    __device__ __forceinline__ const char* abase(const Gemm& g, const Unit& u) const { return (const char*)g.A + (size_t)u.pm * BM * g.lda + (u.pn >= 5 ? 768 : 0); }
    __device__ __forceinline__ const char* bbase(const Gemm& g, const Unit& u) const { return (const char*)g.Bt + (size_t)u.pn * BM * g.ldb + (u.pn >= 5 ? 768 : 0); }
    __device__ __forceinline__ int unit_nt(const Gemm&, const Unit& u) const { return u.pn >= 5 ? 2 : 6; }
};

__device__ __forceinline__ unsigned cvt_pk_bf16(float lo, float hi) { unsigned r; asm volatile("v_cvt_pk_bf16_f32 %0, %1, %2" : "=v"(r) : "v"(lo), "v"(hi)); return r; }

struct EpiBf16 {
    static constexpr bool PERM = true;
    bf16_t* O; int ldc; float sc;
    __device__ __forceinline__ void operator()(const f32x4 (&acc)[2][2][4][2], const Unit& u, int wr, int wc, int fr, int fq) const {
        const int row0 = u.pm * BM + wr * 64 + fr, col0 = u.pn * BM + wc * 32 + 8 * fq;
#pragma unroll
        for (int ai = 0; ai < 2; ++ai)
#pragma unroll
            for (int m = 0; m < 4; ++m) { bf16_t* rowp = O + (size_t)(row0 + ai * HALF + m * 16) * ldc + col0;
#pragma unroll
                for (int bj = 0; bj < 2; ++bj) { const f32x4 v0 = acc[ai][bj][m][0] * sc, v1 = acc[ai][bj][m][1] * sc;
                    u32x4 w; w.x = cvt_pk_bf16(v0[0], v0[1]); w.y = cvt_pk_bf16(v0[2], v0[3]); w.z = cvt_pk_bf16(v1[0], v1[1]); w.w = cvt_pk_bf16(v1[2], v1[3]);
                    *(u32x4*)(rowp + bj * HALF) = w; } }
    }
};
struct EpiBf16Split {
    static constexpr bool PERM = true;
    bf16_t* O; int ldc; float sc; int pm0; size_t qstride;
    __device__ __forceinline__ void operator()(const f32x4 (&acc)[2][2][4][2], const Unit& u, int wr, int wc, int fr, int fq) const {
        const int row0 = (u.pm - pm0) * BM + wr * 64 + fr, col0 = (u.pn & 7) * BM + wc * 32 + 8 * fq; bf16_t* base = O + (size_t)(u.pn >> 3) * qstride;
#pragma unroll
        for (int ai = 0; ai < 2; ++ai)
#pragma unroll
            for (int m = 0; m < 4; ++m) { bf16_t* rowp = base + (size_t)(row0 + ai * HALF + m * 16) * ldc + col0;
#pragma unroll
                for (int bj = 0; bj < 2; ++bj) { const f32x4 v0 = acc[ai][bj][m][0] * sc, v1 = acc[ai][bj][m][1] * sc;
                    u32x4 w; w.x = cvt_pk_bf16(v0[0], v0[1]); w.y = cvt_pk_bf16(v0[2], v0[3]); w.z = cvt_pk_bf16(v1[0], v1[1]); w.w = cvt_pk_bf16(v1[2], v1[3]);
                    *(u32x4*)(rowp + bj * HALF) = w; } }
    }
};
struct EpiBf16Sel {
    static constexpr bool PERM = true;
    bf16_t* O; int ldc; bf16_t* O2; int ldc2;
    __device__ __forceinline__ void operator()(const f32x4 (&acc)[2][2][4][2], const Unit& u, int wr, int wc, int fr, int fq) const {
        const bool ex = u.pm >= 32; bf16_t* base = ex ? O2 : O; const int ld = ex ? ldc2 : ldc;
        const int row0 = (ex ? u.pm - 32 : u.pm) * BM + wr * 64 + fr, col0 = u.pn * BM + wc * 32 + 8 * fq;
#pragma unroll
        for (int ai = 0; ai < 2; ++ai)
#pragma unroll
            for (int m = 0; m < 4; ++m) { bf16_t* rowp = base + (size_t)(row0 + ai * HALF + m * 16) * ld + col0;
#pragma unroll
                for (int bj = 0; bj < 2; ++bj) { const f32x4 v0 = acc[ai][bj][m][0], v1 = acc[ai][bj][m][1];
                    u32x4 w; w.x = cvt_pk_bf16(v0[0], v0[1]); w.y = cvt_pk_bf16(v0[2], v0[3]); w.z = cvt_pk_bf16(v1[0], v1[1]); w.w = cvt_pk_bf16(v1[2], v1[3]);
                    *(u32x4*)(rowp + bj * HALF) = w; } }
    }
};
struct EpiResF32 {
    static constexpr bool PERM = false;
    const float* R; float* C; int ldc; float sc;
    __device__ __forceinline__ void operator()(const f32x4 (&acc)[2][2][4][2], const Unit& u, int wr, int wc, int fr, int fq) const {
        const int row0 = u.pm * BM + wr * 64 + fr, col0 = u.pn * BM + wc * 32 + 4 * fq;
#pragma unroll
        for (int ai = 0; ai < 2; ++ai)
#pragma unroll
            for (int m = 0; m < 4; ++m) { const size_t off = (size_t)(row0 + ai * HALF + m * 16) * ldc + col0;
#pragma unroll
                for (int bj = 0; bj < 2; ++bj)
#pragma unroll
                    for (int n = 0; n < 2; ++n) { const f32x4 r = *(const f32x4*)(R + off + bj * HALF + n * 16); *(f32x4*)(C + off + bj * HALF + n * 16) = r + acc[ai][bj][m][n] * sc; } }
    }
};
__device__ __forceinline__ float silu_mul(float g, float u) { return g * u * __builtin_amdgcn_rcpf(1.0f + __builtin_amdgcn_exp2f(-1.4426950408889634f * g)); }
struct EpiSwiGLU {
    static constexpr bool PERM = true;
    bf16_t* O; int ldc;
    __device__ __forceinline__ void operator()(const f32x4 (&acc)[2][2][4][2], const Unit& u, int wr, int wc, int fr, int fq) const {
        const int row0 = u.pm * BM + wr * 64 + fr, col0 = u.pn * HALF + wc * 32 + 8 * fq;
#pragma unroll
        for (int ai = 0; ai < 2; ++ai)
#pragma unroll
            for (int m = 0; m < 4; ++m) { bf16_t* rowp = O + (size_t)(row0 + ai * HALF + m * 16) * ldc + col0;
                const f32x4 g0 = acc[ai][0][m][0], g1 = acc[ai][0][m][1], u0 = acc[ai][1][m][0], u1 = acc[ai][1][m][1];
                u32x4 w; w.x = cvt_pk_bf16(silu_mul(g0[0], u0[0]), silu_mul(g0[1], u0[1])); w.y = cvt_pk_bf16(silu_mul(g0[2], u0[2]), silu_mul(g0[3], u0[3]));
                w.z = cvt_pk_bf16(silu_mul(g1[0], u1[0]), silu_mul(g1[1], u1[1])); w.w = cvt_pk_bf16(silu_mul(g1[2], u1[2]), silu_mul(g1[3], u1[3]));
                *(u32x4*)rowp = w; }
    }
};

typedef int v8i_t __attribute__((ext_vector_type(8)));
__device__ __forceinline__ v8i_t pg8_cat(bf16x8 lo, bf16x8 hi) { typedef int v4i_t __attribute__((ext_vector_type(4))); const v4i_t a = __builtin_bit_cast(v4i_t, lo), b = __builtin_bit_cast(v4i_t, hi); return (v8i_t){a.x, a.y, a.z, a.w, b.x, b.y, b.z, b.w}; }
struct EpiSwiGLU8 {
    static constexpr bool PERM = true;
    unsigned char* O; int ldc; float sc_in, sc_out;
    __device__ __forceinline__ void operator()(const f32x4 (&acc)[2][2][4][2], const Unit& u, int wr, int wc, int fr, int fq) const {
        const int row0 = u.pm * BM + wr * 64 + fr, col0 = u.pn * HALF + wc * 32 + 8 * fq;
#pragma unroll
        for (int ai = 0; ai < 2; ++ai)
#pragma unroll
            for (int m = 0; m < 4; ++m) { unsigned char* rowp = O + (size_t)(row0 + ai * HALF + m * 16) * ldc + col0;
                const f32x4 g0 = acc[ai][0][m][0] * sc_in, g1 = acc[ai][0][m][1] * sc_in, u0 = acc[ai][1][m][0] * (sc_in * sc_out), u1 = acc[ai][1][m][1] * (sc_in * sc_out);
                int w0 = 0, w1 = 0;
                w0 = __builtin_amdgcn_cvt_pk_fp8_f32(silu_mul(g0[0], u0[0]), silu_mul(g0[1], u0[1]), w0, false); w0 = __builtin_amdgcn_cvt_pk_fp8_f32(silu_mul(g0[2], u0[2]), silu_mul(g0[3], u0[3]), w0, true);
                w1 = __builtin_amdgcn_cvt_pk_fp8_f32(silu_mul(g1[0], u1[0]), silu_mul(g1[1], u1[1]), w1, false); w1 = __builtin_amdgcn_cvt_pk_fp8_f32(silu_mul(g1[2], u1[2]), silu_mul(g1[3], u1[3]), w1, true);
                typedef int v2i_t __attribute__((ext_vector_type(2))); *(v2i_t*)rowp = (v2i_t){w0, w1}; }
    }
};
__device__ __forceinline__ void pg8_mfma8(f32x4& c, v8i_t a, v8i_t b, int sc) { asm volatile("v_mfma_scale_f32_16x16x128_f8f6f4 %0, %1, %2, %0, %3, %3 op_sel_hi:[0,0,0]" : "+v"(c) : "v"(a), "v"(b), "v"(sc)); }
template <class Epi, class Sched, bool ALIGN_EPI = false, bool SP2 = false, bool FP8 = false>
__device__ __forceinline__ void gemm_phase(PG8_LAS unsigned char* lds, const Gemm g, const Sched& S, const Epi& E) {
    int tid_ = threadIdx.x; asm volatile("" : "+v"(tid_));
    const int tid = tid_, wid = __builtin_amdgcn_readfirstlane(tid >> 6), lane = tid & 63, wr = wid >> 2, wc = wid & 3, fr = lane & 15, fq = lane >> 4;
    unsigned voffA[2], voffB[2];
#pragma unroll
    for (int i = 0; i < 2; ++i) { int R, C; stage_rc(tid * 16 + i * 8192, R, C); const int Rb = Epi::PERM ? ((R & ~31) + perm32(R & 31)) : R;
        voffA[i] = (unsigned)(R * g.lda + C * 2); voffB[i] = (unsigned)(Rb * g.ldb + C * 2); }
    const size_t kstep = (size_t)(BK * 2);
    const size_t hstepA = (size_t)HALF * g.lda, hstepB = (size_t)HALF * g.ldb;
    const unsigned ldsw = (unsigned)wid * 1024u;
    const int aoff = lds_byte(wr * 64 + fr, fq * 8), boff = lds_byte(wc * 32 + fr, fq * 8);
#define PG8_SA(b, h) (((b) * 2 + (h)) * HTB)
#define PG8_SB(b, h) ((4 + (b) * 2 + (h)) * HTB)
#define PG8_STAGE(bufoff, gbase, voff) do { _Pragma("unroll") for (int _i = 0; _i < 2; ++_i) \
        __builtin_amdgcn_global_load_lds((const unsigned*)((const char*)(gbase) + (voff)[_i]), (PG8_LAS unsigned*)(lds + (bufoff) + ldsw + _i * 8192), 16, 0, 0); } while (0)
#define PG8_LDA(dst, b, h) do { _Pragma("unroll") for (int m = 0; m < 4; ++m) _Pragma("unroll") for (int k = 0; k < 2; ++k) dst[m][k] = *(const PG8_LAS bf16x8*)(lds + PG8_SA(b, h) + aoff + m * 2048 + k * 1024); } while (0)
#define PG8_LDB(dst, b, h) do { _Pragma("unroll") for (int n = 0; n < 2; ++n) _Pragma("unroll") for (int k = 0; k < 2; ++k) dst[n][k] = *(const PG8_LAS bf16x8*)(lds + PG8_SB(b, h) + boff + n * 2048 + k * 1024); } while (0)
#define PG8_MMA(ai, bj, At, Bt) do { __builtin_amdgcn_s_setprio(1); if constexpr (FP8) { _Pragma("unroll") for (int m = 0; m < 4; ++m) _Pragma("unroll") for (int n = 0; n < 2; ++n) \
        pg8_mfma8(acc[ai][bj][m][n], pg8_cat(Bt[n][0], Bt[n][1]), pg8_cat(At[m][0], At[m][1]), sc8); } else { \
        _Pragma("unroll") for (int m = 0; m < 4; ++m) _Pragma("unroll") for (int n = 0; n < 2; ++n) _Pragma("unroll") for (int k = 0; k < 2; ++k) \
        acc[ai][bj][m][n] = __builtin_amdgcn_mfma_f32_16x16x32_bf16(Bt[n][k], At[m][k], acc[ai][bj][m][n], 0, 0, 0); } __builtin_amdgcn_s_setprio(0); } while (0)
#define PG8_WAIT_V(n) asm volatile("s_waitcnt vmcnt(" #n ")" ::: "memory")
#define PG8_WAIT_L(n) asm volatile("s_waitcnt lgkmcnt(" #n ")" ::: "memory")
#define PG8_BAR __builtin_amdgcn_s_barrier()
#define PG8_SCHED __builtin_amdgcn_sched_barrier(0)
    Unit cur, nxt; int ui = 0;
    if (!S.next(0, cur)) return;
    int sc8 = 0x7F7F7F7F; asm volatile("" : "+v"(sc8));
    f32x4 acc[2][2][4][2];
#pragma unroll
    for (int a = 0; a < 2; ++a)
#pragma unroll
        for (int b = 0; b < 2; ++b)
#pragma unroll
            for (int m = 0; m < 4; ++m)
#pragma unroll
                for (int n = 0; n < 2; ++n) acc[a][b][m][n] = (f32x4){0.f, 0.f, 0.f, 0.f};
    bf16x8 At[4][2], B0[2][2], B1[2][2];
    const char* cA = S.abase(g, cur); const char* cB = S.bbase(g, cur);
    if constexpr (SP2) {
        PG8_STAGE(PG8_SB(0, 0), cB, voffB); PG8_STAGE(PG8_SB(0, 1), cB + hstepB, voffB); PG8_STAGE(PG8_SA(0, 0), cA, voffA); PG8_STAGE(PG8_SA(0, 1), cA + hstepA, voffA);
        if (wr == 1) PG8_BAR;
        PG8_WAIT_V(2); PG8_BAR;
        PG8_STAGE(PG8_SB(1, 0), cB + kstep, voffB); PG8_STAGE(PG8_SA(1, 0), cA + kstep, voffA); PG8_STAGE(PG8_SB(1, 1), cB + hstepB + kstep, voffB);
        PG8_WAIT_V(6); PG8_BAR;
    } else {
        PG8_STAGE(PG8_SB(0, 0), cB, voffB); PG8_STAGE(PG8_SA(0, 0), cA, voffA); PG8_STAGE(PG8_SB(0, 1), cB + hstepB, voffB); PG8_STAGE(PG8_SA(0, 1), cA + hstepA, voffA);
        if (wr == 1) PG8_BAR;
        PG8_WAIT_V(4); PG8_BAR;
        PG8_STAGE(PG8_SB(1, 0), cB + kstep, voffB); PG8_STAGE(PG8_SA(1, 0), cA + kstep, voffA); PG8_STAGE(PG8_SB(1, 1), cB + hstepB + kstep, voffB);
        PG8_WAIT_V(6); PG8_BAR;
    }
    for (;;) {
        const bool has_next = S.next(ui + 1, nxt);
        const int nt = S.unit_nt(g, cur);
        const char* nA = has_next ? S.abase(g, nxt) : cA; const char* nB = has_next ? S.bbase(g, nxt) : cB;
        for (int t = 0; t < nt; t += 2) {
            const bool last = (t == nt - 2);
            const char* a1 = cA + (size_t)(t + 1) * kstep;
            const char* a2 = last ? nA : cA + (size_t)(t + 2) * kstep; const char* b2 = last ? nB : cB + (size_t)(t + 2) * kstep;
            const char* a3 = a2 + kstep; const char* b3 = b2 + kstep;
            if constexpr (SP2) {
            PG8_LDB(B0, 0, 0); PG8_LDB(B1, 0, 1); PG8_SCHED; PG8_LDA(At, 0, 0); PG8_STAGE(PG8_SA(1, 1), a1 + hstepA, voffA);
            PG8_WAIT_V(8); PG8_WAIT_L(0); PG8_BAR; PG8_MMA(0, 0, At, B0); PG8_MMA(0, 1, At, B1); PG8_BAR; PG8_SCHED;
            PG8_LDA(At, 0, 1); PG8_STAGE(PG8_SB(0, 0), b2, voffB); PG8_STAGE(PG8_SB(0, 1), b2 + hstepB, voffB); PG8_STAGE(PG8_SA(0, 0), a2, voffA);
            PG8_WAIT_V(8); PG8_WAIT_L(0); PG8_BAR; PG8_MMA(1, 0, At, B0); PG8_MMA(1, 1, At, B1); PG8_BAR; PG8_SCHED;
            PG8_LDB(B0, 1, 0); PG8_LDB(B1, 1, 1); PG8_SCHED; PG8_LDA(At, 1, 0); PG8_STAGE(PG8_SA(0, 1), a2 + hstepA, voffA);
            PG8_WAIT_V(8); PG8_WAIT_L(0); PG8_BAR; PG8_MMA(0, 0, At, B0); PG8_MMA(0, 1, At, B1); PG8_BAR; PG8_SCHED;
            PG8_LDA(At, 1, 1); PG8_STAGE(PG8_SB(1, 0), b3, voffB); PG8_STAGE(PG8_SB(1, 1), b3 + hstepB, voffB); PG8_STAGE(PG8_SA(1, 0), a3, voffA);
            PG8_WAIT_V(8); PG8_WAIT_L(0); PG8_BAR; PG8_MMA(1, 0, At, B0); PG8_MMA(1, 1, At, B1); PG8_BAR; PG8_SCHED;
            } else {
            PG8_LDB(B0, 0, 0); PG8_SCHED; PG8_LDA(At, 0, 0); PG8_STAGE(PG8_SA(1, 1), a1 + hstepA, voffA);
            PG8_WAIT_L(8); PG8_BAR; PG8_WAIT_L(0); PG8_MMA(0, 0, At, B0); PG8_BAR; PG8_SCHED;
            PG8_LDB(B1, 0, 1); PG8_STAGE(PG8_SB(0, 0), b2, voffB);
            PG8_BAR; PG8_WAIT_L(0); PG8_MMA(0, 1, At, B1); PG8_BAR;
            PG8_LDA(At, 0, 1); PG8_STAGE(PG8_SA(0, 0), a2, voffA);
            PG8_BAR; PG8_WAIT_L(0); PG8_MMA(1, 0, At, B0); PG8_BAR; PG8_SCHED;
            PG8_STAGE(PG8_SB(0, 1), b2 + hstepB, voffB);
            PG8_WAIT_V(6); PG8_BAR; PG8_MMA(1, 1, At, B1); PG8_BAR;
            PG8_LDB(B0, 1, 0); PG8_SCHED; PG8_LDA(At, 1, 0); PG8_STAGE(PG8_SA(0, 1), a2 + hstepA, voffA);
            PG8_WAIT_L(8); PG8_BAR; PG8_WAIT_L(0); PG8_MMA(0, 0, At, B0); PG8_BAR; PG8_SCHED;
            PG8_LDB(B1, 1, 1); PG8_STAGE(PG8_SB(1, 0), b3, voffB);
            PG8_BAR; PG8_WAIT_L(0); PG8_MMA(0, 1, At, B1); PG8_BAR;
            PG8_LDA(At, 1, 1); PG8_STAGE(PG8_SA(1, 0), a3, voffA);
            PG8_BAR; PG8_WAIT_L(0); PG8_MMA(1, 0, At, B0); PG8_BAR; PG8_SCHED;
            PG8_STAGE(PG8_SB(1, 1), b3 + hstepB, voffB);
            PG8_WAIT_V(6); PG8_BAR; PG8_MMA(1, 1, At, B1); PG8_BAR;
            }
        }
        if constexpr (ALIGN_EPI) { if (wr == 0) PG8_BAR; }
        if constexpr (FP8) { PG8_SCHED; asm volatile("s_nop 15\n\ts_nop 7" ::: "memory"); PG8_SCHED; }
        E(acc, cur, wr, wc, fr, fq);
        if (!has_next) break;
#pragma unroll
        for (int a = 0; a < 2; ++a)
#pragma unroll
            for (int b = 0; b < 2; ++b)
#pragma unroll
                for (int m = 0; m < 4; ++m)
#pragma unroll
                    for (int n = 0; n < 2; ++n) acc[a][b][m][n] = (f32x4){0.f, 0.f, 0.f, 0.f};
        cur = nxt; cA = nA; cB = nB; ++ui;
        if constexpr (ALIGN_EPI) { if (wr == 1) PG8_BAR; }
    }
    PG8_WAIT_V(0);
    if constexpr (!ALIGN_EPI) { if (wr == 0) PG8_BAR; }
    PG8_BAR;
#undef PG8_SA
#undef PG8_SB
#undef PG8_STAGE
#undef PG8_LDA
#undef PG8_LDB
#undef PG8_MMA
#undef PG8_WAIT_V
#undef PG8_WAIT_L
#undef PG8_BAR
#undef PG8_SCHED
}
}
namespace att {
#define ATT_LAS __attribute__((address_space(3)))
#define ATT_GAS __attribute__((address_space(1)))
typedef unsigned short bf16;
using bf16x8 = __attribute__((ext_vector_type(8))) short;
using s16x4  = __attribute__((ext_vector_type(4))) short;
using f32x16 = __attribute__((ext_vector_type(16))) float;
using f32x4  = __attribute__((ext_vector_type(4))) float;
using u32x4  = __attribute__((ext_vector_type(4))) unsigned;
constexpr int NW = 8, QBLK = 32, KVBLK = 64, DV = 128;
constexpr float LOG2E = 1.4426950408889634f;
#if defined(ATT_OBF16) && ATT_OBF16
typedef unsigned short OT;
#else
typedef float OT;
#endif
#define SBAR() __builtin_amdgcn_sched_barrier(0)
__device__ __forceinline__ int crow(int r, int hi) { return (r & 3) + 8 * (r >> 2) + 4 * hi; }
__device__ __forceinline__ unsigned cvtpk(float lo, float hi) { unsigned r; asm volatile("v_cvt_pk_bf16_f32 %0, %1, %2" : "=v"(r) : "v"(lo), "v"(hi)); return r; }
__device__ __forceinline__ float bf2f(short s) { return __uint_as_float(((unsigned)(unsigned short)s) << 16); }
__device__ __forceinline__ void st_o(float* p, float v) { *p = v; }
__device__ __forceinline__ void st_o(unsigned short* p, float v) { *p = (unsigned short)(cvtpk(v, v) & 0xffffu); }

__device__ __forceinline__ void partialSM(f32x16& p0, f32x16& p1, float& m_reg, float& mn, float& alpha, const float C, const float THRS) {
  float pmax = p0[0];
#pragma unroll
  for (int r = 1; r < 16; ++r) pmax = fmaxf(pmax, p0[r]);
#pragma unroll
  for (int r = 0; r < 16; ++r) pmax = fmaxf(pmax, p1[r]);
  { auto rr = __builtin_amdgcn_permlane32_swap(__float_as_uint(pmax), __float_as_uint(pmax), false, false);
    pmax = fmaxf(__uint_as_float(rr[0]), __uint_as_float(rr[1])); }
  if (__builtin_expect(__all(pmax - m_reg <= THRS), 1)) { mn = m_reg; alpha = 1.f; }
  else { mn = fmaxf(m_reg, pmax); alpha = __builtin_amdgcn_exp2f((m_reg - mn) * C); m_reg = mn; }
  float mnC = -mn * C;
#pragma unroll
  for (int r = 0; r < 16; ++r) p0[r] = fmaf(p0[r], C, mnC);
#pragma unroll
  for (int r = 0; r < 16; ++r) p1[r] = fmaf(p1[r], C, mnC);
#pragma unroll
  for (int r = 0; r < 16; ++r) p0[r] = __builtin_amdgcn_exp2f(p0[r]);
}
#define ATT_PK4(P, BASE, OUT) do { unsigned a0 = cvtpk(P[BASE + 0], P[BASE + 1]), a1 = cvtpk(P[BASE + 2], P[BASE + 3]);   \
    unsigned b0 = cvtpk(P[BASE + 4], P[BASE + 5]), b1 = cvtpk(P[BASE + 6], P[BASE + 7]);                              \
    auto r0 = __builtin_amdgcn_permlane32_swap(a0, b0, false, false); auto r1 = __builtin_amdgcn_permlane32_swap(a1, b1, false, false); \
    u32x4 w = {r0[0], r1[0], r0[1], r1[1]}; OUT = *reinterpret_cast<bf16x8*>(&w); } while (0)
__device__ __forceinline__ void finishSM(f32x16& p0, f32x16& p1, float alpha, float& l_reg, bf16x8& pa0, bf16x8& pa1, bf16x8& pa2, bf16x8& pa3) {
#pragma unroll
  for (int r = 0; r < 16; ++r) p1[r] = __builtin_amdgcn_exp2f(p1[r]);
  float ps = 0;
#pragma unroll
  for (int r = 0; r < 16; ++r) ps += p0[r];
#pragma unroll
  for (int r = 0; r < 16; ++r) ps += p1[r];
  { auto rr = __builtin_amdgcn_permlane32_swap(__float_as_uint(ps), __float_as_uint(ps), false, false);
    ps = __uint_as_float(rr[0]) + __uint_as_float(rr[1]); }
  l_reg = l_reg * alpha + ps;
  ATT_PK4(p0, 0, pa0); ATT_PK4(p0, 8, pa1); ATT_PK4(p1, 0, pa2); ATT_PK4(p1, 8, pa3);
}
template <int RB> __device__ __forceinline__ int kswz(int row, int colB) { return row * RB + (colB ^ ((row & 7) << 4)); }
template <int DQK> __device__ __forceinline__ void qkt(f32x16& p0, f32x16& p1, const ATT_LAS char* Ks, const bf16x8 (&qr)[DQK / 16], int r32, int hi) {
  p0 = f32x16{}; p1 = f32x16{};
#pragma unroll
  for (int d0 = 0; d0 < DQK / 16; ++d0) { const int cb = (d0 * 16 + hi * 8) * 2;
    bf16x8 b0 = *reinterpret_cast<const ATT_LAS bf16x8*>(Ks + kswz<DQK * 2>(r32, cb));
    bf16x8 b1 = *reinterpret_cast<const ATT_LAS bf16x8*>(Ks + kswz<DQK * 2>(32 + r32, cb));
    p0 = __builtin_amdgcn_mfma_f32_32x32x16_bf16(b0, qr[d0], p0, 0, 0, 0);
    p1 = __builtin_amdgcn_mfma_f32_32x32x16_bf16(b1, qr[d0], p1, 0, 0, 0); }
}
__device__ __forceinline__ void qkt192_lq(f32x16& p0, f32x16& p1, const ATT_LAS char* Ks, const bf16x8 (&qr)[8], const ATT_LAS char* Qs, int lane, int r32, int hi) {
  p0 = f32x16{}; p1 = f32x16{};
#pragma unroll
  for (int d0 = 0; d0 < 12; ++d0) { const int cb = (d0 * 16 + hi * 8) * 2;
    bf16x8 b0 = *reinterpret_cast<const ATT_LAS bf16x8*>(Ks + kswz<384>(r32, cb));
    bf16x8 b1 = *reinterpret_cast<const ATT_LAS bf16x8*>(Ks + kswz<384>(32 + r32, cb));
    const bf16x8 q = d0 < 8 ? qr[d0 < 8 ? d0 : 0] : *reinterpret_cast<const ATT_LAS bf16x8*>(Qs + ((d0 - 8) * 64 + lane) * 16);
    p0 = __builtin_amdgcn_mfma_f32_32x32x16_bf16(b0, q, p0, 0, 0, 0);
    p1 = __builtin_amdgcn_mfma_f32_32x32x16_bf16(b1, q, p1, 0, 0, 0); }
}
__device__ __forceinline__ int v_st(int k, int c) { const int kk = (k & ~0xC) | ((k & 4) << 1) | ((k & 8) >> 1); return ((kk >> 3) * 4 + (c >> 5)) * 512 + ((kk & 7) * 32 + (c & 31)) * 2; }
__device__ __forceinline__ int v_rd_base(int lane) { return ((lane & 3) << 3) | (((lane >> 2) & 3) << 6) | (((lane >> 4) & 1) << 5) | (((lane >> 5) & 1) << 8); }
constexpr int v_rd_off(int d0, int ks, int half) { return d0 * 512 + ks * 4096 + half * 2048; }
template <int OFF> __device__ __forceinline__ s16x4 tr_read(int vb) {
  s16x4 r; asm volatile("ds_read_b64_tr_b16 %0, %1 offset:%2" : "=&v"(r) : "v"(vb), "i"(OFF) : "memory"); return r;
}
#define ATT_PK(L, H) (bf16x8){L[0], L[1], L[2], L[3], H[0], H[1], H[2], H[3]}
template <int D0> __device__ __forceinline__ void pv_one(f32x16& od, int vb, bf16x8 pa0, bf16x8 pa1, bf16x8 pa2, bf16x8 pa3) {
  const s16x4 l0 = tr_read<v_rd_off(D0, 0, 0)>(vb), h0 = tr_read<v_rd_off(D0, 0, 1)>(vb), l1 = tr_read<v_rd_off(D0, 1, 0)>(vb), h1 = tr_read<v_rd_off(D0, 1, 1)>(vb);
  const s16x4 l2 = tr_read<v_rd_off(D0, 2, 0)>(vb), h2 = tr_read<v_rd_off(D0, 2, 1)>(vb), l3 = tr_read<v_rd_off(D0, 3, 0)>(vb), h3 = tr_read<v_rd_off(D0, 3, 1)>(vb);
  asm volatile("s_waitcnt lgkmcnt(0)" ::: "memory"); SBAR();
  od = __builtin_amdgcn_mfma_f32_32x32x16_bf16(pa0, ATT_PK(l0, h0), od, 0, 0, 0);
  od = __builtin_amdgcn_mfma_f32_32x32x16_bf16(pa1, ATT_PK(l1, h1), od, 0, 0, 0);
  od = __builtin_amdgcn_mfma_f32_32x32x16_bf16(pa2, ATT_PK(l2, h2), od, 0, 0, 0);
  od = __builtin_amdgcn_mfma_f32_32x32x16_bf16(pa3, ATT_PK(l3, h3), od, 0, 0, 0);
}
__device__ __forceinline__ void pv_d0(f32x16 (&o)[4], int vb, bf16x8 pa0, bf16x8 pa1, bf16x8 pa2, bf16x8 pa3) {
  pv_one<0>(o[0], vb, pa0, pa1, pa2, pa3); pv_one<1>(o[1], vb, pa0, pa1, pa2, pa3); pv_one<2>(o[2], vb, pa0, pa1, pa2, pa3); pv_one<3>(o[3], vb, pa0, pa1, pa2, pa3);
}
template <int D0> __device__ __forceinline__ void pv32_one(f32x16& od, int vb, bf16x8 pa0, bf16x8 pa1) {
  const s16x4 l0 = tr_read<v_rd_off(D0, 0, 0)>(vb), h0 = tr_read<v_rd_off(D0, 0, 1)>(vb), l1 = tr_read<v_rd_off(D0, 1, 0)>(vb), h1 = tr_read<v_rd_off(D0, 1, 1)>(vb);
  asm volatile("s_waitcnt lgkmcnt(0)" ::: "memory"); SBAR();
  od = __builtin_amdgcn_mfma_f32_32x32x16_bf16(pa0, ATT_PK(l0, h0), od, 0, 0, 0);
  od = __builtin_amdgcn_mfma_f32_32x32x16_bf16(pa1, ATT_PK(l1, h1), od, 0, 0, 0);
}

template <int DQK, int LDQ, int LDK, int LDO, int SDEPTH>
__device__ __forceinline__ void attn_dense_body(const bf16* __restrict__ Qb, const bf16* __restrict__ Kh, const bf16* __restrict__ Kr, const bf16* __restrict__ Vh,
                                                const float* __restrict__ cs_rows, OT* __restrict__ Ob, int seq, const float scale, ATT_LAS char* lds) {
  constexpr int SHM_V = KVBLK * DV * 2, SHM_K = KVBLK * DQK * 2, RB = DQK * 2, NQ = DQK / 16;
  constexpr bool ROPE = (DQK == 192);
  const float C = scale * LOG2E, THRS = 8.f / scale;
  int tid_ = threadIdx.x; asm volatile("" : "+v"(tid_));
  const int tid = tid_, wid = tid >> 6, lane = tid & 63, r32 = lane & 31, hi = lane >> 5;
  ATT_LAS char* V_lds = lds; ATT_LAS char* K_lds = lds + 2 * SHM_V;
  ATT_LAS float* ws = (ATT_LAS float*)(lds + 2 * SHM_V + 2 * SHM_K) + wid * 64; ATT_LAS float* li_l = ws; ATT_LAS float* al_l = ws + 32;
  float m_reg = -1e30f, l_reg = 0; f32x16 o[4] = {}; bf16x8 qr[NQ];
  const bf16* Qw = Qb + (long)(wid * QBLK + r32) * LDQ + hi * 8;
#pragma unroll
  for (int d0 = 0; d0 < NQ; ++d0) qr[d0] = *(const ATT_GAS bf16x8*)(Qw + d0 * 16);
  if constexpr (ROPE) {
    const float* cs = cs_rows + (long)(wid * QBLK + r32) * 64 + hi * 8;
#pragma unroll
    for (int g = 0; g < 2; ++g) {
      const f32x4 c0 = *(const ATT_GAS f32x4*)(cs + g * 16), c1 = *(const ATT_GAS f32x4*)(cs + g * 16 + 4);
      const f32x4 s0 = *(const ATT_GAS f32x4*)(cs + 32 + g * 16), s1 = *(const ATT_GAS f32x4*)(cs + 32 + g * 16 + 4);
      float y1[8], y2[8];
#pragma unroll
      for (int j = 0; j < 8; ++j) { const float co = j < 4 ? c0[j & 3] : c1[j & 3], si = j < 4 ? s0[j & 3] : s1[j & 3];
        const float x1 = bf2f(qr[8 + g][j]), x2 = bf2f(qr[10 + g][j]); y1[j] = x1 * co - x2 * si; y2[j] = x1 * si + x2 * co; }
      u32x4 w1 = {cvtpk(y1[0], y1[1]), cvtpk(y1[2], y1[3]), cvtpk(y1[4], y1[5]), cvtpk(y1[6], y1[7])};
      u32x4 w2 = {cvtpk(y2[0], y2[1]), cvtpk(y2[2], y2[3]), cvtpk(y2[4], y2[5]), cvtpk(y2[6], y2[7])};
      qr[8 + g] = *reinterpret_cast<bf16x8*>(&w1); qr[10 + g] = *reinterpret_cast<bf16x8*>(&w2);
    }
  }
  const int sr = tid >> 4, sc = (tid & 15) * 8, vst0 = v_st(sr, sc), vst1 = v_st(32 + sr, sc);
  const int rr = tid >> 3, rc = (tid & 7) * 8;
  const int vb0 = (int)(unsigned)(uintptr_t)V_lds + v_rd_base(lane);
  struct Slot { bf16x8 vs0, vs1, ks0, ks1, kr; } sr_[SDEPTH];
#define SLOAD(i, k0) do { sr_[i].vs0 = *(const ATT_GAS bf16x8*)(&Vh[(long)((k0) + sr) * LDK + sc]); sr_[i].vs1 = *(const ATT_GAS bf16x8*)(&Vh[(long)((k0) + 32 + sr) * LDK + sc]); \
    sr_[i].ks0 = *(const ATT_GAS bf16x8*)(&Kh[(long)((k0) + sr) * LDK + sc]); sr_[i].ks1 = *(const ATT_GAS bf16x8*)(&Kh[(long)((k0) + 32 + sr) * LDK + sc]); \
    if constexpr (ROPE) sr_[i].kr = *(const ATT_GAS bf16x8*)(&Kr[(long)((k0) + rr) * 64 + rc]); } while (0)
#define SWRITE(b, i) do { *reinterpret_cast<ATT_LAS bf16x8*>(V_lds + (b) * SHM_V + vst0) = sr_[i].vs0;          \
    *reinterpret_cast<ATT_LAS bf16x8*>(V_lds + (b) * SHM_V + vst1) = sr_[i].vs1; const int kc = sc * 2;               \
    *reinterpret_cast<ATT_LAS bf16x8*>(K_lds + (b) * SHM_K + kswz<RB>(sr, kc)) = sr_[i].ks0;                       \
    *reinterpret_cast<ATT_LAS bf16x8*>(K_lds + (b) * SHM_K + kswz<RB>(32 + sr, kc)) = sr_[i].ks1;                  \
    if constexpr (ROPE) *reinterpret_cast<ATT_LAS bf16x8*>(K_lds + (b) * SHM_K + kswz<RB>(rr, 256 + rc * 2)) = sr_[i].kr; } while (0)
#define SWAIT() do { if constexpr (SDEPTH == 2) { if constexpr (ROPE) asm volatile("s_waitcnt vmcnt(5)" ::: "memory"); else asm volatile("s_waitcnt vmcnt(4)" ::: "memory"); } else asm volatile("s_waitcnt vmcnt(0)" ::: "memory"); } while (0)
#define RESC(a) do { if (__any((a) < 1.f)) { if (hi == 0) al_l[r32] = (a); asm volatile("s_waitcnt lgkmcnt(0)" ::: "memory"); \
    _Pragma("unroll") for (int d = 0; d < 4; ++d) _Pragma("unroll") for (int r = 0; r < 16; ++r) o[d][r] *= al_l[crow(r, hi)]; } } while (0)
  f32x16 pA0, pA1, pB0, pB1; float mnA, mnB, alA, alB; bf16x8 pa0, pa1, pa2, pa3; const int NT = seq / KVBLK;
  constexpr int SE = 0, SO = SDEPTH - 1;
  SLOAD(SE, 0); asm volatile("s_waitcnt vmcnt(0)" ::: "memory"); SWRITE(0, SE); __syncthreads();
  qkt<DQK>(pA0, pA1, K_lds, qr, r32, hi); partialSM(pA0, pA1, m_reg, mnA, alA, C, THRS);
  SLOAD(SO, KVBLK); if constexpr (SDEPTH == 2) { if (2 < NT) SLOAD(SE, 2 * KVBLK); }
  SWAIT(); SWRITE(1, SO); __syncthreads();
  for (int j = 1; j + 1 < NT; j += 2) {
    SBAR(); qkt<DQK>(pB0, pB1, K_lds + SHM_K, qr, r32, hi);
    finishSM(pA0, pA1, alA, l_reg, pa0, pa1, pa2, pa3); SBAR();
    SLOAD(SO, (j + SDEPTH) * KVBLK); SBAR();
    pv_d0(o, vb0, pa0, pa1, pa2, pa3); partialSM(pB0, pB1, m_reg, mnB, alB, C, THRS);
    __syncthreads(); SWAIT(); SWRITE(0, SE);
    RESC(alB); __syncthreads();
    SBAR(); qkt<DQK>(pA0, pA1, K_lds, qr, r32, hi);
    finishSM(pB0, pB1, alB, l_reg, pa0, pa1, pa2, pa3); SBAR();
    if (SDEPTH == 1 || j + 3 < NT) SLOAD(SE, (j + 1 + SDEPTH) * KVBLK); SBAR();
    pv_d0(o, vb0 + SHM_V, pa0, pa1, pa2, pa3); partialSM(pA0, pA1, m_reg, mnA, alA, C, THRS);
    __syncthreads(); SWAIT(); SWRITE(1, SO);
    RESC(alA); __syncthreads();
  }
  SBAR(); qkt<DQK>(pB0, pB1, K_lds + SHM_K, qr, r32, hi);
  finishSM(pA0, pA1, alA, l_reg, pa0, pa1, pa2, pa3); SBAR();
  pv_d0(o, vb0, pa0, pa1, pa2, pa3); partialSM(pB0, pB1, m_reg, mnB, alB, C, THRS);
  __syncthreads(); RESC(alB);
  finishSM(pB0, pB1, alB, l_reg, pa0, pa1, pa2, pa3); SBAR();
  pv_d0(o, vb0 + SHM_V, pa0, pa1, pa2, pa3);
  if (hi == 0) li_l[r32] = l_reg; asm volatile("s_waitcnt lgkmcnt(0)" ::: "memory");
  float rli[16];
#pragma unroll
  for (int r = 0; r < 16; ++r) rli[r] = __builtin_amdgcn_rcpf(li_l[crow(r, hi)]);
  OT* Ow = Ob + (long)(wid * QBLK) * LDO;
#pragma unroll
  for (int r = 0; r < 16; ++r) { const int orow = crow(r, hi);
#pragma unroll
    for (int d0 = 0; d0 < 4; ++d0) st_o(&Ow[(long)orow * LDO + d0 * 32 + r32], o[d0][r] * rli[r]); }
  __syncthreads();
#undef SLOAD
#undef SWRITE
#undef SWAIT
#undef RESC
}

template <int LDQ, int LDK, int LDO>
__device__ __forceinline__ void attn_pipe192_body(const bf16* __restrict__ Qb, const bf16* __restrict__ Kh, const bf16* __restrict__ Kr, const bf16* __restrict__ Vh,
                                                const float* __restrict__ cs_rows, OT* __restrict__ Ob, int seq, const float scale, ATT_LAS char* lds) {
  constexpr int DQK = 192, SDEPTH = 1, SHM_V = KVBLK * DV * 2, SHM_K = KVBLK * DQK * 2, RB = DQK * 2, NQ = DQK / 16;
  constexpr bool ROPE = true;
  const float C = scale * LOG2E, THRS = 8.f / scale;
  int tid_ = threadIdx.x; asm volatile("" : "+v"(tid_));
  const int tid = tid_, wid = tid >> 6, lane = tid & 63, r32 = lane & 31, hi = lane >> 5;
  ATT_LAS char* V_lds = lds; ATT_LAS char* K_lds = lds + 2 * SHM_V;
  ATT_LAS float* ws = (ATT_LAS float*)(lds + 2 * SHM_V + 2 * SHM_K) + wid * 64; ATT_LAS float* li_l = ws; ATT_LAS float* al_l = ws + 32;
  ATT_LAS char* Qs = lds + 2 * SHM_V + 2 * SHM_K + 2048 + wid * 4096;
  float m_reg = -1e30f, l_reg = 0; f32x16 o[4] = {}; bf16x8 qr8[8];
  const bf16* Qw = Qb + (long)(wid * QBLK + r32) * LDQ + hi * 8;
  { bf16x8 qr[NQ];
#pragma unroll
  for (int d0 = 0; d0 < NQ; ++d0) qr[d0] = *(const ATT_GAS bf16x8*)(Qw + d0 * 16);
  if constexpr (ROPE) {
    const float* cs = cs_rows + (long)(wid * QBLK + r32) * 64 + hi * 8;
#pragma unroll
    for (int g = 0; g < 2; ++g) {
      const f32x4 c0 = *(const ATT_GAS f32x4*)(cs + g * 16), c1 = *(const ATT_GAS f32x4*)(cs + g * 16 + 4);
      const f32x4 s0 = *(const ATT_GAS f32x4*)(cs + 32 + g * 16), s1 = *(const ATT_GAS f32x4*)(cs + 32 + g * 16 + 4);
      float y1[8], y2[8];
#pragma unroll
      for (int j = 0; j < 8; ++j) { const float co = j < 4 ? c0[j & 3] : c1[j & 3], si = j < 4 ? s0[j & 3] : s1[j & 3];
        const float x1 = bf2f(qr[8 + g][j]), x2 = bf2f(qr[10 + g][j]); y1[j] = x1 * co - x2 * si; y2[j] = x1 * si + x2 * co; }
      u32x4 w1 = {cvtpk(y1[0], y1[1]), cvtpk(y1[2], y1[3]), cvtpk(y1[4], y1[5]), cvtpk(y1[6], y1[7])};
      u32x4 w2 = {cvtpk(y2[0], y2[1]), cvtpk(y2[2], y2[3]), cvtpk(y2[4], y2[5]), cvtpk(y2[6], y2[7])};
      qr[8 + g] = *reinterpret_cast<bf16x8*>(&w1); qr[10 + g] = *reinterpret_cast<bf16x8*>(&w2);
    }
  }
#pragma unroll
  for (int d0 = 0; d0 < 8; ++d0) qr8[d0] = qr[d0];
#pragma unroll
  for (int d0 = 8; d0 < 12; ++d0) *reinterpret_cast<ATT_LAS bf16x8*>(Qs + ((d0 - 8) * 64 + lane) * 16) = qr[d0];
  }
  const int sr = tid >> 4, sc = (tid & 15) * 8, vst0 = v_st(sr, sc), vst1 = v_st(32 + sr, sc);
  const int rr = tid >> 3, rc = (tid & 7) * 8;
  const int vb0 = (int)(unsigned)(uintptr_t)V_lds + v_rd_base(lane);
  struct Slot { bf16x8 vs0, vs1, ks0, ks1, kr; } sr_[SDEPTH];
#define SLOADK(i, k0) do { sr_[i].ks0 = *(const ATT_GAS bf16x8*)(&Kh[(long)((k0) + sr) * LDK + sc]); sr_[i].ks1 = *(const ATT_GAS bf16x8*)(&Kh[(long)((k0) + 32 + sr) * LDK + sc]); } while (0)
#define SLOADV(i, k0) do { sr_[i].vs0 = *(const ATT_GAS bf16x8*)(&Vh[(long)((k0) + sr) * LDK + sc]); sr_[i].vs1 = *(const ATT_GAS bf16x8*)(&Vh[(long)((k0) + 32 + sr) * LDK + sc]); \
    if constexpr (ROPE) sr_[i].kr = *(const ATT_GAS bf16x8*)(&Kr[(long)((k0) + rr) * 64 + rc]); } while (0)
#define SLOAD(i, k0) do { SLOADK(i, k0); SLOADV(i, k0); } while (0)
#define SWRITE(b, i) do { *reinterpret_cast<ATT_LAS bf16x8*>(V_lds + (b) * SHM_V + vst0) = sr_[i].vs0;          \
    *reinterpret_cast<ATT_LAS bf16x8*>(V_lds + (b) * SHM_V + vst1) = sr_[i].vs1; const int kc = sc * 2;               \
    *reinterpret_cast<ATT_LAS bf16x8*>(K_lds + (b) * SHM_K + kswz<RB>(sr, kc)) = sr_[i].ks0;                       \
    *reinterpret_cast<ATT_LAS bf16x8*>(K_lds + (b) * SHM_K + kswz<RB>(32 + sr, kc)) = sr_[i].ks1;                  \
    if constexpr (ROPE) *reinterpret_cast<ATT_LAS bf16x8*>(K_lds + (b) * SHM_K + kswz<RB>(rr, 256 + rc * 2)) = sr_[i].kr; } while (0)
#define SWAIT() do { if constexpr (SDEPTH == 2) { if constexpr (ROPE) asm volatile("s_waitcnt vmcnt(5)" ::: "memory"); else asm volatile("s_waitcnt vmcnt(4)" ::: "memory"); } else asm volatile("s_waitcnt vmcnt(0)" ::: "memory"); } while (0)
#define RESC(a) do { if (__any((a) < 1.f)) { if (hi == 0) al_l[r32] = (a); asm volatile("s_waitcnt lgkmcnt(0)" ::: "memory"); \
    _Pragma("unroll") for (int d = 0; d < 4; ++d) _Pragma("unroll") for (int r = 0; r < 16; ++r) o[d][r] *= al_l[crow(r, hi)]; } } while (0)
  f32x16 pA0, pA1, pB0, pB1; float mnA, mnB, alA, alB; bf16x8 pa0, pa1, pa2, pa3; const int NT = seq / KVBLK;
  constexpr int SE = 0, SO = SDEPTH - 1;
  SLOAD(SE, 0); asm volatile("s_waitcnt vmcnt(0)" ::: "memory"); SWRITE(0, SE); __syncthreads();
  qkt192_lq(pA0, pA1, K_lds, qr8, Qs, lane, r32, hi); partialSM(pA0, pA1, m_reg, mnA, alA, C, THRS);
  SLOAD(SO, KVBLK); if constexpr (SDEPTH == 2) { if (2 < NT) SLOAD(SE, 2 * KVBLK); }
  SWAIT(); SWRITE(1, SO); __syncthreads();
  for (int j = 1; j + 1 < NT; j += 2) {
    SBAR(); qkt192_lq(pB0, pB1, K_lds + SHM_K, qr8, Qs, lane, r32, hi);
    finishSM(pA0, pA1, alA, l_reg, pa0, pa1, pa2, pa3); SBAR();
    SLOADK(SO, (j + SDEPTH) * KVBLK); SBAR();
    pv_d0(o, vb0, pa0, pa1, pa2, pa3); SBAR(); SLOADV(SO, (j + SDEPTH) * KVBLK); SBAR(); partialSM(pB0, pB1, m_reg, mnB, alB, C, THRS);
    __syncthreads(); SWAIT(); SWRITE(0, SE);
    RESC(alB); __syncthreads();
    SBAR(); qkt192_lq(pA0, pA1, K_lds, qr8, Qs, lane, r32, hi);
    finishSM(pB0, pB1, alB, l_reg, pa0, pa1, pa2, pa3); SBAR();
    SLOADK(SE, (j + 1 + SDEPTH) * KVBLK); SBAR();
    pv_d0(o, vb0 + SHM_V, pa0, pa1, pa2, pa3); SBAR(); SLOADV(SE, (j + 1 + SDEPTH) * KVBLK); SBAR(); partialSM(pA0, pA1, m_reg, mnA, alA, C, THRS);
    __syncthreads(); SWAIT(); SWRITE(1, SO);
    RESC(alA); __syncthreads();
  }
  SBAR(); qkt192_lq(pB0, pB1, K_lds + SHM_K, qr8, Qs, lane, r32, hi);
  finishSM(pA0, pA1, alA, l_reg, pa0, pa1, pa2, pa3); SBAR();
  pv_d0(o, vb0, pa0, pa1, pa2, pa3); partialSM(pB0, pB1, m_reg, mnB, alB, C, THRS);
  __syncthreads(); RESC(alB);
  finishSM(pB0, pB1, alB, l_reg, pa0, pa1, pa2, pa3); SBAR();
  pv_d0(o, vb0 + SHM_V, pa0, pa1, pa2, pa3);
  if (hi == 0) li_l[r32] = l_reg; asm volatile("s_waitcnt lgkmcnt(0)" ::: "memory");
  float rli[16];
#pragma unroll
  for (int r = 0; r < 16; ++r) rli[r] = __builtin_amdgcn_rcpf(li_l[crow(r, hi)]);
  OT* Ow = Ob + (long)(wid * QBLK) * LDO;
#pragma unroll
  for (int r = 0; r < 16; ++r) { const int orow = crow(r, hi);
#pragma unroll
    for (int d0 = 0; d0 < 4; ++d0) st_o(&Ow[(long)orow * LDO + d0 * 32 + r32], o[d0][r] * rli[r]); }
  __syncthreads();
#undef SLOAD
#undef SLOADK
#undef SLOADV
#undef SWRITE
#undef SWAIT
#undef RESC
}

template <int DQK, int LDQ, int LDK, int LDO>
__device__ __forceinline__ void attn_simple_body(const bf16* __restrict__ Qb, const bf16* __restrict__ Kh, const bf16* __restrict__ Kr, const bf16* __restrict__ Vh,
                                                 const float* __restrict__ cs_rows, OT* __restrict__ Ob, int seq, const float scale, ATT_LAS char* lds) {
  constexpr int SHM_V = KVBLK * DV * 2, SHM_K = KVBLK * DQK * 2, RB = DQK * 2, NQ = DQK / 16;
  constexpr bool ROPE = (DQK == 192);
  const float C = scale * LOG2E, THRS = 8.f / scale;
  int tid_ = threadIdx.x; asm volatile("" : "+v"(tid_));
  const int tid = tid_, wid = tid >> 6, lane = tid & 63, r32 = lane & 31, hi = lane >> 5;
  ATT_LAS char* V_lds = lds; ATT_LAS char* K_lds = lds + 2 * SHM_V;
  ATT_LAS float* ws = (ATT_LAS float*)(lds + 2 * SHM_V + 2 * SHM_K) + wid * 64; ATT_LAS float* li_l = ws; ATT_LAS float* al_l = ws + 32;
  float m_reg = -1e30f, l_reg = 0; f32x16 o[4] = {}; bf16x8 qr[NQ];
  const bf16* Qw = Qb + (long)(wid * QBLK + r32) * LDQ + hi * 8;
#pragma unroll
  for (int d0 = 0; d0 < NQ; ++d0) qr[d0] = *(const ATT_GAS bf16x8*)(Qw + d0 * 16);
  if constexpr (ROPE) {
    const float* cs = cs_rows + (long)(wid * QBLK + r32) * 64 + hi * 8;
#pragma unroll
    for (int g = 0; g < 2; ++g) {
      const f32x4 c0 = *(const ATT_GAS f32x4*)(cs + g * 16), c1 = *(const ATT_GAS f32x4*)(cs + g * 16 + 4);
      const f32x4 s0 = *(const ATT_GAS f32x4*)(cs + 32 + g * 16), s1 = *(const ATT_GAS f32x4*)(cs + 32 + g * 16 + 4);
      float y1[8], y2[8];
#pragma unroll
      for (int j = 0; j < 8; ++j) { const float co = j < 4 ? c0[j & 3] : c1[j & 3], si = j < 4 ? s0[j & 3] : s1[j & 3];
        const float x1 = bf2f(qr[8 + g][j]), x2 = bf2f(qr[10 + g][j]); y1[j] = x1 * co - x2 * si; y2[j] = x1 * si + x2 * co; }
      u32x4 w1 = {cvtpk(y1[0], y1[1]), cvtpk(y1[2], y1[3]), cvtpk(y1[4], y1[5]), cvtpk(y1[6], y1[7])};
      u32x4 w2 = {cvtpk(y2[0], y2[1]), cvtpk(y2[2], y2[3]), cvtpk(y2[4], y2[5]), cvtpk(y2[6], y2[7])};
      qr[8 + g] = *reinterpret_cast<bf16x8*>(&w1); qr[10 + g] = *reinterpret_cast<bf16x8*>(&w2);
    }
  }
  const int sr = tid >> 4, sc = (tid & 15) * 8, vst0 = v_st(sr, sc), vst1 = v_st(32 + sr, sc);
  const int rr = tid >> 3, rc = (tid & 7) * 8;
  const int vb0 = (int)(unsigned)(uintptr_t)V_lds + v_rd_base(lane);
  bf16x8 vs0, vs1, ks0, ks1, kr;
#define SLOAD(k0) do { vs0 = *(const ATT_GAS bf16x8*)(&Vh[(long)((k0) + sr) * LDK + sc]); vs1 = *(const ATT_GAS bf16x8*)(&Vh[(long)((k0) + 32 + sr) * LDK + sc]); \
    ks0 = *(const ATT_GAS bf16x8*)(&Kh[(long)((k0) + sr) * LDK + sc]); ks1 = *(const ATT_GAS bf16x8*)(&Kh[(long)((k0) + 32 + sr) * LDK + sc]); \
    if constexpr (ROPE) kr = *(const ATT_GAS bf16x8*)(&Kr[(long)((k0) + rr) * 64 + rc]); } while (0)
#define SWRITE(b) do { *reinterpret_cast<ATT_LAS bf16x8*>(V_lds + (b) * SHM_V + vst0) = vs0;          \
    *reinterpret_cast<ATT_LAS bf16x8*>(V_lds + (b) * SHM_V + vst1) = vs1; const int kc = sc * 2;               \
    *reinterpret_cast<ATT_LAS bf16x8*>(K_lds + (b) * SHM_K + kswz<RB>(sr, kc)) = ks0;                       \
    *reinterpret_cast<ATT_LAS bf16x8*>(K_lds + (b) * SHM_K + kswz<RB>(32 + sr, kc)) = ks1;                  \
    if constexpr (ROPE) *reinterpret_cast<ATT_LAS bf16x8*>(K_lds + (b) * SHM_K + kswz<RB>(rr, 256 + rc * 2)) = kr; } while (0)
#define RESC(a) do { if (__any((a) < 1.f)) { if (hi == 0) al_l[r32] = (a); asm volatile("s_waitcnt lgkmcnt(0)" ::: "memory"); \
    _Pragma("unroll") for (int d = 0; d < 4; ++d) _Pragma("unroll") for (int r = 0; r < 16; ++r) o[d][r] *= al_l[crow(r, hi)]; } } while (0)
  const int NT = seq / KVBLK;
  SLOAD(0); SWRITE(0); __syncthreads();
  for (int j = 0; j < NT; ++j) {
    const int b = j & 1;
    if (j + 1 < NT) SLOAD((j + 1) * KVBLK);
    f32x16 p0, p1; float mn, al; bf16x8 pa0, pa1, pa2, pa3;
    SBAR(); qkt<DQK>(p0, p1, K_lds + b * SHM_K, qr, r32, hi);
    partialSM(p0, p1, m_reg, mn, al, C, THRS); RESC(al);
    finishSM(p0, p1, al, l_reg, pa0, pa1, pa2, pa3); SBAR();
    pv_d0(o, vb0 + b * SHM_V, pa0, pa1, pa2, pa3);
    if (j + 1 < NT) SWRITE(b ^ 1);
    __syncthreads();
  }
  if (hi == 0) li_l[r32] = l_reg; asm volatile("s_waitcnt lgkmcnt(0)" ::: "memory");
  float rli[16];
#pragma unroll
  for (int r = 0; r < 16; ++r) rli[r] = __builtin_amdgcn_rcpf(li_l[crow(r, hi)]);
  OT* Ow = Ob + (long)(wid * QBLK) * LDO;
#pragma unroll
  for (int r = 0; r < 16; ++r) { const int orow = crow(r, hi);
#pragma unroll
    for (int d0 = 0; d0 < 4; ++d0) st_o(&Ow[(long)orow * LDO + d0 * 32 + r32], o[d0][r] * rli[r]); }
  __syncthreads();
#undef SLOAD
#undef SWRITE
#undef RESC
}

template <int LDQ, int LDK, int LDO>
__device__ __forceinline__ void attn_dma_body(const bf16* __restrict__ Qb, const bf16* __restrict__ Kh, const bf16* __restrict__ Kr, const bf16* __restrict__ Vh,
                                              const float* __restrict__ cs_rows, OT* __restrict__ Ob, int seq, const float scale, ATT_LAS char* lds) {
  constexpr int DQK = 192, SHM_V = KVBLK * DV * 2, SHM_K = KVBLK * DQK * 2, STG = SHM_K + SHM_V, RB = DQK * 2, NQ = DQK / 16;
  const float C = scale * LOG2E, THRS = 8.f / scale;
  int tid_ = threadIdx.x; asm volatile("" : "+v"(tid_));
  const int tid = tid_, wid = __builtin_amdgcn_readfirstlane(tid >> 6), lane = tid & 63, r32 = lane & 31, hi = lane >> 5;
  ATT_LAS float* ws = (ATT_LAS float*)(lds + 3 * STG) + wid * 64; ATT_LAS float* li_l = ws; ATT_LAS float* al_l = ws + 32;
  float m_reg = -1e30f, l_reg = 0; f32x16 o[4] = {}; bf16x8 qr[NQ];
  const bf16* Qw = Qb + (long)(wid * QBLK + r32) * LDQ + hi * 8;
#pragma unroll
  for (int d0 = 0; d0 < NQ; ++d0) qr[d0] = *(const ATT_GAS bf16x8*)(Qw + d0 * 16);
  { const float* cs = cs_rows + (long)(wid * QBLK + r32) * 64 + hi * 8;
#pragma unroll
    for (int g = 0; g < 2; ++g) {
      const f32x4 c0 = *(const ATT_GAS f32x4*)(cs + g * 16), c1 = *(const ATT_GAS f32x4*)(cs + g * 16 + 4);
      const f32x4 s0 = *(const ATT_GAS f32x4*)(cs + 32 + g * 16), s1 = *(const ATT_GAS f32x4*)(cs + 32 + g * 16 + 4);
      float y1[8], y2[8];
#pragma unroll
      for (int j = 0; j < 8; ++j) { const float co = j < 4 ? c0[j & 3] : c1[j & 3], si = j < 4 ? s0[j & 3] : s1[j & 3];
        const float x1 = bf2f(qr[8 + g][j]), x2 = bf2f(qr[10 + g][j]); y1[j] = x1 * co - x2 * si; y2[j] = x1 * si + x2 * co; }
      u32x4 w1 = {cvtpk(y1[0], y1[1]), cvtpk(y1[2], y1[3]), cvtpk(y1[4], y1[5]), cvtpk(y1[6], y1[7])};
      u32x4 w2 = {cvtpk(y2[0], y2[1]), cvtpk(y2[2], y2[3]), cvtpk(y2[4], y2[5]), cvtpk(y2[6], y2[7])};
      qr[8 + g] = *reinterpret_cast<bf16x8*>(&w1); qr[10 + g] = *reinterpret_cast<bf16x8*>(&w2);
    } }
  const char* ksrc[3]; int kstep[3];
#pragma unroll
  for (int d = 0; d < 3; ++d) { const int p = (wid * 3 + d) * 64 + lane, row = p / 24, cpos = p - row * 24, c = cpos ^ (row & 7);
    if (c < 16) { ksrc[d] = (const char*)(Kh + (long)row * LDK + c * 8); kstep[d] = KVBLK * LDK * 2; } else { ksrc[d] = (const char*)(Kr + (long)row * 64 + (c - 16) * 8); kstep[d] = KVBLK * 64 * 2; } }
  const char* vsrc[2];
#pragma unroll
  for (int d = 0; d < 2; ++d) { const int p = (wid * 2 + d) * 64 + lane, sub = p >> 5, q = p & 31, kk = (sub >> 2) * 8 + (q >> 2), col = (sub & 3) * 32 + (q & 3) * 8;
    const int key = (kk & ~0xC) | ((kk & 4) << 1) | ((kk & 8) >> 1); vsrc[d] = (const char*)(Vh + (long)key * LDK + col); }
#define DMA_TILE(t, stg) do { ATT_LAS char* sb_ = lds + (stg) * STG; \
    _Pragma("unroll") for (int d = 0; d < 3; ++d) __builtin_amdgcn_global_load_lds((const unsigned*)(ksrc[d] + (long)(t) * kstep[d]), (ATT_LAS unsigned*)(sb_ + (wid * 3 + d) * 1024), 16, 0, 0); \
    _Pragma("unroll") for (int d = 0; d < 2; ++d) __builtin_amdgcn_global_load_lds((const unsigned*)(vsrc[d] + (long)(t) * (KVBLK * LDK * 2)), (ATT_LAS unsigned*)(sb_ + SHM_K + (wid * 2 + d) * 1024), 16, 0, 0); } while (0)
#define RESC(a) do { if (__any((a) < 1.f)) { if (hi == 0) al_l[r32] = (a); asm volatile("s_waitcnt lgkmcnt(0)" ::: "memory"); \
    _Pragma("unroll") for (int d = 0; d < 4; ++d) _Pragma("unroll") for (int r = 0; r < 16; ++r) o[d][r] *= al_l[crow(r, hi)]; } } while (0)
  const int NT = seq / KVBLK, vbase = (int)(unsigned)(uintptr_t)lds + SHM_K + v_rd_base(lane);
  asm volatile("s_waitcnt vmcnt(0)" ::: "memory");
  DMA_TILE(0, 0); DMA_TILE(1, 1);
  asm volatile("s_waitcnt vmcnt(5)" ::: "memory"); __builtin_amdgcn_s_barrier(); asm volatile("" ::: "memory");
  int stg = 0;
  for (int j = 0; j < NT; ++j) {
    const int stg2 = stg >= 1 ? stg - 1 : 2;
    if (j + 2 < NT) DMA_TILE(j + 2, stg2);
    f32x16 p0, p1; float mn, al; bf16x8 pa0, pa1, pa2, pa3;
    SBAR(); qkt<DQK>(p0, p1, lds + stg * STG, qr, r32, hi);
    partialSM(p0, p1, m_reg, mn, al, C, THRS); RESC(al);
    finishSM(p0, p1, al, l_reg, pa0, pa1, pa2, pa3); SBAR();
    pv_d0(o, vbase + stg * STG, pa0, pa1, pa2, pa3);
    if (j + 2 < NT) asm volatile("s_waitcnt vmcnt(5)" ::: "memory"); else asm volatile("s_waitcnt vmcnt(0)" ::: "memory");
    asm volatile("s_waitcnt lgkmcnt(0)" ::: "memory"); __builtin_amdgcn_s_barrier(); asm volatile("" ::: "memory");
    stg = stg == 2 ? 0 : stg + 1;
  }
  if (hi == 0) li_l[r32] = l_reg; asm volatile("s_waitcnt lgkmcnt(0)" ::: "memory");
  float rli[16];
#pragma unroll
  for (int r = 0; r < 16; ++r) rli[r] = __builtin_amdgcn_rcpf(li_l[crow(r, hi)]);
  OT* Ow = Ob + (long)(wid * QBLK) * LDO;
#pragma unroll
  for (int r = 0; r < 16; ++r) { const int orow = crow(r, hi);
#pragma unroll
    for (int d0 = 0; d0 < 4; ++d0) st_o(&Ow[(long)orow * LDO + d0 * 32 + r32], o[d0][r] * rli[r]); }
  __syncthreads();
#undef DMA_TILE
#undef RESC
}

template <int LDP>
__device__ __forceinline__ void dil_wave_unit(const bf16* __restrict__ P, int qc, int kc, int vc, int d, int r, int t0, int nT,
                                              OT* __restrict__ O, int oc, float* __restrict__ ST  ,
                                              ATT_LAS char* vlds  , const ATT_LAS float* bias2, const float C, int lane_) {
  int lane = lane_; asm volatile("" : "+v"(lane));
  const int r32 = lane & 31, hi = lane >> 5;
  bf16x8 qr[8];
  { const bf16* qp = P + (long)(r + d * (t0 + r32)) * LDP + qc + hi * 8;
#pragma unroll
    for (int d0 = 0; d0 < 8; ++d0) qr[d0] = *(const ATT_GAS bf16x8*)(qp + d0 * 16); }
  bf16x8 kf[2][8];
#define DIL_LDK(kb, set) do { int kt_ = t0 - 64 + (kb) * 32 + r32; kt_ = kt_ < 0 ? 0 : (kt_ > nT - 1 ? nT - 1 : kt_); \
    const bf16* kp_ = P + (long)(r + d * kt_) * LDP + kc + hi * 8; \
    _Pragma("unroll") for (int d0 = 0; d0 < 8; ++d0) kf[set][d0] = *(const ATT_GAS bf16x8*)(kp_ + d0 * 16); } while (0)
  DIL_LDK(0, 0);
  f32x16 p[5];
#pragma unroll
  for (int kb = 0; kb < 5; ++kb) {
    if (kb + 1 < 5) DIL_LDK(kb + 1, (kb + 1) & 1);
    p[kb] = f32x16{};
#pragma unroll
    for (int d0 = 0; d0 < 8; ++d0) p[kb] = __builtin_amdgcn_mfma_f32_32x32x16_bf16(kf[kb & 1][d0], qr[d0], p[kb], 0, 0, 0);
  }
#undef DIL_LDK
  bf16x8 vv[2][8];
#define DIL_LDV(kb, set) do { _Pragma("unroll") for (int i = 0; i < 8; ++i) { const int id = lane + 64 * i, row = id >> 4, c = (id & 15) * 8; \
      int kt_ = t0 - 64 + (kb) * 32 + row; kt_ = kt_ < 0 ? 0 : (kt_ > nT - 1 ? nT - 1 : kt_); \
      vv[set][i] = *(const ATT_GAS bf16x8*)(P + (long)(r + d * kt_) * LDP + vc + c); } } while (0)
  DIL_LDV(0, 0);
  float m = -1e30f;
  { const int a_ = 4 * hi - r32 + 32, k_ = a_ & 3; const ATT_LAS f32x4* tp = (const ATT_LAS f32x4*)(bias2 + k_ * 196 + (a_ - k_));
    const bool interior = (t0 >= 64) && (t0 + 96 <= nT);
#pragma unroll
    for (int kb = 0; kb < 5; ++kb)
#pragma unroll
      for (int g = 0; g < 4; ++g) { const f32x4 bv = tp[kb * 8 + 2 * g];
#pragma unroll
        for (int e = 0; e < 4; ++e) { const int rg = 4 * g + e; float s = fmaf(p[kb][rg], C, bv[e]);
          if (!interior) { const int kt = t0 - 64 + kb * 32 + crow(rg, hi); s = (kt >= 0 && kt < nT) ? s : -1e30f; }
          p[kb][rg] = s; m = fmaxf(m, s); } } }
  { auto rr = __builtin_amdgcn_permlane32_swap(__float_as_uint(m), __float_as_uint(m), false, false); m = fmaxf(__uint_as_float(rr[0]), __uint_as_float(rr[1])); }
  float Z = 0.f;
#pragma unroll
  for (int kb = 0; kb < 5; ++kb)
#pragma unroll
    for (int rg = 0; rg < 16; ++rg) { p[kb][rg] = __builtin_amdgcn_exp2f(p[kb][rg] - m); Z += p[kb][rg]; }
  { auto rr = __builtin_amdgcn_permlane32_swap(__float_as_uint(Z), __float_as_uint(Z), false, false); Z = __uint_as_float(rr[0]) + __uint_as_float(rr[1]); }
  bf16x8 pa[5][2];
#pragma unroll
  for (int kb = 0; kb < 5; ++kb) { ATT_PK4(p[kb], 0, pa[kb][0]); ATT_PK4(p[kb], 8, pa[kb][1]); }
  f32x16 o[4] = {};
  const int vb = (int)(unsigned)(uintptr_t)vlds + v_rd_base(lane);
#pragma unroll
  for (int kb = 0; kb < 5; ++kb) {
    if (kb + 1 < 5) DIL_LDV(kb + 1, (kb + 1) & 1);
#pragma unroll
    for (int i = 0; i < 8; ++i) { const int id = lane + 64 * i, row = id >> 4, c = (id & 15) * 8;
      *reinterpret_cast<ATT_LAS bf16x8*>(vlds + v_st(row, c)) = vv[kb & 1][i]; }
    asm volatile("s_waitcnt lgkmcnt(0)" ::: "memory"); SBAR();
    pv32_one<0>(o[0], vb, pa[kb][0], pa[kb][1]); pv32_one<1>(o[1], vb, pa[kb][0], pa[kb][1]); pv32_one<2>(o[2], vb, pa[kb][0], pa[kb][1]); pv32_one<3>(o[3], vb, pa[kb][0], pa[kb][1]);
    SBAR();
  }
#undef DIL_LDV
#pragma unroll
  for (int rg = 0; rg < 16; ++rg) { const long row = r + d * (t0 + crow(rg, hi));
#pragma unroll
    for (int d0 = 0; d0 < 4; ++d0) st_o(&O[row * 768 + oc + d0 * 32 + r32], o[d0][rg]); }
  if (hi == 0) { const long row = r + d * (t0 + r32); typedef float f32x2_ __attribute__((ext_vector_type(2))); *(ATT_GAS f32x2_*)(ST + row * 12) = (f32x2_){m, Z}; }
}
template <int LDP>
__device__ __forceinline__ void dil_wg_unit(const bf16* __restrict__ P, int qc, int kc, int vc, int d, int r, int T0, int nT,
                                            OT* __restrict__ O, int oc, float* __restrict__ ST, ATT_LAS char* lds, const ATT_LAS float* bias2, const float C) {
  int tid_ = threadIdx.x; asm volatile("" : "+v"(tid_));
  const int tid = tid_, wid = __builtin_amdgcn_readfirstlane(tid >> 6), lane = tid & 63, r32 = lane & 31, hi = lane >> 5, t0 = T0 + 32 * wid;
  { bf16x8 kk[12];
#pragma unroll
    for (int i = 0; i < 12; ++i) { const int id = tid + 512 * i, row = id >> 4, c = (id & 15) * 8; int kt = T0 - 64 + row; kt = kt < 0 ? 0 : (kt > nT - 1 ? nT - 1 : kt);
      kk[i] = *(const ATT_GAS bf16x8*)(P + (long)(r + d * kt) * LDP + kc + c); }
#pragma unroll
    for (int i = 0; i < 12; ++i) { const int id = tid + 512 * i, row = id >> 4, cB = (id & 15) * 16;
      *reinterpret_cast<ATT_LAS bf16x8*>(lds + kswz<256>(row, cB)) = kk[i]; } }
  bf16x8 qr[8];
  { const bf16* qp = P + (long)(r + d * (t0 + r32)) * LDP + qc + hi * 8;
#pragma unroll
    for (int d0 = 0; d0 < 8; ++d0) qr[d0] = *(const ATT_GAS bf16x8*)(qp + d0 * 16); }
  __syncthreads();
  bf16x8 vv[12];
#pragma unroll
  for (int i = 0; i < 12; ++i) { const int id = tid + 512 * i, row = id >> 4, c = (id & 15) * 8; int kt = T0 - 64 + row; kt = kt < 0 ? 0 : (kt > nT - 1 ? nT - 1 : kt);
    vv[i] = *(const ATT_GAS bf16x8*)(P + (long)(r + d * kt) * LDP + vc + c); }
  f32x16 p[5];
#pragma unroll
  for (int kb = 0; kb < 5; ++kb) { const int krow = 32 * wid + 32 * kb + r32;
    p[kb] = f32x16{};
#pragma unroll
    for (int d0 = 0; d0 < 8; ++d0) { const bf16x8 kf = *reinterpret_cast<const ATT_LAS bf16x8*>(lds + kswz<256>(krow, (d0 * 16 + hi * 8) * 2));
      p[kb] = __builtin_amdgcn_mfma_f32_32x32x16_bf16(kf, qr[d0], p[kb], 0, 0, 0); } }
  float m = -1e30f;
  { const int a_ = 4 * hi - r32 + 32, k_ = a_ & 3; const ATT_LAS f32x4* tp = (const ATT_LAS f32x4*)(bias2 + k_ * 196 + (a_ - k_));
    const bool interior = (t0 >= 64) && (t0 + 96 <= nT);
#pragma unroll
    for (int kb = 0; kb < 5; ++kb)
#pragma unroll
      for (int g = 0; g < 4; ++g) { const f32x4 bv = tp[kb * 8 + 2 * g];
#pragma unroll
        for (int e = 0; e < 4; ++e) { const int rg = 4 * g + e; float s = fmaf(p[kb][rg], C, bv[e]);
          if (!interior) { const int kt = t0 - 64 + kb * 32 + crow(rg, hi); s = (kt >= 0 && kt < nT) ? s : -1e30f; }
          p[kb][rg] = s; m = fmaxf(m, s); } } }
  { auto rr = __builtin_amdgcn_permlane32_swap(__float_as_uint(m), __float_as_uint(m), false, false); m = fmaxf(__uint_as_float(rr[0]), __uint_as_float(rr[1])); }
  float Z = 0.f;
#pragma unroll
  for (int kb = 0; kb < 5; ++kb)
#pragma unroll
    for (int rg = 0; rg < 16; ++rg) { p[kb][rg] = __builtin_amdgcn_exp2f(p[kb][rg] - m); Z += p[kb][rg]; }
  { auto rr = __builtin_amdgcn_permlane32_swap(__float_as_uint(Z), __float_as_uint(Z), false, false); Z = __uint_as_float(rr[0]) + __uint_as_float(rr[1]); }
  bf16x8 pa[5][2];
#pragma unroll
  for (int kb = 0; kb < 5; ++kb) { ATT_PK4(p[kb], 0, pa[kb][0]); ATT_PK4(p[kb], 8, pa[kb][1]); }
  __syncthreads();
#pragma unroll
  for (int i = 0; i < 12; ++i) { const int id = tid + 512 * i, row = id >> 4, c = (id & 15) * 8;
    *reinterpret_cast<ATT_LAS bf16x8*>(lds + (row >> 5) * 8192 + v_st(row & 31, c)) = vv[i]; }
  __syncthreads();
  f32x16 o[4] = {};
#pragma unroll
  for (int kb = 0; kb < 5; ++kb) { const int vb = (int)(unsigned)(uintptr_t)lds + (wid + kb) * 8192 + v_rd_base(lane);
    pv32_one<0>(o[0], vb, pa[kb][0], pa[kb][1]); pv32_one<1>(o[1], vb, pa[kb][0], pa[kb][1]); pv32_one<2>(o[2], vb, pa[kb][0], pa[kb][1]); pv32_one<3>(o[3], vb, pa[kb][0], pa[kb][1]); }
#pragma unroll
  for (int rg = 0; rg < 16; ++rg) { const long row = r + d * (t0 + crow(rg, hi));
#pragma unroll
    for (int d0 = 0; d0 < 4; ++d0) st_o(&O[row * 768 + oc + d0 * 32 + r32], o[d0][rg]); }
  if (hi == 0) { const long row = r + d * (t0 + r32); typedef float f32x2_ __attribute__((ext_vector_type(2))); *(ATT_GAS f32x2_*)(ST + row * 12) = (f32x2_){m, Z}; }
  __syncthreads();
}

#if defined(MLA_DMA) && MLA_DMA == 2
#define MLA_BODY attn_pipe192_body
#elif defined(MLA_DMA) && MLA_DMA
#define MLA_BODY attn_dma_body
#else
template <int LDQ, int LDK, int LDO> __device__ __forceinline__ void attn_simple192(const bf16* Qb, const bf16* Kh, const bf16* Kr, const bf16* Vh, const float* cs, OT* Ob, int seq, const float scale, ATT_LAS char* lds) { attn_simple_body<192, LDQ, LDK, LDO>(Qb, Kh, Kr, Vh, cs, Ob, seq, scale, lds); }
#define MLA_BODY attn_simple192
#endif
}
constexpr int S = 8192, D = 2048, NMEM = 256;
constexpr int DIN = 3392, DINP = 3584;
constexpr int PC_DIL = 768, PC_MEM = 3072;
constexpr int QR = 384, KVR = 128, AQ = 512;
constexpr int NUP = 2816;
constexpr int UC_KV = 1280;
constexpr int DFF = 5632, DFE = 7168, NE = 8;
constexpr int MP = 18432;
constexpr float EPS = 1e-6f;
constexpr int NWAVES = 8;

constexpr size_t al256(size_t x) { return (x + 255) / 256 * 256; }
constexpr size_t WS_CTL = 0, CTL_ZERO_BYTES = 1u << 20;
constexpr size_t WS_WIN = WS_CTL + CTL_ZERO_BYTES;
constexpr size_t WS_WUP = WS_WIN + al256((size_t)2 * DINP * D * 2);
constexpr size_t WS_WMEM = WS_WUP + al256((size_t)2 * NUP * AQ * 2);
constexpr size_t WS_WOUT = WS_WMEM + al256((size_t)2 * 1024 * D * 2);
constexpr size_t WS_WGU = WS_WOUT + al256((size_t)2 * D * D * 2);
constexpr size_t WS_WDN = WS_WGU + al256((size_t)2 * DFF * D * 2);
constexpr size_t WS_MGU = WS_WDN + al256((size_t)D * DFF * 2);
constexpr size_t WS_MDN = WS_MGU + al256((size_t)NE * 2 * DFE * D * 2);
constexpr size_t WS_XN = WS_MDN + al256((size_t)NE * D * DFE * 2);
constexpr size_t WS_MEMN = WS_XN + al256((size_t)S * D * 2);
constexpr size_t WS_MEMKV = WS_MEMN + al256((size_t)2 * NMEM * D * 2);
constexpr size_t WS_PROJ = WS_MEMKV + al256((size_t)2 * NMEM * 1024 * 2);
constexpr size_t WS_AQKV = WS_PROJ + al256((size_t)S * DINP * 2);
constexpr size_t WS_KROPE = WS_AQKV + al256((size_t)S * AQ * 2);
constexpr size_t WS_ROPECS = WS_KROPE + al256((size_t)S * 64 * 2);
constexpr size_t WS_QKVM = WS_ROPECS + al256((size_t)S * 64 * 4);
constexpr size_t WS_YPRE = WS_QKVM + al256((size_t)S * NUP * 2);
constexpr size_t WS_DILO = WS_YPRE + al256((size_t)S * D * 4);
constexpr size_t WS_DILS = WS_DILO + al256((size_t)3 * S * 768 * 4);
constexpr size_t WS_Y = WS_DILS + al256((size_t)3 * S * 12 * 4);
constexpr size_t WS_XA = WS_Y + al256((size_t)S * D * 2);
constexpr size_t WS_ROUTE = WS_XA + al256((size_t)S * D * 4);
constexpr size_t WS_XP = WS_ROUTE + al256((size_t)S * 32);
constexpr size_t WS_OUTP = WS_XP + al256((size_t)MP * D * 2);
constexpr size_t WS_ACTP = WS_OUTP + al256((size_t)MP * D * 2);
constexpr size_t WS_OUTQ = WS_ACTP + al256((size_t)MP * DFE * 2);
constexpr size_t WS_END = WS_OUTQ + al256((size_t)4 * 2048 * D * 2);
static_assert(WS_END <= 1879048192ull, "workspace map exceeds 4 x the largest input");
constexpr int CW_BAR = 16384;
constexpr int CW_QUEUE = 8192;
constexpr int CW_CNT = 8192 + 256;
constexpr int CW_QUEUE2 = 65536;
constexpr int CW_CVT = 8192 + 320;
constexpr int CW_DONE = 8192 + 384;
constexpr int CW_CNTW = 53248;
constexpr int CW_TS = 12288;
constexpr int CW_TILEE = 8192 + 512;
constexpr int RING_BYTES = 131072;
constexpr int LDSCTL_OFF = RING_BYTES, MISC_OFF = LDSCTL_OFF + 320;
constexpr int BIAS_OFF = 132096;
constexpr int LDS_BYTES = 147456;
static_assert(BIAS_OFF >= MISC_OFF + 128 && BIAS_OFF + 3 * 6 * 132 * 4 + 4 * 196 * 4 <= LDS_BYTES, "LDS map");

#define GAS __attribute__((address_space(1)))
#define LAS __attribute__((address_space(3)))
typedef unsigned short bf16;
typedef unsigned v4u __attribute__((ext_vector_type(4)));
typedef unsigned v2u __attribute__((ext_vector_type(2)));
typedef float f32x4 __attribute__((ext_vector_type(4)));
typedef short bf16x8 __attribute__((ext_vector_type(8)));
typedef GAS unsigned gu32;
#define RLX_AGENT __ATOMIC_RELAXED, __HIP_MEMORY_SCOPE_AGENT
#define LDS_WAIT() asm volatile("s_waitcnt lgkmcnt(0)" ::: "memory")
#define VM_WAIT() asm volatile("s_waitcnt vmcnt(0)" ::: "memory")
__device__ __forceinline__ unsigned f2bf(float f) { unsigned u = __builtin_bit_cast(unsigned, f); return (u + 0x7fffu + ((u >> 16) & 1u)) >> 16; }
__device__ __forceinline__ unsigned pk2(float lo, float hi) { return f2bf(lo) | (f2bf(hi) << 16); }
__device__ __forceinline__ float bflo(unsigned w) { return __uint_as_float(w << 16); }
__device__ __forceinline__ float bfhi(unsigned w) { return __uint_as_float(w & 0xffff0000u); }

#ifndef BAR_FLAGS
#define BAR_FLAGS 1
#endif
#define XB_TMO      128
#define XB_XCNT(j)  (256  + 64 * (j))
#define XB_XSUB(j)  (1280 + 64 * (j))
#define XB_XGEN(j)  (2304 + 64 * (j))
#define XB_TOP      3328
#define XB_TOPGEN   3392
#define XCD_BAR_WORDS 3456
#define XB_SPIN_CAP (1u << 18)
__device__ __forceinline__ unsigned xb_ld(unsigned* p)              { return __hip_atomic_load(p, __ATOMIC_RELAXED, __HIP_MEMORY_SCOPE_AGENT); }
__device__ __forceinline__ unsigned xb_add(unsigned* p, unsigned v) { return __hip_atomic_fetch_add(p, v, __ATOMIC_RELAXED, __HIP_MEMORY_SCOPE_AGENT); }
__device__ __forceinline__ unsigned xb_xcc_id() { return (unsigned)__builtin_amdgcn_s_getreg((3 << 11) | 20) & 0xFu; }
#define XB_SPIN(cond, bar) do { unsigned _sp = 0; while (cond) { __builtin_amdgcn_s_sleep(1); \
    if ((++_sp & 255u) == 0u) { if (xb_ld(&(bar)[XB_TMO])) break; if (_sp > XB_SPIN_CAP) { atomicAdd(&(bar)[XB_TMO], 1u); break; } } } } while (0)
struct XcdBarrier { unsigned* bar; unsigned x; volatile LAS unsigned* st; };
__device__ __forceinline__ XcdBarrier xcd_barrier_post(unsigned* bar, volatile LAS unsigned* st) {
    XcdBarrier b; b.bar = bar; b.x = xb_xcc_id(); b.st = st;
    if (threadIdx.x == 0) (void)xb_add(&bar[XB_XCNT(b.x)], 1u);
    return b;
}
__device__ __forceinline__ void xcd_barrier_complete(unsigned* bar, unsigned x, unsigned& nloc, unsigned& nx, unsigned& mask) {
    const unsigned G = gridDim.x * gridDim.y * gridDim.z;
    unsigned sum, cnt, mine, msk, sp = 0u;
    for (;;) {
        sum = 0u; cnt = 0u; mine = 0u; msk = 0u;
#pragma unroll
        for (unsigned j = 0; j < 16; ++j) { const unsigned c = xb_ld(&bar[XB_XCNT(j)]); sum += c; cnt += (c > 0u) ? 1u : 0u; msk |= (c > 0u) ? (1u << j) : 0u; mine = (j == x) ? c : mine; }
        if (sum == G) break;
        __builtin_amdgcn_s_sleep(1);
        if ((++sp & 255u) == 0u) { if (xb_ld(&bar[XB_TMO])) break; if (sp > XB_SPIN_CAP) { atomicAdd(&bar[XB_TMO], 1u); break; } }
    }
    nloc = mine > 0u ? mine : 1u; nx = cnt > 0u ? cnt : 1u; mask = msk;
}
#if BAR_FLAGS
#define XB_XFLAG(j) (3456 + (j))
template <int MODE = 0>
__device__ __forceinline__ void xcd_barrier(const XcdBarrier& b) {
    asm volatile("s_waitcnt vmcnt(0)" ::: "memory");
    __syncthreads();
    if (threadIdx.x < 64) {
        unsigned* bar = b.bar; const unsigned lane = threadIdx.x;
        unsigned gen1 = 0u, mask = 0u; bool leader = false;
        if (lane == 0) {
            __builtin_amdgcn_s_waitcnt(0);
#if BAR_FLAGS == 2
            asm volatile("buffer_inv sc1" ::: "memory");
#endif
            unsigned nloc = b.st[0], nx = b.st[1]; mask = b.st[2];
            if (nloc == 0u) { xcd_barrier_complete(bar, b.x, nloc, nx, mask); b.st[0] = nloc; b.st[1] = nx; b.st[2] = mask; }
            const unsigned old = xb_add(&bar[XB_XSUB(b.x)], 1u);
            const unsigned gen = old / nloc; gen1 = gen + 1u;
            if (old + 1u == gen1 * nloc) { leader = true;
                if (!(MODE & 1)) __builtin_amdgcn_fence(__ATOMIC_RELEASE, "agent");
                asm volatile("s_waitcnt vmcnt(0)" ::: "memory");
#if BAR_FLAGS == 2
                asm volatile("buffer_inv sc1\n\ts_waitcnt vmcnt(0)" ::: "memory");
#endif
                __hip_atomic_store(&bar[XB_XFLAG(b.x)], gen1, __ATOMIC_RELAXED, __HIP_MEMORY_SCOPE_AGENT);
            }
        }
        gen1 = (unsigned)__builtin_amdgcn_readfirstlane((int)gen1); mask = (unsigned)__builtin_amdgcn_readfirstlane((int)mask);
        unsigned sp = 0u;
        for (;;) {
            bool ok = true;
            if (lane < 16) { const unsigned f = xb_ld(&bar[XB_XFLAG(lane)]); ok = (((mask >> lane) & 1u) == 0u) || ((int)(f - gen1) >= 0); }
            if (__all(ok)) break;
            __builtin_amdgcn_s_sleep(1);
            if ((++sp & 255u) == 0u) { if (xb_ld(&bar[XB_TMO])) break; if (sp > XB_SPIN_CAP) { if (lane == 0) atomicAdd(&bar[XB_TMO], 1u); break; } }
        }
#if BAR_FLAGS != 2
        if (!(MODE & 2)) { if (!(MODE & 4) || __builtin_amdgcn_readfirstlane((int)leader)) __builtin_amdgcn_fence(__ATOMIC_ACQUIRE, "agent"); }
#endif
        asm volatile("s_waitcnt vmcnt(0)" ::: "memory");
    }
    __syncthreads();
}
#else
__device__ __forceinline__ void xcd_barrier(const XcdBarrier& b) {
    asm volatile("s_waitcnt vmcnt(0)" ::: "memory");
    __syncthreads();
    if (threadIdx.x == 0) {
        unsigned* bar = b.bar;
        __builtin_amdgcn_s_waitcnt(0);
        unsigned nloc = b.st[0], nx = b.st[1], mask_;
        if (nloc == 0u) { xcd_barrier_complete(bar, b.x, nloc, nx, mask_); b.st[0] = nloc; b.st[1] = nx; }
        const unsigned old = xb_add(&bar[XB_XSUB(b.x)], 1u);
        const unsigned gen = old / nloc;
        if (old + 1u == (gen + 1u) * nloc) {
            __builtin_amdgcn_fence(__ATOMIC_RELEASE, "agent");
            asm volatile("s_waitcnt vmcnt(0)" ::: "memory");
            const unsigned og = xb_add(&bar[XB_TOP], 1u);
            const unsigned tg = og / nx;
            if (og + 1u == (tg + 1u) * nx) xb_add(&bar[XB_TOPGEN], 1u);
            else XB_SPIN(xb_ld(&bar[XB_TOPGEN]) == tg, bar);
            __builtin_amdgcn_fence(__ATOMIC_ACQUIRE, "agent");
            xb_add(&bar[XB_XGEN(b.x)], 1u);
            asm volatile("s_waitcnt vmcnt(0)" ::: "memory");
        } else {
            XB_SPIN(xb_ld(&bar[XB_XGEN(b.x)]) == gen, bar);
            __builtin_amdgcn_fence(__ATOMIC_ACQUIRE, "agent");
            asm volatile("s_waitcnt vmcnt(0)" ::: "memory");
        }
    }
    __syncthreads();
}
#endif

struct Args {
    const float* in[23]; float* out; unsigned char* ws;
    float invf[32];
    int ph_lo, ph_hi, li, rep;
};
struct Frame {
    LAS unsigned char* lds;
    volatile LAS unsigned* MISC;
    gu32* ctl;
    int tid, lane, wave, G, gw, NGW;
    unsigned char* ws;
};
__device__ __forceinline__ float wave_sum(float v) {
#pragma unroll
    for (int o = 1; o < 64; o <<= 1) v += __shfl_xor(v, o);
    return v;
}
__device__ __forceinline__ float wave_max(float v) {
#pragma unroll
    for (int o = 1; o < 64; o <<= 1) v = fmaxf(v, __shfl_xor(v, o));
    return v;
}

__device__ __forceinline__ unsigned pk4_fp8(float a, float b, float c, float d) { int w = 0; w = __builtin_amdgcn_cvt_pk_fp8_f32(a, b, w, false); w = __builtin_amdgcn_cvt_pk_fp8_f32(c, d, w, true); return (unsigned)w; }
#if defined(CVT_REG) && CVT_REG
__device__ __forceinline__ void cvt_load(const float* __restrict__ W, int N, int k0, int n0, int lane, f32x4 (&v)[8]) {
    const GAS float* p = (const GAS float*)(W + (size_t)(k0 + (lane >> 5) * 32) * N + n0 + (lane & 31));
#pragma unroll
    for (int i = 0; i < 8; ++i)
#pragma unroll
        for (int e = 0; e < 4; ++e) v[i][e] = __builtin_nontemporal_load(p + (size_t)(i * 4 + e) * N);
}
template <bool FP8>
__device__ __forceinline__ void cvt_finish(const f32x4 (&v)[8], int k0, void* __restrict__ dstv, int ldd, int drow0, int kdst0, LAS float* scr, int lane, float wsc) {
    const int n = lane & 31, kh = (lane >> 5) * 32;
    if constexpr (FP8) { GAS v4u* d = (GAS v4u*)((unsigned char*)dstv + (size_t)(drow0 + n) * ldd + kdst0 + k0 + kh);
#pragma unroll
        for (int j = 0; j < 2; ++j) { v4u o;
            o.x = pk4_fp8(v[4 * j][0] * wsc, v[4 * j][1] * wsc, v[4 * j][2] * wsc, v[4 * j][3] * wsc); o.y = pk4_fp8(v[4 * j + 1][0] * wsc, v[4 * j + 1][1] * wsc, v[4 * j + 1][2] * wsc, v[4 * j + 1][3] * wsc);
            o.z = pk4_fp8(v[4 * j + 2][0] * wsc, v[4 * j + 2][1] * wsc, v[4 * j + 2][2] * wsc, v[4 * j + 2][3] * wsc); o.w = pk4_fp8(v[4 * j + 3][0] * wsc, v[4 * j + 3][1] * wsc, v[4 * j + 3][2] * wsc, v[4 * j + 3][3] * wsc);
            __builtin_nontemporal_store(o, d + j); } }
    else { GAS v4u* d = (GAS v4u*)((bf16*)dstv + (size_t)(drow0 + n) * ldd + kdst0 + k0 + kh);
#pragma unroll
        for (int j = 0; j < 4; ++j) { v4u o; o.x = pk2(v[2 * j][0], v[2 * j][1]); o.y = pk2(v[2 * j][2], v[2 * j][3]); o.z = pk2(v[2 * j + 1][0], v[2 * j + 1][1]); o.w = pk2(v[2 * j + 1][2], v[2 * j + 1][3]);
            __builtin_nontemporal_store(o, d + j); } }
}
#else
__device__ __forceinline__ void cvt_load(const float* __restrict__ W, int N, int k0, int n0, int lane, f32x4 (&v)[8]) {
    const int lr = lane >> 3, lc = (lane & 7) * 4;
#pragma unroll
    for (int i = 0; i < 8; ++i) v[i] = __builtin_nontemporal_load((const GAS f32x4*)(W + (size_t)(k0 + i * 8 + lr) * N + n0 + lc));
}
template <bool FP8>
__device__ __forceinline__ void cvt_finish(const f32x4 (&v)[8], int k0, void* __restrict__ dstv, int ldd, int drow0, int kdst0, LAS float* scr, int lane, float wsc) {
    const int lr = lane >> 3, lc = (lane & 7) * 4;
#pragma unroll
    for (int i = 0; i < 8; ++i) { LAS float* s = scr + (i * 8 + lr) * 33 + lc; s[0] = v[i][0]; s[1] = v[i][1]; s[2] = v[i][2]; s[3] = v[i][3]; }
    LDS_WAIT(); asm volatile("" ::: "memory");
    const int c = lane & 7;
#pragma unroll
    for (int j = 0; j < 4; ++j) { const int n = (lane >> 3) + 8 * j; const LAS float* s = scr + (8 * c) * 33 + n;
        if constexpr (FP8) { v2u o; o.x = pk4_fp8(s[0 * 33] * wsc, s[1 * 33] * wsc, s[2 * 33] * wsc, s[3 * 33] * wsc); o.y = pk4_fp8(s[4 * 33] * wsc, s[5 * 33] * wsc, s[6 * 33] * wsc, s[7 * 33] * wsc);
            __builtin_nontemporal_store(o, (GAS v2u*)((unsigned char*)dstv + (size_t)(drow0 + n) * ldd + kdst0 + k0 + 8 * c)); }
        else { v4u o; o.x = pk2(s[0 * 33], s[1 * 33]); o.y = pk2(s[2 * 33], s[3 * 33]); o.z = pk2(s[4 * 33], s[5 * 33]); o.w = pk2(s[6 * 33], s[7 * 33]);
            __builtin_nontemporal_store(o, (GAS v4u*)((bf16*)dstv + (size_t)(drow0 + n) * ldd + kdst0 + k0 + 8 * c)); } }
    LDS_WAIT(); asm volatile("" ::: "memory");
}
#endif
__device__ __forceinline__ int cvt_drow(int mode, int n0, int roff) { return mode == 0 ? n0 + roff : (mode == 1 ? (n0 >> 7) * 256 + (n0 & 127) : (mode == 2 ? (n0 >> 7) * 256 + 128 + (n0 & 127) : (n0 < 576 ? n0 : n0 + 192))); }
template <bool FP8>
__device__ __forceinline__ void cvt_job(Frame& F, const float* W, int K, int N, void* dst, int ldd, int kdst0, int mode, int roff, LAS float* scr, float wsc) {
    const int nnb = N / 32, nitems = (K / 64) * nnb;
    int it = F.gw; if (it >= nitems) return;
    f32x4 va[8], vb[8];
    cvt_load(W, N, (it / nnb) * 64, (it % nnb) * 32, F.lane, va);
    for (;;) {
        const int it1 = it + F.NGW; if (it1 < nitems) cvt_load(W, N, (it1 / nnb) * 64, (it1 % nnb) * 32, F.lane, vb);
        cvt_finish<FP8>(va, (it / nnb) * 64, dst, ldd, cvt_drow(mode, (it % nnb) * 32, roff), kdst0, scr, F.lane, wsc);
        if (it1 >= nitems) break;
        const int it2 = it1 + F.NGW; if (it2 < nitems) cvt_load(W, N, (it2 / nnb) * 64, (it2 % nnb) * 32, F.lane, va);
        cvt_finish<FP8>(vb, (it1 / nnb) * 64, dst, ldd, cvt_drow(mode, (it1 % nnb) * 32, roff), kdst0, scr, F.lane, wsc);
        if (it2 >= nitems) break;
        it = it2;
    }
}
__device__ __forceinline__ void rms_row_to_bf16(const float* xrow, const float* g, bf16* orow, int lane) {
    const GAS f32x4* xr = (const GAS f32x4*)xrow + lane; const GAS f32x4* gr = (const GAS f32x4*)g + lane;
    f32x4 v[8]; float s = 0.f;
#pragma unroll
    for (int j = 0; j < 8; ++j) { v[j] = xr[64 * j]; s += (v[j].x * v[j].x + v[j].y * v[j].y) + (v[j].z * v[j].z + v[j].w * v[j].w); }
    const float rstd = 1.f / sqrtf(wave_sum(s) * (1.f / D) + EPS);
    GAS v2u* o8 = (GAS v2u*)orow + lane;
#pragma unroll
    for (int j = 0; j < 8; ++j) { const f32x4 gg = gr[64 * j]; v2u w; w.x = pk2(v[j].x * rstd * gg.x, v[j].y * rstd * gg.y); w.y = pk2(v[j].z * rstd * gg.z, v[j].w * rstd * gg.w); o8[64 * j] = w; }
}
__device__ __forceinline__ void rms_row_to_fp8(const float* xrow, const float* g, unsigned char* orow, int lane) {
    const GAS f32x4* xr = (const GAS f32x4*)xrow + lane; const GAS f32x4* gr = (const GAS f32x4*)g + lane;
    f32x4 v[8]; float s = 0.f;
#pragma unroll
    for (int j = 0; j < 8; ++j) { v[j] = xr[64 * j]; s += (v[j].x * v[j].x + v[j].y * v[j].y) + (v[j].z * v[j].z + v[j].w * v[j].w); }
    const float rstd = 1.f / sqrtf(wave_sum(s) * (1.f / D) + EPS);
    GAS unsigned* o4 = (GAS unsigned*)orow + lane;
#pragma unroll
    for (int j = 0; j < 8; ++j) { const f32x4 gg = gr[64 * j]; o4[64 * j] = pk4_fp8(v[j].x * rstd * gg.x, v[j].y * rstd * gg.y, v[j].z * rstd * gg.z, v[j].w * rstd * gg.w); }
}
__device__ __forceinline__ void sincos_f64(float ang, float& c, float& s) {
    const double a = (double)ang, twopi = 6.283185307179586476925286766559, inv2pi = 0.15915494309189533576888376337251;
    const double q = __builtin_rint(a * inv2pi); const double r = a - q * twopi;
    const double r2 = r * r; double ss = 1.0, cc = 1.0;
#pragma unroll
    for (int k = 14; k >= 1; --k) { ss = 1.0 - r2 * (1.0 / (double)((2 * k) * (2 * k + 1))) * ss; cc = 1.0 - r2 * (1.0 / (double)((2 * k - 1) * (2 * k))) * cc; }
    s = (float)(r * ss); c = (float)cc;
}
__device__ const unsigned char DIL_BUCKET[3][129] = {
 {11,11,11,11,11,11,11,11,11,11,11,11,11,11,11,10,10,10,10,10,10,10,10,10,10,10,10,10,10,10,10,10,10,10,10,10,10,10,9,9,9,9,9,9,9,9,9,9,9,9,8,8,8,8,8,8,8,7,6,5,4,3,2,1,0,17,18,19,20,21,22,23,24,24,24,24,24,24,24,25,25,25,25,25,25,25,25,25,25,25,25,26,26,26,26,26,26,26,26,26,26,26,26,26,26,26,26,26,26,26,26,26,26,26,27,27,27,27,27,27,27,27,27,27,27,27,27,27,27},
 {13,13,13,13,13,13,13,13,13,13,13,13,13,13,13,13,13,13,13,13,13,13,13,12,12,12,12,12,12,12,12,12,12,12,12,12,12,12,12,12,12,12,11,11,11,11,11,11,11,11,11,11,10,10,10,10,10,10,9,9,9,8,8,4,0,20,24,24,25,25,25,26,26,26,26,26,26,27,27,27,27,27,27,27,27,27,27,28,28,28,28,28,28,28,28,28,28,28,28,28,28,28,28,28,28,28,29,29,29,29,29,29,29,29,29,29,29,29,29,29,29,29,29,29,29,29,29,29,29},
 {15,15,15,15,15,15,15,15,15,15,15,15,15,15,15,15,15,15,15,15,15,15,15,15,15,15,15,15,15,15,14,14,14,14,14,14,14,14,14,14,14,14,14,14,14,13,13,13,13,13,13,13,13,13,12,12,12,12,12,11,11,10,10,9,0,25,26,26,27,27,28,28,28,28,28,29,29,29,29,29,29,29,29,29,30,30,30,30,30,30,30,30,30,30,30,30,30,30,30,31,31,31,31,31,31,31,31,31,31,31,31,31,31,31,31,31,31,31,31,31,31,31,31,31,31,31,31,31,31}};

typedef float f32x2 __attribute__((ext_vector_type(2)));
#ifndef UP_EXACT
#define UP_EXACT 1
#endif
#ifndef PRE_ROWS
#define PRE_ROWS 4
#endif
#ifndef COMB_ROWS
#define COMB_ROWS 2
#endif
__device__ __forceinline__ f32x4 ld_r4(const float* p) { return *(const GAS f32x4*)p; }
__device__ __forceinline__ v2u ld_r4(const unsigned short* p) { return *(const GAS v2u*)p; }
__device__ __forceinline__ f32x4 cv4(f32x4 r) { return r; }
__device__ __forceinline__ f32x4 cv4(v2u w) { return (f32x4){bflo(w.x), bfhi(w.x), bflo(w.y), bfhi(w.y)}; }
__device__ __forceinline__ f32x4 ld_o4(const float* p) { return *(const GAS f32x4*)p; }
__device__ __forceinline__ f32x4 ld_o4(const unsigned short* p) { const v2u w = *(const GAS v2u*)p; return (f32x4){bflo(w.x), bfhi(w.x), bflo(w.y), bfhi(w.y)}; }
#ifndef CVT_CHUNK
#define CVT_CHUNK 64
#endif
#ifndef PH_MASK
#define PH_MASK 0xFFFFu
#endif
#ifndef REPEAT_PHASE
#define REPEAT_PHASE -1
#endif
#ifndef ATT_EN
#define ATT_EN 7
#endif
#define PEN(k) ((PH_MASK >> (k)) & 1u)
#ifndef FFN_FP8
#define FFN_FP8 3
#endif
constexpr bool F8D = (FFN_FP8 & 1) != 0, F8M = (FFN_FP8 & 2) != 0;
constexpr int EBD = F8D ? 1 : 2, EBM = F8M ? 1 : 2;
template <bool B> struct Sc { static constexpr float w_gu = B ? 32.f : 1.f, w_dn = B ? 64.f : 1.f, a_sc = B ? 4.f : 1.f, dn = 1.f / (w_dn * a_sc); };
template <bool B> using FfnEpi1 = typename std::conditional<B, pg8::EpiSwiGLU8, pg8::EpiSwiGLU>::type;
template <bool B> struct Epi1Maker;
template <> struct Epi1Maker<true> { static __device__ __forceinline__ pg8::EpiSwiGLU8 make(void* O, int ldc) { return pg8::EpiSwiGLU8{(unsigned char*)O, ldc, 1.f / Sc<true>::w_gu, Sc<true>::a_sc}; } };
template <> struct Epi1Maker<false> { static __device__ __forceinline__ pg8::EpiSwiGLU make(void* O, int ldc) { return pg8::EpiSwiGLU{(unsigned short*)O, ldc}; } };

constexpr int MOE_MAT_ITEMS = 7168, MOE_GU_ITEMS = 16 * MOE_MAT_ITEMS, MOE_NITEMS = 24 * MOE_MAT_ITEMS, MOE_CHUNK = CVT_CHUNK, MOE_NCHUNK = MOE_NITEMS / MOE_CHUNK;
struct MoeItem { const float* W; void* dst; int N, k0, n0, ldd, drow0; float wsc; };
typedef const __attribute__((address_space(4))) Args* KArgs;
__device__ __forceinline__ MoeItem moe_item(KArgs ka, unsigned char* ws, int idx) {
    MoeItem m;
    if (idx < MOE_GU_ITEMS) { const int mat = idx / MOE_MAT_ITEMS, local = idx % MOE_MAT_ITEMS, e = mat >> 1, up = mat & 1, kb = local / (DFE / 32), nb = local % (DFE / 32);
        m.W = ka->in[19 + up] + (size_t)e * D * DFE; m.N = DFE; m.k0 = kb * 64; m.n0 = nb * 32; m.dst = ws + WS_MGU + (size_t)e * 2 * DFE * D * EBM; m.ldd = D;
        m.drow0 = (m.n0 >> 7) * 256 + up * 128 + (m.n0 & 127); m.wsc = Sc<F8M>::w_gu; }
    else { const int i2 = idx - MOE_GU_ITEMS, e = i2 / MOE_MAT_ITEMS, local = i2 % MOE_MAT_ITEMS, kb = local / (D / 32), nb = local % (D / 32);
        m.W = ka->in[21] + (size_t)e * DFE * D; m.N = D; m.k0 = kb * 64; m.n0 = nb * 32; m.dst = ws + WS_MDN + (size_t)e * D * DFE * EBM; m.ldd = DFE; m.drow0 = m.n0; m.wsc = Sc<F8M>::w_dn; }
    return m;
}
__device__ __forceinline__ void moe_cvt_chunk(Frame& F, KArgs ka, int c) {
    LAS float* scr = (LAS float*)(F.lds + F.wave * 16384);
    const int i0 = c * MOE_CHUNK + F.wave * (MOE_CHUNK / 8);
    f32x4 va[8], vb[8], vc[8]; MoeItem ma, mb, mc;
#define MC_L(m, v, i) do { m = moe_item(ka, F.ws, i0 + (i)); cvt_load(m.W, m.N, m.k0, m.n0, F.lane, v); } while (0)
#define MC_F(m, v) cvt_finish<F8M>(v, m.k0, m.dst, m.ldd, m.drow0, 0, scr, F.lane, m.wsc)
    MC_L(ma, va, 0); MC_L(mb, vb, 1); MC_L(mc, vc, 2);
    if constexpr (MOE_CHUNK == 64) {
        MC_F(ma, va); MC_L(ma, va, 3); MC_F(mb, vb); MC_L(mb, vb, 4); MC_F(mc, vc); MC_L(mc, vc, 5);
        MC_F(ma, va); MC_L(ma, va, 6); MC_F(mb, vb); MC_L(mb, vb, 7); MC_F(mc, vc); MC_F(ma, va); MC_F(mb, vb);
    } else {
        MC_F(ma, va); MC_L(ma, va, 3); MC_F(mb, vb); MC_F(mc, vc); MC_F(ma, va);
    }
#undef MC_L
#undef MC_F
}
__device__ __forceinline__ void moe_cvt_fill(Frame& F, KArgs ka, int ph) {
    { int t_ = threadIdx.x; asm volatile("" : "+v"(t_)); F.tid = t_; F.lane = t_ & 63; }
    for (;;) {
        if (F.tid == 0) { unsigned c = MOE_NCHUNK;
            if (ph < 0 || __hip_atomic_load(F.ctl + CW_DONE + ph, RLX_AGENT) < (unsigned)F.G) c = __hip_atomic_fetch_add(F.ctl + CW_CVT + (ph == -2 ? 16 : 0), 1u, RLX_AGENT);
            F.MISC[17] = c; }
        __syncthreads(); const unsigned c = F.MISC[17]; __syncthreads();
        if (c >= (unsigned)MOE_NCHUNK) break;
        moe_cvt_chunk(F, ka, (int)c);
    }
}
#define FILL(ph) do { __syncthreads(); if (F.tid == 0) (void)__hip_atomic_fetch_add(F.ctl + CW_DONE + (ph), 1u, RLX_AGENT); moe_cvt_fill(F, ka, (ph)); } while (0)
#ifndef MLA_DMA
#define MLA_DMA 1
#endif
#ifndef MOE_TAIL
#define MOE_TAIL 1
#endif
#ifndef GEMM_SP2
#define GEMM_SP2 1
#endif
constexpr bool SP2V = (GEMM_SP2 != 0);
#ifndef PROBE_ATT
#define PROBE_ATT 7
#endif
#ifndef FILLMASK
#define FILLMASK 7
#endif
constexpr int PH_PER_LAYER = 11, N_PHASES = 1 + 2 * PH_PER_LAYER;
#ifndef MK_N_LAUNCHES
#define MK_N_LAUNCHES 1
#endif
constexpr int N_LAUNCHES = MK_N_LAUNCHES;

__global__ void __launch_bounds__(NWAVES * 64, 2) mk_fwd(Args) {
    KArgs ka = (KArgs)__builtin_amdgcn_kernarg_segment_ptr(); asm volatile("" : "+s"(ka));
#define args (*ka)
    extern __shared__ __attribute__((aligned(16))) unsigned char lds[];
    Frame F;
    F.lds = (LAS unsigned char*)lds;
    F.MISC = (volatile LAS unsigned*)(F.lds + MISC_OFF);
    F.tid = threadIdx.x; F.lane = F.tid & 63; F.wave = __builtin_amdgcn_readfirstlane(F.tid >> 6);
    F.G = gridDim.x; F.gw = blockIdx.x * NWAVES + F.wave; F.NGW = F.G * NWAVES;
    F.ws = args.ws; F.ctl = (gu32*)(args.ws + WS_CTL);
    unsigned char* ws = args.ws;
    for (int u = F.tid; u < (LDS_BYTES - LDSCTL_OFF) / 4; u += NWAVES * 64) ((LAS unsigned*)(F.lds + LDSCTL_OFF))[u] = 0u;
    __syncthreads();
    XcdBarrier bar; bar.bar = (unsigned*)(F.ctl + CW_BAR) + args.li * 4096; bar.x = 0; bar.st = nullptr;
    if (N_LAUNCHES != N_PHASES) bar = xcd_barrier_post((unsigned*)(F.ctl + CW_BAR) + args.li * 4096, F.MISC + 8);
#define GRID_BAR() do { if (N_LAUNCHES != N_PHASES) xcd_barrier(bar); } while (0)
    const int lo = args.ph_lo, hi = args.ph_hi;
#define IN(k) (lo <= (k) && (k) < hi)
#define BOTH(k) (IN(k) && IN((k) + 1))

#define x_in (args.in[0])
#define XN8 ((unsigned char*)(ws + WS_XN))
#define WIN ((bf16*)(ws + WS_WIN))
#define WUP ((bf16*)(ws + WS_WUP))
#define WMEM ((bf16*)(ws + WS_WMEM))
#define WOUT ((bf16*)(ws + WS_WOUT))
#define WGU ((bf16*)(ws + WS_WGU))
#define WDN ((bf16*)(ws + WS_WDN))
#define MGU ((bf16*)(ws + WS_MGU))
#define MDN ((bf16*)(ws + WS_MDN))
#define XN ((bf16*)(ws + WS_XN))
#define MEMN ((bf16*)(ws + WS_MEMN))
#define MEMKV ((bf16*)(ws + WS_MEMKV))
#define PROJ ((bf16*)(ws + WS_PROJ))
#define AQKV ((bf16*)(ws + WS_AQKV))
#define KROPE ((bf16*)(ws + WS_KROPE))
#define ROPECS ((float*)(ws + WS_ROPECS))
#define QKVM ((bf16*)(ws + WS_QKVM))
#define YPRE ((att::OT*)(ws + WS_YPRE))
#define YPREF ((float*)(ws + WS_YPRE))
#define DILO ((att::OT*)(ws + WS_DILO))
#define DILS ((float*)(ws + WS_DILS))
#define Y ((bf16*)(ws + WS_Y))
#define XA ((float*)(ws + WS_XA))
#define ROUTE ((unsigned*)(ws + WS_ROUTE))
#define XP ((bf16*)(ws + WS_XP))
#define OUTP ((bf16*)(ws + WS_OUTP))
#define OUTQ ((bf16*)(ws + WS_OUTQ))
#define ACTP ((bf16*)(ws + WS_ACTP))
#define ACT ((bf16*)(ws + WS_ACTP))
#if defined(PROBE_T)
#define TSTAMP_AT(p) do { if (threadIdx.x == 0) { ((volatile LAS unsigned*)(F.lds + 131520))[(p)] = (unsigned)__builtin_amdgcn_s_memrealtime(); ((volatile LAS unsigned*)(F.lds + 131520))[32 + (p)] = (unsigned)__builtin_amdgcn_s_memtime(); } } while (0)
#else
#define TSTAMP_AT(p) do { } while (0)
#endif
#define PHASE_BEGIN() do { int t_ = threadIdx.x; asm volatile("" : "+v"(t_)); F.tid = t_; F.lane = t_ & 63; asm volatile("" : "+s"(ka)); } while (0)

    if (PEN(0) && IN(0)) { PHASE_BEGIN(); TSTAMP_AT(0);
        LAS float* scr = (LAS float*)(F.lds + F.wave * 16384);
        { const v4u z = {0u, 0u, 0u, 0u}; const int gt = blockIdx.x * (NWAVES * 64) + F.tid, ngt = F.G * NWAVES * 64;
          for (int l = 0; l < 2; ++l) {
              GAS v4u* w = (GAS v4u*)(WIN + (size_t)l * DINP * D + (size_t)576 * D); for (int i = gt; i < 192 * D / 8; i += ngt) w[i] = z;
              GAS v4u* u = (GAS v4u*)(WUP + (size_t)l * NUP * AQ);
              for (int i = gt; i < NUP * 64; i += ngt) { const int row = i >> 6, c = i & 63; const bool zero = row < 1152 ? (c >= 48) : (row < 1280 ? true : (c < 48)); if (zero) u[i] = z; } } }
        for (int rep = 0; rep < (REPEAT_PHASE == 0 ? 2 : 1); ++rep) {
        for (int l = 0; l < 2; ++l) {
            cvt_job<false>(F, args.in[5] + (size_t)l * D * DIN, D, DIN, WIN + (size_t)l * DINP * D, D, 0, 3, 0, scr, 1.f);
            cvt_job<false>(F, args.in[7] + (size_t)l * QR * 1152, QR, 1152, WUP + (size_t)l * NUP * AQ, AQ, 0, 0, 0, scr, 1.f);
            cvt_job<false>(F, args.in[9] + (size_t)l * KVR * 1536, KVR, 1536, WUP + (size_t)l * NUP * AQ, AQ, QR, 0, UC_KV, scr, 1.f);
            cvt_job<false>(F, args.in[11] + (size_t)l * D * 1024, D, 1024, WMEM + (size_t)l * 1024 * D, D, 0, 0, 0, scr, 1.f);
            cvt_job<false>(F, args.in[13] + (size_t)l * D * D, D, D, WOUT + (size_t)l * D * D, D, 0, 0, 0, scr, 1.f);
        }
        cvt_job<F8D>(F, args.in[15], D, DFF, WGU, D, 0, 1, 0, scr, Sc<F8D>::w_gu);
        cvt_job<F8D>(F, args.in[16], D, DFF, WGU, D, 0, 2, 0, scr, Sc<F8D>::w_gu);
        cvt_job<F8D>(F, args.in[17], DFF, D, WDN, DFF, 0, 0, 0, scr, Sc<F8D>::w_dn);
        }
        { const int* pos = (const int*)args.in[2];
          for (int idx = blockIdx.x * (NWAVES * 64) + F.tid; idx < S * 32; idx += F.G * NWAVES * 64) { const int row = idx >> 5, i = idx & 31;
              const float ang = (float)pos[row] * args.invf[i]; float c, s; sincos_f64(ang, c, s); ROPECS[row * 64 + i] = c; ROPECS[row * 64 + 32 + i] = s; } }
        for (int m = F.gw; m < 2 * NMEM; m += F.NGW) { const int l = m >> 8, r = m & 255; rms_row_to_bf16(args.in[1] + (size_t)r * D, args.in[10] + (size_t)l * D, MEMN + (size_t)m * D, F.lane); }
        for (int m = F.gw; m < S; m += F.NGW) rms_row_to_bf16(x_in + (size_t)m * D, args.in[4], XN + (size_t)m * D, F.lane);
        if (BOTH(0)) GRID_BAR();
    }

    for (int l = 0; l < 2; ++l) {
        const int pb = 1 + l * PH_PER_LAYER;
        if (PEN(1) && IN(pb + 0)) { PHASE_BEGIN(); TSTAMP_AT(pb + 0);
            { pg8::Gemm g{XN, WIN + (size_t)l * DINP * D, 2 * D, 2 * D, D / 64}; pg8::InProjOrder So; So.so.init(S, DINP, F.G, (int)blockIdx.x); So.nextra = (l == 0) ? 8 : 0; So.A2 = MEMN; So.B2 = WMEM;
              pg8::EpiBf16Sel E{PROJ, DINP, MEMKV, 1024};
              pg8::gemm_phase<pg8::EpiBf16Sel, pg8::InProjOrder, true, SP2V>(F.lds, g, So, E); }
            if (FILLMASK & 1) FILL(pb + 0);
            if (BOTH(pb + 0)) GRID_BAR();
        }
        if (PEN(2) && IN(pb + 1)) { PHASE_BEGIN(); TSTAMP_AT(pb + 1);
            const float* gq = args.in[6] + l * QR; const float* gkv = args.in[8] + l * KVR;
            const float* gp = F.lane < 48 ? gq + F.lane * 8 : gkv + (F.lane - 48) * 8;
            const f32x4 g0 = *(const GAS f32x4*)gp, g1 = *(const GAS f32x4*)(gp + 4);
            const int c = F.lane & 7;
            constexpr int PR = PRE_ROWS;
            for (int m0 = F.gw; m0 < S; m0 += PR * F.NGW) {
                v4u w_[PR], kw_[PR]; f32x4 cs_[PR][4];
#pragma unroll
                for (int r = 0; r < PR; ++r) { const int mr = m0 + r * F.NGW, m = mr < S ? mr : m0;
                    w_[r] = *(const GAS v4u*)(PROJ + (size_t)m * DINP + F.lane * 8);
                    kw_[r] = *(const GAS v4u*)(PROJ + (size_t)m * DINP + 512 + c * 8);
                    const float* cs = ROPECS + (size_t)m * 64 + (c & 3) * 8;
                    cs_[r][0] = *(const GAS f32x4*)cs; cs_[r][1] = *(const GAS f32x4*)(cs + 4); cs_[r][2] = *(const GAS f32x4*)(cs + 32); cs_[r][3] = *(const GAS f32x4*)(cs + 36); }
#pragma unroll
                for (int r = 0; r < PR; ++r) { const int m = m0 + r * F.NGW; if (m >= S) break;
                    const v4u w = w_[r];
                    float v[8] = {bflo(w.x), bfhi(w.x), bflo(w.y), bfhi(w.y), bflo(w.z), bfhi(w.z), bflo(w.w), bfhi(w.w)};
                    float sq = 0.f;
#pragma unroll
                    for (int j = 0; j < 8; ++j) sq += v[j] * v[j];
                    const float sq_q = wave_sum(F.lane < 48 ? sq : 0.f), sq_kv = wave_sum(F.lane >= 48 ? sq : 0.f);
                    const float rstd = F.lane < 48 ? 1.f / sqrtf(sq_q * (1.f / QR) + EPS) : 1.f / sqrtf(sq_kv * (1.f / KVR) + EPS);
                    v4u o; o.x = pk2(v[0] * rstd * g0.x, v[1] * rstd * g0.y); o.y = pk2(v[2] * rstd * g0.z, v[3] * rstd * g0.w);
                    o.z = pk2(v[4] * rstd * g1.x, v[5] * rstd * g1.y); o.w = pk2(v[6] * rstd * g1.z, v[7] * rstd * g1.w);
                    *(GAS v4u*)(AQKV + (size_t)m * AQ + F.lane * 8) = o;
                    const v4u kw = kw_[r];
                    float kv[8] = {bflo(kw.x), bfhi(kw.x), bflo(kw.y), bfhi(kw.y), bflo(kw.z), bfhi(kw.z), bflo(kw.w), bfhi(kw.w)};
                    float ko[8];
#pragma unroll
                    for (int j = 0; j < 8; ++j) { const float other = __shfl_xor(kv[j], 4); const float co = cs_[r][j >> 2][j & 3], si = cs_[r][2 + (j >> 2)][j & 3];
                        ko[j] = (c < 4) ? (kv[j] * co - other * si) : (other * si + kv[j] * co); }
                    if (F.lane < 8) { v4u ow; ow.x = pk2(ko[0], ko[1]); ow.y = pk2(ko[2], ko[3]); ow.z = pk2(ko[4], ko[5]); ow.w = pk2(ko[6], ko[7]); *(GAS v4u*)(KROPE + (size_t)m * 64 + c * 8) = ow; }
                }
            }
            if (BOTH(pb + 1)) GRID_BAR();
        }
        if (PEN(3) && IN(pb + 2)) { PHASE_BEGIN(); TSTAMP_AT(pb + 2);
#if UP_EXACT
            pg8::Gemm g{AQKV, WUP + (size_t)l * NUP * AQ, 2 * AQ, 2 * AQ, AQ / 64}; pg8::UpProjOrder So{F.G, (int)blockIdx.x};
            pg8::EpiBf16 E{QKVM, NUP, 1.f};
            pg8::gemm_phase<pg8::EpiBf16, pg8::UpProjOrder, true, SP2V>(F.lds, g, So, E);
#else
            pg8::Gemm g{AQKV, WUP + (size_t)l * NUP * AQ, 2 * AQ, 2 * AQ, AQ / 64}; pg8::StaticOrder So; So.init(S, NUP, F.G, (int)blockIdx.x);
            pg8::EpiBf16 E{QKVM, NUP, 1.f};
            pg8::gemm_phase<pg8::EpiBf16, pg8::StaticOrder, true, SP2V>(F.lds, g, So, E);
#endif
            if (FILLMASK & 2) FILL(pb + 2);
            if (BOTH(pb + 2)) GRID_BAR();
        }
        if (PEN(4) && IN(pb + 3)) { PHASE_BEGIN(); TSTAMP_AT(pb + 3);
            LAS float* BIAS = (LAS float*)(F.lds + BIAS_OFF);
            for (int i = F.tid; i < 3 * 6 * 129; i += NWAVES * 64) { const int b = i / (6 * 129), rem = i % (6 * 129), h = rem / 129, j = rem % 129;
                BIAS[(b * 6 + h) * 132 + j] = args.in[3][DIL_BUCKET[b][j] * 6 + h] * att::LOG2E; }
            __syncthreads();
            for (int rep = 0; rep < (REPEAT_PHASE == 4 ? 2 : 1); ++rep) {
            gu32* qhead = F.ctl + CW_QUEUE + 64 * l + 32 * rep + 4 * args.li;
            constexpr int NU_MLA = 6 * 32, NU_MEM = 4 * 32, NU_DIL = 3 * 6 * 32, NU = NU_MLA + NU_MEM + NU_DIL;
#define QPULL(u) do { if (F.tid == 0) F.MISC[16] = __hip_atomic_fetch_add(qhead, 1u, RLX_AGENT); __syncthreads(); u = (int)F.MISC[16]; __syncthreads(); } while (0)
            int u; QPULL(u);
            if ((ATT_EN & 1) && (!args.rep || (PROBE_ATT & 1))) while (u < NU_MLA) {
                const int h = u >> 5, qb = u & 31;
                att::MLA_BODY<NUP, NUP, D>(QKVM + (size_t)qb * 256 * NUP + h * 192, QKVM + UC_KV + h * 256, KROPE, QKVM + UC_KV + h * 256 + 128,
                                                        ROPECS + (size_t)qb * 256 * 64, YPRE + (size_t)qb * 256 * D + h * 128, S, 0.07216878364870322f, (LAS char*)F.lds);
                QPULL(u);
            }
            if (args.rep && !(PROBE_ATT & 1)) { while (u < NU_MLA) QPULL(u); }
            if ((ATT_EN & 2) && (!args.rep || (PROBE_ATT & 2))) while (u < NU_MLA + NU_MEM) {
                const int v = u - NU_MLA, h = v >> 5, qb = v & 31;
                const bf16* kv = MEMKV + (size_t)l * NMEM * 1024;
                att::attn_dense_body<128, DINP, 1024, D, 1>(PROJ + (size_t)qb * 256 * DINP + PC_MEM + h * 128, kv + h * 128, nullptr, kv + 512 + h * 128,
                                                            nullptr, YPRE + (size_t)qb * 256 * D + 1536 + h * 128, NMEM, 0.08838834764831845f, (LAS char*)F.lds);
                QPULL(u);
            }
            if (args.rep && !(PROBE_ATT & 2)) { while (u < NU_MLA + NU_MEM) QPULL(u); }
            if ((ATT_EN & 4) && (!args.rep || (PROBE_ATT & 4))) while (u < NU) {
                const int w = (u - NU_MLA - NU_MEM) * 8;
                const int b = w / 1536, h = (w % 1536) >> 8, tile = w & 255;
                const int d = b == 0 ? 1 : (b == 1 ? 4 : 16), nT = S / d, tpr = nT / 32;
                const int r = tile / tpr, t0 = (tile % tpr) * 32;
                LAS float* TB = (LAS float*)(F.lds + BIAS_OFF + 3 * 6 * 132 * 4);
                for (int i = F.tid; i < 4 * 196; i += NWAVES * 64) { const int k = i / 196, j = (i % 196) + k - 32; TB[i] = (j >= 0 && j <= 128) ? BIAS[(b * 6 + h) * 132 + j] : -1e30f; }
                __syncthreads();
                att::dil_wg_unit<DINP>(PROJ, PC_DIL + h * 128, PC_DIL + 768 + h * 128, PC_DIL + 1536 + h * 128, d, r, t0, nT,
                                       DILO + (size_t)b * S * 768, h * 128, DILS + (size_t)b * S * 12 + h * 2, (LAS char*)F.lds, TB, 0.08838834764831845f * att::LOG2E);
                QPULL(u);
            }
#undef QPULL
            }
            if (FILLMASK & 4) FILL(pb + 3);
            if (BOTH(pb + 3)) GRID_BAR();
        }
        if (PEN(5) && IN(pb + 4)) { PHASE_BEGIN(); TSTAMP_AT(pb + 4);
            const float* gn = args.in[12] + (size_t)l * D;
            constexpr int CR = COMB_ROWS;
            typedef decltype(ld_r4((const att::OT*)nullptr)) RawO;
            for (int m0 = F.gw; m0 < S; m0 += CR * F.NGW) {
                RawO ya[CR][3], yc[CR][2], ob[CR][3][3]; f32x2 st[CR][3][3];
#pragma unroll
                for (int r = 0; r < CR; ++r) { const int mr = m0 + r * F.NGW, m = mr < S ? mr : m0; const att::OT* yr = YPRE + (size_t)m * D;
#pragma unroll
                    for (int j = 0; j < 3; ++j) ya[r][j] = ld_r4(yr + (F.lane + 64 * j) * 4);
#pragma unroll
                    for (int j = 0; j < 2; ++j) yc[r][j] = ld_r4(yr + 1536 + (F.lane + 64 * j) * 4);
#pragma unroll
                    for (int j = 0; j < 3; ++j) { const int col = (F.lane + 64 * j) * 4, h = col >> 7;
#pragma unroll
                        for (int b = 0; b < 3; ++b) { st[r][j][b] = *(const GAS f32x2*)(DILS + ((size_t)b * S + m) * 12 + h * 2); ob[r][j][b] = ld_r4(DILO + ((size_t)b * S + m) * 768 + col); } } }
#pragma unroll
                for (int r = 0; r < CR; ++r) { const int m = m0 + r * F.NGW; if (m >= S) break;
                    f32x4 a[3]; float sa = 0.f;
#pragma unroll
                    for (int j = 0; j < 3; ++j) { a[j] = cv4(ya[r][j]); sa += (a[j].x * a[j].x + a[j].y * a[j].y) + (a[j].z * a[j].z + a[j].w * a[j].w); }
                    f32x4 c[2]; float sc = 0.f;
#pragma unroll
                    for (int j = 0; j < 2; ++j) { c[j] = cv4(yc[r][j]); sc += (c[j].x * c[j].x + c[j].y * c[j].y) + (c[j].z * c[j].z + c[j].w * c[j].w); }
                    f32x4 bq[3]; float sb = 0.f;
#pragma unroll
                    for (int j = 0; j < 3; ++j) {
                        const float M = fmaxf(st[r][j][0].x, fmaxf(st[r][j][1].x, st[r][j][2].x));
                        float wgt[3], den = 0.f;
#pragma unroll
                        for (int b = 0; b < 3; ++b) { wgt[b] = __builtin_amdgcn_exp2f(st[r][j][b].x - M); den += wgt[b] * st[r][j][b].y; }
                        const float inv = 1.f / den; f32x4 acc = {0.f, 0.f, 0.f, 0.f};
#pragma unroll
                        for (int b = 0; b < 3; ++b) acc += cv4(ob[r][j][b]) * (wgt[b] * inv);
                        bq[j] = acc; sb += (acc.x * acc.x + acc.y * acc.y) + (acc.z * acc.z + acc.w * acc.w); }
                    const float ra = 1.f / sqrtf(wave_sum(sa) * (1.f / 768.f) + EPS), rb = 1.f / sqrtf(wave_sum(sb) * (1.f / 768.f) + EPS), rc = 1.f / sqrtf(wave_sum(sc) * (1.f / 512.f) + EPS);
                    bf16* yo = Y + (size_t)m * D;
#pragma unroll
                    for (int j = 0; j < 3; ++j) { const int col = (F.lane + 64 * j) * 4; const f32x4 g = *(const GAS f32x4*)(gn + col);
                        v2u w; w.x = pk2(a[j].x * ra * g.x, a[j].y * ra * g.y); w.y = pk2(a[j].z * ra * g.z, a[j].w * ra * g.w); *(GAS v2u*)(yo + col) = w; }
#pragma unroll
                    for (int j = 0; j < 3; ++j) { const int col = (F.lane + 64 * j) * 4; const f32x4 g = *(const GAS f32x4*)(gn + 768 + col);
                        v2u w; w.x = pk2(bq[j].x * rb * g.x, bq[j].y * rb * g.y); w.y = pk2(bq[j].z * rb * g.z, bq[j].w * rb * g.w); *(GAS v2u*)(yo + 768 + col) = w; }
#pragma unroll
                    for (int j = 0; j < 2; ++j) { const int col = (F.lane + 64 * j) * 4; const f32x4 g = *(const GAS f32x4*)(gn + 1536 + col);
                        v2u w; w.x = pk2(c[j].x * rc * g.x, c[j].y * rc * g.y); w.y = pk2(c[j].z * rc * g.z, c[j].w * rc * g.w); *(GAS v2u*)(yo + 1536 + col) = w; }
                }
            }
            if (BOTH(pb + 4)) GRID_BAR();
        }
        if (PEN(6) && IN(pb + 5)) { PHASE_BEGIN(); TSTAMP_AT(pb + 5);
            pg8::Gemm g{Y, WOUT + (size_t)l * D * D, 2 * D, 2 * D, D / 64}; pg8::StaticOrder So; So.init(S, D, F.G, (int)blockIdx.x);
            pg8::EpiResF32 E{l == 0 ? x_in : XA, args.rep ? YPREF : XA, D, 1.f};
            pg8::gemm_phase<pg8::EpiResF32, pg8::StaticOrder, true, SP2V>(F.lds, g, So, E);
            if (BOTH(pb + 5)) GRID_BAR();
        }
        if (PEN(7) && IN(pb + 6)) { PHASE_BEGIN(); TSTAMP_AT(pb + 6);
            const float* gf = args.in[14] + (size_t)l * D;
#if defined(PROBE_DEADLINE)
            if (l == 1 && blockIdx.x == 0 && F.tid == 0) F.ctl[CW_CVT + 16] = __hip_atomic_load(F.ctl + CW_CVT, RLX_AGENT);
#endif
            if (l == 0) { for (int m = F.gw; m < S; m += F.NGW) { if constexpr (F8D) rms_row_to_fp8(XA + (size_t)m * D, gf, XN8 + (size_t)m * D, F.lane); else rms_row_to_bf16(XA + (size_t)m * D, gf, XN + (size_t)m * D, F.lane); } }
            else {
                const float* Wr = args.in[18];
                LAS unsigned* LC = (LAS unsigned*)F.lds;
                if (F.tid < NE) LC[F.tid] = 0u;
                LAS f32x4* WL = (LAS f32x4*)(F.lds + 1024);
                for (int i = F.tid; i < 2048 * 2; i += NWAVES * 64) { const int half = i & 1, idx = i >> 1, ln = idx & 63, jq = idx >> 6, j = jq >> 2, q = jq & 3, k = (ln + 64 * j) * 4 + q;
                    WL[i] = *(const GAS f32x4*)(Wr + (size_t)k * NE + half * 4); }
                __syncthreads();
                for (int m = F.gw; m < S; m += F.NGW) {
                    const GAS f32x4* xr = (const GAS f32x4*)(XA + (size_t)m * D) + F.lane; const GAS f32x4* gr = (const GAS f32x4*)gf + F.lane;
                    f32x4 v[8]; float s = 0.f;
#pragma unroll
                    for (int j = 0; j < 8; ++j) { v[j] = xr[64 * j]; s += (v[j].x * v[j].x + v[j].y * v[j].y) + (v[j].z * v[j].z + v[j].w * v[j].w); }
                    const float rstd = 1.f / sqrtf(wave_sum(s) * (1.f / D) + EPS);
                    float lg[8] = {0.f, 0.f, 0.f, 0.f, 0.f, 0.f, 0.f, 0.f};
                    GAS v2u* o8 = (GAS v2u*)(XN + (size_t)m * D) + F.lane; GAS unsigned* o4 = (GAS unsigned*)(XN8 + (size_t)m * D) + F.lane;
#pragma unroll
                    for (int j = 0; j < 8; ++j) { const f32x4 gg = gr[64 * j]; const f32x4 hh = {v[j].x * rstd * gg.x, v[j].y * rstd * gg.y, v[j].z * rstd * gg.z, v[j].w * rstd * gg.w};
                        if constexpr (F8M) o4[64 * j] = pk4_fp8(hh.x, hh.y, hh.z, hh.w); else { v2u w; w.x = pk2(hh.x, hh.y); w.y = pk2(hh.z, hh.w); o8[64 * j] = w; }
#pragma unroll
                        for (int q = 0; q < 4; ++q) { const f32x4 w0 = WL[(((j * 4 + q) * 64) + F.lane) * 2], w1 = WL[(((j * 4 + q) * 64) + F.lane) * 2 + 1]; const float hv = hh[q];
                            lg[0] += hv * w0.x; lg[1] += hv * w0.y; lg[2] += hv * w0.z; lg[3] += hv * w0.w; lg[4] += hv * w1.x; lg[5] += hv * w1.y; lg[6] += hv * w1.z; lg[7] += hv * w1.w; } }
#pragma unroll
                    for (int e = 0; e < NE; ++e) lg[e] = wave_sum(lg[e]);
                    int e1 = 0; float v1 = lg[0];
#pragma unroll
                    for (int e = 1; e < NE; ++e) if (lg[e] > v1) { v1 = lg[e]; e1 = e; }
                    int e2 = -1; float v2 = -3.0e38f;
#pragma unroll
                    for (int e = 0; e < NE; ++e) if (e != e1 && lg[e] > v2) { v2 = lg[e]; e2 = e; }
                    const float g1 = 1.f / (1.f + __expf(v2 - v1)), g2 = 1.f - g1;
                    if (F.lane == 0) { const unsigned s1 = __hip_atomic_fetch_add(LC + e1, 1u, __ATOMIC_RELAXED, __HIP_MEMORY_SCOPE_WORKGROUP), s2 = __hip_atomic_fetch_add(LC + e2, 1u, __ATOMIC_RELAXED, __HIP_MEMORY_SCOPE_WORKGROUP);
                        v4u r0 = {(unsigned)e1, (unsigned)e2, s1, s2}; v4u r1 = {__float_as_uint(g1), __float_as_uint(g2), 0u, 0u};
                        *(GAS v4u*)(ROUTE + (size_t)m * 8) = r0; *(GAS v4u*)(ROUTE + (size_t)m * 8 + 4) = r1; }
                }
                __syncthreads();
                if (F.tid < NE) F.ctl[CW_CNTW + blockIdx.x * NE + F.tid] = LC[F.tid];
            }
            if (BOTH(pb + 6)) GRID_BAR();
        }
        if (PEN(8) && IN(pb + 7)) { PHASE_BEGIN(); TSTAMP_AT(pb + 7);
            if (l == 1) {
                moe_cvt_fill(F, ka, -1);
#if defined(PROBE_DEADLINE)
                for (int r_ = 0; r_ < PROBE_DEADLINE; ++r_) { __syncthreads(); moe_cvt_fill(F, ka, -2); }
#endif
                { LAS unsigned* LT = (LAS unsigned*)F.lds;
                  int tot = 0, bel = 0;
                  for (int w = F.lane; w < F.G; w += 64) { const int c = (int)F.ctl[CW_CNTW + w * NE + F.wave]; tot += c; bel += (w < (int)blockIdx.x) ? c : 0; }
#pragma unroll
                  for (int o = 1; o < 64; o <<= 1) { tot += __shfl_xor(tot, o); bel += __shfl_xor(bel, o); }
                  __syncthreads();
                  if (F.lane == 0) { LT[F.wave] = (unsigned)tot; LT[NE + F.wave] = (unsigned)bel; }
                  __syncthreads(); }
                int base[NE]; int tstart = 0;
#pragma unroll
                for (int e = 0; e < NE; ++e) { const int c = (int)((LAS unsigned*)F.lds)[e]; base[e] = tstart * 256 + (int)((LAS unsigned*)F.lds)[NE + e]; const int nt = (c + 255) >> 8;
                    if (blockIdx.x == 0 && F.tid == 0) { for (int t = 0; t < nt; ++t) F.ctl[CW_TILEE + 1 + tstart + t] = (unsigned)e; }
                    tstart += nt; }
                if (blockIdx.x == 0 && F.tid == 0) F.ctl[CW_TILEE] = (unsigned)tstart;
                for (int m = F.gw; m < S; m += F.NGW) {
                    const v4u r0 = *(const GAS v4u*)(ROUTE + (size_t)m * 8);
                    int p1 = (int)r0.z, p2 = (int)r0.w;
#pragma unroll
                    for (int e = 0; e < NE; ++e) { if ((int)r0.x == e) p1 += base[e]; if ((int)r0.y == e) p2 += base[e]; }
                    if (F.lane == 0) { ROUTE[(size_t)m * 8 + 6] = (unsigned)p1; ROUTE[(size_t)m * 8 + 7] = (unsigned)p2; }
                    const unsigned char* srow = (const unsigned char*)XN8 + (size_t)m * D * EBM; unsigned char* xp = (unsigned char*)XP;
                    const GAS v4u* src = (const GAS v4u*)srow + F.lane; GAS v4u* d1 = (GAS v4u*)(xp + (size_t)p1 * D * EBM) + F.lane; GAS v4u* d2 = (GAS v4u*)(xp + (size_t)p2 * D * EBM) + F.lane;
#pragma unroll
                    for (int j = 0; j < 2 * EBM; ++j) { const v4u t = src[64 * j]; d1[64 * j] = t; d2[64 * j] = t; }
                }
            }
            if (BOTH(pb + 7) && l == 1) GRID_BAR();
        }
        if (PEN(9) && IN(pb + 8)) { PHASE_BEGIN(); TSTAMP_AT(pb + 8);
            if (l == 0) { pg8::Gemm g{XN8, WGU, D * EBD, D * EBD, D * EBD / 128}; pg8::StaticOrder So; So.init(S, 2 * DFF, F.G, (int)blockIdx.x);
                FfnEpi1<F8D> E = Epi1Maker<F8D>::make(ACT, DFF);
                pg8::gemm_phase<FfnEpi1<F8D>, pg8::StaticOrder, true, SP2V, F8D>(F.lds, g, So, E);
                if (FILLMASK & 8) FILL(pb + 8); }
            else { const int ntile = (int)__hip_atomic_load(F.ctl + CW_TILEE, RLX_AGENT);
                pg8::Gemm g{XP, MGU, D * EBM, D * EBM, D * EBM / 128}; pg8::MoeOrder So{F.G, (int)blockIdx.x, 2 * DFE / 256, ntile, 2 * DFE, (const int*)(F.ctl + CW_TILEE + 1)};
                FfnEpi1<F8M> E = Epi1Maker<F8M>::make(ACTP, DFE);
                pg8::gemm_phase<FfnEpi1<F8M>, pg8::MoeOrder, true, SP2V, F8M>(F.lds, g, So, E); }
            if (BOTH(pb + 8)) GRID_BAR();
        }
        if (PEN(10) && IN(pb + 9)) { PHASE_BEGIN(); TSTAMP_AT(pb + 9);
            if (l == 0) { pg8::Gemm g{ACT, WDN, DFF * EBD, DFF * EBD, DFF * EBD / 128}; pg8::StaticOrder So; So.init(S, D, F.G, (int)blockIdx.x);
                pg8::EpiResF32 E{XA, args.rep ? YPREF : XA, D, Sc<F8D>::dn};
                pg8::gemm_phase<pg8::EpiResF32, pg8::StaticOrder, true, SP2V, F8D>(F.lds, g, So, E); }
            else { const int ntile = (int)__hip_atomic_load(F.ctl + CW_TILEE, RLX_AGENT);
                const int pm0 = MOE_TAIL ? ((2 * F.G / 8) < ntile ? (2 * F.G / 8) : ntile) : ntile;
                { pg8::Gemm g{ACTP, MDN, DFE * EBM, DFE * EBM, DFE * EBM / 128}; pg8::MoeOrder So{F.G, (int)blockIdx.x, D / 256, pm0, D, (const int*)(F.ctl + CW_TILEE + 1)};
                  pg8::EpiBf16 E{OUTP, D, Sc<F8M>::dn};
                  pg8::gemm_phase<pg8::EpiBf16, pg8::MoeOrder, true, SP2V, F8M>(F.lds, g, So, E); }
                if (MOE_TAIL && ntile > pm0) { pg8::Gemm g{ACTP, MDN, DFE * EBM, DFE * EBM, DFE * EBM / 512}; pg8::MoeTailOrder So{F.G, (int)blockIdx.x, pm0, ntile - pm0, D, DFE * EBM / 4, (const int*)(F.ctl + CW_TILEE + 1)};
                  pg8::EpiBf16Split E{OUTQ, D, Sc<F8M>::dn, pm0, (size_t)2048 * D};
                  pg8::gemm_phase<pg8::EpiBf16Split, pg8::MoeTailOrder, true, SP2V, F8M>(F.lds, g, So, E); } }
            if (BOTH(pb + 9)) GRID_BAR();
        }
        if (PEN(11) && IN(pb + 10)) { PHASE_BEGIN(); TSTAMP_AT(pb + 10);
            if (l == 0) { for (int m = F.gw; m < S; m += F.NGW) rms_row_to_bf16(XA + (size_t)m * D, args.in[4] + D, XN + (size_t)m * D, F.lane); }
            else {
                const float* gfin = args.in[22];
                const int ntile_f = (int)__hip_atomic_load(F.ctl + CW_TILEE, RLX_AGENT); const int prow0 = (MOE_TAIL ? ((2 * F.G / 8) < ntile_f ? (2 * F.G / 8) : ntile_f) : ntile_f) * 256;
                for (int m = F.gw; m < S; m += F.NGW) {
                    const v4u r1 = *(const GAS v4u*)(ROUTE + (size_t)m * 8 + 4);
                    const float g1 = __uint_as_float(r1.x), g2 = __uint_as_float(r1.y); const int p1 = (int)r1.z, p2 = (int)r1.w;
                    const GAS f32x4* xr = (const GAS f32x4*)(XA + (size_t)m * D) + F.lane;
                    const GAS v2u* o1 = (const GAS v2u*)(OUTP + (size_t)p1 * D) + F.lane; const GAS v2u* o2 = (const GAS v2u*)(OUTP + (size_t)p2 * D) + F.lane;
                    const bool t1 = p1 >= prow0, t2 = p2 >= prow0;
                    const GAS v2u* q1 = (const GAS v2u*)(OUTQ + (size_t)(t1 ? p1 - prow0 : 0) * D) + F.lane; const GAS v2u* q2 = (const GAS v2u*)(OUTQ + (size_t)(t2 ? p2 - prow0 : 0) * D) + F.lane;
                    f32x4 v[8]; float s = 0.f;
                    if (!t1 && !t2) {
#pragma unroll
                        for (int j = 0; j < 8; ++j) { const f32x4 xv = xr[64 * j]; const v2u a = o1[64 * j], b = o2[64 * j];
                            v[j] = xv + (f32x4){bflo(a.x), bfhi(a.x), bflo(a.y), bfhi(a.y)} * g1 + (f32x4){bflo(b.x), bfhi(b.x), bflo(b.y), bfhi(b.y)} * g2;
                            s += (v[j].x * v[j].x + v[j].y * v[j].y) + (v[j].z * v[j].z + v[j].w * v[j].w); }
                    } else
#pragma unroll
                    for (int j = 0; j < 8; ++j) { const f32x4 xv = xr[64 * j]; f32x4 ea, eb;
                        if (!t1) { const v2u a = o1[64 * j]; ea = (f32x4){bflo(a.x), bfhi(a.x), bflo(a.y), bfhi(a.y)}; }
                        else { ea = (f32x4){0.f, 0.f, 0.f, 0.f};
#pragma unroll
                            for (int k = 0; k < 4; ++k) { const v2u a = q1[(size_t)k * (2048 * D / 4) + 64 * j]; ea += (f32x4){bflo(a.x), bfhi(a.x), bflo(a.y), bfhi(a.y)}; } }
                        if (!t2) { const v2u b = o2[64 * j]; eb = (f32x4){bflo(b.x), bfhi(b.x), bflo(b.y), bfhi(b.y)}; }
                        else { eb = (f32x4){0.f, 0.f, 0.f, 0.f};
#pragma unroll
                            for (int k = 0; k < 4; ++k) { const v2u b = q2[(size_t)k * (2048 * D / 4) + 64 * j]; eb += (f32x4){bflo(b.x), bfhi(b.x), bflo(b.y), bfhi(b.y)}; } }
                        v[j] = xv + ea * g1 + eb * g2;
                        s += (v[j].x * v[j].x + v[j].y * v[j].y) + (v[j].z * v[j].z + v[j].w * v[j].w); }
                    const float rstd = 1.f / sqrtf(wave_sum(s) * (1.f / D) + EPS);
                    GAS f32x4* orow = (GAS f32x4*)(args.out + (size_t)m * D) + F.lane; const GAS f32x4* gr = (const GAS f32x4*)gfin + F.lane;
#pragma unroll
                    for (int j = 0; j < 8; ++j) { const f32x4 gg = gr[64 * j]; orow[64 * j] = (f32x4){v[j].x * rstd * gg.x, v[j].y * rstd * gg.y, v[j].z * rstd * gg.z, v[j].w * rstd * gg.w}; }
                }
            }
            if (BOTH(pb + 10) && l == 0) GRID_BAR();
        }
    }
#if defined(PROBE_BARS)
    for (int i_ = 0; i_ < PROBE_BARS; ++i_) xcd_barrier<PROBE_BARMODE>(bar);
#endif
#if defined(PROBE_T)
    if (blockIdx.x == 0 && threadIdx.x == 0) { const unsigned t_end = (unsigned)__builtin_amdgcn_s_memrealtime(); volatile LAS unsigned* ts_ = (volatile LAS unsigned*)(F.lds + 131520); ts_[N_PHASES] = t_end;
#if defined(PROBE_CLK)
        ts_[32 + N_PHASES] = (unsigned)__builtin_amdgcn_s_memtime(); const unsigned dt = (ts_[32 + PROBE_T + 1] - ts_[32 + PROBE_T]) / (16u * PROBE_TK);
#else
        const unsigned dt = ts_[PROBE_T + 1] - ts_[PROBE_T];
#endif
        while ((unsigned)__builtin_amdgcn_s_memrealtime() - t_end < (unsigned)PROBE_TK * dt) __builtin_amdgcn_s_sleep(32); }
#endif
#undef IN
#undef BOTH
#undef GRID_BAR
#undef WIN
#undef WUP
#undef WMEM
#undef WOUT
#undef WGU
#undef WDN
#undef MGU
#undef MDN
#undef XN
#undef MEMN
#undef MEMKV
#undef PROJ
#undef AQKV
#undef KROPE
#undef ROPECS
#undef QKVM
#undef YPRE
#undef YPREF
#undef DILO
#undef DILS
#undef Y
#undef XA
#undef ROUTE
#undef XP
#undef OUTP
#undef OUTQ
#undef ACTP
#undef ACT
#undef x_in
#undef XN8
#undef PHASE_BEGIN
#undef args
#undef FILL
}

extern "C" void kernel_launch(void* const* d_in, const int* in_sizes, int n_in, void* d_out, int out_size, void* d_ws, size_t ws_size, hipStream_t stream) {
    static int grid = 0;
    if (grid == 0) {
        if (n_in != 23 || in_sizes[0] != S * D || out_size != S * D || ws_size < WS_END) { fprintf(stderr, "kernel_launch: shape/workspace mismatch: n_in %d in0 %d out %d ws %zu (need %zu)\n", n_in, n_in > 0 ? in_sizes[0] : -1, out_size, ws_size, (size_t)WS_END); grid = -1; return; }
        int dev = 0, cus = 0, per_cu = 0;
        if (hipGetDevice(&dev) != hipSuccess || hipDeviceGetAttribute(&cus, hipDeviceAttributeMultiprocessorCount, dev) != hipSuccess) { fprintf(stderr, "kernel_launch: device query failed\n"); grid = -1; return; }
        if (hipFuncSetAttribute((const void*)mk_fwd, hipFuncAttributeMaxDynamicSharedMemorySize, LDS_BYTES) != hipSuccess) { fprintf(stderr, "kernel_launch: hipFuncSetAttribute failed\n"); grid = -1; return; }
        if (hipOccupancyMaxActiveBlocksPerMultiprocessor(&per_cu, (const void*)mk_fwd, NWAVES * 64, LDS_BYTES) != hipSuccess || per_cu < 1) { fprintf(stderr, "kernel_launch: occupancy query reports %d workgroups per CU\n", per_cu); }
        (void)hipGetLastError();
        grid = cus;
    }
    if (grid < 0) return;
    (void)hipMemsetAsync((char*)d_ws + WS_CTL, 0, CTL_ZERO_BYTES, stream);
    Args a{};
    for (int i = 0; i < 23; ++i) a.in[i] = (const float*)d_in[i];
    a.out = (float*)d_out; a.ws = (unsigned char*)d_ws;
    for (int i = 0; i < 32; ++i) a.invf[i] = 1.0f / powf(10000.0f, (float)i / 32.0f);
    int lo[8], hi[8], rp[8], nl = 0;
#if defined(PROBE_PHASE) && PROBE_PHASE >= 0
    lo[nl] = 0; hi[nl] = PROBE_PHASE + 1; rp[nl++] = 0;
    for (int r = 0; r < PROBE_REPS; ++r) { lo[nl] = PROBE_PHASE; hi[nl] = PROBE_PHASE + 1; rp[nl++] = 1; }
    if (PROBE_PHASE + 1 < N_PHASES) { lo[nl] = PROBE_PHASE + 1; hi[nl] = N_PHASES; rp[nl++] = 0; }
#else
    if (N_LAUNCHES == N_PHASES) { nl = 0; } else { lo[0] = 0; hi[0] = N_PHASES; rp[0] = 0; nl = 1; }
#endif
    const int total = (N_LAUNCHES == N_PHASES) ? N_PHASES : nl;
    for (int li = 0; li < total; ++li) {
        if (N_LAUNCHES == N_PHASES) { a.ph_lo = li; a.ph_hi = li + 1; a.li = 0; a.rep = 0; } else { a.ph_lo = lo[li]; a.ph_hi = hi[li]; a.li = li; a.rep = rp[li]; }
        hipLaunchKernelGGL(mk_fwd, dim3(grid), dim3(NWAVES * 64), LDS_BYTES, stream, a);
        const hipError_t le = hipPeekAtLastError();
        if (le != hipSuccess) { fprintf(stderr, "kernel_launch: launch %d failed: %s\n", li, hipGetErrorName(le)); break; }
    }
}
```

```cpp
#include <hip/hip_runtime.h>
#include <cstdio>
#include <cstdint>
#include <cmath>
#include <type_traits>
#ifndef MK_N_LAUNCHES
#define MK_N_LAUNCHES 1
#endif
#define REPEAT_PHASE -1
#define FFN_FP8 3
#define PROBE_PHASE -1
#define PROBE_REPS 3
#define FILLMASK 13
#define MLA_DMA 0
#define PROBE_ATT 7
#define GEMM_SP2 1
#define MLA_XCD_STATIC 1
#define FOLD_PRE 1
#define UP_EXACT 1
#define BAR_FLAGS 2
#define PRE_ROWS 4
#define COMB_ROWS 2
#define CVT_CHUNK 32
#define CONV_WGS 1
#define NCV_G 28
#define NCV_U 64
#define NCV_T 64
#define NCV_A 48
#define XA_BF16 0
#define ATT_OBF16 1
#define MOE_TAIL 1
#define CVT_REG 0
#define CVT_BYTE_T 1
#define CVT_FIRST 1
#define CVT_Q0 8
namespace pg8 {
#define PG8_LAS __attribute__((address_space(3)))
typedef unsigned short bf16_t;
typedef short bf16x8 __attribute__((ext_vector_type(8)));
typedef float f32x4 __attribute__((ext_vector_type(4)));
typedef unsigned u32x4 __attribute__((ext_vector_type(4)));
constexpr int BM = 256, BK = 64, HALF = 128, HTB = HALF * BK * 2  , STAGE_BYTES = 8 * HTB, NXCD = 8, WGM = 8;

__host__ __device__ __forceinline__ int lds_byte(int r, int c) { const int st = (r >> 4) * 2 + (c >> 5), rr = r & 15, cc = c & 31, ob = rr * 64 + cc * 2; return st * 1024 + (ob ^ (((ob >> 9) & 1) << 5)); }
__host__ __device__ __forceinline__ void stage_rc(int b, int& R, int& C) { const int st = b / 1024, sb = b % 1024, swz = sb ^ (((sb >> 9) & 1) << 5); R = (st >> 1) * 16 + swz / 64; C = (st & 1) * 32 + (swz % 64) / 2; }
__host__ __device__ __forceinline__ int perm32(int rho) { const int n = rho >> 4, i = rho & 15; return 8 * (i >> 2) + 4 * n + (i & 3); }

struct Unit { int pm, pn, ui; };
struct Gemm { const void* A; const void* Bt; int lda, ldb, nt; };

struct StaticOrder {
    int nM, nN, nwg, G, c;
    __device__ void init(int M, int N, int G_, int c_) { nM = M / BM; nN = N / BM; nwg = nM * nN; G = G_; c = c_; }
    __device__ bool next(int i, Unit& u) const {
        const long L = (long)i * G + c; if (L >= nwg) return false;
        int wgid = (int)L; { const int q = nwg / NXCD, r = nwg % NXCD, xcd = wgid % NXCD, off = wgid / NXCD; wgid = (xcd < r ? xcd * (q + 1) : r * (q + 1) + (xcd - r) * q) + off; }
        const int nig = WGM * nN, gid = wgid / nig, fm = gid * WGM, gsz = (nM - fm) < WGM ? (nM - fm) : WGM;
        u.pm = fm + ((wgid % nig) % gsz); u.pn = (wgid % nig) / gsz; return true;
    }
    __device__ __forceinline__ const char* abase(const Gemm& g, const Unit& u) const { return (const char*)g.A + (size_t)u.pm * BM * g.lda; }
    __device__ __forceinline__ const char* bbase(const Gemm& g, const Unit& u) const { return (const char*)g.Bt + (size_t)u.pn * BM * g.ldb; }
    __device__ __forceinline__ int unit_nt(const Gemm& g, const Unit&) const { return g.nt; }
};
struct InProjOrder {
    StaticOrder so; int nextra; const void* A2; const void* B2;
    __device__ bool next(int i, Unit& u) const { if (so.next(i, u)) return true; const long L = (long)i * so.G + so.c - so.nwg; if (L < 0 || L >= nextra) return false; u.pm = 32 + (int)(L >> 2); u.pn = (int)(L & 3); return true; }
    __device__ __forceinline__ const char* abase(const Gemm& g, const Unit& u) const { return u.pm < 32 ? (const char*)g.A + (size_t)u.pm * BM * g.lda : (const char*)A2 + (size_t)(u.pm - 32) * BM * g.lda; }
    __device__ __forceinline__ const char* bbase(const Gemm& g, const Unit& u) const { return u.pm < 32 ? (const char*)g.Bt + (size_t)u.pn * BM * g.ldb : (const char*)B2 + (size_t)((u.pm - 32) * 1024 + u.pn * BM) * g.ldb; }
    __device__ __forceinline__ int unit_nt(const Gemm& g, const Unit&) const { return g.nt; }
};
struct MemOrder {
    int G, c;
    __device__ bool next(int i, Unit& u) const { const int L = c - (G - 8); if (i != 0 || L < 0 || L >= 8) return false; u.pm = L >> 2; u.pn = L & 3; return true; }
    __device__ __forceinline__ const char* abase(const Gemm& g, const Unit& u) const { return (const char*)g.A + (size_t)u.pm * BM * g.lda; }
    __device__ __forceinline__ const char* bbase(const Gemm& g, const Unit& u) const { return (const char*)g.Bt + (size_t)(u.pm * 1024 + u.pn * BM) * g.ldb; }
    __device__ __forceinline__ int unit_nt(const Gemm& g, const Unit&) const { return g.nt; }
};
struct MoeOrder {
    int G, c, nN, ntile, nexp_rows; const int* tile_e;
    __device__ bool next(int i, Unit& u) const { const long L = (long)i * G + c; if (L >= (long)ntile * nN) return false; u.pm = (int)(L / nN); u.pn = (int)(L % nN); return true; }
    __device__ __forceinline__ const char* abase(const Gemm& g, const Unit& u) const { return (const char*)g.A + (size_t)u.pm * BM * g.lda; }
    __device__ __forceinline__ const char* bbase(const Gemm& g, const Unit& u) const { const int e = __builtin_amdgcn_readfirstlane(tile_e[u.pm]); return (const char*)g.Bt + ((size_t)e * nexp_rows + (size_t)u.pn * BM) * g.ldb; }
    __device__ __forceinline__ int unit_nt(const Gemm& g, const Unit&) const { return g.nt; }
};

struct MoeTailOrder {
    int G, c, pm0, ntail, nexp_rows, kq_bytes; const int* tile_e;
    __device__ bool next(int i, Unit& u) const { const long L = (long)i * G + c; if (L >= (long)ntail * 32) return false; const int ks = (int)(L & 3), rest = (int)(L >> 2); u.pm = pm0 + (rest >> 3); u.pn = (rest & 7) + 8 * ks; return true; }
    __device__ __forceinline__ const char* abase(const Gemm& g, const Unit& u) const { return (const char*)g.A + (size_t)u.pm * BM * g.lda + (size_t)(u.pn >> 3) * kq_bytes; }
    __device__ __forceinline__ const char* bbase(const Gemm& g, const Unit& u) const { const int e = __builtin_amdgcn_readfirstlane(tile_e[u.pm]); return (const char*)g.Bt + ((size_t)e * nexp_rows + (size_t)(u.pn & 7) * BM) * g.ldb + (size_t)(u.pn >> 3) * kq_bytes; }
    __device__ __forceinline__ int unit_nt(const Gemm& g, const Unit&) const { return g.nt; }
};

struct UpProjOrder {
    int G, c;
    __device__ bool next(int i, Unit& u) const { const int L = i * G + c; if (L >= 352) return false;
        int nA = 352 - G; nA = nA < 0 ? 0 : (nA > 192 ? 192 : nA);
        if (L >= nA && L < nA + 160) { const int j = L - nA; u.pm = j & 31; u.pn = j >> 5; }
        else { const int j = L < nA ? L : L - 160; u.pm = j & 31; u.pn = 5 + (j >> 5); }
        return true; }
    __device__ __forceinline__ const char* abase(const Gemm& g, const Unit& u) const { return (const char*)g.A + (size_t)u.pm * BM * g.lda + (u.pn >= 5 ? 768 : 0); }
    __device__ __forceinline__ const char* bbase(const Gemm& g, const Unit& u) const { return (const char*)g.Bt + (size_t)u.pn * BM * g.ldb + (u.pn >= 5 ? 768 : 0); }
    __device__ __forceinline__ int unit_nt(const Gemm&, const Unit& u) const { return u.pn >= 5 ? 2 : 6; }
};

__device__ __forceinline__ unsigned cvt_pk_bf16(float lo, float hi) { unsigned r; asm volatile("v_cvt_pk_bf16_f32 %0, %1, %2" : "=v"(r) : "v"(lo), "v"(hi)); return r; }

struct EpiBf16 {
    static constexpr bool PERM = true;
    bf16_t* O; int ldc; float sc;
    __device__ __forceinline__ void operator()(const f32x4 (&acc)[2][2][4][2], const Unit& u, int wr, int wc, int fr, int fq) const {
        const int row0 = u.pm * BM + wr * 64 + fr, col0 = u.pn * BM + wc * 32 + 8 * fq;
#pragma unroll
        for (int ai = 0; ai < 2; ++ai)
#pragma unroll
            for (int m = 0; m < 4; ++m) { bf16_t* rowp = O + (size_t)(row0 + ai * HALF + m * 16) * ldc + col0;
#pragma unroll
                for (int bj = 0; bj < 2; ++bj) { const f32x4 v0 = acc[ai][bj][m][0] * sc, v1 = acc[ai][bj][m][1] * sc;
                    u32x4 w; w.x = cvt_pk_bf16(v0[0], v0[1]); w.y = cvt_pk_bf16(v0[2], v0[3]); w.z = cvt_pk_bf16(v1[0], v1[1]); w.w = cvt_pk_bf16(v1[2], v1[3]);
                    *(u32x4*)(rowp + bj * HALF) = w; } }
    }
};
struct EpiBf16R {
    static constexpr bool PERM = true;
    bf16_t* O; int ldc; const PG8_LAS float* RS;
    __device__ __forceinline__ void operator()(const f32x4 (&acc)[2][2][4][2], const Unit& u, int wr, int wc, int fr, int fq) const {
        const int row0 = u.pm * BM + wr * 64 + fr, col0 = u.pn * BM + wc * 32 + 8 * fq;
        const PG8_LAS float* rs = RS + u.ui * BM + wr * 64 + fr;
#pragma unroll
        for (int ai = 0; ai < 2; ++ai)
#pragma unroll
            for (int m = 0; m < 4; ++m) { bf16_t* rowp = O + (size_t)(row0 + ai * HALF + m * 16) * ldc + col0; const float sc = rs[ai * HALF + m * 16];
#pragma unroll
                for (int bj = 0; bj < 2; ++bj) { const f32x4 v0 = acc[ai][bj][m][0] * sc, v1 = acc[ai][bj][m][1] * sc;
                    u32x4 w; w.x = cvt_pk_bf16(v0[0], v0[1]); w.y = cvt_pk_bf16(v0[2], v0[3]); w.z = cvt_pk_bf16(v1[0], v1[1]); w.w = cvt_pk_bf16(v1[2], v1[3]);
                    *(u32x4*)(rowp + bj * HALF) = w; } }
    }
};
struct EpiBf16Split {
    static constexpr bool PERM = true;
    bf16_t* O; int ldc; float sc; int pm0; size_t qstride;
    __device__ __forceinline__ void operator()(const f32x4 (&acc)[2][2][4][2], const Unit& u, int wr, int wc, int fr, int fq) const {
        const int row0 = (u.pm - pm0) * BM + wr * 64 + fr, col0 = (u.pn & 7) * BM + wc * 32 + 8 * fq; bf16_t* base = O + (size_t)(u.pn >> 3) * qstride;
#pragma unroll
        for (int ai = 0; ai < 2; ++ai)
#pragma unroll
            for (int m = 0; m < 4; ++m) { bf16_t* rowp = base + (size_t)(row0 + ai * HALF + m * 16) * ldc + col0;
#pragma unroll
                for (int bj = 0; bj < 2; ++bj) { const f32x4 v0 = acc[ai][bj][m][0] * sc, v1 = acc[ai][bj][m][1] * sc;
                    u32x4 w; w.x = cvt_pk_bf16(v0[0], v0[1]); w.y = cvt_pk_bf16(v0[2], v0[3]); w.z = cvt_pk_bf16(v1[0], v1[1]); w.w = cvt_pk_bf16(v1[2], v1[3]);
                    *(u32x4*)(rowp + bj * HALF) = w; } }
    }
};
struct EpiBf16Sel {
    static constexpr bool PERM = true;
    bf16_t* O; int ldc; bf16_t* O2; int ldc2;
    __device__ __forceinline__ void operator()(const f32x4 (&acc)[2][2][4][2], const Unit& u, int wr, int wc, int fr, int fq) const {
        const bool ex = u.pm >= 32; bf16_t* base = ex ? O2 : O; const int ld = ex ? ldc2 : ldc;
        const int row0 = (ex ? u.pm - 32 : u.pm) * BM + wr * 64 + fr, col0 = u.pn * BM + wc * 32 + 8 * fq;
#pragma unroll
        for (int ai = 0; ai < 2; ++ai)
#pragma unroll
            for (int m = 0; m < 4; ++m) { bf16_t* rowp = base + (size_t)(row0 + ai * HALF + m * 16) * ld + col0;
#pragma unroll
                for (int bj = 0; bj < 2; ++bj) { const f32x4 v0 = acc[ai][bj][m][0], v1 = acc[ai][bj][m][1];
                    u32x4 w; w.x = cvt_pk_bf16(v0[0], v0[1]); w.y = cvt_pk_bf16(v0[2], v0[3]); w.z = cvt_pk_bf16(v1[0], v1[1]); w.w = cvt_pk_bf16(v1[2], v1[3]);
                    *(u32x4*)(rowp + bj * HALF) = w; } }
    }
};
struct EpiResF32 {
    static constexpr bool PERM = false;
    const float* R; float* C; int ldc; float sc;
    __device__ __forceinline__ void operator()(const f32x4 (&acc)[2][2][4][2], const Unit& u, int wr, int wc, int fr, int fq) const {
        const int row0 = u.pm * BM + wr * 64 + fr, col0 = u.pn * BM + wc * 32 + 4 * fq;
#pragma unroll
        for (int ai = 0; ai < 2; ++ai)
#pragma unroll
            for (int m = 0; m < 4; ++m) { const size_t off = (size_t)(row0 + ai * HALF + m * 16) * ldc + col0;
#pragma unroll
                for (int bj = 0; bj < 2; ++bj)
#pragma unroll
                    for (int n = 0; n < 2; ++n) { const f32x4 r = *(const f32x4*)(R + off + bj * HALF + n * 16); *(f32x4*)(C + off + bj * HALF + n * 16) = r + acc[ai][bj][m][n] * sc; } }
    }
};
__device__ __forceinline__ float silu_mul(float g, float u) { return g * u * __builtin_amdgcn_rcpf(1.0f + __builtin_amdgcn_exp2f(-1.4426950408889634f * g)); }
struct EpiSwiGLU {
    static constexpr bool PERM = true;
    bf16_t* O; int ldc;
    __device__ __forceinline__ void operator()(const f32x4 (&acc)[2][2][4][2], const Unit& u, int wr, int wc, int fr, int fq) const {
        const int row0 = u.pm * BM + wr * 64 + fr, col0 = u.pn * HALF + wc * 32 + 8 * fq;
#pragma unroll
        for (int ai = 0; ai < 2; ++ai)
#pragma unroll
            for (int m = 0; m < 4; ++m) { bf16_t* rowp = O + (size_t)(row0 + ai * HALF + m * 16) * ldc + col0;
                const f32x4 g0 = acc[ai][0][m][0], g1 = acc[ai][0][m][1], u0 = acc[ai][1][m][0], u1 = acc[ai][1][m][1];
                u32x4 w; w.x = cvt_pk_bf16(silu_mul(g0[0], u0[0]), silu_mul(g0[1], u0[1])); w.y = cvt_pk_bf16(silu_mul(g0[2], u0[2]), silu_mul(g0[3], u0[3]));
                w.z = cvt_pk_bf16(silu_mul(g1[0], u1[0]), silu_mul(g1[1], u1[1])); w.w = cvt_pk_bf16(silu_mul(g1[2], u1[2]), silu_mul(g1[3], u1[3]));
                *(u32x4*)rowp = w; }
    }
};

typedef int v8i_t __attribute__((ext_vector_type(8)));
__device__ __forceinline__ v8i_t pg8_cat(bf16x8 lo, bf16x8 hi) { typedef int v4i_t __attribute__((ext_vector_type(4))); const v4i_t a = __builtin_bit_cast(v4i_t, lo), b = __builtin_bit_cast(v4i_t, hi); return (v8i_t){a.x, a.y, a.z, a.w, b.x, b.y, b.z, b.w}; }
struct EpiSwiGLU8 {
    static constexpr bool PERM = true;
    unsigned char* O; int ldc; float sc_in, sc_out;
    __device__ __forceinline__ void operator()(const f32x4 (&acc)[2][2][4][2], const Unit& u, int wr, int wc, int fr, int fq) const {
        const int row0 = u.pm * BM + wr * 64 + fr, col0 = u.pn * HALF + wc * 32 + 8 * fq;
#pragma unroll
        for (int ai = 0; ai < 2; ++ai)
#pragma unroll
            for (int m = 0; m < 4; ++m) { unsigned char* rowp = O + (size_t)(row0 + ai * HALF + m * 16) * ldc + col0;
                const f32x4 g0 = acc[ai][0][m][0] * sc_in, g1 = acc[ai][0][m][1] * sc_in, u0 = acc[ai][1][m][0] * (sc_in * sc_out), u1 = acc[ai][1][m][1] * (sc_in * sc_out);
                int w0 = 0, w1 = 0;
                w0 = __builtin_amdgcn_cvt_pk_fp8_f32(silu_mul(g0[0], u0[0]), silu_mul(g0[1], u0[1]), w0, false); w0 = __builtin_amdgcn_cvt_pk_fp8_f32(silu_mul(g0[2], u0[2]), silu_mul(g0[3], u0[3]), w0, true);
                w1 = __builtin_amdgcn_cvt_pk_fp8_f32(silu_mul(g1[0], u1[0]), silu_mul(g1[1], u1[1]), w1, false); w1 = __builtin_amdgcn_cvt_pk_fp8_f32(silu_mul(g1[2], u1[2]), silu_mul(g1[3], u1[3]), w1, true);
                typedef int v2i_t __attribute__((ext_vector_type(2))); *(v2i_t*)rowp = (v2i_t){w0, w1}; }
    }
};
__device__ __forceinline__ void pg8_mfma8(f32x4& c, v8i_t a, v8i_t b, int sc) { asm volatile("v_mfma_scale_f32_16x16x128_f8f6f4 %0, %1, %2, %0, %3, %3 op_sel_hi:[0,0,0]" : "+v"(c) : "v"(a), "v"(b), "v"(sc)); }
template <class Epi, class Sched, bool ALIGN_EPI = false, bool SP2 = false, bool FP8 = false>
__device__ __forceinline__ void gemm_phase(PG8_LAS unsigned char* lds, const Gemm g, const Sched& S, const Epi& E) {
    int tid_ = threadIdx.x; asm volatile("" : "+v"(tid_));
    const int tid = tid_, wid = __builtin_amdgcn_readfirstlane(tid >> 6), lane = tid & 63, wr = wid >> 2, wc = wid & 3, fr = lane & 15, fq = lane >> 4;
    unsigned voffA[2], voffB[2];
#pragma unroll
    for (int i = 0; i < 2; ++i) { int R, C; stage_rc(tid * 16 + i * 8192, R, C); const int Rb = Epi::PERM ? ((R & ~31) + perm32(R & 31)) : R;
        voffA[i] = (unsigned)(R * g.lda + C * 2); voffB[i] = (unsigned)(Rb * g.ldb + C * 2); }
    const size_t kstep = (size_t)(BK * 2);
    const size_t hstepA = (size_t)HALF * g.lda, hstepB = (size_t)HALF * g.ldb;
    const unsigned ldsw = (unsigned)wid * 1024u;
    const int aoff = lds_byte(wr * 64 + fr, fq * 8), boff = lds_byte(wc * 32 + fr, fq * 8);
#define PG8_SA(b, h) (((b) * 2 + (h)) * HTB)
#define PG8_SB(b, h) ((4 + (b) * 2 + (h)) * HTB)
#define PG8_STAGE(bufoff, gbase, voff) do { _Pragma("unroll") for (int _i = 0; _i < 2; ++_i) \
        __builtin_amdgcn_global_load_lds((const unsigned*)((const char*)(gbase) + (voff)[_i]), (PG8_LAS unsigned*)(lds + (bufoff) + ldsw + _i * 8192), 16, 0, 0); } while (0)
#define PG8_LDA(dst, b, h) do { _Pragma("unroll") for (int m = 0; m < 4; ++m) _Pragma("unroll") for (int k = 0; k < 2; ++k) dst[m][k] = *(const PG8_LAS bf16x8*)(lds + PG8_SA(b, h) + aoff + m * 2048 + k * 1024); } while (0)
#define PG8_LDB(dst, b, h) do { _Pragma("unroll") for (int n = 0; n < 2; ++n) _Pragma("unroll") for (int k = 0; k < 2; ++k) dst[n][k] = *(const PG8_LAS bf16x8*)(lds + PG8_SB(b, h) + boff + n * 2048 + k * 1024); } while (0)
#define PG8_MMA(ai, bj, At, Bt) do { __builtin_amdgcn_s_setprio(1); if constexpr (FP8) { _Pragma("unroll") for (int m = 0; m < 4; ++m) _Pragma("unroll") for (int n = 0; n < 2; ++n) \
        pg8_mfma8(acc[ai][bj][m][n], pg8_cat(Bt[n][0], Bt[n][1]), pg8_cat(At[m][0], At[m][1]), sc8); } else { \
        _Pragma("unroll") for (int m = 0; m < 4; ++m) _Pragma("unroll") for (int n = 0; n < 2; ++n) _Pragma("unroll") for (int k = 0; k < 2; ++k) \
        acc[ai][bj][m][n] = __builtin_amdgcn_mfma_f32_16x16x32_bf16(Bt[n][k], At[m][k], acc[ai][bj][m][n], 0, 0, 0); } __builtin_amdgcn_s_setprio(0); } while (0)
#define PG8_WAIT_V(n) asm volatile("s_waitcnt vmcnt(" #n ")" ::: "memory")
#define PG8_WAIT_L(n) asm volatile("s_waitcnt lgkmcnt(" #n ")" ::: "memory")
#define PG8_BAR __builtin_amdgcn_s_barrier()
#define PG8_SCHED __builtin_amdgcn_sched_barrier(0)
    Unit cur, nxt; int ui = 0;
    if (!S.next(0, cur)) return;
    cur.ui = 0;
    int sc8 = 0x7F7F7F7F; asm volatile("" : "+v"(sc8));
    f32x4 acc[2][2][4][2];
#pragma unroll
    for (int a = 0; a < 2; ++a)
#pragma unroll
        for (int b = 0; b < 2; ++b)
#pragma unroll
            for (int m = 0; m < 4; ++m)
#pragma unroll
                for (int n = 0; n < 2; ++n) acc[a][b][m][n] = (f32x4){0.f, 0.f, 0.f, 0.f};
    bf16x8 At[4][2], B0[2][2], B1[2][2];
    const char* cA = S.abase(g, cur); const char* cB = S.bbase(g, cur);
    if constexpr (SP2) {
        PG8_STAGE(PG8_SB(0, 0), cB, voffB); PG8_STAGE(PG8_SB(0, 1), cB + hstepB, voffB); PG8_STAGE(PG8_SA(0, 0), cA, voffA); PG8_STAGE(PG8_SA(0, 1), cA + hstepA, voffA);
        if (wr == 1) PG8_BAR;
        PG8_WAIT_V(2); PG8_BAR;
        PG8_STAGE(PG8_SB(1, 0), cB + kstep, voffB); PG8_STAGE(PG8_SA(1, 0), cA + kstep, voffA); PG8_STAGE(PG8_SB(1, 1), cB + hstepB + kstep, voffB);
        PG8_WAIT_V(6); PG8_BAR;
    } else {
        PG8_STAGE(PG8_SB(0, 0), cB, voffB); PG8_STAGE(PG8_SA(0, 0), cA, voffA); PG8_STAGE(PG8_SB(0, 1), cB + hstepB, voffB); PG8_STAGE(PG8_SA(0, 1), cA + hstepA, voffA);
        if (wr == 1) PG8_BAR;
        PG8_WAIT_V(4); PG8_BAR;
        PG8_STAGE(PG8_SB(1, 0), cB + kstep, voffB); PG8_STAGE(PG8_SA(1, 0), cA + kstep, voffA); PG8_STAGE(PG8_SB(1, 1), cB + hstepB + kstep, voffB);
        PG8_WAIT_V(6); PG8_BAR;
    }
    for (;;) {
        const bool has_next = S.next(ui + 1, nxt); nxt.ui = ui + 1;
        const int nt = S.unit_nt(g, cur);
        const char* nA = has_next ? S.abase(g, nxt) : cA; const char* nB = has_next ? S.bbase(g, nxt) : cB;
        for (int t = 0; t < nt; t += 2) {
            const bool last = (t == nt - 2);
            const char* a1 = cA + (size_t)(t + 1) * kstep;
            const char* a2 = last ? nA : cA + (size_t)(t + 2) * kstep; const char* b2 = last ? nB : cB + (size_t)(t + 2) * kstep;
            const char* a3 = a2 + kstep; const char* b3 = b2 + kstep;
            if constexpr (SP2) {
            PG8_LDB(B0, 0, 0); PG8_LDB(B1, 0, 1); PG8_SCHED; PG8_LDA(At, 0, 0); PG8_STAGE(PG8_SA(1, 1), a1 + hstepA, voffA);
            PG8_WAIT_V(8); PG8_WAIT_L(0); PG8_BAR; PG8_MMA(0, 0, At, B0); PG8_MMA(0, 1, At, B1); PG8_BAR; PG8_SCHED;
            PG8_LDA(At, 0, 1); PG8_STAGE(PG8_SB(0, 0), b2, voffB); PG8_STAGE(PG8_SB(0, 1), b2 + hstepB, voffB); PG8_STAGE(PG8_SA(0, 0), a2, voffA);
            PG8_WAIT_V(8); PG8_WAIT_L(0); PG8_BAR; PG8_MMA(1, 0, At, B0); PG8_MMA(1, 1, At, B1); PG8_BAR; PG8_SCHED;
            PG8_LDB(B0, 1, 0); PG8_LDB(B1, 1, 1); PG8_SCHED; PG8_LDA(At, 1, 0); PG8_STAGE(PG8_SA(0, 1), a2 + hstepA, voffA);
            PG8_WAIT_V(8); PG8_WAIT_L(0); PG8_BAR; PG8_MMA(0, 0, At, B0); PG8_MMA(0, 1, At, B1); PG8_BAR; PG8_SCHED;
            PG8_LDA(At, 1, 1); PG8_STAGE(PG8_SB(1, 0), b3, voffB); PG8_STAGE(PG8_SB(1, 1), b3 + hstepB, voffB); PG8_STAGE(PG8_SA(1, 0), a3, voffA);
            PG8_WAIT_V(8); PG8_WAIT_L(0); PG8_BAR; PG8_MMA(1, 0, At, B0); PG8_MMA(1, 1, At, B1); PG8_BAR; PG8_SCHED;
            } else {
            PG8_LDB(B0, 0, 0); PG8_SCHED; PG8_LDA(At, 0, 0); PG8_STAGE(PG8_SA(1, 1), a1 + hstepA, voffA);
            PG8_WAIT_L(8); PG8_BAR; PG8_WAIT_L(0); PG8_MMA(0, 0, At, B0); PG8_BAR; PG8_SCHED;
            PG8_LDB(B1, 0, 1); PG8_STAGE(PG8_SB(0, 0), b2, voffB);
            PG8_BAR; PG8_WAIT_L(0); PG8_MMA(0, 1, At, B1); PG8_BAR;
            PG8_LDA(At, 0, 1); PG8_STAGE(PG8_SA(0, 0), a2, voffA);
            PG8_BAR; PG8_WAIT_L(0); PG8_MMA(1, 0, At, B0); PG8_BAR; PG8_SCHED;
            PG8_STAGE(PG8_SB(0, 1), b2 + hstepB, voffB);
            PG8_WAIT_V(6); PG8_BAR; PG8_MMA(1, 1, At, B1); PG8_BAR;
            PG8_LDB(B0, 1, 0); PG8_SCHED; PG8_LDA(At, 1, 0); PG8_STAGE(PG8_SA(0, 1), a2 + hstepA, voffA);
            PG8_WAIT_L(8); PG8_BAR; PG8_WAIT_L(0); PG8_MMA(0, 0, At, B0); PG8_BAR; PG8_SCHED;
            PG8_LDB(B1, 1, 1); PG8_STAGE(PG8_SB(1, 0), b3, voffB);
            PG8_BAR; PG8_WAIT_L(0); PG8_MMA(0, 1, At, B1); PG8_BAR;
            PG8_LDA(At, 1, 1); PG8_STAGE(PG8_SA(1, 0), a3, voffA);
            PG8_BAR; PG8_WAIT_L(0); PG8_MMA(1, 0, At, B0); PG8_BAR; PG8_SCHED;
            PG8_STAGE(PG8_SB(1, 1), b3 + hstepB, voffB);
            PG8_WAIT_V(6); PG8_BAR; PG8_MMA(1, 1, At, B1); PG8_BAR;
            }
        }
        if constexpr (ALIGN_EPI) { if (wr == 0) PG8_BAR; }
        if constexpr (FP8) { PG8_SCHED; asm volatile("s_nop 15\n\ts_nop 7" ::: "memory"); PG8_SCHED; }
        E(acc, cur, wr, wc, fr, fq);
        if (!has_next) break;
#pragma unroll
        for (int a = 0; a < 2; ++a)
#pragma unroll
            for (int b = 0; b < 2; ++b)
#pragma unroll
                for (int m = 0; m < 4; ++m)
#pragma unroll
                    for (int n = 0; n < 2; ++n) acc[a][b][m][n] = (f32x4){0.f, 0.f, 0.f, 0.f};
        cur = nxt; cA = nA; cB = nB; ++ui;
        if constexpr (ALIGN_EPI) { if (wr == 1) PG8_BAR; }
    }
    PG8_WAIT_V(0);
    if constexpr (!ALIGN_EPI) { if (wr == 0) PG8_BAR; }
    PG8_BAR;
#undef PG8_SA
#undef PG8_SB
#undef PG8_STAGE
#undef PG8_LDA
#undef PG8_LDB
#undef PG8_MMA
#undef PG8_WAIT_V
#undef PG8_WAIT_L
#undef PG8_BAR
#undef PG8_SCHED
}
}
namespace att {
#define ATT_LAS __attribute__((address_space(3)))
#define ATT_GAS __attribute__((address_space(1)))
typedef unsigned short bf16;
using bf16x8 = __attribute__((ext_vector_type(8))) short;
using s16x4  = __attribute__((ext_vector_type(4))) short;
using f32x16 = __attribute__((ext_vector_type(16))) float;
using f32x4  = __attribute__((ext_vector_type(4))) float;
using u32x4  = __attribute__((ext_vector_type(4))) unsigned;
constexpr int NW = 8, QBLK = 32, KVBLK = 64, DV = 128;
constexpr float LOG2E = 1.4426950408889634f;
#if defined(ATT_OBF16) && ATT_OBF16
typedef unsigned short OT;
#else
typedef float OT;
#endif
#define SBAR() __builtin_amdgcn_sched_barrier(0)
__device__ __forceinline__ int crow(int r, int hi) { return (r & 3) + 8 * (r >> 2) + 4 * hi; }
__device__ __forceinline__ unsigned cvtpk(float lo, float hi) { unsigned r; asm volatile("v_cvt_pk_bf16_f32 %0, %1, %2" : "=v"(r) : "v"(lo), "v"(hi)); return r; }
__device__ __forceinline__ float bf2f(short s) { return __uint_as_float(((unsigned)(unsigned short)s) << 16); }
__device__ __forceinline__ void st_o(float* p, float v) { *p = v; }
__device__ __forceinline__ void st_o(unsigned short* p, float v) { *p = (unsigned short)(cvtpk(v, v) & 0xffffu); }

__device__ __forceinline__ void partialSM(f32x16& p0, f32x16& p1, float& m_reg, float& mn, float& alpha, const float C, const float THRS) {
  float pmax = p0[0];
#pragma unroll
  for (int r = 1; r < 16; ++r) pmax = fmaxf(pmax, p0[r]);
#pragma unroll
  for (int r = 0; r < 16; ++r) pmax = fmaxf(pmax, p1[r]);
  { auto rr = __builtin_amdgcn_permlane32_swap(__float_as_uint(pmax), __float_as_uint(pmax), false, false);
    pmax = fmaxf(__uint_as_float(rr[0]), __uint_as_float(rr[1])); }
  if (__builtin_expect(__all(pmax - m_reg <= THRS), 1)) { mn = m_reg; alpha = 1.f; }
  else { mn = fmaxf(m_reg, pmax); alpha = __builtin_amdgcn_exp2f((m_reg - mn) * C); m_reg = mn; }
  float mnC = -mn * C;
#pragma unroll
  for (int r = 0; r < 16; ++r) p0[r] = fmaf(p0[r], C, mnC);
#pragma unroll
  for (int r = 0; r < 16; ++r) p1[r] = fmaf(p1[r], C, mnC);
#pragma unroll
  for (int r = 0; r < 16; ++r) p0[r] = __builtin_amdgcn_exp2f(p0[r]);
}
#define ATT_PK4(P, BASE, OUT) do { unsigned a0 = cvtpk(P[BASE + 0], P[BASE + 1]), a1 = cvtpk(P[BASE + 2], P[BASE + 3]);   \
    unsigned b0 = cvtpk(P[BASE + 4], P[BASE + 5]), b1 = cvtpk(P[BASE + 6], P[BASE + 7]);                              \
    auto r0 = __builtin_amdgcn_permlane32_swap(a0, b0, false, false); auto r1 = __builtin_amdgcn_permlane32_swap(a1, b1, false, false); \
    u32x4 w = {r0[0], r1[0], r0[1], r1[1]}; OUT = *reinterpret_cast<bf16x8*>(&w); } while (0)
__device__ __forceinline__ void finishSM(f32x16& p0, f32x16& p1, float alpha, float& l_reg, bf16x8& pa0, bf16x8& pa1, bf16x8& pa2, bf16x8& pa3) {
#pragma unroll
  for (int r = 0; r < 16; ++r) p1[r] = __builtin_amdgcn_exp2f(p1[r]);
  float ps = 0;
#pragma unroll
  for (int r = 0; r < 16; ++r) ps += p0[r];
#pragma unroll
  for (int r = 0; r < 16; ++r) ps += p1[r];
  { auto rr = __builtin_amdgcn_permlane32_swap(__float_as_uint(ps), __float_as_uint(ps), false, false);
    ps = __uint_as_float(rr[0]) + __uint_as_float(rr[1]); }
  l_reg = l_reg * alpha + ps;
  ATT_PK4(p0, 0, pa0); ATT_PK4(p0, 8, pa1); ATT_PK4(p1, 0, pa2); ATT_PK4(p1, 8, pa3);
}
template <int RB> __device__ __forceinline__ int kswz(int row, int colB) { return row * RB + (colB ^ ((row & 7) << 4)); }
template <int DQK> __device__ __forceinline__ void qkt(f32x16& p0, f32x16& p1, const ATT_LAS char* Ks, const bf16x8 (&qr)[DQK / 16], int r32, int hi) {
  p0 = f32x16{}; p1 = f32x16{};
#pragma unroll
  for (int d0 = 0; d0 < DQK / 16; ++d0) { const int cb = (d0 * 16 + hi * 8) * 2;
    bf16x8 b0 = *reinterpret_cast<const ATT_LAS bf16x8*>(Ks + kswz<DQK * 2>(r32, cb));
    bf16x8 b1 = *reinterpret_cast<const ATT_LAS bf16x8*>(Ks + kswz<DQK * 2>(32 + r32, cb));
    p0 = __builtin_amdgcn_mfma_f32_32x32x16_bf16(b0, qr[d0], p0, 0, 0, 0);
    p1 = __builtin_amdgcn_mfma_f32_32x32x16_bf16(b1, qr[d0], p1, 0, 0, 0); }
}
__device__ __forceinline__ void qkt192_lq(f32x16& p0, f32x16& p1, const ATT_LAS char* Ks, const bf16x8 (&qr)[8], const ATT_LAS char* Qs, int lane, int r32, int hi) {
  p0 = f32x16{}; p1 = f32x16{};
#pragma unroll
  for (int d0 = 0; d0 < 12; ++d0) { const int cb = (d0 * 16 + hi * 8) * 2;
    bf16x8 b0 = *reinterpret_cast<const ATT_LAS bf16x8*>(Ks + kswz<384>(r32, cb));
    bf16x8 b1 = *reinterpret_cast<const ATT_LAS bf16x8*>(Ks + kswz<384>(32 + r32, cb));
    const bf16x8 q = d0 < 8 ? qr[d0 < 8 ? d0 : 0] : *reinterpret_cast<const ATT_LAS bf16x8*>(Qs + ((d0 - 8) * 64 + lane) * 16);
    p0 = __builtin_amdgcn_mfma_f32_32x32x16_bf16(b0, q, p0, 0, 0, 0);
    p1 = __builtin_amdgcn_mfma_f32_32x32x16_bf16(b1, q, p1, 0, 0, 0); }
}
__device__ __forceinline__ int v_st(int k, int c) { const int kk = (k & ~0xC) | ((k & 4) << 1) | ((k & 8) >> 1); return ((kk >> 3) * 4 + (c >> 5)) * 512 + ((kk & 7) * 32 + (c & 31)) * 2; }
__device__ __forceinline__ int v_rd_base(int lane) { return ((lane & 3) << 3) | (((lane >> 2) & 3) << 6) | (((lane >> 4) & 1) << 5) | (((lane >> 5) & 1) << 8); }
constexpr int v_rd_off(int d0, int ks, int half) { return d0 * 512 + ks * 4096 + half * 2048; }
template <int OFF> __device__ __forceinline__ s16x4 tr_read(int vb) {
  s16x4 r; asm volatile("ds_read_b64_tr_b16 %0, %1 offset:%2" : "=&v"(r) : "v"(vb), "i"(OFF) : "memory"); return r;
}
#define ATT_PK(L, H) (bf16x8){L[0], L[1], L[2], L[3], H[0], H[1], H[2], H[3]}
template <int D0> __device__ __forceinline__ void pv_one(f32x16& od, int vb, bf16x8 pa0, bf16x8 pa1, bf16x8 pa2, bf16x8 pa3) {
  const s16x4 l0 = tr_read<v_rd_off(D0, 0, 0)>(vb), h0 = tr_read<v_rd_off(D0, 0, 1)>(vb), l1 = tr_read<v_rd_off(D0, 1, 0)>(vb), h1 = tr_read<v_rd_off(D0, 1, 1)>(vb);
  const s16x4 l2 = tr_read<v_rd_off(D0, 2, 0)>(vb), h2 = tr_read<v_rd_off(D0, 2, 1)>(vb), l3 = tr_read<v_rd_off(D0, 3, 0)>(vb), h3 = tr_read<v_rd_off(D0, 3, 1)>(vb);
  asm volatile("s_waitcnt lgkmcnt(0)" ::: "memory"); SBAR();
  od = __builtin_amdgcn_mfma_f32_32x32x16_bf16(pa0, ATT_PK(l0, h0), od, 0, 0, 0);
  od = __builtin_amdgcn_mfma_f32_32x32x16_bf16(pa1, ATT_PK(l1, h1), od, 0, 0, 0);
  od = __builtin_amdgcn_mfma_f32_32x32x16_bf16(pa2, ATT_PK(l2, h2), od, 0, 0, 0);
  od = __builtin_amdgcn_mfma_f32_32x32x16_bf16(pa3, ATT_PK(l3, h3), od, 0, 0, 0);
}
__device__ __forceinline__ void pv_d0(f32x16 (&o)[4], int vb, bf16x8 pa0, bf16x8 pa1, bf16x8 pa2, bf16x8 pa3) {
  pv_one<0>(o[0], vb, pa0, pa1, pa2, pa3); pv_one<1>(o[1], vb, pa0, pa1, pa2, pa3); pv_one<2>(o[2], vb, pa0, pa1, pa2, pa3); pv_one<3>(o[3], vb, pa0, pa1, pa2, pa3);
}
template <int D0> __device__ __forceinline__ void pv32_one(f32x16& od, int vb, bf16x8 pa0, bf16x8 pa1) {
  const s16x4 l0 = tr_read<v_rd_off(D0, 0, 0)>(vb), h0 = tr_read<v_rd_off(D0, 0, 1)>(vb), l1 = tr_read<v_rd_off(D0, 1, 0)>(vb), h1 = tr_read<v_rd_off(D0, 1, 1)>(vb);
  asm volatile("s_waitcnt lgkmcnt(0)" ::: "memory"); SBAR();
  od = __builtin_amdgcn_mfma_f32_32x32x16_bf16(pa0, ATT_PK(l0, h0), od, 0, 0, 0);
  od = __builtin_amdgcn_mfma_f32_32x32x16_bf16(pa1, ATT_PK(l1, h1), od, 0, 0, 0);
}

template <int DQK, int LDQ, int LDK, int LDO, int SDEPTH>
__device__ __forceinline__ void attn_dense_body(const bf16* __restrict__ Qb, const bf16* __restrict__ Kh, const bf16* __restrict__ Kr, const bf16* __restrict__ Vh,
                                                const float* __restrict__ cs_rows, OT* __restrict__ Ob, int seq, const float scale, ATT_LAS char* lds) {
  constexpr int SHM_V = KVBLK * DV * 2, SHM_K = KVBLK * DQK * 2, RB = DQK * 2, NQ = DQK / 16;
  constexpr bool ROPE = (DQK == 192);
  const float C = scale * LOG2E, THRS = 8.f / scale;
  int tid_ = threadIdx.x; asm volatile("" : "+v"(tid_));
  const int tid = tid_, wid = tid >> 6, lane = tid & 63, r32 = lane & 31, hi = lane >> 5;
  ATT_LAS char* V_lds = lds; ATT_LAS char* K_lds = lds + 2 * SHM_V;
  ATT_LAS float* ws = (ATT_LAS float*)(lds + 2 * SHM_V + 2 * SHM_K) + wid * 64; ATT_LAS float* li_l = ws; ATT_LAS float* al_l = ws + 32;
  float m_reg = -1e30f, l_reg = 0; f32x16 o[4] = {}; bf16x8 qr[NQ];
  const bf16* Qw = Qb + (long)(wid * QBLK + r32) * LDQ + hi * 8;
#pragma unroll
  for (int d0 = 0; d0 < NQ; ++d0) qr[d0] = *(const ATT_GAS bf16x8*)(Qw + d0 * 16);
  if constexpr (ROPE) {
    const float* cs = cs_rows + (long)(wid * QBLK + r32) * 64 + hi * 8;
#pragma unroll
    for (int g = 0; g < 2; ++g) {
      const f32x4 c0 = *(const ATT_GAS f32x4*)(cs + g * 16), c1 = *(const ATT_GAS f32x4*)(cs + g * 16 + 4);
      const f32x4 s0 = *(const ATT_GAS f32x4*)(cs + 32 + g * 16), s1 = *(const ATT_GAS f32x4*)(cs + 32 + g * 16 + 4);
      float y1[8], y2[8];
#pragma unroll
      for (int j = 0; j < 8; ++j) { const float co = j < 4 ? c0[j & 3] : c1[j & 3], si = j < 4 ? s0[j & 3] : s1[j & 3];
        const float x1 = bf2f(qr[8 + g][j]), x2 = bf2f(qr[10 + g][j]); y1[j] = x1 * co - x2 * si; y2[j] = x1 * si + x2 * co; }
      u32x4 w1 = {cvtpk(y1[0], y1[1]), cvtpk(y1[2], y1[3]), cvtpk(y1[4], y1[5]), cvtpk(y1[6], y1[7])};
      u32x4 w2 = {cvtpk(y2[0], y2[1]), cvtpk(y2[2], y2[3]), cvtpk(y2[4], y2[5]), cvtpk(y2[6], y2[7])};
      qr[8 + g] = *reinterpret_cast<bf16x8*>(&w1); qr[10 + g] = *reinterpret_cast<bf16x8*>(&w2);
    }
  }
  const int sr = tid >> 4, sc = (tid & 15) * 8, vst0 = v_st(sr, sc), vst1 = v_st(32 + sr, sc);
  const int rr = tid >> 3, rc = (tid & 7) * 8;
  const int vb0 = (int)(unsigned)(uintptr_t)V_lds + v_rd_base(lane);
  struct Slot { bf16x8 vs0, vs1, ks0, ks1, kr; } sr_[SDEPTH];
#define SLOAD(i, k0) do { sr_[i].vs0 = *(const ATT_GAS bf16x8*)(&Vh[(long)((k0) + sr) * LDK + sc]); sr_[i].vs1 = *(const ATT_GAS bf16x8*)(&Vh[(long)((k0) + 32 + sr) * LDK + sc]); \
    sr_[i].ks0 = *(const ATT_GAS bf16x8*)(&Kh[(long)((k0) + sr) * LDK + sc]); sr_[i].ks1 = *(const ATT_GAS bf16x8*)(&Kh[(long)((k0) + 32 + sr) * LDK + sc]); \
    if constexpr (ROPE) sr_[i].kr = *(const ATT_GAS bf16x8*)(&Kr[(long)((k0) + rr) * 64 + rc]); } while (0)
#define SWRITE(b, i) do { *reinterpret_cast<ATT_LAS bf16x8*>(V_lds + (b) * SHM_V + vst0) = sr_[i].vs0;          \
    *reinterpret_cast<ATT_LAS bf16x8*>(V_lds + (b) * SHM_V + vst1) = sr_[i].vs1; const int kc = sc * 2;               \
    *reinterpret_cast<ATT_LAS bf16x8*>(K_lds + (b) * SHM_K + kswz<RB>(sr, kc)) = sr_[i].ks0;                       \
    *reinterpret_cast<ATT_LAS bf16x8*>(K_lds + (b) * SHM_K + kswz<RB>(32 + sr, kc)) = sr_[i].ks1;                  \
    if constexpr (ROPE) *reinterpret_cast<ATT_LAS bf16x8*>(K_lds + (b) * SHM_K + kswz<RB>(rr, 256 + rc * 2)) = sr_[i].kr; } while (0)
#define SWAIT() do { if constexpr (SDEPTH == 2) { if constexpr (ROPE) asm volatile("s_waitcnt vmcnt(5)" ::: "memory"); else asm volatile("s_waitcnt vmcnt(4)" ::: "memory"); } else asm volatile("s_waitcnt vmcnt(0)" ::: "memory"); } while (0)
#define RESC(a) do { if (__any((a) < 1.f)) { if (hi == 0) al_l[r32] = (a); asm volatile("s_waitcnt lgkmcnt(0)" ::: "memory"); \
    _Pragma("unroll") for (int d = 0; d < 4; ++d) _Pragma("unroll") for (int r = 0; r < 16; ++r) o[d][r] *= al_l[crow(r, hi)]; } } while (0)
  f32x16 pA0, pA1, pB0, pB1; float mnA, mnB, alA, alB; bf16x8 pa0, pa1, pa2, pa3; const int NT = seq / KVBLK;
  constexpr int SE = 0, SO = SDEPTH - 1;
  SLOAD(SE, 0); asm volatile("s_waitcnt vmcnt(0)" ::: "memory"); SWRITE(0, SE); __syncthreads();
  qkt<DQK>(pA0, pA1, K_lds, qr, r32, hi); partialSM(pA0, pA1, m_reg, mnA, alA, C, THRS);
  SLOAD(SO, KVBLK); if constexpr (SDEPTH == 2) { if (2 < NT) SLOAD(SE, 2 * KVBLK); }
  SWAIT(); SWRITE(1, SO); __syncthreads();
  for (int j = 1; j + 1 < NT; j += 2) {
    SBAR(); qkt<DQK>(pB0, pB1, K_lds + SHM_K, qr, r32, hi);
    finishSM(pA0, pA1, alA, l_reg, pa0, pa1, pa2, pa3); SBAR();
    SLOAD(SO, (j + SDEPTH) * KVBLK); SBAR();
    pv_d0(o, vb0, pa0, pa1, pa2, pa3); partialSM(pB0, pB1, m_reg, mnB, alB, C, THRS);
    __syncthreads(); SWAIT(); SWRITE(0, SE);
    RESC(alB); __syncthreads();
    SBAR(); qkt<DQK>(pA0, pA1, K_lds, qr, r32, hi);
    finishSM(pB0, pB1, alB, l_reg, pa0, pa1, pa2, pa3); SBAR();
    if (SDEPTH == 1 || j + 3 < NT) SLOAD(SE, (j + 1 + SDEPTH) * KVBLK); SBAR();
    pv_d0(o, vb0 + SHM_V, pa0, pa1, pa2, pa3); partialSM(pA0, pA1, m_reg, mnA, alA, C, THRS);
    __syncthreads(); SWAIT(); SWRITE(1, SO);
    RESC(alA); __syncthreads();
  }
  SBAR(); qkt<DQK>(pB0, pB1, K_lds + SHM_K, qr, r32, hi);
  finishSM(pA0, pA1, alA, l_reg, pa0, pa1, pa2, pa3); SBAR();
  pv_d0(o, vb0, pa0, pa1, pa2, pa3); partialSM(pB0, pB1, m_reg, mnB, alB, C, THRS);
  __syncthreads(); RESC(alB);
  finishSM(pB0, pB1, alB, l_reg, pa0, pa1, pa2, pa3); SBAR();
  pv_d0(o, vb0 + SHM_V, pa0, pa1, pa2, pa3);
  if (hi == 0) li_l[r32] = l_reg; asm volatile("s_waitcnt lgkmcnt(0)" ::: "memory");
  float rli[16];
#pragma unroll
  for (int r = 0; r < 16; ++r) rli[r] = __builtin_amdgcn_rcpf(li_l[crow(r, hi)]);
  OT* Ow = Ob + (long)(wid * QBLK) * LDO;
#pragma unroll
  for (int r = 0; r < 16; ++r) { const int orow = crow(r, hi);
#pragma unroll
    for (int d0 = 0; d0 < 4; ++d0) st_o(&Ow[(long)orow * LDO + d0 * 32 + r32], o[d0][r] * rli[r]); }
  __syncthreads();
#undef SLOAD
#undef SWRITE
#undef SWAIT
#undef RESC
}

template <int LDQ, int LDK, int LDO>
__device__ __forceinline__ void attn_pipe192_body(const bf16* __restrict__ Qb, const bf16* __restrict__ Kh, const bf16* __restrict__ Kr, const bf16* __restrict__ Vh,
                                                const float* __restrict__ cs_rows, OT* __restrict__ Ob, int seq, const float scale, ATT_LAS char* lds) {
  constexpr int DQK = 192, SDEPTH = 1, SHM_V = KVBLK * DV * 2, SHM_K = KVBLK * DQK * 2, RB = DQK * 2, NQ = DQK / 16;
  constexpr bool ROPE = true;
  const float C = scale * LOG2E, THRS = 8.f / scale;
  int tid_ = threadIdx.x; asm volatile("" : "+v"(tid_));
  const int tid = tid_, wid = tid >> 6, lane = tid & 63, r32 = lane & 31, hi = lane >> 5;
  ATT_LAS char* V_lds = lds; ATT_LAS char* K_lds = lds + 2 * SHM_V;
  ATT_LAS float* ws = (ATT_LAS float*)(lds + 2 * SHM_V + 2 * SHM_K) + wid * 64; ATT_LAS float* li_l = ws; ATT_LAS float* al_l = ws + 32;
  ATT_LAS char* Qs = lds + 2 * SHM_V + 2 * SHM_K + 2048 + wid * 4096;
  float m_reg = -1e30f, l_reg = 0; f32x16 o[4] = {}; bf16x8 qr8[8];
  const bf16* Qw = Qb + (long)(wid * QBLK + r32) * LDQ + hi * 8;
  { bf16x8 qr[NQ];
#pragma unroll
  for (int d0 = 0; d0 < NQ; ++d0) qr[d0] = *(const ATT_GAS bf16x8*)(Qw + d0 * 16);
  if constexpr (ROPE) {
    const float* cs = cs_rows + (long)(wid * QBLK + r32) * 64 + hi * 8;
#pragma unroll
    for (int g = 0; g < 2; ++g) {
      const f32x4 c0 = *(const ATT_GAS f32x4*)(cs + g * 16), c1 = *(const ATT_GAS f32x4*)(cs + g * 16 + 4);
      const f32x4 s0 = *(const ATT_GAS f32x4*)(cs + 32 + g * 16), s1 = *(const ATT_GAS f32x4*)(cs + 32 + g * 16 + 4);
      float y1[8], y2[8];
#pragma unroll
      for (int j = 0; j < 8; ++j) { const float co = j < 4 ? c0[j & 3] : c1[j & 3], si = j < 4 ? s0[j & 3] : s1[j & 3];
        const float x1 = bf2f(qr[8 + g][j]), x2 = bf2f(qr[10 + g][j]); y1[j] = x1 * co - x2 * si; y2[j] = x1 * si + x2 * co; }
      u32x4 w1 = {cvtpk(y1[0], y1[1]), cvtpk(y1[2], y1[3]), cvtpk(y1[4], y1[5]), cvtpk(y1[6], y1[7])};
      u32x4 w2 = {cvtpk(y2[0], y2[1]), cvtpk(y2[2], y2[3]), cvtpk(y2[4], y2[5]), cvtpk(y2[6], y2[7])};
      qr[8 + g] = *reinterpret_cast<bf16x8*>(&w1); qr[10 + g] = *reinterpret_cast<bf16x8*>(&w2);
    }
  }
#pragma unroll
  for (int d0 = 0; d0 < 8; ++d0) qr8[d0] = qr[d0];
#pragma unroll
  for (int d0 = 8; d0 < 12; ++d0) *reinterpret_cast<ATT_LAS bf16x8*>(Qs + ((d0 - 8) * 64 + lane) * 16) = qr[d0];
  }
  const int sr = tid >> 4, sc = (tid & 15) * 8, vst0 = v_st(sr, sc), vst1 = v_st(32 + sr, sc);
  const int rr = tid >> 3, rc = (tid & 7) * 8;
  const int vb0 = (int)(unsigned)(uintptr_t)V_lds + v_rd_base(lane);
  struct Slot { bf16x8 vs0, vs1, ks0, ks1, kr; } sr_[SDEPTH];
#define SLOADK(i, k0) do { sr_[i].ks0 = *(const ATT_GAS bf16x8*)(&Kh[(long)((k0) + sr) * LDK + sc]); sr_[i].ks1 = *(const ATT_GAS bf16x8*)(&Kh[(long)((k0) + 32 + sr) * LDK + sc]); } while (0)
#define SLOADV(i, k0) do { sr_[i].vs0 = *(const ATT_GAS bf16x8*)(&Vh[(long)((k0) + sr) * LDK + sc]); sr_[i].vs1 = *(const ATT_GAS bf16x8*)(&Vh[(long)((k0) + 32 + sr) * LDK + sc]); \
    if constexpr (ROPE) sr_[i].kr = *(const ATT_GAS bf16x8*)(&Kr[(long)((k0) + rr) * 64 + rc]); } while (0)
#define SLOAD(i, k0) do { SLOADK(i, k0); SLOADV(i, k0); } while (0)
#define SWRITE(b, i) do { *reinterpret_cast<ATT_LAS bf16x8*>(V_lds + (b) * SHM_V + vst0) = sr_[i].vs0;          \
    *reinterpret_cast<ATT_LAS bf16x8*>(V_lds + (b) * SHM_V + vst1) = sr_[i].vs1; const int kc = sc * 2;               \
    *reinterpret_cast<ATT_LAS bf16x8*>(K_lds + (b) * SHM_K + kswz<RB>(sr, kc)) = sr_[i].ks0;                       \
    *reinterpret_cast<ATT_LAS bf16x8*>(K_lds + (b) * SHM_K + kswz<RB>(32 + sr, kc)) = sr_[i].ks1;                  \
    if constexpr (ROPE) *reinterpret_cast<ATT_LAS bf16x8*>(K_lds + (b) * SHM_K + kswz<RB>(rr, 256 + rc * 2)) = sr_[i].kr; } while (0)
#define SWAIT() do { if constexpr (SDEPTH == 2) { if constexpr (ROPE) asm volatile("s_waitcnt vmcnt(5)" ::: "memory"); else asm volatile("s_waitcnt vmcnt(4)" ::: "memory"); } else asm volatile("s_waitcnt vmcnt(0)" ::: "memory"); } while (0)
#define RESC(a) do { if (__any((a) < 1.f)) { if (hi == 0) al_l[r32] = (a); asm volatile("s_waitcnt lgkmcnt(0)" ::: "memory"); \
    _Pragma("unroll") for (int d = 0; d < 4; ++d) _Pragma("unroll") for (int r = 0; r < 16; ++r) o[d][r] *= al_l[crow(r, hi)]; } } while (0)
  f32x16 pA0, pA1, pB0, pB1; float mnA, mnB, alA, alB; bf16x8 pa0, pa1, pa2, pa3; const int NT = seq / KVBLK;
  constexpr int SE = 0, SO = SDEPTH - 1;
  SLOAD(SE, 0); asm volatile("s_waitcnt vmcnt(0)" ::: "memory"); SWRITE(0, SE); __syncthreads();
  qkt192_lq(pA0, pA1, K_lds, qr8, Qs, lane, r32, hi); partialSM(pA0, pA1, m_reg, mnA, alA, C, THRS);
  SLOAD(SO, KVBLK); if constexpr (SDEPTH == 2) { if (2 < NT) SLOAD(SE, 2 * KVBLK); }
  SWAIT(); SWRITE(1, SO); __syncthreads();
  for (int j = 1; j + 1 < NT; j += 2) {
    SBAR(); qkt192_lq(pB0, pB1, K_lds + SHM_K, qr8, Qs, lane, r32, hi);
    finishSM(pA0, pA1, alA, l_reg, pa0, pa1, pa2, pa3); SBAR();
    SLOADK(SO, (j + SDEPTH) * KVBLK); SBAR();
    pv_d0(o, vb0, pa0, pa1, pa2, pa3); SBAR(); SLOADV(SO, (j + SDEPTH) * KVBLK); SBAR(); partialSM(pB0, pB1, m_reg, mnB, alB, C, THRS);
    __syncthreads(); SWAIT(); SWRITE(0, SE);
    RESC(alB); __syncthreads();
    SBAR(); qkt192_lq(pA0, pA1, K_lds, qr8, Qs, lane, r32, hi);
    finishSM(pB0, pB1, alB, l_reg, pa0, pa1, pa2, pa3); SBAR();
    SLOADK(SE, (j + 1 + SDEPTH) * KVBLK); SBAR();
    pv_d0(o, vb0 + SHM_V, pa0, pa1, pa2, pa3); SBAR(); SLOADV(SE, (j + 1 + SDEPTH) * KVBLK); SBAR(); partialSM(pA0, pA1, m_reg, mnA, alA, C, THRS);
    __syncthreads(); SWAIT(); SWRITE(1, SO);
    RESC(alA); __syncthreads();
  }
  SBAR(); qkt192_lq(pB0, pB1, K_lds + SHM_K, qr8, Qs, lane, r32, hi);
  finishSM(pA0, pA1, alA, l_reg, pa0, pa1, pa2, pa3); SBAR();
  pv_d0(o, vb0, pa0, pa1, pa2, pa3); partialSM(pB0, pB1, m_reg, mnB, alB, C, THRS);
  __syncthreads(); RESC(alB);
  finishSM(pB0, pB1, alB, l_reg, pa0, pa1, pa2, pa3); SBAR();
  pv_d0(o, vb0 + SHM_V, pa0, pa1, pa2, pa3);
  if (hi == 0) li_l[r32] = l_reg; asm volatile("s_waitcnt lgkmcnt(0)" ::: "memory");
  float rli[16];
#pragma unroll
  for (int r = 0; r < 16; ++r) rli[r] = __builtin_amdgcn_rcpf(li_l[crow(r, hi)]);
  OT* Ow = Ob + (long)(wid * QBLK) * LDO;
#pragma unroll
  for (int r = 0; r < 16; ++r) { const int orow = crow(r, hi);
#pragma unroll
    for (int d0 = 0; d0 < 4; ++d0) st_o(&Ow[(long)orow * LDO + d0 * 32 + r32], o[d0][r] * rli[r]); }
  __syncthreads();
#undef SLOAD
#undef SLOADK
#undef SLOADV
#undef SWRITE
#undef SWAIT
#undef RESC
}

template <int DQK, int LDQ, int LDK, int LDO>
__device__ __forceinline__ void attn_simple_body(const bf16* __restrict__ Qb, const bf16* __restrict__ Kh, const bf16* __restrict__ Kr, const bf16* __restrict__ Vh,
                                                 const float* __restrict__ cs_rows, OT* __restrict__ Ob, int seq, const float scale, ATT_LAS char* lds) {
  constexpr int SHM_V = KVBLK * DV * 2, SHM_K = KVBLK * DQK * 2, RB = DQK * 2, NQ = DQK / 16;
  constexpr bool ROPE = (DQK == 192);
  const float C = scale * LOG2E, THRS = 8.f / scale;
  int tid_ = threadIdx.x; asm volatile("" : "+v"(tid_));
  const int tid = tid_, wid = tid >> 6, lane = tid & 63, r32 = lane & 31, hi = lane >> 5;
  ATT_LAS char* V_lds = lds; ATT_LAS char* K_lds = lds + 2 * SHM_V;
  ATT_LAS float* ws = (ATT_LAS float*)(lds + 2 * SHM_V + 2 * SHM_K) + wid * 64; ATT_LAS float* li_l = ws; ATT_LAS float* al_l = ws + 32;
  float m_reg = -1e30f, l_reg = 0; f32x16 o[4] = {}; bf16x8 qr[NQ];
  const bf16* Qw = Qb + (long)(wid * QBLK + r32) * LDQ + hi * 8;
#pragma unroll
  for (int d0 = 0; d0 < NQ; ++d0) qr[d0] = *(const ATT_GAS bf16x8*)(Qw + d0 * 16);
  if constexpr (ROPE) {
    const float* cs = cs_rows + (long)(wid * QBLK + r32) * 64 + hi * 8;
#pragma unroll
    for (int g = 0; g < 2; ++g) {
      const f32x4 c0 = *(const ATT_GAS f32x4*)(cs + g * 16), c1 = *(const ATT_GAS f32x4*)(cs + g * 16 + 4);
      const f32x4 s0 = *(const ATT_GAS f32x4*)(cs + 32 + g * 16), s1 = *(const ATT_GAS f32x4*)(cs + 32 + g * 16 + 4);
      float y1[8], y2[8];
#pragma unroll
      for (int j = 0; j < 8; ++j) { const float co = j < 4 ? c0[j & 3] : c1[j & 3], si = j < 4 ? s0[j & 3] : s1[j & 3];
        const float x1 = bf2f(qr[8 + g][j]), x2 = bf2f(qr[10 + g][j]); y1[j] = x1 * co - x2 * si; y2[j] = x1 * si + x2 * co; }
      u32x4 w1 = {cvtpk(y1[0], y1[1]), cvtpk(y1[2], y1[3]), cvtpk(y1[4], y1[5]), cvtpk(y1[6], y1[7])};
      u32x4 w2 = {cvtpk(y2[0], y2[1]), cvtpk(y2[2], y2[3]), cvtpk(y2[4], y2[5]), cvtpk(y2[6], y2[7])};
      qr[8 + g] = *reinterpret_cast<bf16x8*>(&w1); qr[10 + g] = *reinterpret_cast<bf16x8*>(&w2);
    }
  }
  const int sr = tid >> 4, sc = (tid & 15) * 8, vst0 = v_st(sr, sc), vst1 = v_st(32 + sr, sc);
  const int rr = tid >> 3, rc = (tid & 7) * 8;
  const int vb0 = (int)(unsigned)(uintptr_t)V_lds + v_rd_base(lane);
  bf16x8 vs0, vs1, ks0, ks1, kr;
#define SLOAD(k0) do { vs0 = *(const ATT_GAS bf16x8*)(&Vh[(long)((k0) + sr) * LDK + sc]); vs1 = *(const ATT_GAS bf16x8*)(&Vh[(long)((k0) + 32 + sr) * LDK + sc]); \
    ks0 = *(const ATT_GAS bf16x8*)(&Kh[(long)((k0) + sr) * LDK + sc]); ks1 = *(const ATT_GAS bf16x8*)(&Kh[(long)((k0) + 32 + sr) * LDK + sc]); \
    if constexpr (ROPE) kr = *(const ATT_GAS bf16x8*)(&Kr[(long)((k0) + rr) * 64 + rc]); } while (0)
#define SWRITE(b) do { *reinterpret_cast<ATT_LAS bf16x8*>(V_lds + (b) * SHM_V + vst0) = vs0;          \
    *reinterpret_cast<ATT_LAS bf16x8*>(V_lds + (b) * SHM_V + vst1) = vs1; const int kc = sc * 2;               \
    *reinterpret_cast<ATT_LAS bf16x8*>(K_lds + (b) * SHM_K + kswz<RB>(sr, kc)) = ks0;                       \
    *reinterpret_cast<ATT_LAS bf16x8*>(K_lds + (b) * SHM_K + kswz<RB>(32 + sr, kc)) = ks1;                  \
    if constexpr (ROPE) *reinterpret_cast<ATT_LAS bf16x8*>(K_lds + (b) * SHM_K + kswz<RB>(rr, 256 + rc * 2)) = kr; } while (0)
#define RESC(a) do { if (__any((a) < 1.f)) { if (hi == 0) al_l[r32] = (a); asm volatile("s_waitcnt lgkmcnt(0)" ::: "memory"); \
    _Pragma("unroll") for (int d = 0; d < 4; ++d) _Pragma("unroll") for (int r = 0; r < 16; ++r) o[d][r] *= al_l[crow(r, hi)]; } } while (0)
  const int NT = seq / KVBLK;
  SLOAD(0); SWRITE(0); __syncthreads();
  for (int j = 0; j < NT; ++j) {
    const int b = j & 1;
    if (j + 1 < NT) SLOAD((j + 1) * KVBLK);
    f32x16 p0, p1; float mn, al; bf16x8 pa0, pa1, pa2, pa3;
    SBAR(); qkt<DQK>(p0, p1, K_lds + b * SHM_K, qr, r32, hi);
    partialSM(p0, p1, m_reg, mn, al, C, THRS); RESC(al);
    finishSM(p0, p1, al, l_reg, pa0, pa1, pa2, pa3); SBAR();
    pv_d0(o, vb0 + b * SHM_V, pa0, pa1, pa2, pa3);
    if (j + 1 < NT) SWRITE(b ^ 1);
    __syncthreads();
  }
  if (hi == 0) li_l[r32] = l_reg; asm volatile("s_waitcnt lgkmcnt(0)" ::: "memory");
  float rli[16];
#pragma unroll
  for (int r = 0; r < 16; ++r) rli[r] = __builtin_amdgcn_rcpf(li_l[crow(r, hi)]);
  OT* Ow = Ob + (long)(wid * QBLK) * LDO;
#pragma unroll
  for (int r = 0; r < 16; ++r) { const int orow = crow(r, hi);
#pragma unroll
    for (int d0 = 0; d0 < 4; ++d0) st_o(&Ow[(long)orow * LDO + d0 * 32 + r32], o[d0][r] * rli[r]); }
  __syncthreads();
#undef SLOAD
#undef SWRITE
#undef RESC
}

template <int LDQ, int LDK, int LDO>
__device__ __forceinline__ void attn_dma_body(const bf16* __restrict__ Qb, const bf16* __restrict__ Kh, const bf16* __restrict__ Kr, const bf16* __restrict__ Vh,
                                              const float* __restrict__ cs_rows, OT* __restrict__ Ob, int seq, const float scale, ATT_LAS char* lds) {
  constexpr int DQK = 192, SHM_V = KVBLK * DV * 2, SHM_K = KVBLK * DQK * 2, STG = SHM_K + SHM_V, RB = DQK * 2, NQ = DQK / 16;
  const float C = scale * LOG2E, THRS = 8.f / scale;
  int tid_ = threadIdx.x; asm volatile("" : "+v"(tid_));
  const int tid = tid_, wid = __builtin_amdgcn_readfirstlane(tid >> 6), lane = tid & 63, r32 = lane & 31, hi = lane >> 5;
  ATT_LAS float* ws = (ATT_LAS float*)(lds + 3 * STG) + wid * 64; ATT_LAS float* li_l = ws; ATT_LAS float* al_l = ws + 32;
  float m_reg = -1e30f, l_reg = 0; f32x16 o[4] = {}; bf16x8 qr[NQ];
  const bf16* Qw = Qb + (long)(wid * QBLK + r32) * LDQ + hi * 8;
#pragma unroll
  for (int d0 = 0; d0 < NQ; ++d0) qr[d0] = *(const ATT_GAS bf16x8*)(Qw + d0 * 16);
  { const float* cs = cs_rows + (long)(wid * QBLK + r32) * 64 + hi * 8;
#pragma unroll
    for (int g = 0; g < 2; ++g) {
      const f32x4 c0 = *(const ATT_GAS f32x4*)(cs + g * 16), c1 = *(const ATT_GAS f32x4*)(cs + g * 16 + 4);
      const f32x4 s0 = *(const ATT_GAS f32x4*)(cs + 32 + g * 16), s1 = *(const ATT_GAS f32x4*)(cs + 32 + g * 16 + 4);
      float y1[8], y2[8];
#pragma unroll
      for (int j = 0; j < 8; ++j) { const float co = j < 4 ? c0[j & 3] : c1[j & 3], si = j < 4 ? s0[j & 3] : s1[j & 3];
        const float x1 = bf2f(qr[8 + g][j]), x2 = bf2f(qr[10 + g][j]); y1[j] = x1 * co - x2 * si; y2[j] = x1 * si + x2 * co; }
      u32x4 w1 = {cvtpk(y1[0], y1[1]), cvtpk(y1[2], y1[3]), cvtpk(y1[4], y1[5]), cvtpk(y1[6], y1[7])};
      u32x4 w2 = {cvtpk(y2[0], y2[1]), cvtpk(y2[2], y2[3]), cvtpk(y2[4], y2[5]), cvtpk(y2[6], y2[7])};
      qr[8 + g] = *reinterpret_cast<bf16x8*>(&w1); qr[10 + g] = *reinterpret_cast<bf16x8*>(&w2);
    } }
  const char* ksrc[3]; int kstep[3];
#pragma unroll
  for (int d = 0; d < 3; ++d) { const int p = (wid * 3 + d) * 64 + lane, row = p / 24, cpos = p - row * 24, c = cpos ^ (row & 7);
    if (c < 16) { ksrc[d] = (const char*)(Kh + (long)row * LDK + c * 8); kstep[d] = KVBLK * LDK * 2; } else { ksrc[d] = (const char*)(Kr + (long)row * 64 + (c - 16) * 8); kstep[d] = KVBLK * 64 * 2; } }
  const char* vsrc[2];
#pragma unroll
  for (int d = 0; d < 2; ++d) { const int p = (wid * 2 + d) * 64 + lane, sub = p >> 5, q = p & 31, kk = (sub >> 2) * 8 + (q >> 2), col = (sub & 3) * 32 + (q & 3) * 8;
    const int key = (kk & ~0xC) | ((kk & 4) << 1) | ((kk & 8) >> 1); vsrc[d] = (const char*)(Vh + (long)key * LDK + col); }
#define DMA_TILE(t, stg) do { ATT_LAS char* sb_ = lds + (stg) * STG; \
    _Pragma("unroll") for (int d = 0; d < 3; ++d) __builtin_amdgcn_global_load_lds((const unsigned*)(ksrc[d] + (long)(t) * kstep[d]), (ATT_LAS unsigned*)(sb_ + (wid * 3 + d) * 1024), 16, 0, 0); \
    _Pragma("unroll") for (int d = 0; d < 2; ++d) __builtin_amdgcn_global_load_lds((const unsigned*)(vsrc[d] + (long)(t) * (KVBLK * LDK * 2)), (ATT_LAS unsigned*)(sb_ + SHM_K + (wid * 2 + d) * 1024), 16, 0, 0); } while (0)
#define RESC(a) do { if (__any((a) < 1.f)) { if (hi == 0) al_l[r32] = (a); asm volatile("s_waitcnt lgkmcnt(0)" ::: "memory"); \
    _Pragma("unroll") for (int d = 0; d < 4; ++d) _Pragma("unroll") for (int r = 0; r < 16; ++r) o[d][r] *= al_l[crow(r, hi)]; } } while (0)
  const int NT = seq / KVBLK, vbase = (int)(unsigned)(uintptr_t)lds + SHM_K + v_rd_base(lane);
  asm volatile("s_waitcnt vmcnt(0)" ::: "memory");
  DMA_TILE(0, 0); DMA_TILE(1, 1);
  asm volatile("s_waitcnt vmcnt(5)" ::: "memory"); __builtin_amdgcn_s_barrier(); asm volatile("" ::: "memory");
  int stg = 0;
  for (int j = 0; j < NT; ++j) {
    const int stg2 = stg >= 1 ? stg - 1 : 2;
    if (j + 2 < NT) DMA_TILE(j + 2, stg2);
    f32x16 p0, p1; float mn, al; bf16x8 pa0, pa1, pa2, pa3;
    SBAR(); qkt<DQK>(p0, p1, lds + stg * STG, qr, r32, hi);
    partialSM(p0, p1, m_reg, mn, al, C, THRS); RESC(al);
    finishSM(p0, p1, al, l_reg, pa0, pa1, pa2, pa3); SBAR();
    pv_d0(o, vbase + stg * STG, pa0, pa1, pa2, pa3);
    if (j + 2 < NT) asm volatile("s_waitcnt vmcnt(5)" ::: "memory"); else asm volatile("s_waitcnt vmcnt(0)" ::: "memory");
    asm volatile("s_waitcnt lgkmcnt(0)" ::: "memory"); __builtin_amdgcn_s_barrier(); asm volatile("" ::: "memory");
    stg = stg == 2 ? 0 : stg + 1;
  }
  if (hi == 0) li_l[r32] = l_reg; asm volatile("s_waitcnt lgkmcnt(0)" ::: "memory");
  float rli[16];
#pragma unroll
  for (int r = 0; r < 16; ++r) rli[r] = __builtin_amdgcn_rcpf(li_l[crow(r, hi)]);
  OT* Ow = Ob + (long)(wid * QBLK) * LDO;
#pragma unroll
  for (int r = 0; r < 16; ++r) { const int orow = crow(r, hi);
#pragma unroll
    for (int d0 = 0; d0 < 4; ++d0) st_o(&Ow[(long)orow * LDO + d0 * 32 + r32], o[d0][r] * rli[r]); }
  __syncthreads();
#undef DMA_TILE
#undef RESC
}

template <int LDP>
__device__ __forceinline__ void dil_wave_unit(const bf16* __restrict__ P, int qc, int kc, int vc, int d, int r, int t0, int nT,
                                              OT* __restrict__ O, int oc, float* __restrict__ ST  ,
                                              ATT_LAS char* vlds  , const ATT_LAS float* bias2, const float C, int lane_) {
  int lane = lane_; asm volatile("" : "+v"(lane));
  const int r32 = lane & 31, hi = lane >> 5;
  bf16x8 qr[8];
  { const bf16* qp = P + (long)(r + d * (t0 + r32)) * LDP + qc + hi * 8;
#pragma unroll
    for (int d0 = 0; d0 < 8; ++d0) qr[d0] = *(const ATT_GAS bf16x8*)(qp + d0 * 16); }
  bf16x8 kf[2][8];
#define DIL_LDK(kb, set) do { int kt_ = t0 - 64 + (kb) * 32 + r32; kt_ = kt_ < 0 ? 0 : (kt_ > nT - 1 ? nT - 1 : kt_); \
    const bf16* kp_ = P + (long)(r + d * kt_) * LDP + kc + hi * 8; \
    _Pragma("unroll") for (int d0 = 0; d0 < 8; ++d0) kf[set][d0] = *(const ATT_GAS bf16x8*)(kp_ + d0 * 16); } while (0)
  DIL_LDK(0, 0);
  f32x16 p[5];
#pragma unroll
  for (int kb = 0; kb < 5; ++kb) {
    if (kb + 1 < 5) DIL_LDK(kb + 1, (kb + 1) & 1);
    p[kb] = f32x16{};
#pragma unroll
    for (int d0 = 0; d0 < 8; ++d0) p[kb] = __builtin_amdgcn_mfma_f32_32x32x16_bf16(kf[kb & 1][d0], qr[d0], p[kb], 0, 0, 0);
  }
#undef DIL_LDK
  bf16x8 vv[2][8];
#define DIL_LDV(kb, set) do { _Pragma("unroll") for (int i = 0; i < 8; ++i) { const int id = lane + 64 * i, row = id >> 4, c = (id & 15) * 8; \
      int kt_ = t0 - 64 + (kb) * 32 + row; kt_ = kt_ < 0 ? 0 : (kt_ > nT - 1 ? nT - 1 : kt_); \
      vv[set][i] = *(const ATT_GAS bf16x8*)(P + (long)(r + d * kt_) * LDP + vc + c); } } while (0)
  DIL_LDV(0, 0);
  float m = -1e30f;
  { const int a_ = 4 * hi - r32 + 32, k_ = a_ & 3; const ATT_LAS f32x4* tp = (const ATT_LAS f32x4*)(bias2 + k_ * 196 + (a_ - k_));
    const bool interior = (t0 >= 64) && (t0 + 96 <= nT);
#pragma unroll
    for (int kb = 0; kb < 5; ++kb)
#pragma unroll
      for (int g = 0; g < 4; ++g) { const f32x4 bv = tp[kb * 8 + 2 * g];
#pragma unroll
        for (int e = 0; e < 4; ++e) { const int rg = 4 * g + e; float s = fmaf(p[kb][rg], C, bv[e]);
          if (!interior) { const int kt = t0 - 64 + kb * 32 + crow(rg, hi); s = (kt >= 0 && kt < nT) ? s : -1e30f; }
          p[kb][rg] = s; m = fmaxf(m, s); } } }
  { auto rr = __builtin_amdgcn_permlane32_swap(__float_as_uint(m), __float_as_uint(m), false, false); m = fmaxf(__uint_as_float(rr[0]), __uint_as_float(rr[1])); }
  float Z = 0.f;
#pragma unroll
  for (int kb = 0; kb < 5; ++kb)
#pragma unroll
    for (int rg = 0; rg < 16; ++rg) { p[kb][rg] = __builtin_amdgcn_exp2f(p[kb][rg] - m); Z += p[kb][rg]; }
  { auto rr = __builtin_amdgcn_permlane32_swap(__float_as_uint(Z), __float_as_uint(Z), false, false); Z = __uint_as_float(rr[0]) + __uint_as_float(rr[1]); }
  bf16x8 pa[5][2];
#pragma unroll
  for (int kb = 0; kb < 5; ++kb) { ATT_PK4(p[kb], 0, pa[kb][0]); ATT_PK4(p[kb], 8, pa[kb][1]); }
  f32x16 o[4] = {};
  const int vb = (int)(unsigned)(uintptr_t)vlds + v_rd_base(lane);
#pragma unroll
  for (int kb = 0; kb < 5; ++kb) {
    if (kb + 1 < 5) DIL_LDV(kb + 1, (kb + 1) & 1);
#pragma unroll
    for (int i = 0; i < 8; ++i) { const int id = lane + 64 * i, row = id >> 4, c = (id & 15) * 8;
      *reinterpret_cast<ATT_LAS bf16x8*>(vlds + v_st(row, c)) = vv[kb & 1][i]; }
    asm volatile("s_waitcnt lgkmcnt(0)" ::: "memory"); SBAR();
    pv32_one<0>(o[0], vb, pa[kb][0], pa[kb][1]); pv32_one<1>(o[1], vb, pa[kb][0], pa[kb][1]); pv32_one<2>(o[2], vb, pa[kb][0], pa[kb][1]); pv32_one<3>(o[3], vb, pa[kb][0], pa[kb][1]);
    SBAR();
  }
#undef DIL_LDV
#pragma unroll
  for (int rg = 0; rg < 16; ++rg) { const long row = r + d * (t0 + crow(rg, hi));
#pragma unroll
    for (int d0 = 0; d0 < 4; ++d0) st_o(&O[row * 768 + oc + d0 * 32 + r32], o[d0][rg]); }
  if (hi == 0) { const long row = r + d * (t0 + r32); typedef float f32x2_ __attribute__((ext_vector_type(2))); *(ATT_GAS f32x2_*)(ST + row * 12) = (f32x2_){m, Z}; }
}
template <int LDP>
__device__ __forceinline__ void dil_wg_unit(const bf16* __restrict__ P, int qc, int kc, int vc, int d, int r, int T0, int nT,
                                            OT* __restrict__ O, int oc, float* __restrict__ ST, ATT_LAS char* lds, const ATT_LAS float* bias2, const float C) {
  int tid_ = threadIdx.x; asm volatile("" : "+v"(tid_));
  const int tid = tid_, wid = __builtin_amdgcn_readfirstlane(tid >> 6), lane = tid & 63, r32 = lane & 31, hi = lane >> 5, t0 = T0 + 32 * wid;
  { bf16x8 kk[12];
#pragma unroll
    for (int i = 0; i < 12; ++i) { const int id = tid + 512 * i, row = id >> 4, c = (id & 15) * 8; int kt = T0 - 64 + row; kt = kt < 0 ? 0 : (kt > nT - 1 ? nT - 1 : kt);
      kk[i] = *(const ATT_GAS bf16x8*)(P + (long)(r + d * kt) * LDP + kc + c); }
#pragma unroll
    for (int i = 0; i < 12; ++i) { const int id = tid + 512 * i, row = id >> 4, cB = (id & 15) * 16;
      *reinterpret_cast<ATT_LAS bf16x8*>(lds + kswz<256>(row, cB)) = kk[i]; } }
  bf16x8 qr[8];
  { const bf16* qp = P + (long)(r + d * (t0 + r32)) * LDP + qc + hi * 8;
#pragma unroll
    for (int d0 = 0; d0 < 8; ++d0) qr[d0] = *(const ATT_GAS bf16x8*)(qp + d0 * 16); }
  __syncthreads();
  bf16x8 vv[12];
#pragma unroll
  for (int i = 0; i < 12; ++i) { const int id = tid + 512 * i, row = id >> 4, c = (id & 15) * 8; int kt = T0 - 64 + row; kt = kt < 0 ? 0 : (kt > nT - 1 ? nT - 1 : kt);
    vv[i] = *(const ATT_GAS bf16x8*)(P + (long)(r + d * kt) * LDP + vc + c); }
  f32x16 p[5];
#pragma unroll
  for (int kb = 0; kb < 5; ++kb) { const int krow = 32 * wid + 32 * kb + r32;
    p[kb] = f32x16{};
#pragma unroll
    for (int d0 = 0; d0 < 8; ++d0) { const bf16x8 kf = *reinterpret_cast<const ATT_LAS bf16x8*>(lds + kswz<256>(krow, (d0 * 16 + hi * 8) * 2));
      p[kb] = __builtin_amdgcn_mfma_f32_32x32x16_bf16(kf, qr[d0], p[kb], 0, 0, 0); } }
  float m = -1e30f;
  { const int a_ = 4 * hi - r32 + 32, k_ = a_ & 3; const ATT_LAS f32x4* tp = (const ATT_LAS f32x4*)(bias2 + k_ * 196 + (a_ - k_));
    const bool interior = (t0 >= 64) && (t0 + 96 <= nT);
#pragma unroll
    for (int kb = 0; kb < 5; ++kb)
#pragma unroll
      for (int g = 0; g < 4; ++g) { const f32x4 bv = tp[kb * 8 + 2 * g];
#pragma unroll
        for (int e = 0; e < 4; ++e) { const int rg = 4 * g + e; float s = fmaf(p[kb][rg], C, bv[e]);
          if (!interior) { const int kt = t0 - 64 + kb * 32 + crow(rg, hi); s = (kt >= 0 && kt < nT) ? s : -1e30f; }
          p[kb][rg] = s; m = fmaxf(m, s); } } }
  { auto rr = __builtin_amdgcn_permlane32_swap(__float_as_uint(m), __float_as_uint(m), false, false); m = fmaxf(__uint_as_float(rr[0]), __uint_as_float(rr[1])); }
  float Z = 0.f;
#pragma unroll
  for (int kb = 0; kb < 5; ++kb)
#pragma unroll
    for (int rg = 0; rg < 16; ++rg) { p[kb][rg] = __builtin_amdgcn_exp2f(p[kb][rg] - m); Z += p[kb][rg]; }
  { auto rr = __builtin_amdgcn_permlane32_swap(__float_as_uint(Z), __float_as_uint(Z), false, false); Z = __uint_as_float(rr[0]) + __uint_as_float(rr[1]); }
  bf16x8 pa[5][2];
#pragma unroll
  for (int kb = 0; kb < 5; ++kb) { ATT_PK4(p[kb], 0, pa[kb][0]); ATT_PK4(p[kb], 8, pa[kb][1]); }
  __syncthreads();
#pragma unroll
  for (int i = 0; i < 12; ++i) { const int id = tid + 512 * i, row = id >> 4, c = (id & 15) * 8;
    *reinterpret_cast<ATT_LAS bf16x8*>(lds + (row >> 5) * 8192 + v_st(row & 31, c)) = vv[i]; }
  __syncthreads();
  f32x16 o[4] = {};
#pragma unroll
  for (int kb = 0; kb < 5; ++kb) { const int vb = (int)(unsigned)(uintptr_t)lds + (wid + kb) * 8192 + v_rd_base(lane);
    pv32_one<0>(o[0], vb, pa[kb][0], pa[kb][1]); pv32_one<1>(o[1], vb, pa[kb][0], pa[kb][1]); pv32_one<2>(o[2], vb, pa[kb][0], pa[kb][1]); pv32_one<3>(o[3], vb, pa[kb][0], pa[kb][1]); }
#pragma unroll
  for (int rg = 0; rg < 16; ++rg) { const long row = r + d * (t0 + crow(rg, hi));
#pragma unroll
    for (int d0 = 0; d0 < 4; ++d0) st_o(&O[row * 768 + oc + d0 * 32 + r32], o[d0][rg]); }
  if (hi == 0) { const long row = r + d * (t0 + r32); typedef float f32x2_ __attribute__((ext_vector_type(2))); *(ATT_GAS f32x2_*)(ST + row * 12) = (f32x2_){m, Z}; }
  __syncthreads();
}

#if defined(MLA_DMA) && MLA_DMA == 2
#define MLA_BODY attn_pipe192_body
#elif defined(MLA_DMA) && MLA_DMA
#define MLA_BODY attn_dma_body
#else
template <int LDQ, int LDK, int LDO> __device__ __forceinline__ void attn_simple192(const bf16* Qb, const bf16* Kh, const bf16* Kr, const bf16* Vh, const float* cs, OT* Ob, int seq, const float scale, ATT_LAS char* lds) { attn_simple_body<192, LDQ, LDK, LDO>(Qb, Kh, Kr, Vh, cs, Ob, seq, scale, lds); }
#define MLA_BODY attn_simple192
#endif
}
constexpr int S = 8192, D = 2048, NMEM = 256;
constexpr int DIN = 3392, DINP = 3584;
constexpr int PC_DIL = 768, PC_MEM = 3072;
constexpr int QR = 384, KVR = 128, AQ = 512;
constexpr int NUP = 2816;
constexpr int UC_KV = 1280;
constexpr int DFF = 5632, DFE = 7168, NE = 8;
constexpr int MP = 18432;
constexpr float EPS = 1e-6f;
constexpr int NWAVES = 8;

constexpr size_t al256(size_t x) { return (x + 255) / 256 * 256; }
constexpr size_t WS_CTL = 0, CTL_ZERO_BYTES = 1u << 20;
constexpr size_t WS_WIN = WS_CTL + CTL_ZERO_BYTES;
constexpr size_t WS_WUP = WS_WIN + al256((size_t)2 * DINP * D * 2);
constexpr size_t WS_WMEM = WS_WUP + al256((size_t)2 * NUP * AQ * 2);
constexpr size_t WS_WOUT = WS_WMEM + al256((size_t)2 * 1024 * D * 2);
constexpr size_t WS_WGU = WS_WOUT + al256((size_t)2 * D * D * 2);
constexpr size_t WS_WDN = WS_WGU + al256((size_t)2 * DFF * D * 2);
constexpr size_t WS_MGU = WS_WDN + al256((size_t)D * DFF * 2);
constexpr size_t WS_MDN = WS_MGU + al256((size_t)NE * 2 * DFE * D * 2);
constexpr size_t WS_XN = WS_MDN + al256((size_t)NE * D * DFE * 2);
constexpr size_t WS_MEMN = WS_XN + al256((size_t)S * D * 2);
constexpr size_t WS_MEMKV = WS_MEMN + al256((size_t)2 * NMEM * D * 2);
constexpr size_t WS_PROJ = WS_MEMKV + al256((size_t)2 * NMEM * 1024 * 2);
constexpr size_t WS_AQKV = WS_PROJ + al256((size_t)S * DINP * 2);
constexpr size_t WS_KROPE = WS_AQKV + al256((size_t)S * AQ * 2);
constexpr size_t WS_ROPECS = WS_KROPE + al256((size_t)S * 64 * 2);
constexpr size_t WS_QKVM = WS_ROPECS + al256((size_t)S * 64 * 4);
constexpr size_t WS_YPRE = WS_QKVM + al256((size_t)S * NUP * 2);
constexpr size_t WS_DILO = WS_YPRE + al256((size_t)S * D * 4);
constexpr size_t WS_DILS = WS_DILO + al256((size_t)3 * S * 768 * 4);
constexpr size_t WS_Y = WS_DILS + al256((size_t)3 * S * 12 * 4);
constexpr size_t WS_XA = WS_Y + al256((size_t)S * D * 2);
constexpr size_t WS_ROUTE = WS_XA + al256((size_t)S * D * 4);
constexpr size_t WS_XP = WS_ROUTE + al256((size_t)S * 32);
constexpr size_t WS_OUTP = WS_XP + al256((size_t)MP * D * 2);
constexpr size_t WS_ACTP = WS_OUTP + al256((size_t)MP * D * 2);
constexpr size_t WS_OUTQ = WS_ACTP + al256((size_t)MP * DFE * 2);
constexpr size_t WS_END = WS_OUTQ + al256((size_t)4 * 2048 * D * 2);
static_assert(WS_END <= 1879048192ull, "workspace map exceeds 4 x the largest input");
constexpr int CW_BAR = 16384;
constexpr int CW_QUEUE = 8192;
constexpr int CW_CNT = 8192 + 256;
constexpr int CW_QUEUE2 = 65536;
constexpr int CW_CVT = 8192 + 320;
constexpr int CW_DONE = 8192 + 384;
constexpr int CW_CNTW = 53248;
constexpr int CW_TS = 12288;
constexpr int CW_TILEE = 8192 + 512;
constexpr int RING_BYTES = 131072;
constexpr int LDSCTL_OFF = RING_BYTES, MISC_OFF = LDSCTL_OFF + 320;
constexpr int BIAS_OFF = 132096;
constexpr int LDS_BYTES = 147456;
static_assert(BIAS_OFF >= MISC_OFF + 128 && BIAS_OFF + 3 * 6 * 132 * 4 + 4 * 196 * 4 <= LDS_BYTES, "LDS map");

#define GAS __attribute__((address_space(1)))
#define LAS __attribute__((address_space(3)))
typedef unsigned short bf16;
typedef unsigned v4u __attribute__((ext_vector_type(4)));
typedef unsigned v2u __attribute__((ext_vector_type(2)));
typedef float f32x4 __attribute__((ext_vector_type(4)));
typedef short bf16x8 __attribute__((ext_vector_type(8)));
typedef GAS unsigned gu32;
#define RLX_AGENT __ATOMIC_RELAXED, __HIP_MEMORY_SCOPE_AGENT
#define LDS_WAIT() asm volatile("s_waitcnt lgkmcnt(0)" ::: "memory")
#define VM_WAIT() asm volatile("s_waitcnt vmcnt(0)" ::: "memory")
__device__ __forceinline__ unsigned f2bf(float f) { unsigned u = __builtin_bit_cast(unsigned, f); return (u + 0x7fffu + ((u >> 16) & 1u)) >> 16; }
__device__ __forceinline__ unsigned pk2(float lo, float hi) { return f2bf(lo) | (f2bf(hi) << 16); }
__device__ __forceinline__ float bflo(unsigned w) { return __uint_as_float(w << 16); }
__device__ __forceinline__ float bfhi(unsigned w) { return __uint_as_float(w & 0xffff0000u); }

#ifndef BAR_FLAGS
#define BAR_FLAGS 1
#endif
#define XB_TMO      128
#define XB_XCNT(j)  (256  + 64 * (j))
#define XB_XSUB(j)  (1280 + 64 * (j))
#define XB_XGEN(j)  (2304 + 64 * (j))
#define XB_TOP      3328
#define XB_TOPGEN   3392
#define XCD_BAR_WORDS 3456
#define XB_SPIN_CAP (1u << 18)
__device__ __forceinline__ unsigned xb_ld(unsigned* p)              { return __hip_atomic_load(p, __ATOMIC_RELAXED, __HIP_MEMORY_SCOPE_AGENT); }
__device__ __forceinline__ unsigned xb_add(unsigned* p, unsigned v) { return __hip_atomic_fetch_add(p, v, __ATOMIC_RELAXED, __HIP_MEMORY_SCOPE_AGENT); }
__device__ __forceinline__ unsigned xb_xcc_id() { return (unsigned)__builtin_amdgcn_s_getreg((3 << 11) | 20) & 0xFu; }
#define XB_SPIN(cond, bar) do { unsigned _sp = 0; while (cond) { __builtin_amdgcn_s_sleep(1); \
    if ((++_sp & 255u) == 0u) { if (xb_ld(&(bar)[XB_TMO])) break; if (_sp > XB_SPIN_CAP) { atomicAdd(&(bar)[XB_TMO], 1u); break; } } } } while (0)
struct XcdBarrier { unsigned* bar; unsigned x; volatile LAS unsigned* st; };
__device__ __forceinline__ XcdBarrier xcd_barrier_post(unsigned* bar, volatile LAS unsigned* st) {
    XcdBarrier b; b.bar = bar; b.x = xb_xcc_id(); b.st = st;
    if (threadIdx.x == 0) (void)xb_add(&bar[XB_XCNT(b.x)], 1u);
    return b;
}
__device__ __forceinline__ void xcd_barrier_complete(unsigned* bar, unsigned x, unsigned& nloc, unsigned& nx, unsigned& mask) {
    const unsigned G = gridDim.x * gridDim.y * gridDim.z;
    unsigned sum, cnt, mine, msk, sp = 0u;
    for (;;) {
        sum = 0u; cnt = 0u; mine = 0u; msk = 0u;
#pragma unroll
        for (unsigned j = 0; j < 16; ++j) { const unsigned c = xb_ld(&bar[XB_XCNT(j)]); sum += c; cnt += (c > 0u) ? 1u : 0u; msk |= (c > 0u) ? (1u << j) : 0u; mine = (j == x) ? c : mine; }
        if (sum == G) break;
        __builtin_amdgcn_s_sleep(1);
        if ((++sp & 255u) == 0u) { if (xb_ld(&bar[XB_TMO])) break; if (sp > XB_SPIN_CAP) { atomicAdd(&bar[XB_TMO], 1u); break; } }
    }
    nloc = mine > 0u ? mine : 1u; nx = cnt > 0u ? cnt : 1u; mask = msk;
}
#if BAR_FLAGS
#define XB_XFLAG(j) (3456 + (j))
template <int MODE = 0>
__device__ __forceinline__ void xcd_barrier(const XcdBarrier& b) {
    asm volatile("s_waitcnt vmcnt(0)" ::: "memory");
    __syncthreads();
    if (threadIdx.x < 64) {
        unsigned* bar = b.bar; const unsigned lane = threadIdx.x;
        unsigned gen1 = 0u, mask = 0u; bool leader = false;
        if (lane == 0) {
            __builtin_amdgcn_s_waitcnt(0);
#if BAR_FLAGS == 2
            asm volatile("buffer_inv sc1" ::: "memory");
#endif
            unsigned nloc = b.st[0], nx = b.st[1]; mask = b.st[2];
            if (nloc == 0u) { xcd_barrier_complete(bar, b.x, nloc, nx, mask); b.st[0] = nloc; b.st[1] = nx; b.st[2] = mask; }
            const unsigned old = xb_add(&bar[XB_XSUB(b.x)], 1u);
            const unsigned gen = old / nloc; gen1 = gen + 1u;
            if (old + 1u == gen1 * nloc) { leader = true;
                if (!(MODE & 1)) __builtin_amdgcn_fence(__ATOMIC_RELEASE, "agent");
                asm volatile("s_waitcnt vmcnt(0)" ::: "memory");
#if BAR_FLAGS == 2
                asm volatile("buffer_inv sc1\n\ts_waitcnt vmcnt(0)" ::: "memory");
#endif
                __hip_atomic_store(&bar[XB_XFLAG(b.x)], gen1, __ATOMIC_RELAXED, __HIP_MEMORY_SCOPE_AGENT);
            }
        }
        gen1 = (unsigned)__builtin_amdgcn_readfirstlane((int)gen1); mask = (unsigned)__builtin_amdgcn_readfirstlane((int)mask);
        unsigned sp = 0u;
        for (;;) {
            bool ok = true;
            if (lane < 16) { const unsigned f = xb_ld(&bar[XB_XFLAG(lane)]); ok = (((mask >> lane) & 1u) == 0u) || ((int)(f - gen1) >= 0); }
            if (__all(ok)) break;
            __builtin_amdgcn_s_sleep(1);
            if ((++sp & 255u) == 0u) { if (xb_ld(&bar[XB_TMO])) break; if (sp > XB_SPIN_CAP) { if (lane == 0) atomicAdd(&bar[XB_TMO], 1u); break; } }
        }
#if BAR_FLAGS != 2
        if (!(MODE & 2)) { if (!(MODE & 4) || __builtin_amdgcn_readfirstlane((int)leader)) __builtin_amdgcn_fence(__ATOMIC_ACQUIRE, "agent"); }
#endif
        asm volatile("s_waitcnt vmcnt(0)" ::: "memory");
    }
    __syncthreads();
}
#else
__device__ __forceinline__ void xcd_barrier(const XcdBarrier& b) {
    asm volatile("s_waitcnt vmcnt(0)" ::: "memory");
    __syncthreads();
    if (threadIdx.x == 0) {
        unsigned* bar = b.bar;
        __builtin_amdgcn_s_waitcnt(0);
        unsigned nloc = b.st[0], nx = b.st[1], mask_;
        if (nloc == 0u) { xcd_barrier_complete(bar, b.x, nloc, nx, mask_); b.st[0] = nloc; b.st[1] = nx; }
        const unsigned old = xb_add(&bar[XB_XSUB(b.x)], 1u);
        const unsigned gen = old / nloc;
        if (old + 1u == (gen + 1u) * nloc) {
            __builtin_amdgcn_fence(__ATOMIC_RELEASE, "agent");
            asm volatile("s_waitcnt vmcnt(0)" ::: "memory");
            const unsigned og = xb_add(&bar[XB_TOP], 1u);
            const unsigned tg = og / nx;
            if (og + 1u == (tg + 1u) * nx) xb_add(&bar[XB_TOPGEN], 1u);
            else XB_SPIN(xb_ld(&bar[XB_TOPGEN]) == tg, bar);
            __builtin_amdgcn_fence(__ATOMIC_ACQUIRE, "agent");
            xb_add(&bar[XB_XGEN(b.x)], 1u);
            asm volatile("s_waitcnt vmcnt(0)" ::: "memory");
        } else {
            XB_SPIN(xb_ld(&bar[XB_XGEN(b.x)]) == gen, bar);
            __builtin_amdgcn_fence(__ATOMIC_ACQUIRE, "agent");
            asm volatile("s_waitcnt vmcnt(0)" ::: "memory");
        }
    }
    __syncthreads();
}
#endif

struct Args {
    const float* in[23]; float* out; unsigned char* ws;
    float invf[32];
    int ph_lo, ph_hi, li, rep;
};
struct Frame {
    LAS unsigned char* lds;
    volatile LAS unsigned* MISC;
    gu32* ctl;
    int tid, lane, wave, G, gw, NGW;
    unsigned char* ws;
};
__device__ __forceinline__ float wave_sum(float v) {
#pragma unroll
    for (int o = 1; o < 64; o <<= 1) v += __shfl_xor(v, o);
    return v;
}
__device__ __forceinline__ float wave_max(float v) {
#pragma unroll
    for (int o = 1; o < 64; o <<= 1) v = fmaxf(v, __shfl_xor(v, o));
    return v;
}

__device__ __forceinline__ unsigned pk4_fp8(float a, float b, float c, float d) { int w = 0; w = __builtin_amdgcn_cvt_pk_fp8_f32(a, b, w, false); w = __builtin_amdgcn_cvt_pk_fp8_f32(c, d, w, true); return (unsigned)w; }
#if defined(CVT_REG) && CVT_REG
__device__ __forceinline__ void cvt_load(const float* __restrict__ W, int N, int k0, int n0, int lane, f32x4 (&v)[8]) {
    const GAS float* p = (const GAS float*)(W + (size_t)(k0 + (lane >> 5) * 32) * N + n0 + (lane & 31));
#pragma unroll
    for (int i = 0; i < 8; ++i)
#pragma unroll
        for (int e = 0; e < 4; ++e) v[i][e] = __builtin_nontemporal_load(p + (size_t)(i * 4 + e) * N);
}
template <bool FP8>
__device__ __forceinline__ void cvt_finish(const f32x4 (&v)[8], int k0, void* __restrict__ dstv, int ldd, int drow0, int kdst0, LAS float* scr, int lane, float wsc) {
    const int n = lane & 31, kh = (lane >> 5) * 32;
    if constexpr (FP8) { GAS v4u* d = (GAS v4u*)((unsigned char*)dstv + (size_t)(drow0 + n) * ldd + kdst0 + k0 + kh);
#pragma unroll
        for (int j = 0; j < 2; ++j) { v4u o;
            o.x = pk4_fp8(v[4 * j][0] * wsc, v[4 * j][1] * wsc, v[4 * j][2] * wsc, v[4 * j][3] * wsc); o.y = pk4_fp8(v[4 * j + 1][0] * wsc, v[4 * j + 1][1] * wsc, v[4 * j + 1][2] * wsc, v[4 * j + 1][3] * wsc);
            o.z = pk4_fp8(v[4 * j + 2][0] * wsc, v[4 * j + 2][1] * wsc, v[4 * j + 2][2] * wsc, v[4 * j + 2][3] * wsc); o.w = pk4_fp8(v[4 * j + 3][0] * wsc, v[4 * j + 3][1] * wsc, v[4 * j + 3][2] * wsc, v[4 * j + 3][3] * wsc);
            __builtin_nontemporal_store(o, d + j); } }
    else { GAS v4u* d = (GAS v4u*)((bf16*)dstv + (size_t)(drow0 + n) * ldd + kdst0 + k0 + kh);
#pragma unroll
        for (int j = 0; j < 4; ++j) { v4u o; o.x = pk2(v[2 * j][0], v[2 * j][1]); o.y = pk2(v[2 * j][2], v[2 * j][3]); o.z = pk2(v[2 * j + 1][0], v[2 * j + 1][1]); o.w = pk2(v[2 * j + 1][2], v[2 * j + 1][3]);
            __builtin_nontemporal_store(o, d + j); } }
}
#else
__device__ __forceinline__ void cvt_load(const float* __restrict__ W, int N, int k0, int n0, int lane, f32x4 (&v)[8]) {
    const int lr = lane >> 3, lc = (lane & 7) * 4;
#pragma unroll
    for (int i = 0; i < 8; ++i) v[i] = __builtin_nontemporal_load((const GAS f32x4*)(W + (size_t)(k0 + i * 8 + lr) * N + n0 + lc));
}
template <bool FP8, bool GAIN = false>
__device__ __forceinline__ void cvt_finish(const f32x4 (&v)[8], int k0, void* __restrict__ dstv, int ldd, int drow0, int kdst0, LAS float* scr, int lane, float wsc, const float* gk = nullptr) {
    const int lr = lane >> 3, lc = (lane & 7) * 4;
#pragma unroll
    for (int i = 0; i < 8; ++i) { LAS float* s = scr + (i * 8 + lr) * 33 + lc; s[0] = v[i][0]; s[1] = v[i][1]; s[2] = v[i][2]; s[3] = v[i][3]; }
    LDS_WAIT(); asm volatile("" ::: "memory");
    const int c = lane & 7;
    float gw[8];
    if constexpr (GAIN) { const f32x4 ga = *(const GAS f32x4*)(gk + k0 + 8 * c), gb = *(const GAS f32x4*)(gk + k0 + 8 * c + 4);
        gw[0] = ga.x * wsc; gw[1] = ga.y * wsc; gw[2] = ga.z * wsc; gw[3] = ga.w * wsc; gw[4] = gb.x * wsc; gw[5] = gb.y * wsc; gw[6] = gb.z * wsc; gw[7] = gb.w * wsc; }
    else {
#pragma unroll
        for (int i = 0; i < 8; ++i) gw[i] = wsc; }
#pragma unroll
    for (int j = 0; j < 4; ++j) { const int n = (lane >> 3) + 8 * j; const LAS float* s = scr + (8 * c) * 33 + n;
        if constexpr (FP8) { v2u o; o.x = pk4_fp8(s[0 * 33] * gw[0], s[1 * 33] * gw[1], s[2 * 33] * gw[2], s[3 * 33] * gw[3]); o.y = pk4_fp8(s[4 * 33] * gw[4], s[5 * 33] * gw[5], s[6 * 33] * gw[6], s[7 * 33] * gw[7]);
            __builtin_nontemporal_store(o, (GAS v2u*)((unsigned char*)dstv + (size_t)(drow0 + n) * ldd + kdst0 + k0 + 8 * c)); }
        else if constexpr (GAIN) { v4u o; o.x = pk2(s[0 * 33] * gw[0], s[1 * 33] * gw[1]); o.y = pk2(s[2 * 33] * gw[2], s[3 * 33] * gw[3]); o.z = pk2(s[4 * 33] * gw[4], s[5 * 33] * gw[5]); o.w = pk2(s[6 * 33] * gw[6], s[7 * 33] * gw[7]);
            __builtin_nontemporal_store(o, (GAS v4u*)((bf16*)dstv + (size_t)(drow0 + n) * ldd + kdst0 + k0 + 8 * c)); }
        else { v4u o; o.x = pk2(s[0 * 33], s[1 * 33]); o.y = pk2(s[2 * 33], s[3 * 33]); o.z = pk2(s[4 * 33], s[5 * 33]); o.w = pk2(s[6 * 33], s[7 * 33]);
            __builtin_nontemporal_store(o, (GAS v4u*)((bf16*)dstv + (size_t)(drow0 + n) * ldd + kdst0 + k0 + 8 * c)); } }
    LDS_WAIT(); asm volatile("" ::: "memory");
}
#endif
__device__ __forceinline__ int cvt_drow(int mode, int n0, int roff) { return mode == 0 ? n0 + roff : (mode == 1 ? (n0 >> 7) * 256 + (n0 & 127) : (mode == 2 ? (n0 >> 7) * 256 + 128 + (n0 & 127) : (n0 < 576 ? n0 : n0 + 192))); }
template <bool FP8, bool GAIN = false>
__device__ __forceinline__ void cvt_job(Frame& F, const float* W, int K, int N, void* dst, int ldd, int kdst0, int mode, int roff, LAS float* scr, float wsc, const float* gk = nullptr) {
    const int nnb = N / 32, nitems = (K / 64) * nnb;
    int it = F.gw; if (it >= nitems) return;
    f32x4 va[8], vb[8];
    cvt_load(W, N, (it / nnb) * 64, (it % nnb) * 32, F.lane, va);
    for (;;) {
        const int it1 = it + F.NGW; if (it1 < nitems) cvt_load(W, N, (it1 / nnb) * 64, (it1 % nnb) * 32, F.lane, vb);
        cvt_finish<FP8, GAIN>(va, (it / nnb) * 64, dst, ldd, cvt_drow(mode, (it % nnb) * 32, roff), kdst0, scr, F.lane, wsc, gk);
        if (it1 >= nitems) break;
        const int it2 = it1 + F.NGW; if (it2 < nitems) cvt_load(W, N, (it2 / nnb) * 64, (it2 % nnb) * 32, F.lane, va);
        cvt_finish<FP8, GAIN>(vb, (it1 / nnb) * 64, dst, ldd, cvt_drow(mode, (it1 % nnb) * 32, roff), kdst0, scr, F.lane, wsc, gk);
        if (it2 >= nitems) break;
        it = it2;
    }
}
__device__ __forceinline__ void rms_row_to_bf16(const float* xrow, const float* g, bf16* orow, int lane) {
    const GAS f32x4* xr = (const GAS f32x4*)xrow + lane; const GAS f32x4* gr = (const GAS f32x4*)g + lane;
    f32x4 v[8]; float s = 0.f;
#pragma unroll
    for (int j = 0; j < 8; ++j) { v[j] = xr[64 * j]; s += (v[j].x * v[j].x + v[j].y * v[j].y) + (v[j].z * v[j].z + v[j].w * v[j].w); }
    const float rstd = 1.f / sqrtf(wave_sum(s) * (1.f / D) + EPS);
    GAS v2u* o8 = (GAS v2u*)orow + lane;
#pragma unroll
    for (int j = 0; j < 8; ++j) { const f32x4 gg = gr[64 * j]; v2u w; w.x = pk2(v[j].x * rstd * gg.x, v[j].y * rstd * gg.y); w.y = pk2(v[j].z * rstd * gg.z, v[j].w * rstd * gg.w); o8[64 * j] = w; }
}
__device__ __forceinline__ void rms_row_to_fp8(const float* xrow, const float* g, unsigned char* orow, int lane) {
    const GAS f32x4* xr = (const GAS f32x4*)xrow + lane; const GAS f32x4* gr = (const GAS f32x4*)g + lane;
    f32x4 v[8]; float s = 0.f;
#pragma unroll
    for (int j = 0; j < 8; ++j) { v[j] = xr[64 * j]; s += (v[j].x * v[j].x + v[j].y * v[j].y) + (v[j].z * v[j].z + v[j].w * v[j].w); }
    const float rstd = 1.f / sqrtf(wave_sum(s) * (1.f / D) + EPS);
    GAS unsigned* o4 = (GAS unsigned*)orow + lane;
#pragma unroll
    for (int j = 0; j < 8; ++j) { const f32x4 gg = gr[64 * j]; o4[64 * j] = pk4_fp8(v[j].x * rstd * gg.x, v[j].y * rstd * gg.y, v[j].z * rstd * gg.z, v[j].w * rstd * gg.w); }
}
__device__ __forceinline__ void sincos_f64(float ang, float& c, float& s) {
    const double a = (double)ang, twopi = 6.283185307179586476925286766559, inv2pi = 0.15915494309189533576888376337251;
    const double q = __builtin_rint(a * inv2pi); const double r = a - q * twopi;
    const double r2 = r * r; double ss = 1.0, cc = 1.0;
#pragma unroll
    for (int k = 14; k >= 1; --k) { ss = 1.0 - r2 * (1.0 / (double)((2 * k) * (2 * k + 1))) * ss; cc = 1.0 - r2 * (1.0 / (double)((2 * k - 1) * (2 * k))) * cc; }
    s = (float)(r * ss); c = (float)cc;
}
__device__ const unsigned char DIL_BUCKET[3][129] = {
 {11,11,11,11,11,11,11,11,11,11,11,11,11,11,11,10,10,10,10,10,10,10,10,10,10,10,10,10,10,10,10,10,10,10,10,10,10,10,9,9,9,9,9,9,9,9,9,9,9,9,8,8,8,8,8,8,8,7,6,5,4,3,2,1,0,17,18,19,20,21,22,23,24,24,24,24,24,24,24,25,25,25,25,25,25,25,25,25,25,25,25,26,26,26,26,26,26,26,26,26,26,26,26,26,26,26,26,26,26,26,26,26,26,26,27,27,27,27,27,27,27,27,27,27,27,27,27,27,27},
 {13,13,13,13,13,13,13,13,13,13,13,13,13,13,13,13,13,13,13,13,13,13,13,12,12,12,12,12,12,12,12,12,12,12,12,12,12,12,12,12,12,12,11,11,11,11,11,11,11,11,11,11,10,10,10,10,10,10,9,9,9,8,8,4,0,20,24,24,25,25,25,26,26,26,26,26,26,27,27,27,27,27,27,27,27,27,27,28,28,28,28,28,28,28,28,28,28,28,28,28,28,28,28,28,28,28,29,29,29,29,29,29,29,29,29,29,29,29,29,29,29,29,29,29,29,29,29,29,29},
 {15,15,15,15,15,15,15,15,15,15,15,15,15,15,15,15,15,15,15,15,15,15,15,15,15,15,15,15,15,15,14,14,14,14,14,14,14,14,14,14,14,14,14,14,14,13,13,13,13,13,13,13,13,13,12,12,12,12,12,11,11,10,10,9,0,25,26,26,27,27,28,28,28,28,28,29,29,29,29,29,29,29,29,29,30,30,30,30,30,30,30,30,30,30,30,30,30,30,30,31,31,31,31,31,31,31,31,31,31,31,31,31,31,31,31,31,31,31,31,31,31,31,31,31,31,31,31,31,31}};

typedef float f32x2 __attribute__((ext_vector_type(2)));
#ifndef FOLD_PRE
#define FOLD_PRE 1
#endif
#ifndef MLA_XCD_STATIC
#define MLA_XCD_STATIC 1
#endif
#ifndef UP_EXACT
#define UP_EXACT 1
#endif
#ifndef PRE_ROWS
#define PRE_ROWS 4
#endif
#ifndef COMB_ROWS
#define COMB_ROWS 2
#endif
__device__ __forceinline__ f32x4 ld_r4(const float* p) { return *(const GAS f32x4*)p; }
__device__ __forceinline__ v2u ld_r4(const unsigned short* p) { return *(const GAS v2u*)p; }
__device__ __forceinline__ f32x4 cv4(f32x4 r) { return r; }
__device__ __forceinline__ f32x4 cv4(v2u w) { return (f32x4){bflo(w.x), bfhi(w.x), bflo(w.y), bfhi(w.y)}; }
__device__ __forceinline__ f32x4 ld_o4(const float* p) { return *(const GAS f32x4*)p; }
__device__ __forceinline__ f32x4 ld_o4(const unsigned short* p) { const v2u w = *(const GAS v2u*)p; return (f32x4){bflo(w.x), bfhi(w.x), bflo(w.y), bfhi(w.y)}; }
#ifndef CVT_CHUNK
#define CVT_CHUNK 64
#endif
#ifndef PH_MASK
#define PH_MASK 0xFFFFu
#endif
#ifndef REPEAT_PHASE
#define REPEAT_PHASE -1
#endif
#ifndef ATT_EN
#define ATT_EN 7
#endif
#define PEN(k) ((PH_MASK >> (k)) & 1u)
#ifndef FFN_FP8
#define FFN_FP8 3
#endif
constexpr bool F8D = (FFN_FP8 & 1) != 0, F8M = (FFN_FP8 & 2) != 0;
constexpr int EBD = F8D ? 1 : 2, EBM = F8M ? 1 : 2;
template <bool B> struct Sc { static constexpr float w_gu = B ? 32.f : 1.f, w_dn = B ? 64.f : 1.f, a_sc = B ? 4.f : 1.f, dn = 1.f / (w_dn * a_sc); };
template <bool B> using FfnEpi1 = typename std::conditional<B, pg8::EpiSwiGLU8, pg8::EpiSwiGLU>::type;
template <bool B> struct Epi1Maker;
template <> struct Epi1Maker<true> { static __device__ __forceinline__ pg8::EpiSwiGLU8 make(void* O, int ldc) { return pg8::EpiSwiGLU8{(unsigned char*)O, ldc, 1.f / Sc<true>::w_gu, Sc<true>::a_sc}; } };
template <> struct Epi1Maker<false> { static __device__ __forceinline__ pg8::EpiSwiGLU make(void* O, int ldc) { return pg8::EpiSwiGLU{(unsigned short*)O, ldc}; } };

constexpr int MOE_MAT_ITEMS = 7168, MOE_GU_ITEMS = 16 * MOE_MAT_ITEMS, MOE_NITEMS = 24 * MOE_MAT_ITEMS, MOE_CHUNK = CVT_CHUNK, MOE_NCHUNK = MOE_NITEMS / MOE_CHUNK;
struct MoeItem { const float* W; void* dst; int N, k0, n0, ldd, drow0; float wsc; };
typedef const __attribute__((address_space(4))) Args* KArgs;
__device__ __forceinline__ MoeItem moe_item(KArgs ka, unsigned char* ws, int idx) {
    MoeItem m;
    if (idx < MOE_GU_ITEMS) { const int mat = idx / MOE_MAT_ITEMS, local = idx % MOE_MAT_ITEMS, e = mat >> 1, up = mat & 1, kb = local / (DFE / 32), nb = local % (DFE / 32);
        m.W = ka->in[19 + up] + (size_t)e * D * DFE; m.N = DFE; m.k0 = kb * 64; m.n0 = nb * 32; m.dst = ws + WS_MGU + (size_t)e * 2 * DFE * D * EBM; m.ldd = D;
        m.drow0 = (m.n0 >> 7) * 256 + up * 128 + (m.n0 & 127); m.wsc = Sc<F8M>::w_gu; }
    else { const int i2 = idx - MOE_GU_ITEMS, e = i2 / MOE_MAT_ITEMS, local = i2 % MOE_MAT_ITEMS, kb = local / (D / 32), nb = local % (D / 32);
        m.W = ka->in[21] + (size_t)e * DFE * D; m.N = D; m.k0 = kb * 64; m.n0 = nb * 32; m.dst = ws + WS_MDN + (size_t)e * D * DFE * EBM; m.ldd = DFE; m.drow0 = m.n0; m.wsc = Sc<F8M>::w_dn; }
    return m;
}
__device__ __forceinline__ void moe_cvt_chunk(Frame& F, KArgs ka, int c) {
    LAS float* scr = (LAS float*)(F.lds + F.wave * 16384);
    const int i0 = c * MOE_CHUNK + F.wave * (MOE_CHUNK / 8);
    f32x4 va[8], vb[8], vc[8]; MoeItem ma, mb, mc;
#define MC_L(m, v, i) do { m = moe_item(ka, F.ws, i0 + (i)); cvt_load(m.W, m.N, m.k0, m.n0, F.lane, v); } while (0)
#define MC_F(m, v) cvt_finish<F8M>(v, m.k0, m.dst, m.ldd, m.drow0, 0, scr, F.lane, m.wsc)
    MC_L(ma, va, 0); MC_L(mb, vb, 1); MC_L(mc, vc, 2);
    if constexpr (MOE_CHUNK == 64) {
        MC_F(ma, va); MC_L(ma, va, 3); MC_F(mb, vb); MC_L(mb, vb, 4); MC_F(mc, vc); MC_L(mc, vc, 5);
        MC_F(ma, va); MC_L(ma, va, 6); MC_F(mb, vb); MC_L(mb, vb, 7); MC_F(mc, vc); MC_F(ma, va); MC_F(mb, vb);
    } else {
        MC_F(ma, va); MC_L(ma, va, 3); MC_F(mb, vb); MC_F(mc, vc); MC_F(ma, va);
    }
#undef MC_L
#undef MC_F
}
__device__ __forceinline__ void moe_cvt_fill(Frame& F, KArgs ka, int ph) {
    { int t_ = threadIdx.x; asm volatile("" : "+v"(t_)); F.tid = t_; F.lane = t_ & 63; }
    for (;;) {
        if (F.tid == 0) { unsigned c = MOE_NCHUNK;
            if (ph < 0 || __hip_atomic_load(F.ctl + CW_DONE + ph, RLX_AGENT) < (unsigned)F.G) c = __hip_atomic_fetch_add(F.ctl + CW_CVT + (ph == -2 ? 16 : 0), 1u, RLX_AGENT);
            F.MISC[17] = c; }
        __syncthreads(); const unsigned c = F.MISC[17]; __syncthreads();
        if (c >= (unsigned)MOE_NCHUNK) break;
        moe_cvt_chunk(F, ka, (int)c);
    }
}
template <int NCH>
__device__ __forceinline__ void up_rs_rows(Frame& F, const bf16* base, int ui, float invk) {
    LAS float* RS = (LAS float*)(F.lds + BIAS_OFF); const int r8 = F.lane >> 3, part = F.lane & 7;
    v4u w[4][NCH];
#pragma unroll
    for (int it = 0; it < 4; ++it) { const bf16* pr = base + (size_t)(F.wave * 32 + it * 8 + r8) * DINP + part * 8;
#pragma unroll
        for (int j = 0; j < NCH; ++j) w[it][j] = *(const GAS v4u*)(pr + 64 * j); }
#pragma unroll
    for (int it = 0; it < 4; ++it) { float sq = 0.f;
#pragma unroll
        for (int j = 0; j < NCH; ++j) { const v4u t = w[it][j];
            const float a0 = bflo(t.x), a1 = bfhi(t.x), a2 = bflo(t.y), a3 = bfhi(t.y), a4 = bflo(t.z), a5 = bfhi(t.z), a6 = bflo(t.w), a7 = bfhi(t.w);
            sq += ((a0 * a0 + a1 * a1) + (a2 * a2 + a3 * a3)) + ((a4 * a4 + a5 * a5) + (a6 * a6 + a7 * a7)); }
        sq += __shfl_xor(sq, 1); sq += __shfl_xor(sq, 2); sq += __shfl_xor(sq, 4);
        if (part == 0) RS[ui * 256 + F.wave * 32 + it * 8 + r8] = 1.f / sqrtf(sq * invk + EPS); }
}
#define FILL(ph) do { __syncthreads(); if (F.tid == 0) (void)__hip_atomic_fetch_add(F.ctl + CW_DONE + (ph), 1u, RLX_AGENT); moe_cvt_fill(F, ka, (ph)); } while (0)
#ifndef MLA_DMA
#define MLA_DMA 1
#endif
#ifndef MOE_TAIL
#define MOE_TAIL 1
#endif
#ifndef GEMM_SP2
#define GEMM_SP2 1
#endif
constexpr bool SP2V = (GEMM_SP2 != 0);
#ifndef PROBE_ATT
#define PROBE_ATT 7
#endif
#ifndef FILLMASK
#define FILLMASK 7
#endif
constexpr int PH_PER_LAYER = 11, N_PHASES = 1 + 2 * PH_PER_LAYER;
#ifndef MK_N_LAUNCHES
#define MK_N_LAUNCHES 1
#endif
constexpr int N_LAUNCHES = MK_N_LAUNCHES;

__global__ void __launch_bounds__(NWAVES * 64, 2) mk_fwd(Args) {
    KArgs ka = (KArgs)__builtin_amdgcn_kernarg_segment_ptr(); asm volatile("" : "+s"(ka));
#define args (*ka)
    extern __shared__ __attribute__((aligned(16))) unsigned char lds[];
    Frame F;
    F.lds = (LAS unsigned char*)lds;
    F.MISC = (volatile LAS unsigned*)(F.lds + MISC_OFF);
    F.tid = threadIdx.x; F.lane = F.tid & 63; F.wave = __builtin_amdgcn_readfirstlane(F.tid >> 6);
    F.G = gridDim.x; F.gw = blockIdx.x * NWAVES + F.wave; F.NGW = F.G * NWAVES;
    F.ws = args.ws; F.ctl = (gu32*)(args.ws + WS_CTL);
    unsigned char* ws = args.ws;
    for (int u = F.tid; u < (LDS_BYTES - LDSCTL_OFF) / 4; u += NWAVES * 64) ((LAS unsigned*)(F.lds + LDSCTL_OFF))[u] = 0u;
    __syncthreads();
    XcdBarrier bar; bar.bar = (unsigned*)(F.ctl + CW_BAR) + args.li * 4096; bar.x = 0; bar.st = nullptr;
    if (N_LAUNCHES != N_PHASES) bar = xcd_barrier_post((unsigned*)(F.ctl + CW_BAR) + args.li * 4096, F.MISC + 8);
#define GRID_BAR() do { if (N_LAUNCHES != N_PHASES) xcd_barrier(bar); } while (0)
    const int lo = args.ph_lo, hi = args.ph_hi;
#define IN(k) (lo <= (k) && (k) < hi)
#define BOTH(k) (IN(k) && IN((k) + 1))

#define x_in (args.in[0])
#define XN8 ((unsigned char*)(ws + WS_XN))
#define WIN ((bf16*)(ws + WS_WIN))
#define WUP ((bf16*)(ws + WS_WUP))
#define WMEM ((bf16*)(ws + WS_WMEM))
#define WOUT ((bf16*)(ws + WS_WOUT))
#define WGU ((bf16*)(ws + WS_WGU))
#define WDN ((bf16*)(ws + WS_WDN))
#define MGU ((bf16*)(ws + WS_MGU))
#define MDN ((bf16*)(ws + WS_MDN))
#define XN ((bf16*)(ws + WS_XN))
#define MEMN ((bf16*)(ws + WS_MEMN))
#define MEMKV ((bf16*)(ws + WS_MEMKV))
#define PROJ ((bf16*)(ws + WS_PROJ))
#define AQKV ((bf16*)(ws + WS_AQKV))
#define KROPE ((bf16*)(ws + WS_KROPE))
#define ROPECS ((float*)(ws + WS_ROPECS))
#define QKVM ((bf16*)(ws + WS_QKVM))
#define YPRE ((att::OT*)(ws + WS_YPRE))
#define YPREF ((float*)(ws + WS_YPRE))
#define DILO ((att::OT*)(ws + WS_DILO))
#define DILS ((float*)(ws + WS_DILS))
#define Y ((bf16*)(ws + WS_Y))
#define XA ((float*)(ws + WS_XA))
#define ROUTE ((unsigned*)(ws + WS_ROUTE))
#define XP ((bf16*)(ws + WS_XP))
#define OUTP ((bf16*)(ws + WS_OUTP))
#define OUTQ ((bf16*)(ws + WS_OUTQ))
#define ACTP ((bf16*)(ws + WS_ACTP))
#define ACT ((bf16*)(ws + WS_ACTP))
#if defined(PROBE_T)
#define TSTAMP_AT(p) do { if (threadIdx.x == 0) { ((volatile LAS unsigned*)(F.lds + 131520))[(p)] = (unsigned)__builtin_amdgcn_s_memrealtime(); ((volatile LAS unsigned*)(F.lds + 131520))[32 + (p)] = (unsigned)__builtin_amdgcn_s_memtime(); } } while (0)
#else
#define TSTAMP_AT(p) do { } while (0)
#endif
#define PHASE_BEGIN() do { int t_ = threadIdx.x; asm volatile("" : "+v"(t_)); F.tid = t_; F.lane = t_ & 63; asm volatile("" : "+s"(ka)); } while (0)

    if (PEN(0) && IN(0)) { PHASE_BEGIN(); TSTAMP_AT(0);
        LAS float* scr = (LAS float*)(F.lds + F.wave * 16384);
        { const v4u z = {0u, 0u, 0u, 0u}; const int gt = blockIdx.x * (NWAVES * 64) + F.tid, ngt = F.G * NWAVES * 64;
          for (int l = 0; l < 2; ++l) {
              GAS v4u* w = (GAS v4u*)(WIN + (size_t)l * DINP * D + (size_t)576 * D); for (int i = gt; i < 192 * D / 8; i += ngt) w[i] = z;
              GAS v4u* u = (GAS v4u*)(WUP + (size_t)l * NUP * AQ);
              for (int i = gt; i < NUP * 64; i += ngt) { const int row = i >> 6, c = i & 63; const bool zero = row < 1152 ? (c >= 48) : (row < 1280 ? true : (c < 48)); if (zero) u[i] = z; } } }
        for (int rep = 0; rep < (REPEAT_PHASE == 0 ? 2 : 1); ++rep) {
        for (int l = 0; l < 2; ++l) {
            cvt_job<false>(F, args.in[5] + (size_t)l * D * DIN, D, DIN, WIN + (size_t)l * DINP * D, D, 0, 3, 0, scr, 1.f);
            cvt_job<false, FOLD_PRE != 0>(F, args.in[7] + (size_t)l * QR * 1152, QR, 1152, WUP + (size_t)l * NUP * AQ, AQ, 0, 0, 0, scr, 1.f, args.in[6] + l * QR);
            cvt_job<false, FOLD_PRE != 0>(F, args.in[9] + (size_t)l * KVR * 1536, KVR, 1536, WUP + (size_t)l * NUP * AQ, AQ, QR, 0, UC_KV, scr, 1.f, args.in[8] + l * KVR);
            cvt_job<false>(F, args.in[11] + (size_t)l * D * 1024, D, 1024, WMEM + (size_t)l * 1024 * D, D, 0, 0, 0, scr, 1.f);
            cvt_job<false>(F, args.in[13] + (size_t)l * D * D, D, D, WOUT + (size_t)l * D * D, D, 0, 0, 0, scr, 1.f);
        }
        cvt_job<F8D>(F, args.in[15], D, DFF, WGU, D, 0, 1, 0, scr, Sc<F8D>::w_gu);
        cvt_job<F8D>(F, args.in[16], D, DFF, WGU, D, 0, 2, 0, scr, Sc<F8D>::w_gu);
        cvt_job<F8D>(F, args.in[17], DFF, D, WDN, DFF, 0, 0, 0, scr, Sc<F8D>::w_dn);
        }
        { const int* pos = (const int*)args.in[2];
          for (int idx = blockIdx.x * (NWAVES * 64) + F.tid; idx < S * 32; idx += F.G * NWAVES * 64) { const int row = idx >> 5, i = idx & 31;
              const float ang = (float)pos[row] * args.invf[i]; float c, s; sincos_f64(ang, c, s); ROPECS[row * 64 + i] = c; ROPECS[row * 64 + 32 + i] = s; } }
        for (int m = F.gw; m < 2 * NMEM; m += F.NGW) { const int l = m >> 8, r = m & 255; rms_row_to_bf16(args.in[1] + (size_t)r * D, args.in[10] + (size_t)l * D, MEMN + (size_t)m * D, F.lane); }
        for (int m = F.gw; m < S; m += F.NGW) rms_row_to_bf16(x_in + (size_t)m * D, args.in[4], XN + (size_t)m * D, F.lane);
        if (BOTH(0)) GRID_BAR();
    }

    for (int l = 0; l < 2; ++l) {
        const int pb = 1 + l * PH_PER_LAYER;
        if (PEN(1) && IN(pb + 0)) { PHASE_BEGIN(); TSTAMP_AT(pb + 0);
            { pg8::Gemm g{XN, WIN + (size_t)l * DINP * D, 2 * D, 2 * D, D / 64}; pg8::InProjOrder So; So.so.init(S, DINP, F.G, (int)blockIdx.x); So.nextra = (l == 0) ? 8 : 0; So.A2 = MEMN; So.B2 = WMEM;
              pg8::EpiBf16Sel E{PROJ, DINP, MEMKV, 1024};
              pg8::gemm_phase<pg8::EpiBf16Sel, pg8::InProjOrder, true, SP2V>(F.lds, g, So, E); }
            if (FILLMASK & 1) FILL(pb + 0);
            if (BOTH(pb + 0)) GRID_BAR();
        }
        if (!FOLD_PRE && PEN(2) && IN(pb + 1)) { PHASE_BEGIN(); TSTAMP_AT(pb + 1);
            const float* gq = args.in[6] + l * QR; const float* gkv = args.in[8] + l * KVR;
            const float* gp = F.lane < 48 ? gq + F.lane * 8 : gkv + (F.lane - 48) * 8;
            const f32x4 g0 = *(const GAS f32x4*)gp, g1 = *(const GAS f32x4*)(gp + 4);
            const int c = F.lane & 7;
            constexpr int PR = PRE_ROWS;
            for (int m0 = F.gw; m0 < S; m0 += PR * F.NGW) {
                v4u w_[PR], kw_[PR]; f32x4 cs_[PR][4];
#pragma unroll
                for (int r = 0; r < PR; ++r) { const int mr = m0 + r * F.NGW, m = mr < S ? mr : m0;
                    w_[r] = *(const GAS v4u*)(PROJ + (size_t)m * DINP + F.lane * 8);
                    kw_[r] = *(const GAS v4u*)(PROJ + (size_t)m * DINP + 512 + c * 8);
                    const float* cs = ROPECS + (size_t)m * 64 + (c & 3) * 8;
                    cs_[r][0] = *(const GAS f32x4*)cs; cs_[r][1] = *(const GAS f32x4*)(cs + 4); cs_[r][2] = *(const GAS f32x4*)(cs + 32); cs_[r][3] = *(const GAS f32x4*)(cs + 36); }
#pragma unroll
                for (int r = 0; r < PR; ++r) { const int m = m0 + r * F.NGW; if (m >= S) break;
                    const v4u w = w_[r];
                    float v[8] = {bflo(w.x), bfhi(w.x), bflo(w.y), bfhi(w.y), bflo(w.z), bfhi(w.z), bflo(w.w), bfhi(w.w)};
                    float sq = 0.f;
#pragma unroll
                    for (int j = 0; j < 8; ++j) sq += v[j] * v[j];
                    const float sq_q = wave_sum(F.lane < 48 ? sq : 0.f), sq_kv = wave_sum(F.lane >= 48 ? sq : 0.f);
                    const float rstd = F.lane < 48 ? 1.f / sqrtf(sq_q * (1.f / QR) + EPS) : 1.f / sqrtf(sq_kv * (1.f / KVR) + EPS);
                    v4u o; o.x = pk2(v[0] * rstd * g0.x, v[1] * rstd * g0.y); o.y = pk2(v[2] * rstd * g0.z, v[3] * rstd * g0.w);
                    o.z = pk2(v[4] * rstd * g1.x, v[5] * rstd * g1.y); o.w = pk2(v[6] * rstd * g1.z, v[7] * rstd * g1.w);
                    *(GAS v4u*)(AQKV + (size_t)m * AQ + F.lane * 8) = o;
                    const v4u kw = kw_[r];
                    float kv[8] = {bflo(kw.x), bfhi(kw.x), bflo(kw.y), bfhi(kw.y), bflo(kw.z), bfhi(kw.z), bflo(kw.w), bfhi(kw.w)};
                    float ko[8];
#pragma unroll
                    for (int j = 0; j < 8; ++j) { const float other = __shfl_xor(kv[j], 4); const float co = cs_[r][j >> 2][j & 3], si = cs_[r][2 + (j >> 2)][j & 3];
                        ko[j] = (c < 4) ? (kv[j] * co - other * si) : (other * si + kv[j] * co); }
                    if (F.lane < 8) { v4u ow; ow.x = pk2(ko[0], ko[1]); ow.y = pk2(ko[2], ko[3]); ow.z = pk2(ko[4], ko[5]); ow.w = pk2(ko[6], ko[7]); *(GAS v4u*)(KROPE + (size_t)m * 64 + c * 8) = ow; }
                }
            }
            if (BOTH(pb + 1)) GRID_BAR();
        }
        if (PEN(3) && IN(pb + 2)) { PHASE_BEGIN(); TSTAMP_AT(pb + 2);
#if UP_EXACT && FOLD_PRE
            { const int c = F.lane & 7;
              for (int m8 = F.gw * 8; m8 < S; m8 += F.NGW * 8) { const int m = m8 + (F.lane >> 3);
                  const v4u kw = *(const GAS v4u*)(PROJ + (size_t)m * DINP + 512 + c * 8);
                  const float* cs = ROPECS + (size_t)m * 64 + (c & 3) * 8;
                  const f32x4 c0 = *(const GAS f32x4*)cs, c1 = *(const GAS f32x4*)(cs + 4), s0 = *(const GAS f32x4*)(cs + 32), s1 = *(const GAS f32x4*)(cs + 36);
                  const float co[8] = {c0.x, c0.y, c0.z, c0.w, c1.x, c1.y, c1.z, c1.w}, si[8] = {s0.x, s0.y, s0.z, s0.w, s1.x, s1.y, s1.z, s1.w};
                  float kv[8] = {bflo(kw.x), bfhi(kw.x), bflo(kw.y), bfhi(kw.y), bflo(kw.z), bfhi(kw.z), bflo(kw.w), bfhi(kw.w)};
                  float ko[8];
#pragma unroll
                  for (int j = 0; j < 8; ++j) { const float other = __shfl_xor(kv[j], 4); ko[j] = (c < 4) ? (kv[j] * co[j] - other * si[j]) : (other * si[j] + kv[j] * co[j]); }
                  v4u ow; ow.x = pk2(ko[0], ko[1]); ow.y = pk2(ko[2], ko[3]); ow.z = pk2(ko[4], ko[5]); ow.w = pk2(ko[6], ko[7]); *(GAS v4u*)(KROPE + (size_t)m * 64 + c * 8) = ow; } }
            pg8::UpProjOrder So{F.G, (int)blockIdx.x};
            { pg8::Unit u;
              for (int i = 0; So.next(i, u); ++i) { if (u.pn >= 5) up_rs_rows<2>(F, PROJ + (size_t)u.pm * 256 * DINP + 384, i, 1.f / KVR); else up_rs_rows<6>(F, PROJ + (size_t)u.pm * 256 * DINP, i, 1.f / QR); }
              __syncthreads(); }
            pg8::Gemm g{PROJ, WUP + (size_t)l * NUP * AQ, 2 * DINP, 2 * AQ, AQ / 64};
            pg8::EpiBf16R E{QKVM, NUP, (const LAS float*)(F.lds + BIAS_OFF)};
            pg8::gemm_phase<pg8::EpiBf16R, pg8::UpProjOrder, true, SP2V>(F.lds, g, So, E);
#elif UP_EXACT
            pg8::Gemm g{AQKV, WUP + (size_t)l * NUP * AQ, 2 * AQ, 2 * AQ, AQ / 64}; pg8::UpProjOrder So{F.G, (int)blockIdx.x};
            pg8::EpiBf16 E{QKVM, NUP, 1.f};
            pg8::gemm_phase<pg8::EpiBf16, pg8::UpProjOrder, true, SP2V>(F.lds, g, So, E);
#else
            pg8::Gemm g{AQKV, WUP + (size_t)l * NUP * AQ, 2 * AQ, 2 * AQ, AQ / 64}; pg8::StaticOrder So; So.init(S, NUP, F.G, (int)blockIdx.x);
            pg8::EpiBf16 E{QKVM, NUP, 1.f};
            pg8::gemm_phase<pg8::EpiBf16, pg8::StaticOrder, true, SP2V>(F.lds, g, So, E);
#endif
            if (FILLMASK & 2) FILL(pb + 2);
            if (BOTH(pb + 2)) GRID_BAR();
        }
        if (PEN(4) && IN(pb + 3)) { PHASE_BEGIN(); TSTAMP_AT(pb + 3);
            LAS float* BIAS = (LAS float*)(F.lds + BIAS_OFF);
            for (int i = F.tid; i < 3 * 6 * 129; i += NWAVES * 64) { const int b = i / (6 * 129), rem = i % (6 * 129), h = rem / 129, j = rem % 129;
                BIAS[(b * 6 + h) * 132 + j] = args.in[3][DIL_BUCKET[b][j] * 6 + h] * att::LOG2E; }
            __syncthreads();
            for (int rep = 0; rep < (REPEAT_PHASE == 4 ? 2 : 1); ++rep) {
            gu32* qhead = F.ctl + CW_QUEUE + 64 * l + 32 * rep + 4 * args.li;
            constexpr int NU_MLA = 6 * 32, NU_MEM = 4 * 32, NU_DIL = 3 * 6 * 32, NU = NU_MLA + NU_MEM + NU_DIL;
            const bool mla_static = MLA_XCD_STATIC && F.G == 256; const int qbase = mla_static ? NU_MLA : 0;
#define QPULL(u) do { if (F.tid == 0) F.MISC[16] = __hip_atomic_fetch_add(qhead, 1u, RLX_AGENT); __syncthreads(); u = qbase + (int)F.MISC[16]; __syncthreads(); } while (0)
            int u;
            if (mla_static && (int)(blockIdx.x >> 3) < 24) u = 24 * (int)(blockIdx.x & 7) + (int)(blockIdx.x >> 3); else QPULL(u);
            if ((ATT_EN & 1) && (!args.rep || (PROBE_ATT & 1))) while (u < NU_MLA) {
                const int h = u >> 5, qb = u & 31;
                att::MLA_BODY<NUP, NUP, D>(QKVM + (size_t)qb * 256 * NUP + h * 192, QKVM + UC_KV + h * 256, KROPE, QKVM + UC_KV + h * 256 + 128,
                                                        ROPECS + (size_t)qb * 256 * 64, YPRE + (size_t)qb * 256 * D + h * 128, S, 0.07216878364870322f, (LAS char*)F.lds);
                QPULL(u);
            }
            if (args.rep && !(PROBE_ATT & 1)) { while (u < NU_MLA) QPULL(u); }
            if ((ATT_EN & 2) && (!args.rep || (PROBE_ATT & 2))) while (u < NU_MLA + NU_MEM) {
                const int v = u - NU_MLA, h = v >> 5, qb = v & 31;
                const bf16* kv = MEMKV + (size_t)l * NMEM * 1024;
                att::attn_dense_body<128, DINP, 1024, D, 1>(PROJ + (size_t)qb * 256 * DINP + PC_MEM + h * 128, kv + h * 128, nullptr, kv + 512 + h * 128,
                                                            nullptr, YPRE + (size_t)qb * 256 * D + 1536 + h * 128, NMEM, 0.08838834764831845f, (LAS char*)F.lds);
                QPULL(u);
            }
            if (args.rep && !(PROBE_ATT & 2)) { while (u < NU_MLA + NU_MEM) QPULL(u); }
            if ((ATT_EN & 4) && (!args.rep || (PROBE_ATT & 4))) while (u < NU) {
                const int w = (u - NU_MLA - NU_MEM) * 8;
                const int b = w / 1536, h = (w % 1536) >> 8, tile = w & 255;
                const int d = b == 0 ? 1 : (b == 1 ? 4 : 16), nT = S / d, tpr = nT / 32;
                const int r = tile / tpr, t0 = (tile % tpr) * 32;
                LAS float* TB = (LAS float*)(F.lds + BIAS_OFF + 3 * 6 * 132 * 4);
                for (int i = F.tid; i < 4 * 196; i += NWAVES * 64) { const int k = i / 196, j = (i % 196) + k - 32; TB[i] = (j >= 0 && j <= 128) ? BIAS[(b * 6 + h) * 132 + j] : -1e30f; }
                __syncthreads();
                att::dil_wg_unit<DINP>(PROJ, PC_DIL + h * 128, PC_DIL + 768 + h * 128, PC_DIL + 1536 + h * 128, d, r, t0, nT,
                                       DILO + (size_t)b * S * 768, h * 128, DILS + (size_t)b * S * 12 + h * 2, (LAS char*)F.lds, TB, 0.08838834764831845f * att::LOG2E);
                QPULL(u);
            }
#undef QPULL
            }
            if (FILLMASK & 4) FILL(pb + 3);
            if (BOTH(pb + 3)) GRID_BAR();
        }
        if (PEN(5) && IN(pb + 4)) { PHASE_BEGIN(); TSTAMP_AT(pb + 4);
            const float* gn = args.in[12] + (size_t)l * D;
            constexpr int CR = COMB_ROWS;
            typedef decltype(ld_r4((const att::OT*)nullptr)) RawO;
            for (int m0 = F.gw; m0 < S; m0 += CR * F.NGW) {
                RawO ya[CR][3], yc[CR][2], ob[CR][3][3]; f32x2 st[CR][3][3];
#pragma unroll
                for (int r = 0; r < CR; ++r) { const int mr = m0 + r * F.NGW, m = mr < S ? mr : m0; const att::OT* yr = YPRE + (size_t)m * D;
#pragma unroll
                    for (int j = 0; j < 3; ++j) ya[r][j] = ld_r4(yr + (F.lane + 64 * j) * 4);
#pragma unroll
                    for (int j = 0; j < 2; ++j) yc[r][j] = ld_r4(yr + 1536 + (F.lane + 64 * j) * 4);
#pragma unroll
                    for (int j = 0; j < 3; ++j) { const int col = (F.lane + 64 * j) * 4, h = col >> 7;
#pragma unroll
                        for (int b = 0; b < 3; ++b) { st[r][j][b] = *(const GAS f32x2*)(DILS + ((size_t)b * S + m) * 12 + h * 2); ob[r][j][b] = ld_r4(DILO + ((size_t)b * S + m) * 768 + col); } } }
#pragma unroll
                for (int r = 0; r < CR; ++r) { const int m = m0 + r * F.NGW; if (m >= S) break;
                    f32x4 a[3]; float sa = 0.f;
#pragma unroll
                    for (int j = 0; j < 3; ++j) { a[j] = cv4(ya[r][j]); sa += (a[j].x * a[j].x + a[j].y * a[j].y) + (a[j].z * a[j].z + a[j].w * a[j].w); }
                    f32x4 c[2]; float sc = 0.f;
#pragma unroll
                    for (int j = 0; j < 2; ++j) { c[j] = cv4(yc[r][j]); sc += (c[j].x * c[j].x + c[j].y * c[j].y) + (c[j].z * c[j].z + c[j].w * c[j].w); }
                    f32x4 bq[3]; float sb = 0.f;
#pragma unroll
                    for (int j = 0; j < 3; ++j) {
                        const float M = fmaxf(st[r][j][0].x, fmaxf(st[r][j][1].x, st[r][j][2].x));
                        float wgt[3], den = 0.f;
#pragma unroll
                        for (int b = 0; b < 3; ++b) { wgt[b] = __builtin_amdgcn_exp2f(st[r][j][b].x - M); den += wgt[b] * st[r][j][b].y; }
                        const float inv = 1.f / den; f32x4 acc = {0.f, 0.f, 0.f, 0.f};
#pragma unroll
                        for (int b = 0; b < 3; ++b) acc += cv4(ob[r][j][b]) * (wgt[b] * inv);
                        bq[j] = acc; sb += (acc.x * acc.x + acc.y * acc.y) + (acc.z * acc.z + acc.w * acc.w); }
                    const float ra = 1.f / sqrtf(wave_sum(sa) * (1.f / 768.f) + EPS), rb = 1.f / sqrtf(wave_sum(sb) * (1.f / 768.f) + EPS), rc = 1.f / sqrtf(wave_sum(sc) * (1.f / 512.f) + EPS);
                    bf16* yo = Y + (size_t)m * D;
#pragma unroll
                    for (int j = 0; j < 3; ++j) { const int col = (F.lane + 64 * j) * 4; const f32x4 g = *(const GAS f32x4*)(gn + col);
                        v2u w; w.x = pk2(a[j].x * ra * g.x, a[j].y * ra * g.y); w.y = pk2(a[j].z * ra * g.z, a[j].w * ra * g.w); *(GAS v2u*)(yo + col) = w; }
#pragma unroll
                    for (int j = 0; j < 3; ++j) { const int col = (F.lane + 64 * j) * 4; const f32x4 g = *(const GAS f32x4*)(gn + 768 + col);
                        v2u w; w.x = pk2(bq[j].x * rb * g.x, bq[j].y * rb * g.y); w.y = pk2(bq[j].z * rb * g.z, bq[j].w * rb * g.w); *(GAS v2u*)(yo + 768 + col) = w; }
#pragma unroll
                    for (int j = 0; j < 2; ++j) { const int col = (F.lane + 64 * j) * 4; const f32x4 g = *(const GAS f32x4*)(gn + 1536 + col);
                        v2u w; w.x = pk2(c[j].x * rc * g.x, c[j].y * rc * g.y); w.y = pk2(c[j].z * rc * g.z, c[j].w * rc * g.w); *(GAS v2u*)(yo + 1536 + col) = w; }
                }
            }
            if (BOTH(pb + 4)) GRID_BAR();
        }
        if (PEN(6) && IN(pb + 5)) { PHASE_BEGIN(); TSTAMP_AT(pb + 5);
            pg8::Gemm g{Y, WOUT + (size_t)l * D * D, 2 * D, 2 * D, D / 64}; pg8::StaticOrder So; So.init(S, D, F.G, (int)blockIdx.x);
            pg8::EpiResF32 E{l == 0 ? x_in : XA, args.rep ? YPREF : XA, D, 1.f};
            pg8::gemm_phase<pg8::EpiResF32, pg8::StaticOrder, true, SP2V>(F.lds, g, So, E);
            if (BOTH(pb + 5)) GRID_BAR();
        }
        if (PEN(7) && IN(pb + 6)) { PHASE_BEGIN(); TSTAMP_AT(pb + 6);
            const float* gf = args.in[14] + (size_t)l * D;
#if defined(PROBE_DEADLINE)
            if (l == 1 && blockIdx.x == 0 && F.tid == 0) F.ctl[CW_CVT + 16] = __hip_atomic_load(F.ctl + CW_CVT, RLX_AGENT);
#endif
            if (l == 0) { for (int m = F.gw; m < S; m += F.NGW) { if constexpr (F8D) rms_row_to_fp8(XA + (size_t)m * D, gf, XN8 + (size_t)m * D, F.lane); else rms_row_to_bf16(XA + (size_t)m * D, gf, XN + (size_t)m * D, F.lane); } }
            else {
                const float* Wr = args.in[18];
                LAS unsigned* LC = (LAS unsigned*)F.lds;
                if (F.tid < NE) LC[F.tid] = 0u;
                LAS f32x4* WL = (LAS f32x4*)(F.lds + 1024);
                for (int i = F.tid; i < 2048 * 2; i += NWAVES * 64) { const int half = i & 1, idx = i >> 1, ln = idx & 63, jq = idx >> 6, j = jq >> 2, q = jq & 3, k = (ln + 64 * j) * 4 + q;
                    WL[i] = *(const GAS f32x4*)(Wr + (size_t)k * NE + half * 4); }
                __syncthreads();
                for (int m = F.gw; m < S; m += F.NGW) {
                    const GAS f32x4* xr = (const GAS f32x4*)(XA + (size_t)m * D) + F.lane; const GAS f32x4* gr = (const GAS f32x4*)gf + F.lane;
                    f32x4 v[8]; float s = 0.f;
#pragma unroll
                    for (int j = 0; j < 8; ++j) { v[j] = xr[64 * j]; s += (v[j].x * v[j].x + v[j].y * v[j].y) + (v[j].z * v[j].z + v[j].w * v[j].w); }
                    const float rstd = 1.f / sqrtf(wave_sum(s) * (1.f / D) + EPS);
                    float lg[8] = {0.f, 0.f, 0.f, 0.f, 0.f, 0.f, 0.f, 0.f};
                    GAS v2u* o8 = (GAS v2u*)(XN + (size_t)m * D) + F.lane; GAS unsigned* o4 = (GAS unsigned*)(XN8 + (size_t)m * D) + F.lane;
#pragma unroll
                    for (int j = 0; j < 8; ++j) { const f32x4 gg = gr[64 * j]; const f32x4 hh = {v[j].x * rstd * gg.x, v[j].y * rstd * gg.y, v[j].z * rstd * gg.z, v[j].w * rstd * gg.w};
                        if constexpr (F8M) o4[64 * j] = pk4_fp8(hh.x, hh.y, hh.z, hh.w); else { v2u w; w.x = pk2(hh.x, hh.y); w.y = pk2(hh.z, hh.w); o8[64 * j] = w; }
#pragma unroll
                        for (int q = 0; q < 4; ++q) { const f32x4 w0 = WL[(((j * 4 + q) * 64) + F.lane) * 2], w1 = WL[(((j * 4 + q) * 64) + F.lane) * 2 + 1]; const float hv = hh[q];
                            lg[0] += hv * w0.x; lg[1] += hv * w0.y; lg[2] += hv * w0.z; lg[3] += hv * w0.w; lg[4] += hv * w1.x; lg[5] += hv * w1.y; lg[6] += hv * w1.z; lg[7] += hv * w1.w; } }
#pragma unroll
                    for (int e = 0; e < NE; ++e) lg[e] = wave_sum(lg[e]);
                    int e1 = 0; float v1 = lg[0];
#pragma unroll
                    for (int e = 1; e < NE; ++e) if (lg[e] > v1) { v1 = lg[e]; e1 = e; }
                    int e2 = -1; float v2 = -3.0e38f;
#pragma unroll
                    for (int e = 0; e < NE; ++e) if (e != e1 && lg[e] > v2) { v2 = lg[e]; e2 = e; }
                    const float g1 = 1.f / (1.f + __expf(v2 - v1)), g2 = 1.f - g1;
                    if (F.lane == 0) { const unsigned s1 = __hip_atomic_fetch_add(LC + e1, 1u, __ATOMIC_RELAXED, __HIP_MEMORY_SCOPE_WORKGROUP), s2 = __hip_atomic_fetch_add(LC + e2, 1u, __ATOMIC_RELAXED, __HIP_MEMORY_SCOPE_WORKGROUP);
                        v4u r0 = {(unsigned)e1, (unsigned)e2, s1, s2}; v4u r1 = {__float_as_uint(g1), __float_as_uint(g2), 0u, 0u};
                        *(GAS v4u*)(ROUTE + (size_t)m * 8) = r0; *(GAS v4u*)(ROUTE + (size_t)m * 8 + 4) = r1; }
                }
                __syncthreads();
                if (F.tid < NE) F.ctl[CW_CNTW + blockIdx.x * NE + F.tid] = LC[F.tid];
            }
            if (BOTH(pb + 6)) GRID_BAR();
        }
        if (PEN(8) && IN(pb + 7)) { PHASE_BEGIN(); TSTAMP_AT(pb + 7);
            if (l == 1) {
                moe_cvt_fill(F, ka, -1);
#if defined(PROBE_DEADLINE)
                for (int r_ = 0; r_ < PROBE_DEADLINE; ++r_) { __syncthreads(); moe_cvt_fill(F, ka, -2); }
#endif
                { LAS unsigned* LT = (LAS unsigned*)F.lds;
                  int tot = 0, bel = 0;
                  for (int w = F.lane; w < F.G; w += 64) { const int c = (int)F.ctl[CW_CNTW + w * NE + F.wave]; tot += c; bel += (w < (int)blockIdx.x) ? c : 0; }
#pragma unroll
                  for (int o = 1; o < 64; o <<= 1) { tot += __shfl_xor(tot, o); bel += __shfl_xor(bel, o); }
                  __syncthreads();
                  if (F.lane == 0) { LT[F.wave] = (unsigned)tot; LT[NE + F.wave] = (unsigned)bel; }
                  __syncthreads(); }
                int base[NE]; int tstart = 0;
#pragma unroll
                for (int e = 0; e < NE; ++e) { const int c = (int)((LAS unsigned*)F.lds)[e]; base[e] = tstart * 256 + (int)((LAS unsigned*)F.lds)[NE + e]; const int nt = (c + 255) >> 8;
                    if (blockIdx.x == 0 && F.tid == 0) { for (int t = 0; t < nt; ++t) F.ctl[CW_TILEE + 1 + tstart + t] = (unsigned)e; }
                    tstart += nt; }
                if (blockIdx.x == 0 && F.tid == 0) F.ctl[CW_TILEE] = (unsigned)tstart;
                for (int m = F.gw; m < S; m += F.NGW) {
                    const v4u r0 = *(const GAS v4u*)(ROUTE + (size_t)m * 8);
                    int p1 = (int)r0.z, p2 = (int)r0.w;
#pragma unroll
                    for (int e = 0; e < NE; ++e) { if ((int)r0.x == e) p1 += base[e]; if ((int)r0.y == e) p2 += base[e]; }
                    if (F.lane == 0) { ROUTE[(size_t)m * 8 + 6] = (unsigned)p1; ROUTE[(size_t)m * 8 + 7] = (unsigned)p2; }
                    const unsigned char* srow = (const unsigned char*)XN8 + (size_t)m * D * EBM; unsigned char* xp = (unsigned char*)XP;
                    const GAS v4u* src = (const GAS v4u*)srow + F.lane; GAS v4u* d1 = (GAS v4u*)(xp + (size_t)p1 * D * EBM) + F.lane; GAS v4u* d2 = (GAS v4u*)(xp + (size_t)p2 * D * EBM) + F.lane;
#pragma unroll
                    for (int j = 0; j < 2 * EBM; ++j) { const v4u t = src[64 * j]; d1[64 * j] = t; d2[64 * j] = t; }
                }
            }
            if (BOTH(pb + 7) && l == 1) GRID_BAR();
        }
        if (PEN(9) && IN(pb + 8)) { PHASE_BEGIN(); TSTAMP_AT(pb + 8);
            if (l == 0) { pg8::Gemm g{XN8, WGU, D * EBD, D * EBD, D * EBD / 128}; pg8::StaticOrder So; So.init(S, 2 * DFF, F.G, (int)blockIdx.x);
                FfnEpi1<F8D> E = Epi1Maker<F8D>::make(ACT, DFF);
                pg8::gemm_phase<FfnEpi1<F8D>, pg8::StaticOrder, true, SP2V, F8D>(F.lds, g, So, E);
                if (FILLMASK & 8) FILL(pb + 8); }
            else { const int ntile = (int)__hip_atomic_load(F.ctl + CW_TILEE, RLX_AGENT);
                pg8::Gemm g{XP, MGU, D * EBM, D * EBM, D * EBM / 128}; pg8::MoeOrder So{F.G, (int)blockIdx.x, 2 * DFE / 256, ntile, 2 * DFE, (const int*)(F.ctl + CW_TILEE + 1)};
                FfnEpi1<F8M> E = Epi1Maker<F8M>::make(ACTP, DFE);
                pg8::gemm_phase<FfnEpi1<F8M>, pg8::MoeOrder, true, SP2V, F8M>(F.lds, g, So, E); }
            if (BOTH(pb + 8)) GRID_BAR();
        }
        if (PEN(10) && IN(pb + 9)) { PHASE_BEGIN(); TSTAMP_AT(pb + 9);
            if (l == 0) { pg8::Gemm g{ACT, WDN, DFF * EBD, DFF * EBD, DFF * EBD / 128}; pg8::StaticOrder So; So.init(S, D, F.G, (int)blockIdx.x);
                pg8::EpiResF32 E{XA, args.rep ? YPREF : XA, D, Sc<F8D>::dn};
                pg8::gemm_phase<pg8::EpiResF32, pg8::StaticOrder, true, SP2V, F8D>(F.lds, g, So, E); }
            else { const int ntile = (int)__hip_atomic_load(F.ctl + CW_TILEE, RLX_AGENT);
                const int pm0 = MOE_TAIL ? ((2 * F.G / 8) < ntile ? (2 * F.G / 8) : ntile) : ntile;
                { pg8::Gemm g{ACTP, MDN, DFE * EBM, DFE * EBM, DFE * EBM / 128}; pg8::MoeOrder So{F.G, (int)blockIdx.x, D / 256, pm0, D, (const int*)(F.ctl + CW_TILEE + 1)};
                  pg8::EpiBf16 E{OUTP, D, Sc<F8M>::dn};
                  pg8::gemm_phase<pg8::EpiBf16, pg8::MoeOrder, true, SP2V, F8M>(F.lds, g, So, E); }
                if (MOE_TAIL && ntile > pm0) { pg8::Gemm g{ACTP, MDN, DFE * EBM, DFE * EBM, DFE * EBM / 512}; pg8::MoeTailOrder So{F.G, (int)blockIdx.x, pm0, ntile - pm0, D, DFE * EBM / 4, (const int*)(F.ctl + CW_TILEE + 1)};
                  pg8::EpiBf16Split E{OUTQ, D, Sc<F8M>::dn, pm0, (size_t)2048 * D};
                  pg8::gemm_phase<pg8::EpiBf16Split, pg8::MoeTailOrder, true, SP2V, F8M>(F.lds, g, So, E); } }
            if (BOTH(pb + 9)) GRID_BAR();
        }
        if (PEN(11) && IN(pb + 10)) { PHASE_BEGIN(); TSTAMP_AT(pb + 10);
            if (l == 0) { for (int m = F.gw; m < S; m += F.NGW) rms_row_to_bf16(XA + (size_t)m * D, args.in[4] + D, XN + (size_t)m * D, F.lane); }
            else {
                const float* gfin = args.in[22];
                const int ntile_f = (int)__hip_atomic_load(F.ctl + CW_TILEE, RLX_AGENT); const int prow0 = (MOE_TAIL ? ((2 * F.G / 8) < ntile_f ? (2 * F.G / 8) : ntile_f) : ntile_f) * 256;
                for (int m = F.gw; m < S; m += F.NGW) {
                    const v4u r1 = *(const GAS v4u*)(ROUTE + (size_t)m * 8 + 4);
                    const float g1 = __uint_as_float(r1.x), g2 = __uint_as_float(r1.y); const int p1 = (int)r1.z, p2 = (int)r1.w;
                    const GAS f32x4* xr = (const GAS f32x4*)(XA + (size_t)m * D) + F.lane;
                    const GAS v2u* o1 = (const GAS v2u*)(OUTP + (size_t)p1 * D) + F.lane; const GAS v2u* o2 = (const GAS v2u*)(OUTP + (size_t)p2 * D) + F.lane;
                    const bool t1 = p1 >= prow0, t2 = p2 >= prow0;
                    const GAS v2u* q1 = (const GAS v2u*)(OUTQ + (size_t)(t1 ? p1 - prow0 : 0) * D) + F.lane; const GAS v2u* q2 = (const GAS v2u*)(OUTQ + (size_t)(t2 ? p2 - prow0 : 0) * D) + F.lane;
                    f32x4 v[8]; float s = 0.f;
                    if (!t1 && !t2) {
#pragma unroll
                        for (int j = 0; j < 8; ++j) { const f32x4 xv = xr[64 * j]; const v2u a = o1[64 * j], b = o2[64 * j];
                            v[j] = xv + (f32x4){bflo(a.x), bfhi(a.x), bflo(a.y), bfhi(a.y)} * g1 + (f32x4){bflo(b.x), bfhi(b.x), bflo(b.y), bfhi(b.y)} * g2;
                            s += (v[j].x * v[j].x + v[j].y * v[j].y) + (v[j].z * v[j].z + v[j].w * v[j].w); }
                    } else
#pragma unroll
                    for (int j = 0; j < 8; ++j) { const f32x4 xv = xr[64 * j]; f32x4 ea, eb;
                        if (!t1) { const v2u a = o1[64 * j]; ea = (f32x4){bflo(a.x), bfhi(a.x), bflo(a.y), bfhi(a.y)}; }
                        else { ea = (f32x4){0.f, 0.f, 0.f, 0.f};
#pragma unroll
                            for (int k = 0; k < 4; ++k) { const v2u a = q1[(size_t)k * (2048 * D / 4) + 64 * j]; ea += (f32x4){bflo(a.x), bfhi(a.x), bflo(a.y), bfhi(a.y)}; } }
                        if (!t2) { const v2u b = o2[64 * j]; eb = (f32x4){bflo(b.x), bfhi(b.x), bflo(b.y), bfhi(b.y)}; }
                        else { eb = (f32x4){0.f, 0.f, 0.f, 0.f};
#pragma unroll
                            for (int k = 0; k < 4; ++k) { const v2u b = q2[(size_t)k * (2048 * D / 4) + 64 * j]; eb += (f32x4){bflo(b.x), bfhi(b.x), bflo(b.y), bfhi(b.y)}; } }
                        v[j] = xv + ea * g1 + eb * g2;
                        s += (v[j].x * v[j].x + v[j].y * v[j].y) + (v[j].z * v[j].z + v[j].w * v[j].w); }
                    const float rstd = 1.f / sqrtf(wave_sum(s) * (1.f / D) + EPS);
                    GAS f32x4* orow = (GAS f32x4*)(args.out + (size_t)m * D) + F.lane; const GAS f32x4* gr = (const GAS f32x4*)gfin + F.lane;
#pragma unroll
                    for (int j = 0; j < 8; ++j) { const f32x4 gg = gr[64 * j]; orow[64 * j] = (f32x4){v[j].x * rstd * gg.x, v[j].y * rstd * gg.y, v[j].z * rstd * gg.z, v[j].w * rstd * gg.w}; }
                }
            }
            if (BOTH(pb + 10) && l == 0) GRID_BAR();
        }
    }
#if defined(PROBE_BARS)
    for (int i_ = 0; i_ < PROBE_BARS; ++i_) xcd_barrier<PROBE_BARMODE>(bar);
#endif
#if defined(PROBE_T)
    if (blockIdx.x == 0 && threadIdx.x == 0) { const unsigned t_end = (unsigned)__builtin_amdgcn_s_memrealtime(); volatile LAS unsigned* ts_ = (volatile LAS unsigned*)(F.lds + 131520); ts_[N_PHASES] = t_end;
#if defined(PROBE_CLK)
        ts_[32 + N_PHASES] = (unsigned)__builtin_amdgcn_s_memtime(); const unsigned dt = (ts_[32 + PROBE_T + 1] - ts_[32 + PROBE_T]) / (16u * PROBE_TK);
#else
        const unsigned dt = ts_[PROBE_T + 1] - ts_[PROBE_T];
#endif
        while ((unsigned)__builtin_amdgcn_s_memrealtime() - t_end < (unsigned)PROBE_TK * dt) __builtin_amdgcn_s_sleep(32); }
#endif
#undef IN
#undef BOTH
#undef GRID_BAR
#undef WIN
#undef WUP
#undef WMEM
#undef WOUT
#undef WGU
#undef WDN
#undef MGU
#undef MDN
#undef XN
#undef MEMN
#undef MEMKV
#undef PROJ
#undef AQKV
#undef KROPE
#undef ROPECS
#undef QKVM
#undef YPRE
#undef YPREF
#undef DILO
#undef DILS
#undef Y
#undef XA
#undef ROUTE
#undef XP
#undef OUTP
#undef OUTQ
#undef ACTP
#undef ACT
#undef x_in
#undef XN8
#undef PHASE_BEGIN
#undef args
#undef FILL
}

extern "C" void kernel_launch(void* const* d_in, const int* in_sizes, int n_in, void* d_out, int out_size, void* d_ws, size_t ws_size, hipStream_t stream) {
    static int grid = 0;
    if (grid == 0) {
        if (n_in != 23 || in_sizes[0] != S * D || out_size != S * D || ws_size < WS_END) { fprintf(stderr, "kernel_launch: shape/workspace mismatch: n_in %d in0 %d out %d ws %zu (need %zu)\n", n_in, n_in > 0 ? in_sizes[0] : -1, out_size, ws_size, (size_t)WS_END); grid = -1; return; }
        int dev = 0, cus = 0, per_cu = 0;
        if (hipGetDevice(&dev) != hipSuccess || hipDeviceGetAttribute(&cus, hipDeviceAttributeMultiprocessorCount, dev) != hipSuccess) { fprintf(stderr, "kernel_launch: device query failed\n"); grid = -1; return; }
        if (hipFuncSetAttribute((const void*)mk_fwd, hipFuncAttributeMaxDynamicSharedMemorySize, LDS_BYTES) != hipSuccess) { fprintf(stderr, "kernel_launch: hipFuncSetAttribute failed\n"); grid = -1; return; }
        if (hipOccupancyMaxActiveBlocksPerMultiprocessor(&per_cu, (const void*)mk_fwd, NWAVES * 64, LDS_BYTES) != hipSuccess || per_cu < 1) { fprintf(stderr, "kernel_launch: occupancy query reports %d workgroups per CU\n", per_cu); }
        (void)hipGetLastError();
        grid = cus;
    }
    if (grid < 0) return;
    (void)hipMemsetAsync((char*)d_ws + WS_CTL, 0, CTL_ZERO_BYTES, stream);
    Args a{};
    for (int i = 0; i < 23; ++i) a.in[i] = (const float*)d_in[i];
    a.out = (float*)d_out; a.ws = (unsigned char*)d_ws;
    for (int i = 0; i < 32; ++i) a.invf[i] = 1.0f / powf(10000.0f, (float)i / 32.0f);
    int lo[8], hi[8], rp[8], nl = 0;
#if defined(PROBE_PHASE) && PROBE_PHASE >= 0
    lo[nl] = 0; hi[nl] = PROBE_PHASE + 1; rp[nl++] = 0;
    for (int r = 0; r < PROBE_REPS; ++r) { lo[nl] = PROBE_PHASE; hi[nl] = PROBE_PHASE + 1; rp[nl++] = 1; }
    if (PROBE_PHASE + 1 < N_PHASES) { lo[nl] = PROBE_PHASE + 1; hi[nl] = N_PHASES; rp[nl++] = 0; }
#else
    if (N_LAUNCHES == N_PHASES) { nl = 0; } else { lo[0] = 0; hi[0] = N_PHASES; rp[0] = 0; nl = 1; }
#endif
    const int total = (N_LAUNCHES == N_PHASES) ? N_PHASES : nl;
    for (int li = 0; li < total; ++li) {
        if (N_LAUNCHES == N_PHASES) { a.ph_lo = li; a.ph_hi = li + 1; a.li = 0; a.rep = 0; } else { a.ph_lo = lo[li]; a.ph_hi = hi[li]; a.li = li; a.rep = rp[li]; }
        hipLaunchKernelGGL(mk_fwd, dim3(grid), dim3(NWAVES * 64), LDS_BYTES, stream, a);
        const hipError_t le = hipPeekAtLastError();
        if (le != hipSuccess) { fprintf(stderr, "kernel_launch: launch %d failed: %s\n", li, hipGetErrorName(le)); break; }
    }
}
```
